# Optimizing an MI355X kernel written in HIP

```python
import jax
import jax.numpy as jnp
from jax import lax
import numpy as np

D_MODEL = 1024
BATCH = 8
SEQ = 2048
DEPTH = 4

GRID_W = 64
CTX_LEN = 256
HEAD_DIM = 64
NA_HEADS = 8
NA_WIN_ROWS = 8
NA_WIN_COLS = 16
GQA_Q_HEADS = 8
GQA_KV_HEADS = 2
Q_BLOCK = 128
ROPE_THETA = 10000.0
ROPE_AXIS_DIM = HEAD_DIM // 2
NA_DIM = NA_HEADS * HEAD_DIM
GQA_Q_DIM = GQA_Q_HEADS * HEAD_DIM
GQA_KV_DIM = GQA_KV_HEADS * HEAD_DIM
ATT_SPLITS = (NA_DIM, 2 * NA_DIM, 3 * NA_DIM, 3 * NA_DIM + GQA_Q_DIM, 3 * NA_DIM + GQA_Q_DIM + GQA_KV_DIM)
ATT_IN = 3 * NA_DIM + GQA_Q_DIM + 2 * GQA_KV_DIM
RWKV_HEADS = 8
RWKV_HEAD = 64
RWKV_DIM = RWKV_HEADS * RWKV_HEAD
DECAY_LORA = 32
ICLR_LORA = 32
GATE_LORA = 96
RWKV_GN_EPS = 64e-5
RWKV_IN = 4 * RWKV_DIM
MLSTM_HEADS = 4
MLSTM_HEAD = 128
MLSTM_DIM = MLSTM_HEADS * MLSTM_HEAD
MLSTM_CHUNK = 64
MLSTM_IN = 4 * MLSTM_DIM + 4 * MLSTM_HEADS
REC_IN = RWKV_IN + MLSTM_IN
D_MIX = NA_DIM + GQA_Q_DIM
N_EXPERTS = 64
TOP_K = 6
EXPERT_FF = 256
SHARED_FF = 256
ROUTED_SCALE = 2.5
MOE_BLOCK = 128
N_ATT_LAYERS = (DEPTH + 1) // 2
N_REC_LAYERS = DEPTH // 2
DN_ALPHA = (2 * DEPTH) ** 0.25
DN_BETA = (8 * DEPTH) ** -0.25
LN_EPS = 1e-5
NORM_EPS = 1e-6
F32 = jnp.float32

kernel_name = 'hybrid_na_gqa_rwkv7_mlstm_moe_dit'


def layer_norm(x, g, b):
    xf = x.astype(F32)
    mu = jnp.mean(xf, -1, keepdims=True)
    var = jnp.mean(jnp.square(xf - mu), -1, keepdims=True)
    return ((xf - mu) * lax.rsqrt(var + LN_EPS)).astype(x.dtype) * g + b


def rms_norm(x, g):
    xf = x.astype(F32)
    return (xf * lax.rsqrt(jnp.mean(jnp.square(xf), -1, keepdims=True) + NORM_EPS)).astype(x.dtype) * g


def swiglu(x, w1, w3, w2):
    return (jax.nn.silu(x @ w1) * (x @ w3)) @ w2


def centred_shift(x):
    xp = jnp.pad(x, ((0, 0), (1, 1), (0, 0)))
    return 0.5 * (xp[:, :-2] + xp[:, 2:])


def seg_flip(x, n_ctx, axis):
    a, b = jnp.split(x, [n_ctx], axis=axis)
    return jnp.concatenate([jnp.flip(a, axis), jnp.flip(b, axis)], axis=axis)


def both_dirs(x, n_ctx):
    return jnp.stack([x, seg_flip(x, n_ctx, 1)])


def own_dirs(x, n_ctx):
    return jnp.stack([x[0], seg_flip(x[1], n_ctx, 1)])


def axial_rope(n_tokens):
    t = jnp.arange(n_tokens)
    row = (t // GRID_W).astype(F32)
    col = (t % GRID_W).astype(F32)
    inv = ROPE_THETA ** (-jnp.arange(0, ROPE_AXIS_DIM, 2, dtype=F32) / ROPE_AXIS_DIM)
    ang = jnp.concatenate([row[:, None] * inv, col[:, None] * inv], -1)
    return jnp.cos(ang), jnp.sin(ang)


def apply_rope(x, cos, sin):
    xp = x.reshape(x.shape[:-1] + (HEAD_DIM // 2, 2))
    x0, x1 = xp[..., 0], xp[..., 1]
    c, s = cos[:, None, :], sin[:, None, :]
    return jnp.stack([x0 * c - x1 * s, x0 * s + x1 * c], -1).reshape(x.shape).astype(x.dtype)


def attend(q, k, v):
    B, Tq, Hq, Dh = q.shape
    hkv = k.shape[2]
    qg = q.reshape(B, Tq, hkv, Hq // hkv, Dh)
    s = jnp.einsum('bqhgd,bkhd->bhgqk', qg, k).astype(F32) * Dh ** -0.5
    p = jax.nn.softmax(s, -1).astype(v.dtype)
    return jnp.einsum('bhgqk,bkhd->bqhgd', p, v).reshape(B, Tq, Hq * Dh)


def blocked_attention(q, k, v):
    B, S, Hq, Dh = q.shape
    nb = S // Q_BLOCK
    qb = jnp.moveaxis(q.reshape(B, nb, Q_BLOCK, Hq, Dh), 1, 0)
    out = lax.map(lambda qi: attend(qi, k, v), qb)
    return jnp.moveaxis(out, 0, 1).reshape(B, S, Hq * Dh)


def neighbourhood_attention(q, k, v, k_ctx, v_ctx, rpb):
    B, S, H, Dh = q.shape
    rows = S // GRID_W
    kr, kc = min(NA_WIN_ROWS, rows), NA_WIN_COLS
    qg = q.reshape(B, rows, GRID_W, H, Dh)
    kg = k.reshape(B, rows, GRID_W, H, Dh)
    vg = v.reshape(B, rows, GRID_W, H, Dh)
    r = jnp.arange(rows)
    row_idx = jnp.clip(r - kr // 2, 0, rows - kr)[:, None] + jnp.arange(kr)[None, :]
    k_band = kg[:, row_idx]
    v_band = vg[:, row_idx]
    cidx = jnp.arange(GRID_W)
    col_start = jnp.clip(cidx - kc // 2, 0, GRID_W - kc)
    col_in = (cidx[None, :] >= col_start[:, None]) & (cidx[None, :] < col_start[:, None] + kc)
    d_row = row_idx - r[:, None] + NA_WIN_ROWS - 1
    d_col = jnp.clip(cidx[None, :] - cidx[:, None], -(kc - 1), kc - 1) + kc - 1
    bias = rpb[:, d_row[:, None, :, None], d_col[None, :, None, :]]
    scale = Dh ** -0.5
    s_lat = jnp.einsum('brqhd,brkwhd->bhrqkw', qg, k_band).astype(F32) * scale + bias
    s_lat = jnp.where(col_in[None, None, None, :, None, :], s_lat, -jnp.inf)
    s_ctx = jnp.einsum('brqhd,bchd->bhrqc', qg, k_ctx).astype(F32) * scale
    n_lat = kr * GRID_W
    s = jnp.concatenate([s_lat.reshape(B, H, rows, GRID_W, n_lat), s_ctx], -1)
    p = jax.nn.softmax(s, -1).astype(v.dtype)
    p_lat = p[..., :n_lat].reshape(B, H, rows, GRID_W, kr, GRID_W)
    out = jnp.einsum('bhrqkw,brkwhd->brqhd', p_lat, v_band) + jnp.einsum('bhrqc,bchd->brqhd', p[..., n_lat:], v_ctx)
    return out.reshape(B, S, H * Dh)


def attention_mixers(h_ctx, h_lat, w_in, rpb, qk_gain, keep_ctx):
    S = h_lat.shape[1]
    heads = lambda t, n: t.reshape(t.shape[:2] + (n, HEAD_DIM))

    def project(h):
        q_a, k_a, v_a, q_b, k_b, v_b = jnp.split(h @ w_in, ATT_SPLITS, axis=-1)
        return (heads(q_a, NA_HEADS), heads(k_a, NA_HEADS), heads(v_a, NA_HEADS),
                rms_norm(heads(q_b, GQA_Q_HEADS), qk_gain[0]), rms_norm(heads(k_b, GQA_KV_HEADS), qk_gain[1]),
                heads(v_b, GQA_KV_HEADS))

    qa_c, ka_c, va_c, qb_c, kb_c, vb_c = project(h_ctx)
    qa, ka, va, qb, kb, vb = project(h_lat)
    cos, sin = axial_rope(S)
    qb, kb = apply_rope(qb, cos, sin), apply_rope(kb, cos, sin)
    out_a = neighbourhood_attention(qa, ka, va, ka_c, va_c, rpb)
    out_b = blocked_attention(qb, jnp.concatenate([kb, kb_c], 1), jnp.concatenate([vb, vb_c], 1))
    out_lat = jnp.concatenate([out_a, out_b], -1)
    if not keep_ctx:
        return None, out_lat
    out_ctx = jnp.concatenate([attend(qa_c, ka_c, va_c), attend(qb_c, kb_c, vb_c)], -1)
    return out_ctx, out_lat


def rwkv7_step(state, inp):
    r, w, k, v, kk, a = inp
    sa = jnp.einsum('...vk,...k->...v', state, -kk)
    state = state * w[..., None, :] + sa[..., :, None] * (kk * a)[..., None, :] + v[..., :, None] * k[..., None, :]
    return state, jnp.einsum('...vk,...k->...v', state, r)


def rwkv7_bidirectional(p_ctx, p_lat, mu, w0, w1, w2, a0, a1, a2, g1, g2, kvec, r_k, gn, keep_ctx):
    n_ctx = p_ctx.shape[1]

    def shift_mix(p):
        d = centred_shift(p) - p
        (r, k, v, z), (dr, dk, dv, dz) = jnp.split(p, 4, -1), jnp.split(d, 4, -1)
        return r + dr * mu[0], k + dk * mu[1], v + dv * mu[2], z + dz * mu[3], z + dz * mu[4], z + dz * mu[5]

    r, k, v, z_w, z_a, z_g = [jnp.concatenate(pair, axis=1) for pair in zip(shift_mix(p_ctx), shift_mix(p_lat))]
    B, T, C = r.shape
    heads = lambda t: t.reshape(t.shape[:-1] + (RWKV_HEADS, RWKV_HEAD)).astype(F32)
    w_pre = w0[:, None, None] + jnp.einsum('dbtr,drc->dbtc', jnp.tanh(jnp.einsum('btc,dcr->dbtr', z_w, w1)), w2)
    decay = jnp.exp(-jnp.exp(-jax.nn.softplus(-w_pre.astype(F32)) - 0.5))
    iclr = jax.nn.sigmoid((a0[:, None, None] + jnp.einsum('dbtr,drc->dbtc', jnp.einsum('btc,dcr->dbtr', z_a, a1), a2)).astype(F32))
    gate = jax.nn.sigmoid(z_g @ g1) @ g2
    kk = heads(k * kvec[0])
    kk = kk * lax.rsqrt(jnp.maximum(jnp.sum(jnp.square(kk), -1, keepdims=True), 1e-24))
    k_eff = heads(k)[None] * (1.0 + (heads(iclr) - 1.0) * heads(kvec[1]))
    xs = (both_dirs(heads(r), n_ctx), own_dirs(heads(decay), n_ctx), own_dirs(k_eff, n_ctx),
          both_dirs(heads(v), n_ctx), both_dirs(kk, n_ctx), own_dirs(heads(iclr), n_ctx))
    xs = tuple(jnp.moveaxis(t, 2, 0) for t in xs)
    state0 = jnp.zeros((2, B, RWKV_HEADS, RWKV_HEAD, RWKV_HEAD), F32)
    _, y = lax.scan(rwkv7_step, state0, xs)
    y = own_dirs(jnp.moveaxis(y, 0, 2), n_ctx).sum(0)
    t0 = 0 if keep_ctx else n_ctx
    y, r_h, v_h, k_h, gate = y[:, t0:], heads(r)[:, t0:], heads(v)[:, t0:], k_eff[:, :, t0:], gate[:, t0:]
    mu_y = jnp.mean(y, -1, keepdims=True)
    var_y = jnp.mean(jnp.square(y - mu_y), -1, keepdims=True)
    y = (y - mu_y) * lax.rsqrt(var_y + RWKV_GN_EPS) * heads(gn[0]) + heads(gn[1])
    bonus = jnp.sum(r_h[None] * k_h * r_k, axis=-1, keepdims=True).sum(0) * v_h
    out = ((y + bonus).reshape(B, T - t0, C) * gate).astype(p_lat.dtype)
    if keep_ctx:
        return out[:, :n_ctx], out[:, n_ctx:]
    return None, out


def mlstm_chunk(carry, inp):
    c_state, n_state, m_state = carry
    q, k, v, ig, lf = inp
    L = q.shape[-2]
    in_order = jnp.tril(jnp.ones((L, L), bool))
    b = jnp.cumsum(lf, -1)
    d_intra = jnp.where(in_order, b[..., :, None] - b[..., None, :] + ig[..., None, :], -jnp.inf)
    d_inter = b + m_state[..., None]
    m_t = jnp.maximum(d_inter, jnp.max(d_intra, -1))
    s = jnp.einsum('...td,...sd->...ts', q, k) * jnp.exp(d_intra - m_t[..., None])
    w_inter = jnp.exp(d_inter - m_t)
    num = jnp.einsum('...ts,...sv->...tv', s, v) + w_inter[..., None] * jnp.einsum('...vd,...td->...tv', c_state, q)
    den = jnp.sum(s, -1) + w_inter * jnp.einsum('...d,...td->...t', n_state, q)
    h = num / jnp.maximum(jnp.abs(den), jnp.exp(-m_t))[..., None]
    b_end = b[..., -1]
    d_state = b_end[..., None] - b + ig
    m_new = jnp.maximum(b_end + m_state, jnp.max(d_state, -1))
    w_s = jnp.exp(d_state - m_new[..., None])
    w_c = jnp.exp(b_end + m_state - m_new)
    c_new = w_c[..., None, None] * c_state + jnp.einsum('...s,...sv,...sd->...vd', w_s, v, k)
    n_new = w_c[..., None] * n_state + jnp.einsum('...s,...sd->...d', w_s, k)
    return (c_new, n_new, m_new), h


def mlstm_bidirectional(p_ctx, p_lat, gate_b, norm_g, keep_ctx):
    n_ctx = p_ctx.shape[1]
    p = jnp.concatenate([p_ctx, p_lat], axis=1)
    B, T, _ = p.shape
    L, nc = MLSTM_CHUNK, T // MLSTM_CHUNK
    q, k, v, o, g = jnp.split(p, [MLSTM_DIM, 2 * MLSTM_DIM, 3 * MLSTM_DIM, 4 * MLSTM_DIM], axis=-1)
    heads = lambda t: t.reshape(B, T, MLSTM_HEADS, MLSTM_HEAD).astype(F32)
    g = g.reshape(B, T, 4, MLSTM_HEADS).astype(F32) + gate_b
    ig = jnp.stack([g[:, :, 0], seg_flip(g[:, :, 2], n_ctx, 1)])
    lf = jax.nn.log_sigmoid(jnp.stack([g[:, :, 1], seg_flip(g[:, :, 3], n_ctx, 1)]))

    def chunks(t):
        t = t.reshape((2, B, nc, L) + t.shape[3:])
        return jnp.moveaxis(jnp.moveaxis(t, 2, 0), 3, 4)

    xs = (chunks(both_dirs(heads(q) * MLSTM_HEAD ** -0.5, n_ctx)), chunks(both_dirs(heads(k), n_ctx)),
          chunks(both_dirs(heads(v), n_ctx)), chunks(ig), chunks(lf))
    carry0 = (jnp.zeros((2, B, MLSTM_HEADS, MLSTM_HEAD, MLSTM_HEAD), F32),
              jnp.zeros((2, B, MLSTM_HEADS, MLSTM_HEAD), F32), jnp.zeros((2, B, MLSTM_HEADS), F32))
    _, h = lax.scan(mlstm_chunk, carry0, xs)
    h = jnp.moveaxis(jnp.moveaxis(h, 4, 3), 0, 2).reshape(2, B, T, MLSTM_HEADS, MLSTM_HEAD)
    h = own_dirs(h, n_ctx).sum(0)
    t0 = 0 if keep_ctx else n_ctx
    h = rms_norm(h[:, t0:], norm_g.reshape(MLSTM_HEADS, MLSTM_HEAD))
    out = (h.reshape(B, T - t0, MLSTM_DIM) * jax.nn.sigmoid(o[:, t0:])).astype(p_lat.dtype)
    if keep_ctx:
        return out[:, :n_ctx], out[:, n_ctx:]
    return None, out


def recurrent_mixers(h_ctx, h_lat, w_in, mu, w0, w1, w2, a0, a1, a2, g1, g2, kvec, r_k, gn, gate_b, norm_g, keep_ctx):
    p_ctx, p_lat = h_ctx @ w_in, h_lat @ w_in
    rc, rl = rwkv7_bidirectional(p_ctx[..., :RWKV_IN], p_lat[..., :RWKV_IN], mu, w0, w1, w2, a0, a1, a2,
                                 g1, g2, kvec, r_k, gn, keep_ctx)
    mc, ml = mlstm_bidirectional(p_ctx[..., RWKV_IN:], p_lat[..., RWKV_IN:], gate_b, norm_g, keep_ctx)
    out_lat = jnp.concatenate([rl, ml], -1)
    if not keep_ctx:
        return None, out_lat
    return jnp.concatenate([rc, mc], -1), out_lat


def grouped_expert_ffn(xt, idx, gates, w1, w3, w2):
    n_tok, D = xt.shape
    n_assign = n_tok * TOP_K
    flat_e = idx.reshape(-1)
    flat_tok = jnp.repeat(jnp.arange(n_tok, dtype=jnp.int32), TOP_K)
    flat_g = gates.reshape(-1)
    order = jnp.argsort(flat_e)
    e_sorted = flat_e[order]
    counts = jnp.bincount(flat_e, length=N_EXPERTS)
    padded = (counts + MOE_BLOCK - 1) // MOE_BLOCK * MOE_BLOCK
    start = jnp.cumsum(counts) - counts
    p_end = jnp.cumsum(padded)
    dest = (p_end - padded)[e_sorted] + jnp.arange(n_assign) - start[e_sorted]
    n_blocks = -(-n_assign // MOE_BLOCK) + N_EXPERTS
    n_rows = n_blocks * MOE_BLOCK
    row_tok = jnp.full((n_rows,), n_tok, jnp.int32).at[dest].set(flat_tok[order])
    row_gate = jnp.zeros((n_rows,), gates.dtype).at[dest].set(flat_g[order])
    block_expert = jnp.minimum(jnp.searchsorted(p_end, jnp.arange(n_blocks) * MOE_BLOCK, side='right'), N_EXPERTS - 1)
    x_pad = jnp.concatenate([xt, jnp.zeros((1, D), xt.dtype)], 0)
    xb = x_pad[row_tok].reshape(n_blocks, MOE_BLOCK, D)
    yb = lax.map(lambda a: swiglu(a[0], w1[a[1]], w3[a[1]], w2[a[1]]), (xb, block_expert))
    y = yb.reshape(n_rows, D) * row_gate[:, None]
    return jax.ops.segment_sum(y, row_tok, num_segments=n_tok + 1)[:n_tok]


def moe_ffn(xt, router_w, router_b, w1, w3, w2, sw1, sw3, sw2):
    scores = jax.nn.sigmoid((xt @ router_w).astype(F32))
    _, idx = lax.top_k(scores + router_b.astype(F32), TOP_K)
    gates = jnp.take_along_axis(scores, idx, -1)
    gates = (gates / jnp.sum(gates, -1, keepdims=True) * ROUTED_SCALE).astype(xt.dtype)
    return grouped_expert_ffn(xt, idx, gates, w1, w3, w2) + swiglu(xt, sw1, sw3, sw2)


def setup_inputs(seed: int = 0) -> dict:
    key = jax.random.key(seed)
    ks = iter(jax.random.split(key, 40))
    nrm = lambda shape, scale: scale * jax.random.normal(next(ks), shape, F32)
    D = D_MODEL
    return {
        'x': nrm((BATCH, SEQ, D), 1.0),
        'c': nrm((BATCH, D), 1.0),
        'ctx': nrm((BATCH, CTX_LEN, D), 1.0),
        'c_ctx': nrm((D,), 1.0),
        'ada_w': nrm((DEPTH, D, 6 * D), 0.5 * D ** -0.5),
        'ada_b': nrm((DEPTH, 6 * D), 0.02),
        'ln_g': 1.0 + nrm((DEPTH, 2, D), 0.02),
        'ln_b': nrm((DEPTH, 2, D), 0.02),
        'mix_w_out': nrm((DEPTH, D_MIX, D), DN_BETA * D_MIX ** -0.5),
        'att_w_in': nrm((N_ATT_LAYERS, D, ATT_IN), D ** -0.5),
        'na_rpb': nrm((N_ATT_LAYERS, NA_HEADS, 2 * NA_WIN_ROWS - 1, 2 * NA_WIN_COLS - 1), 0.1),
        'qk_gain': 1.0 + nrm((N_ATT_LAYERS, 2, HEAD_DIM), 0.02),
        'rec_w_in': nrm((N_REC_LAYERS, D, REC_IN), D ** -0.5),
        'rwkv_mu': jax.random.uniform(next(ks), (N_REC_LAYERS, 6, RWKV_DIM), F32),
        'rwkv_w0': jax.random.uniform(next(ks), (N_REC_LAYERS, 2, RWKV_DIM), F32, minval=-5.5, maxval=0.5),
        'rwkv_w1': nrm((N_REC_LAYERS, 2, RWKV_DIM, DECAY_LORA), RWKV_DIM ** -0.5),
        'rwkv_w2': nrm((N_REC_LAYERS, 2, DECAY_LORA, RWKV_DIM), 0.5 * DECAY_LORA ** -0.5),
        'rwkv_a0': nrm((N_REC_LAYERS, 2, RWKV_DIM), 0.1),
        'rwkv_a1': nrm((N_REC_LAYERS, 2, RWKV_DIM, ICLR_LORA), RWKV_DIM ** -0.5),
        'rwkv_a2': nrm((N_REC_LAYERS, 2, ICLR_LORA, RWKV_DIM), ICLR_LORA ** -0.5),
        'rwkv_g1': nrm((N_REC_LAYERS, RWKV_DIM, GATE_LORA), RWKV_DIM ** -0.5),
        'rwkv_g2': nrm((N_REC_LAYERS, GATE_LORA, RWKV_DIM), GATE_LORA ** -0.5),
        'rwkv_kvec': jnp.array([0.85, 1.0], F32)[None, :, None] + nrm((N_REC_LAYERS, 2, RWKV_DIM), 0.05),
        'rwkv_rk': nrm((N_REC_LAYERS, RWKV_HEADS, RWKV_HEAD), 0.1),
        'rwkv_gn': jnp.array([1.0, 0.0], F32)[None, :, None] + nrm((N_REC_LAYERS, 2, RWKV_DIM), 0.02),
        'mlstm_gate_b': jnp.array([-2.0, 3.0, -2.0, 3.0], F32)[None, :, None] + nrm((N_REC_LAYERS, 4, MLSTM_HEADS), 0.3),
        'mlstm_norm': 1.0 + nrm((N_REC_LAYERS, MLSTM_DIM), 0.02),
        'moe_router': nrm((DEPTH, D, N_EXPERTS), D ** -0.5),
        'moe_bias': nrm((DEPTH, N_EXPERTS), 0.01),
        'moe_w1': nrm((DEPTH, N_EXPERTS, D, EXPERT_FF), D ** -0.5),
        'moe_w3': nrm((DEPTH, N_EXPERTS, D, EXPERT_FF), D ** -0.5),
        'moe_w2': nrm((DEPTH, N_EXPERTS, EXPERT_FF, D), DN_BETA * EXPERT_FF ** -0.5),
        'shared_w1': nrm((DEPTH, D, SHARED_FF), D ** -0.5),
        'shared_w3': nrm((DEPTH, D, SHARED_FF), D ** -0.5),
        'shared_w2': nrm((DEPTH, SHARED_FF, D), DN_BETA * SHARED_FF ** -0.5),
    }


def reference(x, c, ctx, c_ctx, ada_w, ada_b, ln_g, ln_b, mix_w_out, att_w_in, na_rpb, qk_gain,
              rec_w_in, rwkv_mu, rwkv_w0, rwkv_w1, rwkv_w2, rwkv_a0, rwkv_a1, rwkv_a2, rwkv_g1, rwkv_g2,
              rwkv_kvec, rwkv_rk, rwkv_gn, mlstm_gate_b, mlstm_norm, moe_router, moe_bias, moe_w1, moe_w3,
              moe_w2, shared_w1, shared_w3, shared_w2):
    B, S, D = x.shape
    xc = ctx
    for i in range(DEPTH):
        keep_ctx = i < DEPTH - 1
        j = i // 2
        mod = jax.nn.silu(c) @ ada_w[i] + ada_b[i]
        mod_c = jax.nn.silu(c_ctx) @ ada_w[i] + ada_b[i]
        sh1, sc1, g1, sh2, sc2, g2 = [t[:, None] for t in jnp.split(mod, 6, -1)]
        sh1c, sc1c, g1c, sh2c, sc2c, g2c = jnp.split(mod_c, 6, -1)
        h_lat = x * (1.0 + sc1) + sh1
        h_ctx = xc * (1.0 + sc1c) + sh1c
        if i % 2 == 0:
            m_ctx, m_lat = attention_mixers(h_ctx, h_lat, att_w_in[j], na_rpb[j], qk_gain[j], keep_ctx)
        else:
            m_ctx, m_lat = recurrent_mixers(h_ctx, h_lat, rec_w_in[j], rwkv_mu[j], rwkv_w0[j], rwkv_w1[j], rwkv_w2[j],
                                            rwkv_a0[j], rwkv_a1[j], rwkv_a2[j], rwkv_g1[j], rwkv_g2[j], rwkv_kvec[j],
                                            rwkv_rk[j], rwkv_gn[j], mlstm_gate_b[j], mlstm_norm[j], keep_ctx)
        x = layer_norm(DN_ALPHA * x + g1 * (m_lat @ mix_w_out[i]), ln_g[i, 0], ln_b[i, 0])
        h_lat = x * (1.0 + sc2) + sh2
        if keep_ctx:
            xc = layer_norm(DN_ALPHA * xc + g1c * (m_ctx @ mix_w_out[i]), ln_g[i, 0], ln_b[i, 0])
            h_ctx = xc * (1.0 + sc2c) + sh2c
            tokens = jnp.concatenate([h_lat.reshape(-1, D), h_ctx.reshape(-1, D)], 0)
        else:
            tokens = h_lat.reshape(-1, D)
        y = moe_ffn(tokens, moe_router[i], moe_bias[i], moe_w1[i], moe_w3[i], moe_w2[i],
                    shared_w1[i], shared_w3[i], shared_w2[i])
        x = layer_norm(DN_ALPHA * x + g2 * y[:B * S].reshape(B, S, D), ln_g[i, 1], ln_b[i, 1])
        if keep_ctx:
            xc = layer_norm(DN_ALPHA * xc + g2c * y[B * S:].reshape(xc.shape), ln_g[i, 1], ln_b[i, 1])
    return x
```

```cpp
#include <hip/hip_runtime.h>
#include <hip/hip_cooperative_groups.h>
#include <cstdio>
#include <cstring>
namespace cg = cooperative_groups;

constexpr int DM = 1024;
constexpr int NBATCH = 8;
constexpr int SEQ = 2048;
constexpr int CTXL = 256;
constexpr int NL = NBATCH * SEQ;
constexpr int NC = NBATCH * CTXL;
constexpr int NT = NL + NC;
constexpr int TSC = CTXL + SEQ;
constexpr int LDP = 4112;
constexpr int ATT_N = 2304;
constexpr int REC_N = 4112;
constexpr int REC_NP = 4224;
constexpr int NCHUNK = 36;
constexpr int NMT = 64 * NCHUNK;
constexpr int RWS = 5120;
constexpr int NSLOT = 137216;
constexpr float DN_ALPHA = 1.6817928305074290f;
constexpr int NTHR = 256;
constexpr int SMEM_BYTES = 65536 + 4096;
constexpr int META_OFF = 65536;

typedef unsigned short bf16_t;
using bf16x8 = __attribute__((ext_vector_type(8))) short;
using f32x16 = __attribute__((ext_vector_type(16))) float;
using u32x4 = __attribute__((ext_vector_type(4))) unsigned;
using u32x2 = __attribute__((ext_vector_type(2))) unsigned;

struct Params {
  const float *x, *c, *ctx, *c_ctx, *ada_w, *ada_b, *ln_g, *ln_b, *mix_w_out, *att_w_in, *na_rpb, *qk_gain,
      *rec_w_in, *rwkv_mu, *rwkv_w0, *rwkv_w1, *rwkv_w2, *rwkv_a0, *rwkv_a1, *rwkv_a2, *rwkv_g1, *rwkv_g2,
      *rwkv_kvec, *rwkv_rk, *rwkv_gn, *mlstm_gate_b, *mlstm_norm, *moe_router, *moe_bias, *moe_w1, *moe_w3,
      *moe_w2, *shared_w1, *shared_w3, *shared_w2;
  float* out;
  bf16_t *Wt_att, *Wt_rec, *Wt_out, *Wt13, *Wt2;
  float *X, *MOD, *MODP, *GP, *msc, *lgate, *MSn, *Tb;
  bf16_t *AB, *P, *RW, *MS, *ACT, *OUT2;
  int *cnt, *ltok, *tsl;
  int ph_lo, ph_hi;
};

__device__ __forceinline__ int modrow(int t) { return t < NL ? (t >> 11) : 8; }
__device__ __forceinline__ float silu_f(float x) { return x / (1.f + expf(-x)); }
__device__ __forceinline__ float sigm_f(float x) { return 1.f / (1.f + expf(-x)); }
__device__ __forceinline__ float softplus_f(float x) { return fmaxf(x, 0.f) + log1pf(expf(-fabsf(x))); }
__device__ __forceinline__ float wsum(float v) {
#pragma unroll
  for (int o = 32; o; o >>= 1) v += __shfl_xor(v, o);
  return v;
}
__device__ __forceinline__ float wmax(float v) {
#pragma unroll
  for (int o = 32; o; o >>= 1) v = fmaxf(v, __shfl_xor(v, o));
  return v;
}
__device__ __forceinline__ float rdlane(float v, int l) {
  return __int_as_float(__builtin_amdgcn_readlane(__float_as_int(v), l));
}
__device__ __forceinline__ int opaque_tid() {
  int t = threadIdx.x;
  asm volatile("" : "+v"(t));
  return t;
}
__device__ __forceinline__ unsigned pk_bf16(float lo, float hi) {
  unsigned r;
  asm("v_cvt_pk_bf16_f32 %0, %1, %2" : "=v"(r) : "v"(lo), "v"(hi));
  return r;
}
__device__ __forceinline__ bf16_t f2bf(float x) { return (bf16_t)(pk_bf16(x, 0.f) & 0xffffu); }
__device__ __forceinline__ float bf2f(bf16_t v) { return __uint_as_float((unsigned)v << 16); }
__device__ __forceinline__ float bflo(unsigned u) { return __uint_as_float(u << 16); }
__device__ __forceinline__ float bfhi(unsigned u) { return __uint_as_float(u & 0xffff0000u); }
__device__ __forceinline__ int scan_row(int dir, int b, int tau) {
  if (tau < CTXL) return NL + b * CTXL + (dir ? (CTXL - 1 - tau) : tau);
  int s = tau - CTXL;
  return b * SEQ + (dir ? (SEQ - 1 - s) : s);
}

template <class RowPtrA>
__device__ __forceinline__ void gemm128_main(int tid, RowPtrA rowA, const bf16_t* __restrict__ Bt, int K, int n0,
                                             char* lds, f32x16 (&acc)[2][2]) {
  const int lane = tid & 63, w = tid >> 6;
  const int wm = w >> 1, wn = w & 1, r = lane & 31, h = lane >> 5;
  const int c = tid & 7, sr = tid >> 3;
  const int sc = (c ^ ((tid >> 4) & 7)) * 16;
  const bf16_t* ap[4];
  const bf16_t* bp[4];
#pragma unroll
  for (int i = 0; i < 4; ++i) {
    ap[i] = rowA(sr + 32 * i) + c * 8;
    bp[i] = Bt + (size_t)(n0 + sr + 32 * i) * K + c * 8;
  }
  u32x4 ra[4], rb[4];
#pragma unroll
  for (int mi = 0; mi < 2; ++mi)
#pragma unroll
    for (int ni = 0; ni < 2; ++ni)
#pragma unroll
      for (int q = 0; q < 16; ++q) acc[mi][ni][q] = 0.f;
  const int nk = K >> 6;
#pragma unroll
  for (int i = 0; i < 4; ++i) { ra[i] = *(const u32x4*)(ap[i]); rb[i] = *(const u32x4*)(bp[i]); }
  const int sw = (r >> 1) & 7;
  for (int kt = 0; kt < nk; ++kt) {
    char* As = lds + (kt & 1) * 32768;
    char* Bs = As + 16384;
#pragma unroll
    for (int i = 0; i < 4; ++i) {
      *(u32x4*)(As + (sr + 32 * i) * 128 + sc) = ra[i];
      *(u32x4*)(Bs + (sr + 32 * i) * 128 + sc) = rb[i];
    }
    __syncthreads();
    if (kt + 1 < nk) {
      const int k0 = (kt + 1) * 64;
#pragma unroll
      for (int i = 0; i < 4; ++i) { ra[i] = *(const u32x4*)(ap[i] + k0); rb[i] = *(const u32x4*)(bp[i] + k0); }
    }
    const char* Ar = As + (wm * 64 + r) * 128;
    const char* Br = Bs + (wn * 64 + r) * 128;
#pragma unroll
    for (int ks = 0; ks < 4; ++ks) {
      const int off = ((ks * 2 + h) ^ sw) * 16;
      const bf16x8 a0 = *(const bf16x8*)(Ar + off);
      const bf16x8 a1 = *(const bf16x8*)(Ar + 32 * 128 + off);
      const bf16x8 b0 = *(const bf16x8*)(Br + off);
      const bf16x8 b1 = *(const bf16x8*)(Br + 32 * 128 + off);
      acc[0][0] = __builtin_amdgcn_mfma_f32_32x32x16_bf16(a0, b0, acc[0][0], 0, 0, 0);
      acc[0][1] = __builtin_amdgcn_mfma_f32_32x32x16_bf16(a0, b1, acc[0][1], 0, 0, 0);
      acc[1][0] = __builtin_amdgcn_mfma_f32_32x32x16_bf16(a1, b0, acc[1][0], 0, 0, 0);
      acc[1][1] = __builtin_amdgcn_mfma_f32_32x32x16_bf16(a1, b1, acc[1][1], 0, 0, 0);
    }
  }
  __syncthreads();
}
template <class F>
__device__ __forceinline__ void acc_foreach(int tid, const f32x16 (&acc)[2][2], F f) {
  const int lane = tid & 63, w = tid >> 6;
  const int wm = w >> 1, wn = w & 1, r = lane & 31, h = lane >> 5;
#pragma unroll
  for (int mi = 0; mi < 2; ++mi)
#pragma unroll
    for (int ni = 0; ni < 2; ++ni)
#pragma unroll
      for (int q = 0; q < 16; ++q) {
        const int row = wm * 64 + mi * 32 + (q & 3) + 8 * (q >> 2) + 4 * h;
        const int col = wn * 64 + ni * 32 + r;
        f(row, col, acc[mi][ni][q]);
      }
}

template <class RM>
__device__ __forceinline__ void tr_tile(int tid, const float* __restrict__ src, int N, int k0, int n0,
                                        bf16_t* __restrict__ dst, int K, RM rowmap, float* tile) {
  {
    const int tx = tid & 15, ty = tid >> 4;
    const int n = n0 + tx * 4;
#pragma unroll
    for (int i = 0; i < 4; ++i) {
      const int k = ty + 16 * i;
      float4 v = make_float4(0.f, 0.f, 0.f, 0.f);
      if (n < N) v = *(const float4*)(src + (size_t)(k0 + k) * N + n);
      tile[k * 65 + tx * 4 + 0] = v.x; tile[k * 65 + tx * 4 + 1] = v.y;
      tile[k * 65 + tx * 4 + 2] = v.z; tile[k * 65 + tx * 4 + 3] = v.w;
    }
  }
  __syncthreads();
  {
    const int kc = tid & 7;
#pragma unroll
    for (int i = 0; i < 2; ++i) {
      const int n = (tid >> 3) + 32 * i;
      if (n0 + n < N) {
        float v[8];
#pragma unroll
        for (int q = 0; q < 8; ++q) v[q] = tile[(kc * 8 + q) * 65 + n];
        u32x4 o;
        o.x = pk_bf16(v[0], v[1]); o.y = pk_bf16(v[2], v[3]); o.z = pk_bf16(v[4], v[5]); o.w = pk_bf16(v[6], v[7]);
        *(u32x4*)(dst + (size_t)rowmap(n0 + n) * K + k0 + kc * 8) = o;
      }
    }
  }
  __syncthreads();
}

__device__ void ph_init(const Params& p, char* smc) {
  float* sm = (float*)smc;
  const int tid = opaque_tid();
  {
    const size_t n4a = (size_t)NL * DM / 4, n4b = (size_t)NC * DM / 4;
    const float4* xs = (const float4*)p.x;
    const float4* cs = (const float4*)p.ctx;
    float4* X4 = (float4*)p.X;
    for (size_t i = (size_t)blockIdx.x * NTHR + tid; i < n4a + n4b; i += (size_t)gridDim.x * NTHR)
      X4[i] = i < n4a ? xs[i] : cs[i - n4a];
  }
  for (int tile = blockIdx.x; tile < 96 * 8; tile += gridDim.x) {
    const int ct = tile >> 3, ks = tile & 7;
    for (int i = tid; i < 9 * 128; i += NTHR) {
      const int r = i >> 7, k = ks * 128 + (i & 127);
      const float v = r < 8 ? p.c[r * 1024 + k] : p.c_ctx[k];
      sm[i] = silu_f(v);
    }
    __syncthreads();
    const int col = ct * 256 + tid;
    const int layer = col / 6144, n = col % 6144;
    const float* W = p.ada_w + ((size_t)layer * 1024 + ks * 128) * 6144 + n;
    float acc[9];
#pragma unroll
    for (int r = 0; r < 9; ++r) acc[r] = 0.f;
#pragma unroll 4
    for (int k = 0; k < 128; ++k) {
      const float w = W[(size_t)k * 6144];
#pragma unroll
      for (int r = 0; r < 9; ++r) acc[r] = fmaf(sm[r * 128 + k], w, acc[r]);
    }
#pragma unroll
    for (int r = 0; r < 9; ++r) p.MODP[((size_t)(ks * 4 + layer) * 9 + r) * 6144 + n] = acc[r];
    __syncthreads();
  }
  constexpr int T0 = 1152, T1 = T0 + 2080, T2 = T1 + 1024, T3 = T2 + 33280, T4 = T3 + 16640;
  for (int job = blockIdx.x; job < T4; job += gridDim.x) {
    if (job < T0) {
      const int j = job / 576, rem = job % 576, kt = rem / 36, nt = rem % 36;
      tr_tile(tid, p.att_w_in + (size_t)j * 1024 * ATT_N, ATT_N, kt * 64, nt * 64, p.Wt_att + (size_t)j * ATT_N * 1024,
              1024, [](int n) { return n; }, sm);
    } else if (job < T1) {
      const int q = job - T0;
      const int j = q / 1040, rem = q % 1040, kt = rem / 65, nt = rem % 65;
      tr_tile(tid, p.rec_w_in + (size_t)j * 1024 * REC_N, REC_N, kt * 64, nt * 64, p.Wt_rec + (size_t)j * REC_NP * 1024,
              1024, [](int n) { return n; }, sm);
    } else if (job < T2) {
      const int q = job - T1;
      const int i = q >> 8, rem = q & 255, kt = rem >> 4, nt = rem & 15;
      tr_tile(tid, p.mix_w_out + (size_t)i * 1024 * 1024, 1024, kt * 64, nt * 64, p.Wt_out + (size_t)i * 1024 * 1024,
              1024, [](int n) { return n; }, sm);
    } else if (job < T3) {
      const int q = job - T2;
      const int le = q >> 7, rem = q & 127;
      const int which = rem >> 6, kt = (rem >> 2) & 15, nt = rem & 3;
      const int layer = le / 65, e = le % 65;
      const float* src;
      if (e < 64) src = (which ? p.moe_w3 : p.moe_w1) + (size_t)(layer * 64 + e) * 1024 * 256;
      else src = (which ? p.shared_w3 : p.shared_w1) + (size_t)layer * 1024 * 256;
      tr_tile(tid, src, 256, kt * 64, nt * 64, p.Wt13 + (size_t)le * 512 * 1024, 1024,
              [which](int n) { return 64 * (n >> 5) + which * 32 + (n & 31); }, sm);
    } else {
      const int q = job - T3;
      const int le = q >> 6, rem = q & 63;
      const int kt = rem >> 4, nt = rem & 15;
      const int layer = le / 65, e = le % 65;
      const float* src = e < 64 ? p.moe_w2 + (size_t)(layer * 64 + e) * 256 * 1024 : p.shared_w2 + (size_t)layer * 256 * 1024;
      tr_tile(tid, src, 1024, kt * 64, nt * 64, p.Wt2 + (size_t)le * 1024 * 256, 256, [](int n) { return n; }, sm);
    }
  }
}

__device__ void ph_mod_h(const Params& p, char* smc) {
  float* sm = (float*)smc;
  const int tid = opaque_tid();
  for (int i = blockIdx.x * NTHR + tid; i < 4 * 9 * 6144; i += gridDim.x * NTHR) {
    const int layer = i / (9 * 6144), rem = i % (9 * 6144), n = rem % 6144;
    float s = p.ada_b[layer * 6144 + n];
#pragma unroll
    for (int ks = 0; ks < 8; ++ks) s += p.MODP[(size_t)(ks * 4 + layer) * 9 * 6144 + rem];
    p.MOD[i] = s;
  }
  const int lane = tid & 63, wave = tid >> 6;
  const int per = (((NT + gridDim.x - 1) / gridDim.x) + 3) & ~3;
  const int t0 = blockIdx.x * per, t1 = min(NT, t0 + per);
  int cur = -1;
  for (int tb = t0; tb < t1; tb += 4) {
    const int mr = modrow(tb);
    if (mr != cur) {
      __syncthreads();
      for (int n = tid; n < 2048; n += NTHR) {
        float a = p.ada_b[n];
#pragma unroll
        for (int ks = 0; ks < 8; ++ks) a += p.MODP[((size_t)(ks * 4) * 9 + mr) * 6144 + n];
        sm[n] = a;
      }
      cur = mr;
      __syncthreads();
    }
    const int t = tb + wave;
    if (t < t1) {
      const float* src = t < NL ? p.x + (size_t)t * DM : p.ctx + (size_t)(t - NL) * DM;
#pragma unroll
      for (int i = 0; i < 4; ++i) {
        const int n = i * 256 + lane * 4;
        const float4 xv = *(const float4*)(src + n);
        const float4 sh = *(const float4*)(sm + n);
        const float4 sc = *(const float4*)(sm + 1024 + n);
        u32x2 o;
        o.x = pk_bf16(xv.x * (1.f + sc.x) + sh.x, xv.y * (1.f + sc.y) + sh.y);
        o.y = pk_bf16(xv.z * (1.f + sc.z) + sh.z, xv.w * (1.f + sc.w) + sh.w);
        *(u32x2*)(p.AB + (size_t)t * DM + n) = o;
      }
    }
  }
}

__device__ void ph_gemm_in(const Params& p, int layer, char* lds) {
  const int tid = opaque_tid();
  const int j = layer >> 1;
  const bool att = !(layer & 1);
  const int N = att ? ATT_N : REC_N;
  const bf16_t* Wt = att ? p.Wt_att + (size_t)j * ATT_N * 1024 : p.Wt_rec + (size_t)j * REC_NP * 1024;
  const int ntn = att ? 18 : 33, ntm = NT / 128;
  for (int tile = blockIdx.x; tile < ntm * ntn; tile += gridDim.x) {
    const int tm = tile / ntn, tn = tile % ntn;
    const int m0 = tm * 128, n0 = tn * 128;
    const bf16_t* Ab = p.AB + (size_t)m0 * DM;
    f32x16 acc[2][2];
    gemm128_main(tid, [&](int r) { return Ab + (size_t)r * DM; }, Wt, 1024, n0, lds, acc);
    bf16_t* Pb = p.P + (size_t)m0 * LDP;
    float* GPb = p.GP + (size_t)m0 * 16;
    acc_foreach(tid, acc, [&](int row, int col, float v) {
      const int cn = n0 + col;
      if (cn < N) Pb[(size_t)row * LDP + cn] = f2bf(v);
      if (!att && cn >= 4096 && cn < 4112) GPb[row * 16 + (cn - 4096)] = v;
    });
  }
}

__device__ void ph_att_post(const Params& p, int layer) {
  const int tid = opaque_tid();
  const int j = layer >> 1;
  const int lane = tid & 63, wave = tid >> 6;
  for (int task = blockIdx.x * 4 + wave; task < NT * 10; task += gridDim.x * 4) {
    const int t = task / 10, hh = task % 10;
    const int col = hh < 8 ? 1536 + hh * 64 : 2048 + (hh - 8) * 64;
    bf16_t* ptr = p.P + (size_t)t * LDP + col;
    float v = bf2f(ptr[lane]);
    float ss = wsum(v * v);
    const float* g = p.qk_gain + j * 128 + (hh < 8 ? 0 : 64);
    v = v * rsqrtf(ss * (1.f / 64.f) + 1e-6f) * g[lane];
    if (t < NL) {
      const int s = t & 2047;
      const int prow = s >> 6, pcol = s & 63;
      const int pi = lane >> 1;
      const float pos = pi < 16 ? (float)prow : (float)pcol;
      const int f = pi & 15;
      const float inv = powf(10000.f, -(float)f / 16.f);
      const float ang = pos * inv;
      const float cs = cosf(ang), sn = sinf(ang);
      const float other = __shfl_xor(v, 1);
      v = (lane & 1) ? (other * sn + v * cs) : (v * cs - other * sn);
    }
    ptr[lane] = f2bf(v);
  }
}

__device__ void ph_attention(const Params& p, int layer, bool keep) {
  const int tid = opaque_tid();
  const int j = layer >> 1;
  const int lane = tid & 63, wave = tid >> 6;
  const int ntok = keep ? NT : NL;
  for (int task = blockIdx.x * 4 + wave; task < ntok * 16; task += gridDim.x * 4) {
    const int t = task >> 4, hh = task & 15;
    const bool isB = hh >= 8;
    const int h = hh & 7;
    const int qoff = isB ? 1536 + h * 64 : h * 64;
    const int koff = isB ? 2048 + (h >> 2) * 64 : 512 + h * 64;
    const int voff = isB ? 2176 + (h >> 2) * 64 : 1024 + h * 64;
    float q[64];
    {
      const u32x4* qp = (const u32x4*)(p.P + (size_t)t * LDP + qoff);
#pragma unroll
      for (int i = 0; i < 8; ++i) {
        const u32x4 v = qp[i];
        q[8 * i] = bflo(v.x); q[8 * i + 1] = bfhi(v.x); q[8 * i + 2] = bflo(v.y); q[8 * i + 3] = bfhi(v.y);
        q[8 * i + 4] = bflo(v.z); q[8 * i + 5] = bfhi(v.z); q[8 * i + 6] = bflo(v.w); q[8 * i + 7] = bfhi(v.w);
      }
    }
    int b, r = 0, cq = 0, nkeys;
    const bool lat = t < NL;
    if (lat) { b = t >> 11; int s = t & 2047; r = s >> 6; cq = s & 63; nkeys = isB ? 2304 : 384; }
    else { b = (t - NL) >> 8; nkeys = 256; }
    float m = -INFINITY, l = 0.f, acc = 0.f;
    for (int base = 0; base < nkeys; base += 64) {
      const int jj = base + lane;
      int krow; float bias = 0.f;
      if (!lat) krow = NL + b * CTXL + jj;
      else if (isB) krow = jj < SEQ ? b * SEQ + jj : NL + b * CTXL + (jj - SEQ);
      else if (jj < 128) {
        const int i = jj >> 4, cc = jj & 15;
        const int r0 = min(max(r - 4, 0), 24);
        const int kr = r0 + i;
        const int c0 = min(max(cq - 8, 0), 48);
        const int kc = c0 + cc;
        krow = b * SEQ + kr * 64 + kc;
        bias = p.na_rpb[((j * 8 + h) * 15 + (kr - r + 7)) * 31 + (kc - cq + 15)];
      } else krow = NL + b * CTXL + (jj - 128);
      const u32x4* kp = (const u32x4*)(p.P + (size_t)krow * LDP + koff);
      float s = 0.f;
#pragma unroll
      for (int i = 0; i < 8; ++i) {
        const u32x4 v = kp[i];
        s = fmaf(q[8 * i], bflo(v.x), s); s = fmaf(q[8 * i + 1], bfhi(v.x), s);
        s = fmaf(q[8 * i + 2], bflo(v.y), s); s = fmaf(q[8 * i + 3], bfhi(v.y), s);
        s = fmaf(q[8 * i + 4], bflo(v.z), s); s = fmaf(q[8 * i + 5], bfhi(v.z), s);
        s = fmaf(q[8 * i + 6], bflo(v.w), s); s = fmaf(q[8 * i + 7], bfhi(v.w), s);
      }
      s = s * 0.125f + bias;
      const float mn = fmaxf(m, wmax(s));
      const float pr = expf(s - mn);
      const float corr = expf(m - mn);
      l = l * corr + wsum(pr);
      acc *= corr;
      for (int k2 = 0; k2 < 64; ++k2) {
        const float pj = __shfl(pr, k2);
        const int rj = __shfl(krow, k2);
        acc = fmaf(pj, bf2f(p.P[(size_t)rj * LDP + voff + lane]), acc);
      }
      m = mn;
    }
    p.AB[(size_t)t * DM + hh * 64 + lane] = f2bf(acc / l);
  }
}

__device__ void ph_rwkv_prep(const Params& p, int layer, char* smc) {
  float* sm = (float*)smc;
  const int j = layer >> 1;
  const int tid = opaque_tid();
  float* xs = sm;
  float* lw = sm + 6 * 512;
  float* la = lw + 64;
  float* lg = la + 64;
  const float* mu = p.rwkv_mu + j * 6 * 512;
  for (int t = blockIdx.x; t < NT; t += gridDim.x) {
    bool hasp, hasn;
    if (t < NL) { int s = t & 2047; hasp = s > 0; hasn = s < SEQ - 1; }
    else { int s = (t - NL) & 255; hasp = s > 0; hasn = s < CTXL - 1; }
    const bf16_t* pt = p.P + (size_t)t * LDP;
    for (int c = tid; c < 2048; c += NTHR) {
      const int which = c >> 9, ch = c & 511;
      const float cur = bf2f(pt[c]);
      const float pv = hasp ? bf2f(pt[c - LDP]) : 0.f;
      const float nx = hasn ? bf2f(pt[c + LDP]) : 0.f;
      const float d = 0.5f * (pv + nx) - cur;
      if (which < 3) xs[which * 512 + ch] = cur + d * mu[which * 512 + ch];
      else {
        xs[3 * 512 + ch] = cur + d * mu[3 * 512 + ch];
        xs[4 * 512 + ch] = cur + d * mu[4 * 512 + ch];
        xs[5 * 512 + ch] = cur + d * mu[5 * 512 + ch];
      }
    }
    __syncthreads();
    if (tid < 64) {
      const int d = tid >> 5, r = tid & 31;
      const float* w = p.rwkv_w1 + (size_t)(j * 2 + d) * 512 * 32 + r;
      float a = 0.f;
      for (int c = 0; c < 512; ++c) a = fmaf(xs[3 * 512 + c], w[c * 32], a);
      lw[tid] = tanhf(a);
    } else if (tid < 128) {
      const int o = tid - 64, d = o >> 5, r = o & 31;
      const float* w = p.rwkv_a1 + (size_t)(j * 2 + d) * 512 * 32 + r;
      float a = 0.f;
      for (int c = 0; c < 512; ++c) a = fmaf(xs[4 * 512 + c], w[c * 32], a);
      la[o] = a;
    } else if (tid < 224) {
      const int r = tid - 128;
      const float* w = p.rwkv_g1 + (size_t)j * 512 * 96 + r;
      float a = 0.f;
      for (int c = 0; c < 512; ++c) a = fmaf(xs[5 * 512 + c], w[c * 96], a);
      lg[r] = sigm_f(a);
    }
    __syncthreads();
    bf16_t* rw = p.RW + (size_t)t * RWS;
    for (int c = tid; c < 512; c += NTHR) {
      const float kx = xs[512 + c];
      float kkv = kx * p.rwkv_kvec[(j * 2 + 0) * 512 + c];
      const float ss = wsum(kkv * kkv);
      kkv *= rsqrtf(fmaxf(ss, 1e-24f));
      float gate = 0.f;
      for (int r = 0; r < 96; ++r) gate = fmaf(lg[r], p.rwkv_g2[(size_t)(j * 96 + r) * 512 + c], gate);
      const float kv1 = p.rwkv_kvec[(j * 2 + 1) * 512 + c];
#pragma unroll
      for (int d = 0; d < 2; ++d) {
        float wp = p.rwkv_w0[(j * 2 + d) * 512 + c];
        float ap = p.rwkv_a0[(j * 2 + d) * 512 + c];
        for (int r = 0; r < 32; ++r) {
          wp = fmaf(lw[d * 32 + r], p.rwkv_w2[(size_t)((j * 2 + d) * 32 + r) * 512 + c], wp);
          ap = fmaf(la[d * 32 + r], p.rwkv_a2[(size_t)((j * 2 + d) * 32 + r) * 512 + c], ap);
        }
        const float eps = expf(-softplus_f(-wp) - 0.5f);
        const float av = sigm_f(ap);
        rw[(3 + d) * 512 + c] = f2bf(eps);
        rw[(5 + d) * 512 + c] = f2bf(kx * (1.f + (av - 1.f) * kv1));
        rw[(7 + d) * 512 + c] = f2bf(av);
      }
      rw[c] = f2bf(xs[c]);
      rw[512 + c] = f2bf(xs[2 * 512 + c]);
      rw[2 * 512 + c] = f2bf(kkv);
      rw[9 * 512 + c] = f2bf(gate);
    }
    __syncthreads();
  }
}

__device__ void rwkv_chain(const Params& p, int ch, int lane) {
  const int dir = ch >> 6, b = (ch >> 3) & 7, h = ch & 7;
  float S[64];
#pragma unroll
  for (int k = 0; k < 64; ++k) S[k] = 0.f;
  int row = scan_row(dir, b, 0);
  const bf16_t* base = p.RW + (size_t)row * RWS + h * 64 + lane;
  bf16_t r = base[0], v = base[512], kk = base[1024], w = base[(3 + dir) * 512], ke = base[(5 + dir) * 512],
         a = base[(7 + dir) * 512];
  for (int tau = 0; tau < TSC; ++tau) {
    bf16_t nr = 0, nv = 0, nkk = 0, nw = 0, nke = 0, na = 0;
    int nrow = row;
    if (tau + 1 < TSC) {
      nrow = scan_row(dir, b, tau + 1);
      const bf16_t* nb = p.RW + (size_t)nrow * RWS + h * 64 + lane;
      nr = nb[0]; nv = nb[512]; nkk = nb[1024]; nw = nb[(3 + dir) * 512]; nke = nb[(5 + dir) * 512];
      na = nb[(7 + dir) * 512];
    }
    const float fkk = bf2f(kk), fr = bf2f(r), fv = bf2f(v), fke = bf2f(ke);
    const float fw = expf(-bf2f(w));
    const float kka = fkk * bf2f(a);
    float sa = 0.f;
#pragma unroll
    for (int k = 0; k < 64; ++k) sa = fmaf(S[k], rdlane(fkk, k), sa);
    sa = -sa;
    float y = 0.f;
#pragma unroll
    for (int k = 0; k < 64; ++k) {
      float s = S[k] * rdlane(fw, k);
      s = fmaf(sa, rdlane(kka, k), s);
      s = fmaf(fv, rdlane(fke, k), s);
      S[k] = s;
      y = fmaf(s, rdlane(fr, k), y);
    }
    p.P[(size_t)row * LDP + dir * 512 + h * 64 + lane] = f2bf(y);
    row = nrow; r = nr; v = nv; kk = nkk; w = nw; ke = nke; a = na;
  }
}

__device__ void mlstm_s1(const Params& p, int layer, int tile, float* sm, int tid) {
  const int j = layer >> 1;
  const int ch = tile / NCHUNK, c = tile % NCHUNK;
  const int dir = ch >> 5, b = (ch >> 2) & 7, h = ch & 3;
  float* s_ws = sm;
  int* s_row = (int*)(sm + 64);
  float* ks = sm + 128;
  float* vs = ks + 32 * 128;
  if (tid < 64) {
    const int row = scan_row(dir, b, c * 64 + tid);
    s_row[tid] = row;
    const float* g = p.GP + (size_t)row * 16;
    const float gi = g[(dir * 2) * 4 + h] + p.mlstm_gate_b[j * 16 + (dir * 2) * 4 + h];
    const float gf = g[(dir * 2 + 1) * 4 + h] + p.mlstm_gate_b[j * 16 + (dir * 2 + 1) * 4 + h];
    float bc = -softplus_f(-gf);
#pragma unroll
    for (int o = 1; o < 64; o <<= 1) {
      float tmp = __shfl_up(bc, o);
      if (tid >= o) bc += tmp;
    }
    const float bend = __shfl(bc, 63);
    const float ds = bend - bc + gi;
    const float mloc = wmax(ds);
    s_ws[tid] = expf(ds - mloc);
    if (tid == 0) { p.msc[tile] = mloc; p.msc[NMT + tile] = bend; }
  }
  __syncthreads();
  const int tx = tid & 15, ty = tid >> 4;
  float acc[8][8], nacc[8];
#pragma unroll
  for (int i = 0; i < 8; ++i) {
    nacc[i] = 0.f;
#pragma unroll
    for (int q = 0; q < 8; ++q) acc[i][q] = 0.f;
  }
  for (int half = 0; half < 2; ++half) {
    for (int i = tid; i < 32 * 32; i += NTHR) {
      const int s = i >> 5, c4 = (i & 31) * 4;
      const int row = s_row[half * 32 + s];
      const float wsv = s_ws[half * 32 + s];
      const u32x2 kv = *(const u32x2*)(p.P + (size_t)row * LDP + 2560 + h * 128 + c4);
      const u32x2 vv = *(const u32x2*)(p.P + (size_t)row * LDP + 3072 + h * 128 + c4);
      *(float4*)(ks + s * 128 + c4) = make_float4(bflo(kv.x), bfhi(kv.x), bflo(kv.y), bfhi(kv.y));
      *(float4*)(vs + s * 128 + c4) = make_float4(bflo(vv.x) * wsv, bfhi(vv.x) * wsv, bflo(vv.y) * wsv, bfhi(vv.y) * wsv);
    }
    __syncthreads();
    for (int s = 0; s < 32; ++s) {
      const float wsv = s_ws[half * 32 + s];
      float a[8], bb[8];
#pragma unroll
      for (int i = 0; i < 8; ++i) a[i] = ks[s * 128 + ty * 8 + i];
#pragma unroll
      for (int q = 0; q < 8; ++q) bb[q] = vs[s * 128 + tx * 8 + q];
#pragma unroll
      for (int i = 0; i < 8; ++i) {
        nacc[i] = fmaf(a[i], wsv, nacc[i]);
#pragma unroll
        for (int q = 0; q < 8; ++q) acc[i][q] = fmaf(a[i], bb[q], acc[i][q]);
      }
    }
    __syncthreads();
  }
  bf16_t* U = p.MS + (size_t)tile * 16384;
#pragma unroll
  for (int i = 0; i < 8; ++i) {
    u32x4 o;
    o.x = pk_bf16(acc[i][0], acc[i][1]); o.y = pk_bf16(acc[i][2], acc[i][3]);
    o.z = pk_bf16(acc[i][4], acc[i][5]); o.w = pk_bf16(acc[i][6], acc[i][7]);
    *(u32x4*)(U + (ty * 8 + i) * 128 + tx * 8) = o;
    if (tx == 0) p.MSn[tile * 128 + ty * 8 + i] = nacc[i];
  }
}

__device__ void ph_scan_a(const Params& p, int layer, char* smc) {
  float* sm = (float*)smc;
  const int tid = opaque_tid();
  const int wave = tid >> 6;
  const int nblk = gridDim.x, bid = blockIdx.x;
  for (int ch = bid; ch < 128; ch += nblk)
    if (wave == 0) rwkv_chain(p, ch, tid & 63);
  __syncthreads();
  const bool split = nblk > 160;
  const int nb2 = split ? nblk - 128 : nblk;
  const int b2 = split ? bid - 128 : bid;
  if (b2 >= 0)
    for (int tile = b2; tile < NMT; tile += nb2) { mlstm_s1(p, layer, tile, sm, tid); __syncthreads(); }
}

__device__ void ph_mlstm_s2(const Params& p) {
  const int tid = opaque_tid();
  const size_t total = (size_t)64 * 16512;
  for (size_t idx = (size_t)blockIdx.x * NTHR + tid; idx < total; idx += (size_t)gridDim.x * NTHR) {
    const int ch = (int)(idx / 16512), e = (int)(idx % 16512);
    float m = 0.f, C = 0.f;
    for (int c = 0; c < NCHUNK; ++c) {
      const int tile = ch * NCHUNK + c;
      const float mloc = p.msc[tile], bend = p.msc[NMT + tile];
      const float mn = fmaxf(bend + m, mloc);
      const float wc = expf(bend + m - mn), wl = expf(mloc - mn);
      float tmp;
      if (e < 16384) {
        bf16_t* ptr = p.MS + (size_t)tile * 16384 + e;
        tmp = bf2f(*ptr);
        *ptr = f2bf(C);
      } else {
        float* ptr = p.MSn + tile * 128 + (e - 16384);
        tmp = *ptr;
        *ptr = C;
      }
      C = wc * C + wl * tmp;
      if (e == 0) p.msc[2 * NMT + tile] = m;
      m = mn;
    }
  }
}

__device__ void mlstm_s3(const Params& p, int layer, int tile, float* sm, int tid) {
  const int j = layer >> 1;
  const int ch = tile / NCHUNK, c = tile % NCHUNK;
  const int dir = ch >> 5, b = (ch >> 2) & 7, h = ch & 3;
  float* s_b = sm;
  float* s_ig = sm + 64;
  float* s_mt = sm + 128;
  float* s_wi = sm + 192;
  float* s_den = sm + 256;
  int* s_row = (int*)(sm + 320);
  float* Sm = sm + 384;
  float* R = Sm + 64 * 65;
  const float mprev = p.msc[2 * NMT + tile];
  const float qscale = 0.08838834764831845f;
  if (tid < 64) {
    const int row = scan_row(dir, b, c * 64 + tid);
    s_row[tid] = row;
    const float* g = p.GP + (size_t)row * 16;
    const float gi = g[(dir * 2) * 4 + h] + p.mlstm_gate_b[j * 16 + (dir * 2) * 4 + h];
    const float gf = g[(dir * 2 + 1) * 4 + h] + p.mlstm_gate_b[j * 16 + (dir * 2 + 1) * 4 + h];
    float bc = -softplus_f(-gf);
#pragma unroll
    for (int o = 1; o < 64; o <<= 1) {
      float tmp = __shfl_up(bc, o);
      if (tid >= o) bc += tmp;
    }
    s_b[tid] = bc;
    s_ig[tid] = gi;
  }
  __syncthreads();
  if (tid < 64) {
    const float bt = s_b[tid];
    float mt = bt + mprev;
    for (int s = 0; s <= tid; ++s) mt = fmaxf(mt, bt - s_b[s] + s_ig[s]);
    s_mt[tid] = mt;
    s_wi[tid] = expf(bt + mprev - mt);
  }
  float dacc[16];
#pragma unroll
  for (int i = 0; i < 16; ++i) dacc[i] = 0.f;
  float* qh = R;
  float* kh = R + 64 * 65;
  for (int half = 0; half < 2; ++half) {
    __syncthreads();
    for (int i = tid; i < 64 * 16; i += NTHR) {
      const int s = i >> 4, c4 = (i & 15) * 4;
      const int row = s_row[s];
      const u32x2 qv = *(const u32x2*)(p.P + (size_t)row * LDP + 2048 + h * 128 + half * 64 + c4);
      const u32x2 kv = *(const u32x2*)(p.P + (size_t)row * LDP + 2560 + h * 128 + half * 64 + c4);
      qh[s * 65 + c4] = bflo(qv.x); qh[s * 65 + c4 + 1] = bfhi(qv.x); qh[s * 65 + c4 + 2] = bflo(qv.y); qh[s * 65 + c4 + 3] = bfhi(qv.y);
      kh[s * 65 + c4] = bflo(kv.x); kh[s * 65 + c4 + 1] = bfhi(kv.x); kh[s * 65 + c4 + 2] = bflo(kv.y); kh[s * 65 + c4 + 3] = bfhi(kv.y);
    }
    __syncthreads();
    const int s = tid & 63, tb = tid >> 6;
    for (int d = 0; d < 64; ++d) {
      const float kvv = kh[s * 65 + d];
#pragma unroll
      for (int i = 0; i < 16; ++i) dacc[i] = fmaf(qh[(tb + 4 * i) * 65 + d], kvv, dacc[i]);
    }
  }
  {
    const int s = tid & 63, tb = tid >> 6;
#pragma unroll
    for (int i = 0; i < 16; ++i) {
      const int t = tb + 4 * i;
      float val = 0.f;
      if (s <= t) val = dacc[i] * qscale * expf(s_b[t] - s_b[s] + s_ig[s] - s_mt[t]);
      Sm[t * 65 + s] = val;
    }
  }
  __syncthreads();
  if (tid < 64) {
    float d = 0.f;
    for (int s = 0; s < 64; ++s) d += Sm[tid * 65 + s];
    s_den[tid] = d;
  }
  float* vs = R;
  for (int i = tid; i < 64 * 32; i += NTHR) {
    const int s = i >> 5, c4 = (i & 31) * 4;
    const u32x2 vv = *(const u32x2*)(p.P + (size_t)s_row[s] * LDP + 3072 + h * 128 + c4);
    *(float4*)(vs + s * 128 + c4) = make_float4(bflo(vv.x), bfhi(vv.x), bflo(vv.y), bfhi(vv.y));
  }
  __syncthreads();
  const int tx = tid & 15, ty = tid >> 4;
  float acc[4][8];
#pragma unroll
  for (int i = 0; i < 4; ++i)
#pragma unroll
    for (int q = 0; q < 8; ++q) acc[i][q] = 0.f;
  for (int s = 0; s < 64; ++s) {
    float a[4], bb[8];
#pragma unroll
    for (int i = 0; i < 4; ++i) a[i] = Sm[(ty * 4 + i) * 65 + s];
#pragma unroll
    for (int q = 0; q < 8; ++q) bb[q] = vs[s * 128 + tx * 8 + q];
#pragma unroll
    for (int i = 0; i < 4; ++i)
#pragma unroll
      for (int q = 0; q < 8; ++q) acc[i][q] = fmaf(a[i], bb[q], acc[i][q]);
  }
  __syncthreads();
  float* qs = R;
  for (int i = tid; i < 64 * 32; i += NTHR) {
    const int s = i >> 5, c4 = (i & 31) * 4;
    const u32x2 qv = *(const u32x2*)(p.P + (size_t)s_row[s] * LDP + 2048 + h * 128 + c4);
    *(float4*)(qs + s * 128 + c4) =
        make_float4(bflo(qv.x) * qscale, bfhi(qv.x) * qscale, bflo(qv.y) * qscale, bfhi(qv.y) * qscale);
  }
  __syncthreads();
  const bf16_t* Cp = p.MS + (size_t)tile * 16384;
  const float* np = p.MSn + tile * 128;
  float acc2[4][8], qn[4];
#pragma unroll
  for (int i = 0; i < 4; ++i) {
    qn[i] = 0.f;
#pragma unroll
    for (int q = 0; q < 8; ++q) acc2[i][q] = 0.f;
  }
  for (int d = 0; d < 128; ++d) {
    float a[4];
#pragma unroll
    for (int i = 0; i < 4; ++i) a[i] = qs[(ty * 4 + i) * 128 + d];
    const u32x4 cv = *(const u32x4*)(Cp + d * 128 + tx * 8);
    const float nd = np[d];
    const float bb[8] = {bflo(cv.x), bfhi(cv.x), bflo(cv.y), bfhi(cv.y), bflo(cv.z), bfhi(cv.z), bflo(cv.w), bfhi(cv.w)};
#pragma unroll
    for (int i = 0; i < 4; ++i) {
      qn[i] = fmaf(a[i], nd, qn[i]);
#pragma unroll
      for (int q = 0; q < 8; ++q) acc2[i][q] = fmaf(a[i], bb[q], acc2[i][q]);
    }
  }
#pragma unroll
  for (int i = 0; i < 4; ++i) {
    const int t = ty * 4 + i;
    const float wi = s_wi[t];
    const float den = s_den[t] + wi * qn[i];
    const float dn = fmaxf(fabsf(den), expf(-s_mt[t]));
    const float inv = 1.f / dn;
    bf16_t* dst = p.P + (size_t)s_row[t] * LDP + 1024 + dir * 512 + h * 128 + tx * 8;
    float o[8];
#pragma unroll
    for (int q = 0; q < 8; ++q) o[q] = (acc[i][q] + wi * acc2[i][q]) * inv;
    u32x4 ov;
    ov.x = pk_bf16(o[0], o[1]); ov.y = pk_bf16(o[2], o[3]); ov.z = pk_bf16(o[4], o[5]); ov.w = pk_bf16(o[6], o[7]);
    *(u32x4*)dst = ov;
  }
}

__device__ void ph_mlstm_s3(const Params& p, int layer, char* smc) {
  float* sm = (float*)smc;
  const int tid = opaque_tid();
  for (int tile = blockIdx.x; tile < NMT; tile += gridDim.x) { mlstm_s3(p, layer, tile, sm, tid); __syncthreads(); }
}

__device__ void ph_rec_final(const Params& p, int layer, bool keep) {
  const int tid = opaque_tid();
  const int j = layer >> 1;
  const int lane = tid & 63, wave = tid >> 6;
  const int rows = keep ? NT : NL;
  for (int t = blockIdx.x * 4 + wave; t < rows; t += gridDim.x * 4) {
    const bf16_t* rw = p.RW + (size_t)t * RWS;
    const bf16_t* pt = p.P + (size_t)t * LDP;
    bf16_t* mo = p.AB + (size_t)t * DM;
#pragma unroll 1
    for (int h = 0; h < 8; ++h) {
      const int n = h * 64 + lane;
      const float y = bf2f(pt[n]) + bf2f(pt[512 + n]);
      const float mu = wsum(y) * (1.f / 64.f);
      const float dv = y - mu;
      const float var = wsum(dv * dv) * (1.f / 64.f);
      const float yn = dv * rsqrtf(var + 64e-5f) * p.rwkv_gn[(j * 2 + 0) * 512 + n] + p.rwkv_gn[(j * 2 + 1) * 512 + n];
      const float r = bf2f(rw[n]), v = bf2f(rw[512 + n]);
      const float bs = wsum(r * p.rwkv_rk[j * 512 + n] * (bf2f(rw[5 * 512 + n]) + bf2f(rw[6 * 512 + n])));
      mo[n] = f2bf((yn + bs * v) * bf2f(rw[9 * 512 + n]));
    }
#pragma unroll 1
    for (int h = 0; h < 4; ++h) {
      const int e0 = h * 128 + lane, e1 = e0 + 64;
      const float h0 = bf2f(pt[1024 + e0]) + bf2f(pt[1536 + e0]);
      const float h1 = bf2f(pt[1024 + e1]) + bf2f(pt[1536 + e1]);
      const float ss = wsum(h0 * h0 + h1 * h1) * (1.f / 128.f);
      const float rs = rsqrtf(ss + 1e-6f);
      mo[512 + e0] = f2bf(h0 * rs * p.mlstm_norm[j * 512 + e0] * sigm_f(bf2f(pt[3584 + e0])));
      mo[512 + e1] = f2bf(h1 * rs * p.mlstm_norm[j * 512 + e1] * sigm_f(bf2f(pt[3584 + e1])));
    }
  }
}

__device__ void ph_outproj(const Params& p, int layer, bool keep, char* lds) {
  const int tid = opaque_tid();
  const int rows = keep ? NT : NL;
  if (blockIdx.x == 0 && tid < 65) p.cnt[tid] = 0;
  const bf16_t* Wt = p.Wt_out + (size_t)layer * 1024 * 1024;
  const float* mod = p.MOD + layer * 9 * 6144;
  const int ntm = rows / 128;
  for (int tile = blockIdx.x; tile < ntm * 8; tile += gridDim.x) {
    const int tm = tile >> 3, tn = tile & 7;
    const int m0 = tm * 128, n0 = tn * 128;
    const bf16_t* Ab = p.AB + (size_t)m0 * DM;
    f32x16 acc[2][2];
    gemm128_main(tid, [&](int r) { return Ab + (size_t)r * DM; }, Wt, 1024, n0, lds, acc);
    const float* g1 = mod + modrow(m0) * 6144 + 2048 + n0;
    const float* Xb = p.X + (size_t)m0 * DM + n0;
    float* Tt = p.Tb + (size_t)m0 * DM + n0;
    acc_foreach(tid, acc, [&](int row, int col, float v) {
      Tt[(size_t)row * DM + col] = DN_ALPHA * Xb[(size_t)row * DM + col] + g1[col] * v;
    });
  }
}

__device__ void ph_ln_router(const Params& p, int layer, bool keep, char* smc) {
  float* sm = (float*)smc;
  const int tid = opaque_tid();
  const int lane = tid & 63, wave = tid >> 6;
  const int rows = keep ? NT : NL;
  float* hs = sm + wave * 1024;
  const float* lng = p.ln_g + (layer * 2 + 0) * 1024;
  const float* lnb = p.ln_b + (layer * 2 + 0) * 1024;
  const float* Wr = p.moe_router + (size_t)layer * 1024 * 64;
  for (int t = blockIdx.x * 4 + wave; t < rows; t += gridDim.x * 4) {
    const float* mod = p.MOD + (layer * 9 + modrow(t)) * 6144;
    float v[16];
    float s = 0.f;
#pragma unroll
    for (int i = 0; i < 16; ++i) { v[i] = p.Tb[(size_t)t * DM + i * 64 + lane]; s += v[i]; }
    const float mean = wsum(s) * (1.f / 1024.f);
    float q = 0.f;
#pragma unroll
    for (int i = 0; i < 16; ++i) { const float d = v[i] - mean; q += d * d; }
    const float rs = rsqrtf(wsum(q) * (1.f / 1024.f) + 1e-5f);
#pragma unroll
    for (int i = 0; i < 16; ++i) {
      const int n = i * 64 + lane;
      const float xn = (v[i] - mean) * rs * lng[n] + lnb[n];
      p.X[(size_t)t * DM + n] = xn;
      const float hh = xn * (1.f + mod[4096 + n]) + mod[3072 + n];
      p.AB[(size_t)t * DM + n] = f2bf(hh);
      hs[n] = hh;
    }
    float logit = 0.f;
    for (int k = 0; k < 1024; ++k) logit = fmaf(hs[k], Wr[k * 64 + lane], logit);
    const float score = sigm_f(logit);
    float sel = score + p.moe_bias[layer * 64 + lane];
    bool chosen = false;
    for (int r = 0; r < 6; ++r) {
      const float mx = wmax(sel);
      const unsigned long long bal = __ballot(sel == mx);
      const int first = __ffsll((long long)bal) - 1;
      if (lane == first) { chosen = true; sel = -INFINITY; }
    }
    const float gsum = wsum(chosen ? score : 0.f);
    const unsigned long long cb = __ballot(chosen);
    if (chosen) {
      const int kidx = __popcll(cb & ((1ull << lane) - 1ull));
      const int pos = atomicAdd(&p.cnt[lane], 1);
      p.ltok[(size_t)lane * NT + pos] = t;
      p.lgate[(size_t)lane * NT + pos] = score / gsum * 2.5f;
      p.tsl[t * 6 + kidx] = (lane << 16) | pos;
    }
  }
}

__device__ __forceinline__ void moe_prefix(const Params& p, int rows, int* s_pref, int tid) {
  if (tid == 0) {
    int a = 0;
    for (int e = 0; e < 64; ++e) { s_pref[e] = a; a += (p.cnt[e] + 127) >> 7; }
    s_pref[64] = a; a += rows >> 7;
    s_pref[65] = a;
  }
  __syncthreads();
}

__device__ void ph_moe1(const Params& p, int layer, bool keep, char* lds) {
  const int tid = opaque_tid();
  const int rows = keep ? NT : NL;
  int* pref = (int*)(lds + META_OFF);
  int* s_tok = pref + 66;
  moe_prefix(p, rows, pref, tid);
  const int total = pref[65] * 4;
  for (int tile = blockIdx.x; tile < total; tile += gridDim.x) {
    const int mtile = tile >> 2, nt = tile & 3;
    int e = 0;
    while (mtile >= pref[e + 1]) ++e;
    const int mt = mtile - pref[e];
    if (tid < 128) {
      const int pos = mt * 128 + tid;
      int tk = 0;
      if (e < 64) { if (pos < p.cnt[e]) tk = p.ltok[(size_t)e * NT + pos]; }
      else tk = pos;
      s_tok[tid] = tk;
    }
    __syncthreads();
    const bf16_t* Wt = p.Wt13 + (size_t)(layer * 65 + e) * 512 * 1024;
    f32x16 acc[2][2];
    gemm128_main(tid, [&](int r) { return p.AB + (size_t)s_tok[r] * DM; }, Wt, 1024, nt * 128, lds, acc);
    const int lane = tid & 63, w = tid >> 6;
    const int wm = w >> 1, wn = w & 1, r = lane & 31, h = lane >> 5;
    bf16_t* actb = p.ACT + ((size_t)mtile * 128) * 256 + nt * 64 + wn * 32 + r;
#pragma unroll
    for (int mi = 0; mi < 2; ++mi)
#pragma unroll
      for (int q = 0; q < 16; ++q) {
        const int row = wm * 64 + mi * 32 + (q & 3) + 8 * (q >> 2) + 4 * h;
        actb[(size_t)row * 256] = f2bf(silu_f(acc[mi][0][q]) * acc[mi][1][q]);
      }
  }
}

__device__ void ph_moe2(const Params& p, int layer, bool keep, char* lds) {
  const int tid = opaque_tid();
  const int rows = keep ? NT : NL;
  int* pref = (int*)(lds + META_OFF);
  float* s_gate = (float*)(pref + 66);
  moe_prefix(p, rows, pref, tid);
  const int total = pref[65] * 8;
  for (int tile = blockIdx.x; tile < total; tile += gridDim.x) {
    const int mtile = tile >> 3, nt = tile & 7;
    int e = 0;
    while (mtile >= pref[e + 1]) ++e;
    const int mt = mtile - pref[e];
    if (tid < 128) {
      const int pos = mt * 128 + tid;
      float g = 1.f;
      if (e < 64) g = pos < p.cnt[e] ? p.lgate[(size_t)e * NT + pos] : 0.f;
      s_gate[tid] = g;
    }
    __syncthreads();
    const bf16_t* Wt = p.Wt2 + (size_t)(layer * 65 + e) * 1024 * 256;
    const bf16_t* Ab = p.ACT + (size_t)mtile * 128 * 256;
    f32x16 acc[2][2];
    gemm128_main(tid, [&](int r) { return Ab + (size_t)r * 256; }, Wt, 256, nt * 128, lds, acc);
    bf16_t* ob = p.OUT2 + (size_t)mtile * 128 * 1024 + nt * 128;
    acc_foreach(tid, acc, [&](int row, int col, float v) { ob[(size_t)row * 1024 + col] = f2bf(s_gate[row] * v); });
    __syncthreads();
  }
}

__device__ void ph_final_ln(const Params& p, int layer, bool keep, char* lds) {
  const int tid = opaque_tid();
  const int lane = tid & 63, wave = tid >> 6;
  const int rows = keep ? NT : NL;
  int* s_base = (int*)(lds + META_OFF);
  if (tid == 0) {
    int a = 0;
    for (int e = 0; e < 64; ++e) { s_base[e] = a * 128; a += (p.cnt[e] + 127) >> 7; }
    s_base[64] = a * 128;
  }
  __syncthreads();
  const float* lng = p.ln_g + (layer * 2 + 1) * 1024;
  const float* lnb = p.ln_b + (layer * 2 + 1) * 1024;
  for (int t = blockIdx.x * 4 + wave; t < rows; t += gridDim.x * 4) {
    const int mr = modrow(t);
    const float* g2 = p.MOD + (layer * 9 + mr) * 6144 + 5120;
    const bf16_t* src[7];
#pragma unroll
    for (int k = 0; k < 6; ++k) {
      const int v = p.tsl[t * 6 + k];
      src[k] = p.OUT2 + (size_t)(s_base[v >> 16] + (v & 0xffff)) * 1024;
    }
    src[6] = p.OUT2 + (size_t)(s_base[64] + t) * 1024;
    float v[16];
    float s = 0.f;
#pragma unroll
    for (int i = 0; i < 16; ++i) {
      const int n = i * 64 + lane;
      float y = 0.f;
#pragma unroll
      for (int k = 0; k < 7; ++k) y += bf2f(src[k][n]);
      v[i] = DN_ALPHA * p.X[(size_t)t * DM + n] + g2[n] * y;
      s += v[i];
    }
    const float mean = wsum(s) * (1.f / 1024.f);
    float q = 0.f;
#pragma unroll
    for (int i = 0; i < 16; ++i) { const float d = v[i] - mean; q += d * d; }
    const float rs = rsqrtf(wsum(q) * (1.f / 1024.f) + 1e-5f);
    const float* modn = p.MOD + ((layer + 1) * 9 + mr) * 6144;
#pragma unroll
    for (int i = 0; i < 16; ++i) {
      const int n = i * 64 + lane;
      const float xn = (v[i] - mean) * rs * lng[n] + lnb[n];
      p.X[(size_t)t * DM + n] = xn;
      if (layer == 3) p.out[(size_t)t * DM + n] = xn;
      else p.AB[(size_t)t * DM + n] = f2bf(xn * (1.f + modn[1024 + n]) + modn[n]);
    }
  }
}

constexpr int NPHASE = 2 + 4 * 11;
__device__ __forceinline__ bool phase_is_nop(int ph) {
  if (ph < 2) return false;
  const int layer = (ph - 2) / 11, st = (ph - 2) % 11;
  return !(layer & 1) && (st >= 3 && st <= 5);
}
__device__ void run_phase(const Params& p, int ph, char* sm) {
  if (ph == 0) { ph_init(p, sm); return; }
  if (ph == 1) { ph_mod_h(p, sm); return; }
  const int layer = (ph - 2) / 11, st = (ph - 2) % 11;
  const bool odd = layer & 1;
  const bool keep = layer < 3;
  switch (st) {
    case 0: ph_gemm_in(p, layer, sm); break;
    case 1: if (odd) ph_rwkv_prep(p, layer, sm); else ph_att_post(p, layer); break;
    case 2: if (odd) ph_scan_a(p, layer, sm); else ph_attention(p, layer, keep); break;
    case 3: if (odd) ph_mlstm_s2(p); break;
    case 4: if (odd) ph_mlstm_s3(p, layer, sm); break;
    case 5: if (odd) ph_rec_final(p, layer, keep); break;
    case 6: ph_outproj(p, layer, keep, sm); break;
    case 7: ph_ln_router(p, layer, keep, sm); break;
    case 8: ph_moe1(p, layer, keep, sm); break;
    case 9: ph_moe2(p, layer, keep, sm); break;
    case 10: ph_final_ln(p, layer, keep, sm); break;
  }
}

__global__ void __launch_bounds__(NTHR) mega_kernel(Params p) {
  extern __shared__ __attribute__((aligned(16))) char sm[];
  cg::grid_group grid = cg::this_grid();
  for (int ph = p.ph_lo; ph < p.ph_hi; ++ph) {
    if (phase_is_nop(ph)) continue;
    run_phase(p, ph, sm);
    if (ph + 1 < p.ph_hi) grid.sync();
  }
}

extern "C" void kernel_launch(void* const* d_in, const int* in_sizes, int n_in, void* d_out, int out_size, void* d_ws,
                              size_t ws_size, hipStream_t stream) {
  static int grid_blocks = 0;
  if (!grid_blocks) {
    int dev = 0, cus = 0, per_cu = 0;
    (void)hipGetDevice(&dev);
    (void)hipDeviceGetAttribute(&cus, hipDeviceAttributeMultiprocessorCount, dev);
    (void)hipFuncSetAttribute((const void*)mega_kernel, hipFuncAttributeMaxDynamicSharedMemorySize, SMEM_BYTES);
    (void)hipOccupancyMaxActiveBlocksPerMultiprocessor(&per_cu, mega_kernel, NTHR, SMEM_BYTES);
    if (per_cu < 1) per_cu = 1;
    if (per_cu > 2) per_cu = 2;
    grid_blocks = cus * per_cu;
  }
  Params p;
  memset(&p, 0, sizeof(p));
  const float** pin = (const float**)&p;
  for (int i = 0; i < 35; ++i) pin[i] = (const float*)d_in[i];
  p.out = (float*)d_out;
  char* w = (char*)d_ws;
  size_t off = 0;
  auto take = [&](size_t bytes) { char* r = w + off; off += (bytes + 255) & ~(size_t)255; return r; };
  p.Wt_att = (bf16_t*)take((size_t)2 * ATT_N * 1024 * 2);
  p.Wt_rec = (bf16_t*)take((size_t)2 * REC_NP * 1024 * 2);
  p.Wt_out = (bf16_t*)take((size_t)4 * 1024 * 1024 * 2);
  p.Wt13 = (bf16_t*)take((size_t)4 * 65 * 512 * 1024 * 2);
  p.Wt2 = (bf16_t*)take((size_t)4 * 65 * 1024 * 256 * 2);
  p.X = (float*)take((size_t)NT * DM * 4);
  p.AB = (bf16_t*)take((size_t)NT * DM * 2);
  p.MOD = (float*)take((size_t)5 * 9 * 6144 * 4);
  p.MODP = (float*)take((size_t)8 * 4 * 9 * 6144 * 4);
  p.GP = (float*)take((size_t)NT * 16 * 4);
  p.msc = (float*)take((size_t)3 * NMT * 4);
  p.lgate = (float*)take((size_t)64 * NT * 4);
  p.ltok = (int*)take((size_t)64 * NT * 4);
  p.tsl = (int*)take((size_t)NT * 6 * 4);
  p.cnt = (int*)take(512);
  char* region = take(0);
  const size_t szP = (size_t)NT * LDP * 2, szRW = (size_t)NT * RWS * 2, szMS = (size_t)NMT * 16384 * 2,
               szMSn = (size_t)NMT * 128 * 4;
  const size_t szT = (size_t)NT * DM * 4, szOUT2 = (size_t)NSLOT * 1024 * 2;
  p.P = (bf16_t*)region;
  p.RW = (bf16_t*)(region + szP);
  p.MS = (bf16_t*)(region + szP + szRW);
  p.MSn = (float*)(region + szP + szRW + szMS);
  p.Tb = (float*)region;
  p.ACT = (bf16_t*)region;
  p.OUT2 = (bf16_t*)(region + szT);
  size_t mixer = szP + szRW + szMS + szMSn, moe = szT + szOUT2;
  off += (mixer > moe ? mixer : moe);
  if (off > ws_size) { fprintf(stderr, "workspace too small: need %zu have %zu\n", off, ws_size); return; }
  p.ph_lo = 0;
  p.ph_hi = NPHASE;
  void* args[] = {&p};
  hipError_t e = hipLaunchCooperativeKernel((void*)mega_kernel, dim3(grid_blocks), dim3(NTHR), args, SMEM_BYTES, stream);
  if (e != hipSuccess) fprintf(stderr, "cooperative launch failed: %s (grid %d)\n", hipGetErrorString(e), grid_blocks);
}
```

```cpp
#include <hip/hip_runtime.h>
#include <hip/hip_cooperative_groups.h>
#include <cstdio>
#include <cstring>
namespace cg = cooperative_groups;

constexpr int DM = 1024;
constexpr int NBATCH = 8;
constexpr int SEQ = 2048;
constexpr int CTXL = 256;
constexpr int NL = NBATCH * SEQ;
constexpr int NC = NBATCH * CTXL;
constexpr int NT = NL + NC;
constexpr int TSC = CTXL + SEQ;
constexpr int LDP = 4112;
constexpr int ATT_N = 2304;
constexpr int REC_N = 4112;
constexpr int REC_NP = 4224;
constexpr int NCHUNK = 36;
constexpr int NMT = 64 * NCHUNK;
constexpr int RWS = 5120;
constexpr int NSLOT = 137216;
constexpr float DN_ALPHA = 1.6817928305074290f;
constexpr int NTHR = 256;
constexpr int SMEM_BYTES = 65536 + 4096;
constexpr int META_OFF = 65536;

typedef unsigned short bf16_t;
using bf16x8 = __attribute__((ext_vector_type(8))) short;
using f32x16 = __attribute__((ext_vector_type(16))) float;
using u32x4 = __attribute__((ext_vector_type(4))) unsigned;
using u32x2 = __attribute__((ext_vector_type(2))) unsigned;

struct Params {
  const float *x, *c, *ctx, *c_ctx, *ada_w, *ada_b, *ln_g, *ln_b, *mix_w_out, *att_w_in, *na_rpb, *qk_gain,
      *rec_w_in, *rwkv_mu, *rwkv_w0, *rwkv_w1, *rwkv_w2, *rwkv_a0, *rwkv_a1, *rwkv_a2, *rwkv_g1, *rwkv_g2,
      *rwkv_kvec, *rwkv_rk, *rwkv_gn, *mlstm_gate_b, *mlstm_norm, *moe_router, *moe_bias, *moe_w1, *moe_w3,
      *moe_w2, *shared_w1, *shared_w3, *shared_w2;
  float* out;
  bf16_t *Wt_att, *Wt_rec, *Wt_out, *Wt13, *Wt2;
  float *X, *MOD, *MODP, *GP, *msc, *lgate, *MSn, *Tb;
  bf16_t *AB, *P, *RW, *MS, *ACT, *OUT2;
  int *cnt, *ltok, *tsl;
  unsigned* bar;
  int ph_lo, ph_hi;
};

typedef const Params __attribute__((address_space(4))) * KP;

__device__ __forceinline__ int modrow(int t) { return t < NL ? (t >> 11) : 8; }
__device__ __forceinline__ float silu_f(float x) { return x / (1.f + expf(-x)); }
__device__ __forceinline__ float sigm_f(float x) { return 1.f / (1.f + expf(-x)); }
__device__ __forceinline__ float softplus_f(float x) { return fmaxf(x, 0.f) + log1pf(expf(-fabsf(x))); }
__device__ __forceinline__ float wsum(float v) {
#pragma unroll
  for (int o = 32; o; o >>= 1) v += __shfl_xor(v, o);
  return v;
}
__device__ __forceinline__ float wmax(float v) {
#pragma unroll
  for (int o = 32; o; o >>= 1) v = fmaxf(v, __shfl_xor(v, o));
  return v;
}
__device__ __forceinline__ float rdlane(float v, int l) {
  return __int_as_float(__builtin_amdgcn_readlane(__float_as_int(v), l));
}
__device__ __forceinline__ int opaque_tid() {
  int t = threadIdx.x;
  asm volatile("" : "+v"(t));
  return t;
}
__device__ __forceinline__ unsigned pk_bf16(float lo, float hi) {
  unsigned r;
  asm("v_cvt_pk_bf16_f32 %0, %1, %2" : "=v"(r) : "v"(lo), "v"(hi));
  return r;
}
__device__ __forceinline__ bf16_t f2bf(float x) { return (bf16_t)(pk_bf16(x, 0.f) & 0xffffu); }
__device__ __forceinline__ float bf2f(bf16_t v) { return __uint_as_float((unsigned)v << 16); }
__device__ __forceinline__ float bflo(unsigned u) { return __uint_as_float(u << 16); }
__device__ __forceinline__ float bfhi(unsigned u) { return __uint_as_float(u & 0xffff0000u); }
__device__ __forceinline__ int scan_row(int dir, int b, int tau) {
  if (tau < CTXL) return NL + b * CTXL + (dir ? (CTXL - 1 - tau) : tau);
  int s = tau - CTXL;
  return b * SEQ + (dir ? (SEQ - 1 - s) : s);
}

template <class RowPtrA>
__device__ __forceinline__ void gemm128_main(int tid, RowPtrA rowA, const bf16_t* __restrict__ Bt, int K, int n0,
                                             char* lds, f32x16 (&acc)[2][2]) {
  const int lane = tid & 63, w = tid >> 6;
  const int wm = w >> 1, wn = w & 1, r = lane & 31, h = lane >> 5;
  const int c = tid & 7, sr = tid >> 3;
  const int sc = (c ^ ((tid >> 4) & 7)) * 16;
  const bf16_t* ap[4];
#pragma unroll
  for (int i = 0; i < 4; ++i) ap[i] = rowA(sr + 32 * i) + c * 8;
  const bf16_t* bp0 = Bt + (size_t)(n0 + sr) * K + c * 8;
  const int bstr = 32 * K;
  u32x4 ra[4], rb[4];
#pragma unroll
  for (int mi = 0; mi < 2; ++mi)
#pragma unroll
    for (int ni = 0; ni < 2; ++ni)
#pragma unroll
      for (int q = 0; q < 16; ++q) acc[mi][ni][q] = 0.f;
  const int nk = K >> 6;
#pragma unroll
  for (int i = 0; i < 4; ++i) { ra[i] = *(const u32x4*)(ap[i]); rb[i] = *(const u32x4*)(bp0 + i * bstr); }
  const int sw = (r >> 1) & 7;
#pragma unroll 1
  for (int kt = 0; kt < nk; ++kt) {
    char* As = lds + (kt & 1) * 32768;
    char* Bs = As + 16384;
#pragma unroll
    for (int i = 0; i < 4; ++i) {
      *(u32x4*)(As + (sr + 32 * i) * 128 + sc) = ra[i];
      *(u32x4*)(Bs + (sr + 32 * i) * 128 + sc) = rb[i];
    }
    __syncthreads();
    if (kt + 1 < nk) {
      const int k0 = (kt + 1) * 64;
#pragma unroll
      for (int i = 0; i < 4; ++i) { ra[i] = *(const u32x4*)(ap[i] + k0); rb[i] = *(const u32x4*)(bp0 + i * bstr + k0); }
    }
    const char* Ar = As + (wm * 64 + r) * 128;
    const char* Br = Bs + (wn * 64 + r) * 128;
#pragma unroll
    for (int ks = 0; ks < 4; ++ks) {
      const int off = ((ks * 2 + h) ^ sw) * 16;
      const bf16x8 a0 = *(const bf16x8*)(Ar + off);
      const bf16x8 a1 = *(const bf16x8*)(Ar + 32 * 128 + off);
      const bf16x8 b0 = *(const bf16x8*)(Br + off);
      const bf16x8 b1 = *(const bf16x8*)(Br + 32 * 128 + off);
      acc[0][0] = __builtin_amdgcn_mfma_f32_32x32x16_bf16(a0, b0, acc[0][0], 0, 0, 0);
      acc[0][1] = __builtin_amdgcn_mfma_f32_32x32x16_bf16(a0, b1, acc[0][1], 0, 0, 0);
      acc[1][0] = __builtin_amdgcn_mfma_f32_32x32x16_bf16(a1, b0, acc[1][0], 0, 0, 0);
      acc[1][1] = __builtin_amdgcn_mfma_f32_32x32x16_bf16(a1, b1, acc[1][1], 0, 0, 0);
    }
  }
  __syncthreads();
}
template <class F>
__device__ __forceinline__ void acc_foreach(int tid, const f32x16 (&acc)[2][2], F f) {
  const int lane = tid & 63, w = tid >> 6;
  const int wm = w >> 1, wn = w & 1, r = lane & 31, h = lane >> 5;
#pragma unroll
  for (int mi = 0; mi < 2; ++mi)
#pragma unroll
    for (int ni = 0; ni < 2; ++ni)
#pragma unroll
      for (int q = 0; q < 16; ++q) {
        const int row = wm * 64 + mi * 32 + (q & 3) + 8 * (q >> 2) + 4 * h;
        const int col = wn * 64 + ni * 32 + r;
        f(row, col, acc[mi][ni][q]);
        if ((q & 3) == 3) __builtin_amdgcn_sched_barrier(0);
      }
}

template <class RM>
__device__ __forceinline__ void tr_tile(int tid, const float* __restrict__ src, int N, int k0, int n0,
                                        bf16_t* __restrict__ dst, int K, RM rowmap, float* tile) {
  {
    const int tx = tid & 15, ty = tid >> 4;
    const int n = n0 + tx * 4;
#pragma unroll
    for (int i = 0; i < 4; ++i) {
      const int k = ty + 16 * i;
      float4 v = make_float4(0.f, 0.f, 0.f, 0.f);
      if (n < N) v = *(const float4*)(src + (size_t)(k0 + k) * N + n);
      tile[k * 65 + tx * 4 + 0] = v.x; tile[k * 65 + tx * 4 + 1] = v.y;
      tile[k * 65 + tx * 4 + 2] = v.z; tile[k * 65 + tx * 4 + 3] = v.w;
    }
  }
  __syncthreads();
  {
    const int kc = tid & 7;
#pragma unroll
    for (int i = 0; i < 2; ++i) {
      const int n = (tid >> 3) + 32 * i;
      if (n0 + n < N) {
        float v[8];
#pragma unroll
        for (int q = 0; q < 8; ++q) v[q] = tile[(kc * 8 + q) * 65 + n];
        u32x4 o;
        o.x = pk_bf16(v[0], v[1]); o.y = pk_bf16(v[2], v[3]); o.z = pk_bf16(v[4], v[5]); o.w = pk_bf16(v[6], v[7]);
        *(u32x4*)(dst + (size_t)rowmap(n0 + n) * K + k0 + kc * 8) = o;
      }
    }
  }
  __syncthreads();
}

__device__ void ph_init(KP p, char* smc) {
  float* sm = (float*)smc;
  const int tid = opaque_tid();
  {
    const size_t n4a = (size_t)NL * DM / 4, n4b = (size_t)NC * DM / 4;
    const float4* xs = (const float4*)p->x;
    const float4* cs = (const float4*)p->ctx;
    float4* X4 = (float4*)p->X;
    for (size_t i = (size_t)blockIdx.x * NTHR + tid; i < n4a + n4b; i += (size_t)gridDim.x * NTHR)
      X4[i] = i < n4a ? xs[i] : cs[i - n4a];
  }
  for (int tile = blockIdx.x; tile < 96 * 8; tile += gridDim.x) {
    const int ct = tile >> 3, ks = tile & 7;
    for (int i = tid; i < 9 * 128; i += NTHR) {
      const int r = i >> 7, k = ks * 128 + (i & 127);
      const float v = r < 8 ? p->c[r * 1024 + k] : p->c_ctx[k];
      sm[i] = silu_f(v);
    }
    __syncthreads();
    const int col = ct * 256 + tid;
    const int layer = col / 6144, n = col % 6144;
    const float* W = p->ada_w + ((size_t)layer * 1024 + ks * 128) * 6144 + n;
    float acc[9];
#pragma unroll
    for (int r = 0; r < 9; ++r) acc[r] = 0.f;
#pragma unroll 4
    for (int k = 0; k < 128; ++k) {
      const float w = W[(size_t)k * 6144];
#pragma unroll
      for (int r = 0; r < 9; ++r) acc[r] = fmaf(sm[r * 128 + k], w, acc[r]);
    }
#pragma unroll
    for (int r = 0; r < 9; ++r) p->MODP[((size_t)(ks * 4 + layer) * 9 + r) * 6144 + n] = acc[r];
    __syncthreads();
  }
  constexpr int T0 = 1152, T1 = T0 + 2080, T2 = T1 + 1024, T3 = T2 + 33280, T4 = T3 + 16640;
  for (int job = blockIdx.x; job < T4; job += gridDim.x) {
    if (job < T0) {
      const int j = job / 576, rem = job % 576, kt = rem / 36, nt = rem % 36;
      tr_tile(tid, p->att_w_in + (size_t)j * 1024 * ATT_N, ATT_N, kt * 64, nt * 64, p->Wt_att + (size_t)j * ATT_N * 1024,
              1024, [](int n) { return n; }, sm);
    } else if (job < T1) {
      const int q = job - T0;
      const int j = q / 1040, rem = q % 1040, kt = rem / 65, nt = rem % 65;
      tr_tile(tid, p->rec_w_in + (size_t)j * 1024 * REC_N, REC_N, kt * 64, nt * 64, p->Wt_rec + (size_t)j * REC_NP * 1024,
              1024, [](int n) { return n; }, sm);
    } else if (job < T2) {
      const int q = job - T1;
      const int i = q >> 8, rem = q & 255, kt = rem >> 4, nt = rem & 15;
      tr_tile(tid, p->mix_w_out + (size_t)i * 1024 * 1024, 1024, kt * 64, nt * 64, p->Wt_out + (size_t)i * 1024 * 1024,
              1024, [](int n) { return n; }, sm);
    } else if (job < T3) {
      const int q = job - T2;
      const int le = q >> 7, rem = q & 127;
      const int which = rem >> 6, kt = (rem >> 2) & 15, nt = rem & 3;
      const int layer = le / 65, e = le % 65;
      const float* src;
      if (e < 64) src = (which ? p->moe_w3 : p->moe_w1) + (size_t)(layer * 64 + e) * 1024 * 256;
      else src = (which ? p->shared_w3 : p->shared_w1) + (size_t)layer * 1024 * 256;
      tr_tile(tid, src, 256, kt * 64, nt * 64, p->Wt13 + (size_t)le * 512 * 1024, 1024,
              [which](int n) { return 64 * (n >> 5) + which * 32 + (n & 31); }, sm);
    } else {
      const int q = job - T3;
      const int le = q >> 6, rem = q & 63;
      const int kt = rem >> 4, nt = rem & 15;
      const int layer = le / 65, e = le % 65;
      const float* src = e < 64 ? p->moe_w2 + (size_t)(layer * 64 + e) * 256 * 1024 : p->shared_w2 + (size_t)layer * 256 * 1024;
      tr_tile(tid, src, 1024, kt * 64, nt * 64, p->Wt2 + (size_t)le * 1024 * 256, 256, [](int n) { return n; }, sm);
    }
  }
}

__device__ void ph_mod_h(KP p, char* smc) {
  float* sm = (float*)smc;
  const int tid = opaque_tid();
  for (int i = blockIdx.x * NTHR + tid; i < 4 * 9 * 6144; i += gridDim.x * NTHR) {
    const int layer = i / (9 * 6144), rem = i % (9 * 6144), n = rem % 6144;
    float s = p->ada_b[layer * 6144 + n];
#pragma unroll
    for (int ks = 0; ks < 8; ++ks) s += p->MODP[(size_t)(ks * 4 + layer) * 9 * 6144 + rem];
    p->MOD[i] = s;
  }
  const int lane = tid & 63, wave = tid >> 6;
  const int per = (((NT + gridDim.x - 1) / gridDim.x) + 3) & ~3;
  const int t0 = blockIdx.x * per, t1 = min(NT, t0 + per);
  int cur = -1;
  for (int tb = t0; tb < t1; tb += 4) {
    const int mr = modrow(tb);
    if (mr != cur) {
      __syncthreads();
      for (int n = tid; n < 2048; n += NTHR) {
        float a = p->ada_b[n];
#pragma unroll
        for (int ks = 0; ks < 8; ++ks) a += p->MODP[((size_t)(ks * 4) * 9 + mr) * 6144 + n];
        sm[n] = a;
      }
      cur = mr;
      __syncthreads();
    }
    const int t = tb + wave;
    if (t < t1) {
      const float* src = t < NL ? p->x + (size_t)t * DM : p->ctx + (size_t)(t - NL) * DM;
#pragma unroll
      for (int i = 0; i < 4; ++i) {
        const int n = i * 256 + lane * 4;
        const float4 xv = *(const float4*)(src + n);
        const float4 sh = *(const float4*)(sm + n);
        const float4 sc = *(const float4*)(sm + 1024 + n);
        u32x2 o;
        o.x = pk_bf16(xv.x * (1.f + sc.x) + sh.x, xv.y * (1.f + sc.y) + sh.y);
        o.y = pk_bf16(xv.z * (1.f + sc.z) + sh.z, xv.w * (1.f + sc.w) + sh.w);
        *(u32x2*)(p->AB + (size_t)t * DM + n) = o;
      }
    }
  }
}

__device__ void ph_gemm_in(KP p, int layer, char* lds) {
  const int tid = opaque_tid();
  const int j = layer >> 1;
  const bool att = !(layer & 1);
  const int N = att ? ATT_N : REC_N;
  const bf16_t* Wt = att ? p->Wt_att + (size_t)j * ATT_N * 1024 : p->Wt_rec + (size_t)j * REC_NP * 1024;
  const int ntn = att ? 18 : 33, ntm = NT / 128;
  for (int tile = blockIdx.x; tile < ntm * ntn; tile += gridDim.x) {
    const int tm = tile / ntn, tn = tile % ntn;
    const int m0 = tm * 128, n0 = tn * 128;
    const bf16_t* Ab = p->AB + (size_t)m0 * DM;
    f32x16 acc[2][2];
    gemm128_main(tid, [&](int r) { return Ab + (size_t)r * DM; }, Wt, 1024, n0, lds, acc);
    bf16_t* Pb = p->P + (size_t)m0 * LDP;
    float* GPb = p->GP + (size_t)m0 * 16;
    acc_foreach(tid, acc, [&](int row, int col, float v) {
      const int cn = n0 + col;
      if (cn < N) Pb[(size_t)row * LDP + cn] = f2bf(v);
      if (!att && cn >= 4096 && cn < 4112) GPb[row * 16 + (cn - 4096)] = v;
    });
  }
}

__device__ void ph_att_post(KP p, int layer) {
  const int tid = opaque_tid();
  const int j = layer >> 1;
  const int lane = tid & 63, wave = tid >> 6;
  for (int task = blockIdx.x * 4 + wave; task < NT * 10; task += gridDim.x * 4) {
    const int t = task / 10, hh = task % 10;
    const int col = hh < 8 ? 1536 + hh * 64 : 2048 + (hh - 8) * 64;
    bf16_t* ptr = p->P + (size_t)t * LDP + col;
    float v = bf2f(ptr[lane]);
    float ss = wsum(v * v);
    const float* g = p->qk_gain + j * 128 + (hh < 8 ? 0 : 64);
    v = v * rsqrtf(ss * (1.f / 64.f) + 1e-6f) * g[lane];
    if (t < NL) {
      const int s = t & 2047;
      const int prow = s >> 6, pcol = s & 63;
      const int pi = lane >> 1;
      const float pos = pi < 16 ? (float)prow : (float)pcol;
      const int f = pi & 15;
      const float inv = powf(10000.f, -(float)f / 16.f);
      const float ang = pos * inv;
      const float cs = cosf(ang), sn = sinf(ang);
      const float other = __shfl_xor(v, 1);
      v = (lane & 1) ? (other * sn + v * cs) : (v * cs - other * sn);
    }
    ptr[lane] = f2bf(v);
  }
}

typedef short v4i16_t __attribute__((ext_vector_type(4)));
using s16x4 = __attribute__((ext_vector_type(4))) short;
__device__ __forceinline__ s16x4 vtr(const char* p) {
  return __builtin_bit_cast(s16x4, __builtin_amdgcn_ds_read_tr16_b64_v4i16((__attribute__((address_space(3))) v4i16_t*)p));
}
#define MFMA32(a, b, c) __builtin_amdgcn_mfma_f32_32x32x16_bf16(a, b, c, 0, 0, 0)
__device__ void ph_attention(KP p, int layer, bool keep, char* lds) {
  const int tid = opaque_tid();
  const int lane = tid & 63, w = tid >> 6, r32 = lane & 31, hi = lane >> 5;
  const int j = layer >> 1;
  float* bias_lds = (float*)(lds + 32768 + 1024);
  const int n_gqa = 1024, n_na = 1024, n_cb = keep ? 128 : 0, n_ca = keep ? 128 : 0;
  const int total = n_gqa + n_na + n_cb + n_ca;
  constexpr float LOG2E = 1.4426950408889634f;
  constexpr float C2 = 0.125f * LOG2E;
  const int c = tid & 7, sr = tid >> 3;
  const int kso = (c ^ ((tid >> 4) & 7)) * 16;
  const int vso = (c >> 2) * 4096 + (c & 3) * 16;
  const int sw = (r32 >> 1) & 7;
  for (int item = blockIdx.x; item < total; item += gridDim.x) {
    int b, qrow0, qoff, koff, voff, ocol, lat_tiles, lat_row0;
    bool na = false;
    int r_w = 0, start_w = 0, ru0 = 0, hN = 0;
    if (item < n_gqa) {
      b = item >> 7;
      const int g = (item >> 6) & 1, tt = item & 63;
      qrow0 = b * SEQ + tt * 32; qoff = 1536 + (g * 4 + w) * 64; koff = 2048 + g * 64; voff = 2176 + g * 64;
      ocol = 512 + (g * 4 + w) * 64; lat_tiles = 32; lat_row0 = b * SEQ;
    } else if (item < n_gqa + n_na) {
      const int it = item - n_gqa;
      b = it >> 7; hN = (it >> 4) & 7;
      const int rp = it & 15;
      na = true; r_w = 2 * rp + (w >> 1);
      qrow0 = b * SEQ + r_w * 64 + (w & 1) * 32; qoff = hN * 64; koff = 512 + hN * 64; voff = 1024 + hN * 64; ocol = hN * 64;
      const int s0 = min(max(2 * rp - 4, 0), 24), s1 = min(max(2 * rp - 3, 0), 24);
      start_w = (w >> 1) ? s1 : s0; ru0 = s0; lat_tiles = (s1 != s0) ? 9 : 8; lat_row0 = b * SEQ + ru0 * 64;
    } else if (item < n_gqa + n_na + n_cb) {
      const int it = item - n_gqa - n_na;
      b = it >> 4;
      const int g = (it >> 3) & 1, tt = it & 7;
      qrow0 = NL + b * CTXL + tt * 32; qoff = 1536 + (g * 4 + w) * 64; koff = 2048 + g * 64; voff = 2176 + g * 64;
      ocol = 512 + (g * 4 + w) * 64; lat_tiles = 0; lat_row0 = 0;
    } else {
      const int it = item - n_gqa - n_na - n_cb;
      b = it >> 4;
      const int h = (it >> 1) & 7, half = it & 1;
      qrow0 = NL + b * CTXL + half * 128 + w * 32; qoff = h * 64; koff = 512 + h * 64; voff = 1024 + h * 64; ocol = h * 64;
      lat_tiles = 0; lat_row0 = 0;
    }
    const int ctx_row0 = NL + b * CTXL, ntiles = lat_tiles + 4;
    if (na)
      for (int i = tid; i < 465; i += NTHR) bias_lds[i] = p->na_rpb[(j * 8 + hN) * 465 + i] * LOG2E;
    bf16x8 qf[4];
    {
      const bf16_t* qp = p->P + (size_t)(qrow0 + r32) * LDP + qoff + hi * 8;
#pragma unroll
      for (int d0 = 0; d0 < 4; ++d0) qf[d0] = *(const bf16x8*)(qp + d0 * 16);
    }
    f32x16 o0, o1;
#pragma unroll
    for (int q = 0; q < 16; ++q) { o0[q] = 0.f; o1[q] = 0.f; }
    float m = -INFINITY, l = 0.f;
    u32x4 kr0, kr1, vr0, vr1;
    auto gload = [&](int t) {
      const int row0 = t < lat_tiles ? lat_row0 + 64 * t : ctx_row0 + 64 * (t - lat_tiles);
      const bf16_t* base = p->P + (size_t)(row0 + sr) * LDP + c * 8;
      kr0 = *(const u32x4*)(base + koff); kr1 = *(const u32x4*)(base + (size_t)32 * LDP + koff);
      vr0 = *(const u32x4*)(base + voff); vr1 = *(const u32x4*)(base + (size_t)32 * LDP + voff);
    };
    auto swrite = [&](int buf) {
      char* Kb = lds + buf * 16384;
      char* Vb = Kb + 8192;
      *(u32x4*)(Kb + sr * 128 + kso) = kr0; *(u32x4*)(Kb + (sr + 32) * 128 + kso) = kr1;
      *(u32x4*)(Vb + vso + sr * 64) = vr0; *(u32x4*)(Vb + vso + (sr + 32) * 64) = vr1;
    };
    gload(0);
    swrite(0);
    for (int t = 0; t < ntiles; ++t) {
      __syncthreads();
      if (t + 1 < ntiles) gload(t + 1);
      const bool na_tile = na && t < lat_tiles;
      const int kr = ru0 + t;
      const bool part = !na_tile || (kr >= start_w && kr < start_w + 8);
      if (part) {
        const char* Ks = lds + (t & 1) * 16384;
        const char* Vs = Ks + 8192;
        f32x16 s0, s1;
#pragma unroll
        for (int q = 0; q < 16; ++q) { s0[q] = 0.f; s1[q] = 0.f; }
#pragma unroll
        for (int d0 = 0; d0 < 4; ++d0) {
          const int off = ((2 * d0 + hi) ^ sw) * 16;
          const bf16x8 k0 = *(const bf16x8*)(Ks + r32 * 128 + off);
          const bf16x8 k1 = *(const bf16x8*)(Ks + (32 + r32) * 128 + off);
          s0 = MFMA32(k0, qf[d0], s0);
          s1 = MFMA32(k1, qf[d0], s1);
        }
        float mx = -INFINITY;
        if (na_tile) {
          const int cq = (w & 1) * 32 + r32;
          const int c0 = min(max(cq - 8, 0), 48);
          const float* brow = bias_lds + (kr - r_w + 7) * 31 + (15 - cq);
#pragma unroll
          for (int q = 0; q < 16; ++q) {
            const int kc = (q & 3) + 8 * (q >> 2) + 4 * hi;
            const float v0 = ((unsigned)(kc - c0) < 16u) ? fmaf(s0[q], C2, brow[kc]) : -INFINITY;
            const float v1 = ((unsigned)(kc + 32 - c0) < 16u) ? fmaf(s1[q], C2, brow[kc + 32]) : -INFINITY;
            s0[q] = v0; s1[q] = v1;
            mx = fmaxf(mx, fmaxf(v0, v1));
          }
        } else {
#pragma unroll
          for (int q = 0; q < 16; ++q) {
            s0[q] *= C2; s1[q] *= C2;
            mx = fmaxf(mx, fmaxf(s0[q], s1[q]));
          }
        }
        {
          auto rr = __builtin_amdgcn_permlane32_swap(__float_as_uint(mx), __float_as_uint(mx), false, false);
          mx = fmaxf(__uint_as_float(rr[0]), __uint_as_float(rr[1]));
        }
        const float mnew = fmaxf(m, mx);
        const float alpha = __builtin_amdgcn_exp2f(m - mnew);
        float ls = 0.f;
#pragma unroll
        for (int q = 0; q < 16; ++q) {
          s0[q] = __builtin_amdgcn_exp2f(s0[q] - mnew);
          s1[q] = __builtin_amdgcn_exp2f(s1[q] - mnew);
          ls += s0[q] + s1[q];
        }
        l = l * alpha + ls;
        m = mnew;
#pragma unroll
        for (int q = 0; q < 16; ++q) { o0[q] *= alpha; o1[q] *= alpha; }
        bf16x8 pf[4];
#pragma unroll
        for (int s = 0; s < 4; ++s) {
          const int u = (s & 1) * 8;
          u32x4 tpk;
          if (s < 2) {
            tpk.x = pk_bf16(s0[u + 0], s0[u + 1]); tpk.y = pk_bf16(s0[u + 2], s0[u + 3]);
            tpk.z = pk_bf16(s0[u + 4], s0[u + 5]); tpk.w = pk_bf16(s0[u + 6], s0[u + 7]);
          } else {
            tpk.x = pk_bf16(s1[u + 0], s1[u + 1]); tpk.y = pk_bf16(s1[u + 2], s1[u + 3]);
            tpk.z = pk_bf16(s1[u + 4], s1[u + 5]); tpk.w = pk_bf16(s1[u + 6], s1[u + 7]);
          }
          pf[s] = __builtin_bit_cast(bf16x8, tpk);
        }
        const char* vb = Vs + ((lane >> 4) & 1) * 32 + (lane & 3) * 8 + ((lane & 15) >> 2) * 64 + hi * 256;
#pragma unroll
        for (int s = 0; s < 4; ++s) {
          const s16x4 a00 = vtr(vb + (16 * s) * 64), a01 = vtr(vb + (16 * s + 8) * 64);
          const s16x4 a10 = vtr(vb + 4096 + (16 * s) * 64), a11 = vtr(vb + 4096 + (16 * s + 8) * 64);
          const bf16x8 A0 = __builtin_shufflevector(a00, a01, 0, 1, 2, 3, 4, 5, 6, 7);
          const bf16x8 A1 = __builtin_shufflevector(a10, a11, 0, 1, 2, 3, 4, 5, 6, 7);
          o0 = MFMA32(A0, pf[s], o0);
          o1 = MFMA32(A1, pf[s], o1);
        }
      }
      if (t + 1 < ntiles) swrite((t + 1) & 1);
    }
    __syncthreads();
    const float lt = l + __shfl_xor(l, 32);
    const float inv = 1.f / lt;
    bf16_t* op = p->AB + (size_t)(qrow0 + r32) * DM + ocol + 4 * hi;
#pragma unroll
    for (int g = 0; g < 4; ++g) {
      u32x2 v0, v1;
      v0.x = pk_bf16(o0[4 * g] * inv, o0[4 * g + 1] * inv); v0.y = pk_bf16(o0[4 * g + 2] * inv, o0[4 * g + 3] * inv);
      v1.x = pk_bf16(o1[4 * g] * inv, o1[4 * g + 1] * inv); v1.y = pk_bf16(o1[4 * g + 2] * inv, o1[4 * g + 3] * inv);
      *(u32x2*)(op + 8 * g) = v0;
      *(u32x2*)(op + 32 + 8 * g) = v1;
    }
  }
}

__device__ void ph_rwkv_prep(KP p, int layer, char* smc) {
  float* sm = (float*)smc;
  const int j = layer >> 1;
  const int tid = opaque_tid();
  float* xs = sm;
  float* lw = sm + 6 * 512;
  float* la = lw + 64;
  float* lg = la + 64;
  const float* mu = p->rwkv_mu + j * 6 * 512;
  for (int t = blockIdx.x; t < NT; t += gridDim.x) {
    bool hasp, hasn;
    if (t < NL) { int s = t & 2047; hasp = s > 0; hasn = s < SEQ - 1; }
    else { int s = (t - NL) & 255; hasp = s > 0; hasn = s < CTXL - 1; }
    const bf16_t* pt = p->P + (size_t)t * LDP;
    for (int c = tid; c < 2048; c += NTHR) {
      const int which = c >> 9, ch = c & 511;
      const float cur = bf2f(pt[c]);
      const float pv = hasp ? bf2f(pt[c - LDP]) : 0.f;
      const float nx = hasn ? bf2f(pt[c + LDP]) : 0.f;
      const float d = 0.5f * (pv + nx) - cur;
      if (which < 3) xs[which * 512 + ch] = cur + d * mu[which * 512 + ch];
      else {
        xs[3 * 512 + ch] = cur + d * mu[3 * 512 + ch];
        xs[4 * 512 + ch] = cur + d * mu[4 * 512 + ch];
        xs[5 * 512 + ch] = cur + d * mu[5 * 512 + ch];
      }
    }
    __syncthreads();
    if (tid < 64) {
      const int d = tid >> 5, r = tid & 31;
      const float* w = p->rwkv_w1 + (size_t)(j * 2 + d) * 512 * 32 + r;
      float a = 0.f;
      for (int c = 0; c < 512; ++c) a = fmaf(xs[3 * 512 + c], w[c * 32], a);
      lw[tid] = tanhf(a);
    } else if (tid < 128) {
      const int o = tid - 64, d = o >> 5, r = o & 31;
      const float* w = p->rwkv_a1 + (size_t)(j * 2 + d) * 512 * 32 + r;
      float a = 0.f;
      for (int c = 0; c < 512; ++c) a = fmaf(xs[4 * 512 + c], w[c * 32], a);
      la[o] = a;
    } else if (tid < 224) {
      const int r = tid - 128;
      const float* w = p->rwkv_g1 + (size_t)j * 512 * 96 + r;
      float a = 0.f;
      for (int c = 0; c < 512; ++c) a = fmaf(xs[5 * 512 + c], w[c * 96], a);
      lg[r] = sigm_f(a);
    }
    __syncthreads();
    bf16_t* rw = p->RW + (size_t)t * RWS;
    for (int c = tid; c < 512; c += NTHR) {
      const float kx = xs[512 + c];
      float kkv = kx * p->rwkv_kvec[(j * 2 + 0) * 512 + c];
      const float ss = wsum(kkv * kkv);
      kkv *= rsqrtf(fmaxf(ss, 1e-24f));
      float gate = 0.f;
      for (int r = 0; r < 96; ++r) gate = fmaf(lg[r], p->rwkv_g2[(size_t)(j * 96 + r) * 512 + c], gate);
      const float kv1 = p->rwkv_kvec[(j * 2 + 1) * 512 + c];
#pragma unroll
      for (int d = 0; d < 2; ++d) {
        float wp = p->rwkv_w0[(j * 2 + d) * 512 + c];
        float ap = p->rwkv_a0[(j * 2 + d) * 512 + c];
        for (int r = 0; r < 32; ++r) {
          wp = fmaf(lw[d * 32 + r], p->rwkv_w2[(size_t)((j * 2 + d) * 32 + r) * 512 + c], wp);
          ap = fmaf(la[d * 32 + r], p->rwkv_a2[(size_t)((j * 2 + d) * 32 + r) * 512 + c], ap);
        }
        const float eps = expf(-softplus_f(-wp) - 0.5f);
        const float av = sigm_f(ap);
        rw[(3 + d) * 512 + c] = f2bf(eps);
        rw[(5 + d) * 512 + c] = f2bf(kx * (1.f + (av - 1.f) * kv1));
        rw[(7 + d) * 512 + c] = f2bf(av);
      }
      rw[c] = f2bf(xs[c]);
      rw[512 + c] = f2bf(xs[2 * 512 + c]);
      rw[2 * 512 + c] = f2bf(kkv);
      rw[9 * 512 + c] = f2bf(gate);
    }
    __syncthreads();
  }
}

template <int CTRL>
__device__ __forceinline__ float dppx(float x) {
  return __int_as_float(__builtin_amdgcn_update_dpp(0, __float_as_int(x), CTRL, 0xf, 0xf, true));
}
constexpr int RS_STEP = 384;
constexpr int RS_TB = 16;
__device__ void rwkv_unit(KP p, int unit, float* sm, int tid) {
  const int ch = unit >> 1, hf = unit & 1;
  const int dir = ch >> 6, b = (ch >> 3) & 7, h = ch & 7;
  const int lane = tid & 63, w = tid >> 6, rl = lane >> 3, ks = lane & 7;
  float* ybuf = sm + 2 * RS_TB * RS_STEP;
  const int ss = tid >> 4, kq = tid & 15;
  u32x2 g_r, g_kk, g_e, g_ke, g_a, g_v;
  auto gload = [&](int n) {
    const int row = scan_row(dir, b, n * RS_TB + ss);
    const bf16_t* base = p->RW + (size_t)row * RWS + h * 64 + kq * 4;
    g_r = *(const u32x2*)(base);
    g_kk = *(const u32x2*)(base + 2 * 512);
    g_e = *(const u32x2*)(base + (3 + dir) * 512);
    g_ke = *(const u32x2*)(base + (5 + dir) * 512);
    g_a = *(const u32x2*)(base + (7 + dir) * 512);
    g_v = *(const u32x2*)(p->RW + (size_t)row * RWS + 512 + h * 64 + hf * 32 + (kq & 7) * 4);
  };
  auto swrite = [&](int buf) {
    float* sp = sm + (buf * RS_TB + ss) * RS_STEP;
    const float r0 = bflo(g_r.x), r1 = bfhi(g_r.x), r2 = bflo(g_r.y), r3 = bfhi(g_r.y);
    const float k0 = bflo(g_kk.x), k1 = bfhi(g_kk.x), k2 = bflo(g_kk.y), k3 = bfhi(g_kk.y);
    const float w0 = expf(-bflo(g_e.x)), w1 = expf(-bfhi(g_e.x)), w2 = expf(-bflo(g_e.y)), w3 = expf(-bfhi(g_e.y));
    const float e0 = bflo(g_ke.x), e1 = bfhi(g_ke.x), e2 = bflo(g_ke.y), e3 = bfhi(g_ke.y);
    const float a0 = k0 * bflo(g_a.x), a1 = k1 * bfhi(g_a.x), a2 = k2 * bflo(g_a.y), a3 = k3 * bfhi(g_a.y);
    *(float4*)(sp + kq * 4) = make_float4(k0, k1, k2, k3);
    *(float4*)(sp + 64 + kq * 4) = make_float4(w0 * r0, w1 * r1, w2 * r2, w3 * r3);
    *(float4*)(sp + 128 + kq * 4) = make_float4(w0, w1, w2, w3);
    *(float4*)(sp + 192 + kq * 4) = make_float4(a0, a1, a2, a3);
    *(float4*)(sp + 256 + kq * 4) = make_float4(e0, e1, e2, e3);
    if (kq < 8) *(float4*)(sp + 320 + kq * 4) = make_float4(bflo(g_v.x), bfhi(g_v.x), bflo(g_v.y), bfhi(g_v.y));
    float c1 = a0 * r0 + a1 * r1 + a2 * r2 + a3 * r3;
    float c2 = e0 * r0 + e1 * r1 + e2 * r2 + e3 * r3;
#pragma unroll
    for (int o = 1; o < 16; o <<= 1) { c1 += __shfl_xor(c1, o); c2 += __shfl_xor(c2, o); }
    if (kq == 0) { sp[352] = c1; sp[353] = c2; }
  };
  float S[8];
#pragma unroll
  for (int i = 0; i < 8; ++i) S[i] = 0.f;
  constexpr int NB = TSC / RS_TB;
  gload(0);
  swrite(0);
  __syncthreads();
  for (int n = 0; n < NB; ++n) {
    if (n + 1 < NB) gload(n + 1);
    const float* bp = sm + (n & 1) * RS_TB * RS_STEP + ks * 8;
    float* yb = ybuf + (n & 1) * RS_TB * 32 + w * 8 + rl;
#pragma unroll 4
    for (int s = 0; s < RS_TB; ++s) {
      const float* sp = bp + s * RS_STEP;
      const float4 kA = *(const float4*)(sp), kB = *(const float4*)(sp + 4);
      const float4 rA = *(const float4*)(sp + 64), rB = *(const float4*)(sp + 68);
      const float4 wA = *(const float4*)(sp + 128), wB = *(const float4*)(sp + 132);
      const float4 aA = *(const float4*)(sp + 192), aB = *(const float4*)(sp + 196);
      const float4 eA = *(const float4*)(sp + 256), eB = *(const float4*)(sp + 260);
      const float* sq = sm + ((n & 1) * RS_TB + s) * RS_STEP;
      const float vv = sq[320 + w * 8 + rl];
      const float c1 = sq[352], c2 = sq[353];
      float sa = S[0] * kA.x, y0 = S[0] * rA.x;
      sa = fmaf(S[1], kA.y, sa); y0 = fmaf(S[1], rA.y, y0);
      sa = fmaf(S[2], kA.z, sa); y0 = fmaf(S[2], rA.z, y0);
      sa = fmaf(S[3], kA.w, sa); y0 = fmaf(S[3], rA.w, y0);
      sa = fmaf(S[4], kB.x, sa); y0 = fmaf(S[4], rB.x, y0);
      sa = fmaf(S[5], kB.y, sa); y0 = fmaf(S[5], rB.y, y0);
      sa = fmaf(S[6], kB.z, sa); y0 = fmaf(S[6], rB.z, y0);
      sa = fmaf(S[7], kB.w, sa); y0 = fmaf(S[7], rB.w, y0);
      sa += dppx<0xB1>(sa); y0 += dppx<0xB1>(y0);
      sa += dppx<0x4E>(sa); y0 += dppx<0x4E>(y0);
      sa += dppx<0x141>(sa); y0 += dppx<0x141>(y0);
      sa = -sa;
      S[0] = fmaf(vv, eA.x, fmaf(sa, aA.x, S[0] * wA.x));
      S[1] = fmaf(vv, eA.y, fmaf(sa, aA.y, S[1] * wA.y));
      S[2] = fmaf(vv, eA.z, fmaf(sa, aA.z, S[2] * wA.z));
      S[3] = fmaf(vv, eA.w, fmaf(sa, aA.w, S[3] * wA.w));
      S[4] = fmaf(vv, eB.x, fmaf(sa, aB.x, S[4] * wB.x));
      S[5] = fmaf(vv, eB.y, fmaf(sa, aB.y, S[5] * wB.y));
      S[6] = fmaf(vv, eB.z, fmaf(sa, aB.z, S[6] * wB.z));
      S[7] = fmaf(vv, eB.w, fmaf(sa, aB.w, S[7] * wB.w));
      const float y = fmaf(vv, c2, fmaf(sa, c1, y0));
      if (ks == 0) yb[s * 32] = y;
    }
    if (n + 1 < NB) swrite((n + 1) & 1);
    __syncthreads();
    {
      const int row = scan_row(dir, b, n * RS_TB + ss);
      const float* ys = ybuf + (n & 1) * RS_TB * 32 + ss * 32 + kq * 2;
      *(unsigned*)(p->P + (size_t)row * LDP + dir * 512 + h * 64 + hf * 32 + kq * 2) = pk_bf16(ys[0], ys[1]);
    }
  }
  __syncthreads();
}

__device__ void mlstm_s1(KP p, int layer, int tile, float* sm, int tid) {
  const int j = layer >> 1;
  const int ch = tile / NCHUNK, c = tile % NCHUNK;
  const int dir = ch >> 5, b = (ch >> 2) & 7, h = ch & 3;
  float* s_ws = sm;
  int* s_row = (int*)(sm + 64);
  float* ks = sm + 128;
  float* vs = ks + 32 * 128;
  if (tid < 64) {
    const int row = scan_row(dir, b, c * 64 + tid);
    s_row[tid] = row;
    const float* g = p->GP + (size_t)row * 16;
    const float gi = g[(dir * 2) * 4 + h] + p->mlstm_gate_b[j * 16 + (dir * 2) * 4 + h];
    const float gf = g[(dir * 2 + 1) * 4 + h] + p->mlstm_gate_b[j * 16 + (dir * 2 + 1) * 4 + h];
    float bc = -softplus_f(-gf);
#pragma unroll
    for (int o = 1; o < 64; o <<= 1) {
      float tmp = __shfl_up(bc, o);
      if (tid >= o) bc += tmp;
    }
    const float bend = __shfl(bc, 63);
    const float ds = bend - bc + gi;
    const float mloc = wmax(ds);
    s_ws[tid] = expf(ds - mloc);
    if (tid == 0) { p->msc[tile] = mloc; p->msc[NMT + tile] = bend; }
  }
  __syncthreads();
  const int tx = tid & 15, ty = tid >> 4;
  float acc[8][8], nacc[8];
#pragma unroll
  for (int i = 0; i < 8; ++i) {
    nacc[i] = 0.f;
#pragma unroll
    for (int q = 0; q < 8; ++q) acc[i][q] = 0.f;
  }
  for (int half = 0; half < 2; ++half) {
    for (int i = tid; i < 32 * 32; i += NTHR) {
      const int s = i >> 5, c4 = (i & 31) * 4;
      const int row = s_row[half * 32 + s];
      const float wsv = s_ws[half * 32 + s];
      const u32x2 kv = *(const u32x2*)(p->P + (size_t)row * LDP + 2560 + h * 128 + c4);
      const u32x2 vv = *(const u32x2*)(p->P + (size_t)row * LDP + 3072 + h * 128 + c4);
      *(float4*)(ks + s * 128 + c4) = make_float4(bflo(kv.x), bfhi(kv.x), bflo(kv.y), bfhi(kv.y));
      *(float4*)(vs + s * 128 + c4) = make_float4(bflo(vv.x) * wsv, bfhi(vv.x) * wsv, bflo(vv.y) * wsv, bfhi(vv.y) * wsv);
    }
    __syncthreads();
    for (int s = 0; s < 32; ++s) {
      const float wsv = s_ws[half * 32 + s];
      float a[8], bb[8];
#pragma unroll
      for (int i = 0; i < 8; ++i) a[i] = ks[s * 128 + ty * 8 + i];
#pragma unroll
      for (int q = 0; q < 8; ++q) bb[q] = vs[s * 128 + tx * 8 + q];
#pragma unroll
      for (int i = 0; i < 8; ++i) {
        nacc[i] = fmaf(a[i], wsv, nacc[i]);
#pragma unroll
        for (int q = 0; q < 8; ++q) acc[i][q] = fmaf(a[i], bb[q], acc[i][q]);
      }
    }
    __syncthreads();
  }
  bf16_t* U = p->MS + (size_t)tile * 16384;
#pragma unroll
  for (int i = 0; i < 8; ++i) {
    u32x4 o;
    o.x = pk_bf16(acc[i][0], acc[i][1]); o.y = pk_bf16(acc[i][2], acc[i][3]);
    o.z = pk_bf16(acc[i][4], acc[i][5]); o.w = pk_bf16(acc[i][6], acc[i][7]);
    *(u32x4*)(U + (ty * 8 + i) * 128 + tx * 8) = o;
    if (tx == 0) p->MSn[tile * 128 + ty * 8 + i] = nacc[i];
  }
}

__device__ void ph_scan_a(KP p, int layer, char* smc) {
  float* sm = (float*)smc;
  const int tid = opaque_tid();
  for (int u = blockIdx.x; u < 256; u += gridDim.x) rwkv_unit(p, u, sm, tid);
  const int nblk = gridDim.x, bid = blockIdx.x;
  const int start = (bid + nblk - (256 % nblk)) % nblk;
  for (int tile = start; tile < NMT; tile += nblk) { mlstm_s1(p, layer, tile, sm, tid); __syncthreads(); }
}

__device__ void ph_mlstm_s2(KP p, char* smc) {
  float* sw = (float*)smc;
  const int tid = opaque_tid();
  const int nitems = 64 * 33;
  for (int item = blockIdx.x; item < nitems; item += gridDim.x) {
    const int ch = item / 33, seg = item % 33;
    __syncthreads();
    if (tid == 0) {
      float m = 0.f;
      for (int c = 0; c < NCHUNK; ++c) {
        const int tile = ch * NCHUNK + c;
        const float mloc = p->msc[tile], bend = p->msc[NMT + tile];
        const float mn = fmaxf(bend + m, mloc);
        sw[c] = expf(bend + m - mn);
        sw[36 + c] = expf(mloc - mn);
        if (seg == 0) p->msc[2 * NMT + tile] = m;
        m = mn;
      }
    }
    __syncthreads();
    if (seg < 32) {
      unsigned* base = (unsigned*)(p->MS + (size_t)ch * NCHUNK * 16384) + seg * 256 + tid;
      unsigned v[NCHUNK];
#pragma unroll
      for (int c = 0; c < NCHUNK; ++c) v[c] = base[(size_t)c * 8192];
      float C0 = 0.f, C1 = 0.f;
#pragma unroll
      for (int c = 0; c < NCHUNK; ++c) {
        const float t0 = bflo(v[c]), t1 = bfhi(v[c]);
        v[c] = pk_bf16(C0, C1);
        C0 = sw[c] * C0 + sw[36 + c] * t0;
        C1 = sw[c] * C1 + sw[36 + c] * t1;
      }
#pragma unroll
      for (int c = 0; c < NCHUNK; ++c) base[(size_t)c * 8192] = v[c];
    } else if (tid < 128) {
      float* base = p->MSn + (size_t)ch * NCHUNK * 128 + tid;
      float v[NCHUNK];
#pragma unroll
      for (int c = 0; c < NCHUNK; ++c) v[c] = base[c * 128];
      float C = 0.f;
#pragma unroll
      for (int c = 0; c < NCHUNK; ++c) {
        const float t0 = v[c];
        v[c] = C;
        C = sw[c] * C + sw[36 + c] * t0;
      }
#pragma unroll
      for (int c = 0; c < NCHUNK; ++c) base[c * 128] = v[c];
    }
  }
}

__device__ void mlstm_s3(KP p, int layer, int tile, float* sm, int tid) {
  const int j = layer >> 1;
  const int ch = tile / NCHUNK, c = tile % NCHUNK;
  const int dir = ch >> 5, b = (ch >> 2) & 7, h = ch & 3;
  float* s_b = sm;
  float* s_ig = sm + 64;
  float* s_mt = sm + 128;
  float* s_wi = sm + 192;
  float* s_den = sm + 256;
  int* s_row = (int*)(sm + 320);
  float* Sm = sm + 384;
  float* R = Sm + 64 * 65;
  const float mprev = p->msc[2 * NMT + tile];
  const float qscale = 0.08838834764831845f;
  if (tid < 64) {
    const int row = scan_row(dir, b, c * 64 + tid);
    s_row[tid] = row;
    const float* g = p->GP + (size_t)row * 16;
    const float gi = g[(dir * 2) * 4 + h] + p->mlstm_gate_b[j * 16 + (dir * 2) * 4 + h];
    const float gf = g[(dir * 2 + 1) * 4 + h] + p->mlstm_gate_b[j * 16 + (dir * 2 + 1) * 4 + h];
    float bc = -softplus_f(-gf);
#pragma unroll
    for (int o = 1; o < 64; o <<= 1) {
      float tmp = __shfl_up(bc, o);
      if (tid >= o) bc += tmp;
    }
    s_b[tid] = bc;
    s_ig[tid] = gi;
  }
  __syncthreads();
  if (tid < 64) {
    const float bt = s_b[tid];
    float mt = bt + mprev;
    for (int s = 0; s <= tid; ++s) mt = fmaxf(mt, bt - s_b[s] + s_ig[s]);
    s_mt[tid] = mt;
    s_wi[tid] = expf(bt + mprev - mt);
  }
  float dacc[16];
#pragma unroll
  for (int i = 0; i < 16; ++i) dacc[i] = 0.f;
  float* qh = R;
  float* kh = R + 64 * 65;
  for (int half = 0; half < 2; ++half) {
    __syncthreads();
    for (int i = tid; i < 64 * 16; i += NTHR) {
      const int s = i >> 4, c4 = (i & 15) * 4;
      const int row = s_row[s];
      const u32x2 qv = *(const u32x2*)(p->P + (size_t)row * LDP + 2048 + h * 128 + half * 64 + c4);
      const u32x2 kv = *(const u32x2*)(p->P + (size_t)row * LDP + 2560 + h * 128 + half * 64 + c4);
      qh[s * 65 + c4] = bflo(qv.x); qh[s * 65 + c4 + 1] = bfhi(qv.x); qh[s * 65 + c4 + 2] = bflo(qv.y); qh[s * 65 + c4 + 3] = bfhi(qv.y);
      kh[s * 65 + c4] = bflo(kv.x); kh[s * 65 + c4 + 1] = bfhi(kv.x); kh[s * 65 + c4 + 2] = bflo(kv.y); kh[s * 65 + c4 + 3] = bfhi(kv.y);
    }
    __syncthreads();
    const int s = tid & 63, tb = tid >> 6;
    for (int d = 0; d < 64; ++d) {
      const float kvv = kh[s * 65 + d];
#pragma unroll
      for (int i = 0; i < 16; ++i) dacc[i] = fmaf(qh[(tb + 4 * i) * 65 + d], kvv, dacc[i]);
    }
  }
  {
    const int s = tid & 63, tb = tid >> 6;
#pragma unroll
    for (int i = 0; i < 16; ++i) {
      const int t = tb + 4 * i;
      float val = 0.f;
      if (s <= t) val = dacc[i] * qscale * expf(s_b[t] - s_b[s] + s_ig[s] - s_mt[t]);
      Sm[t * 65 + s] = val;
    }
  }
  __syncthreads();
  if (tid < 64) {
    float d = 0.f;
    for (int s = 0; s < 64; ++s) d += Sm[tid * 65 + s];
    s_den[tid] = d;
  }
  float* vs = R;
  for (int i = tid; i < 64 * 32; i += NTHR) {
    const int s = i >> 5, c4 = (i & 31) * 4;
    const u32x2 vv = *(const u32x2*)(p->P + (size_t)s_row[s] * LDP + 3072 + h * 128 + c4);
    *(float4*)(vs + s * 128 + c4) = make_float4(bflo(vv.x), bfhi(vv.x), bflo(vv.y), bfhi(vv.y));
  }
  __syncthreads();
  const int tx = tid & 15, ty = tid >> 4;
  float acc[4][8];
#pragma unroll
  for (int i = 0; i < 4; ++i)
#pragma unroll
    for (int q = 0; q < 8; ++q) acc[i][q] = 0.f;
  for (int s = 0; s < 64; ++s) {
    float a[4], bb[8];
#pragma unroll
    for (int i = 0; i < 4; ++i) a[i] = Sm[(ty * 4 + i) * 65 + s];
#pragma unroll
    for (int q = 0; q < 8; ++q) bb[q] = vs[s * 128 + tx * 8 + q];
#pragma unroll
    for (int i = 0; i < 4; ++i)
#pragma unroll
      for (int q = 0; q < 8; ++q) acc[i][q] = fmaf(a[i], bb[q], acc[i][q]);
  }
  __syncthreads();
  float* qs = R;
  for (int i = tid; i < 64 * 32; i += NTHR) {
    const int s = i >> 5, c4 = (i & 31) * 4;
    const u32x2 qv = *(const u32x2*)(p->P + (size_t)s_row[s] * LDP + 2048 + h * 128 + c4);
    *(float4*)(qs + s * 128 + c4) =
        make_float4(bflo(qv.x) * qscale, bfhi(qv.x) * qscale, bflo(qv.y) * qscale, bfhi(qv.y) * qscale);
  }
  __syncthreads();
  const bf16_t* Cp = p->MS + (size_t)tile * 16384;
  const float* np = p->MSn + tile * 128;
  float acc2[4][8], qn[4];
#pragma unroll
  for (int i = 0; i < 4; ++i) {
    qn[i] = 0.f;
#pragma unroll
    for (int q = 0; q < 8; ++q) acc2[i][q] = 0.f;
  }
  for (int d = 0; d < 128; ++d) {
    float a[4];
#pragma unroll
    for (int i = 0; i < 4; ++i) a[i] = qs[(ty * 4 + i) * 128 + d];
    const u32x4 cv = *(const u32x4*)(Cp + d * 128 + tx * 8);
    const float nd = np[d];
    const float bb[8] = {bflo(cv.x), bfhi(cv.x), bflo(cv.y), bfhi(cv.y), bflo(cv.z), bfhi(cv.z), bflo(cv.w), bfhi(cv.w)};
#pragma unroll
    for (int i = 0; i < 4; ++i) {
      qn[i] = fmaf(a[i], nd, qn[i]);
#pragma unroll
      for (int q = 0; q < 8; ++q) acc2[i][q] = fmaf(a[i], bb[q], acc2[i][q]);
    }
  }
#pragma unroll
  for (int i = 0; i < 4; ++i) {
    const int t = ty * 4 + i;
    const float wi = s_wi[t];
    const float den = s_den[t] + wi * qn[i];
    const float dn = fmaxf(fabsf(den), expf(-s_mt[t]));
    const float inv = 1.f / dn;
    bf16_t* dst = p->P + (size_t)s_row[t] * LDP + 1024 + dir * 512 + h * 128 + tx * 8;
    float o[8];
#pragma unroll
    for (int q = 0; q < 8; ++q) o[q] = (acc[i][q] + wi * acc2[i][q]) * inv;
    u32x4 ov;
    ov.x = pk_bf16(o[0], o[1]); ov.y = pk_bf16(o[2], o[3]); ov.z = pk_bf16(o[4], o[5]); ov.w = pk_bf16(o[6], o[7]);
    *(u32x4*)dst = ov;
  }
}

__device__ void ph_mlstm_s3(KP p, int layer, char* smc) {
  float* sm = (float*)smc;
  const int tid = opaque_tid();
  for (int tile = blockIdx.x; tile < NMT; tile += gridDim.x) { mlstm_s3(p, layer, tile, sm, tid); __syncthreads(); }
}

__device__ void ph_rec_final(KP p, int layer, bool keep) {
  const int tid = opaque_tid();
  const int j = layer >> 1;
  const int lane = tid & 63, wave = tid >> 6;
  const int rows = keep ? NT : NL;
  for (int t = blockIdx.x * 4 + wave; t < rows; t += gridDim.x * 4) {
    const bf16_t* rw = p->RW + (size_t)t * RWS;
    const bf16_t* pt = p->P + (size_t)t * LDP;
    bf16_t* mo = p->AB + (size_t)t * DM;
#pragma unroll 1
    for (int h = 0; h < 8; ++h) {
      const int n = h * 64 + lane;
      const float y = bf2f(pt[n]) + bf2f(pt[512 + n]);
      const float mu = wsum(y) * (1.f / 64.f);
      const float dv = y - mu;
      const float var = wsum(dv * dv) * (1.f / 64.f);
      const float yn = dv * rsqrtf(var + 64e-5f) * p->rwkv_gn[(j * 2 + 0) * 512 + n] + p->rwkv_gn[(j * 2 + 1) * 512 + n];
      const float r = bf2f(rw[n]), v = bf2f(rw[512 + n]);
      const float bs = wsum(r * p->rwkv_rk[j * 512 + n] * (bf2f(rw[5 * 512 + n]) + bf2f(rw[6 * 512 + n])));
      mo[n] = f2bf((yn + bs * v) * bf2f(rw[9 * 512 + n]));
    }
#pragma unroll 1
    for (int h = 0; h < 4; ++h) {
      const int e0 = h * 128 + lane, e1 = e0 + 64;
      const float h0 = bf2f(pt[1024 + e0]) + bf2f(pt[1536 + e0]);
      const float h1 = bf2f(pt[1024 + e1]) + bf2f(pt[1536 + e1]);
      const float ss = wsum(h0 * h0 + h1 * h1) * (1.f / 128.f);
      const float rs = rsqrtf(ss + 1e-6f);
      mo[512 + e0] = f2bf(h0 * rs * p->mlstm_norm[j * 512 + e0] * sigm_f(bf2f(pt[3584 + e0])));
      mo[512 + e1] = f2bf(h1 * rs * p->mlstm_norm[j * 512 + e1] * sigm_f(bf2f(pt[3584 + e1])));
    }
  }
}

__device__ void ph_outproj(KP p, int layer, bool keep, char* lds) {
  const int tid = opaque_tid();
  const int rows = keep ? NT : NL;
  if (blockIdx.x == 0 && tid < 65) p->cnt[tid] = 0;
  const bf16_t* Wt = p->Wt_out + (size_t)layer * 1024 * 1024;
  const float* mod = p->MOD + layer * 9 * 6144;
  const int ntm = rows / 128;
  for (int tile = blockIdx.x; tile < ntm * 8; tile += gridDim.x) {
    const int tm = tile >> 3, tn = tile & 7;
    const int m0 = tm * 128, n0 = tn * 128;
    const bf16_t* Ab = p->AB + (size_t)m0 * DM;
    f32x16 acc[2][2];
    gemm128_main(tid, [&](int r) { return Ab + (size_t)r * DM; }, Wt, 1024, n0, lds, acc);
    const float* g1 = mod + modrow(m0) * 6144 + 2048 + n0;
    const float* Xb = p->X + (size_t)m0 * DM + n0;
    float* Tt = p->Tb + (size_t)m0 * DM + n0;
    acc_foreach(tid, acc, [&](int row, int col, float v) {
      Tt[(size_t)row * DM + col] = DN_ALPHA * Xb[(size_t)row * DM + col] + g1[col] * v;
    });
  }
}

using f32x4v = __attribute__((ext_vector_type(4))) float;
__device__ void ph_ln_router(KP p, int layer, bool keep, char* smc) {
  float* h2s = (float*)smc;
  float* lgs = (float*)smc;
  const int tid = opaque_tid();
  const int lane = tid & 63, wave = tid >> 6;
  const int rows = keep ? NT : NL;
  const float* lng = p->ln_g + (layer * 2 + 0) * 1024;
  const float* lnb = p->ln_b + (layer * 2 + 0) * 1024;
  const float* Wr = p->moe_router + (size_t)layer * 1024 * 64;
  for (int tile = blockIdx.x; tile < rows / 16; tile += gridDim.x) {
    const int t0 = tile * 16;
    const float* mod = p->MOD + (layer * 9 + modrow(t0)) * 6144;
#pragma unroll 1
    for (int q = 0; q < 4; ++q) {
      const int tl = wave * 4 + q, t = t0 + tl;
      float v[16];
      float s = 0.f;
#pragma unroll
      for (int i = 0; i < 16; ++i) { v[i] = p->Tb[(size_t)t * DM + i * 64 + lane]; s += v[i]; }
      const float mean = wsum(s) * (1.f / 1024.f);
      float qq = 0.f;
#pragma unroll
      for (int i = 0; i < 16; ++i) { const float d = v[i] - mean; qq += d * d; }
      const float rs = rsqrtf(wsum(qq) * (1.f / 1024.f) + 1e-5f);
#pragma unroll
      for (int i = 0; i < 16; ++i) {
        const int n = i * 64 + lane;
        const float xn = (v[i] - mean) * rs * lng[n] + lnb[n];
        p->X[(size_t)t * DM + n] = xn;
        const float hh = xn * (1.f + mod[4096 + n]) + mod[3072 + n];
        p->AB[(size_t)t * DM + n] = f2bf(hh);
        h2s[tl * 1028 + n] = hh;
      }
    }
    __syncthreads();
    f32x4v acc = {0.f, 0.f, 0.f, 0.f};
    {
      const int i = lane & 15, kk = lane >> 4;
      const float* arow = h2s + i * 1028 + 4 * kk;
      const float* bcol = Wr + (4 * kk) * 64 + 16 * wave + i;
#pragma unroll 4
      for (int q = 0; q < 64; ++q) {
        const float4 a = *(const float4*)(arow + 16 * q);
        const float b0 = bcol[(16 * q + 0) * 64], b1 = bcol[(16 * q + 1) * 64];
        const float b2 = bcol[(16 * q + 2) * 64], b3 = bcol[(16 * q + 3) * 64];
        acc = __builtin_amdgcn_mfma_f32_16x16x4f32(a.x, b0, acc, 0, 0, 0);
        acc = __builtin_amdgcn_mfma_f32_16x16x4f32(a.y, b1, acc, 0, 0, 0);
        acc = __builtin_amdgcn_mfma_f32_16x16x4f32(a.z, b2, acc, 0, 0, 0);
        acc = __builtin_amdgcn_mfma_f32_16x16x4f32(a.w, b3, acc, 0, 0, 0);
      }
    }
    __syncthreads();
#pragma unroll
    for (int r = 0; r < 4; ++r) lgs[((lane >> 4) * 4 + r) * 64 + 16 * wave + (lane & 15)] = acc[r];
    __syncthreads();
#pragma unroll 1
    for (int q = 0; q < 4; ++q) {
      const int tl = wave * 4 + q, t = t0 + tl;
      const float logit = lgs[tl * 64 + lane];
      const float score = sigm_f(logit);
      float sel = score + p->moe_bias[layer * 64 + lane];
      bool chosen = false;
      for (int r = 0; r < 6; ++r) {
        const float mx = wmax(sel);
        const unsigned long long bal = __ballot(sel == mx);
        const int first = __ffsll((long long)bal) - 1;
        if (lane == first) { chosen = true; sel = -INFINITY; }
      }
      const float gsum = wsum(chosen ? score : 0.f);
      const unsigned long long cb = __ballot(chosen);
      if (chosen) {
        const int kidx = __popcll(cb & ((1ull << lane) - 1ull));
        const int pos = atomicAdd(&p->cnt[lane], 1);
        p->ltok[(size_t)lane * NT + pos] = t;
        p->lgate[(size_t)lane * NT + pos] = score / gsum * 2.5f;
        p->tsl[t * 6 + kidx] = (lane << 16) | pos;
      }
    }
    __syncthreads();
  }
}

__device__ __forceinline__ void moe_prefix(KP p, int rows, int* s_pref, int tid) {
  if (tid == 0) {
    int a = 0;
    for (int e = 0; e < 64; ++e) { s_pref[e] = a; a += (p->cnt[e] + 127) >> 7; }
    s_pref[64] = a; a += rows >> 7;
    s_pref[65] = a;
  }
  __syncthreads();
}

__device__ void ph_moe1(KP p, int layer, bool keep, char* lds) {
  const int tid = opaque_tid();
  const int rows = keep ? NT : NL;
  int* pref = (int*)(lds + META_OFF);
  int* s_tok = pref + 66;
  moe_prefix(p, rows, pref, tid);
  const int total = pref[65] * 4;
  for (int tile = blockIdx.x; tile < total; tile += gridDim.x) {
    const int mtile = tile >> 2, nt = tile & 3;
    int e = 0;
    while (mtile >= pref[e + 1]) ++e;
    const int mt = mtile - pref[e];
    if (tid < 128) {
      const int pos = mt * 128 + tid;
      int tk = 0;
      if (e < 64) { if (pos < p->cnt[e]) tk = p->ltok[(size_t)e * NT + pos]; }
      else tk = pos;
      s_tok[tid] = tk;
    }
    __syncthreads();
    const bf16_t* Wt = p->Wt13 + (size_t)(layer * 65 + e) * 512 * 1024;
    f32x16 acc[2][2];
    gemm128_main(tid, [&](int r) { return p->AB + (size_t)s_tok[r] * DM; }, Wt, 1024, nt * 128, lds, acc);
    const int lane = tid & 63, w = tid >> 6;
    const int wm = w >> 1, wn = w & 1, r = lane & 31, h = lane >> 5;
    bf16_t* actb = p->ACT + ((size_t)mtile * 128) * 256 + nt * 64 + wn * 32 + r;
#pragma unroll
    for (int mi = 0; mi < 2; ++mi)
#pragma unroll
      for (int q = 0; q < 16; ++q) {
        const int row = wm * 64 + mi * 32 + (q & 3) + 8 * (q >> 2) + 4 * h;
        actb[(size_t)row * 256] = f2bf(silu_f(acc[mi][0][q]) * acc[mi][1][q]);
        if ((q & 3) == 3) __builtin_amdgcn_sched_barrier(0);
      }
  }
}

__device__ void ph_moe2(KP p, int layer, bool keep, char* lds) {
  const int tid = opaque_tid();
  const int rows = keep ? NT : NL;
  int* pref = (int*)(lds + META_OFF);
  float* s_gate = (float*)(pref + 66);
  moe_prefix(p, rows, pref, tid);
  const int total = pref[65] * 8;
  for (int tile = blockIdx.x; tile < total; tile += gridDim.x) {
    const int mtile = tile >> 3, nt = tile & 7;
    int e = 0;
    while (mtile >= pref[e + 1]) ++e;
    const int mt = mtile - pref[e];
    if (tid < 128) {
      const int pos = mt * 128 + tid;
      float g = 1.f;
      if (e < 64) g = pos < p->cnt[e] ? p->lgate[(size_t)e * NT + pos] : 0.f;
      s_gate[tid] = g;
    }
    __syncthreads();
    const bf16_t* Wt = p->Wt2 + (size_t)(layer * 65 + e) * 1024 * 256;
    const bf16_t* Ab = p->ACT + (size_t)mtile * 128 * 256;
    f32x16 acc[2][2];
    gemm128_main(tid, [&](int r) { return Ab + (size_t)r * 256; }, Wt, 256, nt * 128, lds, acc);
    bf16_t* ob = p->OUT2 + (size_t)mtile * 128 * 1024 + nt * 128;
    acc_foreach(tid, acc, [&](int row, int col, float v) { ob[(size_t)row * 1024 + col] = f2bf(s_gate[row] * v); });
    __syncthreads();
  }
}

__device__ void ph_final_ln(KP p, int layer, bool keep, char* lds) {
  const int tid = opaque_tid();
  const int lane = tid & 63, wave = tid >> 6;
  const int rows = keep ? NT : NL;
  int* s_base = (int*)(lds + META_OFF);
  if (tid == 0) {
    int a = 0;
    for (int e = 0; e < 64; ++e) { s_base[e] = a * 128; a += (p->cnt[e] + 127) >> 7; }
    s_base[64] = a * 128;
  }
  __syncthreads();
  const float* lng = p->ln_g + (layer * 2 + 1) * 1024;
  const float* lnb = p->ln_b + (layer * 2 + 1) * 1024;
  for (int t = blockIdx.x * 4 + wave; t < rows; t += gridDim.x * 4) {
    const int mr = modrow(t);
    const float* g2 = p->MOD + (layer * 9 + mr) * 6144 + 5120;
    const bf16_t* src[7];
#pragma unroll
    for (int k = 0; k < 6; ++k) {
      const int v = p->tsl[t * 6 + k];
      src[k] = p->OUT2 + (size_t)(s_base[v >> 16] + (v & 0xffff)) * 1024;
    }
    src[6] = p->OUT2 + (size_t)(s_base[64] + t) * 1024;
    float v[16];
    float s = 0.f;
#pragma unroll
    for (int i = 0; i < 16; ++i) {
      const int n = i * 64 + lane;
      float y = 0.f;
#pragma unroll
      for (int k = 0; k < 7; ++k) y += bf2f(src[k][n]);
      v[i] = DN_ALPHA * p->X[(size_t)t * DM + n] + g2[n] * y;
      s += v[i];
    }
    const float mean = wsum(s) * (1.f / 1024.f);
    float q = 0.f;
#pragma unroll
    for (int i = 0; i < 16; ++i) { const float d = v[i] - mean; q += d * d; }
    const float rs = rsqrtf(wsum(q) * (1.f / 1024.f) + 1e-5f);
    const float* modn = p->MOD + ((layer + 1) * 9 + mr) * 6144;
#pragma unroll
    for (int i = 0; i < 16; ++i) {
      const int n = i * 64 + lane;
      const float xn = (v[i] - mean) * rs * lng[n] + lnb[n];
      p->X[(size_t)t * DM + n] = xn;
      if (layer == 3) p->out[(size_t)t * DM + n] = xn;
      else p->AB[(size_t)t * DM + n] = f2bf(xn * (1.f + modn[1024 + n]) + modn[n]);
    }
  }
}

#define XB_TMO      128
#define XB_XCNT(j)  (256  + 64 * (j))
#define XB_XSUB(j)  (1280 + 64 * (j))
#define XB_XGEN(j)  (2304 + 64 * (j))
#define XB_TOP      3328
#define XB_TOPGEN   3392
#define XCD_BAR_WORDS 3456
#define XB_SPIN_CAP (1u << 20)
#define LAS __attribute__((address_space(3)))
__device__ __forceinline__ unsigned xb_ld(unsigned* p) { return __hip_atomic_load(p, __ATOMIC_RELAXED, __HIP_MEMORY_SCOPE_AGENT); }
__device__ __forceinline__ unsigned xb_add(unsigned* p, unsigned v) { return __hip_atomic_fetch_add(p, v, __ATOMIC_RELAXED, __HIP_MEMORY_SCOPE_AGENT); }
__device__ __forceinline__ unsigned xb_xcc_id() { return (unsigned)__builtin_amdgcn_s_getreg((3 << 11) | 20) & 0xFu; }
#define XB_SPIN(cond, bar) do { unsigned _sp = 0; while (cond) { __builtin_amdgcn_s_sleep(1); \
    if ((++_sp & 255u) == 0u) { if (xb_ld(&(bar)[XB_TMO])) break; if (_sp > XB_SPIN_CAP) { atomicAdd(&(bar)[XB_TMO], 1u); break; } } } } while (0)
struct XcdBarrier { unsigned* bar; unsigned x; volatile LAS unsigned* st; };
__device__ __forceinline__ XcdBarrier xcd_barrier_post(unsigned* bar, volatile LAS unsigned* st) {
  XcdBarrier b; b.bar = bar; b.x = xb_xcc_id(); b.st = st;
  if (threadIdx.x == 0) (void)xb_add(&bar[XB_XCNT(b.x)], 1u);
  return b;
}
__device__ __forceinline__ void xcd_barrier_complete(unsigned* bar, unsigned x, unsigned& nloc, unsigned& nx) {
  const unsigned G = gridDim.x;
  unsigned sum, cnt, mine, sp = 0u;
  for (;;) {
    sum = 0u; cnt = 0u; mine = 0u;
#pragma unroll
    for (unsigned j = 0; j < 16; ++j) { const unsigned c = xb_ld(&bar[XB_XCNT(j)]); sum += c; cnt += (c > 0u) ? 1u : 0u; mine = (j == x) ? c : mine; }
    if (sum == G) break;
    __builtin_amdgcn_s_sleep(1);
    if ((++sp & 255u) == 0u) { if (xb_ld(&bar[XB_TMO])) break; if (sp > XB_SPIN_CAP) { atomicAdd(&bar[XB_TMO], 1u); break; } }
  }
  nloc = mine > 0u ? mine : 1u; nx = cnt > 0u ? cnt : 1u;
}
__device__ __forceinline__ void xcd_barrier(const XcdBarrier& b) {
  asm volatile("s_waitcnt vmcnt(0)" ::: "memory");
  __syncthreads();
  if (threadIdx.x == 0) {
    unsigned* bar = b.bar;
    __builtin_amdgcn_s_waitcnt(0);
    unsigned nloc = b.st[0], nx = b.st[1];
    if (nloc == 0u) { xcd_barrier_complete(bar, b.x, nloc, nx); b.st[0] = nloc; b.st[1] = nx; }
    const unsigned old = xb_add(&bar[XB_XSUB(b.x)], 1u);
    const unsigned gen = old / nloc;
    if (old + 1u == (gen + 1u) * nloc) {
      __builtin_amdgcn_fence(__ATOMIC_RELEASE, "agent");
      asm volatile("s_waitcnt vmcnt(0)" ::: "memory");
      const unsigned og = xb_add(&bar[XB_TOP], 1u);
      const unsigned tg = og / nx;
      if (og + 1u == (tg + 1u) * nx) xb_add(&bar[XB_TOPGEN], 1u);
      else XB_SPIN(xb_ld(&bar[XB_TOPGEN]) == tg, bar);
      __builtin_amdgcn_fence(__ATOMIC_ACQUIRE, "agent");
      xb_add(&bar[XB_XGEN(b.x)], 1u);
      asm volatile("s_waitcnt vmcnt(0)" ::: "memory");
    } else {
      XB_SPIN(xb_ld(&bar[XB_XGEN(b.x)]) == gen, bar);
      __builtin_amdgcn_fence(__ATOMIC_ACQUIRE, "agent");
      asm volatile("s_waitcnt vmcnt(0)" ::: "memory");
    }
  }
  __syncthreads();
}

constexpr int NPHASE = 2 + 4 * 11;
__device__ __forceinline__ bool phase_is_nop(int ph) {
  if (ph < 2) return false;
  const int layer = (ph - 2) / 11, st = (ph - 2) % 11;
  return !(layer & 1) && (st >= 3 && st <= 5);
}
__device__ void run_phase(KP p, int ph, char* sm) {
  if (ph == 0) { ph_init(p, sm); return; }
  if (ph == 1) { ph_mod_h(p, sm); return; }
  const int layer = (ph - 2) / 11, st = (ph - 2) % 11;
  const bool odd = layer & 1;
  const bool keep = layer < 3;
  switch (st) {
    case 0: ph_gemm_in(p, layer, sm); break;
    case 1: if (odd) ph_rwkv_prep(p, layer, sm); else ph_att_post(p, layer); break;
    case 2: if (odd) ph_scan_a(p, layer, sm); else ph_attention(p, layer, keep, sm); break;
    case 3: if (odd) ph_mlstm_s2(p, sm); break;
    case 4: if (odd) ph_mlstm_s3(p, layer, sm); break;
    case 5: if (odd) ph_rec_final(p, layer, keep); break;
    case 6: ph_outproj(p, layer, keep, sm); break;
    case 7: ph_ln_router(p, layer, keep, sm); break;
    case 8: ph_moe1(p, layer, keep, sm); break;
    case 9: ph_moe2(p, layer, keep, sm); break;
    case 10: ph_final_ln(p, layer, keep, sm); break;
  }
}

__global__ void __launch_bounds__(NTHR, 2) mega_kernel(Params kargs) {
  extern __shared__ __attribute__((aligned(16))) char sm[];
  cg::grid_group grid = cg::this_grid();
  volatile LAS unsigned* st = (volatile LAS unsigned*)(sm + META_OFF + 4032);
  if (threadIdx.x == 0) { st[0] = 0u; st[1] = 0u; }
  __syncthreads();
  const XcdBarrier xb = xcd_barrier_post(kargs.bar, st);
  for (int ph = kargs.ph_lo; ph < kargs.ph_hi; ++ph) {
    if (phase_is_nop(ph)) continue;
    {
      KP kp = (KP)__builtin_amdgcn_kernarg_segment_ptr();
      asm volatile("" : "+s"(kp));
      run_phase(kp, ph, sm);
    }
    if (ph + 1 < kargs.ph_hi) {
      if (ph == 0) grid.sync();
      else xcd_barrier(xb);
    }
  }
}

extern "C" void kernel_launch(void* const* d_in, const int* in_sizes, int n_in, void* d_out, int out_size, void* d_ws,
                              size_t ws_size, hipStream_t stream) {
  static int grid_blocks = 0;
  if (!grid_blocks) {
    int dev = 0, cus = 0, per_cu = 0;
    (void)hipGetDevice(&dev);
    (void)hipDeviceGetAttribute(&cus, hipDeviceAttributeMultiprocessorCount, dev);
    (void)hipFuncSetAttribute((const void*)mega_kernel, hipFuncAttributeMaxDynamicSharedMemorySize, SMEM_BYTES);
    (void)hipOccupancyMaxActiveBlocksPerMultiprocessor(&per_cu, mega_kernel, NTHR, SMEM_BYTES);
    if (per_cu < 1) per_cu = 1;
    if (per_cu > 2) per_cu = 2;
    grid_blocks = cus * per_cu;
  }
  Params p;
  memset(&p, 0, sizeof(p));
  const float** pin = (const float**)&p;
  for (int i = 0; i < 35; ++i) pin[i] = (const float*)d_in[i];
  p.out = (float*)d_out;
  char* w = (char*)d_ws;
  size_t off = 0;
  auto take = [&](size_t bytes) { char* r = w + off; off += (bytes + 255) & ~(size_t)255; return r; };
  p.Wt_att = (bf16_t*)take((size_t)2 * ATT_N * 1024 * 2);
  p.Wt_rec = (bf16_t*)take((size_t)2 * REC_NP * 1024 * 2);
  p.Wt_out = (bf16_t*)take((size_t)4 * 1024 * 1024 * 2);
  p.Wt13 = (bf16_t*)take((size_t)4 * 65 * 512 * 1024 * 2);
  p.Wt2 = (bf16_t*)take((size_t)4 * 65 * 1024 * 256 * 2);
  p.X = (float*)take((size_t)NT * DM * 4);
  p.AB = (bf16_t*)take((size_t)NT * DM * 2);
  p.MOD = (float*)take((size_t)5 * 9 * 6144 * 4);
  p.MODP = (float*)take((size_t)8 * 4 * 9 * 6144 * 4);
  p.GP = (float*)take((size_t)NT * 16 * 4);
  p.msc = (float*)take((size_t)3 * NMT * 4);
  p.lgate = (float*)take((size_t)64 * NT * 4);
  p.ltok = (int*)take((size_t)64 * NT * 4);
  p.tsl = (int*)take((size_t)NT * 6 * 4);
  p.cnt = (int*)take(512);
  p.bar = (unsigned*)take((size_t)XCD_BAR_WORDS * 4);
  char* region = take(0);
  const size_t szP = (size_t)NT * LDP * 2, szRW = (size_t)NT * RWS * 2, szMS = (size_t)NMT * 16384 * 2,
               szMSn = (size_t)NMT * 128 * 4;
  const size_t szT = (size_t)NT * DM * 4, szOUT2 = (size_t)NSLOT * 1024 * 2;
  p.P = (bf16_t*)region;
  p.RW = (bf16_t*)(region + szP);
  p.MS = (bf16_t*)(region + szP + szRW);
  p.MSn = (float*)(region + szP + szRW + szMS);
  p.Tb = (float*)region;
  p.ACT = (bf16_t*)region;
  p.OUT2 = (bf16_t*)(region + szT);
  size_t mixer = szP + szRW + szMS + szMSn, moe = szT + szOUT2;
  off += (mixer > moe ? mixer : moe);
  if (off > ws_size) { fprintf(stderr, "workspace too small: need %zu have %zu\n", off, ws_size); return; }
  p.ph_lo = 0;
  p.ph_hi = NPHASE;
  (void)hipMemsetAsync(p.bar, 0, (size_t)XCD_BAR_WORDS * 4, stream);
  void* args[] = {&p};
  hipError_t e = hipLaunchCooperativeKernel((void*)mega_kernel, dim3(grid_blocks), dim3(NTHR), args, SMEM_BYTES, stream);
  if (e != hipSuccess) fprintf(stderr, "cooperative launch failed: %s (grid %d)\n", hipGetErrorString(e), grid_blocks);
}
```

```cpp
#include <hip/hip_runtime.h>
#include <hip/hip_cooperative_groups.h>
#include <cstdio>
#include <cstring>
namespace cg = cooperative_groups;

constexpr int DM = 1024;
constexpr int NBATCH = 8;
constexpr int SEQ = 2048;
constexpr int CTXL = 256;
constexpr int NL = NBATCH * SEQ;
constexpr int NC = NBATCH * CTXL;
constexpr int NT = NL + NC;
constexpr int TSC = CTXL + SEQ;
constexpr int LDP = 4112;
constexpr int ATT_N = 2304;
constexpr int REC_N = 4112;
constexpr int REC_NP = 4224;
constexpr int NCHUNK = 36;
constexpr int NMT = 64 * NCHUNK;
constexpr int RWS = 5632;
constexpr int NSLOT = 137216;
constexpr float DN_ALPHA = 1.6817928305074290f;
constexpr int NTHR = 256;
constexpr int SMEM_BYTES = 65536 + 4096;
constexpr int META_OFF = 65536;

typedef unsigned short bf16_t;
using bf16x8 = __attribute__((ext_vector_type(8))) short;
using f32x16 = __attribute__((ext_vector_type(16))) float;
using u32x4 = __attribute__((ext_vector_type(4))) unsigned;
using u32x2 = __attribute__((ext_vector_type(2))) unsigned;

struct Params {
  const float *x, *c, *ctx, *c_ctx, *ada_w, *ada_b, *ln_g, *ln_b, *mix_w_out, *att_w_in, *na_rpb, *qk_gain,
      *rec_w_in, *rwkv_mu, *rwkv_w0, *rwkv_w1, *rwkv_w2, *rwkv_a0, *rwkv_a1, *rwkv_a2, *rwkv_g1, *rwkv_g2,
      *rwkv_kvec, *rwkv_rk, *rwkv_gn, *mlstm_gate_b, *mlstm_norm, *moe_router, *moe_bias, *moe_w1, *moe_w3,
      *moe_w2, *shared_w1, *shared_w3, *shared_w2;
  float* out;
  bf16_t *Wt_att, *Wt_rec, *Wt_out, *Wt13, *Wt2, *Wl1, *Wl2;
  bf16_t *Zb, *L1;
  float *X, *MOD, *MODP, *GP, *msc, *lgate, *MSn, *Tb, *ROPE;
  bf16_t *AB, *P, *RW, *MS, *ACT, *OUT2;
  int *cnt, *ltok, *tsl;
  unsigned* bar;
  int ph_lo, ph_hi;
};

typedef const Params __attribute__((address_space(4))) * KP;

__device__ __forceinline__ int modrow(int t) { return t < NL ? (t >> 11) : 8; }
__device__ __forceinline__ float silu_f(float x) { return x / (1.f + expf(-x)); }
__device__ __forceinline__ float sigm_f(float x) { return 1.f / (1.f + expf(-x)); }
__device__ __forceinline__ float softplus_f(float x) { return fmaxf(x, 0.f) + log1pf(expf(-fabsf(x))); }
__device__ __forceinline__ float wsum(float v) {
#pragma unroll
  for (int o = 32; o; o >>= 1) v += __shfl_xor(v, o);
  return v;
}
__device__ __forceinline__ float wmax(float v) {
#pragma unroll
  for (int o = 32; o; o >>= 1) v = fmaxf(v, __shfl_xor(v, o));
  return v;
}
__device__ __forceinline__ float rdlane(float v, int l) {
  return __int_as_float(__builtin_amdgcn_readlane(__float_as_int(v), l));
}
__device__ __forceinline__ int opaque_tid() {
  int t = threadIdx.x;
  asm volatile("" : "+v"(t));
  return t;
}
typedef __bf16 bf16x2_t __attribute__((ext_vector_type(2)));
typedef float f32x2_t __attribute__((ext_vector_type(2)));
__device__ __forceinline__ unsigned pk_bf16(float lo, float hi) {
  const f32x2_t v = {lo, hi};
  return __builtin_bit_cast(unsigned, __builtin_convertvector(v, bf16x2_t));
}
__device__ __forceinline__ bf16_t f2bf(float x) { return (bf16_t)(pk_bf16(x, 0.f) & 0xffffu); }
__device__ __forceinline__ float bf2f(bf16_t v) { return __uint_as_float((unsigned)v << 16); }
__device__ __forceinline__ float bflo(unsigned u) { return __uint_as_float(u << 16); }
__device__ __forceinline__ float bfhi(unsigned u) { return __uint_as_float(u & 0xffff0000u); }
__device__ __forceinline__ int scan_row(int dir, int b, int tau) {
  if (tau < CTXL) return NL + b * CTXL + (dir ? (CTXL - 1 - tau) : tau);
  int s = tau - CTXL;
  return b * SEQ + (dir ? (SEQ - 1 - s) : s);
}

template <class RowPtrA>
__device__ __forceinline__ void gemm128_main(int tid, RowPtrA rowA, const bf16_t* __restrict__ Bt, int K, int n0,
                                             char* lds, f32x16 (&acc)[2][2]) {
  const int lane = tid & 63, w = tid >> 6;
  const int wm = w >> 1, wn = w & 1, r = lane & 31, h = lane >> 5;
  const int c = tid & 7, sr = tid >> 3;
  const int sc = (c ^ ((tid >> 4) & 7)) * 16;
  const bf16_t* ap[4];
#pragma unroll
  for (int i = 0; i < 4; ++i) ap[i] = rowA(sr + 32 * i) + c * 8;
  const bf16_t* bp0 = Bt + (size_t)(n0 + sr) * K + c * 8;
  const int bstr = 32 * K;
  u32x4 ra[4], rb[4];
#pragma unroll
  for (int mi = 0; mi < 2; ++mi)
#pragma unroll
    for (int ni = 0; ni < 2; ++ni)
#pragma unroll
      for (int q = 0; q < 16; ++q) acc[mi][ni][q] = 0.f;
  const int nk = K >> 6;
#pragma unroll
  for (int i = 0; i < 4; ++i) { ra[i] = *(const u32x4*)(ap[i]); rb[i] = *(const u32x4*)(bp0 + i * bstr); }
  const int sw = (r >> 1) & 7;
#pragma unroll 1
  for (int kt = 0; kt < nk; ++kt) {
    char* As = lds + (kt & 1) * 32768;
    char* Bs = As + 16384;
#pragma unroll
    for (int i = 0; i < 4; ++i) {
      *(u32x4*)(As + (sr + 32 * i) * 128 + sc) = ra[i];
      *(u32x4*)(Bs + (sr + 32 * i) * 128 + sc) = rb[i];
    }
    __syncthreads();
    if (kt + 1 < nk) {
      const int k0 = (kt + 1) * 64;
#pragma unroll
      for (int i = 0; i < 4; ++i) { ra[i] = *(const u32x4*)(ap[i] + k0); rb[i] = *(const u32x4*)(bp0 + i * bstr + k0); }
    }
    const char* Ar = As + (wm * 64 + r) * 128;
    const char* Br = Bs + (wn * 64 + r) * 128;
#pragma unroll
    for (int ks = 0; ks < 4; ++ks) {
      const int off = ((ks * 2 + h) ^ sw) * 16;
      const bf16x8 a0 = *(const bf16x8*)(Ar + off);
      const bf16x8 a1 = *(const bf16x8*)(Ar + 32 * 128 + off);
      const bf16x8 b0 = *(const bf16x8*)(Br + off);
      const bf16x8 b1 = *(const bf16x8*)(Br + 32 * 128 + off);
      acc[0][0] = __builtin_amdgcn_mfma_f32_32x32x16_bf16(a0, b0, acc[0][0], 0, 0, 0);
      acc[0][1] = __builtin_amdgcn_mfma_f32_32x32x16_bf16(a0, b1, acc[0][1], 0, 0, 0);
      acc[1][0] = __builtin_amdgcn_mfma_f32_32x32x16_bf16(a1, b0, acc[1][0], 0, 0, 0);
      acc[1][1] = __builtin_amdgcn_mfma_f32_32x32x16_bf16(a1, b1, acc[1][1], 0, 0, 0);
    }
  }
  __syncthreads();
}
template <class F>
__device__ __forceinline__ void acc_foreach(int tid, const f32x16 (&acc)[2][2], F f) {
  const int lane = tid & 63, w = tid >> 6;
  const int wm = w >> 1, wn = w & 1, r = lane & 31, h = lane >> 5;
#pragma unroll
  for (int mi = 0; mi < 2; ++mi)
#pragma unroll
    for (int ni = 0; ni < 2; ++ni)
#pragma unroll
      for (int q = 0; q < 16; ++q) {
        const int row = wm * 64 + mi * 32 + (q & 3) + 8 * (q >> 2) + 4 * h;
        const int col = wn * 64 + ni * 32 + r;
        f(row, col, acc[mi][ni][q]);
        if ((q & 3) == 3) __builtin_amdgcn_sched_barrier(0);
      }
}

template <class RM>
__device__ __forceinline__ void tr_tile(int tid, const float* __restrict__ src, int N, int k0, int n0,
                                        bf16_t* __restrict__ dst, int K, RM rowmap, float* tile) {
  {
    const int tx = tid & 15, ty = tid >> 4;
    const int n = n0 + tx * 4;
#pragma unroll
    for (int i = 0; i < 4; ++i) {
      const int k = ty + 16 * i;
      float4 v = make_float4(0.f, 0.f, 0.f, 0.f);
      if (n < N) v = *(const float4*)(src + (size_t)(k0 + k) * N + n);
      tile[k * 65 + tx * 4 + 0] = v.x; tile[k * 65 + tx * 4 + 1] = v.y;
      tile[k * 65 + tx * 4 + 2] = v.z; tile[k * 65 + tx * 4 + 3] = v.w;
    }
  }
  __syncthreads();
  {
    const int kc = tid & 7;
#pragma unroll
    for (int i = 0; i < 2; ++i) {
      const int n = (tid >> 3) + 32 * i;
      if (n0 + n < N) {
        float v[8];
#pragma unroll
        for (int q = 0; q < 8; ++q) v[q] = tile[(kc * 8 + q) * 65 + n];
        u32x4 o;
        o.x = pk_bf16(v[0], v[1]); o.y = pk_bf16(v[2], v[3]); o.z = pk_bf16(v[4], v[5]); o.w = pk_bf16(v[6], v[7]);
        *(u32x4*)(dst + (size_t)rowmap(n0 + n) * K + k0 + kc * 8) = o;
      }
    }
  }
  __syncthreads();
}

__device__ void ph_init(KP p, char* smc) {
  float* sm = (float*)smc;
  const int tid = opaque_tid();
  {
    const size_t n4a = (size_t)NL * DM / 4, n4b = (size_t)NC * DM / 4;
    const float4* xs = (const float4*)p->x;
    const float4* cs = (const float4*)p->ctx;
    float4* X4 = (float4*)p->X;
    for (size_t i = (size_t)blockIdx.x * NTHR + tid; i < n4a + n4b; i += (size_t)gridDim.x * NTHR)
      X4[i] = i < n4a ? xs[i] : cs[i - n4a];
  }
  for (int tile = blockIdx.x; tile < 96 * 8; tile += gridDim.x) {
    const int ct = tile >> 3, ks = tile & 7;
    for (int i = tid; i < 9 * 128; i += NTHR) {
      const int r = i >> 7, k = ks * 128 + (i & 127);
      const float v = r < 8 ? p->c[r * 1024 + k] : p->c_ctx[k];
      sm[i] = silu_f(v);
    }
    __syncthreads();
    const int col = ct * 256 + tid;
    const int layer = col / 6144, n = col % 6144;
    const float* W = p->ada_w + ((size_t)layer * 1024 + ks * 128) * 6144 + n;
    float acc[9];
#pragma unroll
    for (int r = 0; r < 9; ++r) acc[r] = 0.f;
#pragma unroll 4
    for (int k = 0; k < 128; ++k) {
      const float w = W[(size_t)k * 6144];
#pragma unroll
      for (int r = 0; r < 9; ++r) acc[r] = fmaf(sm[r * 128 + k], w, acc[r]);
    }
#pragma unroll
    for (int r = 0; r < 9; ++r) p->MODP[((size_t)(ks * 4 + layer) * 9 + r) * 6144 + n] = acc[r];
    __syncthreads();
  }
  constexpr int T0 = 1152, T1 = T0 + 2080, T2 = T1 + 1024, T3 = T2 + 33280, T4 = T3 + 16640;
  for (int job = blockIdx.x; job < T4; job += gridDim.x) {
    if (job < T0) {
      const int j = job / 576, rem = job % 576, kt = rem / 36, nt = rem % 36;
      tr_tile(tid, p->att_w_in + (size_t)j * 1024 * ATT_N, ATT_N, kt * 64, nt * 64, p->Wt_att + (size_t)j * ATT_N * 1024,
              1024, [](int n) { return n; }, sm);
    } else if (job < T1) {
      const int q = job - T0;
      const int j = q / 1040, rem = q % 1040, kt = rem / 65, nt = rem % 65;
      tr_tile(tid, p->rec_w_in + (size_t)j * 1024 * REC_N, REC_N, kt * 64, nt * 64, p->Wt_rec + (size_t)j * REC_NP * 1024,
              1024, [](int n) { return n; }, sm);
    } else if (job < T2) {
      const int q = job - T1;
      const int i = q >> 8, rem = q & 255, kt = rem >> 4, nt = rem & 15;
      tr_tile(tid, p->mix_w_out + (size_t)i * 1024 * 1024, 1024, kt * 64, nt * 64, p->Wt_out + (size_t)i * 1024 * 1024,
              1024, [](int n) { return n; }, sm);
    } else if (job < T3) {
      const int q = job - T2;
      const int le = q >> 7, rem = q & 127;
      const int which = rem >> 6, kt = (rem >> 2) & 15, nt = rem & 3;
      const int layer = le / 65, e = le % 65;
      const float* src;
      if (e < 64) src = (which ? p->moe_w3 : p->moe_w1) + (size_t)(layer * 64 + e) * 1024 * 256;
      else src = (which ? p->shared_w3 : p->shared_w1) + (size_t)layer * 1024 * 256;
      tr_tile(tid, src, 256, kt * 64, nt * 64, p->Wt13 + (size_t)le * 512 * 1024, 1024,
              [which](int n) { return 64 * (n >> 5) + which * 32 + (n & 31); }, sm);
    } else {
      const int q = job - T3;
      const int le = q >> 6, rem = q & 63;
      const int kt = rem >> 4, nt = rem & 15;
      const int layer = le / 65, e = le % 65;
      const float* src = e < 64 ? p->moe_w2 + (size_t)(layer * 64 + e) * 256 * 1024 : p->shared_w2 + (size_t)layer * 256 * 1024;
      tr_tile(tid, src, 1024, kt * 64, nt * 64, p->Wt2 + (size_t)le * 1024 * 256, 256, [](int n) { return n; }, sm);
    }
  }
  for (int i = blockIdx.x * NTHR + tid; i < 2 * 3 * 128 * 512; i += gridDim.x * NTHR) {
    const int k = i & 511, n = (i >> 9) & 127, wj = i >> 16;
    const int j = wj / 3, which = wj % 3;
    float v = 0.f;
    if (which < 2) {
      if (n < 64) v = (which ? p->rwkv_a1 : p->rwkv_w1)[((size_t)(j * 2 + (n >> 5)) * 512 + k) * 32 + (n & 31)];
    } else if (n < 96) v = p->rwkv_g1[((size_t)j * 512 + k) * 96 + n];
    p->Wl1[i] = f2bf(v);
  }
  for (int i = blockIdx.x * NTHR + tid; i < 2 * 2560 * 128; i += gridDim.x * NTHR) {
    const int k = i & 127, n = (i >> 7) % 2560, j = i / (2560 * 128);
    float v = 0.f;
    if (n < 2048) {
      const int d = (n >> 9) & 1, c = n & 511;
      if (k < 64 && (k >> 5) == d) v = (n < 1024 ? p->rwkv_w2 : p->rwkv_a2)[((size_t)(j * 2 + d) * 32 + (k & 31)) * 512 + c];
    } else if (k < 96) v = p->rwkv_g2[((size_t)j * 96 + k) * 512 + (n - 2048)];
    p->Wl2[i] = f2bf(v);
  }
  for (int i = blockIdx.x * NTHR + tid; i < 64 * 16; i += gridDim.x * NTHR) {
    const int pos = i >> 4, f = i & 15;
    const float ang = (float)pos * powf(10000.f, -(float)f / 16.f);
    p->ROPE[2 * i] = cosf(ang);
    p->ROPE[2 * i + 1] = sinf(ang);
  }
}

__device__ void ph_mod_h(KP p, char* smc) {
  float* sm = (float*)smc;
  const int tid = opaque_tid();
  for (int i = blockIdx.x * NTHR + tid; i < 4 * 9 * 6144; i += gridDim.x * NTHR) {
    const int layer = i / (9 * 6144), rem = i % (9 * 6144), n = rem % 6144;
    float s = p->ada_b[layer * 6144 + n];
#pragma unroll
    for (int ks = 0; ks < 8; ++ks) s += p->MODP[(size_t)(ks * 4 + layer) * 9 * 6144 + rem];
    p->MOD[i] = s;
  }
  const int lane = tid & 63, wave = tid >> 6;
  const int per = (((NT + gridDim.x - 1) / gridDim.x) + 3) & ~3;
  const int t0 = blockIdx.x * per, t1 = min(NT, t0 + per);
  int cur = -1;
  for (int tb = t0; tb < t1; tb += 4) {
    const int mr = modrow(tb);
    if (mr != cur) {
      __syncthreads();
      for (int n = tid; n < 2048; n += NTHR) {
        float a = p->ada_b[n];
#pragma unroll
        for (int ks = 0; ks < 8; ++ks) a += p->MODP[((size_t)(ks * 4) * 9 + mr) * 6144 + n];
        sm[n] = a;
      }
      cur = mr;
      __syncthreads();
    }
    const int t = tb + wave;
    if (t < t1) {
      const float* src = t < NL ? p->x + (size_t)t * DM : p->ctx + (size_t)(t - NL) * DM;
#pragma unroll
      for (int i = 0; i < 4; ++i) {
        const int n = i * 256 + lane * 4;
        const float4 xv = *(const float4*)(src + n);
        const float4 sh = *(const float4*)(sm + n);
        const float4 sc = *(const float4*)(sm + 1024 + n);
        u32x2 o;
        o.x = pk_bf16(xv.x * (1.f + sc.x) + sh.x, xv.y * (1.f + sc.y) + sh.y);
        o.y = pk_bf16(xv.z * (1.f + sc.z) + sh.z, xv.w * (1.f + sc.w) + sh.w);
        *(u32x2*)(p->AB + (size_t)t * DM + n) = o;
      }
    }
  }
}

typedef short v4i16_t __attribute__((ext_vector_type(4)));
using s16x4 = __attribute__((ext_vector_type(4))) short;
__device__ __forceinline__ s16x4 vtr(const char* p) {
  return __builtin_bit_cast(s16x4, __builtin_amdgcn_ds_read_tr16_b64_v4i16((__attribute__((address_space(3))) v4i16_t*)p));
}
#define MFMA32(a, b, c) __builtin_amdgcn_mfma_f32_32x32x16_bf16(a, b, c, 0, 0, 0)
__device__ void ph_attention(KP p, int layer, bool keep, char* lds) {
  const int tid = opaque_tid();
  const int lane = tid & 63, w = tid >> 6, r32 = lane & 31, hi = lane >> 5;
  const int j = layer >> 1;
  float* bias_lds = (float*)(lds + 32768 + 1024);
  const int n_gqa = 1024, n_na = 1024, n_cb = keep ? 128 : 0, n_ca = keep ? 128 : 0;
  const int total = n_gqa + n_na + n_cb + n_ca;
  constexpr float LOG2E = 1.4426950408889634f;
  constexpr float C2 = 0.125f * LOG2E;
  const int c = tid & 7, sr = tid >> 3;
  const int kso = (c ^ ((tid >> 4) & 7)) * 16;
  const int vso = (c >> 2) * 4096 + (c & 3) * 16;
  const int sw = (r32 >> 1) & 7;
  for (int item = blockIdx.x; item < total; item += gridDim.x) {
    int b, qrow0, qoff, koff, voff, ocol, lat_tiles, lat_row0;
    bool na = false;
    int r_w = 0, start_w = 0, ru0 = 0, hN = 0;
    if (item < n_gqa) {
      b = item >> 7;
      const int g = (item >> 6) & 1, tt = item & 63;
      qrow0 = b * SEQ + tt * 32; qoff = 1536 + (g * 4 + w) * 64; koff = 2048 + g * 64; voff = 2176 + g * 64;
      ocol = 512 + (g * 4 + w) * 64; lat_tiles = 32; lat_row0 = b * SEQ;
    } else if (item < n_gqa + n_na) {
      const int it = item - n_gqa;
      b = it >> 7; hN = (it >> 4) & 7;
      const int rp = it & 15;
      na = true; r_w = 2 * rp + (w >> 1);
      qrow0 = b * SEQ + r_w * 64 + (w & 1) * 32; qoff = hN * 64; koff = 512 + hN * 64; voff = 1024 + hN * 64; ocol = hN * 64;
      const int s0 = min(max(2 * rp - 4, 0), 24), s1 = min(max(2 * rp - 3, 0), 24);
      start_w = (w >> 1) ? s1 : s0; ru0 = s0; lat_tiles = (s1 != s0) ? 9 : 8; lat_row0 = b * SEQ + ru0 * 64;
    } else if (item < n_gqa + n_na + n_cb) {
      const int it = item - n_gqa - n_na;
      b = it >> 4;
      const int g = (it >> 3) & 1, tt = it & 7;
      qrow0 = NL + b * CTXL + tt * 32; qoff = 1536 + (g * 4 + w) * 64; koff = 2048 + g * 64; voff = 2176 + g * 64;
      ocol = 512 + (g * 4 + w) * 64; lat_tiles = 0; lat_row0 = 0;
    } else {
      const int it = item - n_gqa - n_na - n_cb;
      b = it >> 4;
      const int h = (it >> 1) & 7, half = it & 1;
      qrow0 = NL + b * CTXL + half * 128 + w * 32; qoff = h * 64; koff = 512 + h * 64; voff = 1024 + h * 64; ocol = h * 64;
      lat_tiles = 0; lat_row0 = 0;
    }
    const int ctx_row0 = NL + b * CTXL, ntiles = lat_tiles + 4;
    if (na)
      for (int i = tid; i < 465; i += NTHR) bias_lds[i] = p->na_rpb[(j * 8 + hN) * 465 + i] * LOG2E;
    bf16x8 qf[4];
    {
      const bf16_t* qp = p->P + (size_t)(qrow0 + r32) * LDP + qoff + hi * 8;
#pragma unroll
      for (int d0 = 0; d0 < 4; ++d0) qf[d0] = *(const bf16x8*)(qp + d0 * 16);
    }
    f32x16 o0, o1;
#pragma unroll
    for (int q = 0; q < 16; ++q) { o0[q] = 0.f; o1[q] = 0.f; }
    float m = -INFINITY, l = 0.f;
    u32x4 kr0, kr1, vr0, vr1;
    auto gload = [&](int t) {
      const int row0 = t < lat_tiles ? lat_row0 + 64 * t : ctx_row0 + 64 * (t - lat_tiles);
      const bf16_t* base = p->P + (size_t)(row0 + sr) * LDP + c * 8;
      kr0 = *(const u32x4*)(base + koff); kr1 = *(const u32x4*)(base + (size_t)32 * LDP + koff);
      vr0 = *(const u32x4*)(base + voff); vr1 = *(const u32x4*)(base + (size_t)32 * LDP + voff);
    };
    auto swrite = [&](int buf) {
      char* Kb = lds + buf * 16384;
      char* Vb = Kb + 8192;
      *(u32x4*)(Kb + sr * 128 + kso) = kr0; *(u32x4*)(Kb + (sr + 32) * 128 + kso) = kr1;
      *(u32x4*)(Vb + vso + sr * 64) = vr0; *(u32x4*)(Vb + vso + (sr + 32) * 64) = vr1;
    };
    gload(0);
    swrite(0);
    for (int t = 0; t < ntiles; ++t) {
      __syncthreads();
      if (t + 1 < ntiles) gload(t + 1);
      const bool na_tile = na && t < lat_tiles;
      const int kr = ru0 + t;
      const bool part = !na_tile || (kr >= start_w && kr < start_w + 8);
      if (part) {
        const char* Ks = lds + (t & 1) * 16384;
        const char* Vs = Ks + 8192;
        f32x16 s0, s1;
#pragma unroll
        for (int q = 0; q < 16; ++q) { s0[q] = 0.f; s1[q] = 0.f; }
#pragma unroll
        for (int d0 = 0; d0 < 4; ++d0) {
          const int off = ((2 * d0 + hi) ^ sw) * 16;
          const bf16x8 k0 = *(const bf16x8*)(Ks + r32 * 128 + off);
          const bf16x8 k1 = *(const bf16x8*)(Ks + (32 + r32) * 128 + off);
          s0 = MFMA32(k0, qf[d0], s0);
          s1 = MFMA32(k1, qf[d0], s1);
        }
        float mx = -INFINITY;
        if (na_tile) {
          const int cq = (w & 1) * 32 + r32;
          const int c0 = min(max(cq - 8, 0), 48);
          const float* brow = bias_lds + (kr - r_w + 7) * 31 + (15 - cq);
#pragma unroll
          for (int q = 0; q < 16; ++q) {
            const int kc = (q & 3) + 8 * (q >> 2) + 4 * hi;
            const float v0 = ((unsigned)(kc - c0) < 16u) ? fmaf(s0[q], C2, brow[kc]) : -INFINITY;
            const float v1 = ((unsigned)(kc + 32 - c0) < 16u) ? fmaf(s1[q], C2, brow[kc + 32]) : -INFINITY;
            s0[q] = v0; s1[q] = v1;
            mx = fmaxf(mx, fmaxf(v0, v1));
          }
        } else {
#pragma unroll
          for (int q = 0; q < 16; ++q) {
            s0[q] *= C2; s1[q] *= C2;
            mx = fmaxf(mx, fmaxf(s0[q], s1[q]));
          }
        }
        {
          auto rr = __builtin_amdgcn_permlane32_swap(__float_as_uint(mx), __float_as_uint(mx), false, false);
          mx = fmaxf(__uint_as_float(rr[0]), __uint_as_float(rr[1]));
        }
        const float mnew = fmaxf(m, mx);
        const float alpha = __builtin_amdgcn_exp2f(m - mnew);
        float ls = 0.f;
#pragma unroll
        for (int q = 0; q < 16; ++q) {
          s0[q] = __builtin_amdgcn_exp2f(s0[q] - mnew);
          s1[q] = __builtin_amdgcn_exp2f(s1[q] - mnew);
          ls += s0[q] + s1[q];
        }
        l = l * alpha + ls;
        m = mnew;
#pragma unroll
        for (int q = 0; q < 16; ++q) { o0[q] *= alpha; o1[q] *= alpha; }
        bf16x8 pf[4];
#pragma unroll
        for (int s = 0; s < 4; ++s) {
          const int u = (s & 1) * 8;
          u32x4 tpk;
          if (s < 2) {
            tpk.x = pk_bf16(s0[u + 0], s0[u + 1]); tpk.y = pk_bf16(s0[u + 2], s0[u + 3]);
            tpk.z = pk_bf16(s0[u + 4], s0[u + 5]); tpk.w = pk_bf16(s0[u + 6], s0[u + 7]);
          } else {
            tpk.x = pk_bf16(s1[u + 0], s1[u + 1]); tpk.y = pk_bf16(s1[u + 2], s1[u + 3]);
            tpk.z = pk_bf16(s1[u + 4], s1[u + 5]); tpk.w = pk_bf16(s1[u + 6], s1[u + 7]);
          }
          pf[s] = __builtin_bit_cast(bf16x8, tpk);
        }
        const char* vb = Vs + ((lane >> 4) & 1) * 32 + (lane & 3) * 8 + ((lane & 15) >> 2) * 64 + hi * 256;
#pragma unroll
        for (int s = 0; s < 4; ++s) {
          const s16x4 a00 = vtr(vb + (16 * s) * 64), a01 = vtr(vb + (16 * s + 8) * 64);
          const s16x4 a10 = vtr(vb + 4096 + (16 * s) * 64), a11 = vtr(vb + 4096 + (16 * s + 8) * 64);
          const bf16x8 A0 = __builtin_shufflevector(a00, a01, 0, 1, 2, 3, 4, 5, 6, 7);
          const bf16x8 A1 = __builtin_shufflevector(a10, a11, 0, 1, 2, 3, 4, 5, 6, 7);
          o0 = MFMA32(A0, pf[s], o0);
          o1 = MFMA32(A1, pf[s], o1);
        }
      }
      if (t + 1 < ntiles) swrite((t + 1) & 1);
    }
    __syncthreads();
    const float lt = l + __shfl_xor(l, 32);
    const float inv = 1.f / lt;
    bf16_t* op = p->AB + (size_t)(qrow0 + r32) * DM + ocol + 4 * hi;
#pragma unroll
    for (int g = 0; g < 4; ++g) {
      u32x2 v0, v1;
      v0.x = pk_bf16(o0[4 * g] * inv, o0[4 * g + 1] * inv); v0.y = pk_bf16(o0[4 * g + 2] * inv, o0[4 * g + 3] * inv);
      v1.x = pk_bf16(o1[4 * g] * inv, o1[4 * g + 1] * inv); v1.y = pk_bf16(o1[4 * g + 2] * inv, o1[4 * g + 3] * inv);
      *(u32x2*)(op + 8 * g) = v0;
      *(u32x2*)(op + 32 + 8 * g) = v1;
    }
  }
}

__device__ void ph_rwkv_mix(KP p, int layer) {
  const int j = layer >> 1;
  const int tid = opaque_tid();
  const int lane = tid & 63, wave = tid >> 6;
  const float* mu = p->rwkv_mu + j * 6 * 512;
  for (int t = blockIdx.x * 4 + wave; t < NT; t += gridDim.x * 4) {
    bool hasp, hasn;
    if (t < NL) { int s = t & 2047; hasp = s > 0; hasn = s < SEQ - 1; }
    else { int s = (t - NL) & 255; hasp = s > 0; hasn = s < CTXL - 1; }
    const bf16_t* pt = p->P + (size_t)t * LDP;
    bf16_t* rw = p->RW + (size_t)t * RWS;
    bf16_t* zb = p->Zb + (size_t)t * 1536;
#pragma unroll 2
    for (int hh = 0; hh < 8; ++hh) {
      const int c = hh * 64 + lane;
      float cur[4], d[4];
#pragma unroll
      for (int q = 0; q < 4; ++q) {
        cur[q] = bf2f(pt[q * 512 + c]);
        const float pv = hasp ? bf2f(pt[q * 512 + c - LDP]) : 0.f;
        const float nx = hasn ? bf2f(pt[q * 512 + c + LDP]) : 0.f;
        d[q] = 0.5f * (pv + nx) - cur[q];
      }
      const float xr = cur[0] + d[0] * mu[c];
      const float xk = cur[1] + d[1] * mu[512 + c];
      const float xv = cur[2] + d[2] * mu[1024 + c];
      float kkv = xk * p->rwkv_kvec[(j * 2 + 0) * 512 + c];
      const float ss = wsum(kkv * kkv);
      kkv *= rsqrtf(fmaxf(ss, 1e-24f));
      rw[c] = f2bf(xr);
      rw[512 + c] = f2bf(xv);
      rw[2 * 512 + c] = f2bf(kkv);
      rw[10 * 512 + c] = f2bf(xk);
      zb[c] = f2bf(cur[3] + d[3] * mu[3 * 512 + c]);
      zb[512 + c] = f2bf(cur[3] + d[3] * mu[4 * 512 + c]);
      zb[1024 + c] = f2bf(cur[3] + d[3] * mu[5 * 512 + c]);
    }
  }
}

template <int CTRL>
__device__ __forceinline__ float dppx(float x) {
  return __int_as_float(__builtin_amdgcn_update_dpp(0, __float_as_int(x), CTRL, 0xf, 0xf, true));
}
constexpr int RS_STEP = 384;
constexpr int RS_TB = 16;
struct RwkvStage { u32x2 r, kk, e, ke, a, v; };
__device__ void rwkv_unit(KP p, int unit, float* sm, int tid) {
  const int ch = unit >> 1, hf = unit & 1;
  const int dir = ch >> 6, b = (ch >> 3) & 7, h = ch & 7;
  const int lane = tid & 63, w = tid >> 6, rl = lane >> 3, ks = lane & 7;
  float* ybuf = sm + 2 * RS_TB * RS_STEP;
  const int ss = tid >> 4, kq = tid & 15;
  auto gload = [&](int n, RwkvStage& g) {
    const int row = scan_row(dir, b, n * RS_TB + ss);
    const bf16_t* base = p->RW + (size_t)row * RWS + h * 64 + kq * 4;
    g.r = *(const u32x2*)(base);
    g.kk = *(const u32x2*)(base + 2 * 512);
    g.e = *(const u32x2*)(base + (3 + dir) * 512);
    g.ke = *(const u32x2*)(base + (5 + dir) * 512);
    g.a = *(const u32x2*)(base + (7 + dir) * 512);
    g.v = *(const u32x2*)(p->RW + (size_t)row * RWS + 512 + h * 64 + hf * 32 + (kq & 7) * 4);
  };
  auto swrite = [&](int buf, const RwkvStage& g) {
    float* sp = sm + (buf * RS_TB + ss) * RS_STEP;
    const float r0 = bflo(g.r.x), r1 = bfhi(g.r.x), r2 = bflo(g.r.y), r3 = bfhi(g.r.y);
    const float k0 = bflo(g.kk.x), k1 = bfhi(g.kk.x), k2 = bflo(g.kk.y), k3 = bfhi(g.kk.y);
    const float w0 = __expf(-bflo(g.e.x)), w1 = __expf(-bfhi(g.e.x)), w2 = __expf(-bflo(g.e.y)), w3 = __expf(-bfhi(g.e.y));
    const float e0 = bflo(g.ke.x), e1 = bfhi(g.ke.x), e2 = bflo(g.ke.y), e3 = bfhi(g.ke.y);
    const float a0 = k0 * bflo(g.a.x), a1 = k1 * bfhi(g.a.x), a2 = k2 * bflo(g.a.y), a3 = k3 * bfhi(g.a.y);
    *(float4*)(sp + kq * 4) = make_float4(k0, k1, k2, k3);
    *(float4*)(sp + 64 + kq * 4) = make_float4(w0 * r0, w1 * r1, w2 * r2, w3 * r3);
    *(float4*)(sp + 128 + kq * 4) = make_float4(w0, w1, w2, w3);
    *(float4*)(sp + 192 + kq * 4) = make_float4(a0, a1, a2, a3);
    *(float4*)(sp + 256 + kq * 4) = make_float4(e0, e1, e2, e3);
    if (kq < 8) *(float4*)(sp + 320 + kq * 4) = make_float4(bflo(g.v.x), bfhi(g.v.x), bflo(g.v.y), bfhi(g.v.y));
    float c1 = a0 * r0 + a1 * r1 + a2 * r2 + a3 * r3;
    float c2 = e0 * r0 + e1 * r1 + e2 * r2 + e3 * r3;
    c1 += dppx<0xB1>(c1); c2 += dppx<0xB1>(c2);
    c1 += dppx<0x4E>(c1); c2 += dppx<0x4E>(c2);
    c1 += dppx<0x141>(c1); c2 += dppx<0x141>(c2);
    c1 += dppx<0x140>(c1); c2 += dppx<0x140>(c2);
    if (kq == 0) { sp[352] = c1; sp[353] = c2; }
  };
  typedef float f2 __attribute__((ext_vector_type(2)));
  f2 S01 = {0.f, 0.f}, S23 = {0.f, 0.f}, S45 = {0.f, 0.f}, S67 = {0.f, 0.f};
  auto compute = [&](int n) {
    const float* bp = sm + (n & 1) * RS_TB * RS_STEP;
    float* yb = ybuf + (n & 1) * RS_TB * 32 + w * 8 + rl;
    struct Ops { f2 k[4], r[4], w[4], a[4], e[4]; float vv; f2 c; };
    auto ld = [&](int s, Ops& o) {
      const float* sq = bp + s * RS_STEP;
      const f2* sp = (const f2*)(sq + ks * 8);
#pragma unroll
      for (int i = 0; i < 4; ++i) { o.k[i] = sp[i]; o.r[i] = sp[32 + i]; o.w[i] = sp[64 + i]; o.a[i] = sp[96 + i]; o.e[i] = sp[128 + i]; }
      o.vv = sq[320 + w * 8 + rl]; o.c = *(const f2*)(sq + 352);
    };
    auto step = [&](const Ops& o) -> float {
      f2 sa2 = S01 * o.k[0];
      f2 y2 = S01 * o.r[0];
      sa2 = __builtin_elementwise_fma(S23, o.k[1], sa2); y2 = __builtin_elementwise_fma(S23, o.r[1], y2);
      sa2 = __builtin_elementwise_fma(S45, o.k[2], sa2); y2 = __builtin_elementwise_fma(S45, o.r[2], y2);
      sa2 = __builtin_elementwise_fma(S67, o.k[3], sa2); y2 = __builtin_elementwise_fma(S67, o.r[3], y2);
      float sa = sa2.x + sa2.y, y0 = y2.x + y2.y;
      sa += dppx<0xB1>(sa); y0 += dppx<0xB1>(y0);
      sa += dppx<0x4E>(sa); y0 += dppx<0x4E>(y0);
      sa += dppx<0x141>(sa); y0 += dppx<0x141>(y0);
      sa = -sa;
      const f2 sav = {sa, sa}, vvv = {o.vv, o.vv};
      S01 = __builtin_elementwise_fma(vvv, o.e[0], __builtin_elementwise_fma(sav, o.a[0], S01 * o.w[0]));
      S23 = __builtin_elementwise_fma(vvv, o.e[1], __builtin_elementwise_fma(sav, o.a[1], S23 * o.w[1]));
      S45 = __builtin_elementwise_fma(vvv, o.e[2], __builtin_elementwise_fma(sav, o.a[2], S45 * o.w[2]));
      S67 = __builtin_elementwise_fma(vvv, o.e[3], __builtin_elementwise_fma(sav, o.a[3], S67 * o.w[3]));
      return fmaf(o.vv, o.c.y, fmaf(sa, o.c.x, y0));
    };
    Ops oa, ob;
    ld(0, oa);
#pragma unroll 1
    for (int s = 0; s < RS_TB; s += 2) {
      ld(s + 1, ob);
      const float ya = step(oa);
      ld(s + 2, oa);
      const float yb2 = step(ob);
      if (ks == 0) { yb[s * 32] = ya; yb[(s + 1) * 32] = yb2; }
    }
  };
  auto yout = [&](int n) {
    const int row = scan_row(dir, b, n * RS_TB + ss);
    const float* ys = ybuf + (n & 1) * RS_TB * 32 + ss * 32 + kq * 2;
    *(unsigned*)(p->P + (size_t)row * LDP + dir * 512 + h * 64 + hf * 32 + kq * 2) = pk_bf16(ys[0], ys[1]);
  };
  constexpr int NB = TSC / RS_TB;
  RwkvStage gA, gB;
  gload(0, gA);
  gload(1, gB);
  swrite(0, gA);
  gload(2, gA);
  __syncthreads();
  for (int n = 0; n < NB; n += 2) {
    compute(n);
    swrite(1, gB);
    if (n + 3 < NB) gload(n + 3, gB);
    __syncthreads();
    yout(n);
    compute(n + 1);
    if (n + 2 < NB) swrite(0, gA);
    if (n + 4 < NB) gload(n + 4, gA);
    __syncthreads();
    yout(n + 1);
  }
  __syncthreads();
}

__device__ void mlstm_s1(KP p, int layer, int tile, char* lds, int tid) {
  const int j = layer >> 1;
  const int ch = tile / NCHUNK, c = tile % NCHUNK;
  const int dir = ch >> 5, b = (ch >> 2) & 7, h = ch & 3;
  float* s_ws = (float*)(lds + META_OFF);
  int* s_row = (int*)(s_ws + 64);
  char* kimg = lds;
  char* vimg = lds + 16384;
  if (tid < 64) {
    const int row = scan_row(dir, b, c * 64 + tid);
    s_row[tid] = row;
    const float* g = p->GP + (size_t)row * 16;
    const float gi = g[(dir * 2) * 4 + h] + p->mlstm_gate_b[j * 16 + (dir * 2) * 4 + h];
    const float gf = g[(dir * 2 + 1) * 4 + h] + p->mlstm_gate_b[j * 16 + (dir * 2 + 1) * 4 + h];
    float bc = -softplus_f(-gf);
#pragma unroll
    for (int o = 1; o < 64; o <<= 1) {
      float tmp = __shfl_up(bc, o);
      if (tid >= o) bc += tmp;
    }
    const float bend = __shfl(bc, 63);
    const float ds = bend - bc + gi;
    const float mloc = wmax(ds);
    s_ws[tid] = expf(ds - mloc);
    if (tid == 0) { p->msc[tile] = mloc; p->msc[NMT + tile] = bend; }
  }
  __syncthreads();
  {
    const int c8 = tid & 15;
    const int ioff = (c8 >> 2) * 4096 + (c8 & 3) * 16;
#pragma unroll
    for (int i = 0; i < 4; ++i) {
      const int sidx = (tid >> 4) + 16 * i;
      const bf16_t* src = p->P + (size_t)s_row[sidx] * LDP + h * 128 + c8 * 8;
      const u32x4 kv = *(const u32x4*)(src + 2560);
      u32x4 vv = *(const u32x4*)(src + 3072);
      const float wsv = s_ws[sidx];
      vv.x = pk_bf16(bflo(vv.x) * wsv, bfhi(vv.x) * wsv); vv.y = pk_bf16(bflo(vv.y) * wsv, bfhi(vv.y) * wsv);
      vv.z = pk_bf16(bflo(vv.z) * wsv, bfhi(vv.z) * wsv); vv.w = pk_bf16(bflo(vv.w) * wsv, bfhi(vv.w) * wsv);
      *(u32x4*)(kimg + ioff + sidx * 64) = kv;
      *(u32x4*)(vimg + ioff + sidx * 64) = vv;
    }
  }
  __syncthreads();
  const int lane = tid & 63, w = tid >> 6, wm = w >> 1, wn = w & 1, r32 = lane & 31, hi = lane >> 5;
  f32x16 acc[2][2];
#pragma unroll
  for (int mi = 0; mi < 2; ++mi)
#pragma unroll
    for (int ni = 0; ni < 2; ++ni)
#pragma unroll
      for (int q = 0; q < 16; ++q) acc[mi][ni][q] = 0.f;
  const int toff = ((lane >> 4) & 1) * 32 + (lane & 3) * 8 + ((lane & 15) >> 2) * 64 + hi * 256;
#pragma unroll
  for (int ks = 0; ks < 4; ++ks) {
    bf16x8 af[2], bfr[2];
#pragma unroll
    for (int i = 0; i < 2; ++i) {
      const char* ka = kimg + (wm * 2 + i) * 4096 + toff + (16 * ks) * 64;
      const char* va = vimg + (wn * 2 + i) * 4096 + toff + (16 * ks) * 64;
      af[i] = __builtin_shufflevector(vtr(ka), vtr(ka + 8 * 64), 0, 1, 2, 3, 4, 5, 6, 7);
      bfr[i] = __builtin_shufflevector(vtr(va), vtr(va + 8 * 64), 0, 1, 2, 3, 4, 5, 6, 7);
    }
    acc[0][0] = MFMA32(af[0], bfr[0], acc[0][0]);
    acc[0][1] = MFMA32(af[0], bfr[1], acc[0][1]);
    acc[1][0] = MFMA32(af[1], bfr[0], acc[1][0]);
    acc[1][1] = MFMA32(af[1], bfr[1], acc[1][1]);
  }
  bf16_t* U = p->MS + (size_t)tile * 16384;
#pragma unroll
  for (int mi = 0; mi < 2; ++mi)
#pragma unroll
    for (int ni = 0; ni < 2; ++ni)
#pragma unroll
      for (int q = 0; q < 16; ++q) {
        const int d = wm * 64 + mi * 32 + (q & 3) + 8 * (q >> 2) + 4 * hi;
        U[d * 128 + wn * 64 + ni * 32 + r32] = f2bf(acc[mi][ni][q]);
        if ((q & 3) == 3) __builtin_amdgcn_sched_barrier(0);
      }
  if (tid < 128) {
    const char* kc = kimg + (tid >> 5) * 4096 + (tid & 31) * 2;
    float a = 0.f;
#pragma unroll 8
    for (int sidx = 0; sidx < 64; ++sidx) a = fmaf(s_ws[sidx], bf2f(*(const bf16_t*)(kc + sidx * 64)), a);
    p->MSn[tile * 128 + tid] = a;
  }
}

__device__ void ph_scan_a(KP p, int layer, char* smc) {
  float* sm = (float*)smc;
  const int tid = opaque_tid();
  for (int u = blockIdx.x; u < 256; u += gridDim.x) rwkv_unit(p, u, sm, tid);
  const int nblk = gridDim.x, bid = blockIdx.x;
  const int start = (bid + nblk - (256 % nblk)) % nblk;
  for (int tile = start; tile < NMT; tile += nblk) { mlstm_s1(p, layer, tile, smc, tid); __syncthreads(); }
}

__device__ void ph_mlstm_s2(KP p, char* smc) {
  float* sw = (float*)smc;
  const int tid = opaque_tid();
  const int nitems = 64 * 33;
  for (int item = blockIdx.x; item < nitems; item += gridDim.x) {
    const int ch = item / 33, seg = item % 33;
    __syncthreads();
    if (tid == 0) {
      float m = 0.f;
      for (int c = 0; c < NCHUNK; ++c) {
        const int tile = ch * NCHUNK + c;
        const float mloc = p->msc[tile], bend = p->msc[NMT + tile];
        const float mn = fmaxf(bend + m, mloc);
        sw[c] = expf(bend + m - mn);
        sw[36 + c] = expf(mloc - mn);
        if (seg == 0) p->msc[2 * NMT + tile] = m;
        m = mn;
      }
    }
    __syncthreads();
    if (seg < 32) {
      unsigned* base = (unsigned*)(p->MS + (size_t)ch * NCHUNK * 16384) + seg * 256 + tid;
      unsigned v[NCHUNK];
#pragma unroll
      for (int c = 0; c < NCHUNK; ++c) v[c] = base[(size_t)c * 8192];
      float C0 = 0.f, C1 = 0.f;
#pragma unroll
      for (int c = 0; c < NCHUNK; ++c) {
        const float t0 = bflo(v[c]), t1 = bfhi(v[c]);
        v[c] = pk_bf16(C0, C1);
        C0 = sw[c] * C0 + sw[36 + c] * t0;
        C1 = sw[c] * C1 + sw[36 + c] * t1;
      }
#pragma unroll
      for (int c = 0; c < NCHUNK; ++c) base[(size_t)c * 8192] = v[c];
    } else if (tid < 128) {
      float* base = p->MSn + (size_t)ch * NCHUNK * 128 + tid;
      float v[NCHUNK];
#pragma unroll
      for (int c = 0; c < NCHUNK; ++c) v[c] = base[c * 128];
      float C = 0.f;
#pragma unroll
      for (int c = 0; c < NCHUNK; ++c) {
        const float t0 = v[c];
        v[c] = C;
        C = sw[c] * C + sw[36 + c] * t0;
      }
#pragma unroll
      for (int c = 0; c < NCHUNK; ++c) base[c * 128] = v[c];
    }
  }
}

__device__ void mlstm_s3(KP p, int layer, int tile, char* lds, int tid) {
  const int j = layer >> 1;
  const int ch = tile / NCHUNK, c = tile % NCHUNK;
  const int dir = ch >> 5, b = (ch >> 2) & 7, h = ch & 3;
  float* s_b = (float*)(lds + META_OFF);
  float* s_ig = s_b + 64;
  float* s_mt = s_b + 128;
  float* s_wi = s_b + 192;
  int* s_row = (int*)(s_b + 256);
  float* s_n = s_b + 320;
  char* kimg = lds;
  char* vimg = lds + 16384;
  char* cimg = lds + 32768;
  const float mprev = p->msc[2 * NMT + tile];
  const float qscale = 0.08838834764831845f;
  if (tid < 64) {
    const int row = scan_row(dir, b, c * 64 + tid);
    s_row[tid] = row;
    const float* g = p->GP + (size_t)row * 16;
    const float gi = g[(dir * 2) * 4 + h] + p->mlstm_gate_b[j * 16 + (dir * 2) * 4 + h];
    const float gf = g[(dir * 2 + 1) * 4 + h] + p->mlstm_gate_b[j * 16 + (dir * 2 + 1) * 4 + h];
    float bc = -softplus_f(-gf);
#pragma unroll
    for (int o = 1; o < 64; o <<= 1) {
      float tmp = __shfl_up(bc, o);
      if (tid >= o) bc += tmp;
    }
    s_b[tid] = bc;
    s_ig[tid] = gi;
  } else if (tid < 192) s_n[tid - 64] = p->MSn[tile * 128 + (tid - 64)];
  __syncthreads();
  if (tid < 64) {
    const float bt = s_b[tid];
    float mt = bt + mprev;
    for (int sx = 0; sx <= tid; ++sx) mt = fmaxf(mt, bt - s_b[sx] + s_ig[sx]);
    s_mt[tid] = mt;
    s_wi[tid] = expf(bt + mprev - mt);
  }
  {
    const int c8 = tid & 15;
    const int ioff = (c8 >> 2) * 4096 + (c8 & 3) * 16;
#pragma unroll
    for (int i = 0; i < 4; ++i) {
      const int sidx = (tid >> 4) + 16 * i;
      const bf16_t* src = p->P + (size_t)s_row[sidx] * LDP + h * 128 + c8 * 8;
      *(u32x4*)(kimg + sidx * 256 + ((c8 ^ (sidx & 15)) * 16)) = *(const u32x4*)(src + 2560);
      *(u32x4*)(vimg + ioff + sidx * 64) = *(const u32x4*)(src + 3072);
    }
    const bf16_t* Cp = p->MS + (size_t)tile * 16384;
    const int coff = (c8 >> 2) * 8192 + (c8 & 3) * 16;
#pragma unroll
    for (int i = 0; i < 8; ++i) {
      const int d = (tid >> 4) + 16 * i;
      *(u32x4*)(cimg + coff + d * 64) = *(const u32x4*)(Cp + d * 128 + c8 * 8);
    }
  }
  const int lane = tid & 63, w = tid >> 6, wt = w >> 1, wv = w & 1, r32 = lane & 31, hi = lane >> 5;
  const int t = wt * 32 + r32;
  bf16x8 qf[8];
  {
    const bf16_t* qp = p->P + (size_t)s_row[t] * LDP + 2048 + h * 128 + hi * 8;
#pragma unroll
    for (int d0 = 0; d0 < 8; ++d0) qf[d0] = *(const bf16x8*)(qp + d0 * 16);
  }
  __syncthreads();
  const int toff = ((lane >> 4) & 1) * 32 + (lane & 3) * 8 + ((lane & 15) >> 2) * 64;
  constexpr float LOG2E_ = 1.4426950408889634f;
  float qn = 0.f;
#pragma unroll
  for (int d0 = 0; d0 < 8; ++d0) {
    const u32x4 qq = __builtin_bit_cast(u32x4, qf[d0]);
    const float* np = s_n + d0 * 16 + hi * 8;
    qn = fmaf(bflo(qq.x), np[0], qn); qn = fmaf(bfhi(qq.x), np[1], qn);
    qn = fmaf(bflo(qq.y), np[2], qn); qn = fmaf(bfhi(qq.y), np[3], qn);
    qn = fmaf(bflo(qq.z), np[4], qn); qn = fmaf(bfhi(qq.z), np[5], qn);
    qn = fmaf(bflo(qq.w), np[6], qn); qn = fmaf(bfhi(qq.w), np[7], qn);
  }
  qn += __shfl_xor(qn, 32);
  const float mtt = s_mt[t], wi = s_wi[t];
  const float ct = (s_b[t] - mtt) * LOG2E_;
  const float wq = wi * qscale;
  bf16x8 pf[4];
  float den = 0.f;
  {
    f32x16 sa0, sa1;
#pragma unroll
    for (int q = 0; q < 16; ++q) { sa0[q] = 0.f; sa1[q] = 0.f; }
#pragma unroll
    for (int d0 = 0; d0 < 8; ++d0) {
      const int chn = 2 * d0 + hi;
      const bf16x8 k0 = *(const bf16x8*)(kimg + r32 * 256 + ((chn ^ (r32 & 15)) * 16));
      sa0 = MFMA32(k0, qf[d0], sa0);
      if (wt) {
        const bf16x8 k1 = *(const bf16x8*)(kimg + (32 + r32) * 256 + ((chn ^ (r32 & 15)) * 16));
        sa1 = MFMA32(k1, qf[d0], sa1);
      }
      __builtin_amdgcn_sched_barrier(0);
    }
#pragma unroll
    for (int q = 0; q < 16; ++q) {
      const int s0 = (q & 3) + 8 * (q >> 2) + 4 * hi;
      const float v0 = (s0 <= t) ? sa0[q] * qscale * __builtin_amdgcn_exp2f(ct + (s_ig[s0] - s_b[s0]) * LOG2E_) : 0.f;
      sa0[q] = v0; den += v0;
      const int s1 = s0 + 32;
      const float v1 = (wt && s1 <= t) ? sa1[q] * qscale * __builtin_amdgcn_exp2f(ct + (s_ig[s1] - s_b[s1]) * LOG2E_) : 0.f;
      sa1[q] = v1; den += v1;
      if ((q & 3) == 3) __builtin_amdgcn_sched_barrier(0);
    }
#pragma unroll
    for (int sx = 0; sx < 4; ++sx) {
      const int u = (sx & 1) * 8;
      u32x4 tpk;
      if (sx < 2) {
        tpk.x = pk_bf16(sa0[u + 0], sa0[u + 1]); tpk.y = pk_bf16(sa0[u + 2], sa0[u + 3]);
        tpk.z = pk_bf16(sa0[u + 4], sa0[u + 5]); tpk.w = pk_bf16(sa0[u + 6], sa0[u + 7]);
      } else {
        tpk.x = pk_bf16(sa1[u + 0], sa1[u + 1]); tpk.y = pk_bf16(sa1[u + 2], sa1[u + 3]);
        tpk.z = pk_bf16(sa1[u + 4], sa1[u + 5]); tpk.w = pk_bf16(sa1[u + 6], sa1[u + 7]);
      }
      pf[sx] = __builtin_bit_cast(bf16x8, tpk);
    }
  }
  den += __shfl_xor(den, 32);
  const float dtot = den + wq * qn;
  const float inv = 1.f / fmaxf(fabsf(dtot), expf(-mtt));
  bf16_t* op = p->P + (size_t)s_row[t] * LDP + 1024 + dir * 512 + h * 128 + wv * 64 + 4 * hi;
#pragma unroll 1
  for (int vp = 0; vp < 2; ++vp) {
    f32x16 o0;
#pragma unroll
    for (int q = 0; q < 16; ++q) o0[q] = 0.f;
    const char* cb = cimg + (wv * 2 + vp) * 8192 + toff + hi * 512;
#pragma unroll
    for (int d0 = 0; d0 < 8; ++d0) {
      const bf16x8 A0 = __builtin_shufflevector(vtr(cb + (16 * d0) * 64), vtr(cb + (16 * d0 + 4) * 64), 0, 1, 2, 3, 4, 5, 6, 7);
      o0 = MFMA32(A0, qf[d0], o0);
    }
#pragma unroll
    for (int q = 0; q < 16; ++q) o0[q] *= wq;
    const char* vb = vimg + (wv * 2 + vp) * 4096 + toff + hi * 256;
#pragma unroll
    for (int sx = 0; sx < 4; ++sx) {
      if (sx < 2 || wt) {
        const bf16x8 A0 = __builtin_shufflevector(vtr(vb + (16 * sx) * 64), vtr(vb + (16 * sx + 8) * 64), 0, 1, 2, 3, 4, 5, 6, 7);
        o0 = MFMA32(A0, pf[sx], o0);
      }
    }
#pragma unroll
    for (int g = 0; g < 4; ++g) {
      u32x2 v0;
      v0.x = pk_bf16(o0[4 * g] * inv, o0[4 * g + 1] * inv); v0.y = pk_bf16(o0[4 * g + 2] * inv, o0[4 * g + 3] * inv);
      *(u32x2*)(op + vp * 32 + 8 * g) = v0;
    }
  }
}

__device__ void ph_mlstm_s3(KP p, int layer, char* smc) {
  const int tid = opaque_tid();
  for (int tile = blockIdx.x; tile < NMT; tile += gridDim.x) { mlstm_s3(p, layer, tile, smc, tid); __syncthreads(); }
}

__device__ void ph_rec_final(KP p, int layer, bool keep) {
  const int tid = opaque_tid();
  const int j = layer >> 1;
  const int lane = tid & 63, wave = tid >> 6;
  const int rows = keep ? NT : NL;
  for (int t = blockIdx.x * 4 + wave; t < rows; t += gridDim.x * 4) {
    const bf16_t* rw = p->RW + (size_t)t * RWS;
    const bf16_t* pt = p->P + (size_t)t * LDP;
    bf16_t* mo = p->AB + (size_t)t * DM;
#pragma unroll 1
    for (int h = 0; h < 8; ++h) {
      const int n = h * 64 + lane;
      const float y = bf2f(pt[n]) + bf2f(pt[512 + n]);
      const float mu = wsum(y) * (1.f / 64.f);
      const float dv = y - mu;
      const float var = wsum(dv * dv) * (1.f / 64.f);
      const float yn = dv * rsqrtf(var + 64e-5f) * p->rwkv_gn[(j * 2 + 0) * 512 + n] + p->rwkv_gn[(j * 2 + 1) * 512 + n];
      const float r = bf2f(rw[n]), v = bf2f(rw[512 + n]);
      const float bs = wsum(r * p->rwkv_rk[j * 512 + n] * (bf2f(rw[5 * 512 + n]) + bf2f(rw[6 * 512 + n])));
      mo[n] = f2bf((yn + bs * v) * bf2f(rw[9 * 512 + n]));
    }
#pragma unroll 1
    for (int h = 0; h < 4; ++h) {
      const int e0 = h * 128 + lane, e1 = e0 + 64;
      const float h0 = bf2f(pt[1024 + e0]) + bf2f(pt[1536 + e0]);
      const float h1 = bf2f(pt[1024 + e1]) + bf2f(pt[1536 + e1]);
      const float ss = wsum(h0 * h0 + h1 * h1) * (1.f / 128.f);
      const float rs = rsqrtf(ss + 1e-6f);
      mo[512 + e0] = f2bf(h0 * rs * p->mlstm_norm[j * 512 + e0] * sigm_f(bf2f(pt[3584 + e0])));
      mo[512 + e1] = f2bf(h1 * rs * p->mlstm_norm[j * 512 + e1] * sigm_f(bf2f(pt[3584 + e1])));
    }
  }
}

using f32x4v = __attribute__((ext_vector_type(4))) float;
__device__ void ph_ln_router(KP p, int layer, bool keep, char* smc) {
  float* h2s = (float*)smc;
  float* lgs = (float*)smc;
  const int tid = opaque_tid();
  const int lane = tid & 63, wave = tid >> 6;
  const int rows = keep ? NT : NL;
  const float* lng = p->ln_g + (layer * 2 + 0) * 1024;
  const float* lnb = p->ln_b + (layer * 2 + 0) * 1024;
  const float* Wr = p->moe_router + (size_t)layer * 1024 * 64;
  for (int tile = blockIdx.x; tile < rows / 16; tile += gridDim.x) {
    const int t0 = tile * 16;
    const float* mod = p->MOD + (layer * 9 + modrow(t0)) * 6144;
#pragma unroll 1
    for (int q = 0; q < 4; ++q) {
      const int tl = wave * 4 + q, t = t0 + tl;
      float v[16];
      float s = 0.f;
#pragma unroll
      for (int i = 0; i < 16; ++i) { v[i] = p->Tb[(size_t)t * DM + i * 64 + lane]; s += v[i]; }
      const float mean = wsum(s) * (1.f / 1024.f);
      float qq = 0.f;
#pragma unroll
      for (int i = 0; i < 16; ++i) { const float d = v[i] - mean; qq += d * d; }
      const float rs = rsqrtf(wsum(qq) * (1.f / 1024.f) + 1e-5f);
#pragma unroll
      for (int i = 0; i < 16; ++i) {
        const int n = i * 64 + lane;
        const float xn = (v[i] - mean) * rs * lng[n] + lnb[n];
        p->X[(size_t)t * DM + n] = xn;
        const float hh = xn * (1.f + mod[4096 + n]) + mod[3072 + n];
        p->AB[(size_t)t * DM + n] = f2bf(hh);
        h2s[tl * 1028 + n] = hh;
      }
    }
    __syncthreads();
    f32x4v acc = {0.f, 0.f, 0.f, 0.f};
    {
      f32x4v a1 = {0.f, 0.f, 0.f, 0.f}, a2 = {0.f, 0.f, 0.f, 0.f}, a3 = {0.f, 0.f, 0.f, 0.f};
      const int i = lane & 15, kk = lane >> 4;
      const float* arow = h2s + i * 1028 + 4 * kk;
      const float* bcol = Wr + (4 * kk) * 64 + 16 * wave + i;
#pragma unroll 4
      for (int q = 0; q < 64; ++q) {
        const float4 a = *(const float4*)(arow + 16 * q);
        const float b0 = bcol[(16 * q + 0) * 64], b1 = bcol[(16 * q + 1) * 64];
        const float b2 = bcol[(16 * q + 2) * 64], b3 = bcol[(16 * q + 3) * 64];
        acc = __builtin_amdgcn_mfma_f32_16x16x4f32(a.x, b0, acc, 0, 0, 0);
        a1 = __builtin_amdgcn_mfma_f32_16x16x4f32(a.y, b1, a1, 0, 0, 0);
        a2 = __builtin_amdgcn_mfma_f32_16x16x4f32(a.z, b2, a2, 0, 0, 0);
        a3 = __builtin_amdgcn_mfma_f32_16x16x4f32(a.w, b3, a3, 0, 0, 0);
      }
      acc = (acc + a1) + (a2 + a3);
    }
    __syncthreads();
#pragma unroll
    for (int r = 0; r < 4; ++r) lgs[((lane >> 4) * 4 + r) * 64 + 16 * wave + (lane & 15)] = acc[r];
    __syncthreads();
#pragma unroll 1
    for (int q = 0; q < 4; ++q) {
      const int tl = wave * 4 + q, t = t0 + tl;
      const float logit = lgs[tl * 64 + lane];
      const float score = sigm_f(logit);
      float sel = score + p->moe_bias[layer * 64 + lane];
      bool chosen = false;
      for (int r = 0; r < 6; ++r) {
        const float mx = wmax(sel);
        const unsigned long long bal = __ballot(sel == mx);
        const int first = __ffsll((long long)bal) - 1;
        if (lane == first) { chosen = true; sel = -INFINITY; }
      }
      const float gsum = wsum(chosen ? score : 0.f);
      const unsigned long long cb = __ballot(chosen);
      if (chosen) {
        const int kidx = __popcll(cb & ((1ull << lane) - 1ull));
        const int pos = atomicAdd(&p->cnt[lane], 1);
        p->ltok[(size_t)lane * NT + pos] = t;
        p->lgate[(size_t)lane * NT + pos] = score / gsum * 2.5f;
        p->tsl[t * 6 + kidx] = (lane << 16) | pos;
      }
    }
    __syncthreads();
  }
}

__device__ __forceinline__ void moe_prefix(KP p, int rows, int* s_pref, int tid) {
  if (tid == 0) {
    int a = 0;
    for (int e = 0; e < 64; ++e) { s_pref[e] = a; a += (p->cnt[e] + 127) >> 7; }
    s_pref[64] = a; a += rows >> 7;
    s_pref[65] = a;
  }
  __syncthreads();
}

__device__ void ph_gemm(KP p, int kind, int layer, bool keep, char* lds) {
  const int tid = opaque_tid();
  const int j = layer >> 1;
  const bool att = !(layer & 1);
  const int rows = keep ? NT : NL;
  int* pref = (int*)(lds + META_OFF);
  int* s_idx = pref + 66;
  float* s_gate = (float*)(s_idx + 128);
  if (kind == 1 && blockIdx.x == 0 && tid < 65) p->cnt[tid] = 0;
  if (kind == 2 || kind == 3) moe_prefix(p, rows, pref, tid);
  int total;
  const int ntn_in = att ? 18 : 33;
  switch (kind) {
    case 0: total = (NT / 128) * ntn_in; break;
    case 1: total = (rows / 128) * 8; break;
    case 2: total = pref[65] * 4; break;
    case 3: total = pref[65] * 8; break;
    case 4: total = (NT / 128) * 3; break;
    default: total = (NT / 128) * 20; break;
  }
  for (int tile = blockIdx.x; tile < total; tile += gridDim.x) {
    const bf16_t* Abase; const bf16_t* Bt;
    int astride, K, n0, m0 = 0, aux = 0, e = 0, mtile = 0;
    switch (kind) {
      case 0: { const int tm = tile / ntn_in, tn = tile % ntn_in; m0 = tm * 128; n0 = tn * 128;
                Abase = p->AB + (size_t)m0 * DM; astride = DM; K = 1024;
                Bt = att ? p->Wt_att + (size_t)j * ATT_N * 1024 : p->Wt_rec + (size_t)j * REC_NP * 1024; } break;
      case 1: { const int tm = tile >> 3, tn = tile & 7; m0 = tm * 128; n0 = tn * 128;
                Abase = p->AB + (size_t)m0 * DM; astride = DM; K = 1024; Bt = p->Wt_out + (size_t)layer * 1024 * 1024; } break;
      case 2: { mtile = tile >> 2; aux = tile & 3; n0 = aux * 128; while (mtile >= pref[e + 1]) ++e;
                Abase = p->AB; astride = DM; K = 1024; Bt = p->Wt13 + (size_t)(layer * 65 + e) * 512 * 1024; } break;
      case 3: { mtile = tile >> 3; aux = tile & 7; n0 = aux * 128; while (mtile >= pref[e + 1]) ++e;
                Abase = p->ACT + (size_t)mtile * 128 * 256; astride = 256; K = 256; Bt = p->Wt2 + (size_t)(layer * 65 + e) * 1024 * 256; } break;
      case 4: { const int tm = tile / 3; aux = tile % 3; m0 = tm * 128; n0 = 0;
                Abase = p->Zb + (size_t)m0 * 1536 + aux * 512; astride = 1536; K = 512; Bt = p->Wl1 + (size_t)(j * 3 + aux) * 128 * 512; } break;
      default: { const int tm = tile / 20; aux = tile % 20; m0 = tm * 128; n0 = aux * 128;
                const int grp = aux < 8 ? 0 : (aux < 16 ? 1 : 2);
                Abase = p->L1 + (size_t)m0 * 384 + grp * 128; astride = 384; K = 128; Bt = p->Wl2 + (size_t)j * 2560 * 128; } break;
    }
    if (tid < 128) {
      int idx = tid; float g = 1.f;
      if (kind == 2 || kind == 3) {
        const int pos = (mtile - pref[e]) * 128 + tid;
        if (kind == 2) {
          idx = 0;
          if (e < 64) { if (pos < p->cnt[e]) idx = p->ltok[(size_t)e * NT + pos]; }
          else idx = pos;
        } else if (e < 64) g = pos < p->cnt[e] ? p->lgate[(size_t)e * NT + pos] : 0.f;
      }
      s_idx[tid] = idx; s_gate[tid] = g;
    }
    __syncthreads();
    {
      f32x16 acc[2][2];
      gemm128_main(tid, [&](int r) { return Abase + (size_t)s_idx[r] * astride; }, Bt, K, n0, lds, acc);
      float* Ct = (float*)lds;
      acc_foreach(tid, acc, [&](int row, int col, float v) { Ct[row * 128 + col] = v; });
    }
    __syncthreads();
    {
      const float* Ct = (const float*)lds;
      const int c4 = (tid & 31) * 4, r0 = tid >> 5;
      const int N_in = att ? ATT_N : REC_N;
      const int d5 = (aux >> 2) & 1, c05 = (aux & 3) * 128;
#pragma unroll 2
      for (int it = 0; it < 16; ++it) {
        const int row = it * 8 + r0;
        const float4 v = *(const float4*)(Ct + row * 128 + c4);
        switch (kind) {
          case 0: {
            const int cn = n0 + c4;
            float4 vq = v;
            if (att && n0 >= 1536 && n0 < 2176) {
              float ss = v.x * v.x + v.y * v.y + v.z * v.z + v.w * v.w;
              ss += dppx<0xB1>(ss); ss += dppx<0x4E>(ss); ss += dppx<0x141>(ss); ss += dppx<0x140>(ss);
              const float rs = rsqrtf(ss * (1.f / 64.f) + 1e-6f);
              const float4 g = *(const float4*)(p->qk_gain + j * 128 + (n0 >= 2048 ? 64 : 0) + (cn & 63));
              vq = make_float4(v.x * rs * g.x, v.y * rs * g.y, v.z * rs * g.z, v.w * rs * g.w);
              const int t = m0 + row;
              if (t < NL) {
                const int sidx = t & 2047, pi0 = (cn & 63) >> 1;
                const int pos = pi0 < 16 ? (sidx >> 6) : (sidx & 63);
                const float4 cs = *(const float4*)(p->ROPE + (pos * 16 + (pi0 & 15)) * 2);
                vq = make_float4(vq.x * cs.x - vq.y * cs.y, vq.x * cs.y + vq.y * cs.x,
                                 vq.z * cs.z - vq.w * cs.w, vq.z * cs.w + vq.w * cs.z);
              }
            }
            if (cn < N_in) {
              u32x2 o; o.x = pk_bf16(vq.x, vq.y); o.y = pk_bf16(vq.z, vq.w);
              *(u32x2*)(p->P + (size_t)(m0 + row) * LDP + cn) = o;
            }
            if (!att && cn >= 4096 && cn < 4112) *(float4*)(p->GP + (size_t)(m0 + row) * 16 + (cn - 4096)) = v;
          } break;
          case 1: {
            const size_t o = (size_t)(m0 + row) * DM + n0 + c4;
            const float4 xv = *(const float4*)(p->X + o);
            const float4 g = *(const float4*)(p->MOD + (layer * 9 + modrow(m0)) * 6144 + 2048 + n0 + c4);
            *(float4*)(p->Tb + o) = make_float4(DN_ALPHA * xv.x + g.x * v.x, DN_ALPHA * xv.y + g.y * v.y,
                                                DN_ALPHA * xv.z + g.z * v.z, DN_ALPHA * xv.w + g.w * v.w);
          } break;
          case 2: {
            if (((c4 >> 5) & 1) == 0) {
              const float4 u = *(const float4*)(Ct + row * 128 + c4 + 32);
              u32x2 o;
              o.x = pk_bf16(silu_f(v.x) * u.x, silu_f(v.y) * u.y);
              o.y = pk_bf16(silu_f(v.z) * u.z, silu_f(v.w) * u.w);
              *(u32x2*)(p->ACT + ((size_t)mtile * 128 + row) * 256 + aux * 64 + (c4 >> 6) * 32 + (c4 & 31)) = o;
            }
          } break;
          case 3: {
            const float g = s_gate[row];
            u32x2 o; o.x = pk_bf16(g * v.x, g * v.y); o.y = pk_bf16(g * v.z, g * v.w);
            *(u32x2*)(p->OUT2 + ((size_t)mtile * 128 + row) * 1024 + n0 + c4) = o;
          } break;
          case 4: {
            float4 o4 = v;
            if (aux == 0) o4 = make_float4(tanhf(v.x), tanhf(v.y), tanhf(v.z), tanhf(v.w));
            else if (aux == 2) o4 = make_float4(sigm_f(v.x), sigm_f(v.y), sigm_f(v.z), sigm_f(v.w));
            u32x2 o; o.x = pk_bf16(o4.x, o4.y); o.y = pk_bf16(o4.z, o4.w);
            *(u32x2*)(p->L1 + (size_t)(m0 + row) * 384 + aux * 128 + c4) = o;
          } break;
          default: {
            bf16_t* rr = p->RW + (size_t)(m0 + row) * RWS + c05 + c4;
            const float vv[4] = {v.x, v.y, v.z, v.w};
            if (aux < 8) {
              const float4 b0 = *(const float4*)(p->rwkv_w0 + (j * 2 + d5) * 512 + c05 + c4);
              const float bb[4] = {b0.x, b0.y, b0.z, b0.w};
              float e4[4];
#pragma unroll
              for (int q = 0; q < 4; ++q) e4[q] = expf(-softplus_f(-(bb[q] + vv[q])) - 0.5f);
              u32x2 o; o.x = pk_bf16(e4[0], e4[1]); o.y = pk_bf16(e4[2], e4[3]);
              *(u32x2*)(rr + (3 + d5) * 512) = o;
            } else if (aux < 16) {
              const float4 b0 = *(const float4*)(p->rwkv_a0 + (j * 2 + d5) * 512 + c05 + c4);
              const float4 k1 = *(const float4*)(p->rwkv_kvec + (j * 2 + 1) * 512 + c05 + c4);
              const u32x2 kx2 = *(const u32x2*)(rr + 10 * 512);
              const float bb[4] = {b0.x, b0.y, b0.z, b0.w}, kk1[4] = {k1.x, k1.y, k1.z, k1.w};
              const float kx[4] = {bflo(kx2.x), bfhi(kx2.x), bflo(kx2.y), bfhi(kx2.y)};
              float av[4], ke[4];
#pragma unroll
              for (int q = 0; q < 4; ++q) { av[q] = sigm_f(bb[q] + vv[q]); ke[q] = kx[q] * (1.f + (av[q] - 1.f) * kk1[q]); }
              u32x2 o; o.x = pk_bf16(av[0], av[1]); o.y = pk_bf16(av[2], av[3]);
              *(u32x2*)(rr + (7 + d5) * 512) = o;
              o.x = pk_bf16(ke[0], ke[1]); o.y = pk_bf16(ke[2], ke[3]);
              *(u32x2*)(rr + (5 + d5) * 512) = o;
            } else {
              u32x2 o; o.x = pk_bf16(v.x, v.y); o.y = pk_bf16(v.z, v.w);
              *(u32x2*)(rr + 9 * 512) = o;
            }
          } break;
        }
      }
    }
    __syncthreads();
  }
}

__device__ void ph_final_ln(KP p, int layer, bool keep, char* lds) {
  const int tid = opaque_tid();
  const int lane = tid & 63, wave = tid >> 6;
  const int rows = keep ? NT : NL;
  int* s_base = (int*)(lds + META_OFF);
  if (tid == 0) {
    int a = 0;
    for (int e = 0; e < 64; ++e) { s_base[e] = a * 128; a += (p->cnt[e] + 127) >> 7; }
    s_base[64] = a * 128;
  }
  __syncthreads();
  const float* lng = p->ln_g + (layer * 2 + 1) * 1024;
  const float* lnb = p->ln_b + (layer * 2 + 1) * 1024;
  for (int t = blockIdx.x * 4 + wave; t < rows; t += gridDim.x * 4) {
    const int mr = modrow(t);
    const float* g2 = p->MOD + (layer * 9 + mr) * 6144 + 5120;
    const bf16_t* src[7];
#pragma unroll
    for (int k = 0; k < 6; ++k) {
      const int v = p->tsl[t * 6 + k];
      src[k] = p->OUT2 + (size_t)(s_base[v >> 16] + (v & 0xffff)) * 1024;
    }
    src[6] = p->OUT2 + (size_t)(s_base[64] + t) * 1024;
    float v[16];
    float s = 0.f;
#pragma unroll
    for (int c = 0; c < 2; ++c) {
      const int n0 = c * 512 + lane * 8;
      float y[8];
#pragma unroll
      for (int q = 0; q < 8; ++q) y[q] = 0.f;
#pragma unroll
      for (int k = 0; k < 7; ++k) {
        const u32x4 u = *(const u32x4*)(src[k] + n0);
        y[0] += bflo(u.x); y[1] += bfhi(u.x); y[2] += bflo(u.y); y[3] += bfhi(u.y);
        y[4] += bflo(u.z); y[5] += bfhi(u.z); y[6] += bflo(u.w); y[7] += bfhi(u.w);
      }
      const float4 xa = *(const float4*)(p->X + (size_t)t * DM + n0), xb = *(const float4*)(p->X + (size_t)t * DM + n0 + 4);
      const float4 ga = *(const float4*)(g2 + n0), gb = *(const float4*)(g2 + n0 + 4);
      const float xx[8] = {xa.x, xa.y, xa.z, xa.w, xb.x, xb.y, xb.z, xb.w};
      const float gg[8] = {ga.x, ga.y, ga.z, ga.w, gb.x, gb.y, gb.z, gb.w};
#pragma unroll
      for (int q = 0; q < 8; ++q) { v[c * 8 + q] = DN_ALPHA * xx[q] + gg[q] * y[q]; s += v[c * 8 + q]; }
    }
    const float mean = wsum(s) * (1.f / 1024.f);
    float q2 = 0.f;
#pragma unroll
    for (int i = 0; i < 16; ++i) { const float d = v[i] - mean; q2 += d * d; }
    const float rs = rsqrtf(wsum(q2) * (1.f / 1024.f) + 1e-5f);
    const float* modn = p->MOD + ((layer + 1) * 9 + mr) * 6144;
#pragma unroll
    for (int c = 0; c < 2; ++c) {
      const int n0 = c * 512 + lane * 8;
      float xn[8];
#pragma unroll
      for (int q = 0; q < 8; ++q) xn[q] = (v[c * 8 + q] - mean) * rs * lng[n0 + q] + lnb[n0 + q];
      *(float4*)(p->X + (size_t)t * DM + n0) = make_float4(xn[0], xn[1], xn[2], xn[3]);
      *(float4*)(p->X + (size_t)t * DM + n0 + 4) = make_float4(xn[4], xn[5], xn[6], xn[7]);
      if (layer == 3) {
        *(float4*)(p->out + (size_t)t * DM + n0) = make_float4(xn[0], xn[1], xn[2], xn[3]);
        *(float4*)(p->out + (size_t)t * DM + n0 + 4) = make_float4(xn[4], xn[5], xn[6], xn[7]);
      } else {
        float hb[8];
#pragma unroll
        for (int q = 0; q < 8; ++q) hb[q] = xn[q] * (1.f + modn[1024 + n0 + q]) + modn[n0 + q];
        u32x4 o;
        o.x = pk_bf16(hb[0], hb[1]); o.y = pk_bf16(hb[2], hb[3]); o.z = pk_bf16(hb[4], hb[5]); o.w = pk_bf16(hb[6], hb[7]);
        *(u32x4*)(p->AB + (size_t)t * DM + n0) = o;
      }
    }
  }
}

#define XB_TMO      128
#define XB_XCNT(j)  (256  + 64 * (j))
#define XB_XSUB(j)  (1280 + 64 * (j))
#define XB_XGEN(j)  (2304 + 64 * (j))
#define XB_TOP      3328
#define XB_TOPGEN   3392
#define XCD_BAR_WORDS 3456
#define XB_SPIN_CAP (1u << 20)
#define LAS __attribute__((address_space(3)))
__device__ __forceinline__ unsigned xb_ld(unsigned* p) { return __hip_atomic_load(p, __ATOMIC_RELAXED, __HIP_MEMORY_SCOPE_AGENT); }
__device__ __forceinline__ unsigned xb_add(unsigned* p, unsigned v) { return __hip_atomic_fetch_add(p, v, __ATOMIC_RELAXED, __HIP_MEMORY_SCOPE_AGENT); }
__device__ __forceinline__ unsigned xb_xcc_id() { return (unsigned)__builtin_amdgcn_s_getreg((3 << 11) | 20) & 0xFu; }
#define XB_SPIN(cond, bar) do { unsigned _sp = 0; while (cond) { __builtin_amdgcn_s_sleep(1); \
    if ((++_sp & 255u) == 0u) { if (xb_ld(&(bar)[XB_TMO])) break; if (_sp > XB_SPIN_CAP) { atomicAdd(&(bar)[XB_TMO], 1u); break; } } } } while (0)
struct XcdBarrier { unsigned* bar; unsigned x; volatile LAS unsigned* st; };
__device__ __forceinline__ XcdBarrier xcd_barrier_post(unsigned* bar, volatile LAS unsigned* st) {
  XcdBarrier b; b.bar = bar; b.x = xb_xcc_id(); b.st = st;
  if (threadIdx.x == 0) (void)xb_add(&bar[XB_XCNT(b.x)], 1u);
  return b;
}
__device__ __forceinline__ void xcd_barrier_complete(unsigned* bar, unsigned x, unsigned& nloc, unsigned& nx) {
  const unsigned G = gridDim.x;
  unsigned sum, cnt, mine, sp = 0u;
  for (;;) {
    sum = 0u; cnt = 0u; mine = 0u;
#pragma unroll
    for (unsigned j = 0; j < 16; ++j) { const unsigned c = xb_ld(&bar[XB_XCNT(j)]); sum += c; cnt += (c > 0u) ? 1u : 0u; mine = (j == x) ? c : mine; }
    if (sum == G) break;
    __builtin_amdgcn_s_sleep(1);
    if ((++sp & 255u) == 0u) { if (xb_ld(&bar[XB_TMO])) break; if (sp > XB_SPIN_CAP) { atomicAdd(&bar[XB_TMO], 1u); break; } }
  }
  nloc = mine > 0u ? mine : 1u; nx = cnt > 0u ? cnt : 1u;
}
__device__ __forceinline__ void xcd_barrier(const XcdBarrier& b) {
  asm volatile("s_waitcnt vmcnt(0)" ::: "memory");
  __syncthreads();
  if (threadIdx.x == 0) {
    unsigned* bar = b.bar;
    __builtin_amdgcn_s_waitcnt(0);
    unsigned nloc = b.st[0], nx = b.st[1];
    if (nloc == 0u) { xcd_barrier_complete(bar, b.x, nloc, nx); b.st[0] = nloc; b.st[1] = nx; }
    const unsigned old = xb_add(&bar[XB_XSUB(b.x)], 1u);
    const unsigned gen = old / nloc;
    if (old + 1u == (gen + 1u) * nloc) {
      __builtin_amdgcn_fence(__ATOMIC_RELEASE, "agent");
      asm volatile("s_waitcnt vmcnt(0)" ::: "memory");
      const unsigned og = xb_add(&bar[XB_TOP], 1u);
      const unsigned tg = og / nx;
      if (og + 1u == (tg + 1u) * nx) xb_add(&bar[XB_TOPGEN], 1u);
      else XB_SPIN(xb_ld(&bar[XB_TOPGEN]) == tg, bar);
      __builtin_amdgcn_fence(__ATOMIC_ACQUIRE, "agent");
      xb_add(&bar[XB_XGEN(b.x)], 1u);
      asm volatile("s_waitcnt vmcnt(0)" ::: "memory");
    } else {
      XB_SPIN(xb_ld(&bar[XB_XGEN(b.x)]) == gen, bar);
      __builtin_amdgcn_fence(__ATOMIC_ACQUIRE, "agent");
      asm volatile("s_waitcnt vmcnt(0)" ::: "memory");
    }
  }
  __syncthreads();
}

constexpr int NSLOTS = 13;
constexpr int NPHASE = 2 + 4 * NSLOTS;
__device__ __forceinline__ bool phase_is_nop(int ph) {
  if (ph < 2) return false;
  const int layer = (ph - 2) / NSLOTS, st = (ph - 2) % NSLOTS;
  return !(layer & 1) && (st == 1 || (st >= 3 && st <= 7));
}
__device__ void run_phase(KP p, int ph, char* sm) {
  if (ph == 0) { ph_init(p, sm); return; }
  if (ph == 1) { ph_mod_h(p, sm); return; }
  const int layer = (ph - 2) / NSLOTS, st = (ph - 2) % NSLOTS;
  const bool odd = layer & 1;
  const bool keep = layer < 3;
  int gk = -1;
  if (st == 0) gk = 0;
  else if (st == 8) gk = 1;
  else if (st == 10) gk = 2;
  else if (st == 11) gk = 3;
  else if (odd && st == 2) gk = 4;
  else if (odd && st == 3) gk = 5;
  asm volatile("" : "+s"(gk));
  if (gk >= 0) { ph_gemm(p, gk, layer, keep, sm); return; }
  switch (st) {
    case 1: if (odd) ph_rwkv_mix(p, layer); break;
    case 2: ph_attention(p, layer, keep, sm); break;
    case 4: if (odd) ph_scan_a(p, layer, sm); break;
    case 5: if (odd) ph_mlstm_s2(p, sm); break;
    case 6: if (odd) ph_mlstm_s3(p, layer, sm); break;
    case 7: if (odd) ph_rec_final(p, layer, keep); break;
    case 9: ph_ln_router(p, layer, keep, sm); break;
    case 12: ph_final_ln(p, layer, keep, sm); break;
  }
}

__global__ void __launch_bounds__(NTHR, 2) mega_kernel(Params kargs) {
  extern __shared__ __attribute__((aligned(16))) char sm[];
  cg::grid_group grid = cg::this_grid();
  volatile LAS unsigned* st = (volatile LAS unsigned*)(sm + META_OFF + 4032);
  if (threadIdx.x == 0) { st[0] = 0u; st[1] = 0u; }
  __syncthreads();
  const XcdBarrier xb = xcd_barrier_post(kargs.bar, st);
  for (int ph = kargs.ph_lo; ph < kargs.ph_hi; ++ph) {
    if (phase_is_nop(ph)) continue;
    {
      KP kp = (KP)__builtin_amdgcn_kernarg_segment_ptr();
      asm volatile("" : "+s"(kp));
      run_phase(kp, ph, sm);
    }
    if (ph + 1 < kargs.ph_hi) {
      if (ph == 0) grid.sync();
      else xcd_barrier(xb);
    }
  }
}

extern "C" void kernel_launch(void* const* d_in, const int* in_sizes, int n_in, void* d_out, int out_size, void* d_ws,
                              size_t ws_size, hipStream_t stream) {
  static int grid_blocks = 0;
  if (!grid_blocks) {
    int dev = 0, cus = 0, per_cu = 0;
    (void)hipGetDevice(&dev);
    (void)hipDeviceGetAttribute(&cus, hipDeviceAttributeMultiprocessorCount, dev);
    (void)hipFuncSetAttribute((const void*)mega_kernel, hipFuncAttributeMaxDynamicSharedMemorySize, SMEM_BYTES);
    (void)hipOccupancyMaxActiveBlocksPerMultiprocessor(&per_cu, mega_kernel, NTHR, SMEM_BYTES);
    if (per_cu < 1) per_cu = 1;
    if (per_cu > 2) per_cu = 2;
    grid_blocks = cus * per_cu;
  }
  Params p;
  memset(&p, 0, sizeof(p));
  const float** pin = (const float**)&p;
  for (int i = 0; i < 35; ++i) pin[i] = (const float*)d_in[i];
  p.out = (float*)d_out;
  char* w = (char*)d_ws;
  size_t off = 0;
  auto take = [&](size_t bytes) { char* r = w + off; off += (bytes + 255) & ~(size_t)255; return r; };
  p.Wt_att = (bf16_t*)take((size_t)2 * ATT_N * 1024 * 2);
  p.Wt_rec = (bf16_t*)take((size_t)2 * REC_NP * 1024 * 2);
  p.Wt_out = (bf16_t*)take((size_t)4 * 1024 * 1024 * 2);
  p.Wt13 = (bf16_t*)take((size_t)4 * 65 * 512 * 1024 * 2);
  p.Wt2 = (bf16_t*)take((size_t)4 * 65 * 1024 * 256 * 2);
  p.Wl1 = (bf16_t*)take((size_t)2 * 3 * 128 * 512 * 2);
  p.Wl2 = (bf16_t*)take((size_t)2 * 2560 * 128 * 2);
  p.X = (float*)take((size_t)NT * DM * 4);
  p.AB = (bf16_t*)take((size_t)NT * DM * 2);
  p.MOD = (float*)take((size_t)5 * 9 * 6144 * 4);
  p.MODP = (float*)take((size_t)8 * 4 * 9 * 6144 * 4);
  p.GP = (float*)take((size_t)NT * 16 * 4);
  p.ROPE = (float*)take((size_t)64 * 16 * 2 * 4);
  p.msc = (float*)take((size_t)3 * NMT * 4);
  p.lgate = (float*)take((size_t)64 * NT * 4);
  p.ltok = (int*)take((size_t)64 * NT * 4);
  p.tsl = (int*)take((size_t)NT * 6 * 4);
  p.cnt = (int*)take(512);
  p.bar = (unsigned*)take((size_t)XCD_BAR_WORDS * 4);
  char* region = take(0);
  const size_t szP = (size_t)NT * LDP * 2, szRW = (size_t)NT * RWS * 2, szMS = (size_t)NMT * 16384 * 2,
               szMSn = (size_t)NMT * 128 * 4;
  const size_t szT = (size_t)NT * DM * 4, szOUT2 = (size_t)NSLOT * 1024 * 2;
  p.P = (bf16_t*)region;
  p.RW = (bf16_t*)(region + szP);
  p.MS = (bf16_t*)(region + szP + szRW);
  p.MSn = (float*)(region + szP + szRW + szMS);
  p.Zb = p.MS;
  p.L1 = p.MS + (size_t)NT * 1536;
  p.Tb = (float*)region;
  p.ACT = (bf16_t*)region;
  p.OUT2 = (bf16_t*)(region + szT);
  size_t mixer = szP + szRW + szMS + szMSn, moe = szT + szOUT2;
  off += (mixer > moe ? mixer : moe);
  if (off > ws_size) { fprintf(stderr, "workspace too small: need %zu have %zu\n", off, ws_size); return; }
  p.ph_lo = 0;
  p.ph_hi = NPHASE;
  (void)hipMemsetAsync(p.bar, 0, (size_t)XCD_BAR_WORDS * 4, stream);
  void* args[] = {&p};
  hipError_t e = hipLaunchCooperativeKernel((void*)mega_kernel, dim3(grid_blocks), dim3(NTHR), args, SMEM_BYTES, stream);
  if (e != hipSuccess) fprintf(stderr, "cooperative launch failed: %s (grid %d)\n", hipGetErrorString(e), grid_blocks);
}
```

```cpp
#include <hip/hip_runtime.h>
#include <hip/hip_cooperative_groups.h>
#include <cstdio>
#include <cstring>
namespace cg = cooperative_groups;

constexpr int DM = 1024;
constexpr int NBATCH = 8;
constexpr int SEQ = 2048;
constexpr int CTXL = 256;
constexpr int NL = NBATCH * SEQ;
constexpr int NC = NBATCH * CTXL;
constexpr int NT = NL + NC;
constexpr int TSC = CTXL + SEQ;
constexpr int LDP = 4112;
constexpr int ATT_N = 2304;
constexpr int REC_N = 4112;
constexpr int REC_NP = 4224;
constexpr int NCHUNK = 36;
constexpr int NMT = 64 * NCHUNK;
constexpr int RWS = 5632;
constexpr int NSLOT = 137216;
constexpr float DN_ALPHA = 1.6817928305074290f;
constexpr int NTHR = 256;
constexpr int SMEM_BYTES = 65536 + 4096;
constexpr int META_OFF = 65536;

typedef unsigned short bf16_t;
using bf16x8 = __attribute__((ext_vector_type(8))) short;
using f32x16 = __attribute__((ext_vector_type(16))) float;
using u32x4 = __attribute__((ext_vector_type(4))) unsigned;
using u32x2 = __attribute__((ext_vector_type(2))) unsigned;

struct Params {
  const float *x, *c, *ctx, *c_ctx, *ada_w, *ada_b, *ln_g, *ln_b, *mix_w_out, *att_w_in, *na_rpb, *qk_gain,
      *rec_w_in, *rwkv_mu, *rwkv_w0, *rwkv_w1, *rwkv_w2, *rwkv_a0, *rwkv_a1, *rwkv_a2, *rwkv_g1, *rwkv_g2,
      *rwkv_kvec, *rwkv_rk, *rwkv_gn, *mlstm_gate_b, *mlstm_norm, *moe_router, *moe_bias, *moe_w1, *moe_w3,
      *moe_w2, *shared_w1, *shared_w3, *shared_w2;
  float* out;
  bf16_t *Wt_att, *Wt_rec, *Wt_out, *Wt13, *Wt2, *Wl1, *Wl2;
  bf16_t *Zb, *L1;
  float *X, *MOD, *MODP, *GP, *msc, *lgate, *MSn, *Tb, *ROPE;
  bf16_t *AB, *P, *RW, *MS, *ACT, *OUT2;
  int *cnt, *ltok, *tsl;
  unsigned* bar;
  int ph_lo, ph_hi;
};

typedef const Params __attribute__((address_space(4))) * KP;

__device__ __forceinline__ int modrow(int t) { return t < NL ? (t >> 11) : 8; }
__device__ __forceinline__ float silu_f(float x) { return x / (1.f + expf(-x)); }
__device__ __forceinline__ float sigm_f(float x) { return 1.f / (1.f + expf(-x)); }
__device__ __forceinline__ float softplus_f(float x) { return fmaxf(x, 0.f) + log1pf(expf(-fabsf(x))); }
__device__ __forceinline__ float wsum(float v) {
#pragma unroll
  for (int o = 32; o; o >>= 1) v += __shfl_xor(v, o);
  return v;
}
__device__ __forceinline__ float wmax(float v) {
#pragma unroll
  for (int o = 32; o; o >>= 1) v = fmaxf(v, __shfl_xor(v, o));
  return v;
}
__device__ __forceinline__ float rdlane(float v, int l) {
  return __int_as_float(__builtin_amdgcn_readlane(__float_as_int(v), l));
}
__device__ __forceinline__ int opaque_tid() {
  int t = threadIdx.x;
  asm volatile("" : "+v"(t));
  return t;
}
typedef __bf16 bf16x2_t __attribute__((ext_vector_type(2)));
typedef float f32x2_t __attribute__((ext_vector_type(2)));
__device__ __forceinline__ unsigned pk_bf16(float lo, float hi) {
  const f32x2_t v = {lo, hi};
  return __builtin_bit_cast(unsigned, __builtin_convertvector(v, bf16x2_t));
}
__device__ __forceinline__ bf16_t f2bf(float x) { return (bf16_t)(pk_bf16(x, 0.f) & 0xffffu); }
__device__ __forceinline__ float bf2f(bf16_t v) { return __uint_as_float((unsigned)v << 16); }
__device__ __forceinline__ float bflo(unsigned u) { return __uint_as_float(u << 16); }
__device__ __forceinline__ float bfhi(unsigned u) { return __uint_as_float(u & 0xffff0000u); }
template <int CTRL>
__device__ __forceinline__ float dppx(float x) {
  return __int_as_float(__builtin_amdgcn_update_dpp(0, __float_as_int(x), CTRL, 0xf, 0xf, true));
}
__device__ __forceinline__ int scan_row(int dir, int b, int tau) {
  if (tau < CTXL) return NL + b * CTXL + (dir ? (CTXL - 1 - tau) : tau);
  int s = tau - CTXL;
  return b * SEQ + (dir ? (SEQ - 1 - s) : s);
}

template <class RowPtrA>
__device__ __forceinline__ void gemm128_main(int tid, RowPtrA rowA, const bf16_t* __restrict__ Bt, int K, int n0,
                                             char* lds, f32x16 (&acc)[2][2]) {
  const int lane = tid & 63, w = tid >> 6;
  const int wm = w >> 1, wn = w & 1, r = lane & 31, h = lane >> 5;
  const int c = tid & 7, sr = tid >> 3;
  const int lc = (c ^ ((tid >> 4) & 7)) * 8;
  const bf16_t* ap[4];
#pragma unroll
  for (int i = 0; i < 4; ++i) ap[i] = rowA(sr + 32 * i) + lc;
  const bf16_t* bp0 = Bt + (size_t)(n0 + sr) * K + lc;
  const int bstr = 32 * K;
#pragma unroll
  for (int mi = 0; mi < 2; ++mi)
#pragma unroll
    for (int ni = 0; ni < 2; ++ni)
#pragma unroll
      for (int q = 0; q < 16; ++q) acc[mi][ni][q] = 0.f;
  const int nk = K >> 6;
  auto issue = [&](int kt) {
    char* As = lds + (kt & 1) * 32768 + tid * 16;
    const int k0 = kt * 64;
#pragma unroll
    for (int i = 0; i < 4; ++i) {
      __builtin_amdgcn_global_load_lds((const unsigned*)(ap[i] + k0), (__attribute__((address_space(3))) unsigned*)(As + i * 4096), 16, 0, 0);
      __builtin_amdgcn_global_load_lds((const unsigned*)(bp0 + i * bstr + k0), (__attribute__((address_space(3))) unsigned*)(As + 16384 + i * 4096), 16, 0, 0);
    }
  };
  issue(0);
  const int sw = (r >> 1) & 7;
#pragma unroll 1
  for (int kt = 0; kt < nk; ++kt) {
    asm volatile("s_waitcnt vmcnt(0)" ::: "memory");
    __syncthreads();
    if (kt + 1 < nk) issue(kt + 1);
    const char* As = lds + (kt & 1) * 32768;
    const char* Ar = As + (wm * 64 + r) * 128;
    const char* Br = As + 16384 + (wn * 64 + r) * 128;
#pragma unroll
    for (int ks = 0; ks < 4; ++ks) {
      const int off = ((ks * 2 + h) ^ sw) * 16;
      const bf16x8 a0 = *(const bf16x8*)(Ar + off);
      const bf16x8 a1 = *(const bf16x8*)(Ar + 32 * 128 + off);
      const bf16x8 b0 = *(const bf16x8*)(Br + off);
      const bf16x8 b1 = *(const bf16x8*)(Br + 32 * 128 + off);
      acc[0][0] = __builtin_amdgcn_mfma_f32_32x32x16_bf16(a0, b0, acc[0][0], 0, 0, 0);
      acc[0][1] = __builtin_amdgcn_mfma_f32_32x32x16_bf16(a0, b1, acc[0][1], 0, 0, 0);
      acc[1][0] = __builtin_amdgcn_mfma_f32_32x32x16_bf16(a1, b0, acc[1][0], 0, 0, 0);
      acc[1][1] = __builtin_amdgcn_mfma_f32_32x32x16_bf16(a1, b1, acc[1][1], 0, 0, 0);
    }
  }
  __syncthreads();
}
template <class F>
__device__ __forceinline__ void acc_foreach(int tid, const f32x16 (&acc)[2][2], F f) {
  const int lane = tid & 63, w = tid >> 6;
  const int wm = w >> 1, wn = w & 1, r = lane & 31, h = lane >> 5;
#pragma unroll
  for (int mi = 0; mi < 2; ++mi)
#pragma unroll
    for (int ni = 0; ni < 2; ++ni)
#pragma unroll
      for (int q = 0; q < 16; ++q) {
        const int row = wm * 64 + mi * 32 + (q & 3) + 8 * (q >> 2) + 4 * h;
        const int col = wn * 64 + ni * 32 + r;
        f(row, col, acc[mi][ni][q]);
        if ((q & 3) == 3) __builtin_amdgcn_sched_barrier(0);
      }
}

template <class RM>
__device__ __forceinline__ void tr_tile(int tid, const float* __restrict__ src, int N, int k0, int n0,
                                        bf16_t* __restrict__ dst, int K, RM rowmap, float* tile) {
  {
    const int tx = tid & 15, ty = tid >> 4;
    const int n = n0 + tx * 4;
#pragma unroll
    for (int i = 0; i < 4; ++i) {
      const int k = ty + 16 * i;
      float4 v = make_float4(0.f, 0.f, 0.f, 0.f);
      if (n < N) v = *(const float4*)(src + (size_t)(k0 + k) * N + n);
      tile[k * 65 + tx * 4 + 0] = v.x; tile[k * 65 + tx * 4 + 1] = v.y;
      tile[k * 65 + tx * 4 + 2] = v.z; tile[k * 65 + tx * 4 + 3] = v.w;
    }
  }
  __syncthreads();
  {
    const int kc = tid & 7;
#pragma unroll
    for (int i = 0; i < 2; ++i) {
      const int n = (tid >> 3) + 32 * i;
      if (n0 + n < N) {
        float v[8];
#pragma unroll
        for (int q = 0; q < 8; ++q) v[q] = tile[(kc * 8 + q) * 65 + n];
        u32x4 o;
        o.x = pk_bf16(v[0], v[1]); o.y = pk_bf16(v[2], v[3]); o.z = pk_bf16(v[4], v[5]); o.w = pk_bf16(v[6], v[7]);
        *(u32x4*)(dst + (size_t)rowmap(n0 + n) * K + k0 + kc * 8) = o;
      }
    }
  }
  __syncthreads();
}

__device__ void ph_init(KP p, char* smc) {
  float* sm = (float*)smc;
  const int tid = opaque_tid();
  {
    const size_t n4a = (size_t)NL * DM / 4, n4b = (size_t)NC * DM / 4;
    const float4* xs = (const float4*)p->x;
    const float4* cs = (const float4*)p->ctx;
    float4* X4 = (float4*)p->X;
    for (size_t i = (size_t)blockIdx.x * NTHR + tid; i < n4a + n4b; i += (size_t)gridDim.x * NTHR)
      X4[i] = i < n4a ? xs[i] : cs[i - n4a];
  }
  for (int tile = blockIdx.x; tile < 96 * 8; tile += gridDim.x) {
    const int ct = tile >> 3, ks = tile & 7;
    for (int i = tid; i < 9 * 128; i += NTHR) {
      const int r = i >> 7, k = ks * 128 + (i & 127);
      const float v = r < 8 ? p->c[r * 1024 + k] : p->c_ctx[k];
      sm[i] = silu_f(v);
    }
    __syncthreads();
    const int col = ct * 256 + tid;
    const int layer = col / 6144, n = col % 6144;
    const float* W = p->ada_w + ((size_t)layer * 1024 + ks * 128) * 6144 + n;
    float acc[9];
#pragma unroll
    for (int r = 0; r < 9; ++r) acc[r] = 0.f;
#pragma unroll 4
    for (int k = 0; k < 128; ++k) {
      const float w = W[(size_t)k * 6144];
#pragma unroll
      for (int r = 0; r < 9; ++r) acc[r] = fmaf(sm[r * 128 + k], w, acc[r]);
    }
#pragma unroll
    for (int r = 0; r < 9; ++r) p->MODP[((size_t)(ks * 4 + layer) * 9 + r) * 6144 + n] = acc[r];
    __syncthreads();
  }
  constexpr int T0 = 1152, T1 = T0 + 2080, T2 = T1 + 1024, T3 = T2 + 33280, T4 = T3 + 16640;
  for (int job = blockIdx.x; job < T4; job += gridDim.x) {
    if (job < T0) {
      const int j = job / 576, rem = job % 576, kt = rem / 36, nt = rem % 36;
      tr_tile(tid, p->att_w_in + (size_t)j * 1024 * ATT_N, ATT_N, kt * 64, nt * 64, p->Wt_att + (size_t)j * ATT_N * 1024,
              1024, [](int n) { return n; }, sm);
    } else if (job < T1) {
      const int q = job - T0;
      const int j = q / 1040, rem = q % 1040, kt = rem / 65, nt = rem % 65;
      tr_tile(tid, p->rec_w_in + (size_t)j * 1024 * REC_N, REC_N, kt * 64, nt * 64, p->Wt_rec + (size_t)j * REC_NP * 1024,
              1024, [](int n) { return n; }, sm);
    } else if (job < T2) {
      const int q = job - T1;
      const int i = q >> 8, rem = q & 255, kt = rem >> 4, nt = rem & 15;
      tr_tile(tid, p->mix_w_out + (size_t)i * 1024 * 1024, 1024, kt * 64, nt * 64, p->Wt_out + (size_t)i * 1024 * 1024,
              1024, [](int n) { return n; }, sm);
    } else if (job < T3) {
      const int q = job - T2;
      const int le = q >> 7, rem = q & 127;
      const int which = rem >> 6, kt = (rem >> 2) & 15, nt = rem & 3;
      const int layer = le / 65, e = le % 65;
      const float* src;
      if (e < 64) src = (which ? p->moe_w3 : p->moe_w1) + (size_t)(layer * 64 + e) * 1024 * 256;
      else src = (which ? p->shared_w3 : p->shared_w1) + (size_t)layer * 1024 * 256;
      tr_tile(tid, src, 256, kt * 64, nt * 64, p->Wt13 + (size_t)le * 512 * 1024, 1024,
              [which](int n) { return 64 * (n >> 5) + which * 32 + (n & 31); }, sm);
    } else {
      const int q = job - T3;
      const int le = q >> 6, rem = q & 63;
      const int kt = rem >> 4, nt = rem & 15;
      const int layer = le / 65, e = le % 65;
      const float* src = e < 64 ? p->moe_w2 + (size_t)(layer * 64 + e) * 256 * 1024 : p->shared_w2 + (size_t)layer * 256 * 1024;
      tr_tile(tid, src, 1024, kt * 64, nt * 64, p->Wt2 + (size_t)le * 1024 * 256, 256, [](int n) { return n; }, sm);
    }
  }
  for (int i = blockIdx.x * NTHR + tid; i < 2 * 3 * 128 * 512; i += gridDim.x * NTHR) {
    const int k = i & 511, n = (i >> 9) & 127, wj = i >> 16;
    const int j = wj / 3, which = wj % 3;
    float v = 0.f;
    if (which < 2) {
      if (n < 64) v = (which ? p->rwkv_a1 : p->rwkv_w1)[((size_t)(j * 2 + (n >> 5)) * 512 + k) * 32 + (n & 31)];
    } else if (n < 96) v = p->rwkv_g1[((size_t)j * 512 + k) * 96 + n];
    p->Wl1[i] = f2bf(v);
  }
  for (int i = blockIdx.x * NTHR + tid; i < 2 * 2560 * 128; i += gridDim.x * NTHR) {
    const int k = i & 127, n = (i >> 7) % 2560, j = i / (2560 * 128);
    float v = 0.f;
    if (n < 2048) {
      const int d = (n >> 9) & 1, c = n & 511;
      if (k < 64 && (k >> 5) == d) v = (n < 1024 ? p->rwkv_w2 : p->rwkv_a2)[((size_t)(j * 2 + d) * 32 + (k & 31)) * 512 + c];
    } else if (k < 96) v = p->rwkv_g2[((size_t)j * 96 + k) * 512 + (n - 2048)];
    p->Wl2[i] = f2bf(v);
  }
  for (int i = blockIdx.x * NTHR + tid; i < 64 * 16; i += gridDim.x * NTHR) {
    const int pos = i >> 4, f = i & 15;
    const float ang = (float)pos * powf(10000.f, -(float)f / 16.f);
    p->ROPE[2 * i] = cosf(ang);
    p->ROPE[2 * i + 1] = sinf(ang);
  }
}

__device__ void ph_mod_h(KP p, char* smc) {
  float* sm = (float*)smc;
  const int tid = opaque_tid();
  for (int i = blockIdx.x * NTHR + tid; i < 4 * 9 * 6144; i += gridDim.x * NTHR) {
    const int layer = i / (9 * 6144), rem = i % (9 * 6144), n = rem % 6144;
    float s = p->ada_b[layer * 6144 + n];
#pragma unroll
    for (int ks = 0; ks < 8; ++ks) s += p->MODP[(size_t)(ks * 4 + layer) * 9 * 6144 + rem];
    p->MOD[i] = s;
  }
  const int lane = tid & 63, wave = tid >> 6;
  const int per = (((NT + gridDim.x - 1) / gridDim.x) + 3) & ~3;
  const int t0 = blockIdx.x * per, t1 = min(NT, t0 + per);
  int cur = -1;
  for (int tb = t0; tb < t1; tb += 4) {
    const int mr = modrow(tb);
    if (mr != cur) {
      __syncthreads();
      for (int n = tid; n < 2048; n += NTHR) {
        float a = p->ada_b[n];
#pragma unroll
        for (int ks = 0; ks < 8; ++ks) a += p->MODP[((size_t)(ks * 4) * 9 + mr) * 6144 + n];
        sm[n] = a;
      }
      cur = mr;
      __syncthreads();
    }
    const int t = tb + wave;
    if (t < t1) {
      const float* src = t < NL ? p->x + (size_t)t * DM : p->ctx + (size_t)(t - NL) * DM;
#pragma unroll
      for (int i = 0; i < 4; ++i) {
        const int n = i * 256 + lane * 4;
        const float4 xv = *(const float4*)(src + n);
        const float4 sh = *(const float4*)(sm + n);
        const float4 sc = *(const float4*)(sm + 1024 + n);
        u32x2 o;
        o.x = pk_bf16(xv.x * (1.f + sc.x) + sh.x, xv.y * (1.f + sc.y) + sh.y);
        o.y = pk_bf16(xv.z * (1.f + sc.z) + sh.z, xv.w * (1.f + sc.w) + sh.w);
        *(u32x2*)(p->AB + (size_t)t * DM + n) = o;
      }
    }
  }
}

typedef short v4i16_t __attribute__((ext_vector_type(4)));
using s16x4 = __attribute__((ext_vector_type(4))) short;
__device__ __forceinline__ s16x4 vtr(const char* p) {
  return __builtin_bit_cast(s16x4, __builtin_amdgcn_ds_read_tr16_b64_v4i16((__attribute__((address_space(3))) v4i16_t*)p));
}
#define MFMA32(a, b, c) __builtin_amdgcn_mfma_f32_32x32x16_bf16(a, b, c, 0, 0, 0)
__device__ void ph_attention(KP p, int layer, bool keep, char* lds) {
  const int tid = opaque_tid();
  const int lane = tid & 63, w = tid >> 6, r32 = lane & 31, hi = lane >> 5;
  const int j = layer >> 1;
  float* bias_lds = (float*)(lds + 32768 + 1024);
  const int n_gqa = 1024, n_na = 1024, n_cb = keep ? 128 : 0, n_ca = keep ? 128 : 0;
  const int total = n_gqa + n_na + n_cb + n_ca;
  constexpr float LOG2E = 1.4426950408889634f;
  constexpr float C2 = 0.125f * LOG2E;
  const int c = tid & 7, sr = tid >> 3;
  const int kso = (c ^ ((tid >> 4) & 7)) * 16;
  const int vso = (c >> 2) * 4096 + (c & 3) * 16;
  const int sw = (r32 >> 1) & 7;
  for (int item = blockIdx.x; item < total; item += gridDim.x) {
    int b, qrow0, qoff, koff, voff, ocol, lat_tiles, lat_row0;
    bool na = false;
    int r_w = 0, start_w = 0, ru0 = 0, hN = 0;
    if (item < n_gqa) {
      b = item >> 7;
      const int g = (item >> 6) & 1, tt = item & 63;
      qrow0 = b * SEQ + tt * 32; qoff = 1536 + (g * 4 + w) * 64; koff = 2048 + g * 64; voff = 2176 + g * 64;
      ocol = 512 + (g * 4 + w) * 64; lat_tiles = 32; lat_row0 = b * SEQ;
    } else if (item < n_gqa + n_na) {
      const int it = item - n_gqa;
      b = it >> 7; hN = (it >> 4) & 7;
      const int rp = it & 15;
      na = true; r_w = 2 * rp + (w >> 1);
      qrow0 = b * SEQ + r_w * 64 + (w & 1) * 32; qoff = hN * 64; koff = 512 + hN * 64; voff = 1024 + hN * 64; ocol = hN * 64;
      const int s0 = min(max(2 * rp - 4, 0), 24), s1 = min(max(2 * rp - 3, 0), 24);
      start_w = (w >> 1) ? s1 : s0; ru0 = s0; lat_tiles = (s1 != s0) ? 9 : 8; lat_row0 = b * SEQ + ru0 * 64;
    } else if (item < n_gqa + n_na + n_cb) {
      const int it = item - n_gqa - n_na;
      b = it >> 4;
      const int g = (it >> 3) & 1, tt = it & 7;
      qrow0 = NL + b * CTXL + tt * 32; qoff = 1536 + (g * 4 + w) * 64; koff = 2048 + g * 64; voff = 2176 + g * 64;
      ocol = 512 + (g * 4 + w) * 64; lat_tiles = 0; lat_row0 = 0;
    } else {
      const int it = item - n_gqa - n_na - n_cb;
      b = it >> 4;
      const int h = (it >> 1) & 7, half = it & 1;
      qrow0 = NL + b * CTXL + half * 128 + w * 32; qoff = h * 64; koff = 512 + h * 64; voff = 1024 + h * 64; ocol = h * 64;
      lat_tiles = 0; lat_row0 = 0;
    }
    const int ctx_row0 = NL + b * CTXL, ntiles = lat_tiles + 4;
    if (na)
      for (int i = tid; i < 465; i += NTHR) bias_lds[i] = p->na_rpb[(j * 8 + hN) * 465 + i] * LOG2E;
    bf16x8 qf[4];
    {
      const bf16_t* qp = p->P + (size_t)(qrow0 + r32) * LDP + qoff + hi * 8;
#pragma unroll
      for (int d0 = 0; d0 < 4; ++d0) qf[d0] = *(const bf16x8*)(qp + d0 * 16);
    }
    f32x16 o0, o1;
#pragma unroll
    for (int q = 0; q < 16; ++q) { o0[q] = 0.f; o1[q] = 0.f; }
    float m = -INFINITY, l = 0.f;
    u32x4 kr0, kr1, vr0, vr1;
    auto gload = [&](int t) {
      const int row0 = t < lat_tiles ? lat_row0 + 64 * t : ctx_row0 + 64 * (t - lat_tiles);
      const bf16_t* base = p->P + (size_t)(row0 + sr) * LDP + c * 8;
      kr0 = *(const u32x4*)(base + koff); kr1 = *(const u32x4*)(base + (size_t)32 * LDP + koff);
      vr0 = *(const u32x4*)(base + voff); vr1 = *(const u32x4*)(base + (size_t)32 * LDP + voff);
    };
    auto swrite = [&](int buf) {
      char* Kb = lds + buf * 16384;
      char* Vb = Kb + 8192;
      *(u32x4*)(Kb + sr * 128 + kso) = kr0; *(u32x4*)(Kb + (sr + 32) * 128 + kso) = kr1;
      *(u32x4*)(Vb + vso + sr * 64) = vr0; *(u32x4*)(Vb + vso + (sr + 32) * 64) = vr1;
    };
    gload(0);
    swrite(0);
    for (int t = 0; t < ntiles; ++t) {
      __syncthreads();
      if (t + 1 < ntiles) gload(t + 1);
      const bool na_tile = na && t < lat_tiles;
      const int kr = ru0 + t;
      const bool part = !na_tile || (kr >= start_w && kr < start_w + 8);
      if (part) {
        const char* Ks = lds + (t & 1) * 16384;
        const char* Vs = Ks + 8192;
        f32x16 s0, s1;
#pragma unroll
        for (int q = 0; q < 16; ++q) { s0[q] = 0.f; s1[q] = 0.f; }
#pragma unroll
        for (int d0 = 0; d0 < 4; ++d0) {
          const int off = ((2 * d0 + hi) ^ sw) * 16;
          const bf16x8 k0 = *(const bf16x8*)(Ks + r32 * 128 + off);
          const bf16x8 k1 = *(const bf16x8*)(Ks + (32 + r32) * 128 + off);
          s0 = MFMA32(k0, qf[d0], s0);
          s1 = MFMA32(k1, qf[d0], s1);
        }
        float mx = -INFINITY;
        if (na_tile) {
          const int cq = (w & 1) * 32 + r32;
          const int c0 = min(max(cq - 8, 0), 48);
          const float* brow = bias_lds + (kr - r_w + 7) * 31 + (15 - cq);
#pragma unroll
          for (int q = 0; q < 16; ++q) {
            const int kc = (q & 3) + 8 * (q >> 2) + 4 * hi;
            const float v0 = ((unsigned)(kc - c0) < 16u) ? fmaf(s0[q], C2, brow[kc]) : -INFINITY;
            const float v1 = ((unsigned)(kc + 32 - c0) < 16u) ? fmaf(s1[q], C2, brow[kc + 32]) : -INFINITY;
            s0[q] = v0; s1[q] = v1;
            mx = fmaxf(mx, fmaxf(v0, v1));
          }
        } else {
#pragma unroll
          for (int q = 0; q < 16; ++q) {
            s0[q] *= C2; s1[q] *= C2;
            mx = fmaxf(mx, fmaxf(s0[q], s1[q]));
          }
        }
        {
          auto rr = __builtin_amdgcn_permlane32_swap(__float_as_uint(mx), __float_as_uint(mx), false, false);
          mx = fmaxf(__uint_as_float(rr[0]), __uint_as_float(rr[1]));
        }
        const float mnew = fmaxf(m, mx);
        const float alpha = __builtin_amdgcn_exp2f(m - mnew);
        float ls = 0.f;
#pragma unroll
        for (int q = 0; q < 16; ++q) {
          s0[q] = __builtin_amdgcn_exp2f(s0[q] - mnew);
          s1[q] = __builtin_amdgcn_exp2f(s1[q] - mnew);
          ls += s0[q] + s1[q];
        }
        l = l * alpha + ls;
        m = mnew;
#pragma unroll
        for (int q = 0; q < 16; ++q) { o0[q] *= alpha; o1[q] *= alpha; }
        bf16x8 pf[4];
#pragma unroll
        for (int s = 0; s < 4; ++s) {
          const int u = (s & 1) * 8;
          u32x4 tpk;
          if (s < 2) {
            tpk.x = pk_bf16(s0[u + 0], s0[u + 1]); tpk.y = pk_bf16(s0[u + 2], s0[u + 3]);
            tpk.z = pk_bf16(s0[u + 4], s0[u + 5]); tpk.w = pk_bf16(s0[u + 6], s0[u + 7]);
          } else {
            tpk.x = pk_bf16(s1[u + 0], s1[u + 1]); tpk.y = pk_bf16(s1[u + 2], s1[u + 3]);
            tpk.z = pk_bf16(s1[u + 4], s1[u + 5]); tpk.w = pk_bf16(s1[u + 6], s1[u + 7]);
          }
          pf[s] = __builtin_bit_cast(bf16x8, tpk);
        }
        const char* vb = Vs + ((lane >> 4) & 1) * 32 + (lane & 3) * 8 + ((lane & 15) >> 2) * 64 + hi * 256;
#pragma unroll
        for (int s = 0; s < 4; ++s) {
          const s16x4 a00 = vtr(vb + (16 * s) * 64), a01 = vtr(vb + (16 * s + 8) * 64);
          const s16x4 a10 = vtr(vb + 4096 + (16 * s) * 64), a11 = vtr(vb + 4096 + (16 * s + 8) * 64);
          const bf16x8 A0 = __builtin_shufflevector(a00, a01, 0, 1, 2, 3, 4, 5, 6, 7);
          const bf16x8 A1 = __builtin_shufflevector(a10, a11, 0, 1, 2, 3, 4, 5, 6, 7);
          o0 = MFMA32(A0, pf[s], o0);
          o1 = MFMA32(A1, pf[s], o1);
        }
      }
      if (t + 1 < ntiles) swrite((t + 1) & 1);
    }
    __syncthreads();
    const float lt = l + __shfl_xor(l, 32);
    const float inv = 1.f / lt;
    bf16_t* op = p->AB + (size_t)(qrow0 + r32) * DM + ocol + 4 * hi;
#pragma unroll
    for (int g = 0; g < 4; ++g) {
      u32x2 v0, v1;
      v0.x = pk_bf16(o0[4 * g] * inv, o0[4 * g + 1] * inv); v0.y = pk_bf16(o0[4 * g + 2] * inv, o0[4 * g + 3] * inv);
      v1.x = pk_bf16(o1[4 * g] * inv, o1[4 * g + 1] * inv); v1.y = pk_bf16(o1[4 * g + 2] * inv, o1[4 * g + 3] * inv);
      *(u32x2*)(op + 8 * g) = v0;
      *(u32x2*)(op + 32 + 8 * g) = v1;
    }
  }
}

__device__ void ph_rwkv_mix(KP p, int layer) {
  const int j = layer >> 1;
  const int tid = opaque_tid();
  const int lane = tid & 63, wave = tid >> 6;
  const float* mu = p->rwkv_mu + j * 6 * 512;
  const int c0 = lane * 8;
  auto unpack = [](const u32x4 u, float (&f)[8]) {
    f[0] = bflo(u.x); f[1] = bfhi(u.x); f[2] = bflo(u.y); f[3] = bfhi(u.y);
    f[4] = bflo(u.z); f[5] = bfhi(u.z); f[6] = bflo(u.w); f[7] = bfhi(u.w);
  };
  auto pack = [](const float (&f)[8]) {
    u32x4 o;
    o.x = pk_bf16(f[0], f[1]); o.y = pk_bf16(f[2], f[3]); o.z = pk_bf16(f[4], f[5]); o.w = pk_bf16(f[6], f[7]);
    return o;
  };
  for (int t = blockIdx.x * 4 + wave; t < NT; t += gridDim.x * 4) {
    bool hasp, hasn;
    if (t < NL) { int s = t & 2047; hasp = s > 0; hasn = s < SEQ - 1; }
    else { int s = (t - NL) & 255; hasp = s > 0; hasn = s < CTXL - 1; }
    const bf16_t* pt = p->P + (size_t)t * LDP + c0;
    bf16_t* rw = p->RW + (size_t)t * RWS + c0;
    bf16_t* zb = p->Zb + (size_t)t * 1536 + c0;
    const u32x4 zero = {0u, 0u, 0u, 0u};
#pragma unroll
    for (int q = 0; q < 4; ++q) {
      float cur[8], pv[8], nx[8], d[8];
      unpack(*(const u32x4*)(pt + q * 512), cur);
      unpack(hasp ? *(const u32x4*)(pt + q * 512 - LDP) : zero, pv);
      unpack(hasn ? *(const u32x4*)(pt + q * 512 + LDP) : zero, nx);
#pragma unroll
      for (int e = 0; e < 8; ++e) d[e] = 0.5f * (pv[e] + nx[e]) - cur[e];
      if (q < 3) {
        float o[8];
        const float* m = mu + q * 512 + c0;
#pragma unroll
        for (int e = 0; e < 8; ++e) o[e] = cur[e] + d[e] * m[e];
        if (q == 0) *(u32x4*)(rw) = pack(o);
        else if (q == 2) *(u32x4*)(rw + 512) = pack(o);
        else {
          *(u32x4*)(rw + 10 * 512) = pack(o);
          float kk[8], ss = 0.f;
          const float* kv0 = p->rwkv_kvec + (j * 2 + 0) * 512 + c0;
#pragma unroll
          for (int e = 0; e < 8; ++e) { kk[e] = o[e] * kv0[e]; ss += kk[e] * kk[e]; }
          ss += dppx<0xB1>(ss); ss += dppx<0x4E>(ss); ss += dppx<0x141>(ss);
          const float rn = rsqrtf(fmaxf(ss, 1e-24f));
#pragma unroll
          for (int e = 0; e < 8; ++e) kk[e] *= rn;
          *(u32x4*)(rw + 2 * 512) = pack(kk);
        }
      } else {
#pragma unroll
        for (int z = 0; z < 3; ++z) {
          float o[8];
          const float* m = mu + (3 + z) * 512 + c0;
#pragma unroll
          for (int e = 0; e < 8; ++e) o[e] = cur[e] + d[e] * m[e];
          *(u32x4*)(zb + z * 512) = pack(o);
        }
      }
    }
  }
}

constexpr int RS_STEP = 384;
constexpr int RS_TB = 16;
struct RwkvStage { u32x2 r, kk, e, ke, a, v; };
__device__ void rwkv_unit(KP p, int unit, float* sm, int tid) {
  const int ch = unit >> 1, hf = unit & 1;
  const int dir = ch >> 6, b = (ch >> 3) & 7, h = ch & 7;
  const int lane = tid & 63, w = tid >> 6, rl = lane >> 3, ks = lane & 7;
  float* ybuf = sm + 2 * RS_TB * RS_STEP;
  const int ss = tid >> 4, kq = tid & 15;
  auto gload = [&](int n, RwkvStage& g) {
    const int row = scan_row(dir, b, n * RS_TB + ss);
    const bf16_t* base = p->RW + (size_t)row * RWS + h * 64 + kq * 4;
    g.r = *(const u32x2*)(base);
    g.kk = *(const u32x2*)(base + 2 * 512);
    g.e = *(const u32x2*)(base + (3 + dir) * 512);
    g.ke = *(const u32x2*)(base + (5 + dir) * 512);
    g.a = *(const u32x2*)(base + (7 + dir) * 512);
    g.v = *(const u32x2*)(p->RW + (size_t)row * RWS + 512 + h * 64 + hf * 32 + (kq & 7) * 4);
  };
  auto swrite = [&](int buf, const RwkvStage& g) {
    float* sp = sm + (buf * RS_TB + ss) * RS_STEP;
    const float r0 = bflo(g.r.x), r1 = bfhi(g.r.x), r2 = bflo(g.r.y), r3 = bfhi(g.r.y);
    const float k0 = bflo(g.kk.x), k1 = bfhi(g.kk.x), k2 = bflo(g.kk.y), k3 = bfhi(g.kk.y);
    const float w0 = __expf(-bflo(g.e.x)), w1 = __expf(-bfhi(g.e.x)), w2 = __expf(-bflo(g.e.y)), w3 = __expf(-bfhi(g.e.y));
    const float e0 = bflo(g.ke.x), e1 = bfhi(g.ke.x), e2 = bflo(g.ke.y), e3 = bfhi(g.ke.y);
    const float a0 = k0 * bflo(g.a.x), a1 = k1 * bfhi(g.a.x), a2 = k2 * bflo(g.a.y), a3 = k3 * bfhi(g.a.y);
    *(float4*)(sp + kq * 4) = make_float4(k0, k1, k2, k3);
    *(float4*)(sp + 64 + kq * 4) = make_float4(w0 * r0, w1 * r1, w2 * r2, w3 * r3);
    *(float4*)(sp + 128 + kq * 4) = make_float4(w0, w1, w2, w3);
    *(float4*)(sp + 192 + kq * 4) = make_float4(a0, a1, a2, a3);
    *(float4*)(sp + 256 + kq * 4) = make_float4(e0, e1, e2, e3);
    if (kq < 8) *(float4*)(sp + 320 + kq * 4) = make_float4(bflo(g.v.x), bfhi(g.v.x), bflo(g.v.y), bfhi(g.v.y));
    float c1 = a0 * r0 + a1 * r1 + a2 * r2 + a3 * r3;
    float c2 = e0 * r0 + e1 * r1 + e2 * r2 + e3 * r3;
    c1 += dppx<0xB1>(c1); c2 += dppx<0xB1>(c2);
    c1 += dppx<0x4E>(c1); c2 += dppx<0x4E>(c2);
    c1 += dppx<0x141>(c1); c2 += dppx<0x141>(c2);
    c1 += dppx<0x140>(c1); c2 += dppx<0x140>(c2);
    if (kq == 0) { sp[352] = c1; sp[353] = c2; }
  };
  typedef float f2 __attribute__((ext_vector_type(2)));
  f2 S01 = {0.f, 0.f}, S23 = {0.f, 0.f}, S45 = {0.f, 0.f}, S67 = {0.f, 0.f};
  auto compute = [&](int n) {
    const float* bp = sm + (n & 1) * RS_TB * RS_STEP;
    float* yb = ybuf + (n & 1) * RS_TB * 32 + w * 8 + rl;
    struct Ops { f2 k[4], r[4], w[4], a[4], e[4]; float vv; f2 c; };
    auto ld = [&](int s, Ops& o) {
      const float* sq = bp + s * RS_STEP;
      const f2* sp = (const f2*)(sq + ks * 8);
#pragma unroll
      for (int i = 0; i < 4; ++i) { o.k[i] = sp[i]; o.r[i] = sp[32 + i]; o.w[i] = sp[64 + i]; o.a[i] = sp[96 + i]; o.e[i] = sp[128 + i]; }
      o.vv = sq[320 + w * 8 + rl]; o.c = *(const f2*)(sq + 352);
    };
    auto step = [&](const Ops& o) -> float {
      f2 sa2 = S01 * o.k[0];
      f2 y2 = S01 * o.r[0];
      sa2 = __builtin_elementwise_fma(S23, o.k[1], sa2); y2 = __builtin_elementwise_fma(S23, o.r[1], y2);
      sa2 = __builtin_elementwise_fma(S45, o.k[2], sa2); y2 = __builtin_elementwise_fma(S45, o.r[2], y2);
      sa2 = __builtin_elementwise_fma(S67, o.k[3], sa2); y2 = __builtin_elementwise_fma(S67, o.r[3], y2);
      float sa = sa2.x + sa2.y, y0 = y2.x + y2.y;
      sa += dppx<0xB1>(sa); y0 += dppx<0xB1>(y0);
      sa += dppx<0x4E>(sa); y0 += dppx<0x4E>(y0);
      sa += dppx<0x141>(sa); y0 += dppx<0x141>(y0);
      sa = -sa;
      const f2 sav = {sa, sa}, vvv = {o.vv, o.vv};
      S01 = __builtin_elementwise_fma(vvv, o.e[0], __builtin_elementwise_fma(sav, o.a[0], S01 * o.w[0]));
      S23 = __builtin_elementwise_fma(vvv, o.e[1], __builtin_elementwise_fma(sav, o.a[1], S23 * o.w[1]));
      S45 = __builtin_elementwise_fma(vvv, o.e[2], __builtin_elementwise_fma(sav, o.a[2], S45 * o.w[2]));
      S67 = __builtin_elementwise_fma(vvv, o.e[3], __builtin_elementwise_fma(sav, o.a[3], S67 * o.w[3]));
      return fmaf(o.vv, o.c.y, fmaf(sa, o.c.x, y0));
    };
    Ops oa, ob;
    ld(0, oa);
#pragma unroll 1
    for (int s = 0; s < RS_TB; s += 2) {
      ld(s + 1, ob);
      const float ya = step(oa);
      ld(s + 2, oa);
      const float yb2 = step(ob);
      if (ks == 0) { yb[s * 32] = ya; yb[(s + 1) * 32] = yb2; }
    }
  };
  auto yout = [&](int n) {
    const int row = scan_row(dir, b, n * RS_TB + ss);
    const float* ys = ybuf + (n & 1) * RS_TB * 32 + ss * 32 + kq * 2;
    *(unsigned*)(p->P + (size_t)row * LDP + dir * 512 + h * 64 + hf * 32 + kq * 2) = pk_bf16(ys[0], ys[1]);
  };
  constexpr int NB = TSC / RS_TB;
  RwkvStage gA, gB;
  gload(0, gA);
  gload(1, gB);
  swrite(0, gA);
  gload(2, gA);
  __syncthreads();
  for (int n = 0; n < NB; n += 2) {
    compute(n);
    swrite(1, gB);
    if (n + 3 < NB) gload(n + 3, gB);
    __syncthreads();
    yout(n);
    compute(n + 1);
    if (n + 2 < NB) swrite(0, gA);
    if (n + 4 < NB) gload(n + 4, gA);
    __syncthreads();
    yout(n + 1);
  }
  __syncthreads();
}

__device__ void mlstm_s1(KP p, int layer, int tile, char* lds, int tid) {
  const int j = layer >> 1;
  const int ch = tile / NCHUNK, c = tile % NCHUNK;
  const int dir = ch >> 5, b = (ch >> 2) & 7, h = ch & 3;
  float* s_ws = (float*)(lds + META_OFF);
  int* s_row = (int*)(s_ws + 64);
  char* kimg = lds;
  char* vimg = lds + 16384;
  if (tid < 64) {
    const int row = scan_row(dir, b, c * 64 + tid);
    s_row[tid] = row;
    const float* g = p->GP + (size_t)row * 16;
    const float gi = g[(dir * 2) * 4 + h] + p->mlstm_gate_b[j * 16 + (dir * 2) * 4 + h];
    const float gf = g[(dir * 2 + 1) * 4 + h] + p->mlstm_gate_b[j * 16 + (dir * 2 + 1) * 4 + h];
    float bc = -softplus_f(-gf);
#pragma unroll
    for (int o = 1; o < 64; o <<= 1) {
      float tmp = __shfl_up(bc, o);
      if (tid >= o) bc += tmp;
    }
    const float bend = __shfl(bc, 63);
    const float ds = bend - bc + gi;
    const float mloc = wmax(ds);
    s_ws[tid] = expf(ds - mloc);
    if (tid == 0) { p->msc[tile] = mloc; p->msc[NMT + tile] = bend; }
  }
  __syncthreads();
  {
    const int c8 = tid & 15;
    const int ioff = (c8 >> 2) * 4096 + (c8 & 3) * 16;
#pragma unroll
    for (int i = 0; i < 4; ++i) {
      const int sidx = (tid >> 4) + 16 * i;
      const bf16_t* src = p->P + (size_t)s_row[sidx] * LDP + h * 128 + c8 * 8;
      const u32x4 kv = *(const u32x4*)(src + 2560);
      u32x4 vv = *(const u32x4*)(src + 3072);
      const float wsv = s_ws[sidx];
      vv.x = pk_bf16(bflo(vv.x) * wsv, bfhi(vv.x) * wsv); vv.y = pk_bf16(bflo(vv.y) * wsv, bfhi(vv.y) * wsv);
      vv.z = pk_bf16(bflo(vv.z) * wsv, bfhi(vv.z) * wsv); vv.w = pk_bf16(bflo(vv.w) * wsv, bfhi(vv.w) * wsv);
      *(u32x4*)(kimg + ioff + sidx * 64) = kv;
      *(u32x4*)(vimg + ioff + sidx * 64) = vv;
    }
  }
  __syncthreads();
  const int lane = tid & 63, w = tid >> 6, wm = w >> 1, wn = w & 1, r32 = lane & 31, hi = lane >> 5;
  f32x16 acc[2][2];
#pragma unroll
  for (int mi = 0; mi < 2; ++mi)
#pragma unroll
    for (int ni = 0; ni < 2; ++ni)
#pragma unroll
      for (int q = 0; q < 16; ++q) acc[mi][ni][q] = 0.f;
  const int toff = ((lane >> 4) & 1) * 32 + (lane & 3) * 8 + ((lane & 15) >> 2) * 64 + hi * 256;
#pragma unroll
  for (int ks = 0; ks < 4; ++ks) {
    bf16x8 af[2], bfr[2];
#pragma unroll
    for (int i = 0; i < 2; ++i) {
      const char* ka = kimg + (wm * 2 + i) * 4096 + toff + (16 * ks) * 64;
      const char* va = vimg + (wn * 2 + i) * 4096 + toff + (16 * ks) * 64;
      af[i] = __builtin_shufflevector(vtr(ka), vtr(ka + 8 * 64), 0, 1, 2, 3, 4, 5, 6, 7);
      bfr[i] = __builtin_shufflevector(vtr(va), vtr(va + 8 * 64), 0, 1, 2, 3, 4, 5, 6, 7);
    }
    acc[0][0] = MFMA32(af[0], bfr[0], acc[0][0]);
    acc[0][1] = MFMA32(af[0], bfr[1], acc[0][1]);
    acc[1][0] = MFMA32(af[1], bfr[0], acc[1][0]);
    acc[1][1] = MFMA32(af[1], bfr[1], acc[1][1]);
  }
  bf16_t* U = p->MS + (size_t)tile * 16384;
#pragma unroll
  for (int mi = 0; mi < 2; ++mi)
#pragma unroll
    for (int ni = 0; ni < 2; ++ni)
#pragma unroll
      for (int q = 0; q < 16; ++q) {
        const int d = wm * 64 + mi * 32 + (q & 3) + 8 * (q >> 2) + 4 * hi;
        U[d * 128 + wn * 64 + ni * 32 + r32] = f2bf(acc[mi][ni][q]);
        if ((q & 3) == 3) __builtin_amdgcn_sched_barrier(0);
      }
  if (tid < 128) {
    const char* kc = kimg + (tid >> 5) * 4096 + (tid & 31) * 2;
    float a = 0.f;
#pragma unroll 8
    for (int sidx = 0; sidx < 64; ++sidx) a = fmaf(s_ws[sidx], bf2f(*(const bf16_t*)(kc + sidx * 64)), a);
    p->MSn[tile * 128 + tid] = a;
  }
}

__device__ void ph_scan_a(KP p, int layer, char* smc) {
  float* sm = (float*)smc;
  const int tid = opaque_tid();
  for (int u = blockIdx.x; u < 256; u += gridDim.x) rwkv_unit(p, u, sm, tid);
  const int nblk = gridDim.x, bid = blockIdx.x;
  const int start = (bid + nblk - (256 % nblk)) % nblk;
  for (int tile = start; tile < NMT; tile += nblk) { mlstm_s1(p, layer, tile, smc, tid); __syncthreads(); }
}

__device__ void ph_mlstm_s2(KP p, char* smc) {
  float* sw = (float*)smc;
  const int tid = opaque_tid();
  const int nitems = 64 * 33;
  for (int item = blockIdx.x; item < nitems; item += gridDim.x) {
    const int ch = item / 33, seg = item % 33;
    __syncthreads();
    if (tid == 0) {
      float m = 0.f;
      for (int c = 0; c < NCHUNK; ++c) {
        const int tile = ch * NCHUNK + c;
        const float mloc = p->msc[tile], bend = p->msc[NMT + tile];
        const float mn = fmaxf(bend + m, mloc);
        sw[c] = expf(bend + m - mn);
        sw[36 + c] = expf(mloc - mn);
        if (seg == 0) p->msc[2 * NMT + tile] = m;
        m = mn;
      }
    }
    __syncthreads();
    if (seg < 32) {
      unsigned* base = (unsigned*)(p->MS + (size_t)ch * NCHUNK * 16384) + seg * 256 + tid;
      unsigned v[NCHUNK];
#pragma unroll
      for (int c = 0; c < NCHUNK; ++c) v[c] = base[(size_t)c * 8192];
      float C0 = 0.f, C1 = 0.f;
#pragma unroll
      for (int c = 0; c < NCHUNK; ++c) {
        const float t0 = bflo(v[c]), t1 = bfhi(v[c]);
        v[c] = pk_bf16(C0, C1);
        C0 = sw[c] * C0 + sw[36 + c] * t0;
        C1 = sw[c] * C1 + sw[36 + c] * t1;
      }
#pragma unroll
      for (int c = 0; c < NCHUNK; ++c) base[(size_t)c * 8192] = v[c];
    } else if (tid < 128) {
      float* base = p->MSn + (size_t)ch * NCHUNK * 128 + tid;
      float v[NCHUNK];
#pragma unroll
      for (int c = 0; c < NCHUNK; ++c) v[c] = base[c * 128];
      float C = 0.f;
#pragma unroll
      for (int c = 0; c < NCHUNK; ++c) {
        const float t0 = v[c];
        v[c] = C;
        C = sw[c] * C + sw[36 + c] * t0;
      }
#pragma unroll
      for (int c = 0; c < NCHUNK; ++c) base[c * 128] = v[c];
    }
  }
}

__device__ void mlstm_s3(KP p, int layer, int tile, char* lds, int tid) {
  const int j = layer >> 1;
  const int ch = tile / NCHUNK, c = tile % NCHUNK;
  const int dir = ch >> 5, b = (ch >> 2) & 7, h = ch & 3;
  float* s_b = (float*)(lds + META_OFF);
  float* s_ig = s_b + 64;
  float* s_mt = s_b + 128;
  float* s_wi = s_b + 192;
  int* s_row = (int*)(s_b + 256);
  float* s_n = s_b + 320;
  float* s_c = s_b + 448;
  char* kimg = lds;
  char* vimg = lds + 16384;
  char* cimg = lds + 32768;
  const float mprev = p->msc[2 * NMT + tile];
  const float qscale = 0.08838834764831845f;
  if (tid < 64) {
    const int row = scan_row(dir, b, c * 64 + tid);
    s_row[tid] = row;
    const float* g = p->GP + (size_t)row * 16;
    const float gi = g[(dir * 2) * 4 + h] + p->mlstm_gate_b[j * 16 + (dir * 2) * 4 + h];
    const float gf = g[(dir * 2 + 1) * 4 + h] + p->mlstm_gate_b[j * 16 + (dir * 2 + 1) * 4 + h];
    float bc = -softplus_f(-gf);
#pragma unroll
    for (int o = 1; o < 64; o <<= 1) {
      float tmp = __shfl_up(bc, o);
      if (tid >= o) bc += tmp;
    }
    s_b[tid] = bc;
    s_ig[tid] = gi;
  } else if (tid < 192) s_n[tid - 64] = p->MSn[tile * 128 + (tid - 64)];
  __syncthreads();
  if (tid < 64) {
    const float bt = s_b[tid];
    float mt = bt + mprev;
    for (int sx = 0; sx <= tid; ++sx) mt = fmaxf(mt, bt - s_b[sx] + s_ig[sx]);
    s_mt[tid] = mt;
    s_wi[tid] = expf(bt + mprev - mt);
    s_c[tid] = (s_ig[tid] - bt) * 1.4426950408889634f;
  }
  {
    const int c8 = tid & 15;
    const int ioff = (c8 >> 2) * 4096 + (c8 & 3) * 16;
#pragma unroll
    for (int i = 0; i < 4; ++i) {
      const int sidx = (tid >> 4) + 16 * i;
      const bf16_t* src = p->P + (size_t)s_row[sidx] * LDP + h * 128 + c8 * 8;
      *(u32x4*)(kimg + sidx * 256 + ((c8 ^ (sidx & 15)) * 16)) = *(const u32x4*)(src + 2560);
      *(u32x4*)(vimg + ioff + sidx * 64) = *(const u32x4*)(src + 3072);
    }
    __builtin_amdgcn_sched_barrier(0);
    const bf16_t* Cp = p->MS + (size_t)tile * 16384;
    const int coff = (c8 >> 2) * 8192 + (c8 & 3) * 16;
#pragma unroll
    for (int i = 0; i < 8; ++i) {
      const int d = (tid >> 4) + 16 * i;
      *(u32x4*)(cimg + coff + d * 64) = *(const u32x4*)(Cp + d * 128 + c8 * 8);
      if (i == 3) __builtin_amdgcn_sched_barrier(0);
    }
    __builtin_amdgcn_sched_barrier(0);
  }
  const int lane = tid & 63, w = tid >> 6, wt = w >> 1, wv = w & 1, r32 = lane & 31, hi = lane >> 5;
  const int t = wt * 32 + r32;
  bf16x8 qf[8];
  {
    const bf16_t* qp = p->P + (size_t)s_row[t] * LDP + 2048 + h * 128 + hi * 8;
#pragma unroll
    for (int d0 = 0; d0 < 8; ++d0) qf[d0] = *(const bf16x8*)(qp + d0 * 16);
  }
  __syncthreads();
  const int toff = ((lane >> 4) & 1) * 32 + (lane & 3) * 8 + ((lane & 15) >> 2) * 64;
  constexpr float LOG2E_ = 1.4426950408889634f;
  float qn = 0.f;
#pragma unroll
  for (int d0 = 0; d0 < 8; ++d0) {
    const u32x4 qq = __builtin_bit_cast(u32x4, qf[d0]);
    const float* np = s_n + d0 * 16 + hi * 8;
    qn = fmaf(bflo(qq.x), np[0], qn); qn = fmaf(bfhi(qq.x), np[1], qn);
    qn = fmaf(bflo(qq.y), np[2], qn); qn = fmaf(bfhi(qq.y), np[3], qn);
    qn = fmaf(bflo(qq.z), np[4], qn); qn = fmaf(bfhi(qq.z), np[5], qn);
    qn = fmaf(bflo(qq.w), np[6], qn); qn = fmaf(bfhi(qq.w), np[7], qn);
  }
  qn += __shfl_xor(qn, 32);
  const float mtt = s_mt[t], wi = s_wi[t];
  const float ct = (s_b[t] - mtt) * LOG2E_;
  const float wq = wi * qscale;
  bf16x8 pf[4];
  float den = 0.f;
  {
    f32x16 sa0, sa1;
#pragma unroll
    for (int q = 0; q < 16; ++q) { sa0[q] = 0.f; sa1[q] = 0.f; }
#pragma unroll
    for (int d0 = 0; d0 < 8; ++d0) {
      const int chn = 2 * d0 + hi;
      const bf16x8 k0 = *(const bf16x8*)(kimg + r32 * 256 + ((chn ^ (r32 & 15)) * 16));
      sa0 = MFMA32(k0, qf[d0], sa0);
      if (wt) {
        const bf16x8 k1 = *(const bf16x8*)(kimg + (32 + r32) * 256 + ((chn ^ (r32 & 15)) * 16));
        sa1 = MFMA32(k1, qf[d0], sa1);
      }
      __builtin_amdgcn_sched_barrier(0);
    }
#pragma unroll
    for (int g = 0; g < 4; ++g) {
      const int sb0 = 8 * g + 4 * hi;
      const float4 c0v = *(const float4*)(s_c + sb0);
      const float4 c1v = *(const float4*)(s_c + sb0 + 32);
      const float cc0[4] = {c0v.x, c0v.y, c0v.z, c0v.w}, cc1[4] = {c1v.x, c1v.y, c1v.z, c1v.w};
#pragma unroll
      for (int e = 0; e < 4; ++e) {
        const int q = 4 * g + e;
        const float v0 = (sb0 + e <= t) ? sa0[q] * qscale * __builtin_amdgcn_exp2f(ct + cc0[e]) : 0.f;
        sa0[q] = v0; den += v0;
        const float v1 = (wt && sb0 + 32 + e <= t) ? sa1[q] * qscale * __builtin_amdgcn_exp2f(ct + cc1[e]) : 0.f;
        sa1[q] = v1; den += v1;
      }
      __builtin_amdgcn_sched_barrier(0);
    }
#pragma unroll
    for (int sx = 0; sx < 4; ++sx) {
      const int u = (sx & 1) * 8;
      u32x4 tpk;
      if (sx < 2) {
        tpk.x = pk_bf16(sa0[u + 0], sa0[u + 1]); tpk.y = pk_bf16(sa0[u + 2], sa0[u + 3]);
        tpk.z = pk_bf16(sa0[u + 4], sa0[u + 5]); tpk.w = pk_bf16(sa0[u + 6], sa0[u + 7]);
      } else {
        tpk.x = pk_bf16(sa1[u + 0], sa1[u + 1]); tpk.y = pk_bf16(sa1[u + 2], sa1[u + 3]);
        tpk.z = pk_bf16(sa1[u + 4], sa1[u + 5]); tpk.w = pk_bf16(sa1[u + 6], sa1[u + 7]);
      }
      pf[sx] = __builtin_bit_cast(bf16x8, tpk);
    }
  }
  den += __shfl_xor(den, 32);
  const float dtot = den + wq * qn;
  const float inv = 1.f / fmaxf(fabsf(dtot), expf(-mtt));
  bf16_t* op = p->P + (size_t)s_row[t] * LDP + 1024 + dir * 512 + h * 128 + wv * 64 + 4 * hi;
#pragma unroll 1
  for (int vp = 0; vp < 2; ++vp) {
    f32x16 o0;
#pragma unroll
    for (int q = 0; q < 16; ++q) o0[q] = 0.f;
    const char* cb = cimg + (wv * 2 + vp) * 8192 + toff + hi * 512;
#pragma unroll
    for (int d0 = 0; d0 < 8; ++d0) {
      const bf16x8 A0 = __builtin_shufflevector(vtr(cb + (16 * d0) * 64), vtr(cb + (16 * d0 + 4) * 64), 0, 1, 2, 3, 4, 5, 6, 7);
      o0 = MFMA32(A0, qf[d0], o0);
    }
#pragma unroll
    for (int q = 0; q < 16; ++q) o0[q] *= wq;
    const char* vb = vimg + (wv * 2 + vp) * 4096 + toff + hi * 256;
#pragma unroll
    for (int sx = 0; sx < 4; ++sx) {
      if (sx < 2 || wt) {
        const bf16x8 A0 = __builtin_shufflevector(vtr(vb + (16 * sx) * 64), vtr(vb + (16 * sx + 8) * 64), 0, 1, 2, 3, 4, 5, 6, 7);
        o0 = MFMA32(A0, pf[sx], o0);
      }
    }
#pragma unroll
    for (int g = 0; g < 4; ++g) {
      u32x2 v0;
      v0.x = pk_bf16(o0[4 * g] * inv, o0[4 * g + 1] * inv); v0.y = pk_bf16(o0[4 * g + 2] * inv, o0[4 * g + 3] * inv);
      *(u32x2*)(op + vp * 32 + 8 * g) = v0;
    }
  }
}

__device__ void ph_mlstm_s3(KP p, int layer, char* smc) {
  const int tid = opaque_tid();
  for (int tile = blockIdx.x; tile < NMT; tile += gridDim.x) { mlstm_s3(p, layer, tile, smc, tid); __syncthreads(); }
}

__device__ void ph_rec_final(KP p, int layer, bool keep) {
  const int tid = opaque_tid();
  const int j = layer >> 1;
  const int lane = tid & 63, wave = tid >> 6;
  const int rows = keep ? NT : NL;
  const int c0 = lane * 8;
  auto unpack = [](const u32x4 u, float (&f)[8]) {
    f[0] = bflo(u.x); f[1] = bfhi(u.x); f[2] = bflo(u.y); f[3] = bfhi(u.y);
    f[4] = bflo(u.z); f[5] = bfhi(u.z); f[6] = bflo(u.w); f[7] = bfhi(u.w);
  };
  for (int t = blockIdx.x * 4 + wave; t < rows; t += gridDim.x * 4) {
    const bf16_t* rw = p->RW + (size_t)t * RWS + c0;
    const bf16_t* pt = p->P + (size_t)t * LDP + c0;
    bf16_t* mo = p->AB + (size_t)t * DM + c0;
    {
      float yf[8], yb[8], r[8], v[8], k0[8], k1[8], g[8], y[8], o[8];
      unpack(*(const u32x4*)(pt), yf); unpack(*(const u32x4*)(pt + 512), yb);
      unpack(*(const u32x4*)(rw), r); unpack(*(const u32x4*)(rw + 512), v);
      unpack(*(const u32x4*)(rw + 5 * 512), k0); unpack(*(const u32x4*)(rw + 6 * 512), k1);
      unpack(*(const u32x4*)(rw + 9 * 512), g);
      float s1 = 0.f, bs = 0.f;
      const float* rk = p->rwkv_rk + j * 512 + c0;
#pragma unroll
      for (int e = 0; e < 8; ++e) { y[e] = yf[e] + yb[e]; s1 += y[e]; bs += r[e] * rk[e] * (k0[e] + k1[e]); }
      s1 += dppx<0xB1>(s1); s1 += dppx<0x4E>(s1); s1 += dppx<0x141>(s1);
      bs += dppx<0xB1>(bs); bs += dppx<0x4E>(bs); bs += dppx<0x141>(bs);
      const float mu = s1 * (1.f / 64.f);
      float s2 = 0.f;
#pragma unroll
      for (int e = 0; e < 8; ++e) { const float d = y[e] - mu; s2 += d * d; }
      s2 += dppx<0xB1>(s2); s2 += dppx<0x4E>(s2); s2 += dppx<0x141>(s2);
      const float rs = rsqrtf(s2 * (1.f / 64.f) + 64e-5f);
      const float* gn0 = p->rwkv_gn + (j * 2 + 0) * 512 + c0;
      const float* gn1 = p->rwkv_gn + (j * 2 + 1) * 512 + c0;
#pragma unroll
      for (int e = 0; e < 8; ++e) o[e] = ((y[e] - mu) * rs * gn0[e] + gn1[e] + bs * v[e]) * g[e];
      u32x4 ov;
      ov.x = pk_bf16(o[0], o[1]); ov.y = pk_bf16(o[2], o[3]); ov.z = pk_bf16(o[4], o[5]); ov.w = pk_bf16(o[6], o[7]);
      *(u32x4*)(mo) = ov;
    }
    {
      float hf[8], hb[8], og[8], hsum[8], o[8];
      unpack(*(const u32x4*)(pt + 1024), hf); unpack(*(const u32x4*)(pt + 1536), hb);
      unpack(*(const u32x4*)(pt + 3584), og);
      float ss = 0.f;
#pragma unroll
      for (int e = 0; e < 8; ++e) { hsum[e] = hf[e] + hb[e]; ss += hsum[e] * hsum[e]; }
      ss += dppx<0xB1>(ss); ss += dppx<0x4E>(ss); ss += dppx<0x141>(ss); ss += dppx<0x140>(ss);
      const float rs = rsqrtf(ss * (1.f / 128.f) + 1e-6f);
      const float* ng = p->mlstm_norm + j * 512 + c0;
#pragma unroll
      for (int e = 0; e < 8; ++e) o[e] = hsum[e] * rs * ng[e] * sigm_f(og[e]);
      u32x4 ov;
      ov.x = pk_bf16(o[0], o[1]); ov.y = pk_bf16(o[2], o[3]); ov.z = pk_bf16(o[4], o[5]); ov.w = pk_bf16(o[6], o[7]);
      *(u32x4*)(mo + 512) = ov;
    }
  }
}

using f32x4v = __attribute__((ext_vector_type(4))) float;
__device__ void ph_ln_router(KP p, int layer, bool keep, char* smc) {
  float* h2s = (float*)smc;
  float* lgs = (float*)smc;
  const int tid = opaque_tid();
  const int lane = tid & 63, wave = tid >> 6;
  const int rows = keep ? NT : NL;
  const float* lng = p->ln_g + (layer * 2 + 0) * 1024;
  const float* lnb = p->ln_b + (layer * 2 + 0) * 1024;
  const float* Wr = p->moe_router + (size_t)layer * 1024 * 64;
  for (int tile = blockIdx.x; tile < rows / 16; tile += gridDim.x) {
    const int t0 = tile * 16;
    const float* mod = p->MOD + (layer * 9 + modrow(t0)) * 6144;
#pragma unroll 1
    for (int q = 0; q < 4; ++q) {
      const int tl = wave * 4 + q, t = t0 + tl;
      float4 v[4];
      float s = 0.f;
#pragma unroll
      for (int i = 0; i < 4; ++i) {
        v[i] = *(const float4*)(p->Tb + (size_t)t * DM + i * 256 + lane * 4);
        s += (v[i].x + v[i].y) + (v[i].z + v[i].w);
      }
      const float mean = wsum(s) * (1.f / 1024.f);
      float qq = 0.f;
#pragma unroll
      for (int i = 0; i < 4; ++i) {
        const float d0 = v[i].x - mean, d1 = v[i].y - mean, d2 = v[i].z - mean, d3 = v[i].w - mean;
        qq += (d0 * d0 + d1 * d1) + (d2 * d2 + d3 * d3);
      }
      const float rs = rsqrtf(wsum(qq) * (1.f / 1024.f) + 1e-5f);
#pragma unroll
      for (int i = 0; i < 4; ++i) {
        const int n = i * 256 + lane * 4;
        const float4 g = *(const float4*)(lng + n), bb = *(const float4*)(lnb + n);
        const float4 sc = *(const float4*)(mod + 4096 + n), sh = *(const float4*)(mod + 3072 + n);
        const float4 xn = make_float4((v[i].x - mean) * rs * g.x + bb.x, (v[i].y - mean) * rs * g.y + bb.y,
                                      (v[i].z - mean) * rs * g.z + bb.z, (v[i].w - mean) * rs * g.w + bb.w);
        *(float4*)(p->X + (size_t)t * DM + n) = xn;
        const float4 hh = make_float4(xn.x * (1.f + sc.x) + sh.x, xn.y * (1.f + sc.y) + sh.y,
                                      xn.z * (1.f + sc.z) + sh.z, xn.w * (1.f + sc.w) + sh.w);
        u32x2 o; o.x = pk_bf16(hh.x, hh.y); o.y = pk_bf16(hh.z, hh.w);
        *(u32x2*)(p->AB + (size_t)t * DM + n) = o;
        *(float4*)(h2s + tl * 1028 + n) = hh;
      }
    }
    __syncthreads();
    f32x4v acc = {0.f, 0.f, 0.f, 0.f};
    {
      f32x4v a1 = {0.f, 0.f, 0.f, 0.f}, a2 = {0.f, 0.f, 0.f, 0.f}, a3 = {0.f, 0.f, 0.f, 0.f};
      const int i = lane & 15, kk = lane >> 4;
      const float* arow = h2s + i * 1028 + 4 * kk;
      const float* bcol = Wr + (4 * kk) * 64 + 16 * wave + i;
#pragma unroll 4
      for (int q = 0; q < 64; ++q) {
        const float4 a = *(const float4*)(arow + 16 * q);
        const float b0 = bcol[(16 * q + 0) * 64], b1 = bcol[(16 * q + 1) * 64];
        const float b2 = bcol[(16 * q + 2) * 64], b3 = bcol[(16 * q + 3) * 64];
        acc = __builtin_amdgcn_mfma_f32_16x16x4f32(a.x, b0, acc, 0, 0, 0);
        a1 = __builtin_amdgcn_mfma_f32_16x16x4f32(a.y, b1, a1, 0, 0, 0);
        a2 = __builtin_amdgcn_mfma_f32_16x16x4f32(a.z, b2, a2, 0, 0, 0);
        a3 = __builtin_amdgcn_mfma_f32_16x16x4f32(a.w, b3, a3, 0, 0, 0);
      }
      acc = (acc + a1) + (a2 + a3);
    }
    __syncthreads();
#pragma unroll
    for (int r = 0; r < 4; ++r) lgs[((lane >> 4) * 4 + r) * 64 + 16 * wave + (lane & 15)] = acc[r];
    __syncthreads();
#pragma unroll 1
    for (int q = 0; q < 4; ++q) {
      const int tl = wave * 4 + q, t = t0 + tl;
      const float logit = lgs[tl * 64 + lane];
      const float score = sigm_f(logit);
      float sel = score + p->moe_bias[layer * 64 + lane];
      bool chosen = false;
      for (int r = 0; r < 6; ++r) {
        const float mx = wmax(sel);
        const unsigned long long bal = __ballot(sel == mx);
        const int first = __ffsll((long long)bal) - 1;
        if (lane == first) { chosen = true; sel = -INFINITY; }
      }
      const float gsum = wsum(chosen ? score : 0.f);
      const unsigned long long cb = __ballot(chosen);
      if (chosen) {
        const int kidx = __popcll(cb & ((1ull << lane) - 1ull));
        const int pos = atomicAdd(&p->cnt[lane], 1);
        p->ltok[(size_t)lane * NT + pos] = t;
        p->lgate[(size_t)lane * NT + pos] = score / gsum * 2.5f;
        p->tsl[t * 6 + kidx] = (lane << 16) | pos;
      }
    }
    __syncthreads();
  }
}

__device__ __forceinline__ void moe_prefix(KP p, int rows, int* s_pref, int tid) {
  if (tid == 0) {
    int a = 0;
    for (int e = 0; e < 64; ++e) { s_pref[e] = a; a += (p->cnt[e] + 127) >> 7; }
    s_pref[64] = a; a += rows >> 7;
    s_pref[65] = a;
  }
  __syncthreads();
}

__device__ void ph_gemm(KP p, int kind, int layer, bool keep, char* lds) {
  const int tid = opaque_tid();
  const int j = layer >> 1;
  const bool att = !(layer & 1);
  const int rows = keep ? NT : NL;
  int* pref = (int*)(lds + META_OFF);
  int* s_idx = pref + 66;
  float* s_gate = (float*)(s_idx + 128);
  if (kind == 1 && blockIdx.x == 0 && tid < 65) p->cnt[tid] = 0;
  if (kind == 2 || kind == 3) moe_prefix(p, rows, pref, tid);
  int total;
  const int ntn_in = att ? 18 : 33;
  switch (kind) {
    case 0: total = (NT / 128) * ntn_in; break;
    case 1: total = (rows / 128) * 8; break;
    case 2: total = pref[65] * 4; break;
    case 3: total = pref[65] * 8; break;
    case 4: total = (NT / 128) * 3; break;
    default: total = (NT / 128) * 20; break;
  }
  for (int tile = blockIdx.x; tile < total; tile += gridDim.x) {
    const bf16_t* Abase; const bf16_t* Bt;
    int astride, K, n0, m0 = 0, aux = 0, e = 0, mtile = 0;
    switch (kind) {
      case 0: { const int tm = tile / ntn_in, tn = tile % ntn_in; m0 = tm * 128; n0 = tn * 128;
                Abase = p->AB + (size_t)m0 * DM; astride = DM; K = 1024;
                Bt = att ? p->Wt_att + (size_t)j * ATT_N * 1024 : p->Wt_rec + (size_t)j * REC_NP * 1024; } break;
      case 1: { const int tm = tile >> 3, tn = tile & 7; m0 = tm * 128; n0 = tn * 128;
                Abase = p->AB + (size_t)m0 * DM; astride = DM; K = 1024; Bt = p->Wt_out + (size_t)layer * 1024 * 1024; } break;
      case 2: { mtile = tile >> 2; aux = tile & 3; n0 = aux * 128; while (mtile >= pref[e + 1]) ++e;
                Abase = p->AB; astride = DM; K = 1024; Bt = p->Wt13 + (size_t)(layer * 65 + e) * 512 * 1024; } break;
      case 3: { mtile = tile >> 3; aux = tile & 7; n0 = aux * 128; while (mtile >= pref[e + 1]) ++e;
                Abase = p->ACT + (size_t)mtile * 128 * 256; astride = 256; K = 256; Bt = p->Wt2 + (size_t)(layer * 65 + e) * 1024 * 256; } break;
      case 4: { const int tm = tile / 3; aux = tile % 3; m0 = tm * 128; n0 = 0;
                Abase = p->Zb + (size_t)m0 * 1536 + aux * 512; astride = 1536; K = 512; Bt = p->Wl1 + (size_t)(j * 3 + aux) * 128 * 512; } break;
      default: { const int tm = tile / 20; aux = tile % 20; m0 = tm * 128; n0 = aux * 128;
                const int grp = aux < 8 ? 0 : (aux < 16 ? 1 : 2);
                Abase = p->L1 + (size_t)m0 * 384 + grp * 128; astride = 384; K = 128; Bt = p->Wl2 + (size_t)j * 2560 * 128; } break;
    }
    if (tid < 128) {
      int idx = tid; float g = 1.f;
      if (kind == 2 || kind == 3) {
        const int pos = (mtile - pref[e]) * 128 + tid;
        if (kind == 2) {
          idx = 0;
          if (e < 64) { if (pos < p->cnt[e]) idx = p->ltok[(size_t)e * NT + pos]; }
          else idx = pos;
        } else if (e < 64) g = pos < p->cnt[e] ? p->lgate[(size_t)e * NT + pos] : 0.f;
      }
      s_idx[tid] = idx; s_gate[tid] = g;
    }
    __syncthreads();
    {
      f32x16 acc[2][2];
      gemm128_main(tid, [&](int r) { return Abase + (size_t)s_idx[r] * astride; }, Bt, K, n0, lds, acc);
      float* Ct = (float*)lds;
      acc_foreach(tid, acc, [&](int row, int col, float v) { Ct[row * 128 + col] = v; });
    }
    __syncthreads();
    {
      const float* Ct = (const float*)lds;
      const int c4 = (tid & 31) * 4, r0 = tid >> 5;
      const int N_in = att ? ATT_N : REC_N;
      const int d5 = (aux >> 2) & 1, c05 = (aux & 3) * 128;
#pragma unroll 2
      for (int it = 0; it < 16; ++it) {
        const int row = it * 8 + r0;
        const float4 v = *(const float4*)(Ct + row * 128 + c4);
        switch (kind) {
          case 0: {
            const int cn = n0 + c4;
            float4 vq = v;
            if (att && n0 >= 1536 && n0 < 2176) {
              float ss = v.x * v.x + v.y * v.y + v.z * v.z + v.w * v.w;
              ss += dppx<0xB1>(ss); ss += dppx<0x4E>(ss); ss += dppx<0x141>(ss); ss += dppx<0x140>(ss);
              const float rs = rsqrtf(ss * (1.f / 64.f) + 1e-6f);
              const float4 g = *(const float4*)(p->qk_gain + j * 128 + (n0 >= 2048 ? 64 : 0) + (cn & 63));
              vq = make_float4(v.x * rs * g.x, v.y * rs * g.y, v.z * rs * g.z, v.w * rs * g.w);
              const int t = m0 + row;
              if (t < NL) {
                const int sidx = t & 2047, pi0 = (cn & 63) >> 1;
                const int pos = pi0 < 16 ? (sidx >> 6) : (sidx & 63);
                const float4 cs = *(const float4*)(p->ROPE + (pos * 16 + (pi0 & 15)) * 2);
                vq = make_float4(vq.x * cs.x - vq.y * cs.y, vq.x * cs.y + vq.y * cs.x,
                                 vq.z * cs.z - vq.w * cs.w, vq.z * cs.w + vq.w * cs.z);
              }
            }
            if (cn < N_in) {
              u32x2 o; o.x = pk_bf16(vq.x, vq.y); o.y = pk_bf16(vq.z, vq.w);
              *(u32x2*)(p->P + (size_t)(m0 + row) * LDP + cn) = o;
            }
            if (!att && cn >= 4096 && cn < 4112) *(float4*)(p->GP + (size_t)(m0 + row) * 16 + (cn - 4096)) = v;
          } break;
          case 1: {
            const size_t o = (size_t)(m0 + row) * DM + n0 + c4;
            const float4 xv = *(const float4*)(p->X + o);
            const float4 g = *(const float4*)(p->MOD + (layer * 9 + modrow(m0)) * 6144 + 2048 + n0 + c4);
            *(float4*)(p->Tb + o) = make_float4(DN_ALPHA * xv.x + g.x * v.x, DN_ALPHA * xv.y + g.y * v.y,
                                                DN_ALPHA * xv.z + g.z * v.z, DN_ALPHA * xv.w + g.w * v.w);
          } break;
          case 2: {
            if (((c4 >> 5) & 1) == 0) {
              const float4 u = *(const float4*)(Ct + row * 128 + c4 + 32);
              u32x2 o;
              o.x = pk_bf16(silu_f(v.x) * u.x, silu_f(v.y) * u.y);
              o.y = pk_bf16(silu_f(v.z) * u.z, silu_f(v.w) * u.w);
              *(u32x2*)(p->ACT + ((size_t)mtile * 128 + row) * 256 + aux * 64 + (c4 >> 6) * 32 + (c4 & 31)) = o;
            }
          } break;
          case 3: {
            const float g = s_gate[row];
            u32x2 o; o.x = pk_bf16(g * v.x, g * v.y); o.y = pk_bf16(g * v.z, g * v.w);
            *(u32x2*)(p->OUT2 + ((size_t)mtile * 128 + row) * 1024 + n0 + c4) = o;
          } break;
          case 4: {
            float4 o4 = v;
            if (aux == 0) o4 = make_float4(tanhf(v.x), tanhf(v.y), tanhf(v.z), tanhf(v.w));
            else if (aux == 2) o4 = make_float4(sigm_f(v.x), sigm_f(v.y), sigm_f(v.z), sigm_f(v.w));
            u32x2 o; o.x = pk_bf16(o4.x, o4.y); o.y = pk_bf16(o4.z, o4.w);
            *(u32x2*)(p->L1 + (size_t)(m0 + row) * 384 + aux * 128 + c4) = o;
          } break;
          default: {
            bf16_t* rr = p->RW + (size_t)(m0 + row) * RWS + c05 + c4;
            const float vv[4] = {v.x, v.y, v.z, v.w};
            if (aux < 8) {
              const float4 b0 = *(const float4*)(p->rwkv_w0 + (j * 2 + d5) * 512 + c05 + c4);
              const float bb[4] = {b0.x, b0.y, b0.z, b0.w};
              float e4[4];
#pragma unroll
              for (int q = 0; q < 4; ++q) e4[q] = expf(-softplus_f(-(bb[q] + vv[q])) - 0.5f);
              u32x2 o; o.x = pk_bf16(e4[0], e4[1]); o.y = pk_bf16(e4[2], e4[3]);
              *(u32x2*)(rr + (3 + d5) * 512) = o;
            } else if (aux < 16) {
              const float4 b0 = *(const float4*)(p->rwkv_a0 + (j * 2 + d5) * 512 + c05 + c4);
              const float4 k1 = *(const float4*)(p->rwkv_kvec + (j * 2 + 1) * 512 + c05 + c4);
              const u32x2 kx2 = *(const u32x2*)(rr + 10 * 512);
              const float bb[4] = {b0.x, b0.y, b0.z, b0.w}, kk1[4] = {k1.x, k1.y, k1.z, k1.w};
              const float kx[4] = {bflo(kx2.x), bfhi(kx2.x), bflo(kx2.y), bfhi(kx2.y)};
              float av[4], ke[4];
#pragma unroll
              for (int q = 0; q < 4; ++q) { av[q] = sigm_f(bb[q] + vv[q]); ke[q] = kx[q] * (1.f + (av[q] - 1.f) * kk1[q]); }
              u32x2 o; o.x = pk_bf16(av[0], av[1]); o.y = pk_bf16(av[2], av[3]);
              *(u32x2*)(rr + (7 + d5) * 512) = o;
              o.x = pk_bf16(ke[0], ke[1]); o.y = pk_bf16(ke[2], ke[3]);
              *(u32x2*)(rr + (5 + d5) * 512) = o;
            } else {
              u32x2 o; o.x = pk_bf16(v.x, v.y); o.y = pk_bf16(v.z, v.w);
              *(u32x2*)(rr + 9 * 512) = o;
            }
          } break;
        }
      }
    }
    __syncthreads();
  }
}

__device__ void ph_final_ln(KP p, int layer, bool keep, char* lds) {
  const int tid = opaque_tid();
  const int lane = tid & 63, wave = tid >> 6;
  const int rows = keep ? NT : NL;
  int* s_base = (int*)(lds + META_OFF);
  if (tid == 0) {
    int a = 0;
    for (int e = 0; e < 64; ++e) { s_base[e] = a * 128; a += (p->cnt[e] + 127) >> 7; }
    s_base[64] = a * 128;
  }
  __syncthreads();
  const float* lng = p->ln_g + (layer * 2 + 1) * 1024;
  const float* lnb = p->ln_b + (layer * 2 + 1) * 1024;
  for (int t = blockIdx.x * 4 + wave; t < rows; t += gridDim.x * 4) {
    const int mr = modrow(t);
    const float* g2 = p->MOD + (layer * 9 + mr) * 6144 + 5120;
    const bf16_t* src[7];
#pragma unroll
    for (int k = 0; k < 6; ++k) {
      const int v = p->tsl[t * 6 + k];
      src[k] = p->OUT2 + (size_t)(s_base[v >> 16] + (v & 0xffff)) * 1024;
    }
    src[6] = p->OUT2 + (size_t)(s_base[64] + t) * 1024;
    float v[16];
    float s = 0.f;
#pragma unroll
    for (int c = 0; c < 2; ++c) {
      const int n0 = c * 512 + lane * 8;
      float y[8];
#pragma unroll
      for (int q = 0; q < 8; ++q) y[q] = 0.f;
#pragma unroll
      for (int k = 0; k < 7; ++k) {
        const u32x4 u = *(const u32x4*)(src[k] + n0);
        y[0] += bflo(u.x); y[1] += bfhi(u.x); y[2] += bflo(u.y); y[3] += bfhi(u.y);
        y[4] += bflo(u.z); y[5] += bfhi(u.z); y[6] += bflo(u.w); y[7] += bfhi(u.w);
      }
      const float4 xa = *(const float4*)(p->X + (size_t)t * DM + n0), xb = *(const float4*)(p->X + (size_t)t * DM + n0 + 4);
      const float4 ga = *(const float4*)(g2 + n0), gb = *(const float4*)(g2 + n0 + 4);
      const float xx[8] = {xa.x, xa.y, xa.z, xa.w, xb.x, xb.y, xb.z, xb.w};
      const float gg[8] = {ga.x, ga.y, ga.z, ga.w, gb.x, gb.y, gb.z, gb.w};
#pragma unroll
      for (int q = 0; q < 8; ++q) { v[c * 8 + q] = DN_ALPHA * xx[q] + gg[q] * y[q]; s += v[c * 8 + q]; }
    }
    const float mean = wsum(s) * (1.f / 1024.f);
    float q2 = 0.f;
#pragma unroll
    for (int i = 0; i < 16; ++i) { const float d = v[i] - mean; q2 += d * d; }
    const float rs = rsqrtf(wsum(q2) * (1.f / 1024.f) + 1e-5f);
    const float* modn = p->MOD + ((layer + 1) * 9 + mr) * 6144;
#pragma unroll
    for (int c = 0; c < 2; ++c) {
      const int n0 = c * 512 + lane * 8;
      float xn[8];
#pragma unroll
      for (int q = 0; q < 8; ++q) xn[q] = (v[c * 8 + q] - mean) * rs * lng[n0 + q] + lnb[n0 + q];
      *(float4*)(p->X + (size_t)t * DM + n0) = make_float4(xn[0], xn[1], xn[2], xn[3]);
      *(float4*)(p->X + (size_t)t * DM + n0 + 4) = make_float4(xn[4], xn[5], xn[6], xn[7]);
      if (layer == 3) {
        *(float4*)(p->out + (size_t)t * DM + n0) = make_float4(xn[0], xn[1], xn[2], xn[3]);
        *(float4*)(p->out + (size_t)t * DM + n0 + 4) = make_float4(xn[4], xn[5], xn[6], xn[7]);
      } else {
        float hb[8];
#pragma unroll
        for (int q = 0; q < 8; ++q) hb[q] = xn[q] * (1.f + modn[1024 + n0 + q]) + modn[n0 + q];
        u32x4 o;
        o.x = pk_bf16(hb[0], hb[1]); o.y = pk_bf16(hb[2], hb[3]); o.z = pk_bf16(hb[4], hb[5]); o.w = pk_bf16(hb[6], hb[7]);
        *(u32x4*)(p->AB + (size_t)t * DM + n0) = o;
      }
    }
  }
}

#define XB_TMO      128
#define XB_XCNT(j)  (256  + 64 * (j))
#define XB_XSUB(j)  (1280 + 64 * (j))
#define XB_XGEN(j)  (2304 + 64 * (j))
#define XB_TOP      3328
#define XB_TOPGEN   3392
#define XCD_BAR_WORDS 3456
#define XB_SPIN_CAP (1u << 20)
#define LAS __attribute__((address_space(3)))
__device__ __forceinline__ unsigned xb_ld(unsigned* p) { return __hip_atomic_load(p, __ATOMIC_RELAXED, __HIP_MEMORY_SCOPE_AGENT); }
__device__ __forceinline__ unsigned xb_add(unsigned* p, unsigned v) { return __hip_atomic_fetch_add(p, v, __ATOMIC_RELAXED, __HIP_MEMORY_SCOPE_AGENT); }
__device__ __forceinline__ unsigned xb_xcc_id() { return (unsigned)__builtin_amdgcn_s_getreg((3 << 11) | 20) & 0xFu; }
#define XB_SPIN(cond, bar) do { unsigned _sp = 0; while (cond) { __builtin_amdgcn_s_sleep(1); \
    if ((++_sp & 255u) == 0u) { if (xb_ld(&(bar)[XB_TMO])) break; if (_sp > XB_SPIN_CAP) { atomicAdd(&(bar)[XB_TMO], 1u); break; } } } } while (0)
struct XcdBarrier { unsigned* bar; unsigned x; volatile LAS unsigned* st; };
__device__ __forceinline__ XcdBarrier xcd_barrier_post(unsigned* bar, volatile LAS unsigned* st) {
  XcdBarrier b; b.bar = bar; b.x = xb_xcc_id(); b.st = st;
  if (threadIdx.x == 0) (void)xb_add(&bar[XB_XCNT(b.x)], 1u);
  return b;
}
__device__ __forceinline__ void xcd_barrier_complete(unsigned* bar, unsigned x, unsigned& nloc, unsigned& nx) {
  const unsigned G = gridDim.x;
  unsigned sum, cnt, mine, sp = 0u;
  for (;;) {
    sum = 0u; cnt = 0u; mine = 0u;
#pragma unroll
    for (unsigned j = 0; j < 16; ++j) { const unsigned c = xb_ld(&bar[XB_XCNT(j)]); sum += c; cnt += (c > 0u) ? 1u : 0u; mine = (j == x) ? c : mine; }
    if (sum == G) break;
    __builtin_amdgcn_s_sleep(1);
    if ((++sp & 255u) == 0u) { if (xb_ld(&bar[XB_TMO])) break; if (sp > XB_SPIN_CAP) { atomicAdd(&bar[XB_TMO], 1u); break; } }
  }
  nloc = mine > 0u ? mine : 1u; nx = cnt > 0u ? cnt : 1u;
}
__device__ __forceinline__ void xcd_barrier(const XcdBarrier& b) {
  asm volatile("s_waitcnt vmcnt(0)" ::: "memory");
  __syncthreads();
  if (threadIdx.x == 0) {
    unsigned* bar = b.bar;
    __builtin_amdgcn_s_waitcnt(0);
    unsigned nloc = b.st[0], nx = b.st[1];
    if (nloc == 0u) { xcd_barrier_complete(bar, b.x, nloc, nx); b.st[0] = nloc; b.st[1] = nx; }
    const unsigned old = xb_add(&bar[XB_XSUB(b.x)], 1u);
    const unsigned gen = old / nloc;
    if (old + 1u == (gen + 1u) * nloc) {
      __builtin_amdgcn_fence(__ATOMIC_RELEASE, "agent");
      asm volatile("s_waitcnt vmcnt(0)" ::: "memory");
      const unsigned og = xb_add(&bar[XB_TOP], 1u);
      const unsigned tg = og / nx;
      if (og + 1u == (tg + 1u) * nx) xb_add(&bar[XB_TOPGEN], 1u);
      else XB_SPIN(xb_ld(&bar[XB_TOPGEN]) == tg, bar);
      __builtin_amdgcn_fence(__ATOMIC_ACQUIRE, "agent");
      xb_add(&bar[XB_XGEN(b.x)], 1u);
      asm volatile("s_waitcnt vmcnt(0)" ::: "memory");
    } else {
      XB_SPIN(xb_ld(&bar[XB_XGEN(b.x)]) == gen, bar);
      __builtin_amdgcn_fence(__ATOMIC_ACQUIRE, "agent");
      asm volatile("s_waitcnt vmcnt(0)" ::: "memory");
    }
  }
  __syncthreads();
}

constexpr int NSLOTS = 13;
constexpr int NPHASE = 2 + 4 * NSLOTS;
__device__ __forceinline__ bool phase_is_nop(int ph) {
  if (ph < 2) return false;
  const int layer = (ph - 2) / NSLOTS, st = (ph - 2) % NSLOTS;
  return !(layer & 1) && (st == 1 || (st >= 3 && st <= 7));
}
__device__ void run_phase(KP p, int ph, char* sm) {
  if (ph == 0) { ph_init(p, sm); return; }
  if (ph == 1) { ph_mod_h(p, sm); return; }
  const int layer = (ph - 2) / NSLOTS, st = (ph - 2) % NSLOTS;
  const bool odd = layer & 1;
  const bool keep = layer < 3;
  int gk = -1;
  if (st == 0) gk = 0;
  else if (st == 8) gk = 1;
  else if (st == 10) gk = 2;
  else if (st == 11) gk = 3;
  else if (odd && st == 2) gk = 4;
  else if (odd && st == 3) gk = 5;
  asm volatile("" : "+s"(gk));
  if (gk >= 0) { ph_gemm(p, gk, layer, keep, sm); return; }
  switch (st) {
    case 1: if (odd) ph_rwkv_mix(p, layer); break;
    case 2: ph_attention(p, layer, keep, sm); break;
    case 4: if (odd) ph_scan_a(p, layer, sm); break;
    case 5: if (odd) ph_mlstm_s2(p, sm); break;
    case 6: if (odd) ph_mlstm_s3(p, layer, sm); break;
    case 7: if (odd) ph_rec_final(p, layer, keep); break;
    case 9: ph_ln_router(p, layer, keep, sm); break;
    case 12: ph_final_ln(p, layer, keep, sm); break;
  }
}

__global__ void __launch_bounds__(NTHR, 2) mega_kernel(Params kargs) {
  extern __shared__ __attribute__((aligned(16))) char sm[];
  cg::grid_group grid = cg::this_grid();
  volatile LAS unsigned* st = (volatile LAS unsigned*)(sm + META_OFF + 4032);
  if (threadIdx.x == 0) { st[0] = 0u; st[1] = 0u; }
  __syncthreads();
  const XcdBarrier xb = xcd_barrier_post(kargs.bar, st);
  for (int ph = kargs.ph_lo; ph < kargs.ph_hi; ++ph) {
    if (phase_is_nop(ph)) continue;
    {
      KP kp = (KP)__builtin_amdgcn_kernarg_segment_ptr();
      asm volatile("" : "+s"(kp));
      run_phase(kp, ph, sm);
    }
    if (ph + 1 < kargs.ph_hi) {
      if (ph == 0) grid.sync();
      else xcd_barrier(xb);
    }
  }
}

extern "C" void kernel_launch(void* const* d_in, const int* in_sizes, int n_in, void* d_out, int out_size, void* d_ws,
                              size_t ws_size, hipStream_t stream) {
  static int grid_blocks = 0;
  if (!grid_blocks) {
    int dev = 0, cus = 0, per_cu = 0;
    (void)hipGetDevice(&dev);
    (void)hipDeviceGetAttribute(&cus, hipDeviceAttributeMultiprocessorCount, dev);
    (void)hipFuncSetAttribute((const void*)mega_kernel, hipFuncAttributeMaxDynamicSharedMemorySize, SMEM_BYTES);
    (void)hipOccupancyMaxActiveBlocksPerMultiprocessor(&per_cu, mega_kernel, NTHR, SMEM_BYTES);
    if (per_cu < 1) per_cu = 1;
    if (per_cu > 2) per_cu = 2;
    grid_blocks = cus * per_cu;
  }
  Params p;
  memset(&p, 0, sizeof(p));
  const float** pin = (const float**)&p;
  for (int i = 0; i < 35; ++i) pin[i] = (const float*)d_in[i];
  p.out = (float*)d_out;
  char* w = (char*)d_ws;
  size_t off = 0;
  auto take = [&](size_t bytes) { char* r = w + off; off += (bytes + 255) & ~(size_t)255; return r; };
  p.Wt_att = (bf16_t*)take((size_t)2 * ATT_N * 1024 * 2);
  p.Wt_rec = (bf16_t*)take((size_t)2 * REC_NP * 1024 * 2);
  p.Wt_out = (bf16_t*)take((size_t)4 * 1024 * 1024 * 2);
  p.Wt13 = (bf16_t*)take((size_t)4 * 65 * 512 * 1024 * 2);
  p.Wt2 = (bf16_t*)take((size_t)4 * 65 * 1024 * 256 * 2);
  p.Wl1 = (bf16_t*)take((size_t)2 * 3 * 128 * 512 * 2);
  p.Wl2 = (bf16_t*)take((size_t)2 * 2560 * 128 * 2);
  p.X = (float*)take((size_t)NT * DM * 4);
  p.AB = (bf16_t*)take((size_t)NT * DM * 2);
  p.MOD = (float*)take((size_t)5 * 9 * 6144 * 4);
  p.MODP = (float*)take((size_t)8 * 4 * 9 * 6144 * 4);
  p.GP = (float*)take((size_t)NT * 16 * 4);
  p.ROPE = (float*)take((size_t)64 * 16 * 2 * 4);
  p.msc = (float*)take((size_t)3 * NMT * 4);
  p.lgate = (float*)take((size_t)64 * NT * 4);
  p.ltok = (int*)take((size_t)64 * NT * 4);
  p.tsl = (int*)take((size_t)NT * 6 * 4);
  p.cnt = (int*)take(512);
  p.bar = (unsigned*)take((size_t)XCD_BAR_WORDS * 4);
  char* region = take(0);
  const size_t szP = (size_t)NT * LDP * 2, szRW = (size_t)NT * RWS * 2, szMS = (size_t)NMT * 16384 * 2,
               szMSn = (size_t)NMT * 128 * 4;
  const size_t szT = (size_t)NT * DM * 4, szOUT2 = (size_t)NSLOT * 1024 * 2;
  p.P = (bf16_t*)region;
  p.RW = (bf16_t*)(region + szP);
  p.MS = (bf16_t*)(region + szP + szRW);
  p.MSn = (float*)(region + szP + szRW + szMS);
  p.Zb = p.MS;
  p.L1 = p.MS + (size_t)NT * 1536;
  p.Tb = (float*)region;
  p.ACT = (bf16_t*)region;
  p.OUT2 = (bf16_t*)(region + szT);
  size_t mixer = szP + szRW + szMS + szMSn, moe = szT + szOUT2;
  off += (mixer > moe ? mixer : moe);
  if (off > ws_size) { fprintf(stderr, "workspace too small: need %zu have %zu\n", off, ws_size); return; }
  p.ph_lo = 0;
  p.ph_hi = NPHASE;
  (void)hipMemsetAsync(p.bar, 0, (size_t)XCD_BAR_WORDS * 4, stream);
  void* args[] = {&p};
  hipError_t e = hipLaunchCooperativeKernel((void*)mega_kernel, dim3(grid_blocks), dim3(NTHR), args, SMEM_BYTES, stream);
  if (e != hipSuccess) fprintf(stderr, "cooperative launch failed: %s (grid %d)\n", hipGetErrorString(e), grid_blocks);
}
```

```cpp
#include <hip/hip_runtime.h>
#include <hip/hip_cooperative_groups.h>
#include <cstdio>
#include <cstring>
namespace cg = cooperative_groups;

constexpr int DM = 1024;
constexpr int NBATCH = 8;
constexpr int SEQ = 2048;
constexpr int CTXL = 256;
constexpr int NL = NBATCH * SEQ;
constexpr int NC = NBATCH * CTXL;
constexpr int NT = NL + NC;
constexpr int TSC = CTXL + SEQ;
constexpr int LDP = 4112;
constexpr int ATT_N = 2304;
constexpr int REC_N = 4112;
constexpr int REC_NP = 4224;
constexpr int NCHUNK = 36;
constexpr int NMT = 64 * NCHUNK;
constexpr int RWS = 5632;
constexpr int NSLOT = 137216;
constexpr float DN_ALPHA = 1.6817928305074290f;
constexpr int NTHR = 256;
constexpr int SMEM_BYTES = 65536 + 4096;
constexpr int META_OFF = 65536;
#define XCD_BAR_WORDS 3456
constexpr int BAR_TOTAL_WORDS = XCD_BAR_WORDS + 64;

typedef unsigned short bf16_t;
using bf16x8 = __attribute__((ext_vector_type(8))) short;
using f32x16 = __attribute__((ext_vector_type(16))) float;
using u32x4 = __attribute__((ext_vector_type(4))) unsigned;
using u32x2 = __attribute__((ext_vector_type(2))) unsigned;

struct Params {
  const float *x, *c, *ctx, *c_ctx, *ada_w, *ada_b, *ln_g, *ln_b, *mix_w_out, *att_w_in, *na_rpb, *qk_gain,
      *rec_w_in, *rwkv_mu, *rwkv_w0, *rwkv_w1, *rwkv_w2, *rwkv_a0, *rwkv_a1, *rwkv_a2, *rwkv_g1, *rwkv_g2,
      *rwkv_kvec, *rwkv_rk, *rwkv_gn, *mlstm_gate_b, *mlstm_norm, *moe_router, *moe_bias, *moe_w1, *moe_w3,
      *moe_w2, *shared_w1, *shared_w3, *shared_w2;
  float* out;
  bf16_t *Wt_att, *Wt_rec, *Wt_out, *Wt13, *Wt2, *Wl1, *Wl2;
  bf16_t *Zb, *L1;
  float *X, *MOD, *MODP, *GP, *msc, *lgate, *MSn, *Tb, *ROPE;
  bf16_t *AB, *P, *RW, *MS, *ACT, *OUT2;
  int *cnt, *ltok, *tsl;
  unsigned* bar;
  int ph_lo, ph_hi;
};

typedef const Params __attribute__((address_space(4))) * KP;

__device__ __forceinline__ int modrow(int t) { return t < NL ? (t >> 11) : 8; }
__device__ __forceinline__ float silu_f(float x) { return x / (1.f + expf(-x)); }
__device__ __forceinline__ float sigm_f(float x) { return 1.f / (1.f + expf(-x)); }
__device__ __forceinline__ float softplus_f(float x) { return fmaxf(x, 0.f) + log1pf(expf(-fabsf(x))); }
__device__ __forceinline__ float wsum(float v) {
#pragma unroll
  for (int o = 32; o; o >>= 1) v += __shfl_xor(v, o);
  return v;
}
__device__ __forceinline__ float wmax(float v) {
#pragma unroll
  for (int o = 32; o; o >>= 1) v = fmaxf(v, __shfl_xor(v, o));
  return v;
}
__device__ __forceinline__ float rdlane(float v, int l) {
  return __int_as_float(__builtin_amdgcn_readlane(__float_as_int(v), l));
}
__device__ __forceinline__ int opaque_tid() {
  int t = threadIdx.x;
  asm volatile("" : "+v"(t));
  return t;
}
typedef __bf16 bf16x2_t __attribute__((ext_vector_type(2)));
typedef float f32x2_t __attribute__((ext_vector_type(2)));
__device__ __forceinline__ unsigned pk_bf16(float lo, float hi) {
  const f32x2_t v = {lo, hi};
  return __builtin_bit_cast(unsigned, __builtin_convertvector(v, bf16x2_t));
}
__device__ __forceinline__ bf16_t f2bf(float x) { return (bf16_t)(pk_bf16(x, 0.f) & 0xffffu); }
__device__ __forceinline__ float bf2f(bf16_t v) { return __uint_as_float((unsigned)v << 16); }
__device__ __forceinline__ float bflo(unsigned u) { return __uint_as_float(u << 16); }
__device__ __forceinline__ float bfhi(unsigned u) { return __uint_as_float(u & 0xffff0000u); }
template <int CTRL>
__device__ __forceinline__ float dppx(float x) {
  return __int_as_float(__builtin_amdgcn_update_dpp(0, __float_as_int(x), CTRL, 0xf, 0xf, true));
}
__device__ __forceinline__ int scan_row(int dir, int b, int tau) {
  if (tau < CTXL) return NL + b * CTXL + (dir ? (CTXL - 1 - tau) : tau);
  int s = tau - CTXL;
  return b * SEQ + (dir ? (SEQ - 1 - s) : s);
}

template <class RowPtrA>
__device__ __forceinline__ void gemm128_main(int tid, RowPtrA rowA, const bf16_t* __restrict__ Bt, int K, int n0,
                                             char* lds, f32x16 (&acc)[2][2]) {
  const int lane = tid & 63, w = tid >> 6;
  const int wm = w >> 1, wn = w & 1, r = lane & 31, h = lane >> 5;
  const int c = tid & 7, sr = tid >> 3;
  const int lc = (c ^ ((tid >> 4) & 7)) * 8;
  const bf16_t* ap[4];
#pragma unroll
  for (int i = 0; i < 4; ++i) ap[i] = rowA(sr + 32 * i) + lc;
  const bf16_t* bp0 = Bt + (size_t)(n0 + sr) * K + lc;
  const int bstr = 32 * K;
#pragma unroll
  for (int mi = 0; mi < 2; ++mi)
#pragma unroll
    for (int ni = 0; ni < 2; ++ni)
#pragma unroll
      for (int q = 0; q < 16; ++q) acc[mi][ni][q] = 0.f;
  const int nk = K >> 6;
  auto issue = [&](int kt) {
    char* As = lds + (kt & 1) * 32768 + tid * 16;
    const int k0 = kt * 64;
#pragma unroll
    for (int i = 0; i < 4; ++i) {
      __builtin_amdgcn_global_load_lds((const unsigned*)(ap[i] + k0), (__attribute__((address_space(3))) unsigned*)(As + i * 4096), 16, 0, 0);
      __builtin_amdgcn_global_load_lds((const unsigned*)(bp0 + i * bstr + k0), (__attribute__((address_space(3))) unsigned*)(As + 16384 + i * 4096), 16, 0, 0);
    }
  };
  issue(0);
  const int sw = (r >> 1) & 7;
#pragma unroll 1
  for (int kt = 0; kt < nk; ++kt) {
    asm volatile("s_waitcnt vmcnt(0)" ::: "memory");
    __syncthreads();
    if (kt + 1 < nk) issue(kt + 1);
    const char* As = lds + (kt & 1) * 32768;
    const char* Ar = As + (wm * 64 + r) * 128;
    const char* Br = As + 16384 + (wn * 64 + r) * 128;
#pragma unroll
    for (int ks = 0; ks < 4; ++ks) {
      const int off = ((ks * 2 + h) ^ sw) * 16;
      const bf16x8 a0 = *(const bf16x8*)(Ar + off);
      const bf16x8 a1 = *(const bf16x8*)(Ar + 32 * 128 + off);
      const bf16x8 b0 = *(const bf16x8*)(Br + off);
      const bf16x8 b1 = *(const bf16x8*)(Br + 32 * 128 + off);
      acc[0][0] = __builtin_amdgcn_mfma_f32_32x32x16_bf16(a0, b0, acc[0][0], 0, 0, 0);
      acc[0][1] = __builtin_amdgcn_mfma_f32_32x32x16_bf16(a0, b1, acc[0][1], 0, 0, 0);
      acc[1][0] = __builtin_amdgcn_mfma_f32_32x32x16_bf16(a1, b0, acc[1][0], 0, 0, 0);
      acc[1][1] = __builtin_amdgcn_mfma_f32_32x32x16_bf16(a1, b1, acc[1][1], 0, 0, 0);
    }
  }
  __syncthreads();
}
template <class F>
__device__ __forceinline__ void acc_foreach(int tid, const f32x16 (&acc)[2][2], F f) {
  const int lane = tid & 63, w = tid >> 6;
  const int wm = w >> 1, wn = w & 1, r = lane & 31, h = lane >> 5;
#pragma unroll
  for (int mi = 0; mi < 2; ++mi)
#pragma unroll
    for (int ni = 0; ni < 2; ++ni)
#pragma unroll
      for (int q = 0; q < 16; ++q) {
        const int row = wm * 64 + mi * 32 + (q & 3) + 8 * (q >> 2) + 4 * h;
        const int col = wn * 64 + ni * 32 + r;
        f(row, col, acc[mi][ni][q]);
        if ((q & 3) == 3) __builtin_amdgcn_sched_barrier(0);
      }
}

template <class RM>
__device__ __forceinline__ void tr_tile(int tid, const float* __restrict__ src, int N, int k0, int n0,
                                        bf16_t* __restrict__ dst, int K, RM rowmap, float* tile) {
  {
    const int tx = tid & 15, ty = tid >> 4;
    const int n = n0 + tx * 4;
#pragma unroll
    for (int i = 0; i < 4; ++i) {
      const int k = ty + 16 * i;
      float4 v = make_float4(0.f, 0.f, 0.f, 0.f);
      if (n < N) v = *(const float4*)(src + (size_t)(k0 + k) * N + n);
      tile[k * 65 + tx * 4 + 0] = v.x; tile[k * 65 + tx * 4 + 1] = v.y;
      tile[k * 65 + tx * 4 + 2] = v.z; tile[k * 65 + tx * 4 + 3] = v.w;
    }
  }
  __syncthreads();
  {
    const int kc = tid & 7;
#pragma unroll
    for (int i = 0; i < 2; ++i) {
      const int n = (tid >> 3) + 32 * i;
      if (n0 + n < N) {
        float v[8];
#pragma unroll
        for (int q = 0; q < 8; ++q) v[q] = tile[(kc * 8 + q) * 65 + n];
        u32x4 o;
        o.x = pk_bf16(v[0], v[1]); o.y = pk_bf16(v[2], v[3]); o.z = pk_bf16(v[4], v[5]); o.w = pk_bf16(v[6], v[7]);
        *(u32x4*)(dst + (size_t)rowmap(n0 + n) * K + k0 + kc * 8) = o;
      }
    }
  }
  __syncthreads();
}

constexpr int CJ0 = 1152, CJ1 = CJ0 + 2080, CJ2 = CJ1 + 1024, CJ3 = CJ2 + 33280, CJ4 = CJ3 + 16640;
__device__ void convert_job(KP p, int job, float* sm, int tid) {
  if (job < CJ0) {
    const int j = job / 576, rem = job % 576, kt = rem / 36, nt = rem % 36;
    tr_tile(tid, p->att_w_in + (size_t)j * 1024 * ATT_N, ATT_N, kt * 64, nt * 64, p->Wt_att + (size_t)j * ATT_N * 1024,
            1024, [](int n) { return n; }, sm);
  } else if (job < CJ1) {
    const int q = job - CJ0;
    const int j = q / 1040, rem = q % 1040, kt = rem / 65, nt = rem % 65;
    tr_tile(tid, p->rec_w_in + (size_t)j * 1024 * REC_N, REC_N, kt * 64, nt * 64, p->Wt_rec + (size_t)j * REC_NP * 1024,
            1024, [](int n) { return n; }, sm);
  } else if (job < CJ2) {
    const int q = job - CJ1;
    const int i = q >> 8, rem = q & 255, kt = rem >> 4, nt = rem & 15;
    tr_tile(tid, p->mix_w_out + (size_t)i * 1024 * 1024, 1024, kt * 64, nt * 64, p->Wt_out + (size_t)i * 1024 * 1024,
            1024, [](int n) { return n; }, sm);
  } else if (job < CJ3) {
    const int q = job - CJ2;
    const int le = q >> 7, rem = q & 127;
    const int which = rem >> 6, kt = (rem >> 2) & 15, nt = rem & 3;
    const int layer = le / 65, e = le % 65;
    const float* src;
    if (e < 64) src = (which ? p->moe_w3 : p->moe_w1) + (size_t)(layer * 64 + e) * 1024 * 256;
    else src = (which ? p->shared_w3 : p->shared_w1) + (size_t)layer * 1024 * 256;
    tr_tile(tid, src, 256, kt * 64, nt * 64, p->Wt13 + (size_t)le * 512 * 1024, 1024,
            [which](int n) { return 64 * (n >> 5) + which * 32 + (n & 31); }, sm);
  } else {
    const int q = job - CJ3;
    const int le = q >> 6, rem = q & 63;
    const int kt = rem >> 4, nt = rem & 15;
    const int layer = le / 65, e = le % 65;
    const float* src = e < 64 ? p->moe_w2 + (size_t)(layer * 64 + e) * 256 * 1024 : p->shared_w2 + (size_t)layer * 256 * 1024;
    tr_tile(tid, src, 1024, kt * 64, nt * 64, p->Wt2 + (size_t)le * 1024 * 256, 256, [](int n) { return n; }, sm);
  }
}
__device__ __forceinline__ int conv_stage_total(int stage) {
  return stage == 0 ? (576 + 1040 + 512 + 8320 + 4160) : (stage == 1 ? (576 + 1040 + 256 + 16640 + 8320) : (256 + 8320 + 4160));
}
__device__ __forceinline__ int conv_stage_job(int stage, int q) {
  if (stage == 0) {
    if (q < 8320) return CJ2 + q;  q -= 8320;
    if (q < 4160) return CJ3 + q;  q -= 4160;
    if (q < 576) return q;  q -= 576;
    if (q < 1040) return CJ0 + q;  q -= 1040;
    return CJ1 + q;
  } else if (stage == 1) {
    if (q < 8320) return CJ2 + 8320 + q;  q -= 8320;
    if (q < 4160) return CJ3 + 4160 + q;  q -= 4160;
    if (q < 576) return 576 + q;  q -= 576;
    if (q < 256) return CJ1 + 512 + q;  q -= 256;
    if (q < 8320) return CJ2 + 16640 + q;  q -= 8320;
    if (q < 4160) return CJ3 + 8320 + q;  q -= 4160;
    return CJ0 + 1040 + q;
  }
  if (q < 256) return CJ1 + 768 + q;  q -= 256;
  if (q < 8320) return CJ2 + 24960 + q;  q -= 8320;
  return CJ3 + 12480 + q;
}

__device__ void ph_init(KP p, char* smc) {
  float* sm = (float*)smc;
  const int tid = opaque_tid();
  {
    const size_t n4a = (size_t)NL * DM / 4, n4b = (size_t)NC * DM / 4;
    const float4* xs = (const float4*)p->x;
    const float4* cs = (const float4*)p->ctx;
    float4* X4 = (float4*)p->X;
    for (size_t i = (size_t)blockIdx.x * NTHR + tid; i < n4a + n4b; i += (size_t)gridDim.x * NTHR)
      X4[i] = i < n4a ? xs[i] : cs[i - n4a];
  }
  for (int tile = blockIdx.x; tile < 96 * 8; tile += gridDim.x) {
    const int ct = tile >> 3, ks = tile & 7;
    for (int i = tid; i < 9 * 128; i += NTHR) {
      const int r = i >> 7, k = ks * 128 + (i & 127);
      const float v = r < 8 ? p->c[r * 1024 + k] : p->c_ctx[k];
      sm[i] = silu_f(v);
    }
    __syncthreads();
    const int col = ct * 256 + tid;
    const int layer = col / 6144, n = col % 6144;
    const float* W = p->ada_w + ((size_t)layer * 1024 + ks * 128) * 6144 + n;
    float acc[9];
#pragma unroll
    for (int r = 0; r < 9; ++r) acc[r] = 0.f;
#pragma unroll 4
    for (int k = 0; k < 128; ++k) {
      const float w = W[(size_t)k * 6144];
#pragma unroll
      for (int r = 0; r < 9; ++r) acc[r] = fmaf(sm[r * 128 + k], w, acc[r]);
    }
#pragma unroll
    for (int r = 0; r < 9; ++r) p->MODP[((size_t)(ks * 4 + layer) * 9 + r) * 6144 + n] = acc[r];
    __syncthreads();
  }
  for (int q = blockIdx.x; q < conv_stage_total(0); q += gridDim.x) convert_job(p, conv_stage_job(0, q), sm, tid);
  for (int i = blockIdx.x * NTHR + tid; i < 2 * 3 * 128 * 512; i += gridDim.x * NTHR) {
    const int k = i & 511, n = (i >> 9) & 127, wj = i >> 16;
    const int j = wj / 3, which = wj % 3;
    float v = 0.f;
    if (which < 2) {
      if (n < 64) v = (which ? p->rwkv_a1 : p->rwkv_w1)[((size_t)(j * 2 + (n >> 5)) * 512 + k) * 32 + (n & 31)];
    } else if (n < 96) v = p->rwkv_g1[((size_t)j * 512 + k) * 96 + n];
    p->Wl1[i] = f2bf(v);
  }
  for (int i = blockIdx.x * NTHR + tid; i < 2 * 2560 * 128; i += gridDim.x * NTHR) {
    const int k = i & 127, n = (i >> 7) % 2560, j = i / (2560 * 128);
    float v = 0.f;
    if (n < 2048) {
      const int d = (n >> 9) & 1, c = n & 511;
      if (k < 64 && (k >> 5) == d) v = (n < 1024 ? p->rwkv_w2 : p->rwkv_a2)[((size_t)(j * 2 + d) * 32 + (k & 31)) * 512 + c];
    } else if (k < 96) v = p->rwkv_g2[((size_t)j * 96 + k) * 512 + (n - 2048)];
    p->Wl2[i] = f2bf(v);
  }
  for (int i = blockIdx.x * NTHR + tid; i < 64 * 16; i += gridDim.x * NTHR) {
    const int pos = i >> 4, f = i & 15;
    const float ang = (float)pos * powf(10000.f, -(float)f / 16.f);
    p->ROPE[2 * i] = cosf(ang);
    p->ROPE[2 * i + 1] = sinf(ang);
  }
}

__device__ void ph_mod_h(KP p, char* smc) {
  float* sm = (float*)smc;
  const int tid = opaque_tid();
  for (int i = blockIdx.x * NTHR + tid; i < 4 * 9 * 6144; i += gridDim.x * NTHR) {
    const int layer = i / (9 * 6144), rem = i % (9 * 6144), n = rem % 6144;
    float s = p->ada_b[layer * 6144 + n];
#pragma unroll
    for (int ks = 0; ks < 8; ++ks) s += p->MODP[(size_t)(ks * 4 + layer) * 9 * 6144 + rem];
    p->MOD[i] = s;
  }
  const int lane = tid & 63, wave = tid >> 6;
  const int per = (((NT + gridDim.x - 1) / gridDim.x) + 3) & ~3;
  const int t0 = blockIdx.x * per, t1 = min(NT, t0 + per);
  int cur = -1;
  for (int tb = t0; tb < t1; tb += 4) {
    const int mr = modrow(tb);
    if (mr != cur) {
      __syncthreads();
      for (int n = tid; n < 2048; n += NTHR) {
        float a = p->ada_b[n];
#pragma unroll
        for (int ks = 0; ks < 8; ++ks) a += p->MODP[((size_t)(ks * 4) * 9 + mr) * 6144 + n];
        sm[n] = a;
      }
      cur = mr;
      __syncthreads();
    }
    const int t = tb + wave;
    if (t < t1) {
      const float* src = t < NL ? p->x + (size_t)t * DM : p->ctx + (size_t)(t - NL) * DM;
#pragma unroll
      for (int i = 0; i < 4; ++i) {
        const int n = i * 256 + lane * 4;
        const float4 xv = *(const float4*)(src + n);
        const float4 sh = *(const float4*)(sm + n);
        const float4 sc = *(const float4*)(sm + 1024 + n);
        u32x2 o;
        o.x = pk_bf16(xv.x * (1.f + sc.x) + sh.x, xv.y * (1.f + sc.y) + sh.y);
        o.y = pk_bf16(xv.z * (1.f + sc.z) + sh.z, xv.w * (1.f + sc.w) + sh.w);
        *(u32x2*)(p->AB + (size_t)t * DM + n) = o;
      }
    }
  }
}

typedef short v4i16_t __attribute__((ext_vector_type(4)));
using s16x4 = __attribute__((ext_vector_type(4))) short;
__device__ __forceinline__ s16x4 vtr(const char* p) {
  return __builtin_bit_cast(s16x4, __builtin_amdgcn_ds_read_tr16_b64_v4i16((__attribute__((address_space(3))) v4i16_t*)p));
}
#define MFMA32(a, b, c) __builtin_amdgcn_mfma_f32_32x32x16_bf16(a, b, c, 0, 0, 0)
__device__ void ph_attention(KP p, int layer, bool keep, char* lds) {
  const int tid = opaque_tid();
  const int lane = tid & 63, w = tid >> 6, r32 = lane & 31, hi = lane >> 5;
  const int j = layer >> 1;
  float* bias_lds = (float*)(lds + 32768 + 1024);
  const int n_gqa = 1024, n_na = 1024, n_cb = keep ? 128 : 0, n_ca = keep ? 128 : 0;
  const int total = n_gqa + n_na + n_cb + n_ca;
  constexpr float LOG2E = 1.4426950408889634f;
  constexpr float C2 = 0.125f * LOG2E;
  const int c = tid & 7, sr = tid >> 3;
  const int kso = (c ^ ((tid >> 4) & 7)) * 16;
  const int vso = (c >> 2) * 4096 + (c & 3) * 16;
  const int sw = (r32 >> 1) & 7;
  for (int item = blockIdx.x; item < total; item += gridDim.x) {
    int b, qrow0, qoff, koff, voff, ocol, lat_tiles, lat_row0;
    bool na = false;
    int r_w = 0, start_w = 0, ru0 = 0, hN = 0;
    if (item < n_gqa) {
      b = item >> 7;
      const int g = (item >> 6) & 1, tt = item & 63;
      qrow0 = b * SEQ + tt * 32; qoff = 1536 + (g * 4 + w) * 64; koff = 2048 + g * 64; voff = 2176 + g * 64;
      ocol = 512 + (g * 4 + w) * 64; lat_tiles = 32; lat_row0 = b * SEQ;
    } else if (item < n_gqa + n_na) {
      const int it = item - n_gqa;
      b = it >> 7; hN = (it >> 4) & 7;
      const int rp = it & 15;
      na = true; r_w = 2 * rp + (w >> 1);
      qrow0 = b * SEQ + r_w * 64 + (w & 1) * 32; qoff = hN * 64; koff = 512 + hN * 64; voff = 1024 + hN * 64; ocol = hN * 64;
      const int s0 = min(max(2 * rp - 4, 0), 24), s1 = min(max(2 * rp - 3, 0), 24);
      start_w = (w >> 1) ? s1 : s0; ru0 = s0; lat_tiles = (s1 != s0) ? 9 : 8; lat_row0 = b * SEQ + ru0 * 64;
    } else if (item < n_gqa + n_na + n_cb) {
      const int it = item - n_gqa - n_na;
      b = it >> 4;
      const int g = (it >> 3) & 1, tt = it & 7;
      qrow0 = NL + b * CTXL + tt * 32; qoff = 1536 + (g * 4 + w) * 64; koff = 2048 + g * 64; voff = 2176 + g * 64;
      ocol = 512 + (g * 4 + w) * 64; lat_tiles = 0; lat_row0 = 0;
    } else {
      const int it = item - n_gqa - n_na - n_cb;
      b = it >> 4;
      const int h = (it >> 1) & 7, half = it & 1;
      qrow0 = NL + b * CTXL + half * 128 + w * 32; qoff = h * 64; koff = 512 + h * 64; voff = 1024 + h * 64; ocol = h * 64;
      lat_tiles = 0; lat_row0 = 0;
    }
    const int ctx_row0 = NL + b * CTXL, ntiles = lat_tiles + 4;
    if (na)
      for (int i = tid; i < 465; i += NTHR) bias_lds[i] = p->na_rpb[(j * 8 + hN) * 465 + i] * LOG2E;
    bf16x8 qf[4];
    {
      const bf16_t* qp = p->P + (size_t)(qrow0 + r32) * LDP + qoff + hi * 8;
#pragma unroll
      for (int d0 = 0; d0 < 4; ++d0) qf[d0] = *(const bf16x8*)(qp + d0 * 16);
    }
    f32x16 o0, o1;
#pragma unroll
    for (int q = 0; q < 16; ++q) { o0[q] = 0.f; o1[q] = 0.f; }
    float m = -INFINITY, l = 0.f;
    u32x4 kr0, kr1, vr0, vr1;
    auto gload = [&](int t) {
      const int row0 = t < lat_tiles ? lat_row0 + 64 * t : ctx_row0 + 64 * (t - lat_tiles);
      const bf16_t* base = p->P + (size_t)(row0 + sr) * LDP + c * 8;
      kr0 = *(const u32x4*)(base + koff); kr1 = *(const u32x4*)(base + (size_t)32 * LDP + koff);
      vr0 = *(const u32x4*)(base + voff); vr1 = *(const u32x4*)(base + (size_t)32 * LDP + voff);
    };
    auto swrite = [&](int buf) {
      char* Kb = lds + buf * 16384;
      char* Vb = Kb + 8192;
      *(u32x4*)(Kb + sr * 128 + kso) = kr0; *(u32x4*)(Kb + (sr + 32) * 128 + kso) = kr1;
      *(u32x4*)(Vb + vso + sr * 64) = vr0; *(u32x4*)(Vb + vso + (sr + 32) * 64) = vr1;
    };
    gload(0);
    swrite(0);
    for (int t = 0; t < ntiles; ++t) {
      __syncthreads();
      if (t + 1 < ntiles) gload(t + 1);
      const bool na_tile = na && t < lat_tiles;
      const int kr = ru0 + t;
      const bool part = !na_tile || (kr >= start_w && kr < start_w + 8);
      if (part) {
        const char* Ks = lds + (t & 1) * 16384;
        const char* Vs = Ks + 8192;
        f32x16 s0, s1;
#pragma unroll
        for (int q = 0; q < 16; ++q) { s0[q] = 0.f; s1[q] = 0.f; }
#pragma unroll
        for (int d0 = 0; d0 < 4; ++d0) {
          const int off = ((2 * d0 + hi) ^ sw) * 16;
          const bf16x8 k0 = *(const bf16x8*)(Ks + r32 * 128 + off);
          const bf16x8 k1 = *(const bf16x8*)(Ks + (32 + r32) * 128 + off);
          s0 = MFMA32(k0, qf[d0], s0);
          s1 = MFMA32(k1, qf[d0], s1);
        }
        float mx = -INFINITY;
        if (na_tile) {
          const int cq = (w & 1) * 32 + r32;
          const int c0 = min(max(cq - 8, 0), 48);
          const float* brow = bias_lds + (kr - r_w + 7) * 31 + (15 - cq);
#pragma unroll
          for (int q = 0; q < 16; ++q) {
            const int kc = (q & 3) + 8 * (q >> 2) + 4 * hi;
            const float v0 = ((unsigned)(kc - c0) < 16u) ? fmaf(s0[q], C2, brow[kc]) : -INFINITY;
            const float v1 = ((unsigned)(kc + 32 - c0) < 16u) ? fmaf(s1[q], C2, brow[kc + 32]) : -INFINITY;
            s0[q] = v0; s1[q] = v1;
            mx = fmaxf(mx, fmaxf(v0, v1));
          }
        } else {
#pragma unroll
          for (int q = 0; q < 16; ++q) {
            s0[q] *= C2; s1[q] *= C2;
            mx = fmaxf(mx, fmaxf(s0[q], s1[q]));
          }
        }
        {
          auto rr = __builtin_amdgcn_permlane32_swap(__float_as_uint(mx), __float_as_uint(mx), false, false);
          mx = fmaxf(__uint_as_float(rr[0]), __uint_as_float(rr[1]));
        }
        const float mnew = fmaxf(m, mx);
        const float alpha = __builtin_amdgcn_exp2f(m - mnew);
        float ls = 0.f;
#pragma unroll
        for (int q = 0; q < 16; ++q) {
          s0[q] = __builtin_amdgcn_exp2f(s0[q] - mnew);
          s1[q] = __builtin_amdgcn_exp2f(s1[q] - mnew);
          ls += s0[q] + s1[q];
        }
        l = l * alpha + ls;
        m = mnew;
#pragma unroll
        for (int q = 0; q < 16; ++q) { o0[q] *= alpha; o1[q] *= alpha; }
        bf16x8 pf[4];
#pragma unroll
        for (int s = 0; s < 4; ++s) {
          const int u = (s & 1) * 8;
          u32x4 tpk;
          if (s < 2) {
            tpk.x = pk_bf16(s0[u + 0], s0[u + 1]); tpk.y = pk_bf16(s0[u + 2], s0[u + 3]);
            tpk.z = pk_bf16(s0[u + 4], s0[u + 5]); tpk.w = pk_bf16(s0[u + 6], s0[u + 7]);
          } else {
            tpk.x = pk_bf16(s1[u + 0], s1[u + 1]); tpk.y = pk_bf16(s1[u + 2], s1[u + 3]);
            tpk.z = pk_bf16(s1[u + 4], s1[u + 5]); tpk.w = pk_bf16(s1[u + 6], s1[u + 7]);
          }
          pf[s] = __builtin_bit_cast(bf16x8, tpk);
        }
        const char* vb = Vs + ((lane >> 4) & 1) * 32 + (lane & 3) * 8 + ((lane & 15) >> 2) * 64 + hi * 256;
#pragma unroll
        for (int s = 0; s < 4; ++s) {
          const s16x4 a00 = vtr(vb + (16 * s) * 64), a01 = vtr(vb + (16 * s + 8) * 64);
          const s16x4 a10 = vtr(vb + 4096 + (16 * s) * 64), a11 = vtr(vb + 4096 + (16 * s + 8) * 64);
          const bf16x8 A0 = __builtin_shufflevector(a00, a01, 0, 1, 2, 3, 4, 5, 6, 7);
          const bf16x8 A1 = __builtin_shufflevector(a10, a11, 0, 1, 2, 3, 4, 5, 6, 7);
          o0 = MFMA32(A0, pf[s], o0);
          o1 = MFMA32(A1, pf[s], o1);
        }
      }
      if (t + 1 < ntiles) swrite((t + 1) & 1);
    }
    __syncthreads();
    const float lt = l + __shfl_xor(l, 32);
    const float inv = 1.f / lt;
    bf16_t* op = p->AB + (size_t)(qrow0 + r32) * DM + ocol + 4 * hi;
#pragma unroll
    for (int g = 0; g < 4; ++g) {
      u32x2 v0, v1;
      v0.x = pk_bf16(o0[4 * g] * inv, o0[4 * g + 1] * inv); v0.y = pk_bf16(o0[4 * g + 2] * inv, o0[4 * g + 3] * inv);
      v1.x = pk_bf16(o1[4 * g] * inv, o1[4 * g + 1] * inv); v1.y = pk_bf16(o1[4 * g + 2] * inv, o1[4 * g + 3] * inv);
      *(u32x2*)(op + 8 * g) = v0;
      *(u32x2*)(op + 32 + 8 * g) = v1;
    }
  }
}

__device__ void ph_rwkv_mix(KP p, int layer) {
  const int j = layer >> 1;
  const int tid = opaque_tid();
  const int lane = tid & 63, wave = tid >> 6;
  const float* mu = p->rwkv_mu + j * 6 * 512;
  const int c0 = lane * 8;
  auto unpack = [](const u32x4 u, float (&f)[8]) {
    f[0] = bflo(u.x); f[1] = bfhi(u.x); f[2] = bflo(u.y); f[3] = bfhi(u.y);
    f[4] = bflo(u.z); f[5] = bfhi(u.z); f[6] = bflo(u.w); f[7] = bfhi(u.w);
  };
  auto pack = [](const float (&f)[8]) {
    u32x4 o;
    o.x = pk_bf16(f[0], f[1]); o.y = pk_bf16(f[2], f[3]); o.z = pk_bf16(f[4], f[5]); o.w = pk_bf16(f[6], f[7]);
    return o;
  };
  for (int t = blockIdx.x * 4 + wave; t < NT; t += gridDim.x * 4) {
    bool hasp, hasn;
    if (t < NL) { int s = t & 2047; hasp = s > 0; hasn = s < SEQ - 1; }
    else { int s = (t - NL) & 255; hasp = s > 0; hasn = s < CTXL - 1; }
    const bf16_t* pt = p->P + (size_t)t * LDP + c0;
    bf16_t* rw = p->RW + (size_t)t * RWS + c0;
    bf16_t* zb = p->Zb + (size_t)t * 1536 + c0;
    const u32x4 zero = {0u, 0u, 0u, 0u};
#pragma unroll
    for (int q = 0; q < 4; ++q) {
      float cur[8], pv[8], nx[8], d[8];
      unpack(*(const u32x4*)(pt + q * 512), cur);
      unpack(hasp ? *(const u32x4*)(pt + q * 512 - LDP) : zero, pv);
      unpack(hasn ? *(const u32x4*)(pt + q * 512 + LDP) : zero, nx);
#pragma unroll
      for (int e = 0; e < 8; ++e) d[e] = 0.5f * (pv[e] + nx[e]) - cur[e];
      if (q < 3) {
        float o[8];
        const float* m = mu + q * 512 + c0;
#pragma unroll
        for (int e = 0; e < 8; ++e) o[e] = cur[e] + d[e] * m[e];
        if (q == 0) *(u32x4*)(rw) = pack(o);
        else if (q == 2) *(u32x4*)(rw + 512) = pack(o);
        else {
          *(u32x4*)(rw + 10 * 512) = pack(o);
          float kk[8], ss = 0.f;
          const float* kv0 = p->rwkv_kvec + (j * 2 + 0) * 512 + c0;
#pragma unroll
          for (int e = 0; e < 8; ++e) { kk[e] = o[e] * kv0[e]; ss += kk[e] * kk[e]; }
          ss += dppx<0xB1>(ss); ss += dppx<0x4E>(ss); ss += dppx<0x141>(ss);
          const float rn = rsqrtf(fmaxf(ss, 1e-24f));
#pragma unroll
          for (int e = 0; e < 8; ++e) kk[e] *= rn;
          *(u32x4*)(rw + 2 * 512) = pack(kk);
        }
      } else {
#pragma unroll
        for (int z = 0; z < 3; ++z) {
          float o[8];
          const float* m = mu + (3 + z) * 512 + c0;
#pragma unroll
          for (int e = 0; e < 8; ++e) o[e] = cur[e] + d[e] * m[e];
          *(u32x4*)(zb + z * 512) = pack(o);
        }
      }
    }
  }
}

constexpr int RS_STEP = 384;
constexpr int RS_TB = 16;
struct RwkvStage { u32x2 r, kk, e, ke, a, v; };
__device__ void rwkv_unit(KP p, int unit, float* sm, int tid) {
  const int ch = unit >> 1, hf = unit & 1;
  const int dir = ch >> 6, b = (ch >> 3) & 7, h = ch & 7;
  const int lane = tid & 63, w = tid >> 6, rl = lane >> 3, ks = lane & 7;
  float* ybuf = sm + 2 * RS_TB * RS_STEP;
  const int ss = tid >> 4, kq = tid & 15;
  auto gload = [&](int n, RwkvStage& g) {
    const int row = scan_row(dir, b, n * RS_TB + ss);
    const bf16_t* base = p->RW + (size_t)row * RWS + h * 64 + kq * 4;
    g.r = *(const u32x2*)(base);
    g.kk = *(const u32x2*)(base + 2 * 512);
    g.e = *(const u32x2*)(base + (3 + dir) * 512);
    g.ke = *(const u32x2*)(base + (5 + dir) * 512);
    g.a = *(const u32x2*)(base + (7 + dir) * 512);
    g.v = *(const u32x2*)(p->RW + (size_t)row * RWS + 512 + h * 64 + hf * 32 + (kq & 7) * 4);
  };
  auto swrite = [&](int buf, const RwkvStage& g) {
    float* sp = sm + (buf * RS_TB + ss) * RS_STEP;
    const float r0 = bflo(g.r.x), r1 = bfhi(g.r.x), r2 = bflo(g.r.y), r3 = bfhi(g.r.y);
    const float k0 = bflo(g.kk.x), k1 = bfhi(g.kk.x), k2 = bflo(g.kk.y), k3 = bfhi(g.kk.y);
    const float w0 = __expf(-bflo(g.e.x)), w1 = __expf(-bfhi(g.e.x)), w2 = __expf(-bflo(g.e.y)), w3 = __expf(-bfhi(g.e.y));
    const float e0 = bflo(g.ke.x), e1 = bfhi(g.ke.x), e2 = bflo(g.ke.y), e3 = bfhi(g.ke.y);
    const float a0 = k0 * bflo(g.a.x), a1 = k1 * bfhi(g.a.x), a2 = k2 * bflo(g.a.y), a3 = k3 * bfhi(g.a.y);
    *(float4*)(sp + kq * 4) = make_float4(k0, k1, k2, k3);
    *(float4*)(sp + 64 + kq * 4) = make_float4(w0 * r0, w1 * r1, w2 * r2, w3 * r3);
    *(float4*)(sp + 128 + kq * 4) = make_float4(w0, w1, w2, w3);
    *(float4*)(sp + 192 + kq * 4) = make_float4(a0, a1, a2, a3);
    *(float4*)(sp + 256 + kq * 4) = make_float4(e0, e1, e2, e3);
    if (kq < 8) *(float4*)(sp + 320 + kq * 4) = make_float4(bflo(g.v.x), bfhi(g.v.x), bflo(g.v.y), bfhi(g.v.y));
    float c1 = a0 * r0 + a1 * r1 + a2 * r2 + a3 * r3;
    float c2 = e0 * r0 + e1 * r1 + e2 * r2 + e3 * r3;
    c1 += dppx<0xB1>(c1); c2 += dppx<0xB1>(c2);
    c1 += dppx<0x4E>(c1); c2 += dppx<0x4E>(c2);
    c1 += dppx<0x141>(c1); c2 += dppx<0x141>(c2);
    c1 += dppx<0x140>(c1); c2 += dppx<0x140>(c2);
    if (kq == 0) { sp[352] = c1; sp[353] = c2; }
  };
  typedef float f2 __attribute__((ext_vector_type(2)));
  f2 S01 = {0.f, 0.f}, S23 = {0.f, 0.f}, S45 = {0.f, 0.f}, S67 = {0.f, 0.f};
  auto compute = [&](int n) {
    const float* bp = sm + (n & 1) * RS_TB * RS_STEP;
    float* yb = ybuf + (n & 1) * RS_TB * 32 + w * 8 + rl;
    struct Ops { f2 k[4], r[4], w[4], a[4], e[4]; float vv; f2 c; };
    auto ld = [&](int s, Ops& o) {
      const float* sq = bp + s * RS_STEP;
      const f2* sp = (const f2*)(sq + ks * 8);
#pragma unroll
      for (int i = 0; i < 4; ++i) { o.k[i] = sp[i]; o.r[i] = sp[32 + i]; o.w[i] = sp[64 + i]; o.a[i] = sp[96 + i]; o.e[i] = sp[128 + i]; }
      o.vv = sq[320 + w * 8 + rl]; o.c = *(const f2*)(sq + 352);
    };
    auto step = [&](const Ops& o) -> float {
      f2 sa2 = S01 * o.k[0];
      f2 y2 = S01 * o.r[0];
      sa2 = __builtin_elementwise_fma(S23, o.k[1], sa2); y2 = __builtin_elementwise_fma(S23, o.r[1], y2);
      sa2 = __builtin_elementwise_fma(S45, o.k[2], sa2); y2 = __builtin_elementwise_fma(S45, o.r[2], y2);
      sa2 = __builtin_elementwise_fma(S67, o.k[3], sa2); y2 = __builtin_elementwise_fma(S67, o.r[3], y2);
      float sa = sa2.x + sa2.y, y0 = y2.x + y2.y;
      sa += dppx<0xB1>(sa); y0 += dppx<0xB1>(y0);
      sa += dppx<0x4E>(sa); y0 += dppx<0x4E>(y0);
      sa += dppx<0x141>(sa); y0 += dppx<0x141>(y0);
      sa = -sa;
      const f2 sav = {sa, sa}, vvv = {o.vv, o.vv};
      S01 = __builtin_elementwise_fma(vvv, o.e[0], __builtin_elementwise_fma(sav, o.a[0], S01 * o.w[0]));
      S23 = __builtin_elementwise_fma(vvv, o.e[1], __builtin_elementwise_fma(sav, o.a[1], S23 * o.w[1]));
      S45 = __builtin_elementwise_fma(vvv, o.e[2], __builtin_elementwise_fma(sav, o.a[2], S45 * o.w[2]));
      S67 = __builtin_elementwise_fma(vvv, o.e[3], __builtin_elementwise_fma(sav, o.a[3], S67 * o.w[3]));
      return fmaf(o.vv, o.c.y, fmaf(sa, o.c.x, y0));
    };
    Ops oa, ob, oc;
    ld(0, oa);
    ld(1, ob);
#pragma unroll 1
    for (int s = 0; s < 15; s += 3) {
      ld(s + 2, oc);
      float y0 = step(oa);
      asm volatile("" : "+v"(y0));
      ld(s + 3, oa);
      float y1 = step(ob);
      asm volatile("" : "+v"(y1));
      ld(s + 4, ob);
      float y2 = step(oc);
      asm volatile("" : "+v"(y2));
      if (ks == 0) { yb[s * 32] = y0; yb[(s + 1) * 32] = y1; yb[(s + 2) * 32] = y2; }
    }
    {
      const float y15 = step(oa);
      if (ks == 0) yb[15 * 32] = y15;
    }
  };
  auto yout = [&](int n) {
    const int row = scan_row(dir, b, n * RS_TB + ss);
    const float* ys = ybuf + (n & 1) * RS_TB * 32 + ss * 32 + kq * 2;
    *(unsigned*)(p->P + (size_t)row * LDP + dir * 512 + h * 64 + hf * 32 + kq * 2) = pk_bf16(ys[0], ys[1]);
  };
  constexpr int NB = TSC / RS_TB;
  RwkvStage gA, gB;
  gload(0, gA);
  gload(1, gB);
  swrite(0, gA);
  gload(2, gA);
  __syncthreads();
  for (int n = 0; n < NB; n += 2) {
    compute(n);
    swrite(1, gB);
    if (n + 3 < NB) gload(n + 3, gB);
    __syncthreads();
    yout(n);
    compute(n + 1);
    if (n + 2 < NB) swrite(0, gA);
    if (n + 4 < NB) gload(n + 4, gA);
    __syncthreads();
    yout(n + 1);
  }
  __syncthreads();
}

__device__ void mlstm_s1(KP p, int layer, int tile, char* lds, int tid) {
  const int j = layer >> 1;
  const int ch = tile / NCHUNK, c = tile % NCHUNK;
  const int dir = ch >> 5, b = (ch >> 2) & 7, h = ch & 3;
  float* s_ws = (float*)(lds + META_OFF);
  int* s_row = (int*)(s_ws + 64);
  char* kimg = lds;
  char* vimg = lds + 16384;
  if (tid < 64) {
    const int row = scan_row(dir, b, c * 64 + tid);
    s_row[tid] = row;
    const float* g = p->GP + (size_t)row * 16;
    const float gi = g[(dir * 2) * 4 + h] + p->mlstm_gate_b[j * 16 + (dir * 2) * 4 + h];
    const float gf = g[(dir * 2 + 1) * 4 + h] + p->mlstm_gate_b[j * 16 + (dir * 2 + 1) * 4 + h];
    float bc = -softplus_f(-gf);
#pragma unroll
    for (int o = 1; o < 64; o <<= 1) {
      float tmp = __shfl_up(bc, o);
      if (tid >= o) bc += tmp;
    }
    const float bend = __shfl(bc, 63);
    const float ds = bend - bc + gi;
    const float mloc = wmax(ds);
    s_ws[tid] = expf(ds - mloc);
    if (tid == 0) { p->msc[tile] = mloc; p->msc[NMT + tile] = bend; }
  }
  __syncthreads();
  {
    const int c8 = tid & 15;
    const int ioff = (c8 >> 2) * 4096 + (c8 & 3) * 16;
#pragma unroll
    for (int i = 0; i < 4; ++i) {
      const int sidx = (tid >> 4) + 16 * i;
      const bf16_t* src = p->P + (size_t)s_row[sidx] * LDP + h * 128 + c8 * 8;
      const u32x4 kv = *(const u32x4*)(src + 2560);
      u32x4 vv = *(const u32x4*)(src + 3072);
      const float wsv = s_ws[sidx];
      vv.x = pk_bf16(bflo(vv.x) * wsv, bfhi(vv.x) * wsv); vv.y = pk_bf16(bflo(vv.y) * wsv, bfhi(vv.y) * wsv);
      vv.z = pk_bf16(bflo(vv.z) * wsv, bfhi(vv.z) * wsv); vv.w = pk_bf16(bflo(vv.w) * wsv, bfhi(vv.w) * wsv);
      *(u32x4*)(kimg + ioff + sidx * 64) = kv;
      *(u32x4*)(vimg + ioff + sidx * 64) = vv;
    }
  }
  __syncthreads();
  const int lane = tid & 63, w = tid >> 6, wm = w >> 1, wn = w & 1, r32 = lane & 31, hi = lane >> 5;
  f32x16 acc[2][2];
#pragma unroll
  for (int mi = 0; mi < 2; ++mi)
#pragma unroll
    for (int ni = 0; ni < 2; ++ni)
#pragma unroll
      for (int q = 0; q < 16; ++q) acc[mi][ni][q] = 0.f;
  const int toff = ((lane >> 4) & 1) * 32 + (lane & 3) * 8 + ((lane & 15) >> 2) * 64 + hi * 256;
#pragma unroll
  for (int ks = 0; ks < 4; ++ks) {
    bf16x8 af[2], bfr[2];
#pragma unroll
    for (int i = 0; i < 2; ++i) {
      const char* ka = kimg + (wm * 2 + i) * 4096 + toff + (16 * ks) * 64;
      const char* va = vimg + (wn * 2 + i) * 4096 + toff + (16 * ks) * 64;
      af[i] = __builtin_shufflevector(vtr(ka), vtr(ka + 8 * 64), 0, 1, 2, 3, 4, 5, 6, 7);
      bfr[i] = __builtin_shufflevector(vtr(va), vtr(va + 8 * 64), 0, 1, 2, 3, 4, 5, 6, 7);
    }
    acc[0][0] = MFMA32(af[0], bfr[0], acc[0][0]);
    acc[0][1] = MFMA32(af[0], bfr[1], acc[0][1]);
    acc[1][0] = MFMA32(af[1], bfr[0], acc[1][0]);
    acc[1][1] = MFMA32(af[1], bfr[1], acc[1][1]);
  }
  bf16_t* U = p->MS + (size_t)tile * 16384;
#pragma unroll
  for (int mi = 0; mi < 2; ++mi)
#pragma unroll
    for (int ni = 0; ni < 2; ++ni)
#pragma unroll
      for (int q = 0; q < 16; ++q) {
        const int d = wm * 64 + mi * 32 + (q & 3) + 8 * (q >> 2) + 4 * hi;
        U[d * 128 + wn * 64 + ni * 32 + r32] = f2bf(acc[mi][ni][q]);
        if ((q & 3) == 3) __builtin_amdgcn_sched_barrier(0);
      }
  if (tid < 128) {
    const char* kc = kimg + (tid >> 5) * 4096 + (tid & 31) * 2;
    float a = 0.f;
#pragma unroll 8
    for (int sidx = 0; sidx < 64; ++sidx) a = fmaf(s_ws[sidx], bf2f(*(const bf16_t*)(kc + sidx * 64)), a);
    p->MSn[tile * 128 + tid] = a;
  }
}

__device__ void ph_scan_a(KP p, int layer, char* smc) {
  float* sm = (float*)smc;
  const int tid = opaque_tid();
  for (int u = blockIdx.x; u < 256; u += gridDim.x) rwkv_unit(p, u, sm, tid);
  const int nblk = gridDim.x, bid = blockIdx.x;
  const int start = (bid + nblk - (256 % nblk)) % nblk;
  for (int tile = start; tile < NMT; tile += nblk) { mlstm_s1(p, layer, tile, smc, tid); __syncthreads(); }
  {
    const int stage = layer == 1 ? 1 : 2;
    const int total = conv_stage_total(stage);
    int* qc = (int*)(p->bar + XCD_BAR_WORDS + 16 * stage);
    int* s_q = (int*)(smc + META_OFF + 3968);
    for (;;) {
      __syncthreads();
      if (tid == 0) *s_q = atomicAdd(qc, 1);
      __syncthreads();
      const int q = *s_q;
      if (q >= total) break;
      convert_job(p, conv_stage_job(stage, q), sm, tid);
    }
  }
}

__device__ void ph_mlstm_s2(KP p, char* smc) {
  float* sw = (float*)smc;
  const int tid = opaque_tid();
  const int nitems = 64 * 33;
  for (int item = blockIdx.x; item < nitems; item += gridDim.x) {
    const int ch = item / 33, seg = item % 33;
    __syncthreads();
    if (tid == 0) {
      float m = 0.f;
      for (int c = 0; c < NCHUNK; ++c) {
        const int tile = ch * NCHUNK + c;
        const float mloc = p->msc[tile], bend = p->msc[NMT + tile];
        const float mn = fmaxf(bend + m, mloc);
        sw[c] = expf(bend + m - mn);
        sw[36 + c] = expf(mloc - mn);
        if (seg == 0) p->msc[2 * NMT + tile] = m;
        m = mn;
      }
    }
    __syncthreads();
    if (seg < 32) {
      unsigned* base = (unsigned*)(p->MS + (size_t)ch * NCHUNK * 16384) + seg * 256 + tid;
      unsigned v[NCHUNK];
#pragma unroll
      for (int c = 0; c < NCHUNK; ++c) v[c] = base[(size_t)c * 8192];
      float C0 = 0.f, C1 = 0.f;
#pragma unroll
      for (int c = 0; c < NCHUNK; ++c) {
        const float t0 = bflo(v[c]), t1 = bfhi(v[c]);
        v[c] = pk_bf16(C0, C1);
        C0 = sw[c] * C0 + sw[36 + c] * t0;
        C1 = sw[c] * C1 + sw[36 + c] * t1;
      }
#pragma unroll
      for (int c = 0; c < NCHUNK; ++c) base[(size_t)c * 8192] = v[c];
    } else if (tid < 128) {
      float* base = p->MSn + (size_t)ch * NCHUNK * 128 + tid;
      float v[NCHUNK];
#pragma unroll
      for (int c = 0; c < NCHUNK; ++c) v[c] = base[c * 128];
      float C = 0.f;
#pragma unroll
      for (int c = 0; c < NCHUNK; ++c) {
        const float t0 = v[c];
        v[c] = C;
        C = sw[c] * C + sw[36 + c] * t0;
      }
#pragma unroll
      for (int c = 0; c < NCHUNK; ++c) base[c * 128] = v[c];
    }
  }
}

__device__ void mlstm_s3(KP p, int layer, int tile, char* lds, int tid) {
  const int j = layer >> 1;
  const int ch = tile / NCHUNK, c = tile % NCHUNK;
  const int dir = ch >> 5, b = (ch >> 2) & 7, h = ch & 3;
  float* s_b = (float*)(lds + META_OFF);
  float* s_ig = s_b + 64;
  float* s_mt = s_b + 128;
  float* s_wi = s_b + 192;
  int* s_row = (int*)(s_b + 256);
  float* s_n = s_b + 320;
  float* s_c = s_b + 448;
  char* kimg = lds;
  char* vimg = lds + 16384;
  char* cimg = lds + 32768;
  const float mprev = p->msc[2 * NMT + tile];
  const float qscale = 0.08838834764831845f;
  if (tid < 64) {
    const int row = scan_row(dir, b, c * 64 + tid);
    s_row[tid] = row;
    const float* g = p->GP + (size_t)row * 16;
    const float gi = g[(dir * 2) * 4 + h] + p->mlstm_gate_b[j * 16 + (dir * 2) * 4 + h];
    const float gf = g[(dir * 2 + 1) * 4 + h] + p->mlstm_gate_b[j * 16 + (dir * 2 + 1) * 4 + h];
    float bc = -softplus_f(-gf);
#pragma unroll
    for (int o = 1; o < 64; o <<= 1) {
      float tmp = __shfl_up(bc, o);
      if (tid >= o) bc += tmp;
    }
    s_b[tid] = bc;
    s_ig[tid] = gi;
  } else if (tid < 192) s_n[tid - 64] = p->MSn[tile * 128 + (tid - 64)];
  __syncthreads();
  if (tid < 64) {
    const float bt = s_b[tid];
    float mt = bt + mprev;
    for (int sx = 0; sx <= tid; ++sx) mt = fmaxf(mt, bt - s_b[sx] + s_ig[sx]);
    s_mt[tid] = mt;
    s_wi[tid] = expf(bt + mprev - mt);
    s_c[tid] = (s_ig[tid] - bt) * 1.4426950408889634f;
  }
  {
    const int c8 = tid & 15;
    const int ioff = (c8 >> 2) * 4096 + (c8 & 3) * 16;
#pragma unroll
    for (int i = 0; i < 4; ++i) {
      const int sidx = (tid >> 4) + 16 * i;
      const bf16_t* src = p->P + (size_t)s_row[sidx] * LDP + h * 128 + c8 * 8;
      *(u32x4*)(kimg + sidx * 256 + ((c8 ^ (sidx & 15)) * 16)) = *(const u32x4*)(src + 2560);
      *(u32x4*)(vimg + ioff + sidx * 64) = *(const u32x4*)(src + 3072);
    }
    __builtin_amdgcn_sched_barrier(0);
    const bf16_t* Cp = p->MS + (size_t)tile * 16384;
    const int coff = (c8 >> 2) * 8192 + (c8 & 3) * 16;
#pragma unroll
    for (int i = 0; i < 8; ++i) {
      const int d = (tid >> 4) + 16 * i;
      *(u32x4*)(cimg + coff + d * 64) = *(const u32x4*)(Cp + d * 128 + c8 * 8);
      if (i == 3) __builtin_amdgcn_sched_barrier(0);
    }
    __builtin_amdgcn_sched_barrier(0);
  }
  const int lane = tid & 63, w = tid >> 6, wt = w >> 1, wv = w & 1, r32 = lane & 31, hi = lane >> 5;
  const int t = wt * 32 + r32;
  bf16x8 qf[8];
  {
    const bf16_t* qp = p->P + (size_t)s_row[t] * LDP + 2048 + h * 128 + hi * 8;
#pragma unroll
    for (int d0 = 0; d0 < 8; ++d0) qf[d0] = *(const bf16x8*)(qp + d0 * 16);
  }
  __syncthreads();
  const int toff = ((lane >> 4) & 1) * 32 + (lane & 3) * 8 + ((lane & 15) >> 2) * 64;
  constexpr float LOG2E_ = 1.4426950408889634f;
  float qn = 0.f;
#pragma unroll
  for (int d0 = 0; d0 < 8; ++d0) {
    const u32x4 qq = __builtin_bit_cast(u32x4, qf[d0]);
    const float* np = s_n + d0 * 16 + hi * 8;
    qn = fmaf(bflo(qq.x), np[0], qn); qn = fmaf(bfhi(qq.x), np[1], qn);
    qn = fmaf(bflo(qq.y), np[2], qn); qn = fmaf(bfhi(qq.y), np[3], qn);
    qn = fmaf(bflo(qq.z), np[4], qn); qn = fmaf(bfhi(qq.z), np[5], qn);
    qn = fmaf(bflo(qq.w), np[6], qn); qn = fmaf(bfhi(qq.w), np[7], qn);
  }
  qn += __shfl_xor(qn, 32);
  const float mtt = s_mt[t], wi = s_wi[t];
  const float ct = (s_b[t] - mtt) * LOG2E_;
  const float wq = wi * qscale;
  bf16x8 pf[4];
  float den = 0.f;
  {
    f32x16 sa0, sa1;
#pragma unroll
    for (int q = 0; q < 16; ++q) { sa0[q] = 0.f; sa1[q] = 0.f; }
#pragma unroll
    for (int d0 = 0; d0 < 8; ++d0) {
      const int chn = 2 * d0 + hi;
      const bf16x8 k0 = *(const bf16x8*)(kimg + r32 * 256 + ((chn ^ (r32 & 15)) * 16));
      sa0 = MFMA32(k0, qf[d0], sa0);
      if (wt) {
        const bf16x8 k1 = *(const bf16x8*)(kimg + (32 + r32) * 256 + ((chn ^ (r32 & 15)) * 16));
        sa1 = MFMA32(k1, qf[d0], sa1);
      }
      __builtin_amdgcn_sched_barrier(0);
    }
#pragma unroll
    for (int g = 0; g < 4; ++g) {
      const int sb0 = 8 * g + 4 * hi;
      const float4 c0v = *(const float4*)(s_c + sb0);
      const float4 c1v = *(const float4*)(s_c + sb0 + 32);
      const float cc0[4] = {c0v.x, c0v.y, c0v.z, c0v.w}, cc1[4] = {c1v.x, c1v.y, c1v.z, c1v.w};
#pragma unroll
      for (int e = 0; e < 4; ++e) {
        const int q = 4 * g + e;
        const float v0 = (sb0 + e <= t) ? sa0[q] * qscale * __builtin_amdgcn_exp2f(ct + cc0[e]) : 0.f;
        sa0[q] = v0; den += v0;
        const float v1 = (wt && sb0 + 32 + e <= t) ? sa1[q] * qscale * __builtin_amdgcn_exp2f(ct + cc1[e]) : 0.f;
        sa1[q] = v1; den += v1;
      }
      __builtin_amdgcn_sched_barrier(0);
    }
#pragma unroll
    for (int sx = 0; sx < 4; ++sx) {
      const int u = (sx & 1) * 8;
      u32x4 tpk;
      if (sx < 2) {
        tpk.x = pk_bf16(sa0[u + 0], sa0[u + 1]); tpk.y = pk_bf16(sa0[u + 2], sa0[u + 3]);
        tpk.z = pk_bf16(sa0[u + 4], sa0[u + 5]); tpk.w = pk_bf16(sa0[u + 6], sa0[u + 7]);
      } else {
        tpk.x = pk_bf16(sa1[u + 0], sa1[u + 1]); tpk.y = pk_bf16(sa1[u + 2], sa1[u + 3]);
        tpk.z = pk_bf16(sa1[u + 4], sa1[u + 5]); tpk.w = pk_bf16(sa1[u + 6], sa1[u + 7]);
      }
      pf[sx] = __builtin_bit_cast(bf16x8, tpk);
    }
  }
  den += __shfl_xor(den, 32);
  const float dtot = den + wq * qn;
  const float inv = 1.f / fmaxf(fabsf(dtot), expf(-mtt));
  bf16_t* op = p->P + (size_t)s_row[t] * LDP + 1024 + dir * 512 + h * 128 + wv * 64 + 4 * hi;
#pragma unroll 1
  for (int vp = 0; vp < 2; ++vp) {
    f32x16 o0;
#pragma unroll
    for (int q = 0; q < 16; ++q) o0[q] = 0.f;
    const char* cb = cimg + (wv * 2 + vp) * 8192 + toff + hi * 512;
#pragma unroll
    for (int d0 = 0; d0 < 8; ++d0) {
      const bf16x8 A0 = __builtin_shufflevector(vtr(cb + (16 * d0) * 64), vtr(cb + (16 * d0 + 4) * 64), 0, 1, 2, 3, 4, 5, 6, 7);
      o0 = MFMA32(A0, qf[d0], o0);
    }
#pragma unroll
    for (int q = 0; q < 16; ++q) o0[q] *= wq;
    const char* vb = vimg + (wv * 2 + vp) * 4096 + toff + hi * 256;
#pragma unroll
    for (int sx = 0; sx < 4; ++sx) {
      if (sx < 2 || wt) {
        const bf16x8 A0 = __builtin_shufflevector(vtr(vb + (16 * sx) * 64), vtr(vb + (16 * sx + 8) * 64), 0, 1, 2, 3, 4, 5, 6, 7);
        o0 = MFMA32(A0, pf[sx], o0);
      }
    }
#pragma unroll
    for (int g = 0; g < 4; ++g) {
      u32x2 v0;
      v0.x = pk_bf16(o0[4 * g] * inv, o0[4 * g + 1] * inv); v0.y = pk_bf16(o0[4 * g + 2] * inv, o0[4 * g + 3] * inv);
      *(u32x2*)(op + vp * 32 + 8 * g) = v0;
    }
  }
}

__device__ void ph_mlstm_s3(KP p, int layer, char* smc) {
  const int tid = opaque_tid();
  for (int tile = blockIdx.x; tile < NMT; tile += gridDim.x) { mlstm_s3(p, layer, tile, smc, tid); __syncthreads(); }
}

__device__ void ph_rec_final(KP p, int layer, bool keep) {
  const int tid = opaque_tid();
  const int j = layer >> 1;
  const int lane = tid & 63, wave = tid >> 6;
  const int rows = keep ? NT : NL;
  const int c0 = lane * 8;
  auto unpack = [](const u32x4 u, float (&f)[8]) {
    f[0] = bflo(u.x); f[1] = bfhi(u.x); f[2] = bflo(u.y); f[3] = bfhi(u.y);
    f[4] = bflo(u.z); f[5] = bfhi(u.z); f[6] = bflo(u.w); f[7] = bfhi(u.w);
  };
  for (int t = blockIdx.x * 4 + wave; t < rows; t += gridDim.x * 4) {
    const bf16_t* rw = p->RW + (size_t)t * RWS + c0;
    const bf16_t* pt = p->P + (size_t)t * LDP + c0;
    bf16_t* mo = p->AB + (size_t)t * DM + c0;
    {
      float yf[8], yb[8], r[8], v[8], k0[8], k1[8], g[8], y[8], o[8];
      unpack(*(const u32x4*)(pt), yf); unpack(*(const u32x4*)(pt + 512), yb);
      unpack(*(const u32x4*)(rw), r); unpack(*(const u32x4*)(rw + 512), v);
      unpack(*(const u32x4*)(rw + 5 * 512), k0); unpack(*(const u32x4*)(rw + 6 * 512), k1);
      unpack(*(const u32x4*)(rw + 9 * 512), g);
      float s1 = 0.f, bs = 0.f;
      const float* rk = p->rwkv_rk + j * 512 + c0;
#pragma unroll
      for (int e = 0; e < 8; ++e) { y[e] = yf[e] + yb[e]; s1 += y[e]; bs += r[e] * rk[e] * (k0[e] + k1[e]); }
      s1 += dppx<0xB1>(s1); s1 += dppx<0x4E>(s1); s1 += dppx<0x141>(s1);
      bs += dppx<0xB1>(bs); bs += dppx<0x4E>(bs); bs += dppx<0x141>(bs);
      const float mu = s1 * (1.f / 64.f);
      float s2 = 0.f;
#pragma unroll
      for (int e = 0; e < 8; ++e) { const float d = y[e] - mu; s2 += d * d; }
      s2 += dppx<0xB1>(s2); s2 += dppx<0x4E>(s2); s2 += dppx<0x141>(s2);
      const float rs = rsqrtf(s2 * (1.f / 64.f) + 64e-5f);
      const float* gn0 = p->rwkv_gn + (j * 2 + 0) * 512 + c0;
      const float* gn1 = p->rwkv_gn + (j * 2 + 1) * 512 + c0;
#pragma unroll
      for (int e = 0; e < 8; ++e) o[e] = ((y[e] - mu) * rs * gn0[e] + gn1[e] + bs * v[e]) * g[e];
      u32x4 ov;
      ov.x = pk_bf16(o[0], o[1]); ov.y = pk_bf16(o[2], o[3]); ov.z = pk_bf16(o[4], o[5]); ov.w = pk_bf16(o[6], o[7]);
      *(u32x4*)(mo) = ov;
    }
    {
      float hf[8], hb[8], og[8], hsum[8], o[8];
      unpack(*(const u32x4*)(pt + 1024), hf); unpack(*(const u32x4*)(pt + 1536), hb);
      unpack(*(const u32x4*)(pt + 3584), og);
      float ss = 0.f;
#pragma unroll
      for (int e = 0; e < 8; ++e) { hsum[e] = hf[e] + hb[e]; ss += hsum[e] * hsum[e]; }
      ss += dppx<0xB1>(ss); ss += dppx<0x4E>(ss); ss += dppx<0x141>(ss); ss += dppx<0x140>(ss);
      const float rs = rsqrtf(ss * (1.f / 128.f) + 1e-6f);
      const float* ng = p->mlstm_norm + j * 512 + c0;
#pragma unroll
      for (int e = 0; e < 8; ++e) o[e] = hsum[e] * rs * ng[e] * sigm_f(og[e]);
      u32x4 ov;
      ov.x = pk_bf16(o[0], o[1]); ov.y = pk_bf16(o[2], o[3]); ov.z = pk_bf16(o[4], o[5]); ov.w = pk_bf16(o[6], o[7]);
      *(u32x4*)(mo + 512) = ov;
    }
  }
}

using f32x4v = __attribute__((ext_vector_type(4))) float;
__device__ void ph_ln_router(KP p, int layer, bool keep, char* smc) {
  float* h2s = (float*)smc;
  float* lgs = (float*)smc;
  const int tid = opaque_tid();
  const int lane = tid & 63, wave = tid >> 6;
  const int rows = keep ? NT : NL;
  const float* lng = p->ln_g + (layer * 2 + 0) * 1024;
  const float* lnb = p->ln_b + (layer * 2 + 0) * 1024;
  const float* Wr = p->moe_router + (size_t)layer * 1024 * 64;
  for (int tile = blockIdx.x; tile < rows / 16; tile += gridDim.x) {
    const int t0 = tile * 16;
    const float* mod = p->MOD + (layer * 9 + modrow(t0)) * 6144;
#pragma unroll 1
    for (int q = 0; q < 4; ++q) {
      const int tl = wave * 4 + q, t = t0 + tl;
      float4 v[4];
      float s = 0.f;
#pragma unroll
      for (int i = 0; i < 4; ++i) {
        v[i] = *(const float4*)(p->Tb + (size_t)t * DM + i * 256 + lane * 4);
        s += (v[i].x + v[i].y) + (v[i].z + v[i].w);
      }
      const float mean = wsum(s) * (1.f / 1024.f);
      float qq = 0.f;
#pragma unroll
      for (int i = 0; i < 4; ++i) {
        const float d0 = v[i].x - mean, d1 = v[i].y - mean, d2 = v[i].z - mean, d3 = v[i].w - mean;
        qq += (d0 * d0 + d1 * d1) + (d2 * d2 + d3 * d3);
      }
      const float rs = rsqrtf(wsum(qq) * (1.f / 1024.f) + 1e-5f);
#pragma unroll
      for (int i = 0; i < 4; ++i) {
        const int n = i * 256 + lane * 4;
        const float4 g = *(const float4*)(lng + n), bb = *(const float4*)(lnb + n);
        const float4 sc = *(const float4*)(mod + 4096 + n), sh = *(const float4*)(mod + 3072 + n);
        const float4 xn = make_float4((v[i].x - mean) * rs * g.x + bb.x, (v[i].y - mean) * rs * g.y + bb.y,
                                      (v[i].z - mean) * rs * g.z + bb.z, (v[i].w - mean) * rs * g.w + bb.w);
        *(float4*)(p->X + (size_t)t * DM + n) = xn;
        const float4 hh = make_float4(xn.x * (1.f + sc.x) + sh.x, xn.y * (1.f + sc.y) + sh.y,
                                      xn.z * (1.f + sc.z) + sh.z, xn.w * (1.f + sc.w) + sh.w);
        u32x2 o; o.x = pk_bf16(hh.x, hh.y); o.y = pk_bf16(hh.z, hh.w);
        *(u32x2*)(p->AB + (size_t)t * DM + n) = o;
        *(float4*)(h2s + tl * 1028 + n) = hh;
      }
    }
    __syncthreads();
    f32x4v acc = {0.f, 0.f, 0.f, 0.f};
    {
      f32x4v a1 = {0.f, 0.f, 0.f, 0.f}, a2 = {0.f, 0.f, 0.f, 0.f}, a3 = {0.f, 0.f, 0.f, 0.f};
      const int i = lane & 15, kk = lane >> 4;
      const float* arow = h2s + i * 1028 + 4 * kk;
      const float* bcol = Wr + (4 * kk) * 64 + 16 * wave + i;
#pragma unroll 4
      for (int q = 0; q < 64; ++q) {
        const float4 a = *(const float4*)(arow + 16 * q);
        const float b0 = bcol[(16 * q + 0) * 64], b1 = bcol[(16 * q + 1) * 64];
        const float b2 = bcol[(16 * q + 2) * 64], b3 = bcol[(16 * q + 3) * 64];
        acc = __builtin_amdgcn_mfma_f32_16x16x4f32(a.x, b0, acc, 0, 0, 0);
        a1 = __builtin_amdgcn_mfma_f32_16x16x4f32(a.y, b1, a1, 0, 0, 0);
        a2 = __builtin_amdgcn_mfma_f32_16x16x4f32(a.z, b2, a2, 0, 0, 0);
        a3 = __builtin_amdgcn_mfma_f32_16x16x4f32(a.w, b3, a3, 0, 0, 0);
      }
      acc = (acc + a1) + (a2 + a3);
    }
    __syncthreads();
#pragma unroll
    for (int r = 0; r < 4; ++r) lgs[((lane >> 4) * 4 + r) * 64 + 16 * wave + (lane & 15)] = acc[r];
    __syncthreads();
#pragma unroll 1
    for (int q = 0; q < 4; ++q) {
      const int tl = wave * 4 + q, t = t0 + tl;
      const float logit = lgs[tl * 64 + lane];
      const float score = sigm_f(logit);
      float sel = score + p->moe_bias[layer * 64 + lane];
      bool chosen = false;
      for (int r = 0; r < 6; ++r) {
        const float mx = wmax(sel);
        const unsigned long long bal = __ballot(sel == mx);
        const int first = __ffsll((long long)bal) - 1;
        if (lane == first) { chosen = true; sel = -INFINITY; }
      }
      const float gsum = wsum(chosen ? score : 0.f);
      const unsigned long long cb = __ballot(chosen);
      if (chosen) {
        const int kidx = __popcll(cb & ((1ull << lane) - 1ull));
        const int pos = atomicAdd(&p->cnt[lane], 1);
        p->ltok[(size_t)lane * NT + pos] = t;
        p->lgate[(size_t)lane * NT + pos] = score / gsum * 2.5f;
        p->tsl[t * 6 + kidx] = (lane << 16) | pos;
      }
    }
    __syncthreads();
  }
}

__device__ __forceinline__ void moe_prefix(KP p, int rows, int* s_pref, int tid) {
  if (tid == 0) {
    int a = 0;
    for (int e = 0; e < 64; ++e) { s_pref[e] = a; a += (p->cnt[e] + 127) >> 7; }
    s_pref[64] = a; a += rows >> 7;
    s_pref[65] = a;
  }
  __syncthreads();
}

__device__ void ph_gemm(KP p, int kind, int layer, bool keep, char* lds) {
  const int tid = opaque_tid();
  const int j = layer >> 1;
  const bool att = !(layer & 1);
  const int rows = keep ? NT : NL;
  int* pref = (int*)(lds + META_OFF);
  int* s_idx = pref + 66;
  float* s_gate = (float*)(s_idx + 128);
  if (kind == 1 && blockIdx.x == 0 && tid < 65) p->cnt[tid] = 0;
  if (kind == 2 || kind == 3) moe_prefix(p, rows, pref, tid);
  int total;
  const int ntn_in = att ? 18 : 33;
  switch (kind) {
    case 0: total = (NT / 128) * ntn_in; break;
    case 1: total = (rows / 128) * 8; break;
    case 2: total = pref[65] * 4; break;
    case 3: total = pref[65] * 8; break;
    case 4: total = (NT / 128) * 3; break;
    default: total = (NT / 128) * 20; break;
  }
  for (int tile = blockIdx.x; tile < total; tile += gridDim.x) {
    const bf16_t* Abase; const bf16_t* Bt;
    int astride, K, n0, m0 = 0, aux = 0, e = 0, mtile = 0;
    switch (kind) {
      case 0: { const int tm = tile / ntn_in, tn = tile % ntn_in; m0 = tm * 128; n0 = tn * 128;
                Abase = p->AB + (size_t)m0 * DM; astride = DM; K = 1024;
                Bt = att ? p->Wt_att + (size_t)j * ATT_N * 1024 : p->Wt_rec + (size_t)j * REC_NP * 1024; } break;
      case 1: { const int tm = tile >> 3, tn = tile & 7; m0 = tm * 128; n0 = tn * 128;
                Abase = p->AB + (size_t)m0 * DM; astride = DM; K = 1024; Bt = p->Wt_out + (size_t)layer * 1024 * 1024; } break;
      case 2: { mtile = tile >> 2; aux = tile & 3; n0 = aux * 128; while (mtile >= pref[e + 1]) ++e;
                Abase = p->AB; astride = DM; K = 1024; Bt = p->Wt13 + (size_t)(layer * 65 + e) * 512 * 1024; } break;
      case 3: { mtile = tile >> 3; aux = tile & 7; n0 = aux * 128; while (mtile >= pref[e + 1]) ++e;
                Abase = p->ACT + (size_t)mtile * 128 * 256; astride = 256; K = 256; Bt = p->Wt2 + (size_t)(layer * 65 + e) * 1024 * 256; } break;
      case 4: { const int tm = tile / 3; aux = tile % 3; m0 = tm * 128; n0 = 0;
                Abase = p->Zb + (size_t)m0 * 1536 + aux * 512; astride = 1536; K = 512; Bt = p->Wl1 + (size_t)(j * 3 + aux) * 128 * 512; } break;
      default: { const int tm = tile / 20; aux = tile % 20; m0 = tm * 128; n0 = aux * 128;
                const int grp = aux < 8 ? 0 : (aux < 16 ? 1 : 2);
                Abase = p->L1 + (size_t)m0 * 384 + grp * 128; astride = 384; K = 128; Bt = p->Wl2 + (size_t)j * 2560 * 128; } break;
    }
    if (tid < 128) {
      int idx = tid; float g = 1.f;
      if (kind == 2 || kind == 3) {
        const int pos = (mtile - pref[e]) * 128 + tid;
        if (kind == 2) {
          idx = 0;
          if (e < 64) { if (pos < p->cnt[e]) idx = p->ltok[(size_t)e * NT + pos]; }
          else idx = pos;
        } else if (e < 64) g = pos < p->cnt[e] ? p->lgate[(size_t)e * NT + pos] : 0.f;
      }
      s_idx[tid] = idx; s_gate[tid] = g;
    }
    __syncthreads();
    {
      f32x16 acc[2][2];
      gemm128_main(tid, [&](int r) { return Abase + (size_t)s_idx[r] * astride; }, Bt, K, n0, lds, acc);
      float* Ct = (float*)lds;
      acc_foreach(tid, acc, [&](int row, int col, float v) { Ct[row * 128 + col] = v; });
    }
    __syncthreads();
    {
      const float* Ct = (const float*)lds;
      const int c4 = (tid & 31) * 4, r0 = tid >> 5;
      const int N_in = att ? ATT_N : REC_N;
      const int d5 = (aux >> 2) & 1, c05 = (aux & 3) * 128;
#pragma unroll 2
      for (int it = 0; it < 16; ++it) {
        const int row = it * 8 + r0;
        const float4 v = *(const float4*)(Ct + row * 128 + c4);
        switch (kind) {
          case 0: {
            const int cn = n0 + c4;
            float4 vq = v;
            if (att && n0 >= 1536 && n0 < 2176) {
              float ss = v.x * v.x + v.y * v.y + v.z * v.z + v.w * v.w;
              ss += dppx<0xB1>(ss); ss += dppx<0x4E>(ss); ss += dppx<0x141>(ss); ss += dppx<0x140>(ss);
              const float rs = rsqrtf(ss * (1.f / 64.f) + 1e-6f);
              const float4 g = *(const float4*)(p->qk_gain + j * 128 + (n0 >= 2048 ? 64 : 0) + (cn & 63));
              vq = make_float4(v.x * rs * g.x, v.y * rs * g.y, v.z * rs * g.z, v.w * rs * g.w);
              const int t = m0 + row;
              if (t < NL) {
                const int sidx = t & 2047, pi0 = (cn & 63) >> 1;
                const int pos = pi0 < 16 ? (sidx >> 6) : (sidx & 63);
                const float4 cs = *(const float4*)(p->ROPE + (pos * 16 + (pi0 & 15)) * 2);
                vq = make_float4(vq.x * cs.x - vq.y * cs.y, vq.x * cs.y + vq.y * cs.x,
                                 vq.z * cs.z - vq.w * cs.w, vq.z * cs.w + vq.w * cs.z);
              }
            }
            if (cn < N_in) {
              u32x2 o; o.x = pk_bf16(vq.x, vq.y); o.y = pk_bf16(vq.z, vq.w);
              *(u32x2*)(p->P + (size_t)(m0 + row) * LDP + cn) = o;
            }
            if (!att && cn >= 4096 && cn < 4112) *(float4*)(p->GP + (size_t)(m0 + row) * 16 + (cn - 4096)) = v;
          } break;
          case 1: {
            const size_t o = (size_t)(m0 + row) * DM + n0 + c4;
            const float4 xv = *(const float4*)(p->X + o);
            const float4 g = *(const float4*)(p->MOD + (layer * 9 + modrow(m0)) * 6144 + 2048 + n0 + c4);
            *(float4*)(p->Tb + o) = make_float4(DN_ALPHA * xv.x + g.x * v.x, DN_ALPHA * xv.y + g.y * v.y,
                                                DN_ALPHA * xv.z + g.z * v.z, DN_ALPHA * xv.w + g.w * v.w);
          } break;
          case 2: {
            if (((c4 >> 5) & 1) == 0) {
              const float4 u = *(const float4*)(Ct + row * 128 + c4 + 32);
              u32x2 o;
              o.x = pk_bf16(silu_f(v.x) * u.x, silu_f(v.y) * u.y);
              o.y = pk_bf16(silu_f(v.z) * u.z, silu_f(v.w) * u.w);
              *(u32x2*)(p->ACT + ((size_t)mtile * 128 + row) * 256 + aux * 64 + (c4 >> 6) * 32 + (c4 & 31)) = o;
            }
          } break;
          case 3: {
            const float g = s_gate[row];
            u32x2 o; o.x = pk_bf16(g * v.x, g * v.y); o.y = pk_bf16(g * v.z, g * v.w);
            *(u32x2*)(p->OUT2 + ((size_t)mtile * 128 + row) * 1024 + n0 + c4) = o;
          } break;
          case 4: {
            float4 o4 = v;
            if (aux == 0) o4 = make_float4(tanhf(v.x), tanhf(v.y), tanhf(v.z), tanhf(v.w));
            else if (aux == 2) o4 = make_float4(sigm_f(v.x), sigm_f(v.y), sigm_f(v.z), sigm_f(v.w));
            u32x2 o; o.x = pk_bf16(o4.x, o4.y); o.y = pk_bf16(o4.z, o4.w);
            *(u32x2*)(p->L1 + (size_t)(m0 + row) * 384 + aux * 128 + c4) = o;
          } break;
          default: {
            bf16_t* rr = p->RW + (size_t)(m0 + row) * RWS + c05 + c4;
            const float vv[4] = {v.x, v.y, v.z, v.w};
            if (aux < 8) {
              const float4 b0 = *(const float4*)(p->rwkv_w0 + (j * 2 + d5) * 512 + c05 + c4);
              const float bb[4] = {b0.x, b0.y, b0.z, b0.w};
              float e4[4];
#pragma unroll
              for (int q = 0; q < 4; ++q) e4[q] = expf(-softplus_f(-(bb[q] + vv[q])) - 0.5f);
              u32x2 o; o.x = pk_bf16(e4[0], e4[1]); o.y = pk_bf16(e4[2], e4[3]);
              *(u32x2*)(rr + (3 + d5) * 512) = o;
            } else if (aux < 16) {
              const float4 b0 = *(const float4*)(p->rwkv_a0 + (j * 2 + d5) * 512 + c05 + c4);
              const float4 k1 = *(const float4*)(p->rwkv_kvec + (j * 2 + 1) * 512 + c05 + c4);
              const u32x2 kx2 = *(const u32x2*)(rr + 10 * 512);
              const float bb[4] = {b0.x, b0.y, b0.z, b0.w}, kk1[4] = {k1.x, k1.y, k1.z, k1.w};
              const float kx[4] = {bflo(kx2.x), bfhi(kx2.x), bflo(kx2.y), bfhi(kx2.y)};
              float av[4], ke[4];
#pragma unroll
              for (int q = 0; q < 4; ++q) { av[q] = sigm_f(bb[q] + vv[q]); ke[q] = kx[q] * (1.f + (av[q] - 1.f) * kk1[q]); }
              u32x2 o; o.x = pk_bf16(av[0], av[1]); o.y = pk_bf16(av[2], av[3]);
              *(u32x2*)(rr + (7 + d5) * 512) = o;
              o.x = pk_bf16(ke[0], ke[1]); o.y = pk_bf16(ke[2], ke[3]);
              *(u32x2*)(rr + (5 + d5) * 512) = o;
            } else {
              u32x2 o; o.x = pk_bf16(v.x, v.y); o.y = pk_bf16(v.z, v.w);
              *(u32x2*)(rr + 9 * 512) = o;
            }
          } break;
        }
      }
    }
    __syncthreads();
  }
}

__device__ void ph_final_ln(KP p, int layer, bool keep, char* lds) {
  const int tid = opaque_tid();
  const int lane = tid & 63, wave = tid >> 6;
  const int rows = keep ? NT : NL;
  int* s_base = (int*)(lds + META_OFF);
  if (tid == 0) {
    int a = 0;
    for (int e = 0; e < 64; ++e) { s_base[e] = a * 128; a += (p->cnt[e] + 127) >> 7; }
    s_base[64] = a * 128;
  }
  __syncthreads();
  const float* lng = p->ln_g + (layer * 2 + 1) * 1024;
  const float* lnb = p->ln_b + (layer * 2 + 1) * 1024;
  for (int t = blockIdx.x * 4 + wave; t < rows; t += gridDim.x * 4) {
    const int mr = modrow(t);
    const float* g2 = p->MOD + (layer * 9 + mr) * 6144 + 5120;
    const bf16_t* src[7];
#pragma unroll
    for (int k = 0; k < 6; ++k) {
      const int v = p->tsl[t * 6 + k];
      src[k] = p->OUT2 + (size_t)(s_base[v >> 16] + (v & 0xffff)) * 1024;
    }
    src[6] = p->OUT2 + (size_t)(s_base[64] + t) * 1024;
    float v[16];
    float s = 0.f;
#pragma unroll
    for (int c = 0; c < 2; ++c) {
      const int n0 = c * 512 + lane * 8;
      float y[8];
#pragma unroll
      for (int q = 0; q < 8; ++q) y[q] = 0.f;
#pragma unroll
      for (int k = 0; k < 7; ++k) {
        const u32x4 u = *(const u32x4*)(src[k] + n0);
        y[0] += bflo(u.x); y[1] += bfhi(u.x); y[2] += bflo(u.y); y[3] += bfhi(u.y);
        y[4] += bflo(u.z); y[5] += bfhi(u.z); y[6] += bflo(u.w); y[7] += bfhi(u.w);
      }
      const float4 xa = *(const float4*)(p->X + (size_t)t * DM + n0), xb = *(const float4*)(p->X + (size_t)t * DM + n0 + 4);
      const float4 ga = *(const float4*)(g2 + n0), gb = *(const float4*)(g2 + n0 + 4);
      const float xx[8] = {xa.x, xa.y, xa.z, xa.w, xb.x, xb.y, xb.z, xb.w};
      const float gg[8] = {ga.x, ga.y, ga.z, ga.w, gb.x, gb.y, gb.z, gb.w};
#pragma unroll
      for (int q = 0; q < 8; ++q) { v[c * 8 + q] = DN_ALPHA * xx[q] + gg[q] * y[q]; s += v[c * 8 + q]; }
    }
    const float mean = wsum(s) * (1.f / 1024.f);
    float q2 = 0.f;
#pragma unroll
    for (int i = 0; i < 16; ++i) { const float d = v[i] - mean; q2 += d * d; }
    const float rs = rsqrtf(wsum(q2) * (1.f / 1024.f) + 1e-5f);
    const float* modn = p->MOD + ((layer + 1) * 9 + mr) * 6144;
#pragma unroll
    for (int c = 0; c < 2; ++c) {
      const int n0 = c * 512 + lane * 8;
      float xn[8];
#pragma unroll
      for (int q = 0; q < 8; ++q) xn[q] = (v[c * 8 + q] - mean) * rs * lng[n0 + q] + lnb[n0 + q];
      *(float4*)(p->X + (size_t)t * DM + n0) = make_float4(xn[0], xn[1], xn[2], xn[3]);
      *(float4*)(p->X + (size_t)t * DM + n0 + 4) = make_float4(xn[4], xn[5], xn[6], xn[7]);
      if (layer == 3) {
        *(float4*)(p->out + (size_t)t * DM + n0) = make_float4(xn[0], xn[1], xn[2], xn[3]);
        *(float4*)(p->out + (size_t)t * DM + n0 + 4) = make_float4(xn[4], xn[5], xn[6], xn[7]);
      } else {
        float hb[8];
#pragma unroll
        for (int q = 0; q < 8; ++q) hb[q] = xn[q] * (1.f + modn[1024 + n0 + q]) + modn[n0 + q];
        u32x4 o;
        o.x = pk_bf16(hb[0], hb[1]); o.y = pk_bf16(hb[2], hb[3]); o.z = pk_bf16(hb[4], hb[5]); o.w = pk_bf16(hb[6], hb[7]);
        *(u32x4*)(p->AB + (size_t)t * DM + n0) = o;
      }
    }
  }
}

#define XB_TMO      128
#define XB_XCNT(j)  (256  + 64 * (j))
#define XB_XSUB(j)  (1280 + 64 * (j))
#define XB_XGEN(j)  (2304 + 64 * (j))
#define XB_TOP      3328
#define XB_TOPGEN   3392
#define XB_SPIN_CAP (1u << 20)
#define LAS __attribute__((address_space(3)))
__device__ __forceinline__ unsigned xb_ld(unsigned* p) { return __hip_atomic_load(p, __ATOMIC_RELAXED, __HIP_MEMORY_SCOPE_AGENT); }
__device__ __forceinline__ unsigned xb_add(unsigned* p, unsigned v) { return __hip_atomic_fetch_add(p, v, __ATOMIC_RELAXED, __HIP_MEMORY_SCOPE_AGENT); }
__device__ __forceinline__ unsigned xb_xcc_id() { return (unsigned)__builtin_amdgcn_s_getreg((3 << 11) | 20) & 0xFu; }
#define XB_SPIN(cond, bar) do { unsigned _sp = 0; while (cond) { __builtin_amdgcn_s_sleep(1); \
    if ((++_sp & 255u) == 0u) { if (xb_ld(&(bar)[XB_TMO])) break; if (_sp > XB_SPIN_CAP) { atomicAdd(&(bar)[XB_TMO], 1u); break; } } } } while (0)
struct XcdBarrier { unsigned* bar; unsigned x; volatile LAS unsigned* st; };
__device__ __forceinline__ XcdBarrier xcd_barrier_post(unsigned* bar, volatile LAS unsigned* st) {
  XcdBarrier b; b.bar = bar; b.x = xb_xcc_id(); b.st = st;
  if (threadIdx.x == 0) (void)xb_add(&bar[XB_XCNT(b.x)], 1u);
  return b;
}
__device__ __forceinline__ void xcd_barrier_complete(unsigned* bar, unsigned x, unsigned& nloc, unsigned& nx) {
  const unsigned G = gridDim.x;
  unsigned sum, cnt, mine, sp = 0u;
  for (;;) {
    sum = 0u; cnt = 0u; mine = 0u;
#pragma unroll
    for (unsigned j = 0; j < 16; ++j) { const unsigned c = xb_ld(&bar[XB_XCNT(j)]); sum += c; cnt += (c > 0u) ? 1u : 0u; mine = (j == x) ? c : mine; }
    if (sum == G) break;
    __builtin_amdgcn_s_sleep(1);
    if ((++sp & 255u) == 0u) { if (xb_ld(&bar[XB_TMO])) break; if (sp > XB_SPIN_CAP) { atomicAdd(&bar[XB_TMO], 1u); break; } }
  }
  nloc = mine > 0u ? mine : 1u; nx = cnt > 0u ? cnt : 1u;
}
__device__ __forceinline__ void xcd_barrier(const XcdBarrier& b) {
  asm volatile("s_waitcnt vmcnt(0)" ::: "memory");
  __syncthreads();
  if (threadIdx.x == 0) {
    unsigned* bar = b.bar;
    __builtin_amdgcn_s_waitcnt(0);
    unsigned nloc = b.st[0], nx = b.st[1];
    if (nloc == 0u) { xcd_barrier_complete(bar, b.x, nloc, nx); b.st[0] = nloc; b.st[1] = nx; }
    const unsigned old = xb_add(&bar[XB_XSUB(b.x)], 1u);
    const unsigned gen = old / nloc;
    if (old + 1u == (gen + 1u) * nloc) {
      __builtin_amdgcn_fence(__ATOMIC_RELEASE, "agent");
      asm volatile("s_waitcnt vmcnt(0)" ::: "memory");
      const unsigned og = xb_add(&bar[XB_TOP], 1u);
      const unsigned tg = og / nx;
      if (og + 1u == (tg + 1u) * nx) xb_add(&bar[XB_TOPGEN], 1u);
      else XB_SPIN(xb_ld(&bar[XB_TOPGEN]) == tg, bar);
      __builtin_amdgcn_fence(__ATOMIC_ACQUIRE, "agent");
      xb_add(&bar[XB_XGEN(b.x)], 1u);
      asm volatile("s_waitcnt vmcnt(0)" ::: "memory");
    } else {
      XB_SPIN(xb_ld(&bar[XB_XGEN(b.x)]) == gen, bar);
      __builtin_amdgcn_fence(__ATOMIC_ACQUIRE, "agent");
      asm volatile("s_waitcnt vmcnt(0)" ::: "memory");
    }
  }
  __syncthreads();
}

constexpr int NSLOTS = 13;
constexpr int NPHASE = 2 + 4 * NSLOTS;
__device__ __forceinline__ bool phase_is_nop(int ph) {
  if (ph < 2) return false;
  const int layer = (ph - 2) / NSLOTS, st = (ph - 2) % NSLOTS;
  return !(layer & 1) && (st == 1 || (st >= 3 && st <= 7));
}
__device__ void run_phase(KP p, int ph, char* sm) {
  if (ph == 0) { ph_init(p, sm); return; }
  if (ph == 1) { ph_mod_h(p, sm); return; }
  const int layer = (ph - 2) / NSLOTS, st = (ph - 2) % NSLOTS;
  const bool odd = layer & 1;
  const bool keep = layer < 3;
  int gk = -1;
  if (st == 0) gk = 0;
  else if (st == 8) gk = 1;
  else if (st == 10) gk = 2;
  else if (st == 11) gk = 3;
  else if (odd && st == 2) gk = 4;
  else if (odd && st == 3) gk = 5;
  asm volatile("" : "+s"(gk));
  if (gk >= 0) { ph_gemm(p, gk, layer, keep, sm); return; }
  switch (st) {
    case 1: if (odd) ph_rwkv_mix(p, layer); break;
    case 2: ph_attention(p, layer, keep, sm); break;
    case 4: if (odd) ph_scan_a(p, layer, sm); break;
    case 5: if (odd) ph_mlstm_s2(p, sm); break;
    case 6: if (odd) ph_mlstm_s3(p, layer, sm); break;
    case 7: if (odd) ph_rec_final(p, layer, keep); break;
    case 9: ph_ln_router(p, layer, keep, sm); break;
    case 12: ph_final_ln(p, layer, keep, sm); break;
  }
}

__global__ void __launch_bounds__(NTHR, 2) mega_kernel(Params kargs) {
  extern __shared__ __attribute__((aligned(16))) char sm[];
  cg::grid_group grid = cg::this_grid();
  volatile LAS unsigned* st = (volatile LAS unsigned*)(sm + META_OFF + 4032);
  if (threadIdx.x == 0) { st[0] = 0u; st[1] = 0u; }
  __syncthreads();
  const XcdBarrier xb = xcd_barrier_post(kargs.bar, st);
  for (int ph = kargs.ph_lo; ph < kargs.ph_hi; ++ph) {
    if (phase_is_nop(ph)) continue;
    {
      KP kp = (KP)__builtin_amdgcn_kernarg_segment_ptr();
      asm volatile("" : "+s"(kp));
      run_phase(kp, ph, sm);
    }
    if (ph + 1 < kargs.ph_hi) {
      if (ph == 0) grid.sync();
      else xcd_barrier(xb);
    }
  }
}

extern "C" void kernel_launch(void* const* d_in, const int* in_sizes, int n_in, void* d_out, int out_size, void* d_ws,
                              size_t ws_size, hipStream_t stream) {
  static int grid_blocks = 0;
  if (!grid_blocks) {
    int dev = 0, cus = 0, per_cu = 0;
    (void)hipGetDevice(&dev);
    (void)hipDeviceGetAttribute(&cus, hipDeviceAttributeMultiprocessorCount, dev);
    (void)hipFuncSetAttribute((const void*)mega_kernel, hipFuncAttributeMaxDynamicSharedMemorySize, SMEM_BYTES);
    (void)hipOccupancyMaxActiveBlocksPerMultiprocessor(&per_cu, mega_kernel, NTHR, SMEM_BYTES);
    if (per_cu < 1) per_cu = 1;
    if (per_cu > 2) per_cu = 2;
    grid_blocks = cus * per_cu;
  }
  Params p;
  memset(&p, 0, sizeof(p));
  const float** pin = (const float**)&p;
  for (int i = 0; i < 35; ++i) pin[i] = (const float*)d_in[i];
  p.out = (float*)d_out;
  char* w = (char*)d_ws;
  size_t off = 0;
  auto take = [&](size_t bytes) { char* r = w + off; off += (bytes + 255) & ~(size_t)255; return r; };
  p.Wt_att = (bf16_t*)take((size_t)2 * ATT_N * 1024 * 2);
  p.Wt_rec = (bf16_t*)take((size_t)2 * REC_NP * 1024 * 2);
  p.Wt_out = (bf16_t*)take((size_t)4 * 1024 * 1024 * 2);
  p.Wt13 = (bf16_t*)take((size_t)4 * 65 * 512 * 1024 * 2);
  p.Wt2 = (bf16_t*)take((size_t)4 * 65 * 1024 * 256 * 2);
  p.Wl1 = (bf16_t*)take((size_t)2 * 3 * 128 * 512 * 2);
  p.Wl2 = (bf16_t*)take((size_t)2 * 2560 * 128 * 2);
  p.X = (float*)take((size_t)NT * DM * 4);
  p.AB = (bf16_t*)take((size_t)NT * DM * 2);
  p.MOD = (float*)take((size_t)5 * 9 * 6144 * 4);
  p.MODP = (float*)take((size_t)8 * 4 * 9 * 6144 * 4);
  p.GP = (float*)take((size_t)NT * 16 * 4);
  p.ROPE = (float*)take((size_t)64 * 16 * 2 * 4);
  p.msc = (float*)take((size_t)3 * NMT * 4);
  p.lgate = (float*)take((size_t)64 * NT * 4);
  p.ltok = (int*)take((size_t)64 * NT * 4);
  p.tsl = (int*)take((size_t)NT * 6 * 4);
  p.cnt = (int*)take(512);
  p.bar = (unsigned*)take((size_t)BAR_TOTAL_WORDS * 4);
  char* region = take(0);
  const size_t szP = (size_t)NT * LDP * 2, szRW = (size_t)NT * RWS * 2, szMS = (size_t)NMT * 16384 * 2,
               szMSn = (size_t)NMT * 128 * 4;
  const size_t szT = (size_t)NT * DM * 4, szOUT2 = (size_t)NSLOT * 1024 * 2;
  p.P = (bf16_t*)region;
  p.RW = (bf16_t*)(region + szP);
  p.MS = (bf16_t*)(region + szP + szRW);
  p.MSn = (float*)(region + szP + szRW + szMS);
  p.Zb = p.MS;
  p.L1 = p.MS + (size_t)NT * 1536;
  p.Tb = (float*)region;
  p.ACT = (bf16_t*)region;
  p.OUT2 = (bf16_t*)(region + szT);
  size_t mixer = szP + szRW + szMS + szMSn, moe = szT + szOUT2;
  off += (mixer > moe ? mixer : moe);
  if (off > ws_size) { fprintf(stderr, "workspace too small: need %zu have %zu\n", off, ws_size); return; }
  p.ph_lo = 0;
  p.ph_hi = NPHASE;
  (void)hipMemsetAsync(p.bar, 0, (size_t)BAR_TOTAL_WORDS * 4, stream);
  void* args[] = {&p};
  hipError_t e = hipLaunchCooperativeKernel((void*)mega_kernel, dim3(grid_blocks), dim3(NTHR), args, SMEM_BYTES, stream);
  if (e != hipSuccess) fprintf(stderr, "cooperative launch failed: %s (grid %d)\n", hipGetErrorString(e), grid_blocks);
}
```

```cpp
#include <hip/hip_runtime.h>
#include <hip/hip_cooperative_groups.h>
#include <cstdio>
#include <cstring>
namespace cg = cooperative_groups;

constexpr int DM = 1024;
constexpr int NBATCH = 8;
constexpr int SEQ = 2048;
constexpr int CTXL = 256;
constexpr int NL = NBATCH * SEQ;
constexpr int NC = NBATCH * CTXL;
constexpr int NT = NL + NC;
constexpr int TSC = CTXL + SEQ;
constexpr int LDP = 4112;
constexpr int ATT_N = 2304;
constexpr int REC_N = 4112;
constexpr int REC_NP = 4224;
constexpr int NCHUNK = 36;
constexpr int NMT = 64 * NCHUNK;
constexpr int RWS = 5632;
constexpr int NSLOT = 137216;
constexpr float DN_ALPHA = 1.6817928305074290f;
constexpr int NTHR = 256;
constexpr int SMEM_BYTES = 65536 + 4096;
constexpr int META_OFF = 65536;
#define XCD_BAR_WORDS 3456
constexpr int BAR_TOTAL_WORDS = XCD_BAR_WORDS + 64;

typedef unsigned short bf16_t;
using bf16x8 = __attribute__((ext_vector_type(8))) short;
using f32x16 = __attribute__((ext_vector_type(16))) float;
using u32x4 = __attribute__((ext_vector_type(4))) unsigned;
using u32x2 = __attribute__((ext_vector_type(2))) unsigned;

struct Params {
  const float *x, *c, *ctx, *c_ctx, *ada_w, *ada_b, *ln_g, *ln_b, *mix_w_out, *att_w_in, *na_rpb, *qk_gain,
      *rec_w_in, *rwkv_mu, *rwkv_w0, *rwkv_w1, *rwkv_w2, *rwkv_a0, *rwkv_a1, *rwkv_a2, *rwkv_g1, *rwkv_g2,
      *rwkv_kvec, *rwkv_rk, *rwkv_gn, *mlstm_gate_b, *mlstm_norm, *moe_router, *moe_bias, *moe_w1, *moe_w3,
      *moe_w2, *shared_w1, *shared_w3, *shared_w2;
  float* out;
  bf16_t *Wt_att, *Wt_rec, *Wt_out, *Wt13, *Wt2, *Wl1, *Wl2;
  bf16_t *Zb, *L1;
  float *X, *MOD, *MODP, *GP, *msc, *lgate, *MSn, *Tb, *ROPE;
  bf16_t *AB, *P, *RW, *MS, *ACT, *OUT2;
  int *cnt, *ltok, *tsl;
  unsigned* bar;
  int ph_lo, ph_hi;
};

typedef const Params __attribute__((address_space(4))) * KP;

__device__ __forceinline__ int modrow(int t) { return t < NL ? (t >> 11) : 8; }
__device__ __forceinline__ float silu_f(float x) { return x / (1.f + expf(-x)); }
__device__ __forceinline__ float sigm_f(float x) { return 1.f / (1.f + expf(-x)); }
__device__ __forceinline__ float softplus_f(float x) { return fmaxf(x, 0.f) + log1pf(expf(-fabsf(x))); }
template <int CTRL>
__device__ __forceinline__ float dppx(float x) {
  return __int_as_float(__builtin_amdgcn_update_dpp(0, __float_as_int(x), CTRL, 0xf, 0xf, true));
}
__device__ __forceinline__ float rdlane(float v, int l) {
  return __int_as_float(__builtin_amdgcn_readlane(__float_as_int(v), l));
}
__device__ __forceinline__ float wsum(float v) {
  v += dppx<0xB1>(v); v += dppx<0x4E>(v); v += dppx<0x141>(v); v += dppx<0x140>(v);
  return (rdlane(v, 0) + rdlane(v, 16)) + (rdlane(v, 32) + rdlane(v, 48));
}
__device__ __forceinline__ float wmax(float v) {
  v = fmaxf(v, dppx<0xB1>(v)); v = fmaxf(v, dppx<0x4E>(v)); v = fmaxf(v, dppx<0x141>(v)); v = fmaxf(v, dppx<0x140>(v));
  return fmaxf(fmaxf(rdlane(v, 0), rdlane(v, 16)), fmaxf(rdlane(v, 32), rdlane(v, 48)));
}
__device__ __forceinline__ int opaque_tid() {
  int t = threadIdx.x;
  asm volatile("" : "+v"(t));
  return t;
}
typedef __bf16 bf16x2_t __attribute__((ext_vector_type(2)));
typedef float f32x2_t __attribute__((ext_vector_type(2)));
__device__ __forceinline__ unsigned pk_bf16(float lo, float hi) {
  const f32x2_t v = {lo, hi};
  return __builtin_bit_cast(unsigned, __builtin_convertvector(v, bf16x2_t));
}
__device__ __forceinline__ bf16_t f2bf(float x) { return (bf16_t)(pk_bf16(x, 0.f) & 0xffffu); }
__device__ __forceinline__ float bf2f(bf16_t v) { return __uint_as_float((unsigned)v << 16); }
__device__ __forceinline__ float bflo(unsigned u) { return __uint_as_float(u << 16); }
__device__ __forceinline__ float bfhi(unsigned u) { return __uint_as_float(u & 0xffff0000u); }
__device__ __forceinline__ int scan_row(int dir, int b, int tau) {
  if (tau < CTXL) return NL + b * CTXL + (dir ? (CTXL - 1 - tau) : tau);
  int s = tau - CTXL;
  return b * SEQ + (dir ? (SEQ - 1 - s) : s);
}

template <class RowPtrA>
__device__ __forceinline__ void gemm128_main(int tid, RowPtrA rowA, const bf16_t* __restrict__ Bt, int K, int n0,
                                             char* lds, f32x16 (&acc)[2][2]) {
  const int lane = tid & 63, w = tid >> 6;
  const int wm = w >> 1, wn = w & 1, r = lane & 31, h = lane >> 5;
  const int c = tid & 7, sr = tid >> 3;
  const int lc = (c ^ ((tid >> 4) & 7)) * 8;
  const bf16_t* ap[4];
#pragma unroll
  for (int i = 0; i < 4; ++i) ap[i] = rowA(sr + 32 * i) + lc;
  const bf16_t* bp0 = Bt + (size_t)(n0 + sr) * K + lc;
  const int bstr = 32 * K;
#pragma unroll
  for (int mi = 0; mi < 2; ++mi)
#pragma unroll
    for (int ni = 0; ni < 2; ++ni)
#pragma unroll
      for (int q = 0; q < 16; ++q) acc[mi][ni][q] = 0.f;
  const int nk = K >> 6;
  auto issue = [&](int kt) {
    char* As = lds + (kt & 1) * 32768 + tid * 16;
    const int k0 = kt * 64;
#pragma unroll
    for (int i = 0; i < 4; ++i) {
      __builtin_amdgcn_global_load_lds((const unsigned*)(ap[i] + k0), (__attribute__((address_space(3))) unsigned*)(As + i * 4096), 16, 0, 0);
      __builtin_amdgcn_global_load_lds((const unsigned*)(bp0 + i * bstr + k0), (__attribute__((address_space(3))) unsigned*)(As + 16384 + i * 4096), 16, 0, 0);
    }
  };
  issue(0);
  const int sw = (r >> 1) & 7;
#pragma unroll 1
  for (int kt = 0; kt < nk; ++kt) {
    asm volatile("s_waitcnt vmcnt(0)" ::: "memory");
    __syncthreads();
    if (kt + 1 < nk) issue(kt + 1);
    const char* As = lds + (kt & 1) * 32768;
    const char* Ar = As + (wm * 64 + r) * 128;
    const char* Br = As + 16384 + (wn * 64 + r) * 128;
#pragma unroll
    for (int ks = 0; ks < 4; ++ks) {
      const int off = ((ks * 2 + h) ^ sw) * 16;
      const bf16x8 a0 = *(const bf16x8*)(Ar + off);
      const bf16x8 a1 = *(const bf16x8*)(Ar + 32 * 128 + off);
      const bf16x8 b0 = *(const bf16x8*)(Br + off);
      const bf16x8 b1 = *(const bf16x8*)(Br + 32 * 128 + off);
      acc[0][0] = __builtin_amdgcn_mfma_f32_32x32x16_bf16(a0, b0, acc[0][0], 0, 0, 0);
      acc[0][1] = __builtin_amdgcn_mfma_f32_32x32x16_bf16(a0, b1, acc[0][1], 0, 0, 0);
      acc[1][0] = __builtin_amdgcn_mfma_f32_32x32x16_bf16(a1, b0, acc[1][0], 0, 0, 0);
      acc[1][1] = __builtin_amdgcn_mfma_f32_32x32x16_bf16(a1, b1, acc[1][1], 0, 0, 0);
    }
  }
  __syncthreads();
}
template <class F>
__device__ __forceinline__ void acc_foreach(int tid, const f32x16 (&acc)[2][2], F f) {
  const int lane = tid & 63, w = tid >> 6;
  const int wm = w >> 1, wn = w & 1, r = lane & 31, h = lane >> 5;
#pragma unroll
  for (int mi = 0; mi < 2; ++mi)
#pragma unroll
    for (int ni = 0; ni < 2; ++ni)
#pragma unroll
      for (int q = 0; q < 16; ++q) {
        const int row = wm * 64 + mi * 32 + (q & 3) + 8 * (q >> 2) + 4 * h;
        const int col = wn * 64 + ni * 32 + r;
        f(row, col, acc[mi][ni][q]);
        if ((q & 3) == 3) __builtin_amdgcn_sched_barrier(0);
      }
}

template <class RM>
__device__ __forceinline__ void tr_tile(int tid, const float* __restrict__ src, int N, int k0, int n0,
                                        bf16_t* __restrict__ dst, int K, RM rowmap, float* tile) {
  {
    const int tx = tid & 15, ty = tid >> 4;
    const int n = n0 + tx * 4;
#pragma unroll
    for (int i = 0; i < 4; ++i) {
      const int k = ty + 16 * i;
      float4 v = make_float4(0.f, 0.f, 0.f, 0.f);
      if (n < N) v = *(const float4*)(src + (size_t)(k0 + k) * N + n);
      tile[k * 65 + tx * 4 + 0] = v.x; tile[k * 65 + tx * 4 + 1] = v.y;
      tile[k * 65 + tx * 4 + 2] = v.z; tile[k * 65 + tx * 4 + 3] = v.w;
    }
  }
  __syncthreads();
  {
    const int kc = tid & 7;
#pragma unroll
    for (int i = 0; i < 2; ++i) {
      const int n = (tid >> 3) + 32 * i;
      if (n0 + n < N) {
        float v[8];
#pragma unroll
        for (int q = 0; q < 8; ++q) v[q] = tile[(kc * 8 + q) * 65 + n];
        u32x4 o;
        o.x = pk_bf16(v[0], v[1]); o.y = pk_bf16(v[2], v[3]); o.z = pk_bf16(v[4], v[5]); o.w = pk_bf16(v[6], v[7]);
        *(u32x4*)(dst + (size_t)rowmap(n0 + n) * K + k0 + kc * 8) = o;
      }
    }
  }
  __syncthreads();
}

constexpr int CJ0 = 1152, CJ1 = CJ0 + 2080, CJ2 = CJ1 + 1024, CJ3 = CJ2 + 33280, CJ4 = CJ3 + 16640;
__device__ void convert_job(KP p, int job, float* sm, int tid) {
  if (job < CJ0) {
    const int j = job / 576, rem = job % 576, kt = rem / 36, nt = rem % 36;
    tr_tile(tid, p->att_w_in + (size_t)j * 1024 * ATT_N, ATT_N, kt * 64, nt * 64, p->Wt_att + (size_t)j * ATT_N * 1024,
            1024, [](int n) { return n; }, sm);
  } else if (job < CJ1) {
    const int q = job - CJ0;
    const int j = q / 1040, rem = q % 1040, kt = rem / 65, nt = rem % 65;
    tr_tile(tid, p->rec_w_in + (size_t)j * 1024 * REC_N, REC_N, kt * 64, nt * 64, p->Wt_rec + (size_t)j * REC_NP * 1024,
            1024, [](int n) { return n; }, sm);
  } else if (job < CJ2) {
    const int q = job - CJ1;
    const int i = q >> 8, rem = q & 255, kt = rem >> 4, nt = rem & 15;
    tr_tile(tid, p->mix_w_out + (size_t)i * 1024 * 1024, 1024, kt * 64, nt * 64, p->Wt_out + (size_t)i * 1024 * 1024,
            1024, [](int n) { return n; }, sm);
  } else if (job < CJ3) {
    const int q = job - CJ2;
    const int le = q >> 7, rem = q & 127;
    const int which = rem >> 6, kt = (rem >> 2) & 15, nt = rem & 3;
    const int layer = le / 65, e = le % 65;
    const float* src;
    if (e < 64) src = (which ? p->moe_w3 : p->moe_w1) + (size_t)(layer * 64 + e) * 1024 * 256;
    else src = (which ? p->shared_w3 : p->shared_w1) + (size_t)layer * 1024 * 256;
    tr_tile(tid, src, 256, kt * 64, nt * 64, p->Wt13 + (size_t)le * 512 * 1024, 1024,
            [which](int n) { return 64 * (n >> 5) + which * 32 + (n & 31); }, sm);
  } else {
    const int q = job - CJ3;
    const int le = q >> 6, rem = q & 63;
    const int kt = rem >> 4, nt = rem & 15;
    const int layer = le / 65, e = le % 65;
    const float* src = e < 64 ? p->moe_w2 + (size_t)(layer * 64 + e) * 256 * 1024 : p->shared_w2 + (size_t)layer * 256 * 1024;
    tr_tile(tid, src, 1024, kt * 64, nt * 64, p->Wt2 + (size_t)le * 1024 * 256, 256, [](int n) { return n; }, sm);
  }
}
__device__ __forceinline__ int conv_stage_total(int stage) {
  return stage == 0 ? (576 + 1040 + 512 + 8320 + 4160) : (stage == 1 ? (576 + 1040 + 256 + 16640 + 8320) : (256 + 8320 + 4160));
}
__device__ __forceinline__ int conv_stage_job(int stage, int q) {
  if (stage == 0) {
    if (q < 8320) return CJ2 + q;  q -= 8320;
    if (q < 4160) return CJ3 + q;  q -= 4160;
    if (q < 576) return q;  q -= 576;
    if (q < 1040) return CJ0 + q;  q -= 1040;
    return CJ1 + q;
  } else if (stage == 1) {
    if (q < 8320) return CJ2 + 8320 + q;  q -= 8320;
    if (q < 4160) return CJ3 + 4160 + q;  q -= 4160;
    if (q < 576) return 576 + q;  q -= 576;
    if (q < 256) return CJ1 + 512 + q;  q -= 256;
    if (q < 8320) return CJ2 + 16640 + q;  q -= 8320;
    if (q < 4160) return CJ3 + 8320 + q;  q -= 4160;
    return CJ0 + 1040 + q;
  }
  if (q < 256) return CJ1 + 768 + q;  q -= 256;
  if (q < 8320) return CJ2 + 24960 + q;  q -= 8320;
  return CJ3 + 12480 + q;
}

__device__ void ph_init(KP p, char* smc) {
  float* sm = (float*)smc;
  const int tid = opaque_tid();
  {
    const size_t n4a = (size_t)NL * DM / 4, n4b = (size_t)NC * DM / 4;
    const float4* xs = (const float4*)p->x;
    const float4* cs = (const float4*)p->ctx;
    float4* X4 = (float4*)p->X;
    for (size_t i = (size_t)blockIdx.x * NTHR + tid; i < n4a + n4b; i += (size_t)gridDim.x * NTHR)
      X4[i] = i < n4a ? xs[i] : cs[i - n4a];
  }
  for (int tile = blockIdx.x; tile < 96 * 8; tile += gridDim.x) {
    const int ct = tile >> 3, ks = tile & 7;
    for (int i = tid; i < 9 * 128; i += NTHR) {
      const int r = i >> 7, k = ks * 128 + (i & 127);
      const float v = r < 8 ? p->c[r * 1024 + k] : p->c_ctx[k];
      sm[i] = silu_f(v);
    }
    __syncthreads();
    const int col = ct * 256 + tid;
    const int layer = col / 6144, n = col % 6144;
    const float* W = p->ada_w + ((size_t)layer * 1024 + ks * 128) * 6144 + n;
    float acc[9];
#pragma unroll
    for (int r = 0; r < 9; ++r) acc[r] = 0.f;
#pragma unroll 4
    for (int k = 0; k < 128; ++k) {
      const float w = W[(size_t)k * 6144];
#pragma unroll
      for (int r = 0; r < 9; ++r) acc[r] = fmaf(sm[r * 128 + k], w, acc[r]);
    }
#pragma unroll
    for (int r = 0; r < 9; ++r) p->MODP[((size_t)(ks * 4 + layer) * 9 + r) * 6144 + n] = acc[r];
    __syncthreads();
  }
  for (int q = blockIdx.x; q < conv_stage_total(0); q += gridDim.x) convert_job(p, conv_stage_job(0, q), sm, tid);
  for (int i = blockIdx.x * NTHR + tid; i < 2 * 3 * 128 * 512; i += gridDim.x * NTHR) {
    const int k = i & 511, n = (i >> 9) & 127, wj = i >> 16;
    const int j = wj / 3, which = wj % 3;
    float v = 0.f;
    if (which < 2) {
      if (n < 64) v = (which ? p->rwkv_a1 : p->rwkv_w1)[((size_t)(j * 2 + (n >> 5)) * 512 + k) * 32 + (n & 31)];
    } else if (n < 96) v = p->rwkv_g1[((size_t)j * 512 + k) * 96 + n];
    p->Wl1[i] = f2bf(v);
  }
  for (int i = blockIdx.x * NTHR + tid; i < 2 * 2560 * 128; i += gridDim.x * NTHR) {
    const int k = i & 127, n = (i >> 7) % 2560, j = i / (2560 * 128);
    float v = 0.f;
    if (n < 2048) {
      const int d = (n >> 9) & 1, c = n & 511;
      if (k < 64 && (k >> 5) == d) v = (n < 1024 ? p->rwkv_w2 : p->rwkv_a2)[((size_t)(j * 2 + d) * 32 + (k & 31)) * 512 + c];
    } else if (k < 96) v = p->rwkv_g2[((size_t)j * 96 + k) * 512 + (n - 2048)];
    p->Wl2[i] = f2bf(v);
  }
  for (int i = blockIdx.x * NTHR + tid; i < 64 * 16; i += gridDim.x * NTHR) {
    const int pos = i >> 4, f = i & 15;
    const float ang = (float)pos * powf(10000.f, -(float)f / 16.f);
    p->ROPE[2 * i] = cosf(ang);
    p->ROPE[2 * i + 1] = sinf(ang);
  }
}

__device__ void ph_mod_h(KP p, char* smc) {
  float* sm = (float*)smc;
  const int tid = opaque_tid();
  for (int i = blockIdx.x * NTHR + tid; i < 4 * 9 * 6144; i += gridDim.x * NTHR) {
    const int layer = i / (9 * 6144), rem = i % (9 * 6144), n = rem % 6144;
    float s = p->ada_b[layer * 6144 + n];
#pragma unroll
    for (int ks = 0; ks < 8; ++ks) s += p->MODP[(size_t)(ks * 4 + layer) * 9 * 6144 + rem];
    p->MOD[i] = s;
  }
  const int lane = tid & 63, wave = tid >> 6;
  const int per = (((NT + gridDim.x - 1) / gridDim.x) + 3) & ~3;
  const int t0 = blockIdx.x * per, t1 = min(NT, t0 + per);
  int cur = -1;
  for (int tb = t0; tb < t1; tb += 4) {
    const int mr = modrow(tb);
    if (mr != cur) {
      __syncthreads();
      for (int n = tid; n < 2048; n += NTHR) {
        float a = p->ada_b[n];
#pragma unroll
        for (int ks = 0; ks < 8; ++ks) a += p->MODP[((size_t)(ks * 4) * 9 + mr) * 6144 + n];
        sm[n] = a;
      }
      cur = mr;
      __syncthreads();
    }
    const int t = tb + wave;
    if (t < t1) {
      const float* src = t < NL ? p->x + (size_t)t * DM : p->ctx + (size_t)(t - NL) * DM;
#pragma unroll
      for (int i = 0; i < 4; ++i) {
        const int n = i * 256 + lane * 4;
        const float4 xv = *(const float4*)(src + n);
        const float4 sh = *(const float4*)(sm + n);
        const float4 sc = *(const float4*)(sm + 1024 + n);
        u32x2 o;
        o.x = pk_bf16(xv.x * (1.f + sc.x) + sh.x, xv.y * (1.f + sc.y) + sh.y);
        o.y = pk_bf16(xv.z * (1.f + sc.z) + sh.z, xv.w * (1.f + sc.w) + sh.w);
        *(u32x2*)(p->AB + (size_t)t * DM + n) = o;
      }
    }
  }
}

typedef short v4i16_t __attribute__((ext_vector_type(4)));
using s16x4 = __attribute__((ext_vector_type(4))) short;
__device__ __forceinline__ s16x4 vtr(const char* p) {
  return __builtin_bit_cast(s16x4, __builtin_amdgcn_ds_read_tr16_b64_v4i16((__attribute__((address_space(3))) v4i16_t*)p));
}
#define MFMA32(a, b, c) __builtin_amdgcn_mfma_f32_32x32x16_bf16(a, b, c, 0, 0, 0)
__device__ void ph_attention(KP p, int layer, bool keep, char* lds) {
  const int tid = opaque_tid();
  const int lane = tid & 63, w = tid >> 6, r32 = lane & 31, hi = lane >> 5;
  const int j = layer >> 1;
  float* bias_lds = (float*)(lds + 32768 + 1024);
  const int n_gqa = 1024, n_na = 1024, n_cb = keep ? 128 : 0, n_ca = keep ? 128 : 0;
  const int total = n_gqa + n_na + n_cb + n_ca;
  constexpr float LOG2E = 1.4426950408889634f;
  constexpr float C2 = 0.125f * LOG2E;
  const int c = tid & 7, sr = tid >> 3;
  const int kso = (c ^ ((tid >> 4) & 7)) * 16;
  const int vso = (c >> 2) * 4096 + (c & 3) * 16;
  const int sw = (r32 >> 1) & 7;
  for (int item = blockIdx.x; item < total; item += gridDim.x) {
    int b, qrow0, qoff, koff, voff, ocol, lat_tiles, lat_row0;
    bool na = false;
    int r_w = 0, start_w = 0, ru0 = 0, hN = 0;
    if (item < n_gqa) {
      b = item >> 7;
      const int g = (item >> 6) & 1, tt = item & 63;
      qrow0 = b * SEQ + tt * 32; qoff = 1536 + (g * 4 + w) * 64; koff = 2048 + g * 64; voff = 2176 + g * 64;
      ocol = 512 + (g * 4 + w) * 64; lat_tiles = 32; lat_row0 = b * SEQ;
    } else if (item < n_gqa + n_na) {
      const int it = item - n_gqa;
      b = it >> 7; hN = (it >> 4) & 7;
      const int rp = it & 15;
      na = true; r_w = 2 * rp + (w >> 1);
      qrow0 = b * SEQ + r_w * 64 + (w & 1) * 32; qoff = hN * 64; koff = 512 + hN * 64; voff = 1024 + hN * 64; ocol = hN * 64;
      const int s0 = min(max(2 * rp - 4, 0), 24), s1 = min(max(2 * rp - 3, 0), 24);
      start_w = (w >> 1) ? s1 : s0; ru0 = s0; lat_tiles = (s1 != s0) ? 9 : 8; lat_row0 = b * SEQ + ru0 * 64;
    } else if (item < n_gqa + n_na + n_cb) {
      const int it = item - n_gqa - n_na;
      b = it >> 4;
      const int g = (it >> 3) & 1, tt = it & 7;
      qrow0 = NL + b * CTXL + tt * 32; qoff = 1536 + (g * 4 + w) * 64; koff = 2048 + g * 64; voff = 2176 + g * 64;
      ocol = 512 + (g * 4 + w) * 64; lat_tiles = 0; lat_row0 = 0;
    } else {
      const int it = item - n_gqa - n_na - n_cb;
      b = it >> 4;
      const int h = (it >> 1) & 7, half = it & 1;
      qrow0 = NL + b * CTXL + half * 128 + w * 32; qoff = h * 64; koff = 512 + h * 64; voff = 1024 + h * 64; ocol = h * 64;
      lat_tiles = 0; lat_row0 = 0;
    }
    const int ctx_row0 = NL + b * CTXL, ntiles = lat_tiles + 4;
    if (na)
      for (int i = tid; i < 465; i += NTHR) bias_lds[i] = p->na_rpb[(j * 8 + hN) * 465 + i] * LOG2E;
    bf16x8 qf[4];
    {
      const bf16_t* qp = p->P + (size_t)(qrow0 + r32) * LDP + qoff + hi * 8;
#pragma unroll
      for (int d0 = 0; d0 < 4; ++d0) qf[d0] = *(const bf16x8*)(qp + d0 * 16);
    }
    f32x16 o0, o1;
#pragma unroll
    for (int q = 0; q < 16; ++q) { o0[q] = 0.f; o1[q] = 0.f; }
    float m = -INFINITY, l = 0.f;
    u32x4 kr0, kr1, vr0, vr1;
    auto gload = [&](int t) {
      const int row0 = t < lat_tiles ? lat_row0 + 64 * t : ctx_row0 + 64 * (t - lat_tiles);
      const bf16_t* base = p->P + (size_t)(row0 + sr) * LDP + c * 8;
      kr0 = *(const u32x4*)(base + koff); kr1 = *(const u32x4*)(base + (size_t)32 * LDP + koff);
      vr0 = *(const u32x4*)(base + voff); vr1 = *(const u32x4*)(base + (size_t)32 * LDP + voff);
    };
    auto swrite = [&](int buf) {
      char* Kb = lds + buf * 16384;
      char* Vb = Kb + 8192;
      *(u32x4*)(Kb + sr * 128 + kso) = kr0; *(u32x4*)(Kb + (sr + 32) * 128 + kso) = kr1;
      *(u32x4*)(Vb + vso + sr * 64) = vr0; *(u32x4*)(Vb + vso + (sr + 32) * 64) = vr1;
    };
    gload(0);
    swrite(0);
    for (int t = 0; t < ntiles; ++t) {
      __syncthreads();
      if (t + 1 < ntiles) gload(t + 1);
      const bool na_tile = na && t < lat_tiles;
      const int kr = ru0 + t;
      const bool part = !na_tile || (kr >= start_w && kr < start_w + 8);
      if (part) {
        const char* Ks = lds + (t & 1) * 16384;
        const char* Vs = Ks + 8192;
        f32x16 s0, s1;
#pragma unroll
        for (int q = 0; q < 16; ++q) { s0[q] = 0.f; s1[q] = 0.f; }
#pragma unroll
        for (int d0 = 0; d0 < 4; ++d0) {
          const int off = ((2 * d0 + hi) ^ sw) * 16;
          const bf16x8 k0 = *(const bf16x8*)(Ks + r32 * 128 + off);
          const bf16x8 k1 = *(const bf16x8*)(Ks + (32 + r32) * 128 + off);
          s0 = MFMA32(k0, qf[d0], s0);
          s1 = MFMA32(k1, qf[d0], s1);
        }
        float mx = -INFINITY;
        if (na_tile) {
          const int cq = (w & 1) * 32 + r32;
          const int c0 = min(max(cq - 8, 0), 48);
          const float* brow = bias_lds + (kr - r_w + 7) * 31 + (15 - cq);
#pragma unroll
          for (int q = 0; q < 16; ++q) {
            const int kc = (q & 3) + 8 * (q >> 2) + 4 * hi;
            const float v0 = ((unsigned)(kc - c0) < 16u) ? fmaf(s0[q], C2, brow[kc]) : -INFINITY;
            const float v1 = ((unsigned)(kc + 32 - c0) < 16u) ? fmaf(s1[q], C2, brow[kc + 32]) : -INFINITY;
            s0[q] = v0; s1[q] = v1;
            mx = fmaxf(mx, fmaxf(v0, v1));
          }
        } else {
#pragma unroll
          for (int q = 0; q < 16; ++q) {
            s0[q] *= C2; s1[q] *= C2;
            mx = fmaxf(mx, fmaxf(s0[q], s1[q]));
          }
        }
        {
          auto rr = __builtin_amdgcn_permlane32_swap(__float_as_uint(mx), __float_as_uint(mx), false, false);
          mx = fmaxf(__uint_as_float(rr[0]), __uint_as_float(rr[1]));
        }
        const float mnew = fmaxf(m, mx);
        const float alpha = __builtin_amdgcn_exp2f(m - mnew);
        float ls = 0.f;
#pragma unroll
        for (int q = 0; q < 16; ++q) {
          s0[q] = __builtin_amdgcn_exp2f(s0[q] - mnew);
          s1[q] = __builtin_amdgcn_exp2f(s1[q] - mnew);
          ls += s0[q] + s1[q];
        }
        l = l * alpha + ls;
        m = mnew;
#pragma unroll
        for (int q = 0; q < 16; ++q) { o0[q] *= alpha; o1[q] *= alpha; }
        bf16x8 pf[4];
#pragma unroll
        for (int s = 0; s < 4; ++s) {
          const int u = (s & 1) * 8;
          u32x4 tpk;
          if (s < 2) {
            tpk.x = pk_bf16(s0[u + 0], s0[u + 1]); tpk.y = pk_bf16(s0[u + 2], s0[u + 3]);
            tpk.z = pk_bf16(s0[u + 4], s0[u + 5]); tpk.w = pk_bf16(s0[u + 6], s0[u + 7]);
          } else {
            tpk.x = pk_bf16(s1[u + 0], s1[u + 1]); tpk.y = pk_bf16(s1[u + 2], s1[u + 3]);
            tpk.z = pk_bf16(s1[u + 4], s1[u + 5]); tpk.w = pk_bf16(s1[u + 6], s1[u + 7]);
          }
          pf[s] = __builtin_bit_cast(bf16x8, tpk);
        }
        const char* vb = Vs + ((lane >> 4) & 1) * 32 + (lane & 3) * 8 + ((lane & 15) >> 2) * 64 + hi * 256;
#pragma unroll
        for (int s = 0; s < 4; ++s) {
          const s16x4 a00 = vtr(vb + (16 * s) * 64), a01 = vtr(vb + (16 * s + 8) * 64);
          const s16x4 a10 = vtr(vb + 4096 + (16 * s) * 64), a11 = vtr(vb + 4096 + (16 * s + 8) * 64);
          const bf16x8 A0 = __builtin_shufflevector(a00, a01, 0, 1, 2, 3, 4, 5, 6, 7);
          const bf16x8 A1 = __builtin_shufflevector(a10, a11, 0, 1, 2, 3, 4, 5, 6, 7);
          o0 = MFMA32(A0, pf[s], o0);
          o1 = MFMA32(A1, pf[s], o1);
        }
      }
      if (t + 1 < ntiles) swrite((t + 1) & 1);
    }
    __syncthreads();
    const float lt = l + __shfl_xor(l, 32);
    const float inv = 1.f / lt;
    bf16_t* op = p->AB + (size_t)(qrow0 + r32) * DM + ocol + 4 * hi;
#pragma unroll
    for (int g = 0; g < 4; ++g) {
      u32x2 v0, v1;
      v0.x = pk_bf16(o0[4 * g] * inv, o0[4 * g + 1] * inv); v0.y = pk_bf16(o0[4 * g + 2] * inv, o0[4 * g + 3] * inv);
      v1.x = pk_bf16(o1[4 * g] * inv, o1[4 * g + 1] * inv); v1.y = pk_bf16(o1[4 * g + 2] * inv, o1[4 * g + 3] * inv);
      *(u32x2*)(op + 8 * g) = v0;
      *(u32x2*)(op + 32 + 8 * g) = v1;
    }
  }
}

__device__ void ph_rwkv_mix(KP p, int layer) {
  const int j = layer >> 1;
  const int tid = opaque_tid();
  const int lane = tid & 63, wave = tid >> 6;
  const float* mu = p->rwkv_mu + j * 6 * 512;
  const int c0 = lane * 8;
  auto unpack = [](const u32x4 u, float (&f)[8]) {
    f[0] = bflo(u.x); f[1] = bfhi(u.x); f[2] = bflo(u.y); f[3] = bfhi(u.y);
    f[4] = bflo(u.z); f[5] = bfhi(u.z); f[6] = bflo(u.w); f[7] = bfhi(u.w);
  };
  auto pack = [](const float (&f)[8]) {
    u32x4 o;
    o.x = pk_bf16(f[0], f[1]); o.y = pk_bf16(f[2], f[3]); o.z = pk_bf16(f[4], f[5]); o.w = pk_bf16(f[6], f[7]);
    return o;
  };
  for (int t = blockIdx.x * 4 + wave; t < NT; t += gridDim.x * 4) {
    bool hasp, hasn;
    if (t < NL) { int s = t & 2047; hasp = s > 0; hasn = s < SEQ - 1; }
    else { int s = (t - NL) & 255; hasp = s > 0; hasn = s < CTXL - 1; }
    const bf16_t* pt = p->P + (size_t)t * LDP + c0;
    bf16_t* rw = p->RW + (size_t)t * RWS + c0;
    bf16_t* zb = p->Zb + (size_t)t * 1536 + c0;
    const u32x4 zero = {0u, 0u, 0u, 0u};
#pragma unroll
    for (int q = 0; q < 4; ++q) {
      float cur[8], pv[8], nx[8], d[8];
      unpack(*(const u32x4*)(pt + q * 512), cur);
      unpack(hasp ? *(const u32x4*)(pt + q * 512 - LDP) : zero, pv);
      unpack(hasn ? *(const u32x4*)(pt + q * 512 + LDP) : zero, nx);
#pragma unroll
      for (int e = 0; e < 8; ++e) d[e] = 0.5f * (pv[e] + nx[e]) - cur[e];
      if (q < 3) {
        float o[8];
        const float* m = mu + q * 512 + c0;
#pragma unroll
        for (int e = 0; e < 8; ++e) o[e] = cur[e] + d[e] * m[e];
        if (q == 0) *(u32x4*)(rw) = pack(o);
        else if (q == 2) *(u32x4*)(rw + 512) = pack(o);
        else {
          *(u32x4*)(rw + 10 * 512) = pack(o);
          float kk[8], ss = 0.f;
          const float* kv0 = p->rwkv_kvec + (j * 2 + 0) * 512 + c0;
#pragma unroll
          for (int e = 0; e < 8; ++e) { kk[e] = o[e] * kv0[e]; ss += kk[e] * kk[e]; }
          ss += dppx<0xB1>(ss); ss += dppx<0x4E>(ss); ss += dppx<0x141>(ss);
          const float rn = rsqrtf(fmaxf(ss, 1e-24f));
#pragma unroll
          for (int e = 0; e < 8; ++e) kk[e] *= rn;
          *(u32x4*)(rw + 2 * 512) = pack(kk);
        }
      } else {
#pragma unroll
        for (int z = 0; z < 3; ++z) {
          float o[8];
          const float* m = mu + (3 + z) * 512 + c0;
#pragma unroll
          for (int e = 0; e < 8; ++e) o[e] = cur[e] + d[e] * m[e];
          *(u32x4*)(zb + z * 512) = pack(o);
        }
      }
    }
  }
}

constexpr int RS_STEP = 384;
constexpr int RS_TB = 16;
struct RwkvStage { u32x2 r, kk, e, ke, a, v; };
__device__ void rwkv_unit(KP p, int unit, float* sm, int tid) {
  const int ch = unit >> 1, hf = unit & 1;
  const int dir = ch >> 6, b = (ch >> 3) & 7, h = ch & 7;
  const int lane = tid & 63, w = tid >> 6, rl = lane >> 3, ks = lane & 7;
  float* ybuf = sm + 2 * RS_TB * RS_STEP;
  const int ss = tid >> 4, kq = tid & 15;
  auto gload = [&](int n, RwkvStage& g) {
    const int row = scan_row(dir, b, n * RS_TB + ss);
    const bf16_t* base = p->RW + (size_t)row * RWS + h * 64 + kq * 4;
    g.r = *(const u32x2*)(base);
    g.kk = *(const u32x2*)(base + 2 * 512);
    g.e = *(const u32x2*)(base + (3 + dir) * 512);
    g.ke = *(const u32x2*)(base + (5 + dir) * 512);
    g.a = *(const u32x2*)(base + (7 + dir) * 512);
    g.v = *(const u32x2*)(p->RW + (size_t)row * RWS + 512 + h * 64 + hf * 32 + (kq & 7) * 4);
  };
  auto swrite = [&](int buf, const RwkvStage& g) {
    float* sp = sm + (buf * RS_TB + ss) * RS_STEP;
    const float r0 = bflo(g.r.x), r1 = bfhi(g.r.x), r2 = bflo(g.r.y), r3 = bfhi(g.r.y);
    const float k0 = bflo(g.kk.x), k1 = bfhi(g.kk.x), k2 = bflo(g.kk.y), k3 = bfhi(g.kk.y);
    const float w0 = __expf(-bflo(g.e.x)), w1 = __expf(-bfhi(g.e.x)), w2 = __expf(-bflo(g.e.y)), w3 = __expf(-bfhi(g.e.y));
    const float e0 = bflo(g.ke.x), e1 = bfhi(g.ke.x), e2 = bflo(g.ke.y), e3 = bfhi(g.ke.y);
    const float a0 = k0 * bflo(g.a.x), a1 = k1 * bfhi(g.a.x), a2 = k2 * bflo(g.a.y), a3 = k3 * bfhi(g.a.y);
    *(float4*)(sp + kq * 4) = make_float4(k0, k1, k2, k3);
    *(float4*)(sp + 64 + kq * 4) = make_float4(w0 * r0, w1 * r1, w2 * r2, w3 * r3);
    *(float4*)(sp + 128 + kq * 4) = make_float4(w0, w1, w2, w3);
    *(float4*)(sp + 192 + kq * 4) = make_float4(a0, a1, a2, a3);
    *(float4*)(sp + 256 + kq * 4) = make_float4(e0, e1, e2, e3);
    if (kq < 8) *(float4*)(sp + 320 + kq * 4) = make_float4(bflo(g.v.x), bfhi(g.v.x), bflo(g.v.y), bfhi(g.v.y));
    float c1 = a0 * r0 + a1 * r1 + a2 * r2 + a3 * r3;
    float c2 = e0 * r0 + e1 * r1 + e2 * r2 + e3 * r3;
    c1 += dppx<0xB1>(c1); c2 += dppx<0xB1>(c2);
    c1 += dppx<0x4E>(c1); c2 += dppx<0x4E>(c2);
    c1 += dppx<0x141>(c1); c2 += dppx<0x141>(c2);
    c1 += dppx<0x140>(c1); c2 += dppx<0x140>(c2);
    if (kq == 0) { sp[352] = c1; sp[353] = c2; }
  };
  typedef float f2 __attribute__((ext_vector_type(2)));
  f2 S01 = {0.f, 0.f}, S23 = {0.f, 0.f}, S45 = {0.f, 0.f}, S67 = {0.f, 0.f};
  auto compute = [&](int n) {
    const float* bp = sm + (n & 1) * RS_TB * RS_STEP;
    float* yb = ybuf + (n & 1) * RS_TB * 32 + w * 8 + rl;
    struct Ops { f2 k[4], r[4], w[4], a[4], e[4]; float vv; f2 c; };
    auto ld = [&](int s, Ops& o) {
      const float* sq = bp + s * RS_STEP;
      const f2* sp = (const f2*)(sq + ks * 8);
#pragma unroll
      for (int i = 0; i < 4; ++i) { o.k[i] = sp[i]; o.r[i] = sp[32 + i]; o.w[i] = sp[64 + i]; o.a[i] = sp[96 + i]; o.e[i] = sp[128 + i]; }
      o.vv = sq[320 + w * 8 + rl]; o.c = *(const f2*)(sq + 352);
    };
    auto step = [&](const Ops& o) -> float {
      f2 sa2 = S01 * o.k[0];
      f2 y2 = S01 * o.r[0];
      sa2 = __builtin_elementwise_fma(S23, o.k[1], sa2); y2 = __builtin_elementwise_fma(S23, o.r[1], y2);
      sa2 = __builtin_elementwise_fma(S45, o.k[2], sa2); y2 = __builtin_elementwise_fma(S45, o.r[2], y2);
      sa2 = __builtin_elementwise_fma(S67, o.k[3], sa2); y2 = __builtin_elementwise_fma(S67, o.r[3], y2);
      float sa = sa2.x + sa2.y, y0 = y2.x + y2.y;
      sa += dppx<0xB1>(sa); y0 += dppx<0xB1>(y0);
      sa += dppx<0x4E>(sa); y0 += dppx<0x4E>(y0);
      sa += dppx<0x141>(sa); y0 += dppx<0x141>(y0);
      sa = -sa;
      const f2 sav = {sa, sa}, vvv = {o.vv, o.vv};
      S01 = __builtin_elementwise_fma(vvv, o.e[0], __builtin_elementwise_fma(sav, o.a[0], S01 * o.w[0]));
      S23 = __builtin_elementwise_fma(vvv, o.e[1], __builtin_elementwise_fma(sav, o.a[1], S23 * o.w[1]));
      S45 = __builtin_elementwise_fma(vvv, o.e[2], __builtin_elementwise_fma(sav, o.a[2], S45 * o.w[2]));
      S67 = __builtin_elementwise_fma(vvv, o.e[3], __builtin_elementwise_fma(sav, o.a[3], S67 * o.w[3]));
      return fmaf(o.vv, o.c.y, fmaf(sa, o.c.x, y0));
    };
    Ops oa, ob, oc;
    ld(0, oa);
    ld(1, ob);
#pragma unroll 1
    for (int s = 0; s < 15; s += 3) {
      ld(s + 2, oc);
      float y0 = step(oa);
      asm volatile("" : "+v"(y0));
      ld(s + 3, oa);
      float y1 = step(ob);
      asm volatile("" : "+v"(y1));
      ld(s + 4, ob);
      float y2 = step(oc);
      asm volatile("" : "+v"(y2));
      if (ks == 0) { yb[s * 32] = y0; yb[(s + 1) * 32] = y1; yb[(s + 2) * 32] = y2; }
    }
    {
      const float y15 = step(oa);
      if (ks == 0) yb[15 * 32] = y15;
    }
  };
  auto yout = [&](int n) {
    const int row = scan_row(dir, b, n * RS_TB + ss);
    const float* ys = ybuf + (n & 1) * RS_TB * 32 + ss * 32 + kq * 2;
    *(unsigned*)(p->P + (size_t)row * LDP + dir * 512 + h * 64 + hf * 32 + kq * 2) = pk_bf16(ys[0], ys[1]);
  };
  constexpr int NB = TSC / RS_TB;
  RwkvStage gA, gB;
  gload(0, gA);
  gload(1, gB);
  swrite(0, gA);
  gload(2, gA);
  __syncthreads();
  for (int n = 0; n < NB; n += 2) {
    compute(n);
    swrite(1, gB);
    if (n + 3 < NB) gload(n + 3, gB);
    __syncthreads();
    yout(n);
    compute(n + 1);
    if (n + 2 < NB) swrite(0, gA);
    if (n + 4 < NB) gload(n + 4, gA);
    __syncthreads();
    yout(n + 1);
  }
  __syncthreads();
}

__device__ void mlstm_s1(KP p, int layer, int tile, char* lds, int tid) {
  const int j = layer >> 1;
  const int ch = tile / NCHUNK, c = tile % NCHUNK;
  const int dir = ch >> 5, b = (ch >> 2) & 7, h = ch & 3;
  float* s_ws = (float*)(lds + META_OFF);
  int* s_row = (int*)(s_ws + 64);
  char* kimg = lds;
  char* vimg = lds + 16384;
  if (tid < 64) {
    const int row = scan_row(dir, b, c * 64 + tid);
    s_row[tid] = row;
    const float* g = p->GP + (size_t)row * 16;
    const float gi = g[(dir * 2) * 4 + h] + p->mlstm_gate_b[j * 16 + (dir * 2) * 4 + h];
    const float gf = g[(dir * 2 + 1) * 4 + h] + p->mlstm_gate_b[j * 16 + (dir * 2 + 1) * 4 + h];
    float bc = -softplus_f(-gf);
#pragma unroll
    for (int o = 1; o < 64; o <<= 1) {
      float tmp = __shfl_up(bc, o);
      if (tid >= o) bc += tmp;
    }
    const float bend = __shfl(bc, 63);
    const float ds = bend - bc + gi;
    const float mloc = wmax(ds);
    s_ws[tid] = expf(ds - mloc);
    if (tid == 0) { p->msc[tile] = mloc; p->msc[NMT + tile] = bend; }
  }
  __syncthreads();
  {
    const int c8 = tid & 15;
    const int ioff = (c8 >> 2) * 4096 + (c8 & 3) * 16;
#pragma unroll
    for (int i = 0; i < 4; ++i) {
      const int sidx = (tid >> 4) + 16 * i;
      const bf16_t* src = p->P + (size_t)s_row[sidx] * LDP + h * 128 + c8 * 8;
      const u32x4 kv = *(const u32x4*)(src + 2560);
      u32x4 vv = *(const u32x4*)(src + 3072);
      const float wsv = s_ws[sidx];
      vv.x = pk_bf16(bflo(vv.x) * wsv, bfhi(vv.x) * wsv); vv.y = pk_bf16(bflo(vv.y) * wsv, bfhi(vv.y) * wsv);
      vv.z = pk_bf16(bflo(vv.z) * wsv, bfhi(vv.z) * wsv); vv.w = pk_bf16(bflo(vv.w) * wsv, bfhi(vv.w) * wsv);
      *(u32x4*)(kimg + ioff + sidx * 64) = kv;
      *(u32x4*)(vimg + ioff + sidx * 64) = vv;
    }
  }
  __syncthreads();
  const int lane = tid & 63, w = tid >> 6, wm = w >> 1, wn = w & 1, r32 = lane & 31, hi = lane >> 5;
  f32x16 acc[2][2];
#pragma unroll
  for (int mi = 0; mi < 2; ++mi)
#pragma unroll
    for (int ni = 0; ni < 2; ++ni)
#pragma unroll
      for (int q = 0; q < 16; ++q) acc[mi][ni][q] = 0.f;
  const int toff = ((lane >> 4) & 1) * 32 + (lane & 3) * 8 + ((lane & 15) >> 2) * 64 + hi * 256;
#pragma unroll
  for (int ks = 0; ks < 4; ++ks) {
    bf16x8 af[2], bfr[2];
#pragma unroll
    for (int i = 0; i < 2; ++i) {
      const char* ka = kimg + (wm * 2 + i) * 4096 + toff + (16 * ks) * 64;
      const char* va = vimg + (wn * 2 + i) * 4096 + toff + (16 * ks) * 64;
      af[i] = __builtin_shufflevector(vtr(ka), vtr(ka + 8 * 64), 0, 1, 2, 3, 4, 5, 6, 7);
      bfr[i] = __builtin_shufflevector(vtr(va), vtr(va + 8 * 64), 0, 1, 2, 3, 4, 5, 6, 7);
    }
    acc[0][0] = MFMA32(af[0], bfr[0], acc[0][0]);
    acc[0][1] = MFMA32(af[0], bfr[1], acc[0][1]);
    acc[1][0] = MFMA32(af[1], bfr[0], acc[1][0]);
    acc[1][1] = MFMA32(af[1], bfr[1], acc[1][1]);
  }
  bf16_t* U = p->MS + (size_t)tile * 16384;
#pragma unroll
  for (int mi = 0; mi < 2; ++mi)
#pragma unroll
    for (int ni = 0; ni < 2; ++ni)
#pragma unroll
      for (int q = 0; q < 16; ++q) {
        const int d = wm * 64 + mi * 32 + (q & 3) + 8 * (q >> 2) + 4 * hi;
        U[d * 128 + wn * 64 + ni * 32 + r32] = f2bf(acc[mi][ni][q]);
        if ((q & 3) == 3) __builtin_amdgcn_sched_barrier(0);
      }
  if (tid < 128) {
    const char* kc = kimg + (tid >> 5) * 4096 + (tid & 31) * 2;
    float a = 0.f;
#pragma unroll 8
    for (int sidx = 0; sidx < 64; ++sidx) a = fmaf(s_ws[sidx], bf2f(*(const bf16_t*)(kc + sidx * 64)), a);
    p->MSn[tile * 128 + tid] = a;
  }
}

__device__ void ph_scan_a(KP p, int layer, char* smc) {
  float* sm = (float*)smc;
  const int tid = opaque_tid();
  for (int u = blockIdx.x; u < 256; u += gridDim.x) rwkv_unit(p, u, sm, tid);
  const int nblk = gridDim.x, bid = blockIdx.x;
  const int start = (bid + nblk - (256 % nblk)) % nblk;
  for (int tile = start; tile < NMT; tile += nblk) { mlstm_s1(p, layer, tile, smc, tid); __syncthreads(); }
  {
    const int stage = layer == 1 ? 1 : 2;
    const int total = conv_stage_total(stage);
    int* qc = (int*)(p->bar + XCD_BAR_WORDS + 16 * stage);
    int* s_q = (int*)(smc + META_OFF + 3968);
    for (;;) {
      __syncthreads();
      if (tid == 0) *s_q = atomicAdd(qc, 1);
      __syncthreads();
      const int q = *s_q;
      if (q >= total) break;
      convert_job(p, conv_stage_job(stage, q), sm, tid);
    }
  }
}

__device__ void ph_mlstm_s2(KP p, char* smc) {
  float* sw = (float*)smc;
  const int tid = opaque_tid();
  const int nitems = 64 * 33;
  for (int item = blockIdx.x; item < nitems; item += gridDim.x) {
    const int ch = item / 33, seg = item % 33;
    __syncthreads();
    if (tid == 0) {
      float m = 0.f;
      for (int c = 0; c < NCHUNK; ++c) {
        const int tile = ch * NCHUNK + c;
        const float mloc = p->msc[tile], bend = p->msc[NMT + tile];
        const float mn = fmaxf(bend + m, mloc);
        sw[c] = expf(bend + m - mn);
        sw[36 + c] = expf(mloc - mn);
        if (seg == 0) p->msc[2 * NMT + tile] = m;
        m = mn;
      }
    }
    __syncthreads();
    if (seg < 32) {
      unsigned* base = (unsigned*)(p->MS + (size_t)ch * NCHUNK * 16384) + seg * 256 + tid;
      unsigned v[NCHUNK];
#pragma unroll
      for (int c = 0; c < NCHUNK; ++c) v[c] = base[(size_t)c * 8192];
      float C0 = 0.f, C1 = 0.f;
#pragma unroll
      for (int c = 0; c < NCHUNK; ++c) {
        const float t0 = bflo(v[c]), t1 = bfhi(v[c]);
        v[c] = pk_bf16(C0, C1);
        C0 = sw[c] * C0 + sw[36 + c] * t0;
        C1 = sw[c] * C1 + sw[36 + c] * t1;
      }
#pragma unroll
      for (int c = 0; c < NCHUNK; ++c) base[(size_t)c * 8192] = v[c];
    } else if (tid < 128) {
      float* base = p->MSn + (size_t)ch * NCHUNK * 128 + tid;
      float v[NCHUNK];
#pragma unroll
      for (int c = 0; c < NCHUNK; ++c) v[c] = base[c * 128];
      float C = 0.f;
#pragma unroll
      for (int c = 0; c < NCHUNK; ++c) {
        const float t0 = v[c];
        v[c] = C;
        C = sw[c] * C + sw[36 + c] * t0;
      }
#pragma unroll
      for (int c = 0; c < NCHUNK; ++c) base[c * 128] = v[c];
    }
  }
}

__device__ void mlstm_s3(KP p, int layer, int tile, char* lds, int tid) {
  const int j = layer >> 1;
  const int ch = tile / NCHUNK, c = tile % NCHUNK;
  const int dir = ch >> 5, b = (ch >> 2) & 7, h = ch & 3;
  float* s_b = (float*)(lds + META_OFF);
  float* s_ig = s_b + 64;
  float* s_mt = s_b + 128;
  float* s_wi = s_b + 192;
  int* s_row = (int*)(s_b + 256);
  float* s_n = s_b + 320;
  float* s_c = s_b + 448;
  char* kimg = lds;
  char* vimg = lds + 16384;
  char* cimg = lds + 32768;
  const float mprev = p->msc[2 * NMT + tile];
  const float qscale = 0.08838834764831845f;
  if (tid < 64) {
    const int row = scan_row(dir, b, c * 64 + tid);
    s_row[tid] = row;
    const float* g = p->GP + (size_t)row * 16;
    const float gi = g[(dir * 2) * 4 + h] + p->mlstm_gate_b[j * 16 + (dir * 2) * 4 + h];
    const float gf = g[(dir * 2 + 1) * 4 + h] + p->mlstm_gate_b[j * 16 + (dir * 2 + 1) * 4 + h];
    float bc = -softplus_f(-gf);
#pragma unroll
    for (int o = 1; o < 64; o <<= 1) {
      float tmp = __shfl_up(bc, o);
      if (tid >= o) bc += tmp;
    }
    s_b[tid] = bc;
    s_ig[tid] = gi;
  } else if (tid < 192) s_n[tid - 64] = p->MSn[tile * 128 + (tid - 64)];
  __syncthreads();
  if (tid < 64) {
    const float bt = s_b[tid];
    float mt = bt + mprev;
    for (int sx = 0; sx <= tid; ++sx) mt = fmaxf(mt, bt - s_b[sx] + s_ig[sx]);
    s_mt[tid] = mt;
    s_wi[tid] = expf(bt + mprev - mt);
    s_c[tid] = (s_ig[tid] - bt) * 1.4426950408889634f;
  }
  {
    const int c8 = tid & 15;
    const int ioff = (c8 >> 2) * 4096 + (c8 & 3) * 16;
#pragma unroll
    for (int i = 0; i < 4; ++i) {
      const int sidx = (tid >> 4) + 16 * i;
      const bf16_t* src = p->P + (size_t)s_row[sidx] * LDP + h * 128 + c8 * 8;
      *(u32x4*)(kimg + sidx * 256 + ((c8 ^ (sidx & 15)) * 16)) = *(const u32x4*)(src + 2560);
      *(u32x4*)(vimg + ioff + sidx * 64) = *(const u32x4*)(src + 3072);
    }
    __builtin_amdgcn_sched_barrier(0);
    const bf16_t* Cp = p->MS + (size_t)tile * 16384;
    const int coff = (c8 >> 2) * 8192 + (c8 & 3) * 16;
#pragma unroll
    for (int i = 0; i < 8; ++i) {
      const int d = (tid >> 4) + 16 * i;
      *(u32x4*)(cimg + coff + d * 64) = *(const u32x4*)(Cp + d * 128 + c8 * 8);
      if (i == 3) __builtin_amdgcn_sched_barrier(0);
    }
    __builtin_amdgcn_sched_barrier(0);
  }
  const int lane = tid & 63, w = tid >> 6, wt = w >> 1, wv = w & 1, r32 = lane & 31, hi = lane >> 5;
  const int t = wt * 32 + r32;
  bf16x8 qf[8];
  {
    const bf16_t* qp = p->P + (size_t)s_row[t] * LDP + 2048 + h * 128 + hi * 8;
#pragma unroll
    for (int d0 = 0; d0 < 8; ++d0) qf[d0] = *(const bf16x8*)(qp + d0 * 16);
  }
  __syncthreads();
  const int toff = ((lane >> 4) & 1) * 32 + (lane & 3) * 8 + ((lane & 15) >> 2) * 64;
  constexpr float LOG2E_ = 1.4426950408889634f;
  float qn = 0.f;
#pragma unroll
  for (int d0 = 0; d0 < 8; ++d0) {
    const u32x4 qq = __builtin_bit_cast(u32x4, qf[d0]);
    const float* np = s_n + d0 * 16 + hi * 8;
    qn = fmaf(bflo(qq.x), np[0], qn); qn = fmaf(bfhi(qq.x), np[1], qn);
    qn = fmaf(bflo(qq.y), np[2], qn); qn = fmaf(bfhi(qq.y), np[3], qn);
    qn = fmaf(bflo(qq.z), np[4], qn); qn = fmaf(bfhi(qq.z), np[5], qn);
    qn = fmaf(bflo(qq.w), np[6], qn); qn = fmaf(bfhi(qq.w), np[7], qn);
  }
  qn += __shfl_xor(qn, 32);
  const float mtt = s_mt[t], wi = s_wi[t];
  const float ct = (s_b[t] - mtt) * LOG2E_;
  const float wq = wi * qscale;
  bf16x8 pf[4];
  float den = 0.f;
  {
    f32x16 sa0, sa1;
#pragma unroll
    for (int q = 0; q < 16; ++q) { sa0[q] = 0.f; sa1[q] = 0.f; }
#pragma unroll
    for (int d0 = 0; d0 < 8; ++d0) {
      const int chn = 2 * d0 + hi;
      const bf16x8 k0 = *(const bf16x8*)(kimg + r32 * 256 + ((chn ^ (r32 & 15)) * 16));
      sa0 = MFMA32(k0, qf[d0], sa0);
      if (wt) {
        const bf16x8 k1 = *(const bf16x8*)(kimg + (32 + r32) * 256 + ((chn ^ (r32 & 15)) * 16));
        sa1 = MFMA32(k1, qf[d0], sa1);
      }
      __builtin_amdgcn_sched_barrier(0);
    }
#pragma unroll
    for (int g = 0; g < 4; ++g) {
      const int sb0 = 8 * g + 4 * hi;
      const float4 c0v = *(const float4*)(s_c + sb0);
      const float4 c1v = *(const float4*)(s_c + sb0 + 32);
      const float cc0[4] = {c0v.x, c0v.y, c0v.z, c0v.w}, cc1[4] = {c1v.x, c1v.y, c1v.z, c1v.w};
#pragma unroll
      for (int e = 0; e < 4; ++e) {
        const int q = 4 * g + e;
        const float v0 = (sb0 + e <= t) ? sa0[q] * qscale * __builtin_amdgcn_exp2f(ct + cc0[e]) : 0.f;
        sa0[q] = v0; den += v0;
        const float v1 = (wt && sb0 + 32 + e <= t) ? sa1[q] * qscale * __builtin_amdgcn_exp2f(ct + cc1[e]) : 0.f;
        sa1[q] = v1; den += v1;
      }
      __builtin_amdgcn_sched_barrier(0);
    }
#pragma unroll
    for (int sx = 0; sx < 4; ++sx) {
      const int u = (sx & 1) * 8;
      u32x4 tpk;
      if (sx < 2) {
        tpk.x = pk_bf16(sa0[u + 0], sa0[u + 1]); tpk.y = pk_bf16(sa0[u + 2], sa0[u + 3]);
        tpk.z = pk_bf16(sa0[u + 4], sa0[u + 5]); tpk.w = pk_bf16(sa0[u + 6], sa0[u + 7]);
      } else {
        tpk.x = pk_bf16(sa1[u + 0], sa1[u + 1]); tpk.y = pk_bf16(sa1[u + 2], sa1[u + 3]);
        tpk.z = pk_bf16(sa1[u + 4], sa1[u + 5]); tpk.w = pk_bf16(sa1[u + 6], sa1[u + 7]);
      }
      pf[sx] = __builtin_bit_cast(bf16x8, tpk);
    }
  }
  den += __shfl_xor(den, 32);
  const float dtot = den + wq * qn;
  const float inv = 1.f / fmaxf(fabsf(dtot), expf(-mtt));
  bf16_t* op = p->P + (size_t)s_row[t] * LDP + 1024 + dir * 512 + h * 128 + wv * 64 + 4 * hi;
#pragma unroll 1
  for (int vp = 0; vp < 2; ++vp) {
    f32x16 o0;
#pragma unroll
    for (int q = 0; q < 16; ++q) o0[q] = 0.f;
    const char* cb = cimg + (wv * 2 + vp) * 8192 + toff + hi * 512;
#pragma unroll
    for (int d0 = 0; d0 < 8; ++d0) {
      const bf16x8 A0 = __builtin_shufflevector(vtr(cb + (16 * d0) * 64), vtr(cb + (16 * d0 + 4) * 64), 0, 1, 2, 3, 4, 5, 6, 7);
      o0 = MFMA32(A0, qf[d0], o0);
    }
#pragma unroll
    for (int q = 0; q < 16; ++q) o0[q] *= wq;
    const char* vb = vimg + (wv * 2 + vp) * 4096 + toff + hi * 256;
#pragma unroll
    for (int sx = 0; sx < 4; ++sx) {
      if (sx < 2 || wt) {
        const bf16x8 A0 = __builtin_shufflevector(vtr(vb + (16 * sx) * 64), vtr(vb + (16 * sx + 8) * 64), 0, 1, 2, 3, 4, 5, 6, 7);
        o0 = MFMA32(A0, pf[sx], o0);
      }
    }
#pragma unroll
    for (int g = 0; g < 4; ++g) {
      u32x2 v0;
      v0.x = pk_bf16(o0[4 * g] * inv, o0[4 * g + 1] * inv); v0.y = pk_bf16(o0[4 * g + 2] * inv, o0[4 * g + 3] * inv);
      *(u32x2*)(op + vp * 32 + 8 * g) = v0;
    }
  }
}

__device__ void ph_mlstm_s3(KP p, int layer, char* smc) {
  const int tid = opaque_tid();
  for (int tile = blockIdx.x; tile < NMT; tile += gridDim.x) { mlstm_s3(p, layer, tile, smc, tid); __syncthreads(); }
}

__device__ void ph_rec_final(KP p, int layer, bool keep) {
  const int tid = opaque_tid();
  const int j = layer >> 1;
  const int lane = tid & 63, wave = tid >> 6;
  const int rows = keep ? NT : NL;
  const int c0 = lane * 8;
  auto unpack = [](const u32x4 u, float (&f)[8]) {
    f[0] = bflo(u.x); f[1] = bfhi(u.x); f[2] = bflo(u.y); f[3] = bfhi(u.y);
    f[4] = bflo(u.z); f[5] = bfhi(u.z); f[6] = bflo(u.w); f[7] = bfhi(u.w);
  };
  for (int t = blockIdx.x * 4 + wave; t < rows; t += gridDim.x * 4) {
    const bf16_t* rw = p->RW + (size_t)t * RWS + c0;
    const bf16_t* pt = p->P + (size_t)t * LDP + c0;
    bf16_t* mo = p->AB + (size_t)t * DM + c0;
    {
      float yf[8], yb[8], r[8], v[8], k0[8], k1[8], g[8], y[8], o[8];
      unpack(*(const u32x4*)(pt), yf); unpack(*(const u32x4*)(pt + 512), yb);
      unpack(*(const u32x4*)(rw), r); unpack(*(const u32x4*)(rw + 512), v);
      unpack(*(const u32x4*)(rw + 5 * 512), k0); unpack(*(const u32x4*)(rw + 6 * 512), k1);
      unpack(*(const u32x4*)(rw + 9 * 512), g);
      float s1 = 0.f, bs = 0.f;
      const float* rk = p->rwkv_rk + j * 512 + c0;
#pragma unroll
      for (int e = 0; e < 8; ++e) { y[e] = yf[e] + yb[e]; s1 += y[e]; bs += r[e] * rk[e] * (k0[e] + k1[e]); }
      s1 += dppx<0xB1>(s1); s1 += dppx<0x4E>(s1); s1 += dppx<0x141>(s1);
      bs += dppx<0xB1>(bs); bs += dppx<0x4E>(bs); bs += dppx<0x141>(bs);
      const float mu = s1 * (1.f / 64.f);
      float s2 = 0.f;
#pragma unroll
      for (int e = 0; e < 8; ++e) { const float d = y[e] - mu; s2 += d * d; }
      s2 += dppx<0xB1>(s2); s2 += dppx<0x4E>(s2); s2 += dppx<0x141>(s2);
      const float rs = rsqrtf(s2 * (1.f / 64.f) + 64e-5f);
      const float* gn0 = p->rwkv_gn + (j * 2 + 0) * 512 + c0;
      const float* gn1 = p->rwkv_gn + (j * 2 + 1) * 512 + c0;
#pragma unroll
      for (int e = 0; e < 8; ++e) o[e] = ((y[e] - mu) * rs * gn0[e] + gn1[e] + bs * v[e]) * g[e];
      u32x4 ov;
      ov.x = pk_bf16(o[0], o[1]); ov.y = pk_bf16(o[2], o[3]); ov.z = pk_bf16(o[4], o[5]); ov.w = pk_bf16(o[6], o[7]);
      *(u32x4*)(mo) = ov;
    }
    {
      float hf[8], hb[8], og[8], hsum[8], o[8];
      unpack(*(const u32x4*)(pt + 1024), hf); unpack(*(const u32x4*)(pt + 1536), hb);
      unpack(*(const u32x4*)(pt + 3584), og);
      float ss = 0.f;
#pragma unroll
      for (int e = 0; e < 8; ++e) { hsum[e] = hf[e] + hb[e]; ss += hsum[e] * hsum[e]; }
      ss += dppx<0xB1>(ss); ss += dppx<0x4E>(ss); ss += dppx<0x141>(ss); ss += dppx<0x140>(ss);
      const float rs = rsqrtf(ss * (1.f / 128.f) + 1e-6f);
      const float* ng = p->mlstm_norm + j * 512 + c0;
#pragma unroll
      for (int e = 0; e < 8; ++e) o[e] = hsum[e] * rs * ng[e] * sigm_f(og[e]);
      u32x4 ov;
      ov.x = pk_bf16(o[0], o[1]); ov.y = pk_bf16(o[2], o[3]); ov.z = pk_bf16(o[4], o[5]); ov.w = pk_bf16(o[6], o[7]);
      *(u32x4*)(mo + 512) = ov;
    }
  }
}

using f32x4v = __attribute__((ext_vector_type(4))) float;
__device__ void ph_ln_router(KP p, int layer, bool keep, char* smc) {
  float* h2s = (float*)smc;
  float* lgs = (float*)smc;
  const int tid = opaque_tid();
  const int lane = tid & 63, wave = tid >> 6;
  const int rows = keep ? NT : NL;
  const float* lng = p->ln_g + (layer * 2 + 0) * 1024;
  const float* lnb = p->ln_b + (layer * 2 + 0) * 1024;
  const float* Wr = p->moe_router + (size_t)layer * 1024 * 64;
  for (int tile = blockIdx.x; tile < rows / 16; tile += gridDim.x) {
    const int t0 = tile * 16;
    const float* mod = p->MOD + (layer * 9 + modrow(t0)) * 6144;
#pragma unroll 1
    for (int q = 0; q < 4; ++q) {
      const int tl = wave * 4 + q, t = t0 + tl;
      float4 v[4];
      float s = 0.f;
#pragma unroll
      for (int i = 0; i < 4; ++i) {
        v[i] = *(const float4*)(p->Tb + (size_t)t * DM + i * 256 + lane * 4);
        s += (v[i].x + v[i].y) + (v[i].z + v[i].w);
      }
      const float mean = wsum(s) * (1.f / 1024.f);
      float qq = 0.f;
#pragma unroll
      for (int i = 0; i < 4; ++i) {
        const float d0 = v[i].x - mean, d1 = v[i].y - mean, d2 = v[i].z - mean, d3 = v[i].w - mean;
        qq += (d0 * d0 + d1 * d1) + (d2 * d2 + d3 * d3);
      }
      const float rs = rsqrtf(wsum(qq) * (1.f / 1024.f) + 1e-5f);
#pragma unroll
      for (int i = 0; i < 4; ++i) {
        const int n = i * 256 + lane * 4;
        const float4 g = *(const float4*)(lng + n), bb = *(const float4*)(lnb + n);
        const float4 sc = *(const float4*)(mod + 4096 + n), sh = *(const float4*)(mod + 3072 + n);
        const float4 xn = make_float4((v[i].x - mean) * rs * g.x + bb.x, (v[i].y - mean) * rs * g.y + bb.y,
                                      (v[i].z - mean) * rs * g.z + bb.z, (v[i].w - mean) * rs * g.w + bb.w);
        *(float4*)(p->X + (size_t)t * DM + n) = xn;
        const float4 hh = make_float4(xn.x * (1.f + sc.x) + sh.x, xn.y * (1.f + sc.y) + sh.y,
                                      xn.z * (1.f + sc.z) + sh.z, xn.w * (1.f + sc.w) + sh.w);
        u32x2 o; o.x = pk_bf16(hh.x, hh.y); o.y = pk_bf16(hh.z, hh.w);
        *(u32x2*)(p->AB + (size_t)t * DM + n) = o;
        *(float4*)(h2s + tl * 1028 + n) = hh;
      }
    }
    __syncthreads();
    f32x4v acc = {0.f, 0.f, 0.f, 0.f};
    {
      f32x4v a1 = {0.f, 0.f, 0.f, 0.f}, a2 = {0.f, 0.f, 0.f, 0.f}, a3 = {0.f, 0.f, 0.f, 0.f};
      const int i = lane & 15, kk = lane >> 4;
      const float* arow = h2s + i * 1028 + 4 * kk;
      const float* bcol = Wr + (4 * kk) * 64 + 16 * wave + i;
#pragma unroll 4
      for (int q = 0; q < 64; ++q) {
        const float4 a = *(const float4*)(arow + 16 * q);
        const float b0 = bcol[(16 * q + 0) * 64], b1 = bcol[(16 * q + 1) * 64];
        const float b2 = bcol[(16 * q + 2) * 64], b3 = bcol[(16 * q + 3) * 64];
        acc = __builtin_amdgcn_mfma_f32_16x16x4f32(a.x, b0, acc, 0, 0, 0);
        a1 = __builtin_amdgcn_mfma_f32_16x16x4f32(a.y, b1, a1, 0, 0, 0);
        a2 = __builtin_amdgcn_mfma_f32_16x16x4f32(a.z, b2, a2, 0, 0, 0);
        a3 = __builtin_amdgcn_mfma_f32_16x16x4f32(a.w, b3, a3, 0, 0, 0);
      }
      acc = (acc + a1) + (a2 + a3);
    }
    __syncthreads();
#pragma unroll
    for (int r = 0; r < 4; ++r) lgs[((lane >> 4) * 4 + r) * 64 + 16 * wave + (lane & 15)] = acc[r];
    __syncthreads();
#pragma unroll 1
    for (int q = 0; q < 4; ++q) {
      const int tl = wave * 4 + q, t = t0 + tl;
      const float logit = lgs[tl * 64 + lane];
      const float score = sigm_f(logit);
      float sel = score + p->moe_bias[layer * 64 + lane];
      bool chosen = false;
      for (int r = 0; r < 6; ++r) {
        const float mx = wmax(sel);
        const unsigned long long bal = __ballot(sel == mx);
        const int first = __ffsll((long long)bal) - 1;
        if (lane == first) { chosen = true; sel = -INFINITY; }
      }
      const float gsum = wsum(chosen ? score : 0.f);
      const unsigned long long cb = __ballot(chosen);
      if (chosen) {
        const int kidx = __popcll(cb & ((1ull << lane) - 1ull));
        const int pos = atomicAdd(&p->cnt[lane], 1);
        p->ltok[(size_t)lane * NT + pos] = t;
        p->lgate[(size_t)lane * NT + pos] = score / gsum * 2.5f;
        p->tsl[t * 6 + kidx] = (lane << 16) | pos;
      }
    }
    __syncthreads();
  }
}

__device__ __forceinline__ void moe_prefix(KP p, int rows, int* s_pref, int tid) {
  if (tid == 0) {
    int a = 0;
    for (int e = 0; e < 64; ++e) { s_pref[e] = a; a += (p->cnt[e] + 127) >> 7; }
    s_pref[64] = a; a += rows >> 7;
    s_pref[65] = a;
  }
  __syncthreads();
}

__device__ void ph_gemm(KP p, int kind, int layer, bool keep, char* lds) {
  const int tid = opaque_tid();
  const int j = layer >> 1;
  const bool att = !(layer & 1);
  const int rows = keep ? NT : NL;
  int* pref = (int*)(lds + META_OFF);
  int* s_idx = pref + 66;
  float* s_gate = (float*)(s_idx + 128);
  if (kind == 1 && blockIdx.x == 0 && tid < 65) p->cnt[tid] = 0;
  if (kind == 2 || kind == 3) moe_prefix(p, rows, pref, tid);
  int total;
  const int ntn_in = att ? 18 : 33;
  switch (kind) {
    case 0: total = (NT / 128) * ntn_in; break;
    case 1: total = (rows / 128) * 8; break;
    case 2: total = pref[65] * 4; break;
    case 3: total = pref[65] * 8; break;
    case 4: total = (NT / 128) * 3; break;
    default: total = (NT / 128) * 20; break;
  }
  for (int tile = blockIdx.x; tile < total; tile += gridDim.x) {
    const bf16_t* Abase; const bf16_t* Bt;
    int astride, K, n0, m0 = 0, aux = 0, e = 0, mtile = 0;
    switch (kind) {
      case 0: { const int tm = tile / ntn_in, tn = tile % ntn_in; m0 = tm * 128; n0 = tn * 128;
                Abase = p->AB + (size_t)m0 * DM; astride = DM; K = 1024;
                Bt = att ? p->Wt_att + (size_t)j * ATT_N * 1024 : p->Wt_rec + (size_t)j * REC_NP * 1024; } break;
      case 1: { const int tm = tile >> 3, tn = tile & 7; m0 = tm * 128; n0 = tn * 128;
                Abase = p->AB + (size_t)m0 * DM; astride = DM; K = 1024; Bt = p->Wt_out + (size_t)layer * 1024 * 1024; } break;
      case 2: { mtile = tile >> 2; aux = tile & 3; n0 = aux * 128; while (mtile >= pref[e + 1]) ++e;
                Abase = p->AB; astride = DM; K = 1024; Bt = p->Wt13 + (size_t)(layer * 65 + e) * 512 * 1024; } break;
      case 3: { mtile = tile >> 3; aux = tile & 7; n0 = aux * 128; while (mtile >= pref[e + 1]) ++e;
                Abase = p->ACT + (size_t)mtile * 128 * 256; astride = 256; K = 256; Bt = p->Wt2 + (size_t)(layer * 65 + e) * 1024 * 256; } break;
      case 4: { const int tm = tile / 3; aux = tile % 3; m0 = tm * 128; n0 = 0;
                Abase = p->Zb + (size_t)m0 * 1536 + aux * 512; astride = 1536; K = 512; Bt = p->Wl1 + (size_t)(j * 3 + aux) * 128 * 512; } break;
      default: { const int tm = tile / 20; aux = tile % 20; m0 = tm * 128; n0 = aux * 128;
                const int grp = aux < 8 ? 0 : (aux < 16 ? 1 : 2);
                Abase = p->L1 + (size_t)m0 * 384 + grp * 128; astride = 384; K = 128; Bt = p->Wl2 + (size_t)j * 2560 * 128; } break;
    }
    if (tid < 128) {
      int idx = tid; float g = 1.f;
      if (kind == 2 || kind == 3) {
        const int pos = (mtile - pref[e]) * 128 + tid;
        if (kind == 2) {
          idx = 0;
          if (e < 64) { if (pos < p->cnt[e]) idx = p->ltok[(size_t)e * NT + pos]; }
          else idx = pos;
        } else if (e < 64) g = pos < p->cnt[e] ? p->lgate[(size_t)e * NT + pos] : 0.f;
      }
      s_idx[tid] = idx; s_gate[tid] = g;
    }
    __syncthreads();
    {
      f32x16 acc[2][2];
      gemm128_main(tid, [&](int r) { return Abase + (size_t)s_idx[r] * astride; }, Bt, K, n0, lds, acc);
      float* Ct = (float*)lds;
      acc_foreach(tid, acc, [&](int row, int col, float v) { Ct[row * 128 + col] = v; });
    }
    __syncthreads();
    {
      const float* Ct = (const float*)lds;
      const int c4 = (tid & 31) * 4, r0 = tid >> 5;
      const int N_in = att ? ATT_N : REC_N;
      const int d5 = (aux >> 2) & 1, c05 = (aux & 3) * 128;
      switch (kind) {
        case 0: {
#pragma unroll 8
          for (int it = 0; it < 16; ++it) {
            const int row = it * 8 + r0;
            const float4 v = *(const float4*)(Ct + row * 128 + c4);

            const int cn = n0 + c4;
            float4 vq = v;
            if (att && n0 >= 1536 && n0 < 2176) {
              float ss = v.x * v.x + v.y * v.y + v.z * v.z + v.w * v.w;
              ss += dppx<0xB1>(ss); ss += dppx<0x4E>(ss); ss += dppx<0x141>(ss); ss += dppx<0x140>(ss);
              const float rs = rsqrtf(ss * (1.f / 64.f) + 1e-6f);
              const float4 g = *(const float4*)(p->qk_gain + j * 128 + (n0 >= 2048 ? 64 : 0) + (cn & 63));
              vq = make_float4(v.x * rs * g.x, v.y * rs * g.y, v.z * rs * g.z, v.w * rs * g.w);
              const int t = m0 + row;
              if (t < NL) {
                const int sidx = t & 2047, pi0 = (cn & 63) >> 1;
                const int pos = pi0 < 16 ? (sidx >> 6) : (sidx & 63);
                const float4 cs = *(const float4*)(p->ROPE + (pos * 16 + (pi0 & 15)) * 2);
                vq = make_float4(vq.x * cs.x - vq.y * cs.y, vq.x * cs.y + vq.y * cs.x,
                                 vq.z * cs.z - vq.w * cs.w, vq.z * cs.w + vq.w * cs.z);
              }
            }
            if (cn < N_in) {
              u32x2 o; o.x = pk_bf16(vq.x, vq.y); o.y = pk_bf16(vq.z, vq.w);
              *(u32x2*)(p->P + (size_t)(m0 + row) * LDP + cn) = o;
            }
            if (!att && cn >= 4096 && cn < 4112) *(float4*)(p->GP + (size_t)(m0 + row) * 16 + (cn - 4096)) = v;
          }
        } break;
        case 1: {
#pragma unroll 16
          for (int it = 0; it < 16; ++it) {
            const int row = it * 8 + r0;
            const float4 v = *(const float4*)(Ct + row * 128 + c4);

            const size_t o = (size_t)(m0 + row) * DM + n0 + c4;
            const float4 xv = *(const float4*)(p->X + o);
            const float4 g = *(const float4*)(p->MOD + (layer * 9 + modrow(m0)) * 6144 + 2048 + n0 + c4);
            *(float4*)(p->Tb + o) = make_float4(DN_ALPHA * xv.x + g.x * v.x, DN_ALPHA * xv.y + g.y * v.y,
                                                DN_ALPHA * xv.z + g.z * v.z, DN_ALPHA * xv.w + g.w * v.w);
          }
        } break;
        case 2: {
#pragma unroll 8
          for (int it = 0; it < 16; ++it) {
            const int row = it * 8 + r0;
            const float4 v = *(const float4*)(Ct + row * 128 + c4);

            if (((c4 >> 5) & 1) == 0) {
              const float4 u = *(const float4*)(Ct + row * 128 + c4 + 32);
              u32x2 o;
              o.x = pk_bf16(silu_f(v.x) * u.x, silu_f(v.y) * u.y);
              o.y = pk_bf16(silu_f(v.z) * u.z, silu_f(v.w) * u.w);
              *(u32x2*)(p->ACT + ((size_t)mtile * 128 + row) * 256 + aux * 64 + (c4 >> 6) * 32 + (c4 & 31)) = o;
            }
          }
        } break;
        case 3: {
#pragma unroll 16
          for (int it = 0; it < 16; ++it) {
            const int row = it * 8 + r0;
            const float4 v = *(const float4*)(Ct + row * 128 + c4);

            const float g = s_gate[row];
            u32x2 o; o.x = pk_bf16(g * v.x, g * v.y); o.y = pk_bf16(g * v.z, g * v.w);
            *(u32x2*)(p->OUT2 + ((size_t)mtile * 128 + row) * 1024 + n0 + c4) = o;
          }
        } break;
        case 4: {
#pragma unroll 4
          for (int it = 0; it < 16; ++it) {
            const int row = it * 8 + r0;
            const float4 v = *(const float4*)(Ct + row * 128 + c4);

            float4 o4 = v;
            if (aux == 0) o4 = make_float4(tanhf(v.x), tanhf(v.y), tanhf(v.z), tanhf(v.w));
            else if (aux == 2) o4 = make_float4(sigm_f(v.x), sigm_f(v.y), sigm_f(v.z), sigm_f(v.w));
            u32x2 o; o.x = pk_bf16(o4.x, o4.y); o.y = pk_bf16(o4.z, o4.w);
            *(u32x2*)(p->L1 + (size_t)(m0 + row) * 384 + aux * 128 + c4) = o;
          }
        } break;
        default: {
#pragma unroll 4
          for (int it = 0; it < 16; ++it) {
            const int row = it * 8 + r0;
            const float4 v = *(const float4*)(Ct + row * 128 + c4);

            bf16_t* rr = p->RW + (size_t)(m0 + row) * RWS + c05 + c4;
            const float vv[4] = {v.x, v.y, v.z, v.w};
            if (aux < 8) {
              const float4 b0 = *(const float4*)(p->rwkv_w0 + (j * 2 + d5) * 512 + c05 + c4);
              const float bb[4] = {b0.x, b0.y, b0.z, b0.w};
              float e4[4];
#pragma unroll
              for (int q = 0; q < 4; ++q) e4[q] = expf(-softplus_f(-(bb[q] + vv[q])) - 0.5f);
              u32x2 o; o.x = pk_bf16(e4[0], e4[1]); o.y = pk_bf16(e4[2], e4[3]);
              *(u32x2*)(rr + (3 + d5) * 512) = o;
            } else if (aux < 16) {
              const float4 b0 = *(const float4*)(p->rwkv_a0 + (j * 2 + d5) * 512 + c05 + c4);
              const float4 k1 = *(const float4*)(p->rwkv_kvec + (j * 2 + 1) * 512 + c05 + c4);
              const u32x2 kx2 = *(const u32x2*)(rr + 10 * 512);
              const float bb[4] = {b0.x, b0.y, b0.z, b0.w}, kk1[4] = {k1.x, k1.y, k1.z, k1.w};
              const float kx[4] = {bflo(kx2.x), bfhi(kx2.x), bflo(kx2.y), bfhi(kx2.y)};
              float av[4], ke[4];
#pragma unroll
              for (int q = 0; q < 4; ++q) { av[q] = sigm_f(bb[q] + vv[q]); ke[q] = kx[q] * (1.f + (av[q] - 1.f) * kk1[q]); }
              u32x2 o; o.x = pk_bf16(av[0], av[1]); o.y = pk_bf16(av[2], av[3]);
              *(u32x2*)(rr + (7 + d5) * 512) = o;
              o.x = pk_bf16(ke[0], ke[1]); o.y = pk_bf16(ke[2], ke[3]);
              *(u32x2*)(rr + (5 + d5) * 512) = o;
            } else {
              u32x2 o; o.x = pk_bf16(v.x, v.y); o.y = pk_bf16(v.z, v.w);
              *(u32x2*)(rr + 9 * 512) = o;
            }
          }
        } break;
      }
    }
    __syncthreads();
  }
}

__device__ void ph_final_ln(KP p, int layer, bool keep, char* lds) {
  const int tid = opaque_tid();
  const int lane = tid & 63, wave = tid >> 6;
  const int rows = keep ? NT : NL;
  int* s_base = (int*)(lds + META_OFF);
  if (tid == 0) {
    int a = 0;
    for (int e = 0; e < 64; ++e) { s_base[e] = a * 128; a += (p->cnt[e] + 127) >> 7; }
    s_base[64] = a * 128;
  }
  __syncthreads();
  const float* lng = p->ln_g + (layer * 2 + 1) * 1024;
  const float* lnb = p->ln_b + (layer * 2 + 1) * 1024;
  for (int t = blockIdx.x * 4 + wave; t < rows; t += gridDim.x * 4) {
    const int mr = modrow(t);
    const float* g2 = p->MOD + (layer * 9 + mr) * 6144 + 5120;
    const bf16_t* src[7];
#pragma unroll
    for (int k = 0; k < 6; ++k) {
      const int v = p->tsl[t * 6 + k];
      src[k] = p->OUT2 + (size_t)(s_base[v >> 16] + (v & 0xffff)) * 1024;
    }
    src[6] = p->OUT2 + (size_t)(s_base[64] + t) * 1024;
    float v[16];
    float s = 0.f;
#pragma unroll
    for (int c = 0; c < 2; ++c) {
      const int n0 = c * 512 + lane * 8;
      float y[8];
#pragma unroll
      for (int q = 0; q < 8; ++q) y[q] = 0.f;
#pragma unroll
      for (int k = 0; k < 7; ++k) {
        const u32x4 u = *(const u32x4*)(src[k] + n0);
        y[0] += bflo(u.x); y[1] += bfhi(u.x); y[2] += bflo(u.y); y[3] += bfhi(u.y);
        y[4] += bflo(u.z); y[5] += bfhi(u.z); y[6] += bflo(u.w); y[7] += bfhi(u.w);
      }
      const float4 xa = *(const float4*)(p->X + (size_t)t * DM + n0), xb = *(const float4*)(p->X + (size_t)t * DM + n0 + 4);
      const float4 ga = *(const float4*)(g2 + n0), gb = *(const float4*)(g2 + n0 + 4);
      const float xx[8] = {xa.x, xa.y, xa.z, xa.w, xb.x, xb.y, xb.z, xb.w};
      const float gg[8] = {ga.x, ga.y, ga.z, ga.w, gb.x, gb.y, gb.z, gb.w};
#pragma unroll
      for (int q = 0; q < 8; ++q) { v[c * 8 + q] = DN_ALPHA * xx[q] + gg[q] * y[q]; s += v[c * 8 + q]; }
    }
    const float mean = wsum(s) * (1.f / 1024.f);
    float q2 = 0.f;
#pragma unroll
    for (int i = 0; i < 16; ++i) { const float d = v[i] - mean; q2 += d * d; }
    const float rs = rsqrtf(wsum(q2) * (1.f / 1024.f) + 1e-5f);
    const float* modn = p->MOD + ((layer + 1) * 9 + mr) * 6144;
#pragma unroll
    for (int c = 0; c < 2; ++c) {
      const int n0 = c * 512 + lane * 8;
      float xn[8];
#pragma unroll
      for (int q = 0; q < 8; ++q) xn[q] = (v[c * 8 + q] - mean) * rs * lng[n0 + q] + lnb[n0 + q];
      *(float4*)(p->X + (size_t)t * DM + n0) = make_float4(xn[0], xn[1], xn[2], xn[3]);
      *(float4*)(p->X + (size_t)t * DM + n0 + 4) = make_float4(xn[4], xn[5], xn[6], xn[7]);
      if (layer == 3) {
        *(float4*)(p->out + (size_t)t * DM + n0) = make_float4(xn[0], xn[1], xn[2], xn[3]);
        *(float4*)(p->out + (size_t)t * DM + n0 + 4) = make_float4(xn[4], xn[5], xn[6], xn[7]);
      } else {
        float hb[8];
#pragma unroll
        for (int q = 0; q < 8; ++q) hb[q] = xn[q] * (1.f + modn[1024 + n0 + q]) + modn[n0 + q];
        u32x4 o;
        o.x = pk_bf16(hb[0], hb[1]); o.y = pk_bf16(hb[2], hb[3]); o.z = pk_bf16(hb[4], hb[5]); o.w = pk_bf16(hb[6], hb[7]);
        *(u32x4*)(p->AB + (size_t)t * DM + n0) = o;
      }
    }
  }
}

#define XB_TMO      128
#define XB_XCNT(j)  (256  + 64 * (j))
#define XB_XSUB(j)  (1280 + 64 * (j))
#define XB_XGEN(j)  (2304 + 64 * (j))
#define XB_TOP      3328
#define XB_TOPGEN   3392
#define XB_SPIN_CAP (1u << 20)
#define LAS __attribute__((address_space(3)))
__device__ __forceinline__ unsigned xb_ld(unsigned* p) { return __hip_atomic_load(p, __ATOMIC_RELAXED, __HIP_MEMORY_SCOPE_AGENT); }
__device__ __forceinline__ unsigned xb_add(unsigned* p, unsigned v) { return __hip_atomic_fetch_add(p, v, __ATOMIC_RELAXED, __HIP_MEMORY_SCOPE_AGENT); }
__device__ __forceinline__ unsigned xb_xcc_id() { return (unsigned)__builtin_amdgcn_s_getreg((3 << 11) | 20) & 0xFu; }
#define XB_SPIN(cond, bar) do { unsigned _sp = 0; while (cond) { __builtin_amdgcn_s_sleep(1); \
    if ((++_sp & 255u) == 0u) { if (xb_ld(&(bar)[XB_TMO])) break; if (_sp > XB_SPIN_CAP) { atomicAdd(&(bar)[XB_TMO], 1u); break; } } } } while (0)
struct XcdBarrier { unsigned* bar; unsigned x; volatile LAS unsigned* st; };
__device__ __forceinline__ XcdBarrier xcd_barrier_post(unsigned* bar, volatile LAS unsigned* st) {
  XcdBarrier b; b.bar = bar; b.x = xb_xcc_id(); b.st = st;
  if (threadIdx.x == 0) (void)xb_add(&bar[XB_XCNT(b.x)], 1u);
  return b;
}
__device__ __forceinline__ void xcd_barrier_complete(unsigned* bar, unsigned x, unsigned& nloc, unsigned& nx) {
  const unsigned G = gridDim.x;
  unsigned sum, cnt, mine, sp = 0u;
  for (;;) {
    sum = 0u; cnt = 0u; mine = 0u;
#pragma unroll
    for (unsigned j = 0; j < 16; ++j) { const unsigned c = xb_ld(&bar[XB_XCNT(j)]); sum += c; cnt += (c > 0u) ? 1u : 0u; mine = (j == x) ? c : mine; }
    if (sum == G) break;
    __builtin_amdgcn_s_sleep(1);
    if ((++sp & 255u) == 0u) { if (xb_ld(&bar[XB_TMO])) break; if (sp > XB_SPIN_CAP) { atomicAdd(&bar[XB_TMO], 1u); break; } }
  }
  nloc = mine > 0u ? mine : 1u; nx = cnt > 0u ? cnt : 1u;
}
__device__ __forceinline__ void xcd_barrier(const XcdBarrier& b) {
  asm volatile("s_waitcnt vmcnt(0)" ::: "memory");
  __syncthreads();
  if (threadIdx.x == 0) {
    unsigned* bar = b.bar;
    __builtin_amdgcn_s_waitcnt(0);
    unsigned nloc = b.st[0], nx = b.st[1];
    if (nloc == 0u) { xcd_barrier_complete(bar, b.x, nloc, nx); b.st[0] = nloc; b.st[1] = nx; }
    const unsigned old = xb_add(&bar[XB_XSUB(b.x)], 1u);
    const unsigned gen = old / nloc;
    if (old + 1u == (gen + 1u) * nloc) {
      __builtin_amdgcn_fence(__ATOMIC_RELEASE, "agent");
      asm volatile("s_waitcnt vmcnt(0)" ::: "memory");
      const unsigned og = xb_add(&bar[XB_TOP], 1u);
      const unsigned tg = og / nx;
      if (og + 1u == (tg + 1u) * nx) xb_add(&bar[XB_TOPGEN], 1u);
      else XB_SPIN(xb_ld(&bar[XB_TOPGEN]) == tg, bar);
      __builtin_amdgcn_fence(__ATOMIC_ACQUIRE, "agent");
      xb_add(&bar[XB_XGEN(b.x)], 1u);
      asm volatile("s_waitcnt vmcnt(0)" ::: "memory");
    } else {
      XB_SPIN(xb_ld(&bar[XB_XGEN(b.x)]) == gen, bar);
      __builtin_amdgcn_fence(__ATOMIC_ACQUIRE, "agent");
      asm volatile("s_waitcnt vmcnt(0)" ::: "memory");
    }
  }
  __syncthreads();
}

constexpr int NSLOTS = 13;
constexpr int NPHASE = 2 + 4 * NSLOTS;
__device__ __forceinline__ bool phase_is_nop(int ph) {
  if (ph < 2) return false;
  const int layer = (ph - 2) / NSLOTS, st = (ph - 2) % NSLOTS;
  return !(layer & 1) && (st == 1 || (st >= 3 && st <= 7));
}
__device__ void run_phase(KP p, int ph, char* sm) {
  if (ph == 0) { ph_init(p, sm); return; }
  if (ph == 1) { ph_mod_h(p, sm); return; }
  const int layer = (ph - 2) / NSLOTS, st = (ph - 2) % NSLOTS;
  const bool odd = layer & 1;
  const bool keep = layer < 3;
  int gk = -1;
  if (st == 0) gk = 0;
  else if (st == 8) gk = 1;
  else if (st == 10) gk = 2;
  else if (st == 11) gk = 3;
  else if (odd && st == 2) gk = 4;
  else if (odd && st == 3) gk = 5;
  asm volatile("" : "+s"(gk));
  if (gk >= 0) { ph_gemm(p, gk, layer, keep, sm); return; }
  switch (st) {
    case 1: if (odd) ph_rwkv_mix(p, layer); break;
    case 2: ph_attention(p, layer, keep, sm); break;
    case 4: if (odd) ph_scan_a(p, layer, sm); break;
    case 5: if (odd) ph_mlstm_s2(p, sm); break;
    case 6: if (odd) ph_mlstm_s3(p, layer, sm); break;
    case 7: if (odd) ph_rec_final(p, layer, keep); break;
    case 9: ph_ln_router(p, layer, keep, sm); break;
    case 12: ph_final_ln(p, layer, keep, sm); break;
  }
}

__global__ void __launch_bounds__(NTHR, 2) mega_kernel(Params kargs) {
  extern __shared__ __attribute__((aligned(16))) char sm[];
  cg::grid_group grid = cg::this_grid();
  volatile LAS unsigned* st = (volatile LAS unsigned*)(sm + META_OFF + 4032);
  if (threadIdx.x == 0) { st[0] = 0u; st[1] = 0u; }
  __syncthreads();
  const XcdBarrier xb = xcd_barrier_post(kargs.bar, st);
  for (int ph = kargs.ph_lo; ph < kargs.ph_hi; ++ph) {
    if (phase_is_nop(ph)) continue;
    {
      KP kp = (KP)__builtin_amdgcn_kernarg_segment_ptr();
      asm volatile("" : "+s"(kp));
      run_phase(kp, ph, sm);
    }
    if (ph + 1 < kargs.ph_hi) {
      if (ph == 0) grid.sync();
      else xcd_barrier(xb);
    }
  }
}

extern "C" void kernel_launch(void* const* d_in, const int* in_sizes, int n_in, void* d_out, int out_size, void* d_ws,
                              size_t ws_size, hipStream_t stream) {
  static int grid_blocks = 0;
  if (!grid_blocks) {
    int dev = 0, cus = 0, per_cu = 0;
    (void)hipGetDevice(&dev);
    (void)hipDeviceGetAttribute(&cus, hipDeviceAttributeMultiprocessorCount, dev);
    (void)hipFuncSetAttribute((const void*)mega_kernel, hipFuncAttributeMaxDynamicSharedMemorySize, SMEM_BYTES);
    (void)hipOccupancyMaxActiveBlocksPerMultiprocessor(&per_cu, mega_kernel, NTHR, SMEM_BYTES);
    if (per_cu < 1) per_cu = 1;
    if (per_cu > 2) per_cu = 2;
    grid_blocks = cus * per_cu;
  }
  Params p;
  memset(&p, 0, sizeof(p));
  const float** pin = (const float**)&p;
  for (int i = 0; i < 35; ++i) pin[i] = (const float*)d_in[i];
  p.out = (float*)d_out;
  char* w = (char*)d_ws;
  size_t off = 0;
  auto take = [&](size_t bytes) { char* r = w + off; off += (bytes + 255) & ~(size_t)255; return r; };
  p.Wt_att = (bf16_t*)take((size_t)2 * ATT_N * 1024 * 2);
  p.Wt_rec = (bf16_t*)take((size_t)2 * REC_NP * 1024 * 2);
  p.Wt_out = (bf16_t*)take((size_t)4 * 1024 * 1024 * 2);
  p.Wt13 = (bf16_t*)take((size_t)4 * 65 * 512 * 1024 * 2);
  p.Wt2 = (bf16_t*)take((size_t)4 * 65 * 1024 * 256 * 2);
  p.Wl1 = (bf16_t*)take((size_t)2 * 3 * 128 * 512 * 2);
  p.Wl2 = (bf16_t*)take((size_t)2 * 2560 * 128 * 2);
  p.X = (float*)take((size_t)NT * DM * 4);
  p.AB = (bf16_t*)take((size_t)NT * DM * 2);
  p.MOD = (float*)take((size_t)5 * 9 * 6144 * 4);
  p.MODP = (float*)take((size_t)8 * 4 * 9 * 6144 * 4);
  p.GP = (float*)take((size_t)NT * 16 * 4);
  p.ROPE = (float*)take((size_t)64 * 16 * 2 * 4);
  p.msc = (float*)take((size_t)3 * NMT * 4);
  p.lgate = (float*)take((size_t)64 * NT * 4);
  p.ltok = (int*)take((size_t)64 * NT * 4);
  p.tsl = (int*)take((size_t)NT * 6 * 4);
  p.cnt = (int*)take(512);
  p.bar = (unsigned*)take((size_t)BAR_TOTAL_WORDS * 4);
  char* region = take(0);
  const size_t szP = (size_t)NT * LDP * 2, szRW = (size_t)NT * RWS * 2, szMS = (size_t)NMT * 16384 * 2,
               szMSn = (size_t)NMT * 128 * 4;
  const size_t szT = (size_t)NT * DM * 4, szOUT2 = (size_t)NSLOT * 1024 * 2;
  p.P = (bf16_t*)region;
  p.RW = (bf16_t*)(region + szP);
  p.MS = (bf16_t*)(region + szP + szRW);
  p.MSn = (float*)(region + szP + szRW + szMS);
  p.Zb = p.MS;
  p.L1 = p.MS + (size_t)NT * 1536;
  p.Tb = (float*)region;
  p.ACT = (bf16_t*)region;
  p.OUT2 = (bf16_t*)(region + szT);
  size_t mixer = szP + szRW + szMS + szMSn, moe = szT + szOUT2;
  off += (mixer > moe ? mixer : moe);
  if (off > ws_size) { fprintf(stderr, "workspace too small: need %zu have %zu\n", off, ws_size); return; }
  p.ph_lo = 0;
  p.ph_hi = NPHASE;
  (void)hipMemsetAsync(p.bar, 0, (size_t)BAR_TOTAL_WORDS * 4, stream);
  void* args[] = {&p};
  hipError_t e = hipLaunchCooperativeKernel((void*)mega_kernel, dim3(grid_blocks), dim3(NTHR), args, SMEM_BYTES, stream);
  if (e != hipSuccess) fprintf(stderr, "cooperative launch failed: %s (grid %d)\n", hipGetErrorString(e), grid_blocks);
}
```

```cpp
#include <hip/hip_runtime.h>
#include <hip/hip_cooperative_groups.h>
#include <cstdio>
#include <cstring>
namespace cg = cooperative_groups;

constexpr int DM = 1024;
constexpr int NBATCH = 8;
constexpr int SEQ = 2048;
constexpr int CTXL = 256;
constexpr int NL = NBATCH * SEQ;
constexpr int NC = NBATCH * CTXL;
constexpr int NT = NL + NC;
constexpr int TSC = CTXL + SEQ;
constexpr int LDP = 4112;
constexpr int ATT_N = 2304;
constexpr int REC_N = 4112;
constexpr int REC_NP = 4224;
constexpr int NCHUNK = 36;
constexpr int NMT = 64 * NCHUNK;
constexpr int RWS = 5632;
constexpr int NSLOT = 137216;
constexpr float DN_ALPHA = 1.6817928305074290f;
constexpr int NTHR = 256;
constexpr int SMEM_BYTES = 65536 + 4096;
constexpr int META_OFF = 65536;
#define XCD_BAR_WORDS 3456
constexpr int BAR_TOTAL_WORDS = XCD_BAR_WORDS + 64;

typedef unsigned short bf16_t;
using bf16x8 = __attribute__((ext_vector_type(8))) short;
using f32x16 = __attribute__((ext_vector_type(16))) float;
using u32x4 = __attribute__((ext_vector_type(4))) unsigned;
using u32x2 = __attribute__((ext_vector_type(2))) unsigned;

struct Params {
  const float *x, *c, *ctx, *c_ctx, *ada_w, *ada_b, *ln_g, *ln_b, *mix_w_out, *att_w_in, *na_rpb, *qk_gain,
      *rec_w_in, *rwkv_mu, *rwkv_w0, *rwkv_w1, *rwkv_w2, *rwkv_a0, *rwkv_a1, *rwkv_a2, *rwkv_g1, *rwkv_g2,
      *rwkv_kvec, *rwkv_rk, *rwkv_gn, *mlstm_gate_b, *mlstm_norm, *moe_router, *moe_bias, *moe_w1, *moe_w3,
      *moe_w2, *shared_w1, *shared_w3, *shared_w2;
  float* out;
  bf16_t *Wt_att, *Wt_rec, *Wt_out, *Wt13, *Wt2, *Wl1, *Wl2;
  bf16_t *Zb, *L1;
  float *X, *MOD, *MODP, *GP, *msc, *lgate, *MSn, *Tb, *ROPE;
  bf16_t *AB, *P, *RW, *MS, *ACT, *OUT2;
  int *cnt, *ltok, *tsl;
  unsigned* bar;
  int ph_lo, ph_hi;
};

typedef const Params __attribute__((address_space(4))) * KP;

__device__ __forceinline__ int modrow(int t) { return t < NL ? (t >> 11) : 8; }
__device__ __forceinline__ float silu_f(float x) { return x / (1.f + expf(-x)); }
__device__ __forceinline__ float sigm_f(float x) { return 1.f / (1.f + expf(-x)); }
__device__ __forceinline__ float softplus_f(float x) { return fmaxf(x, 0.f) + log1pf(expf(-fabsf(x))); }
template <int CTRL>
__device__ __forceinline__ float dppx(float x) {
  return __int_as_float(__builtin_amdgcn_update_dpp(0, __float_as_int(x), CTRL, 0xf, 0xf, true));
}
__device__ __forceinline__ float rdlane(float v, int l) {
  return __int_as_float(__builtin_amdgcn_readlane(__float_as_int(v), l));
}
__device__ __forceinline__ float wsum(float v) {
  v += dppx<0xB1>(v); v += dppx<0x4E>(v); v += dppx<0x141>(v); v += dppx<0x140>(v);
  return (rdlane(v, 0) + rdlane(v, 16)) + (rdlane(v, 32) + rdlane(v, 48));
}
__device__ __forceinline__ float wmax(float v) {
  v = fmaxf(v, dppx<0xB1>(v)); v = fmaxf(v, dppx<0x4E>(v)); v = fmaxf(v, dppx<0x141>(v)); v = fmaxf(v, dppx<0x140>(v));
  return fmaxf(fmaxf(rdlane(v, 0), rdlane(v, 16)), fmaxf(rdlane(v, 32), rdlane(v, 48)));
}
__device__ __forceinline__ int opaque_tid() {
  int t = threadIdx.x;
  asm volatile("" : "+v"(t));
  return t;
}
typedef __bf16 bf16x2_t __attribute__((ext_vector_type(2)));
typedef float f32x2_t __attribute__((ext_vector_type(2)));
__device__ __forceinline__ unsigned pk_bf16(float lo, float hi) {
  const f32x2_t v = {lo, hi};
  return __builtin_bit_cast(unsigned, __builtin_convertvector(v, bf16x2_t));
}
__device__ __forceinline__ bf16_t f2bf(float x) { return (bf16_t)(pk_bf16(x, 0.f) & 0xffffu); }
__device__ __forceinline__ float bf2f(bf16_t v) { return __uint_as_float((unsigned)v << 16); }
__device__ __forceinline__ float bflo(unsigned u) { return __uint_as_float(u << 16); }
__device__ __forceinline__ float bfhi(unsigned u) { return __uint_as_float(u & 0xffff0000u); }
__device__ __forceinline__ int scan_row(int dir, int b, int tau) {
  if (tau < CTXL) return NL + b * CTXL + (dir ? (CTXL - 1 - tau) : tau);
  int s = tau - CTXL;
  return b * SEQ + (dir ? (SEQ - 1 - s) : s);
}

template <class RowPtrA>
__device__ __forceinline__ void gemm128_main(int tid, RowPtrA rowA, const bf16_t* __restrict__ Bt, int K, int n0,
                                             char* lds, f32x16 (&acc)[2][2]) {
  const int lane = tid & 63, w = tid >> 6;
  const int wm = w >> 1, wn = w & 1, r = lane & 31, h = lane >> 5;
  const int c = tid & 7, sr = tid >> 3;
  const int lc = (c ^ ((tid >> 4) & 7)) * 8;
  const bf16_t* ap[4];
#pragma unroll
  for (int i = 0; i < 4; ++i) ap[i] = rowA(sr + 32 * i) + lc;
  const bf16_t* bp0 = Bt + (size_t)(n0 + sr) * K + lc;
  const int bstr = 32 * K;
#pragma unroll
  for (int mi = 0; mi < 2; ++mi)
#pragma unroll
    for (int ni = 0; ni < 2; ++ni)
#pragma unroll
      for (int q = 0; q < 16; ++q) acc[mi][ni][q] = 0.f;
  const int nk = K >> 6;
  auto issue = [&](int kt) {
    char* As = lds + (kt & 1) * 32768 + tid * 16;
    const int k0 = kt * 64;
#pragma unroll
    for (int i = 0; i < 4; ++i) {
      __builtin_amdgcn_global_load_lds((const unsigned*)(ap[i] + k0), (__attribute__((address_space(3))) unsigned*)(As + i * 4096), 16, 0, 0);
      __builtin_amdgcn_global_load_lds((const unsigned*)(bp0 + i * bstr + k0), (__attribute__((address_space(3))) unsigned*)(As + 16384 + i * 4096), 16, 0, 0);
    }
  };
  issue(0);
  const int sw = (r >> 1) & 7;
#pragma unroll 1
  for (int kt = 0; kt < nk; ++kt) {
    asm volatile("s_waitcnt vmcnt(0)" ::: "memory");
    __syncthreads();
    if (kt + 1 < nk) issue(kt + 1);
    const char* As = lds + (kt & 1) * 32768;
    const char* Ar = As + (wm * 64 + r) * 128;
    const char* Br = As + 16384 + (wn * 64 + r) * 128;
#pragma unroll
    for (int ks = 0; ks < 4; ++ks) {
      const int off = ((ks * 2 + h) ^ sw) * 16;
      const bf16x8 a0 = *(const bf16x8*)(Ar + off);
      const bf16x8 a1 = *(const bf16x8*)(Ar + 32 * 128 + off);
      const bf16x8 b0 = *(const bf16x8*)(Br + off);
      const bf16x8 b1 = *(const bf16x8*)(Br + 32 * 128 + off);
      acc[0][0] = __builtin_amdgcn_mfma_f32_32x32x16_bf16(a0, b0, acc[0][0], 0, 0, 0);
      acc[0][1] = __builtin_amdgcn_mfma_f32_32x32x16_bf16(a0, b1, acc[0][1], 0, 0, 0);
      acc[1][0] = __builtin_amdgcn_mfma_f32_32x32x16_bf16(a1, b0, acc[1][0], 0, 0, 0);
      acc[1][1] = __builtin_amdgcn_mfma_f32_32x32x16_bf16(a1, b1, acc[1][1], 0, 0, 0);
    }
  }
  __syncthreads();
}
using i64 = long;
template <class RowPtrA8>
__device__ __forceinline__ void gemm128_fp8(int tid, RowPtrA8 rowA, const unsigned char* __restrict__ Bt, int K, int n0,
                                            char* lds, f32x16 (&acc)[2][2]) {
  const int lane = tid & 63, w = tid >> 6;
  const int wm = w >> 1, wn = w & 1, r = lane & 31, h = lane >> 5;
  const int c = tid & 7, sr = tid >> 3;
  const int lc = (c ^ ((tid >> 4) & 7)) * 16;
  const unsigned char* ap[4];
#pragma unroll
  for (int i = 0; i < 4; ++i) ap[i] = rowA(sr + 32 * i) + lc;
  const unsigned char* bp0 = Bt + (size_t)(n0 + sr) * K + lc;
  const int bstr = 32 * K;
#pragma unroll
  for (int mi = 0; mi < 2; ++mi)
#pragma unroll
    for (int ni = 0; ni < 2; ++ni)
#pragma unroll
      for (int q = 0; q < 16; ++q) acc[mi][ni][q] = 0.f;
  const int nk = K >> 7;
  auto issue = [&](int kt) {
    char* As = lds + (kt & 1) * 32768 + tid * 16;
    const int k0 = kt * 128;
#pragma unroll
    for (int i = 0; i < 4; ++i) {
      __builtin_amdgcn_global_load_lds((const unsigned*)(ap[i] + k0), (__attribute__((address_space(3))) unsigned*)(As + i * 4096), 16, 0, 0);
      __builtin_amdgcn_global_load_lds((const unsigned*)(bp0 + i * bstr + k0), (__attribute__((address_space(3))) unsigned*)(As + 16384 + i * 4096), 16, 0, 0);
    }
  };
  issue(0);
  const int sw = (r >> 1) & 7;
#pragma unroll 1
  for (int kt = 0; kt < nk; ++kt) {
    asm volatile("s_waitcnt vmcnt(0)" ::: "memory");
    __syncthreads();
    if (kt + 1 < nk) issue(kt + 1);
    const char* As = lds + (kt & 1) * 32768;
    const char* Ar = As + (wm * 64 + r) * 128;
    const char* Br = As + 16384 + (wn * 64 + r) * 128;
#pragma unroll
    for (int q = 0; q < 4; ++q) {
      const int off = ((q * 2 + h) ^ sw) * 16;
      const u32x4 a0 = *(const u32x4*)(Ar + off);
      const u32x4 a1 = *(const u32x4*)(Ar + 32 * 128 + off);
      const u32x4 b0 = *(const u32x4*)(Br + off);
      const u32x4 b1 = *(const u32x4*)(Br + 32 * 128 + off);
      const i64 a0l = (i64)(((unsigned long long)a0.y << 32) | a0.x), a0h = (i64)(((unsigned long long)a0.w << 32) | a0.z);
      const i64 a1l = (i64)(((unsigned long long)a1.y << 32) | a1.x), a1h = (i64)(((unsigned long long)a1.w << 32) | a1.z);
      const i64 b0l = (i64)(((unsigned long long)b0.y << 32) | b0.x), b0h = (i64)(((unsigned long long)b0.w << 32) | b0.z);
      const i64 b1l = (i64)(((unsigned long long)b1.y << 32) | b1.x), b1h = (i64)(((unsigned long long)b1.w << 32) | b1.z);
      acc[0][0] = __builtin_amdgcn_mfma_f32_32x32x16_fp8_fp8(a0l, b0l, acc[0][0], 0, 0, 0);
      acc[0][1] = __builtin_amdgcn_mfma_f32_32x32x16_fp8_fp8(a0l, b1l, acc[0][1], 0, 0, 0);
      acc[1][0] = __builtin_amdgcn_mfma_f32_32x32x16_fp8_fp8(a1l, b0l, acc[1][0], 0, 0, 0);
      acc[1][1] = __builtin_amdgcn_mfma_f32_32x32x16_fp8_fp8(a1l, b1l, acc[1][1], 0, 0, 0);
      acc[0][0] = __builtin_amdgcn_mfma_f32_32x32x16_fp8_fp8(a0h, b0h, acc[0][0], 0, 0, 0);
      acc[0][1] = __builtin_amdgcn_mfma_f32_32x32x16_fp8_fp8(a0h, b1h, acc[0][1], 0, 0, 0);
      acc[1][0] = __builtin_amdgcn_mfma_f32_32x32x16_fp8_fp8(a1h, b0h, acc[1][0], 0, 0, 0);
      acc[1][1] = __builtin_amdgcn_mfma_f32_32x32x16_fp8_fp8(a1h, b1h, acc[1][1], 0, 0, 0);
    }
  }
  __syncthreads();
}
template <class F>
__device__ __forceinline__ void acc_foreach(int tid, const f32x16 (&acc)[2][2], F f) {
  const int lane = tid & 63, w = tid >> 6;
  const int wm = w >> 1, wn = w & 1, r = lane & 31, h = lane >> 5;
#pragma unroll
  for (int mi = 0; mi < 2; ++mi)
#pragma unroll
    for (int ni = 0; ni < 2; ++ni)
#pragma unroll
      for (int q = 0; q < 16; ++q) {
        const int row = wm * 64 + mi * 32 + (q & 3) + 8 * (q >> 2) + 4 * h;
        const int col = wn * 64 + ni * 32 + r;
        f(row, col, acc[mi][ni][q]);
        if ((q & 3) == 3) __builtin_amdgcn_sched_barrier(0);
      }
}

template <class RM>
__device__ __forceinline__ void tr_tile(int tid, const float* __restrict__ src, int N, int k0, int n0,
                                        bf16_t* __restrict__ dst, int K, RM rowmap, float* tile) {
  {
    const int tx = tid & 15, ty = tid >> 4;
    const int n = n0 + tx * 4;
#pragma unroll
    for (int i = 0; i < 4; ++i) {
      const int k = ty + 16 * i;
      float4 v = make_float4(0.f, 0.f, 0.f, 0.f);
      if (n < N) v = *(const float4*)(src + (size_t)(k0 + k) * N + n);
      tile[k * 65 + tx * 4 + 0] = v.x; tile[k * 65 + tx * 4 + 1] = v.y;
      tile[k * 65 + tx * 4 + 2] = v.z; tile[k * 65 + tx * 4 + 3] = v.w;
    }
  }
  __syncthreads();
  {
    const int kc = tid & 7;
#pragma unroll
    for (int i = 0; i < 2; ++i) {
      const int n = (tid >> 3) + 32 * i;
      if (n0 + n < N) {
        float v[8];
#pragma unroll
        for (int q = 0; q < 8; ++q) v[q] = tile[(kc * 8 + q) * 65 + n];
        u32x4 o;
        o.x = pk_bf16(v[0], v[1]); o.y = pk_bf16(v[2], v[3]); o.z = pk_bf16(v[4], v[5]); o.w = pk_bf16(v[6], v[7]);
        *(u32x4*)(dst + (size_t)rowmap(n0 + n) * K + k0 + kc * 8) = o;
      }
    }
  }
  __syncthreads();
}

constexpr float W8_SCALE = 32.f, W8_INV = 1.f / 32.f;
__device__ __forceinline__ unsigned pk_fp8x4(float a, float b, float c, float d) {
  int r = __builtin_amdgcn_cvt_pk_fp8_f32(a, b, 0, false);
  r = __builtin_amdgcn_cvt_pk_fp8_f32(c, d, r, true);
  return (unsigned)r;
}
template <class RM>
__device__ __forceinline__ void tr_tile_fp8(int tid, const float* __restrict__ src, int N, int k0, int n0,
                                            unsigned char* __restrict__ dst, int K, RM rowmap, float* tile) {
  {
    const int tx = tid & 15, ty = tid >> 4;
    const int n = n0 + tx * 4;
#pragma unroll
    for (int i = 0; i < 4; ++i) {
      const int k = ty + 16 * i;
      const float4 v = *(const float4*)(src + (size_t)(k0 + k) * N + n);
      tile[k * 65 + tx * 4 + 0] = v.x; tile[k * 65 + tx * 4 + 1] = v.y;
      tile[k * 65 + tx * 4 + 2] = v.z; tile[k * 65 + tx * 4 + 3] = v.w;
    }
  }
  __syncthreads();
  {
    const int kc = tid & 3, n = tid >> 2;
    float v[16];
#pragma unroll
    for (int q = 0; q < 16; ++q) v[q] = tile[(kc * 16 + q) * 65 + n] * W8_SCALE;
    u32x4 o;
    o.x = pk_fp8x4(v[0], v[1], v[2], v[3]); o.y = pk_fp8x4(v[4], v[5], v[6], v[7]);
    o.z = pk_fp8x4(v[8], v[9], v[10], v[11]); o.w = pk_fp8x4(v[12], v[13], v[14], v[15]);
    *(u32x4*)(dst + (size_t)rowmap(n0 + n) * K + k0 + kc * 16) = o;
  }
  __syncthreads();
}

constexpr int CJ0 = 1152, CJ1 = CJ0 + 2080, CJ2 = CJ1 + 1024, CJ3 = CJ2 + 33280, CJ4 = CJ3 + 16640;
__device__ void convert_job(KP p, int job, float* sm, int tid) {
  if (job < CJ0) {
    const int j = job / 576, rem = job % 576, kt = rem / 36, nt = rem % 36;
    tr_tile(tid, p->att_w_in + (size_t)j * 1024 * ATT_N, ATT_N, kt * 64, nt * 64, p->Wt_att + (size_t)j * ATT_N * 1024,
            1024, [](int n) { return n; }, sm);
  } else if (job < CJ1) {
    const int q = job - CJ0;
    const int j = q / 1040, rem = q % 1040, kt = rem / 65, nt = rem % 65;
    tr_tile(tid, p->rec_w_in + (size_t)j * 1024 * REC_N, REC_N, kt * 64, nt * 64, p->Wt_rec + (size_t)j * REC_NP * 1024,
            1024, [](int n) { return n; }, sm);
  } else if (job < CJ2) {
    const int q = job - CJ1;
    const int i = q >> 8, rem = q & 255, kt = rem >> 4, nt = rem & 15;
    tr_tile(tid, p->mix_w_out + (size_t)i * 1024 * 1024, 1024, kt * 64, nt * 64, p->Wt_out + (size_t)i * 1024 * 1024,
            1024, [](int n) { return n; }, sm);
  } else if (job < CJ3) {
    const int q = job - CJ2;
    const int le = q >> 7, rem = q & 127;
    const int which = rem >> 6, kt = (rem >> 2) & 15, nt = rem & 3;
    const int layer = le / 65, e = le % 65;
    const float* src;
    if (e < 64) src = (which ? p->moe_w3 : p->moe_w1) + (size_t)(layer * 64 + e) * 1024 * 256;
    else src = (which ? p->shared_w3 : p->shared_w1) + (size_t)layer * 1024 * 256;
    tr_tile_fp8(tid, src, 256, kt * 64, nt * 64, (unsigned char*)p->Wt13 + (size_t)le * 512 * 1024, 1024,
                [which](int n) { return 64 * (n >> 5) + which * 32 + (n & 31); }, sm);
  } else {
    const int q = job - CJ3;
    const int le = q >> 6, rem = q & 63;
    const int kt = rem >> 4, nt = rem & 15;
    const int layer = le / 65, e = le % 65;
    const float* src = e < 64 ? p->moe_w2 + (size_t)(layer * 64 + e) * 256 * 1024 : p->shared_w2 + (size_t)layer * 256 * 1024;
    tr_tile_fp8(tid, src, 1024, kt * 64, nt * 64, (unsigned char*)p->Wt2 + (size_t)le * 1024 * 256, 256, [](int n) { return n; }, sm);
  }
}
__device__ __forceinline__ int conv_stage_total(int stage) {
  return stage == 0 ? (576 + 1040 + 512 + 8320 + 4160) : (stage == 1 ? (576 + 1040 + 256 + 16640 + 8320) : (256 + 8320 + 4160));
}
__device__ __forceinline__ int conv_stage_job(int stage, int q) {
  if (stage == 0) {
    if (q < 8320) return CJ2 + q;  q -= 8320;
    if (q < 4160) return CJ3 + q;  q -= 4160;
    if (q < 576) return q;  q -= 576;
    if (q < 1040) return CJ0 + q;  q -= 1040;
    return CJ1 + q;
  } else if (stage == 1) {
    if (q < 8320) return CJ2 + 8320 + q;  q -= 8320;
    if (q < 4160) return CJ3 + 4160 + q;  q -= 4160;
    if (q < 576) return 576 + q;  q -= 576;
    if (q < 256) return CJ1 + 512 + q;  q -= 256;
    if (q < 8320) return CJ2 + 16640 + q;  q -= 8320;
    if (q < 4160) return CJ3 + 8320 + q;  q -= 4160;
    return CJ0 + 1040 + q;
  }
  if (q < 256) return CJ1 + 768 + q;  q -= 256;
  if (q < 8320) return CJ2 + 24960 + q;  q -= 8320;
  return CJ3 + 12480 + q;
}

__device__ void ph_init(KP p, char* smc) {
  float* sm = (float*)smc;
  const int tid = opaque_tid();
  {
    const size_t n4a = (size_t)NL * DM / 4, n4b = (size_t)NC * DM / 4;
    const float4* xs = (const float4*)p->x;
    const float4* cs = (const float4*)p->ctx;
    float4* X4 = (float4*)p->X;
    for (size_t i = (size_t)blockIdx.x * NTHR + tid; i < n4a + n4b; i += (size_t)gridDim.x * NTHR)
      X4[i] = i < n4a ? xs[i] : cs[i - n4a];
  }
  for (int tile = blockIdx.x; tile < 96 * 8; tile += gridDim.x) {
    const int ct = tile >> 3, ks = tile & 7;
    for (int i = tid; i < 9 * 128; i += NTHR) {
      const int r = i >> 7, k = ks * 128 + (i & 127);
      const float v = r < 8 ? p->c[r * 1024 + k] : p->c_ctx[k];
      sm[i] = silu_f(v);
    }
    __syncthreads();
    const int col = ct * 256 + tid;
    const int layer = col / 6144, n = col % 6144;
    const float* W = p->ada_w + ((size_t)layer * 1024 + ks * 128) * 6144 + n;
    float acc[9];
#pragma unroll
    for (int r = 0; r < 9; ++r) acc[r] = 0.f;
#pragma unroll 4
    for (int k = 0; k < 128; ++k) {
      const float w = W[(size_t)k * 6144];
#pragma unroll
      for (int r = 0; r < 9; ++r) acc[r] = fmaf(sm[r * 128 + k], w, acc[r]);
    }
#pragma unroll
    for (int r = 0; r < 9; ++r) p->MODP[((size_t)(ks * 4 + layer) * 9 + r) * 6144 + n] = acc[r];
    __syncthreads();
  }
  for (int q = blockIdx.x; q < conv_stage_total(0); q += gridDim.x) convert_job(p, conv_stage_job(0, q), sm, tid);
  for (int i = blockIdx.x * NTHR + tid; i < 2 * 3 * 128 * 512; i += gridDim.x * NTHR) {
    const int k = i & 511, n = (i >> 9) & 127, wj = i >> 16;
    const int j = wj / 3, which = wj % 3;
    float v = 0.f;
    if (which < 2) {
      if (n < 64) v = (which ? p->rwkv_a1 : p->rwkv_w1)[((size_t)(j * 2 + (n >> 5)) * 512 + k) * 32 + (n & 31)];
    } else if (n < 96) v = p->rwkv_g1[((size_t)j * 512 + k) * 96 + n];
    p->Wl1[i] = f2bf(v);
  }
  for (int i = blockIdx.x * NTHR + tid; i < 2 * 2560 * 128; i += gridDim.x * NTHR) {
    const int k = i & 127, n = (i >> 7) % 2560, j = i / (2560 * 128);
    float v = 0.f;
    if (n < 2048) {
      const int d = (n >> 9) & 1, c = n & 511;
      if (k < 64 && (k >> 5) == d) v = (n < 1024 ? p->rwkv_w2 : p->rwkv_a2)[((size_t)(j * 2 + d) * 32 + (k & 31)) * 512 + c];
    } else if (k < 96) v = p->rwkv_g2[((size_t)j * 96 + k) * 512 + (n - 2048)];
    p->Wl2[i] = f2bf(v);
  }
  for (int i = blockIdx.x * NTHR + tid; i < 64 * 16; i += gridDim.x * NTHR) {
    const int pos = i >> 4, f = i & 15;
    const float ang = (float)pos * powf(10000.f, -(float)f / 16.f);
    p->ROPE[2 * i] = cosf(ang);
    p->ROPE[2 * i + 1] = sinf(ang);
  }
}

__device__ void ph_mod_h(KP p, char* smc) {
  float* sm = (float*)smc;
  const int tid = opaque_tid();
  for (int i = blockIdx.x * NTHR + tid; i < 4 * 9 * 6144; i += gridDim.x * NTHR) {
    const int layer = i / (9 * 6144), rem = i % (9 * 6144), n = rem % 6144;
    float s = p->ada_b[layer * 6144 + n];
#pragma unroll
    for (int ks = 0; ks < 8; ++ks) s += p->MODP[(size_t)(ks * 4 + layer) * 9 * 6144 + rem];
    p->MOD[i] = s;
  }
  const int lane = tid & 63, wave = tid >> 6;
  const int per = (((NT + gridDim.x - 1) / gridDim.x) + 3) & ~3;
  const int t0 = blockIdx.x * per, t1 = min(NT, t0 + per);
  int cur = -1;
  for (int tb = t0; tb < t1; tb += 4) {
    const int mr = modrow(tb);
    if (mr != cur) {
      __syncthreads();
      for (int n = tid; n < 2048; n += NTHR) {
        float a = p->ada_b[n];
#pragma unroll
        for (int ks = 0; ks < 8; ++ks) a += p->MODP[((size_t)(ks * 4) * 9 + mr) * 6144 + n];
        sm[n] = a;
      }
      cur = mr;
      __syncthreads();
    }
    const int t = tb + wave;
    if (t < t1) {
      const float* src = t < NL ? p->x + (size_t)t * DM : p->ctx + (size_t)(t - NL) * DM;
#pragma unroll
      for (int i = 0; i < 4; ++i) {
        const int n = i * 256 + lane * 4;
        const float4 xv = *(const float4*)(src + n);
        const float4 sh = *(const float4*)(sm + n);
        const float4 sc = *(const float4*)(sm + 1024 + n);
        u32x2 o;
        o.x = pk_bf16(xv.x * (1.f + sc.x) + sh.x, xv.y * (1.f + sc.y) + sh.y);
        o.y = pk_bf16(xv.z * (1.f + sc.z) + sh.z, xv.w * (1.f + sc.w) + sh.w);
        *(u32x2*)(p->AB + (size_t)t * DM + n) = o;
      }
    }
  }
}

typedef short v4i16_t __attribute__((ext_vector_type(4)));
using s16x4 = __attribute__((ext_vector_type(4))) short;
__device__ __forceinline__ s16x4 vtr(const char* p) {
  return __builtin_bit_cast(s16x4, __builtin_amdgcn_ds_read_tr16_b64_v4i16((__attribute__((address_space(3))) v4i16_t*)p));
}
#define MFMA32(a, b, c) __builtin_amdgcn_mfma_f32_32x32x16_bf16(a, b, c, 0, 0, 0)
__device__ void ph_attention(KP p, int layer, bool keep, char* lds) {
  const int tid = opaque_tid();
  const int lane = tid & 63, w = tid >> 6, r32 = lane & 31, hi = lane >> 5;
  const int j = layer >> 1;
  float* bias_lds = (float*)(lds + 32768 + 1024);
  const int n_gqa = 1024, n_na = 1024, n_cb = keep ? 128 : 0, n_ca = keep ? 128 : 0;
  const int total = n_gqa + n_na + n_cb + n_ca;
  constexpr float LOG2E = 1.4426950408889634f;
  constexpr float C2 = 0.125f * LOG2E;
  const int c = tid & 7, sr = tid >> 3;
  const int kso = (c ^ ((tid >> 4) & 7)) * 16;
  const int vso = (c >> 2) * 4096 + (c & 3) * 16;
  const int sw = (r32 >> 1) & 7;
  for (int item = blockIdx.x; item < total; item += gridDim.x) {
    int b, qrow0, qoff, koff, voff, ocol, lat_tiles, lat_row0;
    bool na = false;
    int r_w = 0, start_w = 0, ru0 = 0, hN = 0;
    if (item < n_gqa) {
      b = item >> 7;
      const int g = (item >> 6) & 1, tt = item & 63;
      qrow0 = b * SEQ + tt * 32; qoff = 1536 + (g * 4 + w) * 64; koff = 2048 + g * 64; voff = 2176 + g * 64;
      ocol = 512 + (g * 4 + w) * 64; lat_tiles = 32; lat_row0 = b * SEQ;
    } else if (item < n_gqa + n_na) {
      const int it = item - n_gqa;
      b = it >> 7; hN = (it >> 4) & 7;
      const int rp = it & 15;
      na = true; r_w = 2 * rp + (w >> 1);
      qrow0 = b * SEQ + r_w * 64 + (w & 1) * 32; qoff = hN * 64; koff = 512 + hN * 64; voff = 1024 + hN * 64; ocol = hN * 64;
      const int s0 = min(max(2 * rp - 4, 0), 24), s1 = min(max(2 * rp - 3, 0), 24);
      start_w = (w >> 1) ? s1 : s0; ru0 = s0; lat_tiles = (s1 != s0) ? 9 : 8; lat_row0 = b * SEQ + ru0 * 64;
    } else if (item < n_gqa + n_na + n_cb) {
      const int it = item - n_gqa - n_na;
      b = it >> 4;
      const int g = (it >> 3) & 1, tt = it & 7;
      qrow0 = NL + b * CTXL + tt * 32; qoff = 1536 + (g * 4 + w) * 64; koff = 2048 + g * 64; voff = 2176 + g * 64;
      ocol = 512 + (g * 4 + w) * 64; lat_tiles = 0; lat_row0 = 0;
    } else {
      const int it = item - n_gqa - n_na - n_cb;
      b = it >> 4;
      const int h = (it >> 1) & 7, half = it & 1;
      qrow0 = NL + b * CTXL + half * 128 + w * 32; qoff = h * 64; koff = 512 + h * 64; voff = 1024 + h * 64; ocol = h * 64;
      lat_tiles = 0; lat_row0 = 0;
    }
    const int ctx_row0 = NL + b * CTXL, ntiles = lat_tiles + 4;
    if (na)
      for (int i = tid; i < 465; i += NTHR) bias_lds[i] = p->na_rpb[(j * 8 + hN) * 465 + i] * LOG2E;
    bf16x8 qf[4];
    {
      const bf16_t* qp = p->P + (size_t)(qrow0 + r32) * LDP + qoff + hi * 8;
#pragma unroll
      for (int d0 = 0; d0 < 4; ++d0) qf[d0] = *(const bf16x8*)(qp + d0 * 16);
    }
    f32x16 o0, o1;
#pragma unroll
    for (int q = 0; q < 16; ++q) { o0[q] = 0.f; o1[q] = 0.f; }
    float m = -INFINITY, l = 0.f;
    u32x4 kr0, kr1, vr0, vr1;
    auto gload = [&](int t) {
      const int row0 = t < lat_tiles ? lat_row0 + 64 * t : ctx_row0 + 64 * (t - lat_tiles);
      const bf16_t* base = p->P + (size_t)(row0 + sr) * LDP + c * 8;
      kr0 = *(const u32x4*)(base + koff); kr1 = *(const u32x4*)(base + (size_t)32 * LDP + koff);
      vr0 = *(const u32x4*)(base + voff); vr1 = *(const u32x4*)(base + (size_t)32 * LDP + voff);
    };
    auto swrite = [&](int buf) {
      char* Kb = lds + buf * 16384;
      char* Vb = Kb + 8192;
      *(u32x4*)(Kb + sr * 128 + kso) = kr0; *(u32x4*)(Kb + (sr + 32) * 128 + kso) = kr1;
      *(u32x4*)(Vb + vso + sr * 64) = vr0; *(u32x4*)(Vb + vso + (sr + 32) * 64) = vr1;
    };
    gload(0);
    swrite(0);
    for (int t = 0; t < ntiles; ++t) {
      __syncthreads();
      if (t + 1 < ntiles) gload(t + 1);
      const bool na_tile = na && t < lat_tiles;
      const int kr = ru0 + t;
      const bool part = !na_tile || (kr >= start_w && kr < start_w + 8);
      if (part) {
        const char* Ks = lds + (t & 1) * 16384;
        const char* Vs = Ks + 8192;
        f32x16 s0, s1;
#pragma unroll
        for (int q = 0; q < 16; ++q) { s0[q] = 0.f; s1[q] = 0.f; }
#pragma unroll
        for (int d0 = 0; d0 < 4; ++d0) {
          const int off = ((2 * d0 + hi) ^ sw) * 16;
          const bf16x8 k0 = *(const bf16x8*)(Ks + r32 * 128 + off);
          const bf16x8 k1 = *(const bf16x8*)(Ks + (32 + r32) * 128 + off);
          s0 = MFMA32(k0, qf[d0], s0);
          s1 = MFMA32(k1, qf[d0], s1);
        }
        float mx = -INFINITY;
        if (na_tile) {
          const int cq = (w & 1) * 32 + r32;
          const int c0 = min(max(cq - 8, 0), 48);
          const float* brow = bias_lds + (kr - r_w + 7) * 31 + (15 - cq);
#pragma unroll
          for (int q = 0; q < 16; ++q) {
            const int kc = (q & 3) + 8 * (q >> 2) + 4 * hi;
            const float v0 = ((unsigned)(kc - c0) < 16u) ? fmaf(s0[q], C2, brow[kc]) : -INFINITY;
            const float v1 = ((unsigned)(kc + 32 - c0) < 16u) ? fmaf(s1[q], C2, brow[kc + 32]) : -INFINITY;
            s0[q] = v0; s1[q] = v1;
            mx = fmaxf(mx, fmaxf(v0, v1));
          }
        } else {
#pragma unroll
          for (int q = 0; q < 16; ++q) {
            s0[q] *= C2; s1[q] *= C2;
            mx = fmaxf(mx, fmaxf(s0[q], s1[q]));
          }
        }
        {
          auto rr = __builtin_amdgcn_permlane32_swap(__float_as_uint(mx), __float_as_uint(mx), false, false);
          mx = fmaxf(__uint_as_float(rr[0]), __uint_as_float(rr[1]));
        }
        const float mnew = fmaxf(m, mx);
        const float alpha = __builtin_amdgcn_exp2f(m - mnew);
        float ls = 0.f;
#pragma unroll
        for (int q = 0; q < 16; ++q) {
          s0[q] = __builtin_amdgcn_exp2f(s0[q] - mnew);
          s1[q] = __builtin_amdgcn_exp2f(s1[q] - mnew);
          ls += s0[q] + s1[q];
        }
        l = l * alpha + ls;
        m = mnew;
#pragma unroll
        for (int q = 0; q < 16; ++q) { o0[q] *= alpha; o1[q] *= alpha; }
        bf16x8 pf[4];
#pragma unroll
        for (int s = 0; s < 4; ++s) {
          const int u = (s & 1) * 8;
          u32x4 tpk;
          if (s < 2) {
            tpk.x = pk_bf16(s0[u + 0], s0[u + 1]); tpk.y = pk_bf16(s0[u + 2], s0[u + 3]);
            tpk.z = pk_bf16(s0[u + 4], s0[u + 5]); tpk.w = pk_bf16(s0[u + 6], s0[u + 7]);
          } else {
            tpk.x = pk_bf16(s1[u + 0], s1[u + 1]); tpk.y = pk_bf16(s1[u + 2], s1[u + 3]);
            tpk.z = pk_bf16(s1[u + 4], s1[u + 5]); tpk.w = pk_bf16(s1[u + 6], s1[u + 7]);
          }
          pf[s] = __builtin_bit_cast(bf16x8, tpk);
        }
        const char* vb = Vs + ((lane >> 4) & 1) * 32 + (lane & 3) * 8 + ((lane & 15) >> 2) * 64 + hi * 256;
#pragma unroll
        for (int s = 0; s < 4; ++s) {
          const s16x4 a00 = vtr(vb + (16 * s) * 64), a01 = vtr(vb + (16 * s + 8) * 64);
          const s16x4 a10 = vtr(vb + 4096 + (16 * s) * 64), a11 = vtr(vb + 4096 + (16 * s + 8) * 64);
          const bf16x8 A0 = __builtin_shufflevector(a00, a01, 0, 1, 2, 3, 4, 5, 6, 7);
          const bf16x8 A1 = __builtin_shufflevector(a10, a11, 0, 1, 2, 3, 4, 5, 6, 7);
          o0 = MFMA32(A0, pf[s], o0);
          o1 = MFMA32(A1, pf[s], o1);
        }
      }
      if (t + 1 < ntiles) swrite((t + 1) & 1);
    }
    __syncthreads();
    const float lt = l + __shfl_xor(l, 32);
    const float inv = 1.f / lt;
    bf16_t* op = p->AB + (size_t)(qrow0 + r32) * DM + ocol + 4 * hi;
#pragma unroll
    for (int g = 0; g < 4; ++g) {
      u32x2 v0, v1;
      v0.x = pk_bf16(o0[4 * g] * inv, o0[4 * g + 1] * inv); v0.y = pk_bf16(o0[4 * g + 2] * inv, o0[4 * g + 3] * inv);
      v1.x = pk_bf16(o1[4 * g] * inv, o1[4 * g + 1] * inv); v1.y = pk_bf16(o1[4 * g + 2] * inv, o1[4 * g + 3] * inv);
      *(u32x2*)(op + 8 * g) = v0;
      *(u32x2*)(op + 32 + 8 * g) = v1;
    }
  }
}

__device__ void ph_rwkv_mix(KP p, int layer) {
  const int j = layer >> 1;
  const int tid = opaque_tid();
  const int lane = tid & 63, wave = tid >> 6;
  const float* mu = p->rwkv_mu + j * 6 * 512;
  const int c0 = lane * 8;
  auto unpack = [](const u32x4 u, float (&f)[8]) {
    f[0] = bflo(u.x); f[1] = bfhi(u.x); f[2] = bflo(u.y); f[3] = bfhi(u.y);
    f[4] = bflo(u.z); f[5] = bfhi(u.z); f[6] = bflo(u.w); f[7] = bfhi(u.w);
  };
  auto pack = [](const float (&f)[8]) {
    u32x4 o;
    o.x = pk_bf16(f[0], f[1]); o.y = pk_bf16(f[2], f[3]); o.z = pk_bf16(f[4], f[5]); o.w = pk_bf16(f[6], f[7]);
    return o;
  };
  for (int t = blockIdx.x * 4 + wave; t < NT; t += gridDim.x * 4) {
    bool hasp, hasn;
    if (t < NL) { int s = t & 2047; hasp = s > 0; hasn = s < SEQ - 1; }
    else { int s = (t - NL) & 255; hasp = s > 0; hasn = s < CTXL - 1; }
    const bf16_t* pt = p->P + (size_t)t * LDP + c0;
    bf16_t* rw = p->RW + (size_t)t * RWS + c0;
    bf16_t* zb = p->Zb + (size_t)t * 1536 + c0;
    const u32x4 zero = {0u, 0u, 0u, 0u};
#pragma unroll
    for (int q = 0; q < 4; ++q) {
      float cur[8], pv[8], nx[8], d[8];
      unpack(*(const u32x4*)(pt + q * 512), cur);
      unpack(hasp ? *(const u32x4*)(pt + q * 512 - LDP) : zero, pv);
      unpack(hasn ? *(const u32x4*)(pt + q * 512 + LDP) : zero, nx);
#pragma unroll
      for (int e = 0; e < 8; ++e) d[e] = 0.5f * (pv[e] + nx[e]) - cur[e];
      if (q < 3) {
        float o[8];
        const float* m = mu + q * 512 + c0;
#pragma unroll
        for (int e = 0; e < 8; ++e) o[e] = cur[e] + d[e] * m[e];
        if (q == 0) *(u32x4*)(rw) = pack(o);
        else if (q == 2) *(u32x4*)(rw + 512) = pack(o);
        else {
          *(u32x4*)(rw + 10 * 512) = pack(o);
          float kk[8], ss = 0.f;
          const float* kv0 = p->rwkv_kvec + (j * 2 + 0) * 512 + c0;
#pragma unroll
          for (int e = 0; e < 8; ++e) { kk[e] = o[e] * kv0[e]; ss += kk[e] * kk[e]; }
          ss += dppx<0xB1>(ss); ss += dppx<0x4E>(ss); ss += dppx<0x141>(ss);
          const float rn = rsqrtf(fmaxf(ss, 1e-24f));
#pragma unroll
          for (int e = 0; e < 8; ++e) kk[e] *= rn;
          *(u32x4*)(rw + 2 * 512) = pack(kk);
        }
      } else {
#pragma unroll
        for (int z = 0; z < 3; ++z) {
          float o[8];
          const float* m = mu + (3 + z) * 512 + c0;
#pragma unroll
          for (int e = 0; e < 8; ++e) o[e] = cur[e] + d[e] * m[e];
          *(u32x4*)(zb + z * 512) = pack(o);
        }
      }
    }
  }
}

constexpr int RS_STEP = 384;
constexpr int RS_TB = 16;
struct RwkvStage { u32x2 r, kk, e, ke, a, v; };
__device__ void rwkv_unit(KP p, int unit, float* sm, int tid) {
  const int ch = unit >> 1, hf = unit & 1;
  const int dir = ch >> 6, b = (ch >> 3) & 7, h = ch & 7;
  const int lane = tid & 63, w = tid >> 6, rl = lane >> 3, ks = lane & 7;
  float* ybuf = sm + 2 * RS_TB * RS_STEP;
  const int ss = tid >> 4, kq = tid & 15;
  auto gload = [&](int n, RwkvStage& g) {
    const int row = scan_row(dir, b, n * RS_TB + ss);
    const bf16_t* base = p->RW + (size_t)row * RWS + h * 64 + kq * 4;
    g.r = *(const u32x2*)(base);
    g.kk = *(const u32x2*)(base + 2 * 512);
    g.e = *(const u32x2*)(base + (3 + dir) * 512);
    g.ke = *(const u32x2*)(base + (5 + dir) * 512);
    g.a = *(const u32x2*)(base + (7 + dir) * 512);
    g.v = *(const u32x2*)(p->RW + (size_t)row * RWS + 512 + h * 64 + hf * 32 + (kq & 7) * 4);
  };
  auto swrite = [&](int buf, const RwkvStage& g) {
    float* sp = sm + (buf * RS_TB + ss) * RS_STEP;
    const float r0 = bflo(g.r.x), r1 = bfhi(g.r.x), r2 = bflo(g.r.y), r3 = bfhi(g.r.y);
    const float k0 = bflo(g.kk.x), k1 = bfhi(g.kk.x), k2 = bflo(g.kk.y), k3 = bfhi(g.kk.y);
    const float w0 = __expf(-bflo(g.e.x)), w1 = __expf(-bfhi(g.e.x)), w2 = __expf(-bflo(g.e.y)), w3 = __expf(-bfhi(g.e.y));
    const float e0 = bflo(g.ke.x), e1 = bfhi(g.ke.x), e2 = bflo(g.ke.y), e3 = bfhi(g.ke.y);
    const float a0 = k0 * bflo(g.a.x), a1 = k1 * bfhi(g.a.x), a2 = k2 * bflo(g.a.y), a3 = k3 * bfhi(g.a.y);
    *(float4*)(sp + kq * 4) = make_float4(k0, k1, k2, k3);
    *(float4*)(sp + 64 + kq * 4) = make_float4(w0 * r0, w1 * r1, w2 * r2, w3 * r3);
    *(float4*)(sp + 128 + kq * 4) = make_float4(w0, w1, w2, w3);
    *(float4*)(sp + 192 + kq * 4) = make_float4(a0, a1, a2, a3);
    *(float4*)(sp + 256 + kq * 4) = make_float4(e0, e1, e2, e3);
    if (kq < 8) *(float4*)(sp + 320 + kq * 4) = make_float4(bflo(g.v.x), bfhi(g.v.x), bflo(g.v.y), bfhi(g.v.y));
    float c1 = a0 * r0 + a1 * r1 + a2 * r2 + a3 * r3;
    float c2 = e0 * r0 + e1 * r1 + e2 * r2 + e3 * r3;
    c1 += dppx<0xB1>(c1); c2 += dppx<0xB1>(c2);
    c1 += dppx<0x4E>(c1); c2 += dppx<0x4E>(c2);
    c1 += dppx<0x141>(c1); c2 += dppx<0x141>(c2);
    c1 += dppx<0x140>(c1); c2 += dppx<0x140>(c2);
    if (kq == 0) { sp[352] = c1; sp[353] = c2; }
  };
  typedef float f2 __attribute__((ext_vector_type(2)));
  f2 S01 = {0.f, 0.f}, S23 = {0.f, 0.f}, S45 = {0.f, 0.f}, S67 = {0.f, 0.f};
  auto compute = [&](int n) {
    const float* bp = sm + (n & 1) * RS_TB * RS_STEP;
    float* yb = ybuf + (n & 1) * RS_TB * 32 + w * 8 + rl;
    struct Ops { f2 k[4], r[4], w[4], a[4], e[4]; float vv; f2 c; };
    auto ld = [&](int s, Ops& o) {
      const float* sq = bp + s * RS_STEP;
      const f2* sp = (const f2*)(sq + ks * 8);
#pragma unroll
      for (int i = 0; i < 4; ++i) { o.k[i] = sp[i]; o.r[i] = sp[32 + i]; o.w[i] = sp[64 + i]; o.a[i] = sp[96 + i]; o.e[i] = sp[128 + i]; }
      o.vv = sq[320 + w * 8 + rl]; o.c = *(const f2*)(sq + 352);
    };
    auto step = [&](const Ops& o) -> float {
      f2 sa2 = S01 * o.k[0];
      f2 y2 = S01 * o.r[0];
      sa2 = __builtin_elementwise_fma(S23, o.k[1], sa2); y2 = __builtin_elementwise_fma(S23, o.r[1], y2);
      sa2 = __builtin_elementwise_fma(S45, o.k[2], sa2); y2 = __builtin_elementwise_fma(S45, o.r[2], y2);
      sa2 = __builtin_elementwise_fma(S67, o.k[3], sa2); y2 = __builtin_elementwise_fma(S67, o.r[3], y2);
      float sa = sa2.x + sa2.y, y0 = y2.x + y2.y;
      sa += dppx<0xB1>(sa); y0 += dppx<0xB1>(y0);
      sa += dppx<0x4E>(sa); y0 += dppx<0x4E>(y0);
      sa += dppx<0x141>(sa); y0 += dppx<0x141>(y0);
      sa = -sa;
      const f2 sav = {sa, sa}, vvv = {o.vv, o.vv};
      S01 = __builtin_elementwise_fma(vvv, o.e[0], __builtin_elementwise_fma(sav, o.a[0], S01 * o.w[0]));
      S23 = __builtin_elementwise_fma(vvv, o.e[1], __builtin_elementwise_fma(sav, o.a[1], S23 * o.w[1]));
      S45 = __builtin_elementwise_fma(vvv, o.e[2], __builtin_elementwise_fma(sav, o.a[2], S45 * o.w[2]));
      S67 = __builtin_elementwise_fma(vvv, o.e[3], __builtin_elementwise_fma(sav, o.a[3], S67 * o.w[3]));
      return fmaf(o.vv, o.c.y, fmaf(sa, o.c.x, y0));
    };
    Ops oa, ob, oc;
    ld(0, oa);
    ld(1, ob);
#pragma unroll 1
    for (int s = 0; s < 15; s += 3) {
      ld(s + 2, oc);
      float y0 = step(oa);
      asm volatile("" : "+v"(y0));
      ld(s + 3, oa);
      float y1 = step(ob);
      asm volatile("" : "+v"(y1));
      ld(s + 4, ob);
      float y2 = step(oc);
      asm volatile("" : "+v"(y2));
      if (ks == 0) { yb[s * 32] = y0; yb[(s + 1) * 32] = y1; yb[(s + 2) * 32] = y2; }
    }
    {
      const float y15 = step(oa);
      if (ks == 0) yb[15 * 32] = y15;
    }
  };
  auto yout = [&](int n) {
    const int row = scan_row(dir, b, n * RS_TB + ss);
    const float* ys = ybuf + (n & 1) * RS_TB * 32 + ss * 32 + kq * 2;
    *(unsigned*)(p->P + (size_t)row * LDP + dir * 512 + h * 64 + hf * 32 + kq * 2) = pk_bf16(ys[0], ys[1]);
  };
  constexpr int NB = TSC / RS_TB;
  RwkvStage gA, gB;
  gload(0, gA);
  gload(1, gB);
  swrite(0, gA);
  gload(2, gA);
  __syncthreads();
  for (int n = 0; n < NB; n += 2) {
    compute(n);
    swrite(1, gB);
    if (n + 3 < NB) gload(n + 3, gB);
    __syncthreads();
    yout(n);
    compute(n + 1);
    if (n + 2 < NB) swrite(0, gA);
    if (n + 4 < NB) gload(n + 4, gA);
    __syncthreads();
    yout(n + 1);
  }
  __syncthreads();
}

__device__ void mlstm_s1(KP p, int layer, int tile, char* lds, int tid) {
  const int j = layer >> 1;
  const int ch = tile / NCHUNK, c = tile % NCHUNK;
  const int dir = ch >> 5, b = (ch >> 2) & 7, h = ch & 3;
  float* s_ws = (float*)(lds + META_OFF);
  int* s_row = (int*)(s_ws + 64);
  char* kimg = lds;
  char* vimg = lds + 16384;
  if (tid < 64) {
    const int row = scan_row(dir, b, c * 64 + tid);
    s_row[tid] = row;
    const float* g = p->GP + (size_t)row * 16;
    const float gi = g[(dir * 2) * 4 + h] + p->mlstm_gate_b[j * 16 + (dir * 2) * 4 + h];
    const float gf = g[(dir * 2 + 1) * 4 + h] + p->mlstm_gate_b[j * 16 + (dir * 2 + 1) * 4 + h];
    float bc = -softplus_f(-gf);
#pragma unroll
    for (int o = 1; o < 64; o <<= 1) {
      float tmp = __shfl_up(bc, o);
      if (tid >= o) bc += tmp;
    }
    const float bend = __shfl(bc, 63);
    const float ds = bend - bc + gi;
    const float mloc = wmax(ds);
    s_ws[tid] = expf(ds - mloc);
    if (tid == 0) { p->msc[tile] = mloc; p->msc[NMT + tile] = bend; }
  }
  __syncthreads();
  {
    const int c8 = tid & 15;
    const int ioff = (c8 >> 2) * 4096 + (c8 & 3) * 16;
#pragma unroll
    for (int i = 0; i < 4; ++i) {
      const int sidx = (tid >> 4) + 16 * i;
      const bf16_t* src = p->P + (size_t)s_row[sidx] * LDP + h * 128 + c8 * 8;
      const u32x4 kv = *(const u32x4*)(src + 2560);
      u32x4 vv = *(const u32x4*)(src + 3072);
      const float wsv = s_ws[sidx];
      vv.x = pk_bf16(bflo(vv.x) * wsv, bfhi(vv.x) * wsv); vv.y = pk_bf16(bflo(vv.y) * wsv, bfhi(vv.y) * wsv);
      vv.z = pk_bf16(bflo(vv.z) * wsv, bfhi(vv.z) * wsv); vv.w = pk_bf16(bflo(vv.w) * wsv, bfhi(vv.w) * wsv);
      *(u32x4*)(kimg + ioff + sidx * 64) = kv;
      *(u32x4*)(vimg + ioff + sidx * 64) = vv;
    }
  }
  __syncthreads();
  const int lane = tid & 63, w = tid >> 6, wm = w >> 1, wn = w & 1, r32 = lane & 31, hi = lane >> 5;
  f32x16 acc[2][2];
#pragma unroll
  for (int mi = 0; mi < 2; ++mi)
#pragma unroll
    for (int ni = 0; ni < 2; ++ni)
#pragma unroll
      for (int q = 0; q < 16; ++q) acc[mi][ni][q] = 0.f;
  const int toff = ((lane >> 4) & 1) * 32 + (lane & 3) * 8 + ((lane & 15) >> 2) * 64 + hi * 256;
#pragma unroll
  for (int ks = 0; ks < 4; ++ks) {
    bf16x8 af[2], bfr[2];
#pragma unroll
    for (int i = 0; i < 2; ++i) {
      const char* ka = kimg + (wm * 2 + i) * 4096 + toff + (16 * ks) * 64;
      const char* va = vimg + (wn * 2 + i) * 4096 + toff + (16 * ks) * 64;
      af[i] = __builtin_shufflevector(vtr(ka), vtr(ka + 8 * 64), 0, 1, 2, 3, 4, 5, 6, 7);
      bfr[i] = __builtin_shufflevector(vtr(va), vtr(va + 8 * 64), 0, 1, 2, 3, 4, 5, 6, 7);
    }
    acc[0][0] = MFMA32(af[0], bfr[0], acc[0][0]);
    acc[0][1] = MFMA32(af[0], bfr[1], acc[0][1]);
    acc[1][0] = MFMA32(af[1], bfr[0], acc[1][0]);
    acc[1][1] = MFMA32(af[1], bfr[1], acc[1][1]);
  }
  bf16_t* U = p->MS + (size_t)tile * 16384;
#pragma unroll
  for (int mi = 0; mi < 2; ++mi)
#pragma unroll
    for (int ni = 0; ni < 2; ++ni)
#pragma unroll
      for (int q = 0; q < 16; ++q) {
        const int d = wm * 64 + mi * 32 + (q & 3) + 8 * (q >> 2) + 4 * hi;
        U[d * 128 + wn * 64 + ni * 32 + r32] = f2bf(acc[mi][ni][q]);
        if ((q & 3) == 3) __builtin_amdgcn_sched_barrier(0);
      }
  if (tid < 128) {
    const char* kc = kimg + (tid >> 5) * 4096 + (tid & 31) * 2;
    float a = 0.f;
#pragma unroll 8
    for (int sidx = 0; sidx < 64; ++sidx) a = fmaf(s_ws[sidx], bf2f(*(const bf16_t*)(kc + sidx * 64)), a);
    p->MSn[tile * 128 + tid] = a;
  }
}

__device__ void ph_scan_a(KP p, int layer, char* smc) {
  float* sm = (float*)smc;
  const int tid = opaque_tid();
  for (int u = blockIdx.x; u < 256; u += gridDim.x) rwkv_unit(p, u, sm, tid);
  const int nblk = gridDim.x, bid = blockIdx.x;
  const int start = (bid + nblk - (256 % nblk)) % nblk;
  for (int tile = start; tile < NMT; tile += nblk) { mlstm_s1(p, layer, tile, smc, tid); __syncthreads(); }
  {
    const int stage = layer == 1 ? 1 : 2;
    const int total = conv_stage_total(stage);
    int* qc = (int*)(p->bar + XCD_BAR_WORDS + 16 * stage);
    int* s_q = (int*)(smc + META_OFF + 3968);
    for (;;) {
      __syncthreads();
      if (tid == 0) *s_q = atomicAdd(qc, 1);
      __syncthreads();
      const int q = *s_q;
      if (q >= total) break;
      convert_job(p, conv_stage_job(stage, q), sm, tid);
    }
  }
}

__device__ void ph_mlstm_s2(KP p, char* smc) {
  float* sw = (float*)smc;
  const int tid = opaque_tid();
  const int nitems = 64 * 33;
  for (int item = blockIdx.x; item < nitems; item += gridDim.x) {
    const int ch = item / 33, seg = item % 33;
    __syncthreads();
    if (tid == 0) {
      float m = 0.f;
      for (int c = 0; c < NCHUNK; ++c) {
        const int tile = ch * NCHUNK + c;
        const float mloc = p->msc[tile], bend = p->msc[NMT + tile];
        const float mn = fmaxf(bend + m, mloc);
        sw[c] = expf(bend + m - mn);
        sw[36 + c] = expf(mloc - mn);
        if (seg == 0) p->msc[2 * NMT + tile] = m;
        m = mn;
      }
    }
    __syncthreads();
    if (seg < 32) {
      unsigned* base = (unsigned*)(p->MS + (size_t)ch * NCHUNK * 16384) + seg * 256 + tid;
      unsigned v[NCHUNK];
#pragma unroll
      for (int c = 0; c < NCHUNK; ++c) v[c] = base[(size_t)c * 8192];
      float C0 = 0.f, C1 = 0.f;
#pragma unroll
      for (int c = 0; c < NCHUNK; ++c) {
        const float t0 = bflo(v[c]), t1 = bfhi(v[c]);
        v[c] = pk_bf16(C0, C1);
        C0 = sw[c] * C0 + sw[36 + c] * t0;
        C1 = sw[c] * C1 + sw[36 + c] * t1;
      }
#pragma unroll
      for (int c = 0; c < NCHUNK; ++c) base[(size_t)c * 8192] = v[c];
    } else if (tid < 128) {
      float* base = p->MSn + (size_t)ch * NCHUNK * 128 + tid;
      float v[NCHUNK];
#pragma unroll
      for (int c = 0; c < NCHUNK; ++c) v[c] = base[c * 128];
      float C = 0.f;
#pragma unroll
      for (int c = 0; c < NCHUNK; ++c) {
        const float t0 = v[c];
        v[c] = C;
        C = sw[c] * C + sw[36 + c] * t0;
      }
#pragma unroll
      for (int c = 0; c < NCHUNK; ++c) base[c * 128] = v[c];
    }
  }
}

__device__ void mlstm_s3(KP p, int layer, int tile, char* lds, int tid) {
  const int j = layer >> 1;
  const int ch = tile / NCHUNK, c = tile % NCHUNK;
  const int dir = ch >> 5, b = (ch >> 2) & 7, h = ch & 3;
  float* s_b = (float*)(lds + META_OFF);
  float* s_ig = s_b + 64;
  float* s_mt = s_b + 128;
  float* s_wi = s_b + 192;
  int* s_row = (int*)(s_b + 256);
  float* s_n = s_b + 320;
  float* s_c = s_b + 448;
  char* kimg = lds;
  char* vimg = lds + 16384;
  char* cimg = lds + 32768;
  const float mprev = p->msc[2 * NMT + tile];
  const float qscale = 0.08838834764831845f;
  if (tid < 64) {
    const int row = scan_row(dir, b, c * 64 + tid);
    s_row[tid] = row;
    const float* g = p->GP + (size_t)row * 16;
    const float gi = g[(dir * 2) * 4 + h] + p->mlstm_gate_b[j * 16 + (dir * 2) * 4 + h];
    const float gf = g[(dir * 2 + 1) * 4 + h] + p->mlstm_gate_b[j * 16 + (dir * 2 + 1) * 4 + h];
    float bc = -softplus_f(-gf);
#pragma unroll
    for (int o = 1; o < 64; o <<= 1) {
      float tmp = __shfl_up(bc, o);
      if (tid >= o) bc += tmp;
    }
    s_b[tid] = bc;
    s_ig[tid] = gi;
  } else if (tid < 192) s_n[tid - 64] = p->MSn[tile * 128 + (tid - 64)];
  __syncthreads();
  if (tid < 64) {
    const float bt = s_b[tid];
    float mt = bt + mprev;
    for (int sx = 0; sx <= tid; ++sx) mt = fmaxf(mt, bt - s_b[sx] + s_ig[sx]);
    s_mt[tid] = mt;
    s_wi[tid] = expf(bt + mprev - mt);
    s_c[tid] = (s_ig[tid] - bt) * 1.4426950408889634f;
  }
  {
    const int c8 = tid & 15;
    const int ioff = (c8 >> 2) * 4096 + (c8 & 3) * 16;
#pragma unroll
    for (int i = 0; i < 4; ++i) {
      const int sidx = (tid >> 4) + 16 * i;
      const bf16_t* src = p->P + (size_t)s_row[sidx] * LDP + h * 128 + c8 * 8;
      *(u32x4*)(kimg + sidx * 256 + ((c8 ^ (sidx & 15)) * 16)) = *(const u32x4*)(src + 2560);
      *(u32x4*)(vimg + ioff + sidx * 64) = *(const u32x4*)(src + 3072);
    }
    __builtin_amdgcn_sched_barrier(0);
    const bf16_t* Cp = p->MS + (size_t)tile * 16384;
    const int coff = (c8 >> 2) * 8192 + (c8 & 3) * 16;
#pragma unroll
    for (int i = 0; i < 8; ++i) {
      const int d = (tid >> 4) + 16 * i;
      *(u32x4*)(cimg + coff + d * 64) = *(const u32x4*)(Cp + d * 128 + c8 * 8);
      if (i == 3) __builtin_amdgcn_sched_barrier(0);
    }
    __builtin_amdgcn_sched_barrier(0);
  }
  const int lane = tid & 63, w = tid >> 6, wt = w >> 1, wv = w & 1, r32 = lane & 31, hi = lane >> 5;
  const int t = wt * 32 + r32;
  bf16x8 qf[8];
  {
    const bf16_t* qp = p->P + (size_t)s_row[t] * LDP + 2048 + h * 128 + hi * 8;
#pragma unroll
    for (int d0 = 0; d0 < 8; ++d0) qf[d0] = *(const bf16x8*)(qp + d0 * 16);
  }
  __syncthreads();
  const int toff = ((lane >> 4) & 1) * 32 + (lane & 3) * 8 + ((lane & 15) >> 2) * 64;
  constexpr float LOG2E_ = 1.4426950408889634f;
  float qn = 0.f;
#pragma unroll
  for (int d0 = 0; d0 < 8; ++d0) {
    const u32x4 qq = __builtin_bit_cast(u32x4, qf[d0]);
    const float* np = s_n + d0 * 16 + hi * 8;
    qn = fmaf(bflo(qq.x), np[0], qn); qn = fmaf(bfhi(qq.x), np[1], qn);
    qn = fmaf(bflo(qq.y), np[2], qn); qn = fmaf(bfhi(qq.y), np[3], qn);
    qn = fmaf(bflo(qq.z), np[4], qn); qn = fmaf(bfhi(qq.z), np[5], qn);
    qn = fmaf(bflo(qq.w), np[6], qn); qn = fmaf(bfhi(qq.w), np[7], qn);
  }
  qn += __shfl_xor(qn, 32);
  const float mtt = s_mt[t], wi = s_wi[t];
  const float ct = (s_b[t] - mtt) * LOG2E_;
  const float wq = wi * qscale;
  bf16x8 pf[4];
  float den = 0.f;
  {
    f32x16 sa0, sa1;
#pragma unroll
    for (int q = 0; q < 16; ++q) { sa0[q] = 0.f; sa1[q] = 0.f; }
#pragma unroll
    for (int d0 = 0; d0 < 8; ++d0) {
      const int chn = 2 * d0 + hi;
      const bf16x8 k0 = *(const bf16x8*)(kimg + r32 * 256 + ((chn ^ (r32 & 15)) * 16));
      sa0 = MFMA32(k0, qf[d0], sa0);
      if (wt) {
        const bf16x8 k1 = *(const bf16x8*)(kimg + (32 + r32) * 256 + ((chn ^ (r32 & 15)) * 16));
        sa1 = MFMA32(k1, qf[d0], sa1);
      }
      __builtin_amdgcn_sched_barrier(0);
    }
#pragma unroll
    for (int g = 0; g < 4; ++g) {
      const int sb0 = 8 * g + 4 * hi;
      const float4 c0v = *(const float4*)(s_c + sb0);
      const float4 c1v = *(const float4*)(s_c + sb0 + 32);
      const float cc0[4] = {c0v.x, c0v.y, c0v.z, c0v.w}, cc1[4] = {c1v.x, c1v.y, c1v.z, c1v.w};
#pragma unroll
      for (int e = 0; e < 4; ++e) {
        const int q = 4 * g + e;
        const float v0 = (sb0 + e <= t) ? sa0[q] * qscale * __builtin_amdgcn_exp2f(ct + cc0[e]) : 0.f;
        sa0[q] = v0; den += v0;
        const float v1 = (wt && sb0 + 32 + e <= t) ? sa1[q] * qscale * __builtin_amdgcn_exp2f(ct + cc1[e]) : 0.f;
        sa1[q] = v1; den += v1;
      }
      __builtin_amdgcn_sched_barrier(0);
    }
#pragma unroll
    for (int sx = 0; sx < 4; ++sx) {
      const int u = (sx & 1) * 8;
      u32x4 tpk;
      if (sx < 2) {
        tpk.x = pk_bf16(sa0[u + 0], sa0[u + 1]); tpk.y = pk_bf16(sa0[u + 2], sa0[u + 3]);
        tpk.z = pk_bf16(sa0[u + 4], sa0[u + 5]); tpk.w = pk_bf16(sa0[u + 6], sa0[u + 7]);
      } else {
        tpk.x = pk_bf16(sa1[u + 0], sa1[u + 1]); tpk.y = pk_bf16(sa1[u + 2], sa1[u + 3]);
        tpk.z = pk_bf16(sa1[u + 4], sa1[u + 5]); tpk.w = pk_bf16(sa1[u + 6], sa1[u + 7]);
      }
      pf[sx] = __builtin_bit_cast(bf16x8, tpk);
    }
  }
  den += __shfl_xor(den, 32);
  const float dtot = den + wq * qn;
  const float inv = 1.f / fmaxf(fabsf(dtot), expf(-mtt));
  bf16_t* op = p->P + (size_t)s_row[t] * LDP + 1024 + dir * 512 + h * 128 + wv * 64 + 4 * hi;
#pragma unroll 1
  for (int vp = 0; vp < 2; ++vp) {
    f32x16 o0;
#pragma unroll
    for (int q = 0; q < 16; ++q) o0[q] = 0.f;
    const char* cb = cimg + (wv * 2 + vp) * 8192 + toff + hi * 512;
#pragma unroll
    for (int d0 = 0; d0 < 8; ++d0) {
      const bf16x8 A0 = __builtin_shufflevector(vtr(cb + (16 * d0) * 64), vtr(cb + (16 * d0 + 4) * 64), 0, 1, 2, 3, 4, 5, 6, 7);
      o0 = MFMA32(A0, qf[d0], o0);
    }
#pragma unroll
    for (int q = 0; q < 16; ++q) o0[q] *= wq;
    const char* vb = vimg + (wv * 2 + vp) * 4096 + toff + hi * 256;
#pragma unroll
    for (int sx = 0; sx < 4; ++sx) {
      if (sx < 2 || wt) {
        const bf16x8 A0 = __builtin_shufflevector(vtr(vb + (16 * sx) * 64), vtr(vb + (16 * sx + 8) * 64), 0, 1, 2, 3, 4, 5, 6, 7);
        o0 = MFMA32(A0, pf[sx], o0);
      }
    }
#pragma unroll
    for (int g = 0; g < 4; ++g) {
      u32x2 v0;
      v0.x = pk_bf16(o0[4 * g] * inv, o0[4 * g + 1] * inv); v0.y = pk_bf16(o0[4 * g + 2] * inv, o0[4 * g + 3] * inv);
      *(u32x2*)(op + vp * 32 + 8 * g) = v0;
    }
  }
}

__device__ void ph_mlstm_s3(KP p, int layer, char* smc) {
  const int tid = opaque_tid();
  for (int tile = blockIdx.x; tile < NMT; tile += gridDim.x) { mlstm_s3(p, layer, tile, smc, tid); __syncthreads(); }
}

__device__ void ph_rec_final(KP p, int layer, bool keep) {
  const int tid = opaque_tid();
  const int j = layer >> 1;
  const int lane = tid & 63, wave = tid >> 6;
  const int rows = keep ? NT : NL;
  const int c0 = lane * 8;
  auto unpack = [](const u32x4 u, float (&f)[8]) {
    f[0] = bflo(u.x); f[1] = bfhi(u.x); f[2] = bflo(u.y); f[3] = bfhi(u.y);
    f[4] = bflo(u.z); f[5] = bfhi(u.z); f[6] = bflo(u.w); f[7] = bfhi(u.w);
  };
  for (int t = blockIdx.x * 4 + wave; t < rows; t += gridDim.x * 4) {
    const bf16_t* rw = p->RW + (size_t)t * RWS + c0;
    const bf16_t* pt = p->P + (size_t)t * LDP + c0;
    bf16_t* mo = p->AB + (size_t)t * DM + c0;
    {
      float yf[8], yb[8], r[8], v[8], k0[8], k1[8], g[8], y[8], o[8];
      unpack(*(const u32x4*)(pt), yf); unpack(*(const u32x4*)(pt + 512), yb);
      unpack(*(const u32x4*)(rw), r); unpack(*(const u32x4*)(rw + 512), v);
      unpack(*(const u32x4*)(rw + 5 * 512), k0); unpack(*(const u32x4*)(rw + 6 * 512), k1);
      unpack(*(const u32x4*)(rw + 9 * 512), g);
      float s1 = 0.f, bs = 0.f;
      const float* rk = p->rwkv_rk + j * 512 + c0;
#pragma unroll
      for (int e = 0; e < 8; ++e) { y[e] = yf[e] + yb[e]; s1 += y[e]; bs += r[e] * rk[e] * (k0[e] + k1[e]); }
      s1 += dppx<0xB1>(s1); s1 += dppx<0x4E>(s1); s1 += dppx<0x141>(s1);
      bs += dppx<0xB1>(bs); bs += dppx<0x4E>(bs); bs += dppx<0x141>(bs);
      const float mu = s1 * (1.f / 64.f);
      float s2 = 0.f;
#pragma unroll
      for (int e = 0; e < 8; ++e) { const float d = y[e] - mu; s2 += d * d; }
      s2 += dppx<0xB1>(s2); s2 += dppx<0x4E>(s2); s2 += dppx<0x141>(s2);
      const float rs = rsqrtf(s2 * (1.f / 64.f) + 64e-5f);
      const float* gn0 = p->rwkv_gn + (j * 2 + 0) * 512 + c0;
      const float* gn1 = p->rwkv_gn + (j * 2 + 1) * 512 + c0;
#pragma unroll
      for (int e = 0; e < 8; ++e) o[e] = ((y[e] - mu) * rs * gn0[e] + gn1[e] + bs * v[e]) * g[e];
      u32x4 ov;
      ov.x = pk_bf16(o[0], o[1]); ov.y = pk_bf16(o[2], o[3]); ov.z = pk_bf16(o[4], o[5]); ov.w = pk_bf16(o[6], o[7]);
      *(u32x4*)(mo) = ov;
    }
    {
      float hf[8], hb[8], og[8], hsum[8], o[8];
      unpack(*(const u32x4*)(pt + 1024), hf); unpack(*(const u32x4*)(pt + 1536), hb);
      unpack(*(const u32x4*)(pt + 3584), og);
      float ss = 0.f;
#pragma unroll
      for (int e = 0; e < 8; ++e) { hsum[e] = hf[e] + hb[e]; ss += hsum[e] * hsum[e]; }
      ss += dppx<0xB1>(ss); ss += dppx<0x4E>(ss); ss += dppx<0x141>(ss); ss += dppx<0x140>(ss);
      const float rs = rsqrtf(ss * (1.f / 128.f) + 1e-6f);
      const float* ng = p->mlstm_norm + j * 512 + c0;
#pragma unroll
      for (int e = 0; e < 8; ++e) o[e] = hsum[e] * rs * ng[e] * sigm_f(og[e]);
      u32x4 ov;
      ov.x = pk_bf16(o[0], o[1]); ov.y = pk_bf16(o[2], o[3]); ov.z = pk_bf16(o[4], o[5]); ov.w = pk_bf16(o[6], o[7]);
      *(u32x4*)(mo + 512) = ov;
    }
  }
}

using f32x4v = __attribute__((ext_vector_type(4))) float;
__device__ void ph_ln_router(KP p, int layer, bool keep, char* smc) {
  float* h2s = (float*)smc;
  float* lgs = (float*)smc;
  const int tid = opaque_tid();
  const int lane = tid & 63, wave = tid >> 6;
  const int rows = keep ? NT : NL;
  const float* lng = p->ln_g + (layer * 2 + 0) * 1024;
  const float* lnb = p->ln_b + (layer * 2 + 0) * 1024;
  const float* Wr = p->moe_router + (size_t)layer * 1024 * 64;
  for (int tile = blockIdx.x; tile < rows / 16; tile += gridDim.x) {
    const int t0 = tile * 16;
    const float* mod = p->MOD + (layer * 9 + modrow(t0)) * 6144;
#pragma unroll 1
    for (int q = 0; q < 4; ++q) {
      const int tl = wave * 4 + q, t = t0 + tl;
      float4 v[4];
      float s = 0.f;
#pragma unroll
      for (int i = 0; i < 4; ++i) {
        v[i] = *(const float4*)(p->Tb + (size_t)t * DM + i * 256 + lane * 4);
        s += (v[i].x + v[i].y) + (v[i].z + v[i].w);
      }
      const float mean = wsum(s) * (1.f / 1024.f);
      float qq = 0.f;
#pragma unroll
      for (int i = 0; i < 4; ++i) {
        const float d0 = v[i].x - mean, d1 = v[i].y - mean, d2 = v[i].z - mean, d3 = v[i].w - mean;
        qq += (d0 * d0 + d1 * d1) + (d2 * d2 + d3 * d3);
      }
      const float rs = rsqrtf(wsum(qq) * (1.f / 1024.f) + 1e-5f);
#pragma unroll
      for (int i = 0; i < 4; ++i) {
        const int n = i * 256 + lane * 4;
        const float4 g = *(const float4*)(lng + n), bb = *(const float4*)(lnb + n);
        const float4 sc = *(const float4*)(mod + 4096 + n), sh = *(const float4*)(mod + 3072 + n);
        const float4 xn = make_float4((v[i].x - mean) * rs * g.x + bb.x, (v[i].y - mean) * rs * g.y + bb.y,
                                      (v[i].z - mean) * rs * g.z + bb.z, (v[i].w - mean) * rs * g.w + bb.w);
        *(float4*)(p->X + (size_t)t * DM + n) = xn;
        const float4 hh = make_float4(xn.x * (1.f + sc.x) + sh.x, xn.y * (1.f + sc.y) + sh.y,
                                      xn.z * (1.f + sc.z) + sh.z, xn.w * (1.f + sc.w) + sh.w);
        *(unsigned*)((unsigned char*)p->AB + (size_t)t * DM + n) = pk_fp8x4(hh.x, hh.y, hh.z, hh.w);
        *(float4*)(h2s + tl * 1028 + n) = hh;
      }
    }
    __syncthreads();
    f32x4v acc = {0.f, 0.f, 0.f, 0.f};
    {
      f32x4v a1 = {0.f, 0.f, 0.f, 0.f}, a2 = {0.f, 0.f, 0.f, 0.f}, a3 = {0.f, 0.f, 0.f, 0.f};
      const int i = lane & 15, kk = lane >> 4;
      const float* arow = h2s + i * 1028 + 4 * kk;
      const float* bcol = Wr + (4 * kk) * 64 + 16 * wave + i;
#pragma unroll 4
      for (int q = 0; q < 64; ++q) {
        const float4 a = *(const float4*)(arow + 16 * q);
        const float b0 = bcol[(16 * q + 0) * 64], b1 = bcol[(16 * q + 1) * 64];
        const float b2 = bcol[(16 * q + 2) * 64], b3 = bcol[(16 * q + 3) * 64];
        acc = __builtin_amdgcn_mfma_f32_16x16x4f32(a.x, b0, acc, 0, 0, 0);
        a1 = __builtin_amdgcn_mfma_f32_16x16x4f32(a.y, b1, a1, 0, 0, 0);
        a2 = __builtin_amdgcn_mfma_f32_16x16x4f32(a.z, b2, a2, 0, 0, 0);
        a3 = __builtin_amdgcn_mfma_f32_16x16x4f32(a.w, b3, a3, 0, 0, 0);
      }
      acc = (acc + a1) + (a2 + a3);
    }
    __syncthreads();
#pragma unroll
    for (int r = 0; r < 4; ++r) lgs[((lane >> 4) * 4 + r) * 64 + 16 * wave + (lane & 15)] = acc[r];
    __syncthreads();
#pragma unroll 1
    for (int q = 0; q < 4; ++q) {
      const int tl = wave * 4 + q, t = t0 + tl;
      const float logit = lgs[tl * 64 + lane];
      const float score = sigm_f(logit);
      float sel = score + p->moe_bias[layer * 64 + lane];
      bool chosen = false;
      for (int r = 0; r < 6; ++r) {
        const float mx = wmax(sel);
        const unsigned long long bal = __ballot(sel == mx);
        const int first = __ffsll((long long)bal) - 1;
        if (lane == first) { chosen = true; sel = -INFINITY; }
      }
      const float gsum = wsum(chosen ? score : 0.f);
      const unsigned long long cb = __ballot(chosen);
      if (chosen) {
        const int kidx = __popcll(cb & ((1ull << lane) - 1ull));
        const int pos = atomicAdd(&p->cnt[lane], 1);
        p->ltok[(size_t)lane * NT + pos] = t;
        p->lgate[(size_t)lane * NT + pos] = score / gsum * 2.5f;
        p->tsl[t * 6 + kidx] = (lane << 16) | pos;
      }
    }
    __syncthreads();
  }
}

__device__ __forceinline__ void moe_prefix(KP p, int rows, int* s_pref, int tid) {
  if (tid == 0) {
    int a = 0;
    for (int e = 0; e < 64; ++e) { s_pref[e] = a; a += (p->cnt[e] + 127) >> 7; }
    s_pref[64] = a; a += rows >> 7;
    s_pref[65] = a;
  }
  __syncthreads();
}

__device__ void ph_gemm(KP p, int kind, int layer, bool keep, char* lds) {
  const int tid = opaque_tid();
  const int j = layer >> 1;
  const bool att = !(layer & 1);
  const int rows = keep ? NT : NL;
  int* pref = (int*)(lds + META_OFF);
  int* s_idx = pref + 66;
  float* s_gate = (float*)(s_idx + 128);
  if (kind == 1 && blockIdx.x == 0 && tid < 65) p->cnt[tid] = 0;
  if (kind == 2 || kind == 3) moe_prefix(p, rows, pref, tid);
  int total;
  const int ntn_in = att ? 18 : 33;
  switch (kind) {
    case 0: total = (NT / 128) * ntn_in; break;
    case 1: total = (rows / 128) * 8; break;
    case 2: total = pref[65] * 4; break;
    case 3: total = pref[65] * 8; break;
    case 4: total = (NT / 128) * 3; break;
    default: total = (NT / 128) * 20; break;
  }
  for (int tile = blockIdx.x; tile < total; tile += gridDim.x) {
    const bf16_t* Abase; const bf16_t* Bt;
    int astride, K, n0, m0 = 0, aux = 0, e = 0, mtile = 0;
    switch (kind) {
      case 0: { const int tm = tile / ntn_in, tn = tile % ntn_in; m0 = tm * 128; n0 = tn * 128;
                Abase = p->AB + (size_t)m0 * DM; astride = DM; K = 1024;
                Bt = att ? p->Wt_att + (size_t)j * ATT_N * 1024 : p->Wt_rec + (size_t)j * REC_NP * 1024; } break;
      case 1: { const int tm = tile >> 3, tn = tile & 7; m0 = tm * 128; n0 = tn * 128;
                Abase = p->AB + (size_t)m0 * DM; astride = DM; K = 1024; Bt = p->Wt_out + (size_t)layer * 1024 * 1024; } break;
      case 2: { mtile = tile >> 2; aux = tile & 3; n0 = aux * 128; while (mtile >= pref[e + 1]) ++e;
                Abase = p->AB; astride = DM; K = 1024;
                Bt = (const bf16_t*)((const unsigned char*)p->Wt13 + (size_t)(layer * 65 + e) * 512 * 1024); } break;
      case 3: { mtile = tile >> 3; aux = tile & 7; n0 = aux * 128; while (mtile >= pref[e + 1]) ++e;
                Abase = (const bf16_t*)((const unsigned char*)p->ACT + (size_t)mtile * 128 * 256); astride = 256; K = 256;
                Bt = (const bf16_t*)((const unsigned char*)p->Wt2 + (size_t)(layer * 65 + e) * 1024 * 256); } break;
      case 4: { const int tm = tile / 3; aux = tile % 3; m0 = tm * 128; n0 = 0;
                Abase = p->Zb + (size_t)m0 * 1536 + aux * 512; astride = 1536; K = 512; Bt = p->Wl1 + (size_t)(j * 3 + aux) * 128 * 512; } break;
      default: { const int tm = tile / 20; aux = tile % 20; m0 = tm * 128; n0 = aux * 128;
                const int grp = aux < 8 ? 0 : (aux < 16 ? 1 : 2);
                Abase = p->L1 + (size_t)m0 * 384 + grp * 128; astride = 384; K = 128; Bt = p->Wl2 + (size_t)j * 2560 * 128; } break;
    }
    if (tid < 128) {
      int idx = tid; float g = 1.f;
      if (kind == 2 || kind == 3) {
        const int pos = (mtile - pref[e]) * 128 + tid;
        if (kind == 2) {
          idx = 0;
          if (e < 64) { if (pos < p->cnt[e]) idx = p->ltok[(size_t)e * NT + pos]; }
          else idx = pos;
        } else if (e < 64) g = pos < p->cnt[e] ? p->lgate[(size_t)e * NT + pos] : 0.f;
      }
      s_idx[tid] = idx; s_gate[tid] = g;
    }
    __syncthreads();
    {
      f32x16 acc[2][2];
      if (kind == 2 || kind == 3) {
        const unsigned char* A8 = (const unsigned char*)Abase;
        gemm128_fp8(tid, [&](int r) { return A8 + (size_t)s_idx[r] * astride; }, (const unsigned char*)Bt, K, n0, lds, acc);
      } else
        gemm128_main(tid, [&](int r) { return Abase + (size_t)s_idx[r] * astride; }, Bt, K, n0, lds, acc);
      float* Ct = (float*)lds;
      acc_foreach(tid, acc, [&](int row, int col, float v) { Ct[row * 128 + col] = v; });
    }
    __syncthreads();
    {
      const float* Ct = (const float*)lds;
      const int c4 = (tid & 31) * 4, r0 = tid >> 5;
      const int N_in = att ? ATT_N : REC_N;
      const int d5 = (aux >> 2) & 1, c05 = (aux & 3) * 128;
      switch (kind) {
        case 0: {
#pragma unroll 8
          for (int it = 0; it < 16; ++it) {
            const int row = it * 8 + r0;
            const float4 v = *(const float4*)(Ct + row * 128 + c4);

            const int cn = n0 + c4;
            float4 vq = v;
            if (att && n0 >= 1536 && n0 < 2176) {
              float ss = v.x * v.x + v.y * v.y + v.z * v.z + v.w * v.w;
              ss += dppx<0xB1>(ss); ss += dppx<0x4E>(ss); ss += dppx<0x141>(ss); ss += dppx<0x140>(ss);
              const float rs = rsqrtf(ss * (1.f / 64.f) + 1e-6f);
              const float4 g = *(const float4*)(p->qk_gain + j * 128 + (n0 >= 2048 ? 64 : 0) + (cn & 63));
              vq = make_float4(v.x * rs * g.x, v.y * rs * g.y, v.z * rs * g.z, v.w * rs * g.w);
              const int t = m0 + row;
              if (t < NL) {
                const int sidx = t & 2047, pi0 = (cn & 63) >> 1;
                const int pos = pi0 < 16 ? (sidx >> 6) : (sidx & 63);
                const float4 cs = *(const float4*)(p->ROPE + (pos * 16 + (pi0 & 15)) * 2);
                vq = make_float4(vq.x * cs.x - vq.y * cs.y, vq.x * cs.y + vq.y * cs.x,
                                 vq.z * cs.z - vq.w * cs.w, vq.z * cs.w + vq.w * cs.z);
              }
            }
            if (cn < N_in) {
              u32x2 o; o.x = pk_bf16(vq.x, vq.y); o.y = pk_bf16(vq.z, vq.w);
              *(u32x2*)(p->P + (size_t)(m0 + row) * LDP + cn) = o;
            }
            if (!att && cn >= 4096 && cn < 4112) *(float4*)(p->GP + (size_t)(m0 + row) * 16 + (cn - 4096)) = v;
          }
        } break;
        case 1: {
#pragma unroll 16
          for (int it = 0; it < 16; ++it) {
            const int row = it * 8 + r0;
            const float4 v = *(const float4*)(Ct + row * 128 + c4);

            const size_t o = (size_t)(m0 + row) * DM + n0 + c4;
            const float4 xv = *(const float4*)(p->X + o);
            const float4 g = *(const float4*)(p->MOD + (layer * 9 + modrow(m0)) * 6144 + 2048 + n0 + c4);
            *(float4*)(p->Tb + o) = make_float4(DN_ALPHA * xv.x + g.x * v.x, DN_ALPHA * xv.y + g.y * v.y,
                                                DN_ALPHA * xv.z + g.z * v.z, DN_ALPHA * xv.w + g.w * v.w);
          }
        } break;
        case 2: {
#pragma unroll 8
          for (int it = 0; it < 16; ++it) {
            const int row = it * 8 + r0;
            const float4 v = *(const float4*)(Ct + row * 128 + c4);

            if (((c4 >> 5) & 1) == 0) {
              const float4 u = *(const float4*)(Ct + row * 128 + c4 + 32);
              const float a0 = v.x * W8_INV, a1 = v.y * W8_INV, a2 = v.z * W8_INV, a3 = v.w * W8_INV;
              *(unsigned*)((unsigned char*)p->ACT + ((size_t)mtile * 128 + row) * 256 + aux * 64 + (c4 >> 6) * 32 + (c4 & 31)) =
                  pk_fp8x4(silu_f(a0) * (u.x * W8_INV), silu_f(a1) * (u.y * W8_INV), silu_f(a2) * (u.z * W8_INV), silu_f(a3) * (u.w * W8_INV));
            }
          }
        } break;
        case 3: {
#pragma unroll 16
          for (int it = 0; it < 16; ++it) {
            const int row = it * 8 + r0;
            const float4 v = *(const float4*)(Ct + row * 128 + c4);

            const float g = s_gate[row] * W8_INV;
            u32x2 o; o.x = pk_bf16(g * v.x, g * v.y); o.y = pk_bf16(g * v.z, g * v.w);
            *(u32x2*)(p->OUT2 + ((size_t)mtile * 128 + row) * 1024 + n0 + c4) = o;
          }
        } break;
        case 4: {
#pragma unroll 4
          for (int it = 0; it < 16; ++it) {
            const int row = it * 8 + r0;
            const float4 v = *(const float4*)(Ct + row * 128 + c4);

            float4 o4 = v;
            if (aux == 0) o4 = make_float4(tanhf(v.x), tanhf(v.y), tanhf(v.z), tanhf(v.w));
            else if (aux == 2) o4 = make_float4(sigm_f(v.x), sigm_f(v.y), sigm_f(v.z), sigm_f(v.w));
            u32x2 o; o.x = pk_bf16(o4.x, o4.y); o.y = pk_bf16(o4.z, o4.w);
            *(u32x2*)(p->L1 + (size_t)(m0 + row) * 384 + aux * 128 + c4) = o;
          }
        } break;
        default: {
#pragma unroll 4
          for (int it = 0; it < 16; ++it) {
            const int row = it * 8 + r0;
            const float4 v = *(const float4*)(Ct + row * 128 + c4);

            bf16_t* rr = p->RW + (size_t)(m0 + row) * RWS + c05 + c4;
            const float vv[4] = {v.x, v.y, v.z, v.w};
            if (aux < 8) {
              const float4 b0 = *(const float4*)(p->rwkv_w0 + (j * 2 + d5) * 512 + c05 + c4);
              const float bb[4] = {b0.x, b0.y, b0.z, b0.w};
              float e4[4];
#pragma unroll
              for (int q = 0; q < 4; ++q) e4[q] = expf(-softplus_f(-(bb[q] + vv[q])) - 0.5f);
              u32x2 o; o.x = pk_bf16(e4[0], e4[1]); o.y = pk_bf16(e4[2], e4[3]);
              *(u32x2*)(rr + (3 + d5) * 512) = o;
            } else if (aux < 16) {
              const float4 b0 = *(const float4*)(p->rwkv_a0 + (j * 2 + d5) * 512 + c05 + c4);
              const float4 k1 = *(const float4*)(p->rwkv_kvec + (j * 2 + 1) * 512 + c05 + c4);
              const u32x2 kx2 = *(const u32x2*)(rr + 10 * 512);
              const float bb[4] = {b0.x, b0.y, b0.z, b0.w}, kk1[4] = {k1.x, k1.y, k1.z, k1.w};
              const float kx[4] = {bflo(kx2.x), bfhi(kx2.x), bflo(kx2.y), bfhi(kx2.y)};
              float av[4], ke[4];
#pragma unroll
              for (int q = 0; q < 4; ++q) { av[q] = sigm_f(bb[q] + vv[q]); ke[q] = kx[q] * (1.f + (av[q] - 1.f) * kk1[q]); }
              u32x2 o; o.x = pk_bf16(av[0], av[1]); o.y = pk_bf16(av[2], av[3]);
              *(u32x2*)(rr + (7 + d5) * 512) = o;
              o.x = pk_bf16(ke[0], ke[1]); o.y = pk_bf16(ke[2], ke[3]);
              *(u32x2*)(rr + (5 + d5) * 512) = o;
            } else {
              u32x2 o; o.x = pk_bf16(v.x, v.y); o.y = pk_bf16(v.z, v.w);
              *(u32x2*)(rr + 9 * 512) = o;
            }
          }
        } break;
      }
    }
    __syncthreads();
  }
}

__device__ void ph_final_ln(KP p, int layer, bool keep, char* lds) {
  const int tid = opaque_tid();
  const int lane = tid & 63, wave = tid >> 6;
  const int rows = keep ? NT : NL;
  int* s_base = (int*)(lds + META_OFF);
  if (tid == 0) {
    int a = 0;
    for (int e = 0; e < 64; ++e) { s_base[e] = a * 128; a += (p->cnt[e] + 127) >> 7; }
    s_base[64] = a * 128;
  }
  __syncthreads();
  const float* lng = p->ln_g + (layer * 2 + 1) * 1024;
  const float* lnb = p->ln_b + (layer * 2 + 1) * 1024;
  for (int t = blockIdx.x * 4 + wave; t < rows; t += gridDim.x * 4) {
    const int mr = modrow(t);
    const float* g2 = p->MOD + (layer * 9 + mr) * 6144 + 5120;
    const bf16_t* src[7];
#pragma unroll
    for (int k = 0; k < 6; ++k) {
      const int v = p->tsl[t * 6 + k];
      src[k] = p->OUT2 + (size_t)(s_base[v >> 16] + (v & 0xffff)) * 1024;
    }
    src[6] = p->OUT2 + (size_t)(s_base[64] + t) * 1024;
    float v[16];
    float s = 0.f;
#pragma unroll
    for (int c = 0; c < 2; ++c) {
      const int n0 = c * 512 + lane * 8;
      float y[8];
#pragma unroll
      for (int q = 0; q < 8; ++q) y[q] = 0.f;
#pragma unroll
      for (int k = 0; k < 7; ++k) {
        const u32x4 u = *(const u32x4*)(src[k] + n0);
        y[0] += bflo(u.x); y[1] += bfhi(u.x); y[2] += bflo(u.y); y[3] += bfhi(u.y);
        y[4] += bflo(u.z); y[5] += bfhi(u.z); y[6] += bflo(u.w); y[7] += bfhi(u.w);
      }
      const float4 xa = *(const float4*)(p->X + (size_t)t * DM + n0), xb = *(const float4*)(p->X + (size_t)t * DM + n0 + 4);
      const float4 ga = *(const float4*)(g2 + n0), gb = *(const float4*)(g2 + n0 + 4);
      const float xx[8] = {xa.x, xa.y, xa.z, xa.w, xb.x, xb.y, xb.z, xb.w};
      const float gg[8] = {ga.x, ga.y, ga.z, ga.w, gb.x, gb.y, gb.z, gb.w};
#pragma unroll
      for (int q = 0; q < 8; ++q) { v[c * 8 + q] = DN_ALPHA * xx[q] + gg[q] * y[q]; s += v[c * 8 + q]; }
    }
    const float mean = wsum(s) * (1.f / 1024.f);
    float q2 = 0.f;
#pragma unroll
    for (int i = 0; i < 16; ++i) { const float d = v[i] - mean; q2 += d * d; }
    const float rs = rsqrtf(wsum(q2) * (1.f / 1024.f) + 1e-5f);
    const float* modn = p->MOD + ((layer + 1) * 9 + mr) * 6144;
#pragma unroll
    for (int c = 0; c < 2; ++c) {
      const int n0 = c * 512 + lane * 8;
      float xn[8];
#pragma unroll
      for (int q = 0; q < 8; ++q) xn[q] = (v[c * 8 + q] - mean) * rs * lng[n0 + q] + lnb[n0 + q];
      *(float4*)(p->X + (size_t)t * DM + n0) = make_float4(xn[0], xn[1], xn[2], xn[3]);
      *(float4*)(p->X + (size_t)t * DM + n0 + 4) = make_float4(xn[4], xn[5], xn[6], xn[7]);
      if (layer == 3) {
        *(float4*)(p->out + (size_t)t * DM + n0) = make_float4(xn[0], xn[1], xn[2], xn[3]);
        *(float4*)(p->out + (size_t)t * DM + n0 + 4) = make_float4(xn[4], xn[5], xn[6], xn[7]);
      } else {
        float hb[8];
#pragma unroll
        for (int q = 0; q < 8; ++q) hb[q] = xn[q] * (1.f + modn[1024 + n0 + q]) + modn[n0 + q];
        u32x4 o;
        o.x = pk_bf16(hb[0], hb[1]); o.y = pk_bf16(hb[2], hb[3]); o.z = pk_bf16(hb[4], hb[5]); o.w = pk_bf16(hb[6], hb[7]);
        *(u32x4*)(p->AB + (size_t)t * DM + n0) = o;
      }
    }
  }
}

#define XB_TMO      128
#define XB_XCNT(j)  (256  + 64 * (j))
#define XB_XSUB(j)  (1280 + 64 * (j))
#define XB_XGEN(j)  (2304 + 64 * (j))
#define XB_TOP      3328
#define XB_TOPGEN   3392
#define XB_SPIN_CAP (1u << 20)
#define LAS __attribute__((address_space(3)))
__device__ __forceinline__ unsigned xb_ld(unsigned* p) { return __hip_atomic_load(p, __ATOMIC_RELAXED, __HIP_MEMORY_SCOPE_AGENT); }
__device__ __forceinline__ unsigned xb_add(unsigned* p, unsigned v) { return __hip_atomic_fetch_add(p, v, __ATOMIC_RELAXED, __HIP_MEMORY_SCOPE_AGENT); }
__device__ __forceinline__ unsigned xb_xcc_id() { return (unsigned)__builtin_amdgcn_s_getreg((3 << 11) | 20) & 0xFu; }
#define XB_SPIN(cond, bar) do { unsigned _sp = 0; while (cond) { __builtin_amdgcn_s_sleep(1); \
    if ((++_sp & 255u) == 0u) { if (xb_ld(&(bar)[XB_TMO])) break; if (_sp > XB_SPIN_CAP) { atomicAdd(&(bar)[XB_TMO], 1u); break; } } } } while (0)
struct XcdBarrier { unsigned* bar; unsigned x; volatile LAS unsigned* st; };
__device__ __forceinline__ XcdBarrier xcd_barrier_post(unsigned* bar, volatile LAS unsigned* st) {
  XcdBarrier b; b.bar = bar; b.x = xb_xcc_id(); b.st = st;
  if (threadIdx.x == 0) (void)xb_add(&bar[XB_XCNT(b.x)], 1u);
  return b;
}
__device__ __forceinline__ void xcd_barrier_complete(unsigned* bar, unsigned x, unsigned& nloc, unsigned& nx) {
  const unsigned G = gridDim.x;
  unsigned sum, cnt, mine, sp = 0u;
  for (;;) {
    sum = 0u; cnt = 0u; mine = 0u;
#pragma unroll
    for (unsigned j = 0; j < 16; ++j) { const unsigned c = xb_ld(&bar[XB_XCNT(j)]); sum += c; cnt += (c > 0u) ? 1u : 0u; mine = (j == x) ? c : mine; }
    if (sum == G) break;
    __builtin_amdgcn_s_sleep(1);
    if ((++sp & 255u) == 0u) { if (xb_ld(&bar[XB_TMO])) break; if (sp > XB_SPIN_CAP) { atomicAdd(&bar[XB_TMO], 1u); break; } }
  }
  nloc = mine > 0u ? mine : 1u; nx = cnt > 0u ? cnt : 1u;
}
__device__ __forceinline__ void xcd_barrier(const XcdBarrier& b) {
  asm volatile("s_waitcnt vmcnt(0)" ::: "memory");
  __syncthreads();
  if (threadIdx.x == 0) {
    unsigned* bar = b.bar;
    __builtin_amdgcn_s_waitcnt(0);
    unsigned nloc = b.st[0], nx = b.st[1];
    if (nloc == 0u) { xcd_barrier_complete(bar, b.x, nloc, nx); b.st[0] = nloc; b.st[1] = nx; }
    const unsigned old = xb_add(&bar[XB_XSUB(b.x)], 1u);
    const unsigned gen = old / nloc;
    if (old + 1u == (gen + 1u) * nloc) {
      __builtin_amdgcn_fence(__ATOMIC_RELEASE, "agent");
      asm volatile("s_waitcnt vmcnt(0)" ::: "memory");
      const unsigned og = xb_add(&bar[XB_TOP], 1u);
      const unsigned tg = og / nx;
      if (og + 1u == (tg + 1u) * nx) xb_add(&bar[XB_TOPGEN], 1u);
      else XB_SPIN(xb_ld(&bar[XB_TOPGEN]) == tg, bar);
      __builtin_amdgcn_fence(__ATOMIC_ACQUIRE, "agent");
      xb_add(&bar[XB_XGEN(b.x)], 1u);
      asm volatile("s_waitcnt vmcnt(0)" ::: "memory");
    } else {
      XB_SPIN(xb_ld(&bar[XB_XGEN(b.x)]) == gen, bar);
      __builtin_amdgcn_fence(__ATOMIC_ACQUIRE, "agent");
      asm volatile("s_waitcnt vmcnt(0)" ::: "memory");
    }
  }
  __syncthreads();
}

constexpr int NSLOTS = 13;
constexpr int NPHASE = 2 + 4 * NSLOTS;
__device__ __forceinline__ bool phase_is_nop(int ph) {
  if (ph < 2) return false;
  const int layer = (ph - 2) / NSLOTS, st = (ph - 2) % NSLOTS;
  return !(layer & 1) && (st == 1 || (st >= 3 && st <= 7));
}
__device__ void run_phase(KP p, int ph, char* sm) {
  if (ph == 0) { ph_init(p, sm); return; }
  if (ph == 1) { ph_mod_h(p, sm); return; }
  const int layer = (ph - 2) / NSLOTS, st = (ph - 2) % NSLOTS;
  const bool odd = layer & 1;
  const bool keep = layer < 3;
  int gk = -1;
  if (st == 0) gk = 0;
  else if (st == 8) gk = 1;
  else if (st == 10) gk = 2;
  else if (st == 11) gk = 3;
  else if (odd && st == 2) gk = 4;
  else if (odd && st == 3) gk = 5;
  asm volatile("" : "+s"(gk));
  if (gk >= 0) { ph_gemm(p, gk, layer, keep, sm); return; }
  switch (st) {
    case 1: if (odd) ph_rwkv_mix(p, layer); break;
    case 2: ph_attention(p, layer, keep, sm); break;
    case 4: if (odd) ph_scan_a(p, layer, sm); break;
    case 5: if (odd) ph_mlstm_s2(p, sm); break;
    case 6: if (odd) ph_mlstm_s3(p, layer, sm); break;
    case 7: if (odd) ph_rec_final(p, layer, keep); break;
    case 9: ph_ln_router(p, layer, keep, sm); break;
    case 12: ph_final_ln(p, layer, keep, sm); break;
  }
}

__global__ void __launch_bounds__(NTHR, 2) mega_kernel(Params kargs) {
  extern __shared__ __attribute__((aligned(16))) char sm[];
  cg::grid_group grid = cg::this_grid();
  volatile LAS unsigned* st = (volatile LAS unsigned*)(sm + META_OFF + 4032);
  if (threadIdx.x == 0) { st[0] = 0u; st[1] = 0u; }
  __syncthreads();
  const XcdBarrier xb = xcd_barrier_post(kargs.bar, st);
  for (int ph = kargs.ph_lo; ph < kargs.ph_hi; ++ph) {
    if (phase_is_nop(ph)) continue;
    {
      KP kp = (KP)__builtin_amdgcn_kernarg_segment_ptr();
      asm volatile("" : "+s"(kp));
      run_phase(kp, ph, sm);
    }
    if (ph + 1 < kargs.ph_hi) {
      if (ph == 0) grid.sync();
      else xcd_barrier(xb);
    }
  }
}

extern "C" void kernel_launch(void* const* d_in, const int* in_sizes, int n_in, void* d_out, int out_size, void* d_ws,
                              size_t ws_size, hipStream_t stream) {
  static int grid_blocks = 0;
  if (!grid_blocks) {
    int dev = 0, cus = 0, per_cu = 0;
    (void)hipGetDevice(&dev);
    (void)hipDeviceGetAttribute(&cus, hipDeviceAttributeMultiprocessorCount, dev);
    (void)hipFuncSetAttribute((const void*)mega_kernel, hipFuncAttributeMaxDynamicSharedMemorySize, SMEM_BYTES);
    (void)hipOccupancyMaxActiveBlocksPerMultiprocessor(&per_cu, mega_kernel, NTHR, SMEM_BYTES);
    if (per_cu < 1) per_cu = 1;
    if (per_cu > 2) per_cu = 2;
    grid_blocks = cus * per_cu;
  }
  Params p;
  memset(&p, 0, sizeof(p));
  const float** pin = (const float**)&p;
  for (int i = 0; i < 35; ++i) pin[i] = (const float*)d_in[i];
  p.out = (float*)d_out;
  char* w = (char*)d_ws;
  size_t off = 0;
  auto take = [&](size_t bytes) { char* r = w + off; off += (bytes + 255) & ~(size_t)255; return r; };
  p.Wt_att = (bf16_t*)take((size_t)2 * ATT_N * 1024 * 2);
  p.Wt_rec = (bf16_t*)take((size_t)2 * REC_NP * 1024 * 2);
  p.Wt_out = (bf16_t*)take((size_t)4 * 1024 * 1024 * 2);
  p.Wt13 = (bf16_t*)take((size_t)4 * 65 * 512 * 1024 * 2);
  p.Wt2 = (bf16_t*)take((size_t)4 * 65 * 1024 * 256 * 2);
  p.Wl1 = (bf16_t*)take((size_t)2 * 3 * 128 * 512 * 2);
  p.Wl2 = (bf16_t*)take((size_t)2 * 2560 * 128 * 2);
  p.X = (float*)take((size_t)NT * DM * 4);
  p.AB = (bf16_t*)take((size_t)NT * DM * 2);
  p.MOD = (float*)take((size_t)5 * 9 * 6144 * 4);
  p.MODP = (float*)take((size_t)8 * 4 * 9 * 6144 * 4);
  p.GP = (float*)take((size_t)NT * 16 * 4);
  p.ROPE = (float*)take((size_t)64 * 16 * 2 * 4);
  p.msc = (float*)take((size_t)3 * NMT * 4);
  p.lgate = (float*)take((size_t)64 * NT * 4);
  p.ltok = (int*)take((size_t)64 * NT * 4);
  p.tsl = (int*)take((size_t)NT * 6 * 4);
  p.cnt = (int*)take(512);
  p.bar = (unsigned*)take((size_t)BAR_TOTAL_WORDS * 4);
  char* region = take(0);
  const size_t szP = (size_t)NT * LDP * 2, szRW = (size_t)NT * RWS * 2, szMS = (size_t)NMT * 16384 * 2,
               szMSn = (size_t)NMT * 128 * 4;
  const size_t szT = (size_t)NT * DM * 4, szOUT2 = (size_t)NSLOT * 1024 * 2;
  p.P = (bf16_t*)region;
  p.RW = (bf16_t*)(region + szP);
  p.MS = (bf16_t*)(region + szP + szRW);
  p.MSn = (float*)(region + szP + szRW + szMS);
  p.Zb = p.MS;
  p.L1 = p.MS + (size_t)NT * 1536;
  p.Tb = (float*)region;
  p.ACT = (bf16_t*)region;
  p.OUT2 = (bf16_t*)(region + szT);
  size_t mixer = szP + szRW + szMS + szMSn, moe = szT + szOUT2;
  off += (mixer > moe ? mixer : moe);
  if (off > ws_size) { fprintf(stderr, "workspace too small: need %zu have %zu\n", off, ws_size); return; }
  p.ph_lo = 0;
  p.ph_hi = NPHASE;
  (void)hipMemsetAsync(p.bar, 0, (size_t)BAR_TOTAL_WORDS * 4, stream);
  void* args[] = {&p};
  hipError_t e = hipLaunchCooperativeKernel((void*)mega_kernel, dim3(grid_blocks), dim3(NTHR), args, SMEM_BYTES, stream);
  if (e != hipSuccess) fprintf(stderr, "cooperative launch failed: %s (grid %d)\n", hipGetErrorString(e), grid_blocks);
}
```

```cpp
#include <hip/hip_runtime.h>
#include <hip/hip_cooperative_groups.h>
#include <cstdio>
#include <cstring>
namespace cg = cooperative_groups;

constexpr int DM = 1024;
constexpr int NBATCH = 8;
constexpr int SEQ = 2048;
constexpr int CTXL = 256;
constexpr int NL = NBATCH * SEQ;
constexpr int NC = NBATCH * CTXL;
constexpr int NT = NL + NC;
constexpr int TSC = CTXL + SEQ;
constexpr int LDP = 4112;
constexpr int ATT_N = 2304;
constexpr int REC_N = 4112;
constexpr int REC_NP = 4224;
constexpr int NCHUNK = 36;
constexpr int NMT = 64 * NCHUNK;
constexpr int RWS = 5632;
constexpr int NSLOT = 137216;
constexpr float DN_ALPHA = 1.6817928305074290f;
constexpr int NTHR = 256;
constexpr int SMEM_BYTES = 65536 + 4096;
constexpr int META_OFF = 65536;
#define XCD_BAR_WORDS 3456
constexpr int BAR_TOTAL_WORDS = XCD_BAR_WORDS + 64;

typedef unsigned short bf16_t;
using bf16x8 = __attribute__((ext_vector_type(8))) short;
using f32x16 = __attribute__((ext_vector_type(16))) float;
using u32x4 = __attribute__((ext_vector_type(4))) unsigned;
using u32x2 = __attribute__((ext_vector_type(2))) unsigned;

struct Params {
  const float *x, *c, *ctx, *c_ctx, *ada_w, *ada_b, *ln_g, *ln_b, *mix_w_out, *att_w_in, *na_rpb, *qk_gain,
      *rec_w_in, *rwkv_mu, *rwkv_w0, *rwkv_w1, *rwkv_w2, *rwkv_a0, *rwkv_a1, *rwkv_a2, *rwkv_g1, *rwkv_g2,
      *rwkv_kvec, *rwkv_rk, *rwkv_gn, *mlstm_gate_b, *mlstm_norm, *moe_router, *moe_bias, *moe_w1, *moe_w3,
      *moe_w2, *shared_w1, *shared_w3, *shared_w2;
  float* out;
  bf16_t *Wt_att, *Wt_rec, *Wt_out, *Wt13, *Wt2, *Wl1, *Wl2;
  bf16_t *Zb, *L1;
  float *X, *MOD, *MODP, *GP, *msc, *lgate, *MSn, *Tb, *ROPE;
  bf16_t *AB, *P, *RW, *MS, *ACT, *OUT2;
  int *cnt, *ltok, *tsl;
  unsigned* bar;
  int ph_lo, ph_hi;
};

typedef const Params __attribute__((address_space(4))) * KP;

__device__ __forceinline__ int modrow(int t) { return t < NL ? (t >> 11) : 8; }
__device__ __forceinline__ float silu_f(float x) { return x / (1.f + expf(-x)); }
__device__ __forceinline__ float sigm_f(float x) { return 1.f / (1.f + expf(-x)); }
__device__ __forceinline__ float softplus_f(float x) { return fmaxf(x, 0.f) + log1pf(expf(-fabsf(x))); }
template <int CTRL>
__device__ __forceinline__ float dppx(float x) {
  return __int_as_float(__builtin_amdgcn_update_dpp(0, __float_as_int(x), CTRL, 0xf, 0xf, true));
}
__device__ __forceinline__ float rdlane(float v, int l) {
  return __int_as_float(__builtin_amdgcn_readlane(__float_as_int(v), l));
}
__device__ __forceinline__ float wsum(float v) {
  v += dppx<0xB1>(v); v += dppx<0x4E>(v); v += dppx<0x141>(v); v += dppx<0x140>(v);
  return (rdlane(v, 0) + rdlane(v, 16)) + (rdlane(v, 32) + rdlane(v, 48));
}
__device__ __forceinline__ float wmax(float v) {
  v = fmaxf(v, dppx<0xB1>(v)); v = fmaxf(v, dppx<0x4E>(v)); v = fmaxf(v, dppx<0x141>(v)); v = fmaxf(v, dppx<0x140>(v));
  return fmaxf(fmaxf(rdlane(v, 0), rdlane(v, 16)), fmaxf(rdlane(v, 32), rdlane(v, 48)));
}
__device__ __forceinline__ int opaque_tid() {
  int t = threadIdx.x;
  asm volatile("" : "+v"(t));
  return t;
}
typedef __bf16 bf16x2_t __attribute__((ext_vector_type(2)));
typedef float f32x2_t __attribute__((ext_vector_type(2)));
__device__ __forceinline__ unsigned pk_bf16(float lo, float hi) {
  const f32x2_t v = {lo, hi};
  return __builtin_bit_cast(unsigned, __builtin_convertvector(v, bf16x2_t));
}
__device__ __forceinline__ bf16_t f2bf(float x) { return (bf16_t)(pk_bf16(x, 0.f) & 0xffffu); }
__device__ __forceinline__ float bf2f(bf16_t v) { return __uint_as_float((unsigned)v << 16); }
__device__ __forceinline__ float bflo(unsigned u) { return __uint_as_float(u << 16); }
__device__ __forceinline__ float bfhi(unsigned u) { return __uint_as_float(u & 0xffff0000u); }
__device__ __forceinline__ int scan_row(int dir, int b, int tau) {
  if (tau < CTXL) return NL + b * CTXL + (dir ? (CTXL - 1 - tau) : tau);
  int s = tau - CTXL;
  return b * SEQ + (dir ? (SEQ - 1 - s) : s);
}

template <class RowPtrA>
__device__ __forceinline__ void gemm128_main(int tid, RowPtrA rowA, const bf16_t* __restrict__ Bt, int K, int n0,
                                             char* lds, f32x16 (&acc)[2][2]) {
  const int lane = tid & 63, w = tid >> 6;
  const int wm = w >> 1, wn = w & 1, r = lane & 31, h = lane >> 5;
  const int c = tid & 7, sr = tid >> 3;
  const int lc = (c ^ ((tid >> 4) & 7)) * 8;
  const bf16_t* ap[4];
#pragma unroll
  for (int i = 0; i < 4; ++i) ap[i] = rowA(sr + 32 * i) + lc;
  const bf16_t* bp0 = Bt + (size_t)(n0 + sr) * K + lc;
  const int bstr = 32 * K;
#pragma unroll
  for (int mi = 0; mi < 2; ++mi)
#pragma unroll
    for (int ni = 0; ni < 2; ++ni)
#pragma unroll
      for (int q = 0; q < 16; ++q) acc[mi][ni][q] = 0.f;
  const int nk = K >> 6;
  auto issue = [&](int kt) {
    char* As = lds + (kt & 1) * 32768 + tid * 16;
    const int k0 = kt * 64;
#pragma unroll
    for (int i = 0; i < 4; ++i) {
      __builtin_amdgcn_global_load_lds((const unsigned*)(ap[i] + k0), (__attribute__((address_space(3))) unsigned*)(As + i * 4096), 16, 0, 0);
      __builtin_amdgcn_global_load_lds((const unsigned*)(bp0 + i * bstr + k0), (__attribute__((address_space(3))) unsigned*)(As + 16384 + i * 4096), 16, 0, 0);
    }
  };
  issue(0);
  const int sw = (r >> 1) & 7;
#pragma unroll 1
  for (int kt = 0; kt < nk; ++kt) {
    asm volatile("s_waitcnt vmcnt(0)" ::: "memory");
    __syncthreads();
    if (kt + 1 < nk) issue(kt + 1);
    const char* As = lds + (kt & 1) * 32768;
    const char* Ar = As + (wm * 64 + r) * 128;
    const char* Br = As + 16384 + (wn * 64 + r) * 128;
#pragma unroll
    for (int ks = 0; ks < 4; ++ks) {
      const int off = ((ks * 2 + h) ^ sw) * 16;
      const bf16x8 a0 = *(const bf16x8*)(Ar + off);
      const bf16x8 a1 = *(const bf16x8*)(Ar + 32 * 128 + off);
      const bf16x8 b0 = *(const bf16x8*)(Br + off);
      const bf16x8 b1 = *(const bf16x8*)(Br + 32 * 128 + off);
      acc[0][0] = __builtin_amdgcn_mfma_f32_32x32x16_bf16(a0, b0, acc[0][0], 0, 0, 0);
      acc[0][1] = __builtin_amdgcn_mfma_f32_32x32x16_bf16(a0, b1, acc[0][1], 0, 0, 0);
      acc[1][0] = __builtin_amdgcn_mfma_f32_32x32x16_bf16(a1, b0, acc[1][0], 0, 0, 0);
      acc[1][1] = __builtin_amdgcn_mfma_f32_32x32x16_bf16(a1, b1, acc[1][1], 0, 0, 0);
    }
  }
  __syncthreads();
}
using i64 = long;
template <class RowPtrA8>
__device__ __forceinline__ void gemm128_fp8(int tid, RowPtrA8 rowA, const unsigned char* __restrict__ Bt, int K, int n0,
                                            char* lds, f32x16 (&acc)[2][2]) {
  const int lane = tid & 63, w = tid >> 6;
  const int wm = w >> 1, wn = w & 1, r = lane & 31, h = lane >> 5;
  const int c = tid & 7, sr = tid >> 3;
  const int lc = (c ^ ((tid >> 4) & 7)) * 16;
  const unsigned char* ap[4];
#pragma unroll
  for (int i = 0; i < 4; ++i) ap[i] = rowA(sr + 32 * i) + lc;
  const unsigned char* bp0 = Bt + (size_t)(n0 + sr) * K + lc;
  const int bstr = 32 * K;
#pragma unroll
  for (int mi = 0; mi < 2; ++mi)
#pragma unroll
    for (int ni = 0; ni < 2; ++ni)
#pragma unroll
      for (int q = 0; q < 16; ++q) acc[mi][ni][q] = 0.f;
  const int nk = K >> 7;
  auto issue = [&](int kt) {
    char* As = lds + (kt & 1) * 32768 + tid * 16;
    const int k0 = kt * 128;
#pragma unroll
    for (int i = 0; i < 4; ++i) {
      __builtin_amdgcn_global_load_lds((const unsigned*)(ap[i] + k0), (__attribute__((address_space(3))) unsigned*)(As + i * 4096), 16, 0, 0);
      __builtin_amdgcn_global_load_lds((const unsigned*)(bp0 + i * bstr + k0), (__attribute__((address_space(3))) unsigned*)(As + 16384 + i * 4096), 16, 0, 0);
    }
  };
  issue(0);
  const int sw = (r >> 1) & 7;
#pragma unroll 1
  for (int kt = 0; kt < nk; ++kt) {
    asm volatile("s_waitcnt vmcnt(0)" ::: "memory");
    __syncthreads();
    if (kt + 1 < nk) issue(kt + 1);
    const char* As = lds + (kt & 1) * 32768;
    const char* Ar = As + (wm * 64 + r) * 128;
    const char* Br = As + 16384 + (wn * 64 + r) * 128;
#pragma unroll
    for (int q = 0; q < 4; ++q) {
      const int off = ((q * 2 + h) ^ sw) * 16;
      const u32x4 a0 = *(const u32x4*)(Ar + off);
      const u32x4 a1 = *(const u32x4*)(Ar + 32 * 128 + off);
      const u32x4 b0 = *(const u32x4*)(Br + off);
      const u32x4 b1 = *(const u32x4*)(Br + 32 * 128 + off);
      const i64 a0l = (i64)(((unsigned long long)a0.y << 32) | a0.x), a0h = (i64)(((unsigned long long)a0.w << 32) | a0.z);
      const i64 a1l = (i64)(((unsigned long long)a1.y << 32) | a1.x), a1h = (i64)(((unsigned long long)a1.w << 32) | a1.z);
      const i64 b0l = (i64)(((unsigned long long)b0.y << 32) | b0.x), b0h = (i64)(((unsigned long long)b0.w << 32) | b0.z);
      const i64 b1l = (i64)(((unsigned long long)b1.y << 32) | b1.x), b1h = (i64)(((unsigned long long)b1.w << 32) | b1.z);
      acc[0][0] = __builtin_amdgcn_mfma_f32_32x32x16_fp8_fp8(a0l, b0l, acc[0][0], 0, 0, 0);
      acc[0][1] = __builtin_amdgcn_mfma_f32_32x32x16_fp8_fp8(a0l, b1l, acc[0][1], 0, 0, 0);
      acc[1][0] = __builtin_amdgcn_mfma_f32_32x32x16_fp8_fp8(a1l, b0l, acc[1][0], 0, 0, 0);
      acc[1][1] = __builtin_amdgcn_mfma_f32_32x32x16_fp8_fp8(a1l, b1l, acc[1][1], 0, 0, 0);
      acc[0][0] = __builtin_amdgcn_mfma_f32_32x32x16_fp8_fp8(a0h, b0h, acc[0][0], 0, 0, 0);
      acc[0][1] = __builtin_amdgcn_mfma_f32_32x32x16_fp8_fp8(a0h, b1h, acc[0][1], 0, 0, 0);
      acc[1][0] = __builtin_amdgcn_mfma_f32_32x32x16_fp8_fp8(a1h, b0h, acc[1][0], 0, 0, 0);
      acc[1][1] = __builtin_amdgcn_mfma_f32_32x32x16_fp8_fp8(a1h, b1h, acc[1][1], 0, 0, 0);
    }
  }
  __syncthreads();
}
template <class F>
__device__ __forceinline__ void acc_foreach(int tid, const f32x16 (&acc)[2][2], F f) {
  const int lane = tid & 63, w = tid >> 6;
  const int wm = w >> 1, wn = w & 1, r = lane & 31, h = lane >> 5;
#pragma unroll
  for (int mi = 0; mi < 2; ++mi)
#pragma unroll
    for (int ni = 0; ni < 2; ++ni)
#pragma unroll
      for (int q = 0; q < 16; ++q) {
        const int row = wm * 64 + mi * 32 + (q & 3) + 8 * (q >> 2) + 4 * h;
        const int col = wn * 64 + ni * 32 + r;
        f(row, col, acc[mi][ni][q]);
        if ((q & 3) == 3) __builtin_amdgcn_sched_barrier(0);
      }
}

template <class RM>
__device__ __forceinline__ void tr_tile(int tid, const float* __restrict__ src, int N, int k0, int n0,
                                        bf16_t* __restrict__ dst, int K, RM rowmap, float* tile) {
  {
    const int tx = tid & 15, ty = tid >> 4;
    const int n = n0 + tx * 4;
#pragma unroll
    for (int i = 0; i < 4; ++i) {
      const int k = ty + 16 * i;
      float4 v = make_float4(0.f, 0.f, 0.f, 0.f);
      if (n < N) v = *(const float4*)(src + (size_t)(k0 + k) * N + n);
      tile[k * 65 + tx * 4 + 0] = v.x; tile[k * 65 + tx * 4 + 1] = v.y;
      tile[k * 65 + tx * 4 + 2] = v.z; tile[k * 65 + tx * 4 + 3] = v.w;
    }
  }
  __syncthreads();
  {
    const int kc = tid & 7;
#pragma unroll
    for (int i = 0; i < 2; ++i) {
      const int n = (tid >> 3) + 32 * i;
      if (n0 + n < N) {
        float v[8];
#pragma unroll
        for (int q = 0; q < 8; ++q) v[q] = tile[(kc * 8 + q) * 65 + n];
        u32x4 o;
        o.x = pk_bf16(v[0], v[1]); o.y = pk_bf16(v[2], v[3]); o.z = pk_bf16(v[4], v[5]); o.w = pk_bf16(v[6], v[7]);
        *(u32x4*)(dst + (size_t)rowmap(n0 + n) * K + k0 + kc * 8) = o;
      }
    }
  }
  __syncthreads();
}

constexpr float W8_SCALE = 32.f, W8_INV = 1.f / 32.f;
__device__ __forceinline__ unsigned pk_fp8x4(float a, float b, float c, float d) {
  int r = __builtin_amdgcn_cvt_pk_fp8_f32(a, b, 0, false);
  r = __builtin_amdgcn_cvt_pk_fp8_f32(c, d, r, true);
  return (unsigned)r;
}
template <class RM>
__device__ __forceinline__ void tr_tile_fp8(int tid, const float* __restrict__ src, int N, int k0, int n0,
                                            unsigned char* __restrict__ dst, int K, RM rowmap, float* tile) {
  {
    const int tx = tid & 15, ty = tid >> 4;
    const int n = n0 + tx * 4;
#pragma unroll
    for (int i = 0; i < 4; ++i) {
      const int k = ty + 16 * i;
      const float4 v = *(const float4*)(src + (size_t)(k0 + k) * N + n);
      tile[k * 65 + tx * 4 + 0] = v.x; tile[k * 65 + tx * 4 + 1] = v.y;
      tile[k * 65 + tx * 4 + 2] = v.z; tile[k * 65 + tx * 4 + 3] = v.w;
    }
  }
  __syncthreads();
  {
    const int kc = tid & 3, n = tid >> 2;
    float v[16];
#pragma unroll
    for (int q = 0; q < 16; ++q) v[q] = tile[(kc * 16 + q) * 65 + n] * W8_SCALE;
    u32x4 o;
    o.x = pk_fp8x4(v[0], v[1], v[2], v[3]); o.y = pk_fp8x4(v[4], v[5], v[6], v[7]);
    o.z = pk_fp8x4(v[8], v[9], v[10], v[11]); o.w = pk_fp8x4(v[12], v[13], v[14], v[15]);
    *(u32x4*)(dst + (size_t)rowmap(n0 + n) * K + k0 + kc * 16) = o;
  }
  __syncthreads();
}

constexpr int CJ0 = 1152, CJ1 = CJ0 + 2080, CJ2 = CJ1 + 1024, CJ3 = CJ2 + 33280, CJ4 = CJ3 + 16640;
__device__ void convert_job(KP p, int job, float* sm, int tid) {
  if (job < CJ0) {
    const int j = job / 576, rem = job % 576, kt = rem / 36, nt = rem % 36;
    tr_tile(tid, p->att_w_in + (size_t)j * 1024 * ATT_N, ATT_N, kt * 64, nt * 64, p->Wt_att + (size_t)j * ATT_N * 1024,
            1024, [](int n) { return n; }, sm);
  } else if (job < CJ1) {
    const int q = job - CJ0;
    const int j = q / 1040, rem = q % 1040, kt = rem / 65, nt = rem % 65;
    tr_tile(tid, p->rec_w_in + (size_t)j * 1024 * REC_N, REC_N, kt * 64, nt * 64, p->Wt_rec + (size_t)j * REC_NP * 1024,
            1024, [](int n) { return n; }, sm);
  } else if (job < CJ2) {
    const int q = job - CJ1;
    const int i = q >> 8, rem = q & 255, kt = rem >> 4, nt = rem & 15;
    tr_tile(tid, p->mix_w_out + (size_t)i * 1024 * 1024, 1024, kt * 64, nt * 64, p->Wt_out + (size_t)i * 1024 * 1024,
            1024, [](int n) { return n; }, sm);
  } else if (job < CJ3) {
    const int q = job - CJ2;
    const int le = q >> 7, rem = q & 127;
    const int which = rem >> 6, kt = (rem >> 2) & 15, nt = rem & 3;
    const int layer = le / 65, e = le % 65;
    const float* src;
    if (e < 64) src = (which ? p->moe_w3 : p->moe_w1) + (size_t)(layer * 64 + e) * 1024 * 256;
    else src = (which ? p->shared_w3 : p->shared_w1) + (size_t)layer * 1024 * 256;
    tr_tile_fp8(tid, src, 256, kt * 64, nt * 64, (unsigned char*)p->Wt13 + (size_t)le * 512 * 1024, 1024,
                [which](int n) { return 64 * (n >> 5) + which * 32 + (n & 31); }, sm);
  } else {
    const int q = job - CJ3;
    const int le = q >> 6, rem = q & 63;
    const int kt = rem >> 4, nt = rem & 15;
    const int layer = le / 65, e = le % 65;
    const float* src = e < 64 ? p->moe_w2 + (size_t)(layer * 64 + e) * 256 * 1024 : p->shared_w2 + (size_t)layer * 256 * 1024;
    tr_tile_fp8(tid, src, 1024, kt * 64, nt * 64, (unsigned char*)p->Wt2 + (size_t)le * 1024 * 256, 256, [](int n) { return n; }, sm);
  }
}
__device__ __forceinline__ int conv_stage_total(int stage) {
  return stage == 0 ? (576 + 1040 + 512 + 8320 + 4160) : (stage == 1 ? (576 + 1040 + 256 + 16640 + 8320) : (256 + 8320 + 4160));
}
__device__ __forceinline__ int conv_stage_job(int stage, int q) {
  if (stage == 0) {
    if (q < 8320) return CJ2 + q;  q -= 8320;
    if (q < 4160) return CJ3 + q;  q -= 4160;
    if (q < 576) return q;  q -= 576;
    if (q < 1040) return CJ0 + q;  q -= 1040;
    return CJ1 + q;
  } else if (stage == 1) {
    if (q < 8320) return CJ2 + 8320 + q;  q -= 8320;
    if (q < 4160) return CJ3 + 4160 + q;  q -= 4160;
    if (q < 576) return 576 + q;  q -= 576;
    if (q < 256) return CJ1 + 512 + q;  q -= 256;
    if (q < 8320) return CJ2 + 16640 + q;  q -= 8320;
    if (q < 4160) return CJ3 + 8320 + q;  q -= 4160;
    return CJ0 + 1040 + q;
  }
  if (q < 256) return CJ1 + 768 + q;  q -= 256;
  if (q < 8320) return CJ2 + 24960 + q;  q -= 8320;
  return CJ3 + 12480 + q;
}

__device__ void ph_init(KP p, char* smc) {
  float* sm = (float*)smc;
  const int tid = opaque_tid();
  {
    const size_t n4a = (size_t)NL * DM / 4, n4b = (size_t)NC * DM / 4;
    const float4* xs = (const float4*)p->x;
    const float4* cs = (const float4*)p->ctx;
    float4* X4 = (float4*)p->X;
    for (size_t i = (size_t)blockIdx.x * NTHR + tid; i < n4a + n4b; i += (size_t)gridDim.x * NTHR)
      X4[i] = i < n4a ? xs[i] : cs[i - n4a];
  }
  for (int tile = blockIdx.x; tile < 96 * 8; tile += gridDim.x) {
    const int ct = tile >> 3, ks = tile & 7;
    for (int i = tid; i < 9 * 128; i += NTHR) {
      const int r = i >> 7, k = ks * 128 + (i & 127);
      const float v = r < 8 ? p->c[r * 1024 + k] : p->c_ctx[k];
      sm[i] = silu_f(v);
    }
    __syncthreads();
    const int col = ct * 256 + tid;
    const int layer = col / 6144, n = col % 6144;
    const float* W = p->ada_w + ((size_t)layer * 1024 + ks * 128) * 6144 + n;
    float acc[9];
#pragma unroll
    for (int r = 0; r < 9; ++r) acc[r] = 0.f;
#pragma unroll 4
    for (int k = 0; k < 128; ++k) {
      const float w = W[(size_t)k * 6144];
#pragma unroll
      for (int r = 0; r < 9; ++r) acc[r] = fmaf(sm[r * 128 + k], w, acc[r]);
    }
#pragma unroll
    for (int r = 0; r < 9; ++r) p->MODP[((size_t)(ks * 4 + layer) * 9 + r) * 6144 + n] = acc[r];
    __syncthreads();
  }
  for (int q = blockIdx.x; q < conv_stage_total(0); q += gridDim.x) convert_job(p, conv_stage_job(0, q), sm, tid);
  for (int i = blockIdx.x * NTHR + tid; i < 2 * 3 * 128 * 512; i += gridDim.x * NTHR) {
    const int k = i & 511, n = (i >> 9) & 127, wj = i >> 16;
    const int j = wj / 3, which = wj % 3;
    float v = 0.f;
    if (which < 2) {
      if (n < 64) v = (which ? p->rwkv_a1 : p->rwkv_w1)[((size_t)(j * 2 + (n >> 5)) * 512 + k) * 32 + (n & 31)];
    } else if (n < 96) v = p->rwkv_g1[((size_t)j * 512 + k) * 96 + n];
    p->Wl1[i] = f2bf(v);
  }
  for (int i = blockIdx.x * NTHR + tid; i < 2 * 2560 * 128; i += gridDim.x * NTHR) {
    const int k = i & 127, n = (i >> 7) % 2560, j = i / (2560 * 128);
    float v = 0.f;
    if (n < 2048) {
      const int d = (n >> 9) & 1, c = n & 511;
      if (k < 64 && (k >> 5) == d) v = (n < 1024 ? p->rwkv_w2 : p->rwkv_a2)[((size_t)(j * 2 + d) * 32 + (k & 31)) * 512 + c];
    } else if (k < 96) v = p->rwkv_g2[((size_t)j * 96 + k) * 512 + (n - 2048)];
    p->Wl2[i] = f2bf(v);
  }
  for (int i = blockIdx.x * NTHR + tid; i < 64 * 16; i += gridDim.x * NTHR) {
    const int pos = i >> 4, f = i & 15;
    const float ang = (float)pos * powf(10000.f, -(float)f / 16.f);
    p->ROPE[2 * i] = cosf(ang);
    p->ROPE[2 * i + 1] = sinf(ang);
  }
}

__device__ void ph_mod_h(KP p, char* smc) {
  float* sm = (float*)smc;
  const int tid = opaque_tid();
  for (int i = blockIdx.x * NTHR + tid; i < 4 * 9 * 6144; i += gridDim.x * NTHR) {
    const int layer = i / (9 * 6144), rem = i % (9 * 6144), n = rem % 6144;
    float s = p->ada_b[layer * 6144 + n];
#pragma unroll
    for (int ks = 0; ks < 8; ++ks) s += p->MODP[(size_t)(ks * 4 + layer) * 9 * 6144 + rem];
    p->MOD[i] = s;
  }
  const int lane = tid & 63, wave = tid >> 6;
  const int per = (((NT + gridDim.x - 1) / gridDim.x) + 3) & ~3;
  const int t0 = blockIdx.x * per, t1 = min(NT, t0 + per);
  int cur = -1;
  for (int tb = t0; tb < t1; tb += 4) {
    const int mr = modrow(tb);
    if (mr != cur) {
      __syncthreads();
      for (int n = tid; n < 2048; n += NTHR) {
        float a = p->ada_b[n];
#pragma unroll
        for (int ks = 0; ks < 8; ++ks) a += p->MODP[((size_t)(ks * 4) * 9 + mr) * 6144 + n];
        sm[n] = a;
      }
      cur = mr;
      __syncthreads();
    }
    const int t = tb + wave;
    if (t < t1) {
      const float* src = t < NL ? p->x + (size_t)t * DM : p->ctx + (size_t)(t - NL) * DM;
#pragma unroll
      for (int i = 0; i < 4; ++i) {
        const int n = i * 256 + lane * 4;
        const float4 xv = *(const float4*)(src + n);
        const float4 sh = *(const float4*)(sm + n);
        const float4 sc = *(const float4*)(sm + 1024 + n);
        u32x2 o;
        o.x = pk_bf16(xv.x * (1.f + sc.x) + sh.x, xv.y * (1.f + sc.y) + sh.y);
        o.y = pk_bf16(xv.z * (1.f + sc.z) + sh.z, xv.w * (1.f + sc.w) + sh.w);
        *(u32x2*)(p->AB + (size_t)t * DM + n) = o;
      }
    }
  }
}

typedef short v4i16_t __attribute__((ext_vector_type(4)));
using s16x4 = __attribute__((ext_vector_type(4))) short;
__device__ __forceinline__ s16x4 vtr(const char* p) {
  return __builtin_bit_cast(s16x4, __builtin_amdgcn_ds_read_tr16_b64_v4i16((__attribute__((address_space(3))) v4i16_t*)p));
}
#define MFMA32(a, b, c) __builtin_amdgcn_mfma_f32_32x32x16_bf16(a, b, c, 0, 0, 0)
__device__ void ph_attention(KP p, int layer, bool keep, char* lds) {
  const int tid = opaque_tid();
  const int lane = tid & 63, w = tid >> 6, r32 = lane & 31, hi = lane >> 5;
  const int j = layer >> 1;
  float* bias_lds = (float*)(lds + 32768 + 1024);
  const int n_gqa = 1024, n_na = 1024, n_cb = keep ? 128 : 0, n_ca = keep ? 128 : 0;
  const int total = n_gqa + n_na + n_cb + n_ca;
  constexpr float LOG2E = 1.4426950408889634f;
  constexpr float C2 = 0.125f * LOG2E;
  const int c = tid & 7, sr = tid >> 3;
  const int kso = (c ^ ((tid >> 4) & 7)) * 16;
  const int vso = (c >> 2) * 4096 + (c & 3) * 16;
  const int sw = (r32 >> 1) & 7;
  for (int item = blockIdx.x; item < total; item += gridDim.x) {
    int b, qrow0, qoff, koff, voff, ocol, lat_tiles, lat_row0;
    bool na = false;
    int r_w = 0, start_w = 0, ru0 = 0, hN = 0;
    if (item < n_gqa) {
      b = item >> 7;
      const int g = (item >> 6) & 1, tt = item & 63;
      qrow0 = b * SEQ + tt * 32; qoff = 1536 + (g * 4 + w) * 64; koff = 2048 + g * 64; voff = 2176 + g * 64;
      ocol = 512 + (g * 4 + w) * 64; lat_tiles = 32; lat_row0 = b * SEQ;
    } else if (item < n_gqa + n_na) {
      const int it = item - n_gqa;
      b = it >> 7; hN = (it >> 4) & 7;
      const int rp = it & 15;
      na = true; r_w = 2 * rp + (w >> 1);
      qrow0 = b * SEQ + r_w * 64 + (w & 1) * 32; qoff = hN * 64; koff = 512 + hN * 64; voff = 1024 + hN * 64; ocol = hN * 64;
      const int s0 = min(max(2 * rp - 4, 0), 24), s1 = min(max(2 * rp - 3, 0), 24);
      start_w = (w >> 1) ? s1 : s0; ru0 = s0; lat_tiles = (s1 != s0) ? 9 : 8; lat_row0 = b * SEQ + ru0 * 64;
    } else if (item < n_gqa + n_na + n_cb) {
      const int it = item - n_gqa - n_na;
      b = it >> 4;
      const int g = (it >> 3) & 1, tt = it & 7;
      qrow0 = NL + b * CTXL + tt * 32; qoff = 1536 + (g * 4 + w) * 64; koff = 2048 + g * 64; voff = 2176 + g * 64;
      ocol = 512 + (g * 4 + w) * 64; lat_tiles = 0; lat_row0 = 0;
    } else {
      const int it = item - n_gqa - n_na - n_cb;
      b = it >> 4;
      const int h = (it >> 1) & 7, half = it & 1;
      qrow0 = NL + b * CTXL + half * 128 + w * 32; qoff = h * 64; koff = 512 + h * 64; voff = 1024 + h * 64; ocol = h * 64;
      lat_tiles = 0; lat_row0 = 0;
    }
    const int ctx_row0 = NL + b * CTXL, ntiles = lat_tiles + 4;
    if (na)
      for (int i = tid; i < 465; i += NTHR) bias_lds[i] = p->na_rpb[(j * 8 + hN) * 465 + i] * LOG2E;
    bf16x8 qf[4];
    {
      const bf16_t* qp = p->P + (size_t)(qrow0 + r32) * LDP + qoff + hi * 8;
#pragma unroll
      for (int d0 = 0; d0 < 4; ++d0) qf[d0] = *(const bf16x8*)(qp + d0 * 16);
    }
    f32x16 o0, o1;
#pragma unroll
    for (int q = 0; q < 16; ++q) { o0[q] = 0.f; o1[q] = 0.f; }
    float m = -INFINITY, l = 0.f;
    u32x4 kr0, kr1, vr0, vr1;
    auto gload = [&](int t) {
      const int row0 = t < lat_tiles ? lat_row0 + 64 * t : ctx_row0 + 64 * (t - lat_tiles);
      const bf16_t* base = p->P + (size_t)(row0 + sr) * LDP + c * 8;
      kr0 = *(const u32x4*)(base + koff); kr1 = *(const u32x4*)(base + (size_t)32 * LDP + koff);
      vr0 = *(const u32x4*)(base + voff); vr1 = *(const u32x4*)(base + (size_t)32 * LDP + voff);
    };
    auto swrite = [&](int buf) {
      char* Kb = lds + buf * 16384;
      char* Vb = Kb + 8192;
      *(u32x4*)(Kb + sr * 128 + kso) = kr0; *(u32x4*)(Kb + (sr + 32) * 128 + kso) = kr1;
      *(u32x4*)(Vb + vso + sr * 64) = vr0; *(u32x4*)(Vb + vso + (sr + 32) * 64) = vr1;
    };
    gload(0);
    swrite(0);
    for (int t = 0; t < ntiles; ++t) {
      __syncthreads();
      if (t + 1 < ntiles) gload(t + 1);
      const bool na_tile = na && t < lat_tiles;
      const int kr = ru0 + t;
      const bool part = !na_tile || (kr >= start_w && kr < start_w + 8);
      if (part) {
        const char* Ks = lds + (t & 1) * 16384;
        const char* Vs = Ks + 8192;
        f32x16 s0, s1;
#pragma unroll
        for (int q = 0; q < 16; ++q) { s0[q] = 0.f; s1[q] = 0.f; }
#pragma unroll
        for (int d0 = 0; d0 < 4; ++d0) {
          const int off = ((2 * d0 + hi) ^ sw) * 16;
          const bf16x8 k0 = *(const bf16x8*)(Ks + r32 * 128 + off);
          const bf16x8 k1 = *(const bf16x8*)(Ks + (32 + r32) * 128 + off);
          s0 = MFMA32(k0, qf[d0], s0);
          s1 = MFMA32(k1, qf[d0], s1);
        }
        float mx = -INFINITY;
        if (na_tile) {
          const int cq = (w & 1) * 32 + r32;
          const int c0 = min(max(cq - 8, 0), 48);
          const float* brow = bias_lds + (kr - r_w + 7) * 31 + (15 - cq);
#pragma unroll
          for (int q = 0; q < 16; ++q) {
            const int kc = (q & 3) + 8 * (q >> 2) + 4 * hi;
            const float v0 = ((unsigned)(kc - c0) < 16u) ? fmaf(s0[q], C2, brow[kc]) : -INFINITY;
            const float v1 = ((unsigned)(kc + 32 - c0) < 16u) ? fmaf(s1[q], C2, brow[kc + 32]) : -INFINITY;
            s0[q] = v0; s1[q] = v1;
            mx = fmaxf(mx, fmaxf(v0, v1));
          }
        } else {
#pragma unroll
          for (int q = 0; q < 16; ++q) {
            s0[q] *= C2; s1[q] *= C2;
            mx = fmaxf(mx, fmaxf(s0[q], s1[q]));
          }
        }
        {
          auto rr = __builtin_amdgcn_permlane32_swap(__float_as_uint(mx), __float_as_uint(mx), false, false);
          mx = fmaxf(__uint_as_float(rr[0]), __uint_as_float(rr[1]));
        }
        const float mnew = fmaxf(m, mx);
        const float alpha = __builtin_amdgcn_exp2f(m - mnew);
        float ls = 0.f;
#pragma unroll
        for (int q = 0; q < 16; ++q) {
          s0[q] = __builtin_amdgcn_exp2f(s0[q] - mnew);
          s1[q] = __builtin_amdgcn_exp2f(s1[q] - mnew);
          ls += s0[q] + s1[q];
        }
        l = l * alpha + ls;
        m = mnew;
#pragma unroll
        for (int q = 0; q < 16; ++q) { o0[q] *= alpha; o1[q] *= alpha; }
        bf16x8 pf[4];
#pragma unroll
        for (int s = 0; s < 4; ++s) {
          const int u = (s & 1) * 8;
          u32x4 tpk;
          if (s < 2) {
            tpk.x = pk_bf16(s0[u + 0], s0[u + 1]); tpk.y = pk_bf16(s0[u + 2], s0[u + 3]);
            tpk.z = pk_bf16(s0[u + 4], s0[u + 5]); tpk.w = pk_bf16(s0[u + 6], s0[u + 7]);
          } else {
            tpk.x = pk_bf16(s1[u + 0], s1[u + 1]); tpk.y = pk_bf16(s1[u + 2], s1[u + 3]);
            tpk.z = pk_bf16(s1[u + 4], s1[u + 5]); tpk.w = pk_bf16(s1[u + 6], s1[u + 7]);
          }
          pf[s] = __builtin_bit_cast(bf16x8, tpk);
        }
        const char* vb = Vs + ((lane >> 4) & 1) * 32 + (lane & 3) * 8 + ((lane & 15) >> 2) * 64 + hi * 256;
#pragma unroll
        for (int s = 0; s < 4; ++s) {
          const s16x4 a00 = vtr(vb + (16 * s) * 64), a01 = vtr(vb + (16 * s + 8) * 64);
          const s16x4 a10 = vtr(vb + 4096 + (16 * s) * 64), a11 = vtr(vb + 4096 + (16 * s + 8) * 64);
          const bf16x8 A0 = __builtin_shufflevector(a00, a01, 0, 1, 2, 3, 4, 5, 6, 7);
          const bf16x8 A1 = __builtin_shufflevector(a10, a11, 0, 1, 2, 3, 4, 5, 6, 7);
          o0 = MFMA32(A0, pf[s], o0);
          o1 = MFMA32(A1, pf[s], o1);
        }
      }
      if (t + 1 < ntiles) swrite((t + 1) & 1);
    }
    __syncthreads();
    const float lt = l + __shfl_xor(l, 32);
    const float inv = 1.f / lt;
    bf16_t* op = p->AB + (size_t)(qrow0 + r32) * DM + ocol + 4 * hi;
#pragma unroll
    for (int g = 0; g < 4; ++g) {
      u32x2 v0, v1;
      v0.x = pk_bf16(o0[4 * g] * inv, o0[4 * g + 1] * inv); v0.y = pk_bf16(o0[4 * g + 2] * inv, o0[4 * g + 3] * inv);
      v1.x = pk_bf16(o1[4 * g] * inv, o1[4 * g + 1] * inv); v1.y = pk_bf16(o1[4 * g + 2] * inv, o1[4 * g + 3] * inv);
      *(u32x2*)(op + 8 * g) = v0;
      *(u32x2*)(op + 32 + 8 * g) = v1;
    }
  }
}

__device__ void ph_rwkv_mix(KP p, int layer) {
  const int j = layer >> 1;
  const int tid = opaque_tid();
  const int lane = tid & 63, wave = tid >> 6;
  const float* mu = p->rwkv_mu + j * 6 * 512;
  const int c0 = lane * 8;
  auto unpack = [](const u32x4 u, float (&f)[8]) {
    f[0] = bflo(u.x); f[1] = bfhi(u.x); f[2] = bflo(u.y); f[3] = bfhi(u.y);
    f[4] = bflo(u.z); f[5] = bfhi(u.z); f[6] = bflo(u.w); f[7] = bfhi(u.w);
  };
  auto pack = [](const float (&f)[8]) {
    u32x4 o;
    o.x = pk_bf16(f[0], f[1]); o.y = pk_bf16(f[2], f[3]); o.z = pk_bf16(f[4], f[5]); o.w = pk_bf16(f[6], f[7]);
    return o;
  };
  for (int t = blockIdx.x * 4 + wave; t < NT; t += gridDim.x * 4) {
    bool hasp, hasn;
    if (t < NL) { int s = t & 2047; hasp = s > 0; hasn = s < SEQ - 1; }
    else { int s = (t - NL) & 255; hasp = s > 0; hasn = s < CTXL - 1; }
    const bf16_t* pt = p->P + (size_t)t * LDP + c0;
    bf16_t* rw = p->RW + (size_t)t * RWS + c0;
    bf16_t* zb = p->Zb + (size_t)t * 1536 + c0;
    const u32x4 zero = {0u, 0u, 0u, 0u};
#pragma unroll
    for (int q = 0; q < 4; ++q) {
      float cur[8], pv[8], nx[8], d[8];
      unpack(*(const u32x4*)(pt + q * 512), cur);
      unpack(hasp ? *(const u32x4*)(pt + q * 512 - LDP) : zero, pv);
      unpack(hasn ? *(const u32x4*)(pt + q * 512 + LDP) : zero, nx);
#pragma unroll
      for (int e = 0; e < 8; ++e) d[e] = 0.5f * (pv[e] + nx[e]) - cur[e];
      if (q < 3) {
        float o[8];
        const float* m = mu + q * 512 + c0;
#pragma unroll
        for (int e = 0; e < 8; ++e) o[e] = cur[e] + d[e] * m[e];
        if (q == 0) *(u32x4*)(rw) = pack(o);
        else if (q == 2) *(u32x4*)(rw + 512) = pack(o);
        else {
          *(u32x4*)(rw + 10 * 512) = pack(o);
          float kk[8], ss = 0.f;
          const float* kv0 = p->rwkv_kvec + (j * 2 + 0) * 512 + c0;
#pragma unroll
          for (int e = 0; e < 8; ++e) { kk[e] = o[e] * kv0[e]; ss += kk[e] * kk[e]; }
          ss += dppx<0xB1>(ss); ss += dppx<0x4E>(ss); ss += dppx<0x141>(ss);
          const float rn = rsqrtf(fmaxf(ss, 1e-24f));
#pragma unroll
          for (int e = 0; e < 8; ++e) kk[e] *= rn;
          *(u32x4*)(rw + 2 * 512) = pack(kk);
        }
      } else {
#pragma unroll
        for (int z = 0; z < 3; ++z) {
          float o[8];
          const float* m = mu + (3 + z) * 512 + c0;
#pragma unroll
          for (int e = 0; e < 8; ++e) o[e] = cur[e] + d[e] * m[e];
          *(u32x4*)(zb + z * 512) = pack(o);
        }
      }
    }
  }
}

constexpr int RS_STEP = 384;
constexpr int RS_TB = 16;
struct RwkvStage { u32x2 r, kk, e, ke, a, v; };
__device__ void rwkv_unit(KP p, int unit, float* sm, int tid) {
  const int ch = unit >> 1, hf = unit & 1;
  const int dir = ch >> 6, b = (ch >> 3) & 7, h = ch & 7;
  const int lane = tid & 63, w = tid >> 6, rl = lane >> 3, ks = lane & 7;
  float* ybuf = sm + 2 * RS_TB * RS_STEP;
  const int ss = tid >> 4, kq = tid & 15;
  auto gload = [&](int n, RwkvStage& g) {
    const int row = scan_row(dir, b, n * RS_TB + ss);
    const bf16_t* base = p->RW + (size_t)row * RWS + h * 64 + kq * 4;
    g.r = *(const u32x2*)(base);
    g.kk = *(const u32x2*)(base + 2 * 512);
    g.e = *(const u32x2*)(base + (3 + dir) * 512);
    g.ke = *(const u32x2*)(base + (5 + dir) * 512);
    g.a = *(const u32x2*)(base + (7 + dir) * 512);
    g.v = *(const u32x2*)(p->RW + (size_t)row * RWS + 512 + h * 64 + hf * 32 + (kq & 7) * 4);
  };
  auto swrite = [&](int buf, const RwkvStage& g) {
    float* sp = sm + (buf * RS_TB + ss) * RS_STEP;
    const float r0 = bflo(g.r.x), r1 = bfhi(g.r.x), r2 = bflo(g.r.y), r3 = bfhi(g.r.y);
    const float k0 = bflo(g.kk.x), k1 = bfhi(g.kk.x), k2 = bflo(g.kk.y), k3 = bfhi(g.kk.y);
    const float w0 = __expf(-bflo(g.e.x)), w1 = __expf(-bfhi(g.e.x)), w2 = __expf(-bflo(g.e.y)), w3 = __expf(-bfhi(g.e.y));
    const float e0 = bflo(g.ke.x), e1 = bfhi(g.ke.x), e2 = bflo(g.ke.y), e3 = bfhi(g.ke.y);
    const float a0 = k0 * bflo(g.a.x), a1 = k1 * bfhi(g.a.x), a2 = k2 * bflo(g.a.y), a3 = k3 * bfhi(g.a.y);
    *(float4*)(sp + kq * 4) = make_float4(k0, k1, k2, k3);
    *(float4*)(sp + 64 + kq * 4) = make_float4(w0 * r0, w1 * r1, w2 * r2, w3 * r3);
    *(float4*)(sp + 128 + kq * 4) = make_float4(w0, w1, w2, w3);
    *(float4*)(sp + 192 + kq * 4) = make_float4(a0, a1, a2, a3);
    *(float4*)(sp + 256 + kq * 4) = make_float4(e0, e1, e2, e3);
    if (kq < 8) *(float4*)(sp + 320 + kq * 4) = make_float4(bflo(g.v.x), bfhi(g.v.x), bflo(g.v.y), bfhi(g.v.y));
    float c1 = a0 * r0 + a1 * r1 + a2 * r2 + a3 * r3;
    float c2 = e0 * r0 + e1 * r1 + e2 * r2 + e3 * r3;
    c1 += dppx<0xB1>(c1); c2 += dppx<0xB1>(c2);
    c1 += dppx<0x4E>(c1); c2 += dppx<0x4E>(c2);
    c1 += dppx<0x141>(c1); c2 += dppx<0x141>(c2);
    c1 += dppx<0x140>(c1); c2 += dppx<0x140>(c2);
    if (kq == 0) { sp[352] = c1; sp[353] = c2; }
  };
  typedef float f2 __attribute__((ext_vector_type(2)));
  f2 S01 = {0.f, 0.f}, S23 = {0.f, 0.f}, S45 = {0.f, 0.f}, S67 = {0.f, 0.f};
  auto compute = [&](int n) {
    const float* bp = sm + (n & 1) * RS_TB * RS_STEP;
    float* yb = ybuf + (n & 1) * RS_TB * 32 + w * 8 + rl;
    struct Ops { f2 k[4], r[4], w[4], a[4], e[4]; float vv; f2 c; };
    auto ld = [&](int s, Ops& o) {
      const float* sq = bp + s * RS_STEP;
      const f2* sp = (const f2*)(sq + ks * 8);
#pragma unroll
      for (int i = 0; i < 4; ++i) { o.k[i] = sp[i]; o.r[i] = sp[32 + i]; o.w[i] = sp[64 + i]; o.a[i] = sp[96 + i]; o.e[i] = sp[128 + i]; }
      o.vv = sq[320 + w * 8 + rl]; o.c = *(const f2*)(sq + 352);
    };
    auto step = [&](const Ops& o) -> float {
      f2 sa2 = S01 * o.k[0];
      f2 y2 = S01 * o.r[0];
      sa2 = __builtin_elementwise_fma(S23, o.k[1], sa2); y2 = __builtin_elementwise_fma(S23, o.r[1], y2);
      sa2 = __builtin_elementwise_fma(S45, o.k[2], sa2); y2 = __builtin_elementwise_fma(S45, o.r[2], y2);
      sa2 = __builtin_elementwise_fma(S67, o.k[3], sa2); y2 = __builtin_elementwise_fma(S67, o.r[3], y2);
      float sa = sa2.x + sa2.y, y0 = y2.x + y2.y;
      sa += dppx<0xB1>(sa); y0 += dppx<0xB1>(y0);
      sa += dppx<0x4E>(sa); y0 += dppx<0x4E>(y0);
      sa += dppx<0x141>(sa); y0 += dppx<0x141>(y0);
      sa = -sa;
      const f2 sav = {sa, sa}, vvv = {o.vv, o.vv};
      S01 = __builtin_elementwise_fma(vvv, o.e[0], __builtin_elementwise_fma(sav, o.a[0], S01 * o.w[0]));
      S23 = __builtin_elementwise_fma(vvv, o.e[1], __builtin_elementwise_fma(sav, o.a[1], S23 * o.w[1]));
      S45 = __builtin_elementwise_fma(vvv, o.e[2], __builtin_elementwise_fma(sav, o.a[2], S45 * o.w[2]));
      S67 = __builtin_elementwise_fma(vvv, o.e[3], __builtin_elementwise_fma(sav, o.a[3], S67 * o.w[3]));
      return fmaf(o.vv, o.c.y, fmaf(sa, o.c.x, y0));
    };
    Ops oa, ob;
    ld(0, oa);
#pragma unroll 1
    for (int s = 0; s < RS_TB; s += 2) {
      __builtin_amdgcn_sched_barrier(0);
      ld(s + 1, ob);
      __builtin_amdgcn_sched_barrier(0);
      float y0 = step(oa);
      asm volatile("" : "+v"(y0));
      __builtin_amdgcn_sched_barrier(0);
      ld(s + 2, oa);
      __builtin_amdgcn_sched_barrier(0);
      float y1 = step(ob);
      asm volatile("" : "+v"(y1));
      __builtin_amdgcn_sched_barrier(0);
      if (ks == 0) { yb[s * 32] = y0; yb[(s + 1) * 32] = y1; }
    }
  };
  auto yout = [&](int n) {
    const int row = scan_row(dir, b, n * RS_TB + ss);
    const float* ys = ybuf + (n & 1) * RS_TB * 32 + ss * 32 + kq * 2;
    *(unsigned*)(p->P + (size_t)row * LDP + dir * 512 + h * 64 + hf * 32 + kq * 2) = pk_bf16(ys[0], ys[1]);
  };
  constexpr int NB = TSC / RS_TB;
  RwkvStage gA, gB;
  gload(0, gA);
  gload(1, gB);
  swrite(0, gA);
  gload(2, gA);
  __syncthreads();
  for (int n = 0; n < NB; n += 2) {
    compute(n);
    swrite(1, gB);
    if (n + 3 < NB) gload(n + 3, gB);
    __syncthreads();
    yout(n);
    compute(n + 1);
    if (n + 2 < NB) swrite(0, gA);
    if (n + 4 < NB) gload(n + 4, gA);
    __syncthreads();
    yout(n + 1);
  }
  __syncthreads();
}

__device__ void mlstm_s1(KP p, int layer, int tile, char* lds, int tid) {
  const int j = layer >> 1;
  const int ch = tile / NCHUNK, c = tile % NCHUNK;
  const int dir = ch >> 5, b = (ch >> 2) & 7, h = ch & 3;
  float* s_ws = (float*)(lds + META_OFF);
  int* s_row = (int*)(s_ws + 64);
  char* kimg = lds;
  char* vimg = lds + 16384;
  if (tid < 64) {
    const int row = scan_row(dir, b, c * 64 + tid);
    s_row[tid] = row;
    const float* g = p->GP + (size_t)row * 16;
    const float gi = g[(dir * 2) * 4 + h] + p->mlstm_gate_b[j * 16 + (dir * 2) * 4 + h];
    const float gf = g[(dir * 2 + 1) * 4 + h] + p->mlstm_gate_b[j * 16 + (dir * 2 + 1) * 4 + h];
    float bc = -softplus_f(-gf);
#pragma unroll
    for (int o = 1; o < 64; o <<= 1) {
      float tmp = __shfl_up(bc, o);
      if (tid >= o) bc += tmp;
    }
    const float bend = __shfl(bc, 63);
    const float ds = bend - bc + gi;
    const float mloc = wmax(ds);
    s_ws[tid] = expf(ds - mloc);
    if (tid == 0) { p->msc[tile] = mloc; p->msc[NMT + tile] = bend; }
  }
  __syncthreads();
  {
    const int c8 = tid & 15;
    const int ioff = (c8 >> 2) * 4096 + (c8 & 3) * 16;
#pragma unroll
    for (int i = 0; i < 4; ++i) {
      const int sidx = (tid >> 4) + 16 * i;
      const bf16_t* src = p->P + (size_t)s_row[sidx] * LDP + h * 128 + c8 * 8;
      const u32x4 kv = *(const u32x4*)(src + 2560);
      u32x4 vv = *(const u32x4*)(src + 3072);
      const float wsv = s_ws[sidx];
      vv.x = pk_bf16(bflo(vv.x) * wsv, bfhi(vv.x) * wsv); vv.y = pk_bf16(bflo(vv.y) * wsv, bfhi(vv.y) * wsv);
      vv.z = pk_bf16(bflo(vv.z) * wsv, bfhi(vv.z) * wsv); vv.w = pk_bf16(bflo(vv.w) * wsv, bfhi(vv.w) * wsv);
      *(u32x4*)(kimg + ioff + sidx * 64) = kv;
      *(u32x4*)(vimg + ioff + sidx * 64) = vv;
    }
  }
  __syncthreads();
  const int lane = tid & 63, w = tid >> 6, wm = w >> 1, wn = w & 1, r32 = lane & 31, hi = lane >> 5;
  f32x16 acc[2][2];
#pragma unroll
  for (int mi = 0; mi < 2; ++mi)
#pragma unroll
    for (int ni = 0; ni < 2; ++ni)
#pragma unroll
      for (int q = 0; q < 16; ++q) acc[mi][ni][q] = 0.f;
  const int toff = ((lane >> 4) & 1) * 32 + (lane & 3) * 8 + ((lane & 15) >> 2) * 64 + hi * 256;
#pragma unroll
  for (int ks = 0; ks < 4; ++ks) {
    bf16x8 af[2], bfr[2];
#pragma unroll
    for (int i = 0; i < 2; ++i) {
      const char* ka = kimg + (wm * 2 + i) * 4096 + toff + (16 * ks) * 64;
      const char* va = vimg + (wn * 2 + i) * 4096 + toff + (16 * ks) * 64;
      af[i] = __builtin_shufflevector(vtr(ka), vtr(ka + 8 * 64), 0, 1, 2, 3, 4, 5, 6, 7);
      bfr[i] = __builtin_shufflevector(vtr(va), vtr(va + 8 * 64), 0, 1, 2, 3, 4, 5, 6, 7);
    }
    acc[0][0] = MFMA32(af[0], bfr[0], acc[0][0]);
    acc[0][1] = MFMA32(af[0], bfr[1], acc[0][1]);
    acc[1][0] = MFMA32(af[1], bfr[0], acc[1][0]);
    acc[1][1] = MFMA32(af[1], bfr[1], acc[1][1]);
  }
  bf16_t* U = p->MS + (size_t)tile * 16384;
#pragma unroll
  for (int mi = 0; mi < 2; ++mi)
#pragma unroll
    for (int ni = 0; ni < 2; ++ni)
#pragma unroll
      for (int q = 0; q < 16; ++q) {
        const int d = wm * 64 + mi * 32 + (q & 3) + 8 * (q >> 2) + 4 * hi;
        U[d * 128 + wn * 64 + ni * 32 + r32] = f2bf(acc[mi][ni][q]);
        if ((q & 3) == 3) __builtin_amdgcn_sched_barrier(0);
      }
  if (tid < 128) {
    const char* kc = kimg + (tid >> 5) * 4096 + (tid & 31) * 2;
    float a = 0.f;
#pragma unroll 8
    for (int sidx = 0; sidx < 64; ++sidx) a = fmaf(s_ws[sidx], bf2f(*(const bf16_t*)(kc + sidx * 64)), a);
    p->MSn[tile * 128 + tid] = a;
  }
}

__device__ void ph_scan_a(KP p, int layer, char* smc) {
  float* sm = (float*)smc;
  const int tid = opaque_tid();
  for (int u = blockIdx.x; u < 256; u += gridDim.x) rwkv_unit(p, u, sm, tid);
  const int nblk = gridDim.x, bid = blockIdx.x;
  const int start = (bid + nblk - (256 % nblk)) % nblk;
  for (int tile = start; tile < NMT; tile += nblk) { mlstm_s1(p, layer, tile, smc, tid); __syncthreads(); }
  {
    const int stage = layer == 1 ? 1 : 2;
    const int total = conv_stage_total(stage);
    int* qc = (int*)(p->bar + XCD_BAR_WORDS + 16 * stage);
    int* s_q = (int*)(smc + META_OFF + 3968);
    for (;;) {
      __syncthreads();
      if (tid == 0) *s_q = atomicAdd(qc, 1);
      __syncthreads();
      const int q = *s_q;
      if (q >= total) break;
      convert_job(p, conv_stage_job(stage, q), sm, tid);
    }
  }
}

__device__ void ph_mlstm_s2(KP p, char* smc) {
  float* sw = (float*)smc;
  const int tid = opaque_tid();
  const int nitems = 64 * 33;
  for (int item = blockIdx.x; item < nitems; item += gridDim.x) {
    const int ch = item / 33, seg = item % 33;
    __syncthreads();
    if (tid == 0) {
      float m = 0.f;
      for (int c = 0; c < NCHUNK; ++c) {
        const int tile = ch * NCHUNK + c;
        const float mloc = p->msc[tile], bend = p->msc[NMT + tile];
        const float mn = fmaxf(bend + m, mloc);
        sw[c] = expf(bend + m - mn);
        sw[36 + c] = expf(mloc - mn);
        if (seg == 0) p->msc[2 * NMT + tile] = m;
        m = mn;
      }
    }
    __syncthreads();
    if (seg < 32) {
      unsigned* base = (unsigned*)(p->MS + (size_t)ch * NCHUNK * 16384) + seg * 256 + tid;
      unsigned v[NCHUNK];
#pragma unroll
      for (int c = 0; c < NCHUNK; ++c) v[c] = base[(size_t)c * 8192];
      float C0 = 0.f, C1 = 0.f;
#pragma unroll
      for (int c = 0; c < NCHUNK; ++c) {
        const float t0 = bflo(v[c]), t1 = bfhi(v[c]);
        v[c] = pk_bf16(C0, C1);
        C0 = sw[c] * C0 + sw[36 + c] * t0;
        C1 = sw[c] * C1 + sw[36 + c] * t1;
      }
#pragma unroll
      for (int c = 0; c < NCHUNK; ++c) base[(size_t)c * 8192] = v[c];
    } else if (tid < 128) {
      float* base = p->MSn + (size_t)ch * NCHUNK * 128 + tid;
      float v[NCHUNK];
#pragma unroll
      for (int c = 0; c < NCHUNK; ++c) v[c] = base[c * 128];
      float C = 0.f;
#pragma unroll
      for (int c = 0; c < NCHUNK; ++c) {
        const float t0 = v[c];
        v[c] = C;
        C = sw[c] * C + sw[36 + c] * t0;
      }
#pragma unroll
      for (int c = 0; c < NCHUNK; ++c) base[c * 128] = v[c];
    }
  }
}

__device__ void mlstm_s3(KP p, int layer, int tile, char* lds, int tid) {
  const int j = layer >> 1;
  const int ch = tile / NCHUNK, c = tile % NCHUNK;
  const int dir = ch >> 5, b = (ch >> 2) & 7, h = ch & 3;
  float* s_b = (float*)(lds + META_OFF);
  float* s_ig = s_b + 64;
  float* s_mt = s_b + 128;
  float* s_wi = s_b + 192;
  int* s_row = (int*)(s_b + 256);
  float* s_n = s_b + 320;
  float* s_c = s_b + 448;
  char* kimg = lds;
  char* vimg = lds + 16384;
  char* cimg = lds + 32768;
  const float mprev = p->msc[2 * NMT + tile];
  const float qscale = 0.08838834764831845f;
  if (tid < 64) {
    const int row = scan_row(dir, b, c * 64 + tid);
    s_row[tid] = row;
    const float* g = p->GP + (size_t)row * 16;
    const float gi = g[(dir * 2) * 4 + h] + p->mlstm_gate_b[j * 16 + (dir * 2) * 4 + h];
    const float gf = g[(dir * 2 + 1) * 4 + h] + p->mlstm_gate_b[j * 16 + (dir * 2 + 1) * 4 + h];
    float bc = -softplus_f(-gf);
#pragma unroll
    for (int o = 1; o < 64; o <<= 1) {
      float tmp = __shfl_up(bc, o);
      if (tid >= o) bc += tmp;
    }
    s_b[tid] = bc;
    s_ig[tid] = gi;
  } else if (tid < 192) s_n[tid - 64] = p->MSn[tile * 128 + (tid - 64)];
  __syncthreads();
  if (tid < 64) {
    const float bt = s_b[tid];
    float mt = bt + mprev;
    for (int sx = 0; sx <= tid; ++sx) mt = fmaxf(mt, bt - s_b[sx] + s_ig[sx]);
    s_mt[tid] = mt;
    s_wi[tid] = expf(bt + mprev - mt);
    s_c[tid] = (s_ig[tid] - bt) * 1.4426950408889634f;
  }
  {
    const int c8 = tid & 15;
    const int ioff = (c8 >> 2) * 4096 + (c8 & 3) * 16;
#pragma unroll
    for (int i = 0; i < 4; ++i) {
      const int sidx = (tid >> 4) + 16 * i;
      const bf16_t* src = p->P + (size_t)s_row[sidx] * LDP + h * 128 + c8 * 8;
      *(u32x4*)(kimg + sidx * 256 + ((c8 ^ (sidx & 15)) * 16)) = *(const u32x4*)(src + 2560);
      *(u32x4*)(vimg + ioff + sidx * 64) = *(const u32x4*)(src + 3072);
    }
    __builtin_amdgcn_sched_barrier(0);
    const bf16_t* Cp = p->MS + (size_t)tile * 16384;
    const int coff = (c8 >> 2) * 8192 + (c8 & 3) * 16;
#pragma unroll
    for (int i = 0; i < 8; ++i) {
      const int d = (tid >> 4) + 16 * i;
      *(u32x4*)(cimg + coff + d * 64) = *(const u32x4*)(Cp + d * 128 + c8 * 8);
      if (i == 3) __builtin_amdgcn_sched_barrier(0);
    }
    __builtin_amdgcn_sched_barrier(0);
  }
  const int lane = tid & 63, w = tid >> 6, wt = w >> 1, wv = w & 1, r32 = lane & 31, hi = lane >> 5;
  const int t = wt * 32 + r32;
  bf16x8 qf[8];
  {
    const bf16_t* qp = p->P + (size_t)s_row[t] * LDP + 2048 + h * 128 + hi * 8;
#pragma unroll
    for (int d0 = 0; d0 < 8; ++d0) qf[d0] = *(const bf16x8*)(qp + d0 * 16);
  }
  __syncthreads();
  const int toff = ((lane >> 4) & 1) * 32 + (lane & 3) * 8 + ((lane & 15) >> 2) * 64;
  constexpr float LOG2E_ = 1.4426950408889634f;
  float qn = 0.f;
#pragma unroll
  for (int d0 = 0; d0 < 8; ++d0) {
    const u32x4 qq = __builtin_bit_cast(u32x4, qf[d0]);
    const float* np = s_n + d0 * 16 + hi * 8;
    qn = fmaf(bflo(qq.x), np[0], qn); qn = fmaf(bfhi(qq.x), np[1], qn);
    qn = fmaf(bflo(qq.y), np[2], qn); qn = fmaf(bfhi(qq.y), np[3], qn);
    qn = fmaf(bflo(qq.z), np[4], qn); qn = fmaf(bfhi(qq.z), np[5], qn);
    qn = fmaf(bflo(qq.w), np[6], qn); qn = fmaf(bfhi(qq.w), np[7], qn);
  }
  qn += __shfl_xor(qn, 32);
  const float mtt = s_mt[t], wi = s_wi[t];
  const float ct = (s_b[t] - mtt) * LOG2E_;
  const float wq = wi * qscale;
  bf16x8 pf[4];
  float den = 0.f;
  {
    f32x16 sa0, sa1;
#pragma unroll
    for (int q = 0; q < 16; ++q) { sa0[q] = 0.f; sa1[q] = 0.f; }
#pragma unroll
    for (int d0 = 0; d0 < 8; ++d0) {
      const int chn = 2 * d0 + hi;
      const bf16x8 k0 = *(const bf16x8*)(kimg + r32 * 256 + ((chn ^ (r32 & 15)) * 16));
      sa0 = MFMA32(k0, qf[d0], sa0);
      if (wt) {
        const bf16x8 k1 = *(const bf16x8*)(kimg + (32 + r32) * 256 + ((chn ^ (r32 & 15)) * 16));
        sa1 = MFMA32(k1, qf[d0], sa1);
      }
      __builtin_amdgcn_sched_barrier(0);
    }
#pragma unroll
    for (int g = 0; g < 4; ++g) {
      const int sb0 = 8 * g + 4 * hi;
      const float4 c0v = *(const float4*)(s_c + sb0);
      const float4 c1v = *(const float4*)(s_c + sb0 + 32);
      const float cc0[4] = {c0v.x, c0v.y, c0v.z, c0v.w}, cc1[4] = {c1v.x, c1v.y, c1v.z, c1v.w};
#pragma unroll
      for (int e = 0; e < 4; ++e) {
        const int q = 4 * g + e;
        const float v0 = (sb0 + e <= t) ? sa0[q] * qscale * __builtin_amdgcn_exp2f(ct + cc0[e]) : 0.f;
        sa0[q] = v0; den += v0;
        const float v1 = (wt && sb0 + 32 + e <= t) ? sa1[q] * qscale * __builtin_amdgcn_exp2f(ct + cc1[e]) : 0.f;
        sa1[q] = v1; den += v1;
      }
      __builtin_amdgcn_sched_barrier(0);
    }
#pragma unroll
    for (int sx = 0; sx < 4; ++sx) {
      const int u = (sx & 1) * 8;
      u32x4 tpk;
      if (sx < 2) {
        tpk.x = pk_bf16(sa0[u + 0], sa0[u + 1]); tpk.y = pk_bf16(sa0[u + 2], sa0[u + 3]);
        tpk.z = pk_bf16(sa0[u + 4], sa0[u + 5]); tpk.w = pk_bf16(sa0[u + 6], sa0[u + 7]);
      } else {
        tpk.x = pk_bf16(sa1[u + 0], sa1[u + 1]); tpk.y = pk_bf16(sa1[u + 2], sa1[u + 3]);
        tpk.z = pk_bf16(sa1[u + 4], sa1[u + 5]); tpk.w = pk_bf16(sa1[u + 6], sa1[u + 7]);
      }
      pf[sx] = __builtin_bit_cast(bf16x8, tpk);
    }
  }
  den += __shfl_xor(den, 32);
  const float dtot = den + wq * qn;
  const float inv = 1.f / fmaxf(fabsf(dtot), expf(-mtt));
  bf16_t* op = p->P + (size_t)s_row[t] * LDP + 1024 + dir * 512 + h * 128 + wv * 64 + 4 * hi;
#pragma unroll 1
  for (int vp = 0; vp < 2; ++vp) {
    f32x16 o0;
#pragma unroll
    for (int q = 0; q < 16; ++q) o0[q] = 0.f;
    const char* cb = cimg + (wv * 2 + vp) * 8192 + toff + hi * 512;
#pragma unroll
    for (int d0 = 0; d0 < 8; ++d0) {
      const bf16x8 A0 = __builtin_shufflevector(vtr(cb + (16 * d0) * 64), vtr(cb + (16 * d0 + 4) * 64), 0, 1, 2, 3, 4, 5, 6, 7);
      o0 = MFMA32(A0, qf[d0], o0);
    }
#pragma unroll
    for (int q = 0; q < 16; ++q) o0[q] *= wq;
    const char* vb = vimg + (wv * 2 + vp) * 4096 + toff + hi * 256;
#pragma unroll
    for (int sx = 0; sx < 4; ++sx) {
      if (sx < 2 || wt) {
        const bf16x8 A0 = __builtin_shufflevector(vtr(vb + (16 * sx) * 64), vtr(vb + (16 * sx + 8) * 64), 0, 1, 2, 3, 4, 5, 6, 7);
        o0 = MFMA32(A0, pf[sx], o0);
      }
    }
#pragma unroll
    for (int g = 0; g < 4; ++g) {
      u32x2 v0;
      v0.x = pk_bf16(o0[4 * g] * inv, o0[4 * g + 1] * inv); v0.y = pk_bf16(o0[4 * g + 2] * inv, o0[4 * g + 3] * inv);
      *(u32x2*)(op + vp * 32 + 8 * g) = v0;
    }
  }
}

__device__ void ph_mlstm_s3(KP p, int layer, char* smc) {
  const int tid = opaque_tid();
  for (int tile = blockIdx.x; tile < NMT; tile += gridDim.x) { mlstm_s3(p, layer, tile, smc, tid); __syncthreads(); }
}

__device__ void ph_rec_final(KP p, int layer, bool keep) {
  const int tid = opaque_tid();
  const int j = layer >> 1;
  const int lane = tid & 63, wave = tid >> 6;
  const int rows = keep ? NT : NL;
  const int c0 = lane * 8;
  auto unpack = [](const u32x4 u, float (&f)[8]) {
    f[0] = bflo(u.x); f[1] = bfhi(u.x); f[2] = bflo(u.y); f[3] = bfhi(u.y);
    f[4] = bflo(u.z); f[5] = bfhi(u.z); f[6] = bflo(u.w); f[7] = bfhi(u.w);
  };
  for (int t = blockIdx.x * 4 + wave; t < rows; t += gridDim.x * 4) {
    const bf16_t* rw = p->RW + (size_t)t * RWS + c0;
    const bf16_t* pt = p->P + (size_t)t * LDP + c0;
    bf16_t* mo = p->AB + (size_t)t * DM + c0;
    {
      float yf[8], yb[8], r[8], v[8], k0[8], k1[8], g[8], y[8], o[8];
      unpack(*(const u32x4*)(pt), yf); unpack(*(const u32x4*)(pt + 512), yb);
      unpack(*(const u32x4*)(rw), r); unpack(*(const u32x4*)(rw + 512), v);
      unpack(*(const u32x4*)(rw + 5 * 512), k0); unpack(*(const u32x4*)(rw + 6 * 512), k1);
      unpack(*(const u32x4*)(rw + 9 * 512), g);
      float s1 = 0.f, bs = 0.f;
      const float* rk = p->rwkv_rk + j * 512 + c0;
#pragma unroll
      for (int e = 0; e < 8; ++e) { y[e] = yf[e] + yb[e]; s1 += y[e]; bs += r[e] * rk[e] * (k0[e] + k1[e]); }
      s1 += dppx<0xB1>(s1); s1 += dppx<0x4E>(s1); s1 += dppx<0x141>(s1);
      bs += dppx<0xB1>(bs); bs += dppx<0x4E>(bs); bs += dppx<0x141>(bs);
      const float mu = s1 * (1.f / 64.f);
      float s2 = 0.f;
#pragma unroll
      for (int e = 0; e < 8; ++e) { const float d = y[e] - mu; s2 += d * d; }
      s2 += dppx<0xB1>(s2); s2 += dppx<0x4E>(s2); s2 += dppx<0x141>(s2);
      const float rs = rsqrtf(s2 * (1.f / 64.f) + 64e-5f);
      const float* gn0 = p->rwkv_gn + (j * 2 + 0) * 512 + c0;
      const float* gn1 = p->rwkv_gn + (j * 2 + 1) * 512 + c0;
#pragma unroll
      for (int e = 0; e < 8; ++e) o[e] = ((y[e] - mu) * rs * gn0[e] + gn1[e] + bs * v[e]) * g[e];
      u32x4 ov;
      ov.x = pk_bf16(o[0], o[1]); ov.y = pk_bf16(o[2], o[3]); ov.z = pk_bf16(o[4], o[5]); ov.w = pk_bf16(o[6], o[7]);
      *(u32x4*)(mo) = ov;
    }
    {
      float hf[8], hb[8], og[8], hsum[8], o[8];
      unpack(*(const u32x4*)(pt + 1024), hf); unpack(*(const u32x4*)(pt + 1536), hb);
      unpack(*(const u32x4*)(pt + 3584), og);
      float ss = 0.f;
#pragma unroll
      for (int e = 0; e < 8; ++e) { hsum[e] = hf[e] + hb[e]; ss += hsum[e] * hsum[e]; }
      ss += dppx<0xB1>(ss); ss += dppx<0x4E>(ss); ss += dppx<0x141>(ss); ss += dppx<0x140>(ss);
      const float rs = rsqrtf(ss * (1.f / 128.f) + 1e-6f);
      const float* ng = p->mlstm_norm + j * 512 + c0;
#pragma unroll
      for (int e = 0; e < 8; ++e) o[e] = hsum[e] * rs * ng[e] * sigm_f(og[e]);
      u32x4 ov;
      ov.x = pk_bf16(o[0], o[1]); ov.y = pk_bf16(o[2], o[3]); ov.z = pk_bf16(o[4], o[5]); ov.w = pk_bf16(o[6], o[7]);
      *(u32x4*)(mo + 512) = ov;
    }
  }
}

using f32x4v = __attribute__((ext_vector_type(4))) float;
__device__ void ph_ln_router(KP p, int layer, bool keep, char* smc) {
  float* h2s = (float*)smc;
  float* lgs = (float*)smc;
  const int tid = opaque_tid();
  const int lane = tid & 63, wave = tid >> 6;
  const int rows = keep ? NT : NL;
  const float* lng = p->ln_g + (layer * 2 + 0) * 1024;
  const float* lnb = p->ln_b + (layer * 2 + 0) * 1024;
  const float* Wr = p->moe_router + (size_t)layer * 1024 * 64;
  for (int tile = blockIdx.x; tile < rows / 16; tile += gridDim.x) {
    const int t0 = tile * 16;
    const float* mod = p->MOD + (layer * 9 + modrow(t0)) * 6144;
#pragma unroll 1
    for (int q = 0; q < 4; ++q) {
      const int tl = wave * 4 + q, t = t0 + tl;
      float4 v[4];
      float s = 0.f;
#pragma unroll
      for (int i = 0; i < 4; ++i) {
        v[i] = *(const float4*)(p->Tb + (size_t)t * DM + i * 256 + lane * 4);
        s += (v[i].x + v[i].y) + (v[i].z + v[i].w);
      }
      const float mean = wsum(s) * (1.f / 1024.f);
      float qq = 0.f;
#pragma unroll
      for (int i = 0; i < 4; ++i) {
        const float d0 = v[i].x - mean, d1 = v[i].y - mean, d2 = v[i].z - mean, d3 = v[i].w - mean;
        qq += (d0 * d0 + d1 * d1) + (d2 * d2 + d3 * d3);
      }
      const float rs = rsqrtf(wsum(qq) * (1.f / 1024.f) + 1e-5f);
#pragma unroll
      for (int i = 0; i < 4; ++i) {
        const int n = i * 256 + lane * 4;
        const float4 g = *(const float4*)(lng + n), bb = *(const float4*)(lnb + n);
        const float4 sc = *(const float4*)(mod + 4096 + n), sh = *(const float4*)(mod + 3072 + n);
        const float4 xn = make_float4((v[i].x - mean) * rs * g.x + bb.x, (v[i].y - mean) * rs * g.y + bb.y,
                                      (v[i].z - mean) * rs * g.z + bb.z, (v[i].w - mean) * rs * g.w + bb.w);
        *(float4*)(p->X + (size_t)t * DM + n) = xn;
        const float4 hh = make_float4(xn.x * (1.f + sc.x) + sh.x, xn.y * (1.f + sc.y) + sh.y,
                                      xn.z * (1.f + sc.z) + sh.z, xn.w * (1.f + sc.w) + sh.w);
        *(unsigned*)((unsigned char*)p->AB + (size_t)t * DM + n) = pk_fp8x4(hh.x, hh.y, hh.z, hh.w);
        *(float4*)(h2s + tl * 1028 + n) = hh;
      }
    }
    __syncthreads();
    f32x4v acc = {0.f, 0.f, 0.f, 0.f};
    {
      f32x4v a1 = {0.f, 0.f, 0.f, 0.f}, a2 = {0.f, 0.f, 0.f, 0.f}, a3 = {0.f, 0.f, 0.f, 0.f};
      const int i = lane & 15, kk = lane >> 4;
      const float* arow = h2s + i * 1028 + 4 * kk;
      const float* bcol = Wr + (4 * kk) * 64 + 16 * wave + i;
#pragma unroll 4
      for (int q = 0; q < 64; ++q) {
        const float4 a = *(const float4*)(arow + 16 * q);
        const float b0 = bcol[(16 * q + 0) * 64], b1 = bcol[(16 * q + 1) * 64];
        const float b2 = bcol[(16 * q + 2) * 64], b3 = bcol[(16 * q + 3) * 64];
        acc = __builtin_amdgcn_mfma_f32_16x16x4f32(a.x, b0, acc, 0, 0, 0);
        a1 = __builtin_amdgcn_mfma_f32_16x16x4f32(a.y, b1, a1, 0, 0, 0);
        a2 = __builtin_amdgcn_mfma_f32_16x16x4f32(a.z, b2, a2, 0, 0, 0);
        a3 = __builtin_amdgcn_mfma_f32_16x16x4f32(a.w, b3, a3, 0, 0, 0);
      }
      acc = (acc + a1) + (a2 + a3);
    }
    __syncthreads();
#pragma unroll
    for (int r = 0; r < 4; ++r) lgs[((lane >> 4) * 4 + r) * 64 + 16 * wave + (lane & 15)] = acc[r];
    __syncthreads();
#pragma unroll 1
    for (int q = 0; q < 4; ++q) {
      const int tl = wave * 4 + q, t = t0 + tl;
      const float logit = lgs[tl * 64 + lane];
      const float score = sigm_f(logit);
      float sel = score + p->moe_bias[layer * 64 + lane];
      bool chosen = false;
      for (int r = 0; r < 6; ++r) {
        const float mx = wmax(sel);
        const unsigned long long bal = __ballot(sel == mx);
        const int first = __ffsll((long long)bal) - 1;
        if (lane == first) { chosen = true; sel = -INFINITY; }
      }
      const float gsum = wsum(chosen ? score : 0.f);
      const unsigned long long cb = __ballot(chosen);
      if (chosen) {
        const int kidx = __popcll(cb & ((1ull << lane) - 1ull));
        const int pos = atomicAdd(&p->cnt[lane], 1);
        p->ltok[(size_t)lane * NT + pos] = t;
        p->lgate[(size_t)lane * NT + pos] = score / gsum * 2.5f;
        p->tsl[t * 6 + kidx] = (lane << 16) | pos;
      }
    }
    __syncthreads();
  }
}

__device__ __forceinline__ void moe_prefix(KP p, int rows, int* s_pref, int tid) {
  if (tid == 0) {
    int a = 0;
    for (int e = 0; e < 64; ++e) { s_pref[e] = a; a += (p->cnt[e] + 127) >> 7; }
    s_pref[64] = a; a += rows >> 7;
    s_pref[65] = a;
  }
  __syncthreads();
}

__device__ void ph_gemm(KP p, int kind, int layer, bool keep, char* lds) {
  const int tid = opaque_tid();
  const int j = layer >> 1;
  const bool att = !(layer & 1);
  const int rows = keep ? NT : NL;
  int* pref = (int*)(lds + META_OFF);
  int* s_idx = pref + 66;
  float* s_gate = (float*)(s_idx + 128);
  if (kind == 1 && blockIdx.x == 0 && tid < 65) p->cnt[tid] = 0;
  if (kind == 2 || kind == 3) moe_prefix(p, rows, pref, tid);
  int total;
  const int ntn_in = att ? 18 : 33;
  switch (kind) {
    case 0: total = (NT / 128) * ntn_in; break;
    case 1: total = (rows / 128) * 8; break;
    case 2: total = pref[65] * 4; break;
    case 3: total = pref[65] * 8; break;
    case 4: total = (NT / 128) * 3; break;
    default: total = (NT / 128) * 20; break;
  }
  for (int tile = blockIdx.x; tile < total; tile += gridDim.x) {
    const bf16_t* Abase; const bf16_t* Bt;
    int astride, K, n0, m0 = 0, aux = 0, e = 0, mtile = 0;
    switch (kind) {
      case 0: { const int tm = tile / ntn_in, tn = tile % ntn_in; m0 = tm * 128; n0 = tn * 128;
                Abase = p->AB + (size_t)m0 * DM; astride = DM; K = 1024;
                Bt = att ? p->Wt_att + (size_t)j * ATT_N * 1024 : p->Wt_rec + (size_t)j * REC_NP * 1024; } break;
      case 1: { const int tm = tile >> 3, tn = tile & 7; m0 = tm * 128; n0 = tn * 128;
                Abase = p->AB + (size_t)m0 * DM; astride = DM; K = 1024; Bt = p->Wt_out + (size_t)layer * 1024 * 1024; } break;
      case 2: { mtile = tile >> 2; aux = tile & 3; n0 = aux * 128; while (mtile >= pref[e + 1]) ++e;
                Abase = p->AB; astride = DM; K = 1024;
                Bt = (const bf16_t*)((const unsigned char*)p->Wt13 + (size_t)(layer * 65 + e) * 512 * 1024); } break;
      case 3: { mtile = tile >> 3; aux = tile & 7; n0 = aux * 128; while (mtile >= pref[e + 1]) ++e;
                Abase = (const bf16_t*)((const unsigned char*)p->ACT + (size_t)mtile * 128 * 256); astride = 256; K = 256;
                Bt = (const bf16_t*)((const unsigned char*)p->Wt2 + (size_t)(layer * 65 + e) * 1024 * 256); } break;
      case 4: { const int tm = tile / 3; aux = tile % 3; m0 = tm * 128; n0 = 0;
                Abase = p->Zb + (size_t)m0 * 1536 + aux * 512; astride = 1536; K = 512; Bt = p->Wl1 + (size_t)(j * 3 + aux) * 128 * 512; } break;
      default: { const int tm = tile / 20; aux = tile % 20; m0 = tm * 128; n0 = aux * 128;
                const int grp = aux < 8 ? 0 : (aux < 16 ? 1 : 2);
                Abase = p->L1 + (size_t)m0 * 384 + grp * 128; astride = 384; K = 128; Bt = p->Wl2 + (size_t)j * 2560 * 128; } break;
    }
    if (tid < 128) {
      int idx = tid; float g = 1.f;
      if (kind == 2 || kind == 3) {
        const int pos = (mtile - pref[e]) * 128 + tid;
        if (kind == 2) {
          idx = 0;
          if (e < 64) { if (pos < p->cnt[e]) idx = p->ltok[(size_t)e * NT + pos]; }
          else idx = pos;
        } else if (e < 64) g = pos < p->cnt[e] ? p->lgate[(size_t)e * NT + pos] : 0.f;
      }
      s_idx[tid] = idx; s_gate[tid] = g;
    }
    __syncthreads();
    {
      f32x16 acc[2][2];
      if (kind == 2 || kind == 3) {
        const unsigned char* A8 = (const unsigned char*)Abase;
        gemm128_fp8(tid, [&](int r) { return A8 + (size_t)s_idx[r] * astride; }, (const unsigned char*)Bt, K, n0, lds, acc);
      } else
        gemm128_main(tid, [&](int r) { return Abase + (size_t)s_idx[r] * astride; }, Bt, K, n0, lds, acc);
      float* Ct = (float*)lds;
      acc_foreach(tid, acc, [&](int row, int col, float v) { Ct[row * 128 + col] = v; });
    }
    __syncthreads();
    {
      const float* Ct = (const float*)lds;
      const int c4 = (tid & 31) * 4, r0 = tid >> 5;
      const int N_in = att ? ATT_N : REC_N;
      const int d5 = (aux >> 2) & 1, c05 = (aux & 3) * 128;
      switch (kind) {
        case 0: {
#pragma unroll 8
          for (int it = 0; it < 16; ++it) {
            const int row = it * 8 + r0;
            const float4 v = *(const float4*)(Ct + row * 128 + c4);

            const int cn = n0 + c4;
            float4 vq = v;
            if (att && n0 >= 1536 && n0 < 2176) {
              float ss = v.x * v.x + v.y * v.y + v.z * v.z + v.w * v.w;
              ss += dppx<0xB1>(ss); ss += dppx<0x4E>(ss); ss += dppx<0x141>(ss); ss += dppx<0x140>(ss);
              const float rs = rsqrtf(ss * (1.f / 64.f) + 1e-6f);
              const float4 g = *(const float4*)(p->qk_gain + j * 128 + (n0 >= 2048 ? 64 : 0) + (cn & 63));
              vq = make_float4(v.x * rs * g.x, v.y * rs * g.y, v.z * rs * g.z, v.w * rs * g.w);
              const int t = m0 + row;
              if (t < NL) {
                const int sidx = t & 2047, pi0 = (cn & 63) >> 1;
                const int pos = pi0 < 16 ? (sidx >> 6) : (sidx & 63);
                const float4 cs = *(const float4*)(p->ROPE + (pos * 16 + (pi0 & 15)) * 2);
                vq = make_float4(vq.x * cs.x - vq.y * cs.y, vq.x * cs.y + vq.y * cs.x,
                                 vq.z * cs.z - vq.w * cs.w, vq.z * cs.w + vq.w * cs.z);
              }
            }
            if (cn < N_in) {
              u32x2 o; o.x = pk_bf16(vq.x, vq.y); o.y = pk_bf16(vq.z, vq.w);
              *(u32x2*)(p->P + (size_t)(m0 + row) * LDP + cn) = o;
            }
            if (!att && cn >= 4096 && cn < 4112) *(float4*)(p->GP + (size_t)(m0 + row) * 16 + (cn - 4096)) = v;
          }
        } break;
        case 1: {
#pragma unroll 16
          for (int it = 0; it < 16; ++it) {
            const int row = it * 8 + r0;
            const float4 v = *(const float4*)(Ct + row * 128 + c4);

            const size_t o = (size_t)(m0 + row) * DM + n0 + c4;
            const float4 xv = *(const float4*)(p->X + o);
            const float4 g = *(const float4*)(p->MOD + (layer * 9 + modrow(m0)) * 6144 + 2048 + n0 + c4);
            *(float4*)(p->Tb + o) = make_float4(DN_ALPHA * xv.x + g.x * v.x, DN_ALPHA * xv.y + g.y * v.y,
                                                DN_ALPHA * xv.z + g.z * v.z, DN_ALPHA * xv.w + g.w * v.w);
          }
        } break;
        case 2: {
#pragma unroll 8
          for (int it = 0; it < 16; ++it) {
            const int row = it * 8 + r0;
            const float4 v = *(const float4*)(Ct + row * 128 + c4);

            if (((c4 >> 5) & 1) == 0) {
              const float4 u = *(const float4*)(Ct + row * 128 + c4 + 32);
              const float a0 = v.x * W8_INV, a1 = v.y * W8_INV, a2 = v.z * W8_INV, a3 = v.w * W8_INV;
              *(unsigned*)((unsigned char*)p->ACT + ((size_t)mtile * 128 + row) * 256 + aux * 64 + (c4 >> 6) * 32 + (c4 & 31)) =
                  pk_fp8x4(silu_f(a0) * (u.x * W8_INV), silu_f(a1) * (u.y * W8_INV), silu_f(a2) * (u.z * W8_INV), silu_f(a3) * (u.w * W8_INV));
            }
          }
        } break;
        case 3: {
#pragma unroll 16
          for (int it = 0; it < 16; ++it) {
            const int row = it * 8 + r0;
            const float4 v = *(const float4*)(Ct + row * 128 + c4);

            const float g = s_gate[row] * W8_INV;
            u32x2 o; o.x = pk_bf16(g * v.x, g * v.y); o.y = pk_bf16(g * v.z, g * v.w);
            *(u32x2*)(p->OUT2 + ((size_t)mtile * 128 + row) * 1024 + n0 + c4) = o;
          }
        } break;
        case 4: {
#pragma unroll 4
          for (int it = 0; it < 16; ++it) {
            const int row = it * 8 + r0;
            const float4 v = *(const float4*)(Ct + row * 128 + c4);

            float4 o4 = v;
            if (aux == 0) o4 = make_float4(tanhf(v.x), tanhf(v.y), tanhf(v.z), tanhf(v.w));
            else if (aux == 2) o4 = make_float4(sigm_f(v.x), sigm_f(v.y), sigm_f(v.z), sigm_f(v.w));
            u32x2 o; o.x = pk_bf16(o4.x, o4.y); o.y = pk_bf16(o4.z, o4.w);
            *(u32x2*)(p->L1 + (size_t)(m0 + row) * 384 + aux * 128 + c4) = o;
          }
        } break;
        default: {
#pragma unroll 4
          for (int it = 0; it < 16; ++it) {
            const int row = it * 8 + r0;
            const float4 v = *(const float4*)(Ct + row * 128 + c4);

            bf16_t* rr = p->RW + (size_t)(m0 + row) * RWS + c05 + c4;
            const float vv[4] = {v.x, v.y, v.z, v.w};
            if (aux < 8) {
              const float4 b0 = *(const float4*)(p->rwkv_w0 + (j * 2 + d5) * 512 + c05 + c4);
              const float bb[4] = {b0.x, b0.y, b0.z, b0.w};
              float e4[4];
#pragma unroll
              for (int q = 0; q < 4; ++q) e4[q] = expf(-softplus_f(-(bb[q] + vv[q])) - 0.5f);
              u32x2 o; o.x = pk_bf16(e4[0], e4[1]); o.y = pk_bf16(e4[2], e4[3]);
              *(u32x2*)(rr + (3 + d5) * 512) = o;
            } else if (aux < 16) {
              const float4 b0 = *(const float4*)(p->rwkv_a0 + (j * 2 + d5) * 512 + c05 + c4);
              const float4 k1 = *(const float4*)(p->rwkv_kvec + (j * 2 + 1) * 512 + c05 + c4);
              const u32x2 kx2 = *(const u32x2*)(rr + 10 * 512);
              const float bb[4] = {b0.x, b0.y, b0.z, b0.w}, kk1[4] = {k1.x, k1.y, k1.z, k1.w};
              const float kx[4] = {bflo(kx2.x), bfhi(kx2.x), bflo(kx2.y), bfhi(kx2.y)};
              float av[4], ke[4];
#pragma unroll
              for (int q = 0; q < 4; ++q) { av[q] = sigm_f(bb[q] + vv[q]); ke[q] = kx[q] * (1.f + (av[q] - 1.f) * kk1[q]); }
              u32x2 o; o.x = pk_bf16(av[0], av[1]); o.y = pk_bf16(av[2], av[3]);
              *(u32x2*)(rr + (7 + d5) * 512) = o;
              o.x = pk_bf16(ke[0], ke[1]); o.y = pk_bf16(ke[2], ke[3]);
              *(u32x2*)(rr + (5 + d5) * 512) = o;
            } else {
              u32x2 o; o.x = pk_bf16(v.x, v.y); o.y = pk_bf16(v.z, v.w);
              *(u32x2*)(rr + 9 * 512) = o;
            }
          }
        } break;
      }
    }
    __syncthreads();
  }
}

__device__ void ph_final_ln(KP p, int layer, bool keep, char* lds) {
  const int tid = opaque_tid();
  const int lane = tid & 63, wave = tid >> 6;
  const int rows = keep ? NT : NL;
  int* s_base = (int*)(lds + META_OFF);
  if (tid == 0) {
    int a = 0;
    for (int e = 0; e < 64; ++e) { s_base[e] = a * 128; a += (p->cnt[e] + 127) >> 7; }
    s_base[64] = a * 128;
  }
  __syncthreads();
  const float* lng = p->ln_g + (layer * 2 + 1) * 1024;
  const float* lnb = p->ln_b + (layer * 2 + 1) * 1024;
  for (int t = blockIdx.x * 4 + wave; t < rows; t += gridDim.x * 4) {
    const int mr = modrow(t);
    const float* g2 = p->MOD + (layer * 9 + mr) * 6144 + 5120;
    const bf16_t* src[7];
#pragma unroll
    for (int k = 0; k < 6; ++k) {
      const int v = p->tsl[t * 6 + k];
      src[k] = p->OUT2 + (size_t)(s_base[v >> 16] + (v & 0xffff)) * 1024;
    }
    src[6] = p->OUT2 + (size_t)(s_base[64] + t) * 1024;
    float v[16];
    float s = 0.f;
#pragma unroll
    for (int c = 0; c < 2; ++c) {
      const int n0 = c * 512 + lane * 8;
      float y[8];
#pragma unroll
      for (int q = 0; q < 8; ++q) y[q] = 0.f;
#pragma unroll
      for (int k = 0; k < 7; ++k) {
        const u32x4 u = *(const u32x4*)(src[k] + n0);
        y[0] += bflo(u.x); y[1] += bfhi(u.x); y[2] += bflo(u.y); y[3] += bfhi(u.y);
        y[4] += bflo(u.z); y[5] += bfhi(u.z); y[6] += bflo(u.w); y[7] += bfhi(u.w);
      }
      const float4 xa = *(const float4*)(p->X + (size_t)t * DM + n0), xb = *(const float4*)(p->X + (size_t)t * DM + n0 + 4);
      const float4 ga = *(const float4*)(g2 + n0), gb = *(const float4*)(g2 + n0 + 4);
      const float xx[8] = {xa.x, xa.y, xa.z, xa.w, xb.x, xb.y, xb.z, xb.w};
      const float gg[8] = {ga.x, ga.y, ga.z, ga.w, gb.x, gb.y, gb.z, gb.w};
#pragma unroll
      for (int q = 0; q < 8; ++q) { v[c * 8 + q] = DN_ALPHA * xx[q] + gg[q] * y[q]; s += v[c * 8 + q]; }
    }
    const float mean = wsum(s) * (1.f / 1024.f);
    float q2 = 0.f;
#pragma unroll
    for (int i = 0; i < 16; ++i) { const float d = v[i] - mean; q2 += d * d; }
    const float rs = rsqrtf(wsum(q2) * (1.f / 1024.f) + 1e-5f);
    const float* modn = p->MOD + ((layer + 1) * 9 + mr) * 6144;
#pragma unroll
    for (int c = 0; c < 2; ++c) {
      const int n0 = c * 512 + lane * 8;
      float xn[8];
#pragma unroll
      for (int q = 0; q < 8; ++q) xn[q] = (v[c * 8 + q] - mean) * rs * lng[n0 + q] + lnb[n0 + q];
      *(float4*)(p->X + (size_t)t * DM + n0) = make_float4(xn[0], xn[1], xn[2], xn[3]);
      *(float4*)(p->X + (size_t)t * DM + n0 + 4) = make_float4(xn[4], xn[5], xn[6], xn[7]);
      if (layer == 3) {
        *(float4*)(p->out + (size_t)t * DM + n0) = make_float4(xn[0], xn[1], xn[2], xn[3]);
        *(float4*)(p->out + (size_t)t * DM + n0 + 4) = make_float4(xn[4], xn[5], xn[6], xn[7]);
      } else {
        float hb[8];
#pragma unroll
        for (int q = 0; q < 8; ++q) hb[q] = xn[q] * (1.f + modn[1024 + n0 + q]) + modn[n0 + q];
        u32x4 o;
        o.x = pk_bf16(hb[0], hb[1]); o.y = pk_bf16(hb[2], hb[3]); o.z = pk_bf16(hb[4], hb[5]); o.w = pk_bf16(hb[6], hb[7]);
        *(u32x4*)(p->AB + (size_t)t * DM + n0) = o;
      }
    }
  }
}

#define XB_TMO      128
#define XB_XCNT(j)  (256  + 64 * (j))
#define XB_XSUB(j)  (1280 + 64 * (j))
#define XB_XGEN(j)  (2304 + 64 * (j))
#define XB_TOP      3328
#define XB_TOPGEN   3392
#define XB_SPIN_CAP (1u << 20)
#define LAS __attribute__((address_space(3)))
__device__ __forceinline__ unsigned xb_ld(unsigned* p) { return __hip_atomic_load(p, __ATOMIC_RELAXED, __HIP_MEMORY_SCOPE_AGENT); }
__device__ __forceinline__ unsigned xb_add(unsigned* p, unsigned v) { return __hip_atomic_fetch_add(p, v, __ATOMIC_RELAXED, __HIP_MEMORY_SCOPE_AGENT); }
__device__ __forceinline__ unsigned xb_xcc_id() { return (unsigned)__builtin_amdgcn_s_getreg((3 << 11) | 20) & 0xFu; }
#define XB_SPIN(cond, bar) do { unsigned _sp = 0; while (cond) { __builtin_amdgcn_s_sleep(1); \
    if ((++_sp & 255u) == 0u) { if (xb_ld(&(bar)[XB_TMO])) break; if (_sp > XB_SPIN_CAP) { atomicAdd(&(bar)[XB_TMO], 1u); break; } } } } while (0)
struct XcdBarrier { unsigned* bar; unsigned x; volatile LAS unsigned* st; };
__device__ __forceinline__ XcdBarrier xcd_barrier_post(unsigned* bar, volatile LAS unsigned* st) {
  XcdBarrier b; b.bar = bar; b.x = xb_xcc_id(); b.st = st;
  if (threadIdx.x == 0) (void)xb_add(&bar[XB_XCNT(b.x)], 1u);
  return b;
}
__device__ __forceinline__ void xcd_barrier_complete(unsigned* bar, unsigned x, unsigned& nloc, unsigned& nx) {
  const unsigned G = gridDim.x;
  unsigned sum, cnt, mine, sp = 0u;
  for (;;) {
    sum = 0u; cnt = 0u; mine = 0u;
#pragma unroll
    for (unsigned j = 0; j < 16; ++j) { const unsigned c = xb_ld(&bar[XB_XCNT(j)]); sum += c; cnt += (c > 0u) ? 1u : 0u; mine = (j == x) ? c : mine; }
    if (sum == G) break;
    __builtin_amdgcn_s_sleep(1);
    if ((++sp & 255u) == 0u) { if (xb_ld(&bar[XB_TMO])) break; if (sp > XB_SPIN_CAP) { atomicAdd(&bar[XB_TMO], 1u); break; } }
  }
  nloc = mine > 0u ? mine : 1u; nx = cnt > 0u ? cnt : 1u;
}
__device__ __forceinline__ void xcd_barrier(const XcdBarrier& b) {
  asm volatile("s_waitcnt vmcnt(0)" ::: "memory");
  __syncthreads();
  if (threadIdx.x == 0) {
    unsigned* bar = b.bar;
    __builtin_amdgcn_s_waitcnt(0);
    unsigned nloc = b.st[0], nx = b.st[1];
    if (nloc == 0u) { xcd_barrier_complete(bar, b.x, nloc, nx); b.st[0] = nloc; b.st[1] = nx; }
    const unsigned old = xb_add(&bar[XB_XSUB(b.x)], 1u);
    const unsigned gen = old / nloc;
    if (old + 1u == (gen + 1u) * nloc) {
      __builtin_amdgcn_fence(__ATOMIC_RELEASE, "agent");
      asm volatile("s_waitcnt vmcnt(0)" ::: "memory");
      const unsigned og = xb_add(&bar[XB_TOP], 1u);
      const unsigned tg = og / nx;
      if (og + 1u == (tg + 1u) * nx) xb_add(&bar[XB_TOPGEN], 1u);
      else XB_SPIN(xb_ld(&bar[XB_TOPGEN]) == tg, bar);
      __builtin_amdgcn_fence(__ATOMIC_ACQUIRE, "agent");
      xb_add(&bar[XB_XGEN(b.x)], 1u);
      asm volatile("s_waitcnt vmcnt(0)" ::: "memory");
    } else {
      XB_SPIN(xb_ld(&bar[XB_XGEN(b.x)]) == gen, bar);
      __builtin_amdgcn_fence(__ATOMIC_ACQUIRE, "agent");
      asm volatile("s_waitcnt vmcnt(0)" ::: "memory");
    }
  }
  __syncthreads();
}

constexpr int NSLOTS = 13;
constexpr int NPHASE = 2 + 4 * NSLOTS;
__device__ __forceinline__ bool phase_is_nop(int ph) {
  if (ph < 2) return false;
  const int layer = (ph - 2) / NSLOTS, st = (ph - 2) % NSLOTS;
  return !(layer & 1) && (st == 1 || (st >= 3 && st <= 7));
}
__device__ void run_phase(KP p, int ph, char* sm) {
  if (ph == 0) { ph_init(p, sm); return; }
  if (ph == 1) { ph_mod_h(p, sm); return; }
  const int layer = (ph - 2) / NSLOTS, st = (ph - 2) % NSLOTS;
  const bool odd = layer & 1;
  const bool keep = layer < 3;
  int gk = -1;
  if (st == 0) gk = 0;
  else if (st == 8) gk = 1;
  else if (st == 10) gk = 2;
  else if (st == 11) gk = 3;
  else if (odd && st == 2) gk = 4;
  else if (odd && st == 3) gk = 5;
  asm volatile("" : "+s"(gk));
  if (gk >= 0) { ph_gemm(p, gk, layer, keep, sm); return; }
  switch (st) {
    case 1: if (odd) ph_rwkv_mix(p, layer); break;
    case 2: ph_attention(p, layer, keep, sm); break;
    case 4: if (odd) ph_scan_a(p, layer, sm); break;
    case 5: if (odd) ph_mlstm_s2(p, sm); break;
    case 6: if (odd) ph_mlstm_s3(p, layer, sm); break;
    case 7: if (odd) ph_rec_final(p, layer, keep); break;
    case 9: ph_ln_router(p, layer, keep, sm); break;
    case 12: ph_final_ln(p, layer, keep, sm); break;
  }
}

__global__ void __launch_bounds__(NTHR, 2) mega_kernel(Params kargs) {
  extern __shared__ __attribute__((aligned(16))) char sm[];
  cg::grid_group grid = cg::this_grid();
  volatile LAS unsigned* st = (volatile LAS unsigned*)(sm + META_OFF + 4032);
  if (threadIdx.x == 0) { st[0] = 0u; st[1] = 0u; }
  __syncthreads();
  const XcdBarrier xb = xcd_barrier_post(kargs.bar, st);
  for (int ph = kargs.ph_lo; ph < kargs.ph_hi; ++ph) {
    if (phase_is_nop(ph)) continue;
    {
      KP kp = (KP)__builtin_amdgcn_kernarg_segment_ptr();
      asm volatile("" : "+s"(kp));
      run_phase(kp, ph, sm);
    }
    if (ph + 1 < kargs.ph_hi) {
      if (ph == 0) grid.sync();
      else xcd_barrier(xb);
    }
  }
}

extern "C" void kernel_launch(void* const* d_in, const int* in_sizes, int n_in, void* d_out, int out_size, void* d_ws,
                              size_t ws_size, hipStream_t stream) {
  static int grid_blocks = 0;
  if (!grid_blocks) {
    int dev = 0, cus = 0, per_cu = 0;
    (void)hipGetDevice(&dev);
    (void)hipDeviceGetAttribute(&cus, hipDeviceAttributeMultiprocessorCount, dev);
    (void)hipFuncSetAttribute((const void*)mega_kernel, hipFuncAttributeMaxDynamicSharedMemorySize, SMEM_BYTES);
    (void)hipOccupancyMaxActiveBlocksPerMultiprocessor(&per_cu, mega_kernel, NTHR, SMEM_BYTES);
    if (per_cu < 1) per_cu = 1;
    if (per_cu > 2) per_cu = 2;
    grid_blocks = cus * per_cu;
  }
  Params p;
  memset(&p, 0, sizeof(p));
  const float** pin = (const float**)&p;
  for (int i = 0; i < 35; ++i) pin[i] = (const float*)d_in[i];
  p.out = (float*)d_out;
  char* w = (char*)d_ws;
  size_t off = 0;
  auto take = [&](size_t bytes) { char* r = w + off; off += (bytes + 255) & ~(size_t)255; return r; };
  p.Wt_att = (bf16_t*)take((size_t)2 * ATT_N * 1024 * 2);
  p.Wt_rec = (bf16_t*)take((size_t)2 * REC_NP * 1024 * 2);
  p.Wt_out = (bf16_t*)take((size_t)4 * 1024 * 1024 * 2);
  p.Wt13 = (bf16_t*)take((size_t)4 * 65 * 512 * 1024 * 2);
  p.Wt2 = (bf16_t*)take((size_t)4 * 65 * 1024 * 256 * 2);
  p.Wl1 = (bf16_t*)take((size_t)2 * 3 * 128 * 512 * 2);
  p.Wl2 = (bf16_t*)take((size_t)2 * 2560 * 128 * 2);
  p.X = (float*)take((size_t)NT * DM * 4);
  p.AB = (bf16_t*)take((size_t)NT * DM * 2);
  p.MOD = (float*)take((size_t)5 * 9 * 6144 * 4);
  p.MODP = (float*)take((size_t)8 * 4 * 9 * 6144 * 4);
  p.GP = (float*)take((size_t)NT * 16 * 4);
  p.ROPE = (float*)take((size_t)64 * 16 * 2 * 4);
  p.msc = (float*)take((size_t)3 * NMT * 4);
  p.lgate = (float*)take((size_t)64 * NT * 4);
  p.ltok = (int*)take((size_t)64 * NT * 4);
  p.tsl = (int*)take((size_t)NT * 6 * 4);
  p.cnt = (int*)take(512);
  p.bar = (unsigned*)take((size_t)BAR_TOTAL_WORDS * 4);
  char* region = take(0);
  const size_t szP = (size_t)NT * LDP * 2, szRW = (size_t)NT * RWS * 2, szMS = (size_t)NMT * 16384 * 2,
               szMSn = (size_t)NMT * 128 * 4;
  const size_t szT = (size_t)NT * DM * 4, szOUT2 = (size_t)NSLOT * 1024 * 2;
  p.P = (bf16_t*)region;
  p.RW = (bf16_t*)(region + szP);
  p.MS = (bf16_t*)(region + szP + szRW);
  p.MSn = (float*)(region + szP + szRW + szMS);
  p.Zb = p.MS;
  p.L1 = p.MS + (size_t)NT * 1536;
  p.Tb = (float*)region;
  p.ACT = (bf16_t*)region;
  p.OUT2 = (bf16_t*)(region + szT);
  size_t mixer = szP + szRW + szMS + szMSn, moe = szT + szOUT2;
  off += (mixer > moe ? mixer : moe);
  if (off > ws_size) { fprintf(stderr, "workspace too small: need %zu have %zu\n", off, ws_size); return; }
  p.ph_lo = 0;
  p.ph_hi = NPHASE;
  (void)hipMemsetAsync(p.bar, 0, (size_t)BAR_TOTAL_WORDS * 4, stream);
  void* args[] = {&p};
  hipError_t e = hipLaunchCooperativeKernel((void*)mega_kernel, dim3(grid_blocks), dim3(NTHR), args, SMEM_BYTES, stream);
  if (e != hipSuccess) fprintf(stderr, "cooperative launch failed: %s (grid %d)\n", hipGetErrorString(e), grid_blocks);
}
```

```cpp
#include <hip/hip_runtime.h>
#include <hip/hip_cooperative_groups.h>
#include <cstdio>
#include <cstring>
namespace cg = cooperative_groups;

constexpr int DM = 1024;
constexpr int NBATCH = 8;
constexpr int SEQ = 2048;
constexpr int CTXL = 256;
constexpr int NL = NBATCH * SEQ;
constexpr int NC = NBATCH * CTXL;
constexpr int NT = NL + NC;
constexpr int TSC = CTXL + SEQ;
constexpr int LDP = 4112;
constexpr int ATT_N = 2304;
constexpr int REC_N = 4112;
constexpr int REC_NP = 4224;
constexpr int NCHUNK = 36;
constexpr int NMT = 64 * NCHUNK;
constexpr int RWS = 5632;
constexpr int NSLOT = 137216;
constexpr float DN_ALPHA = 1.6817928305074290f;
constexpr int NTHR = 256;
constexpr int SMEM_BYTES = 65536 + 4096;
constexpr int META_OFF = 65536;
#define XCD_BAR_WORDS 3456
constexpr int BAR_TOTAL_WORDS = XCD_BAR_WORDS + 64;

typedef unsigned short bf16_t;
using bf16x8 = __attribute__((ext_vector_type(8))) short;
using f32x16 = __attribute__((ext_vector_type(16))) float;
using u32x4 = __attribute__((ext_vector_type(4))) unsigned;
using u32x2 = __attribute__((ext_vector_type(2))) unsigned;

struct Params {
  const float *x, *c, *ctx, *c_ctx, *ada_w, *ada_b, *ln_g, *ln_b, *mix_w_out, *att_w_in, *na_rpb, *qk_gain,
      *rec_w_in, *rwkv_mu, *rwkv_w0, *rwkv_w1, *rwkv_w2, *rwkv_a0, *rwkv_a1, *rwkv_a2, *rwkv_g1, *rwkv_g2,
      *rwkv_kvec, *rwkv_rk, *rwkv_gn, *mlstm_gate_b, *mlstm_norm, *moe_router, *moe_bias, *moe_w1, *moe_w3,
      *moe_w2, *shared_w1, *shared_w3, *shared_w2;
  float* out;
  bf16_t *Wt_att, *Wt_rec, *Wt_out, *Wt13, *Wt2, *Wl1, *Wl2;
  bf16_t *Zb, *L1;
  float *X, *MOD, *MODP, *GP, *msc, *lgate, *MSn, *Tb, *ROPE;
  bf16_t *AB, *P, *RW, *MS, *ACT, *OUT2;
  int *cnt, *ltok, *tsl;
  unsigned* bar;
  int ph_lo, ph_hi;
};

typedef const Params __attribute__((address_space(4))) * KP;

__device__ __forceinline__ int modrow(int t) { return t < NL ? (t >> 11) : 8; }
__device__ __forceinline__ float silu_f(float x) { return x / (1.f + expf(-x)); }
__device__ __forceinline__ float sigm_f(float x) { return 1.f / (1.f + expf(-x)); }
__device__ __forceinline__ float softplus_f(float x) { return fmaxf(x, 0.f) + log1pf(expf(-fabsf(x))); }
template <int CTRL>
__device__ __forceinline__ float dppx(float x) {
  return __int_as_float(__builtin_amdgcn_update_dpp(0, __float_as_int(x), CTRL, 0xf, 0xf, true));
}
__device__ __forceinline__ float rdlane(float v, int l) {
  return __int_as_float(__builtin_amdgcn_readlane(__float_as_int(v), l));
}
__device__ __forceinline__ float wsum(float v) {
  v += dppx<0xB1>(v); v += dppx<0x4E>(v); v += dppx<0x141>(v); v += dppx<0x140>(v);
  return (rdlane(v, 0) + rdlane(v, 16)) + (rdlane(v, 32) + rdlane(v, 48));
}
__device__ __forceinline__ float wmax(float v) {
  v = fmaxf(v, dppx<0xB1>(v)); v = fmaxf(v, dppx<0x4E>(v)); v = fmaxf(v, dppx<0x141>(v)); v = fmaxf(v, dppx<0x140>(v));
  return fmaxf(fmaxf(rdlane(v, 0), rdlane(v, 16)), fmaxf(rdlane(v, 32), rdlane(v, 48)));
}
__device__ __forceinline__ int opaque_tid() {
  int t = threadIdx.x;
  asm volatile("" : "+v"(t));
  return t;
}
typedef __bf16 bf16x2_t __attribute__((ext_vector_type(2)));
typedef float f32x2_t __attribute__((ext_vector_type(2)));
__device__ __forceinline__ unsigned pk_bf16(float lo, float hi) {
  const f32x2_t v = {lo, hi};
  return __builtin_bit_cast(unsigned, __builtin_convertvector(v, bf16x2_t));
}
__device__ __forceinline__ bf16_t f2bf(float x) { return (bf16_t)(pk_bf16(x, 0.f) & 0xffffu); }
__device__ __forceinline__ float bf2f(bf16_t v) { return __uint_as_float((unsigned)v << 16); }
__device__ __forceinline__ float bflo(unsigned u) { return __uint_as_float(u << 16); }
__device__ __forceinline__ float bfhi(unsigned u) { return __uint_as_float(u & 0xffff0000u); }
__device__ __forceinline__ int scan_row(int dir, int b, int tau) {
  if (tau < CTXL) return NL + b * CTXL + (dir ? (CTXL - 1 - tau) : tau);
  int s = tau - CTXL;
  return b * SEQ + (dir ? (SEQ - 1 - s) : s);
}

template <class RowPtrA>
__device__ __forceinline__ void gemm128_main(int tid, RowPtrA rowA, const bf16_t* __restrict__ Bt, int K, int n0,
                                             char* lds, f32x16 (&acc)[2][2]) {
  const int lane = tid & 63, w = tid >> 6;
  const int wm = w >> 1, wn = w & 1, r = lane & 31, h = lane >> 5;
  const int c = tid & 7, sr = tid >> 3;
  const int lc = (c ^ ((tid >> 4) & 7)) * 8;
  const bf16_t* ap[4];
#pragma unroll
  for (int i = 0; i < 4; ++i) ap[i] = rowA(sr + 32 * i) + lc;
  const bf16_t* bp0 = Bt + (size_t)(n0 + sr) * K + lc;
  const int bstr = 32 * K;
#pragma unroll
  for (int mi = 0; mi < 2; ++mi)
#pragma unroll
    for (int ni = 0; ni < 2; ++ni)
#pragma unroll
      for (int q = 0; q < 16; ++q) acc[mi][ni][q] = 0.f;
  const int nk = K >> 6;
  auto issue = [&](int kt) {
    char* As = lds + (kt & 1) * 32768 + tid * 16;
    const int k0 = kt * 64;
#pragma unroll
    for (int i = 0; i < 4; ++i) {
      __builtin_amdgcn_global_load_lds((const unsigned*)(ap[i] + k0), (__attribute__((address_space(3))) unsigned*)(As + i * 4096), 16, 0, 0);
      __builtin_amdgcn_global_load_lds((const unsigned*)(bp0 + i * bstr + k0), (__attribute__((address_space(3))) unsigned*)(As + 16384 + i * 4096), 16, 0, 0);
    }
  };
  issue(0);
  const int sw = (r >> 1) & 7;
#pragma unroll 1
  for (int kt = 0; kt < nk; ++kt) {
    asm volatile("s_waitcnt vmcnt(0)" ::: "memory");
    __syncthreads();
    if (kt + 1 < nk) issue(kt + 1);
    const char* As = lds + (kt & 1) * 32768;
    const char* Ar = As + (wm * 64 + r) * 128;
    const char* Br = As + 16384 + (wn * 64 + r) * 128;
#pragma unroll
    for (int ks = 0; ks < 4; ++ks) {
      const int off = ((ks * 2 + h) ^ sw) * 16;
      const bf16x8 a0 = *(const bf16x8*)(Ar + off);
      const bf16x8 a1 = *(const bf16x8*)(Ar + 32 * 128 + off);
      const bf16x8 b0 = *(const bf16x8*)(Br + off);
      const bf16x8 b1 = *(const bf16x8*)(Br + 32 * 128 + off);
      acc[0][0] = __builtin_amdgcn_mfma_f32_32x32x16_bf16(a0, b0, acc[0][0], 0, 0, 0);
      acc[0][1] = __builtin_amdgcn_mfma_f32_32x32x16_bf16(a0, b1, acc[0][1], 0, 0, 0);
      acc[1][0] = __builtin_amdgcn_mfma_f32_32x32x16_bf16(a1, b0, acc[1][0], 0, 0, 0);
      acc[1][1] = __builtin_amdgcn_mfma_f32_32x32x16_bf16(a1, b1, acc[1][1], 0, 0, 0);
    }
  }
  __syncthreads();
}
using i64 = long;
template <class RowPtrA8>
__device__ __forceinline__ void gemm128_fp8(int tid, RowPtrA8 rowA, const unsigned char* __restrict__ Bt, int K, int n0,
                                            char* lds, f32x16 (&acc)[2][2]) {
  const int lane = tid & 63, w = tid >> 6;
  const int wm = w >> 1, wn = w & 1, r = lane & 31, h = lane >> 5;
  const int c = tid & 7, sr = tid >> 3;
  const int lc = (c ^ ((tid >> 4) & 7)) * 16;
  const unsigned char* ap[4];
#pragma unroll
  for (int i = 0; i < 4; ++i) ap[i] = rowA(sr + 32 * i) + lc;
  const unsigned char* bp0 = Bt + (size_t)(n0 + sr) * K + lc;
  const int bstr = 32 * K;
#pragma unroll
  for (int mi = 0; mi < 2; ++mi)
#pragma unroll
    for (int ni = 0; ni < 2; ++ni)
#pragma unroll
      for (int q = 0; q < 16; ++q) acc[mi][ni][q] = 0.f;
  const int nk = K >> 7;
  auto issue = [&](int kt) {
    char* As = lds + (kt & 1) * 32768 + tid * 16;
    const int k0 = kt * 128;
#pragma unroll
    for (int i = 0; i < 4; ++i) {
      __builtin_amdgcn_global_load_lds((const unsigned*)(ap[i] + k0), (__attribute__((address_space(3))) unsigned*)(As + i * 4096), 16, 0, 0);
      __builtin_amdgcn_global_load_lds((const unsigned*)(bp0 + i * bstr + k0), (__attribute__((address_space(3))) unsigned*)(As + 16384 + i * 4096), 16, 0, 0);
    }
  };
  issue(0);
  const int sw = (r >> 1) & 7;
#pragma unroll 1
  for (int kt = 0; kt < nk; ++kt) {
    asm volatile("s_waitcnt vmcnt(0)" ::: "memory");
    __syncthreads();
    if (kt + 1 < nk) issue(kt + 1);
    const char* As = lds + (kt & 1) * 32768;
    const char* Ar = As + (wm * 64 + r) * 128;
    const char* Br = As + 16384 + (wn * 64 + r) * 128;
#pragma unroll
    for (int q = 0; q < 4; ++q) {
      const int off = ((q * 2 + h) ^ sw) * 16;
      const u32x4 a0 = *(const u32x4*)(Ar + off);
      const u32x4 a1 = *(const u32x4*)(Ar + 32 * 128 + off);
      const u32x4 b0 = *(const u32x4*)(Br + off);
      const u32x4 b1 = *(const u32x4*)(Br + 32 * 128 + off);
      const i64 a0l = (i64)(((unsigned long long)a0.y << 32) | a0.x), a0h = (i64)(((unsigned long long)a0.w << 32) | a0.z);
      const i64 a1l = (i64)(((unsigned long long)a1.y << 32) | a1.x), a1h = (i64)(((unsigned long long)a1.w << 32) | a1.z);
      const i64 b0l = (i64)(((unsigned long long)b0.y << 32) | b0.x), b0h = (i64)(((unsigned long long)b0.w << 32) | b0.z);
      const i64 b1l = (i64)(((unsigned long long)b1.y << 32) | b1.x), b1h = (i64)(((unsigned long long)b1.w << 32) | b1.z);
      acc[0][0] = __builtin_amdgcn_mfma_f32_32x32x16_fp8_fp8(a0l, b0l, acc[0][0], 0, 0, 0);
      acc[0][1] = __builtin_amdgcn_mfma_f32_32x32x16_fp8_fp8(a0l, b1l, acc[0][1], 0, 0, 0);
      acc[1][0] = __builtin_amdgcn_mfma_f32_32x32x16_fp8_fp8(a1l, b0l, acc[1][0], 0, 0, 0);
      acc[1][1] = __builtin_amdgcn_mfma_f32_32x32x16_fp8_fp8(a1l, b1l, acc[1][1], 0, 0, 0);
      acc[0][0] = __builtin_amdgcn_mfma_f32_32x32x16_fp8_fp8(a0h, b0h, acc[0][0], 0, 0, 0);
      acc[0][1] = __builtin_amdgcn_mfma_f32_32x32x16_fp8_fp8(a0h, b1h, acc[0][1], 0, 0, 0);
      acc[1][0] = __builtin_amdgcn_mfma_f32_32x32x16_fp8_fp8(a1h, b0h, acc[1][0], 0, 0, 0);
      acc[1][1] = __builtin_amdgcn_mfma_f32_32x32x16_fp8_fp8(a1h, b1h, acc[1][1], 0, 0, 0);
    }
  }
  __syncthreads();
}
template <class F>
__device__ __forceinline__ void acc_foreach(int tid, const f32x16 (&acc)[2][2], F f) {
  const int lane = tid & 63, w = tid >> 6;
  const int wm = w >> 1, wn = w & 1, r = lane & 31, h = lane >> 5;
#pragma unroll
  for (int mi = 0; mi < 2; ++mi)
#pragma unroll
    for (int ni = 0; ni < 2; ++ni)
#pragma unroll
      for (int q = 0; q < 16; ++q) {
        const int row = wm * 64 + mi * 32 + (q & 3) + 8 * (q >> 2) + 4 * h;
        const int col = wn * 64 + ni * 32 + r;
        f(row, col, acc[mi][ni][q]);
        if ((q & 3) == 3) __builtin_amdgcn_sched_barrier(0);
      }
}

template <class RM>
__device__ __forceinline__ void tr_tile(int tid, const float* __restrict__ src, int N, int k0, int n0,
                                        bf16_t* __restrict__ dst, int K, RM rowmap, float* tile) {
  {
    const int tx = tid & 15, ty = tid >> 4;
    const int n = n0 + tx * 4;
#pragma unroll
    for (int i = 0; i < 4; ++i) {
      const int k = ty + 16 * i;
      float4 v = make_float4(0.f, 0.f, 0.f, 0.f);
      if (n < N) v = *(const float4*)(src + (size_t)(k0 + k) * N + n);
      tile[k * 65 + tx * 4 + 0] = v.x; tile[k * 65 + tx * 4 + 1] = v.y;
      tile[k * 65 + tx * 4 + 2] = v.z; tile[k * 65 + tx * 4 + 3] = v.w;
    }
  }
  __syncthreads();
  {
    const int kc = tid & 7;
#pragma unroll
    for (int i = 0; i < 2; ++i) {
      const int n = (tid >> 3) + 32 * i;
      if (n0 + n < N) {
        float v[8];
#pragma unroll
        for (int q = 0; q < 8; ++q) v[q] = tile[(kc * 8 + q) * 65 + n];
        u32x4 o;
        o.x = pk_bf16(v[0], v[1]); o.y = pk_bf16(v[2], v[3]); o.z = pk_bf16(v[4], v[5]); o.w = pk_bf16(v[6], v[7]);
        *(u32x4*)(dst + (size_t)rowmap(n0 + n) * K + k0 + kc * 8) = o;
      }
    }
  }
  __syncthreads();
}

constexpr float W8_SCALE = 32.f, W8_INV = 1.f / 32.f;
__device__ __forceinline__ unsigned pk_fp8x4(float a, float b, float c, float d) {
  int r = __builtin_amdgcn_cvt_pk_fp8_f32(a, b, 0, false);
  r = __builtin_amdgcn_cvt_pk_fp8_f32(c, d, r, true);
  return (unsigned)r;
}
template <class RM>
__device__ __forceinline__ void tr_tile_fp8(int tid, const float* __restrict__ src, int N, int k0, int n0,
                                            unsigned char* __restrict__ dst, int K, RM rowmap, float* tile) {
  {
    const int tx = tid & 15, ty = tid >> 4;
    const int n = n0 + tx * 4;
#pragma unroll
    for (int i = 0; i < 4; ++i) {
      const int k = ty + 16 * i;
      const float4 v = *(const float4*)(src + (size_t)(k0 + k) * N + n);
      tile[k * 65 + tx * 4 + 0] = v.x; tile[k * 65 + tx * 4 + 1] = v.y;
      tile[k * 65 + tx * 4 + 2] = v.z; tile[k * 65 + tx * 4 + 3] = v.w;
    }
  }
  __syncthreads();
  {
    const int kc = tid & 3, n = tid >> 2;
    float v[16];
#pragma unroll
    for (int q = 0; q < 16; ++q) v[q] = tile[(kc * 16 + q) * 65 + n] * W8_SCALE;
    u32x4 o;
    o.x = pk_fp8x4(v[0], v[1], v[2], v[3]); o.y = pk_fp8x4(v[4], v[5], v[6], v[7]);
    o.z = pk_fp8x4(v[8], v[9], v[10], v[11]); o.w = pk_fp8x4(v[12], v[13], v[14], v[15]);
    *(u32x4*)(dst + (size_t)rowmap(n0 + n) * K + k0 + kc * 16) = o;
  }
  __syncthreads();
}

constexpr int CJ0 = 1152, CJ1 = CJ0 + 2080, CJ2 = CJ1 + 1024, CJ3 = CJ2 + 33280, CJ4 = CJ3 + 16640;
__device__ void convert_job(KP p, int job, float* sm, int tid) {
  if (job < CJ0) {
    const int j = job / 576, rem = job % 576, kt = rem / 36, nt = rem % 36;
    tr_tile(tid, p->att_w_in + (size_t)j * 1024 * ATT_N, ATT_N, kt * 64, nt * 64, p->Wt_att + (size_t)j * ATT_N * 1024,
            1024, [](int n) { return n; }, sm);
  } else if (job < CJ1) {
    const int q = job - CJ0;
    const int j = q / 1040, rem = q % 1040, kt = rem / 65, nt = rem % 65;
    tr_tile(tid, p->rec_w_in + (size_t)j * 1024 * REC_N, REC_N, kt * 64, nt * 64, p->Wt_rec + (size_t)j * REC_NP * 1024,
            1024, [](int n) { return n; }, sm);
  } else if (job < CJ2) {
    const int q = job - CJ1;
    const int i = q >> 8, rem = q & 255, kt = rem >> 4, nt = rem & 15;
    tr_tile(tid, p->mix_w_out + (size_t)i * 1024 * 1024, 1024, kt * 64, nt * 64, p->Wt_out + (size_t)i * 1024 * 1024,
            1024, [](int n) { return n; }, sm);
  } else if (job < CJ3) {
    const int q = job - CJ2;
    const int le = q >> 7, rem = q & 127;
    const int which = rem >> 6, kt = (rem >> 2) & 15, nt = rem & 3;
    const int layer = le / 65, e = le % 65;
    const float* src;
    if (e < 64) src = (which ? p->moe_w3 : p->moe_w1) + (size_t)(layer * 64 + e) * 1024 * 256;
    else src = (which ? p->shared_w3 : p->shared_w1) + (size_t)layer * 1024 * 256;
    tr_tile_fp8(tid, src, 256, kt * 64, nt * 64, (unsigned char*)p->Wt13 + (size_t)le * 512 * 1024, 1024,
                [which](int n) { return 64 * (n >> 5) + which * 32 + (n & 31); }, sm);
  } else {
    const int q = job - CJ3;
    const int le = q >> 6, rem = q & 63;
    const int kt = rem >> 4, nt = rem & 15;
    const int layer = le / 65, e = le % 65;
    const float* src = e < 64 ? p->moe_w2 + (size_t)(layer * 64 + e) * 256 * 1024 : p->shared_w2 + (size_t)layer * 256 * 1024;
    tr_tile_fp8(tid, src, 1024, kt * 64, nt * 64, (unsigned char*)p->Wt2 + (size_t)le * 1024 * 256, 256, [](int n) { return n; }, sm);
  }
}
__device__ __forceinline__ int conv_stage_total(int stage) {
  return stage == 0 ? (576 + 1040 + 512 + 8320 + 4160) : (stage == 1 ? (576 + 1040 + 256 + 16640 + 8320) : (256 + 8320 + 4160));
}
__device__ __forceinline__ int conv_stage_job(int stage, int q) {
  if (stage == 0) {
    if (q < 8320) return CJ2 + q;  q -= 8320;
    if (q < 4160) return CJ3 + q;  q -= 4160;
    if (q < 576) return q;  q -= 576;
    if (q < 1040) return CJ0 + q;  q -= 1040;
    return CJ1 + q;
  } else if (stage == 1) {
    if (q < 8320) return CJ2 + 8320 + q;  q -= 8320;
    if (q < 4160) return CJ3 + 4160 + q;  q -= 4160;
    if (q < 576) return 576 + q;  q -= 576;
    if (q < 256) return CJ1 + 512 + q;  q -= 256;
    if (q < 8320) return CJ2 + 16640 + q;  q -= 8320;
    if (q < 4160) return CJ3 + 8320 + q;  q -= 4160;
    return CJ0 + 1040 + q;
  }
  if (q < 256) return CJ1 + 768 + q;  q -= 256;
  if (q < 8320) return CJ2 + 24960 + q;  q -= 8320;
  return CJ3 + 12480 + q;
}

__device__ void ph_init(KP p, char* smc) {
  float* sm = (float*)smc;
  const int tid = opaque_tid();
  {
    const size_t n4a = (size_t)NL * DM / 4, n4b = (size_t)NC * DM / 4;
    const float4* xs = (const float4*)p->x;
    const float4* cs = (const float4*)p->ctx;
    float4* X4 = (float4*)p->X;
    for (size_t i = (size_t)blockIdx.x * NTHR + tid; i < n4a + n4b; i += (size_t)gridDim.x * NTHR)
      X4[i] = i < n4a ? xs[i] : cs[i - n4a];
  }
  for (int tile = blockIdx.x; tile < 96 * 8; tile += gridDim.x) {
    const int ct = tile >> 3, ks = tile & 7;
    for (int i = tid; i < 9 * 128; i += NTHR) {
      const int r = i >> 7, k = ks * 128 + (i & 127);
      const float v = r < 8 ? p->c[r * 1024 + k] : p->c_ctx[k];
      sm[i] = silu_f(v);
    }
    __syncthreads();
    const int col = ct * 256 + tid;
    const int layer = col / 6144, n = col % 6144;
    const float* W = p->ada_w + ((size_t)layer * 1024 + ks * 128) * 6144 + n;
    float acc[9];
#pragma unroll
    for (int r = 0; r < 9; ++r) acc[r] = 0.f;
#pragma unroll 4
    for (int k = 0; k < 128; ++k) {
      const float w = W[(size_t)k * 6144];
#pragma unroll
      for (int r = 0; r < 9; ++r) acc[r] = fmaf(sm[r * 128 + k], w, acc[r]);
    }
#pragma unroll
    for (int r = 0; r < 9; ++r) p->MODP[((size_t)(ks * 4 + layer) * 9 + r) * 6144 + n] = acc[r];
    __syncthreads();
  }
  for (int q = blockIdx.x; q < conv_stage_total(0); q += gridDim.x) convert_job(p, conv_stage_job(0, q), sm, tid);
  for (int i = blockIdx.x * NTHR + tid; i < 2 * 3 * 128 * 512; i += gridDim.x * NTHR) {
    const int k = i & 511, n = (i >> 9) & 127, wj = i >> 16;
    const int j = wj / 3, which = wj % 3;
    float v = 0.f;
    if (which < 2) {
      if (n < 64) v = (which ? p->rwkv_a1 : p->rwkv_w1)[((size_t)(j * 2 + (n >> 5)) * 512 + k) * 32 + (n & 31)];
    } else if (n < 96) v = p->rwkv_g1[((size_t)j * 512 + k) * 96 + n];
    p->Wl1[i] = f2bf(v);
  }
  for (int i = blockIdx.x * NTHR + tid; i < 2 * 2560 * 128; i += gridDim.x * NTHR) {
    const int k = i & 127, n = (i >> 7) % 2560, j = i / (2560 * 128);
    float v = 0.f;
    if (n < 2048) {
      const int d = (n >> 9) & 1, c = n & 511;
      if (k < 64 && (k >> 5) == d) v = (n < 1024 ? p->rwkv_w2 : p->rwkv_a2)[((size_t)(j * 2 + d) * 32 + (k & 31)) * 512 + c];
    } else if (k < 96) v = p->rwkv_g2[((size_t)j * 96 + k) * 512 + (n - 2048)];
    p->Wl2[i] = f2bf(v);
  }
  for (int i = blockIdx.x * NTHR + tid; i < 64 * 16; i += gridDim.x * NTHR) {
    const int pos = i >> 4, f = i & 15;
    const float ang = (float)pos * powf(10000.f, -(float)f / 16.f);
    p->ROPE[2 * i] = cosf(ang);
    p->ROPE[2 * i + 1] = sinf(ang);
  }
}

__device__ void ph_mod_h(KP p, char* smc) {
  float* sm = (float*)smc;
  const int tid = opaque_tid();
  for (int i = blockIdx.x * NTHR + tid; i < 4 * 9 * 6144; i += gridDim.x * NTHR) {
    const int layer = i / (9 * 6144), rem = i % (9 * 6144), n = rem % 6144;
    float s = p->ada_b[layer * 6144 + n];
#pragma unroll
    for (int ks = 0; ks < 8; ++ks) s += p->MODP[(size_t)(ks * 4 + layer) * 9 * 6144 + rem];
    p->MOD[i] = s;
  }
  const int lane = tid & 63, wave = tid >> 6;
  const int per = (((NT + gridDim.x - 1) / gridDim.x) + 3) & ~3;
  const int t0 = blockIdx.x * per, t1 = min(NT, t0 + per);
  int cur = -1;
  for (int tb = t0; tb < t1; tb += 4) {
    const int mr = modrow(tb);
    if (mr != cur) {
      __syncthreads();
      for (int n = tid; n < 2048; n += NTHR) {
        float a = p->ada_b[n];
#pragma unroll
        for (int ks = 0; ks < 8; ++ks) a += p->MODP[((size_t)(ks * 4) * 9 + mr) * 6144 + n];
        sm[n] = a;
      }
      cur = mr;
      __syncthreads();
    }
    const int t = tb + wave;
    if (t < t1) {
      const float* src = t < NL ? p->x + (size_t)t * DM : p->ctx + (size_t)(t - NL) * DM;
#pragma unroll
      for (int i = 0; i < 4; ++i) {
        const int n = i * 256 + lane * 4;
        const float4 xv = *(const float4*)(src + n);
        const float4 sh = *(const float4*)(sm + n);
        const float4 sc = *(const float4*)(sm + 1024 + n);
        u32x2 o;
        o.x = pk_bf16(xv.x * (1.f + sc.x) + sh.x, xv.y * (1.f + sc.y) + sh.y);
        o.y = pk_bf16(xv.z * (1.f + sc.z) + sh.z, xv.w * (1.f + sc.w) + sh.w);
        *(u32x2*)(p->AB + (size_t)t * DM + n) = o;
      }
    }
  }
}

typedef short v4i16_t __attribute__((ext_vector_type(4)));
using s16x4 = __attribute__((ext_vector_type(4))) short;
__device__ __forceinline__ s16x4 vtr(const char* p) {
  return __builtin_bit_cast(s16x4, __builtin_amdgcn_ds_read_tr16_b64_v4i16((__attribute__((address_space(3))) v4i16_t*)p));
}
#define MFMA32(a, b, c) __builtin_amdgcn_mfma_f32_32x32x16_bf16(a, b, c, 0, 0, 0)
__device__ void ph_attention(KP p, int layer, bool keep, char* lds) {
  const int tid = opaque_tid();
  const int lane = tid & 63, w = tid >> 6, r32 = lane & 31, hi = lane >> 5;
  const int j = layer >> 1;
  float* bias_lds = (float*)(lds + 32768 + 1024);
  const int n_gqa = 1024, n_na = 1024, n_cb = keep ? 128 : 0, n_ca = keep ? 128 : 0;
  const int total = n_gqa + n_na + n_cb + n_ca;
  constexpr float LOG2E = 1.4426950408889634f;
  constexpr float C2 = 0.125f * LOG2E;
  const int c = tid & 7, sr = tid >> 3;
  const int kso = (c ^ ((tid >> 4) & 7)) * 16;
  const int vso = (c >> 2) * 4096 + (c & 3) * 16;
  const int sw = (r32 >> 1) & 7;
  for (int item = blockIdx.x; item < total; item += gridDim.x) {
    int b, qrow0, qoff, koff, voff, ocol, lat_tiles, lat_row0;
    bool na = false;
    int r_w = 0, start_w = 0, ru0 = 0, hN = 0;
    if (item < n_gqa) {
      b = item >> 7;
      const int g = (item >> 6) & 1, tt = item & 63;
      qrow0 = b * SEQ + tt * 32; qoff = 1536 + (g * 4 + w) * 64; koff = 2048 + g * 64; voff = 2176 + g * 64;
      ocol = 512 + (g * 4 + w) * 64; lat_tiles = 32; lat_row0 = b * SEQ;
    } else if (item < n_gqa + n_na) {
      const int it = item - n_gqa;
      b = it >> 7; hN = (it >> 4) & 7;
      const int rp = it & 15;
      na = true; r_w = 2 * rp + (w >> 1);
      qrow0 = b * SEQ + r_w * 64 + (w & 1) * 32; qoff = hN * 64; koff = 512 + hN * 64; voff = 1024 + hN * 64; ocol = hN * 64;
      const int s0 = min(max(2 * rp - 4, 0), 24), s1 = min(max(2 * rp - 3, 0), 24);
      start_w = (w >> 1) ? s1 : s0; ru0 = s0; lat_tiles = (s1 != s0) ? 9 : 8; lat_row0 = b * SEQ + ru0 * 64;
    } else if (item < n_gqa + n_na + n_cb) {
      const int it = item - n_gqa - n_na;
      b = it >> 4;
      const int g = (it >> 3) & 1, tt = it & 7;
      qrow0 = NL + b * CTXL + tt * 32; qoff = 1536 + (g * 4 + w) * 64; koff = 2048 + g * 64; voff = 2176 + g * 64;
      ocol = 512 + (g * 4 + w) * 64; lat_tiles = 0; lat_row0 = 0;
    } else {
      const int it = item - n_gqa - n_na - n_cb;
      b = it >> 4;
      const int h = (it >> 1) & 7, half = it & 1;
      qrow0 = NL + b * CTXL + half * 128 + w * 32; qoff = h * 64; koff = 512 + h * 64; voff = 1024 + h * 64; ocol = h * 64;
      lat_tiles = 0; lat_row0 = 0;
    }
    const int ctx_row0 = NL + b * CTXL, ntiles = lat_tiles + 4;
    if (na)
      for (int i = tid; i < 465; i += NTHR) bias_lds[i] = p->na_rpb[(j * 8 + hN) * 465 + i] * LOG2E;
    bf16x8 qf[4];
    {
      const bf16_t* qp = p->P + (size_t)(qrow0 + r32) * LDP + qoff + hi * 8;
#pragma unroll
      for (int d0 = 0; d0 < 4; ++d0) qf[d0] = *(const bf16x8*)(qp + d0 * 16);
    }
    f32x16 o0, o1;
#pragma unroll
    for (int q = 0; q < 16; ++q) { o0[q] = 0.f; o1[q] = 0.f; }
    float m = -INFINITY, l = 0.f;
    u32x4 kr0, kr1, vr0, vr1;
    auto gload = [&](int t) {
      const int row0 = t < lat_tiles ? lat_row0 + 64 * t : ctx_row0 + 64 * (t - lat_tiles);
      const bf16_t* base = p->P + (size_t)(row0 + sr) * LDP + c * 8;
      kr0 = *(const u32x4*)(base + koff); kr1 = *(const u32x4*)(base + (size_t)32 * LDP + koff);
      vr0 = *(const u32x4*)(base + voff); vr1 = *(const u32x4*)(base + (size_t)32 * LDP + voff);
    };
    auto swrite = [&](int buf) {
      char* Kb = lds + buf * 16384;
      char* Vb = Kb + 8192;
      *(u32x4*)(Kb + sr * 128 + kso) = kr0; *(u32x4*)(Kb + (sr + 32) * 128 + kso) = kr1;
      *(u32x4*)(Vb + vso + sr * 64) = vr0; *(u32x4*)(Vb + vso + (sr + 32) * 64) = vr1;
    };
    gload(0);
    swrite(0);
    for (int t = 0; t < ntiles; ++t) {
      __syncthreads();
      if (t + 1 < ntiles) gload(t + 1);
      const bool na_tile = na && t < lat_tiles;
      const int kr = ru0 + t;
      const bool part = !na_tile || (kr >= start_w && kr < start_w + 8);
      if (part) {
        const char* Ks = lds + (t & 1) * 16384;
        const char* Vs = Ks + 8192;
        f32x16 s0, s1;
#pragma unroll
        for (int q = 0; q < 16; ++q) { s0[q] = 0.f; s1[q] = 0.f; }
#pragma unroll
        for (int d0 = 0; d0 < 4; ++d0) {
          const int off = ((2 * d0 + hi) ^ sw) * 16;
          const bf16x8 k0 = *(const bf16x8*)(Ks + r32 * 128 + off);
          const bf16x8 k1 = *(const bf16x8*)(Ks + (32 + r32) * 128 + off);
          s0 = MFMA32(k0, qf[d0], s0);
          s1 = MFMA32(k1, qf[d0], s1);
        }
        float mx = -INFINITY;
        if (na_tile) {
          const int cq = (w & 1) * 32 + r32;
          const int c0 = min(max(cq - 8, 0), 48);
          const float* brow = bias_lds + (kr - r_w + 7) * 31 + (15 - cq);
#pragma unroll
          for (int q = 0; q < 16; ++q) {
            const int kc = (q & 3) + 8 * (q >> 2) + 4 * hi;
            const float v0 = ((unsigned)(kc - c0) < 16u) ? fmaf(s0[q], C2, brow[kc]) : -INFINITY;
            const float v1 = ((unsigned)(kc + 32 - c0) < 16u) ? fmaf(s1[q], C2, brow[kc + 32]) : -INFINITY;
            s0[q] = v0; s1[q] = v1;
            mx = fmaxf(mx, fmaxf(v0, v1));
          }
        } else {
#pragma unroll
          for (int q = 0; q < 16; ++q) {
            s0[q] *= C2; s1[q] *= C2;
            mx = fmaxf(mx, fmaxf(s0[q], s1[q]));
          }
        }
        {
          auto rr = __builtin_amdgcn_permlane32_swap(__float_as_uint(mx), __float_as_uint(mx), false, false);
          mx = fmaxf(__uint_as_float(rr[0]), __uint_as_float(rr[1]));
        }
        const float mnew = fmaxf(m, mx);
        const float alpha = __builtin_amdgcn_exp2f(m - mnew);
        float ls = 0.f;
#pragma unroll
        for (int q = 0; q < 16; ++q) {
          s0[q] = __builtin_amdgcn_exp2f(s0[q] - mnew);
          s1[q] = __builtin_amdgcn_exp2f(s1[q] - mnew);
          ls += s0[q] + s1[q];
        }
        l = l * alpha + ls;
        m = mnew;
#pragma unroll
        for (int q = 0; q < 16; ++q) { o0[q] *= alpha; o1[q] *= alpha; }
        bf16x8 pf[4];
#pragma unroll
        for (int s = 0; s < 4; ++s) {
          const int u = (s & 1) * 8;
          u32x4 tpk;
          if (s < 2) {
            tpk.x = pk_bf16(s0[u + 0], s0[u + 1]); tpk.y = pk_bf16(s0[u + 2], s0[u + 3]);
            tpk.z = pk_bf16(s0[u + 4], s0[u + 5]); tpk.w = pk_bf16(s0[u + 6], s0[u + 7]);
          } else {
            tpk.x = pk_bf16(s1[u + 0], s1[u + 1]); tpk.y = pk_bf16(s1[u + 2], s1[u + 3]);
            tpk.z = pk_bf16(s1[u + 4], s1[u + 5]); tpk.w = pk_bf16(s1[u + 6], s1[u + 7]);
          }
          pf[s] = __builtin_bit_cast(bf16x8, tpk);
        }
        const char* vb = Vs + ((lane >> 4) & 1) * 32 + (lane & 3) * 8 + ((lane & 15) >> 2) * 64 + hi * 256;
#pragma unroll
        for (int s = 0; s < 4; ++s) {
          const s16x4 a00 = vtr(vb + (16 * s) * 64), a01 = vtr(vb + (16 * s + 8) * 64);
          const s16x4 a10 = vtr(vb + 4096 + (16 * s) * 64), a11 = vtr(vb + 4096 + (16 * s + 8) * 64);
          const bf16x8 A0 = __builtin_shufflevector(a00, a01, 0, 1, 2, 3, 4, 5, 6, 7);
          const bf16x8 A1 = __builtin_shufflevector(a10, a11, 0, 1, 2, 3, 4, 5, 6, 7);
          o0 = MFMA32(A0, pf[s], o0);
          o1 = MFMA32(A1, pf[s], o1);
        }
      }
      if (t + 1 < ntiles) swrite((t + 1) & 1);
    }
    __syncthreads();
    const float lt = l + __shfl_xor(l, 32);
    const float inv = 1.f / lt;
    bf16_t* op = p->AB + (size_t)(qrow0 + r32) * DM + ocol + 4 * hi;
#pragma unroll
    for (int g = 0; g < 4; ++g) {
      u32x2 v0, v1;
      v0.x = pk_bf16(o0[4 * g] * inv, o0[4 * g + 1] * inv); v0.y = pk_bf16(o0[4 * g + 2] * inv, o0[4 * g + 3] * inv);
      v1.x = pk_bf16(o1[4 * g] * inv, o1[4 * g + 1] * inv); v1.y = pk_bf16(o1[4 * g + 2] * inv, o1[4 * g + 3] * inv);
      *(u32x2*)(op + 8 * g) = v0;
      *(u32x2*)(op + 32 + 8 * g) = v1;
    }
  }
}

__device__ void ph_rwkv_mix(KP p, int layer) {
  const int j = layer >> 1;
  const int tid = opaque_tid();
  const int lane = tid & 63, wave = tid >> 6;
  const float* mu = p->rwkv_mu + j * 6 * 512;
  const int c0 = lane * 8;
  auto unpack = [](const u32x4 u, float (&f)[8]) {
    f[0] = bflo(u.x); f[1] = bfhi(u.x); f[2] = bflo(u.y); f[3] = bfhi(u.y);
    f[4] = bflo(u.z); f[5] = bfhi(u.z); f[6] = bflo(u.w); f[7] = bfhi(u.w);
  };
  auto pack = [](const float (&f)[8]) {
    u32x4 o;
    o.x = pk_bf16(f[0], f[1]); o.y = pk_bf16(f[2], f[3]); o.z = pk_bf16(f[4], f[5]); o.w = pk_bf16(f[6], f[7]);
    return o;
  };
  for (int t = blockIdx.x * 4 + wave; t < NT; t += gridDim.x * 4) {
    bool hasp, hasn;
    if (t < NL) { int s = t & 2047; hasp = s > 0; hasn = s < SEQ - 1; }
    else { int s = (t - NL) & 255; hasp = s > 0; hasn = s < CTXL - 1; }
    const bf16_t* pt = p->P + (size_t)t * LDP + c0;
    bf16_t* rw = p->RW + (size_t)t * RWS + c0;
    bf16_t* zb = p->Zb + (size_t)t * 1536 + c0;
    const u32x4 zero = {0u, 0u, 0u, 0u};
#pragma unroll
    for (int q = 0; q < 4; ++q) {
      float cur[8], pv[8], nx[8], d[8];
      unpack(*(const u32x4*)(pt + q * 512), cur);
      unpack(hasp ? *(const u32x4*)(pt + q * 512 - LDP) : zero, pv);
      unpack(hasn ? *(const u32x4*)(pt + q * 512 + LDP) : zero, nx);
#pragma unroll
      for (int e = 0; e < 8; ++e) d[e] = 0.5f * (pv[e] + nx[e]) - cur[e];
      if (q < 3) {
        float o[8];
        const float* m = mu + q * 512 + c0;
#pragma unroll
        for (int e = 0; e < 8; ++e) o[e] = cur[e] + d[e] * m[e];
        if (q == 0) *(u32x4*)(rw) = pack(o);
        else if (q == 2) *(u32x4*)(rw + 512) = pack(o);
        else {
          *(u32x4*)(rw + 10 * 512) = pack(o);
          float kk[8], ss = 0.f;
          const float* kv0 = p->rwkv_kvec + (j * 2 + 0) * 512 + c0;
#pragma unroll
          for (int e = 0; e < 8; ++e) { kk[e] = o[e] * kv0[e]; ss += kk[e] * kk[e]; }
          ss += dppx<0xB1>(ss); ss += dppx<0x4E>(ss); ss += dppx<0x141>(ss);
          const float rn = rsqrtf(fmaxf(ss, 1e-24f));
#pragma unroll
          for (int e = 0; e < 8; ++e) kk[e] *= rn;
          *(u32x4*)(rw + 2 * 512) = pack(kk);
        }
      } else {
#pragma unroll
        for (int z = 0; z < 3; ++z) {
          float o[8];
          const float* m = mu + (3 + z) * 512 + c0;
#pragma unroll
          for (int e = 0; e < 8; ++e) o[e] = cur[e] + d[e] * m[e];
          *(u32x4*)(zb + z * 512) = pack(o);
        }
      }
    }
  }
}

constexpr int RS_STEP = 384;
constexpr int RS_TB = 16;
struct RwkvStage { u32x2 r, kk, e, ke, a, v; };
__device__ void rwkv_unit(KP p, int unit, float* sm, int tid) {
  const int ch = unit >> 1, hf = unit & 1;
  const int dir = ch >> 6, b = (ch >> 3) & 7, h = ch & 7;
  const int lane = tid & 63, w = tid >> 6, rl = lane >> 3, ks = lane & 7;
  float* ybuf = sm + 2 * RS_TB * RS_STEP;
  const int ss = tid >> 4, kq = tid & 15;
  auto gload = [&](int n, RwkvStage& g) {
    const int row = scan_row(dir, b, n * RS_TB + ss);
    const bf16_t* base = p->RW + (size_t)row * RWS + h * 64 + kq * 4;
    g.r = *(const u32x2*)(base);
    g.kk = *(const u32x2*)(base + 2 * 512);
    g.e = *(const u32x2*)(base + (3 + dir) * 512);
    g.ke = *(const u32x2*)(base + (5 + dir) * 512);
    g.a = *(const u32x2*)(base + (7 + dir) * 512);
    g.v = *(const u32x2*)(p->RW + (size_t)row * RWS + 512 + h * 64 + hf * 32 + (kq & 7) * 4);
  };
  auto swrite = [&](int buf, const RwkvStage& g) {
    float* sp = sm + (buf * RS_TB + ss) * RS_STEP;
    const float r0 = bflo(g.r.x), r1 = bfhi(g.r.x), r2 = bflo(g.r.y), r3 = bfhi(g.r.y);
    const float k0 = bflo(g.kk.x), k1 = bfhi(g.kk.x), k2 = bflo(g.kk.y), k3 = bfhi(g.kk.y);
    const float w0 = __expf(-bflo(g.e.x)), w1 = __expf(-bfhi(g.e.x)), w2 = __expf(-bflo(g.e.y)), w3 = __expf(-bfhi(g.e.y));
    const float e0 = bflo(g.ke.x), e1 = bfhi(g.ke.x), e2 = bflo(g.ke.y), e3 = bfhi(g.ke.y);
    const float a0 = k0 * bflo(g.a.x), a1 = k1 * bfhi(g.a.x), a2 = k2 * bflo(g.a.y), a3 = k3 * bfhi(g.a.y);
    *(float4*)(sp + kq * 4) = make_float4(k0, k1, k2, k3);
    *(float4*)(sp + 64 + kq * 4) = make_float4(w0 * r0, w1 * r1, w2 * r2, w3 * r3);
    *(float4*)(sp + 128 + kq * 4) = make_float4(w0, w1, w2, w3);
    *(float4*)(sp + 192 + kq * 4) = make_float4(a0, a1, a2, a3);
    *(float4*)(sp + 256 + kq * 4) = make_float4(e0, e1, e2, e3);
    if (kq < 8) *(float4*)(sp + 320 + kq * 4) = make_float4(bflo(g.v.x), bfhi(g.v.x), bflo(g.v.y), bfhi(g.v.y));
    float c1 = a0 * r0 + a1 * r1 + a2 * r2 + a3 * r3;
    float c2 = e0 * r0 + e1 * r1 + e2 * r2 + e3 * r3;
    c1 += dppx<0xB1>(c1); c2 += dppx<0xB1>(c2);
    c1 += dppx<0x4E>(c1); c2 += dppx<0x4E>(c2);
    c1 += dppx<0x141>(c1); c2 += dppx<0x141>(c2);
    c1 += dppx<0x140>(c1); c2 += dppx<0x140>(c2);
    if (kq == 0) { sp[352] = c1; sp[353] = c2; }
  };
  typedef float f2 __attribute__((ext_vector_type(2)));
  f2 S01 = {0.f, 0.f}, S23 = {0.f, 0.f}, S45 = {0.f, 0.f}, S67 = {0.f, 0.f};
  auto compute = [&](int n) {
    const float* bp = sm + (n & 1) * RS_TB * RS_STEP;
    float* yb = ybuf + (n & 1) * RS_TB * 32 + w * 8 + rl;
    struct Ops { f2 k[4], r[4], w[4], a[4], e[4]; float vv; f2 c; };
    auto ld = [&](int s, Ops& o) {
      const float* sq = bp + s * RS_STEP;
      const f2* sp = (const f2*)(sq + ks * 8);
#pragma unroll
      for (int i = 0; i < 4; ++i) { o.k[i] = sp[i]; o.r[i] = sp[32 + i]; o.w[i] = sp[64 + i]; o.a[i] = sp[96 + i]; o.e[i] = sp[128 + i]; }
      o.vv = sq[320 + w * 8 + rl]; o.c = *(const f2*)(sq + 352);
    };
    auto step = [&](const Ops& o) -> float {
      f2 sa2 = S01 * o.k[0];
      f2 y2 = S01 * o.r[0];
      sa2 = __builtin_elementwise_fma(S23, o.k[1], sa2); y2 = __builtin_elementwise_fma(S23, o.r[1], y2);
      sa2 = __builtin_elementwise_fma(S45, o.k[2], sa2); y2 = __builtin_elementwise_fma(S45, o.r[2], y2);
      sa2 = __builtin_elementwise_fma(S67, o.k[3], sa2); y2 = __builtin_elementwise_fma(S67, o.r[3], y2);
      float sa = sa2.x + sa2.y, y0 = y2.x + y2.y;
      sa += dppx<0xB1>(sa); y0 += dppx<0xB1>(y0);
      sa += dppx<0x4E>(sa); y0 += dppx<0x4E>(y0);
      sa += dppx<0x141>(sa); y0 += dppx<0x141>(y0);
      sa = -sa;
      const f2 sav = {sa, sa}, vvv = {o.vv, o.vv};
      S01 = __builtin_elementwise_fma(vvv, o.e[0], __builtin_elementwise_fma(sav, o.a[0], S01 * o.w[0]));
      S23 = __builtin_elementwise_fma(vvv, o.e[1], __builtin_elementwise_fma(sav, o.a[1], S23 * o.w[1]));
      S45 = __builtin_elementwise_fma(vvv, o.e[2], __builtin_elementwise_fma(sav, o.a[2], S45 * o.w[2]));
      S67 = __builtin_elementwise_fma(vvv, o.e[3], __builtin_elementwise_fma(sav, o.a[3], S67 * o.w[3]));
      return fmaf(o.vv, o.c.y, fmaf(sa, o.c.x, y0));
    };
    Ops oa, ob;
    ld(0, oa);
#pragma unroll 1
    for (int s = 0; s < RS_TB; s += 2) {
      __builtin_amdgcn_sched_barrier(0);
      ld(s + 1, ob);
      __builtin_amdgcn_sched_barrier(0);
      float y0 = step(oa);
      asm volatile("" : "+v"(y0));
      __builtin_amdgcn_sched_barrier(0);
      ld(s + 2, oa);
      __builtin_amdgcn_sched_barrier(0);
      float y1 = step(ob);
      asm volatile("" : "+v"(y1));
      __builtin_amdgcn_sched_barrier(0);
      if (ks == 0) { yb[s * 32] = y0; yb[(s + 1) * 32] = y1; }
    }
  };
  auto yout = [&](int n) {
    const int row = scan_row(dir, b, n * RS_TB + ss);
    const float* ys = ybuf + (n & 1) * RS_TB * 32 + ss * 32 + kq * 2;
    *(unsigned*)(p->P + (size_t)row * LDP + dir * 512 + h * 64 + hf * 32 + kq * 2) = pk_bf16(ys[0], ys[1]);
  };
  constexpr int NB = TSC / RS_TB;
  RwkvStage gA, gB;
  gload(0, gA);
  gload(1, gB);
  swrite(0, gA);
  gload(2, gA);
  __syncthreads();
  for (int n = 0; n < NB; n += 2) {
    compute(n);
    swrite(1, gB);
    if (n + 3 < NB) gload(n + 3, gB);
    __syncthreads();
    yout(n);
    compute(n + 1);
    if (n + 2 < NB) swrite(0, gA);
    if (n + 4 < NB) gload(n + 4, gA);
    __syncthreads();
    yout(n + 1);
  }
  __syncthreads();
}

__device__ void mlstm_s1(KP p, int layer, int tile, char* lds, int tid) {
  const int j = layer >> 1;
  const int ch = tile / NCHUNK, c = tile % NCHUNK;
  const int dir = ch >> 5, b = (ch >> 2) & 7, h = ch & 3;
  float* s_ws = (float*)(lds + META_OFF);
  int* s_row = (int*)(s_ws + 64);
  char* kimg = lds;
  char* vimg = lds + 16384;
  if (tid < 64) {
    const int row = scan_row(dir, b, c * 64 + tid);
    s_row[tid] = row;
    const float* g = p->GP + (size_t)row * 16;
    const float gi = g[(dir * 2) * 4 + h] + p->mlstm_gate_b[j * 16 + (dir * 2) * 4 + h];
    const float gf = g[(dir * 2 + 1) * 4 + h] + p->mlstm_gate_b[j * 16 + (dir * 2 + 1) * 4 + h];
    float bc = -softplus_f(-gf);
#pragma unroll
    for (int o = 1; o < 64; o <<= 1) {
      float tmp = __shfl_up(bc, o);
      if (tid >= o) bc += tmp;
    }
    const float bend = __shfl(bc, 63);
    const float ds = bend - bc + gi;
    const float mloc = wmax(ds);
    s_ws[tid] = expf(ds - mloc);
    if (tid == 0) { p->msc[tile] = mloc; p->msc[NMT + tile] = bend; }
  }
  __syncthreads();
  {
    const int c8 = tid & 15;
    const int ioff = (c8 >> 2) * 4096 + (c8 & 3) * 16;
#pragma unroll
    for (int i = 0; i < 4; ++i) {
      const int sidx = (tid >> 4) + 16 * i;
      const bf16_t* src = p->P + (size_t)s_row[sidx] * LDP + h * 128 + c8 * 8;
      const u32x4 kv = *(const u32x4*)(src + 2560);
      u32x4 vv = *(const u32x4*)(src + 3072);
      const float wsv = s_ws[sidx];
      vv.x = pk_bf16(bflo(vv.x) * wsv, bfhi(vv.x) * wsv); vv.y = pk_bf16(bflo(vv.y) * wsv, bfhi(vv.y) * wsv);
      vv.z = pk_bf16(bflo(vv.z) * wsv, bfhi(vv.z) * wsv); vv.w = pk_bf16(bflo(vv.w) * wsv, bfhi(vv.w) * wsv);
      *(u32x4*)(kimg + ioff + sidx * 64) = kv;
      *(u32x4*)(vimg + ioff + sidx * 64) = vv;
    }
  }
  __syncthreads();
  const int lane = tid & 63, w = tid >> 6, wm = w >> 1, wn = w & 1, r32 = lane & 31, hi = lane >> 5;
  f32x16 acc[2][2];
#pragma unroll
  for (int mi = 0; mi < 2; ++mi)
#pragma unroll
    for (int ni = 0; ni < 2; ++ni)
#pragma unroll
      for (int q = 0; q < 16; ++q) acc[mi][ni][q] = 0.f;
  const int toff = ((lane >> 4) & 1) * 32 + (lane & 3) * 8 + ((lane & 15) >> 2) * 64 + hi * 256;
#pragma unroll
  for (int ks = 0; ks < 4; ++ks) {
    bf16x8 af[2], bfr[2];
#pragma unroll
    for (int i = 0; i < 2; ++i) {
      const char* ka = kimg + (wm * 2 + i) * 4096 + toff + (16 * ks) * 64;
      const char* va = vimg + (wn * 2 + i) * 4096 + toff + (16 * ks) * 64;
      af[i] = __builtin_shufflevector(vtr(ka), vtr(ka + 8 * 64), 0, 1, 2, 3, 4, 5, 6, 7);
      bfr[i] = __builtin_shufflevector(vtr(va), vtr(va + 8 * 64), 0, 1, 2, 3, 4, 5, 6, 7);
    }
    acc[0][0] = MFMA32(af[0], bfr[0], acc[0][0]);
    acc[0][1] = MFMA32(af[0], bfr[1], acc[0][1]);
    acc[1][0] = MFMA32(af[1], bfr[0], acc[1][0]);
    acc[1][1] = MFMA32(af[1], bfr[1], acc[1][1]);
  }
  bf16_t* U = p->MS + (size_t)tile * 16384;
#pragma unroll
  for (int mi = 0; mi < 2; ++mi)
#pragma unroll
    for (int ni = 0; ni < 2; ++ni)
#pragma unroll
      for (int q = 0; q < 16; ++q) {
        const int d = wm * 64 + mi * 32 + (q & 3) + 8 * (q >> 2) + 4 * hi;
        U[d * 128 + wn * 64 + ni * 32 + r32] = f2bf(acc[mi][ni][q]);
        if ((q & 3) == 3) __builtin_amdgcn_sched_barrier(0);
      }
  if (tid < 128) {
    const char* kc = kimg + (tid >> 5) * 4096 + (tid & 31) * 2;
    float a = 0.f;
#pragma unroll 8
    for (int sidx = 0; sidx < 64; ++sidx) a = fmaf(s_ws[sidx], bf2f(*(const bf16_t*)(kc + sidx * 64)), a);
    p->MSn[tile * 128 + tid] = a;
  }
}

__device__ void ph_scan_a(KP p, int layer, char* smc) {
  float* sm = (float*)smc;
  const int tid = opaque_tid();
  for (int u = blockIdx.x; u < 256; u += gridDim.x) rwkv_unit(p, u, sm, tid);
  {
    const int stage = layer == 1 ? 1 : 2;
    const int total = NMT + conv_stage_total(stage);
    int* qc = (int*)(p->bar + XCD_BAR_WORDS + 16 * stage);
    int* s_q = (int*)(smc + META_OFF + 3968);
    for (;;) {
      __syncthreads();
      if (tid == 0) *s_q = atomicAdd(qc, 1);
      __syncthreads();
      const int q = *s_q;
      if (q >= total) break;
      if (q < NMT) mlstm_s1(p, layer, q, smc, tid);
      else convert_job(p, conv_stage_job(stage, q - NMT), sm, tid);
    }
  }
}

__device__ void ph_mlstm_s2(KP p, char* smc) {
  float* sw = (float*)smc;
  const int tid = opaque_tid();
  const int nitems = 64 * 33;
  for (int item = blockIdx.x; item < nitems; item += gridDim.x) {
    const int ch = item / 33, seg = item % 33;
    __syncthreads();
    if (tid == 0) {
      float m = 0.f;
      for (int c = 0; c < NCHUNK; ++c) {
        const int tile = ch * NCHUNK + c;
        const float mloc = p->msc[tile], bend = p->msc[NMT + tile];
        const float mn = fmaxf(bend + m, mloc);
        sw[c] = expf(bend + m - mn);
        sw[36 + c] = expf(mloc - mn);
        if (seg == 0) p->msc[2 * NMT + tile] = m;
        m = mn;
      }
    }
    __syncthreads();
    if (seg < 32) {
      unsigned* base = (unsigned*)(p->MS + (size_t)ch * NCHUNK * 16384) + seg * 256 + tid;
      unsigned v[NCHUNK];
#pragma unroll
      for (int c = 0; c < NCHUNK; ++c) v[c] = base[(size_t)c * 8192];
      float C0 = 0.f, C1 = 0.f;
#pragma unroll
      for (int c = 0; c < NCHUNK; ++c) {
        const float t0 = bflo(v[c]), t1 = bfhi(v[c]);
        v[c] = pk_bf16(C0, C1);
        C0 = sw[c] * C0 + sw[36 + c] * t0;
        C1 = sw[c] * C1 + sw[36 + c] * t1;
      }
#pragma unroll
      for (int c = 0; c < NCHUNK; ++c) base[(size_t)c * 8192] = v[c];
    } else if (tid < 128) {
      float* base = p->MSn + (size_t)ch * NCHUNK * 128 + tid;
      float v[NCHUNK];
#pragma unroll
      for (int c = 0; c < NCHUNK; ++c) v[c] = base[c * 128];
      float C = 0.f;
#pragma unroll
      for (int c = 0; c < NCHUNK; ++c) {
        const float t0 = v[c];
        v[c] = C;
        C = sw[c] * C + sw[36 + c] * t0;
      }
#pragma unroll
      for (int c = 0; c < NCHUNK; ++c) base[c * 128] = v[c];
    }
  }
}

__device__ void mlstm_s3(KP p, int layer, int tile, char* lds, int tid) {
  const int j = layer >> 1;
  const int ch = tile / NCHUNK, c = tile % NCHUNK;
  const int dir = ch >> 5, b = (ch >> 2) & 7, h = ch & 3;
  float* s_b = (float*)(lds + META_OFF);
  float* s_ig = s_b + 64;
  float* s_mt = s_b + 128;
  float* s_wi = s_b + 192;
  int* s_row = (int*)(s_b + 256);
  float* s_n = s_b + 320;
  float* s_c = s_b + 448;
  char* kimg = lds;
  char* vimg = lds + 16384;
  char* cimg = lds + 32768;
  const float mprev = p->msc[2 * NMT + tile];
  const float qscale = 0.08838834764831845f;
  if (tid < 64) {
    const int row = scan_row(dir, b, c * 64 + tid);
    s_row[tid] = row;
    const float* g = p->GP + (size_t)row * 16;
    const float gi = g[(dir * 2) * 4 + h] + p->mlstm_gate_b[j * 16 + (dir * 2) * 4 + h];
    const float gf = g[(dir * 2 + 1) * 4 + h] + p->mlstm_gate_b[j * 16 + (dir * 2 + 1) * 4 + h];
    float bc = -softplus_f(-gf);
#pragma unroll
    for (int o = 1; o < 64; o <<= 1) {
      float tmp = __shfl_up(bc, o);
      if (tid >= o) bc += tmp;
    }
    s_b[tid] = bc;
    s_ig[tid] = gi;
  } else if (tid < 192) s_n[tid - 64] = p->MSn[tile * 128 + (tid - 64)];
  __syncthreads();
  if (tid < 64) {
    const float bt = s_b[tid];
    float mt = bt + mprev;
    for (int sx = 0; sx <= tid; ++sx) mt = fmaxf(mt, bt - s_b[sx] + s_ig[sx]);
    s_mt[tid] = mt;
    s_wi[tid] = expf(bt + mprev - mt);
    s_c[tid] = (s_ig[tid] - bt) * 1.4426950408889634f;
  }
  {
    const int c8 = tid & 15;
    const int ioff = (c8 >> 2) * 4096 + (c8 & 3) * 16;
#pragma unroll
    for (int i = 0; i < 4; ++i) {
      const int sidx = (tid >> 4) + 16 * i;
      const bf16_t* src = p->P + (size_t)s_row[sidx] * LDP + h * 128 + c8 * 8;
      *(u32x4*)(kimg + sidx * 256 + ((c8 ^ (sidx & 15)) * 16)) = *(const u32x4*)(src + 2560);
      *(u32x4*)(vimg + ioff + sidx * 64) = *(const u32x4*)(src + 3072);
    }
    __builtin_amdgcn_sched_barrier(0);
    const bf16_t* Cp = p->MS + (size_t)tile * 16384;
    const int coff = (c8 >> 2) * 8192 + (c8 & 3) * 16;
#pragma unroll
    for (int i = 0; i < 8; ++i) {
      const int d = (tid >> 4) + 16 * i;
      *(u32x4*)(cimg + coff + d * 64) = *(const u32x4*)(Cp + d * 128 + c8 * 8);
      if (i == 3) __builtin_amdgcn_sched_barrier(0);
    }
    __builtin_amdgcn_sched_barrier(0);
  }
  const int lane = tid & 63, w = tid >> 6, wt = w >> 1, wv = w & 1, r32 = lane & 31, hi = lane >> 5;
  const int t = wt * 32 + r32;
  bf16x8 qf[8];
  {
    const bf16_t* qp = p->P + (size_t)s_row[t] * LDP + 2048 + h * 128 + hi * 8;
#pragma unroll
    for (int d0 = 0; d0 < 8; ++d0) qf[d0] = *(const bf16x8*)(qp + d0 * 16);
  }
  __syncthreads();
  const int toff = ((lane >> 4) & 1) * 32 + (lane & 3) * 8 + ((lane & 15) >> 2) * 64;
  constexpr float LOG2E_ = 1.4426950408889634f;
  float qn = 0.f;
#pragma unroll
  for (int d0 = 0; d0 < 8; ++d0) {
    const u32x4 qq = __builtin_bit_cast(u32x4, qf[d0]);
    const float* np = s_n + d0 * 16 + hi * 8;
    qn = fmaf(bflo(qq.x), np[0], qn); qn = fmaf(bfhi(qq.x), np[1], qn);
    qn = fmaf(bflo(qq.y), np[2], qn); qn = fmaf(bfhi(qq.y), np[3], qn);
    qn = fmaf(bflo(qq.z), np[4], qn); qn = fmaf(bfhi(qq.z), np[5], qn);
    qn = fmaf(bflo(qq.w), np[6], qn); qn = fmaf(bfhi(qq.w), np[7], qn);
  }
  qn += __shfl_xor(qn, 32);
  const float mtt = s_mt[t], wi = s_wi[t];
  const float ct = (s_b[t] - mtt) * LOG2E_;
  const float wq = wi * qscale;
  bf16x8 pf[4];
  float den = 0.f;
  {
    f32x16 sa0, sa1;
#pragma unroll
    for (int q = 0; q < 16; ++q) { sa0[q] = 0.f; sa1[q] = 0.f; }
#pragma unroll
    for (int d0 = 0; d0 < 8; ++d0) {
      const int chn = 2 * d0 + hi;
      const bf16x8 k0 = *(const bf16x8*)(kimg + r32 * 256 + ((chn ^ (r32 & 15)) * 16));
      sa0 = MFMA32(k0, qf[d0], sa0);
      if (wt) {
        const bf16x8 k1 = *(const bf16x8*)(kimg + (32 + r32) * 256 + ((chn ^ (r32 & 15)) * 16));
        sa1 = MFMA32(k1, qf[d0], sa1);
      }
      __builtin_amdgcn_sched_barrier(0);
    }
#pragma unroll
    for (int g = 0; g < 4; ++g) {
      const int sb0 = 8 * g + 4 * hi;
      const float4 c0v = *(const float4*)(s_c + sb0);
      const float4 c1v = *(const float4*)(s_c + sb0 + 32);
      const float cc0[4] = {c0v.x, c0v.y, c0v.z, c0v.w}, cc1[4] = {c1v.x, c1v.y, c1v.z, c1v.w};
#pragma unroll
      for (int e = 0; e < 4; ++e) {
        const int q = 4 * g + e;
        const float v0 = (sb0 + e <= t) ? sa0[q] * qscale * __builtin_amdgcn_exp2f(ct + cc0[e]) : 0.f;
        sa0[q] = v0; den += v0;
        const float v1 = (wt && sb0 + 32 + e <= t) ? sa1[q] * qscale * __builtin_amdgcn_exp2f(ct + cc1[e]) : 0.f;
        sa1[q] = v1; den += v1;
      }
      __builtin_amdgcn_sched_barrier(0);
    }
#pragma unroll
    for (int sx = 0; sx < 4; ++sx) {
      const int u = (sx & 1) * 8;
      u32x4 tpk;
      if (sx < 2) {
        tpk.x = pk_bf16(sa0[u + 0], sa0[u + 1]); tpk.y = pk_bf16(sa0[u + 2], sa0[u + 3]);
        tpk.z = pk_bf16(sa0[u + 4], sa0[u + 5]); tpk.w = pk_bf16(sa0[u + 6], sa0[u + 7]);
      } else {
        tpk.x = pk_bf16(sa1[u + 0], sa1[u + 1]); tpk.y = pk_bf16(sa1[u + 2], sa1[u + 3]);
        tpk.z = pk_bf16(sa1[u + 4], sa1[u + 5]); tpk.w = pk_bf16(sa1[u + 6], sa1[u + 7]);
      }
      pf[sx] = __builtin_bit_cast(bf16x8, tpk);
    }
  }
  den += __shfl_xor(den, 32);
  const float dtot = den + wq * qn;
  const float inv = 1.f / fmaxf(fabsf(dtot), expf(-mtt));
  bf16_t* op = p->P + (size_t)s_row[t] * LDP + 1024 + dir * 512 + h * 128 + wv * 64 + 4 * hi;
#pragma unroll 1
  for (int vp = 0; vp < 2; ++vp) {
    f32x16 o0;
#pragma unroll
    for (int q = 0; q < 16; ++q) o0[q] = 0.f;
    const char* cb = cimg + (wv * 2 + vp) * 8192 + toff + hi * 512;
#pragma unroll
    for (int d0 = 0; d0 < 8; ++d0) {
      const bf16x8 A0 = __builtin_shufflevector(vtr(cb + (16 * d0) * 64), vtr(cb + (16 * d0 + 4) * 64), 0, 1, 2, 3, 4, 5, 6, 7);
      o0 = MFMA32(A0, qf[d0], o0);
    }
#pragma unroll
    for (int q = 0; q < 16; ++q) o0[q] *= wq;
    const char* vb = vimg + (wv * 2 + vp) * 4096 + toff + hi * 256;
#pragma unroll
    for (int sx = 0; sx < 4; ++sx) {
      if (sx < 2 || wt) {
        const bf16x8 A0 = __builtin_shufflevector(vtr(vb + (16 * sx) * 64), vtr(vb + (16 * sx + 8) * 64), 0, 1, 2, 3, 4, 5, 6, 7);
        o0 = MFMA32(A0, pf[sx], o0);
      }
    }
#pragma unroll
    for (int g = 0; g < 4; ++g) {
      u32x2 v0;
      v0.x = pk_bf16(o0[4 * g] * inv, o0[4 * g + 1] * inv); v0.y = pk_bf16(o0[4 * g + 2] * inv, o0[4 * g + 3] * inv);
      *(u32x2*)(op + vp * 32 + 8 * g) = v0;
    }
  }
}

__device__ void ph_mlstm_s3(KP p, int layer, char* smc) {
  const int tid = opaque_tid();
  for (int tile = blockIdx.x; tile < NMT; tile += gridDim.x) { mlstm_s3(p, layer, tile, smc, tid); __syncthreads(); }
}

__device__ void ph_rec_final(KP p, int layer, bool keep) {
  const int tid = opaque_tid();
  const int j = layer >> 1;
  const int lane = tid & 63, wave = tid >> 6;
  const int rows = keep ? NT : NL;
  const int c0 = lane * 8;
  auto unpack = [](const u32x4 u, float (&f)[8]) {
    f[0] = bflo(u.x); f[1] = bfhi(u.x); f[2] = bflo(u.y); f[3] = bfhi(u.y);
    f[4] = bflo(u.z); f[5] = bfhi(u.z); f[6] = bflo(u.w); f[7] = bfhi(u.w);
  };
  for (int t = blockIdx.x * 4 + wave; t < rows; t += gridDim.x * 4) {
    const bf16_t* rw = p->RW + (size_t)t * RWS + c0;
    const bf16_t* pt = p->P + (size_t)t * LDP + c0;
    bf16_t* mo = p->AB + (size_t)t * DM + c0;
    {
      float yf[8], yb[8], r[8], v[8], k0[8], k1[8], g[8], y[8], o[8];
      unpack(*(const u32x4*)(pt), yf); unpack(*(const u32x4*)(pt + 512), yb);
      unpack(*(const u32x4*)(rw), r); unpack(*(const u32x4*)(rw + 512), v);
      unpack(*(const u32x4*)(rw + 5 * 512), k0); unpack(*(const u32x4*)(rw + 6 * 512), k1);
      unpack(*(const u32x4*)(rw + 9 * 512), g);
      float s1 = 0.f, bs = 0.f;
      const float* rk = p->rwkv_rk + j * 512 + c0;
#pragma unroll
      for (int e = 0; e < 8; ++e) { y[e] = yf[e] + yb[e]; s1 += y[e]; bs += r[e] * rk[e] * (k0[e] + k1[e]); }
      s1 += dppx<0xB1>(s1); s1 += dppx<0x4E>(s1); s1 += dppx<0x141>(s1);
      bs += dppx<0xB1>(bs); bs += dppx<0x4E>(bs); bs += dppx<0x141>(bs);
      const float mu = s1 * (1.f / 64.f);
      float s2 = 0.f;
#pragma unroll
      for (int e = 0; e < 8; ++e) { const float d = y[e] - mu; s2 += d * d; }
      s2 += dppx<0xB1>(s2); s2 += dppx<0x4E>(s2); s2 += dppx<0x141>(s2);
      const float rs = rsqrtf(s2 * (1.f / 64.f) + 64e-5f);
      const float* gn0 = p->rwkv_gn + (j * 2 + 0) * 512 + c0;
      const float* gn1 = p->rwkv_gn + (j * 2 + 1) * 512 + c0;
#pragma unroll
      for (int e = 0; e < 8; ++e) o[e] = ((y[e] - mu) * rs * gn0[e] + gn1[e] + bs * v[e]) * g[e];
      u32x4 ov;
      ov.x = pk_bf16(o[0], o[1]); ov.y = pk_bf16(o[2], o[3]); ov.z = pk_bf16(o[4], o[5]); ov.w = pk_bf16(o[6], o[7]);
      *(u32x4*)(mo) = ov;
    }
    {
      float hf[8], hb[8], og[8], hsum[8], o[8];
      unpack(*(const u32x4*)(pt + 1024), hf); unpack(*(const u32x4*)(pt + 1536), hb);
      unpack(*(const u32x4*)(pt + 3584), og);
      float ss = 0.f;
#pragma unroll
      for (int e = 0; e < 8; ++e) { hsum[e] = hf[e] + hb[e]; ss += hsum[e] * hsum[e]; }
      ss += dppx<0xB1>(ss); ss += dppx<0x4E>(ss); ss += dppx<0x141>(ss); ss += dppx<0x140>(ss);
      const float rs = rsqrtf(ss * (1.f / 128.f) + 1e-6f);
      const float* ng = p->mlstm_norm + j * 512 + c0;
#pragma unroll
      for (int e = 0; e < 8; ++e) o[e] = hsum[e] * rs * ng[e] * sigm_f(og[e]);
      u32x4 ov;
      ov.x = pk_bf16(o[0], o[1]); ov.y = pk_bf16(o[2], o[3]); ov.z = pk_bf16(o[4], o[5]); ov.w = pk_bf16(o[6], o[7]);
      *(u32x4*)(mo + 512) = ov;
    }
  }
}

using f32x4v = __attribute__((ext_vector_type(4))) float;
__device__ void ph_ln_router(KP p, int layer, bool keep, char* smc) {
  float* h2s = (float*)smc;
  float* lgs = (float*)smc;
  const int tid = opaque_tid();
  const int lane = tid & 63, wave = tid >> 6;
  const int rows = keep ? NT : NL;
  const float* lng = p->ln_g + (layer * 2 + 0) * 1024;
  const float* lnb = p->ln_b + (layer * 2 + 0) * 1024;
  const float* Wr = p->moe_router + (size_t)layer * 1024 * 64;
  for (int tile = blockIdx.x; tile < rows / 16; tile += gridDim.x) {
    const int t0 = tile * 16;
    const float* mod = p->MOD + (layer * 9 + modrow(t0)) * 6144;
#pragma unroll 1
    for (int q = 0; q < 4; ++q) {
      const int tl = wave * 4 + q, t = t0 + tl;
      float4 v[4];
      float s = 0.f;
#pragma unroll
      for (int i = 0; i < 4; ++i) {
        v[i] = *(const float4*)(p->Tb + (size_t)t * DM + i * 256 + lane * 4);
        s += (v[i].x + v[i].y) + (v[i].z + v[i].w);
      }
      const float mean = wsum(s) * (1.f / 1024.f);
      float qq = 0.f;
#pragma unroll
      for (int i = 0; i < 4; ++i) {
        const float d0 = v[i].x - mean, d1 = v[i].y - mean, d2 = v[i].z - mean, d3 = v[i].w - mean;
        qq += (d0 * d0 + d1 * d1) + (d2 * d2 + d3 * d3);
      }
      const float rs = rsqrtf(wsum(qq) * (1.f / 1024.f) + 1e-5f);
#pragma unroll
      for (int i = 0; i < 4; ++i) {
        const int n = i * 256 + lane * 4;
        const float4 g = *(const float4*)(lng + n), bb = *(const float4*)(lnb + n);
        const float4 sc = *(const float4*)(mod + 4096 + n), sh = *(const float4*)(mod + 3072 + n);
        const float4 xn = make_float4((v[i].x - mean) * rs * g.x + bb.x, (v[i].y - mean) * rs * g.y + bb.y,
                                      (v[i].z - mean) * rs * g.z + bb.z, (v[i].w - mean) * rs * g.w + bb.w);
        *(float4*)(p->X + (size_t)t * DM + n) = xn;
        const float4 hh = make_float4(xn.x * (1.f + sc.x) + sh.x, xn.y * (1.f + sc.y) + sh.y,
                                      xn.z * (1.f + sc.z) + sh.z, xn.w * (1.f + sc.w) + sh.w);
        *(unsigned*)((unsigned char*)p->AB + (size_t)t * DM + n) = pk_fp8x4(hh.x, hh.y, hh.z, hh.w);
        *(float4*)(h2s + tl * 1028 + n) = hh;
      }
    }
    __syncthreads();
    f32x4v acc = {0.f, 0.f, 0.f, 0.f};
    {
      f32x4v a1 = {0.f, 0.f, 0.f, 0.f}, a2 = {0.f, 0.f, 0.f, 0.f}, a3 = {0.f, 0.f, 0.f, 0.f};
      const int i = lane & 15, kk = lane >> 4;
      const float* arow = h2s + i * 1028 + 4 * kk;
      const float* bcol = Wr + (4 * kk) * 64 + 16 * wave + i;
#pragma unroll 4
      for (int q = 0; q < 64; ++q) {
        const float4 a = *(const float4*)(arow + 16 * q);
        const float b0 = bcol[(16 * q + 0) * 64], b1 = bcol[(16 * q + 1) * 64];
        const float b2 = bcol[(16 * q + 2) * 64], b3 = bcol[(16 * q + 3) * 64];
        acc = __builtin_amdgcn_mfma_f32_16x16x4f32(a.x, b0, acc, 0, 0, 0);
        a1 = __builtin_amdgcn_mfma_f32_16x16x4f32(a.y, b1, a1, 0, 0, 0);
        a2 = __builtin_amdgcn_mfma_f32_16x16x4f32(a.z, b2, a2, 0, 0, 0);
        a3 = __builtin_amdgcn_mfma_f32_16x16x4f32(a.w, b3, a3, 0, 0, 0);
      }
      acc = (acc + a1) + (a2 + a3);
    }
    __syncthreads();
#pragma unroll
    for (int r = 0; r < 4; ++r) lgs[((lane >> 4) * 4 + r) * 64 + 16 * wave + (lane & 15)] = acc[r];
    __syncthreads();
#pragma unroll 1
    for (int q = 0; q < 4; ++q) {
      const int tl = wave * 4 + q, t = t0 + tl;
      const float logit = lgs[tl * 64 + lane];
      const float score = sigm_f(logit);
      float sel = score + p->moe_bias[layer * 64 + lane];
      bool chosen = false;
      for (int r = 0; r < 6; ++r) {
        const float mx = wmax(sel);
        const unsigned long long bal = __ballot(sel == mx);
        const int first = __ffsll((long long)bal) - 1;
        if (lane == first) { chosen = true; sel = -INFINITY; }
      }
      const float gsum = wsum(chosen ? score : 0.f);
      const unsigned long long cb = __ballot(chosen);
      if (chosen) {
        const int kidx = __popcll(cb & ((1ull << lane) - 1ull));
        const int pos = atomicAdd(&p->cnt[lane], 1);
        p->ltok[(size_t)lane * NT + pos] = t;
        p->lgate[(size_t)lane * NT + pos] = score / gsum * 2.5f;
        p->tsl[t * 6 + kidx] = (lane << 16) | pos;
      }
    }
    __syncthreads();
  }
}

__device__ __forceinline__ void moe_prefix(KP p, int rows, int* s_pref, int tid) {
  if (tid == 0) {
    int a = 0;
    for (int e = 0; e < 64; ++e) { s_pref[e] = a; a += (p->cnt[e] + 127) >> 7; }
    s_pref[64] = a; a += rows >> 7;
    s_pref[65] = a;
  }
  __syncthreads();
}

__device__ void ph_gemm(KP p, int kind, int layer, bool keep, char* lds) {
  const int tid = opaque_tid();
  const int j = layer >> 1;
  const bool att = !(layer & 1);
  const int rows = keep ? NT : NL;
  int* pref = (int*)(lds + META_OFF);
  int* s_idx = pref + 66;
  float* s_gate = (float*)(s_idx + 128);
  if (kind == 1 && blockIdx.x == 0 && tid < 65) p->cnt[tid] = 0;
  if (kind == 2 || kind == 3) moe_prefix(p, rows, pref, tid);
  int total;
  const int ntn_in = att ? 18 : 33;
  switch (kind) {
    case 0: total = (NT / 128) * ntn_in; break;
    case 1: total = (rows / 128) * 8; break;
    case 2: total = pref[65] * 4; break;
    case 3: total = pref[65] * 8; break;
    case 4: total = (NT / 128) * 3; break;
    default: total = (NT / 128) * 20; break;
  }
  for (int tile = blockIdx.x; tile < total; tile += gridDim.x) {
    const bf16_t* Abase; const bf16_t* Bt;
    int astride, K, n0, m0 = 0, aux = 0, e = 0, mtile = 0;
    switch (kind) {
      case 0: { const int tm = tile / ntn_in, tn = tile % ntn_in; m0 = tm * 128; n0 = tn * 128;
                Abase = p->AB + (size_t)m0 * DM; astride = DM; K = 1024;
                Bt = att ? p->Wt_att + (size_t)j * ATT_N * 1024 : p->Wt_rec + (size_t)j * REC_NP * 1024; } break;
      case 1: { const int tm = tile >> 3, tn = tile & 7; m0 = tm * 128; n0 = tn * 128;
                Abase = p->AB + (size_t)m0 * DM; astride = DM; K = 1024; Bt = p->Wt_out + (size_t)layer * 1024 * 1024; } break;
      case 2: { mtile = tile >> 2; aux = tile & 3; n0 = aux * 128; while (mtile >= pref[e + 1]) ++e;
                Abase = p->AB; astride = DM; K = 1024;
                Bt = (const bf16_t*)((const unsigned char*)p->Wt13 + (size_t)(layer * 65 + e) * 512 * 1024); } break;
      case 3: { mtile = tile >> 3; aux = tile & 7; n0 = aux * 128; while (mtile >= pref[e + 1]) ++e;
                Abase = (const bf16_t*)((const unsigned char*)p->ACT + (size_t)mtile * 128 * 256); astride = 256; K = 256;
                Bt = (const bf16_t*)((const unsigned char*)p->Wt2 + (size_t)(layer * 65 + e) * 1024 * 256); } break;
      case 4: { const int tm = tile / 3; aux = tile % 3; m0 = tm * 128; n0 = 0;
                Abase = p->Zb + (size_t)m0 * 1536 + aux * 512; astride = 1536; K = 512; Bt = p->Wl1 + (size_t)(j * 3 + aux) * 128 * 512; } break;
      default: { const int tm = tile / 20; aux = tile % 20; m0 = tm * 128; n0 = aux * 128;
                const int grp = aux < 8 ? 0 : (aux < 16 ? 1 : 2);
                Abase = p->L1 + (size_t)m0 * 384 + grp * 128; astride = 384; K = 128; Bt = p->Wl2 + (size_t)j * 2560 * 128; } break;
    }
    if (tid < 128) {
      int idx = tid; float g = 1.f;
      if (kind == 2 || kind == 3) {
        const int pos = (mtile - pref[e]) * 128 + tid;
        if (kind == 2) {
          idx = 0;
          if (e < 64) { if (pos < p->cnt[e]) idx = p->ltok[(size_t)e * NT + pos]; }
          else idx = pos;
        } else if (e < 64) g = pos < p->cnt[e] ? p->lgate[(size_t)e * NT + pos] : 0.f;
      }
      s_idx[tid] = idx; s_gate[tid] = g;
    }
    __syncthreads();
    {
      f32x16 acc[2][2];
      if (kind == 2 || kind == 3) {
        const unsigned char* A8 = (const unsigned char*)Abase;
        gemm128_fp8(tid, [&](int r) { return A8 + (size_t)s_idx[r] * astride; }, (const unsigned char*)Bt, K, n0, lds, acc);
      } else
        gemm128_main(tid, [&](int r) { return Abase + (size_t)s_idx[r] * astride; }, Bt, K, n0, lds, acc);
      float* Ct = (float*)lds;
      acc_foreach(tid, acc, [&](int row, int col, float v) { Ct[row * 128 + col] = v; });
    }
    __syncthreads();
    {
      const float* Ct = (const float*)lds;
      const int c4 = (tid & 31) * 4, r0 = tid >> 5;
      const int N_in = att ? ATT_N : REC_N;
      const int d5 = (aux >> 2) & 1, c05 = (aux & 3) * 128;
      switch (kind) {
        case 0: {
#pragma unroll 8
          for (int it = 0; it < 16; ++it) {
            const int row = it * 8 + r0;
            const float4 v = *(const float4*)(Ct + row * 128 + c4);

            const int cn = n0 + c4;
            float4 vq = v;
            if (att && n0 >= 1536 && n0 < 2176) {
              float ss = v.x * v.x + v.y * v.y + v.z * v.z + v.w * v.w;
              ss += dppx<0xB1>(ss); ss += dppx<0x4E>(ss); ss += dppx<0x141>(ss); ss += dppx<0x140>(ss);
              const float rs = rsqrtf(ss * (1.f / 64.f) + 1e-6f);
              const float4 g = *(const float4*)(p->qk_gain + j * 128 + (n0 >= 2048 ? 64 : 0) + (cn & 63));
              vq = make_float4(v.x * rs * g.x, v.y * rs * g.y, v.z * rs * g.z, v.w * rs * g.w);
              const int t = m0 + row;
              if (t < NL) {
                const int sidx = t & 2047, pi0 = (cn & 63) >> 1;
                const int pos = pi0 < 16 ? (sidx >> 6) : (sidx & 63);
                const float4 cs = *(const float4*)(p->ROPE + (pos * 16 + (pi0 & 15)) * 2);
                vq = make_float4(vq.x * cs.x - vq.y * cs.y, vq.x * cs.y + vq.y * cs.x,
                                 vq.z * cs.z - vq.w * cs.w, vq.z * cs.w + vq.w * cs.z);
              }
            }
            if (cn < N_in) {
              u32x2 o; o.x = pk_bf16(vq.x, vq.y); o.y = pk_bf16(vq.z, vq.w);
              *(u32x2*)(p->P + (size_t)(m0 + row) * LDP + cn) = o;
            }
            if (!att && cn >= 4096 && cn < 4112) *(float4*)(p->GP + (size_t)(m0 + row) * 16 + (cn - 4096)) = v;
          }
        } break;
        case 1: {
#pragma unroll 16
          for (int it = 0; it < 16; ++it) {
            const int row = it * 8 + r0;
            const float4 v = *(const float4*)(Ct + row * 128 + c4);

            const size_t o = (size_t)(m0 + row) * DM + n0 + c4;
            const float4 xv = *(const float4*)(p->X + o);
            const float4 g = *(const float4*)(p->MOD + (layer * 9 + modrow(m0)) * 6144 + 2048 + n0 + c4);
            *(float4*)(p->Tb + o) = make_float4(DN_ALPHA * xv.x + g.x * v.x, DN_ALPHA * xv.y + g.y * v.y,
                                                DN_ALPHA * xv.z + g.z * v.z, DN_ALPHA * xv.w + g.w * v.w);
          }
        } break;
        case 2: {
#pragma unroll 8
          for (int it = 0; it < 16; ++it) {
            const int row = it * 8 + r0;
            const float4 v = *(const float4*)(Ct + row * 128 + c4);

            if (((c4 >> 5) & 1) == 0) {
              const float4 u = *(const float4*)(Ct + row * 128 + c4 + 32);
              const float a0 = v.x * W8_INV, a1 = v.y * W8_INV, a2 = v.z * W8_INV, a3 = v.w * W8_INV;
              *(unsigned*)((unsigned char*)p->ACT + ((size_t)mtile * 128 + row) * 256 + aux * 64 + (c4 >> 6) * 32 + (c4 & 31)) =
                  pk_fp8x4(silu_f(a0) * (u.x * W8_INV), silu_f(a1) * (u.y * W8_INV), silu_f(a2) * (u.z * W8_INV), silu_f(a3) * (u.w * W8_INV));
            }
          }
        } break;
        case 3: {
#pragma unroll 16
          for (int it = 0; it < 16; ++it) {
            const int row = it * 8 + r0;
            const float4 v = *(const float4*)(Ct + row * 128 + c4);

            const float g = s_gate[row] * W8_INV;
            u32x2 o; o.x = pk_bf16(g * v.x, g * v.y); o.y = pk_bf16(g * v.z, g * v.w);
            *(u32x2*)(p->OUT2 + ((size_t)mtile * 128 + row) * 1024 + n0 + c4) = o;
          }
        } break;
        case 4: {
#pragma unroll 4
          for (int it = 0; it < 16; ++it) {
            const int row = it * 8 + r0;
            const float4 v = *(const float4*)(Ct + row * 128 + c4);

            float4 o4 = v;
            if (aux == 0) o4 = make_float4(tanhf(v.x), tanhf(v.y), tanhf(v.z), tanhf(v.w));
            else if (aux == 2) o4 = make_float4(sigm_f(v.x), sigm_f(v.y), sigm_f(v.z), sigm_f(v.w));
            u32x2 o; o.x = pk_bf16(o4.x, o4.y); o.y = pk_bf16(o4.z, o4.w);
            *(u32x2*)(p->L1 + (size_t)(m0 + row) * 384 + aux * 128 + c4) = o;
          }
        } break;
        default: {
#pragma unroll 4
          for (int it = 0; it < 16; ++it) {
            const int row = it * 8 + r0;
            const float4 v = *(const float4*)(Ct + row * 128 + c4);

            bf16_t* rr = p->RW + (size_t)(m0 + row) * RWS + c05 + c4;
            const float vv[4] = {v.x, v.y, v.z, v.w};
            if (aux < 8) {
              const float4 b0 = *(const float4*)(p->rwkv_w0 + (j * 2 + d5) * 512 + c05 + c4);
              const float bb[4] = {b0.x, b0.y, b0.z, b0.w};
              float e4[4];
#pragma unroll
              for (int q = 0; q < 4; ++q) e4[q] = expf(-softplus_f(-(bb[q] + vv[q])) - 0.5f);
              u32x2 o; o.x = pk_bf16(e4[0], e4[1]); o.y = pk_bf16(e4[2], e4[3]);
              *(u32x2*)(rr + (3 + d5) * 512) = o;
            } else if (aux < 16) {
              const float4 b0 = *(const float4*)(p->rwkv_a0 + (j * 2 + d5) * 512 + c05 + c4);
              const float4 k1 = *(const float4*)(p->rwkv_kvec + (j * 2 + 1) * 512 + c05 + c4);
              const u32x2 kx2 = *(const u32x2*)(rr + 10 * 512);
              const float bb[4] = {b0.x, b0.y, b0.z, b0.w}, kk1[4] = {k1.x, k1.y, k1.z, k1.w};
              const float kx[4] = {bflo(kx2.x), bfhi(kx2.x), bflo(kx2.y), bfhi(kx2.y)};
              float av[4], ke[4];
#pragma unroll
              for (int q = 0; q < 4; ++q) { av[q] = sigm_f(bb[q] + vv[q]); ke[q] = kx[q] * (1.f + (av[q] - 1.f) * kk1[q]); }
              u32x2 o; o.x = pk_bf16(av[0], av[1]); o.y = pk_bf16(av[2], av[3]);
              *(u32x2*)(rr + (7 + d5) * 512) = o;
              o.x = pk_bf16(ke[0], ke[1]); o.y = pk_bf16(ke[2], ke[3]);
              *(u32x2*)(rr + (5 + d5) * 512) = o;
            } else {
              u32x2 o; o.x = pk_bf16(v.x, v.y); o.y = pk_bf16(v.z, v.w);
              *(u32x2*)(rr + 9 * 512) = o;
            }
          }
        } break;
      }
    }
    __syncthreads();
  }
}

__device__ void ph_final_ln(KP p, int layer, bool keep, char* lds) {
  const int tid = opaque_tid();
  const int lane = tid & 63, wave = tid >> 6;
  const int rows = keep ? NT : NL;
  int* s_base = (int*)(lds + META_OFF);
  if (tid == 0) {
    int a = 0;
    for (int e = 0; e < 64; ++e) { s_base[e] = a * 128; a += (p->cnt[e] + 127) >> 7; }
    s_base[64] = a * 128;
  }
  __syncthreads();
  const float* lng = p->ln_g + (layer * 2 + 1) * 1024;
  const float* lnb = p->ln_b + (layer * 2 + 1) * 1024;
  for (int t = blockIdx.x * 4 + wave; t < rows; t += gridDim.x * 4) {
    const int mr = modrow(t);
    const float* g2 = p->MOD + (layer * 9 + mr) * 6144 + 5120;
    const bf16_t* src[7];
#pragma unroll
    for (int k = 0; k < 6; ++k) {
      const int v = p->tsl[t * 6 + k];
      src[k] = p->OUT2 + (size_t)(s_base[v >> 16] + (v & 0xffff)) * 1024;
    }
    src[6] = p->OUT2 + (size_t)(s_base[64] + t) * 1024;
    float v[16];
    float s = 0.f;
#pragma unroll
    for (int c = 0; c < 2; ++c) {
      const int n0 = c * 512 + lane * 8;
      float y[8];
#pragma unroll
      for (int q = 0; q < 8; ++q) y[q] = 0.f;
#pragma unroll
      for (int k = 0; k < 7; ++k) {
        const u32x4 u = *(const u32x4*)(src[k] + n0);
        y[0] += bflo(u.x); y[1] += bfhi(u.x); y[2] += bflo(u.y); y[3] += bfhi(u.y);
        y[4] += bflo(u.z); y[5] += bfhi(u.z); y[6] += bflo(u.w); y[7] += bfhi(u.w);
      }
      const float4 xa = *(const float4*)(p->X + (size_t)t * DM + n0), xb = *(const float4*)(p->X + (size_t)t * DM + n0 + 4);
      const float4 ga = *(const float4*)(g2 + n0), gb = *(const float4*)(g2 + n0 + 4);
      const float xx[8] = {xa.x, xa.y, xa.z, xa.w, xb.x, xb.y, xb.z, xb.w};
      const float gg[8] = {ga.x, ga.y, ga.z, ga.w, gb.x, gb.y, gb.z, gb.w};
#pragma unroll
      for (int q = 0; q < 8; ++q) { v[c * 8 + q] = DN_ALPHA * xx[q] + gg[q] * y[q]; s += v[c * 8 + q]; }
    }
    const float mean = wsum(s) * (1.f / 1024.f);
    float q2 = 0.f;
#pragma unroll
    for (int i = 0; i < 16; ++i) { const float d = v[i] - mean; q2 += d * d; }
    const float rs = rsqrtf(wsum(q2) * (1.f / 1024.f) + 1e-5f);
    const float* modn = p->MOD + ((layer + 1) * 9 + mr) * 6144;
#pragma unroll
    for (int c = 0; c < 2; ++c) {
      const int n0 = c * 512 + lane * 8;
      float xn[8];
#pragma unroll
      for (int q = 0; q < 8; ++q) xn[q] = (v[c * 8 + q] - mean) * rs * lng[n0 + q] + lnb[n0 + q];
      *(float4*)(p->X + (size_t)t * DM + n0) = make_float4(xn[0], xn[1], xn[2], xn[3]);
      *(float4*)(p->X + (size_t)t * DM + n0 + 4) = make_float4(xn[4], xn[5], xn[6], xn[7]);
      if (layer == 3) {
        *(float4*)(p->out + (size_t)t * DM + n0) = make_float4(xn[0], xn[1], xn[2], xn[3]);
        *(float4*)(p->out + (size_t)t * DM + n0 + 4) = make_float4(xn[4], xn[5], xn[6], xn[7]);
      } else {
        float hb[8];
#pragma unroll
        for (int q = 0; q < 8; ++q) hb[q] = xn[q] * (1.f + modn[1024 + n0 + q]) + modn[n0 + q];
        u32x4 o;
        o.x = pk_bf16(hb[0], hb[1]); o.y = pk_bf16(hb[2], hb[3]); o.z = pk_bf16(hb[4], hb[5]); o.w = pk_bf16(hb[6], hb[7]);
        *(u32x4*)(p->AB + (size_t)t * DM + n0) = o;
      }
    }
  }
}

#define XB_TMO      128
#define XB_XCNT(j)  (256  + 64 * (j))
#define XB_XSUB(j)  (1280 + 64 * (j))
#define XB_XGEN(j)  (2304 + 64 * (j))
#define XB_TOP      3328
#define XB_TOPGEN   3392
#define XB_SPIN_CAP (1u << 20)
#define LAS __attribute__((address_space(3)))
__device__ __forceinline__ unsigned xb_ld(unsigned* p) { return __hip_atomic_load(p, __ATOMIC_RELAXED, __HIP_MEMORY_SCOPE_AGENT); }
__device__ __forceinline__ unsigned xb_add(unsigned* p, unsigned v) { return __hip_atomic_fetch_add(p, v, __ATOMIC_RELAXED, __HIP_MEMORY_SCOPE_AGENT); }
__device__ __forceinline__ unsigned xb_xcc_id() { return (unsigned)__builtin_amdgcn_s_getreg((3 << 11) | 20) & 0xFu; }
#define XB_SPIN(cond, bar) do { unsigned _sp = 0; while (cond) { __builtin_amdgcn_s_sleep(1); \
    if ((++_sp & 255u) == 0u) { if (xb_ld(&(bar)[XB_TMO])) break; if (_sp > XB_SPIN_CAP) { atomicAdd(&(bar)[XB_TMO], 1u); break; } } } } while (0)
struct XcdBarrier { unsigned* bar; unsigned x; volatile LAS unsigned* st; };
__device__ __forceinline__ XcdBarrier xcd_barrier_post(unsigned* bar, volatile LAS unsigned* st) {
  XcdBarrier b; b.bar = bar; b.x = xb_xcc_id(); b.st = st;
  if (threadIdx.x == 0) (void)xb_add(&bar[XB_XCNT(b.x)], 1u);
  return b;
}
__device__ __forceinline__ void xcd_barrier_complete(unsigned* bar, unsigned x, unsigned& nloc, unsigned& nx) {
  const unsigned G = gridDim.x;
  unsigned sum, cnt, mine, sp = 0u;
  for (;;) {
    sum = 0u; cnt = 0u; mine = 0u;
#pragma unroll
    for (unsigned j = 0; j < 16; ++j) { const unsigned c = xb_ld(&bar[XB_XCNT(j)]); sum += c; cnt += (c > 0u) ? 1u : 0u; mine = (j == x) ? c : mine; }
    if (sum == G) break;
    __builtin_amdgcn_s_sleep(1);
    if ((++sp & 255u) == 0u) { if (xb_ld(&bar[XB_TMO])) break; if (sp > XB_SPIN_CAP) { atomicAdd(&bar[XB_TMO], 1u); break; } }
  }
  nloc = mine > 0u ? mine : 1u; nx = cnt > 0u ? cnt : 1u;
}
__device__ __forceinline__ void xcd_barrier(const XcdBarrier& b) {
  asm volatile("s_waitcnt vmcnt(0)" ::: "memory");
  __syncthreads();
  if (threadIdx.x == 0) {
    unsigned* bar = b.bar;
    __builtin_amdgcn_s_waitcnt(0);
    unsigned nloc = b.st[0], nx = b.st[1];
    if (nloc == 0u) { xcd_barrier_complete(bar, b.x, nloc, nx); b.st[0] = nloc; b.st[1] = nx; }
    const unsigned old = xb_add(&bar[XB_XSUB(b.x)], 1u);
    const unsigned gen = old / nloc;
    if (old + 1u == (gen + 1u) * nloc) {
      __builtin_amdgcn_fence(__ATOMIC_RELEASE, "agent");
      asm volatile("s_waitcnt vmcnt(0)" ::: "memory");
      const unsigned og = xb_add(&bar[XB_TOP], 1u);
      const unsigned tg = og / nx;
      if (og + 1u == (tg + 1u) * nx) xb_add(&bar[XB_TOPGEN], 1u);
      else XB_SPIN(xb_ld(&bar[XB_TOPGEN]) == tg, bar);
      __builtin_amdgcn_fence(__ATOMIC_ACQUIRE, "agent");
      xb_add(&bar[XB_XGEN(b.x)], 1u);
      asm volatile("s_waitcnt vmcnt(0)" ::: "memory");
    } else {
      XB_SPIN(xb_ld(&bar[XB_XGEN(b.x)]) == gen, bar);
      __builtin_amdgcn_fence(__ATOMIC_ACQUIRE, "agent");
      asm volatile("s_waitcnt vmcnt(0)" ::: "memory");
    }
  }
  __syncthreads();
}

constexpr int NSLOTS = 13;
constexpr int NPHASE = 2 + 4 * NSLOTS;
__device__ __forceinline__ bool phase_is_nop(int ph) {
  if (ph < 2) return false;
  const int layer = (ph - 2) / NSLOTS, st = (ph - 2) % NSLOTS;
  return !(layer & 1) && (st == 1 || (st >= 3 && st <= 7));
}
__device__ void run_phase(KP p, int ph, char* sm) {
  if (ph == 0) { ph_init(p, sm); return; }
  if (ph == 1) { ph_mod_h(p, sm); return; }
  const int layer = (ph - 2) / NSLOTS, st = (ph - 2) % NSLOTS;
  const bool odd = layer & 1;
  const bool keep = layer < 3;
  int gk = -1;
  if (st == 0) gk = 0;
  else if (st == 8) gk = 1;
  else if (st == 10) gk = 2;
  else if (st == 11) gk = 3;
  else if (odd && st == 2) gk = 4;
  else if (odd && st == 3) gk = 5;
  asm volatile("" : "+s"(gk));
  if (gk >= 0) { ph_gemm(p, gk, layer, keep, sm); return; }
  switch (st) {
    case 1: if (odd) ph_rwkv_mix(p, layer); break;
    case 2: ph_attention(p, layer, keep, sm); break;
    case 4: if (odd) ph_scan_a(p, layer, sm); break;
    case 5: if (odd) ph_mlstm_s2(p, sm); break;
    case 6: if (odd) ph_mlstm_s3(p, layer, sm); break;
    case 7: if (odd) ph_rec_final(p, layer, keep); break;
    case 9: ph_ln_router(p, layer, keep, sm); break;
    case 12: ph_final_ln(p, layer, keep, sm); break;
  }
}

__global__ void __launch_bounds__(NTHR, 2) mega_kernel(Params kargs) {
  extern __shared__ __attribute__((aligned(16))) char sm[];
  cg::grid_group grid = cg::this_grid();
  volatile LAS unsigned* st = (volatile LAS unsigned*)(sm + META_OFF + 4032);
  if (threadIdx.x == 0) { st[0] = 0u; st[1] = 0u; }
  __syncthreads();
  const XcdBarrier xb = xcd_barrier_post(kargs.bar, st);
  for (int ph = kargs.ph_lo; ph < kargs.ph_hi; ++ph) {
    if (phase_is_nop(ph)) continue;
    {
      KP kp = (KP)__builtin_amdgcn_kernarg_segment_ptr();
      asm volatile("" : "+s"(kp));
      run_phase(kp, ph, sm);
    }
    if (ph + 1 < kargs.ph_hi) {
      if (ph == 0) grid.sync();
      else xcd_barrier(xb);
    }
  }
}

extern "C" void kernel_launch(void* const* d_in, const int* in_sizes, int n_in, void* d_out, int out_size, void* d_ws,
                              size_t ws_size, hipStream_t stream) {
  static int grid_blocks = 0;
  if (!grid_blocks) {
    int dev = 0, cus = 0, per_cu = 0;
    (void)hipGetDevice(&dev);
    (void)hipDeviceGetAttribute(&cus, hipDeviceAttributeMultiprocessorCount, dev);
    (void)hipFuncSetAttribute((const void*)mega_kernel, hipFuncAttributeMaxDynamicSharedMemorySize, SMEM_BYTES);
    (void)hipOccupancyMaxActiveBlocksPerMultiprocessor(&per_cu, mega_kernel, NTHR, SMEM_BYTES);
    if (per_cu < 1) per_cu = 1;
    if (per_cu > 2) per_cu = 2;
    grid_blocks = cus * per_cu;
  }
  Params p;
  memset(&p, 0, sizeof(p));
  const float** pin = (const float**)&p;
  for (int i = 0; i < 35; ++i) pin[i] = (const float*)d_in[i];
  p.out = (float*)d_out;
  char* w = (char*)d_ws;
  size_t off = 0;
  auto take = [&](size_t bytes) { char* r = w + off; off += (bytes + 255) & ~(size_t)255; return r; };
  p.Wt_att = (bf16_t*)take((size_t)2 * ATT_N * 1024 * 2);
  p.Wt_rec = (bf16_t*)take((size_t)2 * REC_NP * 1024 * 2);
  p.Wt_out = (bf16_t*)take((size_t)4 * 1024 * 1024 * 2);
  p.Wt13 = (bf16_t*)take((size_t)4 * 65 * 512 * 1024 * 2);
  p.Wt2 = (bf16_t*)take((size_t)4 * 65 * 1024 * 256 * 2);
  p.Wl1 = (bf16_t*)take((size_t)2 * 3 * 128 * 512 * 2);
  p.Wl2 = (bf16_t*)take((size_t)2 * 2560 * 128 * 2);
  p.X = (float*)take((size_t)NT * DM * 4);
  p.AB = (bf16_t*)take((size_t)NT * DM * 2);
  p.MOD = (float*)take((size_t)5 * 9 * 6144 * 4);
  p.MODP = (float*)take((size_t)8 * 4 * 9 * 6144 * 4);
  p.GP = (float*)take((size_t)NT * 16 * 4);
  p.ROPE = (float*)take((size_t)64 * 16 * 2 * 4);
  p.msc = (float*)take((size_t)3 * NMT * 4);
  p.lgate = (float*)take((size_t)64 * NT * 4);
  p.ltok = (int*)take((size_t)64 * NT * 4);
  p.tsl = (int*)take((size_t)NT * 6 * 4);
  p.cnt = (int*)take(512);
  p.bar = (unsigned*)take((size_t)BAR_TOTAL_WORDS * 4);
  char* region = take(0);
  const size_t szP = (size_t)NT * LDP * 2, szRW = (size_t)NT * RWS * 2, szMS = (size_t)NMT * 16384 * 2,
               szMSn = (size_t)NMT * 128 * 4;
  const size_t szT = (size_t)NT * DM * 4, szOUT2 = (size_t)NSLOT * 1024 * 2;
  p.P = (bf16_t*)region;
  p.RW = (bf16_t*)(region + szP);
  p.MS = (bf16_t*)(region + szP + szRW);
  p.MSn = (float*)(region + szP + szRW + szMS);
  p.Zb = p.MS;
  p.L1 = p.MS + (size_t)NT * 1536;
  p.Tb = (float*)region;
  p.ACT = (bf16_t*)region;
  p.OUT2 = (bf16_t*)(region + szT);
  size_t mixer = szP + szRW + szMS + szMSn, moe = szT + szOUT2;
  off += (mixer > moe ? mixer : moe);
  if (off > ws_size) { fprintf(stderr, "workspace too small: need %zu have %zu\n", off, ws_size); return; }
  p.ph_lo = 0;
  p.ph_hi = NPHASE;
  (void)hipMemsetAsync(p.bar, 0, (size_t)BAR_TOTAL_WORDS * 4, stream);
  void* args[] = {&p};
  hipError_t e = hipLaunchCooperativeKernel((void*)mega_kernel, dim3(grid_blocks), dim3(NTHR), args, SMEM_BYTES, stream);
  if (e != hipSuccess) fprintf(stderr, "cooperative launch failed: %s (grid %d)\n", hipGetErrorString(e), grid_blocks);
}
```

```cpp
#include <hip/hip_runtime.h>
#include <hip/hip_cooperative_groups.h>
#include <cstdio>
#include <cstring>
namespace cg = cooperative_groups;

constexpr int DM = 1024;
constexpr int NBATCH = 8;
constexpr int SEQ = 2048;
constexpr int CTXL = 256;
constexpr int NL = NBATCH * SEQ;
constexpr int NC = NBATCH * CTXL;
constexpr int NT = NL + NC;
constexpr int TSC = CTXL + SEQ;
constexpr int LDP = 4112;
constexpr int ATT_N = 2304;
constexpr int REC_N = 4112;
constexpr int REC_NP = 4224;
constexpr int NCHUNK = 36;
constexpr int NMT = 64 * NCHUNK;
constexpr int RWS = 5632;
constexpr int NSLOT = 137216;
constexpr float DN_ALPHA = 1.6817928305074290f;
constexpr int NTHR = 256;
constexpr int SMEM_BYTES = 65536 + 4096;
constexpr int META_OFF = 65536;
#define XCD_BAR_WORDS 3456
constexpr int BAR_TOTAL_WORDS = XCD_BAR_WORDS + 64;

typedef unsigned short bf16_t;
using bf16x8 = __attribute__((ext_vector_type(8))) short;
using f32x16 = __attribute__((ext_vector_type(16))) float;
using u32x4 = __attribute__((ext_vector_type(4))) unsigned;
using u32x2 = __attribute__((ext_vector_type(2))) unsigned;

struct Params {
  const float *x, *c, *ctx, *c_ctx, *ada_w, *ada_b, *ln_g, *ln_b, *mix_w_out, *att_w_in, *na_rpb, *qk_gain,
      *rec_w_in, *rwkv_mu, *rwkv_w0, *rwkv_w1, *rwkv_w2, *rwkv_a0, *rwkv_a1, *rwkv_a2, *rwkv_g1, *rwkv_g2,
      *rwkv_kvec, *rwkv_rk, *rwkv_gn, *mlstm_gate_b, *mlstm_norm, *moe_router, *moe_bias, *moe_w1, *moe_w3,
      *moe_w2, *shared_w1, *shared_w3, *shared_w2;
  float* out;
  bf16_t *Wt_att, *Wt_rec, *Wt_out, *Wt13, *Wt2, *Wl1, *Wl2;
  bf16_t *Zb, *L1;
  float *X, *MOD, *MODP, *GP, *msc, *lgate, *MSn, *Tb, *ROPE;
  bf16_t *AB, *P, *RW, *MS, *ACT, *OUT2;
  int *cnt, *ltok, *tsl;
  unsigned* bar;
  int ph_lo, ph_hi;
};

typedef const Params __attribute__((address_space(4))) * KP;

__device__ __forceinline__ int modrow(int t) { return t < NL ? (t >> 11) : 8; }
__device__ __forceinline__ float silu_f(float x) { return x / (1.f + expf(-x)); }
__device__ __forceinline__ float sigm_f(float x) { return 1.f / (1.f + expf(-x)); }
__device__ __forceinline__ float softplus_f(float x) { return fmaxf(x, 0.f) + log1pf(expf(-fabsf(x))); }
template <int CTRL>
__device__ __forceinline__ float dppx(float x) {
  return __int_as_float(__builtin_amdgcn_update_dpp(0, __float_as_int(x), CTRL, 0xf, 0xf, true));
}
__device__ __forceinline__ float rdlane(float v, int l) {
  return __int_as_float(__builtin_amdgcn_readlane(__float_as_int(v), l));
}
__device__ __forceinline__ float wsum(float v) {
  v += dppx<0xB1>(v); v += dppx<0x4E>(v); v += dppx<0x141>(v); v += dppx<0x140>(v);
  return (rdlane(v, 0) + rdlane(v, 16)) + (rdlane(v, 32) + rdlane(v, 48));
}
__device__ __forceinline__ float wmax(float v) {
  v = fmaxf(v, dppx<0xB1>(v)); v = fmaxf(v, dppx<0x4E>(v)); v = fmaxf(v, dppx<0x141>(v)); v = fmaxf(v, dppx<0x140>(v));
  return fmaxf(fmaxf(rdlane(v, 0), rdlane(v, 16)), fmaxf(rdlane(v, 32), rdlane(v, 48)));
}
__device__ __forceinline__ int opaque_tid() {
  int t = threadIdx.x;
  asm volatile("" : "+v"(t));
  return t;
}
typedef __bf16 bf16x2_t __attribute__((ext_vector_type(2)));
typedef float f32x2_t __attribute__((ext_vector_type(2)));
__device__ __forceinline__ unsigned pk_bf16(float lo, float hi) {
  const f32x2_t v = {lo, hi};
  return __builtin_bit_cast(unsigned, __builtin_convertvector(v, bf16x2_t));
}
__device__ __forceinline__ bf16_t f2bf(float x) { return (bf16_t)(pk_bf16(x, 0.f) & 0xffffu); }
__device__ __forceinline__ float bf2f(bf16_t v) { return __uint_as_float((unsigned)v << 16); }
__device__ __forceinline__ float bflo(unsigned u) { return __uint_as_float(u << 16); }
__device__ __forceinline__ float bfhi(unsigned u) { return __uint_as_float(u & 0xffff0000u); }
__device__ __forceinline__ int scan_row(int dir, int b, int tau) {
  if (tau < CTXL) return NL + b * CTXL + (dir ? (CTXL - 1 - tau) : tau);
  int s = tau - CTXL;
  return b * SEQ + (dir ? (SEQ - 1 - s) : s);
}

template <class RowPtrA>
__device__ __forceinline__ void gemm128_main(int tid, RowPtrA rowA, const bf16_t* __restrict__ Bt, int K, int n0,
                                             char* lds, f32x16 (&acc)[2][2]) {
  const int lane = tid & 63, w = tid >> 6;
  const int wm = w >> 1, wn = w & 1, r = lane & 31, h = lane >> 5;
  const int c = tid & 7, sr = tid >> 3;
  const int lc = (c ^ ((tid >> 4) & 7)) * 8;
  const bf16_t* ap[4];
#pragma unroll
  for (int i = 0; i < 4; ++i) ap[i] = rowA(sr + 32 * i) + lc;
  const bf16_t* bp0 = Bt + (size_t)(n0 + sr) * K + lc;
  const int bstr = 32 * K;
#pragma unroll
  for (int mi = 0; mi < 2; ++mi)
#pragma unroll
    for (int ni = 0; ni < 2; ++ni)
#pragma unroll
      for (int q = 0; q < 16; ++q) acc[mi][ni][q] = 0.f;
  const int nk = K >> 6;
  auto issue = [&](int kt) {
    char* As = lds + (kt & 1) * 32768 + tid * 16;
    const int k0 = kt * 64;
#pragma unroll
    for (int i = 0; i < 4; ++i) {
      __builtin_amdgcn_global_load_lds((const unsigned*)(ap[i] + k0), (__attribute__((address_space(3))) unsigned*)(As + i * 4096), 16, 0, 0);
      __builtin_amdgcn_global_load_lds((const unsigned*)(bp0 + i * bstr + k0), (__attribute__((address_space(3))) unsigned*)(As + 16384 + i * 4096), 16, 0, 0);
    }
  };
  issue(0);
  const int sw = (r >> 1) & 7;
#pragma unroll 1
  for (int kt = 0; kt < nk; ++kt) {
    asm volatile("s_waitcnt vmcnt(0)" ::: "memory");
    __syncthreads();
    if (kt + 1 < nk) issue(kt + 1);
    const char* As = lds + (kt & 1) * 32768;
    const char* Ar = As + (wm * 64 + r) * 128;
    const char* Br = As + 16384 + (wn * 64 + r) * 128;
#pragma unroll
    for (int ks = 0; ks < 4; ++ks) {
      const int off = ((ks * 2 + h) ^ sw) * 16;
      const bf16x8 a0 = *(const bf16x8*)(Ar + off);
      const bf16x8 a1 = *(const bf16x8*)(Ar + 32 * 128 + off);
      const bf16x8 b0 = *(const bf16x8*)(Br + off);
      const bf16x8 b1 = *(const bf16x8*)(Br + 32 * 128 + off);
      acc[0][0] = __builtin_amdgcn_mfma_f32_32x32x16_bf16(a0, b0, acc[0][0], 0, 0, 0);
      acc[0][1] = __builtin_amdgcn_mfma_f32_32x32x16_bf16(a0, b1, acc[0][1], 0, 0, 0);
      acc[1][0] = __builtin_amdgcn_mfma_f32_32x32x16_bf16(a1, b0, acc[1][0], 0, 0, 0);
      acc[1][1] = __builtin_amdgcn_mfma_f32_32x32x16_bf16(a1, b1, acc[1][1], 0, 0, 0);
    }
  }
  __syncthreads();
}
using i64 = long;
template <class RowPtrA8>
__device__ __forceinline__ void gemm128_fp8(int tid, RowPtrA8 rowA, const unsigned char* __restrict__ Bt, int K, int n0,
                                            char* lds, f32x16 (&acc)[2][2]) {
  const int lane = tid & 63, w = tid >> 6;
  const int wm = w >> 1, wn = w & 1, r = lane & 31, h = lane >> 5;
  const int c = tid & 7, sr = tid >> 3;
  const int lc = (c ^ ((tid >> 4) & 7)) * 16;
  const unsigned char* ap[4];
#pragma unroll
  for (int i = 0; i < 4; ++i) ap[i] = rowA(sr + 32 * i) + lc;
  const unsigned char* bp0 = Bt + (size_t)(n0 + sr) * K + lc;
  const int bstr = 32 * K;
#pragma unroll
  for (int mi = 0; mi < 2; ++mi)
#pragma unroll
    for (int ni = 0; ni < 2; ++ni)
#pragma unroll
      for (int q = 0; q < 16; ++q) acc[mi][ni][q] = 0.f;
  const int nk = K >> 7;
  auto issue = [&](int kt) {
    char* As = lds + (kt & 1) * 32768 + tid * 16;
    const int k0 = kt * 128;
#pragma unroll
    for (int i = 0; i < 4; ++i) {
      __builtin_amdgcn_global_load_lds((const unsigned*)(ap[i] + k0), (__attribute__((address_space(3))) unsigned*)(As + i * 4096), 16, 0, 0);
      __builtin_amdgcn_global_load_lds((const unsigned*)(bp0 + i * bstr + k0), (__attribute__((address_space(3))) unsigned*)(As + 16384 + i * 4096), 16, 0, 0);
    }
  };
  issue(0);
  const int sw = (r >> 1) & 7;
#pragma unroll 1
  for (int kt = 0; kt < nk; ++kt) {
    asm volatile("s_waitcnt vmcnt(0)" ::: "memory");
    __syncthreads();
    if (kt + 1 < nk) issue(kt + 1);
    const char* As = lds + (kt & 1) * 32768;
    const char* Ar = As + (wm * 64 + r) * 128;
    const char* Br = As + 16384 + (wn * 64 + r) * 128;
#pragma unroll
    for (int q = 0; q < 4; ++q) {
      const int off = ((q * 2 + h) ^ sw) * 16;
      const u32x4 a0 = *(const u32x4*)(Ar + off);
      const u32x4 a1 = *(const u32x4*)(Ar + 32 * 128 + off);
      const u32x4 b0 = *(const u32x4*)(Br + off);
      const u32x4 b1 = *(const u32x4*)(Br + 32 * 128 + off);
      const i64 a0l = (i64)(((unsigned long long)a0.y << 32) | a0.x), a0h = (i64)(((unsigned long long)a0.w << 32) | a0.z);
      const i64 a1l = (i64)(((unsigned long long)a1.y << 32) | a1.x), a1h = (i64)(((unsigned long long)a1.w << 32) | a1.z);
      const i64 b0l = (i64)(((unsigned long long)b0.y << 32) | b0.x), b0h = (i64)(((unsigned long long)b0.w << 32) | b0.z);
      const i64 b1l = (i64)(((unsigned long long)b1.y << 32) | b1.x), b1h = (i64)(((unsigned long long)b1.w << 32) | b1.z);
      acc[0][0] = __builtin_amdgcn_mfma_f32_32x32x16_fp8_fp8(a0l, b0l, acc[0][0], 0, 0, 0);
      acc[0][1] = __builtin_amdgcn_mfma_f32_32x32x16_fp8_fp8(a0l, b1l, acc[0][1], 0, 0, 0);
      acc[1][0] = __builtin_amdgcn_mfma_f32_32x32x16_fp8_fp8(a1l, b0l, acc[1][0], 0, 0, 0);
      acc[1][1] = __builtin_amdgcn_mfma_f32_32x32x16_fp8_fp8(a1l, b1l, acc[1][1], 0, 0, 0);
      acc[0][0] = __builtin_amdgcn_mfma_f32_32x32x16_fp8_fp8(a0h, b0h, acc[0][0], 0, 0, 0);
      acc[0][1] = __builtin_amdgcn_mfma_f32_32x32x16_fp8_fp8(a0h, b1h, acc[0][1], 0, 0, 0);
      acc[1][0] = __builtin_amdgcn_mfma_f32_32x32x16_fp8_fp8(a1h, b0h, acc[1][0], 0, 0, 0);
      acc[1][1] = __builtin_amdgcn_mfma_f32_32x32x16_fp8_fp8(a1h, b1h, acc[1][1], 0, 0, 0);
    }
  }
  __syncthreads();
}
template <class F>
__device__ __forceinline__ void acc_foreach(int tid, const f32x16 (&acc)[2][2], F f) {
  const int lane = tid & 63, w = tid >> 6;
  const int wm = w >> 1, wn = w & 1, r = lane & 31, h = lane >> 5;
#pragma unroll
  for (int mi = 0; mi < 2; ++mi)
#pragma unroll
    for (int ni = 0; ni < 2; ++ni)
#pragma unroll
      for (int q = 0; q < 16; ++q) {
        const int row = wm * 64 + mi * 32 + (q & 3) + 8 * (q >> 2) + 4 * h;
        const int col = wn * 64 + ni * 32 + r;
        f(row, col, acc[mi][ni][q]);
        if ((q & 3) == 3) __builtin_amdgcn_sched_barrier(0);
      }
}

template <class RM>
__device__ __forceinline__ void tr_tile(int tid, const float* __restrict__ src, int N, int k0, int n0,
                                        bf16_t* __restrict__ dst, int K, RM rowmap, float* tile) {
  {
    const int tx = tid & 15, ty = tid >> 4;
    const int n = n0 + tx * 4;
#pragma unroll
    for (int i = 0; i < 4; ++i) {
      const int k = ty + 16 * i;
      float4 v = make_float4(0.f, 0.f, 0.f, 0.f);
      if (n < N) v = *(const float4*)(src + (size_t)(k0 + k) * N + n);
      tile[k * 65 + tx * 4 + 0] = v.x; tile[k * 65 + tx * 4 + 1] = v.y;
      tile[k * 65 + tx * 4 + 2] = v.z; tile[k * 65 + tx * 4 + 3] = v.w;
    }
  }
  __syncthreads();
  {
    const int kc = tid & 7;
#pragma unroll
    for (int i = 0; i < 2; ++i) {
      const int n = (tid >> 3) + 32 * i;
      if (n0 + n < N) {
        float v[8];
#pragma unroll
        for (int q = 0; q < 8; ++q) v[q] = tile[(kc * 8 + q) * 65 + n];
        u32x4 o;
        o.x = pk_bf16(v[0], v[1]); o.y = pk_bf16(v[2], v[3]); o.z = pk_bf16(v[4], v[5]); o.w = pk_bf16(v[6], v[7]);
        *(u32x4*)(dst + (size_t)rowmap(n0 + n) * K + k0 + kc * 8) = o;
      }
    }
  }
  __syncthreads();
}

constexpr float W8_SCALE = 32.f, W8_INV = 1.f / 32.f;
__device__ __forceinline__ unsigned pk_fp8x4(float a, float b, float c, float d) {
  int r = __builtin_amdgcn_cvt_pk_fp8_f32(a, b, 0, false);
  r = __builtin_amdgcn_cvt_pk_fp8_f32(c, d, r, true);
  return (unsigned)r;
}
template <class RM>
__device__ __forceinline__ void tr_tile_fp8(int tid, const float* __restrict__ src, int N, int k0, int n0,
                                            unsigned char* __restrict__ dst, int K, RM rowmap, float* tile) {
  {
    const int tx = tid & 15, ty = tid >> 4;
    const int n = n0 + tx * 4;
#pragma unroll
    for (int i = 0; i < 4; ++i) {
      const int k = ty + 16 * i;
      const float4 v = *(const float4*)(src + (size_t)(k0 + k) * N + n);
      tile[k * 65 + tx * 4 + 0] = v.x; tile[k * 65 + tx * 4 + 1] = v.y;
      tile[k * 65 + tx * 4 + 2] = v.z; tile[k * 65 + tx * 4 + 3] = v.w;
    }
  }
  __syncthreads();
  {
    const int kc = tid & 3, n = tid >> 2;
    float v[16];
#pragma unroll
    for (int q = 0; q < 16; ++q) v[q] = tile[(kc * 16 + q) * 65 + n] * W8_SCALE;
    u32x4 o;
    o.x = pk_fp8x4(v[0], v[1], v[2], v[3]); o.y = pk_fp8x4(v[4], v[5], v[6], v[7]);
    o.z = pk_fp8x4(v[8], v[9], v[10], v[11]); o.w = pk_fp8x4(v[12], v[13], v[14], v[15]);
    *(u32x4*)(dst + (size_t)rowmap(n0 + n) * K + k0 + kc * 16) = o;
  }
  __syncthreads();
}

constexpr int CJ0 = 1152, CJ1 = CJ0 + 2080, CJ2 = CJ1 + 1024, CJ3 = CJ2 + 33280, CJ4 = CJ3 + 16640;
__device__ void convert_job(KP p, int job, float* sm, int tid) {
  if (job < CJ0) {
    const int j = job / 576, rem = job % 576, kt = rem / 36, nt = rem % 36;
    tr_tile(tid, p->att_w_in + (size_t)j * 1024 * ATT_N, ATT_N, kt * 64, nt * 64, p->Wt_att + (size_t)j * ATT_N * 1024,
            1024, [](int n) { return n; }, sm);
  } else if (job < CJ1) {
    const int q = job - CJ0;
    const int j = q / 1040, rem = q % 1040, kt = rem / 65, nt = rem % 65;
    tr_tile(tid, p->rec_w_in + (size_t)j * 1024 * REC_N, REC_N, kt * 64, nt * 64, p->Wt_rec + (size_t)j * REC_NP * 1024,
            1024, [](int n) { return n; }, sm);
  } else if (job < CJ2) {
    const int q = job - CJ1;
    const int i = q >> 8, rem = q & 255, kt = rem >> 4, nt = rem & 15;
    tr_tile(tid, p->mix_w_out + (size_t)i * 1024 * 1024, 1024, kt * 64, nt * 64, p->Wt_out + (size_t)i * 1024 * 1024,
            1024, [](int n) { return n; }, sm);
  } else if (job < CJ3) {
    const int q = job - CJ2;
    const int le = q >> 7, rem = q & 127;
    const int which = rem >> 6, kt = (rem >> 2) & 15, nt = rem & 3;
    const int layer = le / 65, e = le % 65;
    const float* src;
    if (e < 64) src = (which ? p->moe_w3 : p->moe_w1) + (size_t)(layer * 64 + e) * 1024 * 256;
    else src = (which ? p->shared_w3 : p->shared_w1) + (size_t)layer * 1024 * 256;
    tr_tile_fp8(tid, src, 256, kt * 64, nt * 64, (unsigned char*)p->Wt13 + (size_t)le * 512 * 1024, 1024,
                [which](int n) { return 64 * (n >> 5) + which * 32 + (n & 31); }, sm);
  } else {
    const int q = job - CJ3;
    const int le = q >> 6, rem = q & 63;
    const int kt = rem >> 4, nt = rem & 15;
    const int layer = le / 65, e = le % 65;
    const float* src = e < 64 ? p->moe_w2 + (size_t)(layer * 64 + e) * 256 * 1024 : p->shared_w2 + (size_t)layer * 256 * 1024;
    tr_tile_fp8(tid, src, 1024, kt * 64, nt * 64, (unsigned char*)p->Wt2 + (size_t)le * 1024 * 256, 256, [](int n) { return n; }, sm);
  }
}
__device__ __forceinline__ int conv_stage_total(int stage) {
  return stage == 0 ? (576 + 1040 + 512 + 8320 + 4160) : (stage == 1 ? (576 + 1040 + 256 + 16640 + 8320) : (256 + 8320 + 4160));
}
__device__ __forceinline__ int conv_stage_job(int stage, int q) {
  if (stage == 0) {
    if (q < 8320) return CJ2 + q;  q -= 8320;
    if (q < 4160) return CJ3 + q;  q -= 4160;
    if (q < 576) return q;  q -= 576;
    if (q < 1040) return CJ0 + q;  q -= 1040;
    return CJ1 + q;
  } else if (stage == 1) {
    if (q < 8320) return CJ2 + 8320 + q;  q -= 8320;
    if (q < 4160) return CJ3 + 4160 + q;  q -= 4160;
    if (q < 576) return 576 + q;  q -= 576;
    if (q < 256) return CJ1 + 512 + q;  q -= 256;
    if (q < 8320) return CJ2 + 16640 + q;  q -= 8320;
    if (q < 4160) return CJ3 + 8320 + q;  q -= 4160;
    return CJ0 + 1040 + q;
  }
  if (q < 256) return CJ1 + 768 + q;  q -= 256;
  if (q < 8320) return CJ2 + 24960 + q;  q -= 8320;
  return CJ3 + 12480 + q;
}

__device__ void ph_init(KP p, char* smc) {
  float* sm = (float*)smc;
  const int tid = opaque_tid();
  {
    const size_t n4a = (size_t)NL * DM / 4, n4b = (size_t)NC * DM / 4;
    const float4* xs = (const float4*)p->x;
    const float4* cs = (const float4*)p->ctx;
    float4* X4 = (float4*)p->X;
    for (size_t i = (size_t)blockIdx.x * NTHR + tid; i < n4a + n4b; i += (size_t)gridDim.x * NTHR)
      X4[i] = i < n4a ? xs[i] : cs[i - n4a];
  }
  for (int tile = blockIdx.x; tile < 96 * 8; tile += gridDim.x) {
    const int ct = tile >> 3, ks = tile & 7;
    for (int i = tid; i < 9 * 128; i += NTHR) {
      const int r = i >> 7, k = ks * 128 + (i & 127);
      const float v = r < 8 ? p->c[r * 1024 + k] : p->c_ctx[k];
      sm[i] = silu_f(v);
    }
    __syncthreads();
    const int col = ct * 256 + tid;
    const int layer = col / 6144, n = col % 6144;
    const float* W = p->ada_w + ((size_t)layer * 1024 + ks * 128) * 6144 + n;
    float acc[9];
#pragma unroll
    for (int r = 0; r < 9; ++r) acc[r] = 0.f;
#pragma unroll 4
    for (int k = 0; k < 128; ++k) {
      const float w = W[(size_t)k * 6144];
#pragma unroll
      for (int r = 0; r < 9; ++r) acc[r] = fmaf(sm[r * 128 + k], w, acc[r]);
    }
#pragma unroll
    for (int r = 0; r < 9; ++r) p->MODP[((size_t)(ks * 4 + layer) * 9 + r) * 6144 + n] = acc[r];
    __syncthreads();
  }
  for (int q = blockIdx.x; q < conv_stage_total(0); q += gridDim.x) convert_job(p, conv_stage_job(0, q), sm, tid);
  for (int i = blockIdx.x * NTHR + tid; i < 2 * 3 * 128 * 512; i += gridDim.x * NTHR) {
    const int k = i & 511, n = (i >> 9) & 127, wj = i >> 16;
    const int j = wj / 3, which = wj % 3;
    float v = 0.f;
    if (which < 2) {
      if (n < 64) v = (which ? p->rwkv_a1 : p->rwkv_w1)[((size_t)(j * 2 + (n >> 5)) * 512 + k) * 32 + (n & 31)];
    } else if (n < 96) v = p->rwkv_g1[((size_t)j * 512 + k) * 96 + n];
    p->Wl1[i] = f2bf(v);
  }
  for (int i = blockIdx.x * NTHR + tid; i < 2 * 2560 * 128; i += gridDim.x * NTHR) {
    const int k = i & 127, n = (i >> 7) % 2560, j = i / (2560 * 128);
    float v = 0.f;
    if (n < 2048) {
      const int d = (n >> 9) & 1, c = n & 511;
      if (k < 64 && (k >> 5) == d) v = (n < 1024 ? p->rwkv_w2 : p->rwkv_a2)[((size_t)(j * 2 + d) * 32 + (k & 31)) * 512 + c];
    } else if (k < 96) v = p->rwkv_g2[((size_t)j * 96 + k) * 512 + (n - 2048)];
    p->Wl2[i] = f2bf(v);
  }
  for (int i = blockIdx.x * NTHR + tid; i < 64 * 16; i += gridDim.x * NTHR) {
    const int pos = i >> 4, f = i & 15;
    const float ang = (float)pos * powf(10000.f, -(float)f / 16.f);
    p->ROPE[2 * i] = cosf(ang);
    p->ROPE[2 * i + 1] = sinf(ang);
  }
}

__device__ void ph_mod_h(KP p, char* smc) {
  float* sm = (float*)smc;
  const int tid = opaque_tid();
  for (int i = blockIdx.x * NTHR + tid; i < 4 * 9 * 6144; i += gridDim.x * NTHR) {
    const int layer = i / (9 * 6144), rem = i % (9 * 6144), n = rem % 6144;
    float s = p->ada_b[layer * 6144 + n];
#pragma unroll
    for (int ks = 0; ks < 8; ++ks) s += p->MODP[(size_t)(ks * 4 + layer) * 9 * 6144 + rem];
    p->MOD[i] = s;
  }
  const int lane = tid & 63, wave = tid >> 6;
  const int per = (((NT + gridDim.x - 1) / gridDim.x) + 3) & ~3;
  const int t0 = blockIdx.x * per, t1 = min(NT, t0 + per);
  int cur = -1;
  for (int tb = t0; tb < t1; tb += 4) {
    const int mr = modrow(tb);
    if (mr != cur) {
      __syncthreads();
      for (int n = tid; n < 2048; n += NTHR) {
        float a = p->ada_b[n];
#pragma unroll
        for (int ks = 0; ks < 8; ++ks) a += p->MODP[((size_t)(ks * 4) * 9 + mr) * 6144 + n];
        sm[n] = a;
      }
      cur = mr;
      __syncthreads();
    }
    const int t = tb + wave;
    if (t < t1) {
      const float* src = t < NL ? p->x + (size_t)t * DM : p->ctx + (size_t)(t - NL) * DM;
#pragma unroll
      for (int i = 0; i < 4; ++i) {
        const int n = i * 256 + lane * 4;
        const float4 xv = *(const float4*)(src + n);
        const float4 sh = *(const float4*)(sm + n);
        const float4 sc = *(const float4*)(sm + 1024 + n);
        u32x2 o;
        o.x = pk_bf16(xv.x * (1.f + sc.x) + sh.x, xv.y * (1.f + sc.y) + sh.y);
        o.y = pk_bf16(xv.z * (1.f + sc.z) + sh.z, xv.w * (1.f + sc.w) + sh.w);
        *(u32x2*)(p->AB + (size_t)t * DM + n) = o;
      }
    }
  }
}

typedef short v4i16_t __attribute__((ext_vector_type(4)));
using s16x4 = __attribute__((ext_vector_type(4))) short;
__device__ __forceinline__ s16x4 vtr(const char* p) {
  return __builtin_bit_cast(s16x4, __builtin_amdgcn_ds_read_tr16_b64_v4i16((__attribute__((address_space(3))) v4i16_t*)p));
}
#define MFMA32(a, b, c) __builtin_amdgcn_mfma_f32_32x32x16_bf16(a, b, c, 0, 0, 0)
__device__ void ph_attention(KP p, int layer, bool keep, char* lds) {
  const int tid = opaque_tid();
  const int lane = tid & 63, w = tid >> 6, r32 = lane & 31, hi = lane >> 5;
  const int j = layer >> 1;
  float* bias_lds = (float*)(lds + 32768 + 1024);
  const int n_gqa = 1024, n_na = 1024, n_cb = keep ? 128 : 0, n_ca = keep ? 128 : 0;
  const int total = n_gqa + n_na + n_cb + n_ca;
  constexpr float LOG2E = 1.4426950408889634f;
  constexpr float C2 = 0.125f * LOG2E;
  const int c = tid & 7, sr = tid >> 3;
  const int kso = (c ^ ((tid >> 4) & 7)) * 16;
  const int vso = (c >> 2) * 4096 + (c & 3) * 16;
  const int sw = (r32 >> 1) & 7;
  for (int item = blockIdx.x; item < total; item += gridDim.x) {
    int b, qrow0, qoff, koff, voff, ocol, lat_tiles, lat_row0;
    bool na = false;
    int r_w = 0, start_w = 0, ru0 = 0, hN = 0;
    if (item < n_gqa) {
      b = item >> 7;
      const int g = (item >> 6) & 1, tt = item & 63;
      qrow0 = b * SEQ + tt * 32; qoff = 1536 + (g * 4 + w) * 64; koff = 2048 + g * 64; voff = 2176 + g * 64;
      ocol = 512 + (g * 4 + w) * 64; lat_tiles = 32; lat_row0 = b * SEQ;
    } else if (item < n_gqa + n_na) {
      const int it = item - n_gqa;
      b = it >> 7; hN = (it >> 4) & 7;
      const int rp = it & 15;
      na = true; r_w = 2 * rp + (w >> 1);
      qrow0 = b * SEQ + r_w * 64 + (w & 1) * 32; qoff = hN * 64; koff = 512 + hN * 64; voff = 1024 + hN * 64; ocol = hN * 64;
      const int s0 = min(max(2 * rp - 4, 0), 24), s1 = min(max(2 * rp - 3, 0), 24);
      start_w = (w >> 1) ? s1 : s0; ru0 = s0; lat_tiles = (s1 != s0) ? 9 : 8; lat_row0 = b * SEQ + ru0 * 64;
    } else if (item < n_gqa + n_na + n_cb) {
      const int it = item - n_gqa - n_na;
      b = it >> 4;
      const int g = (it >> 3) & 1, tt = it & 7;
      qrow0 = NL + b * CTXL + tt * 32; qoff = 1536 + (g * 4 + w) * 64; koff = 2048 + g * 64; voff = 2176 + g * 64;
      ocol = 512 + (g * 4 + w) * 64; lat_tiles = 0; lat_row0 = 0;
    } else {
      const int it = item - n_gqa - n_na - n_cb;
      b = it >> 4;
      const int h = (it >> 1) & 7, half = it & 1;
      qrow0 = NL + b * CTXL + half * 128 + w * 32; qoff = h * 64; koff = 512 + h * 64; voff = 1024 + h * 64; ocol = h * 64;
      lat_tiles = 0; lat_row0 = 0;
    }
    const int ctx_row0 = NL + b * CTXL, ntiles = lat_tiles + 4;
    if (na)
      for (int i = tid; i < 465; i += NTHR) bias_lds[i] = p->na_rpb[(j * 8 + hN) * 465 + i] * LOG2E;
    bf16x8 qf[4];
    {
      const bf16_t* qp = p->P + (size_t)(qrow0 + r32) * LDP + qoff + hi * 8;
#pragma unroll
      for (int d0 = 0; d0 < 4; ++d0) qf[d0] = *(const bf16x8*)(qp + d0 * 16);
    }
    f32x16 o0, o1;
#pragma unroll
    for (int q = 0; q < 16; ++q) { o0[q] = 0.f; o1[q] = 0.f; }
    float m = -INFINITY, l = 0.f;
    u32x4 kr0, kr1, vr0, vr1;
    auto gload = [&](int t) {
      const int row0 = t < lat_tiles ? lat_row0 + 64 * t : ctx_row0 + 64 * (t - lat_tiles);
      const bf16_t* base = p->P + (size_t)(row0 + sr) * LDP + c * 8;
      kr0 = *(const u32x4*)(base + koff); kr1 = *(const u32x4*)(base + (size_t)32 * LDP + koff);
      vr0 = *(const u32x4*)(base + voff); vr1 = *(const u32x4*)(base + (size_t)32 * LDP + voff);
    };
    auto swrite = [&](int buf) {
      char* Kb = lds + buf * 16384;
      char* Vb = Kb + 8192;
      *(u32x4*)(Kb + sr * 128 + kso) = kr0; *(u32x4*)(Kb + (sr + 32) * 128 + kso) = kr1;
      *(u32x4*)(Vb + vso + sr * 64) = vr0; *(u32x4*)(Vb + vso + (sr + 32) * 64) = vr1;
    };
    gload(0);
    swrite(0);
    for (int t = 0; t < ntiles; ++t) {
      __syncthreads();
      if (t + 1 < ntiles) gload(t + 1);
      const bool na_tile = na && t < lat_tiles;
      const int kr = ru0 + t;
      const bool part = !na_tile || (kr >= start_w && kr < start_w + 8);
      if (part) {
        const char* Ks = lds + (t & 1) * 16384;
        const char* Vs = Ks + 8192;
        f32x16 s0, s1;
#pragma unroll
        for (int q = 0; q < 16; ++q) { s0[q] = 0.f; s1[q] = 0.f; }
#pragma unroll
        for (int d0 = 0; d0 < 4; ++d0) {
          const int off = ((2 * d0 + hi) ^ sw) * 16;
          const bf16x8 k0 = *(const bf16x8*)(Ks + r32 * 128 + off);
          const bf16x8 k1 = *(const bf16x8*)(Ks + (32 + r32) * 128 + off);
          s0 = MFMA32(k0, qf[d0], s0);
          s1 = MFMA32(k1, qf[d0], s1);
        }
        float mx = -INFINITY;
        if (na_tile) {
          const int cq = (w & 1) * 32 + r32;
          const int c0 = min(max(cq - 8, 0), 48);
          const float* brow = bias_lds + (kr - r_w + 7) * 31 + (15 - cq);
#pragma unroll
          for (int q = 0; q < 16; ++q) {
            const int kc = (q & 3) + 8 * (q >> 2) + 4 * hi;
            const float v0 = ((unsigned)(kc - c0) < 16u) ? fmaf(s0[q], C2, brow[kc]) : -INFINITY;
            const float v1 = ((unsigned)(kc + 32 - c0) < 16u) ? fmaf(s1[q], C2, brow[kc + 32]) : -INFINITY;
            s0[q] = v0; s1[q] = v1;
            mx = fmaxf(mx, fmaxf(v0, v1));
          }
        } else {
#pragma unroll
          for (int q = 0; q < 16; ++q) {
            s0[q] *= C2; s1[q] *= C2;
            mx = fmaxf(mx, fmaxf(s0[q], s1[q]));
          }
        }
        {
          auto rr = __builtin_amdgcn_permlane32_swap(__float_as_uint(mx), __float_as_uint(mx), false, false);
          mx = fmaxf(__uint_as_float(rr[0]), __uint_as_float(rr[1]));
        }
        const float mnew = fmaxf(m, mx);
        const float alpha = __builtin_amdgcn_exp2f(m - mnew);
        float ls = 0.f;
#pragma unroll
        for (int q = 0; q < 16; ++q) {
          s0[q] = __builtin_amdgcn_exp2f(s0[q] - mnew);
          s1[q] = __builtin_amdgcn_exp2f(s1[q] - mnew);
          ls += s0[q] + s1[q];
        }
        l = l * alpha + ls;
        m = mnew;
#pragma unroll
        for (int q = 0; q < 16; ++q) { o0[q] *= alpha; o1[q] *= alpha; }
        bf16x8 pf[4];
#pragma unroll
        for (int s = 0; s < 4; ++s) {
          const int u = (s & 1) * 8;
          u32x4 tpk;
          if (s < 2) {
            tpk.x = pk_bf16(s0[u + 0], s0[u + 1]); tpk.y = pk_bf16(s0[u + 2], s0[u + 3]);
            tpk.z = pk_bf16(s0[u + 4], s0[u + 5]); tpk.w = pk_bf16(s0[u + 6], s0[u + 7]);
          } else {
            tpk.x = pk_bf16(s1[u + 0], s1[u + 1]); tpk.y = pk_bf16(s1[u + 2], s1[u + 3]);
            tpk.z = pk_bf16(s1[u + 4], s1[u + 5]); tpk.w = pk_bf16(s1[u + 6], s1[u + 7]);
          }
          pf[s] = __builtin_bit_cast(bf16x8, tpk);
        }
        const char* vb = Vs + ((lane >> 4) & 1) * 32 + (lane & 3) * 8 + ((lane & 15) >> 2) * 64 + hi * 256;
#pragma unroll
        for (int s = 0; s < 4; ++s) {
          const s16x4 a00 = vtr(vb + (16 * s) * 64), a01 = vtr(vb + (16 * s + 8) * 64);
          const s16x4 a10 = vtr(vb + 4096 + (16 * s) * 64), a11 = vtr(vb + 4096 + (16 * s + 8) * 64);
          const bf16x8 A0 = __builtin_shufflevector(a00, a01, 0, 1, 2, 3, 4, 5, 6, 7);
          const bf16x8 A1 = __builtin_shufflevector(a10, a11, 0, 1, 2, 3, 4, 5, 6, 7);
          o0 = MFMA32(A0, pf[s], o0);
          o1 = MFMA32(A1, pf[s], o1);
        }
      }
      if (t + 1 < ntiles) swrite((t + 1) & 1);
    }
    __syncthreads();
    const float lt = l + __shfl_xor(l, 32);
    const float inv = 1.f / lt;
    bf16_t* op = p->AB + (size_t)(qrow0 + r32) * DM + ocol + 4 * hi;
#pragma unroll
    for (int g = 0; g < 4; ++g) {
      u32x2 v0, v1;
      v0.x = pk_bf16(o0[4 * g] * inv, o0[4 * g + 1] * inv); v0.y = pk_bf16(o0[4 * g + 2] * inv, o0[4 * g + 3] * inv);
      v1.x = pk_bf16(o1[4 * g] * inv, o1[4 * g + 1] * inv); v1.y = pk_bf16(o1[4 * g + 2] * inv, o1[4 * g + 3] * inv);
      *(u32x2*)(op + 8 * g) = v0;
      *(u32x2*)(op + 32 + 8 * g) = v1;
    }
  }
}

__device__ void ph_rwkv_mix(KP p, int layer) {
  const int j = layer >> 1;
  const int tid = opaque_tid();
  const int lane = tid & 63, wave = tid >> 6;
  const float* mu = p->rwkv_mu + j * 6 * 512;
  const int c0 = lane * 8;
  auto unpack = [](const u32x4 u, float (&f)[8]) {
    f[0] = bflo(u.x); f[1] = bfhi(u.x); f[2] = bflo(u.y); f[3] = bfhi(u.y);
    f[4] = bflo(u.z); f[5] = bfhi(u.z); f[6] = bflo(u.w); f[7] = bfhi(u.w);
  };
  auto pack = [](const float (&f)[8]) {
    u32x4 o;
    o.x = pk_bf16(f[0], f[1]); o.y = pk_bf16(f[2], f[3]); o.z = pk_bf16(f[4], f[5]); o.w = pk_bf16(f[6], f[7]);
    return o;
  };
  for (int t = blockIdx.x * 4 + wave; t < NT; t += gridDim.x * 4) {
    bool hasp, hasn;
    if (t < NL) { int s = t & 2047; hasp = s > 0; hasn = s < SEQ - 1; }
    else { int s = (t - NL) & 255; hasp = s > 0; hasn = s < CTXL - 1; }
    const bf16_t* pt = p->P + (size_t)t * LDP + c0;
    bf16_t* rw = p->RW + (size_t)t * RWS + c0;
    bf16_t* zb = p->Zb + (size_t)t * 1536 + c0;
    const u32x4 zero = {0u, 0u, 0u, 0u};
#pragma unroll
    for (int q = 0; q < 4; ++q) {
      float cur[8], pv[8], nx[8], d[8];
      unpack(*(const u32x4*)(pt + q * 512), cur);
      unpack(hasp ? *(const u32x4*)(pt + q * 512 - LDP) : zero, pv);
      unpack(hasn ? *(const u32x4*)(pt + q * 512 + LDP) : zero, nx);
#pragma unroll
      for (int e = 0; e < 8; ++e) d[e] = 0.5f * (pv[e] + nx[e]) - cur[e];
      if (q < 3) {
        float o[8];
        const float* m = mu + q * 512 + c0;
#pragma unroll
        for (int e = 0; e < 8; ++e) o[e] = cur[e] + d[e] * m[e];
        if (q == 0) *(u32x4*)(rw) = pack(o);
        else if (q == 2) *(u32x4*)(rw + 512) = pack(o);
        else {
          *(u32x4*)(rw + 10 * 512) = pack(o);
          float kk[8], ss = 0.f;
          const float* kv0 = p->rwkv_kvec + (j * 2 + 0) * 512 + c0;
#pragma unroll
          for (int e = 0; e < 8; ++e) { kk[e] = o[e] * kv0[e]; ss += kk[e] * kk[e]; }
          ss += dppx<0xB1>(ss); ss += dppx<0x4E>(ss); ss += dppx<0x141>(ss);
          const float rn = rsqrtf(fmaxf(ss, 1e-24f));
#pragma unroll
          for (int e = 0; e < 8; ++e) kk[e] *= rn;
          *(u32x4*)(rw + 2 * 512) = pack(kk);
        }
      } else {
#pragma unroll
        for (int z = 0; z < 3; ++z) {
          float o[8];
          const float* m = mu + (3 + z) * 512 + c0;
#pragma unroll
          for (int e = 0; e < 8; ++e) o[e] = cur[e] + d[e] * m[e];
          *(u32x4*)(zb + z * 512) = pack(o);
        }
      }
    }
  }
}

constexpr int RS_STEP = 384;
constexpr int RS_TB = 16;
struct RwkvStage { u32x2 r, kk, e, ke, a, v; };
__device__ void rwkv_unit(KP p, int unit, float* sm, int tid) {
  const int ch = unit >> 1, hf = unit & 1;
  const int dir = ch >> 6, b = (ch >> 3) & 7, h = ch & 7;
  const int lane = tid & 63, w = tid >> 6, rl = lane >> 3, ks = lane & 7;
  float* ybuf = sm + 2 * RS_TB * RS_STEP;
  const int ss = tid >> 4, kq = tid & 15;
  auto gload = [&](int n, RwkvStage& g) {
    const int row = scan_row(dir, b, n * RS_TB + ss);
    const bf16_t* base = p->RW + (size_t)row * RWS + h * 64 + kq * 4;
    g.r = *(const u32x2*)(base);
    g.kk = *(const u32x2*)(base + 2 * 512);
    g.e = *(const u32x2*)(base + (3 + dir) * 512);
    g.ke = *(const u32x2*)(base + (5 + dir) * 512);
    g.a = *(const u32x2*)(base + (7 + dir) * 512);
    g.v = *(const u32x2*)(p->RW + (size_t)row * RWS + 512 + h * 64 + hf * 32 + (kq & 7) * 4);
  };
  auto swrite = [&](int buf, const RwkvStage& g) {
    float* sp = sm + (buf * RS_TB + ss) * RS_STEP;
    const float r0 = bflo(g.r.x), r1 = bfhi(g.r.x), r2 = bflo(g.r.y), r3 = bfhi(g.r.y);
    const float k0 = bflo(g.kk.x), k1 = bfhi(g.kk.x), k2 = bflo(g.kk.y), k3 = bfhi(g.kk.y);
    const float w0 = __expf(-bflo(g.e.x)), w1 = __expf(-bfhi(g.e.x)), w2 = __expf(-bflo(g.e.y)), w3 = __expf(-bfhi(g.e.y));
    const float e0 = bflo(g.ke.x), e1 = bfhi(g.ke.x), e2 = bflo(g.ke.y), e3 = bfhi(g.ke.y);
    const float a0 = k0 * bflo(g.a.x), a1 = k1 * bfhi(g.a.x), a2 = k2 * bflo(g.a.y), a3 = k3 * bfhi(g.a.y);
    *(float4*)(sp + kq * 4) = make_float4(k0, k1, k2, k3);
    *(float4*)(sp + 64 + kq * 4) = make_float4(w0 * r0, w1 * r1, w2 * r2, w3 * r3);
    *(float4*)(sp + 128 + kq * 4) = make_float4(w0, w1, w2, w3);
    *(float4*)(sp + 192 + kq * 4) = make_float4(a0, a1, a2, a3);
    *(float4*)(sp + 256 + kq * 4) = make_float4(e0, e1, e2, e3);
    if (kq < 8) *(float4*)(sp + 320 + kq * 4) = make_float4(bflo(g.v.x), bfhi(g.v.x), bflo(g.v.y), bfhi(g.v.y));
    float c1 = a0 * r0 + a1 * r1 + a2 * r2 + a3 * r3;
    float c2 = e0 * r0 + e1 * r1 + e2 * r2 + e3 * r3;
    c1 += dppx<0xB1>(c1); c2 += dppx<0xB1>(c2);
    c1 += dppx<0x4E>(c1); c2 += dppx<0x4E>(c2);
    c1 += dppx<0x141>(c1); c2 += dppx<0x141>(c2);
    c1 += dppx<0x140>(c1); c2 += dppx<0x140>(c2);
    if (kq == 0) { sp[352] = c1; sp[353] = c2; }
  };
  typedef float f2 __attribute__((ext_vector_type(2)));
  f2 S01 = {0.f, 0.f}, S23 = {0.f, 0.f}, S45 = {0.f, 0.f}, S67 = {0.f, 0.f};
  auto compute = [&](int n) {
    const float* bp = sm + (n & 1) * RS_TB * RS_STEP;
    float* yb = ybuf + (n & 1) * RS_TB * 32 + w * 8 + rl;
    struct Ops { f2 k[4], r[4], w[4], a[4], e[4]; float vv; f2 c; };
    auto ld = [&](int s, Ops& o) {
      const float* sq = bp + s * RS_STEP;
      const f2* sp = (const f2*)(sq + ks * 8);
#pragma unroll
      for (int i = 0; i < 4; ++i) { o.k[i] = sp[i]; o.r[i] = sp[32 + i]; o.w[i] = sp[64 + i]; o.a[i] = sp[96 + i]; o.e[i] = sp[128 + i]; }
      o.vv = sq[320 + w * 8 + rl]; o.c = *(const f2*)(sq + 352);
    };
    auto step = [&](const Ops& o) -> float {
      f2 sa2 = S01 * o.k[0];
      f2 y2 = S01 * o.r[0];
      sa2 = __builtin_elementwise_fma(S23, o.k[1], sa2); y2 = __builtin_elementwise_fma(S23, o.r[1], y2);
      sa2 = __builtin_elementwise_fma(S45, o.k[2], sa2); y2 = __builtin_elementwise_fma(S45, o.r[2], y2);
      sa2 = __builtin_elementwise_fma(S67, o.k[3], sa2); y2 = __builtin_elementwise_fma(S67, o.r[3], y2);
      float sa = sa2.x + sa2.y, y0 = y2.x + y2.y;
      sa += dppx<0xB1>(sa); y0 += dppx<0xB1>(y0);
      sa += dppx<0x4E>(sa); y0 += dppx<0x4E>(y0);
      sa += dppx<0x141>(sa); y0 += dppx<0x141>(y0);
      sa = -sa;
      const f2 sav = {sa, sa}, vvv = {o.vv, o.vv};
      S01 = __builtin_elementwise_fma(vvv, o.e[0], __builtin_elementwise_fma(sav, o.a[0], S01 * o.w[0]));
      S23 = __builtin_elementwise_fma(vvv, o.e[1], __builtin_elementwise_fma(sav, o.a[1], S23 * o.w[1]));
      S45 = __builtin_elementwise_fma(vvv, o.e[2], __builtin_elementwise_fma(sav, o.a[2], S45 * o.w[2]));
      S67 = __builtin_elementwise_fma(vvv, o.e[3], __builtin_elementwise_fma(sav, o.a[3], S67 * o.w[3]));
      return fmaf(o.vv, o.c.y, fmaf(sa, o.c.x, y0));
    };
    Ops oa, ob;
    ld(0, oa);
#pragma unroll 1
    for (int s = 0; s < RS_TB; s += 2) {
      __builtin_amdgcn_sched_barrier(0);
      ld(s + 1, ob);
      __builtin_amdgcn_sched_barrier(0);
      float y0 = step(oa);
      asm volatile("" : "+v"(y0));
      __builtin_amdgcn_sched_barrier(0);
      ld(s + 2, oa);
      __builtin_amdgcn_sched_barrier(0);
      float y1 = step(ob);
      asm volatile("" : "+v"(y1));
      __builtin_amdgcn_sched_barrier(0);
      if (ks == 0) { yb[s * 32] = y0; yb[(s + 1) * 32] = y1; }
    }
  };
  auto yout = [&](int n) {
    const int row = scan_row(dir, b, n * RS_TB + ss);
    const float* ys = ybuf + (n & 1) * RS_TB * 32 + ss * 32 + kq * 2;
    *(unsigned*)(p->P + (size_t)row * LDP + dir * 512 + h * 64 + hf * 32 + kq * 2) = pk_bf16(ys[0], ys[1]);
  };
  constexpr int NB = TSC / RS_TB;
  RwkvStage gA, gB;
  gload(0, gA);
  gload(1, gB);
  swrite(0, gA);
  gload(2, gA);
  __syncthreads();
  for (int n = 0; n < NB; n += 2) {
    compute(n);
    swrite(1, gB);
    if (n + 3 < NB) gload(n + 3, gB);
    __syncthreads();
    yout(n);
    compute(n + 1);
    if (n + 2 < NB) swrite(0, gA);
    if (n + 4 < NB) gload(n + 4, gA);
    __syncthreads();
    yout(n + 1);
  }
  __syncthreads();
}

__device__ void mlstm_s1(KP p, int layer, int tile, char* lds, int tid) {
  const int j = layer >> 1;
  const int ch = tile / NCHUNK, c = tile % NCHUNK;
  const int dir = ch >> 5, b = (ch >> 2) & 7, h = ch & 3;
  float* s_ws = (float*)(lds + META_OFF);
  int* s_row = (int*)(s_ws + 64);
  char* kimg = lds;
  char* vimg = lds + 16384;
  if (tid < 64) {
    const int row = scan_row(dir, b, c * 64 + tid);
    s_row[tid] = row;
    const float* g = p->GP + (size_t)row * 16;
    const float gi = g[(dir * 2) * 4 + h] + p->mlstm_gate_b[j * 16 + (dir * 2) * 4 + h];
    const float gf = g[(dir * 2 + 1) * 4 + h] + p->mlstm_gate_b[j * 16 + (dir * 2 + 1) * 4 + h];
    float bc = -softplus_f(-gf);
#pragma unroll
    for (int o = 1; o < 64; o <<= 1) {
      float tmp = __shfl_up(bc, o);
      if (tid >= o) bc += tmp;
    }
    const float bend = __shfl(bc, 63);
    const float ds = bend - bc + gi;
    const float mloc = wmax(ds);
    s_ws[tid] = expf(ds - mloc);
    if (tid == 0) { p->msc[tile] = mloc; p->msc[NMT + tile] = bend; }
  }
  __syncthreads();
  {
    const int c8 = tid & 15;
    const int ioff = (c8 >> 2) * 4096 + (c8 & 3) * 16;
#pragma unroll
    for (int i = 0; i < 4; ++i) {
      const int sidx = (tid >> 4) + 16 * i;
      const bf16_t* src = p->P + (size_t)s_row[sidx] * LDP + h * 128 + c8 * 8;
      const u32x4 kv = *(const u32x4*)(src + 2560);
      u32x4 vv = *(const u32x4*)(src + 3072);
      const float wsv = s_ws[sidx];
      vv.x = pk_bf16(bflo(vv.x) * wsv, bfhi(vv.x) * wsv); vv.y = pk_bf16(bflo(vv.y) * wsv, bfhi(vv.y) * wsv);
      vv.z = pk_bf16(bflo(vv.z) * wsv, bfhi(vv.z) * wsv); vv.w = pk_bf16(bflo(vv.w) * wsv, bfhi(vv.w) * wsv);
      *(u32x4*)(kimg + ioff + sidx * 64) = kv;
      *(u32x4*)(vimg + ioff + sidx * 64) = vv;
    }
  }
  __syncthreads();
  const int lane = tid & 63, w = tid >> 6, wm = w >> 1, wn = w & 1, r32 = lane & 31, hi = lane >> 5;
  f32x16 acc[2][2];
#pragma unroll
  for (int mi = 0; mi < 2; ++mi)
#pragma unroll
    for (int ni = 0; ni < 2; ++ni)
#pragma unroll
      for (int q = 0; q < 16; ++q) acc[mi][ni][q] = 0.f;
  const int toff = ((lane >> 4) & 1) * 32 + (lane & 3) * 8 + ((lane & 15) >> 2) * 64 + hi * 256;
#pragma unroll
  for (int ks = 0; ks < 4; ++ks) {
    bf16x8 af[2], bfr[2];
#pragma unroll
    for (int i = 0; i < 2; ++i) {
      const char* ka = kimg + (wm * 2 + i) * 4096 + toff + (16 * ks) * 64;
      const char* va = vimg + (wn * 2 + i) * 4096 + toff + (16 * ks) * 64;
      af[i] = __builtin_shufflevector(vtr(ka), vtr(ka + 8 * 64), 0, 1, 2, 3, 4, 5, 6, 7);
      bfr[i] = __builtin_shufflevector(vtr(va), vtr(va + 8 * 64), 0, 1, 2, 3, 4, 5, 6, 7);
    }
    acc[0][0] = MFMA32(af[0], bfr[0], acc[0][0]);
    acc[0][1] = MFMA32(af[0], bfr[1], acc[0][1]);
    acc[1][0] = MFMA32(af[1], bfr[0], acc[1][0]);
    acc[1][1] = MFMA32(af[1], bfr[1], acc[1][1]);
  }
  bf16_t* U = p->MS + (size_t)tile * 16384;
#pragma unroll
  for (int mi = 0; mi < 2; ++mi)
#pragma unroll
    for (int ni = 0; ni < 2; ++ni)
#pragma unroll
      for (int q = 0; q < 16; ++q) {
        const int d = wm * 64 + mi * 32 + (q & 3) + 8 * (q >> 2) + 4 * hi;
        U[d * 128 + wn * 64 + ni * 32 + r32] = f2bf(acc[mi][ni][q]);
        if ((q & 3) == 3) __builtin_amdgcn_sched_barrier(0);
      }
  if (tid < 128) {
    const char* kc = kimg + (tid >> 5) * 4096 + (tid & 31) * 2;
    float a = 0.f;
#pragma unroll 8
    for (int sidx = 0; sidx < 64; ++sidx) a = fmaf(s_ws[sidx], bf2f(*(const bf16_t*)(kc + sidx * 64)), a);
    p->MSn[tile * 128 + tid] = a;
  }
}

__device__ void mlstm_s3(KP p, int layer, int tile, char* lds, int tid);
__device__ void ph_scan_a(KP p, int layer, char* smc) {
  float* sm = (float*)smc;
  const int tid = opaque_tid();
  for (int u = blockIdx.x; u < 256; u += gridDim.x) rwkv_unit(p, u, sm, tid);
  {
    const int stage = layer == 1 ? 1 : 2;
    const int total = NMT + conv_stage_total(stage);
    int* qc = (int*)(p->bar + XCD_BAR_WORDS + 16 * stage);
    int* s_q = (int*)(smc + META_OFF + 3968);
    for (;;) {
      __syncthreads();
      if (tid == 0) *s_q = atomicAdd(qc, 1);
      __syncthreads();
      const int q = *s_q;
      if (q >= total) break;
      if (q < NMT) mlstm_s3(p, layer, q, smc, tid);
      else convert_job(p, conv_stage_job(stage, q - NMT), sm, tid);
    }
  }
}

__device__ void ph_mlstm_s2(KP p, char* smc) {
  float* sw = (float*)smc;
  const int tid = opaque_tid();
  const int nitems = 64 * 33;
  for (int item = blockIdx.x; item < nitems; item += gridDim.x) {
    const int ch = item / 33, seg = item % 33;
    __syncthreads();
    if (tid == 0) {
      float m = 0.f;
      for (int c = 0; c < NCHUNK; ++c) {
        const int tile = ch * NCHUNK + c;
        const float mloc = p->msc[tile], bend = p->msc[NMT + tile];
        const float mn = fmaxf(bend + m, mloc);
        sw[c] = expf(bend + m - mn);
        sw[36 + c] = expf(mloc - mn);
        if (seg == 0) p->msc[2 * NMT + tile] = m;
        m = mn;
      }
    }
    __syncthreads();
    if (seg < 32) {
      unsigned* base = (unsigned*)(p->MS + (size_t)ch * NCHUNK * 16384) + seg * 256 + tid;
      unsigned v[NCHUNK];
#pragma unroll
      for (int c = 0; c < NCHUNK; ++c) v[c] = base[(size_t)c * 8192];
      float C0 = 0.f, C1 = 0.f;
#pragma unroll
      for (int c = 0; c < NCHUNK; ++c) {
        const float t0 = bflo(v[c]), t1 = bfhi(v[c]);
        v[c] = pk_bf16(C0, C1);
        C0 = sw[c] * C0 + sw[36 + c] * t0;
        C1 = sw[c] * C1 + sw[36 + c] * t1;
      }
#pragma unroll
      for (int c = 0; c < NCHUNK; ++c) base[(size_t)c * 8192] = v[c];
    } else if (tid < 128) {
      float* base = p->MSn + (size_t)ch * NCHUNK * 128 + tid;
      float v[NCHUNK];
#pragma unroll
      for (int c = 0; c < NCHUNK; ++c) v[c] = base[c * 128];
      float C = 0.f;
#pragma unroll
      for (int c = 0; c < NCHUNK; ++c) {
        const float t0 = v[c];
        v[c] = C;
        C = sw[c] * C + sw[36 + c] * t0;
      }
#pragma unroll
      for (int c = 0; c < NCHUNK; ++c) base[c * 128] = v[c];
    }
  }
}

__device__ void mlstm_s3(KP p, int layer, int tile, char* lds, int tid) {
  const int j = layer >> 1;
  const int ch = tile / NCHUNK, c = tile % NCHUNK;
  const int dir = ch >> 5, b = (ch >> 2) & 7, h = ch & 3;
  float* s_b = (float*)(lds + META_OFF);
  float* s_ig = s_b + 64;
  float* s_mt = s_b + 128;
  float* s_wi = s_b + 192;
  int* s_row = (int*)(s_b + 256);
  float* s_n = s_b + 320;
  float* s_c = s_b + 448;
  char* kimg = lds;
  char* vimg = lds + 16384;
  char* cimg = lds + 32768;
  const float mprev = p->msc[2 * NMT + tile];
  const float qscale = 0.08838834764831845f;
  if (tid < 64) {
    const int row = scan_row(dir, b, c * 64 + tid);
    s_row[tid] = row;
    const float* g = p->GP + (size_t)row * 16;
    const float gi = g[(dir * 2) * 4 + h] + p->mlstm_gate_b[j * 16 + (dir * 2) * 4 + h];
    const float gf = g[(dir * 2 + 1) * 4 + h] + p->mlstm_gate_b[j * 16 + (dir * 2 + 1) * 4 + h];
    float bc = -softplus_f(-gf);
#pragma unroll
    for (int o = 1; o < 64; o <<= 1) {
      float tmp = __shfl_up(bc, o);
      if (tid >= o) bc += tmp;
    }
    s_b[tid] = bc;
    s_ig[tid] = gi;
  } else if (tid < 192) s_n[tid - 64] = p->MSn[tile * 128 + (tid - 64)];
  __syncthreads();
  if (tid < 64) {
    const float bt = s_b[tid];
    float mt = bt + mprev;
    for (int sx = 0; sx <= tid; ++sx) mt = fmaxf(mt, bt - s_b[sx] + s_ig[sx]);
    s_mt[tid] = mt;
    s_wi[tid] = expf(bt + mprev - mt);
    s_c[tid] = (s_ig[tid] - bt) * 1.4426950408889634f;
  }
  {
    const int c8 = tid & 15;
    const int ioff = (c8 >> 2) * 4096 + (c8 & 3) * 16;
#pragma unroll
    for (int i = 0; i < 4; ++i) {
      const int sidx = (tid >> 4) + 16 * i;
      const bf16_t* src = p->P + (size_t)s_row[sidx] * LDP + h * 128 + c8 * 8;
      *(u32x4*)(kimg + sidx * 256 + ((c8 ^ (sidx & 15)) * 16)) = *(const u32x4*)(src + 2560);
      *(u32x4*)(vimg + ioff + sidx * 64) = *(const u32x4*)(src + 3072);
    }
    __builtin_amdgcn_sched_barrier(0);
    const bf16_t* Cp = p->MS + (size_t)tile * 16384;
    const int coff = (c8 >> 2) * 8192 + (c8 & 3) * 16;
#pragma unroll
    for (int i = 0; i < 8; ++i) {
      const int d = (tid >> 4) + 16 * i;
      *(u32x4*)(cimg + coff + d * 64) = *(const u32x4*)(Cp + d * 128 + c8 * 8);
      if (i == 3) __builtin_amdgcn_sched_barrier(0);
    }
    __builtin_amdgcn_sched_barrier(0);
  }
  const int lane = tid & 63, w = tid >> 6, wt = w >> 1, wv = w & 1, r32 = lane & 31, hi = lane >> 5;
  const int t = wt * 32 + r32;
  bf16x8 qf[8];
  {
    const bf16_t* qp = p->P + (size_t)s_row[t] * LDP + 2048 + h * 128 + hi * 8;
#pragma unroll
    for (int d0 = 0; d0 < 8; ++d0) qf[d0] = *(const bf16x8*)(qp + d0 * 16);
  }
  __syncthreads();
  const int toff = ((lane >> 4) & 1) * 32 + (lane & 3) * 8 + ((lane & 15) >> 2) * 64;
  constexpr float LOG2E_ = 1.4426950408889634f;
  float qn = 0.f;
#pragma unroll
  for (int d0 = 0; d0 < 8; ++d0) {
    const u32x4 qq = __builtin_bit_cast(u32x4, qf[d0]);
    const float* np = s_n + d0 * 16 + hi * 8;
    qn = fmaf(bflo(qq.x), np[0], qn); qn = fmaf(bfhi(qq.x), np[1], qn);
    qn = fmaf(bflo(qq.y), np[2], qn); qn = fmaf(bfhi(qq.y), np[3], qn);
    qn = fmaf(bflo(qq.z), np[4], qn); qn = fmaf(bfhi(qq.z), np[5], qn);
    qn = fmaf(bflo(qq.w), np[6], qn); qn = fmaf(bfhi(qq.w), np[7], qn);
  }
  qn += __shfl_xor(qn, 32);
  const float mtt = s_mt[t], wi = s_wi[t];
  const float ct = (s_b[t] - mtt) * LOG2E_;
  const float wq = wi * qscale;
  bf16x8 pf[4];
  float den = 0.f;
  {
    f32x16 sa0, sa1;
#pragma unroll
    for (int q = 0; q < 16; ++q) { sa0[q] = 0.f; sa1[q] = 0.f; }
#pragma unroll
    for (int d0 = 0; d0 < 8; ++d0) {
      const int chn = 2 * d0 + hi;
      const bf16x8 k0 = *(const bf16x8*)(kimg + r32 * 256 + ((chn ^ (r32 & 15)) * 16));
      sa0 = MFMA32(k0, qf[d0], sa0);
      if (wt) {
        const bf16x8 k1 = *(const bf16x8*)(kimg + (32 + r32) * 256 + ((chn ^ (r32 & 15)) * 16));
        sa1 = MFMA32(k1, qf[d0], sa1);
      }
      __builtin_amdgcn_sched_barrier(0);
    }
#pragma unroll
    for (int g = 0; g < 4; ++g) {
      const int sb0 = 8 * g + 4 * hi;
      const float4 c0v = *(const float4*)(s_c + sb0);
      const float4 c1v = *(const float4*)(s_c + sb0 + 32);
      const float cc0[4] = {c0v.x, c0v.y, c0v.z, c0v.w}, cc1[4] = {c1v.x, c1v.y, c1v.z, c1v.w};
#pragma unroll
      for (int e = 0; e < 4; ++e) {
        const int q = 4 * g + e;
        const float v0 = (sb0 + e <= t) ? sa0[q] * qscale * __builtin_amdgcn_exp2f(ct + cc0[e]) : 0.f;
        sa0[q] = v0; den += v0;
        const float v1 = (wt && sb0 + 32 + e <= t) ? sa1[q] * qscale * __builtin_amdgcn_exp2f(ct + cc1[e]) : 0.f;
        sa1[q] = v1; den += v1;
      }
      __builtin_amdgcn_sched_barrier(0);
    }
#pragma unroll
    for (int sx = 0; sx < 4; ++sx) {
      const int u = (sx & 1) * 8;
      u32x4 tpk;
      if (sx < 2) {
        tpk.x = pk_bf16(sa0[u + 0], sa0[u + 1]); tpk.y = pk_bf16(sa0[u + 2], sa0[u + 3]);
        tpk.z = pk_bf16(sa0[u + 4], sa0[u + 5]); tpk.w = pk_bf16(sa0[u + 6], sa0[u + 7]);
      } else {
        tpk.x = pk_bf16(sa1[u + 0], sa1[u + 1]); tpk.y = pk_bf16(sa1[u + 2], sa1[u + 3]);
        tpk.z = pk_bf16(sa1[u + 4], sa1[u + 5]); tpk.w = pk_bf16(sa1[u + 6], sa1[u + 7]);
      }
      pf[sx] = __builtin_bit_cast(bf16x8, tpk);
    }
  }
  den += __shfl_xor(den, 32);
  const float dtot = den + wq * qn;
  const float inv = 1.f / fmaxf(fabsf(dtot), expf(-mtt));
  bf16_t* op = p->P + (size_t)s_row[t] * LDP + 1024 + dir * 512 + h * 128 + wv * 64 + 4 * hi;
#pragma unroll 1
  for (int vp = 0; vp < 2; ++vp) {
    f32x16 o0;
#pragma unroll
    for (int q = 0; q < 16; ++q) o0[q] = 0.f;
    const char* cb = cimg + (wv * 2 + vp) * 8192 + toff + hi * 512;
#pragma unroll
    for (int d0 = 0; d0 < 8; ++d0) {
      const bf16x8 A0 = __builtin_shufflevector(vtr(cb + (16 * d0) * 64), vtr(cb + (16 * d0 + 4) * 64), 0, 1, 2, 3, 4, 5, 6, 7);
      o0 = MFMA32(A0, qf[d0], o0);
    }
#pragma unroll
    for (int q = 0; q < 16; ++q) o0[q] *= wq;
    const char* vb = vimg + (wv * 2 + vp) * 4096 + toff + hi * 256;
#pragma unroll
    for (int sx = 0; sx < 4; ++sx) {
      if (sx < 2 || wt) {
        const bf16x8 A0 = __builtin_shufflevector(vtr(vb + (16 * sx) * 64), vtr(vb + (16 * sx + 8) * 64), 0, 1, 2, 3, 4, 5, 6, 7);
        o0 = MFMA32(A0, pf[sx], o0);
      }
    }
#pragma unroll
    for (int g = 0; g < 4; ++g) {
      u32x2 v0;
      v0.x = pk_bf16(o0[4 * g] * inv, o0[4 * g + 1] * inv); v0.y = pk_bf16(o0[4 * g + 2] * inv, o0[4 * g + 3] * inv);
      *(u32x2*)(op + vp * 32 + 8 * g) = v0;
    }
  }
}

__device__ void ph_mlstm_s1(KP p, int layer, char* smc) {
  const int tid = opaque_tid();
  __syncthreads();
  for (int tile = blockIdx.x; tile < NMT; tile += gridDim.x) { mlstm_s1(p, layer, tile, smc, tid); __syncthreads(); }
}

__device__ void ph_rec_final(KP p, int layer, bool keep) {
  const int tid = opaque_tid();
  const int j = layer >> 1;
  const int lane = tid & 63, wave = tid >> 6;
  const int rows = keep ? NT : NL;
  const int c0 = lane * 8;
  auto unpack = [](const u32x4 u, float (&f)[8]) {
    f[0] = bflo(u.x); f[1] = bfhi(u.x); f[2] = bflo(u.y); f[3] = bfhi(u.y);
    f[4] = bflo(u.z); f[5] = bfhi(u.z); f[6] = bflo(u.w); f[7] = bfhi(u.w);
  };
  for (int t = blockIdx.x * 4 + wave; t < rows; t += gridDim.x * 4) {
    const bf16_t* rw = p->RW + (size_t)t * RWS + c0;
    const bf16_t* pt = p->P + (size_t)t * LDP + c0;
    bf16_t* mo = p->AB + (size_t)t * DM + c0;
    {
      float yf[8], yb[8], r[8], v[8], k0[8], k1[8], g[8], y[8], o[8];
      unpack(*(const u32x4*)(pt), yf); unpack(*(const u32x4*)(pt + 512), yb);
      unpack(*(const u32x4*)(rw), r); unpack(*(const u32x4*)(rw + 512), v);
      unpack(*(const u32x4*)(rw + 5 * 512), k0); unpack(*(const u32x4*)(rw + 6 * 512), k1);
      unpack(*(const u32x4*)(rw + 9 * 512), g);
      float s1 = 0.f, bs = 0.f;
      const float* rk = p->rwkv_rk + j * 512 + c0;
#pragma unroll
      for (int e = 0; e < 8; ++e) { y[e] = yf[e] + yb[e]; s1 += y[e]; bs += r[e] * rk[e] * (k0[e] + k1[e]); }
      s1 += dppx<0xB1>(s1); s1 += dppx<0x4E>(s1); s1 += dppx<0x141>(s1);
      bs += dppx<0xB1>(bs); bs += dppx<0x4E>(bs); bs += dppx<0x141>(bs);
      const float mu = s1 * (1.f / 64.f);
      float s2 = 0.f;
#pragma unroll
      for (int e = 0; e < 8; ++e) { const float d = y[e] - mu; s2 += d * d; }
      s2 += dppx<0xB1>(s2); s2 += dppx<0x4E>(s2); s2 += dppx<0x141>(s2);
      const float rs = rsqrtf(s2 * (1.f / 64.f) + 64e-5f);
      const float* gn0 = p->rwkv_gn + (j * 2 + 0) * 512 + c0;
      const float* gn1 = p->rwkv_gn + (j * 2 + 1) * 512 + c0;
#pragma unroll
      for (int e = 0; e < 8; ++e) o[e] = ((y[e] - mu) * rs * gn0[e] + gn1[e] + bs * v[e]) * g[e];
      u32x4 ov;
      ov.x = pk_bf16(o[0], o[1]); ov.y = pk_bf16(o[2], o[3]); ov.z = pk_bf16(o[4], o[5]); ov.w = pk_bf16(o[6], o[7]);
      *(u32x4*)(mo) = ov;
    }
    {
      float hf[8], hb[8], og[8], hsum[8], o[8];
      unpack(*(const u32x4*)(pt + 1024), hf); unpack(*(const u32x4*)(pt + 1536), hb);
      unpack(*(const u32x4*)(pt + 3584), og);
      float ss = 0.f;
#pragma unroll
      for (int e = 0; e < 8; ++e) { hsum[e] = hf[e] + hb[e]; ss += hsum[e] * hsum[e]; }
      ss += dppx<0xB1>(ss); ss += dppx<0x4E>(ss); ss += dppx<0x141>(ss); ss += dppx<0x140>(ss);
      const float rs = rsqrtf(ss * (1.f / 128.f) + 1e-6f);
      const float* ng = p->mlstm_norm + j * 512 + c0;
#pragma unroll
      for (int e = 0; e < 8; ++e) o[e] = hsum[e] * rs * ng[e] * sigm_f(og[e]);
      u32x4 ov;
      ov.x = pk_bf16(o[0], o[1]); ov.y = pk_bf16(o[2], o[3]); ov.z = pk_bf16(o[4], o[5]); ov.w = pk_bf16(o[6], o[7]);
      *(u32x4*)(mo + 512) = ov;
    }
  }
}

using f32x4v = __attribute__((ext_vector_type(4))) float;
__device__ void ph_ln_router(KP p, int layer, bool keep, char* smc) {
  float* h2s = (float*)smc;
  float* lgs = (float*)smc;
  const int tid = opaque_tid();
  const int lane = tid & 63, wave = tid >> 6;
  const int rows = keep ? NT : NL;
  const float* lng = p->ln_g + (layer * 2 + 0) * 1024;
  const float* lnb = p->ln_b + (layer * 2 + 0) * 1024;
  const float* Wr = p->moe_router + (size_t)layer * 1024 * 64;
  for (int tile = blockIdx.x; tile < rows / 16; tile += gridDim.x) {
    const int t0 = tile * 16;
    const float* mod = p->MOD + (layer * 9 + modrow(t0)) * 6144;
#pragma unroll 1
    for (int q = 0; q < 4; ++q) {
      const int tl = wave * 4 + q, t = t0 + tl;
      float4 v[4];
      float s = 0.f;
#pragma unroll
      for (int i = 0; i < 4; ++i) {
        v[i] = *(const float4*)(p->Tb + (size_t)t * DM + i * 256 + lane * 4);
        s += (v[i].x + v[i].y) + (v[i].z + v[i].w);
      }
      const float mean = wsum(s) * (1.f / 1024.f);
      float qq = 0.f;
#pragma unroll
      for (int i = 0; i < 4; ++i) {
        const float d0 = v[i].x - mean, d1 = v[i].y - mean, d2 = v[i].z - mean, d3 = v[i].w - mean;
        qq += (d0 * d0 + d1 * d1) + (d2 * d2 + d3 * d3);
      }
      const float rs = rsqrtf(wsum(qq) * (1.f / 1024.f) + 1e-5f);
#pragma unroll
      for (int i = 0; i < 4; ++i) {
        const int n = i * 256 + lane * 4;
        const float4 g = *(const float4*)(lng + n), bb = *(const float4*)(lnb + n);
        const float4 sc = *(const float4*)(mod + 4096 + n), sh = *(const float4*)(mod + 3072 + n);
        const float4 xn = make_float4((v[i].x - mean) * rs * g.x + bb.x, (v[i].y - mean) * rs * g.y + bb.y,
                                      (v[i].z - mean) * rs * g.z + bb.z, (v[i].w - mean) * rs * g.w + bb.w);
        *(float4*)(p->X + (size_t)t * DM + n) = xn;
        const float4 hh = make_float4(xn.x * (1.f + sc.x) + sh.x, xn.y * (1.f + sc.y) + sh.y,
                                      xn.z * (1.f + sc.z) + sh.z, xn.w * (1.f + sc.w) + sh.w);
        *(unsigned*)((unsigned char*)p->AB + (size_t)t * DM + n) = pk_fp8x4(hh.x, hh.y, hh.z, hh.w);
        *(float4*)(h2s + tl * 1028 + n) = hh;
      }
    }
    __syncthreads();
    f32x4v acc = {0.f, 0.f, 0.f, 0.f};
    {
      f32x4v a1 = {0.f, 0.f, 0.f, 0.f}, a2 = {0.f, 0.f, 0.f, 0.f}, a3 = {0.f, 0.f, 0.f, 0.f};
      const int i = lane & 15, kk = lane >> 4;
      const float* arow = h2s + i * 1028 + 4 * kk;
      const float* bcol = Wr + (4 * kk) * 64 + 16 * wave + i;
#pragma unroll 4
      for (int q = 0; q < 64; ++q) {
        const float4 a = *(const float4*)(arow + 16 * q);
        const float b0 = bcol[(16 * q + 0) * 64], b1 = bcol[(16 * q + 1) * 64];
        const float b2 = bcol[(16 * q + 2) * 64], b3 = bcol[(16 * q + 3) * 64];
        acc = __builtin_amdgcn_mfma_f32_16x16x4f32(a.x, b0, acc, 0, 0, 0);
        a1 = __builtin_amdgcn_mfma_f32_16x16x4f32(a.y, b1, a1, 0, 0, 0);
        a2 = __builtin_amdgcn_mfma_f32_16x16x4f32(a.z, b2, a2, 0, 0, 0);
        a3 = __builtin_amdgcn_mfma_f32_16x16x4f32(a.w, b3, a3, 0, 0, 0);
      }
      acc = (acc + a1) + (a2 + a3);
    }
    __syncthreads();
#pragma unroll
    for (int r = 0; r < 4; ++r) lgs[((lane >> 4) * 4 + r) * 64 + 16 * wave + (lane & 15)] = acc[r];
    __syncthreads();
#pragma unroll 1
    for (int q = 0; q < 4; ++q) {
      const int tl = wave * 4 + q, t = t0 + tl;
      const float logit = lgs[tl * 64 + lane];
      const float score = sigm_f(logit);
      float sel = score + p->moe_bias[layer * 64 + lane];
      bool chosen = false;
      for (int r = 0; r < 6; ++r) {
        const float mx = wmax(sel);
        const unsigned long long bal = __ballot(sel == mx);
        const int first = __ffsll((long long)bal) - 1;
        if (lane == first) { chosen = true; sel = -INFINITY; }
      }
      const float gsum = wsum(chosen ? score : 0.f);
      const unsigned long long cb = __ballot(chosen);
      if (chosen) {
        const int kidx = __popcll(cb & ((1ull << lane) - 1ull));
        const int pos = atomicAdd(&p->cnt[lane], 1);
        p->ltok[(size_t)lane * NT + pos] = t;
        p->lgate[(size_t)lane * NT + pos] = score / gsum * 2.5f;
        p->tsl[t * 6 + kidx] = (lane << 16) | pos;
      }
    }
    __syncthreads();
  }
}

__device__ __forceinline__ void moe_prefix(KP p, int rows, int* s_pref, int tid) {
  if (tid == 0) {
    int a = 0;
    for (int e = 0; e < 64; ++e) { s_pref[e] = a; a += (p->cnt[e] + 127) >> 7; }
    s_pref[64] = a; a += rows >> 7;
    s_pref[65] = a;
  }
  __syncthreads();
}

__device__ void ph_gemm(KP p, int kind, int layer, bool keep, char* lds) {
  const int tid = opaque_tid();
  const int j = layer >> 1;
  const bool att = !(layer & 1);
  const int rows = keep ? NT : NL;
  int* pref = (int*)(lds + META_OFF);
  int* s_idx = pref + 66;
  float* s_gate = (float*)(s_idx + 128);
  if (kind == 1 && blockIdx.x == 0 && tid < 65) p->cnt[tid] = 0;
  if (kind == 2 || kind == 3) moe_prefix(p, rows, pref, tid);
  int total;
  const int ntn_in = att ? 18 : 33;
  switch (kind) {
    case 0: total = (NT / 128) * ntn_in; break;
    case 1: total = (rows / 128) * 8; break;
    case 2: total = pref[65] * 4; break;
    case 3: total = pref[65] * 8; break;
    case 4: total = (NT / 128) * 3; break;
    default: total = (NT / 128) * 20; break;
  }
  for (int tile = blockIdx.x; tile < total; tile += gridDim.x) {
    const bf16_t* Abase; const bf16_t* Bt;
    int astride, K, n0, m0 = 0, aux = 0, e = 0, mtile = 0;
    switch (kind) {
      case 0: { const int tm = tile / ntn_in, tn = tile % ntn_in; m0 = tm * 128; n0 = tn * 128;
                Abase = p->AB + (size_t)m0 * DM; astride = DM; K = 1024;
                Bt = att ? p->Wt_att + (size_t)j * ATT_N * 1024 : p->Wt_rec + (size_t)j * REC_NP * 1024; } break;
      case 1: { const int tm = tile >> 3, tn = tile & 7; m0 = tm * 128; n0 = tn * 128;
                Abase = p->AB + (size_t)m0 * DM; astride = DM; K = 1024; Bt = p->Wt_out + (size_t)layer * 1024 * 1024; } break;
      case 2: { mtile = tile >> 2; aux = tile & 3; n0 = aux * 128; while (mtile >= pref[e + 1]) ++e;
                Abase = p->AB; astride = DM; K = 1024;
                Bt = (const bf16_t*)((const unsigned char*)p->Wt13 + (size_t)(layer * 65 + e) * 512 * 1024); } break;
      case 3: { mtile = tile >> 3; aux = tile & 7; n0 = aux * 128; while (mtile >= pref[e + 1]) ++e;
                Abase = (const bf16_t*)((const unsigned char*)p->ACT + (size_t)mtile * 128 * 256); astride = 256; K = 256;
                Bt = (const bf16_t*)((const unsigned char*)p->Wt2 + (size_t)(layer * 65 + e) * 1024 * 256); } break;
      case 4: { const int tm = tile / 3; aux = tile % 3; m0 = tm * 128; n0 = 0;
                Abase = p->Zb + (size_t)m0 * 1536 + aux * 512; astride = 1536; K = 512; Bt = p->Wl1 + (size_t)(j * 3 + aux) * 128 * 512; } break;
      default: { const int tm = tile / 20; aux = tile % 20; m0 = tm * 128; n0 = aux * 128;
                const int grp = aux < 8 ? 0 : (aux < 16 ? 1 : 2);
                Abase = p->L1 + (size_t)m0 * 384 + grp * 128; astride = 384; K = 128; Bt = p->Wl2 + (size_t)j * 2560 * 128; } break;
    }
    if (tid < 128) {
      int idx = tid; float g = 1.f;
      if (kind == 2 || kind == 3) {
        const int pos = (mtile - pref[e]) * 128 + tid;
        if (kind == 2) {
          idx = 0;
          if (e < 64) { if (pos < p->cnt[e]) idx = p->ltok[(size_t)e * NT + pos]; }
          else idx = pos;
        } else if (e < 64) g = pos < p->cnt[e] ? p->lgate[(size_t)e * NT + pos] : 0.f;
      }
      s_idx[tid] = idx; s_gate[tid] = g;
    }
    __syncthreads();
    {
      f32x16 acc[2][2];
      if (kind == 2 || kind == 3) {
        const unsigned char* A8 = (const unsigned char*)Abase;
        gemm128_fp8(tid, [&](int r) { return A8 + (size_t)s_idx[r] * astride; }, (const unsigned char*)Bt, K, n0, lds, acc);
      } else
        gemm128_main(tid, [&](int r) { return Abase + (size_t)s_idx[r] * astride; }, Bt, K, n0, lds, acc);
      float* Ct = (float*)lds;
      acc_foreach(tid, acc, [&](int row, int col, float v) { Ct[row * 128 + col] = v; });
    }
    __syncthreads();
    {
      const float* Ct = (const float*)lds;
      const int c4 = (tid & 31) * 4, r0 = tid >> 5;
      const int N_in = att ? ATT_N : REC_N;
      const int d5 = (aux >> 2) & 1, c05 = (aux & 3) * 128;
      switch (kind) {
        case 0: {
#pragma unroll 8
          for (int it = 0; it < 16; ++it) {
            const int row = it * 8 + r0;
            const float4 v = *(const float4*)(Ct + row * 128 + c4);

            const int cn = n0 + c4;
            float4 vq = v;
            if (att && n0 >= 1536 && n0 < 2176) {
              float ss = v.x * v.x + v.y * v.y + v.z * v.z + v.w * v.w;
              ss += dppx<0xB1>(ss); ss += dppx<0x4E>(ss); ss += dppx<0x141>(ss); ss += dppx<0x140>(ss);
              const float rs = rsqrtf(ss * (1.f / 64.f) + 1e-6f);
              const float4 g = *(const float4*)(p->qk_gain + j * 128 + (n0 >= 2048 ? 64 : 0) + (cn & 63));
              vq = make_float4(v.x * rs * g.x, v.y * rs * g.y, v.z * rs * g.z, v.w * rs * g.w);
              const int t = m0 + row;
              if (t < NL) {
                const int sidx = t & 2047, pi0 = (cn & 63) >> 1;
                const int pos = pi0 < 16 ? (sidx >> 6) : (sidx & 63);
                const float4 cs = *(const float4*)(p->ROPE + (pos * 16 + (pi0 & 15)) * 2);
                vq = make_float4(vq.x * cs.x - vq.y * cs.y, vq.x * cs.y + vq.y * cs.x,
                                 vq.z * cs.z - vq.w * cs.w, vq.z * cs.w + vq.w * cs.z);
              }
            }
            if (cn < N_in) {
              u32x2 o; o.x = pk_bf16(vq.x, vq.y); o.y = pk_bf16(vq.z, vq.w);
              *(u32x2*)(p->P + (size_t)(m0 + row) * LDP + cn) = o;
            }
            if (!att && cn >= 4096 && cn < 4112) *(float4*)(p->GP + (size_t)(m0 + row) * 16 + (cn - 4096)) = v;
          }
        } break;
        case 1: {
#pragma unroll 16
          for (int it = 0; it < 16; ++it) {
            const int row = it * 8 + r0;
            const float4 v = *(const float4*)(Ct + row * 128 + c4);

            const size_t o = (size_t)(m0 + row) * DM + n0 + c4;
            const float4 xv = *(const float4*)(p->X + o);
            const float4 g = *(const float4*)(p->MOD + (layer * 9 + modrow(m0)) * 6144 + 2048 + n0 + c4);
            *(float4*)(p->Tb + o) = make_float4(DN_ALPHA * xv.x + g.x * v.x, DN_ALPHA * xv.y + g.y * v.y,
                                                DN_ALPHA * xv.z + g.z * v.z, DN_ALPHA * xv.w + g.w * v.w);
          }
        } break;
        case 2: {
#pragma unroll 8
          for (int it = 0; it < 16; ++it) {
            const int row = it * 8 + r0;
            const float4 v = *(const float4*)(Ct + row * 128 + c4);

            if (((c4 >> 5) & 1) == 0) {
              const float4 u = *(const float4*)(Ct + row * 128 + c4 + 32);
              const float a0 = v.x * W8_INV, a1 = v.y * W8_INV, a2 = v.z * W8_INV, a3 = v.w * W8_INV;
              *(unsigned*)((unsigned char*)p->ACT + ((size_t)mtile * 128 + row) * 256 + aux * 64 + (c4 >> 6) * 32 + (c4 & 31)) =
                  pk_fp8x4(silu_f(a0) * (u.x * W8_INV), silu_f(a1) * (u.y * W8_INV), silu_f(a2) * (u.z * W8_INV), silu_f(a3) * (u.w * W8_INV));
            }
          }
        } break;
        case 3: {
#pragma unroll 16
          for (int it = 0; it < 16; ++it) {
            const int row = it * 8 + r0;
            const float4 v = *(const float4*)(Ct + row * 128 + c4);

            const float g = s_gate[row] * W8_INV;
            u32x2 o; o.x = pk_bf16(g * v.x, g * v.y); o.y = pk_bf16(g * v.z, g * v.w);
            *(u32x2*)(p->OUT2 + ((size_t)mtile * 128 + row) * 1024 + n0 + c4) = o;
          }
        } break;
        case 4: {
#pragma unroll 4
          for (int it = 0; it < 16; ++it) {
            const int row = it * 8 + r0;
            const float4 v = *(const float4*)(Ct + row * 128 + c4);

            float4 o4 = v;
            if (aux == 0) o4 = make_float4(tanhf(v.x), tanhf(v.y), tanhf(v.z), tanhf(v.w));
            else if (aux == 2) o4 = make_float4(sigm_f(v.x), sigm_f(v.y), sigm_f(v.z), sigm_f(v.w));
            u32x2 o; o.x = pk_bf16(o4.x, o4.y); o.y = pk_bf16(o4.z, o4.w);
            *(u32x2*)(p->L1 + (size_t)(m0 + row) * 384 + aux * 128 + c4) = o;
          }
        } break;
        default: {
#pragma unroll 4
          for (int it = 0; it < 16; ++it) {
            const int row = it * 8 + r0;
            const float4 v = *(const float4*)(Ct + row * 128 + c4);

            bf16_t* rr = p->RW + (size_t)(m0 + row) * RWS + c05 + c4;
            const float vv[4] = {v.x, v.y, v.z, v.w};
            if (aux < 8) {
              const float4 b0 = *(const float4*)(p->rwkv_w0 + (j * 2 + d5) * 512 + c05 + c4);
              const float bb[4] = {b0.x, b0.y, b0.z, b0.w};
              float e4[4];
#pragma unroll
              for (int q = 0; q < 4; ++q) e4[q] = expf(-softplus_f(-(bb[q] + vv[q])) - 0.5f);
              u32x2 o; o.x = pk_bf16(e4[0], e4[1]); o.y = pk_bf16(e4[2], e4[3]);
              *(u32x2*)(rr + (3 + d5) * 512) = o;
            } else if (aux < 16) {
              const float4 b0 = *(const float4*)(p->rwkv_a0 + (j * 2 + d5) * 512 + c05 + c4);
              const float4 k1 = *(const float4*)(p->rwkv_kvec + (j * 2 + 1) * 512 + c05 + c4);
              const u32x2 kx2 = *(const u32x2*)(rr + 10 * 512);
              const float bb[4] = {b0.x, b0.y, b0.z, b0.w}, kk1[4] = {k1.x, k1.y, k1.z, k1.w};
              const float kx[4] = {bflo(kx2.x), bfhi(kx2.x), bflo(kx2.y), bfhi(kx2.y)};
              float av[4], ke[4];
#pragma unroll
              for (int q = 0; q < 4; ++q) { av[q] = sigm_f(bb[q] + vv[q]); ke[q] = kx[q] * (1.f + (av[q] - 1.f) * kk1[q]); }
              u32x2 o; o.x = pk_bf16(av[0], av[1]); o.y = pk_bf16(av[2], av[3]);
              *(u32x2*)(rr + (7 + d5) * 512) = o;
              o.x = pk_bf16(ke[0], ke[1]); o.y = pk_bf16(ke[2], ke[3]);
              *(u32x2*)(rr + (5 + d5) * 512) = o;
            } else {
              u32x2 o; o.x = pk_bf16(v.x, v.y); o.y = pk_bf16(v.z, v.w);
              *(u32x2*)(rr + 9 * 512) = o;
            }
          }
        } break;
      }
    }
    __syncthreads();
  }
}

__device__ void ph_final_ln(KP p, int layer, bool keep, char* lds) {
  const int tid = opaque_tid();
  const int lane = tid & 63, wave = tid >> 6;
  const int rows = keep ? NT : NL;
  int* s_base = (int*)(lds + META_OFF);
  if (tid == 0) {
    int a = 0;
    for (int e = 0; e < 64; ++e) { s_base[e] = a * 128; a += (p->cnt[e] + 127) >> 7; }
    s_base[64] = a * 128;
  }
  __syncthreads();
  const float* lng = p->ln_g + (layer * 2 + 1) * 1024;
  const float* lnb = p->ln_b + (layer * 2 + 1) * 1024;
  for (int t = blockIdx.x * 4 + wave; t < rows; t += gridDim.x * 4) {
    const int mr = modrow(t);
    const float* g2 = p->MOD + (layer * 9 + mr) * 6144 + 5120;
    const bf16_t* src[7];
#pragma unroll
    for (int k = 0; k < 6; ++k) {
      const int v = p->tsl[t * 6 + k];
      src[k] = p->OUT2 + (size_t)(s_base[v >> 16] + (v & 0xffff)) * 1024;
    }
    src[6] = p->OUT2 + (size_t)(s_base[64] + t) * 1024;
    float v[16];
    float s = 0.f;
#pragma unroll
    for (int c = 0; c < 2; ++c) {
      const int n0 = c * 512 + lane * 8;
      float y[8];
#pragma unroll
      for (int q = 0; q < 8; ++q) y[q] = 0.f;
#pragma unroll
      for (int k = 0; k < 7; ++k) {
        const u32x4 u = *(const u32x4*)(src[k] + n0);
        y[0] += bflo(u.x); y[1] += bfhi(u.x); y[2] += bflo(u.y); y[3] += bfhi(u.y);
        y[4] += bflo(u.z); y[5] += bfhi(u.z); y[6] += bflo(u.w); y[7] += bfhi(u.w);
      }
      const float4 xa = *(const float4*)(p->X + (size_t)t * DM + n0), xb = *(const float4*)(p->X + (size_t)t * DM + n0 + 4);
      const float4 ga = *(const float4*)(g2 + n0), gb = *(const float4*)(g2 + n0 + 4);
      const float xx[8] = {xa.x, xa.y, xa.z, xa.w, xb.x, xb.y, xb.z, xb.w};
      const float gg[8] = {ga.x, ga.y, ga.z, ga.w, gb.x, gb.y, gb.z, gb.w};
#pragma unroll
      for (int q = 0; q < 8; ++q) { v[c * 8 + q] = DN_ALPHA * xx[q] + gg[q] * y[q]; s += v[c * 8 + q]; }
    }
    const float mean = wsum(s) * (1.f / 1024.f);
    float q2 = 0.f;
#pragma unroll
    for (int i = 0; i < 16; ++i) { const float d = v[i] - mean; q2 += d * d; }
    const float rs = rsqrtf(wsum(q2) * (1.f / 1024.f) + 1e-5f);
    const float* modn = p->MOD + ((layer + 1) * 9 + mr) * 6144;
#pragma unroll
    for (int c = 0; c < 2; ++c) {
      const int n0 = c * 512 + lane * 8;
      float xn[8];
#pragma unroll
      for (int q = 0; q < 8; ++q) xn[q] = (v[c * 8 + q] - mean) * rs * lng[n0 + q] + lnb[n0 + q];
      *(float4*)(p->X + (size_t)t * DM + n0) = make_float4(xn[0], xn[1], xn[2], xn[3]);
      *(float4*)(p->X + (size_t)t * DM + n0 + 4) = make_float4(xn[4], xn[5], xn[6], xn[7]);
      if (layer == 3) {
        *(float4*)(p->out + (size_t)t * DM + n0) = make_float4(xn[0], xn[1], xn[2], xn[3]);
        *(float4*)(p->out + (size_t)t * DM + n0 + 4) = make_float4(xn[4], xn[5], xn[6], xn[7]);
      } else {
        float hb[8];
#pragma unroll
        for (int q = 0; q < 8; ++q) hb[q] = xn[q] * (1.f + modn[1024 + n0 + q]) + modn[n0 + q];
        u32x4 o;
        o.x = pk_bf16(hb[0], hb[1]); o.y = pk_bf16(hb[2], hb[3]); o.z = pk_bf16(hb[4], hb[5]); o.w = pk_bf16(hb[6], hb[7]);
        *(u32x4*)(p->AB + (size_t)t * DM + n0) = o;
      }
    }
  }
}

#define XB_TMO      128
#define XB_XCNT(j)  (256  + 64 * (j))
#define XB_XSUB(j)  (1280 + 64 * (j))
#define XB_XGEN(j)  (2304 + 64 * (j))
#define XB_TOP      3328
#define XB_TOPGEN   3392
#define XB_SPIN_CAP (1u << 20)
#define LAS __attribute__((address_space(3)))
__device__ __forceinline__ unsigned xb_ld(unsigned* p) { return __hip_atomic_load(p, __ATOMIC_RELAXED, __HIP_MEMORY_SCOPE_AGENT); }
__device__ __forceinline__ unsigned xb_add(unsigned* p, unsigned v) { return __hip_atomic_fetch_add(p, v, __ATOMIC_RELAXED, __HIP_MEMORY_SCOPE_AGENT); }
__device__ __forceinline__ unsigned xb_xcc_id() { return (unsigned)__builtin_amdgcn_s_getreg((3 << 11) | 20) & 0xFu; }
#define XB_SPIN(cond, bar) do { unsigned _sp = 0; while (cond) { __builtin_amdgcn_s_sleep(1); \
    if ((++_sp & 255u) == 0u) { if (xb_ld(&(bar)[XB_TMO])) break; if (_sp > XB_SPIN_CAP) { atomicAdd(&(bar)[XB_TMO], 1u); break; } } } } while (0)
struct XcdBarrier { unsigned* bar; unsigned x; volatile LAS unsigned* st; };
__device__ __forceinline__ XcdBarrier xcd_barrier_post(unsigned* bar, volatile LAS unsigned* st) {
  XcdBarrier b; b.bar = bar; b.x = xb_xcc_id(); b.st = st;
  if (threadIdx.x == 0) (void)xb_add(&bar[XB_XCNT(b.x)], 1u);
  return b;
}
__device__ __forceinline__ void xcd_barrier_complete(unsigned* bar, unsigned x, unsigned& nloc, unsigned& nx) {
  const unsigned G = gridDim.x;
  unsigned sum, cnt, mine, sp = 0u;
  for (;;) {
    sum = 0u; cnt = 0u; mine = 0u;
#pragma unroll
    for (unsigned j = 0; j < 16; ++j) { const unsigned c = xb_ld(&bar[XB_XCNT(j)]); sum += c; cnt += (c > 0u) ? 1u : 0u; mine = (j == x) ? c : mine; }
    if (sum == G) break;
    __builtin_amdgcn_s_sleep(1);
    if ((++sp & 255u) == 0u) { if (xb_ld(&bar[XB_TMO])) break; if (sp > XB_SPIN_CAP) { atomicAdd(&bar[XB_TMO], 1u); break; } }
  }
  nloc = mine > 0u ? mine : 1u; nx = cnt > 0u ? cnt : 1u;
}
__device__ __forceinline__ void xcd_barrier(const XcdBarrier& b) {
  asm volatile("s_waitcnt vmcnt(0)" ::: "memory");
  __syncthreads();
  if (threadIdx.x == 0) {
    unsigned* bar = b.bar;
    __builtin_amdgcn_s_waitcnt(0);
    unsigned nloc = b.st[0], nx = b.st[1];
    if (nloc == 0u) { xcd_barrier_complete(bar, b.x, nloc, nx); b.st[0] = nloc; b.st[1] = nx; }
    const unsigned old = xb_add(&bar[XB_XSUB(b.x)], 1u);
    const unsigned gen = old / nloc;
    if (old + 1u == (gen + 1u) * nloc) {
      __builtin_amdgcn_fence(__ATOMIC_RELEASE, "agent");
      asm volatile("s_waitcnt vmcnt(0)" ::: "memory");
      const unsigned og = xb_add(&bar[XB_TOP], 1u);
      const unsigned tg = og / nx;
      if (og + 1u == (tg + 1u) * nx) xb_add(&bar[XB_TOPGEN], 1u);
      else XB_SPIN(xb_ld(&bar[XB_TOPGEN]) == tg, bar);
      __builtin_amdgcn_fence(__ATOMIC_ACQUIRE, "agent");
      xb_add(&bar[XB_XGEN(b.x)], 1u);
      asm volatile("s_waitcnt vmcnt(0)" ::: "memory");
    } else {
      XB_SPIN(xb_ld(&bar[XB_XGEN(b.x)]) == gen, bar);
      __builtin_amdgcn_fence(__ATOMIC_ACQUIRE, "agent");
      asm volatile("s_waitcnt vmcnt(0)" ::: "memory");
    }
  }
  __syncthreads();
}

constexpr int NSLOTS = 13;
constexpr int NPHASE = 2 + 4 * NSLOTS;
__device__ __forceinline__ bool phase_is_nop(int ph) {
  if (ph < 2) return false;
  const int layer = (ph - 2) / NSLOTS, st = (ph - 2) % NSLOTS;
  if (st == 5 || st == 6) return true;
  return !(layer & 1) && (st == 1 || (st >= 3 && st <= 7));
}
__device__ void run_phase(KP p, int ph, char* sm) {
  if (ph == 0) { ph_init(p, sm); return; }
  if (ph == 1) { ph_mod_h(p, sm); return; }
  const int layer = (ph - 2) / NSLOTS, st = (ph - 2) % NSLOTS;
  const bool odd = layer & 1;
  const bool keep = layer < 3;
  int gk = -1;
  if (st == 0) gk = 0;
  else if (st == 8) gk = 1;
  else if (st == 10) gk = 2;
  else if (st == 11) gk = 3;
  else if (odd && st == 2) gk = 4;
  else if (odd && st == 3) gk = 5;
  asm volatile("" : "+s"(gk));
  if (gk >= 0) {
    ph_gemm(p, gk, layer, keep, sm);
    if (gk == 5) { __syncthreads(); ph_mlstm_s2(p, sm); }
    return;
  }
  switch (st) {
    case 1: if (odd) { ph_rwkv_mix(p, layer); ph_mlstm_s1(p, layer, sm); } break;
    case 2: ph_attention(p, layer, keep, sm); break;
    case 4: if (odd) ph_scan_a(p, layer, sm); break;
    case 7: if (odd) ph_rec_final(p, layer, keep); break;
    case 9: ph_ln_router(p, layer, keep, sm); break;
    case 12: ph_final_ln(p, layer, keep, sm); break;
  }
}

__global__ void __launch_bounds__(NTHR, 2) mega_kernel(Params kargs) {
  extern __shared__ __attribute__((aligned(16))) char sm[];
  cg::grid_group grid = cg::this_grid();
  volatile LAS unsigned* st = (volatile LAS unsigned*)(sm + META_OFF + 4032);
  if (threadIdx.x == 0) { st[0] = 0u; st[1] = 0u; }
  __syncthreads();
  const XcdBarrier xb = xcd_barrier_post(kargs.bar, st);
  for (int ph = kargs.ph_lo; ph < kargs.ph_hi; ++ph) {
    if (phase_is_nop(ph)) continue;
    {
      KP kp = (KP)__builtin_amdgcn_kernarg_segment_ptr();
      asm volatile("" : "+s"(kp));
      run_phase(kp, ph, sm);
    }
    if (ph + 1 < kargs.ph_hi) {
      if (ph == 0) grid.sync();
      else xcd_barrier(xb);
    }
  }
}

extern "C" void kernel_launch(void* const* d_in, const int* in_sizes, int n_in, void* d_out, int out_size, void* d_ws,
                              size_t ws_size, hipStream_t stream) {
  static int grid_blocks = 0;
  if (!grid_blocks) {
    int dev = 0, cus = 0, per_cu = 0;
    (void)hipGetDevice(&dev);
    (void)hipDeviceGetAttribute(&cus, hipDeviceAttributeMultiprocessorCount, dev);
    (void)hipFuncSetAttribute((const void*)mega_kernel, hipFuncAttributeMaxDynamicSharedMemorySize, SMEM_BYTES);
    (void)hipOccupancyMaxActiveBlocksPerMultiprocessor(&per_cu, mega_kernel, NTHR, SMEM_BYTES);
    if (per_cu < 1) per_cu = 1;
    if (per_cu > 2) per_cu = 2;
    grid_blocks = cus * per_cu;
  }
  Params p;
  memset(&p, 0, sizeof(p));
  const float** pin = (const float**)&p;
  for (int i = 0; i < 35; ++i) pin[i] = (const float*)d_in[i];
  p.out = (float*)d_out;
  char* w = (char*)d_ws;
  size_t off = 0;
  auto take = [&](size_t bytes) { char* r = w + off; off += (bytes + 255) & ~(size_t)255; return r; };
  p.Wt_att = (bf16_t*)take((size_t)2 * ATT_N * 1024 * 2);
  p.Wt_rec = (bf16_t*)take((size_t)2 * REC_NP * 1024 * 2);
  p.Wt_out = (bf16_t*)take((size_t)4 * 1024 * 1024 * 2);
  p.Wt13 = (bf16_t*)take((size_t)4 * 65 * 512 * 1024);
  p.Wt2 = (bf16_t*)take((size_t)4 * 65 * 1024 * 256);
  p.Wl1 = (bf16_t*)take((size_t)2 * 3 * 128 * 512 * 2);
  p.Wl2 = (bf16_t*)take((size_t)2 * 2560 * 128 * 2);
  p.X = (float*)take((size_t)NT * DM * 4);
  p.AB = (bf16_t*)take((size_t)NT * DM * 2);
  p.MOD = (float*)take((size_t)5 * 9 * 6144 * 4);
  p.MODP = (float*)take((size_t)8 * 4 * 9 * 6144 * 4);
  p.GP = (float*)take((size_t)NT * 16 * 4);
  p.ROPE = (float*)take((size_t)64 * 16 * 2 * 4);
  p.msc = (float*)take((size_t)3 * NMT * 4);
  p.lgate = (float*)take((size_t)64 * NT * 4);
  p.ltok = (int*)take((size_t)64 * NT * 4);
  p.tsl = (int*)take((size_t)NT * 6 * 4);
  p.cnt = (int*)take(512);
  p.bar = (unsigned*)take((size_t)BAR_TOTAL_WORDS * 4);
  char* region = take(0);
  const size_t szP = (size_t)NT * LDP * 2, szRW = (size_t)NT * RWS * 2, szMS = (size_t)NMT * 16384 * 2,
               szMSn = (size_t)NMT * 128 * 4;
  const size_t szT = (size_t)NT * DM * 4, szOUT2 = (size_t)NSLOT * 1024 * 2;
  p.P = (bf16_t*)region;
  p.RW = (bf16_t*)(region + szP);
  p.MS = (bf16_t*)(region + szP + szRW);
  p.MSn = (float*)(region + szP + szRW + szMS);
  p.Tb = (float*)region;
  p.ACT = (bf16_t*)region;
  p.OUT2 = (bf16_t*)(region + szT);
  const size_t szZ = (size_t)NT * 2048 * 2;
  p.Zb = (bf16_t*)(region + szP + szRW + szMS + szMSn);
  p.L1 = p.Zb + (size_t)NT * 1536;
  size_t mixer = szP + szRW + szMS + szMSn + szZ, moe = szT + szOUT2;
  off += (mixer > moe ? mixer : moe);
  if (off > ws_size) { fprintf(stderr, "workspace too small: need %zu have %zu\n", off, ws_size); return; }
  p.ph_lo = 0;
  p.ph_hi = NPHASE;
  (void)hipMemsetAsync(p.bar, 0, (size_t)BAR_TOTAL_WORDS * 4, stream);
  void* args[] = {&p};
  hipError_t e = hipLaunchCooperativeKernel((void*)mega_kernel, dim3(grid_blocks), dim3(NTHR), args, SMEM_BYTES, stream);
  if (e != hipSuccess) fprintf(stderr, "cooperative launch failed: %s (grid %d)\n", hipGetErrorString(e), grid_blocks);
}
```

```cpp
#include <hip/hip_runtime.h>
#include <hip/hip_cooperative_groups.h>
#include <cstdio>
#include <cstring>
namespace cg = cooperative_groups;

constexpr int DM = 1024;
constexpr int NBATCH = 8;
constexpr int SEQ = 2048;
constexpr int CTXL = 256;
constexpr int NL = NBATCH * SEQ;
constexpr int NC = NBATCH * CTXL;
constexpr int NT = NL + NC;
constexpr int TSC = CTXL + SEQ;
constexpr int LDP = 4112;
constexpr int ATT_N = 2304;
constexpr int REC_N = 4112;
constexpr int REC_NP = 4224;
constexpr int NCHUNK = 36;
constexpr int NMT = 64 * NCHUNK;
constexpr int RWS = 5632;
constexpr int NSLOT = 137216;
constexpr float DN_ALPHA = 1.6817928305074290f;
constexpr int NTHR = 256;
constexpr int SMEM_BYTES = 65536 + 4096;
constexpr int META_OFF = 65536;
#define XCD_BAR_WORDS 3456
constexpr int CSTR = 32;
constexpr int BAR_TOTAL_WORDS = XCD_BAR_WORDS + 64;

typedef unsigned short bf16_t;
using bf16x8 = __attribute__((ext_vector_type(8))) short;
using f32x16 = __attribute__((ext_vector_type(16))) float;
using u32x4 = __attribute__((ext_vector_type(4))) unsigned;
using u32x2 = __attribute__((ext_vector_type(2))) unsigned;

struct Params {
  const float *x, *c, *ctx, *c_ctx, *ada_w, *ada_b, *ln_g, *ln_b, *mix_w_out, *att_w_in, *na_rpb, *qk_gain,
      *rec_w_in, *rwkv_mu, *rwkv_w0, *rwkv_w1, *rwkv_w2, *rwkv_a0, *rwkv_a1, *rwkv_a2, *rwkv_g1, *rwkv_g2,
      *rwkv_kvec, *rwkv_rk, *rwkv_gn, *mlstm_gate_b, *mlstm_norm, *moe_router, *moe_bias, *moe_w1, *moe_w3,
      *moe_w2, *shared_w1, *shared_w3, *shared_w2;
  float* out;
  bf16_t *Wt_att, *Wt_rec, *Wt_out, *Wt13, *Wt2, *Wl1, *Wl2;
  bf16_t *Zb, *L1;
  float *X, *MOD, *MODP, *GP, *msc, *lgate, *MSn, *Tb, *ROPE, *WrT;
  bf16_t *AB, *P, *RW, *MS, *ACT, *OUT2;
  int *cnt, *ltok, *tsl;
  unsigned* bar;
  int ph_lo, ph_hi;
};

typedef const Params __attribute__((address_space(4))) * KP;

__device__ __forceinline__ int modrow(int t) { return t < NL ? (t >> 11) : 8; }
__device__ __forceinline__ float silu_f(float x) { return x / (1.f + expf(-x)); }
__device__ __forceinline__ float sigm_f(float x) { return 1.f / (1.f + expf(-x)); }
__device__ __forceinline__ float softplus_f(float x) { return fmaxf(x, 0.f) + log1pf(expf(-fabsf(x))); }
template <int CTRL>
__device__ __forceinline__ float dppx(float x) {
  return __int_as_float(__builtin_amdgcn_update_dpp(0, __float_as_int(x), CTRL, 0xf, 0xf, true));
}
__device__ __forceinline__ float rdlane(float v, int l) {
  return __int_as_float(__builtin_amdgcn_readlane(__float_as_int(v), l));
}
__device__ __forceinline__ float wsum(float v) {
  v += dppx<0xB1>(v); v += dppx<0x4E>(v); v += dppx<0x141>(v); v += dppx<0x140>(v);
  return (rdlane(v, 0) + rdlane(v, 16)) + (rdlane(v, 32) + rdlane(v, 48));
}
__device__ __forceinline__ float wmax(float v) {
  v = fmaxf(v, dppx<0xB1>(v)); v = fmaxf(v, dppx<0x4E>(v)); v = fmaxf(v, dppx<0x141>(v)); v = fmaxf(v, dppx<0x140>(v));
  return fmaxf(fmaxf(rdlane(v, 0), rdlane(v, 16)), fmaxf(rdlane(v, 32), rdlane(v, 48)));
}
__device__ __forceinline__ int opaque_tid() {
  int t = threadIdx.x;
  asm volatile("" : "+v"(t));
  return t;
}
typedef __bf16 bf16x2_t __attribute__((ext_vector_type(2)));
typedef float f32x2_t __attribute__((ext_vector_type(2)));
__device__ __forceinline__ unsigned pk_bf16(float lo, float hi) {
  const f32x2_t v = {lo, hi};
  return __builtin_bit_cast(unsigned, __builtin_convertvector(v, bf16x2_t));
}
__device__ __forceinline__ bf16_t f2bf(float x) { return (bf16_t)(pk_bf16(x, 0.f) & 0xffffu); }
__device__ __forceinline__ float bf2f(bf16_t v) { return __uint_as_float((unsigned)v << 16); }
__device__ __forceinline__ float bflo(unsigned u) { return __uint_as_float(u << 16); }
__device__ __forceinline__ float bfhi(unsigned u) { return __uint_as_float(u & 0xffff0000u); }
__device__ __forceinline__ int scan_row(int dir, int b, int tau) {
  if (tau < CTXL) return NL + b * CTXL + (dir ? (CTXL - 1 - tau) : tau);
  int s = tau - CTXL;
  return b * SEQ + (dir ? (SEQ - 1 - s) : s);
}

template <class RowPtrA>
__device__ __forceinline__ void gemm128_main(int tid, RowPtrA rowA, const bf16_t* __restrict__ Bt, int K, int n0,
                                             char* lds, f32x16 (&acc)[2][2]) {
  const int lane = tid & 63, w = tid >> 6;
  const int wm = w >> 1, wn = w & 1, r = lane & 31, h = lane >> 5;
  const int c = tid & 7, sr = tid >> 3;
  const int lc = (c ^ ((tid >> 4) & 7)) * 8;
  const bf16_t* ap[4];
#pragma unroll
  for (int i = 0; i < 4; ++i) ap[i] = rowA(sr + 32 * i) + lc;
  const bf16_t* bp0 = Bt + (size_t)(n0 + sr) * K + lc;
  const int bstr = 32 * K;
#pragma unroll
  for (int mi = 0; mi < 2; ++mi)
#pragma unroll
    for (int ni = 0; ni < 2; ++ni)
#pragma unroll
      for (int q = 0; q < 16; ++q) acc[mi][ni][q] = 0.f;
  const int nk = K >> 6;
  auto issue = [&](int kt) {
    char* As = lds + (kt & 1) * 32768 + tid * 16;
    const int k0 = kt * 64;
#pragma unroll
    for (int i = 0; i < 4; ++i) {
      __builtin_amdgcn_global_load_lds((const unsigned*)(ap[i] + k0), (__attribute__((address_space(3))) unsigned*)(As + i * 4096), 16, 0, 0);
      __builtin_amdgcn_global_load_lds((const unsigned*)(bp0 + i * bstr + k0), (__attribute__((address_space(3))) unsigned*)(As + 16384 + i * 4096), 16, 0, 0);
    }
  };
  issue(0);
  const int sw = (r >> 1) & 7;
#pragma unroll 1
  for (int kt = 0; kt < nk; ++kt) {
    asm volatile("s_waitcnt vmcnt(0)" ::: "memory");
    __syncthreads();
    if (kt + 1 < nk) issue(kt + 1);
    const char* As = lds + (kt & 1) * 32768;
    const char* Ar = As + (wm * 64 + r) * 128;
    const char* Br = As + 16384 + (wn * 64 + r) * 128;
#pragma unroll
    for (int ks = 0; ks < 4; ++ks) {
      const int off = ((ks * 2 + h) ^ sw) * 16;
      const bf16x8 a0 = *(const bf16x8*)(Ar + off);
      const bf16x8 a1 = *(const bf16x8*)(Ar + 32 * 128 + off);
      const bf16x8 b0 = *(const bf16x8*)(Br + off);
      const bf16x8 b1 = *(const bf16x8*)(Br + 32 * 128 + off);
      acc[0][0] = __builtin_amdgcn_mfma_f32_32x32x16_bf16(a0, b0, acc[0][0], 0, 0, 0);
      acc[0][1] = __builtin_amdgcn_mfma_f32_32x32x16_bf16(a0, b1, acc[0][1], 0, 0, 0);
      acc[1][0] = __builtin_amdgcn_mfma_f32_32x32x16_bf16(a1, b0, acc[1][0], 0, 0, 0);
      acc[1][1] = __builtin_amdgcn_mfma_f32_32x32x16_bf16(a1, b1, acc[1][1], 0, 0, 0);
    }
  }
  __syncthreads();
}
using i64 = long;
template <class RowPtrA8>
__device__ __forceinline__ void gemm128_fp8(int tid, RowPtrA8 rowA, const unsigned char* __restrict__ Bt, int K, int n0,
                                            char* lds, f32x16 (&acc)[2][2]) {
  const int lane = tid & 63, w = tid >> 6;
  const int wm = w >> 1, wn = w & 1, r = lane & 31, h = lane >> 5;
  const int c = tid & 7, sr = tid >> 3;
  const int lc = (c ^ ((tid >> 4) & 7)) * 16;
  const unsigned char* ap[4];
#pragma unroll
  for (int i = 0; i < 4; ++i) ap[i] = rowA(sr + 32 * i) + lc;
  const unsigned char* bp0 = Bt + (size_t)(n0 + sr) * K + lc;
  const int bstr = 32 * K;
#pragma unroll
  for (int mi = 0; mi < 2; ++mi)
#pragma unroll
    for (int ni = 0; ni < 2; ++ni)
#pragma unroll
      for (int q = 0; q < 16; ++q) acc[mi][ni][q] = 0.f;
  const int nk = K >> 7;
  auto issue = [&](int kt) {
    char* As = lds + (kt & 1) * 32768 + tid * 16;
    const int k0 = kt * 128;
#pragma unroll
    for (int i = 0; i < 4; ++i) {
      __builtin_amdgcn_global_load_lds((const unsigned*)(ap[i] + k0), (__attribute__((address_space(3))) unsigned*)(As + i * 4096), 16, 0, 0);
      __builtin_amdgcn_global_load_lds((const unsigned*)(bp0 + i * bstr + k0), (__attribute__((address_space(3))) unsigned*)(As + 16384 + i * 4096), 16, 0, 0);
    }
  };
  issue(0);
  const int sw = (r >> 1) & 7;
#pragma unroll 1
  for (int kt = 0; kt < nk; ++kt) {
    asm volatile("s_waitcnt vmcnt(0)" ::: "memory");
    __syncthreads();
    if (kt + 1 < nk) issue(kt + 1);
    const char* As = lds + (kt & 1) * 32768;
    const char* Ar = As + (wm * 64 + r) * 128;
    const char* Br = As + 16384 + (wn * 64 + r) * 128;
#pragma unroll
    for (int q = 0; q < 4; ++q) {
      const int off = ((q * 2 + h) ^ sw) * 16;
      const u32x4 a0 = *(const u32x4*)(Ar + off);
      const u32x4 a1 = *(const u32x4*)(Ar + 32 * 128 + off);
      const u32x4 b0 = *(const u32x4*)(Br + off);
      const u32x4 b1 = *(const u32x4*)(Br + 32 * 128 + off);
      const i64 a0l = (i64)(((unsigned long long)a0.y << 32) | a0.x), a0h = (i64)(((unsigned long long)a0.w << 32) | a0.z);
      const i64 a1l = (i64)(((unsigned long long)a1.y << 32) | a1.x), a1h = (i64)(((unsigned long long)a1.w << 32) | a1.z);
      const i64 b0l = (i64)(((unsigned long long)b0.y << 32) | b0.x), b0h = (i64)(((unsigned long long)b0.w << 32) | b0.z);
      const i64 b1l = (i64)(((unsigned long long)b1.y << 32) | b1.x), b1h = (i64)(((unsigned long long)b1.w << 32) | b1.z);
      acc[0][0] = __builtin_amdgcn_mfma_f32_32x32x16_fp8_fp8(a0l, b0l, acc[0][0], 0, 0, 0);
      acc[0][1] = __builtin_amdgcn_mfma_f32_32x32x16_fp8_fp8(a0l, b1l, acc[0][1], 0, 0, 0);
      acc[1][0] = __builtin_amdgcn_mfma_f32_32x32x16_fp8_fp8(a1l, b0l, acc[1][0], 0, 0, 0);
      acc[1][1] = __builtin_amdgcn_mfma_f32_32x32x16_fp8_fp8(a1l, b1l, acc[1][1], 0, 0, 0);
      acc[0][0] = __builtin_amdgcn_mfma_f32_32x32x16_fp8_fp8(a0h, b0h, acc[0][0], 0, 0, 0);
      acc[0][1] = __builtin_amdgcn_mfma_f32_32x32x16_fp8_fp8(a0h, b1h, acc[0][1], 0, 0, 0);
      acc[1][0] = __builtin_amdgcn_mfma_f32_32x32x16_fp8_fp8(a1h, b0h, acc[1][0], 0, 0, 0);
      acc[1][1] = __builtin_amdgcn_mfma_f32_32x32x16_fp8_fp8(a1h, b1h, acc[1][1], 0, 0, 0);
    }
  }
  __syncthreads();
}
template <class F>
__device__ __forceinline__ void acc_foreach(int tid, const f32x16 (&acc)[2][2], F f) {
  const int lane = tid & 63, w = tid >> 6;
  const int wm = w >> 1, wn = w & 1, r = lane & 31, h = lane >> 5;
#pragma unroll
  for (int mi = 0; mi < 2; ++mi)
#pragma unroll
    for (int ni = 0; ni < 2; ++ni)
#pragma unroll
      for (int q = 0; q < 16; ++q) {
        const int row = wm * 64 + mi * 32 + (q & 3) + 8 * (q >> 2) + 4 * h;
        const int col = wn * 64 + ni * 32 + r;
        f(row, col, acc[mi][ni][q]);
        if ((q & 3) == 3) __builtin_amdgcn_sched_barrier(0);
      }
}

template <class RM>
__device__ __forceinline__ void tr_tile(int tid, const float* __restrict__ src, int N, int k0, int n0,
                                        bf16_t* __restrict__ dst, int K, RM rowmap, float* tile) {
  {
    const int tx = tid & 15, ty = tid >> 4;
    const int n = n0 + tx * 4;
#pragma unroll
    for (int i = 0; i < 4; ++i) {
      const int k = ty + 16 * i;
      float4 v = make_float4(0.f, 0.f, 0.f, 0.f);
      if (n < N) v = *(const float4*)(src + (size_t)(k0 + k) * N + n);
      tile[k * 65 + tx * 4 + 0] = v.x; tile[k * 65 + tx * 4 + 1] = v.y;
      tile[k * 65 + tx * 4 + 2] = v.z; tile[k * 65 + tx * 4 + 3] = v.w;
    }
  }
  __syncthreads();
  {
    const int kc = tid & 7;
#pragma unroll
    for (int i = 0; i < 2; ++i) {
      const int n = (tid >> 3) + 32 * i;
      if (n0 + n < N) {
        float v[8];
#pragma unroll
        for (int q = 0; q < 8; ++q) v[q] = tile[(kc * 8 + q) * 65 + n];
        u32x4 o;
        o.x = pk_bf16(v[0], v[1]); o.y = pk_bf16(v[2], v[3]); o.z = pk_bf16(v[4], v[5]); o.w = pk_bf16(v[6], v[7]);
        *(u32x4*)(dst + (size_t)rowmap(n0 + n) * K + k0 + kc * 8) = o;
      }
    }
  }
  __syncthreads();
}

constexpr float W8_SCALE = 32.f, W8_INV = 1.f / 32.f;
__device__ __forceinline__ unsigned pk_fp8x4(float a, float b, float c, float d) {
  int r = __builtin_amdgcn_cvt_pk_fp8_f32(a, b, 0, false);
  r = __builtin_amdgcn_cvt_pk_fp8_f32(c, d, r, true);
  return (unsigned)r;
}
template <class RM>
__device__ __forceinline__ void tr_tile_fp8(int tid, const float* __restrict__ src, int N, int k0, int n0,
                                            unsigned char* __restrict__ dst, int K, RM rowmap, float* tile) {
  {
    const int tx = tid & 15, ty = tid >> 4;
    const int n = n0 + tx * 4;
#pragma unroll
    for (int i = 0; i < 4; ++i) {
      const int k = ty + 16 * i;
      const float4 v = *(const float4*)(src + (size_t)(k0 + k) * N + n);
      tile[k * 65 + tx * 4 + 0] = v.x; tile[k * 65 + tx * 4 + 1] = v.y;
      tile[k * 65 + tx * 4 + 2] = v.z; tile[k * 65 + tx * 4 + 3] = v.w;
    }
  }
  __syncthreads();
  {
    const int kc = tid & 3, n = tid >> 2;
    float v[16];
#pragma unroll
    for (int q = 0; q < 16; ++q) v[q] = tile[(kc * 16 + q) * 65 + n] * W8_SCALE;
    u32x4 o;
    o.x = pk_fp8x4(v[0], v[1], v[2], v[3]); o.y = pk_fp8x4(v[4], v[5], v[6], v[7]);
    o.z = pk_fp8x4(v[8], v[9], v[10], v[11]); o.w = pk_fp8x4(v[12], v[13], v[14], v[15]);
    *(u32x4*)(dst + (size_t)rowmap(n0 + n) * K + k0 + kc * 16) = o;
  }
  __syncthreads();
}

constexpr int CJ0 = 1152, CJ1 = CJ0 + 2080, CJ2 = CJ1 + 1024, CJ3 = CJ2 + 33280, CJ4 = CJ3 + 16640;
__device__ void convert_job(KP p, int job, float* sm, int tid) {
  if (job < CJ0) {
    const int j = job / 576, rem = job % 576, kt = rem / 36, nt = rem % 36;
    tr_tile(tid, p->att_w_in + (size_t)j * 1024 * ATT_N, ATT_N, kt * 64, nt * 64, p->Wt_att + (size_t)j * ATT_N * 1024,
            1024, [](int n) { return n; }, sm);
  } else if (job < CJ1) {
    const int q = job - CJ0;
    const int j = q / 1040, rem = q % 1040, kt = rem / 65, nt = rem % 65;
    tr_tile(tid, p->rec_w_in + (size_t)j * 1024 * REC_N, REC_N, kt * 64, nt * 64, p->Wt_rec + (size_t)j * REC_NP * 1024,
            1024, [](int n) { return n; }, sm);
  } else if (job < CJ2) {
    const int q = job - CJ1;
    const int i = q >> 8, rem = q & 255, kt = rem >> 4, nt = rem & 15;
    tr_tile(tid, p->mix_w_out + (size_t)i * 1024 * 1024, 1024, kt * 64, nt * 64, p->Wt_out + (size_t)i * 1024 * 1024,
            1024, [](int n) { return n; }, sm);
  } else if (job < CJ3) {
    const int q = job - CJ2;
    const int le = q >> 7, rem = q & 127;
    const int which = rem >> 6, kt = (rem >> 2) & 15, nt = rem & 3;
    const int layer = le / 65, e = le % 65;
    const float* src;
    if (e < 64) src = (which ? p->moe_w3 : p->moe_w1) + (size_t)(layer * 64 + e) * 1024 * 256;
    else src = (which ? p->shared_w3 : p->shared_w1) + (size_t)layer * 1024 * 256;
    tr_tile_fp8(tid, src, 256, kt * 64, nt * 64, (unsigned char*)p->Wt13 + (size_t)le * 512 * 1024, 1024,
                [which](int n) { return 64 * (n >> 5) + which * 32 + (n & 31); }, sm);
  } else {
    const int q = job - CJ3;
    const int le = q >> 6, rem = q & 63;
    const int kt = rem >> 4, nt = rem & 15;
    const int layer = le / 65, e = le % 65;
    const float* src = e < 64 ? p->moe_w2 + (size_t)(layer * 64 + e) * 256 * 1024 : p->shared_w2 + (size_t)layer * 256 * 1024;
    tr_tile_fp8(tid, src, 1024, kt * 64, nt * 64, (unsigned char*)p->Wt2 + (size_t)le * 1024 * 256, 256, [](int n) { return n; }, sm);
  }
}
__device__ __forceinline__ int conv_stage_total(int stage) {
  return stage == 0 ? (576 + 1040 + 512 + 8320 + 4160) : (stage == 1 ? (576 + 1040 + 256 + 16640 + 8320) : (256 + 8320 + 4160));
}
__device__ __forceinline__ int conv_stage_job(int stage, int q) {
  if (stage == 0) {
    if (q < 8320) return CJ2 + q;  q -= 8320;
    if (q < 4160) return CJ3 + q;  q -= 4160;
    if (q < 576) return q;  q -= 576;
    if (q < 1040) return CJ0 + q;  q -= 1040;
    return CJ1 + q;
  } else if (stage == 1) {
    if (q < 8320) return CJ2 + 8320 + q;  q -= 8320;
    if (q < 4160) return CJ3 + 4160 + q;  q -= 4160;
    if (q < 576) return 576 + q;  q -= 576;
    if (q < 256) return CJ1 + 512 + q;  q -= 256;
    if (q < 8320) return CJ2 + 16640 + q;  q -= 8320;
    if (q < 4160) return CJ3 + 8320 + q;  q -= 4160;
    return CJ0 + 1040 + q;
  }
  if (q < 256) return CJ1 + 768 + q;  q -= 256;
  if (q < 8320) return CJ2 + 24960 + q;  q -= 8320;
  return CJ3 + 12480 + q;
}

__device__ void ph_init(KP p, char* smc) {
  float* sm = (float*)smc;
  const int tid = opaque_tid();
  {
    const size_t n4a = (size_t)NL * DM / 4, n4b = (size_t)NC * DM / 4;
    const float4* xs = (const float4*)p->x;
    const float4* cs = (const float4*)p->ctx;
    float4* X4 = (float4*)p->X;
    for (size_t i = (size_t)blockIdx.x * NTHR + tid; i < n4a + n4b; i += (size_t)gridDim.x * NTHR)
      X4[i] = i < n4a ? xs[i] : cs[i - n4a];
  }
  for (int tile = blockIdx.x; tile < 96 * 8; tile += gridDim.x) {
    const int ct = tile >> 3, ks = tile & 7;
    for (int i = tid; i < 9 * 128; i += NTHR) {
      const int r = i >> 7, k = ks * 128 + (i & 127);
      const float v = r < 8 ? p->c[r * 1024 + k] : p->c_ctx[k];
      sm[i] = silu_f(v);
    }
    __syncthreads();
    const int col = ct * 256 + tid;
    const int layer = col / 6144, n = col % 6144;
    const float* W = p->ada_w + ((size_t)layer * 1024 + ks * 128) * 6144 + n;
    float acc[9];
#pragma unroll
    for (int r = 0; r < 9; ++r) acc[r] = 0.f;
#pragma unroll 4
    for (int k = 0; k < 128; ++k) {
      const float w = W[(size_t)k * 6144];
#pragma unroll
      for (int r = 0; r < 9; ++r) acc[r] = fmaf(sm[r * 128 + k], w, acc[r]);
    }
#pragma unroll
    for (int r = 0; r < 9; ++r) p->MODP[((size_t)(ks * 4 + layer) * 9 + r) * 6144 + n] = acc[r];
    __syncthreads();
  }
  for (int q = blockIdx.x; q < conv_stage_total(0); q += gridDim.x) convert_job(p, conv_stage_job(0, q), sm, tid);
  for (int i = blockIdx.x * NTHR + tid; i < 2 * 3 * 128 * 512; i += gridDim.x * NTHR) {
    const int k = i & 511, n = (i >> 9) & 127, wj = i >> 16;
    const int j = wj / 3, which = wj % 3;
    float v = 0.f;
    if (which < 2) {
      if (n < 64) v = (which ? p->rwkv_a1 : p->rwkv_w1)[((size_t)(j * 2 + (n >> 5)) * 512 + k) * 32 + (n & 31)];
    } else if (n < 96) v = p->rwkv_g1[((size_t)j * 512 + k) * 96 + n];
    p->Wl1[i] = f2bf(v);
  }
  for (int i = blockIdx.x * NTHR + tid; i < 2 * 2560 * 128; i += gridDim.x * NTHR) {
    const int k = i & 127, n = (i >> 7) % 2560, j = i / (2560 * 128);
    float v = 0.f;
    if (n < 2048) {
      const int d = (n >> 9) & 1, c = n & 511;
      if (k < 64 && (k >> 5) == d) v = (n < 1024 ? p->rwkv_w2 : p->rwkv_a2)[((size_t)(j * 2 + d) * 32 + (k & 31)) * 512 + c];
    } else if (k < 96) v = p->rwkv_g2[((size_t)j * 96 + k) * 512 + (n - 2048)];
    p->Wl2[i] = f2bf(v);
  }
  for (int i = blockIdx.x * NTHR + tid; i < 4 * 64 * 1024; i += gridDim.x * NTHR) {
    const int k = i & 1023, n = (i >> 10) & 63, l = i >> 16;
    p->WrT[i] = p->moe_router[((size_t)l * 1024 + k) * 64 + n];
  }
  for (int i = blockIdx.x * NTHR + tid; i < 64 * 16; i += gridDim.x * NTHR) {
    const int pos = i >> 4, f = i & 15;
    const float ang = (float)pos * powf(10000.f, -(float)f / 16.f);
    p->ROPE[2 * i] = cosf(ang);
    p->ROPE[2 * i + 1] = sinf(ang);
  }
}

__device__ void ph_mod_h(KP p, char* smc) {
  float* sm = (float*)smc;
  const int tid = opaque_tid();
  for (int i = blockIdx.x * NTHR + tid; i < 4 * 9 * 6144; i += gridDim.x * NTHR) {
    const int layer = i / (9 * 6144), rem = i % (9 * 6144), n = rem % 6144;
    float s = p->ada_b[layer * 6144 + n];
#pragma unroll
    for (int ks = 0; ks < 8; ++ks) s += p->MODP[(size_t)(ks * 4 + layer) * 9 * 6144 + rem];
    p->MOD[i] = s;
  }
  const int lane = tid & 63, wave = tid >> 6;
  const int per = (((NT + gridDim.x - 1) / gridDim.x) + 3) & ~3;
  const int t0 = blockIdx.x * per, t1 = min(NT, t0 + per);
  int cur = -1;
  for (int tb = t0; tb < t1; tb += 4) {
    const int mr = modrow(tb);
    if (mr != cur) {
      __syncthreads();
      for (int n = tid; n < 2048; n += NTHR) {
        float a = p->ada_b[n];
#pragma unroll
        for (int ks = 0; ks < 8; ++ks) a += p->MODP[((size_t)(ks * 4) * 9 + mr) * 6144 + n];
        sm[n] = a;
      }
      cur = mr;
      __syncthreads();
    }
    const int t = tb + wave;
    if (t < t1) {
      const float* src = t < NL ? p->x + (size_t)t * DM : p->ctx + (size_t)(t - NL) * DM;
#pragma unroll
      for (int i = 0; i < 4; ++i) {
        const int n = i * 256 + lane * 4;
        const float4 xv = *(const float4*)(src + n);
        const float4 sh = *(const float4*)(sm + n);
        const float4 sc = *(const float4*)(sm + 1024 + n);
        u32x2 o;
        o.x = pk_bf16(xv.x * (1.f + sc.x) + sh.x, xv.y * (1.f + sc.y) + sh.y);
        o.y = pk_bf16(xv.z * (1.f + sc.z) + sh.z, xv.w * (1.f + sc.w) + sh.w);
        *(u32x2*)(p->AB + (size_t)t * DM + n) = o;
      }
    }
  }
}

typedef short v4i16_t __attribute__((ext_vector_type(4)));
using s16x4 = __attribute__((ext_vector_type(4))) short;
__device__ __forceinline__ s16x4 vtr(const char* p) {
  return __builtin_bit_cast(s16x4, __builtin_amdgcn_ds_read_tr16_b64_v4i16((__attribute__((address_space(3))) v4i16_t*)p));
}
#define MFMA32(a, b, c) __builtin_amdgcn_mfma_f32_32x32x16_bf16(a, b, c, 0, 0, 0)
__device__ void ph_attention(KP p, int layer, bool keep, char* lds) {
  const int tid = opaque_tid();
  const int lane = tid & 63, w = tid >> 6, r32 = lane & 31, hi = lane >> 5;
  const int j = layer >> 1;
  float* bias_lds = (float*)(lds + 32768 + 1024);
  const int n_gqa = 1024, n_na = 1024, n_cb = keep ? 128 : 0, n_ca = keep ? 128 : 0;
  const int total = n_gqa + n_na + n_cb + n_ca;
  constexpr float LOG2E = 1.4426950408889634f;
  constexpr float C2 = 0.125f * LOG2E;
  const int c = tid & 7, sr = tid >> 3;
  const int kso = (c ^ ((tid >> 4) & 7)) * 16;
  const int vso = (c >> 2) * 4096 + (c & 3) * 16;
  const int sw = (r32 >> 1) & 7;
  for (int item = blockIdx.x; item < total; item += gridDim.x) {
    int b, qrow0, qoff, koff, voff, ocol, lat_tiles, lat_row0;
    bool na = false;
    int r_w = 0, start_w = 0, ru0 = 0, hN = 0;
    if (item < n_gqa) {
      b = item >> 7;
      const int g = (item >> 6) & 1, tt = item & 63;
      qrow0 = b * SEQ + tt * 32; qoff = 1536 + (g * 4 + w) * 64; koff = 2048 + g * 64; voff = 2176 + g * 64;
      ocol = 512 + (g * 4 + w) * 64; lat_tiles = 32; lat_row0 = b * SEQ;
    } else if (item < n_gqa + n_na) {
      const int it = item - n_gqa;
      b = it >> 7; hN = (it >> 4) & 7;
      const int rp = it & 15;
      na = true; r_w = 2 * rp + (w >> 1);
      qrow0 = b * SEQ + r_w * 64 + (w & 1) * 32; qoff = hN * 64; koff = 512 + hN * 64; voff = 1024 + hN * 64; ocol = hN * 64;
      const int s0 = min(max(2 * rp - 4, 0), 24), s1 = min(max(2 * rp - 3, 0), 24);
      start_w = (w >> 1) ? s1 : s0; ru0 = s0; lat_tiles = (s1 != s0) ? 9 : 8; lat_row0 = b * SEQ + ru0 * 64;
    } else if (item < n_gqa + n_na + n_cb) {
      const int it = item - n_gqa - n_na;
      b = it >> 4;
      const int g = (it >> 3) & 1, tt = it & 7;
      qrow0 = NL + b * CTXL + tt * 32; qoff = 1536 + (g * 4 + w) * 64; koff = 2048 + g * 64; voff = 2176 + g * 64;
      ocol = 512 + (g * 4 + w) * 64; lat_tiles = 0; lat_row0 = 0;
    } else {
      const int it = item - n_gqa - n_na - n_cb;
      b = it >> 4;
      const int h = (it >> 1) & 7, half = it & 1;
      qrow0 = NL + b * CTXL + half * 128 + w * 32; qoff = h * 64; koff = 512 + h * 64; voff = 1024 + h * 64; ocol = h * 64;
      lat_tiles = 0; lat_row0 = 0;
    }
    const int ctx_row0 = NL + b * CTXL, ntiles = lat_tiles + 4;
    if (na)
      for (int i = tid; i < 465; i += NTHR) bias_lds[i] = p->na_rpb[(j * 8 + hN) * 465 + i] * LOG2E;
    bf16x8 qf[4];
    {
      const bf16_t* qp = p->P + (size_t)(qrow0 + r32) * LDP + qoff + hi * 8;
#pragma unroll
      for (int d0 = 0; d0 < 4; ++d0) qf[d0] = *(const bf16x8*)(qp + d0 * 16);
    }
    f32x16 o0, o1;
#pragma unroll
    for (int q = 0; q < 16; ++q) { o0[q] = 0.f; o1[q] = 0.f; }
    float m = -INFINITY, l = 0.f;
    u32x4 kr0, kr1, vr0, vr1;
    auto gload = [&](int t) {
      const int row0 = t < lat_tiles ? lat_row0 + 64 * t : ctx_row0 + 64 * (t - lat_tiles);
      const bf16_t* base = p->P + (size_t)(row0 + sr) * LDP + c * 8;
      kr0 = *(const u32x4*)(base + koff); kr1 = *(const u32x4*)(base + (size_t)32 * LDP + koff);
      vr0 = *(const u32x4*)(base + voff); vr1 = *(const u32x4*)(base + (size_t)32 * LDP + voff);
    };
    auto swrite = [&](int buf) {
      char* Kb = lds + buf * 16384;
      char* Vb = Kb + 8192;
      *(u32x4*)(Kb + sr * 128 + kso) = kr0; *(u32x4*)(Kb + (sr + 32) * 128 + kso) = kr1;
      *(u32x4*)(Vb + vso + sr * 64) = vr0; *(u32x4*)(Vb + vso + (sr + 32) * 64) = vr1;
    };
    gload(0);
    swrite(0);
    for (int t = 0; t < ntiles; ++t) {
      __syncthreads();
      if (t + 1 < ntiles) gload(t + 1);
      const bool na_tile = na && t < lat_tiles;
      const int kr = ru0 + t;
      const bool part = !na_tile || (kr >= start_w && kr < start_w + 8);
      if (part) {
        const char* Ks = lds + (t & 1) * 16384;
        const char* Vs = Ks + 8192;
        f32x16 s0, s1;
#pragma unroll
        for (int q = 0; q < 16; ++q) { s0[q] = 0.f; s1[q] = 0.f; }
#pragma unroll
        for (int d0 = 0; d0 < 4; ++d0) {
          const int off = ((2 * d0 + hi) ^ sw) * 16;
          const bf16x8 k0 = *(const bf16x8*)(Ks + r32 * 128 + off);
          const bf16x8 k1 = *(const bf16x8*)(Ks + (32 + r32) * 128 + off);
          s0 = MFMA32(k0, qf[d0], s0);
          s1 = MFMA32(k1, qf[d0], s1);
        }
        float mx = -INFINITY;
        if (na_tile) {
          const int cq = (w & 1) * 32 + r32;
          const int c0 = min(max(cq - 8, 0), 48);
          const float* brow = bias_lds + (kr - r_w + 7) * 31 + (15 - cq);
#pragma unroll
          for (int q = 0; q < 16; ++q) {
            const int kc = (q & 3) + 8 * (q >> 2) + 4 * hi;
            const float v0 = ((unsigned)(kc - c0) < 16u) ? fmaf(s0[q], C2, brow[kc]) : -INFINITY;
            const float v1 = ((unsigned)(kc + 32 - c0) < 16u) ? fmaf(s1[q], C2, brow[kc + 32]) : -INFINITY;
            s0[q] = v0; s1[q] = v1;
            mx = fmaxf(mx, fmaxf(v0, v1));
          }
        } else {
#pragma unroll
          for (int q = 0; q < 16; ++q) {
            s0[q] *= C2; s1[q] *= C2;
            mx = fmaxf(mx, fmaxf(s0[q], s1[q]));
          }
        }
        {
          auto rr = __builtin_amdgcn_permlane32_swap(__float_as_uint(mx), __float_as_uint(mx), false, false);
          mx = fmaxf(__uint_as_float(rr[0]), __uint_as_float(rr[1]));
        }
        const float mnew = fmaxf(m, mx);
        const float alpha = __builtin_amdgcn_exp2f(m - mnew);
        float ls = 0.f;
#pragma unroll
        for (int q = 0; q < 16; ++q) {
          s0[q] = __builtin_amdgcn_exp2f(s0[q] - mnew);
          s1[q] = __builtin_amdgcn_exp2f(s1[q] - mnew);
          ls += s0[q] + s1[q];
        }
        l = l * alpha + ls;
        m = mnew;
#pragma unroll
        for (int q = 0; q < 16; ++q) { o0[q] *= alpha; o1[q] *= alpha; }
        bf16x8 pf[4];
#pragma unroll
        for (int s = 0; s < 4; ++s) {
          const int u = (s & 1) * 8;
          u32x4 tpk;
          if (s < 2) {
            tpk.x = pk_bf16(s0[u + 0], s0[u + 1]); tpk.y = pk_bf16(s0[u + 2], s0[u + 3]);
            tpk.z = pk_bf16(s0[u + 4], s0[u + 5]); tpk.w = pk_bf16(s0[u + 6], s0[u + 7]);
          } else {
            tpk.x = pk_bf16(s1[u + 0], s1[u + 1]); tpk.y = pk_bf16(s1[u + 2], s1[u + 3]);
            tpk.z = pk_bf16(s1[u + 4], s1[u + 5]); tpk.w = pk_bf16(s1[u + 6], s1[u + 7]);
          }
          pf[s] = __builtin_bit_cast(bf16x8, tpk);
        }
        const char* vb = Vs + ((lane >> 4) & 1) * 32 + (lane & 3) * 8 + ((lane & 15) >> 2) * 64 + hi * 256;
#pragma unroll
        for (int s = 0; s < 4; ++s) {
          const s16x4 a00 = vtr(vb + (16 * s) * 64), a01 = vtr(vb + (16 * s + 8) * 64);
          const s16x4 a10 = vtr(vb + 4096 + (16 * s) * 64), a11 = vtr(vb + 4096 + (16 * s + 8) * 64);
          const bf16x8 A0 = __builtin_shufflevector(a00, a01, 0, 1, 2, 3, 4, 5, 6, 7);
          const bf16x8 A1 = __builtin_shufflevector(a10, a11, 0, 1, 2, 3, 4, 5, 6, 7);
          o0 = MFMA32(A0, pf[s], o0);
          o1 = MFMA32(A1, pf[s], o1);
        }
      }
      if (t + 1 < ntiles) swrite((t + 1) & 1);
    }
    __syncthreads();
    const float lt = l + __shfl_xor(l, 32);
    const float inv = 1.f / lt;
    bf16_t* op = p->AB + (size_t)(qrow0 + r32) * DM + ocol + 4 * hi;
#pragma unroll
    for (int g = 0; g < 4; ++g) {
      u32x2 v0, v1;
      v0.x = pk_bf16(o0[4 * g] * inv, o0[4 * g + 1] * inv); v0.y = pk_bf16(o0[4 * g + 2] * inv, o0[4 * g + 3] * inv);
      v1.x = pk_bf16(o1[4 * g] * inv, o1[4 * g + 1] * inv); v1.y = pk_bf16(o1[4 * g + 2] * inv, o1[4 * g + 3] * inv);
      *(u32x2*)(op + 8 * g) = v0;
      *(u32x2*)(op + 32 + 8 * g) = v1;
    }
  }
}

__device__ void ph_rwkv_mix(KP p, int layer) {
  const int j = layer >> 1;
  const int tid = opaque_tid();
  const int lane = tid & 63, wave = tid >> 6;
  const float* mu = p->rwkv_mu + j * 6 * 512;
  const int c0 = lane * 8;
  auto unpack = [](const u32x4 u, float (&f)[8]) {
    f[0] = bflo(u.x); f[1] = bfhi(u.x); f[2] = bflo(u.y); f[3] = bfhi(u.y);
    f[4] = bflo(u.z); f[5] = bfhi(u.z); f[6] = bflo(u.w); f[7] = bfhi(u.w);
  };
  auto pack = [](const float (&f)[8]) {
    u32x4 o;
    o.x = pk_bf16(f[0], f[1]); o.y = pk_bf16(f[2], f[3]); o.z = pk_bf16(f[4], f[5]); o.w = pk_bf16(f[6], f[7]);
    return o;
  };
  for (int t = blockIdx.x * 4 + wave; t < NT; t += gridDim.x * 4) {
    bool hasp, hasn;
    if (t < NL) { int s = t & 2047; hasp = s > 0; hasn = s < SEQ - 1; }
    else { int s = (t - NL) & 255; hasp = s > 0; hasn = s < CTXL - 1; }
    const bf16_t* pt = p->P + (size_t)t * LDP + c0;
    bf16_t* rw = p->RW + (size_t)t * RWS + c0;
    bf16_t* zb = p->Zb + (size_t)t * 1536 + c0;
    const u32x4 zero = {0u, 0u, 0u, 0u};
#pragma unroll
    for (int q = 0; q < 4; ++q) {
      float cur[8], pv[8], nx[8], d[8];
      unpack(*(const u32x4*)(pt + q * 512), cur);
      unpack(hasp ? *(const u32x4*)(pt + q * 512 - LDP) : zero, pv);
      unpack(hasn ? *(const u32x4*)(pt + q * 512 + LDP) : zero, nx);
#pragma unroll
      for (int e = 0; e < 8; ++e) d[e] = 0.5f * (pv[e] + nx[e]) - cur[e];
      if (q < 3) {
        float o[8];
        const float* m = mu + q * 512 + c0;
#pragma unroll
        for (int e = 0; e < 8; ++e) o[e] = cur[e] + d[e] * m[e];
        if (q == 0) *(u32x4*)(rw) = pack(o);
        else if (q == 2) *(u32x4*)(rw + 512) = pack(o);
        else {
          *(u32x4*)(rw + 10 * 512) = pack(o);
          float kk[8], ss = 0.f;
          const float* kv0 = p->rwkv_kvec + (j * 2 + 0) * 512 + c0;
#pragma unroll
          for (int e = 0; e < 8; ++e) { kk[e] = o[e] * kv0[e]; ss += kk[e] * kk[e]; }
          ss += dppx<0xB1>(ss); ss += dppx<0x4E>(ss); ss += dppx<0x141>(ss);
          const float rn = rsqrtf(fmaxf(ss, 1e-24f));
#pragma unroll
          for (int e = 0; e < 8; ++e) kk[e] *= rn;
          *(u32x4*)(rw + 2 * 512) = pack(kk);
        }
      } else {
#pragma unroll
        for (int z = 0; z < 3; ++z) {
          float o[8];
          const float* m = mu + (3 + z) * 512 + c0;
#pragma unroll
          for (int e = 0; e < 8; ++e) o[e] = cur[e] + d[e] * m[e];
          *(u32x4*)(zb + z * 512) = pack(o);
        }
      }
    }
  }
}

constexpr int RS_STEP = 384;
constexpr int RS_TB = 16;
struct RwkvStage { u32x2 r, kk, e, ke, a, v; };
__device__ void rwkv_unit(KP p, int unit, float* sm, int tid) {
  const int ch = unit >> 1, hf = unit & 1;
  const int dir = ch >> 6, b = (ch >> 3) & 7, h = ch & 7;
  const int lane = tid & 63, w = tid >> 6, rl = lane >> 3, ks = lane & 7;
  float* ybuf = sm + 2 * RS_TB * RS_STEP;
  const int ss = tid >> 4, kq = tid & 15;
  auto gload = [&](int n, RwkvStage& g) {
    const int row = scan_row(dir, b, n * RS_TB + ss);
    const bf16_t* base = p->RW + (size_t)row * RWS + h * 64 + kq * 4;
    g.r = *(const u32x2*)(base);
    g.kk = *(const u32x2*)(base + 2 * 512);
    g.e = *(const u32x2*)(base + (3 + dir) * 512);
    g.ke = *(const u32x2*)(base + (5 + dir) * 512);
    g.a = *(const u32x2*)(base + (7 + dir) * 512);
    g.v = *(const u32x2*)(p->RW + (size_t)row * RWS + 512 + h * 64 + hf * 32 + (kq & 7) * 4);
  };
  auto swrite = [&](int buf, const RwkvStage& g) {
    float* sp = sm + (buf * RS_TB + ss) * RS_STEP;
    const float r0 = bflo(g.r.x), r1 = bfhi(g.r.x), r2 = bflo(g.r.y), r3 = bfhi(g.r.y);
    const float k0 = bflo(g.kk.x), k1 = bfhi(g.kk.x), k2 = bflo(g.kk.y), k3 = bfhi(g.kk.y);
    const float w0 = __expf(-bflo(g.e.x)), w1 = __expf(-bfhi(g.e.x)), w2 = __expf(-bflo(g.e.y)), w3 = __expf(-bfhi(g.e.y));
    const float e0 = bflo(g.ke.x), e1 = bfhi(g.ke.x), e2 = bflo(g.ke.y), e3 = bfhi(g.ke.y);
    const float a0 = k0 * bflo(g.a.x), a1 = k1 * bfhi(g.a.x), a2 = k2 * bflo(g.a.y), a3 = k3 * bfhi(g.a.y);
    *(float4*)(sp + kq * 4) = make_float4(k0, k1, k2, k3);
    *(float4*)(sp + 64 + kq * 4) = make_float4(w0 * r0, w1 * r1, w2 * r2, w3 * r3);
    *(float4*)(sp + 128 + kq * 4) = make_float4(w0, w1, w2, w3);
    *(float4*)(sp + 192 + kq * 4) = make_float4(a0, a1, a2, a3);
    *(float4*)(sp + 256 + kq * 4) = make_float4(e0, e1, e2, e3);
    if (kq < 8) *(float4*)(sp + 320 + kq * 4) = make_float4(bflo(g.v.x), bfhi(g.v.x), bflo(g.v.y), bfhi(g.v.y));
    float c1 = a0 * r0 + a1 * r1 + a2 * r2 + a3 * r3;
    float c2 = e0 * r0 + e1 * r1 + e2 * r2 + e3 * r3;
    c1 += dppx<0xB1>(c1); c2 += dppx<0xB1>(c2);
    c1 += dppx<0x4E>(c1); c2 += dppx<0x4E>(c2);
    c1 += dppx<0x141>(c1); c2 += dppx<0x141>(c2);
    c1 += dppx<0x140>(c1); c2 += dppx<0x140>(c2);
    if (kq == 0) { sp[352] = c1; sp[353] = c2; }
  };
  typedef float f2 __attribute__((ext_vector_type(2)));
  f2 S01 = {0.f, 0.f}, S23 = {0.f, 0.f}, S45 = {0.f, 0.f}, S67 = {0.f, 0.f};
  auto compute = [&](int n) {
    const float* bp = sm + (n & 1) * RS_TB * RS_STEP;
    float* yb = ybuf + (n & 1) * RS_TB * 32 + w * 8 + rl;
    struct Ops { f2 k[4], r[4], w[4], a[4], e[4]; float vv; f2 c; };
    auto ld = [&](int s, Ops& o) {
      const float* sq = bp + s * RS_STEP;
      const f2* sp = (const f2*)(sq + ks * 8);
#pragma unroll
      for (int i = 0; i < 4; ++i) { o.k[i] = sp[i]; o.r[i] = sp[32 + i]; o.w[i] = sp[64 + i]; o.a[i] = sp[96 + i]; o.e[i] = sp[128 + i]; }
      o.vv = sq[320 + w * 8 + rl]; o.c = *(const f2*)(sq + 352);
    };
    auto step = [&](const Ops& o) -> float {
      f2 sa2 = S01 * o.k[0];
      f2 y2 = S01 * o.r[0];
      sa2 = __builtin_elementwise_fma(S23, o.k[1], sa2); y2 = __builtin_elementwise_fma(S23, o.r[1], y2);
      sa2 = __builtin_elementwise_fma(S45, o.k[2], sa2); y2 = __builtin_elementwise_fma(S45, o.r[2], y2);
      sa2 = __builtin_elementwise_fma(S67, o.k[3], sa2); y2 = __builtin_elementwise_fma(S67, o.r[3], y2);
      float sa = sa2.x + sa2.y, y0 = y2.x + y2.y;
      sa += dppx<0xB1>(sa); y0 += dppx<0xB1>(y0);
      sa += dppx<0x4E>(sa); y0 += dppx<0x4E>(y0);
      sa += dppx<0x141>(sa); y0 += dppx<0x141>(y0);
      sa = -sa;
      const f2 sav = {sa, sa}, vvv = {o.vv, o.vv};
      S01 = __builtin_elementwise_fma(vvv, o.e[0], __builtin_elementwise_fma(sav, o.a[0], S01 * o.w[0]));
      S23 = __builtin_elementwise_fma(vvv, o.e[1], __builtin_elementwise_fma(sav, o.a[1], S23 * o.w[1]));
      S45 = __builtin_elementwise_fma(vvv, o.e[2], __builtin_elementwise_fma(sav, o.a[2], S45 * o.w[2]));
      S67 = __builtin_elementwise_fma(vvv, o.e[3], __builtin_elementwise_fma(sav, o.a[3], S67 * o.w[3]));
      return fmaf(o.vv, o.c.y, fmaf(sa, o.c.x, y0));
    };
    Ops oa, ob;
    ld(0, oa);
#pragma unroll 1
    for (int s = 0; s < RS_TB; s += 2) {
      __builtin_amdgcn_sched_barrier(0);
      ld(s + 1, ob);
      __builtin_amdgcn_sched_barrier(0);
      float y0 = step(oa);
      asm volatile("" : "+v"(y0));
      __builtin_amdgcn_sched_barrier(0);
      ld(s + 2, oa);
      __builtin_amdgcn_sched_barrier(0);
      float y1 = step(ob);
      asm volatile("" : "+v"(y1));
      __builtin_amdgcn_sched_barrier(0);
      if (ks == 0) { yb[s * 32] = y0; yb[(s + 1) * 32] = y1; }
    }
  };
  auto yout = [&](int n) {
    const int row = scan_row(dir, b, n * RS_TB + ss);
    const float* ys = ybuf + (n & 1) * RS_TB * 32 + ss * 32 + kq * 2;
    *(unsigned*)(p->P + (size_t)row * LDP + dir * 512 + h * 64 + hf * 32 + kq * 2) = pk_bf16(ys[0], ys[1]);
  };
  constexpr int NB = TSC / RS_TB;
  RwkvStage gA, gB;
  gload(0, gA);
  gload(1, gB);
  swrite(0, gA);
  gload(2, gA);
  __syncthreads();
  for (int n = 0; n < NB; n += 2) {
    compute(n);
    swrite(1, gB);
    if (n + 3 < NB) gload(n + 3, gB);
    __syncthreads();
    yout(n);
    compute(n + 1);
    if (n + 2 < NB) swrite(0, gA);
    if (n + 4 < NB) gload(n + 4, gA);
    __syncthreads();
    yout(n + 1);
  }
  __syncthreads();
}

__device__ void mlstm_s1(KP p, int layer, int tile, char* lds, int tid) {
  const int j = layer >> 1;
  const int ch = tile / NCHUNK, c = tile % NCHUNK;
  const int dir = ch >> 5, b = (ch >> 2) & 7, h = ch & 3;
  float* s_ws = (float*)(lds + META_OFF);
  int* s_row = (int*)(s_ws + 64);
  char* kimg = lds;
  char* vimg = lds + 16384;
  if (tid < 64) {
    const int row = scan_row(dir, b, c * 64 + tid);
    s_row[tid] = row;
    const float* g = p->GP + (size_t)row * 16;
    const float gi = g[(dir * 2) * 4 + h] + p->mlstm_gate_b[j * 16 + (dir * 2) * 4 + h];
    const float gf = g[(dir * 2 + 1) * 4 + h] + p->mlstm_gate_b[j * 16 + (dir * 2 + 1) * 4 + h];
    float bc = -softplus_f(-gf);
#pragma unroll
    for (int o = 1; o < 64; o <<= 1) {
      float tmp = __shfl_up(bc, o);
      if (tid >= o) bc += tmp;
    }
    const float bend = __shfl(bc, 63);
    const float ds = bend - bc + gi;
    const float mloc = wmax(ds);
    s_ws[tid] = expf(ds - mloc);
    if (tid == 0) { p->msc[tile] = mloc; p->msc[NMT + tile] = bend; }
  }
  __syncthreads();
  {
    const int c8 = tid & 15;
    const int ioff = (c8 >> 2) * 4096 + (c8 & 3) * 16;
#pragma unroll
    for (int i = 0; i < 4; ++i) {
      const int sidx = (tid >> 4) + 16 * i;
      const bf16_t* src = p->P + (size_t)s_row[sidx] * LDP + h * 128 + c8 * 8;
      const u32x4 kv = *(const u32x4*)(src + 2560);
      u32x4 vv = *(const u32x4*)(src + 3072);
      const float wsv = s_ws[sidx];
      vv.x = pk_bf16(bflo(vv.x) * wsv, bfhi(vv.x) * wsv); vv.y = pk_bf16(bflo(vv.y) * wsv, bfhi(vv.y) * wsv);
      vv.z = pk_bf16(bflo(vv.z) * wsv, bfhi(vv.z) * wsv); vv.w = pk_bf16(bflo(vv.w) * wsv, bfhi(vv.w) * wsv);
      *(u32x4*)(kimg + ioff + sidx * 64) = kv;
      *(u32x4*)(vimg + ioff + sidx * 64) = vv;
    }
  }
  __syncthreads();
  const int lane = tid & 63, w = tid >> 6, wm = w >> 1, wn = w & 1, r32 = lane & 31, hi = lane >> 5;
  f32x16 acc[2][2];
#pragma unroll
  for (int mi = 0; mi < 2; ++mi)
#pragma unroll
    for (int ni = 0; ni < 2; ++ni)
#pragma unroll
      for (int q = 0; q < 16; ++q) acc[mi][ni][q] = 0.f;
  const int toff = ((lane >> 4) & 1) * 32 + (lane & 3) * 8 + ((lane & 15) >> 2) * 64 + hi * 256;
#pragma unroll
  for (int ks = 0; ks < 4; ++ks) {
    bf16x8 af[2], bfr[2];
#pragma unroll
    for (int i = 0; i < 2; ++i) {
      const char* ka = kimg + (wm * 2 + i) * 4096 + toff + (16 * ks) * 64;
      const char* va = vimg + (wn * 2 + i) * 4096 + toff + (16 * ks) * 64;
      af[i] = __builtin_shufflevector(vtr(ka), vtr(ka + 8 * 64), 0, 1, 2, 3, 4, 5, 6, 7);
      bfr[i] = __builtin_shufflevector(vtr(va), vtr(va + 8 * 64), 0, 1, 2, 3, 4, 5, 6, 7);
    }
    acc[0][0] = MFMA32(af[0], bfr[0], acc[0][0]);
    acc[0][1] = MFMA32(af[0], bfr[1], acc[0][1]);
    acc[1][0] = MFMA32(af[1], bfr[0], acc[1][0]);
    acc[1][1] = MFMA32(af[1], bfr[1], acc[1][1]);
  }
  bf16_t* U = p->MS + (size_t)tile * 16384;
#pragma unroll
  for (int mi = 0; mi < 2; ++mi)
#pragma unroll
    for (int ni = 0; ni < 2; ++ni)
#pragma unroll
      for (int q = 0; q < 16; ++q) {
        const int d = wm * 64 + mi * 32 + (q & 3) + 8 * (q >> 2) + 4 * hi;
        U[d * 128 + wn * 64 + ni * 32 + r32] = f2bf(acc[mi][ni][q]);
        if ((q & 3) == 3) __builtin_amdgcn_sched_barrier(0);
      }
  if (tid < 128) {
    const char* kc = kimg + (tid >> 5) * 4096 + (tid & 31) * 2;
    float a = 0.f;
#pragma unroll 8
    for (int sidx = 0; sidx < 64; ++sidx) a = fmaf(s_ws[sidx], bf2f(*(const bf16_t*)(kc + sidx * 64)), a);
    p->MSn[tile * 128 + tid] = a;
  }
}

__device__ void mlstm_s3(KP p, int layer, int tile, char* lds, int tid);
__device__ void ph_scan_a(KP p, int layer, char* smc) {
  float* sm = (float*)smc;
  const int tid = opaque_tid();
  for (int u = blockIdx.x; u < 256; u += gridDim.x) rwkv_unit(p, u, sm, tid);
  {
    const int stage = layer == 1 ? 1 : 2;
    const int total = NMT + conv_stage_total(stage);
    int* qc = (int*)(p->bar + XCD_BAR_WORDS + 16 * stage);
    int* s_q = (int*)(smc + META_OFF + 3968);
    for (;;) {
      __syncthreads();
      if (tid == 0) *s_q = atomicAdd(qc, 1);
      __syncthreads();
      const int q = *s_q;
      if (q >= total) break;
      if (q < NMT) mlstm_s3(p, layer, q, smc, tid);
      else convert_job(p, conv_stage_job(stage, q - NMT), sm, tid);
    }
  }
}

__device__ void ph_mlstm_s2(KP p, char* smc) {
  float* sw = (float*)smc;
  const int tid = opaque_tid();
  const int nitems = 64 * 33;
  for (int item = blockIdx.x; item < nitems; item += gridDim.x) {
    const int ch = item / 33, seg = item % 33;
    __syncthreads();
    if (tid == 0) {
      float m = 0.f;
      for (int c = 0; c < NCHUNK; ++c) {
        const int tile = ch * NCHUNK + c;
        const float mloc = p->msc[tile], bend = p->msc[NMT + tile];
        const float mn = fmaxf(bend + m, mloc);
        sw[c] = expf(bend + m - mn);
        sw[36 + c] = expf(mloc - mn);
        if (seg == 0) p->msc[2 * NMT + tile] = m;
        m = mn;
      }
    }
    __syncthreads();
    if (seg < 32) {
      unsigned* base = (unsigned*)(p->MS + (size_t)ch * NCHUNK * 16384) + seg * 256 + tid;
      unsigned v[NCHUNK];
#pragma unroll
      for (int c = 0; c < NCHUNK; ++c) v[c] = base[(size_t)c * 8192];
      float C0 = 0.f, C1 = 0.f;
#pragma unroll
      for (int c = 0; c < NCHUNK; ++c) {
        const float t0 = bflo(v[c]), t1 = bfhi(v[c]);
        v[c] = pk_bf16(C0, C1);
        C0 = sw[c] * C0 + sw[36 + c] * t0;
        C1 = sw[c] * C1 + sw[36 + c] * t1;
      }
#pragma unroll
      for (int c = 0; c < NCHUNK; ++c) base[(size_t)c * 8192] = v[c];
    } else if (tid < 128) {
      float* base = p->MSn + (size_t)ch * NCHUNK * 128 + tid;
      float v[NCHUNK];
#pragma unroll
      for (int c = 0; c < NCHUNK; ++c) v[c] = base[c * 128];
      float C = 0.f;
#pragma unroll
      for (int c = 0; c < NCHUNK; ++c) {
        const float t0 = v[c];
        v[c] = C;
        C = sw[c] * C + sw[36 + c] * t0;
      }
#pragma unroll
      for (int c = 0; c < NCHUNK; ++c) base[c * 128] = v[c];
    }
  }
}

__device__ void mlstm_s3(KP p, int layer, int tile, char* lds, int tid) {
  const int j = layer >> 1;
  const int ch = tile / NCHUNK, c = tile % NCHUNK;
  const int dir = ch >> 5, b = (ch >> 2) & 7, h = ch & 3;
  float* s_b = (float*)(lds + META_OFF);
  float* s_ig = s_b + 64;
  float* s_mt = s_b + 128;
  float* s_wi = s_b + 192;
  int* s_row = (int*)(s_b + 256);
  float* s_n = s_b + 320;
  float* s_c = s_b + 448;
  char* kimg = lds;
  char* vimg = lds + 16384;
  char* cimg = lds + 32768;
  const float mprev = p->msc[2 * NMT + tile];
  const float qscale = 0.08838834764831845f;
  if (tid < 64) {
    const int row = scan_row(dir, b, c * 64 + tid);
    s_row[tid] = row;
    const float* g = p->GP + (size_t)row * 16;
    const float gi = g[(dir * 2) * 4 + h] + p->mlstm_gate_b[j * 16 + (dir * 2) * 4 + h];
    const float gf = g[(dir * 2 + 1) * 4 + h] + p->mlstm_gate_b[j * 16 + (dir * 2 + 1) * 4 + h];
    float bc = -softplus_f(-gf);
#pragma unroll
    for (int o = 1; o < 64; o <<= 1) {
      float tmp = __shfl_up(bc, o);
      if (tid >= o) bc += tmp;
    }
    s_b[tid] = bc;
    s_ig[tid] = gi;
  } else if (tid < 192) s_n[tid - 64] = p->MSn[tile * 128 + (tid - 64)];
  __syncthreads();
  if (tid < 64) {
    const float bt = s_b[tid];
    float mt = bt + mprev;
    for (int sx = 0; sx <= tid; ++sx) mt = fmaxf(mt, bt - s_b[sx] + s_ig[sx]);
    s_mt[tid] = mt;
    s_wi[tid] = expf(bt + mprev - mt);
    s_c[tid] = (s_ig[tid] - bt) * 1.4426950408889634f;
  }
  {
    const int c8 = tid & 15;
    const int ioff = (c8 >> 2) * 4096 + (c8 & 3) * 16;
#pragma unroll
    for (int i = 0; i < 4; ++i) {
      const int sidx = (tid >> 4) + 16 * i;
      const bf16_t* src = p->P + (size_t)s_row[sidx] * LDP + h * 128 + c8 * 8;
      *(u32x4*)(kimg + sidx * 256 + ((c8 ^ (sidx & 15)) * 16)) = *(const u32x4*)(src + 2560);
      *(u32x4*)(vimg + ioff + sidx * 64) = *(const u32x4*)(src + 3072);
    }
    __builtin_amdgcn_sched_barrier(0);
    const bf16_t* Cp = p->MS + (size_t)tile * 16384;
    const int coff = (c8 >> 2) * 8192 + (c8 & 3) * 16;
#pragma unroll
    for (int i = 0; i < 8; ++i) {
      const int d = (tid >> 4) + 16 * i;
      *(u32x4*)(cimg + coff + d * 64) = *(const u32x4*)(Cp + d * 128 + c8 * 8);
      if (i == 3) __builtin_amdgcn_sched_barrier(0);
    }
    __builtin_amdgcn_sched_barrier(0);
  }
  const int lane = tid & 63, w = tid >> 6, wt = w >> 1, wv = w & 1, r32 = lane & 31, hi = lane >> 5;
  const int t = wt * 32 + r32;
  bf16x8 qf[8];
  {
    const bf16_t* qp = p->P + (size_t)s_row[t] * LDP + 2048 + h * 128 + hi * 8;
#pragma unroll
    for (int d0 = 0; d0 < 8; ++d0) qf[d0] = *(const bf16x8*)(qp + d0 * 16);
  }
  __syncthreads();
  const int toff = ((lane >> 4) & 1) * 32 + (lane & 3) * 8 + ((lane & 15) >> 2) * 64;
  constexpr float LOG2E_ = 1.4426950408889634f;
  float qn = 0.f;
#pragma unroll
  for (int d0 = 0; d0 < 8; ++d0) {
    const u32x4 qq = __builtin_bit_cast(u32x4, qf[d0]);
    const float* np = s_n + d0 * 16 + hi * 8;
    qn = fmaf(bflo(qq.x), np[0], qn); qn = fmaf(bfhi(qq.x), np[1], qn);
    qn = fmaf(bflo(qq.y), np[2], qn); qn = fmaf(bfhi(qq.y), np[3], qn);
    qn = fmaf(bflo(qq.z), np[4], qn); qn = fmaf(bfhi(qq.z), np[5], qn);
    qn = fmaf(bflo(qq.w), np[6], qn); qn = fmaf(bfhi(qq.w), np[7], qn);
  }
  qn += __shfl_xor(qn, 32);
  const float mtt = s_mt[t], wi = s_wi[t];
  const float ct = (s_b[t] - mtt) * LOG2E_;
  const float wq = wi * qscale;
  bf16x8 pf[4];
  float den = 0.f;
  {
    f32x16 sa0, sa1;
#pragma unroll
    for (int q = 0; q < 16; ++q) { sa0[q] = 0.f; sa1[q] = 0.f; }
#pragma unroll
    for (int d0 = 0; d0 < 8; ++d0) {
      const int chn = 2 * d0 + hi;
      const bf16x8 k0 = *(const bf16x8*)(kimg + r32 * 256 + ((chn ^ (r32 & 15)) * 16));
      sa0 = MFMA32(k0, qf[d0], sa0);
      if (wt) {
        const bf16x8 k1 = *(const bf16x8*)(kimg + (32 + r32) * 256 + ((chn ^ (r32 & 15)) * 16));
        sa1 = MFMA32(k1, qf[d0], sa1);
      }
      __builtin_amdgcn_sched_barrier(0);
    }
#pragma unroll
    for (int g = 0; g < 4; ++g) {
      const int sb0 = 8 * g + 4 * hi;
      const float4 c0v = *(const float4*)(s_c + sb0);
      const float4 c1v = *(const float4*)(s_c + sb0 + 32);
      const float cc0[4] = {c0v.x, c0v.y, c0v.z, c0v.w}, cc1[4] = {c1v.x, c1v.y, c1v.z, c1v.w};
#pragma unroll
      for (int e = 0; e < 4; ++e) {
        const int q = 4 * g + e;
        const float v0 = (sb0 + e <= t) ? sa0[q] * qscale * __builtin_amdgcn_exp2f(ct + cc0[e]) : 0.f;
        sa0[q] = v0; den += v0;
        const float v1 = (wt && sb0 + 32 + e <= t) ? sa1[q] * qscale * __builtin_amdgcn_exp2f(ct + cc1[e]) : 0.f;
        sa1[q] = v1; den += v1;
      }
      __builtin_amdgcn_sched_barrier(0);
    }
#pragma unroll
    for (int sx = 0; sx < 4; ++sx) {
      const int u = (sx & 1) * 8;
      u32x4 tpk;
      if (sx < 2) {
        tpk.x = pk_bf16(sa0[u + 0], sa0[u + 1]); tpk.y = pk_bf16(sa0[u + 2], sa0[u + 3]);
        tpk.z = pk_bf16(sa0[u + 4], sa0[u + 5]); tpk.w = pk_bf16(sa0[u + 6], sa0[u + 7]);
      } else {
        tpk.x = pk_bf16(sa1[u + 0], sa1[u + 1]); tpk.y = pk_bf16(sa1[u + 2], sa1[u + 3]);
        tpk.z = pk_bf16(sa1[u + 4], sa1[u + 5]); tpk.w = pk_bf16(sa1[u + 6], sa1[u + 7]);
      }
      pf[sx] = __builtin_bit_cast(bf16x8, tpk);
    }
  }
  den += __shfl_xor(den, 32);
  const float dtot = den + wq * qn;
  const float inv = 1.f / fmaxf(fabsf(dtot), expf(-mtt));
  bf16_t* op = p->P + (size_t)s_row[t] * LDP + 1024 + dir * 512 + h * 128 + wv * 64 + 4 * hi;
#pragma unroll 1
  for (int vp = 0; vp < 2; ++vp) {
    f32x16 o0;
#pragma unroll
    for (int q = 0; q < 16; ++q) o0[q] = 0.f;
    const char* cb = cimg + (wv * 2 + vp) * 8192 + toff + hi * 512;
#pragma unroll
    for (int d0 = 0; d0 < 8; ++d0) {
      const bf16x8 A0 = __builtin_shufflevector(vtr(cb + (16 * d0) * 64), vtr(cb + (16 * d0 + 4) * 64), 0, 1, 2, 3, 4, 5, 6, 7);
      o0 = MFMA32(A0, qf[d0], o0);
    }
#pragma unroll
    for (int q = 0; q < 16; ++q) o0[q] *= wq;
    const char* vb = vimg + (wv * 2 + vp) * 4096 + toff + hi * 256;
#pragma unroll
    for (int sx = 0; sx < 4; ++sx) {
      if (sx < 2 || wt) {
        const bf16x8 A0 = __builtin_shufflevector(vtr(vb + (16 * sx) * 64), vtr(vb + (16 * sx + 8) * 64), 0, 1, 2, 3, 4, 5, 6, 7);
        o0 = MFMA32(A0, pf[sx], o0);
      }
    }
#pragma unroll
    for (int g = 0; g < 4; ++g) {
      u32x2 v0;
      v0.x = pk_bf16(o0[4 * g] * inv, o0[4 * g + 1] * inv); v0.y = pk_bf16(o0[4 * g + 2] * inv, o0[4 * g + 3] * inv);
      *(u32x2*)(op + vp * 32 + 8 * g) = v0;
    }
  }
}

__device__ void ph_mlstm_s1(KP p, int layer, char* smc) {
  const int tid = opaque_tid();
  __syncthreads();
  for (int tile = blockIdx.x; tile < NMT; tile += gridDim.x) { mlstm_s1(p, layer, tile, smc, tid); __syncthreads(); }
}

__device__ void ph_rec_final(KP p, int layer, bool keep) {
  const int tid = opaque_tid();
  const int j = layer >> 1;
  const int lane = tid & 63, wave = tid >> 6;
  const int rows = keep ? NT : NL;
  const int c0 = lane * 8;
  auto unpack = [](const u32x4 u, float (&f)[8]) {
    f[0] = bflo(u.x); f[1] = bfhi(u.x); f[2] = bflo(u.y); f[3] = bfhi(u.y);
    f[4] = bflo(u.z); f[5] = bfhi(u.z); f[6] = bflo(u.w); f[7] = bfhi(u.w);
  };
  for (int t = blockIdx.x * 4 + wave; t < rows; t += gridDim.x * 4) {
    const bf16_t* rw = p->RW + (size_t)t * RWS + c0;
    const bf16_t* pt = p->P + (size_t)t * LDP + c0;
    bf16_t* mo = p->AB + (size_t)t * DM + c0;
    {
      float yf[8], yb[8], r[8], v[8], k0[8], k1[8], g[8], y[8], o[8];
      unpack(*(const u32x4*)(pt), yf); unpack(*(const u32x4*)(pt + 512), yb);
      unpack(*(const u32x4*)(rw), r); unpack(*(const u32x4*)(rw + 512), v);
      unpack(*(const u32x4*)(rw + 5 * 512), k0); unpack(*(const u32x4*)(rw + 6 * 512), k1);
      unpack(*(const u32x4*)(rw + 9 * 512), g);
      float s1 = 0.f, bs = 0.f;
      const float* rk = p->rwkv_rk + j * 512 + c0;
#pragma unroll
      for (int e = 0; e < 8; ++e) { y[e] = yf[e] + yb[e]; s1 += y[e]; bs += r[e] * rk[e] * (k0[e] + k1[e]); }
      s1 += dppx<0xB1>(s1); s1 += dppx<0x4E>(s1); s1 += dppx<0x141>(s1);
      bs += dppx<0xB1>(bs); bs += dppx<0x4E>(bs); bs += dppx<0x141>(bs);
      const float mu = s1 * (1.f / 64.f);
      float s2 = 0.f;
#pragma unroll
      for (int e = 0; e < 8; ++e) { const float d = y[e] - mu; s2 += d * d; }
      s2 += dppx<0xB1>(s2); s2 += dppx<0x4E>(s2); s2 += dppx<0x141>(s2);
      const float rs = rsqrtf(s2 * (1.f / 64.f) + 64e-5f);
      const float* gn0 = p->rwkv_gn + (j * 2 + 0) * 512 + c0;
      const float* gn1 = p->rwkv_gn + (j * 2 + 1) * 512 + c0;
#pragma unroll
      for (int e = 0; e < 8; ++e) o[e] = ((y[e] - mu) * rs * gn0[e] + gn1[e] + bs * v[e]) * g[e];
      u32x4 ov;
      ov.x = pk_bf16(o[0], o[1]); ov.y = pk_bf16(o[2], o[3]); ov.z = pk_bf16(o[4], o[5]); ov.w = pk_bf16(o[6], o[7]);
      *(u32x4*)(mo) = ov;
    }
    {
      float hf[8], hb[8], og[8], hsum[8], o[8];
      unpack(*(const u32x4*)(pt + 1024), hf); unpack(*(const u32x4*)(pt + 1536), hb);
      unpack(*(const u32x4*)(pt + 3584), og);
      float ss = 0.f;
#pragma unroll
      for (int e = 0; e < 8; ++e) { hsum[e] = hf[e] + hb[e]; ss += hsum[e] * hsum[e]; }
      ss += dppx<0xB1>(ss); ss += dppx<0x4E>(ss); ss += dppx<0x141>(ss); ss += dppx<0x140>(ss);
      const float rs = rsqrtf(ss * (1.f / 128.f) + 1e-6f);
      const float* ng = p->mlstm_norm + j * 512 + c0;
#pragma unroll
      for (int e = 0; e < 8; ++e) o[e] = hsum[e] * rs * ng[e] * sigm_f(og[e]);
      u32x4 ov;
      ov.x = pk_bf16(o[0], o[1]); ov.y = pk_bf16(o[2], o[3]); ov.z = pk_bf16(o[4], o[5]); ov.w = pk_bf16(o[6], o[7]);
      *(u32x4*)(mo + 512) = ov;
    }
  }
}

using f32x4v = __attribute__((ext_vector_type(4))) float;
__device__ void ph_ln_router(KP p, int layer, bool keep, char* smc) {
  float* h2s = (float*)smc;
  float* lgs = (float*)smc;
  const int tid = opaque_tid();
  const int lane = tid & 63, wave = tid >> 6;
  const int rows = keep ? NT : NL;
  const float* lng = p->ln_g + (layer * 2 + 0) * 1024;
  const float* lnb = p->ln_b + (layer * 2 + 0) * 1024;
  for (int tile = blockIdx.x; tile < rows / 16; tile += gridDim.x) {
    const int t0 = tile * 16;
    const float* mod = p->MOD + (layer * 9 + modrow(t0)) * 6144;
    {
      float4 v[4][4];
      float s4[4];
#pragma unroll
      for (int q = 0; q < 4; ++q) {
        const int t = t0 + wave * 4 + q;
        s4[q] = 0.f;
#pragma unroll
        for (int i = 0; i < 4; ++i) v[q][i] = *(const float4*)(p->Tb + (size_t)t * DM + i * 256 + lane * 4);
      }
#pragma unroll
      for (int q = 0; q < 4; ++q)
#pragma unroll
        for (int i = 0; i < 4; ++i) s4[q] += (v[q][i].x + v[q][i].y) + (v[q][i].z + v[q][i].w);
      float mean4[4], rs4[4];
#pragma unroll
      for (int q = 0; q < 4; ++q) mean4[q] = wsum(s4[q]) * (1.f / 1024.f);
#pragma unroll
      for (int q = 0; q < 4; ++q) {
        float qq = 0.f;
#pragma unroll
        for (int i = 0; i < 4; ++i) {
          const float d0 = v[q][i].x - mean4[q], d1 = v[q][i].y - mean4[q], d2 = v[q][i].z - mean4[q], d3 = v[q][i].w - mean4[q];
          qq += (d0 * d0 + d1 * d1) + (d2 * d2 + d3 * d3);
        }
        s4[q] = qq;
      }
#pragma unroll
      for (int q = 0; q < 4; ++q) rs4[q] = rsqrtf(wsum(s4[q]) * (1.f / 1024.f) + 1e-5f);
#pragma unroll
      for (int i = 0; i < 4; ++i) {
        const int n = i * 256 + lane * 4;
        const float4 g = *(const float4*)(lng + n), bb = *(const float4*)(lnb + n);
        const float4 sc = *(const float4*)(mod + 4096 + n), sh = *(const float4*)(mod + 3072 + n);
#pragma unroll
        for (int q = 0; q < 4; ++q) {
          const int tl = wave * 4 + q, t = t0 + tl;
          const float mean = mean4[q], rs = rs4[q];
          const float4 xn = make_float4((v[q][i].x - mean) * rs * g.x + bb.x, (v[q][i].y - mean) * rs * g.y + bb.y,
                                        (v[q][i].z - mean) * rs * g.z + bb.z, (v[q][i].w - mean) * rs * g.w + bb.w);
          *(float4*)(p->X + (size_t)t * DM + n) = xn;
          const float4 hh = make_float4(xn.x * (1.f + sc.x) + sh.x, xn.y * (1.f + sc.y) + sh.y,
                                        xn.z * (1.f + sc.z) + sh.z, xn.w * (1.f + sc.w) + sh.w);
          *(unsigned*)((unsigned char*)p->AB + (size_t)t * DM + n) = pk_fp8x4(hh.x, hh.y, hh.z, hh.w);
          *(float4*)(h2s + tl * 1028 + n) = hh;
        }
      }
    }
    __syncthreads();
    f32x4v acc = {0.f, 0.f, 0.f, 0.f};
    {
      f32x4v a1 = {0.f, 0.f, 0.f, 0.f}, a2 = {0.f, 0.f, 0.f, 0.f}, a3 = {0.f, 0.f, 0.f, 0.f};
      const int i = lane & 15, kk = lane >> 4;
      const float* arow = h2s + i * 1028 + 4 * kk;
      const float* brow = p->WrT + ((size_t)layer * 64 + 16 * wave + i) * 1024 + 4 * kk;
#pragma unroll 8
      for (int q = 0; q < 64; ++q) {
        const float4 a = *(const float4*)(arow + 16 * q);
        const float4 b = *(const float4*)(brow + 16 * q);
        acc = __builtin_amdgcn_mfma_f32_16x16x4f32(a.x, b.x, acc, 0, 0, 0);
        a1 = __builtin_amdgcn_mfma_f32_16x16x4f32(a.y, b.y, a1, 0, 0, 0);
        a2 = __builtin_amdgcn_mfma_f32_16x16x4f32(a.z, b.z, a2, 0, 0, 0);
        a3 = __builtin_amdgcn_mfma_f32_16x16x4f32(a.w, b.w, a3, 0, 0, 0);
      }
      acc = (acc + a1) + (a2 + a3);
    }
    __syncthreads();
#pragma unroll
    for (int r = 0; r < 4; ++r) lgs[((lane >> 4) * 4 + r) * 64 + 16 * wave + (lane & 15)] = acc[r];
    __syncthreads();
#pragma unroll 1
    for (int q = 0; q < 4; ++q) {
      const int tl = wave * 4 + q, t = t0 + tl;
      const float logit = lgs[tl * 64 + lane];
      const float score = sigm_f(logit);
      float sel = score + p->moe_bias[layer * 64 + lane];
      bool chosen = false;
      for (int r = 0; r < 6; ++r) {
        const float mx = wmax(sel);
        const unsigned long long bal = __ballot(sel == mx);
        const int first = __ffsll((long long)bal) - 1;
        if (lane == first) { chosen = true; sel = -INFINITY; }
      }
      const float gsum = wsum(chosen ? score : 0.f);
      const unsigned long long cb = __ballot(chosen);
      if (chosen) {
        const int kidx = __popcll(cb & ((1ull << lane) - 1ull));
        const int pos = atomicAdd(&p->cnt[lane * CSTR], 1);
        p->ltok[(size_t)lane * NT + pos] = t;
        p->lgate[(size_t)lane * NT + pos] = score / gsum * 2.5f;
        p->tsl[t * 6 + kidx] = (lane << 16) | pos;
      }
    }
    __syncthreads();
  }
}

__device__ __forceinline__ void moe_prefix(KP p, int rows, int* s_pref, int tid) {
  if (tid < 64) s_pref[322 + tid] = p->cnt[tid * CSTR];
  __syncthreads();
  if (tid == 0) {
    int a = 0;
    for (int e = 0; e < 64; ++e) { s_pref[e] = a; a += (s_pref[322 + e] + 127) >> 7; }
    s_pref[64] = a; a += rows >> 7;
    s_pref[65] = a;
  }
  __syncthreads();
}

__device__ void ph_gemm(KP p, int kind, int layer, bool keep, char* lds) {
  const int tid = opaque_tid();
  const int j = layer >> 1;
  const bool att = !(layer & 1);
  const int rows = keep ? NT : NL;
  int* pref = (int*)(lds + META_OFF);
  int* s_idx = pref + 66;
  float* s_gate = (float*)(s_idx + 128);
  if (kind == 1 && blockIdx.x == 0 && tid < 65) p->cnt[tid * CSTR] = 0;
  int total;
  const int ntn_in = att ? 18 : 33;
  switch (kind) {
    case 0: total = (NT / 128) * ntn_in; break;
    case 1: total = (rows / 128) * 8; break;
    case 2: total = pref[65] * 4; break;
    case 3: total = pref[65] * 8; break;
    case 4: total = (NT / 128) * 3; break;
    default: total = (NT / 128) * 20; break;
  }
  for (int tile = blockIdx.x; tile < total; tile += gridDim.x) {
    const bf16_t* Abase; const bf16_t* Bt;
    int astride, K, n0, m0 = 0, aux = 0, e = 0, mtile = 0;
    switch (kind) {
      case 0: { const int tm = tile / ntn_in, tn = tile % ntn_in; m0 = tm * 128; n0 = tn * 128;
                Abase = p->AB + (size_t)m0 * DM; astride = DM; K = 1024;
                Bt = att ? p->Wt_att + (size_t)j * ATT_N * 1024 : p->Wt_rec + (size_t)j * REC_NP * 1024; } break;
      case 1: { const int tm = tile >> 3, tn = tile & 7; m0 = tm * 128; n0 = tn * 128;
                Abase = p->AB + (size_t)m0 * DM; astride = DM; K = 1024; Bt = p->Wt_out + (size_t)layer * 1024 * 1024; } break;
      case 2: { mtile = tile >> 2; aux = tile & 3; n0 = aux * 128; while (mtile >= pref[e + 1]) ++e;
                Abase = p->AB; astride = DM; K = 1024;
                Bt = (const bf16_t*)((const unsigned char*)p->Wt13 + (size_t)(layer * 65 + e) * 512 * 1024); } break;
      case 3: { mtile = tile >> 3; aux = tile & 7; n0 = aux * 128; while (mtile >= pref[e + 1]) ++e;
                Abase = (const bf16_t*)((const unsigned char*)p->ACT + (size_t)mtile * 128 * 256); astride = 256; K = 256;
                Bt = (const bf16_t*)((const unsigned char*)p->Wt2 + (size_t)(layer * 65 + e) * 1024 * 256); } break;
      case 4: { const int tm = tile / 3; aux = tile % 3; m0 = tm * 128; n0 = 0;
                Abase = p->Zb + (size_t)m0 * 1536 + aux * 512; astride = 1536; K = 512; Bt = p->Wl1 + (size_t)(j * 3 + aux) * 128 * 512; } break;
      default: { const int tm = tile / 20; aux = tile % 20; m0 = tm * 128; n0 = aux * 128;
                const int grp = aux < 8 ? 0 : (aux < 16 ? 1 : 2);
                Abase = p->L1 + (size_t)m0 * 384 + grp * 128; astride = 384; K = 128; Bt = p->Wl2 + (size_t)j * 2560 * 128; } break;
    }
    if (tid < 128) {
      int idx = tid; float g = 1.f;
      if (kind == 2 || kind == 3) {
        const int pos = (mtile - pref[e]) * 128 + tid;
        if (kind == 2) {
          idx = 0;
          if (e < 64) { if (pos < pref[322 + e]) idx = p->ltok[(size_t)e * NT + pos]; }
          else idx = pos;
        } else if (e < 64) g = pos < pref[322 + e] ? p->lgate[(size_t)e * NT + pos] : 0.f;
      }
      s_idx[tid] = idx; s_gate[tid] = g;
    }
    __syncthreads();
    {
      f32x16 acc[2][2];
      if (kind == 2 || kind == 3) {
        const unsigned char* A8 = (const unsigned char*)Abase;
        gemm128_fp8(tid, [&](int r) { return A8 + (size_t)s_idx[r] * astride; }, (const unsigned char*)Bt, K, n0, lds, acc);
      } else
        gemm128_main(tid, [&](int r) { return Abase + (size_t)s_idx[r] * astride; }, Bt, K, n0, lds, acc);
      float* Ct = (float*)lds;
      acc_foreach(tid, acc, [&](int row, int col, float v) { Ct[row * 128 + col] = v; });
    }
    __syncthreads();
    {
      const float* Ct = (const float*)lds;
      int c4 = (tid & 31) * 4, r0 = tid >> 5;
      asm volatile("" : "+v"(c4), "+v"(r0));
      const int N_in = att ? ATT_N : REC_N;
      const int d5 = (aux >> 2) & 1, c05 = (aux & 3) * 128;
      switch (kind) {
        case 0: {
#pragma unroll 8
          for (int it = 0; it < 16; ++it) {
            const int row = it * 8 + r0;
            const float4 v = *(const float4*)(Ct + row * 128 + c4);

            const int cn = n0 + c4;
            float4 vq = v;
            if (att && n0 >= 1536 && n0 < 2176) {
              float ss = v.x * v.x + v.y * v.y + v.z * v.z + v.w * v.w;
              ss += dppx<0xB1>(ss); ss += dppx<0x4E>(ss); ss += dppx<0x141>(ss); ss += dppx<0x140>(ss);
              const float rs = rsqrtf(ss * (1.f / 64.f) + 1e-6f);
              const float4 g = *(const float4*)(p->qk_gain + j * 128 + (n0 >= 2048 ? 64 : 0) + (cn & 63));
              vq = make_float4(v.x * rs * g.x, v.y * rs * g.y, v.z * rs * g.z, v.w * rs * g.w);
              const int t = m0 + row;
              if (t < NL) {
                const int sidx = t & 2047, pi0 = (cn & 63) >> 1;
                const int pos = pi0 < 16 ? (sidx >> 6) : (sidx & 63);
                const float4 cs = *(const float4*)(p->ROPE + (pos * 16 + (pi0 & 15)) * 2);
                vq = make_float4(vq.x * cs.x - vq.y * cs.y, vq.x * cs.y + vq.y * cs.x,
                                 vq.z * cs.z - vq.w * cs.w, vq.z * cs.w + vq.w * cs.z);
              }
            }
            if (cn < N_in) {
              u32x2 o; o.x = pk_bf16(vq.x, vq.y); o.y = pk_bf16(vq.z, vq.w);
              *(u32x2*)(p->P + (size_t)(m0 + row) * LDP + cn) = o;
            }
            if (!att && cn >= 4096 && cn < 4112) *(float4*)(p->GP + (size_t)(m0 + row) * 16 + (cn - 4096)) = v;
          }
        } break;
        case 1: {
#pragma unroll 16
          for (int it = 0; it < 16; ++it) {
            const int row = it * 8 + r0;
            const float4 v = *(const float4*)(Ct + row * 128 + c4);

            const size_t o = (size_t)(m0 + row) * DM + n0 + c4;
            const float4 xv = *(const float4*)(p->X + o);
            const float4 g = *(const float4*)(p->MOD + (layer * 9 + modrow(m0)) * 6144 + 2048 + n0 + c4);
            *(float4*)(p->Tb + o) = make_float4(DN_ALPHA * xv.x + g.x * v.x, DN_ALPHA * xv.y + g.y * v.y,
                                                DN_ALPHA * xv.z + g.z * v.z, DN_ALPHA * xv.w + g.w * v.w);
          }
        } break;
        case 2: {
#pragma unroll 8
          for (int it = 0; it < 16; ++it) {
            const int row = it * 8 + r0;
            const float4 v = *(const float4*)(Ct + row * 128 + c4);

            if (((c4 >> 5) & 1) == 0) {
              const float4 u = *(const float4*)(Ct + row * 128 + c4 + 32);
              const float a0 = v.x * W8_INV, a1 = v.y * W8_INV, a2 = v.z * W8_INV, a3 = v.w * W8_INV;
              *(unsigned*)((unsigned char*)p->ACT + ((size_t)mtile * 128 + row) * 256 + aux * 64 + (c4 >> 6) * 32 + (c4 & 31)) =
                  pk_fp8x4(silu_f(a0) * (u.x * W8_INV), silu_f(a1) * (u.y * W8_INV), silu_f(a2) * (u.z * W8_INV), silu_f(a3) * (u.w * W8_INV));
            }
          }
        } break;
        case 3: {
#pragma unroll 16
          for (int it = 0; it < 16; ++it) {
            const int row = it * 8 + r0;
            const float4 v = *(const float4*)(Ct + row * 128 + c4);

            const float g = s_gate[row] * W8_INV;
            u32x2 o; o.x = pk_bf16(g * v.x, g * v.y); o.y = pk_bf16(g * v.z, g * v.w);
            *(u32x2*)(p->OUT2 + ((size_t)mtile * 128 + row) * 1024 + n0 + c4) = o;
          }
        } break;
        case 4: {
#pragma unroll 4
          for (int it = 0; it < 16; ++it) {
            const int row = it * 8 + r0;
            const float4 v = *(const float4*)(Ct + row * 128 + c4);

            float4 o4 = v;
            if (aux == 0) o4 = make_float4(tanhf(v.x), tanhf(v.y), tanhf(v.z), tanhf(v.w));
            else if (aux == 2) o4 = make_float4(sigm_f(v.x), sigm_f(v.y), sigm_f(v.z), sigm_f(v.w));
            u32x2 o; o.x = pk_bf16(o4.x, o4.y); o.y = pk_bf16(o4.z, o4.w);
            *(u32x2*)(p->L1 + (size_t)(m0 + row) * 384 + aux * 128 + c4) = o;
          }
        } break;
        default: {
#pragma unroll 4
          for (int it = 0; it < 16; ++it) {
            const int row = it * 8 + r0;
            const float4 v = *(const float4*)(Ct + row * 128 + c4);

            bf16_t* rr = p->RW + (size_t)(m0 + row) * RWS + c05 + c4;
            const float vv[4] = {v.x, v.y, v.z, v.w};
            if (aux < 8) {
              const float4 b0 = *(const float4*)(p->rwkv_w0 + (j * 2 + d5) * 512 + c05 + c4);
              const float bb[4] = {b0.x, b0.y, b0.z, b0.w};
              float e4[4];
#pragma unroll
              for (int q = 0; q < 4; ++q) e4[q] = expf(-softplus_f(-(bb[q] + vv[q])) - 0.5f);
              u32x2 o; o.x = pk_bf16(e4[0], e4[1]); o.y = pk_bf16(e4[2], e4[3]);
              *(u32x2*)(rr + (3 + d5) * 512) = o;
            } else if (aux < 16) {
              const float4 b0 = *(const float4*)(p->rwkv_a0 + (j * 2 + d5) * 512 + c05 + c4);
              const float4 k1 = *(const float4*)(p->rwkv_kvec + (j * 2 + 1) * 512 + c05 + c4);
              const u32x2 kx2 = *(const u32x2*)(rr + 10 * 512);
              const float bb[4] = {b0.x, b0.y, b0.z, b0.w}, kk1[4] = {k1.x, k1.y, k1.z, k1.w};
              const float kx[4] = {bflo(kx2.x), bfhi(kx2.x), bflo(kx2.y), bfhi(kx2.y)};
              float av[4], ke[4];
#pragma unroll
              for (int q = 0; q < 4; ++q) { av[q] = sigm_f(bb[q] + vv[q]); ke[q] = kx[q] * (1.f + (av[q] - 1.f) * kk1[q]); }
              u32x2 o; o.x = pk_bf16(av[0], av[1]); o.y = pk_bf16(av[2], av[3]);
              *(u32x2*)(rr + (7 + d5) * 512) = o;
              o.x = pk_bf16(ke[0], ke[1]); o.y = pk_bf16(ke[2], ke[3]);
              *(u32x2*)(rr + (5 + d5) * 512) = o;
            } else {
              u32x2 o; o.x = pk_bf16(v.x, v.y); o.y = pk_bf16(v.z, v.w);
              *(u32x2*)(rr + 9 * 512) = o;
            }
          }
        } break;
      }
    }
    __syncthreads();
  }
}

__device__ void ph_final_ln(KP p, int layer, bool keep, char* lds) {
  const int tid = opaque_tid();
  const int lane = tid & 63, wave = tid >> 6;
  const int rows = keep ? NT : NL;
  int* s_base = (int*)(lds + META_OFF);
  if (tid == 0) {
    int a = 0;
#pragma unroll 1
    for (int e = 0; e < 64; ++e) { s_base[e] = a * 128; a += (p->cnt[e * CSTR] + 127) >> 7; }
    s_base[64] = a * 128;
  }
  __syncthreads();
  const float* lng = p->ln_g + (layer * 2 + 1) * 1024;
  const float* lnb = p->ln_b + (layer * 2 + 1) * 1024;
  for (int t = blockIdx.x * 4 + wave; t < rows; t += gridDim.x * 4) {
    const int mr = modrow(t);
    const float* g2 = p->MOD + (layer * 9 + mr) * 6144 + 5120;
    const bf16_t* src[7];
#pragma unroll
    for (int k = 0; k < 6; ++k) {
      const int v = p->tsl[t * 6 + k];
      src[k] = p->OUT2 + (size_t)(s_base[v >> 16] + (v & 0xffff)) * 1024;
    }
    src[6] = p->OUT2 + (size_t)(s_base[64] + t) * 1024;
    float v[16];
    float s = 0.f;
#pragma unroll
    for (int c = 0; c < 2; ++c) {
      const int n0 = c * 512 + lane * 8;
      float y[8];
#pragma unroll
      for (int q = 0; q < 8; ++q) y[q] = 0.f;
#pragma unroll
      for (int k = 0; k < 7; ++k) {
        const u32x4 u = *(const u32x4*)(src[k] + n0);
        y[0] += bflo(u.x); y[1] += bfhi(u.x); y[2] += bflo(u.y); y[3] += bfhi(u.y);
        y[4] += bflo(u.z); y[5] += bfhi(u.z); y[6] += bflo(u.w); y[7] += bfhi(u.w);
      }
      const float4 xa = *(const float4*)(p->X + (size_t)t * DM + n0), xb = *(const float4*)(p->X + (size_t)t * DM + n0 + 4);
      const float4 ga = *(const float4*)(g2 + n0), gb = *(const float4*)(g2 + n0 + 4);
      const float xx[8] = {xa.x, xa.y, xa.z, xa.w, xb.x, xb.y, xb.z, xb.w};
      const float gg[8] = {ga.x, ga.y, ga.z, ga.w, gb.x, gb.y, gb.z, gb.w};
#pragma unroll
      for (int q = 0; q < 8; ++q) { v[c * 8 + q] = DN_ALPHA * xx[q] + gg[q] * y[q]; s += v[c * 8 + q]; }
    }
    const float mean = wsum(s) * (1.f / 1024.f);
    float q2 = 0.f;
#pragma unroll
    for (int i = 0; i < 16; ++i) { const float d = v[i] - mean; q2 += d * d; }
    const float rs = rsqrtf(wsum(q2) * (1.f / 1024.f) + 1e-5f);
    const float* modn = p->MOD + ((layer + 1) * 9 + mr) * 6144;
#pragma unroll
    for (int c = 0; c < 2; ++c) {
      const int n0 = c * 512 + lane * 8;
      float xn[8];
#pragma unroll
      for (int q = 0; q < 8; ++q) xn[q] = (v[c * 8 + q] - mean) * rs * lng[n0 + q] + lnb[n0 + q];
      *(float4*)(p->X + (size_t)t * DM + n0) = make_float4(xn[0], xn[1], xn[2], xn[3]);
      *(float4*)(p->X + (size_t)t * DM + n0 + 4) = make_float4(xn[4], xn[5], xn[6], xn[7]);
      if (layer == 3) {
        *(float4*)(p->out + (size_t)t * DM + n0) = make_float4(xn[0], xn[1], xn[2], xn[3]);
        *(float4*)(p->out + (size_t)t * DM + n0 + 4) = make_float4(xn[4], xn[5], xn[6], xn[7]);
      } else {
        float hb[8];
#pragma unroll
        for (int q = 0; q < 8; ++q) hb[q] = xn[q] * (1.f + modn[1024 + n0 + q]) + modn[n0 + q];
        u32x4 o;
        o.x = pk_bf16(hb[0], hb[1]); o.y = pk_bf16(hb[2], hb[3]); o.z = pk_bf16(hb[4], hb[5]); o.w = pk_bf16(hb[6], hb[7]);
        *(u32x4*)(p->AB + (size_t)t * DM + n0) = o;
      }
    }
  }
}

#define XB_TMO      128
#define XB_XCNT(j)  (256  + 64 * (j))
#define XB_XSUB(j)  (1280 + 64 * (j))
#define XB_XGEN(j)  (2304 + 64 * (j))
#define XB_TOP      3328
#define XB_TOPGEN   3392
#define XB_SPIN_CAP (1u << 20)
#define LAS __attribute__((address_space(3)))
__device__ __forceinline__ unsigned xb_ld(unsigned* p) { return __hip_atomic_load(p, __ATOMIC_RELAXED, __HIP_MEMORY_SCOPE_AGENT); }
__device__ __forceinline__ unsigned xb_add(unsigned* p, unsigned v) { return __hip_atomic_fetch_add(p, v, __ATOMIC_RELAXED, __HIP_MEMORY_SCOPE_AGENT); }
__device__ __forceinline__ unsigned xb_xcc_id() { return (unsigned)__builtin_amdgcn_s_getreg((3 << 11) | 20) & 0xFu; }
#define XB_SPIN(cond, bar) do { unsigned _sp = 0; while (cond) { __builtin_amdgcn_s_sleep(1); \
    if ((++_sp & 255u) == 0u) { if (xb_ld(&(bar)[XB_TMO])) break; if (_sp > XB_SPIN_CAP) { atomicAdd(&(bar)[XB_TMO], 1u); break; } } } } while (0)
struct XcdBarrier { unsigned* bar; unsigned x; volatile LAS unsigned* st; };
__device__ __forceinline__ XcdBarrier xcd_barrier_post(unsigned* bar, volatile LAS unsigned* st) {
  XcdBarrier b; b.bar = bar; b.x = xb_xcc_id(); b.st = st;
  if (threadIdx.x == 0) (void)xb_add(&bar[XB_XCNT(b.x)], 1u);
  return b;
}
__device__ __forceinline__ void xcd_barrier_complete(unsigned* bar, unsigned x, unsigned& nloc, unsigned& nx) {
  const unsigned G = gridDim.x;
  unsigned sum, cnt, mine, sp = 0u;
  for (;;) {
    sum = 0u; cnt = 0u; mine = 0u;
#pragma unroll
    for (unsigned j = 0; j < 16; ++j) { const unsigned c = xb_ld(&bar[XB_XCNT(j)]); sum += c; cnt += (c > 0u) ? 1u : 0u; mine = (j == x) ? c : mine; }
    if (sum == G) break;
    __builtin_amdgcn_s_sleep(1);
    if ((++sp & 255u) == 0u) { if (xb_ld(&bar[XB_TMO])) break; if (sp > XB_SPIN_CAP) { atomicAdd(&bar[XB_TMO], 1u); break; } }
  }
  nloc = mine > 0u ? mine : 1u; nx = cnt > 0u ? cnt : 1u;
}
__device__ __forceinline__ void xcd_barrier(const XcdBarrier& b) {
  asm volatile("s_waitcnt vmcnt(0)" ::: "memory");
  __syncthreads();
  if (threadIdx.x == 0) {
    unsigned* bar = b.bar;
    __builtin_amdgcn_s_waitcnt(0);
    unsigned nloc = b.st[0], nx = b.st[1];
    if (nloc == 0u) { xcd_barrier_complete(bar, b.x, nloc, nx); b.st[0] = nloc; b.st[1] = nx; }
    const unsigned old = xb_add(&bar[XB_XSUB(b.x)], 1u);
    const unsigned gen = old / nloc;
    if (old + 1u == (gen + 1u) * nloc) {
      __builtin_amdgcn_fence(__ATOMIC_RELEASE, "agent");
      asm volatile("s_waitcnt vmcnt(0)" ::: "memory");
      const unsigned og = xb_add(&bar[XB_TOP], 1u);
      const unsigned tg = og / nx;
      if (og + 1u == (tg + 1u) * nx) xb_add(&bar[XB_TOPGEN], 1u);
      else XB_SPIN(xb_ld(&bar[XB_TOPGEN]) == tg, bar);
      __builtin_amdgcn_fence(__ATOMIC_ACQUIRE, "agent");
      xb_add(&bar[XB_XGEN(b.x)], 1u);
      asm volatile("s_waitcnt vmcnt(0)" ::: "memory");
    } else {
      XB_SPIN(xb_ld(&bar[XB_XGEN(b.x)]) == gen, bar);
      __builtin_amdgcn_fence(__ATOMIC_ACQUIRE, "agent");
      asm volatile("s_waitcnt vmcnt(0)" ::: "memory");
    }
  }
  __syncthreads();
}

constexpr int NSLOTS = 13;
constexpr int NPHASE = 2 + 4 * NSLOTS;
__device__ __forceinline__ bool phase_is_nop(int ph) {
  if (ph < 2) return false;
  const int layer = (ph - 2) / NSLOTS, st = (ph - 2) % NSLOTS;
  if (st == 5 || st == 6) return true;
  return !(layer & 1) && (st == 1 || (st >= 3 && st <= 7));
}
__device__ void run_phase(KP p, int ph, char* sm) {
  if (ph == 0) { ph_init(p, sm); return; }
  if (ph == 1) { ph_mod_h(p, sm); return; }
  const int layer = (ph - 2) / NSLOTS, st = (ph - 2) % NSLOTS;
  const bool odd = layer & 1;
  const bool keep = layer < 3;
  int gk = -1;
  if (st == 0) gk = 0;
  else if (st == 8) gk = 1;
  else if (st == 10) gk = 2;
  else if (st == 11) gk = 3;
  else if (odd && st == 2) gk = 4;
  else if (odd && st == 3) gk = 5;
  asm volatile("" : "+s"(gk));
  if (gk >= 0) {
    if (gk == 2 || gk == 3) moe_prefix(p, keep ? NT : NL, (int*)(sm + META_OFF), opaque_tid());
    ph_gemm(p, gk, layer, keep, sm);
    if (gk == 5) { __syncthreads(); ph_mlstm_s2(p, sm); }
    return;
  }
  switch (st) {
    case 1: if (odd) { ph_rwkv_mix(p, layer); ph_mlstm_s1(p, layer, sm); } break;
    case 2: ph_attention(p, layer, keep, sm); break;
    case 4: if (odd) ph_scan_a(p, layer, sm); break;
    case 7: if (odd) ph_rec_final(p, layer, keep); break;
    case 9: ph_ln_router(p, layer, keep, sm); break;
    case 12: ph_final_ln(p, layer, keep, sm); break;
  }
}

__global__ void __launch_bounds__(NTHR, 2) mega_kernel(Params kargs) {
  extern __shared__ __attribute__((aligned(16))) char sm[];
  cg::grid_group grid = cg::this_grid();
  volatile LAS unsigned* st = (volatile LAS unsigned*)(sm + META_OFF + 4032);
  if (threadIdx.x == 0) { st[0] = 0u; st[1] = 0u; }
  __syncthreads();
  const XcdBarrier xb = xcd_barrier_post(kargs.bar, st);
  for (int ph = kargs.ph_lo; ph < kargs.ph_hi; ++ph) {
    if (phase_is_nop(ph)) continue;
    {
      KP kp = (KP)__builtin_amdgcn_kernarg_segment_ptr();
      asm volatile("" : "+s"(kp));
      run_phase(kp, ph, sm);
    }
    if (ph + 1 < kargs.ph_hi) {
      if (ph == 0) grid.sync();
      else xcd_barrier(xb);
    }
  }
}

extern "C" void kernel_launch(void* const* d_in, const int* in_sizes, int n_in, void* d_out, int out_size, void* d_ws,
                              size_t ws_size, hipStream_t stream) {
  static int grid_blocks = 0;
  if (!grid_blocks) {
    int dev = 0, cus = 0, per_cu = 0;
    (void)hipGetDevice(&dev);
    (void)hipDeviceGetAttribute(&cus, hipDeviceAttributeMultiprocessorCount, dev);
    (void)hipFuncSetAttribute((const void*)mega_kernel, hipFuncAttributeMaxDynamicSharedMemorySize, SMEM_BYTES);
    (void)hipOccupancyMaxActiveBlocksPerMultiprocessor(&per_cu, mega_kernel, NTHR, SMEM_BYTES);
    if (per_cu < 1) per_cu = 1;
    if (per_cu > 2) per_cu = 2;
    grid_blocks = cus * per_cu;
  }
  Params p;
  memset(&p, 0, sizeof(p));
  const float** pin = (const float**)&p;
  for (int i = 0; i < 35; ++i) pin[i] = (const float*)d_in[i];
  p.out = (float*)d_out;
  char* w = (char*)d_ws;
  size_t off = 0;
  auto take = [&](size_t bytes) { char* r = w + off; off += (bytes + 255) & ~(size_t)255; return r; };
  p.Wt_att = (bf16_t*)take((size_t)2 * ATT_N * 1024 * 2);
  p.Wt_rec = (bf16_t*)take((size_t)2 * REC_NP * 1024 * 2);
  p.Wt_out = (bf16_t*)take((size_t)4 * 1024 * 1024 * 2);
  p.Wt13 = (bf16_t*)take((size_t)4 * 65 * 512 * 1024);
  p.Wt2 = (bf16_t*)take((size_t)4 * 65 * 1024 * 256);
  p.Wl1 = (bf16_t*)take((size_t)2 * 3 * 128 * 512 * 2);
  p.Wl2 = (bf16_t*)take((size_t)2 * 2560 * 128 * 2);
  p.X = (float*)take((size_t)NT * DM * 4);
  p.AB = (bf16_t*)take((size_t)NT * DM * 2);
  p.MOD = (float*)take((size_t)5 * 9 * 6144 * 4);
  p.MODP = (float*)take((size_t)8 * 4 * 9 * 6144 * 4);
  p.GP = (float*)take((size_t)NT * 16 * 4);
  p.ROPE = (float*)take((size_t)64 * 16 * 2 * 4);
  p.WrT = (float*)take((size_t)4 * 64 * 1024 * 4);
  p.msc = (float*)take((size_t)3 * NMT * 4);
  p.lgate = (float*)take((size_t)64 * NT * 4);
  p.ltok = (int*)take((size_t)64 * NT * 4);
  p.tsl = (int*)take((size_t)NT * 6 * 4);
  p.cnt = (int*)take((size_t)65 * CSTR * 4);
  p.bar = (unsigned*)take((size_t)BAR_TOTAL_WORDS * 4);
  char* region = take(0);
  const size_t szP = (size_t)NT * LDP * 2, szRW = (size_t)NT * RWS * 2, szMS = (size_t)NMT * 16384 * 2,
               szMSn = (size_t)NMT * 128 * 4;
  const size_t szT = (size_t)NT * DM * 4, szOUT2 = (size_t)NSLOT * 1024 * 2;
  p.P = (bf16_t*)region;
  p.RW = (bf16_t*)(region + szP);
  p.MS = (bf16_t*)(region + szP + szRW);
  p.MSn = (float*)(region + szP + szRW + szMS);
  p.Tb = (float*)region;
  p.ACT = (bf16_t*)region;
  p.OUT2 = (bf16_t*)(region + szT);
  const size_t szZ = (size_t)NT * 2048 * 2;
  p.Zb = (bf16_t*)(region + szP + szRW + szMS + szMSn);
  p.L1 = p.Zb + (size_t)NT * 1536;
  size_t mixer = szP + szRW + szMS + szMSn + szZ, moe = szT + szOUT2;
  off += (mixer > moe ? mixer : moe);
  if (off > ws_size) { fprintf(stderr, "workspace too small: need %zu have %zu\n", off, ws_size); return; }
  p.ph_lo = 0;
  p.ph_hi = NPHASE;
  (void)hipMemsetAsync(p.bar, 0, (size_t)BAR_TOTAL_WORDS * 4, stream);
  void* args[] = {&p};
  hipError_t e = hipLaunchCooperativeKernel((void*)mega_kernel, dim3(grid_blocks), dim3(NTHR), args, SMEM_BYTES, stream);
  if (e != hipSuccess) fprintf(stderr, "cooperative launch failed: %s (grid %d)\n", hipGetErrorString(e), grid_blocks);
}
```

```cpp
#include <hip/hip_runtime.h>
#include <hip/hip_cooperative_groups.h>
#include <cstdio>
#include <cstring>
namespace cg = cooperative_groups;

constexpr int DM = 1024;
constexpr int NBATCH = 8;
constexpr int SEQ = 2048;
constexpr int CTXL = 256;
constexpr int NL = NBATCH * SEQ;
constexpr int NC = NBATCH * CTXL;
constexpr int NT = NL + NC;
constexpr int TSC = CTXL + SEQ;
constexpr int LDP = 4112;
constexpr int ATT_N = 2304;
constexpr int REC_N = 4112;
constexpr int REC_NP = 4224;
constexpr int NCHUNK = 36;
constexpr int NMT = 64 * NCHUNK;
constexpr int RWS = 5632;
constexpr int NSLOT = 137216;
constexpr float DN_ALPHA = 1.6817928305074290f;
constexpr int NTHR = 256;
constexpr int SMEM_BYTES = 65536 + 4096;
constexpr int META_OFF = 65536;
#define XCD_BAR_WORDS 3456
constexpr int CSTR = 32;
constexpr int BAR_TOTAL_WORDS = XCD_BAR_WORDS + 64;

typedef unsigned short bf16_t;
using bf16x8 = __attribute__((ext_vector_type(8))) short;
using f32x16 = __attribute__((ext_vector_type(16))) float;
using u32x4 = __attribute__((ext_vector_type(4))) unsigned;
using u32x2 = __attribute__((ext_vector_type(2))) unsigned;

struct Params {
  const float *x, *c, *ctx, *c_ctx, *ada_w, *ada_b, *ln_g, *ln_b, *mix_w_out, *att_w_in, *na_rpb, *qk_gain,
      *rec_w_in, *rwkv_mu, *rwkv_w0, *rwkv_w1, *rwkv_w2, *rwkv_a0, *rwkv_a1, *rwkv_a2, *rwkv_g1, *rwkv_g2,
      *rwkv_kvec, *rwkv_rk, *rwkv_gn, *mlstm_gate_b, *mlstm_norm, *moe_router, *moe_bias, *moe_w1, *moe_w3,
      *moe_w2, *shared_w1, *shared_w3, *shared_w2;
  float* out;
  bf16_t *Wt_att, *Wt_rec, *Wt_out, *Wt13, *Wt2, *Wl1, *Wl2;
  bf16_t *Zb, *L1;
  float *X, *MOD, *MODP, *GP, *msc, *lgate, *MSn, *Tb, *ROPE, *WrT;
  bf16_t *AB, *P, *RW, *MS, *ACT, *OUT2;
  int *cnt, *ltok, *tsl;
  unsigned* bar;
  int ph_lo, ph_hi;
};

typedef const Params __attribute__((address_space(4))) * KP;

__device__ __forceinline__ int modrow(int t) { return t < NL ? (t >> 11) : 8; }
__device__ __forceinline__ float silu_f(float x) { return x / (1.f + expf(-x)); }
__device__ __forceinline__ float sigm_f(float x) { return 1.f / (1.f + expf(-x)); }
__device__ __forceinline__ float softplus_f(float x) { return fmaxf(x, 0.f) + log1pf(expf(-fabsf(x))); }
template <int CTRL>
__device__ __forceinline__ float dppx(float x) {
  return __int_as_float(__builtin_amdgcn_update_dpp(0, __float_as_int(x), CTRL, 0xf, 0xf, true));
}
__device__ __forceinline__ float rdlane(float v, int l) {
  return __int_as_float(__builtin_amdgcn_readlane(__float_as_int(v), l));
}
__device__ __forceinline__ float wsum(float v) {
  v += dppx<0xB1>(v); v += dppx<0x4E>(v); v += dppx<0x141>(v); v += dppx<0x140>(v);
  return (rdlane(v, 0) + rdlane(v, 16)) + (rdlane(v, 32) + rdlane(v, 48));
}
__device__ __forceinline__ float wmax(float v) {
  v = fmaxf(v, dppx<0xB1>(v)); v = fmaxf(v, dppx<0x4E>(v)); v = fmaxf(v, dppx<0x141>(v)); v = fmaxf(v, dppx<0x140>(v));
  return fmaxf(fmaxf(rdlane(v, 0), rdlane(v, 16)), fmaxf(rdlane(v, 32), rdlane(v, 48)));
}
__device__ __forceinline__ int opaque_tid() {
  int t = threadIdx.x;
  asm volatile("" : "+v"(t));
  return t;
}
typedef __bf16 bf16x2_t __attribute__((ext_vector_type(2)));
typedef float f32x2_t __attribute__((ext_vector_type(2)));
__device__ __forceinline__ unsigned pk_bf16(float lo, float hi) {
  const f32x2_t v = {lo, hi};
  return __builtin_bit_cast(unsigned, __builtin_convertvector(v, bf16x2_t));
}
__device__ __forceinline__ bf16_t f2bf(float x) { return (bf16_t)(pk_bf16(x, 0.f) & 0xffffu); }
__device__ __forceinline__ float bf2f(bf16_t v) { return __uint_as_float((unsigned)v << 16); }
__device__ __forceinline__ float bflo(unsigned u) { return __uint_as_float(u << 16); }
__device__ __forceinline__ float bfhi(unsigned u) { return __uint_as_float(u & 0xffff0000u); }
__device__ __forceinline__ int scan_row(int dir, int b, int tau) {
  if (tau < CTXL) return NL + b * CTXL + (dir ? (CTXL - 1 - tau) : tau);
  int s = tau - CTXL;
  return b * SEQ + (dir ? (SEQ - 1 - s) : s);
}

template <class RowPtrA>
__device__ __forceinline__ void gemm128_main(int tid, RowPtrA rowA, const bf16_t* __restrict__ Bt, int K, int n0,
                                             char* lds, f32x16 (&acc)[2][2]) {
  const int lane = tid & 63, w = tid >> 6;
  const int wm = w >> 1, wn = w & 1, r = lane & 31, h = lane >> 5;
  const int c = tid & 7, sr = tid >> 3;
  const int lc = (c ^ ((tid >> 4) & 7)) * 8;
  const bf16_t* ap[4];
#pragma unroll
  for (int i = 0; i < 4; ++i) ap[i] = rowA(sr + 32 * i) + lc;
  const bf16_t* bp0 = Bt + (size_t)(n0 + sr) * K + lc;
  const int bstr = 32 * K;
#pragma unroll
  for (int mi = 0; mi < 2; ++mi)
#pragma unroll
    for (int ni = 0; ni < 2; ++ni)
#pragma unroll
      for (int q = 0; q < 16; ++q) acc[mi][ni][q] = 0.f;
  const int nk = K >> 6;
  auto issue = [&](int kt) {
    char* As = lds + (kt & 1) * 32768 + tid * 16;
    const int k0 = kt * 64;
#pragma unroll
    for (int i = 0; i < 4; ++i) {
      __builtin_amdgcn_global_load_lds((const unsigned*)(ap[i] + k0), (__attribute__((address_space(3))) unsigned*)(As + i * 4096), 16, 0, 0);
      __builtin_amdgcn_global_load_lds((const unsigned*)(bp0 + i * bstr + k0), (__attribute__((address_space(3))) unsigned*)(As + 16384 + i * 4096), 16, 0, 0);
    }
  };
  issue(0);
  const int sw = (r >> 1) & 7;
#pragma unroll 1
  for (int kt = 0; kt < nk; ++kt) {
    asm volatile("s_waitcnt vmcnt(0)" ::: "memory");
    __syncthreads();
    if (kt + 1 < nk) issue(kt + 1);
    const char* As = lds + (kt & 1) * 32768;
    const char* Ar = As + (wm * 64 + r) * 128;
    const char* Br = As + 16384 + (wn * 64 + r) * 128;
#pragma unroll
    for (int ks = 0; ks < 4; ++ks) {
      const int off = ((ks * 2 + h) ^ sw) * 16;
      const bf16x8 a0 = *(const bf16x8*)(Ar + off);
      const bf16x8 a1 = *(const bf16x8*)(Ar + 32 * 128 + off);
      const bf16x8 b0 = *(const bf16x8*)(Br + off);
      const bf16x8 b1 = *(const bf16x8*)(Br + 32 * 128 + off);
      acc[0][0] = __builtin_amdgcn_mfma_f32_32x32x16_bf16(a0, b0, acc[0][0], 0, 0, 0);
      acc[0][1] = __builtin_amdgcn_mfma_f32_32x32x16_bf16(a0, b1, acc[0][1], 0, 0, 0);
      acc[1][0] = __builtin_amdgcn_mfma_f32_32x32x16_bf16(a1, b0, acc[1][0], 0, 0, 0);
      acc[1][1] = __builtin_amdgcn_mfma_f32_32x32x16_bf16(a1, b1, acc[1][1], 0, 0, 0);
    }
  }
  __syncthreads();
}
using i64 = long;
template <class RowPtrA8>
__device__ __forceinline__ void gemm128_fp8(int tid, RowPtrA8 rowA, const unsigned char* __restrict__ Bt, int K, int n0,
                                            char* lds, f32x16 (&acc)[2][2]) {
  const int lane = tid & 63, w = tid >> 6;
  const int wm = w >> 1, wn = w & 1, r = lane & 31, h = lane >> 5;
  const int c = tid & 7, sr = tid >> 3;
  const int lc = (c ^ ((tid >> 4) & 7)) * 16;
  const unsigned char* ap[4];
#pragma unroll
  for (int i = 0; i < 4; ++i) ap[i] = rowA(sr + 32 * i) + lc;
  const unsigned char* bp0 = Bt + (size_t)(n0 + sr) * K + lc;
  const int bstr = 32 * K;
#pragma unroll
  for (int mi = 0; mi < 2; ++mi)
#pragma unroll
    for (int ni = 0; ni < 2; ++ni)
#pragma unroll
      for (int q = 0; q < 16; ++q) acc[mi][ni][q] = 0.f;
  const int nk = K >> 7;
  auto issue = [&](int kt) {
    char* As = lds + (kt & 1) * 32768 + tid * 16;
    const int k0 = kt * 128;
#pragma unroll
    for (int i = 0; i < 4; ++i) {
      __builtin_amdgcn_global_load_lds((const unsigned*)(ap[i] + k0), (__attribute__((address_space(3))) unsigned*)(As + i * 4096), 16, 0, 0);
      __builtin_amdgcn_global_load_lds((const unsigned*)(bp0 + i * bstr + k0), (__attribute__((address_space(3))) unsigned*)(As + 16384 + i * 4096), 16, 0, 0);
    }
  };
  issue(0);
  const int sw = (r >> 1) & 7;
#pragma unroll 1
  for (int kt = 0; kt < nk; ++kt) {
    asm volatile("s_waitcnt vmcnt(0)" ::: "memory");
    __syncthreads();
    if (kt + 1 < nk) issue(kt + 1);
    const char* As = lds + (kt & 1) * 32768;
    const char* Ar = As + (wm * 64 + r) * 128;
    const char* Br = As + 16384 + (wn * 64 + r) * 128;
#pragma unroll
    for (int q = 0; q < 4; ++q) {
      const int off = ((q * 2 + h) ^ sw) * 16;
      const u32x4 a0 = *(const u32x4*)(Ar + off);
      const u32x4 a1 = *(const u32x4*)(Ar + 32 * 128 + off);
      const u32x4 b0 = *(const u32x4*)(Br + off);
      const u32x4 b1 = *(const u32x4*)(Br + 32 * 128 + off);
      const i64 a0l = (i64)(((unsigned long long)a0.y << 32) | a0.x), a0h = (i64)(((unsigned long long)a0.w << 32) | a0.z);
      const i64 a1l = (i64)(((unsigned long long)a1.y << 32) | a1.x), a1h = (i64)(((unsigned long long)a1.w << 32) | a1.z);
      const i64 b0l = (i64)(((unsigned long long)b0.y << 32) | b0.x), b0h = (i64)(((unsigned long long)b0.w << 32) | b0.z);
      const i64 b1l = (i64)(((unsigned long long)b1.y << 32) | b1.x), b1h = (i64)(((unsigned long long)b1.w << 32) | b1.z);
      acc[0][0] = __builtin_amdgcn_mfma_f32_32x32x16_fp8_fp8(a0l, b0l, acc[0][0], 0, 0, 0);
      acc[0][1] = __builtin_amdgcn_mfma_f32_32x32x16_fp8_fp8(a0l, b1l, acc[0][1], 0, 0, 0);
      acc[1][0] = __builtin_amdgcn_mfma_f32_32x32x16_fp8_fp8(a1l, b0l, acc[1][0], 0, 0, 0);
      acc[1][1] = __builtin_amdgcn_mfma_f32_32x32x16_fp8_fp8(a1l, b1l, acc[1][1], 0, 0, 0);
      acc[0][0] = __builtin_amdgcn_mfma_f32_32x32x16_fp8_fp8(a0h, b0h, acc[0][0], 0, 0, 0);
      acc[0][1] = __builtin_amdgcn_mfma_f32_32x32x16_fp8_fp8(a0h, b1h, acc[0][1], 0, 0, 0);
      acc[1][0] = __builtin_amdgcn_mfma_f32_32x32x16_fp8_fp8(a1h, b0h, acc[1][0], 0, 0, 0);
      acc[1][1] = __builtin_amdgcn_mfma_f32_32x32x16_fp8_fp8(a1h, b1h, acc[1][1], 0, 0, 0);
    }
  }
  __syncthreads();
}
template <class F>
__device__ __forceinline__ void acc_foreach(int tid, const f32x16 (&acc)[2][2], F f) {
  const int lane = tid & 63, w = tid >> 6;
  const int wm = w >> 1, wn = w & 1, r = lane & 31, h = lane >> 5;
#pragma unroll
  for (int mi = 0; mi < 2; ++mi)
#pragma unroll
    for (int ni = 0; ni < 2; ++ni)
#pragma unroll
      for (int q = 0; q < 16; ++q) {
        const int row = wm * 64 + mi * 32 + (q & 3) + 8 * (q >> 2) + 4 * h;
        const int col = wn * 64 + ni * 32 + r;
        f(row, col, acc[mi][ni][q]);
        if ((q & 3) == 3) __builtin_amdgcn_sched_barrier(0);
      }
}

template <class RM>
__device__ __forceinline__ void tr_tile(int tid, const float* __restrict__ src, int N, int k0, int n0,
                                        bf16_t* __restrict__ dst, int K, RM rowmap, float* tile) {
  {
    const int tx = tid & 15, ty = tid >> 4;
    const int n = n0 + tx * 4;
#pragma unroll
    for (int i = 0; i < 4; ++i) {
      const int k = ty + 16 * i;
      float4 v = make_float4(0.f, 0.f, 0.f, 0.f);
      if (n < N) v = *(const float4*)(src + (size_t)(k0 + k) * N + n);
      tile[k * 65 + tx * 4 + 0] = v.x; tile[k * 65 + tx * 4 + 1] = v.y;
      tile[k * 65 + tx * 4 + 2] = v.z; tile[k * 65 + tx * 4 + 3] = v.w;
    }
  }
  __syncthreads();
  {
    const int kc = tid & 7;
#pragma unroll
    for (int i = 0; i < 2; ++i) {
      const int n = (tid >> 3) + 32 * i;
      if (n0 + n < N) {
        float v[8];
#pragma unroll
        for (int q = 0; q < 8; ++q) v[q] = tile[(kc * 8 + q) * 65 + n];
        u32x4 o;
        o.x = pk_bf16(v[0], v[1]); o.y = pk_bf16(v[2], v[3]); o.z = pk_bf16(v[4], v[5]); o.w = pk_bf16(v[6], v[7]);
        *(u32x4*)(dst + (size_t)rowmap(n0 + n) * K + k0 + kc * 8) = o;
      }
    }
  }
  __syncthreads();
}

constexpr float W8_SCALE = 32.f, W8_INV = 1.f / 32.f;
__device__ __forceinline__ unsigned pk_fp8x4(float a, float b, float c, float d) {
  int r = __builtin_amdgcn_cvt_pk_fp8_f32(a, b, 0, false);
  r = __builtin_amdgcn_cvt_pk_fp8_f32(c, d, r, true);
  return (unsigned)r;
}
template <class RM>
__device__ __forceinline__ void tr_tile_fp8(int tid, const float* __restrict__ src, int N, int k0, int n0,
                                            unsigned char* __restrict__ dst, int K, RM rowmap, float* tile) {
  {
    const int tx = tid & 15, ty = tid >> 4;
    const int n = n0 + tx * 4;
#pragma unroll
    for (int i = 0; i < 4; ++i) {
      const int k = ty + 16 * i;
      const float4 v = *(const float4*)(src + (size_t)(k0 + k) * N + n);
      tile[k * 65 + tx * 4 + 0] = v.x; tile[k * 65 + tx * 4 + 1] = v.y;
      tile[k * 65 + tx * 4 + 2] = v.z; tile[k * 65 + tx * 4 + 3] = v.w;
    }
  }
  __syncthreads();
  {
    const int kc = tid & 3, n = tid >> 2;
    float v[16];
#pragma unroll
    for (int q = 0; q < 16; ++q) v[q] = tile[(kc * 16 + q) * 65 + n] * W8_SCALE;
    u32x4 o;
    o.x = pk_fp8x4(v[0], v[1], v[2], v[3]); o.y = pk_fp8x4(v[4], v[5], v[6], v[7]);
    o.z = pk_fp8x4(v[8], v[9], v[10], v[11]); o.w = pk_fp8x4(v[12], v[13], v[14], v[15]);
    *(u32x4*)(dst + (size_t)rowmap(n0 + n) * K + k0 + kc * 16) = o;
  }
  __syncthreads();
}

constexpr int CJ0 = 1152, CJ1 = CJ0 + 2080, CJ2 = CJ1 + 1024, CJ3 = CJ2 + 33280, CJ4 = CJ3 + 16640;
__device__ void convert_job(KP p, int job, float* sm, int tid) {
  if (job < CJ0) {
    const int j = job / 576, rem = job % 576, kt = rem / 36, nt = rem % 36;
    tr_tile(tid, p->att_w_in + (size_t)j * 1024 * ATT_N, ATT_N, kt * 64, nt * 64, p->Wt_att + (size_t)j * ATT_N * 1024,
            1024, [](int n) { return n; }, sm);
  } else if (job < CJ1) {
    const int q = job - CJ0;
    const int j = q / 1040, rem = q % 1040, kt = rem / 65, nt = rem % 65;
    tr_tile(tid, p->rec_w_in + (size_t)j * 1024 * REC_N, REC_N, kt * 64, nt * 64, p->Wt_rec + (size_t)j * REC_NP * 1024,
            1024, [](int n) { return n; }, sm);
  } else if (job < CJ2) {
    const int q = job - CJ1;
    const int i = q >> 8, rem = q & 255, kt = rem >> 4, nt = rem & 15;
    tr_tile(tid, p->mix_w_out + (size_t)i * 1024 * 1024, 1024, kt * 64, nt * 64, p->Wt_out + (size_t)i * 1024 * 1024,
            1024, [](int n) { return n; }, sm);
  } else if (job < CJ3) {
    const int q = job - CJ2;
    const int le = q >> 7, rem = q & 127;
    const int which = rem >> 6, kt = (rem >> 2) & 15, nt = rem & 3;
    const int layer = le / 65, e = le % 65;
    const float* src;
    if (e < 64) src = (which ? p->moe_w3 : p->moe_w1) + (size_t)(layer * 64 + e) * 1024 * 256;
    else src = (which ? p->shared_w3 : p->shared_w1) + (size_t)layer * 1024 * 256;
    tr_tile_fp8(tid, src, 256, kt * 64, nt * 64, (unsigned char*)p->Wt13 + (size_t)le * 512 * 1024, 1024,
                [which](int n) { return 64 * (n >> 5) + which * 32 + (n & 31); }, sm);
  } else {
    const int q = job - CJ3;
    const int le = q >> 6, rem = q & 63;
    const int kt = rem >> 4, nt = rem & 15;
    const int layer = le / 65, e = le % 65;
    const float* src = e < 64 ? p->moe_w2 + (size_t)(layer * 64 + e) * 256 * 1024 : p->shared_w2 + (size_t)layer * 256 * 1024;
    tr_tile_fp8(tid, src, 1024, kt * 64, nt * 64, (unsigned char*)p->Wt2 + (size_t)le * 1024 * 256, 256, [](int n) { return n; }, sm);
  }
}
__device__ __forceinline__ int conv_stage_total(int stage) {
  return stage == 0 ? (576 + 1040 + 512 + 8320 + 4160) : (stage == 1 ? (576 + 1040 + 256 + 16640 + 8320) : (256 + 8320 + 4160));
}
__device__ __forceinline__ int conv_stage_job(int stage, int q) {
  if (stage == 0) {
    if (q < 8320) return CJ2 + q;  q -= 8320;
    if (q < 4160) return CJ3 + q;  q -= 4160;
    if (q < 576) return q;  q -= 576;
    if (q < 1040) return CJ0 + q;  q -= 1040;
    return CJ1 + q;
  } else if (stage == 1) {
    if (q < 8320) return CJ2 + 8320 + q;  q -= 8320;
    if (q < 4160) return CJ3 + 4160 + q;  q -= 4160;
    if (q < 576) return 576 + q;  q -= 576;
    if (q < 256) return CJ1 + 512 + q;  q -= 256;
    if (q < 8320) return CJ2 + 16640 + q;  q -= 8320;
    if (q < 4160) return CJ3 + 8320 + q;  q -= 4160;
    return CJ0 + 1040 + q;
  }
  if (q < 256) return CJ1 + 768 + q;  q -= 256;
  if (q < 8320) return CJ2 + 24960 + q;  q -= 8320;
  return CJ3 + 12480 + q;
}

struct CvDesc { const float* src; unsigned char* dst; int N, K, k0, n0, which; };
__device__ __forceinline__ bool conv_desc_fp8(KP p, int job, CvDesc& d) {
  if (job < CJ2) return false;
  if (job < CJ3) {
    const int q = job - CJ2;
    const int le = q >> 7, rem = q & 127;
    const int which = rem >> 6, kt = (rem >> 2) & 15, nt = rem & 3;
    const int layer = le / 65, e = le % 65;
    if (e < 64) d.src = (which ? p->moe_w3 : p->moe_w1) + (size_t)(layer * 64 + e) * 1024 * 256;
    else d.src = (which ? p->shared_w3 : p->shared_w1) + (size_t)layer * 1024 * 256;
    d.dst = (unsigned char*)p->Wt13 + (size_t)le * 512 * 1024;
    d.N = 256; d.K = 1024; d.k0 = kt * 64; d.n0 = nt * 64; d.which = which;
  } else {
    const int q = job - CJ3;
    const int le = q >> 6, rem = q & 63;
    const int kt = rem >> 4, nt = rem & 15;
    const int layer = le / 65, e = le % 65;
    d.src = e < 64 ? p->moe_w2 + (size_t)(layer * 64 + e) * 256 * 1024 : p->shared_w2 + (size_t)layer * 256 * 1024;
    d.dst = (unsigned char*)p->Wt2 + (size_t)le * 1024 * 256;
    d.N = 1024; d.K = 256; d.k0 = kt * 64; d.n0 = nt * 64; d.which = -1;
  }
  return true;
}
typedef float cvf4 __attribute__((ext_vector_type(4)));
__device__ __forceinline__ void cv_load(const CvDesc& d, int tid, cvf4& v0, cvf4& v1, cvf4& v2, cvf4& v3) {
  const int tx = tid & 15, ty = tid >> 4;
  const float* s0 = d.src + (size_t)(d.k0 + ty) * d.N + d.n0 + tx * 4;
  v0 = *(const cvf4*)(s0);
  v1 = *(const cvf4*)(s0 + (size_t)16 * d.N);
  v2 = *(const cvf4*)(s0 + (size_t)32 * d.N);
  v3 = *(const cvf4*)(s0 + (size_t)48 * d.N);
}
__device__ __forceinline__ void cv_emit(const CvDesc& d, int tid, const cvf4 v0, const cvf4 v1, const cvf4 v2, const cvf4 v3, float* tile) {
  {
    const int tx = tid & 15, ty = tid >> 4;
    float* t0 = tile + ty * 65 + tx * 4;
    t0[0] = v0.x; t0[1] = v0.y; t0[2] = v0.z; t0[3] = v0.w;
    t0[16 * 65 + 0] = v1.x; t0[16 * 65 + 1] = v1.y; t0[16 * 65 + 2] = v1.z; t0[16 * 65 + 3] = v1.w;
    t0[32 * 65 + 0] = v2.x; t0[32 * 65 + 1] = v2.y; t0[32 * 65 + 2] = v2.z; t0[32 * 65 + 3] = v2.w;
    t0[48 * 65 + 0] = v3.x; t0[48 * 65 + 1] = v3.y; t0[48 * 65 + 2] = v3.z; t0[48 * 65 + 3] = v3.w;
  }
  __syncthreads();
  {
    const int kc = tid & 3, n = tid >> 2;
    float v[16];
#pragma unroll
    for (int q = 0; q < 16; ++q) v[q] = tile[(kc * 16 + q) * 65 + n] * W8_SCALE;
    u32x4 o;
    o.x = pk_fp8x4(v[0], v[1], v[2], v[3]); o.y = pk_fp8x4(v[4], v[5], v[6], v[7]);
    o.z = pk_fp8x4(v[8], v[9], v[10], v[11]); o.w = pk_fp8x4(v[12], v[13], v[14], v[15]);
    const int nn = d.n0 + n;
    const int row = d.which >= 0 ? 64 * (nn >> 5) + d.which * 32 + (nn & 31) : nn;
    *(u32x4*)(d.dst + (size_t)row * d.K + d.k0 + kc * 16) = o;
  }
  __syncthreads();
}
__device__ __forceinline__ void convert_run(KP p, int stage, int jj, int j1, float* sm, int tid) {
  CvDesc d, dn;
  cvf4 a0, a1, a2, a3, b0, b1, b2, b3;
  bool cur = false;
#pragma unroll 1
  for (; jj < j1; ++jj) {
    const int job = conv_stage_job(stage, jj);
    if (!cur) {
      if (!conv_desc_fp8(p, job, d)) { convert_job(p, job, sm, tid); continue; }
      cv_load(d, tid, a0, a1, a2, a3);
    }
    bool nxt = false;
    if (jj + 1 < j1) {
      nxt = conv_desc_fp8(p, conv_stage_job(stage, jj + 1), dn);
      if (nxt) cv_load(dn, tid, b0, b1, b2, b3);
    }
    cv_emit(d, tid, a0, a1, a2, a3, sm);
    if (nxt) { d = dn; a0 = b0; a1 = b1; a2 = b2; a3 = b3; }
    cur = nxt;
  }
}

__device__ void ph_init(KP p, char* smc) {
  float* sm = (float*)smc;
  const int tid = opaque_tid();
  {
    const size_t n4a = (size_t)NL * DM / 4, n4b = (size_t)NC * DM / 4;
    const float4* xs = (const float4*)p->x;
    const float4* cs = (const float4*)p->ctx;
    float4* X4 = (float4*)p->X;
    for (size_t i = (size_t)blockIdx.x * NTHR + tid; i < n4a + n4b; i += (size_t)gridDim.x * NTHR)
      X4[i] = i < n4a ? xs[i] : cs[i - n4a];
  }
  for (int tile = blockIdx.x; tile < 96 * 8; tile += gridDim.x) {
    const int ct = tile >> 3, ks = tile & 7;
    for (int i = tid; i < 9 * 128; i += NTHR) {
      const int r = i >> 7, k = ks * 128 + (i & 127);
      const float v = r < 8 ? p->c[r * 1024 + k] : p->c_ctx[k];
      sm[i] = silu_f(v);
    }
    __syncthreads();
    const int col = ct * 256 + tid;
    const int layer = col / 6144, n = col % 6144;
    const float* W = p->ada_w + ((size_t)layer * 1024 + ks * 128) * 6144 + n;
    float acc[9];
#pragma unroll
    for (int r = 0; r < 9; ++r) acc[r] = 0.f;
#pragma unroll 4
    for (int k = 0; k < 128; ++k) {
      const float w = W[(size_t)k * 6144];
#pragma unroll
      for (int r = 0; r < 9; ++r) acc[r] = fmaf(sm[r * 128 + k], w, acc[r]);
    }
#pragma unroll
    for (int r = 0; r < 9; ++r) p->MODP[((size_t)(ks * 4 + layer) * 9 + r) * 6144 + n] = acc[r];
    __syncthreads();
  }
  {
    const int total = conv_stage_total(0), chunk = (total + gridDim.x - 1) / gridDim.x;
    const int lo = min((int)blockIdx.x * chunk, total), hi = min(lo + chunk, total);
    __syncthreads();
    convert_run(p, 0, lo, hi, sm, tid);
  }
  for (int i = blockIdx.x * NTHR + tid; i < 2 * 3 * 128 * 512; i += gridDim.x * NTHR) {
    const int k = i & 511, n = (i >> 9) & 127, wj = i >> 16;
    const int j = wj / 3, which = wj % 3;
    float v = 0.f;
    if (which < 2) {
      if (n < 64) v = (which ? p->rwkv_a1 : p->rwkv_w1)[((size_t)(j * 2 + (n >> 5)) * 512 + k) * 32 + (n & 31)];
    } else if (n < 96) v = p->rwkv_g1[((size_t)j * 512 + k) * 96 + n];
    p->Wl1[i] = f2bf(v);
  }
  for (int i = blockIdx.x * NTHR + tid; i < 2 * 2560 * 128; i += gridDim.x * NTHR) {
    const int k = i & 127, n = (i >> 7) % 2560, j = i / (2560 * 128);
    float v = 0.f;
    if (n < 2048) {
      const int d = (n >> 9) & 1, c = n & 511;
      if (k < 64 && (k >> 5) == d) v = (n < 1024 ? p->rwkv_w2 : p->rwkv_a2)[((size_t)(j * 2 + d) * 32 + (k & 31)) * 512 + c];
    } else if (k < 96) v = p->rwkv_g2[((size_t)j * 96 + k) * 512 + (n - 2048)];
    p->Wl2[i] = f2bf(v);
  }
  for (int i = blockIdx.x * NTHR + tid; i < 4 * 64 * 1024; i += gridDim.x * NTHR) {
    const int k = i & 1023, n = (i >> 10) & 63, l = i >> 16;
    p->WrT[i] = p->moe_router[((size_t)l * 1024 + k) * 64 + n];
  }
  for (int i = blockIdx.x * NTHR + tid; i < 64 * 16; i += gridDim.x * NTHR) {
    const int pos = i >> 4, f = i & 15;
    const float ang = (float)pos * powf(10000.f, -(float)f / 16.f);
    p->ROPE[2 * i] = cosf(ang);
    p->ROPE[2 * i + 1] = sinf(ang);
  }
}

__device__ void ph_mod_h(KP p, char* smc) {
  float* sm = (float*)smc;
  const int tid = opaque_tid();
  for (int i = blockIdx.x * NTHR + tid; i < 4 * 9 * 6144; i += gridDim.x * NTHR) {
    const int layer = i / (9 * 6144), rem = i % (9 * 6144), n = rem % 6144;
    float s = p->ada_b[layer * 6144 + n];
#pragma unroll
    for (int ks = 0; ks < 8; ++ks) s += p->MODP[(size_t)(ks * 4 + layer) * 9 * 6144 + rem];
    p->MOD[i] = s;
  }
  const int lane = tid & 63, wave = tid >> 6;
  const int per = (((NT + gridDim.x - 1) / gridDim.x) + 3) & ~3;
  const int t0 = blockIdx.x * per, t1 = min(NT, t0 + per);
  int cur = -1;
  for (int tb = t0; tb < t1; tb += 4) {
    const int mr = modrow(tb);
    if (mr != cur) {
      __syncthreads();
      for (int n = tid; n < 2048; n += NTHR) {
        float a = p->ada_b[n];
#pragma unroll
        for (int ks = 0; ks < 8; ++ks) a += p->MODP[((size_t)(ks * 4) * 9 + mr) * 6144 + n];
        sm[n] = a;
      }
      cur = mr;
      __syncthreads();
    }
    const int t = tb + wave;
    if (t < t1) {
      const float* src = t < NL ? p->x + (size_t)t * DM : p->ctx + (size_t)(t - NL) * DM;
#pragma unroll
      for (int i = 0; i < 4; ++i) {
        const int n = i * 256 + lane * 4;
        const float4 xv = *(const float4*)(src + n);
        const float4 sh = *(const float4*)(sm + n);
        const float4 sc = *(const float4*)(sm + 1024 + n);
        u32x2 o;
        o.x = pk_bf16(xv.x * (1.f + sc.x) + sh.x, xv.y * (1.f + sc.y) + sh.y);
        o.y = pk_bf16(xv.z * (1.f + sc.z) + sh.z, xv.w * (1.f + sc.w) + sh.w);
        *(u32x2*)(p->AB + (size_t)t * DM + n) = o;
      }
    }
  }
}

typedef short v4i16_t __attribute__((ext_vector_type(4)));
using s16x4 = __attribute__((ext_vector_type(4))) short;
__device__ __forceinline__ s16x4 vtr(const char* p) {
  return __builtin_bit_cast(s16x4, __builtin_amdgcn_ds_read_tr16_b64_v4i16((__attribute__((address_space(3))) v4i16_t*)p));
}
#define MFMA32(a, b, c) __builtin_amdgcn_mfma_f32_32x32x16_bf16(a, b, c, 0, 0, 0)
__device__ void ph_attention(KP p, int layer, bool keep, char* lds) {
  const int tid = opaque_tid();
  const int lane = tid & 63, w = tid >> 6, r32 = lane & 31, hi = lane >> 5;
  const int j = layer >> 1;
  float* bias_lds = (float*)(lds + 32768 + 1024);
  const int n_gqa = 1024, n_na = 1024, n_cb = keep ? 128 : 0, n_ca = keep ? 128 : 0;
  const int total = n_gqa + n_na + n_cb + n_ca;
  constexpr float LOG2E = 1.4426950408889634f;
  constexpr float C2 = 0.125f * LOG2E;
  const int c = tid & 7, sr = tid >> 3;
  const int kso = (c ^ ((tid >> 4) & 7)) * 16;
  const int vso = (c >> 2) * 4096 + (c & 3) * 16;
  const int sw = (r32 >> 1) & 7;
  for (int item = blockIdx.x; item < total; item += gridDim.x) {
    int b, qrow0, qoff, koff, voff, ocol, lat_tiles, lat_row0;
    bool na = false;
    int r_w = 0, start_w = 0, ru0 = 0, hN = 0;
    if (item < n_gqa) {
      b = item >> 7;
      const int g = (item >> 6) & 1, tt = item & 63;
      qrow0 = b * SEQ + tt * 32; qoff = 1536 + (g * 4 + w) * 64; koff = 2048 + g * 64; voff = 2176 + g * 64;
      ocol = 512 + (g * 4 + w) * 64; lat_tiles = 32; lat_row0 = b * SEQ;
    } else if (item < n_gqa + n_na) {
      const int it = item - n_gqa;
      b = it >> 7; hN = (it >> 4) & 7;
      const int rp = it & 15;
      na = true; r_w = 2 * rp + (w >> 1);
      qrow0 = b * SEQ + r_w * 64 + (w & 1) * 32; qoff = hN * 64; koff = 512 + hN * 64; voff = 1024 + hN * 64; ocol = hN * 64;
      const int s0 = min(max(2 * rp - 4, 0), 24), s1 = min(max(2 * rp - 3, 0), 24);
      start_w = (w >> 1) ? s1 : s0; ru0 = s0; lat_tiles = (s1 != s0) ? 9 : 8; lat_row0 = b * SEQ + ru0 * 64;
    } else if (item < n_gqa + n_na + n_cb) {
      const int it = item - n_gqa - n_na;
      b = it >> 4;
      const int g = (it >> 3) & 1, tt = it & 7;
      qrow0 = NL + b * CTXL + tt * 32; qoff = 1536 + (g * 4 + w) * 64; koff = 2048 + g * 64; voff = 2176 + g * 64;
      ocol = 512 + (g * 4 + w) * 64; lat_tiles = 0; lat_row0 = 0;
    } else {
      const int it = item - n_gqa - n_na - n_cb;
      b = it >> 4;
      const int h = (it >> 1) & 7, half = it & 1;
      qrow0 = NL + b * CTXL + half * 128 + w * 32; qoff = h * 64; koff = 512 + h * 64; voff = 1024 + h * 64; ocol = h * 64;
      lat_tiles = 0; lat_row0 = 0;
    }
    const int ctx_row0 = NL + b * CTXL, ntiles = lat_tiles + 4;
    if (na)
      for (int i = tid; i < 465; i += NTHR) bias_lds[i] = p->na_rpb[(j * 8 + hN) * 465 + i] * LOG2E;
    bf16x8 qf[4];
    {
      const bf16_t* qp = p->P + (size_t)(qrow0 + r32) * LDP + qoff + hi * 8;
#pragma unroll
      for (int d0 = 0; d0 < 4; ++d0) qf[d0] = *(const bf16x8*)(qp + d0 * 16);
    }
    f32x16 o0, o1;
#pragma unroll
    for (int q = 0; q < 16; ++q) { o0[q] = 0.f; o1[q] = 0.f; }
    float m = -INFINITY, l = 0.f;
    u32x4 kr0, kr1, vr0, vr1;
    auto gload = [&](int t) {
      const int row0 = t < lat_tiles ? lat_row0 + 64 * t : ctx_row0 + 64 * (t - lat_tiles);
      const bf16_t* base = p->P + (size_t)(row0 + sr) * LDP + c * 8;
      kr0 = *(const u32x4*)(base + koff); kr1 = *(const u32x4*)(base + (size_t)32 * LDP + koff);
      vr0 = *(const u32x4*)(base + voff); vr1 = *(const u32x4*)(base + (size_t)32 * LDP + voff);
    };
    auto swrite = [&](int buf) {
      char* Kb = lds + buf * 16384;
      char* Vb = Kb + 8192;
      *(u32x4*)(Kb + sr * 128 + kso) = kr0; *(u32x4*)(Kb + (sr + 32) * 128 + kso) = kr1;
      *(u32x4*)(Vb + vso + sr * 64) = vr0; *(u32x4*)(Vb + vso + (sr + 32) * 64) = vr1;
    };
    gload(0);
    swrite(0);
    for (int t = 0; t < ntiles; ++t) {
      __syncthreads();
      if (t + 1 < ntiles) gload(t + 1);
      const bool na_tile = na && t < lat_tiles;
      const int kr = ru0 + t;
      const bool part = !na_tile || (kr >= start_w && kr < start_w + 8);
      if (part) {
        const char* Ks = lds + (t & 1) * 16384;
        const char* Vs = Ks + 8192;
        f32x16 s0, s1;
#pragma unroll
        for (int q = 0; q < 16; ++q) { s0[q] = 0.f; s1[q] = 0.f; }
#pragma unroll
        for (int d0 = 0; d0 < 4; ++d0) {
          const int off = ((2 * d0 + hi) ^ sw) * 16;
          const bf16x8 k0 = *(const bf16x8*)(Ks + r32 * 128 + off);
          const bf16x8 k1 = *(const bf16x8*)(Ks + (32 + r32) * 128 + off);
          s0 = MFMA32(k0, qf[d0], s0);
          s1 = MFMA32(k1, qf[d0], s1);
        }
        float mx = -INFINITY;
        if (na_tile) {
          const int cq = (w & 1) * 32 + r32;
          const int c0 = min(max(cq - 8, 0), 48);
          const float* brow = bias_lds + (kr - r_w + 7) * 31 + (15 - cq);
#pragma unroll
          for (int q = 0; q < 16; ++q) {
            const int kc = (q & 3) + 8 * (q >> 2) + 4 * hi;
            const float v0 = ((unsigned)(kc - c0) < 16u) ? fmaf(s0[q], C2, brow[kc]) : -INFINITY;
            const float v1 = ((unsigned)(kc + 32 - c0) < 16u) ? fmaf(s1[q], C2, brow[kc + 32]) : -INFINITY;
            s0[q] = v0; s1[q] = v1;
            mx = fmaxf(mx, fmaxf(v0, v1));
          }
        } else {
#pragma unroll
          for (int q = 0; q < 16; ++q) {
            s0[q] *= C2; s1[q] *= C2;
            mx = fmaxf(mx, fmaxf(s0[q], s1[q]));
          }
        }
        {
          auto rr = __builtin_amdgcn_permlane32_swap(__float_as_uint(mx), __float_as_uint(mx), false, false);
          mx = fmaxf(__uint_as_float(rr[0]), __uint_as_float(rr[1]));
        }
        const float mnew = fmaxf(m, mx);
        const float alpha = __builtin_amdgcn_exp2f(m - mnew);
        float ls = 0.f;
#pragma unroll
        for (int q = 0; q < 16; ++q) {
          s0[q] = __builtin_amdgcn_exp2f(s0[q] - mnew);
          s1[q] = __builtin_amdgcn_exp2f(s1[q] - mnew);
          ls += s0[q] + s1[q];
        }
        l = l * alpha + ls;
        m = mnew;
#pragma unroll
        for (int q = 0; q < 16; ++q) { o0[q] *= alpha; o1[q] *= alpha; }
        bf16x8 pf[4];
#pragma unroll
        for (int s = 0; s < 4; ++s) {
          const int u = (s & 1) * 8;
          u32x4 tpk;
          if (s < 2) {
            tpk.x = pk_bf16(s0[u + 0], s0[u + 1]); tpk.y = pk_bf16(s0[u + 2], s0[u + 3]);
            tpk.z = pk_bf16(s0[u + 4], s0[u + 5]); tpk.w = pk_bf16(s0[u + 6], s0[u + 7]);
          } else {
            tpk.x = pk_bf16(s1[u + 0], s1[u + 1]); tpk.y = pk_bf16(s1[u + 2], s1[u + 3]);
            tpk.z = pk_bf16(s1[u + 4], s1[u + 5]); tpk.w = pk_bf16(s1[u + 6], s1[u + 7]);
          }
          pf[s] = __builtin_bit_cast(bf16x8, tpk);
        }
        const char* vb = Vs + ((lane >> 4) & 1) * 32 + (lane & 3) * 8 + ((lane & 15) >> 2) * 64 + hi * 256;
#pragma unroll
        for (int s = 0; s < 4; ++s) {
          const s16x4 a00 = vtr(vb + (16 * s) * 64), a01 = vtr(vb + (16 * s + 8) * 64);
          const s16x4 a10 = vtr(vb + 4096 + (16 * s) * 64), a11 = vtr(vb + 4096 + (16 * s + 8) * 64);
          const bf16x8 A0 = __builtin_shufflevector(a00, a01, 0, 1, 2, 3, 4, 5, 6, 7);
          const bf16x8 A1 = __builtin_shufflevector(a10, a11, 0, 1, 2, 3, 4, 5, 6, 7);
          o0 = MFMA32(A0, pf[s], o0);
          o1 = MFMA32(A1, pf[s], o1);
        }
      }
      if (t + 1 < ntiles) swrite((t + 1) & 1);
    }
    __syncthreads();
    const float lt = l + __shfl_xor(l, 32);
    const float inv = 1.f / lt;
    bf16_t* op = p->AB + (size_t)(qrow0 + r32) * DM + ocol + 4 * hi;
#pragma unroll
    for (int g = 0; g < 4; ++g) {
      u32x2 v0, v1;
      v0.x = pk_bf16(o0[4 * g] * inv, o0[4 * g + 1] * inv); v0.y = pk_bf16(o0[4 * g + 2] * inv, o0[4 * g + 3] * inv);
      v1.x = pk_bf16(o1[4 * g] * inv, o1[4 * g + 1] * inv); v1.y = pk_bf16(o1[4 * g + 2] * inv, o1[4 * g + 3] * inv);
      *(u32x2*)(op + 8 * g) = v0;
      *(u32x2*)(op + 32 + 8 * g) = v1;
    }
  }
}

__device__ void ph_rwkv_mix(KP p, int layer) {
  const int j = layer >> 1;
  const int tid = opaque_tid();
  const int lane = tid & 63, wave = tid >> 6;
  const float* mu = p->rwkv_mu + j * 6 * 512;
  const int c0 = lane * 8;
  auto unpack = [](const u32x4 u, float (&f)[8]) {
    f[0] = bflo(u.x); f[1] = bfhi(u.x); f[2] = bflo(u.y); f[3] = bfhi(u.y);
    f[4] = bflo(u.z); f[5] = bfhi(u.z); f[6] = bflo(u.w); f[7] = bfhi(u.w);
  };
  auto pack = [](const float (&f)[8]) {
    u32x4 o;
    o.x = pk_bf16(f[0], f[1]); o.y = pk_bf16(f[2], f[3]); o.z = pk_bf16(f[4], f[5]); o.w = pk_bf16(f[6], f[7]);
    return o;
  };
  for (int t = blockIdx.x * 4 + wave; t < NT; t += gridDim.x * 4) {
    bool hasp, hasn;
    if (t < NL) { int s = t & 2047; hasp = s > 0; hasn = s < SEQ - 1; }
    else { int s = (t - NL) & 255; hasp = s > 0; hasn = s < CTXL - 1; }
    const bf16_t* pt = p->P + (size_t)t * LDP + c0;
    bf16_t* rw = p->RW + (size_t)t * RWS + c0;
    bf16_t* zb = p->Zb + (size_t)t * 1536 + c0;
    const u32x4 zero = {0u, 0u, 0u, 0u};
#pragma unroll
    for (int q = 0; q < 4; ++q) {
      float cur[8], pv[8], nx[8], d[8];
      unpack(*(const u32x4*)(pt + q * 512), cur);
      unpack(hasp ? *(const u32x4*)(pt + q * 512 - LDP) : zero, pv);
      unpack(hasn ? *(const u32x4*)(pt + q * 512 + LDP) : zero, nx);
#pragma unroll
      for (int e = 0; e < 8; ++e) d[e] = 0.5f * (pv[e] + nx[e]) - cur[e];
      if (q < 3) {
        float o[8];
        const float* m = mu + q * 512 + c0;
#pragma unroll
        for (int e = 0; e < 8; ++e) o[e] = cur[e] + d[e] * m[e];
        if (q == 0) *(u32x4*)(rw) = pack(o);
        else if (q == 2) *(u32x4*)(rw + 512) = pack(o);
        else {
          *(u32x4*)(rw + 10 * 512) = pack(o);
          float kk[8], ss = 0.f;
          const float* kv0 = p->rwkv_kvec + (j * 2 + 0) * 512 + c0;
#pragma unroll
          for (int e = 0; e < 8; ++e) { kk[e] = o[e] * kv0[e]; ss += kk[e] * kk[e]; }
          ss += dppx<0xB1>(ss); ss += dppx<0x4E>(ss); ss += dppx<0x141>(ss);
          const float rn = rsqrtf(fmaxf(ss, 1e-24f));
#pragma unroll
          for (int e = 0; e < 8; ++e) kk[e] *= rn;
          *(u32x4*)(rw + 2 * 512) = pack(kk);
        }
      } else {
#pragma unroll
        for (int z = 0; z < 3; ++z) {
          float o[8];
          const float* m = mu + (3 + z) * 512 + c0;
#pragma unroll
          for (int e = 0; e < 8; ++e) o[e] = cur[e] + d[e] * m[e];
          *(u32x4*)(zb + z * 512) = pack(o);
        }
      }
    }
  }
}

constexpr int RS_STEP = 384;
constexpr int RS_TB = 16;
struct RwkvStage { u32x2 r, kk, e, ke, a, v; };
__device__ void rwkv_unit(KP p, int unit, float* sm, int tid) {
  const int ch = unit >> 1, hf = unit & 1;
  const int dir = ch >> 6, b = (ch >> 3) & 7, h = ch & 7;
  const int lane = tid & 63, w = tid >> 6, rl = lane >> 3, ks = lane & 7;
  float* ybuf = sm + 2 * RS_TB * RS_STEP;
  const int ss = tid >> 4, kq = tid & 15;
  auto gload = [&](int n, RwkvStage& g) {
    const int row = scan_row(dir, b, n * RS_TB + ss);
    const bf16_t* base = p->RW + (size_t)row * RWS + h * 64 + kq * 4;
    g.r = *(const u32x2*)(base);
    g.kk = *(const u32x2*)(base + 2 * 512);
    g.e = *(const u32x2*)(base + (3 + dir) * 512);
    g.ke = *(const u32x2*)(base + (5 + dir) * 512);
    g.a = *(const u32x2*)(base + (7 + dir) * 512);
    g.v = *(const u32x2*)(p->RW + (size_t)row * RWS + 512 + h * 64 + hf * 32 + (kq & 7) * 4);
  };
  auto swrite = [&](int buf, const RwkvStage& g) {
    float* sp = sm + (buf * RS_TB + ss) * RS_STEP;
    const float r0 = bflo(g.r.x), r1 = bfhi(g.r.x), r2 = bflo(g.r.y), r3 = bfhi(g.r.y);
    const float k0 = bflo(g.kk.x), k1 = bfhi(g.kk.x), k2 = bflo(g.kk.y), k3 = bfhi(g.kk.y);
    const float w0 = __expf(-bflo(g.e.x)), w1 = __expf(-bfhi(g.e.x)), w2 = __expf(-bflo(g.e.y)), w3 = __expf(-bfhi(g.e.y));
    const float e0 = bflo(g.ke.x), e1 = bfhi(g.ke.x), e2 = bflo(g.ke.y), e3 = bfhi(g.ke.y);
    const float a0 = k0 * bflo(g.a.x), a1 = k1 * bfhi(g.a.x), a2 = k2 * bflo(g.a.y), a3 = k3 * bfhi(g.a.y);
    *(float4*)(sp + kq * 4) = make_float4(k0, k1, k2, k3);
    *(float4*)(sp + 64 + kq * 4) = make_float4(w0 * r0, w1 * r1, w2 * r2, w3 * r3);
    *(float4*)(sp + 128 + kq * 4) = make_float4(w0, w1, w2, w3);
    *(float4*)(sp + 192 + kq * 4) = make_float4(a0, a1, a2, a3);
    *(float4*)(sp + 256 + kq * 4) = make_float4(e0, e1, e2, e3);
    if (kq < 8) *(float4*)(sp + 320 + kq * 4) = make_float4(bflo(g.v.x), bfhi(g.v.x), bflo(g.v.y), bfhi(g.v.y));
    float c1 = a0 * r0 + a1 * r1 + a2 * r2 + a3 * r3;
    float c2 = e0 * r0 + e1 * r1 + e2 * r2 + e3 * r3;
    c1 += dppx<0xB1>(c1); c2 += dppx<0xB1>(c2);
    c1 += dppx<0x4E>(c1); c2 += dppx<0x4E>(c2);
    c1 += dppx<0x141>(c1); c2 += dppx<0x141>(c2);
    c1 += dppx<0x140>(c1); c2 += dppx<0x140>(c2);
    if (kq == 0) { sp[352] = c1; sp[353] = c2; }
  };
  typedef float f2 __attribute__((ext_vector_type(2)));
  f2 S01 = {0.f, 0.f}, S23 = {0.f, 0.f}, S45 = {0.f, 0.f}, S67 = {0.f, 0.f};
  auto compute = [&](int n) {
    const float* bp = sm + (n & 1) * RS_TB * RS_STEP;
    float* yb = ybuf + (n & 1) * RS_TB * 32 + w * 8 + rl;
    struct Ops { f2 k[4], r[4], w[4], a[4], e[4]; float vv; f2 c; };
    auto ld = [&](int s, Ops& o) {
      const float* sq = bp + s * RS_STEP;
      const f2* sp = (const f2*)(sq + ks * 8);
#pragma unroll
      for (int i = 0; i < 4; ++i) { o.k[i] = sp[i]; o.r[i] = sp[32 + i]; o.w[i] = sp[64 + i]; o.a[i] = sp[96 + i]; o.e[i] = sp[128 + i]; }
      o.vv = sq[320 + w * 8 + rl]; o.c = *(const f2*)(sq + 352);
    };
    auto step = [&](const Ops& o) -> float {
      f2 sa2 = S01 * o.k[0];
      f2 y2 = S01 * o.r[0];
      sa2 = __builtin_elementwise_fma(S23, o.k[1], sa2); y2 = __builtin_elementwise_fma(S23, o.r[1], y2);
      sa2 = __builtin_elementwise_fma(S45, o.k[2], sa2); y2 = __builtin_elementwise_fma(S45, o.r[2], y2);
      sa2 = __builtin_elementwise_fma(S67, o.k[3], sa2); y2 = __builtin_elementwise_fma(S67, o.r[3], y2);
      float sa = sa2.x + sa2.y, y0 = y2.x + y2.y;
      sa += dppx<0xB1>(sa); y0 += dppx<0xB1>(y0);
      sa += dppx<0x4E>(sa); y0 += dppx<0x4E>(y0);
      sa += dppx<0x141>(sa); y0 += dppx<0x141>(y0);
      sa = -sa;
      const f2 sav = {sa, sa}, vvv = {o.vv, o.vv};
      S01 = __builtin_elementwise_fma(vvv, o.e[0], __builtin_elementwise_fma(sav, o.a[0], S01 * o.w[0]));
      S23 = __builtin_elementwise_fma(vvv, o.e[1], __builtin_elementwise_fma(sav, o.a[1], S23 * o.w[1]));
      S45 = __builtin_elementwise_fma(vvv, o.e[2], __builtin_elementwise_fma(sav, o.a[2], S45 * o.w[2]));
      S67 = __builtin_elementwise_fma(vvv, o.e[3], __builtin_elementwise_fma(sav, o.a[3], S67 * o.w[3]));
      return fmaf(o.vv, o.c.y, fmaf(sa, o.c.x, y0));
    };
    Ops oa, ob;
    ld(0, oa);
#pragma unroll 1
    for (int s = 0; s < RS_TB; s += 2) {
      __builtin_amdgcn_sched_barrier(0);
      ld(s + 1, ob);
      __builtin_amdgcn_sched_barrier(0);
      float y0 = step(oa);
      asm volatile("" : "+v"(y0));
      __builtin_amdgcn_sched_barrier(0);
      ld(s + 2, oa);
      __builtin_amdgcn_sched_barrier(0);
      float y1 = step(ob);
      asm volatile("" : "+v"(y1));
      __builtin_amdgcn_sched_barrier(0);
      if (ks == 0) { yb[s * 32] = y0; yb[(s + 1) * 32] = y1; }
    }
  };
  auto yout = [&](int n) {
    const int row = scan_row(dir, b, n * RS_TB + ss);
    const float* ys = ybuf + (n & 1) * RS_TB * 32 + ss * 32 + kq * 2;
    *(unsigned*)(p->P + (size_t)row * LDP + dir * 512 + h * 64 + hf * 32 + kq * 2) = pk_bf16(ys[0], ys[1]);
  };
  constexpr int NB = TSC / RS_TB;
  RwkvStage gA, gB;
  gload(0, gA);
  gload(1, gB);
  swrite(0, gA);
  gload(2, gA);
  __syncthreads();
  for (int n = 0; n < NB; n += 2) {
    compute(n);
    swrite(1, gB);
    if (n + 3 < NB) gload(n + 3, gB);
    __syncthreads();
    yout(n);
    compute(n + 1);
    if (n + 2 < NB) swrite(0, gA);
    if (n + 4 < NB) gload(n + 4, gA);
    __syncthreads();
    yout(n + 1);
  }
  __syncthreads();
}

__device__ void mlstm_s1(KP p, int layer, int tile, char* lds, int tid) {
  const int j = layer >> 1;
  const int ch = tile / NCHUNK, c = tile % NCHUNK;
  const int dir = ch >> 5, b = (ch >> 2) & 7, h = ch & 3;
  float* s_ws = (float*)(lds + META_OFF);
  int* s_row = (int*)(s_ws + 64);
  char* kimg = lds;
  char* vimg = lds + 16384;
  if (tid < 64) {
    const int row = scan_row(dir, b, c * 64 + tid);
    s_row[tid] = row;
    const float* g = p->GP + (size_t)row * 16;
    const float gi = g[(dir * 2) * 4 + h] + p->mlstm_gate_b[j * 16 + (dir * 2) * 4 + h];
    const float gf = g[(dir * 2 + 1) * 4 + h] + p->mlstm_gate_b[j * 16 + (dir * 2 + 1) * 4 + h];
    float bc = -softplus_f(-gf);
#pragma unroll
    for (int o = 1; o < 64; o <<= 1) {
      float tmp = __shfl_up(bc, o);
      if (tid >= o) bc += tmp;
    }
    const float bend = __shfl(bc, 63);
    const float ds = bend - bc + gi;
    const float mloc = wmax(ds);
    s_ws[tid] = expf(ds - mloc);
    if (tid == 0) { p->msc[tile] = mloc; p->msc[NMT + tile] = bend; }
  }
  __syncthreads();
  {
    const int c8 = tid & 15;
    const int ioff = (c8 >> 2) * 4096 + (c8 & 3) * 16;
#pragma unroll
    for (int i = 0; i < 4; ++i) {
      const int sidx = (tid >> 4) + 16 * i;
      const bf16_t* src = p->P + (size_t)s_row[sidx] * LDP + h * 128 + c8 * 8;
      const u32x4 kv = *(const u32x4*)(src + 2560);
      u32x4 vv = *(const u32x4*)(src + 3072);
      const float wsv = s_ws[sidx];
      vv.x = pk_bf16(bflo(vv.x) * wsv, bfhi(vv.x) * wsv); vv.y = pk_bf16(bflo(vv.y) * wsv, bfhi(vv.y) * wsv);
      vv.z = pk_bf16(bflo(vv.z) * wsv, bfhi(vv.z) * wsv); vv.w = pk_bf16(bflo(vv.w) * wsv, bfhi(vv.w) * wsv);
      *(u32x4*)(kimg + ioff + sidx * 64) = kv;
      *(u32x4*)(vimg + ioff + sidx * 64) = vv;
    }
  }
  __syncthreads();
  const int lane = tid & 63, w = tid >> 6, wm = w >> 1, wn = w & 1, r32 = lane & 31, hi = lane >> 5;
  f32x16 acc[2][2];
#pragma unroll
  for (int mi = 0; mi < 2; ++mi)
#pragma unroll
    for (int ni = 0; ni < 2; ++ni)
#pragma unroll
      for (int q = 0; q < 16; ++q) acc[mi][ni][q] = 0.f;
  const int toff = ((lane >> 4) & 1) * 32 + (lane & 3) * 8 + ((lane & 15) >> 2) * 64 + hi * 256;
#pragma unroll
  for (int ks = 0; ks < 4; ++ks) {
    bf16x8 af[2], bfr[2];
#pragma unroll
    for (int i = 0; i < 2; ++i) {
      const char* ka = kimg + (wm * 2 + i) * 4096 + toff + (16 * ks) * 64;
      const char* va = vimg + (wn * 2 + i) * 4096 + toff + (16 * ks) * 64;
      af[i] = __builtin_shufflevector(vtr(ka), vtr(ka + 8 * 64), 0, 1, 2, 3, 4, 5, 6, 7);
      bfr[i] = __builtin_shufflevector(vtr(va), vtr(va + 8 * 64), 0, 1, 2, 3, 4, 5, 6, 7);
    }
    acc[0][0] = MFMA32(af[0], bfr[0], acc[0][0]);
    acc[0][1] = MFMA32(af[0], bfr[1], acc[0][1]);
    acc[1][0] = MFMA32(af[1], bfr[0], acc[1][0]);
    acc[1][1] = MFMA32(af[1], bfr[1], acc[1][1]);
  }
  bf16_t* U = p->MS + (size_t)tile * 16384;
#pragma unroll
  for (int mi = 0; mi < 2; ++mi)
#pragma unroll
    for (int ni = 0; ni < 2; ++ni)
#pragma unroll
      for (int q = 0; q < 16; ++q) {
        const int d = wm * 64 + mi * 32 + (q & 3) + 8 * (q >> 2) + 4 * hi;
        U[d * 128 + wn * 64 + ni * 32 + r32] = f2bf(acc[mi][ni][q]);
        if ((q & 3) == 3) __builtin_amdgcn_sched_barrier(0);
      }
  if (tid < 128) {
    const char* kc = kimg + (tid >> 5) * 4096 + (tid & 31) * 2;
    float a = 0.f;
#pragma unroll 8
    for (int sidx = 0; sidx < 64; ++sidx) a = fmaf(s_ws[sidx], bf2f(*(const bf16_t*)(kc + sidx * 64)), a);
    p->MSn[tile * 128 + tid] = a;
  }
}

__device__ void mlstm_s3(KP p, int layer, int tile, char* lds, int tid);
__device__ void ph_scan_a(KP p, int layer, char* smc) {
  float* sm = (float*)smc;
  const int tid = opaque_tid();
  __builtin_amdgcn_s_setprio(3);
  for (int u = blockIdx.x; u < 256; u += gridDim.x) rwkv_unit(p, u, sm, tid);
  __builtin_amdgcn_s_setprio(0);
  {
    const int stage = layer == 1 ? 1 : 2;
    const int nconv = conv_stage_total(stage);
    const int total = NMT + (nconv + 7) / 8;
    int* qc = (int*)(p->bar + XCD_BAR_WORDS + 16 * stage);
    int* s_q = (int*)(smc + META_OFF + 3968);
    int jj = 0, j1 = 0;
#pragma unroll 1
    for (;;) {
      if (jj >= j1) {
        __syncthreads();
        if (tid == 0) *s_q = atomicAdd(qc, 1);
        __syncthreads();
        const int q = *s_q;
        if (q >= total) break;
        if (q < NMT) { mlstm_s3(p, layer, q, smc, tid); continue; }
        jj = (q - NMT) * 8; j1 = min(jj + 8, nconv);
      }
      convert_run(p, stage, jj, j1, sm, tid);
      jj = j1;
    }
  }
}

__device__ void ph_mlstm_s2(KP p, char* smc) {
  float* sw = (float*)smc;
  const int tid = opaque_tid();
  const int nitems = 64 * 33;
  for (int item = blockIdx.x; item < nitems; item += gridDim.x) {
    const int ch = item / 33, seg = item % 33;
    __syncthreads();
    if (tid < 2 * NCHUNK) sw[72 + tid] = p->msc[(tid < NCHUNK ? 0 : NMT - NCHUNK) + ch * NCHUNK + tid];
    __syncthreads();
    if (tid == 0) {
      float m = 0.f;
      for (int c = 0; c < NCHUNK; ++c) {
        const int tile = ch * NCHUNK + c;
        const float mloc = sw[72 + c], bend = sw[72 + NCHUNK + c];
        const float mn = fmaxf(bend + m, mloc);
        sw[c] = expf(bend + m - mn);
        sw[36 + c] = expf(mloc - mn);
        if (seg == 0) p->msc[2 * NMT + tile] = m;
        m = mn;
      }
    }
    __syncthreads();
    if (seg < 32) {
      unsigned* base = (unsigned*)(p->MS + (size_t)ch * NCHUNK * 16384) + seg * 256 + tid;
      unsigned v[NCHUNK];
#pragma unroll
      for (int c = 0; c < NCHUNK; ++c) v[c] = base[(size_t)c * 8192];
      float C0 = 0.f, C1 = 0.f;
#pragma unroll
      for (int c = 0; c < NCHUNK; ++c) {
        const float t0 = bflo(v[c]), t1 = bfhi(v[c]);
        v[c] = pk_bf16(C0, C1);
        C0 = sw[c] * C0 + sw[36 + c] * t0;
        C1 = sw[c] * C1 + sw[36 + c] * t1;
      }
#pragma unroll
      for (int c = 0; c < NCHUNK; ++c) base[(size_t)c * 8192] = v[c];
    } else if (tid < 128) {
      float* base = p->MSn + (size_t)ch * NCHUNK * 128 + tid;
      float v[NCHUNK];
#pragma unroll
      for (int c = 0; c < NCHUNK; ++c) v[c] = base[c * 128];
      float C = 0.f;
#pragma unroll
      for (int c = 0; c < NCHUNK; ++c) {
        const float t0 = v[c];
        v[c] = C;
        C = sw[c] * C + sw[36 + c] * t0;
      }
#pragma unroll
      for (int c = 0; c < NCHUNK; ++c) base[c * 128] = v[c];
    }
  }
}

__device__ void mlstm_s3(KP p, int layer, int tile, char* lds, int tid) {
  const int j = layer >> 1;
  const int ch = tile / NCHUNK, c = tile % NCHUNK;
  const int dir = ch >> 5, b = (ch >> 2) & 7, h = ch & 3;
  float* s_b = (float*)(lds + META_OFF);
  float* s_ig = s_b + 64;
  float* s_mt = s_b + 128;
  float* s_wi = s_b + 192;
  int* s_row = (int*)(s_b + 256);
  float* s_n = s_b + 320;
  float* s_c = s_b + 448;
  char* kimg = lds;
  char* vimg = lds + 16384;
  char* cimg = lds + 32768;
  const float mprev = p->msc[2 * NMT + tile];
  const float qscale = 0.08838834764831845f;
  const int lane = tid & 63, w = tid >> 6, wt = w >> 1, wv = w & 1, r32 = lane & 31, hi = lane >> 5;
  const int t = wt * 32 + r32;
  const int rowq = scan_row(dir, b, c * 64 + t);
  const int c8 = tid & 15;
  u32x4 kr[4], vr[4], cr[8];
#pragma unroll
  for (int i = 0; i < 4; ++i) {
    const int sidx = (tid >> 4) + 16 * i;
    const bf16_t* src = p->P + (size_t)scan_row(dir, b, c * 64 + sidx) * LDP + h * 128 + c8 * 8;
    kr[i] = *(const u32x4*)(src + 2560);
    vr[i] = *(const u32x4*)(src + 3072);
  }
  {
    const bf16_t* Cp = p->MS + (size_t)tile * 16384;
#pragma unroll
    for (int i = 0; i < 8; ++i) cr[i] = *(const u32x4*)(Cp + ((tid >> 4) + 16 * i) * 128 + c8 * 8);
  }
  bf16x8 qf[8];
  {
    const bf16_t* qp = p->P + (size_t)rowq * LDP + 2048 + h * 128 + hi * 8;
#pragma unroll
    for (int d0 = 0; d0 < 8; ++d0) qf[d0] = *(const bf16x8*)(qp + d0 * 16);
  }
  if (tid < 64) {
    const int row = scan_row(dir, b, c * 64 + tid);
    s_row[tid] = row;
    const float* g = p->GP + (size_t)row * 16;
    const float gi = g[(dir * 2) * 4 + h] + p->mlstm_gate_b[j * 16 + (dir * 2) * 4 + h];
    const float gf = g[(dir * 2 + 1) * 4 + h] + p->mlstm_gate_b[j * 16 + (dir * 2 + 1) * 4 + h];
    float bc = -softplus_f(-gf);
#pragma unroll
    for (int o = 1; o < 64; o <<= 1) {
      float tmp = __shfl_up(bc, o);
      if (tid >= o) bc += tmp;
    }
    float pm = gi - bc;
#pragma unroll
    for (int o = 1; o < 64; o <<= 1) {
      float tmp = __shfl_up(pm, o);
      if (tid >= o) pm = fmaxf(pm, tmp);
    }
    const float mt = bc + fmaxf(mprev, pm);
    s_b[tid] = bc;
    s_ig[tid] = gi;
    s_mt[tid] = mt;
    s_wi[tid] = expf(bc + mprev - mt);
    s_c[tid] = (gi - bc) * 1.4426950408889634f;
  } else if (tid < 192) s_n[tid - 64] = p->MSn[tile * 128 + (tid - 64)];
  {
    const int ioff = (c8 >> 2) * 4096 + (c8 & 3) * 16;
#pragma unroll
    for (int i = 0; i < 4; ++i) {
      const int sidx = (tid >> 4) + 16 * i;
      *(u32x4*)(kimg + sidx * 256 + ((c8 ^ (sidx & 15)) * 16)) = kr[i];
      *(u32x4*)(vimg + ioff + sidx * 64) = vr[i];
    }
    const int coff = (c8 >> 2) * 8192 + (c8 & 3) * 16;
#pragma unroll
    for (int i = 0; i < 8; ++i) *(u32x4*)(cimg + coff + ((tid >> 4) + 16 * i) * 64) = cr[i];
  }
  __syncthreads();
  const int toff = ((lane >> 4) & 1) * 32 + (lane & 3) * 8 + ((lane & 15) >> 2) * 64;
  constexpr float LOG2E_ = 1.4426950408889634f;
  float qn = 0.f;
#pragma unroll
  for (int d0 = 0; d0 < 8; ++d0) {
    const u32x4 qq = __builtin_bit_cast(u32x4, qf[d0]);
    const float* np = s_n + d0 * 16 + hi * 8;
    qn = fmaf(bflo(qq.x), np[0], qn); qn = fmaf(bfhi(qq.x), np[1], qn);
    qn = fmaf(bflo(qq.y), np[2], qn); qn = fmaf(bfhi(qq.y), np[3], qn);
    qn = fmaf(bflo(qq.z), np[4], qn); qn = fmaf(bfhi(qq.z), np[5], qn);
    qn = fmaf(bflo(qq.w), np[6], qn); qn = fmaf(bfhi(qq.w), np[7], qn);
  }
  qn += __shfl_xor(qn, 32);
  const float mtt = s_mt[t], wi = s_wi[t];
  const float ct = (s_b[t] - mtt) * LOG2E_;
  const float wq = wi * qscale;
  bf16x8 pf[4];
  float den = 0.f;
  {
    f32x16 sa0, sa1;
#pragma unroll
    for (int q = 0; q < 16; ++q) { sa0[q] = 0.f; sa1[q] = 0.f; }
#pragma unroll
    for (int d0 = 0; d0 < 8; ++d0) {
      const int chn = 2 * d0 + hi;
      const bf16x8 k0 = *(const bf16x8*)(kimg + r32 * 256 + ((chn ^ (r32 & 15)) * 16));
      sa0 = MFMA32(k0, qf[d0], sa0);
      if (wt) {
        const bf16x8 k1 = *(const bf16x8*)(kimg + (32 + r32) * 256 + ((chn ^ (r32 & 15)) * 16));
        sa1 = MFMA32(k1, qf[d0], sa1);
      }
      __builtin_amdgcn_sched_barrier(0);
    }
#pragma unroll
    for (int g = 0; g < 4; ++g) {
      const int sb0 = 8 * g + 4 * hi;
      const float4 c0v = *(const float4*)(s_c + sb0);
      const float4 c1v = *(const float4*)(s_c + sb0 + 32);
      const float cc0[4] = {c0v.x, c0v.y, c0v.z, c0v.w}, cc1[4] = {c1v.x, c1v.y, c1v.z, c1v.w};
#pragma unroll
      for (int e = 0; e < 4; ++e) {
        const int q = 4 * g + e;
        const float v0 = (sb0 + e <= t) ? sa0[q] * qscale * __builtin_amdgcn_exp2f(ct + cc0[e]) : 0.f;
        sa0[q] = v0; den += v0;
        const float v1 = (wt && sb0 + 32 + e <= t) ? sa1[q] * qscale * __builtin_amdgcn_exp2f(ct + cc1[e]) : 0.f;
        sa1[q] = v1; den += v1;
      }
      __builtin_amdgcn_sched_barrier(0);
    }
#pragma unroll
    for (int sx = 0; sx < 4; ++sx) {
      const int u = (sx & 1) * 8;
      u32x4 tpk;
      if (sx < 2) {
        tpk.x = pk_bf16(sa0[u + 0], sa0[u + 1]); tpk.y = pk_bf16(sa0[u + 2], sa0[u + 3]);
        tpk.z = pk_bf16(sa0[u + 4], sa0[u + 5]); tpk.w = pk_bf16(sa0[u + 6], sa0[u + 7]);
      } else {
        tpk.x = pk_bf16(sa1[u + 0], sa1[u + 1]); tpk.y = pk_bf16(sa1[u + 2], sa1[u + 3]);
        tpk.z = pk_bf16(sa1[u + 4], sa1[u + 5]); tpk.w = pk_bf16(sa1[u + 6], sa1[u + 7]);
      }
      pf[sx] = __builtin_bit_cast(bf16x8, tpk);
    }
  }
  den += __shfl_xor(den, 32);
  const float dtot = den + wq * qn;
  const float inv = 1.f / fmaxf(fabsf(dtot), expf(-mtt));
  bf16_t* op = p->P + (size_t)rowq * LDP + 1024 + dir * 512 + h * 128 + wv * 64 + 4 * hi;
#pragma unroll 1
  for (int vp = 0; vp < 2; ++vp) {
    f32x16 o0;
#pragma unroll
    for (int q = 0; q < 16; ++q) o0[q] = 0.f;
    const char* cb = cimg + (wv * 2 + vp) * 8192 + toff + hi * 512;
#pragma unroll
    for (int d0 = 0; d0 < 8; ++d0) {
      const bf16x8 A0 = __builtin_shufflevector(vtr(cb + (16 * d0) * 64), vtr(cb + (16 * d0 + 4) * 64), 0, 1, 2, 3, 4, 5, 6, 7);
      o0 = MFMA32(A0, qf[d0], o0);
    }
#pragma unroll
    for (int q = 0; q < 16; ++q) o0[q] *= wq;
    const char* vb = vimg + (wv * 2 + vp) * 4096 + toff + hi * 256;
#pragma unroll
    for (int sx = 0; sx < 4; ++sx) {
      if (sx < 2 || wt) {
        const bf16x8 A0 = __builtin_shufflevector(vtr(vb + (16 * sx) * 64), vtr(vb + (16 * sx + 8) * 64), 0, 1, 2, 3, 4, 5, 6, 7);
        o0 = MFMA32(A0, pf[sx], o0);
      }
    }
#pragma unroll
    for (int g = 0; g < 4; ++g) {
      u32x2 v0;
      v0.x = pk_bf16(o0[4 * g] * inv, o0[4 * g + 1] * inv); v0.y = pk_bf16(o0[4 * g + 2] * inv, o0[4 * g + 3] * inv);
      *(u32x2*)(op + vp * 32 + 8 * g) = v0;
    }
  }
}

__device__ void ph_mlstm_s1(KP p, int layer, char* smc) {
  const int tid = opaque_tid();
  __syncthreads();
  for (int tile = blockIdx.x; tile < NMT; tile += gridDim.x) { mlstm_s1(p, layer, tile, smc, tid); __syncthreads(); }
}

__device__ void ph_rec_final(KP p, int layer, bool keep) {
  const int tid = opaque_tid();
  const int j = layer >> 1;
  const int lane = tid & 63, wave = tid >> 6;
  const int rows = keep ? NT : NL;
  const int c0 = lane * 8;
  auto unpack = [](const u32x4 u, float (&f)[8]) {
    f[0] = bflo(u.x); f[1] = bfhi(u.x); f[2] = bflo(u.y); f[3] = bfhi(u.y);
    f[4] = bflo(u.z); f[5] = bfhi(u.z); f[6] = bflo(u.w); f[7] = bfhi(u.w);
  };
  for (int t = blockIdx.x * 4 + wave; t < rows; t += gridDim.x * 4) {
    const bf16_t* rw = p->RW + (size_t)t * RWS + c0;
    const bf16_t* pt = p->P + (size_t)t * LDP + c0;
    bf16_t* mo = p->AB + (size_t)t * DM + c0;
    {
      float yf[8], yb[8], r[8], v[8], k0[8], k1[8], g[8], y[8], o[8];
      unpack(*(const u32x4*)(pt), yf); unpack(*(const u32x4*)(pt + 512), yb);
      unpack(*(const u32x4*)(rw), r); unpack(*(const u32x4*)(rw + 512), v);
      unpack(*(const u32x4*)(rw + 5 * 512), k0); unpack(*(const u32x4*)(rw + 6 * 512), k1);
      unpack(*(const u32x4*)(rw + 9 * 512), g);
      float s1 = 0.f, bs = 0.f;
      const float* rk = p->rwkv_rk + j * 512 + c0;
#pragma unroll
      for (int e = 0; e < 8; ++e) { y[e] = yf[e] + yb[e]; s1 += y[e]; bs += r[e] * rk[e] * (k0[e] + k1[e]); }
      s1 += dppx<0xB1>(s1); s1 += dppx<0x4E>(s1); s1 += dppx<0x141>(s1);
      bs += dppx<0xB1>(bs); bs += dppx<0x4E>(bs); bs += dppx<0x141>(bs);
      const float mu = s1 * (1.f / 64.f);
      float s2 = 0.f;
#pragma unroll
      for (int e = 0; e < 8; ++e) { const float d = y[e] - mu; s2 += d * d; }
      s2 += dppx<0xB1>(s2); s2 += dppx<0x4E>(s2); s2 += dppx<0x141>(s2);
      const float rs = rsqrtf(s2 * (1.f / 64.f) + 64e-5f);
      const float* gn0 = p->rwkv_gn + (j * 2 + 0) * 512 + c0;
      const float* gn1 = p->rwkv_gn + (j * 2 + 1) * 512 + c0;
#pragma unroll
      for (int e = 0; e < 8; ++e) o[e] = ((y[e] - mu) * rs * gn0[e] + gn1[e] + bs * v[e]) * g[e];
      u32x4 ov;
      ov.x = pk_bf16(o[0], o[1]); ov.y = pk_bf16(o[2], o[3]); ov.z = pk_bf16(o[4], o[5]); ov.w = pk_bf16(o[6], o[7]);
      *(u32x4*)(mo) = ov;
    }
    {
      float hf[8], hb[8], og[8], hsum[8], o[8];
      unpack(*(const u32x4*)(pt + 1024), hf); unpack(*(const u32x4*)(pt + 1536), hb);
      unpack(*(const u32x4*)(pt + 3584), og);
      float ss = 0.f;
#pragma unroll
      for (int e = 0; e < 8; ++e) { hsum[e] = hf[e] + hb[e]; ss += hsum[e] * hsum[e]; }
      ss += dppx<0xB1>(ss); ss += dppx<0x4E>(ss); ss += dppx<0x141>(ss); ss += dppx<0x140>(ss);
      const float rs = rsqrtf(ss * (1.f / 128.f) + 1e-6f);
      const float* ng = p->mlstm_norm + j * 512 + c0;
#pragma unroll
      for (int e = 0; e < 8; ++e) o[e] = hsum[e] * rs * ng[e] * sigm_f(og[e]);
      u32x4 ov;
      ov.x = pk_bf16(o[0], o[1]); ov.y = pk_bf16(o[2], o[3]); ov.z = pk_bf16(o[4], o[5]); ov.w = pk_bf16(o[6], o[7]);
      *(u32x4*)(mo + 512) = ov;
    }
  }
}

using f32x4v = __attribute__((ext_vector_type(4))) float;
__device__ void ph_ln_router(KP p, int layer, bool keep, char* smc) {
  float* h2s = (float*)smc;
  float* lgs = (float*)smc;
  const int tid = opaque_tid();
  const int lane = tid & 63, wave = tid >> 6;
  const int rows = keep ? NT : NL;
  const float* lng = p->ln_g + (layer * 2 + 0) * 1024;
  const float* lnb = p->ln_b + (layer * 2 + 0) * 1024;
  for (int tile = blockIdx.x; tile < rows / 16; tile += gridDim.x) {
    const int t0 = tile * 16;
    const float* mod = p->MOD + (layer * 9 + modrow(t0)) * 6144;
    {
      float4 v[4][4];
      float s4[4];
#pragma unroll
      for (int q = 0; q < 4; ++q) {
        const int t = t0 + wave * 4 + q;
        s4[q] = 0.f;
#pragma unroll
        for (int i = 0; i < 4; ++i) v[q][i] = *(const float4*)(p->Tb + (size_t)t * DM + i * 256 + lane * 4);
      }
#pragma unroll
      for (int q = 0; q < 4; ++q)
#pragma unroll
        for (int i = 0; i < 4; ++i) s4[q] += (v[q][i].x + v[q][i].y) + (v[q][i].z + v[q][i].w);
      float mean4[4], rs4[4];
#pragma unroll
      for (int q = 0; q < 4; ++q) mean4[q] = wsum(s4[q]) * (1.f / 1024.f);
#pragma unroll
      for (int q = 0; q < 4; ++q) {
        float qq = 0.f;
#pragma unroll
        for (int i = 0; i < 4; ++i) {
          const float d0 = v[q][i].x - mean4[q], d1 = v[q][i].y - mean4[q], d2 = v[q][i].z - mean4[q], d3 = v[q][i].w - mean4[q];
          qq += (d0 * d0 + d1 * d1) + (d2 * d2 + d3 * d3);
        }
        s4[q] = qq;
      }
#pragma unroll
      for (int q = 0; q < 4; ++q) rs4[q] = rsqrtf(wsum(s4[q]) * (1.f / 1024.f) + 1e-5f);
#pragma unroll
      for (int i = 0; i < 4; ++i) {
        const int n = i * 256 + lane * 4;
        const float4 g = *(const float4*)(lng + n), bb = *(const float4*)(lnb + n);
        const float4 sc = *(const float4*)(mod + 4096 + n), sh = *(const float4*)(mod + 3072 + n);
#pragma unroll
        for (int q = 0; q < 4; ++q) {
          const int tl = wave * 4 + q, t = t0 + tl;
          const float mean = mean4[q], rs = rs4[q];
          const float4 xn = make_float4((v[q][i].x - mean) * rs * g.x + bb.x, (v[q][i].y - mean) * rs * g.y + bb.y,
                                        (v[q][i].z - mean) * rs * g.z + bb.z, (v[q][i].w - mean) * rs * g.w + bb.w);
          *(float4*)(p->X + (size_t)t * DM + n) = xn;
          const float4 hh = make_float4(xn.x * (1.f + sc.x) + sh.x, xn.y * (1.f + sc.y) + sh.y,
                                        xn.z * (1.f + sc.z) + sh.z, xn.w * (1.f + sc.w) + sh.w);
          *(unsigned*)((unsigned char*)p->AB + (size_t)t * DM + n) = pk_fp8x4(hh.x, hh.y, hh.z, hh.w);
          *(float4*)(h2s + tl * 1028 + n) = hh;
        }
      }
    }
    __syncthreads();
    f32x4v acc = {0.f, 0.f, 0.f, 0.f};
    {
      f32x4v a1 = {0.f, 0.f, 0.f, 0.f}, a2 = {0.f, 0.f, 0.f, 0.f}, a3 = {0.f, 0.f, 0.f, 0.f};
      const int i = lane & 15, kk = lane >> 4;
      const float* arow = h2s + i * 1028 + 4 * kk;
      const float* brow = p->WrT + ((size_t)layer * 64 + 16 * wave + i) * 1024 + 4 * kk;
#pragma unroll 8
      for (int q = 0; q < 64; ++q) {
        const float4 a = *(const float4*)(arow + 16 * q);
        const float4 b = *(const float4*)(brow + 16 * q);
        acc = __builtin_amdgcn_mfma_f32_16x16x4f32(a.x, b.x, acc, 0, 0, 0);
        a1 = __builtin_amdgcn_mfma_f32_16x16x4f32(a.y, b.y, a1, 0, 0, 0);
        a2 = __builtin_amdgcn_mfma_f32_16x16x4f32(a.z, b.z, a2, 0, 0, 0);
        a3 = __builtin_amdgcn_mfma_f32_16x16x4f32(a.w, b.w, a3, 0, 0, 0);
      }
      acc = (acc + a1) + (a2 + a3);
    }
    __syncthreads();
#pragma unroll
    for (int r = 0; r < 4; ++r) lgs[((lane >> 4) * 4 + r) * 64 + 16 * wave + (lane & 15)] = acc[r];
    __syncthreads();
    {
      float score4[4], gate4[4];
      int kidx4[4], pos4[4];
      bool chosen4[4];
#pragma unroll
      for (int q = 0; q < 4; ++q) {
        const int tl = wave * 4 + q;
        const float logit = lgs[tl * 64 + lane];
        const float score = sigm_f(logit);
        float sel = score + p->moe_bias[layer * 64 + lane];
        bool chosen = false;
        for (int r = 0; r < 6; ++r) {
          const float mx = wmax(sel);
          const unsigned long long bal = __ballot(sel == mx);
          const int first = __ffsll((long long)bal) - 1;
          if (lane == first) { chosen = true; sel = -INFINITY; }
        }
        const float gsum = wsum(chosen ? score : 0.f);
        const unsigned long long cb = __ballot(chosen);
        score4[q] = score; gate4[q] = score / gsum * 2.5f; chosen4[q] = chosen;
        kidx4[q] = __popcll(cb & ((1ull << lane) - 1ull));
      }
#pragma unroll
      for (int q = 0; q < 4; ++q) pos4[q] = chosen4[q] ? atomicAdd(&p->cnt[lane * CSTR], 1) : 0;
#pragma unroll
      for (int q = 0; q < 4; ++q) {
        const int t = t0 + wave * 4 + q;
        if (chosen4[q]) {
          p->ltok[(size_t)lane * NT + pos4[q]] = t;
          p->lgate[(size_t)lane * NT + pos4[q]] = gate4[q];
          p->tsl[t * 6 + kidx4[q]] = (lane << 16) | pos4[q];
        }
      }
    }
    __syncthreads();
  }
}

__device__ __forceinline__ void moe_prefix(KP p, int rows, int* s_pref, int tid) {
  if (tid < 64) s_pref[322 + tid] = p->cnt[tid * CSTR];
  __syncthreads();
  if (tid == 0) {
    int a = 0;
    for (int e = 0; e < 64; ++e) { s_pref[e] = a; a += (s_pref[322 + e] + 127) >> 7; }
    s_pref[64] = a; a += rows >> 7;
    s_pref[65] = a;
  }
  __syncthreads();
}

__device__ void ph_gemm(KP p, int kind, int layer, bool keep, char* lds) {
  const int tid = opaque_tid();
  const int j = layer >> 1;
  const bool att = !(layer & 1);
  const int rows = keep ? NT : NL;
  int* pref = (int*)(lds + META_OFF);
  int* s_idx = pref + 66;
  float* s_gate = (float*)(s_idx + 128);
  if (kind == 1 && blockIdx.x == 0 && tid < 65) p->cnt[tid * CSTR] = 0;
  int total;
  const int ntn_in = att ? 18 : 33;
  switch (kind) {
    case 0: total = (NT / 128) * ntn_in; break;
    case 1: total = (rows / 128) * 8; break;
    case 2: total = pref[65] * 4; break;
    case 3: total = pref[65] * 8; break;
    case 4: total = (NT / 128) * 3; break;
    default: total = (NT / 128) * 20; break;
  }
  const bool moe = kind == 2 || kind == 3;
  const int tsh = kind == 2 ? 2 : 3;
  int e_nx = 0, idx_nx = tid; float g_nx = 1.f;
  auto fetch_moe = [&](int tl) {
    const int mt = tl >> tsh;
    while (mt >= pref[e_nx + 1]) ++e_nx;
    idx_nx = tid; g_nx = 1.f;
    if (tid < 128) {
      const int pos = (mt - pref[e_nx]) * 128 + tid;
      if (kind == 2) {
        idx_nx = 0;
        if (e_nx < 64) { if (pos < pref[322 + e_nx]) idx_nx = p->ltok[(size_t)e_nx * NT + pos]; }
        else idx_nx = pos;
      } else if (e_nx < 64) g_nx = pos < pref[322 + e_nx] ? p->lgate[(size_t)e_nx * NT + pos] : 0.f;
    }
  };
  if (moe && (int)blockIdx.x < total) fetch_moe(blockIdx.x);
  for (int tile = blockIdx.x; tile < total; tile += gridDim.x) {
    const bf16_t* Abase; const bf16_t* Bt;
    int astride, K, n0, m0 = 0, aux = 0, e = e_nx, mtile = 0;
    switch (kind) {
      case 0: { const int tm = tile / ntn_in, tn = tile % ntn_in; m0 = tm * 128; n0 = tn * 128;
                Abase = p->AB + (size_t)m0 * DM; astride = DM; K = 1024;
                Bt = att ? p->Wt_att + (size_t)j * ATT_N * 1024 : p->Wt_rec + (size_t)j * REC_NP * 1024; } break;
      case 1: { const int tm = tile >> 3, tn = tile & 7; m0 = tm * 128; n0 = tn * 128;
                Abase = p->AB + (size_t)m0 * DM; astride = DM; K = 1024; Bt = p->Wt_out + (size_t)layer * 1024 * 1024; } break;
      case 2: { mtile = tile >> 2; aux = tile & 3; n0 = aux * 128;
                Abase = p->AB; astride = DM; K = 1024;
                Bt = (const bf16_t*)((const unsigned char*)p->Wt13 + (size_t)(layer * 65 + e) * 512 * 1024); } break;
      case 3: { mtile = tile >> 3; aux = tile & 7; n0 = aux * 128;
                Abase = (const bf16_t*)((const unsigned char*)p->ACT + (size_t)mtile * 128 * 256); astride = 256; K = 256;
                Bt = (const bf16_t*)((const unsigned char*)p->Wt2 + (size_t)(layer * 65 + e) * 1024 * 256); } break;
      case 4: { const int tm = tile / 3; aux = tile % 3; m0 = tm * 128; n0 = 0;
                Abase = p->Zb + (size_t)m0 * 1536 + aux * 512; astride = 1536; K = 512; Bt = p->Wl1 + (size_t)(j * 3 + aux) * 128 * 512; } break;
      default: { const int tm = tile / 20; aux = tile % 20; m0 = tm * 128; n0 = aux * 128;
                const int grp = aux < 8 ? 0 : (aux < 16 ? 1 : 2);
                Abase = p->L1 + (size_t)m0 * 384 + grp * 128; astride = 384; K = 128; Bt = p->Wl2 + (size_t)j * 2560 * 128; } break;
    }
    if (tid < 128) { s_idx[tid] = idx_nx; s_gate[tid] = g_nx; }
    __syncthreads();
    if (moe && tile + (int)gridDim.x < total) fetch_moe(tile + gridDim.x);
    {
      f32x16 acc[2][2];
      if (kind == 2 || kind == 3) {
        const unsigned char* A8 = (const unsigned char*)Abase;
        gemm128_fp8(tid, [&](int r) { return A8 + (size_t)s_idx[r] * astride; }, (const unsigned char*)Bt, K, n0, lds, acc);
      } else
        gemm128_main(tid, [&](int r) { return Abase + (size_t)s_idx[r] * astride; }, Bt, K, n0, lds, acc);
      float* Ct = (float*)lds;
      acc_foreach(tid, acc, [&](int row, int col, float v) { Ct[row * 128 + col] = v; });
    }
    __syncthreads();
    {
      const float* Ct = (const float*)lds;
      int c4 = (tid & 31) * 4, r0 = tid >> 5;
      asm volatile("" : "+v"(c4), "+v"(r0));
      const int N_in = att ? ATT_N : REC_N;
      const int d5 = (aux >> 2) & 1, c05 = (aux & 3) * 128;
      switch (kind) {
        case 0: {
#pragma unroll 8
          for (int it = 0; it < 16; ++it) {
            const int row = it * 8 + r0;
            const float4 v = *(const float4*)(Ct + row * 128 + c4);

            const int cn = n0 + c4;
            float4 vq = v;
            if (att && n0 >= 1536 && n0 < 2176) {
              float ss = v.x * v.x + v.y * v.y + v.z * v.z + v.w * v.w;
              ss += dppx<0xB1>(ss); ss += dppx<0x4E>(ss); ss += dppx<0x141>(ss); ss += dppx<0x140>(ss);
              const float rs = rsqrtf(ss * (1.f / 64.f) + 1e-6f);
              const float4 g = *(const float4*)(p->qk_gain + j * 128 + (n0 >= 2048 ? 64 : 0) + (cn & 63));
              vq = make_float4(v.x * rs * g.x, v.y * rs * g.y, v.z * rs * g.z, v.w * rs * g.w);
              const int t = m0 + row;
              if (t < NL) {
                const int sidx = t & 2047, pi0 = (cn & 63) >> 1;
                const int pos = pi0 < 16 ? (sidx >> 6) : (sidx & 63);
                const float4 cs = *(const float4*)(p->ROPE + (pos * 16 + (pi0 & 15)) * 2);
                vq = make_float4(vq.x * cs.x - vq.y * cs.y, vq.x * cs.y + vq.y * cs.x,
                                 vq.z * cs.z - vq.w * cs.w, vq.z * cs.w + vq.w * cs.z);
              }
            }
            if (cn < N_in) {
              u32x2 o; o.x = pk_bf16(vq.x, vq.y); o.y = pk_bf16(vq.z, vq.w);
              *(u32x2*)(p->P + (size_t)(m0 + row) * LDP + cn) = o;
            }
            if (!att && cn >= 4096 && cn < 4112) *(float4*)(p->GP + (size_t)(m0 + row) * 16 + (cn - 4096)) = v;
          }
        } break;
        case 1: {
#pragma unroll 16
          for (int it = 0; it < 16; ++it) {
            const int row = it * 8 + r0;
            const float4 v = *(const float4*)(Ct + row * 128 + c4);

            const size_t o = (size_t)(m0 + row) * DM + n0 + c4;
            const float4 xv = *(const float4*)(p->X + o);
            const float4 g = *(const float4*)(p->MOD + (layer * 9 + modrow(m0)) * 6144 + 2048 + n0 + c4);
            *(float4*)(p->Tb + o) = make_float4(DN_ALPHA * xv.x + g.x * v.x, DN_ALPHA * xv.y + g.y * v.y,
                                                DN_ALPHA * xv.z + g.z * v.z, DN_ALPHA * xv.w + g.w * v.w);
          }
        } break;
        case 2: {
#pragma unroll 8
          for (int it = 0; it < 16; ++it) {
            const int row = it * 8 + r0;
            const float4 v = *(const float4*)(Ct + row * 128 + c4);

            if (((c4 >> 5) & 1) == 0) {
              const float4 u = *(const float4*)(Ct + row * 128 + c4 + 32);
              const float a0 = v.x * W8_INV, a1 = v.y * W8_INV, a2 = v.z * W8_INV, a3 = v.w * W8_INV;
              *(unsigned*)((unsigned char*)p->ACT + ((size_t)mtile * 128 + row) * 256 + aux * 64 + (c4 >> 6) * 32 + (c4 & 31)) =
                  pk_fp8x4(silu_f(a0) * (u.x * W8_INV), silu_f(a1) * (u.y * W8_INV), silu_f(a2) * (u.z * W8_INV), silu_f(a3) * (u.w * W8_INV));
            }
          }
        } break;
        case 3: {
#pragma unroll 16
          for (int it = 0; it < 16; ++it) {
            const int row = it * 8 + r0;
            const float4 v = *(const float4*)(Ct + row * 128 + c4);

            const float g = s_gate[row] * W8_INV;
            u32x2 o; o.x = pk_bf16(g * v.x, g * v.y); o.y = pk_bf16(g * v.z, g * v.w);
            *(u32x2*)(p->OUT2 + ((size_t)mtile * 128 + row) * 1024 + n0 + c4) = o;
          }
        } break;
        case 4: {
#pragma unroll 4
          for (int it = 0; it < 16; ++it) {
            const int row = it * 8 + r0;
            const float4 v = *(const float4*)(Ct + row * 128 + c4);

            float4 o4 = v;
            if (aux == 0) o4 = make_float4(tanhf(v.x), tanhf(v.y), tanhf(v.z), tanhf(v.w));
            else if (aux == 2) o4 = make_float4(sigm_f(v.x), sigm_f(v.y), sigm_f(v.z), sigm_f(v.w));
            u32x2 o; o.x = pk_bf16(o4.x, o4.y); o.y = pk_bf16(o4.z, o4.w);
            *(u32x2*)(p->L1 + (size_t)(m0 + row) * 384 + aux * 128 + c4) = o;
          }
        } break;
        default: {
#pragma unroll 4
          for (int it = 0; it < 16; ++it) {
            const int row = it * 8 + r0;
            const float4 v = *(const float4*)(Ct + row * 128 + c4);

            bf16_t* rr = p->RW + (size_t)(m0 + row) * RWS + c05 + c4;
            const float vv[4] = {v.x, v.y, v.z, v.w};
            if (aux < 8) {
              const float4 b0 = *(const float4*)(p->rwkv_w0 + (j * 2 + d5) * 512 + c05 + c4);
              const float bb[4] = {b0.x, b0.y, b0.z, b0.w};
              float e4[4];
#pragma unroll
              for (int q = 0; q < 4; ++q) e4[q] = expf(-softplus_f(-(bb[q] + vv[q])) - 0.5f);
              u32x2 o; o.x = pk_bf16(e4[0], e4[1]); o.y = pk_bf16(e4[2], e4[3]);
              *(u32x2*)(rr + (3 + d5) * 512) = o;
            } else if (aux < 16) {
              const float4 b0 = *(const float4*)(p->rwkv_a0 + (j * 2 + d5) * 512 + c05 + c4);
              const float4 k1 = *(const float4*)(p->rwkv_kvec + (j * 2 + 1) * 512 + c05 + c4);
              const u32x2 kx2 = *(const u32x2*)(rr + 10 * 512);
              const float bb[4] = {b0.x, b0.y, b0.z, b0.w}, kk1[4] = {k1.x, k1.y, k1.z, k1.w};
              const float kx[4] = {bflo(kx2.x), bfhi(kx2.x), bflo(kx2.y), bfhi(kx2.y)};
              float av[4], ke[4];
#pragma unroll
              for (int q = 0; q < 4; ++q) { av[q] = sigm_f(bb[q] + vv[q]); ke[q] = kx[q] * (1.f + (av[q] - 1.f) * kk1[q]); }
              u32x2 o; o.x = pk_bf16(av[0], av[1]); o.y = pk_bf16(av[2], av[3]);
              *(u32x2*)(rr + (7 + d5) * 512) = o;
              o.x = pk_bf16(ke[0], ke[1]); o.y = pk_bf16(ke[2], ke[3]);
              *(u32x2*)(rr + (5 + d5) * 512) = o;
            } else {
              u32x2 o; o.x = pk_bf16(v.x, v.y); o.y = pk_bf16(v.z, v.w);
              *(u32x2*)(rr + 9 * 512) = o;
            }
          }
        } break;
      }
    }
    __syncthreads();
  }
}

__device__ void ph_final_ln(KP p, int layer, bool keep, char* lds) {
  const int tid = opaque_tid();
  const int lane = tid & 63, wave = tid >> 6;
  const int rows = keep ? NT : NL;
  int* s_base = (int*)(lds + META_OFF);
  if (tid == 0) {
    int a = 0;
#pragma unroll 1
    for (int e = 0; e < 64; ++e) { s_base[e] = a * 128; a += (p->cnt[e * CSTR] + 127) >> 7; }
    s_base[64] = a * 128;
  }
  __syncthreads();
  const float* lng = p->ln_g + (layer * 2 + 1) * 1024;
  const float* lnb = p->ln_b + (layer * 2 + 1) * 1024;
  for (int t = blockIdx.x * 4 + wave; t < rows; t += gridDim.x * 4) {
    const int mr = modrow(t);
    const float* g2 = p->MOD + (layer * 9 + mr) * 6144 + 5120;
    const bf16_t* src[7];
#pragma unroll
    for (int k = 0; k < 6; ++k) {
      const int v = p->tsl[t * 6 + k];
      src[k] = p->OUT2 + (size_t)(s_base[v >> 16] + (v & 0xffff)) * 1024;
    }
    src[6] = p->OUT2 + (size_t)(s_base[64] + t) * 1024;
    float v[16];
    float s = 0.f;
#pragma unroll
    for (int c = 0; c < 2; ++c) {
      const int n0 = c * 512 + lane * 8;
      float y[8];
#pragma unroll
      for (int q = 0; q < 8; ++q) y[q] = 0.f;
#pragma unroll
      for (int k = 0; k < 7; ++k) {
        const u32x4 u = *(const u32x4*)(src[k] + n0);
        y[0] += bflo(u.x); y[1] += bfhi(u.x); y[2] += bflo(u.y); y[3] += bfhi(u.y);
        y[4] += bflo(u.z); y[5] += bfhi(u.z); y[6] += bflo(u.w); y[7] += bfhi(u.w);
      }
      const float4 xa = *(const float4*)(p->X + (size_t)t * DM + n0), xb = *(const float4*)(p->X + (size_t)t * DM + n0 + 4);
      const float4 ga = *(const float4*)(g2 + n0), gb = *(const float4*)(g2 + n0 + 4);
      const float xx[8] = {xa.x, xa.y, xa.z, xa.w, xb.x, xb.y, xb.z, xb.w};
      const float gg[8] = {ga.x, ga.y, ga.z, ga.w, gb.x, gb.y, gb.z, gb.w};
#pragma unroll
      for (int q = 0; q < 8; ++q) { v[c * 8 + q] = DN_ALPHA * xx[q] + gg[q] * y[q]; s += v[c * 8 + q]; }
    }
    const float mean = wsum(s) * (1.f / 1024.f);
    float q2 = 0.f;
#pragma unroll
    for (int i = 0; i < 16; ++i) { const float d = v[i] - mean; q2 += d * d; }
    const float rs = rsqrtf(wsum(q2) * (1.f / 1024.f) + 1e-5f);
    const float* modn = p->MOD + ((layer + 1) * 9 + mr) * 6144;
#pragma unroll
    for (int c = 0; c < 2; ++c) {
      const int n0 = c * 512 + lane * 8;
      float xn[8];
#pragma unroll
      for (int q = 0; q < 8; ++q) xn[q] = (v[c * 8 + q] - mean) * rs * lng[n0 + q] + lnb[n0 + q];
      *(float4*)(p->X + (size_t)t * DM + n0) = make_float4(xn[0], xn[1], xn[2], xn[3]);
      *(float4*)(p->X + (size_t)t * DM + n0 + 4) = make_float4(xn[4], xn[5], xn[6], xn[7]);
      if (layer == 3) {
        *(float4*)(p->out + (size_t)t * DM + n0) = make_float4(xn[0], xn[1], xn[2], xn[3]);
        *(float4*)(p->out + (size_t)t * DM + n0 + 4) = make_float4(xn[4], xn[5], xn[6], xn[7]);
      } else {
        float hb[8];
#pragma unroll
        for (int q = 0; q < 8; ++q) hb[q] = xn[q] * (1.f + modn[1024 + n0 + q]) + modn[n0 + q];
        u32x4 o;
        o.x = pk_bf16(hb[0], hb[1]); o.y = pk_bf16(hb[2], hb[3]); o.z = pk_bf16(hb[4], hb[5]); o.w = pk_bf16(hb[6], hb[7]);
        *(u32x4*)(p->AB + (size_t)t * DM + n0) = o;
      }
    }
  }
}

#define XB_TMO      128
#define XB_XCNT(j)  (256  + 64 * (j))
#define XB_XSUB(j)  (1280 + 64 * (j))
#define XB_XGEN(j)  (2304 + 64 * (j))
#define XB_TOP      3328
#define XB_TOPGEN   3392
#define XB_SPIN_CAP (1u << 20)
#define LAS __attribute__((address_space(3)))
__device__ __forceinline__ unsigned xb_ld(unsigned* p) { return __hip_atomic_load(p, __ATOMIC_RELAXED, __HIP_MEMORY_SCOPE_AGENT); }
__device__ __forceinline__ unsigned xb_add(unsigned* p, unsigned v) { return __hip_atomic_fetch_add(p, v, __ATOMIC_RELAXED, __HIP_MEMORY_SCOPE_AGENT); }
__device__ __forceinline__ unsigned xb_xcc_id() { return (unsigned)__builtin_amdgcn_s_getreg((3 << 11) | 20) & 0xFu; }
#define XB_SPIN(cond, bar) do { unsigned _sp = 0; while (cond) { __builtin_amdgcn_s_sleep(1); \
    if ((++_sp & 255u) == 0u) { if (xb_ld(&(bar)[XB_TMO])) break; if (_sp > XB_SPIN_CAP) { atomicAdd(&(bar)[XB_TMO], 1u); break; } } } } while (0)
struct XcdBarrier { unsigned* bar; unsigned x; volatile LAS unsigned* st; };
__device__ __forceinline__ XcdBarrier xcd_barrier_post(unsigned* bar, volatile LAS unsigned* st) {
  XcdBarrier b; b.bar = bar; b.x = xb_xcc_id(); b.st = st;
  if (threadIdx.x == 0) (void)xb_add(&bar[XB_XCNT(b.x)], 1u);
  return b;
}
__device__ __forceinline__ void xcd_barrier_complete(unsigned* bar, unsigned x, unsigned& nloc, unsigned& nx) {
  const unsigned G = gridDim.x;
  unsigned sum, cnt, mine, sp = 0u;
  for (;;) {
    sum = 0u; cnt = 0u; mine = 0u;
#pragma unroll
    for (unsigned j = 0; j < 16; ++j) { const unsigned c = xb_ld(&bar[XB_XCNT(j)]); sum += c; cnt += (c > 0u) ? 1u : 0u; mine = (j == x) ? c : mine; }
    if (sum == G) break;
    __builtin_amdgcn_s_sleep(1);
    if ((++sp & 255u) == 0u) { if (xb_ld(&bar[XB_TMO])) break; if (sp > XB_SPIN_CAP) { atomicAdd(&bar[XB_TMO], 1u); break; } }
  }
  nloc = mine > 0u ? mine : 1u; nx = cnt > 0u ? cnt : 1u;
}
__device__ __forceinline__ void xcd_barrier(const XcdBarrier& b) {
  asm volatile("s_waitcnt vmcnt(0)" ::: "memory");
  __syncthreads();
  if (threadIdx.x == 0) {
    unsigned* bar = b.bar;
    __builtin_amdgcn_s_waitcnt(0);
    unsigned nloc = b.st[0], nx = b.st[1];
    if (nloc == 0u) { xcd_barrier_complete(bar, b.x, nloc, nx); b.st[0] = nloc; b.st[1] = nx; }
    const unsigned old = xb_add(&bar[XB_XSUB(b.x)], 1u);
    const unsigned gen = old / nloc;
    if (old + 1u == (gen + 1u) * nloc) {
      __builtin_amdgcn_fence(__ATOMIC_RELEASE, "agent");
      asm volatile("s_waitcnt vmcnt(0)" ::: "memory");
      const unsigned og = xb_add(&bar[XB_TOP], 1u);
      const unsigned tg = og / nx;
      if (og + 1u == (tg + 1u) * nx) xb_add(&bar[XB_TOPGEN], 1u);
      else XB_SPIN(xb_ld(&bar[XB_TOPGEN]) == tg, bar);
      __builtin_amdgcn_fence(__ATOMIC_ACQUIRE, "agent");
      xb_add(&bar[XB_XGEN(b.x)], 1u);
      asm volatile("s_waitcnt vmcnt(0)" ::: "memory");
    } else {
      XB_SPIN(xb_ld(&bar[XB_XGEN(b.x)]) == gen, bar);
      __builtin_amdgcn_fence(__ATOMIC_ACQUIRE, "agent");
      asm volatile("s_waitcnt vmcnt(0)" ::: "memory");
    }
  }
  __syncthreads();
}

constexpr int NSLOTS = 13;
constexpr int NPHASE = 2 + 4 * NSLOTS;
__device__ __forceinline__ bool phase_is_nop(int ph) {
  if (ph < 2) return false;
  const int layer = (ph - 2) / NSLOTS, st = (ph - 2) % NSLOTS;
  if (st == 5 || st == 6) return true;
  return !(layer & 1) && (st == 1 || (st >= 3 && st <= 7));
}
__device__ void run_phase(KP p, int ph, char* sm) {
  if (ph == 0) { ph_init(p, sm); return; }
  if (ph == 1) { ph_mod_h(p, sm); return; }
  const int layer = (ph - 2) / NSLOTS, st = (ph - 2) % NSLOTS;
  const bool odd = layer & 1;
  const bool keep = layer < 3;
  int gk = -1;
  if (st == 0) gk = 0;
  else if (st == 8) gk = 1;
  else if (st == 10) gk = 2;
  else if (st == 11) gk = 3;
  else if (odd && st == 2) gk = 4;
  else if (odd && st == 3) gk = 5;
  asm volatile("" : "+s"(gk));
  if (gk >= 0) {
    if (gk == 2 || gk == 3) moe_prefix(p, keep ? NT : NL, (int*)(sm + META_OFF), opaque_tid());
    ph_gemm(p, gk, layer, keep, sm);
    if (gk == 5) { __syncthreads(); ph_mlstm_s2(p, sm); }
    return;
  }
  switch (st) {
    case 1: if (odd) { ph_rwkv_mix(p, layer); ph_mlstm_s1(p, layer, sm); } break;
    case 2: ph_attention(p, layer, keep, sm); break;
    case 4: if (odd) ph_scan_a(p, layer, sm); break;
    case 7: if (odd) ph_rec_final(p, layer, keep); break;
    case 9: ph_ln_router(p, layer, keep, sm); break;
    case 12: ph_final_ln(p, layer, keep, sm); break;
  }
}

__global__ void __launch_bounds__(NTHR, 2) mega_kernel(Params kargs) {
  extern __shared__ __attribute__((aligned(16))) char sm[];
  cg::grid_group grid = cg::this_grid();
  volatile LAS unsigned* st = (volatile LAS unsigned*)(sm + META_OFF + 4032);
  if (threadIdx.x == 0) { st[0] = 0u; st[1] = 0u; }
  __syncthreads();
  const XcdBarrier xb = xcd_barrier_post(kargs.bar, st);
  for (int ph = kargs.ph_lo; ph < kargs.ph_hi; ++ph) {
    if (phase_is_nop(ph)) continue;
    {
      KP kp = (KP)__builtin_amdgcn_kernarg_segment_ptr();
      asm volatile("" : "+s"(kp));
      run_phase(kp, ph, sm);
    }
    if (ph + 1 < kargs.ph_hi) {
      if (ph == 0) grid.sync();
      else xcd_barrier(xb);
    }
  }
}

extern "C" void kernel_launch(void* const* d_in, const int* in_sizes, int n_in, void* d_out, int out_size, void* d_ws,
                              size_t ws_size, hipStream_t stream) {
  static int grid_blocks = 0;
  if (!grid_blocks) {
    int dev = 0, cus = 0, per_cu = 0;
    (void)hipGetDevice(&dev);
    (void)hipDeviceGetAttribute(&cus, hipDeviceAttributeMultiprocessorCount, dev);
    (void)hipFuncSetAttribute((const void*)mega_kernel, hipFuncAttributeMaxDynamicSharedMemorySize, SMEM_BYTES);
    (void)hipOccupancyMaxActiveBlocksPerMultiprocessor(&per_cu, mega_kernel, NTHR, SMEM_BYTES);
    if (per_cu < 1) per_cu = 1;
    if (per_cu > 2) per_cu = 2;
    grid_blocks = cus * per_cu;
  }
  Params p;
  memset(&p, 0, sizeof(p));
  const float** pin = (const float**)&p;
  for (int i = 0; i < 35; ++i) pin[i] = (const float*)d_in[i];
  p.out = (float*)d_out;
  char* w = (char*)d_ws;
  size_t off = 0;
  auto take = [&](size_t bytes) { char* r = w + off; off += (bytes + 255) & ~(size_t)255; return r; };
  p.Wt_att = (bf16_t*)take((size_t)2 * ATT_N * 1024 * 2);
  p.Wt_rec = (bf16_t*)take((size_t)2 * REC_NP * 1024 * 2);
  p.Wt_out = (bf16_t*)take((size_t)4 * 1024 * 1024 * 2);
  p.Wt13 = (bf16_t*)take((size_t)4 * 65 * 512 * 1024);
  p.Wt2 = (bf16_t*)take((size_t)4 * 65 * 1024 * 256);
  p.Wl1 = (bf16_t*)take((size_t)2 * 3 * 128 * 512 * 2);
  p.Wl2 = (bf16_t*)take((size_t)2 * 2560 * 128 * 2);
  p.X = (float*)take((size_t)NT * DM * 4);
  p.AB = (bf16_t*)take((size_t)NT * DM * 2);
  p.MOD = (float*)take((size_t)5 * 9 * 6144 * 4);
  p.MODP = (float*)take((size_t)8 * 4 * 9 * 6144 * 4);
  p.GP = (float*)take((size_t)NT * 16 * 4);
  p.ROPE = (float*)take((size_t)64 * 16 * 2 * 4);
  p.WrT = (float*)take((size_t)4 * 64 * 1024 * 4);
  p.msc = (float*)take((size_t)3 * NMT * 4);
  p.lgate = (float*)take((size_t)64 * NT * 4);
  p.ltok = (int*)take((size_t)64 * NT * 4);
  p.tsl = (int*)take((size_t)NT * 6 * 4);
  p.cnt = (int*)take((size_t)65 * CSTR * 4);
  p.bar = (unsigned*)take((size_t)BAR_TOTAL_WORDS * 4);
  char* region = take(0);
  const size_t szP = (size_t)NT * LDP * 2, szRW = (size_t)NT * RWS * 2, szMS = (size_t)NMT * 16384 * 2,
               szMSn = (size_t)NMT * 128 * 4;
  const size_t szT = (size_t)NT * DM * 4, szOUT2 = (size_t)NSLOT * 1024 * 2;
  p.P = (bf16_t*)region;
  p.RW = (bf16_t*)(region + szP);
  p.MS = (bf16_t*)(region + szP + szRW);
  p.MSn = (float*)(region + szP + szRW + szMS);
  p.Tb = (float*)region;
  p.ACT = (bf16_t*)region;
  p.OUT2 = (bf16_t*)(region + szT);
  const size_t szZ = (size_t)NT * 2048 * 2;
  p.Zb = (bf16_t*)(region + szP + szRW + szMS + szMSn);
  p.L1 = p.Zb + (size_t)NT * 1536;
  size_t mixer = szP + szRW + szMS + szMSn + szZ, moe = szT + szOUT2;
  off += (mixer > moe ? mixer : moe);
  if (off > ws_size) { fprintf(stderr, "workspace too small: need %zu have %zu\n", off, ws_size); return; }
  p.ph_lo = 0;
  p.ph_hi = NPHASE;
  (void)hipMemsetAsync(p.bar, 0, (size_t)BAR_TOTAL_WORDS * 4, stream);
  void* args[] = {&p};
  hipError_t e = hipLaunchCooperativeKernel((void*)mega_kernel, dim3(grid_blocks), dim3(NTHR), args, SMEM_BYTES, stream);
  if (e != hipSuccess) fprintf(stderr, "cooperative launch failed: %s (grid %d)\n", hipGetErrorString(e), grid_blocks);
}
```

```cpp
#include <hip/hip_runtime.h>
#include <hip/hip_cooperative_groups.h>
#include <cstdio>
#include <cstring>
namespace cg = cooperative_groups;

constexpr int DM = 1024;
constexpr int NBATCH = 8;
constexpr int SEQ = 2048;
constexpr int CTXL = 256;
constexpr int NL = NBATCH * SEQ;
constexpr int NC = NBATCH * CTXL;
constexpr int NT = NL + NC;
constexpr int TSC = CTXL + SEQ;
constexpr int LDP = 4112;
constexpr int ATT_N = 2304;
constexpr int REC_N = 4112;
constexpr int REC_NP = 4224;
constexpr int NCHUNK = 36;
constexpr int NMT = 64 * NCHUNK;
constexpr int RWS = 5632;
constexpr int NSLOT = 137216;
constexpr float DN_ALPHA = 1.6817928305074290f;
constexpr int NTHR = 256;
constexpr int SMEM_BYTES = 65536 + 4096;
constexpr int META_OFF = 65536;
#define XCD_BAR_WORDS 3456
constexpr int CSTR = 32;
constexpr int BAR_TOTAL_WORDS = XCD_BAR_WORDS + 64;

typedef unsigned short bf16_t;
using bf16x8 = __attribute__((ext_vector_type(8))) short;
using f32x16 = __attribute__((ext_vector_type(16))) float;
using u32x4 = __attribute__((ext_vector_type(4))) unsigned;
using u32x2 = __attribute__((ext_vector_type(2))) unsigned;

struct Params {
  const float *x, *c, *ctx, *c_ctx, *ada_w, *ada_b, *ln_g, *ln_b, *mix_w_out, *att_w_in, *na_rpb, *qk_gain,
      *rec_w_in, *rwkv_mu, *rwkv_w0, *rwkv_w1, *rwkv_w2, *rwkv_a0, *rwkv_a1, *rwkv_a2, *rwkv_g1, *rwkv_g2,
      *rwkv_kvec, *rwkv_rk, *rwkv_gn, *mlstm_gate_b, *mlstm_norm, *moe_router, *moe_bias, *moe_w1, *moe_w3,
      *moe_w2, *shared_w1, *shared_w3, *shared_w2;
  float* out;
  bf16_t *Wt_att, *Wt_rec, *Wt_out, *Wt13, *Wt2, *Wl1, *Wl2;
  bf16_t *Zb, *L1;
  float *X, *MOD, *MODP, *GP, *msc, *lgate, *MSn, *Tb, *ROPE, *WrT;
  bf16_t *AB, *P, *RW, *MS, *ACT, *OUT2;
  int *cnt, *ltok, *tsl;
  unsigned* bar;
  int ph_lo, ph_hi;
};

typedef const Params __attribute__((address_space(4))) * KP;

__device__ __forceinline__ int modrow(int t) { return t < NL ? (t >> 11) : 8; }
__device__ __forceinline__ float silu_f(float x) { return x / (1.f + expf(-x)); }
__device__ __forceinline__ float sigm_f(float x) { return 1.f / (1.f + expf(-x)); }
__device__ __forceinline__ float softplus_f(float x) { return fmaxf(x, 0.f) + log1pf(expf(-fabsf(x))); }
template <int CTRL>
__device__ __forceinline__ float dppx(float x) {
  return __int_as_float(__builtin_amdgcn_update_dpp(0, __float_as_int(x), CTRL, 0xf, 0xf, true));
}
__device__ __forceinline__ float rdlane(float v, int l) {
  return __int_as_float(__builtin_amdgcn_readlane(__float_as_int(v), l));
}
__device__ __forceinline__ float wsum(float v) {
  v += dppx<0xB1>(v); v += dppx<0x4E>(v); v += dppx<0x141>(v); v += dppx<0x140>(v);
  return (rdlane(v, 0) + rdlane(v, 16)) + (rdlane(v, 32) + rdlane(v, 48));
}
__device__ __forceinline__ float wmax(float v) {
  v = fmaxf(v, dppx<0xB1>(v)); v = fmaxf(v, dppx<0x4E>(v)); v = fmaxf(v, dppx<0x141>(v)); v = fmaxf(v, dppx<0x140>(v));
  return fmaxf(fmaxf(rdlane(v, 0), rdlane(v, 16)), fmaxf(rdlane(v, 32), rdlane(v, 48)));
}
__device__ __forceinline__ int opaque_tid() {
  int t = threadIdx.x;
  asm volatile("" : "+v"(t));
  return t;
}
typedef __bf16 bf16x2_t __attribute__((ext_vector_type(2)));
typedef float f32x2_t __attribute__((ext_vector_type(2)));
__device__ __forceinline__ unsigned pk_bf16(float lo, float hi) {
  const f32x2_t v = {lo, hi};
  return __builtin_bit_cast(unsigned, __builtin_convertvector(v, bf16x2_t));
}
__device__ __forceinline__ bf16_t f2bf(float x) { return (bf16_t)(pk_bf16(x, 0.f) & 0xffffu); }
__device__ __forceinline__ float bf2f(bf16_t v) { return __uint_as_float((unsigned)v << 16); }
__device__ __forceinline__ float bflo(unsigned u) { return __uint_as_float(u << 16); }
__device__ __forceinline__ float bfhi(unsigned u) { return __uint_as_float(u & 0xffff0000u); }
__device__ __forceinline__ int scan_row(int dir, int b, int tau) {
  if (tau < CTXL) return NL + b * CTXL + (dir ? (CTXL - 1 - tau) : tau);
  int s = tau - CTXL;
  return b * SEQ + (dir ? (SEQ - 1 - s) : s);
}

template <class RowPtrA>
__device__ __forceinline__ void gemm128_main(int tid, RowPtrA rowA, const bf16_t* __restrict__ Bt, int K, int n0,
                                             char* lds, f32x16 (&acc)[2][2]) {
  const int lane = tid & 63, w = tid >> 6;
  const int wm = w >> 1, wn = w & 1, r = lane & 31, h = lane >> 5;
  const int c = tid & 7, sr = tid >> 3;
  const int lc = (c ^ ((tid >> 4) & 7)) * 8;
  const bf16_t* ap[4];
#pragma unroll
  for (int i = 0; i < 4; ++i) ap[i] = rowA(sr + 32 * i) + lc;
  const bf16_t* bp0 = Bt + (size_t)(n0 + sr) * K + lc;
  const int bstr = 32 * K;
#pragma unroll
  for (int mi = 0; mi < 2; ++mi)
#pragma unroll
    for (int ni = 0; ni < 2; ++ni)
#pragma unroll
      for (int q = 0; q < 16; ++q) acc[mi][ni][q] = 0.f;
  const int nk = K >> 6;
  auto issue = [&](int kt) {
    char* As = lds + (kt & 1) * 32768 + tid * 16;
    const int k0 = kt * 64;
#pragma unroll
    for (int i = 0; i < 4; ++i) {
      __builtin_amdgcn_global_load_lds((const unsigned*)(ap[i] + k0), (__attribute__((address_space(3))) unsigned*)(As + i * 4096), 16, 0, 0);
      __builtin_amdgcn_global_load_lds((const unsigned*)(bp0 + i * bstr + k0), (__attribute__((address_space(3))) unsigned*)(As + 16384 + i * 4096), 16, 0, 0);
    }
  };
  issue(0);
  const int sw = (r >> 1) & 7;
#pragma unroll 1
  for (int kt = 0; kt < nk; ++kt) {
    asm volatile("s_waitcnt vmcnt(0)" ::: "memory");
    __syncthreads();
    if (kt + 1 < nk) issue(kt + 1);
    const char* As = lds + (kt & 1) * 32768;
    const char* Ar = As + (wm * 64 + r) * 128;
    const char* Br = As + 16384 + (wn * 64 + r) * 128;
#pragma unroll
    for (int ks = 0; ks < 4; ++ks) {
      const int off = ((ks * 2 + h) ^ sw) * 16;
      const bf16x8 a0 = *(const bf16x8*)(Ar + off);
      const bf16x8 a1 = *(const bf16x8*)(Ar + 32 * 128 + off);
      const bf16x8 b0 = *(const bf16x8*)(Br + off);
      const bf16x8 b1 = *(const bf16x8*)(Br + 32 * 128 + off);
      acc[0][0] = __builtin_amdgcn_mfma_f32_32x32x16_bf16(a0, b0, acc[0][0], 0, 0, 0);
      acc[0][1] = __builtin_amdgcn_mfma_f32_32x32x16_bf16(a0, b1, acc[0][1], 0, 0, 0);
      acc[1][0] = __builtin_amdgcn_mfma_f32_32x32x16_bf16(a1, b0, acc[1][0], 0, 0, 0);
      acc[1][1] = __builtin_amdgcn_mfma_f32_32x32x16_bf16(a1, b1, acc[1][1], 0, 0, 0);
    }
  }
  __syncthreads();
}
using i64 = long;
template <class RowPtrA8>
__device__ __forceinline__ void gemm128_fp8(int tid, RowPtrA8 rowA, const unsigned char* __restrict__ Bt, int K, int n0,
                                            char* lds, f32x16 (&acc)[2][2]) {
  const int lane = tid & 63, w = tid >> 6;
  const int wm = w >> 1, wn = w & 1, r = lane & 31, h = lane >> 5;
  const int c = tid & 7, sr = tid >> 3;
  const int lc = (c ^ ((tid >> 4) & 7)) * 16;
  const unsigned char* ap[4];
#pragma unroll
  for (int i = 0; i < 4; ++i) ap[i] = rowA(sr + 32 * i) + lc;
  const unsigned char* bp0 = Bt + (size_t)(n0 + sr) * K + lc;
  const int bstr = 32 * K;
#pragma unroll
  for (int mi = 0; mi < 2; ++mi)
#pragma unroll
    for (int ni = 0; ni < 2; ++ni)
#pragma unroll
      for (int q = 0; q < 16; ++q) acc[mi][ni][q] = 0.f;
  const int nk = K >> 7;
  auto issue = [&](int kt) {
    char* As = lds + (kt & 1) * 32768 + tid * 16;
    const int k0 = kt * 128;
#pragma unroll
    for (int i = 0; i < 4; ++i) {
      __builtin_amdgcn_global_load_lds((const unsigned*)(ap[i] + k0), (__attribute__((address_space(3))) unsigned*)(As + i * 4096), 16, 0, 0);
      __builtin_amdgcn_global_load_lds((const unsigned*)(bp0 + i * bstr + k0), (__attribute__((address_space(3))) unsigned*)(As + 16384 + i * 4096), 16, 0, 0);
    }
  };
  issue(0);
  const int sw = (r >> 1) & 7;
#pragma unroll 1
  for (int kt = 0; kt < nk; ++kt) {
    asm volatile("s_waitcnt vmcnt(0)" ::: "memory");
    __syncthreads();
    if (kt + 1 < nk) issue(kt + 1);
    const char* As = lds + (kt & 1) * 32768;
    const char* Ar = As + (wm * 64 + r) * 128;
    const char* Br = As + 16384 + (wn * 64 + r) * 128;
#pragma unroll
    for (int q = 0; q < 4; ++q) {
      const int off = ((q * 2 + h) ^ sw) * 16;
      const u32x4 a0 = *(const u32x4*)(Ar + off);
      const u32x4 a1 = *(const u32x4*)(Ar + 32 * 128 + off);
      const u32x4 b0 = *(const u32x4*)(Br + off);
      const u32x4 b1 = *(const u32x4*)(Br + 32 * 128 + off);
      const i64 a0l = (i64)(((unsigned long long)a0.y << 32) | a0.x), a0h = (i64)(((unsigned long long)a0.w << 32) | a0.z);
      const i64 a1l = (i64)(((unsigned long long)a1.y << 32) | a1.x), a1h = (i64)(((unsigned long long)a1.w << 32) | a1.z);
      const i64 b0l = (i64)(((unsigned long long)b0.y << 32) | b0.x), b0h = (i64)(((unsigned long long)b0.w << 32) | b0.z);
      const i64 b1l = (i64)(((unsigned long long)b1.y << 32) | b1.x), b1h = (i64)(((unsigned long long)b1.w << 32) | b1.z);
      acc[0][0] = __builtin_amdgcn_mfma_f32_32x32x16_fp8_fp8(a0l, b0l, acc[0][0], 0, 0, 0);
      acc[0][1] = __builtin_amdgcn_mfma_f32_32x32x16_fp8_fp8(a0l, b1l, acc[0][1], 0, 0, 0);
      acc[1][0] = __builtin_amdgcn_mfma_f32_32x32x16_fp8_fp8(a1l, b0l, acc[1][0], 0, 0, 0);
      acc[1][1] = __builtin_amdgcn_mfma_f32_32x32x16_fp8_fp8(a1l, b1l, acc[1][1], 0, 0, 0);
      acc[0][0] = __builtin_amdgcn_mfma_f32_32x32x16_fp8_fp8(a0h, b0h, acc[0][0], 0, 0, 0);
      acc[0][1] = __builtin_amdgcn_mfma_f32_32x32x16_fp8_fp8(a0h, b1h, acc[0][1], 0, 0, 0);
      acc[1][0] = __builtin_amdgcn_mfma_f32_32x32x16_fp8_fp8(a1h, b0h, acc[1][0], 0, 0, 0);
      acc[1][1] = __builtin_amdgcn_mfma_f32_32x32x16_fp8_fp8(a1h, b1h, acc[1][1], 0, 0, 0);
    }
  }
  __syncthreads();
}
template <class F>
__device__ __forceinline__ void acc_foreach(int tid, const f32x16 (&acc)[2][2], F f) {
  const int lane = tid & 63, w = tid >> 6;
  const int wm = w >> 1, wn = w & 1, r = lane & 31, h = lane >> 5;
#pragma unroll
  for (int mi = 0; mi < 2; ++mi)
#pragma unroll
    for (int ni = 0; ni < 2; ++ni)
#pragma unroll
      for (int q = 0; q < 16; ++q) {
        const int row = wm * 64 + mi * 32 + (q & 3) + 8 * (q >> 2) + 4 * h;
        const int col = wn * 64 + ni * 32 + r;
        f(row, col, acc[mi][ni][q]);
        if ((q & 3) == 3) __builtin_amdgcn_sched_barrier(0);
      }
}

template <class RM>
__device__ __forceinline__ void tr_tile(int tid, const float* __restrict__ src, int N, int k0, int n0,
                                        bf16_t* __restrict__ dst, int K, RM rowmap, float* tile) {
  {
    const int tx = tid & 15, ty = tid >> 4;
    const int n = n0 + tx * 4;
#pragma unroll
    for (int i = 0; i < 4; ++i) {
      const int k = ty + 16 * i;
      float4 v = make_float4(0.f, 0.f, 0.f, 0.f);
      if (n < N) v = *(const float4*)(src + (size_t)(k0 + k) * N + n);
      tile[k * 65 + tx * 4 + 0] = v.x; tile[k * 65 + tx * 4 + 1] = v.y;
      tile[k * 65 + tx * 4 + 2] = v.z; tile[k * 65 + tx * 4 + 3] = v.w;
    }
  }
  __syncthreads();
  {
    const int kc = tid & 7;
#pragma unroll
    for (int i = 0; i < 2; ++i) {
      const int n = (tid >> 3) + 32 * i;
      if (n0 + n < N) {
        float v[8];
#pragma unroll
        for (int q = 0; q < 8; ++q) v[q] = tile[(kc * 8 + q) * 65 + n];
        u32x4 o;
        o.x = pk_bf16(v[0], v[1]); o.y = pk_bf16(v[2], v[3]); o.z = pk_bf16(v[4], v[5]); o.w = pk_bf16(v[6], v[7]);
        *(u32x4*)(dst + (size_t)rowmap(n0 + n) * K + k0 + kc * 8) = o;
      }
    }
  }
  __syncthreads();
}

constexpr float W8_SCALE = 32.f, W8_INV = 1.f / 32.f;
__device__ __forceinline__ unsigned pk_fp8x4(float a, float b, float c, float d) {
  int r = __builtin_amdgcn_cvt_pk_fp8_f32(a, b, 0, false);
  r = __builtin_amdgcn_cvt_pk_fp8_f32(c, d, r, true);
  return (unsigned)r;
}
template <class RM>
__device__ __forceinline__ void tr_tile_fp8(int tid, const float* __restrict__ src, int N, int k0, int n0,
                                            unsigned char* __restrict__ dst, int K, RM rowmap, float* tile) {
  {
    const int tx = tid & 15, ty = tid >> 4;
    const int n = n0 + tx * 4;
#pragma unroll
    for (int i = 0; i < 4; ++i) {
      const int k = ty + 16 * i;
      const float4 v = *(const float4*)(src + (size_t)(k0 + k) * N + n);
      tile[k * 65 + tx * 4 + 0] = v.x; tile[k * 65 + tx * 4 + 1] = v.y;
      tile[k * 65 + tx * 4 + 2] = v.z; tile[k * 65 + tx * 4 + 3] = v.w;
    }
  }
  __syncthreads();
  {
    const int kc = tid & 3, n = tid >> 2;
    float v[16];
#pragma unroll
    for (int q = 0; q < 16; ++q) v[q] = tile[(kc * 16 + q) * 65 + n] * W8_SCALE;
    u32x4 o;
    o.x = pk_fp8x4(v[0], v[1], v[2], v[3]); o.y = pk_fp8x4(v[4], v[5], v[6], v[7]);
    o.z = pk_fp8x4(v[8], v[9], v[10], v[11]); o.w = pk_fp8x4(v[12], v[13], v[14], v[15]);
    *(u32x4*)(dst + (size_t)rowmap(n0 + n) * K + k0 + kc * 16) = o;
  }
  __syncthreads();
}

constexpr int CJ0 = 1152, CJ1 = CJ0 + 2080, CJ2 = CJ1 + 1024, CJ3 = CJ2 + 33280, CJ4 = CJ3 + 16640;
__device__ void convert_job(KP p, int job, float* sm, int tid) {
  if (job < CJ0) {
    const int j = job / 576, rem = job % 576, kt = rem / 36, nt = rem % 36;
    tr_tile(tid, p->att_w_in + (size_t)j * 1024 * ATT_N, ATT_N, kt * 64, nt * 64, p->Wt_att + (size_t)j * ATT_N * 1024,
            1024, [](int n) { return n; }, sm);
  } else if (job < CJ1) {
    const int q = job - CJ0;
    const int j = q / 1040, rem = q % 1040, kt = rem / 65, nt = rem % 65;
    tr_tile(tid, p->rec_w_in + (size_t)j * 1024 * REC_N, REC_N, kt * 64, nt * 64, p->Wt_rec + (size_t)j * REC_NP * 1024,
            1024, [](int n) { return n; }, sm);
  } else if (job < CJ2) {
    const int q = job - CJ1;
    const int i = q >> 8, rem = q & 255, kt = rem >> 4, nt = rem & 15;
    tr_tile(tid, p->mix_w_out + (size_t)i * 1024 * 1024, 1024, kt * 64, nt * 64, p->Wt_out + (size_t)i * 1024 * 1024,
            1024, [](int n) { return n; }, sm);
  } else if (job < CJ3) {
    const int q = job - CJ2;
    const int le = q >> 7, rem = q & 127;
    const int which = rem >> 6, kt = (rem >> 2) & 15, nt = rem & 3;
    const int layer = le / 65, e = le % 65;
    const float* src;
    if (e < 64) src = (which ? p->moe_w3 : p->moe_w1) + (size_t)(layer * 64 + e) * 1024 * 256;
    else src = (which ? p->shared_w3 : p->shared_w1) + (size_t)layer * 1024 * 256;
    tr_tile_fp8(tid, src, 256, kt * 64, nt * 64, (unsigned char*)p->Wt13 + (size_t)le * 512 * 1024, 1024,
                [which](int n) { return 64 * (n >> 5) + which * 32 + (n & 31); }, sm);
  } else {
    const int q = job - CJ3;
    const int le = q >> 6, rem = q & 63;
    const int kt = rem >> 4, nt = rem & 15;
    const int layer = le / 65, e = le % 65;
    const float* src = e < 64 ? p->moe_w2 + (size_t)(layer * 64 + e) * 256 * 1024 : p->shared_w2 + (size_t)layer * 256 * 1024;
    tr_tile_fp8(tid, src, 1024, kt * 64, nt * 64, (unsigned char*)p->Wt2 + (size_t)le * 1024 * 256, 256, [](int n) { return n; }, sm);
  }
}
__device__ __forceinline__ int conv_stage_total(int stage) {
  return stage == 0 ? (576 + 1040 + 512 + 8320 + 4160) : (stage == 1 ? (576 + 1040 + 256 + 16640 + 8320) : (256 + 8320 + 4160));
}
__device__ __forceinline__ int conv_stage_job(int stage, int q) {
  if (stage == 0) {
    if (q < 8320) return CJ2 + q;  q -= 8320;
    if (q < 4160) return CJ3 + q;  q -= 4160;
    if (q < 576) return q;  q -= 576;
    if (q < 1040) return CJ0 + q;  q -= 1040;
    return CJ1 + q;
  } else if (stage == 1) {
    if (q < 8320) return CJ2 + 8320 + q;  q -= 8320;
    if (q < 4160) return CJ3 + 4160 + q;  q -= 4160;
    if (q < 576) return 576 + q;  q -= 576;
    if (q < 256) return CJ1 + 512 + q;  q -= 256;
    if (q < 8320) return CJ2 + 16640 + q;  q -= 8320;
    if (q < 4160) return CJ3 + 8320 + q;  q -= 4160;
    return CJ0 + 1040 + q;
  }
  if (q < 256) return CJ1 + 768 + q;  q -= 256;
  if (q < 8320) return CJ2 + 24960 + q;  q -= 8320;
  return CJ3 + 12480 + q;
}

struct CvDesc { const float* src; unsigned char* dst; int N, K, k0, n0, which; };
__device__ __forceinline__ bool conv_desc_fp8(KP p, int job, CvDesc& d) {
  if (job < CJ2) return false;
  if (job < CJ3) {
    const int q = job - CJ2;
    const int le = q >> 7, rem = q & 127;
    const int which = rem >> 6, kt = (rem >> 2) & 15, nt = rem & 3;
    const int layer = le / 65, e = le % 65;
    if (e < 64) d.src = (which ? p->moe_w3 : p->moe_w1) + (size_t)(layer * 64 + e) * 1024 * 256;
    else d.src = (which ? p->shared_w3 : p->shared_w1) + (size_t)layer * 1024 * 256;
    d.dst = (unsigned char*)p->Wt13 + (size_t)le * 512 * 1024;
    d.N = 256; d.K = 1024; d.k0 = kt * 64; d.n0 = nt * 64; d.which = which;
  } else {
    const int q = job - CJ3;
    const int le = q >> 6, rem = q & 63;
    const int kt = rem >> 4, nt = rem & 15;
    const int layer = le / 65, e = le % 65;
    d.src = e < 64 ? p->moe_w2 + (size_t)(layer * 64 + e) * 256 * 1024 : p->shared_w2 + (size_t)layer * 256 * 1024;
    d.dst = (unsigned char*)p->Wt2 + (size_t)le * 1024 * 256;
    d.N = 1024; d.K = 256; d.k0 = kt * 64; d.n0 = nt * 64; d.which = -1;
  }
  return true;
}
typedef float cvf4 __attribute__((ext_vector_type(4)));
__device__ __forceinline__ void cv_load(const CvDesc& d, int tid, cvf4& v0, cvf4& v1, cvf4& v2, cvf4& v3) {
  const int tx = tid & 15, ty = tid >> 4;
  const float* s0 = d.src + (size_t)(d.k0 + ty) * d.N + d.n0 + tx * 4;
  v0 = *(const cvf4*)(s0);
  v1 = *(const cvf4*)(s0 + (size_t)16 * d.N);
  v2 = *(const cvf4*)(s0 + (size_t)32 * d.N);
  v3 = *(const cvf4*)(s0 + (size_t)48 * d.N);
}
__device__ __forceinline__ void cv_emit(const CvDesc& d, int tid, const cvf4 v0, const cvf4 v1, const cvf4 v2, const cvf4 v3, float* tile) {
  {
    const int tx = tid & 15, ty = tid >> 4;
    float* t0 = tile + ty * 65 + tx * 4;
    t0[0] = v0.x; t0[1] = v0.y; t0[2] = v0.z; t0[3] = v0.w;
    t0[16 * 65 + 0] = v1.x; t0[16 * 65 + 1] = v1.y; t0[16 * 65 + 2] = v1.z; t0[16 * 65 + 3] = v1.w;
    t0[32 * 65 + 0] = v2.x; t0[32 * 65 + 1] = v2.y; t0[32 * 65 + 2] = v2.z; t0[32 * 65 + 3] = v2.w;
    t0[48 * 65 + 0] = v3.x; t0[48 * 65 + 1] = v3.y; t0[48 * 65 + 2] = v3.z; t0[48 * 65 + 3] = v3.w;
  }
  __syncthreads();
  {
    const int kc = tid & 3, n = tid >> 2;
    float v[16];
#pragma unroll
    for (int q = 0; q < 16; ++q) v[q] = tile[(kc * 16 + q) * 65 + n] * W8_SCALE;
    u32x4 o;
    o.x = pk_fp8x4(v[0], v[1], v[2], v[3]); o.y = pk_fp8x4(v[4], v[5], v[6], v[7]);
    o.z = pk_fp8x4(v[8], v[9], v[10], v[11]); o.w = pk_fp8x4(v[12], v[13], v[14], v[15]);
    const int nn = d.n0 + n;
    const int row = d.which >= 0 ? 64 * (nn >> 5) + d.which * 32 + (nn & 31) : nn;
    *(u32x4*)(d.dst + (size_t)row * d.K + d.k0 + kc * 16) = o;
  }
  __syncthreads();
}
__device__ __forceinline__ void convert_run(KP p, int stage, int jj, int j1, float* sm, int tid) {
  CvDesc d, dn;
  cvf4 a0, a1, a2, a3, b0, b1, b2, b3;
  bool cur = false;
#pragma unroll 1
  for (; jj < j1; ++jj) {
    const int job = conv_stage_job(stage, jj);
    if (!cur) {
      if (!conv_desc_fp8(p, job, d)) { convert_job(p, job, sm, tid); continue; }
      cv_load(d, tid, a0, a1, a2, a3);
    }
    bool nxt = false;
    if (jj + 1 < j1) {
      nxt = conv_desc_fp8(p, conv_stage_job(stage, jj + 1), dn);
      if (nxt) cv_load(dn, tid, b0, b1, b2, b3);
    }
    cv_emit(d, tid, a0, a1, a2, a3, sm);
    if (nxt) { d = dn; a0 = b0; a1 = b1; a2 = b2; a3 = b3; }
    cur = nxt;
  }
}

__device__ void ph_init(KP p, char* smc) {
  float* sm = (float*)smc;
  const int tid = opaque_tid();
  {
    const size_t n4a = (size_t)NL * DM / 4, n4b = (size_t)NC * DM / 4;
    const float4* xs = (const float4*)p->x;
    const float4* cs = (const float4*)p->ctx;
    float4* X4 = (float4*)p->X;
    for (size_t i = (size_t)blockIdx.x * NTHR + tid; i < n4a + n4b; i += (size_t)gridDim.x * NTHR)
      X4[i] = i < n4a ? xs[i] : cs[i - n4a];
  }
  for (int tile = blockIdx.x; tile < 96 * 8; tile += gridDim.x) {
    const int ct = tile >> 3, ks = tile & 7;
    for (int i = tid; i < 9 * 128; i += NTHR) {
      const int r = i >> 7, k = ks * 128 + (i & 127);
      const float v = r < 8 ? p->c[r * 1024 + k] : p->c_ctx[k];
      sm[i] = silu_f(v);
    }
    __syncthreads();
    const int col = ct * 256 + tid;
    const int layer = col / 6144, n = col % 6144;
    const float* W = p->ada_w + ((size_t)layer * 1024 + ks * 128) * 6144 + n;
    float acc[9];
#pragma unroll
    for (int r = 0; r < 9; ++r) acc[r] = 0.f;
#pragma unroll 4
    for (int k = 0; k < 128; ++k) {
      const float w = W[(size_t)k * 6144];
#pragma unroll
      for (int r = 0; r < 9; ++r) acc[r] = fmaf(sm[r * 128 + k], w, acc[r]);
    }
#pragma unroll
    for (int r = 0; r < 9; ++r) p->MODP[((size_t)(ks * 4 + layer) * 9 + r) * 6144 + n] = acc[r];
    __syncthreads();
  }
  {
    const int total = conv_stage_total(0), chunk = (total + gridDim.x - 1) / gridDim.x;
    const int lo = min((int)blockIdx.x * chunk, total), hi = min(lo + chunk, total);
    __syncthreads();
    convert_run(p, 0, lo, hi, sm, tid);
  }
  for (int i = blockIdx.x * NTHR + tid; i < 2 * 3 * 128 * 512; i += gridDim.x * NTHR) {
    const int k = i & 511, n = (i >> 9) & 127, wj = i >> 16;
    const int j = wj / 3, which = wj % 3;
    float v = 0.f;
    if (which < 2) {
      if (n < 64) v = (which ? p->rwkv_a1 : p->rwkv_w1)[((size_t)(j * 2 + (n >> 5)) * 512 + k) * 32 + (n & 31)];
    } else if (n < 96) v = p->rwkv_g1[((size_t)j * 512 + k) * 96 + n];
    p->Wl1[i] = f2bf(v);
  }
  for (int i = blockIdx.x * NTHR + tid; i < 2 * 2560 * 128; i += gridDim.x * NTHR) {
    const int k = i & 127, n = (i >> 7) % 2560, j = i / (2560 * 128);
    float v = 0.f;
    if (n < 2048) {
      const int d = (n >> 9) & 1, c = n & 511;
      if (k < 64 && (k >> 5) == d) v = (n < 1024 ? p->rwkv_w2 : p->rwkv_a2)[((size_t)(j * 2 + d) * 32 + (k & 31)) * 512 + c];
    } else if (k < 96) v = p->rwkv_g2[((size_t)j * 96 + k) * 512 + (n - 2048)];
    p->Wl2[i] = f2bf(v);
  }
  for (int i = blockIdx.x * NTHR + tid; i < 4 * 64 * 1024; i += gridDim.x * NTHR) {
    const int k = i & 1023, n = (i >> 10) & 63, l = i >> 16;
    p->WrT[i] = p->moe_router[((size_t)l * 1024 + k) * 64 + n];
  }
  for (int i = blockIdx.x * NTHR + tid; i < 64 * 16; i += gridDim.x * NTHR) {
    const int pos = i >> 4, f = i & 15;
    const float ang = (float)pos * powf(10000.f, -(float)f / 16.f);
    p->ROPE[2 * i] = cosf(ang);
    p->ROPE[2 * i + 1] = sinf(ang);
  }
}

__device__ void ph_mod_h(KP p, char* smc) {
  float* sm = (float*)smc;
  const int tid = opaque_tid();
  for (int i = blockIdx.x * NTHR + tid; i < 4 * 9 * 6144; i += gridDim.x * NTHR) {
    const int layer = i / (9 * 6144), rem = i % (9 * 6144), n = rem % 6144;
    float s = p->ada_b[layer * 6144 + n];
#pragma unroll
    for (int ks = 0; ks < 8; ++ks) s += p->MODP[(size_t)(ks * 4 + layer) * 9 * 6144 + rem];
    p->MOD[i] = s;
  }
  const int lane = tid & 63, wave = tid >> 6;
  const int per = (((NT + gridDim.x - 1) / gridDim.x) + 3) & ~3;
  const int t0 = blockIdx.x * per, t1 = min(NT, t0 + per);
  int cur = -1;
  for (int tb = t0; tb < t1; tb += 4) {
    const int mr = modrow(tb);
    if (mr != cur) {
      __syncthreads();
      for (int n = tid; n < 2048; n += NTHR) {
        float a = p->ada_b[n];
#pragma unroll
        for (int ks = 0; ks < 8; ++ks) a += p->MODP[((size_t)(ks * 4) * 9 + mr) * 6144 + n];
        sm[n] = a;
      }
      cur = mr;
      __syncthreads();
    }
    const int t = tb + wave;
    if (t < t1) {
      const float* src = t < NL ? p->x + (size_t)t * DM : p->ctx + (size_t)(t - NL) * DM;
#pragma unroll
      for (int i = 0; i < 4; ++i) {
        const int n = i * 256 + lane * 4;
        const float4 xv = *(const float4*)(src + n);
        const float4 sh = *(const float4*)(sm + n);
        const float4 sc = *(const float4*)(sm + 1024 + n);
        u32x2 o;
        o.x = pk_bf16(xv.x * (1.f + sc.x) + sh.x, xv.y * (1.f + sc.y) + sh.y);
        o.y = pk_bf16(xv.z * (1.f + sc.z) + sh.z, xv.w * (1.f + sc.w) + sh.w);
        *(u32x2*)(p->AB + (size_t)t * DM + n) = o;
      }
    }
  }
}

typedef short v4i16_t __attribute__((ext_vector_type(4)));
using s16x4 = __attribute__((ext_vector_type(4))) short;
__device__ __forceinline__ s16x4 vtr(const char* p) {
  return __builtin_bit_cast(s16x4, __builtin_amdgcn_ds_read_tr16_b64_v4i16((__attribute__((address_space(3))) v4i16_t*)p));
}
#define MFMA32(a, b, c) __builtin_amdgcn_mfma_f32_32x32x16_bf16(a, b, c, 0, 0, 0)
__device__ void ph_attention(KP p, int layer, bool keep, char* lds) {
  const int tid = opaque_tid();
  const int lane = tid & 63, w = tid >> 6, r32 = lane & 31, hi = lane >> 5;
  const int j = layer >> 1;
  float* bias_lds = (float*)(lds + 32768 + 1024);
  const int n_gqa = 1024, n_na = 1024, n_cb = keep ? 128 : 0, n_ca = keep ? 128 : 0;
  const int total = n_gqa + n_na + n_cb + n_ca;
  constexpr float LOG2E = 1.4426950408889634f;
  constexpr float C2 = 0.125f * LOG2E;
  const int c = tid & 7, sr = tid >> 3;
  const int kso = (c ^ ((tid >> 4) & 7)) * 16;
  const int vso = (c >> 2) * 4096 + (c & 3) * 16;
  const int sw = (r32 >> 1) & 7;
  for (int item = blockIdx.x; item < total; item += gridDim.x) {
    int b, qrow0, qoff, koff, voff, ocol, lat_tiles, lat_row0;
    bool na = false;
    int r_w = 0, start_w = 0, ru0 = 0, hN = 0;
    if (item < n_gqa) {
      b = item >> 7;
      const int g = (item >> 6) & 1, tt = item & 63;
      qrow0 = b * SEQ + tt * 32; qoff = 1536 + (g * 4 + w) * 64; koff = 2048 + g * 64; voff = 2176 + g * 64;
      ocol = 512 + (g * 4 + w) * 64; lat_tiles = 32; lat_row0 = b * SEQ;
    } else if (item < n_gqa + n_na) {
      const int it = item - n_gqa;
      b = it >> 7; hN = (it >> 4) & 7;
      const int rp = it & 15;
      na = true; r_w = 2 * rp + (w >> 1);
      qrow0 = b * SEQ + r_w * 64 + (w & 1) * 32; qoff = hN * 64; koff = 512 + hN * 64; voff = 1024 + hN * 64; ocol = hN * 64;
      const int s0 = min(max(2 * rp - 4, 0), 24), s1 = min(max(2 * rp - 3, 0), 24);
      start_w = (w >> 1) ? s1 : s0; ru0 = s0; lat_tiles = (s1 != s0) ? 9 : 8; lat_row0 = b * SEQ + ru0 * 64;
    } else if (item < n_gqa + n_na + n_cb) {
      const int it = item - n_gqa - n_na;
      b = it >> 4;
      const int g = (it >> 3) & 1, tt = it & 7;
      qrow0 = NL + b * CTXL + tt * 32; qoff = 1536 + (g * 4 + w) * 64; koff = 2048 + g * 64; voff = 2176 + g * 64;
      ocol = 512 + (g * 4 + w) * 64; lat_tiles = 0; lat_row0 = 0;
    } else {
      const int it = item - n_gqa - n_na - n_cb;
      b = it >> 4;
      const int h = (it >> 1) & 7, half = it & 1;
      qrow0 = NL + b * CTXL + half * 128 + w * 32; qoff = h * 64; koff = 512 + h * 64; voff = 1024 + h * 64; ocol = h * 64;
      lat_tiles = 0; lat_row0 = 0;
    }
    const int ctx_row0 = NL + b * CTXL, ntiles = lat_tiles + 4;
    if (na)
      for (int i = tid; i < 465; i += NTHR) bias_lds[i] = p->na_rpb[(j * 8 + hN) * 465 + i] * LOG2E;
    bf16x8 qf[4];
    {
      const bf16_t* qp = p->P + (size_t)(qrow0 + r32) * LDP + qoff + hi * 8;
#pragma unroll
      for (int d0 = 0; d0 < 4; ++d0) qf[d0] = *(const bf16x8*)(qp + d0 * 16);
    }
    f32x16 o0, o1;
#pragma unroll
    for (int q = 0; q < 16; ++q) { o0[q] = 0.f; o1[q] = 0.f; }
    float m = -INFINITY, l = 0.f;
    u32x4 kr0, kr1, vr0, vr1;
    auto gload = [&](int t) {
      const int row0 = t < lat_tiles ? lat_row0 + 64 * t : ctx_row0 + 64 * (t - lat_tiles);
      const bf16_t* base = p->P + (size_t)(row0 + sr) * LDP + c * 8;
      kr0 = *(const u32x4*)(base + koff); kr1 = *(const u32x4*)(base + (size_t)32 * LDP + koff);
      vr0 = *(const u32x4*)(base + voff); vr1 = *(const u32x4*)(base + (size_t)32 * LDP + voff);
    };
    auto swrite = [&](int buf) {
      char* Kb = lds + buf * 16384;
      char* Vb = Kb + 8192;
      *(u32x4*)(Kb + sr * 128 + kso) = kr0; *(u32x4*)(Kb + (sr + 32) * 128 + kso) = kr1;
      *(u32x4*)(Vb + vso + sr * 64) = vr0; *(u32x4*)(Vb + vso + (sr + 32) * 64) = vr1;
    };
    gload(0);
    swrite(0);
    for (int t = 0; t < ntiles; ++t) {
      __syncthreads();
      if (t + 1 < ntiles) gload(t + 1);
      const bool na_tile = na && t < lat_tiles;
      const int kr = ru0 + t;
      const bool part = !na_tile || (kr >= start_w && kr < start_w + 8);
      if (part) {
        const char* Ks = lds + (t & 1) * 16384;
        const char* Vs = Ks + 8192;
        f32x16 s0, s1;
#pragma unroll
        for (int q = 0; q < 16; ++q) { s0[q] = 0.f; s1[q] = 0.f; }
#pragma unroll
        for (int d0 = 0; d0 < 4; ++d0) {
          const int off = ((2 * d0 + hi) ^ sw) * 16;
          const bf16x8 k0 = *(const bf16x8*)(Ks + r32 * 128 + off);
          const bf16x8 k1 = *(const bf16x8*)(Ks + (32 + r32) * 128 + off);
          s0 = MFMA32(k0, qf[d0], s0);
          s1 = MFMA32(k1, qf[d0], s1);
        }
        float mx = -INFINITY;
        if (na_tile) {
          const int cq = (w & 1) * 32 + r32;
          const int c0 = min(max(cq - 8, 0), 48);
          const float* brow = bias_lds + (kr - r_w + 7) * 31 + (15 - cq);
#pragma unroll
          for (int q = 0; q < 16; ++q) {
            const int kc = (q & 3) + 8 * (q >> 2) + 4 * hi;
            const float v0 = ((unsigned)(kc - c0) < 16u) ? fmaf(s0[q], C2, brow[kc]) : -INFINITY;
            const float v1 = ((unsigned)(kc + 32 - c0) < 16u) ? fmaf(s1[q], C2, brow[kc + 32]) : -INFINITY;
            s0[q] = v0; s1[q] = v1;
            mx = fmaxf(mx, fmaxf(v0, v1));
          }
        } else {
#pragma unroll
          for (int q = 0; q < 16; ++q) {
            s0[q] *= C2; s1[q] *= C2;
            mx = fmaxf(mx, fmaxf(s0[q], s1[q]));
          }
        }
        {
          auto rr = __builtin_amdgcn_permlane32_swap(__float_as_uint(mx), __float_as_uint(mx), false, false);
          mx = fmaxf(__uint_as_float(rr[0]), __uint_as_float(rr[1]));
        }
        const float mnew = fmaxf(m, mx);
        const float alpha = __builtin_amdgcn_exp2f(m - mnew);
        float ls = 0.f;
#pragma unroll
        for (int q = 0; q < 16; ++q) {
          s0[q] = __builtin_amdgcn_exp2f(s0[q] - mnew);
          s1[q] = __builtin_amdgcn_exp2f(s1[q] - mnew);
          ls += s0[q] + s1[q];
        }
        l = l * alpha + ls;
        m = mnew;
#pragma unroll
        for (int q = 0; q < 16; ++q) { o0[q] *= alpha; o1[q] *= alpha; }
        bf16x8 pf[4];
#pragma unroll
        for (int s = 0; s < 4; ++s) {
          const int u = (s & 1) * 8;
          u32x4 tpk;
          if (s < 2) {
            tpk.x = pk_bf16(s0[u + 0], s0[u + 1]); tpk.y = pk_bf16(s0[u + 2], s0[u + 3]);
            tpk.z = pk_bf16(s0[u + 4], s0[u + 5]); tpk.w = pk_bf16(s0[u + 6], s0[u + 7]);
          } else {
            tpk.x = pk_bf16(s1[u + 0], s1[u + 1]); tpk.y = pk_bf16(s1[u + 2], s1[u + 3]);
            tpk.z = pk_bf16(s1[u + 4], s1[u + 5]); tpk.w = pk_bf16(s1[u + 6], s1[u + 7]);
          }
          pf[s] = __builtin_bit_cast(bf16x8, tpk);
        }
        const char* vb = Vs + ((lane >> 4) & 1) * 32 + (lane & 3) * 8 + ((lane & 15) >> 2) * 64 + hi * 256;
#pragma unroll
        for (int s = 0; s < 4; ++s) {
          const s16x4 a00 = vtr(vb + (16 * s) * 64), a01 = vtr(vb + (16 * s + 8) * 64);
          const s16x4 a10 = vtr(vb + 4096 + (16 * s) * 64), a11 = vtr(vb + 4096 + (16 * s + 8) * 64);
          const bf16x8 A0 = __builtin_shufflevector(a00, a01, 0, 1, 2, 3, 4, 5, 6, 7);
          const bf16x8 A1 = __builtin_shufflevector(a10, a11, 0, 1, 2, 3, 4, 5, 6, 7);
          o0 = MFMA32(A0, pf[s], o0);
          o1 = MFMA32(A1, pf[s], o1);
        }
      }
      if (t + 1 < ntiles) swrite((t + 1) & 1);
    }
    __syncthreads();
    const float lt = l + __shfl_xor(l, 32);
    const float inv = 1.f / lt;
    bf16_t* op = p->AB + (size_t)(qrow0 + r32) * DM + ocol + 4 * hi;
#pragma unroll
    for (int g = 0; g < 4; ++g) {
      u32x2 v0, v1;
      v0.x = pk_bf16(o0[4 * g] * inv, o0[4 * g + 1] * inv); v0.y = pk_bf16(o0[4 * g + 2] * inv, o0[4 * g + 3] * inv);
      v1.x = pk_bf16(o1[4 * g] * inv, o1[4 * g + 1] * inv); v1.y = pk_bf16(o1[4 * g + 2] * inv, o1[4 * g + 3] * inv);
      *(u32x2*)(op + 8 * g) = v0;
      *(u32x2*)(op + 32 + 8 * g) = v1;
    }
  }
}

__device__ void ph_rwkv_mix(KP p, int layer) {
  const int j = layer >> 1;
  const int tid = opaque_tid();
  const int lane = tid & 63, wave = tid >> 6;
  const float* mu = p->rwkv_mu + j * 6 * 512;
  const int c0 = lane * 8;
  auto unpack = [](const u32x4 u, float (&f)[8]) {
    f[0] = bflo(u.x); f[1] = bfhi(u.x); f[2] = bflo(u.y); f[3] = bfhi(u.y);
    f[4] = bflo(u.z); f[5] = bfhi(u.z); f[6] = bflo(u.w); f[7] = bfhi(u.w);
  };
  auto pack = [](const float (&f)[8]) {
    u32x4 o;
    o.x = pk_bf16(f[0], f[1]); o.y = pk_bf16(f[2], f[3]); o.z = pk_bf16(f[4], f[5]); o.w = pk_bf16(f[6], f[7]);
    return o;
  };
  for (int t = blockIdx.x * 4 + wave; t < NT; t += gridDim.x * 4) {
    bool hasp, hasn;
    if (t < NL) { int s = t & 2047; hasp = s > 0; hasn = s < SEQ - 1; }
    else { int s = (t - NL) & 255; hasp = s > 0; hasn = s < CTXL - 1; }
    const bf16_t* pt = p->P + (size_t)t * LDP + c0;
    bf16_t* rw = p->RW + (size_t)t * RWS + c0;
    bf16_t* zb = p->Zb + (size_t)t * 1536 + c0;
    const u32x4 zero = {0u, 0u, 0u, 0u};
#pragma unroll
    for (int q = 0; q < 4; ++q) {
      float cur[8], pv[8], nx[8], d[8];
      unpack(*(const u32x4*)(pt + q * 512), cur);
      unpack(hasp ? *(const u32x4*)(pt + q * 512 - LDP) : zero, pv);
      unpack(hasn ? *(const u32x4*)(pt + q * 512 + LDP) : zero, nx);
#pragma unroll
      for (int e = 0; e < 8; ++e) d[e] = 0.5f * (pv[e] + nx[e]) - cur[e];
      if (q < 3) {
        float o[8];
        const float* m = mu + q * 512 + c0;
#pragma unroll
        for (int e = 0; e < 8; ++e) o[e] = cur[e] + d[e] * m[e];
        if (q == 0) *(u32x4*)(rw) = pack(o);
        else if (q == 2) *(u32x4*)(rw + 512) = pack(o);
        else {
          *(u32x4*)(rw + 10 * 512) = pack(o);
          float kk[8], ss = 0.f;
          const float* kv0 = p->rwkv_kvec + (j * 2 + 0) * 512 + c0;
#pragma unroll
          for (int e = 0; e < 8; ++e) { kk[e] = o[e] * kv0[e]; ss += kk[e] * kk[e]; }
          ss += dppx<0xB1>(ss); ss += dppx<0x4E>(ss); ss += dppx<0x141>(ss);
          const float rn = rsqrtf(fmaxf(ss, 1e-24f));
#pragma unroll
          for (int e = 0; e < 8; ++e) kk[e] *= rn;
          *(u32x4*)(rw + 2 * 512) = pack(kk);
        }
      } else {
#pragma unroll
        for (int z = 0; z < 3; ++z) {
          float o[8];
          const float* m = mu + (3 + z) * 512 + c0;
#pragma unroll
          for (int e = 0; e < 8; ++e) o[e] = cur[e] + d[e] * m[e];
          *(u32x4*)(zb + z * 512) = pack(o);
        }
      }
    }
  }
}

constexpr int RS_STEP = 384;
constexpr int RS_TB = 16;
struct RwkvStage { u32x2 r, kk, e, ke, a, v; };
__device__ void rwkv_unit(KP p, int unit, float* sm, int tid) {
  const int ch = unit >> 1, hf = unit & 1;
  const int dir = ch >> 6, b = (ch >> 3) & 7, h = ch & 7;
  const int lane = tid & 63, w = tid >> 6, rl = lane >> 3, ks = lane & 7;
  float* ybuf = sm + 2 * RS_TB * RS_STEP;
  const int ss = tid >> 4, kq = tid & 15;
  auto gload = [&](int n, RwkvStage& g) {
    const int row = scan_row(dir, b, n * RS_TB + ss);
    const bf16_t* base = p->RW + (size_t)row * RWS + h * 64 + kq * 4;
    g.r = *(const u32x2*)(base);
    g.kk = *(const u32x2*)(base + 2 * 512);
    g.e = *(const u32x2*)(base + (3 + dir) * 512);
    g.ke = *(const u32x2*)(base + (5 + dir) * 512);
    g.a = *(const u32x2*)(base + (7 + dir) * 512);
    g.v = *(const u32x2*)(p->RW + (size_t)row * RWS + 512 + h * 64 + hf * 32 + (kq & 7) * 4);
  };
  auto swrite = [&](int buf, const RwkvStage& g) {
    float* sp = sm + (buf * RS_TB + ss) * RS_STEP;
    const float r0 = bflo(g.r.x), r1 = bfhi(g.r.x), r2 = bflo(g.r.y), r3 = bfhi(g.r.y);
    const float k0 = bflo(g.kk.x), k1 = bfhi(g.kk.x), k2 = bflo(g.kk.y), k3 = bfhi(g.kk.y);
    const float w0 = __expf(-bflo(g.e.x)), w1 = __expf(-bfhi(g.e.x)), w2 = __expf(-bflo(g.e.y)), w3 = __expf(-bfhi(g.e.y));
    const float e0 = bflo(g.ke.x), e1 = bfhi(g.ke.x), e2 = bflo(g.ke.y), e3 = bfhi(g.ke.y);
    const float a0 = k0 * bflo(g.a.x), a1 = k1 * bfhi(g.a.x), a2 = k2 * bflo(g.a.y), a3 = k3 * bfhi(g.a.y);
    *(float4*)(sp + kq * 4) = make_float4(k0, k1, k2, k3);
    *(float4*)(sp + 64 + kq * 4) = make_float4(w0 * r0, w1 * r1, w2 * r2, w3 * r3);
    *(float4*)(sp + 128 + kq * 4) = make_float4(w0, w1, w2, w3);
    *(float4*)(sp + 192 + kq * 4) = make_float4(a0, a1, a2, a3);
    *(float4*)(sp + 256 + kq * 4) = make_float4(e0, e1, e2, e3);
    if (kq < 8) *(float4*)(sp + 320 + kq * 4) = make_float4(bflo(g.v.x), bfhi(g.v.x), bflo(g.v.y), bfhi(g.v.y));
    float c1 = a0 * r0 + a1 * r1 + a2 * r2 + a3 * r3;
    float c2 = e0 * r0 + e1 * r1 + e2 * r2 + e3 * r3;
    c1 += dppx<0xB1>(c1); c2 += dppx<0xB1>(c2);
    c1 += dppx<0x4E>(c1); c2 += dppx<0x4E>(c2);
    c1 += dppx<0x141>(c1); c2 += dppx<0x141>(c2);
    c1 += dppx<0x140>(c1); c2 += dppx<0x140>(c2);
    if (kq == 0) { sp[352] = c1; sp[353] = c2; }
  };
  typedef float f2 __attribute__((ext_vector_type(2)));
  f2 S01 = {0.f, 0.f}, S23 = {0.f, 0.f}, S45 = {0.f, 0.f}, S67 = {0.f, 0.f};
  auto compute = [&](int n) {
    const float* bp = sm + (n & 1) * RS_TB * RS_STEP;
    float* yb = ybuf + (n & 1) * RS_TB * 32 + w * 8 + rl;
    struct Ops { f2 k[4], r[4], w[4], a[4], e[4]; float vv; f2 c; };
    auto ld = [&](int s, Ops& o) {
      const float* sq = bp + s * RS_STEP;
      const f2* sp = (const f2*)(sq + ks * 8);
#pragma unroll
      for (int i = 0; i < 4; ++i) { o.k[i] = sp[i]; o.r[i] = sp[32 + i]; o.w[i] = sp[64 + i]; o.a[i] = sp[96 + i]; o.e[i] = sp[128 + i]; }
      o.vv = sq[320 + w * 8 + rl]; o.c = *(const f2*)(sq + 352);
    };
    auto step = [&](const Ops& o) -> float {
      f2 sa2 = S01 * o.k[0];
      f2 y2 = S01 * o.r[0];
      sa2 = __builtin_elementwise_fma(S23, o.k[1], sa2); y2 = __builtin_elementwise_fma(S23, o.r[1], y2);
      sa2 = __builtin_elementwise_fma(S45, o.k[2], sa2); y2 = __builtin_elementwise_fma(S45, o.r[2], y2);
      sa2 = __builtin_elementwise_fma(S67, o.k[3], sa2); y2 = __builtin_elementwise_fma(S67, o.r[3], y2);
      float sa = sa2.x + sa2.y, y0 = y2.x + y2.y;
      sa += dppx<0xB1>(sa); y0 += dppx<0xB1>(y0);
      sa += dppx<0x4E>(sa); y0 += dppx<0x4E>(y0);
      sa += dppx<0x141>(sa); y0 += dppx<0x141>(y0);
      sa = -sa;
      const f2 sav = {sa, sa}, vvv = {o.vv, o.vv};
      S01 = __builtin_elementwise_fma(vvv, o.e[0], __builtin_elementwise_fma(sav, o.a[0], S01 * o.w[0]));
      S23 = __builtin_elementwise_fma(vvv, o.e[1], __builtin_elementwise_fma(sav, o.a[1], S23 * o.w[1]));
      S45 = __builtin_elementwise_fma(vvv, o.e[2], __builtin_elementwise_fma(sav, o.a[2], S45 * o.w[2]));
      S67 = __builtin_elementwise_fma(vvv, o.e[3], __builtin_elementwise_fma(sav, o.a[3], S67 * o.w[3]));
      return fmaf(o.vv, o.c.y, fmaf(sa, o.c.x, y0));
    };
    Ops oa, ob;
    ld(0, oa);
#pragma unroll 1
    for (int s = 0; s < RS_TB; s += 2) {
      __builtin_amdgcn_sched_barrier(0);
      ld(s + 1, ob);
      __builtin_amdgcn_sched_barrier(0);
      float y0 = step(oa);
      asm volatile("" : "+v"(y0));
      __builtin_amdgcn_sched_barrier(0);
      ld(s + 2, oa);
      __builtin_amdgcn_sched_barrier(0);
      float y1 = step(ob);
      asm volatile("" : "+v"(y1));
      __builtin_amdgcn_sched_barrier(0);
      if (ks == 0) { yb[s * 32] = y0; yb[(s + 1) * 32] = y1; }
    }
  };
  auto yout = [&](int n) {
    const int row = scan_row(dir, b, n * RS_TB + ss);
    const float* ys = ybuf + (n & 1) * RS_TB * 32 + ss * 32 + kq * 2;
    *(unsigned*)(p->P + (size_t)row * LDP + dir * 512 + h * 64 + hf * 32 + kq * 2) = pk_bf16(ys[0], ys[1]);
  };
  constexpr int NB = TSC / RS_TB;
  RwkvStage gA, gB;
  gload(0, gA);
  gload(1, gB);
  swrite(0, gA);
  gload(2, gA);
  __syncthreads();
  for (int n = 0; n < NB; n += 2) {
    compute(n);
    swrite(1, gB);
    if (n + 3 < NB) gload(n + 3, gB);
    __syncthreads();
    yout(n);
    compute(n + 1);
    if (n + 2 < NB) swrite(0, gA);
    if (n + 4 < NB) gload(n + 4, gA);
    __syncthreads();
    yout(n + 1);
  }
  __syncthreads();
}

__device__ void mlstm_s1(KP p, int layer, int tile, char* lds, int tid) {
  const int j = layer >> 1;
  const int ch = tile / NCHUNK, c = tile % NCHUNK;
  const int dir = ch >> 5, b = (ch >> 2) & 7, h = ch & 3;
  float* s_ws = (float*)(lds + META_OFF);
  int* s_row = (int*)(s_ws + 64);
  char* kimg = lds;
  char* vimg = lds + 16384;
  if (tid < 64) {
    const int row = scan_row(dir, b, c * 64 + tid);
    s_row[tid] = row;
    const float* g = p->GP + (size_t)row * 16;
    const float gi = g[(dir * 2) * 4 + h] + p->mlstm_gate_b[j * 16 + (dir * 2) * 4 + h];
    const float gf = g[(dir * 2 + 1) * 4 + h] + p->mlstm_gate_b[j * 16 + (dir * 2 + 1) * 4 + h];
    float bc = -softplus_f(-gf);
#pragma unroll
    for (int o = 1; o < 64; o <<= 1) {
      float tmp = __shfl_up(bc, o);
      if (tid >= o) bc += tmp;
    }
    const float bend = __shfl(bc, 63);
    const float ds = bend - bc + gi;
    const float mloc = wmax(ds);
    s_ws[tid] = expf(ds - mloc);
    if (tid == 0) { p->msc[tile] = mloc; p->msc[NMT + tile] = bend; }
  }
  __syncthreads();
  {
    const int c8 = tid & 15;
    const int ioff = (c8 >> 2) * 4096 + (c8 & 3) * 16;
#pragma unroll
    for (int i = 0; i < 4; ++i) {
      const int sidx = (tid >> 4) + 16 * i;
      const bf16_t* src = p->P + (size_t)s_row[sidx] * LDP + h * 128 + c8 * 8;
      const u32x4 kv = *(const u32x4*)(src + 2560);
      u32x4 vv = *(const u32x4*)(src + 3072);
      const float wsv = s_ws[sidx];
      vv.x = pk_bf16(bflo(vv.x) * wsv, bfhi(vv.x) * wsv); vv.y = pk_bf16(bflo(vv.y) * wsv, bfhi(vv.y) * wsv);
      vv.z = pk_bf16(bflo(vv.z) * wsv, bfhi(vv.z) * wsv); vv.w = pk_bf16(bflo(vv.w) * wsv, bfhi(vv.w) * wsv);
      *(u32x4*)(kimg + ioff + sidx * 64) = kv;
      *(u32x4*)(vimg + ioff + sidx * 64) = vv;
    }
  }
  __syncthreads();
  const int lane = tid & 63, w = tid >> 6, wm = w >> 1, wn = w & 1, r32 = lane & 31, hi = lane >> 5;
  f32x16 acc[2][2];
#pragma unroll
  for (int mi = 0; mi < 2; ++mi)
#pragma unroll
    for (int ni = 0; ni < 2; ++ni)
#pragma unroll
      for (int q = 0; q < 16; ++q) acc[mi][ni][q] = 0.f;
  const int toff = ((lane >> 4) & 1) * 32 + (lane & 3) * 8 + ((lane & 15) >> 2) * 64 + hi * 256;
#pragma unroll
  for (int ks = 0; ks < 4; ++ks) {
    bf16x8 af[2], bfr[2];
#pragma unroll
    for (int i = 0; i < 2; ++i) {
      const char* ka = kimg + (wm * 2 + i) * 4096 + toff + (16 * ks) * 64;
      const char* va = vimg + (wn * 2 + i) * 4096 + toff + (16 * ks) * 64;
      af[i] = __builtin_shufflevector(vtr(ka), vtr(ka + 8 * 64), 0, 1, 2, 3, 4, 5, 6, 7);
      bfr[i] = __builtin_shufflevector(vtr(va), vtr(va + 8 * 64), 0, 1, 2, 3, 4, 5, 6, 7);
    }
    acc[0][0] = MFMA32(af[0], bfr[0], acc[0][0]);
    acc[0][1] = MFMA32(af[0], bfr[1], acc[0][1]);
    acc[1][0] = MFMA32(af[1], bfr[0], acc[1][0]);
    acc[1][1] = MFMA32(af[1], bfr[1], acc[1][1]);
  }
  bf16_t* U = p->MS + (size_t)tile * 16384;
#pragma unroll
  for (int mi = 0; mi < 2; ++mi)
#pragma unroll
    for (int ni = 0; ni < 2; ++ni)
#pragma unroll
      for (int q = 0; q < 16; ++q) {
        const int d = wm * 64 + mi * 32 + (q & 3) + 8 * (q >> 2) + 4 * hi;
        U[d * 128 + wn * 64 + ni * 32 + r32] = f2bf(acc[mi][ni][q]);
        if ((q & 3) == 3) __builtin_amdgcn_sched_barrier(0);
      }
  if (tid < 128) {
    const char* kc = kimg + (tid >> 5) * 4096 + (tid & 31) * 2;
    float a = 0.f;
#pragma unroll 8
    for (int sidx = 0; sidx < 64; ++sidx) a = fmaf(s_ws[sidx], bf2f(*(const bf16_t*)(kc + sidx * 64)), a);
    p->MSn[tile * 128 + tid] = a;
  }
}

__device__ void mlstm_s3(KP p, int layer, int tile, char* lds, int tid);
__device__ void ph_scan_a(KP p, int layer, char* smc) {
  float* sm = (float*)smc;
  const int tid = opaque_tid();
  __builtin_amdgcn_s_setprio(3);
  for (int u = blockIdx.x; u < 256; u += gridDim.x) rwkv_unit(p, u, sm, tid);
  __builtin_amdgcn_s_setprio(0);
  {
    const int stage = layer == 1 ? 1 : 2;
    const int nconv = conv_stage_total(stage);
    const int total = NMT + (nconv + 7) / 8;
    int* qc = (int*)(p->bar + XCD_BAR_WORDS + 16 * stage);
    int* s_q = (int*)(smc + META_OFF + 3968);
    int jj = 0, j1 = 0;
#pragma unroll 1
    for (;;) {
      if (jj >= j1) {
        __syncthreads();
        if (tid == 0) *s_q = atomicAdd(qc, 1);
        __syncthreads();
        const int q = *s_q;
        if (q >= total) break;
        if (q < NMT) { mlstm_s3(p, layer, q, smc, tid); continue; }
        jj = (q - NMT) * 8; j1 = min(jj + 8, nconv);
      }
      convert_run(p, stage, jj, j1, sm, tid);
      jj = j1;
    }
  }
}

__device__ void ph_mlstm_s2(KP p, char* smc) {
  float* sw = (float*)smc;
  const int tid = opaque_tid();
  const int nitems = 64 * 33;
  for (int item = blockIdx.x; item < nitems; item += gridDim.x) {
    const int ch = item / 33, seg = item % 33;
    __syncthreads();
    if (tid < 2 * NCHUNK) sw[72 + tid] = p->msc[(tid < NCHUNK ? 0 : NMT - NCHUNK) + ch * NCHUNK + tid];
    __syncthreads();
    if (tid == 0) {
      float m = 0.f;
      for (int c = 0; c < NCHUNK; ++c) {
        const int tile = ch * NCHUNK + c;
        const float mloc = sw[72 + c], bend = sw[72 + NCHUNK + c];
        const float mn = fmaxf(bend + m, mloc);
        sw[c] = expf(bend + m - mn);
        sw[36 + c] = expf(mloc - mn);
        if (seg == 0) p->msc[2 * NMT + tile] = m;
        m = mn;
      }
    }
    __syncthreads();
    if (seg < 32) {
      unsigned* base = (unsigned*)(p->MS + (size_t)ch * NCHUNK * 16384) + seg * 256 + tid;
      unsigned v[NCHUNK];
#pragma unroll
      for (int c = 0; c < NCHUNK; ++c) v[c] = base[(size_t)c * 8192];
      float C0 = 0.f, C1 = 0.f;
#pragma unroll
      for (int c = 0; c < NCHUNK; ++c) {
        const float t0 = bflo(v[c]), t1 = bfhi(v[c]);
        v[c] = pk_bf16(C0, C1);
        C0 = sw[c] * C0 + sw[36 + c] * t0;
        C1 = sw[c] * C1 + sw[36 + c] * t1;
      }
#pragma unroll
      for (int c = 0; c < NCHUNK; ++c) base[(size_t)c * 8192] = v[c];
    } else if (tid < 128) {
      float* base = p->MSn + (size_t)ch * NCHUNK * 128 + tid;
      float v[NCHUNK];
#pragma unroll
      for (int c = 0; c < NCHUNK; ++c) v[c] = base[c * 128];
      float C = 0.f;
#pragma unroll
      for (int c = 0; c < NCHUNK; ++c) {
        const float t0 = v[c];
        v[c] = C;
        C = sw[c] * C + sw[36 + c] * t0;
      }
#pragma unroll
      for (int c = 0; c < NCHUNK; ++c) base[c * 128] = v[c];
    }
  }
}

__device__ void mlstm_s3(KP p, int layer, int tile, char* lds, int tid) {
  const int j = layer >> 1;
  const int ch = tile / NCHUNK, c = tile % NCHUNK;
  const int dir = ch >> 5, b = (ch >> 2) & 7, h = ch & 3;
  float* s_b = (float*)(lds + META_OFF);
  float* s_ig = s_b + 64;
  float* s_mt = s_b + 128;
  float* s_wi = s_b + 192;
  int* s_row = (int*)(s_b + 256);
  float* s_n = s_b + 320;
  float* s_c = s_b + 448;
  char* kimg = lds;
  char* vimg = lds + 16384;
  char* cimg = lds + 32768;
  const float mprev = p->msc[2 * NMT + tile];
  const float qscale = 0.08838834764831845f;
  const int lane = tid & 63, w = tid >> 6, wt = w >> 1, wv = w & 1, r32 = lane & 31, hi = lane >> 5;
  const int t = wt * 32 + r32;
  const int rowq = scan_row(dir, b, c * 64 + t);
  const int c8 = tid & 15;
  u32x4 kr[4], vr[4], cr[8];
#pragma unroll
  for (int i = 0; i < 4; ++i) {
    const int sidx = (tid >> 4) + 16 * i;
    const bf16_t* src = p->P + (size_t)scan_row(dir, b, c * 64 + sidx) * LDP + h * 128 + c8 * 8;
    kr[i] = *(const u32x4*)(src + 2560);
    vr[i] = *(const u32x4*)(src + 3072);
  }
  {
    const bf16_t* Cp = p->MS + (size_t)tile * 16384;
#pragma unroll
    for (int i = 0; i < 8; ++i) cr[i] = *(const u32x4*)(Cp + ((tid >> 4) + 16 * i) * 128 + c8 * 8);
  }
  bf16x8 qf[8];
  {
    const bf16_t* qp = p->P + (size_t)rowq * LDP + 2048 + h * 128 + hi * 8;
#pragma unroll
    for (int d0 = 0; d0 < 8; ++d0) qf[d0] = *(const bf16x8*)(qp + d0 * 16);
  }
  if (tid < 64) {
    const int row = scan_row(dir, b, c * 64 + tid);
    s_row[tid] = row;
    const float* g = p->GP + (size_t)row * 16;
    const float gi = g[(dir * 2) * 4 + h] + p->mlstm_gate_b[j * 16 + (dir * 2) * 4 + h];
    const float gf = g[(dir * 2 + 1) * 4 + h] + p->mlstm_gate_b[j * 16 + (dir * 2 + 1) * 4 + h];
    float bc = -softplus_f(-gf);
#pragma unroll
    for (int o = 1; o < 64; o <<= 1) {
      float tmp = __shfl_up(bc, o);
      if (tid >= o) bc += tmp;
    }
    float pm = gi - bc;
#pragma unroll
    for (int o = 1; o < 64; o <<= 1) {
      float tmp = __shfl_up(pm, o);
      if (tid >= o) pm = fmaxf(pm, tmp);
    }
    const float mt = bc + fmaxf(mprev, pm);
    s_b[tid] = bc;
    s_ig[tid] = gi;
    s_mt[tid] = mt;
    s_wi[tid] = expf(bc + mprev - mt);
    s_c[tid] = (gi - bc) * 1.4426950408889634f;
  } else if (tid < 192) s_n[tid - 64] = p->MSn[tile * 128 + (tid - 64)];
  {
    const int ioff = (c8 >> 2) * 4096 + (c8 & 3) * 16;
#pragma unroll
    for (int i = 0; i < 4; ++i) {
      const int sidx = (tid >> 4) + 16 * i;
      *(u32x4*)(kimg + sidx * 256 + ((c8 ^ (sidx & 15)) * 16)) = kr[i];
      *(u32x4*)(vimg + ioff + sidx * 64) = vr[i];
    }
    const int coff = (c8 >> 2) * 8192 + (c8 & 3) * 16;
#pragma unroll
    for (int i = 0; i < 8; ++i) *(u32x4*)(cimg + coff + ((tid >> 4) + 16 * i) * 64) = cr[i];
  }
  __syncthreads();
  const int toff = ((lane >> 4) & 1) * 32 + (lane & 3) * 8 + ((lane & 15) >> 2) * 64;
  constexpr float LOG2E_ = 1.4426950408889634f;
  float qn = 0.f;
#pragma unroll
  for (int d0 = 0; d0 < 8; ++d0) {
    const u32x4 qq = __builtin_bit_cast(u32x4, qf[d0]);
    const float* np = s_n + d0 * 16 + hi * 8;
    qn = fmaf(bflo(qq.x), np[0], qn); qn = fmaf(bfhi(qq.x), np[1], qn);
    qn = fmaf(bflo(qq.y), np[2], qn); qn = fmaf(bfhi(qq.y), np[3], qn);
    qn = fmaf(bflo(qq.z), np[4], qn); qn = fmaf(bfhi(qq.z), np[5], qn);
    qn = fmaf(bflo(qq.w), np[6], qn); qn = fmaf(bfhi(qq.w), np[7], qn);
  }
  qn += __shfl_xor(qn, 32);
  const float mtt = s_mt[t], wi = s_wi[t];
  const float ct = (s_b[t] - mtt) * LOG2E_;
  const float wq = wi * qscale;
  bf16x8 pf[4];
  float den = 0.f;
  {
    f32x16 sa0, sa1;
#pragma unroll
    for (int q = 0; q < 16; ++q) { sa0[q] = 0.f; sa1[q] = 0.f; }
#pragma unroll
    for (int d0 = 0; d0 < 8; ++d0) {
      const int chn = 2 * d0 + hi;
      const bf16x8 k0 = *(const bf16x8*)(kimg + r32 * 256 + ((chn ^ (r32 & 15)) * 16));
      sa0 = MFMA32(k0, qf[d0], sa0);
      if (wt) {
        const bf16x8 k1 = *(const bf16x8*)(kimg + (32 + r32) * 256 + ((chn ^ (r32 & 15)) * 16));
        sa1 = MFMA32(k1, qf[d0], sa1);
      }
      __builtin_amdgcn_sched_barrier(0);
    }
#pragma unroll
    for (int g = 0; g < 4; ++g) {
      const int sb0 = 8 * g + 4 * hi;
      const float4 c0v = *(const float4*)(s_c + sb0);
      const float4 c1v = *(const float4*)(s_c + sb0 + 32);
      const float cc0[4] = {c0v.x, c0v.y, c0v.z, c0v.w}, cc1[4] = {c1v.x, c1v.y, c1v.z, c1v.w};
#pragma unroll
      for (int e = 0; e < 4; ++e) {
        const int q = 4 * g + e;
        const float v0 = (sb0 + e <= t) ? sa0[q] * qscale * __builtin_amdgcn_exp2f(ct + cc0[e]) : 0.f;
        sa0[q] = v0; den += v0;
        const float v1 = (wt && sb0 + 32 + e <= t) ? sa1[q] * qscale * __builtin_amdgcn_exp2f(ct + cc1[e]) : 0.f;
        sa1[q] = v1; den += v1;
      }
      __builtin_amdgcn_sched_barrier(0);
    }
#pragma unroll
    for (int sx = 0; sx < 4; ++sx) {
      const int u = (sx & 1) * 8;
      u32x4 tpk;
      if (sx < 2) {
        tpk.x = pk_bf16(sa0[u + 0], sa0[u + 1]); tpk.y = pk_bf16(sa0[u + 2], sa0[u + 3]);
        tpk.z = pk_bf16(sa0[u + 4], sa0[u + 5]); tpk.w = pk_bf16(sa0[u + 6], sa0[u + 7]);
      } else {
        tpk.x = pk_bf16(sa1[u + 0], sa1[u + 1]); tpk.y = pk_bf16(sa1[u + 2], sa1[u + 3]);
        tpk.z = pk_bf16(sa1[u + 4], sa1[u + 5]); tpk.w = pk_bf16(sa1[u + 6], sa1[u + 7]);
      }
      pf[sx] = __builtin_bit_cast(bf16x8, tpk);
    }
  }
  den += __shfl_xor(den, 32);
  const float dtot = den + wq * qn;
  const float inv = 1.f / fmaxf(fabsf(dtot), expf(-mtt));
  bf16_t* op = p->P + (size_t)rowq * LDP + 1024 + dir * 512 + h * 128 + wv * 64 + 4 * hi;
#pragma unroll 1
  for (int vp = 0; vp < 2; ++vp) {
    f32x16 o0;
#pragma unroll
    for (int q = 0; q < 16; ++q) o0[q] = 0.f;
    const char* cb = cimg + (wv * 2 + vp) * 8192 + toff + hi * 512;
#pragma unroll
    for (int d0 = 0; d0 < 8; ++d0) {
      const bf16x8 A0 = __builtin_shufflevector(vtr(cb + (16 * d0) * 64), vtr(cb + (16 * d0 + 4) * 64), 0, 1, 2, 3, 4, 5, 6, 7);
      o0 = MFMA32(A0, qf[d0], o0);
    }
#pragma unroll
    for (int q = 0; q < 16; ++q) o0[q] *= wq;
    const char* vb = vimg + (wv * 2 + vp) * 4096 + toff + hi * 256;
#pragma unroll
    for (int sx = 0; sx < 4; ++sx) {
      if (sx < 2 || wt) {
        const bf16x8 A0 = __builtin_shufflevector(vtr(vb + (16 * sx) * 64), vtr(vb + (16 * sx + 8) * 64), 0, 1, 2, 3, 4, 5, 6, 7);
        o0 = MFMA32(A0, pf[sx], o0);
      }
    }
#pragma unroll
    for (int g = 0; g < 4; ++g) {
      u32x2 v0;
      v0.x = pk_bf16(o0[4 * g] * inv, o0[4 * g + 1] * inv); v0.y = pk_bf16(o0[4 * g + 2] * inv, o0[4 * g + 3] * inv);
      *(u32x2*)(op + vp * 32 + 8 * g) = v0;
    }
  }
}

__device__ void ph_mlstm_s1(KP p, int layer, char* smc) {
  const int tid = opaque_tid();
  __syncthreads();
  for (int tile = blockIdx.x; tile < NMT; tile += gridDim.x) { mlstm_s1(p, layer, tile, smc, tid); __syncthreads(); }
}

__device__ void ph_rec_final(KP p, int layer, bool keep) {
  const int tid = opaque_tid();
  const int j = layer >> 1;
  const int lane = tid & 63, wave = tid >> 6;
  const int rows = keep ? NT : NL;
  const int c0 = lane * 8;
  auto unpack = [](const u32x4 u, float (&f)[8]) {
    f[0] = bflo(u.x); f[1] = bfhi(u.x); f[2] = bflo(u.y); f[3] = bfhi(u.y);
    f[4] = bflo(u.z); f[5] = bfhi(u.z); f[6] = bflo(u.w); f[7] = bfhi(u.w);
  };
  for (int t = blockIdx.x * 4 + wave; t < rows; t += gridDim.x * 4) {
    const bf16_t* rw = p->RW + (size_t)t * RWS + c0;
    const bf16_t* pt = p->P + (size_t)t * LDP + c0;
    bf16_t* mo = p->AB + (size_t)t * DM + c0;
    {
      float yf[8], yb[8], r[8], v[8], k0[8], k1[8], g[8], y[8], o[8];
      unpack(*(const u32x4*)(pt), yf); unpack(*(const u32x4*)(pt + 512), yb);
      unpack(*(const u32x4*)(rw), r); unpack(*(const u32x4*)(rw + 512), v);
      unpack(*(const u32x4*)(rw + 5 * 512), k0); unpack(*(const u32x4*)(rw + 6 * 512), k1);
      unpack(*(const u32x4*)(rw + 9 * 512), g);
      float s1 = 0.f, bs = 0.f;
      const float* rk = p->rwkv_rk + j * 512 + c0;
#pragma unroll
      for (int e = 0; e < 8; ++e) { y[e] = yf[e] + yb[e]; s1 += y[e]; bs += r[e] * rk[e] * (k0[e] + k1[e]); }
      s1 += dppx<0xB1>(s1); s1 += dppx<0x4E>(s1); s1 += dppx<0x141>(s1);
      bs += dppx<0xB1>(bs); bs += dppx<0x4E>(bs); bs += dppx<0x141>(bs);
      const float mu = s1 * (1.f / 64.f);
      float s2 = 0.f;
#pragma unroll
      for (int e = 0; e < 8; ++e) { const float d = y[e] - mu; s2 += d * d; }
      s2 += dppx<0xB1>(s2); s2 += dppx<0x4E>(s2); s2 += dppx<0x141>(s2);
      const float rs = rsqrtf(s2 * (1.f / 64.f) + 64e-5f);
      const float* gn0 = p->rwkv_gn + (j * 2 + 0) * 512 + c0;
      const float* gn1 = p->rwkv_gn + (j * 2 + 1) * 512 + c0;
#pragma unroll
      for (int e = 0; e < 8; ++e) o[e] = ((y[e] - mu) * rs * gn0[e] + gn1[e] + bs * v[e]) * g[e];
      u32x4 ov;
      ov.x = pk_bf16(o[0], o[1]); ov.y = pk_bf16(o[2], o[3]); ov.z = pk_bf16(o[4], o[5]); ov.w = pk_bf16(o[6], o[7]);
      *(u32x4*)(mo) = ov;
    }
    {
      float hf[8], hb[8], og[8], hsum[8], o[8];
      unpack(*(const u32x4*)(pt + 1024), hf); unpack(*(const u32x4*)(pt + 1536), hb);
      unpack(*(const u32x4*)(pt + 3584), og);
      float ss = 0.f;
#pragma unroll
      for (int e = 0; e < 8; ++e) { hsum[e] = hf[e] + hb[e]; ss += hsum[e] * hsum[e]; }
      ss += dppx<0xB1>(ss); ss += dppx<0x4E>(ss); ss += dppx<0x141>(ss); ss += dppx<0x140>(ss);
      const float rs = rsqrtf(ss * (1.f / 128.f) + 1e-6f);
      const float* ng = p->mlstm_norm + j * 512 + c0;
#pragma unroll
      for (int e = 0; e < 8; ++e) o[e] = hsum[e] * rs * ng[e] * sigm_f(og[e]);
      u32x4 ov;
      ov.x = pk_bf16(o[0], o[1]); ov.y = pk_bf16(o[2], o[3]); ov.z = pk_bf16(o[4], o[5]); ov.w = pk_bf16(o[6], o[7]);
      *(u32x4*)(mo + 512) = ov;
    }
  }
}

using f32x4v = __attribute__((ext_vector_type(4))) float;
__device__ void ph_ln_router(KP p, int layer, bool keep, char* smc) {
  float* h2s = (float*)smc;
  float* lgs = (float*)smc;
  const int tid = opaque_tid();
  const int lane = tid & 63, wave = tid >> 6;
  const int rows = keep ? NT : NL;
  const float* lng = p->ln_g + (layer * 2 + 0) * 1024;
  const float* lnb = p->ln_b + (layer * 2 + 0) * 1024;
  for (int tile = blockIdx.x; tile < rows / 16; tile += gridDim.x) {
    const int t0 = tile * 16;
    const float* mod = p->MOD + (layer * 9 + modrow(t0)) * 6144;
    const float* brow = p->WrT + ((size_t)layer * 64 + 16 * wave + (lane & 15)) * 1024 + 4 * (lane >> 4);
    f32x4v b0[8], b1[8], b2[8];
#pragma unroll
    for (int q = 0; q < 8; ++q) { b0[q] = *(const f32x4v*)(brow + 16 * q); b1[q] = *(const f32x4v*)(brow + 16 * (8 + q)); }
    __builtin_amdgcn_sched_barrier(0);
    {
      float4 v[4][4];
      float s4[4];
#pragma unroll
      for (int q = 0; q < 4; ++q) {
        const int t = t0 + wave * 4 + q;
        s4[q] = 0.f;
#pragma unroll
        for (int i = 0; i < 4; ++i) v[q][i] = *(const float4*)(p->Tb + (size_t)t * DM + i * 256 + lane * 4);
      }
#pragma unroll
      for (int q = 0; q < 4; ++q)
#pragma unroll
        for (int i = 0; i < 4; ++i) s4[q] += (v[q][i].x + v[q][i].y) + (v[q][i].z + v[q][i].w);
      float mean4[4], rs4[4];
#pragma unroll
      for (int q = 0; q < 4; ++q) mean4[q] = wsum(s4[q]) * (1.f / 1024.f);
#pragma unroll
      for (int q = 0; q < 4; ++q) {
        float qq = 0.f;
#pragma unroll
        for (int i = 0; i < 4; ++i) {
          const float d0 = v[q][i].x - mean4[q], d1 = v[q][i].y - mean4[q], d2 = v[q][i].z - mean4[q], d3 = v[q][i].w - mean4[q];
          qq += (d0 * d0 + d1 * d1) + (d2 * d2 + d3 * d3);
        }
        s4[q] = qq;
      }
#pragma unroll
      for (int q = 0; q < 4; ++q) rs4[q] = rsqrtf(wsum(s4[q]) * (1.f / 1024.f) + 1e-5f);
#pragma unroll
      for (int i = 0; i < 4; ++i) {
        const int n = i * 256 + lane * 4;
        const float4 g = *(const float4*)(lng + n), bb = *(const float4*)(lnb + n);
        const float4 sc = *(const float4*)(mod + 4096 + n), sh = *(const float4*)(mod + 3072 + n);
#pragma unroll
        for (int q = 0; q < 4; ++q) {
          const int tl = wave * 4 + q, t = t0 + tl;
          const float mean = mean4[q], rs = rs4[q];
          const float4 xn = make_float4((v[q][i].x - mean) * rs * g.x + bb.x, (v[q][i].y - mean) * rs * g.y + bb.y,
                                        (v[q][i].z - mean) * rs * g.z + bb.z, (v[q][i].w - mean) * rs * g.w + bb.w);
          *(float4*)(p->X + (size_t)t * DM + n) = xn;
          const float4 hh = make_float4(xn.x * (1.f + sc.x) + sh.x, xn.y * (1.f + sc.y) + sh.y,
                                        xn.z * (1.f + sc.z) + sh.z, xn.w * (1.f + sc.w) + sh.w);
          *(unsigned*)((unsigned char*)p->AB + (size_t)t * DM + n) = pk_fp8x4(hh.x, hh.y, hh.z, hh.w);
          *(float4*)(h2s + tl * 1028 + n) = hh;
        }
      }
    }
    __syncthreads();
    f32x4v acc = {0.f, 0.f, 0.f, 0.f};
    {
      f32x4v a1 = {0.f, 0.f, 0.f, 0.f}, a2 = {0.f, 0.f, 0.f, 0.f}, a3 = {0.f, 0.f, 0.f, 0.f};
      const int i = lane & 15, kk = lane >> 4;
      const float* arow = h2s + i * 1028 + 4 * kk;
#define ROUTER_LOAD(B, Q0) _Pragma("unroll") for (int q = 0; q < 8; ++q) B[q] = *(const f32x4v*)(brow + 16 * ((Q0) + q)); __builtin_amdgcn_sched_barrier(0);
#define ROUTER_MFMA(B, Q0) _Pragma("unroll") for (int q = 0; q < 8; ++q) { \
        const float4 a = *(const float4*)(arow + 16 * ((Q0) + q)); \
        acc = __builtin_amdgcn_mfma_f32_16x16x4f32(a.x, B[q].x, acc, 0, 0, 0); \
        a1 = __builtin_amdgcn_mfma_f32_16x16x4f32(a.y, B[q].y, a1, 0, 0, 0); \
        a2 = __builtin_amdgcn_mfma_f32_16x16x4f32(a.z, B[q].z, a2, 0, 0, 0); \
        a3 = __builtin_amdgcn_mfma_f32_16x16x4f32(a.w, B[q].w, a3, 0, 0, 0); } __builtin_amdgcn_sched_barrier(0);
      ROUTER_LOAD(b2, 16) ROUTER_MFMA(b0, 0)
      ROUTER_LOAD(b0, 24) ROUTER_MFMA(b1, 8)
      ROUTER_LOAD(b1, 32) ROUTER_MFMA(b2, 16)
      ROUTER_LOAD(b2, 40) ROUTER_MFMA(b0, 24)
      ROUTER_LOAD(b0, 48) ROUTER_MFMA(b1, 32)
      ROUTER_LOAD(b1, 56) ROUTER_MFMA(b2, 40)
      ROUTER_MFMA(b0, 48)
      ROUTER_MFMA(b1, 56)
      acc = (acc + a1) + (a2 + a3);
    }
    __syncthreads();
#pragma unroll
    for (int r = 0; r < 4; ++r) lgs[((lane >> 4) * 4 + r) * 64 + 16 * wave + (lane & 15)] = acc[r];
    __syncthreads();
    {
      float score4[4], gate4[4];
      int kidx4[4], pos4[4];
      bool chosen4[4];
#pragma unroll
      for (int q = 0; q < 4; ++q) {
        const int tl = wave * 4 + q;
        const float logit = lgs[tl * 64 + lane];
        const float score = sigm_f(logit);
        float sel = score + p->moe_bias[layer * 64 + lane];
        bool chosen = false;
        for (int r = 0; r < 6; ++r) {
          const float mx = wmax(sel);
          const unsigned long long bal = __ballot(sel == mx);
          const int first = __ffsll((long long)bal) - 1;
          if (lane == first) { chosen = true; sel = -INFINITY; }
        }
        const float gsum = wsum(chosen ? score : 0.f);
        const unsigned long long cb = __ballot(chosen);
        score4[q] = score; gate4[q] = score / gsum * 2.5f; chosen4[q] = chosen;
        kidx4[q] = __popcll(cb & ((1ull << lane) - 1ull));
      }
#pragma unroll
      for (int q = 0; q < 4; ++q) pos4[q] = chosen4[q] ? atomicAdd(&p->cnt[lane * CSTR], 1) : 0;
#pragma unroll
      for (int q = 0; q < 4; ++q) {
        const int t = t0 + wave * 4 + q;
        if (chosen4[q]) {
          p->ltok[(size_t)lane * NT + pos4[q]] = t;
          p->lgate[(size_t)lane * NT + pos4[q]] = gate4[q];
          p->tsl[t * 6 + kidx4[q]] = (lane << 16) | pos4[q];
        }
      }
    }
    __syncthreads();
  }
}

__device__ __forceinline__ void moe_prefix(KP p, int rows, int* s_pref, int tid) {
  if (tid < 64) s_pref[322 + tid] = p->cnt[tid * CSTR];
  __syncthreads();
  if (tid == 0) {
    int a = 0;
    for (int e = 0; e < 64; ++e) { s_pref[e] = a; a += (s_pref[322 + e] + 127) >> 7; }
    s_pref[64] = a; a += rows >> 7;
    s_pref[65] = a;
  }
  __syncthreads();
}

__device__ void ph_gemm(KP p, int kind, int layer, bool keep, char* lds) {
  const int tid = opaque_tid();
  const int j = layer >> 1;
  const bool att = !(layer & 1);
  const int rows = keep ? NT : NL;
  int* pref = (int*)(lds + META_OFF);
  int* s_idx = pref + 66;
  float* s_gate = (float*)(s_idx + 128);
  if (kind == 1 && blockIdx.x == 0 && tid < 65) p->cnt[tid * CSTR] = 0;
  int total;
  const int ntn_in = att ? 18 : 33;
  switch (kind) {
    case 0: total = (NT / 128) * ntn_in; break;
    case 1: total = (rows / 128) * 8; break;
    case 2: total = pref[65] * 4; break;
    case 3: total = pref[65] * 8; break;
    case 4: total = (NT / 128) * 3; break;
    default: total = (NT / 128) * 20; break;
  }
  const bool moe = kind == 2 || kind == 3;
  const int tsh = kind == 2 ? 2 : 3;
  int e_nx = 0, idx_nx = tid; float g_nx = 1.f;
  auto fetch_moe = [&](int tl) {
    const int mt = tl >> tsh;
    while (mt >= pref[e_nx + 1]) ++e_nx;
    idx_nx = tid; g_nx = 1.f;
    if (tid < 128) {
      const int pos = (mt - pref[e_nx]) * 128 + tid;
      if (kind == 2) {
        idx_nx = 0;
        if (e_nx < 64) { if (pos < pref[322 + e_nx]) idx_nx = p->ltok[(size_t)e_nx * NT + pos]; }
        else idx_nx = pos;
      } else if (e_nx < 64) g_nx = pos < pref[322 + e_nx] ? p->lgate[(size_t)e_nx * NT + pos] : 0.f;
    }
  };
  if (moe && (int)blockIdx.x < total) fetch_moe(blockIdx.x);
  for (int tile = blockIdx.x; tile < total; tile += gridDim.x) {
    const bf16_t* Abase; const bf16_t* Bt;
    int astride, K, n0, m0 = 0, aux = 0, e = e_nx, mtile = 0;
    switch (kind) {
      case 0: { const int tm = tile / ntn_in, tn = tile % ntn_in; m0 = tm * 128; n0 = tn * 128;
                Abase = p->AB + (size_t)m0 * DM; astride = DM; K = 1024;
                Bt = att ? p->Wt_att + (size_t)j * ATT_N * 1024 : p->Wt_rec + (size_t)j * REC_NP * 1024; } break;
      case 1: { const int tm = tile >> 3, tn = tile & 7; m0 = tm * 128; n0 = tn * 128;
                Abase = p->AB + (size_t)m0 * DM; astride = DM; K = 1024; Bt = p->Wt_out + (size_t)layer * 1024 * 1024; } break;
      case 2: { mtile = tile >> 2; aux = tile & 3; n0 = aux * 128;
                Abase = p->AB; astride = DM; K = 1024;
                Bt = (const bf16_t*)((const unsigned char*)p->Wt13 + (size_t)(layer * 65 + e) * 512 * 1024); } break;
      case 3: { mtile = tile >> 3; aux = tile & 7; n0 = aux * 128;
                Abase = (const bf16_t*)((const unsigned char*)p->ACT + (size_t)mtile * 128 * 256); astride = 256; K = 256;
                Bt = (const bf16_t*)((const unsigned char*)p->Wt2 + (size_t)(layer * 65 + e) * 1024 * 256); } break;
      case 4: { const int tm = tile / 3; aux = tile % 3; m0 = tm * 128; n0 = 0;
                Abase = p->Zb + (size_t)m0 * 1536 + aux * 512; astride = 1536; K = 512; Bt = p->Wl1 + (size_t)(j * 3 + aux) * 128 * 512; } break;
      default: { const int tm = tile / 20; aux = tile % 20; m0 = tm * 128; n0 = aux * 128;
                const int grp = aux < 8 ? 0 : (aux < 16 ? 1 : 2);
                Abase = p->L1 + (size_t)m0 * 384 + grp * 128; astride = 384; K = 128; Bt = p->Wl2 + (size_t)j * 2560 * 128; } break;
    }
    if (tid < 128) { s_idx[tid] = idx_nx; s_gate[tid] = g_nx; }
    __syncthreads();
    if (moe && tile + (int)gridDim.x < total) fetch_moe(tile + gridDim.x);
    {
      f32x16 acc[2][2];
      if (kind == 2 || kind == 3) {
        const unsigned char* A8 = (const unsigned char*)Abase;
        gemm128_fp8(tid, [&](int r) { return A8 + (size_t)s_idx[r] * astride; }, (const unsigned char*)Bt, K, n0, lds, acc);
      } else
        gemm128_main(tid, [&](int r) { return Abase + (size_t)s_idx[r] * astride; }, Bt, K, n0, lds, acc);
      float* Ct = (float*)lds;
      acc_foreach(tid, acc, [&](int row, int col, float v) { Ct[row * 128 + col] = v; });
    }
    __syncthreads();
    {
      const float* Ct = (const float*)lds;
      int c4 = (tid & 31) * 4, r0 = tid >> 5;
      asm volatile("" : "+v"(c4), "+v"(r0));
      const int N_in = att ? ATT_N : REC_N;
      const int d5 = (aux >> 2) & 1, c05 = (aux & 3) * 128;
      switch (kind) {
        case 0: {
#pragma unroll 8
          for (int it = 0; it < 16; ++it) {
            const int row = it * 8 + r0;
            const float4 v = *(const float4*)(Ct + row * 128 + c4);

            const int cn = n0 + c4;
            float4 vq = v;
            if (att && n0 >= 1536 && n0 < 2176) {
              float ss = v.x * v.x + v.y * v.y + v.z * v.z + v.w * v.w;
              ss += dppx<0xB1>(ss); ss += dppx<0x4E>(ss); ss += dppx<0x141>(ss); ss += dppx<0x140>(ss);
              const float rs = rsqrtf(ss * (1.f / 64.f) + 1e-6f);
              const float4 g = *(const float4*)(p->qk_gain + j * 128 + (n0 >= 2048 ? 64 : 0) + (cn & 63));
              vq = make_float4(v.x * rs * g.x, v.y * rs * g.y, v.z * rs * g.z, v.w * rs * g.w);
              const int t = m0 + row;
              if (t < NL) {
                const int sidx = t & 2047, pi0 = (cn & 63) >> 1;
                const int pos = pi0 < 16 ? (sidx >> 6) : (sidx & 63);
                const float4 cs = *(const float4*)(p->ROPE + (pos * 16 + (pi0 & 15)) * 2);
                vq = make_float4(vq.x * cs.x - vq.y * cs.y, vq.x * cs.y + vq.y * cs.x,
                                 vq.z * cs.z - vq.w * cs.w, vq.z * cs.w + vq.w * cs.z);
              }
            }
            if (cn < N_in) {
              u32x2 o; o.x = pk_bf16(vq.x, vq.y); o.y = pk_bf16(vq.z, vq.w);
              *(u32x2*)(p->P + (size_t)(m0 + row) * LDP + cn) = o;
            }
            if (!att && cn >= 4096 && cn < 4112) *(float4*)(p->GP + (size_t)(m0 + row) * 16 + (cn - 4096)) = v;
          }
        } break;
        case 1: {
#pragma unroll 16
          for (int it = 0; it < 16; ++it) {
            const int row = it * 8 + r0;
            const float4 v = *(const float4*)(Ct + row * 128 + c4);

            const size_t o = (size_t)(m0 + row) * DM + n0 + c4;
            const float4 xv = *(const float4*)(p->X + o);
            const float4 g = *(const float4*)(p->MOD + (layer * 9 + modrow(m0)) * 6144 + 2048 + n0 + c4);
            *(float4*)(p->Tb + o) = make_float4(DN_ALPHA * xv.x + g.x * v.x, DN_ALPHA * xv.y + g.y * v.y,
                                                DN_ALPHA * xv.z + g.z * v.z, DN_ALPHA * xv.w + g.w * v.w);
          }
        } break;
        case 2: {
#pragma unroll 8
          for (int it = 0; it < 16; ++it) {
            const int row = it * 8 + r0;
            const float4 v = *(const float4*)(Ct + row * 128 + c4);

            if (((c4 >> 5) & 1) == 0) {
              const float4 u = *(const float4*)(Ct + row * 128 + c4 + 32);
              const float a0 = v.x * W8_INV, a1 = v.y * W8_INV, a2 = v.z * W8_INV, a3 = v.w * W8_INV;
              *(unsigned*)((unsigned char*)p->ACT + ((size_t)mtile * 128 + row) * 256 + aux * 64 + (c4 >> 6) * 32 + (c4 & 31)) =
                  pk_fp8x4(silu_f(a0) * (u.x * W8_INV), silu_f(a1) * (u.y * W8_INV), silu_f(a2) * (u.z * W8_INV), silu_f(a3) * (u.w * W8_INV));
            }
          }
        } break;
        case 3: {
#pragma unroll 16
          for (int it = 0; it < 16; ++it) {
            const int row = it * 8 + r0;
            const float4 v = *(const float4*)(Ct + row * 128 + c4);

            const float g = s_gate[row] * W8_INV;
            u32x2 o; o.x = pk_bf16(g * v.x, g * v.y); o.y = pk_bf16(g * v.z, g * v.w);
            *(u32x2*)(p->OUT2 + ((size_t)mtile * 128 + row) * 1024 + n0 + c4) = o;
          }
        } break;
        case 4: {
#pragma unroll 4
          for (int it = 0; it < 16; ++it) {
            const int row = it * 8 + r0;
            const float4 v = *(const float4*)(Ct + row * 128 + c4);

            float4 o4 = v;
            if (aux == 0) o4 = make_float4(tanhf(v.x), tanhf(v.y), tanhf(v.z), tanhf(v.w));
            else if (aux == 2) o4 = make_float4(sigm_f(v.x), sigm_f(v.y), sigm_f(v.z), sigm_f(v.w));
            u32x2 o; o.x = pk_bf16(o4.x, o4.y); o.y = pk_bf16(o4.z, o4.w);
            *(u32x2*)(p->L1 + (size_t)(m0 + row) * 384 + aux * 128 + c4) = o;
          }
        } break;
        default: {
#pragma unroll 4
          for (int it = 0; it < 16; ++it) {
            const int row = it * 8 + r0;
            const float4 v = *(const float4*)(Ct + row * 128 + c4);

            bf16_t* rr = p->RW + (size_t)(m0 + row) * RWS + c05 + c4;
            const float vv[4] = {v.x, v.y, v.z, v.w};
            if (aux < 8) {
              const float4 b0 = *(const float4*)(p->rwkv_w0 + (j * 2 + d5) * 512 + c05 + c4);
              const float bb[4] = {b0.x, b0.y, b0.z, b0.w};
              float e4[4];
#pragma unroll
              for (int q = 0; q < 4; ++q) e4[q] = expf(-softplus_f(-(bb[q] + vv[q])) - 0.5f);
              u32x2 o; o.x = pk_bf16(e4[0], e4[1]); o.y = pk_bf16(e4[2], e4[3]);
              *(u32x2*)(rr + (3 + d5) * 512) = o;
            } else if (aux < 16) {
              const float4 b0 = *(const float4*)(p->rwkv_a0 + (j * 2 + d5) * 512 + c05 + c4);
              const float4 k1 = *(const float4*)(p->rwkv_kvec + (j * 2 + 1) * 512 + c05 + c4);
              const u32x2 kx2 = *(const u32x2*)(rr + 10 * 512);
              const float bb[4] = {b0.x, b0.y, b0.z, b0.w}, kk1[4] = {k1.x, k1.y, k1.z, k1.w};
              const float kx[4] = {bflo(kx2.x), bfhi(kx2.x), bflo(kx2.y), bfhi(kx2.y)};
              float av[4], ke[4];
#pragma unroll
              for (int q = 0; q < 4; ++q) { av[q] = sigm_f(bb[q] + vv[q]); ke[q] = kx[q] * (1.f + (av[q] - 1.f) * kk1[q]); }
              u32x2 o; o.x = pk_bf16(av[0], av[1]); o.y = pk_bf16(av[2], av[3]);
              *(u32x2*)(rr + (7 + d5) * 512) = o;
              o.x = pk_bf16(ke[0], ke[1]); o.y = pk_bf16(ke[2], ke[3]);
              *(u32x2*)(rr + (5 + d5) * 512) = o;
            } else {
              u32x2 o; o.x = pk_bf16(v.x, v.y); o.y = pk_bf16(v.z, v.w);
              *(u32x2*)(rr + 9 * 512) = o;
            }
          }
        } break;
      }
    }
    __syncthreads();
  }
}

__device__ void ph_final_ln(KP p, int layer, bool keep, char* lds) {
  const int tid = opaque_tid();
  const int lane = tid & 63, wave = tid >> 6;
  const int rows = keep ? NT : NL;
  int* s_base = (int*)(lds + META_OFF);
  if (tid == 0) {
    int a = 0;
#pragma unroll 1
    for (int e = 0; e < 64; ++e) { s_base[e] = a * 128; a += (p->cnt[e * CSTR] + 127) >> 7; }
    s_base[64] = a * 128;
  }
  __syncthreads();
  const float* lng = p->ln_g + (layer * 2 + 1) * 1024;
  const float* lnb = p->ln_b + (layer * 2 + 1) * 1024;
  for (int t = blockIdx.x * 4 + wave; t < rows; t += gridDim.x * 4) {
    const int mr = modrow(t);
    const float* g2 = p->MOD + (layer * 9 + mr) * 6144 + 5120;
    const bf16_t* src[7];
#pragma unroll
    for (int k = 0; k < 6; ++k) {
      const int v = p->tsl[t * 6 + k];
      src[k] = p->OUT2 + (size_t)(s_base[v >> 16] + (v & 0xffff)) * 1024;
    }
    src[6] = p->OUT2 + (size_t)(s_base[64] + t) * 1024;
    float v[16];
    float s = 0.f;
#pragma unroll
    for (int c = 0; c < 2; ++c) {
      const int n0 = c * 512 + lane * 8;
      float y[8];
#pragma unroll
      for (int q = 0; q < 8; ++q) y[q] = 0.f;
#pragma unroll
      for (int k = 0; k < 7; ++k) {
        const u32x4 u = *(const u32x4*)(src[k] + n0);
        y[0] += bflo(u.x); y[1] += bfhi(u.x); y[2] += bflo(u.y); y[3] += bfhi(u.y);
        y[4] += bflo(u.z); y[5] += bfhi(u.z); y[6] += bflo(u.w); y[7] += bfhi(u.w);
      }
      const float4 xa = *(const float4*)(p->X + (size_t)t * DM + n0), xb = *(const float4*)(p->X + (size_t)t * DM + n0 + 4);
      const float4 ga = *(const float4*)(g2 + n0), gb = *(const float4*)(g2 + n0 + 4);
      const float xx[8] = {xa.x, xa.y, xa.z, xa.w, xb.x, xb.y, xb.z, xb.w};
      const float gg[8] = {ga.x, ga.y, ga.z, ga.w, gb.x, gb.y, gb.z, gb.w};
#pragma unroll
      for (int q = 0; q < 8; ++q) { v[c * 8 + q] = DN_ALPHA * xx[q] + gg[q] * y[q]; s += v[c * 8 + q]; }
    }
    const float mean = wsum(s) * (1.f / 1024.f);
    float q2 = 0.f;
#pragma unroll
    for (int i = 0; i < 16; ++i) { const float d = v[i] - mean; q2 += d * d; }
    const float rs = rsqrtf(wsum(q2) * (1.f / 1024.f) + 1e-5f);
    const float* modn = p->MOD + ((layer + 1) * 9 + mr) * 6144;
#pragma unroll
    for (int c = 0; c < 2; ++c) {
      const int n0 = c * 512 + lane * 8;
      float xn[8];
#pragma unroll
      for (int q = 0; q < 8; ++q) xn[q] = (v[c * 8 + q] - mean) * rs * lng[n0 + q] + lnb[n0 + q];
      *(float4*)(p->X + (size_t)t * DM + n0) = make_float4(xn[0], xn[1], xn[2], xn[3]);
      *(float4*)(p->X + (size_t)t * DM + n0 + 4) = make_float4(xn[4], xn[5], xn[6], xn[7]);
      if (layer == 3) {
        *(float4*)(p->out + (size_t)t * DM + n0) = make_float4(xn[0], xn[1], xn[2], xn[3]);
        *(float4*)(p->out + (size_t)t * DM + n0 + 4) = make_float4(xn[4], xn[5], xn[6], xn[7]);
      } else {
        float hb[8];
#pragma unroll
        for (int q = 0; q < 8; ++q) hb[q] = xn[q] * (1.f + modn[1024 + n0 + q]) + modn[n0 + q];
        u32x4 o;
        o.x = pk_bf16(hb[0], hb[1]); o.y = pk_bf16(hb[2], hb[3]); o.z = pk_bf16(hb[4], hb[5]); o.w = pk_bf16(hb[6], hb[7]);
        *(u32x4*)(p->AB + (size_t)t * DM + n0) = o;
      }
    }
  }
}

#define XB_TMO      128
#define XB_XCNT(j)  (256  + 64 * (j))
#define XB_XSUB(j)  (1280 + 64 * (j))
#define XB_XGEN(j)  (2304 + 64 * (j))
#define XB_TOP      3328
#define XB_TOPGEN   3392
#define XB_SPIN_CAP (1u << 20)
#define LAS __attribute__((address_space(3)))
__device__ __forceinline__ unsigned xb_ld(unsigned* p) { return __hip_atomic_load(p, __ATOMIC_RELAXED, __HIP_MEMORY_SCOPE_AGENT); }
__device__ __forceinline__ unsigned xb_add(unsigned* p, unsigned v) { return __hip_atomic_fetch_add(p, v, __ATOMIC_RELAXED, __HIP_MEMORY_SCOPE_AGENT); }
__device__ __forceinline__ unsigned xb_xcc_id() { return (unsigned)__builtin_amdgcn_s_getreg((3 << 11) | 20) & 0xFu; }
#define XB_SPIN(cond, bar) do { unsigned _sp = 0; while (cond) { __builtin_amdgcn_s_sleep(1); \
    if ((++_sp & 255u) == 0u) { if (xb_ld(&(bar)[XB_TMO])) break; if (_sp > XB_SPIN_CAP) { atomicAdd(&(bar)[XB_TMO], 1u); break; } } } } while (0)
struct XcdBarrier { unsigned* bar; unsigned x; volatile LAS unsigned* st; };
__device__ __forceinline__ XcdBarrier xcd_barrier_post(unsigned* bar, volatile LAS unsigned* st) {
  XcdBarrier b; b.bar = bar; b.x = xb_xcc_id(); b.st = st;
  if (threadIdx.x == 0) (void)xb_add(&bar[XB_XCNT(b.x)], 1u);
  return b;
}
__device__ __forceinline__ void xcd_barrier_complete(unsigned* bar, unsigned x, unsigned& nloc, unsigned& nx) {
  const unsigned G = gridDim.x;
  unsigned sum, cnt, mine, sp = 0u;
  for (;;) {
    sum = 0u; cnt = 0u; mine = 0u;
#pragma unroll
    for (unsigned j = 0; j < 16; ++j) { const unsigned c = xb_ld(&bar[XB_XCNT(j)]); sum += c; cnt += (c > 0u) ? 1u : 0u; mine = (j == x) ? c : mine; }
    if (sum == G) break;
    __builtin_amdgcn_s_sleep(1);
    if ((++sp & 255u) == 0u) { if (xb_ld(&bar[XB_TMO])) break; if (sp > XB_SPIN_CAP) { atomicAdd(&bar[XB_TMO], 1u); break; } }
  }
  nloc = mine > 0u ? mine : 1u; nx = cnt > 0u ? cnt : 1u;
}
__device__ __forceinline__ void xcd_barrier(const XcdBarrier& b) {
  asm volatile("s_waitcnt vmcnt(0)" ::: "memory");
  __syncthreads();
  if (threadIdx.x == 0) {
    unsigned* bar = b.bar;
    __builtin_amdgcn_s_waitcnt(0);
    unsigned nloc = b.st[0], nx = b.st[1];
    if (nloc == 0u) { xcd_barrier_complete(bar, b.x, nloc, nx); b.st[0] = nloc; b.st[1] = nx; }
    const unsigned old = xb_add(&bar[XB_XSUB(b.x)], 1u);
    const unsigned gen = old / nloc;
    if (old + 1u == (gen + 1u) * nloc) {
      __builtin_amdgcn_fence(__ATOMIC_RELEASE, "agent");
      asm volatile("s_waitcnt vmcnt(0)" ::: "memory");
      const unsigned og = xb_add(&bar[XB_TOP], 1u);
      const unsigned tg = og / nx;
      if (og + 1u == (tg + 1u) * nx) xb_add(&bar[XB_TOPGEN], 1u);
      else XB_SPIN(xb_ld(&bar[XB_TOPGEN]) == tg, bar);
      __builtin_amdgcn_fence(__ATOMIC_ACQUIRE, "agent");
      xb_add(&bar[XB_XGEN(b.x)], 1u);
      asm volatile("s_waitcnt vmcnt(0)" ::: "memory");
    } else {
      XB_SPIN(xb_ld(&bar[XB_XGEN(b.x)]) == gen, bar);
      __builtin_amdgcn_fence(__ATOMIC_ACQUIRE, "agent");
      asm volatile("s_waitcnt vmcnt(0)" ::: "memory");
    }
  }
  __syncthreads();
}

constexpr int NSLOTS = 13;
constexpr int NPHASE = 2 + 4 * NSLOTS;
__device__ __forceinline__ bool phase_is_nop(int ph) {
  if (ph < 2) return false;
  const int layer = (ph - 2) / NSLOTS, st = (ph - 2) % NSLOTS;
  if (st == 5 || st == 6) return true;
  return !(layer & 1) && (st == 1 || (st >= 3 && st <= 7));
}
__device__ void run_phase(KP p, int ph, char* sm) {
  if (ph == 0) { ph_init(p, sm); return; }
  if (ph == 1) { ph_mod_h(p, sm); return; }
  const int layer = (ph - 2) / NSLOTS, st = (ph - 2) % NSLOTS;
  const bool odd = layer & 1;
  const bool keep = layer < 3;
  int gk = -1;
  if (st == 0) gk = 0;
  else if (st == 8) gk = 1;
  else if (st == 10) gk = 2;
  else if (st == 11) gk = 3;
  else if (odd && st == 2) gk = 4;
  else if (odd && st == 3) gk = 5;
  asm volatile("" : "+s"(gk));
  if (gk >= 0) {
    if (gk == 2 || gk == 3) moe_prefix(p, keep ? NT : NL, (int*)(sm + META_OFF), opaque_tid());
    ph_gemm(p, gk, layer, keep, sm);
    if (gk == 5) { __syncthreads(); ph_mlstm_s2(p, sm); }
    return;
  }
  switch (st) {
    case 1: if (odd) { ph_rwkv_mix(p, layer); ph_mlstm_s1(p, layer, sm); } break;
    case 2: ph_attention(p, layer, keep, sm); break;
    case 4: if (odd) ph_scan_a(p, layer, sm); break;
    case 7: if (odd) ph_rec_final(p, layer, keep); break;
    case 9: ph_ln_router(p, layer, keep, sm); break;
    case 12: ph_final_ln(p, layer, keep, sm); break;
  }
}

__global__ void __launch_bounds__(NTHR, 2) mega_kernel(Params kargs) {
  extern __shared__ __attribute__((aligned(16))) char sm[];
  cg::grid_group grid = cg::this_grid();
  volatile LAS unsigned* st = (volatile LAS unsigned*)(sm + META_OFF + 4032);
  if (threadIdx.x == 0) { st[0] = 0u; st[1] = 0u; }
  __syncthreads();
  const XcdBarrier xb = xcd_barrier_post(kargs.bar, st);
  for (int ph = kargs.ph_lo; ph < kargs.ph_hi; ++ph) {
    if (phase_is_nop(ph)) continue;
    {
      KP kp = (KP)__builtin_amdgcn_kernarg_segment_ptr();
      asm volatile("" : "+s"(kp));
      run_phase(kp, ph, sm);
    }
    if (ph + 1 < kargs.ph_hi) {
      if (ph == 0) grid.sync();
      else xcd_barrier(xb);
    }
  }
}

extern "C" void kernel_launch(void* const* d_in, const int* in_sizes, int n_in, void* d_out, int out_size, void* d_ws,
                              size_t ws_size, hipStream_t stream) {
  static int grid_blocks = 0;
  if (!grid_blocks) {
    int dev = 0, cus = 0, per_cu = 0;
    (void)hipGetDevice(&dev);
    (void)hipDeviceGetAttribute(&cus, hipDeviceAttributeMultiprocessorCount, dev);
    (void)hipFuncSetAttribute((const void*)mega_kernel, hipFuncAttributeMaxDynamicSharedMemorySize, SMEM_BYTES);
    (void)hipOccupancyMaxActiveBlocksPerMultiprocessor(&per_cu, mega_kernel, NTHR, SMEM_BYTES);
    if (per_cu < 1) per_cu = 1;
    if (per_cu > 2) per_cu = 2;
    grid_blocks = cus * per_cu;
  }
  Params p;
  memset(&p, 0, sizeof(p));
  const float** pin = (const float**)&p;
  for (int i = 0; i < 35; ++i) pin[i] = (const float*)d_in[i];
  p.out = (float*)d_out;
  char* w = (char*)d_ws;
  size_t off = 0;
  auto take = [&](size_t bytes) { char* r = w + off; off += (bytes + 255) & ~(size_t)255; return r; };
  p.Wt_att = (bf16_t*)take((size_t)2 * ATT_N * 1024 * 2);
  p.Wt_rec = (bf16_t*)take((size_t)2 * REC_NP * 1024 * 2);
  p.Wt_out = (bf16_t*)take((size_t)4 * 1024 * 1024 * 2);
  p.Wt13 = (bf16_t*)take((size_t)4 * 65 * 512 * 1024);
  p.Wt2 = (bf16_t*)take((size_t)4 * 65 * 1024 * 256);
  p.Wl1 = (bf16_t*)take((size_t)2 * 3 * 128 * 512 * 2);
  p.Wl2 = (bf16_t*)take((size_t)2 * 2560 * 128 * 2);
  p.X = (float*)take((size_t)NT * DM * 4);
  p.AB = (bf16_t*)take((size_t)NT * DM * 2);
  p.MOD = (float*)take((size_t)5 * 9 * 6144 * 4);
  p.MODP = (float*)take((size_t)8 * 4 * 9 * 6144 * 4);
  p.GP = (float*)take((size_t)NT * 16 * 4);
  p.ROPE = (float*)take((size_t)64 * 16 * 2 * 4);
  p.WrT = (float*)take((size_t)4 * 64 * 1024 * 4);
  p.msc = (float*)take((size_t)3 * NMT * 4);
  p.lgate = (float*)take((size_t)64 * NT * 4);
  p.ltok = (int*)take((size_t)64 * NT * 4);
  p.tsl = (int*)take((size_t)NT * 6 * 4);
  p.cnt = (int*)take((size_t)65 * CSTR * 4);
  p.bar = (unsigned*)take((size_t)BAR_TOTAL_WORDS * 4);
  char* region = take(0);
  const size_t szP = (size_t)NT * LDP * 2, szRW = (size_t)NT * RWS * 2, szMS = (size_t)NMT * 16384 * 2,
               szMSn = (size_t)NMT * 128 * 4;
  const size_t szT = (size_t)NT * DM * 4, szOUT2 = (size_t)NSLOT * 1024 * 2;
  p.P = (bf16_t*)region;
  p.RW = (bf16_t*)(region + szP);
  p.MS = (bf16_t*)(region + szP + szRW);
  p.MSn = (float*)(region + szP + szRW + szMS);
  p.Tb = (float*)region;
  p.ACT = (bf16_t*)region;
  p.OUT2 = (bf16_t*)(region + szT);
  const size_t szZ = (size_t)NT * 2048 * 2;
  p.Zb = (bf16_t*)(region + szP + szRW + szMS + szMSn);
  p.L1 = p.Zb + (size_t)NT * 1536;
  size_t mixer = szP + szRW + szMS + szMSn + szZ, moe = szT + szOUT2;
  off += (mixer > moe ? mixer : moe);
  if (off > ws_size) { fprintf(stderr, "workspace too small: need %zu have %zu\n", off, ws_size); return; }
  p.ph_lo = 0;
  p.ph_hi = NPHASE;
  (void)hipMemsetAsync(p.bar, 0, (size_t)BAR_TOTAL_WORDS * 4, stream);
  void* args[] = {&p};
  hipError_t e = hipLaunchCooperativeKernel((void*)mega_kernel, dim3(grid_blocks), dim3(NTHR), args, SMEM_BYTES, stream);
  if (e != hipSuccess) fprintf(stderr, "cooperative launch failed: %s (grid %d)\n", hipGetErrorString(e), grid_blocks);
}
```

```cpp
#include <hip/hip_runtime.h>
#include <hip/hip_cooperative_groups.h>
#include <cstdio>
#include <cstring>
namespace cg = cooperative_groups;

constexpr int DM = 1024;
constexpr int NBATCH = 8;
constexpr int SEQ = 2048;
constexpr int CTXL = 256;
constexpr int NL = NBATCH * SEQ;
constexpr int NC = NBATCH * CTXL;
constexpr int NT = NL + NC;
constexpr int TSC = CTXL + SEQ;
constexpr int LDP = 4112;
constexpr int ATT_N = 2304;
constexpr int REC_N = 4112;
constexpr int REC_NP = 4224;
constexpr int NCHUNK = 36;
constexpr int NMT = 64 * NCHUNK;
constexpr int RWS = 5632;
constexpr int NSLOT = 137216;
constexpr float DN_ALPHA = 1.6817928305074290f;
constexpr int NTHR = 256;
constexpr int SMEM_BYTES = 65536 + 4096;
constexpr int META_OFF = 65536;
#define XCD_BAR_WORDS 3456
constexpr int CSTR = 32;
constexpr int BAR_TOTAL_WORDS = XCD_BAR_WORDS + 64;

typedef unsigned short bf16_t;
using bf16x8 = __attribute__((ext_vector_type(8))) short;
using f32x16 = __attribute__((ext_vector_type(16))) float;
using u32x4 = __attribute__((ext_vector_type(4))) unsigned;
using u32x2 = __attribute__((ext_vector_type(2))) unsigned;

struct Params {
  const float *x, *c, *ctx, *c_ctx, *ada_w, *ada_b, *ln_g, *ln_b, *mix_w_out, *att_w_in, *na_rpb, *qk_gain,
      *rec_w_in, *rwkv_mu, *rwkv_w0, *rwkv_w1, *rwkv_w2, *rwkv_a0, *rwkv_a1, *rwkv_a2, *rwkv_g1, *rwkv_g2,
      *rwkv_kvec, *rwkv_rk, *rwkv_gn, *mlstm_gate_b, *mlstm_norm, *moe_router, *moe_bias, *moe_w1, *moe_w3,
      *moe_w2, *shared_w1, *shared_w3, *shared_w2;
  float* out;
  bf16_t *Wt_att, *Wt_rec, *Wt_out, *Wt13, *Wt2, *Wl1, *Wl2;
  bf16_t *Zb, *L1;
  float *X, *MOD, *MODP, *GP, *msc, *lgate, *MSn, *Tb, *ROPE, *WrT;
  bf16_t *AB, *P, *RW, *MS, *ACT, *OUT2;
  int *cnt, *ltok, *tsl;
  unsigned* bar;
  int ph_lo, ph_hi;
};

typedef const Params __attribute__((address_space(4))) * KP;

__device__ __forceinline__ int modrow(int t) { return t < NL ? (t >> 11) : 8; }
__device__ __forceinline__ float silu_f(float x) { return x / (1.f + expf(-x)); }
__device__ __forceinline__ float sigm_f(float x) { return 1.f / (1.f + expf(-x)); }
__device__ __forceinline__ float softplus_f(float x) { return fmaxf(x, 0.f) + log1pf(expf(-fabsf(x))); }
template <int CTRL>
__device__ __forceinline__ float dppx(float x) {
  return __int_as_float(__builtin_amdgcn_update_dpp(0, __float_as_int(x), CTRL, 0xf, 0xf, true));
}
__device__ __forceinline__ float rdlane(float v, int l) {
  return __int_as_float(__builtin_amdgcn_readlane(__float_as_int(v), l));
}
__device__ __forceinline__ float wsum(float v) {
  v += dppx<0xB1>(v); v += dppx<0x4E>(v); v += dppx<0x141>(v); v += dppx<0x140>(v);
  return (rdlane(v, 0) + rdlane(v, 16)) + (rdlane(v, 32) + rdlane(v, 48));
}
__device__ __forceinline__ float wmax(float v) {
  v = fmaxf(v, dppx<0xB1>(v)); v = fmaxf(v, dppx<0x4E>(v)); v = fmaxf(v, dppx<0x141>(v)); v = fmaxf(v, dppx<0x140>(v));
  return fmaxf(fmaxf(rdlane(v, 0), rdlane(v, 16)), fmaxf(rdlane(v, 32), rdlane(v, 48)));
}
__device__ __forceinline__ int opaque_tid() {
  int t = threadIdx.x;
  asm volatile("" : "+v"(t));
  return t;
}
typedef __bf16 bf16x2_t __attribute__((ext_vector_type(2)));
typedef float f32x2_t __attribute__((ext_vector_type(2)));
__device__ __forceinline__ unsigned pk_bf16(float lo, float hi) {
  const f32x2_t v = {lo, hi};
  return __builtin_bit_cast(unsigned, __builtin_convertvector(v, bf16x2_t));
}
__device__ __forceinline__ bf16_t f2bf(float x) { return (bf16_t)(pk_bf16(x, 0.f) & 0xffffu); }
__device__ __forceinline__ float bf2f(bf16_t v) { return __uint_as_float((unsigned)v << 16); }
__device__ __forceinline__ float bflo(unsigned u) { return __uint_as_float(u << 16); }
__device__ __forceinline__ float bfhi(unsigned u) { return __uint_as_float(u & 0xffff0000u); }
__device__ __forceinline__ int scan_row(int dir, int b, int tau) {
  if (tau < CTXL) return NL + b * CTXL + (dir ? (CTXL - 1 - tau) : tau);
  int s = tau - CTXL;
  return b * SEQ + (dir ? (SEQ - 1 - s) : s);
}

template <class RowPtrA>
__device__ __forceinline__ void gemm128_main(int tid, RowPtrA rowA, const bf16_t* __restrict__ Bt, int K, int n0,
                                             char* lds, f32x16 (&acc)[2][2]) {
  const int lane = tid & 63, w = tid >> 6;
  const int wm = w >> 1, wn = w & 1, r = lane & 31, h = lane >> 5;
  const int c = tid & 7, sr = tid >> 3;
  const int lc = (c ^ ((tid >> 4) & 7)) * 8;
  const bf16_t* ap[4];
#pragma unroll
  for (int i = 0; i < 4; ++i) ap[i] = rowA(sr + 32 * i) + lc;
  const bf16_t* bp0 = Bt + (size_t)(n0 + sr) * K + lc;
  const int bstr = 32 * K;
#pragma unroll
  for (int mi = 0; mi < 2; ++mi)
#pragma unroll
    for (int ni = 0; ni < 2; ++ni)
#pragma unroll
      for (int q = 0; q < 16; ++q) acc[mi][ni][q] = 0.f;
  const int nk = K >> 6;
  auto issue = [&](int kt) {
    char* As = lds + (kt & 1) * 32768 + tid * 16;
    const int k0 = kt * 64;
#pragma unroll
    for (int i = 0; i < 4; ++i) {
      __builtin_amdgcn_global_load_lds((const unsigned*)(ap[i] + k0), (__attribute__((address_space(3))) unsigned*)(As + i * 4096), 16, 0, 0);
      __builtin_amdgcn_global_load_lds((const unsigned*)(bp0 + i * bstr + k0), (__attribute__((address_space(3))) unsigned*)(As + 16384 + i * 4096), 16, 0, 0);
    }
  };
  issue(0);
  const int sw = (r >> 1) & 7;
#pragma unroll 1
  for (int kt = 0; kt < nk; ++kt) {
    asm volatile("s_waitcnt vmcnt(0)" ::: "memory");
    __syncthreads();
    if (kt + 1 < nk) issue(kt + 1);
    const char* As = lds + (kt & 1) * 32768;
    const char* Ar = As + (wm * 64 + r) * 128;
    const char* Br = As + 16384 + (wn * 64 + r) * 128;
#pragma unroll
    for (int ks = 0; ks < 4; ++ks) {
      const int off = ((ks * 2 + h) ^ sw) * 16;
      const bf16x8 a0 = *(const bf16x8*)(Ar + off);
      const bf16x8 a1 = *(const bf16x8*)(Ar + 32 * 128 + off);
      const bf16x8 b0 = *(const bf16x8*)(Br + off);
      const bf16x8 b1 = *(const bf16x8*)(Br + 32 * 128 + off);
      acc[0][0] = __builtin_amdgcn_mfma_f32_32x32x16_bf16(a0, b0, acc[0][0], 0, 0, 0);
      acc[0][1] = __builtin_amdgcn_mfma_f32_32x32x16_bf16(a0, b1, acc[0][1], 0, 0, 0);
      acc[1][0] = __builtin_amdgcn_mfma_f32_32x32x16_bf16(a1, b0, acc[1][0], 0, 0, 0);
      acc[1][1] = __builtin_amdgcn_mfma_f32_32x32x16_bf16(a1, b1, acc[1][1], 0, 0, 0);
    }
  }
  __syncthreads();
}
using i64 = long;
template <class RowPtrA8>
__device__ __forceinline__ void gemm128_fp8(int tid, RowPtrA8 rowA, const unsigned char* __restrict__ Bt, int K, int n0,
                                            char* lds, f32x16 (&acc)[2][2]) {
  const int lane = tid & 63, w = tid >> 6;
  const int wm = w >> 1, wn = w & 1, r = lane & 31, h = lane >> 5;
  const int c = tid & 7, sr = tid >> 3;
  const int lc = (c ^ ((tid >> 4) & 7)) * 16;
  const unsigned char* ap[4];
#pragma unroll
  for (int i = 0; i < 4; ++i) ap[i] = rowA(sr + 32 * i) + lc;
  const unsigned char* bp0 = Bt + (size_t)(n0 + sr) * K + lc;
  const int bstr = 32 * K;
#pragma unroll
  for (int mi = 0; mi < 2; ++mi)
#pragma unroll
    for (int ni = 0; ni < 2; ++ni)
#pragma unroll
      for (int q = 0; q < 16; ++q) acc[mi][ni][q] = 0.f;
  const int nk = K >> 7;
  auto issue = [&](int kt) {
    char* As = lds + (kt & 1) * 32768 + tid * 16;
    const int k0 = kt * 128;
#pragma unroll
    for (int i = 0; i < 4; ++i) {
      __builtin_amdgcn_global_load_lds((const unsigned*)(ap[i] + k0), (__attribute__((address_space(3))) unsigned*)(As + i * 4096), 16, 0, 0);
      __builtin_amdgcn_global_load_lds((const unsigned*)(bp0 + i * bstr + k0), (__attribute__((address_space(3))) unsigned*)(As + 16384 + i * 4096), 16, 0, 0);
    }
  };
  issue(0);
  const int sw = (r >> 1) & 7;
#pragma unroll 1
  for (int kt = 0; kt < nk; ++kt) {
    asm volatile("s_waitcnt vmcnt(0)" ::: "memory");
    __syncthreads();
    if (kt + 1 < nk) issue(kt + 1);
    const char* As = lds + (kt & 1) * 32768;
    const char* Ar = As + (wm * 64 + r) * 128;
    const char* Br = As + 16384 + (wn * 64 + r) * 128;
#pragma unroll
    for (int q = 0; q < 4; ++q) {
      const int off = ((q * 2 + h) ^ sw) * 16;
      const u32x4 a0 = *(const u32x4*)(Ar + off);
      const u32x4 a1 = *(const u32x4*)(Ar + 32 * 128 + off);
      const u32x4 b0 = *(const u32x4*)(Br + off);
      const u32x4 b1 = *(const u32x4*)(Br + 32 * 128 + off);
      const i64 a0l = (i64)(((unsigned long long)a0.y << 32) | a0.x), a0h = (i64)(((unsigned long long)a0.w << 32) | a0.z);
      const i64 a1l = (i64)(((unsigned long long)a1.y << 32) | a1.x), a1h = (i64)(((unsigned long long)a1.w << 32) | a1.z);
      const i64 b0l = (i64)(((unsigned long long)b0.y << 32) | b0.x), b0h = (i64)(((unsigned long long)b0.w << 32) | b0.z);
      const i64 b1l = (i64)(((unsigned long long)b1.y << 32) | b1.x), b1h = (i64)(((unsigned long long)b1.w << 32) | b1.z);
      acc[0][0] = __builtin_amdgcn_mfma_f32_32x32x16_fp8_fp8(a0l, b0l, acc[0][0], 0, 0, 0);
      acc[0][1] = __builtin_amdgcn_mfma_f32_32x32x16_fp8_fp8(a0l, b1l, acc[0][1], 0, 0, 0);
      acc[1][0] = __builtin_amdgcn_mfma_f32_32x32x16_fp8_fp8(a1l, b0l, acc[1][0], 0, 0, 0);
      acc[1][1] = __builtin_amdgcn_mfma_f32_32x32x16_fp8_fp8(a1l, b1l, acc[1][1], 0, 0, 0);
      acc[0][0] = __builtin_amdgcn_mfma_f32_32x32x16_fp8_fp8(a0h, b0h, acc[0][0], 0, 0, 0);
      acc[0][1] = __builtin_amdgcn_mfma_f32_32x32x16_fp8_fp8(a0h, b1h, acc[0][1], 0, 0, 0);
      acc[1][0] = __builtin_amdgcn_mfma_f32_32x32x16_fp8_fp8(a1h, b0h, acc[1][0], 0, 0, 0);
      acc[1][1] = __builtin_amdgcn_mfma_f32_32x32x16_fp8_fp8(a1h, b1h, acc[1][1], 0, 0, 0);
    }
  }
  __syncthreads();
}
template <class F>
__device__ __forceinline__ void acc_foreach(int tid, const f32x16 (&acc)[2][2], F f) {
  const int lane = tid & 63, w = tid >> 6;
  const int wm = w >> 1, wn = w & 1, r = lane & 31, h = lane >> 5;
#pragma unroll
  for (int mi = 0; mi < 2; ++mi)
#pragma unroll
    for (int ni = 0; ni < 2; ++ni)
#pragma unroll
      for (int q = 0; q < 16; ++q) {
        const int row = wm * 64 + mi * 32 + (q & 3) + 8 * (q >> 2) + 4 * h;
        const int col = wn * 64 + ni * 32 + r;
        f(row, col, acc[mi][ni][q]);
        if ((q & 3) == 3) __builtin_amdgcn_sched_barrier(0);
      }
}

template <class RM>
__device__ __forceinline__ void tr_tile(int tid, const float* __restrict__ src, int N, int k0, int n0,
                                        bf16_t* __restrict__ dst, int K, RM rowmap, float* tile) {
  {
    const int tx = tid & 15, ty = tid >> 4;
    const int n = n0 + tx * 4;
#pragma unroll
    for (int i = 0; i < 4; ++i) {
      const int k = ty + 16 * i;
      float4 v = make_float4(0.f, 0.f, 0.f, 0.f);
      if (n < N) v = *(const float4*)(src + (size_t)(k0 + k) * N + n);
      tile[k * 65 + tx * 4 + 0] = v.x; tile[k * 65 + tx * 4 + 1] = v.y;
      tile[k * 65 + tx * 4 + 2] = v.z; tile[k * 65 + tx * 4 + 3] = v.w;
    }
  }
  __syncthreads();
  {
    const int kc = tid & 7;
#pragma unroll
    for (int i = 0; i < 2; ++i) {
      const int n = (tid >> 3) + 32 * i;
      if (n0 + n < N) {
        float v[8];
#pragma unroll
        for (int q = 0; q < 8; ++q) v[q] = tile[(kc * 8 + q) * 65 + n];
        u32x4 o;
        o.x = pk_bf16(v[0], v[1]); o.y = pk_bf16(v[2], v[3]); o.z = pk_bf16(v[4], v[5]); o.w = pk_bf16(v[6], v[7]);
        *(u32x4*)(dst + (size_t)rowmap(n0 + n) * K + k0 + kc * 8) = o;
      }
    }
  }
  __syncthreads();
}

constexpr float W8_SCALE = 32.f, W8_INV = 1.f / 32.f;
__device__ __forceinline__ unsigned pk_fp8x4(float a, float b, float c, float d) {
  int r = __builtin_amdgcn_cvt_pk_fp8_f32(a, b, 0, false);
  r = __builtin_amdgcn_cvt_pk_fp8_f32(c, d, r, true);
  return (unsigned)r;
}
template <class RM>
__device__ __forceinline__ void tr_tile_fp8(int tid, const float* __restrict__ src, int N, int k0, int n0,
                                            unsigned char* __restrict__ dst, int K, RM rowmap, float* tile) {
  {
    const int tx = tid & 15, ty = tid >> 4;
    const int n = n0 + tx * 4;
#pragma unroll
    for (int i = 0; i < 4; ++i) {
      const int k = ty + 16 * i;
      const float4 v = *(const float4*)(src + (size_t)(k0 + k) * N + n);
      tile[k * 65 + tx * 4 + 0] = v.x; tile[k * 65 + tx * 4 + 1] = v.y;
      tile[k * 65 + tx * 4 + 2] = v.z; tile[k * 65 + tx * 4 + 3] = v.w;
    }
  }
  __syncthreads();
  {
    const int kc = tid & 3, n = tid >> 2;
    float v[16];
#pragma unroll
    for (int q = 0; q < 16; ++q) v[q] = tile[(kc * 16 + q) * 65 + n] * W8_SCALE;
    u32x4 o;
    o.x = pk_fp8x4(v[0], v[1], v[2], v[3]); o.y = pk_fp8x4(v[4], v[5], v[6], v[7]);
    o.z = pk_fp8x4(v[8], v[9], v[10], v[11]); o.w = pk_fp8x4(v[12], v[13], v[14], v[15]);
    *(u32x4*)(dst + (size_t)rowmap(n0 + n) * K + k0 + kc * 16) = o;
  }
  __syncthreads();
}

constexpr int CJ0 = 1152, CJ1 = CJ0 + 2080, CJ2 = CJ1 + 1024, CJ3 = CJ2 + 33280, CJ4 = CJ3 + 16640;
__device__ void convert_job(KP p, int job, float* sm, int tid) {
  if (job < CJ0) {
    const int j = job / 576, rem = job % 576, kt = rem / 36, nt = rem % 36;
    tr_tile(tid, p->att_w_in + (size_t)j * 1024 * ATT_N, ATT_N, kt * 64, nt * 64, p->Wt_att + (size_t)j * ATT_N * 1024,
            1024, [](int n) { return n; }, sm);
  } else if (job < CJ1) {
    const int q = job - CJ0;
    const int j = q / 1040, rem = q % 1040, kt = rem / 65, nt = rem % 65;
    tr_tile(tid, p->rec_w_in + (size_t)j * 1024 * REC_N, REC_N, kt * 64, nt * 64, p->Wt_rec + (size_t)j * REC_NP * 1024,
            1024, [](int n) { return n; }, sm);
  } else if (job < CJ2) {
    const int q = job - CJ1;
    const int i = q >> 8, rem = q & 255, kt = rem >> 4, nt = rem & 15;
    tr_tile(tid, p->mix_w_out + (size_t)i * 1024 * 1024, 1024, kt * 64, nt * 64, p->Wt_out + (size_t)i * 1024 * 1024,
            1024, [](int n) { return n; }, sm);
  } else if (job < CJ3) {
    const int q = job - CJ2;
    const int le = q >> 7, rem = q & 127;
    const int which = rem >> 6, kt = (rem >> 2) & 15, nt = rem & 3;
    const int layer = le / 65, e = le % 65;
    const float* src;
    if (e < 64) src = (which ? p->moe_w3 : p->moe_w1) + (size_t)(layer * 64 + e) * 1024 * 256;
    else src = (which ? p->shared_w3 : p->shared_w1) + (size_t)layer * 1024 * 256;
    tr_tile_fp8(tid, src, 256, kt * 64, nt * 64, (unsigned char*)p->Wt13 + (size_t)le * 512 * 1024, 1024,
                [which](int n) { return 64 * (n >> 5) + which * 32 + (n & 31); }, sm);
  } else {
    const int q = job - CJ3;
    const int le = q >> 6, rem = q & 63;
    const int kt = rem >> 4, nt = rem & 15;
    const int layer = le / 65, e = le % 65;
    const float* src = e < 64 ? p->moe_w2 + (size_t)(layer * 64 + e) * 256 * 1024 : p->shared_w2 + (size_t)layer * 256 * 1024;
    tr_tile_fp8(tid, src, 1024, kt * 64, nt * 64, (unsigned char*)p->Wt2 + (size_t)le * 1024 * 256, 256, [](int n) { return n; }, sm);
  }
}
__device__ __forceinline__ int conv_stage_total(int stage) {
  return stage == 0 ? (576 + 1040 + 512 + 8320 + 4160) : (stage == 1 ? (576 + 1040 + 256 + 16640 + 8320) : (256 + 8320 + 4160));
}
__device__ __forceinline__ int conv_stage_job(int stage, int q) {
  if (stage == 0) {
    if (q < 8320) return CJ2 + q;  q -= 8320;
    if (q < 4160) return CJ3 + q;  q -= 4160;
    if (q < 576) return q;  q -= 576;
    if (q < 1040) return CJ0 + q;  q -= 1040;
    return CJ1 + q;
  } else if (stage == 1) {
    if (q < 8320) return CJ2 + 8320 + q;  q -= 8320;
    if (q < 4160) return CJ3 + 4160 + q;  q -= 4160;
    if (q < 576) return 576 + q;  q -= 576;
    if (q < 256) return CJ1 + 512 + q;  q -= 256;
    if (q < 8320) return CJ2 + 16640 + q;  q -= 8320;
    if (q < 4160) return CJ3 + 8320 + q;  q -= 4160;
    return CJ0 + 1040 + q;
  }
  if (q < 256) return CJ1 + 768 + q;  q -= 256;
  if (q < 8320) return CJ2 + 24960 + q;  q -= 8320;
  return CJ3 + 12480 + q;
}

struct CvDesc { const float* src; unsigned char* dst; int N, K, k0, n0, which; };
__device__ __forceinline__ bool conv_desc_fp8(KP p, int job, CvDesc& d) {
  if (job < CJ2) return false;
  if (job < CJ3) {
    const int q = job - CJ2;
    const int le = q >> 7, rem = q & 127;
    const int which = rem >> 6, kt = (rem >> 2) & 15, nt = rem & 3;
    const int layer = le / 65, e = le % 65;
    if (e < 64) d.src = (which ? p->moe_w3 : p->moe_w1) + (size_t)(layer * 64 + e) * 1024 * 256;
    else d.src = (which ? p->shared_w3 : p->shared_w1) + (size_t)layer * 1024 * 256;
    d.dst = (unsigned char*)p->Wt13 + (size_t)le * 512 * 1024;
    d.N = 256; d.K = 1024; d.k0 = kt * 64; d.n0 = nt * 64; d.which = which;
  } else {
    const int q = job - CJ3;
    const int le = q >> 6, rem = q & 63;
    const int kt = rem >> 4, nt = rem & 15;
    const int layer = le / 65, e = le % 65;
    d.src = e < 64 ? p->moe_w2 + (size_t)(layer * 64 + e) * 256 * 1024 : p->shared_w2 + (size_t)layer * 256 * 1024;
    d.dst = (unsigned char*)p->Wt2 + (size_t)le * 1024 * 256;
    d.N = 1024; d.K = 256; d.k0 = kt * 64; d.n0 = nt * 64; d.which = -1;
  }
  return true;
}
typedef float cvf4 __attribute__((ext_vector_type(4)));
__device__ __forceinline__ void cv_load(const CvDesc& d, int tid, cvf4& v0, cvf4& v1, cvf4& v2, cvf4& v3) {
  const int tx = tid & 15, ty = tid >> 4;
  const float* s0 = d.src + (size_t)(d.k0 + ty) * d.N + d.n0 + tx * 4;
  v0 = *(const cvf4*)(s0);
  v1 = *(const cvf4*)(s0 + (size_t)16 * d.N);
  v2 = *(const cvf4*)(s0 + (size_t)32 * d.N);
  v3 = *(const cvf4*)(s0 + (size_t)48 * d.N);
}
__device__ __forceinline__ void cv_emit(const CvDesc& d, int tid, const cvf4 v0, const cvf4 v1, const cvf4 v2, const cvf4 v3, float* tile) {
  {
    const int tx = tid & 15, ty = tid >> 4;
    float* t0 = tile + ty * 65 + tx * 4;
    t0[0] = v0.x; t0[1] = v0.y; t0[2] = v0.z; t0[3] = v0.w;
    t0[16 * 65 + 0] = v1.x; t0[16 * 65 + 1] = v1.y; t0[16 * 65 + 2] = v1.z; t0[16 * 65 + 3] = v1.w;
    t0[32 * 65 + 0] = v2.x; t0[32 * 65 + 1] = v2.y; t0[32 * 65 + 2] = v2.z; t0[32 * 65 + 3] = v2.w;
    t0[48 * 65 + 0] = v3.x; t0[48 * 65 + 1] = v3.y; t0[48 * 65 + 2] = v3.z; t0[48 * 65 + 3] = v3.w;
  }
  __syncthreads();
  {
    const int kc = tid & 3, n = tid >> 2;
    float v[16];
#pragma unroll
    for (int q = 0; q < 16; ++q) v[q] = tile[(kc * 16 + q) * 65 + n] * W8_SCALE;
    u32x4 o;
    o.x = pk_fp8x4(v[0], v[1], v[2], v[3]); o.y = pk_fp8x4(v[4], v[5], v[6], v[7]);
    o.z = pk_fp8x4(v[8], v[9], v[10], v[11]); o.w = pk_fp8x4(v[12], v[13], v[14], v[15]);
    const int nn = d.n0 + n;
    const int row = d.which >= 0 ? 64 * (nn >> 5) + d.which * 32 + (nn & 31) : nn;
    *(u32x4*)(d.dst + (size_t)row * d.K + d.k0 + kc * 16) = o;
  }
  __syncthreads();
}
__device__ __forceinline__ void convert_run(KP p, int stage, int jj, int j1, float* sm, int tid) {
  CvDesc d, dn;
  cvf4 a0, a1, a2, a3, b0, b1, b2, b3;
  bool cur = false;
#pragma unroll 1
  for (; jj < j1; ++jj) {
    const int job = conv_stage_job(stage, jj);
    if (!cur) {
      if (!conv_desc_fp8(p, job, d)) { convert_job(p, job, sm, tid); continue; }
      cv_load(d, tid, a0, a1, a2, a3);
    }
    bool nxt = false;
    if (jj + 1 < j1) {
      nxt = conv_desc_fp8(p, conv_stage_job(stage, jj + 1), dn);
      if (nxt) cv_load(dn, tid, b0, b1, b2, b3);
    }
    cv_emit(d, tid, a0, a1, a2, a3, sm);
    if (nxt) { d = dn; a0 = b0; a1 = b1; a2 = b2; a3 = b3; }
    cur = nxt;
  }
}

__device__ void ph_init(KP p, char* smc) {
  float* sm = (float*)smc;
  const int tid = opaque_tid();
  {
    const size_t n4a = (size_t)NL * DM / 4, n4b = (size_t)NC * DM / 4;
    const float4* xs = (const float4*)p->x;
    const float4* cs = (const float4*)p->ctx;
    float4* X4 = (float4*)p->X;
    for (size_t i = (size_t)blockIdx.x * NTHR + tid; i < n4a + n4b; i += (size_t)gridDim.x * NTHR)
      X4[i] = i < n4a ? xs[i] : cs[i - n4a];
  }
  for (int tile = blockIdx.x; tile < 96 * 8; tile += gridDim.x) {
    const int ct = tile >> 3, ks = tile & 7;
    for (int i = tid; i < 9 * 128; i += NTHR) {
      const int r = i >> 7, k = ks * 128 + (i & 127);
      const float v = r < 8 ? p->c[r * 1024 + k] : p->c_ctx[k];
      sm[i] = silu_f(v);
    }
    __syncthreads();
    const int col = ct * 256 + tid;
    const int layer = col / 6144, n = col % 6144;
    const float* W = p->ada_w + ((size_t)layer * 1024 + ks * 128) * 6144 + n;
    float acc[9];
#pragma unroll
    for (int r = 0; r < 9; ++r) acc[r] = 0.f;
#pragma unroll 4
    for (int k = 0; k < 128; ++k) {
      const float w = W[(size_t)k * 6144];
#pragma unroll
      for (int r = 0; r < 9; ++r) acc[r] = fmaf(sm[r * 128 + k], w, acc[r]);
    }
#pragma unroll
    for (int r = 0; r < 9; ++r) p->MODP[((size_t)(ks * 4 + layer) * 9 + r) * 6144 + n] = acc[r];
    __syncthreads();
  }
  {
    const int total = conv_stage_total(0), chunk = (total + gridDim.x - 1) / gridDim.x;
    const int lo = min((int)blockIdx.x * chunk, total), hi = min(lo + chunk, total);
    __syncthreads();
    convert_run(p, 0, lo, hi, sm, tid);
  }
  for (int i = blockIdx.x * NTHR + tid; i < 2 * 3 * 128 * 512; i += gridDim.x * NTHR) {
    const int k = i & 511, n = (i >> 9) & 127, wj = i >> 16;
    const int j = wj / 3, which = wj % 3;
    float v = 0.f;
    if (which < 2) {
      if (n < 64) v = (which ? p->rwkv_a1 : p->rwkv_w1)[((size_t)(j * 2 + (n >> 5)) * 512 + k) * 32 + (n & 31)];
    } else if (n < 96) v = p->rwkv_g1[((size_t)j * 512 + k) * 96 + n];
    p->Wl1[i] = f2bf(v);
  }
  for (int i = blockIdx.x * NTHR + tid; i < 2 * 2560 * 128; i += gridDim.x * NTHR) {
    const int k = i & 127, n = (i >> 7) % 2560, j = i / (2560 * 128);
    float v = 0.f;
    if (n < 2048) {
      const int d = (n >> 9) & 1, c = n & 511;
      if (k < 64 && (k >> 5) == d) v = (n < 1024 ? p->rwkv_w2 : p->rwkv_a2)[((size_t)(j * 2 + d) * 32 + (k & 31)) * 512 + c];
    } else if (k < 96) v = p->rwkv_g2[((size_t)j * 96 + k) * 512 + (n - 2048)];
    p->Wl2[i] = f2bf(v);
  }
  for (int i = blockIdx.x * NTHR + tid; i < 4 * 64 * 1024; i += gridDim.x * NTHR) {
    const int k = i & 1023, n = (i >> 10) & 63, l = i >> 16;
    p->WrT[i] = p->moe_router[((size_t)l * 1024 + k) * 64 + n];
  }
  for (int i = blockIdx.x * NTHR + tid; i < 64 * 16; i += gridDim.x * NTHR) {
    const int pos = i >> 4, f = i & 15;
    const float ang = (float)pos * powf(10000.f, -(float)f / 16.f);
    p->ROPE[2 * i] = cosf(ang);
    p->ROPE[2 * i + 1] = sinf(ang);
  }
}

__device__ void ph_mod_h(KP p, char* smc) {
  float* sm = (float*)smc;
  const int tid = opaque_tid();
  for (int i = blockIdx.x * NTHR + tid; i < 4 * 9 * 6144; i += gridDim.x * NTHR) {
    const int layer = i / (9 * 6144), rem = i % (9 * 6144), n = rem % 6144;
    float s = p->ada_b[layer * 6144 + n];
#pragma unroll
    for (int ks = 0; ks < 8; ++ks) s += p->MODP[(size_t)(ks * 4 + layer) * 9 * 6144 + rem];
    p->MOD[i] = s;
  }
  const int lane = tid & 63, wave = tid >> 6;
  const int per = (((NT + gridDim.x - 1) / gridDim.x) + 3) & ~3;
  const int t0 = blockIdx.x * per, t1 = min(NT, t0 + per);
  int cur = -1;
  for (int tb = t0; tb < t1; tb += 4) {
    const int mr = modrow(tb);
    if (mr != cur) {
      __syncthreads();
      for (int n = tid; n < 2048; n += NTHR) {
        float a = p->ada_b[n];
#pragma unroll
        for (int ks = 0; ks < 8; ++ks) a += p->MODP[((size_t)(ks * 4) * 9 + mr) * 6144 + n];
        sm[n] = a;
      }
      cur = mr;
      __syncthreads();
    }
    const int t = tb + wave;
    if (t < t1) {
      const float* src = t < NL ? p->x + (size_t)t * DM : p->ctx + (size_t)(t - NL) * DM;
#pragma unroll
      for (int i = 0; i < 4; ++i) {
        const int n = i * 256 + lane * 4;
        const float4 xv = *(const float4*)(src + n);
        const float4 sh = *(const float4*)(sm + n);
        const float4 sc = *(const float4*)(sm + 1024 + n);
        u32x2 o;
        o.x = pk_bf16(xv.x * (1.f + sc.x) + sh.x, xv.y * (1.f + sc.y) + sh.y);
        o.y = pk_bf16(xv.z * (1.f + sc.z) + sh.z, xv.w * (1.f + sc.w) + sh.w);
        *(u32x2*)(p->AB + (size_t)t * DM + n) = o;
      }
    }
  }
}

typedef short v4i16_t __attribute__((ext_vector_type(4)));
using s16x4 = __attribute__((ext_vector_type(4))) short;
__device__ __forceinline__ s16x4 vtr(const char* p) {
  return __builtin_bit_cast(s16x4, __builtin_amdgcn_ds_read_tr16_b64_v4i16((__attribute__((address_space(3))) v4i16_t*)p));
}
#define MFMA32(a, b, c) __builtin_amdgcn_mfma_f32_32x32x16_bf16(a, b, c, 0, 0, 0)
__device__ void ph_attention(KP p, int layer, bool keep, char* lds) {
  const int tid = opaque_tid();
  const int lane = tid & 63, w = tid >> 6, r32 = lane & 31, hi = lane >> 5;
  const int j = layer >> 1;
  float* bias_lds = (float*)(lds + 32768 + 1024);
  const int n_gqa = 1024, n_na = 1024, n_cb = keep ? 128 : 0, n_ca = keep ? 128 : 0;
  const int total = n_gqa + n_na + n_cb + n_ca;
  constexpr float LOG2E = 1.4426950408889634f;
  constexpr float C2 = 0.125f * LOG2E;
  const int c = tid & 7, sr = tid >> 3;
  const int kso = (c ^ ((tid >> 4) & 7)) * 16;
  const int vso = (c >> 2) * 4096 + (c & 3) * 16;
  const int sw = (r32 >> 1) & 7;
  for (int item = blockIdx.x; item < total; item += gridDim.x) {
    int b, qrow0, qoff, koff, voff, ocol, lat_tiles, lat_row0;
    bool na = false;
    int r_w = 0, start_w = 0, ru0 = 0, hN = 0;
    if (item < n_gqa) {
      b = item >> 7;
      const int g = (item >> 6) & 1, tt = item & 63;
      qrow0 = b * SEQ + tt * 32; qoff = 1536 + (g * 4 + w) * 64; koff = 2048 + g * 64; voff = 2176 + g * 64;
      ocol = 512 + (g * 4 + w) * 64; lat_tiles = 32; lat_row0 = b * SEQ;
    } else if (item < n_gqa + n_na) {
      const int it = item - n_gqa;
      b = it >> 7; hN = (it >> 4) & 7;
      const int rp = it & 15;
      na = true; r_w = 2 * rp + (w >> 1);
      qrow0 = b * SEQ + r_w * 64 + (w & 1) * 32; qoff = hN * 64; koff = 512 + hN * 64; voff = 1024 + hN * 64; ocol = hN * 64;
      const int s0 = min(max(2 * rp - 4, 0), 24), s1 = min(max(2 * rp - 3, 0), 24);
      start_w = (w >> 1) ? s1 : s0; ru0 = s0; lat_tiles = (s1 != s0) ? 9 : 8; lat_row0 = b * SEQ + ru0 * 64;
    } else if (item < n_gqa + n_na + n_cb) {
      const int it = item - n_gqa - n_na;
      b = it >> 4;
      const int g = (it >> 3) & 1, tt = it & 7;
      qrow0 = NL + b * CTXL + tt * 32; qoff = 1536 + (g * 4 + w) * 64; koff = 2048 + g * 64; voff = 2176 + g * 64;
      ocol = 512 + (g * 4 + w) * 64; lat_tiles = 0; lat_row0 = 0;
    } else {
      const int it = item - n_gqa - n_na - n_cb;
      b = it >> 4;
      const int h = (it >> 1) & 7, half = it & 1;
      qrow0 = NL + b * CTXL + half * 128 + w * 32; qoff = h * 64; koff = 512 + h * 64; voff = 1024 + h * 64; ocol = h * 64;
      lat_tiles = 0; lat_row0 = 0;
    }
    const int ctx_row0 = NL + b * CTXL, ntiles = lat_tiles + 4;
    if (na)
      for (int i = tid; i < 465; i += NTHR) bias_lds[i] = p->na_rpb[(j * 8 + hN) * 465 + i] * LOG2E;
    bf16x8 qf[4];
    {
      const bf16_t* qp = p->P + (size_t)(qrow0 + r32) * LDP + qoff + hi * 8;
#pragma unroll
      for (int d0 = 0; d0 < 4; ++d0) qf[d0] = *(const bf16x8*)(qp + d0 * 16);
    }
    f32x16 o0, o1;
#pragma unroll
    for (int q = 0; q < 16; ++q) { o0[q] = 0.f; o1[q] = 0.f; }
    float m = -INFINITY, l = 0.f;
    u32x4 kr0, kr1, vr0, vr1;
    auto gload = [&](int t) {
      const int row0 = t < lat_tiles ? lat_row0 + 64 * t : ctx_row0 + 64 * (t - lat_tiles);
      const bf16_t* base = p->P + (size_t)(row0 + sr) * LDP + c * 8;
      kr0 = *(const u32x4*)(base + koff); kr1 = *(const u32x4*)(base + (size_t)32 * LDP + koff);
      vr0 = *(const u32x4*)(base + voff); vr1 = *(const u32x4*)(base + (size_t)32 * LDP + voff);
    };
    auto swrite = [&](int buf) {
      char* Kb = lds + buf * 16384;
      char* Vb = Kb + 8192;
      *(u32x4*)(Kb + sr * 128 + kso) = kr0; *(u32x4*)(Kb + (sr + 32) * 128 + kso) = kr1;
      *(u32x4*)(Vb + vso + sr * 64) = vr0; *(u32x4*)(Vb + vso + (sr + 32) * 64) = vr1;
    };
    gload(0);
    swrite(0);
    for (int t = 0; t < ntiles; ++t) {
      __syncthreads();
      if (t + 1 < ntiles) gload(t + 1);
      const bool na_tile = na && t < lat_tiles;
      const int kr = ru0 + t;
      const bool part = !na_tile || (kr >= start_w && kr < start_w + 8);
      if (part) {
        const char* Ks = lds + (t & 1) * 16384;
        const char* Vs = Ks + 8192;
        f32x16 s0, s1;
#pragma unroll
        for (int q = 0; q < 16; ++q) { s0[q] = 0.f; s1[q] = 0.f; }
#pragma unroll
        for (int d0 = 0; d0 < 4; ++d0) {
          const int off = ((2 * d0 + hi) ^ sw) * 16;
          const bf16x8 k0 = *(const bf16x8*)(Ks + r32 * 128 + off);
          const bf16x8 k1 = *(const bf16x8*)(Ks + (32 + r32) * 128 + off);
          s0 = MFMA32(k0, qf[d0], s0);
          s1 = MFMA32(k1, qf[d0], s1);
        }
        float mx = -INFINITY;
        if (na_tile) {
          const int cq = (w & 1) * 32 + r32;
          const int c0 = min(max(cq - 8, 0), 48);
          const float* brow = bias_lds + (kr - r_w + 7) * 31 + (15 - cq);
#pragma unroll
          for (int q = 0; q < 16; ++q) {
            const int kc = (q & 3) + 8 * (q >> 2) + 4 * hi;
            const float v0 = ((unsigned)(kc - c0) < 16u) ? fmaf(s0[q], C2, brow[kc]) : -INFINITY;
            const float v1 = ((unsigned)(kc + 32 - c0) < 16u) ? fmaf(s1[q], C2, brow[kc + 32]) : -INFINITY;
            s0[q] = v0; s1[q] = v1;
            mx = fmaxf(mx, fmaxf(v0, v1));
          }
        } else {
#pragma unroll
          for (int q = 0; q < 16; ++q) {
            s0[q] *= C2; s1[q] *= C2;
            mx = fmaxf(mx, fmaxf(s0[q], s1[q]));
          }
        }
        {
          auto rr = __builtin_amdgcn_permlane32_swap(__float_as_uint(mx), __float_as_uint(mx), false, false);
          mx = fmaxf(__uint_as_float(rr[0]), __uint_as_float(rr[1]));
        }
        const float mnew = fmaxf(m, mx);
        const float alpha = __builtin_amdgcn_exp2f(m - mnew);
        float ls = 0.f;
#pragma unroll
        for (int q = 0; q < 16; ++q) {
          s0[q] = __builtin_amdgcn_exp2f(s0[q] - mnew);
          s1[q] = __builtin_amdgcn_exp2f(s1[q] - mnew);
          ls += s0[q] + s1[q];
        }
        l = l * alpha + ls;
        m = mnew;
#pragma unroll
        for (int q = 0; q < 16; ++q) { o0[q] *= alpha; o1[q] *= alpha; }
        bf16x8 pf[4];
#pragma unroll
        for (int s = 0; s < 4; ++s) {
          const int u = (s & 1) * 8;
          u32x4 tpk;
          if (s < 2) {
            tpk.x = pk_bf16(s0[u + 0], s0[u + 1]); tpk.y = pk_bf16(s0[u + 2], s0[u + 3]);
            tpk.z = pk_bf16(s0[u + 4], s0[u + 5]); tpk.w = pk_bf16(s0[u + 6], s0[u + 7]);
          } else {
            tpk.x = pk_bf16(s1[u + 0], s1[u + 1]); tpk.y = pk_bf16(s1[u + 2], s1[u + 3]);
            tpk.z = pk_bf16(s1[u + 4], s1[u + 5]); tpk.w = pk_bf16(s1[u + 6], s1[u + 7]);
          }
          pf[s] = __builtin_bit_cast(bf16x8, tpk);
        }
        const char* vb = Vs + ((lane >> 4) & 1) * 32 + (lane & 3) * 8 + ((lane & 15) >> 2) * 64 + hi * 256;
#pragma unroll
        for (int s = 0; s < 4; ++s) {
          const s16x4 a00 = vtr(vb + (16 * s) * 64), a01 = vtr(vb + (16 * s + 8) * 64);
          const s16x4 a10 = vtr(vb + 4096 + (16 * s) * 64), a11 = vtr(vb + 4096 + (16 * s + 8) * 64);
          const bf16x8 A0 = __builtin_shufflevector(a00, a01, 0, 1, 2, 3, 4, 5, 6, 7);
          const bf16x8 A1 = __builtin_shufflevector(a10, a11, 0, 1, 2, 3, 4, 5, 6, 7);
          o0 = MFMA32(A0, pf[s], o0);
          o1 = MFMA32(A1, pf[s], o1);
        }
      }
      if (t + 1 < ntiles) swrite((t + 1) & 1);
    }
    __syncthreads();
    const float lt = l + __shfl_xor(l, 32);
    const float inv = 1.f / lt;
    bf16_t* op = p->AB + (size_t)(qrow0 + r32) * DM + ocol + 4 * hi;
#pragma unroll
    for (int g = 0; g < 4; ++g) {
      u32x2 v0, v1;
      v0.x = pk_bf16(o0[4 * g] * inv, o0[4 * g + 1] * inv); v0.y = pk_bf16(o0[4 * g + 2] * inv, o0[4 * g + 3] * inv);
      v1.x = pk_bf16(o1[4 * g] * inv, o1[4 * g + 1] * inv); v1.y = pk_bf16(o1[4 * g + 2] * inv, o1[4 * g + 3] * inv);
      *(u32x2*)(op + 8 * g) = v0;
      *(u32x2*)(op + 32 + 8 * g) = v1;
    }
  }
}

__device__ void ph_rwkv_mix(KP p, int layer) {
  const int j = layer >> 1;
  const int tid = opaque_tid();
  const int lane = tid & 63, wave = tid >> 6;
  const float* mu = p->rwkv_mu + j * 6 * 512;
  const int c0 = lane * 8;
  auto unpack = [](const u32x4 u, float (&f)[8]) {
    f[0] = bflo(u.x); f[1] = bfhi(u.x); f[2] = bflo(u.y); f[3] = bfhi(u.y);
    f[4] = bflo(u.z); f[5] = bfhi(u.z); f[6] = bflo(u.w); f[7] = bfhi(u.w);
  };
  auto pack = [](const float (&f)[8]) {
    u32x4 o;
    o.x = pk_bf16(f[0], f[1]); o.y = pk_bf16(f[2], f[3]); o.z = pk_bf16(f[4], f[5]); o.w = pk_bf16(f[6], f[7]);
    return o;
  };
  for (int t = blockIdx.x * 4 + wave; t < NT; t += gridDim.x * 4) {
    bool hasp, hasn;
    if (t < NL) { int s = t & 2047; hasp = s > 0; hasn = s < SEQ - 1; }
    else { int s = (t - NL) & 255; hasp = s > 0; hasn = s < CTXL - 1; }
    const bf16_t* pt = p->P + (size_t)t * LDP + c0;
    bf16_t* rw = p->RW + (size_t)t * RWS + c0;
    bf16_t* zb = p->Zb + (size_t)t * 1536 + c0;
    const u32x4 zero = {0u, 0u, 0u, 0u};
#pragma unroll
    for (int q = 0; q < 4; ++q) {
      float cur[8], pv[8], nx[8], d[8];
      unpack(*(const u32x4*)(pt + q * 512), cur);
      unpack(hasp ? *(const u32x4*)(pt + q * 512 - LDP) : zero, pv);
      unpack(hasn ? *(const u32x4*)(pt + q * 512 + LDP) : zero, nx);
#pragma unroll
      for (int e = 0; e < 8; ++e) d[e] = 0.5f * (pv[e] + nx[e]) - cur[e];
      if (q < 3) {
        float o[8];
        const float* m = mu + q * 512 + c0;
#pragma unroll
        for (int e = 0; e < 8; ++e) o[e] = cur[e] + d[e] * m[e];
        if (q == 0) *(u32x4*)(rw) = pack(o);
        else if (q == 2) *(u32x4*)(rw + 512) = pack(o);
        else {
          *(u32x4*)(rw + 10 * 512) = pack(o);
          float kk[8], ss = 0.f;
          const float* kv0 = p->rwkv_kvec + (j * 2 + 0) * 512 + c0;
#pragma unroll
          for (int e = 0; e < 8; ++e) { kk[e] = o[e] * kv0[e]; ss += kk[e] * kk[e]; }
          ss += dppx<0xB1>(ss); ss += dppx<0x4E>(ss); ss += dppx<0x141>(ss);
          const float rn = rsqrtf(fmaxf(ss, 1e-24f));
#pragma unroll
          for (int e = 0; e < 8; ++e) kk[e] *= rn;
          *(u32x4*)(rw + 2 * 512) = pack(kk);
        }
      } else {
#pragma unroll
        for (int z = 0; z < 3; ++z) {
          float o[8];
          const float* m = mu + (3 + z) * 512 + c0;
#pragma unroll
          for (int e = 0; e < 8; ++e) o[e] = cur[e] + d[e] * m[e];
          *(u32x4*)(zb + z * 512) = pack(o);
        }
      }
    }
  }
}

constexpr int RS_STEP = 384;
constexpr int RS_TB = 16;
struct RwkvStage { u32x2 r, kk, e, ke, a, v; };
__device__ void rwkv_unit(KP p, int unit, float* sm, int tid) {
  const int ch = unit >> 1, hf = unit & 1;
  const int dir = ch >> 6, b = (ch >> 3) & 7, h = ch & 7;
  const int lane = tid & 63, w = tid >> 6, rl = lane >> 3, ks = lane & 7;
  float* ybuf = sm + 2 * RS_TB * RS_STEP;
  const int ss = tid >> 4, kq = tid & 15;
  auto gload = [&](int n, RwkvStage& g) {
    const int row = scan_row(dir, b, n * RS_TB + ss);
    const bf16_t* base = p->RW + (size_t)row * RWS + h * 64 + kq * 4;
    g.r = *(const u32x2*)(base);
    g.kk = *(const u32x2*)(base + 2 * 512);
    g.e = *(const u32x2*)(base + (3 + dir) * 512);
    g.ke = *(const u32x2*)(base + (5 + dir) * 512);
    g.a = *(const u32x2*)(base + (7 + dir) * 512);
    g.v = *(const u32x2*)(p->RW + (size_t)row * RWS + 512 + h * 64 + hf * 32 + (kq & 7) * 4);
  };
  auto swrite = [&](int buf, const RwkvStage& g) {
    float* sp = sm + (buf * RS_TB + ss) * RS_STEP;
    const float r0 = bflo(g.r.x), r1 = bfhi(g.r.x), r2 = bflo(g.r.y), r3 = bfhi(g.r.y);
    const float k0 = bflo(g.kk.x), k1 = bfhi(g.kk.x), k2 = bflo(g.kk.y), k3 = bfhi(g.kk.y);
    const float w0 = __expf(-bflo(g.e.x)), w1 = __expf(-bfhi(g.e.x)), w2 = __expf(-bflo(g.e.y)), w3 = __expf(-bfhi(g.e.y));
    const float e0 = bflo(g.ke.x), e1 = bfhi(g.ke.x), e2 = bflo(g.ke.y), e3 = bfhi(g.ke.y);
    const float a0 = k0 * bflo(g.a.x), a1 = k1 * bfhi(g.a.x), a2 = k2 * bflo(g.a.y), a3 = k3 * bfhi(g.a.y);
    *(float4*)(sp + kq * 4) = make_float4(k0, k1, k2, k3);
    *(float4*)(sp + 64 + kq * 4) = make_float4(w0 * r0, w1 * r1, w2 * r2, w3 * r3);
    *(float4*)(sp + 128 + kq * 4) = make_float4(w0, w1, w2, w3);
    *(float4*)(sp + 192 + kq * 4) = make_float4(a0, a1, a2, a3);
    *(float4*)(sp + 256 + kq * 4) = make_float4(e0, e1, e2, e3);
    if (kq < 8) *(float4*)(sp + 320 + kq * 4) = make_float4(bflo(g.v.x), bfhi(g.v.x), bflo(g.v.y), bfhi(g.v.y));
    float c1 = a0 * r0 + a1 * r1 + a2 * r2 + a3 * r3;
    float c2 = e0 * r0 + e1 * r1 + e2 * r2 + e3 * r3;
    c1 += dppx<0xB1>(c1); c2 += dppx<0xB1>(c2);
    c1 += dppx<0x4E>(c1); c2 += dppx<0x4E>(c2);
    c1 += dppx<0x141>(c1); c2 += dppx<0x141>(c2);
    c1 += dppx<0x140>(c1); c2 += dppx<0x140>(c2);
    if (kq == 0) { sp[352] = c1; sp[353] = c2; }
  };
  typedef float f2 __attribute__((ext_vector_type(2)));
  f2 S01 = {0.f, 0.f}, S23 = {0.f, 0.f}, S45 = {0.f, 0.f}, S67 = {0.f, 0.f};
  auto compute = [&](int n) {
    const float* bp = sm + (n & 1) * RS_TB * RS_STEP;
    float* yb = ybuf + (n & 1) * RS_TB * 32 + w * 8 + rl;
    struct Ops { f2 k[4], r[4], w[4], a[4], e[4]; float vv; f2 c; };
    auto ld = [&](int s, Ops& o) {
      const float* sq = bp + s * RS_STEP;
      const f2* sp = (const f2*)(sq + ks * 8);
#pragma unroll
      for (int i = 0; i < 4; ++i) { o.k[i] = sp[i]; o.r[i] = sp[32 + i]; o.w[i] = sp[64 + i]; o.a[i] = sp[96 + i]; o.e[i] = sp[128 + i]; }
      o.vv = sq[320 + w * 8 + rl]; o.c = *(const f2*)(sq + 352);
    };
    auto step = [&](const Ops& o) -> float {
      f2 sa2 = S01 * o.k[0];
      f2 y2 = S01 * o.r[0];
      sa2 = __builtin_elementwise_fma(S23, o.k[1], sa2); y2 = __builtin_elementwise_fma(S23, o.r[1], y2);
      sa2 = __builtin_elementwise_fma(S45, o.k[2], sa2); y2 = __builtin_elementwise_fma(S45, o.r[2], y2);
      sa2 = __builtin_elementwise_fma(S67, o.k[3], sa2); y2 = __builtin_elementwise_fma(S67, o.r[3], y2);
      float sa = sa2.x + sa2.y, y0 = y2.x + y2.y;
      sa += dppx<0xB1>(sa); y0 += dppx<0xB1>(y0);
      sa += dppx<0x4E>(sa); y0 += dppx<0x4E>(y0);
      sa += dppx<0x141>(sa); y0 += dppx<0x141>(y0);
      sa = -sa;
      const f2 sav = {sa, sa}, vvv = {o.vv, o.vv};
      S01 = __builtin_elementwise_fma(vvv, o.e[0], __builtin_elementwise_fma(sav, o.a[0], S01 * o.w[0]));
      S23 = __builtin_elementwise_fma(vvv, o.e[1], __builtin_elementwise_fma(sav, o.a[1], S23 * o.w[1]));
      S45 = __builtin_elementwise_fma(vvv, o.e[2], __builtin_elementwise_fma(sav, o.a[2], S45 * o.w[2]));
      S67 = __builtin_elementwise_fma(vvv, o.e[3], __builtin_elementwise_fma(sav, o.a[3], S67 * o.w[3]));
      return fmaf(o.vv, o.c.y, fmaf(sa, o.c.x, y0));
    };
    Ops oa, ob;
    ld(0, oa);
#pragma unroll 1
    for (int s = 0; s < RS_TB; s += 2) {
      __builtin_amdgcn_sched_barrier(0);
      ld(s + 1, ob);
      __builtin_amdgcn_sched_barrier(0);
      float y0 = step(oa);
      asm volatile("" : "+v"(y0));
      __builtin_amdgcn_sched_barrier(0);
      ld(s + 2, oa);
      __builtin_amdgcn_sched_barrier(0);
      float y1 = step(ob);
      asm volatile("" : "+v"(y1));
      __builtin_amdgcn_sched_barrier(0);
      if (ks == 0) { yb[s * 32] = y0; yb[(s + 1) * 32] = y1; }
    }
  };
  auto yout = [&](int n) {
    const int row = scan_row(dir, b, n * RS_TB + ss);
    const float* ys = ybuf + (n & 1) * RS_TB * 32 + ss * 32 + kq * 2;
    *(unsigned*)(p->P + (size_t)row * LDP + dir * 512 + h * 64 + hf * 32 + kq * 2) = pk_bf16(ys[0], ys[1]);
  };
  constexpr int NB = TSC / RS_TB;
  RwkvStage gA, gB;
  gload(0, gA);
  gload(1, gB);
  swrite(0, gA);
  gload(2, gA);
  __syncthreads();
  for (int n = 0; n < NB; n += 2) {
    compute(n);
    swrite(1, gB);
    if (n + 3 < NB) gload(n + 3, gB);
    __syncthreads();
    yout(n);
    compute(n + 1);
    if (n + 2 < NB) swrite(0, gA);
    if (n + 4 < NB) gload(n + 4, gA);
    __syncthreads();
    yout(n + 1);
  }
  __syncthreads();
}

__device__ void mlstm_s1(KP p, int layer, int tile, char* lds, int tid) {
  const int j = layer >> 1;
  const int ch = tile / NCHUNK, c = tile % NCHUNK;
  const int dir = ch >> 5, b = (ch >> 2) & 7, h = ch & 3;
  float* s_ws = (float*)(lds + META_OFF);
  int* s_row = (int*)(s_ws + 64);
  char* kimg = lds;
  char* vimg = lds + 16384;
  if (tid < 64) {
    const int row = scan_row(dir, b, c * 64 + tid);
    s_row[tid] = row;
    const float* g = p->GP + (size_t)row * 16;
    const float gi = g[(dir * 2) * 4 + h] + p->mlstm_gate_b[j * 16 + (dir * 2) * 4 + h];
    const float gf = g[(dir * 2 + 1) * 4 + h] + p->mlstm_gate_b[j * 16 + (dir * 2 + 1) * 4 + h];
    float bc = -softplus_f(-gf);
#pragma unroll
    for (int o = 1; o < 64; o <<= 1) {
      float tmp = __shfl_up(bc, o);
      if (tid >= o) bc += tmp;
    }
    const float bend = __shfl(bc, 63);
    const float ds = bend - bc + gi;
    const float mloc = wmax(ds);
    s_ws[tid] = expf(ds - mloc);
    if (tid == 0) { p->msc[tile] = mloc; p->msc[NMT + tile] = bend; }
  }
  __syncthreads();
  {
    const int c8 = tid & 15;
    const int ioff = (c8 >> 2) * 4096 + (c8 & 3) * 16;
#pragma unroll
    for (int i = 0; i < 4; ++i) {
      const int sidx = (tid >> 4) + 16 * i;
      const bf16_t* src = p->P + (size_t)s_row[sidx] * LDP + h * 128 + c8 * 8;
      const u32x4 kv = *(const u32x4*)(src + 2560);
      u32x4 vv = *(const u32x4*)(src + 3072);
      const float wsv = s_ws[sidx];
      vv.x = pk_bf16(bflo(vv.x) * wsv, bfhi(vv.x) * wsv); vv.y = pk_bf16(bflo(vv.y) * wsv, bfhi(vv.y) * wsv);
      vv.z = pk_bf16(bflo(vv.z) * wsv, bfhi(vv.z) * wsv); vv.w = pk_bf16(bflo(vv.w) * wsv, bfhi(vv.w) * wsv);
      *(u32x4*)(kimg + ioff + sidx * 64) = kv;
      *(u32x4*)(vimg + ioff + sidx * 64) = vv;
    }
  }
  __syncthreads();
  const int lane = tid & 63, w = tid >> 6, wm = w >> 1, wn = w & 1, r32 = lane & 31, hi = lane >> 5;
  f32x16 acc[2][2];
#pragma unroll
  for (int mi = 0; mi < 2; ++mi)
#pragma unroll
    for (int ni = 0; ni < 2; ++ni)
#pragma unroll
      for (int q = 0; q < 16; ++q) acc[mi][ni][q] = 0.f;
  const int toff = ((lane >> 4) & 1) * 32 + (lane & 3) * 8 + ((lane & 15) >> 2) * 64 + hi * 256;
#pragma unroll
  for (int ks = 0; ks < 4; ++ks) {
    bf16x8 af[2], bfr[2];
#pragma unroll
    for (int i = 0; i < 2; ++i) {
      const char* ka = kimg + (wm * 2 + i) * 4096 + toff + (16 * ks) * 64;
      const char* va = vimg + (wn * 2 + i) * 4096 + toff + (16 * ks) * 64;
      af[i] = __builtin_shufflevector(vtr(ka), vtr(ka + 8 * 64), 0, 1, 2, 3, 4, 5, 6, 7);
      bfr[i] = __builtin_shufflevector(vtr(va), vtr(va + 8 * 64), 0, 1, 2, 3, 4, 5, 6, 7);
    }
    acc[0][0] = MFMA32(af[0], bfr[0], acc[0][0]);
    acc[0][1] = MFMA32(af[0], bfr[1], acc[0][1]);
    acc[1][0] = MFMA32(af[1], bfr[0], acc[1][0]);
    acc[1][1] = MFMA32(af[1], bfr[1], acc[1][1]);
  }
  bf16_t* U = p->MS + (size_t)tile * 16384;
#pragma unroll
  for (int mi = 0; mi < 2; ++mi)
#pragma unroll
    for (int ni = 0; ni < 2; ++ni)
#pragma unroll
      for (int q = 0; q < 16; ++q) {
        const int d = wm * 64 + mi * 32 + (q & 3) + 8 * (q >> 2) + 4 * hi;
        U[d * 128 + wn * 64 + ni * 32 + r32] = f2bf(acc[mi][ni][q]);
        if ((q & 3) == 3) __builtin_amdgcn_sched_barrier(0);
      }
  if (tid < 128) {
    const char* kc = kimg + (tid >> 5) * 4096 + (tid & 31) * 2;
    float a = 0.f;
#pragma unroll 8
    for (int sidx = 0; sidx < 64; ++sidx) a = fmaf(s_ws[sidx], bf2f(*(const bf16_t*)(kc + sidx * 64)), a);
    p->MSn[tile * 128 + tid] = a;
  }
}

__device__ void mlstm_s3(KP p, int layer, int tile, char* lds, int tid);
__device__ void ph_scan_a(KP p, int layer, char* smc) {
  float* sm = (float*)smc;
  const int tid = opaque_tid();
  __builtin_amdgcn_s_setprio(3);
  for (int u = blockIdx.x; u < 256; u += gridDim.x) rwkv_unit(p, u, sm, tid);
  __builtin_amdgcn_s_setprio(0);
  {
    const int stage = layer == 1 ? 1 : 2;
    const int nconv = conv_stage_total(stage);
    const int total = NMT + (nconv + 7) / 8;
    int* qc = (int*)(p->bar + XCD_BAR_WORDS + 16 * stage);
    int* s_q = (int*)(smc + META_OFF + 3968);
    int jj = 0, j1 = 0;
#pragma unroll 1
    for (;;) {
      if (jj >= j1) {
        __syncthreads();
        if (tid == 0) *s_q = atomicAdd(qc, 1);
        __syncthreads();
        const int q = *s_q;
        if (q >= total) break;
        if (q < NMT) { mlstm_s3(p, layer, q, smc, tid); continue; }
        jj = (q - NMT) * 8; j1 = min(jj + 8, nconv);
      }
      convert_run(p, stage, jj, j1, sm, tid);
      jj = j1;
    }
  }
}

__device__ void ph_mlstm_s2(KP p, char* smc) {
  float* sw = (float*)smc;
  const int tid = opaque_tid();
  const int nitems = 64 * 33;
  for (int item = blockIdx.x; item < nitems; item += gridDim.x) {
    const int ch = item / 33, seg = item % 33;
    __syncthreads();
    if (tid < 2 * NCHUNK) sw[72 + tid] = p->msc[(tid < NCHUNK ? 0 : NMT - NCHUNK) + ch * NCHUNK + tid];
    __syncthreads();
    if (tid == 0) {
      float m = 0.f;
      for (int c = 0; c < NCHUNK; ++c) {
        const int tile = ch * NCHUNK + c;
        const float mloc = sw[72 + c], bend = sw[72 + NCHUNK + c];
        const float mn = fmaxf(bend + m, mloc);
        sw[c] = expf(bend + m - mn);
        sw[36 + c] = expf(mloc - mn);
        if (seg == 0) p->msc[2 * NMT + tile] = m;
        m = mn;
      }
    }
    __syncthreads();
    if (seg < 32) {
      unsigned* base = (unsigned*)(p->MS + (size_t)ch * NCHUNK * 16384) + seg * 256 + tid;
      unsigned v[NCHUNK];
#pragma unroll
      for (int c = 0; c < NCHUNK; ++c) v[c] = base[(size_t)c * 8192];
      float C0 = 0.f, C1 = 0.f;
#pragma unroll
      for (int c = 0; c < NCHUNK; ++c) {
        const float t0 = bflo(v[c]), t1 = bfhi(v[c]);
        v[c] = pk_bf16(C0, C1);
        C0 = sw[c] * C0 + sw[36 + c] * t0;
        C1 = sw[c] * C1 + sw[36 + c] * t1;
      }
#pragma unroll
      for (int c = 0; c < NCHUNK; ++c) base[(size_t)c * 8192] = v[c];
    } else if (tid < 128) {
      float* base = p->MSn + (size_t)ch * NCHUNK * 128 + tid;
      float v[NCHUNK];
#pragma unroll
      for (int c = 0; c < NCHUNK; ++c) v[c] = base[c * 128];
      float C = 0.f;
#pragma unroll
      for (int c = 0; c < NCHUNK; ++c) {
        const float t0 = v[c];
        v[c] = C;
        C = sw[c] * C + sw[36 + c] * t0;
      }
#pragma unroll
      for (int c = 0; c < NCHUNK; ++c) base[c * 128] = v[c];
    }
  }
}

__device__ void mlstm_s3(KP p, int layer, int tile, char* lds, int tid) {
  const int j = layer >> 1;
  const int ch = tile / NCHUNK, c = tile % NCHUNK;
  const int dir = ch >> 5, b = (ch >> 2) & 7, h = ch & 3;
  float* s_b = (float*)(lds + META_OFF);
  float* s_ig = s_b + 64;
  float* s_mt = s_b + 128;
  float* s_wi = s_b + 192;
  int* s_row = (int*)(s_b + 256);
  float* s_n = s_b + 320;
  float* s_c = s_b + 448;
  char* kimg = lds;
  char* vimg = lds + 16384;
  char* cimg = lds + 32768;
  const float mprev = p->msc[2 * NMT + tile];
  const float qscale = 0.08838834764831845f;
  const int lane = tid & 63, w = tid >> 6, wt = w >> 1, wv = w & 1, r32 = lane & 31, hi = lane >> 5;
  const int t = wt * 32 + r32;
  const int rowq = scan_row(dir, b, c * 64 + t);
  const int c8 = tid & 15;
  u32x4 kr[4], vr[4], cr[8];
#pragma unroll
  for (int i = 0; i < 4; ++i) {
    const int sidx = (tid >> 4) + 16 * i;
    const bf16_t* src = p->P + (size_t)scan_row(dir, b, c * 64 + sidx) * LDP + h * 128 + c8 * 8;
    kr[i] = *(const u32x4*)(src + 2560);
    vr[i] = *(const u32x4*)(src + 3072);
  }
  {
    const bf16_t* Cp = p->MS + (size_t)tile * 16384;
#pragma unroll
    for (int i = 0; i < 8; ++i) cr[i] = *(const u32x4*)(Cp + ((tid >> 4) + 16 * i) * 128 + c8 * 8);
  }
  bf16x8 qf[8];
  {
    const bf16_t* qp = p->P + (size_t)rowq * LDP + 2048 + h * 128 + hi * 8;
#pragma unroll
    for (int d0 = 0; d0 < 8; ++d0) qf[d0] = *(const bf16x8*)(qp + d0 * 16);
  }
  if (tid < 64) {
    const int row = scan_row(dir, b, c * 64 + tid);
    s_row[tid] = row;
    const float* g = p->GP + (size_t)row * 16;
    const float gi = g[(dir * 2) * 4 + h] + p->mlstm_gate_b[j * 16 + (dir * 2) * 4 + h];
    const float gf = g[(dir * 2 + 1) * 4 + h] + p->mlstm_gate_b[j * 16 + (dir * 2 + 1) * 4 + h];
    float bc = -softplus_f(-gf);
#pragma unroll
    for (int o = 1; o < 64; o <<= 1) {
      float tmp = __shfl_up(bc, o);
      if (tid >= o) bc += tmp;
    }
    float pm = gi - bc;
#pragma unroll
    for (int o = 1; o < 64; o <<= 1) {
      float tmp = __shfl_up(pm, o);
      if (tid >= o) pm = fmaxf(pm, tmp);
    }
    const float mt = bc + fmaxf(mprev, pm);
    s_b[tid] = bc;
    s_ig[tid] = gi;
    s_mt[tid] = mt;
    s_wi[tid] = expf(bc + mprev - mt);
    s_c[tid] = (gi - bc) * 1.4426950408889634f;
  } else if (tid < 192) s_n[tid - 64] = p->MSn[tile * 128 + (tid - 64)];
  {
    const int ioff = (c8 >> 2) * 4096 + (c8 & 3) * 16;
#pragma unroll
    for (int i = 0; i < 4; ++i) {
      const int sidx = (tid >> 4) + 16 * i;
      *(u32x4*)(kimg + sidx * 256 + ((c8 ^ (sidx & 15)) * 16)) = kr[i];
      *(u32x4*)(vimg + ioff + sidx * 64) = vr[i];
    }
    const int coff = (c8 >> 2) * 8192 + (c8 & 3) * 16;
#pragma unroll
    for (int i = 0; i < 8; ++i) *(u32x4*)(cimg + coff + ((tid >> 4) + 16 * i) * 64) = cr[i];
  }
  __syncthreads();
  const int toff = ((lane >> 4) & 1) * 32 + (lane & 3) * 8 + ((lane & 15) >> 2) * 64;
  constexpr float LOG2E_ = 1.4426950408889634f;
  float qn = 0.f;
#pragma unroll
  for (int d0 = 0; d0 < 8; ++d0) {
    const u32x4 qq = __builtin_bit_cast(u32x4, qf[d0]);
    const float* np = s_n + d0 * 16 + hi * 8;
    qn = fmaf(bflo(qq.x), np[0], qn); qn = fmaf(bfhi(qq.x), np[1], qn);
    qn = fmaf(bflo(qq.y), np[2], qn); qn = fmaf(bfhi(qq.y), np[3], qn);
    qn = fmaf(bflo(qq.z), np[4], qn); qn = fmaf(bfhi(qq.z), np[5], qn);
    qn = fmaf(bflo(qq.w), np[6], qn); qn = fmaf(bfhi(qq.w), np[7], qn);
  }
  qn += __shfl_xor(qn, 32);
  const float mtt = s_mt[t], wi = s_wi[t];
  const float ct = (s_b[t] - mtt) * LOG2E_;
  const float wq = wi * qscale;
  bf16x8 pf[4];
  float den = 0.f;
  {
    f32x16 sa0, sa1;
#pragma unroll
    for (int q = 0; q < 16; ++q) { sa0[q] = 0.f; sa1[q] = 0.f; }
#pragma unroll
    for (int d0 = 0; d0 < 8; ++d0) {
      const int chn = 2 * d0 + hi;
      const bf16x8 k0 = *(const bf16x8*)(kimg + r32 * 256 + ((chn ^ (r32 & 15)) * 16));
      sa0 = MFMA32(k0, qf[d0], sa0);
      if (wt) {
        const bf16x8 k1 = *(const bf16x8*)(kimg + (32 + r32) * 256 + ((chn ^ (r32 & 15)) * 16));
        sa1 = MFMA32(k1, qf[d0], sa1);
      }
      __builtin_amdgcn_sched_barrier(0);
    }
#pragma unroll
    for (int g = 0; g < 4; ++g) {
      const int sb0 = 8 * g + 4 * hi;
      const float4 c0v = *(const float4*)(s_c + sb0);
      const float4 c1v = *(const float4*)(s_c + sb0 + 32);
      const float cc0[4] = {c0v.x, c0v.y, c0v.z, c0v.w}, cc1[4] = {c1v.x, c1v.y, c1v.z, c1v.w};
#pragma unroll
      for (int e = 0; e < 4; ++e) {
        const int q = 4 * g + e;
        const float v0 = (sb0 + e <= t) ? sa0[q] * qscale * __builtin_amdgcn_exp2f(ct + cc0[e]) : 0.f;
        sa0[q] = v0; den += v0;
        const float v1 = (wt && sb0 + 32 + e <= t) ? sa1[q] * qscale * __builtin_amdgcn_exp2f(ct + cc1[e]) : 0.f;
        sa1[q] = v1; den += v1;
      }
      __builtin_amdgcn_sched_barrier(0);
    }
#pragma unroll
    for (int sx = 0; sx < 4; ++sx) {
      const int u = (sx & 1) * 8;
      u32x4 tpk;
      if (sx < 2) {
        tpk.x = pk_bf16(sa0[u + 0], sa0[u + 1]); tpk.y = pk_bf16(sa0[u + 2], sa0[u + 3]);
        tpk.z = pk_bf16(sa0[u + 4], sa0[u + 5]); tpk.w = pk_bf16(sa0[u + 6], sa0[u + 7]);
      } else {
        tpk.x = pk_bf16(sa1[u + 0], sa1[u + 1]); tpk.y = pk_bf16(sa1[u + 2], sa1[u + 3]);
        tpk.z = pk_bf16(sa1[u + 4], sa1[u + 5]); tpk.w = pk_bf16(sa1[u + 6], sa1[u + 7]);
      }
      pf[sx] = __builtin_bit_cast(bf16x8, tpk);
    }
  }
  den += __shfl_xor(den, 32);
  const float dtot = den + wq * qn;
  const float inv = 1.f / fmaxf(fabsf(dtot), expf(-mtt));
  bf16_t* op = p->P + (size_t)rowq * LDP + 1024 + dir * 512 + h * 128 + wv * 64 + 4 * hi;
#pragma unroll 1
  for (int vp = 0; vp < 2; ++vp) {
    f32x16 o0;
#pragma unroll
    for (int q = 0; q < 16; ++q) o0[q] = 0.f;
    const char* cb = cimg + (wv * 2 + vp) * 8192 + toff + hi * 512;
#pragma unroll
    for (int d0 = 0; d0 < 8; ++d0) {
      const bf16x8 A0 = __builtin_shufflevector(vtr(cb + (16 * d0) * 64), vtr(cb + (16 * d0 + 4) * 64), 0, 1, 2, 3, 4, 5, 6, 7);
      o0 = MFMA32(A0, qf[d0], o0);
    }
#pragma unroll
    for (int q = 0; q < 16; ++q) o0[q] *= wq;
    const char* vb = vimg + (wv * 2 + vp) * 4096 + toff + hi * 256;
#pragma unroll
    for (int sx = 0; sx < 4; ++sx) {
      if (sx < 2 || wt) {
        const bf16x8 A0 = __builtin_shufflevector(vtr(vb + (16 * sx) * 64), vtr(vb + (16 * sx + 8) * 64), 0, 1, 2, 3, 4, 5, 6, 7);
        o0 = MFMA32(A0, pf[sx], o0);
      }
    }
#pragma unroll
    for (int g = 0; g < 4; ++g) {
      u32x2 v0;
      v0.x = pk_bf16(o0[4 * g] * inv, o0[4 * g + 1] * inv); v0.y = pk_bf16(o0[4 * g + 2] * inv, o0[4 * g + 3] * inv);
      *(u32x2*)(op + vp * 32 + 8 * g) = v0;
    }
  }
}

__device__ void ph_mlstm_s1(KP p, int layer, char* smc) {
  const int tid = opaque_tid();
  __syncthreads();
  for (int tile = blockIdx.x; tile < NMT; tile += gridDim.x) { mlstm_s1(p, layer, tile, smc, tid); __syncthreads(); }
}

__device__ void ph_rec_final(KP p, int layer, bool keep) {
  const int tid = opaque_tid();
  const int j = layer >> 1;
  const int lane = tid & 63, wave = tid >> 6;
  const int rows = keep ? NT : NL;
  const int c0 = lane * 8;
  auto unpack = [](const u32x4 u, float (&f)[8]) {
    f[0] = bflo(u.x); f[1] = bfhi(u.x); f[2] = bflo(u.y); f[3] = bfhi(u.y);
    f[4] = bflo(u.z); f[5] = bfhi(u.z); f[6] = bflo(u.w); f[7] = bfhi(u.w);
  };
  for (int t = blockIdx.x * 4 + wave; t < rows; t += gridDim.x * 4) {
    const bf16_t* rw = p->RW + (size_t)t * RWS + c0;
    const bf16_t* pt = p->P + (size_t)t * LDP + c0;
    bf16_t* mo = p->AB + (size_t)t * DM + c0;
    {
      float yf[8], yb[8], r[8], v[8], k0[8], k1[8], g[8], y[8], o[8];
      unpack(*(const u32x4*)(pt), yf); unpack(*(const u32x4*)(pt + 512), yb);
      unpack(*(const u32x4*)(rw), r); unpack(*(const u32x4*)(rw + 512), v);
      unpack(*(const u32x4*)(rw + 5 * 512), k0); unpack(*(const u32x4*)(rw + 6 * 512), k1);
      unpack(*(const u32x4*)(rw + 9 * 512), g);
      float s1 = 0.f, bs = 0.f;
      const float* rk = p->rwkv_rk + j * 512 + c0;
#pragma unroll
      for (int e = 0; e < 8; ++e) { y[e] = yf[e] + yb[e]; s1 += y[e]; bs += r[e] * rk[e] * (k0[e] + k1[e]); }
      s1 += dppx<0xB1>(s1); s1 += dppx<0x4E>(s1); s1 += dppx<0x141>(s1);
      bs += dppx<0xB1>(bs); bs += dppx<0x4E>(bs); bs += dppx<0x141>(bs);
      const float mu = s1 * (1.f / 64.f);
      float s2 = 0.f;
#pragma unroll
      for (int e = 0; e < 8; ++e) { const float d = y[e] - mu; s2 += d * d; }
      s2 += dppx<0xB1>(s2); s2 += dppx<0x4E>(s2); s2 += dppx<0x141>(s2);
      const float rs = rsqrtf(s2 * (1.f / 64.f) + 64e-5f);
      const float* gn0 = p->rwkv_gn + (j * 2 + 0) * 512 + c0;
      const float* gn1 = p->rwkv_gn + (j * 2 + 1) * 512 + c0;
#pragma unroll
      for (int e = 0; e < 8; ++e) o[e] = ((y[e] - mu) * rs * gn0[e] + gn1[e] + bs * v[e]) * g[e];
      u32x4 ov;
      ov.x = pk_bf16(o[0], o[1]); ov.y = pk_bf16(o[2], o[3]); ov.z = pk_bf16(o[4], o[5]); ov.w = pk_bf16(o[6], o[7]);
      *(u32x4*)(mo) = ov;
    }
    {
      float hf[8], hb[8], og[8], hsum[8], o[8];
      unpack(*(const u32x4*)(pt + 1024), hf); unpack(*(const u32x4*)(pt + 1536), hb);
      unpack(*(const u32x4*)(pt + 3584), og);
      float ss = 0.f;
#pragma unroll
      for (int e = 0; e < 8; ++e) { hsum[e] = hf[e] + hb[e]; ss += hsum[e] * hsum[e]; }
      ss += dppx<0xB1>(ss); ss += dppx<0x4E>(ss); ss += dppx<0x141>(ss); ss += dppx<0x140>(ss);
      const float rs = rsqrtf(ss * (1.f / 128.f) + 1e-6f);
      const float* ng = p->mlstm_norm + j * 512 + c0;
#pragma unroll
      for (int e = 0; e < 8; ++e) o[e] = hsum[e] * rs * ng[e] * sigm_f(og[e]);
      u32x4 ov;
      ov.x = pk_bf16(o[0], o[1]); ov.y = pk_bf16(o[2], o[3]); ov.z = pk_bf16(o[4], o[5]); ov.w = pk_bf16(o[6], o[7]);
      *(u32x4*)(mo + 512) = ov;
    }
  }
}

using f32x4v = __attribute__((ext_vector_type(4))) float;
__device__ void ph_ln_router(KP p, int layer, bool keep, char* smc) {
  float* h2s = (float*)smc;
  float* lgs = (float*)smc;
  const int tid = opaque_tid();
  const int lane = tid & 63, wave = tid >> 6;
  const int rows = keep ? NT : NL;
  const float* lng = p->ln_g + (layer * 2 + 0) * 1024;
  const float* lnb = p->ln_b + (layer * 2 + 0) * 1024;
  for (int tile = blockIdx.x; tile < rows / 16; tile += gridDim.x) {
    const int t0 = tile * 16;
    const float* mod = p->MOD + (layer * 9 + modrow(t0)) * 6144;
    const float* brow = p->WrT + ((size_t)layer * 64 + 16 * wave + (lane & 15)) * 1024 + 4 * (lane >> 4);
    f32x4v b0[8], b1[8], b2[8];
#pragma unroll
    for (int q = 0; q < 8; ++q) { b0[q] = *(const f32x4v*)(brow + 16 * q); b1[q] = *(const f32x4v*)(brow + 16 * (8 + q)); }
    __builtin_amdgcn_sched_barrier(0);
    {
      float4 v[4][4];
      float s4[4];
#pragma unroll
      for (int q = 0; q < 4; ++q) {
        const int t = t0 + wave * 4 + q;
        s4[q] = 0.f;
#pragma unroll
        for (int i = 0; i < 4; ++i) v[q][i] = *(const float4*)(p->Tb + (size_t)t * DM + i * 256 + lane * 4);
      }
#pragma unroll
      for (int q = 0; q < 4; ++q)
#pragma unroll
        for (int i = 0; i < 4; ++i) s4[q] += (v[q][i].x + v[q][i].y) + (v[q][i].z + v[q][i].w);
      float mean4[4], rs4[4];
#pragma unroll
      for (int q = 0; q < 4; ++q) mean4[q] = wsum(s4[q]) * (1.f / 1024.f);
#pragma unroll
      for (int q = 0; q < 4; ++q) {
        float qq = 0.f;
#pragma unroll
        for (int i = 0; i < 4; ++i) {
          const float d0 = v[q][i].x - mean4[q], d1 = v[q][i].y - mean4[q], d2 = v[q][i].z - mean4[q], d3 = v[q][i].w - mean4[q];
          qq += (d0 * d0 + d1 * d1) + (d2 * d2 + d3 * d3);
        }
        s4[q] = qq;
      }
#pragma unroll
      for (int q = 0; q < 4; ++q) rs4[q] = rsqrtf(wsum(s4[q]) * (1.f / 1024.f) + 1e-5f);
#pragma unroll
      for (int i = 0; i < 4; ++i) {
        const int n = i * 256 + lane * 4;
        const float4 g = *(const float4*)(lng + n), bb = *(const float4*)(lnb + n);
        const float4 sc = *(const float4*)(mod + 4096 + n), sh = *(const float4*)(mod + 3072 + n);
#pragma unroll
        for (int q = 0; q < 4; ++q) {
          const int tl = wave * 4 + q, t = t0 + tl;
          const float mean = mean4[q], rs = rs4[q];
          const float4 xn = make_float4((v[q][i].x - mean) * rs * g.x + bb.x, (v[q][i].y - mean) * rs * g.y + bb.y,
                                        (v[q][i].z - mean) * rs * g.z + bb.z, (v[q][i].w - mean) * rs * g.w + bb.w);
          *(float4*)(p->X + (size_t)t * DM + n) = xn;
          const float4 hh = make_float4(xn.x * (1.f + sc.x) + sh.x, xn.y * (1.f + sc.y) + sh.y,
                                        xn.z * (1.f + sc.z) + sh.z, xn.w * (1.f + sc.w) + sh.w);
          *(unsigned*)((unsigned char*)p->AB + (size_t)t * DM + n) = pk_fp8x4(hh.x, hh.y, hh.z, hh.w);
          *(float4*)(h2s + tl * 1028 + n) = hh;
        }
      }
    }
    __syncthreads();
    f32x4v acc = {0.f, 0.f, 0.f, 0.f};
    {
      f32x4v a1 = {0.f, 0.f, 0.f, 0.f}, a2 = {0.f, 0.f, 0.f, 0.f}, a3 = {0.f, 0.f, 0.f, 0.f};
      const int i = lane & 15, kk = lane >> 4;
      const float* arow = h2s + i * 1028 + 4 * kk;
#define ROUTER_LOAD(B, Q0) _Pragma("unroll") for (int q = 0; q < 8; ++q) B[q] = *(const f32x4v*)(brow + 16 * ((Q0) + q)); __builtin_amdgcn_sched_barrier(0);
#define ROUTER_MFMA(B, Q0) _Pragma("unroll") for (int q = 0; q < 8; ++q) { \
        const float4 a = *(const float4*)(arow + 16 * ((Q0) + q)); \
        acc = __builtin_amdgcn_mfma_f32_16x16x4f32(a.x, B[q].x, acc, 0, 0, 0); \
        a1 = __builtin_amdgcn_mfma_f32_16x16x4f32(a.y, B[q].y, a1, 0, 0, 0); \
        a2 = __builtin_amdgcn_mfma_f32_16x16x4f32(a.z, B[q].z, a2, 0, 0, 0); \
        a3 = __builtin_amdgcn_mfma_f32_16x16x4f32(a.w, B[q].w, a3, 0, 0, 0); } __builtin_amdgcn_sched_barrier(0);
      ROUTER_LOAD(b2, 16) ROUTER_MFMA(b0, 0)
      ROUTER_LOAD(b0, 24) ROUTER_MFMA(b1, 8)
      ROUTER_LOAD(b1, 32) ROUTER_MFMA(b2, 16)
      ROUTER_LOAD(b2, 40) ROUTER_MFMA(b0, 24)
      ROUTER_LOAD(b0, 48) ROUTER_MFMA(b1, 32)
      ROUTER_LOAD(b1, 56) ROUTER_MFMA(b2, 40)
      ROUTER_MFMA(b0, 48)
      ROUTER_MFMA(b1, 56)
      acc = (acc + a1) + (a2 + a3);
    }
    __syncthreads();
#pragma unroll
    for (int r = 0; r < 4; ++r) lgs[((lane >> 4) * 4 + r) * 64 + 16 * wave + (lane & 15)] = acc[r];
    __syncthreads();
    {
      float score4[4], gate4[4];
      int kidx4[4], pos4[4];
      bool chosen4[4];
#pragma unroll
      for (int q = 0; q < 4; ++q) {
        const int tl = wave * 4 + q;
        const float logit = lgs[tl * 64 + lane];
        const float score = sigm_f(logit);
        float sel = score + p->moe_bias[layer * 64 + lane];
        bool chosen = false;
        for (int r = 0; r < 6; ++r) {
          const float mx = wmax(sel);
          const unsigned long long bal = __ballot(sel == mx);
          const int first = __ffsll((long long)bal) - 1;
          if (lane == first) { chosen = true; sel = -INFINITY; }
        }
        const float gsum = wsum(chosen ? score : 0.f);
        const unsigned long long cb = __ballot(chosen);
        score4[q] = score; gate4[q] = score / gsum * 2.5f; chosen4[q] = chosen;
        kidx4[q] = __popcll(cb & ((1ull << lane) - 1ull));
      }
#pragma unroll
      for (int q = 0; q < 4; ++q) pos4[q] = chosen4[q] ? atomicAdd(&p->cnt[lane * CSTR], 1) : 0;
#pragma unroll
      for (int q = 0; q < 4; ++q) {
        const int t = t0 + wave * 4 + q;
        if (chosen4[q]) {
          p->ltok[(size_t)lane * NT + pos4[q]] = t;
          p->lgate[(size_t)lane * NT + pos4[q]] = gate4[q];
          p->tsl[t * 6 + kidx4[q]] = (lane << 16) | pos4[q];
        }
      }
    }
    __syncthreads();
  }
}

__device__ __forceinline__ void moe_prefix(KP p, int rows, int* s_pref, int tid) {
  if (tid < 64) s_pref[322 + tid] = p->cnt[tid * CSTR];
  __syncthreads();
  if (tid == 0) {
    int a = 0;
    for (int e = 0; e < 64; ++e) { s_pref[e] = a; a += (s_pref[322 + e] + 127) >> 7; }
    s_pref[64] = a; a += rows >> 7;
    s_pref[65] = a;
  }
  __syncthreads();
}

__device__ void ph_gemm(KP p, int kind, int layer, bool keep, char* lds) {
  const int tid = opaque_tid();
  const int j = layer >> 1;
  const bool att = !(layer & 1);
  const int rows = keep ? NT : NL;
  int* pref = (int*)(lds + META_OFF);
  int* s_idx = pref + 66;
  float* s_gate = (float*)(s_idx + 128);
  if (kind == 1 && blockIdx.x == 0 && tid < 65) p->cnt[tid * CSTR] = 0;
  int total;
  const int ntn_in = att ? 18 : 33;
  switch (kind) {
    case 0: total = (NT / 128) * ntn_in; break;
    case 1: total = (rows / 128) * 8; break;
    case 2: total = pref[65] * 4; break;
    case 3: total = pref[65] * 8; break;
    case 4: total = (NT / 128) * 3; break;
    default: total = (NT / 128) * 20; break;
  }
  const bool moe = kind == 2 || kind == 3;
  const int tsh = kind == 2 ? 2 : 3;
  int e_nx = 0, idx_nx = tid; float g_nx = 1.f;
  auto fetch_moe = [&](int tl) {
    const int mt = tl >> tsh;
    while (mt >= pref[e_nx + 1]) ++e_nx;
    idx_nx = tid; g_nx = 1.f;
    if (tid < 128) {
      const int pos = (mt - pref[e_nx]) * 128 + tid;
      if (kind == 2) {
        idx_nx = 0;
        if (e_nx < 64) { if (pos < pref[322 + e_nx]) idx_nx = p->ltok[(size_t)e_nx * NT + pos]; }
        else idx_nx = pos;
      } else if (e_nx < 64) g_nx = pos < pref[322 + e_nx] ? p->lgate[(size_t)e_nx * NT + pos] : 0.f;
    }
  };
  if (moe && (int)blockIdx.x < total) fetch_moe(blockIdx.x);
  for (int tile = blockIdx.x; tile < total; tile += gridDim.x) {
    const bf16_t* Abase; const bf16_t* Bt;
    int astride, K, n0, m0 = 0, aux = 0, e = e_nx, mtile = 0;
    switch (kind) {
      case 0: { const int tm = tile / ntn_in, tn = tile % ntn_in; m0 = tm * 128; n0 = tn * 128;
                Abase = p->AB + (size_t)m0 * DM; astride = DM; K = 1024;
                Bt = att ? p->Wt_att + (size_t)j * ATT_N * 1024 : p->Wt_rec + (size_t)j * REC_NP * 1024; } break;
      case 1: { const int tm = tile >> 3, tn = tile & 7; m0 = tm * 128; n0 = tn * 128;
                Abase = p->AB + (size_t)m0 * DM; astride = DM; K = 1024; Bt = p->Wt_out + (size_t)layer * 1024 * 1024; } break;
      case 2: { mtile = tile >> 2; aux = tile & 3; n0 = aux * 128;
                Abase = p->AB; astride = DM; K = 1024;
                Bt = (const bf16_t*)((const unsigned char*)p->Wt13 + (size_t)(layer * 65 + e) * 512 * 1024); } break;
      case 3: { mtile = tile >> 3; aux = tile & 7; n0 = aux * 128;
                Abase = (const bf16_t*)((const unsigned char*)p->ACT + (size_t)mtile * 128 * 256); astride = 256; K = 256;
                Bt = (const bf16_t*)((const unsigned char*)p->Wt2 + (size_t)(layer * 65 + e) * 1024 * 256); } break;
      case 4: { const int tm = tile / 3; aux = tile % 3; m0 = tm * 128; n0 = 0;
                Abase = p->Zb + (size_t)m0 * 1536 + aux * 512; astride = 1536; K = 512; Bt = p->Wl1 + (size_t)(j * 3 + aux) * 128 * 512; } break;
      default: { const int tm = tile / 20; aux = tile % 20; m0 = tm * 128; n0 = aux * 128;
                const int grp = aux < 8 ? 0 : (aux < 16 ? 1 : 2);
                Abase = p->L1 + (size_t)m0 * 384 + grp * 128; astride = 384; K = 128; Bt = p->Wl2 + (size_t)j * 2560 * 128; } break;
    }
    if (tid < 128) { s_idx[tid] = idx_nx; s_gate[tid] = g_nx; }
    __syncthreads();
    if (moe && tile + (int)gridDim.x < total) fetch_moe(tile + gridDim.x);
    {
      f32x16 acc[2][2];
      if (kind == 2 || kind == 3) {
        const unsigned char* A8 = (const unsigned char*)Abase;
        gemm128_fp8(tid, [&](int r) { return A8 + (size_t)s_idx[r] * astride; }, (const unsigned char*)Bt, K, n0, lds, acc);
      } else
        gemm128_main(tid, [&](int r) { return Abase + (size_t)s_idx[r] * astride; }, Bt, K, n0, lds, acc);
      float* Ct = (float*)lds;
      acc_foreach(tid, acc, [&](int row, int col, float v) { Ct[row * 128 + col] = v; });
    }
    __syncthreads();
    {
      const float* Ct = (const float*)lds;
      int c4 = (tid & 31) * 4, r0 = tid >> 5;
      asm volatile("" : "+v"(c4), "+v"(r0));
      const int N_in = att ? ATT_N : REC_N;
      const int d5 = (aux >> 2) & 1, c05 = (aux & 3) * 128;
      switch (kind) {
        case 0: {
#pragma unroll 8
          for (int it = 0; it < 16; ++it) {
            const int row = it * 8 + r0;
            const float4 v = *(const float4*)(Ct + row * 128 + c4);

            const int cn = n0 + c4;
            float4 vq = v;
            if (att && n0 >= 1536 && n0 < 2176) {
              float ss = v.x * v.x + v.y * v.y + v.z * v.z + v.w * v.w;
              ss += dppx<0xB1>(ss); ss += dppx<0x4E>(ss); ss += dppx<0x141>(ss); ss += dppx<0x140>(ss);
              const float rs = rsqrtf(ss * (1.f / 64.f) + 1e-6f);
              const float4 g = *(const float4*)(p->qk_gain + j * 128 + (n0 >= 2048 ? 64 : 0) + (cn & 63));
              vq = make_float4(v.x * rs * g.x, v.y * rs * g.y, v.z * rs * g.z, v.w * rs * g.w);
              const int t = m0 + row;
              if (t < NL) {
                const int sidx = t & 2047, pi0 = (cn & 63) >> 1;
                const int pos = pi0 < 16 ? (sidx >> 6) : (sidx & 63);
                const float4 cs = *(const float4*)(p->ROPE + (pos * 16 + (pi0 & 15)) * 2);
                vq = make_float4(vq.x * cs.x - vq.y * cs.y, vq.x * cs.y + vq.y * cs.x,
                                 vq.z * cs.z - vq.w * cs.w, vq.z * cs.w + vq.w * cs.z);
              }
            }
            if (cn < N_in) {
              u32x2 o; o.x = pk_bf16(vq.x, vq.y); o.y = pk_bf16(vq.z, vq.w);
              *(u32x2*)(p->P + (size_t)(m0 + row) * LDP + cn) = o;
            }
            if (!att && cn >= 4096 && cn < 4112) *(float4*)(p->GP + (size_t)(m0 + row) * 16 + (cn - 4096)) = v;
          }
        } break;
        case 1: {
#pragma unroll 16
          for (int it = 0; it < 16; ++it) {
            const int row = it * 8 + r0;
            const float4 v = *(const float4*)(Ct + row * 128 + c4);

            const size_t o = (size_t)(m0 + row) * DM + n0 + c4;
            const float4 xv = *(const float4*)(p->X + o);
            const float4 g = *(const float4*)(p->MOD + (layer * 9 + modrow(m0)) * 6144 + 2048 + n0 + c4);
            *(float4*)(p->Tb + o) = make_float4(DN_ALPHA * xv.x + g.x * v.x, DN_ALPHA * xv.y + g.y * v.y,
                                                DN_ALPHA * xv.z + g.z * v.z, DN_ALPHA * xv.w + g.w * v.w);
          }
        } break;
        case 2: {
#pragma unroll 8
          for (int it = 0; it < 16; ++it) {
            const int row = it * 8 + r0;
            const float4 v = *(const float4*)(Ct + row * 128 + c4);

            if (((c4 >> 5) & 1) == 0) {
              const float4 u = *(const float4*)(Ct + row * 128 + c4 + 32);
              const float a0 = v.x * W8_INV, a1 = v.y * W8_INV, a2 = v.z * W8_INV, a3 = v.w * W8_INV;
              *(unsigned*)((unsigned char*)p->ACT + ((size_t)mtile * 128 + row) * 256 + aux * 64 + (c4 >> 6) * 32 + (c4 & 31)) =
                  pk_fp8x4(silu_f(a0) * (u.x * W8_INV), silu_f(a1) * (u.y * W8_INV), silu_f(a2) * (u.z * W8_INV), silu_f(a3) * (u.w * W8_INV));
            }
          }
        } break;
        case 3: {
#pragma unroll 16
          for (int it = 0; it < 16; ++it) {
            const int row = it * 8 + r0;
            const float4 v = *(const float4*)(Ct + row * 128 + c4);

            const float g = s_gate[row] * W8_INV;
            u32x2 o; o.x = pk_bf16(g * v.x, g * v.y); o.y = pk_bf16(g * v.z, g * v.w);
            *(u32x2*)(p->OUT2 + ((size_t)mtile * 128 + row) * 1024 + n0 + c4) = o;
          }
        } break;
        case 4: {
#pragma unroll 4
          for (int it = 0; it < 16; ++it) {
            const int row = it * 8 + r0;
            const float4 v = *(const float4*)(Ct + row * 128 + c4);

            float4 o4 = v;
            if (aux == 0) o4 = make_float4(tanhf(v.x), tanhf(v.y), tanhf(v.z), tanhf(v.w));
            else if (aux == 2) o4 = make_float4(sigm_f(v.x), sigm_f(v.y), sigm_f(v.z), sigm_f(v.w));
            u32x2 o; o.x = pk_bf16(o4.x, o4.y); o.y = pk_bf16(o4.z, o4.w);
            *(u32x2*)(p->L1 + (size_t)(m0 + row) * 384 + aux * 128 + c4) = o;
          }
        } break;
        default: {
#pragma unroll 4
          for (int it = 0; it < 16; ++it) {
            const int row = it * 8 + r0;
            const float4 v = *(const float4*)(Ct + row * 128 + c4);

            bf16_t* rr = p->RW + (size_t)(m0 + row) * RWS + c05 + c4;
            const float vv[4] = {v.x, v.y, v.z, v.w};
            if (aux < 8) {
              const float4 b0 = *(const float4*)(p->rwkv_w0 + (j * 2 + d5) * 512 + c05 + c4);
              const float bb[4] = {b0.x, b0.y, b0.z, b0.w};
              float e4[4];
#pragma unroll
              for (int q = 0; q < 4; ++q) e4[q] = expf(-softplus_f(-(bb[q] + vv[q])) - 0.5f);
              u32x2 o; o.x = pk_bf16(e4[0], e4[1]); o.y = pk_bf16(e4[2], e4[3]);
              *(u32x2*)(rr + (3 + d5) * 512) = o;
            } else if (aux < 16) {
              const float4 b0 = *(const float4*)(p->rwkv_a0 + (j * 2 + d5) * 512 + c05 + c4);
              const float4 k1 = *(const float4*)(p->rwkv_kvec + (j * 2 + 1) * 512 + c05 + c4);
              const u32x2 kx2 = *(const u32x2*)(rr + 10 * 512);
              const float bb[4] = {b0.x, b0.y, b0.z, b0.w}, kk1[4] = {k1.x, k1.y, k1.z, k1.w};
              const float kx[4] = {bflo(kx2.x), bfhi(kx2.x), bflo(kx2.y), bfhi(kx2.y)};
              float av[4], ke[4];
#pragma unroll
              for (int q = 0; q < 4; ++q) { av[q] = sigm_f(bb[q] + vv[q]); ke[q] = kx[q] * (1.f + (av[q] - 1.f) * kk1[q]); }
              u32x2 o; o.x = pk_bf16(av[0], av[1]); o.y = pk_bf16(av[2], av[3]);
              *(u32x2*)(rr + (7 + d5) * 512) = o;
              o.x = pk_bf16(ke[0], ke[1]); o.y = pk_bf16(ke[2], ke[3]);
              *(u32x2*)(rr + (5 + d5) * 512) = o;
            } else {
              u32x2 o; o.x = pk_bf16(v.x, v.y); o.y = pk_bf16(v.z, v.w);
              *(u32x2*)(rr + 9 * 512) = o;
            }
          }
        } break;
      }
    }
    __syncthreads();
  }
}

__device__ void ph_final_ln(KP p, int layer, bool keep, char* lds) {
  const int tid = opaque_tid();
  const int lane = tid & 63, wave = tid >> 6;
  const int rows = keep ? NT : NL;
  int* s_base = (int*)(lds + META_OFF);
  if (tid == 0) {
    int a = 0;
#pragma unroll 1
    for (int e = 0; e < 64; ++e) { s_base[e] = a * 128; a += (p->cnt[e * CSTR] + 127) >> 7; }
    s_base[64] = a * 128;
  }
  __syncthreads();
  const float* lng = p->ln_g + (layer * 2 + 1) * 1024;
  const float* lnb = p->ln_b + (layer * 2 + 1) * 1024;
  for (int t = blockIdx.x * 4 + wave; t < rows; t += gridDim.x * 4) {
    const int mr = modrow(t);
    const float* g2 = p->MOD + (layer * 9 + mr) * 6144 + 5120;
    const bf16_t* src[7];
#pragma unroll
    for (int k = 0; k < 6; ++k) {
      const int v = p->tsl[t * 6 + k];
      src[k] = p->OUT2 + (size_t)(s_base[v >> 16] + (v & 0xffff)) * 1024;
    }
    src[6] = p->OUT2 + (size_t)(s_base[64] + t) * 1024;
    float v[16];
    float s = 0.f;
#pragma unroll
    for (int c = 0; c < 2; ++c) {
      const int n0 = c * 512 + lane * 8;
      float y[8];
#pragma unroll
      for (int q = 0; q < 8; ++q) y[q] = 0.f;
#pragma unroll
      for (int k = 0; k < 7; ++k) {
        const u32x4 u = *(const u32x4*)(src[k] + n0);
        y[0] += bflo(u.x); y[1] += bfhi(u.x); y[2] += bflo(u.y); y[3] += bfhi(u.y);
        y[4] += bflo(u.z); y[5] += bfhi(u.z); y[6] += bflo(u.w); y[7] += bfhi(u.w);
      }
      const float4 xa = *(const float4*)(p->X + (size_t)t * DM + n0), xb = *(const float4*)(p->X + (size_t)t * DM + n0 + 4);
      const float4 ga = *(const float4*)(g2 + n0), gb = *(const float4*)(g2 + n0 + 4);
      const float xx[8] = {xa.x, xa.y, xa.z, xa.w, xb.x, xb.y, xb.z, xb.w};
      const float gg[8] = {ga.x, ga.y, ga.z, ga.w, gb.x, gb.y, gb.z, gb.w};
#pragma unroll
      for (int q = 0; q < 8; ++q) { v[c * 8 + q] = DN_ALPHA * xx[q] + gg[q] * y[q]; s += v[c * 8 + q]; }
    }
    const float mean = wsum(s) * (1.f / 1024.f);
    float q2 = 0.f;
#pragma unroll
    for (int i = 0; i < 16; ++i) { const float d = v[i] - mean; q2 += d * d; }
    const float rs = rsqrtf(wsum(q2) * (1.f / 1024.f) + 1e-5f);
    const float* modn = p->MOD + ((layer + 1) * 9 + mr) * 6144;
#pragma unroll
    for (int c = 0; c < 2; ++c) {
      const int n0 = c * 512 + lane * 8;
      float xn[8];
#pragma unroll
      for (int q = 0; q < 8; ++q) xn[q] = (v[c * 8 + q] - mean) * rs * lng[n0 + q] + lnb[n0 + q];
      float* xo = (layer == 3 ? p->out : p->X) + (size_t)t * DM + n0;
      *(float4*)(xo) = make_float4(xn[0], xn[1], xn[2], xn[3]);
      *(float4*)(xo + 4) = make_float4(xn[4], xn[5], xn[6], xn[7]);
      if (layer != 3) {
        float hb[8];
#pragma unroll
        for (int q = 0; q < 8; ++q) hb[q] = xn[q] * (1.f + modn[1024 + n0 + q]) + modn[n0 + q];
        u32x4 o;
        o.x = pk_bf16(hb[0], hb[1]); o.y = pk_bf16(hb[2], hb[3]); o.z = pk_bf16(hb[4], hb[5]); o.w = pk_bf16(hb[6], hb[7]);
        *(u32x4*)(p->AB + (size_t)t * DM + n0) = o;
      }
    }
  }
}

#define XB_TMO      128
#define XB_XCNT(j)  (256  + 64 * (j))
#define XB_XSUB(j)  (1280 + 64 * (j))
#define XB_XGEN(j)  (2304 + 64 * (j))
#define XB_TOP      3328
#define XB_TOPGEN   3392
#define XB_SPIN_CAP (1u << 20)
#define LAS __attribute__((address_space(3)))
__device__ __forceinline__ unsigned xb_ld(unsigned* p) { return __hip_atomic_load(p, __ATOMIC_RELAXED, __HIP_MEMORY_SCOPE_AGENT); }
__device__ __forceinline__ unsigned xb_add(unsigned* p, unsigned v) { return __hip_atomic_fetch_add(p, v, __ATOMIC_RELAXED, __HIP_MEMORY_SCOPE_AGENT); }
__device__ __forceinline__ unsigned xb_xcc_id() { return (unsigned)__builtin_amdgcn_s_getreg((3 << 11) | 20) & 0xFu; }
#define XB_SPIN(cond, bar) do { unsigned _sp = 0; while (cond) { __builtin_amdgcn_s_sleep(1); \
    if ((++_sp & 255u) == 0u) { if (xb_ld(&(bar)[XB_TMO])) break; if (_sp > XB_SPIN_CAP) { atomicAdd(&(bar)[XB_TMO], 1u); break; } } } } while (0)
struct XcdBarrier { unsigned* bar; unsigned x; volatile LAS unsigned* st; };
__device__ __forceinline__ XcdBarrier xcd_barrier_post(unsigned* bar, volatile LAS unsigned* st) {
  XcdBarrier b; b.bar = bar; b.x = xb_xcc_id(); b.st = st;
  if (threadIdx.x == 0) (void)xb_add(&bar[XB_XCNT(b.x)], 1u);
  return b;
}
__device__ __forceinline__ void xcd_barrier_complete(unsigned* bar, unsigned x, unsigned& nloc, unsigned& nx) {
  const unsigned G = gridDim.x;
  unsigned sum, cnt, mine, sp = 0u;
  for (;;) {
    sum = 0u; cnt = 0u; mine = 0u;
#pragma unroll
    for (unsigned j = 0; j < 16; ++j) { const unsigned c = xb_ld(&bar[XB_XCNT(j)]); sum += c; cnt += (c > 0u) ? 1u : 0u; mine = (j == x) ? c : mine; }
    if (sum == G) break;
    __builtin_amdgcn_s_sleep(1);
    if ((++sp & 255u) == 0u) { if (xb_ld(&bar[XB_TMO])) break; if (sp > XB_SPIN_CAP) { atomicAdd(&bar[XB_TMO], 1u); break; } }
  }
  nloc = mine > 0u ? mine : 1u; nx = cnt > 0u ? cnt : 1u;
}
__device__ __forceinline__ void xcd_barrier(const XcdBarrier& b) {
  asm volatile("s_waitcnt vmcnt(0)" ::: "memory");
  __syncthreads();
  if (threadIdx.x == 0) {
    unsigned* bar = b.bar;
    __builtin_amdgcn_s_waitcnt(0);
    unsigned nloc = b.st[0], nx = b.st[1];
    if (nloc == 0u) { xcd_barrier_complete(bar, b.x, nloc, nx); b.st[0] = nloc; b.st[1] = nx; }
    const unsigned old = xb_add(&bar[XB_XSUB(b.x)], 1u);
    const unsigned gen = old / nloc;
    if (old + 1u == (gen + 1u) * nloc) {
      __builtin_amdgcn_fence(__ATOMIC_RELEASE, "agent");
      asm volatile("s_waitcnt vmcnt(0)" ::: "memory");
      const unsigned og = xb_add(&bar[XB_TOP], 1u);
      const unsigned tg = og / nx;
      if (og + 1u == (tg + 1u) * nx) xb_add(&bar[XB_TOPGEN], 1u);
      else XB_SPIN(xb_ld(&bar[XB_TOPGEN]) == tg, bar);
      __builtin_amdgcn_fence(__ATOMIC_ACQUIRE, "agent");
      xb_add(&bar[XB_XGEN(b.x)], 1u);
      asm volatile("s_waitcnt vmcnt(0)" ::: "memory");
    } else {
      XB_SPIN(xb_ld(&bar[XB_XGEN(b.x)]) == gen, bar);
      __builtin_amdgcn_fence(__ATOMIC_ACQUIRE, "agent");
      asm volatile("s_waitcnt vmcnt(0)" ::: "memory");
    }
  }
  __syncthreads();
}

constexpr int NSLOTS = 13;
constexpr int NPHASE = 2 + 4 * NSLOTS;
__device__ __forceinline__ bool phase_is_nop(int ph) {
  if (ph < 2) return false;
  const int layer = (ph - 2) / NSLOTS, st = (ph - 2) % NSLOTS;
  if (st == 5 || st == 6) return true;
  return !(layer & 1) && (st == 1 || (st >= 3 && st <= 7));
}
__device__ void run_phase(KP p, int ph, char* sm) {
  if (ph == 0) { ph_init(p, sm); return; }
  if (ph == 1) { ph_mod_h(p, sm); return; }
  const int layer = (ph - 2) / NSLOTS, st = (ph - 2) % NSLOTS;
  const bool odd = layer & 1;
  const bool keep = layer < 3;
  int gk = -1;
  if (st == 0) gk = 0;
  else if (st == 8) gk = 1;
  else if (st == 10) gk = 2;
  else if (st == 11) gk = 3;
  else if (odd && st == 2) gk = 4;
  else if (odd && st == 3) gk = 5;
  asm volatile("" : "+s"(gk));
  if (gk >= 0) {
    if (gk == 2 || gk == 3) moe_prefix(p, keep ? NT : NL, (int*)(sm + META_OFF), opaque_tid());
    ph_gemm(p, gk, layer, keep, sm);
    if (gk == 5) { __syncthreads(); ph_mlstm_s2(p, sm); }
    return;
  }
  switch (st) {
    case 1: if (odd) { ph_rwkv_mix(p, layer); ph_mlstm_s1(p, layer, sm); } break;
    case 2: ph_attention(p, layer, keep, sm); break;
    case 4: if (odd) ph_scan_a(p, layer, sm); break;
    case 7: if (odd) ph_rec_final(p, layer, keep); break;
    case 9: ph_ln_router(p, layer, keep, sm); break;
    case 12: ph_final_ln(p, layer, keep, sm); break;
  }
}

__global__ void __launch_bounds__(NTHR, 2) mega_kernel(Params kargs) {
  extern __shared__ __attribute__((aligned(16))) char sm[];
  cg::grid_group grid = cg::this_grid();
  volatile LAS unsigned* st = (volatile LAS unsigned*)(sm + META_OFF + 4032);
  if (threadIdx.x == 0) { st[0] = 0u; st[1] = 0u; }
  __syncthreads();
  const XcdBarrier xb = xcd_barrier_post(kargs.bar, st);
  for (int ph = kargs.ph_lo; ph < kargs.ph_hi; ++ph) {
    if (phase_is_nop(ph)) continue;
    {
      KP kp = (KP)__builtin_amdgcn_kernarg_segment_ptr();
      asm volatile("" : "+s"(kp));
      run_phase(kp, ph, sm);
    }
    if (ph + 1 < kargs.ph_hi) {
      if (ph == 0) grid.sync();
      else xcd_barrier(xb);
    }
  }
}

extern "C" void kernel_launch(void* const* d_in, const int* in_sizes, int n_in, void* d_out, int out_size, void* d_ws,
                              size_t ws_size, hipStream_t stream) {
  static int grid_blocks = 0;
  if (!grid_blocks) {
    int dev = 0, cus = 0, per_cu = 0;
    (void)hipGetDevice(&dev);
    (void)hipDeviceGetAttribute(&cus, hipDeviceAttributeMultiprocessorCount, dev);
    (void)hipFuncSetAttribute((const void*)mega_kernel, hipFuncAttributeMaxDynamicSharedMemorySize, SMEM_BYTES);
    (void)hipOccupancyMaxActiveBlocksPerMultiprocessor(&per_cu, mega_kernel, NTHR, SMEM_BYTES);
    if (per_cu < 1) per_cu = 1;
    if (per_cu > 2) per_cu = 2;
    grid_blocks = cus * per_cu;
  }
  Params p;
  memset(&p, 0, sizeof(p));
  const float** pin = (const float**)&p;
  for (int i = 0; i < 35; ++i) pin[i] = (const float*)d_in[i];
  p.out = (float*)d_out;
  char* w = (char*)d_ws;
  size_t off = 0;
  auto take = [&](size_t bytes) { char* r = w + off; off += (bytes + 255) & ~(size_t)255; return r; };
  p.Wt_att = (bf16_t*)take((size_t)2 * ATT_N * 1024 * 2);
  p.Wt_rec = (bf16_t*)take((size_t)2 * REC_NP * 1024 * 2);
  p.Wt_out = (bf16_t*)take((size_t)4 * 1024 * 1024 * 2);
  p.Wt13 = (bf16_t*)take((size_t)4 * 65 * 512 * 1024);
  p.Wt2 = (bf16_t*)take((size_t)4 * 65 * 1024 * 256);
  p.Wl1 = (bf16_t*)take((size_t)2 * 3 * 128 * 512 * 2);
  p.Wl2 = (bf16_t*)take((size_t)2 * 2560 * 128 * 2);
  p.X = (float*)take((size_t)NT * DM * 4);
  p.AB = (bf16_t*)take((size_t)NT * DM * 2);
  p.MOD = (float*)take((size_t)5 * 9 * 6144 * 4);
  p.MODP = (float*)take((size_t)8 * 4 * 9 * 6144 * 4);
  p.GP = (float*)take((size_t)NT * 16 * 4);
  p.ROPE = (float*)take((size_t)64 * 16 * 2 * 4);
  p.WrT = (float*)take((size_t)4 * 64 * 1024 * 4);
  p.msc = (float*)take((size_t)3 * NMT * 4);
  p.lgate = (float*)take((size_t)64 * NT * 4);
  p.ltok = (int*)take((size_t)64 * NT * 4);
  p.tsl = (int*)take((size_t)NT * 6 * 4);
  p.cnt = (int*)take((size_t)65 * CSTR * 4);
  p.bar = (unsigned*)take((size_t)BAR_TOTAL_WORDS * 4);
  char* region = take(0);
  const size_t szP = (size_t)NT * LDP * 2, szRW = (size_t)NT * RWS * 2, szMS = (size_t)NMT * 16384 * 2,
               szMSn = (size_t)NMT * 128 * 4;
  const size_t szT = (size_t)NT * DM * 4, szOUT2 = (size_t)NSLOT * 1024 * 2;
  p.P = (bf16_t*)region;
  p.RW = (bf16_t*)(region + szP);
  p.MS = (bf16_t*)(region + szP + szRW);
  p.MSn = (float*)(region + szP + szRW + szMS);
  p.Tb = (float*)region;
  p.ACT = (bf16_t*)region;
  p.OUT2 = (bf16_t*)(region + szT);
  const size_t szZ = (size_t)NT * 2048 * 2;
  p.Zb = (bf16_t*)(region + szP + szRW + szMS + szMSn);
  p.L1 = p.Zb + (size_t)NT * 1536;
  size_t mixer = szP + szRW + szMS + szMSn + szZ, moe = szT + szOUT2;
  off += (mixer > moe ? mixer : moe);
  if (off > ws_size) { fprintf(stderr, "workspace too small: need %zu have %zu\n", off, ws_size); return; }
  p.ph_lo = 0;
  p.ph_hi = NPHASE;
  (void)hipMemsetAsync(p.bar, 0, (size_t)BAR_TOTAL_WORDS * 4, stream);
  void* args[] = {&p};
  hipError_t e = hipLaunchCooperativeKernel((void*)mega_kernel, dim3(grid_blocks), dim3(NTHR), args, SMEM_BYTES, stream);
  if (e != hipSuccess) fprintf(stderr, "cooperative launch failed: %s (grid %d)\n", hipGetErrorString(e), grid_blocks);
}
```

```cpp
#include <hip/hip_runtime.h>
#include <hip/hip_cooperative_groups.h>
#include <cstdio>
#include <cstring>
namespace cg = cooperative_groups;

constexpr int DM = 1024;
constexpr int NBATCH = 8;
constexpr int SEQ = 2048;
constexpr int CTXL = 256;
constexpr int NL = NBATCH * SEQ;
constexpr int NC = NBATCH * CTXL;
constexpr int NT = NL + NC;
constexpr int TSC = CTXL + SEQ;
constexpr int LDP = 4112;
constexpr int ATT_N = 2304;
constexpr int REC_N = 4112;
constexpr int REC_NP = 4224;
constexpr int NCHUNK = 36;
constexpr int NMT = 64 * NCHUNK;
constexpr int RWS = 5632;
constexpr int NSLOT = 137216;
constexpr float DN_ALPHA = 1.6817928305074290f;
constexpr int NTHR = 256;
constexpr int SMEM_BYTES = 65536 + 4096;
constexpr int META_OFF = 65536;
#define XCD_BAR_WORDS 3456
constexpr int CSTR = 32;
constexpr int BAR_TOTAL_WORDS = XCD_BAR_WORDS + 64;

typedef unsigned short bf16_t;
using bf16x8 = __attribute__((ext_vector_type(8))) short;
using f32x16 = __attribute__((ext_vector_type(16))) float;
using u32x4 = __attribute__((ext_vector_type(4))) unsigned;
using u32x2 = __attribute__((ext_vector_type(2))) unsigned;

struct Params {
  const float *x, *c, *ctx, *c_ctx, *ada_w, *ada_b, *ln_g, *ln_b, *mix_w_out, *att_w_in, *na_rpb, *qk_gain,
      *rec_w_in, *rwkv_mu, *rwkv_w0, *rwkv_w1, *rwkv_w2, *rwkv_a0, *rwkv_a1, *rwkv_a2, *rwkv_g1, *rwkv_g2,
      *rwkv_kvec, *rwkv_rk, *rwkv_gn, *mlstm_gate_b, *mlstm_norm, *moe_router, *moe_bias, *moe_w1, *moe_w3,
      *moe_w2, *shared_w1, *shared_w3, *shared_w2;
  float* out;
  bf16_t *Wt_att, *Wt_rec, *Wt_out, *Wt13, *Wt2, *Wl1, *Wl2;
  bf16_t *Zb, *L1;
  float *X, *MOD, *MODP, *GP, *msc, *lgate, *MSn, *Tb, *ROPE, *WrT;
  bf16_t *AB, *P, *RW, *MS, *ACT, *OUT2;
  int *cnt, *ltok, *tsl;
  unsigned* bar;
  int ph_lo, ph_hi;
};

typedef const Params __attribute__((address_space(4))) * KP;

__device__ __forceinline__ int modrow(int t) { return t < NL ? (t >> 11) : 8; }
__device__ __forceinline__ float silu_f(float x) { return x / (1.f + expf(-x)); }
__device__ __forceinline__ float sigm_f(float x) { return 1.f / (1.f + expf(-x)); }
__device__ __forceinline__ float softplus_f(float x) { return fmaxf(x, 0.f) + log1pf(expf(-fabsf(x))); }
template <int CTRL>
__device__ __forceinline__ float dppx(float x) {
  return __int_as_float(__builtin_amdgcn_update_dpp(0, __float_as_int(x), CTRL, 0xf, 0xf, true));
}
__device__ __forceinline__ float rdlane(float v, int l) {
  return __int_as_float(__builtin_amdgcn_readlane(__float_as_int(v), l));
}
__device__ __forceinline__ float wsum(float v) {
  v += dppx<0xB1>(v); v += dppx<0x4E>(v); v += dppx<0x141>(v); v += dppx<0x140>(v);
  return (rdlane(v, 0) + rdlane(v, 16)) + (rdlane(v, 32) + rdlane(v, 48));
}
__device__ __forceinline__ float wmax(float v) {
  v = fmaxf(v, dppx<0xB1>(v)); v = fmaxf(v, dppx<0x4E>(v)); v = fmaxf(v, dppx<0x141>(v)); v = fmaxf(v, dppx<0x140>(v));
  return fmaxf(fmaxf(rdlane(v, 0), rdlane(v, 16)), fmaxf(rdlane(v, 32), rdlane(v, 48)));
}
__device__ __forceinline__ int opaque_tid() {
  int t = threadIdx.x;
  asm volatile("" : "+v"(t));
  return t;
}
typedef __bf16 bf16x2_t __attribute__((ext_vector_type(2)));
typedef float f32x2_t __attribute__((ext_vector_type(2)));
__device__ __forceinline__ unsigned pk_bf16(float lo, float hi) {
  const f32x2_t v = {lo, hi};
  return __builtin_bit_cast(unsigned, __builtin_convertvector(v, bf16x2_t));
}
__device__ __forceinline__ bf16_t f2bf(float x) { return (bf16_t)(pk_bf16(x, 0.f) & 0xffffu); }
__device__ __forceinline__ float bf2f(bf16_t v) { return __uint_as_float((unsigned)v << 16); }
__device__ __forceinline__ float bflo(unsigned u) { return __uint_as_float(u << 16); }
__device__ __forceinline__ float bfhi(unsigned u) { return __uint_as_float(u & 0xffff0000u); }
__device__ __forceinline__ int scan_row(int dir, int b, int tau) {
  if (tau < CTXL) return NL + b * CTXL + (dir ? (CTXL - 1 - tau) : tau);
  int s = tau - CTXL;
  return b * SEQ + (dir ? (SEQ - 1 - s) : s);
}

template <class RowPtrA>
__device__ __forceinline__ void gemm128_main(int tid, RowPtrA rowA, const bf16_t* __restrict__ Bt, int K, int n0,
                                             char* lds, f32x16 (&acc)[2][2]) {
  const int lane = tid & 63, w = tid >> 6;
  const int wm = w >> 1, wn = w & 1, r = lane & 31, h = lane >> 5;
  const int c = tid & 7, sr = tid >> 3;
  const int lc = (c ^ ((tid >> 4) & 7)) * 8;
  const bf16_t* ap[4];
#pragma unroll
  for (int i = 0; i < 4; ++i) ap[i] = rowA(sr + 32 * i) + lc;
  const bf16_t* bp0 = Bt + (size_t)(n0 + sr) * K + lc;
  const int bstr = 32 * K;
#pragma unroll
  for (int mi = 0; mi < 2; ++mi)
#pragma unroll
    for (int ni = 0; ni < 2; ++ni)
#pragma unroll
      for (int q = 0; q < 16; ++q) acc[mi][ni][q] = 0.f;
  const int nk = K >> 6;
  auto issue = [&](int kt) {
    char* As = lds + (kt & 1) * 32768 + tid * 16;
    const int k0 = kt * 64;
#pragma unroll
    for (int i = 0; i < 4; ++i) {
      __builtin_amdgcn_global_load_lds((const unsigned*)(ap[i] + k0), (__attribute__((address_space(3))) unsigned*)(As + i * 4096), 16, 0, 0);
      __builtin_amdgcn_global_load_lds((const unsigned*)(bp0 + i * bstr + k0), (__attribute__((address_space(3))) unsigned*)(As + 16384 + i * 4096), 16, 0, 0);
    }
  };
  issue(0);
  const int sw = (r >> 1) & 7;
#pragma unroll 1
  for (int kt = 0; kt < nk; ++kt) {
    asm volatile("s_waitcnt vmcnt(0)" ::: "memory");
    __syncthreads();
    if (kt + 1 < nk) issue(kt + 1);
    const char* As = lds + (kt & 1) * 32768;
    const char* Ar = As + (wm * 64 + r) * 128;
    const char* Br = As + 16384 + (wn * 64 + r) * 128;
#pragma unroll
    for (int ks = 0; ks < 4; ++ks) {
      const int off = ((ks * 2 + h) ^ sw) * 16;
      const bf16x8 a0 = *(const bf16x8*)(Ar + off);
      const bf16x8 a1 = *(const bf16x8*)(Ar + 32 * 128 + off);
      const bf16x8 b0 = *(const bf16x8*)(Br + off);
      const bf16x8 b1 = *(const bf16x8*)(Br + 32 * 128 + off);
      acc[0][0] = __builtin_amdgcn_mfma_f32_32x32x16_bf16(a0, b0, acc[0][0], 0, 0, 0);
      acc[0][1] = __builtin_amdgcn_mfma_f32_32x32x16_bf16(a0, b1, acc[0][1], 0, 0, 0);
      acc[1][0] = __builtin_amdgcn_mfma_f32_32x32x16_bf16(a1, b0, acc[1][0], 0, 0, 0);
      acc[1][1] = __builtin_amdgcn_mfma_f32_32x32x16_bf16(a1, b1, acc[1][1], 0, 0, 0);
    }
  }
  __syncthreads();
}
using i64 = long;
template <class RowPtrA8>
__device__ __forceinline__ void gemm128_fp8(int tid, RowPtrA8 rowA, const unsigned char* __restrict__ Bt, int K, int n0,
                                            char* lds, f32x16 (&acc)[2][2]) {
  const int lane = tid & 63, w = tid >> 6;
  const int wm = w >> 1, wn = w & 1, r = lane & 31, h = lane >> 5;
  const int c = tid & 7, sr = tid >> 3;
  const int lc = (c ^ ((tid >> 4) & 7)) * 16;
  const unsigned char* ap[4];
#pragma unroll
  for (int i = 0; i < 4; ++i) ap[i] = rowA(sr + 32 * i) + lc;
  const unsigned char* bp0 = Bt + (size_t)(n0 + sr) * K + lc;
  const int bstr = 32 * K;
#pragma unroll
  for (int mi = 0; mi < 2; ++mi)
#pragma unroll
    for (int ni = 0; ni < 2; ++ni)
#pragma unroll
      for (int q = 0; q < 16; ++q) acc[mi][ni][q] = 0.f;
  const int nk = K >> 7;
  auto issue = [&](int kt) {
    char* As = lds + (kt & 1) * 32768 + tid * 16;
    const int k0 = kt * 128;
#pragma unroll
    for (int i = 0; i < 4; ++i) {
      __builtin_amdgcn_global_load_lds((const unsigned*)(ap[i] + k0), (__attribute__((address_space(3))) unsigned*)(As + i * 4096), 16, 0, 0);
      __builtin_amdgcn_global_load_lds((const unsigned*)(bp0 + i * bstr + k0), (__attribute__((address_space(3))) unsigned*)(As + 16384 + i * 4096), 16, 0, 0);
    }
  };
  issue(0);
  const int sw = (r >> 1) & 7;
#pragma unroll 1
  for (int kt = 0; kt < nk; ++kt) {
    asm volatile("s_waitcnt vmcnt(0)" ::: "memory");
    __syncthreads();
    if (kt + 1 < nk) issue(kt + 1);
    const char* As = lds + (kt & 1) * 32768;
    const char* Ar = As + (wm * 64 + r) * 128;
    const char* Br = As + 16384 + (wn * 64 + r) * 128;
#pragma unroll
    for (int q = 0; q < 4; ++q) {
      const int off = ((q * 2 + h) ^ sw) * 16;
      const u32x4 a0 = *(const u32x4*)(Ar + off);
      const u32x4 a1 = *(const u32x4*)(Ar + 32 * 128 + off);
      const u32x4 b0 = *(const u32x4*)(Br + off);
      const u32x4 b1 = *(const u32x4*)(Br + 32 * 128 + off);
      const i64 a0l = (i64)(((unsigned long long)a0.y << 32) | a0.x), a0h = (i64)(((unsigned long long)a0.w << 32) | a0.z);
      const i64 a1l = (i64)(((unsigned long long)a1.y << 32) | a1.x), a1h = (i64)(((unsigned long long)a1.w << 32) | a1.z);
      const i64 b0l = (i64)(((unsigned long long)b0.y << 32) | b0.x), b0h = (i64)(((unsigned long long)b0.w << 32) | b0.z);
      const i64 b1l = (i64)(((unsigned long long)b1.y << 32) | b1.x), b1h = (i64)(((unsigned long long)b1.w << 32) | b1.z);
      acc[0][0] = __builtin_amdgcn_mfma_f32_32x32x16_fp8_fp8(a0l, b0l, acc[0][0], 0, 0, 0);
      acc[0][1] = __builtin_amdgcn_mfma_f32_32x32x16_fp8_fp8(a0l, b1l, acc[0][1], 0, 0, 0);
      acc[1][0] = __builtin_amdgcn_mfma_f32_32x32x16_fp8_fp8(a1l, b0l, acc[1][0], 0, 0, 0);
      acc[1][1] = __builtin_amdgcn_mfma_f32_32x32x16_fp8_fp8(a1l, b1l, acc[1][1], 0, 0, 0);
      acc[0][0] = __builtin_amdgcn_mfma_f32_32x32x16_fp8_fp8(a0h, b0h, acc[0][0], 0, 0, 0);
      acc[0][1] = __builtin_amdgcn_mfma_f32_32x32x16_fp8_fp8(a0h, b1h, acc[0][1], 0, 0, 0);
      acc[1][0] = __builtin_amdgcn_mfma_f32_32x32x16_fp8_fp8(a1h, b0h, acc[1][0], 0, 0, 0);
      acc[1][1] = __builtin_amdgcn_mfma_f32_32x32x16_fp8_fp8(a1h, b1h, acc[1][1], 0, 0, 0);
    }
  }
  __syncthreads();
}
template <class F>
__device__ __forceinline__ void acc_foreach(int tid, const f32x16 (&acc)[2][2], F f) {
  const int lane = tid & 63, w = tid >> 6;
  const int wm = w >> 1, wn = w & 1, r = lane & 31, h = lane >> 5;
#pragma unroll
  for (int mi = 0; mi < 2; ++mi)
#pragma unroll
    for (int ni = 0; ni < 2; ++ni)
#pragma unroll
      for (int q = 0; q < 16; ++q) {
        const int row = wm * 64 + mi * 32 + (q & 3) + 8 * (q >> 2) + 4 * h;
        const int col = wn * 64 + ni * 32 + r;
        f(row, col, acc[mi][ni][q]);
        if ((q & 3) == 3) __builtin_amdgcn_sched_barrier(0);
      }
}

template <class RM>
__device__ __forceinline__ void tr_tile(int tid, const float* __restrict__ src, int N, int k0, int n0,
                                        bf16_t* __restrict__ dst, int K, RM rowmap, float* tile) {
  {
    const int tx = tid & 15, ty = tid >> 4;
    const int n = n0 + tx * 4;
#pragma unroll
    for (int i = 0; i < 4; ++i) {
      const int k = ty + 16 * i;
      float4 v = make_float4(0.f, 0.f, 0.f, 0.f);
      if (n < N) v = *(const float4*)(src + (size_t)(k0 + k) * N + n);
      tile[k * 65 + tx * 4 + 0] = v.x; tile[k * 65 + tx * 4 + 1] = v.y;
      tile[k * 65 + tx * 4 + 2] = v.z; tile[k * 65 + tx * 4 + 3] = v.w;
    }
  }
  __syncthreads();
  {
    const int kc = tid & 7;
#pragma unroll
    for (int i = 0; i < 2; ++i) {
      const int n = (tid >> 3) + 32 * i;
      if (n0 + n < N) {
        float v[8];
#pragma unroll
        for (int q = 0; q < 8; ++q) v[q] = tile[(kc * 8 + q) * 65 + n];
        u32x4 o;
        o.x = pk_bf16(v[0], v[1]); o.y = pk_bf16(v[2], v[3]); o.z = pk_bf16(v[4], v[5]); o.w = pk_bf16(v[6], v[7]);
        *(u32x4*)(dst + (size_t)rowmap(n0 + n) * K + k0 + kc * 8) = o;
      }
    }
  }
  __syncthreads();
}

constexpr float W8_SCALE = 32.f, W8_INV = 1.f / 32.f;
__device__ __forceinline__ unsigned pk_fp8x4(float a, float b, float c, float d) {
  int r = __builtin_amdgcn_cvt_pk_fp8_f32(a, b, 0, false);
  r = __builtin_amdgcn_cvt_pk_fp8_f32(c, d, r, true);
  return (unsigned)r;
}
template <class RM>
__device__ __forceinline__ void tr_tile_fp8(int tid, const float* __restrict__ src, int N, int k0, int n0,
                                            unsigned char* __restrict__ dst, int K, RM rowmap, float* tile) {
  {
    const int tx = tid & 15, ty = tid >> 4;
    const int n = n0 + tx * 4;
#pragma unroll
    for (int i = 0; i < 4; ++i) {
      const int k = ty + 16 * i;
      const float4 v = *(const float4*)(src + (size_t)(k0 + k) * N + n);
      tile[k * 65 + tx * 4 + 0] = v.x; tile[k * 65 + tx * 4 + 1] = v.y;
      tile[k * 65 + tx * 4 + 2] = v.z; tile[k * 65 + tx * 4 + 3] = v.w;
    }
  }
  __syncthreads();
  {
    const int kc = tid & 3, n = tid >> 2;
    float v[16];
#pragma unroll
    for (int q = 0; q < 16; ++q) v[q] = tile[(kc * 16 + q) * 65 + n] * W8_SCALE;
    u32x4 o;
    o.x = pk_fp8x4(v[0], v[1], v[2], v[3]); o.y = pk_fp8x4(v[4], v[5], v[6], v[7]);
    o.z = pk_fp8x4(v[8], v[9], v[10], v[11]); o.w = pk_fp8x4(v[12], v[13], v[14], v[15]);
    *(u32x4*)(dst + (size_t)rowmap(n0 + n) * K + k0 + kc * 16) = o;
  }
  __syncthreads();
}

constexpr int CJ0 = 1152, CJ1 = CJ0 + 2080, CJ2 = CJ1 + 1024, CJ3 = CJ2 + 33280, CJ4 = CJ3 + 16640;
__device__ void convert_job(KP p, int job, float* sm, int tid) {
  if (job < CJ0) {
    const int j = job / 576, rem = job % 576, kt = rem / 36, nt = rem % 36;
    tr_tile(tid, p->att_w_in + (size_t)j * 1024 * ATT_N, ATT_N, kt * 64, nt * 64, p->Wt_att + (size_t)j * ATT_N * 1024,
            1024, [](int n) { return n; }, sm);
  } else if (job < CJ1) {
    const int q = job - CJ0;
    const int j = q / 1040, rem = q % 1040, kt = rem / 65, nt = rem % 65;
    tr_tile(tid, p->rec_w_in + (size_t)j * 1024 * REC_N, REC_N, kt * 64, nt * 64, p->Wt_rec + (size_t)j * REC_NP * 1024,
            1024, [](int n) { return n; }, sm);
  } else if (job < CJ2) {
    const int q = job - CJ1;
    const int i = q >> 8, rem = q & 255, kt = rem >> 4, nt = rem & 15;
    tr_tile(tid, p->mix_w_out + (size_t)i * 1024 * 1024, 1024, kt * 64, nt * 64, p->Wt_out + (size_t)i * 1024 * 1024,
            1024, [](int n) { return n; }, sm);
  } else if (job < CJ3) {
    const int q = job - CJ2;
    const int le = q >> 7, rem = q & 127;
    const int which = rem >> 6, kt = (rem >> 2) & 15, nt = rem & 3;
    const int layer = le / 65, e = le % 65;
    const float* src;
    if (e < 64) src = (which ? p->moe_w3 : p->moe_w1) + (size_t)(layer * 64 + e) * 1024 * 256;
    else src = (which ? p->shared_w3 : p->shared_w1) + (size_t)layer * 1024 * 256;
    tr_tile_fp8(tid, src, 256, kt * 64, nt * 64, (unsigned char*)p->Wt13 + (size_t)le * 512 * 1024, 1024,
                [which](int n) { return 64 * (n >> 5) + which * 32 + (n & 31); }, sm);
  } else {
    const int q = job - CJ3;
    const int le = q >> 6, rem = q & 63;
    const int kt = rem >> 4, nt = rem & 15;
    const int layer = le / 65, e = le % 65;
    const float* src = e < 64 ? p->moe_w2 + (size_t)(layer * 64 + e) * 256 * 1024 : p->shared_w2 + (size_t)layer * 256 * 1024;
    tr_tile_fp8(tid, src, 1024, kt * 64, nt * 64, (unsigned char*)p->Wt2 + (size_t)le * 1024 * 256, 256, [](int n) { return n; }, sm);
  }
}
__device__ __forceinline__ int conv_stage_total(int stage) {
  return stage == 0 ? (576 + 1040 + 512 + 8320 + 4160) : (stage == 1 ? (576 + 1040 + 256 + 16640 + 8320) : (256 + 8320 + 4160));
}
__device__ __forceinline__ int conv_stage_job(int stage, int q) {
  if (stage == 0) {
    if (q < 8320) return CJ2 + q;  q -= 8320;
    if (q < 4160) return CJ3 + q;  q -= 4160;
    if (q < 576) return q;  q -= 576;
    if (q < 1040) return CJ0 + q;  q -= 1040;
    return CJ1 + q;
  } else if (stage == 1) {
    if (q < 8320) return CJ2 + 8320 + q;  q -= 8320;
    if (q < 4160) return CJ3 + 4160 + q;  q -= 4160;
    if (q < 576) return 576 + q;  q -= 576;
    if (q < 256) return CJ1 + 512 + q;  q -= 256;
    if (q < 8320) return CJ2 + 16640 + q;  q -= 8320;
    if (q < 4160) return CJ3 + 8320 + q;  q -= 4160;
    return CJ0 + 1040 + q;
  }
  if (q < 256) return CJ1 + 768 + q;  q -= 256;
  if (q < 8320) return CJ2 + 24960 + q;  q -= 8320;
  return CJ3 + 12480 + q;
}

struct CvDesc { const float* src; unsigned char* dst; int N, K, k0, n0, which; };
__device__ __forceinline__ bool conv_desc_fp8(KP p, int job, CvDesc& d) {
  if (job < CJ2) return false;
  if (job < CJ3) {
    const int q = job - CJ2;
    const int le = q >> 7, rem = q & 127;
    const int which = rem >> 6, kt = (rem >> 2) & 15, nt = rem & 3;
    const int layer = le / 65, e = le % 65;
    if (e < 64) d.src = (which ? p->moe_w3 : p->moe_w1) + (size_t)(layer * 64 + e) * 1024 * 256;
    else d.src = (which ? p->shared_w3 : p->shared_w1) + (size_t)layer * 1024 * 256;
    d.dst = (unsigned char*)p->Wt13 + (size_t)le * 512 * 1024;
    d.N = 256; d.K = 1024; d.k0 = kt * 64; d.n0 = nt * 64; d.which = which;
  } else {
    const int q = job - CJ3;
    const int le = q >> 6, rem = q & 63;
    const int kt = rem >> 4, nt = rem & 15;
    const int layer = le / 65, e = le % 65;
    d.src = e < 64 ? p->moe_w2 + (size_t)(layer * 64 + e) * 256 * 1024 : p->shared_w2 + (size_t)layer * 256 * 1024;
    d.dst = (unsigned char*)p->Wt2 + (size_t)le * 1024 * 256;
    d.N = 1024; d.K = 256; d.k0 = kt * 64; d.n0 = nt * 64; d.which = -1;
  }
  return true;
}
typedef float cvf4 __attribute__((ext_vector_type(4)));
__device__ __forceinline__ void cv_load(const CvDesc& d, int tid, cvf4& v0, cvf4& v1, cvf4& v2, cvf4& v3) {
  const int tx = tid & 15, ty = tid >> 4;
  const float* s0 = d.src + (size_t)(d.k0 + ty) * d.N + d.n0 + tx * 4;
  v0 = *(const cvf4*)(s0);
  v1 = *(const cvf4*)(s0 + (size_t)16 * d.N);
  v2 = *(const cvf4*)(s0 + (size_t)32 * d.N);
  v3 = *(const cvf4*)(s0 + (size_t)48 * d.N);
}
__device__ __forceinline__ void cv_emit(const CvDesc& d, int tid, const cvf4 v0, const cvf4 v1, const cvf4 v2, const cvf4 v3, float* tile) {
  {
    const int tx = tid & 15, ty = tid >> 4;
    float* t0 = tile + ty * 65 + tx * 4;
    t0[0] = v0.x; t0[1] = v0.y; t0[2] = v0.z; t0[3] = v0.w;
    t0[16 * 65 + 0] = v1.x; t0[16 * 65 + 1] = v1.y; t0[16 * 65 + 2] = v1.z; t0[16 * 65 + 3] = v1.w;
    t0[32 * 65 + 0] = v2.x; t0[32 * 65 + 1] = v2.y; t0[32 * 65 + 2] = v2.z; t0[32 * 65 + 3] = v2.w;
    t0[48 * 65 + 0] = v3.x; t0[48 * 65 + 1] = v3.y; t0[48 * 65 + 2] = v3.z; t0[48 * 65 + 3] = v3.w;
  }
  __syncthreads();
  {
    const int kc = tid & 3, n = tid >> 2;
    float v[16];
#pragma unroll
    for (int q = 0; q < 16; ++q) v[q] = tile[(kc * 16 + q) * 65 + n] * W8_SCALE;
    u32x4 o;
    o.x = pk_fp8x4(v[0], v[1], v[2], v[3]); o.y = pk_fp8x4(v[4], v[5], v[6], v[7]);
    o.z = pk_fp8x4(v[8], v[9], v[10], v[11]); o.w = pk_fp8x4(v[12], v[13], v[14], v[15]);
    const int nn = d.n0 + n;
    const int row = d.which >= 0 ? 64 * (nn >> 5) + d.which * 32 + (nn & 31) : nn;
    *(u32x4*)(d.dst + (size_t)row * d.K + d.k0 + kc * 16) = o;
  }
  __syncthreads();
}
__device__ __forceinline__ void convert_run(KP p, int stage, int jj, int j1, float* sm, int tid) {
  CvDesc d, dn;
  cvf4 a0, a1, a2, a3, b0, b1, b2, b3;
  bool cur = false;
#pragma unroll 1
  for (; jj < j1; ++jj) {
    const int job = conv_stage_job(stage, jj);
    if (!cur) {
      if (!conv_desc_fp8(p, job, d)) { convert_job(p, job, sm, tid); continue; }
      cv_load(d, tid, a0, a1, a2, a3);
    }
    bool nxt = false;
    if (jj + 1 < j1) {
      nxt = conv_desc_fp8(p, conv_stage_job(stage, jj + 1), dn);
      if (nxt) cv_load(dn, tid, b0, b1, b2, b3);
    }
    cv_emit(d, tid, a0, a1, a2, a3, sm);
    if (nxt) { d = dn; a0 = b0; a1 = b1; a2 = b2; a3 = b3; }
    cur = nxt;
  }
}

__device__ void ph_init(KP p, char* smc) {
  float* sm = (float*)smc;
  const int tid = opaque_tid();
  {
    const size_t n4a = (size_t)NL * DM / 4, n4b = (size_t)NC * DM / 4;
    const float4* xs = (const float4*)p->x;
    const float4* cs = (const float4*)p->ctx;
    float4* X4 = (float4*)p->X;
    for (size_t i = (size_t)blockIdx.x * NTHR + tid; i < n4a + n4b; i += (size_t)gridDim.x * NTHR)
      X4[i] = i < n4a ? xs[i] : cs[i - n4a];
  }
  for (int tile = blockIdx.x; tile < 96 * 8; tile += gridDim.x) {
    const int ct = tile >> 3, ks = tile & 7;
    for (int i = tid; i < 9 * 128; i += NTHR) {
      const int r = i >> 7, k = ks * 128 + (i & 127);
      const float v = r < 8 ? p->c[r * 1024 + k] : p->c_ctx[k];
      sm[i] = silu_f(v);
    }
    __syncthreads();
    const int col = ct * 256 + tid;
    const int layer = col / 6144, n = col % 6144;
    const float* W = p->ada_w + ((size_t)layer * 1024 + ks * 128) * 6144 + n;
    float acc[9];
#pragma unroll
    for (int r = 0; r < 9; ++r) acc[r] = 0.f;
#pragma unroll 4
    for (int k = 0; k < 128; ++k) {
      const float w = W[(size_t)k * 6144];
#pragma unroll
      for (int r = 0; r < 9; ++r) acc[r] = fmaf(sm[r * 128 + k], w, acc[r]);
    }
#pragma unroll
    for (int r = 0; r < 9; ++r) p->MODP[((size_t)(ks * 4 + layer) * 9 + r) * 6144 + n] = acc[r];
    __syncthreads();
  }
  {
    const int total = conv_stage_total(0), chunk = (total + gridDim.x - 1) / gridDim.x;
    const int lo = min((int)blockIdx.x * chunk, total), hi = min(lo + chunk, total);
    __syncthreads();
    convert_run(p, 0, lo, hi, sm, tid);
  }
  for (int i = blockIdx.x * NTHR + tid; i < 2 * 3 * 128 * 512; i += gridDim.x * NTHR) {
    const int k = i & 511, n = (i >> 9) & 127, wj = i >> 16;
    const int j = wj / 3, which = wj % 3;
    float v = 0.f;
    if (which < 2) {
      if (n < 64) v = (which ? p->rwkv_a1 : p->rwkv_w1)[((size_t)(j * 2 + (n >> 5)) * 512 + k) * 32 + (n & 31)];
    } else if (n < 96) v = p->rwkv_g1[((size_t)j * 512 + k) * 96 + n];
    p->Wl1[i] = f2bf(v);
  }
  for (int i = blockIdx.x * NTHR + tid; i < 2 * 2560 * 128; i += gridDim.x * NTHR) {
    const int k = i & 127, n = (i >> 7) % 2560, j = i / (2560 * 128);
    float v = 0.f;
    if (n < 2048) {
      const int d = (n >> 9) & 1, c = n & 511;
      if (k < 64 && (k >> 5) == d) v = (n < 1024 ? p->rwkv_w2 : p->rwkv_a2)[((size_t)(j * 2 + d) * 32 + (k & 31)) * 512 + c];
    } else if (k < 96) v = p->rwkv_g2[((size_t)j * 96 + k) * 512 + (n - 2048)];
    p->Wl2[i] = f2bf(v);
  }
  for (int i = blockIdx.x * NTHR + tid; i < 4 * 64 * 1024; i += gridDim.x * NTHR) {
    const int k = i & 1023, n = (i >> 10) & 63, l = i >> 16;
    p->WrT[i] = p->moe_router[((size_t)l * 1024 + k) * 64 + n];
  }
  for (int i = blockIdx.x * NTHR + tid; i < 64 * 16; i += gridDim.x * NTHR) {
    const int pos = i >> 4, f = i & 15;
    const float ang = (float)pos * powf(10000.f, -(float)f / 16.f);
    p->ROPE[2 * i] = cosf(ang);
    p->ROPE[2 * i + 1] = sinf(ang);
  }
}

__device__ void ph_mod_h(KP p, char* smc) {
  float* sm = (float*)smc;
  const int tid = opaque_tid();
  for (int i = blockIdx.x * NTHR + tid; i < 4 * 9 * 6144; i += gridDim.x * NTHR) {
    const int layer = i / (9 * 6144), rem = i % (9 * 6144), n = rem % 6144;
    float s = p->ada_b[layer * 6144 + n];
#pragma unroll
    for (int ks = 0; ks < 8; ++ks) s += p->MODP[(size_t)(ks * 4 + layer) * 9 * 6144 + rem];
    p->MOD[i] = s;
  }
  const int lane = tid & 63, wave = tid >> 6;
  const int per = (((NT + gridDim.x - 1) / gridDim.x) + 3) & ~3;
  const int t0 = blockIdx.x * per, t1 = min(NT, t0 + per);
  int cur = -1;
  for (int tb = t0; tb < t1; tb += 4) {
    const int mr = modrow(tb);
    if (mr != cur) {
      __syncthreads();
      for (int n = tid; n < 2048; n += NTHR) {
        float a = p->ada_b[n];
#pragma unroll
        for (int ks = 0; ks < 8; ++ks) a += p->MODP[((size_t)(ks * 4) * 9 + mr) * 6144 + n];
        sm[n] = a;
      }
      cur = mr;
      __syncthreads();
    }
    const int t = tb + wave;
    if (t < t1) {
      const float* src = t < NL ? p->x + (size_t)t * DM : p->ctx + (size_t)(t - NL) * DM;
#pragma unroll
      for (int i = 0; i < 4; ++i) {
        const int n = i * 256 + lane * 4;
        const float4 xv = *(const float4*)(src + n);
        const float4 sh = *(const float4*)(sm + n);
        const float4 sc = *(const float4*)(sm + 1024 + n);
        u32x2 o;
        o.x = pk_bf16(xv.x * (1.f + sc.x) + sh.x, xv.y * (1.f + sc.y) + sh.y);
        o.y = pk_bf16(xv.z * (1.f + sc.z) + sh.z, xv.w * (1.f + sc.w) + sh.w);
        *(u32x2*)(p->AB + (size_t)t * DM + n) = o;
      }
    }
  }
}

typedef short v4i16_t __attribute__((ext_vector_type(4)));
using s16x4 = __attribute__((ext_vector_type(4))) short;
__device__ __forceinline__ s16x4 vtr(const char* p) {
  return __builtin_bit_cast(s16x4, __builtin_amdgcn_ds_read_tr16_b64_v4i16((__attribute__((address_space(3))) v4i16_t*)p));
}
#define MFMA32(a, b, c) __builtin_amdgcn_mfma_f32_32x32x16_bf16(a, b, c, 0, 0, 0)
__device__ void ph_attention(KP p, int layer, bool keep, char* lds) {
  const int tid = opaque_tid();
  const int lane = tid & 63, w = tid >> 6, r32 = lane & 31, hi = lane >> 5;
  const int j = layer >> 1;
  float* bias_lds = (float*)(lds + 32768 + 1024);
  const int n_gqa = 1024, n_na = 1024, n_cb = keep ? 128 : 0, n_ca = keep ? 128 : 0;
  const int total = n_gqa + n_na + n_cb + n_ca;
  constexpr float LOG2E = 1.4426950408889634f;
  constexpr float C2 = 0.125f * LOG2E;
  const int c = tid & 7, sr = tid >> 3;
  const int kso = (c ^ ((tid >> 4) & 7)) * 16;
  const int vso = (c >> 2) * 4096 + (c & 3) * 16;
  const int sw = (r32 >> 1) & 7;
  for (int item = blockIdx.x; item < total; item += gridDim.x) {
    int b, qrow0, qoff, koff, voff, ocol, lat_tiles, lat_row0;
    bool na = false;
    int r_w = 0, start_w = 0, ru0 = 0, hN = 0;
    if (item < n_gqa) {
      b = item >> 7;
      const int g = (item >> 6) & 1, tt = item & 63;
      qrow0 = b * SEQ + tt * 32; qoff = 1536 + (g * 4 + w) * 64; koff = 2048 + g * 64; voff = 2176 + g * 64;
      ocol = 512 + (g * 4 + w) * 64; lat_tiles = 32; lat_row0 = b * SEQ;
    } else if (item < n_gqa + n_na) {
      const int it = item - n_gqa;
      b = it >> 7; hN = (it >> 4) & 7;
      const int rp = it & 15;
      na = true; r_w = 2 * rp + (w >> 1);
      qrow0 = b * SEQ + r_w * 64 + (w & 1) * 32; qoff = hN * 64; koff = 512 + hN * 64; voff = 1024 + hN * 64; ocol = hN * 64;
      const int s0 = min(max(2 * rp - 4, 0), 24), s1 = min(max(2 * rp - 3, 0), 24);
      start_w = (w >> 1) ? s1 : s0; ru0 = s0; lat_tiles = (s1 != s0) ? 9 : 8; lat_row0 = b * SEQ + ru0 * 64;
    } else if (item < n_gqa + n_na + n_cb) {
      const int it = item - n_gqa - n_na;
      b = it >> 4;
      const int g = (it >> 3) & 1, tt = it & 7;
      qrow0 = NL + b * CTXL + tt * 32; qoff = 1536 + (g * 4 + w) * 64; koff = 2048 + g * 64; voff = 2176 + g * 64;
      ocol = 512 + (g * 4 + w) * 64; lat_tiles = 0; lat_row0 = 0;
    } else {
      const int it = item - n_gqa - n_na - n_cb;
      b = it >> 4;
      const int h = (it >> 1) & 7, half = it & 1;
      qrow0 = NL + b * CTXL + half * 128 + w * 32; qoff = h * 64; koff = 512 + h * 64; voff = 1024 + h * 64; ocol = h * 64;
      lat_tiles = 0; lat_row0 = 0;
    }
    const int ctx_row0 = NL + b * CTXL, ntiles = lat_tiles + 4;
    if (na)
      for (int i = tid; i < 465; i += NTHR) bias_lds[i] = p->na_rpb[(j * 8 + hN) * 465 + i] * LOG2E;
    bf16x8 qf[4];
    {
      const bf16_t* qp = p->P + (size_t)(qrow0 + r32) * LDP + qoff + hi * 8;
#pragma unroll
      for (int d0 = 0; d0 < 4; ++d0) qf[d0] = *(const bf16x8*)(qp + d0 * 16);
    }
    f32x16 o0, o1;
#pragma unroll
    for (int q = 0; q < 16; ++q) { o0[q] = 0.f; o1[q] = 0.f; }
    float m = -INFINITY, l = 0.f;
    u32x4 kr0, kr1, vr0, vr1;
    auto gload = [&](int t) {
      const int row0 = t < lat_tiles ? lat_row0 + 64 * t : ctx_row0 + 64 * (t - lat_tiles);
      const bf16_t* base = p->P + (size_t)(row0 + sr) * LDP + c * 8;
      kr0 = *(const u32x4*)(base + koff); kr1 = *(const u32x4*)(base + (size_t)32 * LDP + koff);
      vr0 = *(const u32x4*)(base + voff); vr1 = *(const u32x4*)(base + (size_t)32 * LDP + voff);
    };
    auto swrite = [&](int buf) {
      char* Kb = lds + buf * 16384;
      char* Vb = Kb + 8192;
      *(u32x4*)(Kb + sr * 128 + kso) = kr0; *(u32x4*)(Kb + (sr + 32) * 128 + kso) = kr1;
      *(u32x4*)(Vb + vso + sr * 64) = vr0; *(u32x4*)(Vb + vso + (sr + 32) * 64) = vr1;
    };
    gload(0);
    swrite(0);
    for (int t = 0; t < ntiles; ++t) {
      __syncthreads();
      if (t + 1 < ntiles) gload(t + 1);
      const bool na_tile = na && t < lat_tiles;
      const int kr = ru0 + t;
      const bool part = !na_tile || (kr >= start_w && kr < start_w + 8);
      if (part) {
        const char* Ks = lds + (t & 1) * 16384;
        const char* Vs = Ks + 8192;
        f32x16 s0, s1;
#pragma unroll
        for (int q = 0; q < 16; ++q) { s0[q] = 0.f; s1[q] = 0.f; }
#pragma unroll
        for (int d0 = 0; d0 < 4; ++d0) {
          const int off = ((2 * d0 + hi) ^ sw) * 16;
          const bf16x8 k0 = *(const bf16x8*)(Ks + r32 * 128 + off);
          const bf16x8 k1 = *(const bf16x8*)(Ks + (32 + r32) * 128 + off);
          s0 = MFMA32(k0, qf[d0], s0);
          s1 = MFMA32(k1, qf[d0], s1);
        }
        float mx = -INFINITY;
        if (na_tile) {
          const int cq = (w & 1) * 32 + r32;
          const int c0 = min(max(cq - 8, 0), 48);
          const float* brow = bias_lds + (kr - r_w + 7) * 31 + (15 - cq);
#pragma unroll
          for (int q = 0; q < 16; ++q) {
            const int kc = (q & 3) + 8 * (q >> 2) + 4 * hi;
            const float v0 = ((unsigned)(kc - c0) < 16u) ? fmaf(s0[q], C2, brow[kc]) : -INFINITY;
            const float v1 = ((unsigned)(kc + 32 - c0) < 16u) ? fmaf(s1[q], C2, brow[kc + 32]) : -INFINITY;
            s0[q] = v0; s1[q] = v1;
            mx = fmaxf(mx, fmaxf(v0, v1));
          }
        } else {
#pragma unroll
          for (int q = 0; q < 16; ++q) {
            s0[q] *= C2; s1[q] *= C2;
            mx = fmaxf(mx, fmaxf(s0[q], s1[q]));
          }
        }
        {
          auto rr = __builtin_amdgcn_permlane32_swap(__float_as_uint(mx), __float_as_uint(mx), false, false);
          mx = fmaxf(__uint_as_float(rr[0]), __uint_as_float(rr[1]));
        }
        const float mnew = fmaxf(m, mx);
        const float alpha = __builtin_amdgcn_exp2f(m - mnew);
        float ls = 0.f;
#pragma unroll
        for (int q = 0; q < 16; ++q) {
          s0[q] = __builtin_amdgcn_exp2f(s0[q] - mnew);
          s1[q] = __builtin_amdgcn_exp2f(s1[q] - mnew);
          ls += s0[q] + s1[q];
        }
        l = l * alpha + ls;
        m = mnew;
#pragma unroll
        for (int q = 0; q < 16; ++q) { o0[q] *= alpha; o1[q] *= alpha; }
        bf16x8 pf[4];
#pragma unroll
        for (int s = 0; s < 4; ++s) {
          const int u = (s & 1) * 8;
          u32x4 tpk;
          if (s < 2) {
            tpk.x = pk_bf16(s0[u + 0], s0[u + 1]); tpk.y = pk_bf16(s0[u + 2], s0[u + 3]);
            tpk.z = pk_bf16(s0[u + 4], s0[u + 5]); tpk.w = pk_bf16(s0[u + 6], s0[u + 7]);
          } else {
            tpk.x = pk_bf16(s1[u + 0], s1[u + 1]); tpk.y = pk_bf16(s1[u + 2], s1[u + 3]);
            tpk.z = pk_bf16(s1[u + 4], s1[u + 5]); tpk.w = pk_bf16(s1[u + 6], s1[u + 7]);
          }
          pf[s] = __builtin_bit_cast(bf16x8, tpk);
        }
        const char* vb = Vs + ((lane >> 4) & 1) * 32 + (lane & 3) * 8 + ((lane & 15) >> 2) * 64 + hi * 256;
#pragma unroll
        for (int s = 0; s < 4; ++s) {
          const s16x4 a00 = vtr(vb + (16 * s) * 64), a01 = vtr(vb + (16 * s + 8) * 64);
          const s16x4 a10 = vtr(vb + 4096 + (16 * s) * 64), a11 = vtr(vb + 4096 + (16 * s + 8) * 64);
          const bf16x8 A0 = __builtin_shufflevector(a00, a01, 0, 1, 2, 3, 4, 5, 6, 7);
          const bf16x8 A1 = __builtin_shufflevector(a10, a11, 0, 1, 2, 3, 4, 5, 6, 7);
          o0 = MFMA32(A0, pf[s], o0);
          o1 = MFMA32(A1, pf[s], o1);
        }
      }
      if (t + 1 < ntiles) swrite((t + 1) & 1);
    }
    __syncthreads();
    const float lt = l + __shfl_xor(l, 32);
    const float inv = 1.f / lt;
    bf16_t* op = p->AB + (size_t)(qrow0 + r32) * DM + ocol + 4 * hi;
#pragma unroll
    for (int g = 0; g < 4; ++g) {
      u32x2 v0, v1;
      v0.x = pk_bf16(o0[4 * g] * inv, o0[4 * g + 1] * inv); v0.y = pk_bf16(o0[4 * g + 2] * inv, o0[4 * g + 3] * inv);
      v1.x = pk_bf16(o1[4 * g] * inv, o1[4 * g + 1] * inv); v1.y = pk_bf16(o1[4 * g + 2] * inv, o1[4 * g + 3] * inv);
      *(u32x2*)(op + 8 * g) = v0;
      *(u32x2*)(op + 32 + 8 * g) = v1;
    }
  }
}

__device__ void ph_rwkv_mix(KP p, int layer) {
  const int j = layer >> 1;
  const int tid = opaque_tid();
  const int lane = tid & 63, wave = tid >> 6;
  const float* mu = p->rwkv_mu + j * 6 * 512;
  const int c0 = lane * 8;
  auto unpack = [](const u32x4 u, float (&f)[8]) {
    f[0] = bflo(u.x); f[1] = bfhi(u.x); f[2] = bflo(u.y); f[3] = bfhi(u.y);
    f[4] = bflo(u.z); f[5] = bfhi(u.z); f[6] = bflo(u.w); f[7] = bfhi(u.w);
  };
  auto pack = [](const float (&f)[8]) {
    u32x4 o;
    o.x = pk_bf16(f[0], f[1]); o.y = pk_bf16(f[2], f[3]); o.z = pk_bf16(f[4], f[5]); o.w = pk_bf16(f[6], f[7]);
    return o;
  };
  for (int t = blockIdx.x * 4 + wave; t < NT; t += gridDim.x * 4) {
    bool hasp, hasn;
    if (t < NL) { int s = t & 2047; hasp = s > 0; hasn = s < SEQ - 1; }
    else { int s = (t - NL) & 255; hasp = s > 0; hasn = s < CTXL - 1; }
    const bf16_t* pt = p->P + (size_t)t * LDP + c0;
    bf16_t* rw = p->RW + (size_t)t * RWS + c0;
    bf16_t* zb = p->Zb + (size_t)t * 1536 + c0;
    const u32x4 zero = {0u, 0u, 0u, 0u};
#pragma unroll
    for (int q = 0; q < 4; ++q) {
      float cur[8], pv[8], nx[8], d[8];
      unpack(*(const u32x4*)(pt + q * 512), cur);
      unpack(hasp ? *(const u32x4*)(pt + q * 512 - LDP) : zero, pv);
      unpack(hasn ? *(const u32x4*)(pt + q * 512 + LDP) : zero, nx);
#pragma unroll
      for (int e = 0; e < 8; ++e) d[e] = 0.5f * (pv[e] + nx[e]) - cur[e];
      if (q < 3) {
        float o[8];
        const float* m = mu + q * 512 + c0;
#pragma unroll
        for (int e = 0; e < 8; ++e) o[e] = cur[e] + d[e] * m[e];
        if (q == 0) *(u32x4*)(rw) = pack(o);
        else if (q == 2) *(u32x4*)(rw + 512) = pack(o);
        else {
          *(u32x4*)(rw + 10 * 512) = pack(o);
          float kk[8], ss = 0.f;
          const float* kv0 = p->rwkv_kvec + (j * 2 + 0) * 512 + c0;
#pragma unroll
          for (int e = 0; e < 8; ++e) { kk[e] = o[e] * kv0[e]; ss += kk[e] * kk[e]; }
          ss += dppx<0xB1>(ss); ss += dppx<0x4E>(ss); ss += dppx<0x141>(ss);
          const float rn = rsqrtf(fmaxf(ss, 1e-24f));
#pragma unroll
          for (int e = 0; e < 8; ++e) kk[e] *= rn;
          *(u32x4*)(rw + 2 * 512) = pack(kk);
        }
      } else {
#pragma unroll
        for (int z = 0; z < 3; ++z) {
          float o[8];
          const float* m = mu + (3 + z) * 512 + c0;
#pragma unroll
          for (int e = 0; e < 8; ++e) o[e] = cur[e] + d[e] * m[e];
          *(u32x4*)(zb + z * 512) = pack(o);
        }
      }
    }
  }
}

constexpr int RS_STEP = 384;
constexpr int RS_TB = 16;
struct RwkvStage { u32x2 r, kk, e, ke, a, v; };
__device__ void rwkv_unit(KP p, int unit, float* sm, int tid) {
  const int ch = unit >> 1, hf = unit & 1;
  const int dir = ch >> 6, b = (ch >> 3) & 7, h = ch & 7;
  const int lane = tid & 63, w = tid >> 6, rl = lane >> 3, ks = lane & 7;
  float* ybuf = sm + 2 * RS_TB * RS_STEP;
  const int ss = tid >> 4, kq = tid & 15;
  auto gload = [&](int n, RwkvStage& g) {
    const int row = scan_row(dir, b, n * RS_TB + ss);
    const bf16_t* base = p->RW + (size_t)row * RWS + h * 64 + kq * 4;
    g.r = *(const u32x2*)(base);
    g.kk = *(const u32x2*)(base + 2 * 512);
    g.e = *(const u32x2*)(base + (3 + dir) * 512);
    g.ke = *(const u32x2*)(base + (5 + dir) * 512);
    g.a = *(const u32x2*)(base + (7 + dir) * 512);
    g.v = *(const u32x2*)(p->RW + (size_t)row * RWS + 512 + h * 64 + hf * 32 + (kq & 7) * 4);
  };
  auto swrite = [&](int buf, const RwkvStage& g) {
    float* sp = sm + (buf * RS_TB + ss) * RS_STEP;
    const float r0 = bflo(g.r.x), r1 = bfhi(g.r.x), r2 = bflo(g.r.y), r3 = bfhi(g.r.y);
    const float k0 = bflo(g.kk.x), k1 = bfhi(g.kk.x), k2 = bflo(g.kk.y), k3 = bfhi(g.kk.y);
    const float w0 = __expf(-bflo(g.e.x)), w1 = __expf(-bfhi(g.e.x)), w2 = __expf(-bflo(g.e.y)), w3 = __expf(-bfhi(g.e.y));
    const float e0 = bflo(g.ke.x), e1 = bfhi(g.ke.x), e2 = bflo(g.ke.y), e3 = bfhi(g.ke.y);
    const float a0 = k0 * bflo(g.a.x), a1 = k1 * bfhi(g.a.x), a2 = k2 * bflo(g.a.y), a3 = k3 * bfhi(g.a.y);
    *(float4*)(sp + kq * 4) = make_float4(k0, k1, k2, k3);
    *(float4*)(sp + 64 + kq * 4) = make_float4(w0 * r0, w1 * r1, w2 * r2, w3 * r3);
    *(float4*)(sp + 128 + kq * 4) = make_float4(w0, w1, w2, w3);
    *(float4*)(sp + 192 + kq * 4) = make_float4(a0, a1, a2, a3);
    *(float4*)(sp + 256 + kq * 4) = make_float4(e0, e1, e2, e3);
    if (kq < 8) *(float4*)(sp + 320 + kq * 4) = make_float4(bflo(g.v.x), bfhi(g.v.x), bflo(g.v.y), bfhi(g.v.y));
    float c1 = a0 * r0 + a1 * r1 + a2 * r2 + a3 * r3;
    float c2 = e0 * r0 + e1 * r1 + e2 * r2 + e3 * r3;
    c1 += dppx<0xB1>(c1); c2 += dppx<0xB1>(c2);
    c1 += dppx<0x4E>(c1); c2 += dppx<0x4E>(c2);
    c1 += dppx<0x141>(c1); c2 += dppx<0x141>(c2);
    c1 += dppx<0x140>(c1); c2 += dppx<0x140>(c2);
    if (kq == 0) { sp[352] = c1; sp[353] = c2; }
  };
  typedef float f2 __attribute__((ext_vector_type(2)));
  f2 S01 = {0.f, 0.f}, S23 = {0.f, 0.f}, S45 = {0.f, 0.f}, S67 = {0.f, 0.f};
  auto compute = [&](int n) {
    const float* bp = sm + (n & 1) * RS_TB * RS_STEP;
    float* yb = ybuf + (n & 1) * RS_TB * 32 + w * 8 + rl;
    struct Ops { f2 k[4], r[4], w[4], a[4], e[4]; float vv; f2 c; };
    auto ld = [&](int s, Ops& o) {
      const float* sq = bp + s * RS_STEP;
      const f2* sp = (const f2*)(sq + ks * 8);
#pragma unroll
      for (int i = 0; i < 4; ++i) { o.k[i] = sp[i]; o.r[i] = sp[32 + i]; o.w[i] = sp[64 + i]; o.a[i] = sp[96 + i]; o.e[i] = sp[128 + i]; }
      o.vv = sq[320 + w * 8 + rl]; o.c = *(const f2*)(sq + 352);
    };
    auto step = [&](const Ops& o) -> float {
      f2 sa2 = S01 * o.k[0];
      f2 y2 = S01 * o.r[0];
      sa2 = __builtin_elementwise_fma(S23, o.k[1], sa2); y2 = __builtin_elementwise_fma(S23, o.r[1], y2);
      sa2 = __builtin_elementwise_fma(S45, o.k[2], sa2); y2 = __builtin_elementwise_fma(S45, o.r[2], y2);
      sa2 = __builtin_elementwise_fma(S67, o.k[3], sa2); y2 = __builtin_elementwise_fma(S67, o.r[3], y2);
      float sa = sa2.x + sa2.y, y0 = y2.x + y2.y;
      sa += dppx<0xB1>(sa); y0 += dppx<0xB1>(y0);
      sa += dppx<0x4E>(sa); y0 += dppx<0x4E>(y0);
      sa += dppx<0x141>(sa); y0 += dppx<0x141>(y0);
      sa = -sa;
      const f2 sav = {sa, sa}, vvv = {o.vv, o.vv};
      S01 = __builtin_elementwise_fma(vvv, o.e[0], __builtin_elementwise_fma(sav, o.a[0], S01 * o.w[0]));
      S23 = __builtin_elementwise_fma(vvv, o.e[1], __builtin_elementwise_fma(sav, o.a[1], S23 * o.w[1]));
      S45 = __builtin_elementwise_fma(vvv, o.e[2], __builtin_elementwise_fma(sav, o.a[2], S45 * o.w[2]));
      S67 = __builtin_elementwise_fma(vvv, o.e[3], __builtin_elementwise_fma(sav, o.a[3], S67 * o.w[3]));
      return fmaf(o.vv, o.c.y, fmaf(sa, o.c.x, y0));
    };
    Ops oa, ob;
    ld(0, oa);
#pragma unroll 1
    for (int s = 0; s < RS_TB; s += 2) {
      __builtin_amdgcn_sched_barrier(0);
      ld(s + 1, ob);
      __builtin_amdgcn_sched_barrier(0);
      float y0 = step(oa);
      asm volatile("" : "+v"(y0));
      __builtin_amdgcn_sched_barrier(0);
      ld(s + 2, oa);
      __builtin_amdgcn_sched_barrier(0);
      float y1 = step(ob);
      asm volatile("" : "+v"(y1));
      __builtin_amdgcn_sched_barrier(0);
      if (ks == 0) { yb[s * 32] = y0; yb[(s + 1) * 32] = y1; }
    }
  };
  auto yout = [&](int n) {
    const int row = scan_row(dir, b, n * RS_TB + ss);
    const float* ys = ybuf + (n & 1) * RS_TB * 32 + ss * 32 + kq * 2;
    *(unsigned*)(p->P + (size_t)row * LDP + dir * 512 + h * 64 + hf * 32 + kq * 2) = pk_bf16(ys[0], ys[1]);
  };
  constexpr int NB = TSC / RS_TB;
  RwkvStage gA, gB;
  gload(0, gA);
  gload(1, gB);
  swrite(0, gA);
  gload(2, gA);
  __syncthreads();
  for (int n = 0; n < NB; n += 2) {
    compute(n);
    swrite(1, gB);
    if (n + 3 < NB) gload(n + 3, gB);
    __syncthreads();
    yout(n);
    compute(n + 1);
    if (n + 2 < NB) swrite(0, gA);
    if (n + 4 < NB) gload(n + 4, gA);
    __syncthreads();
    yout(n + 1);
  }
  __syncthreads();
}

__device__ void mlstm_s1(KP p, int layer, int tile, char* lds, int tid) {
  const int j = layer >> 1;
  const int ch = tile / NCHUNK, c = tile % NCHUNK;
  const int dir = ch >> 5, b = (ch >> 2) & 7, h = ch & 3;
  float* s_ws = (float*)(lds + META_OFF);
  int* s_row = (int*)(s_ws + 64);
  char* kimg = lds;
  char* vimg = lds + 16384;
  if (tid < 64) {
    const int row = scan_row(dir, b, c * 64 + tid);
    s_row[tid] = row;
    const float* g = p->GP + (size_t)row * 16;
    const float gi = g[(dir * 2) * 4 + h] + p->mlstm_gate_b[j * 16 + (dir * 2) * 4 + h];
    const float gf = g[(dir * 2 + 1) * 4 + h] + p->mlstm_gate_b[j * 16 + (dir * 2 + 1) * 4 + h];
    float bc = -softplus_f(-gf);
#pragma unroll
    for (int o = 1; o < 64; o <<= 1) {
      float tmp = __shfl_up(bc, o);
      if (tid >= o) bc += tmp;
    }
    const float bend = __shfl(bc, 63);
    const float ds = bend - bc + gi;
    const float mloc = wmax(ds);
    s_ws[tid] = expf(ds - mloc);
    if (tid == 0) { p->msc[tile] = mloc; p->msc[NMT + tile] = bend; }
  }
  __syncthreads();
  {
    const int c8 = tid & 15;
    const int ioff = (c8 >> 2) * 4096 + (c8 & 3) * 16;
#pragma unroll
    for (int i = 0; i < 4; ++i) {
      const int sidx = (tid >> 4) + 16 * i;
      const bf16_t* src = p->P + (size_t)s_row[sidx] * LDP + h * 128 + c8 * 8;
      const u32x4 kv = *(const u32x4*)(src + 2560);
      u32x4 vv = *(const u32x4*)(src + 3072);
      const float wsv = s_ws[sidx];
      vv.x = pk_bf16(bflo(vv.x) * wsv, bfhi(vv.x) * wsv); vv.y = pk_bf16(bflo(vv.y) * wsv, bfhi(vv.y) * wsv);
      vv.z = pk_bf16(bflo(vv.z) * wsv, bfhi(vv.z) * wsv); vv.w = pk_bf16(bflo(vv.w) * wsv, bfhi(vv.w) * wsv);
      *(u32x4*)(kimg + ioff + sidx * 64) = kv;
      *(u32x4*)(vimg + ioff + sidx * 64) = vv;
    }
  }
  __syncthreads();
  const int lane = tid & 63, w = tid >> 6, wm = w >> 1, wn = w & 1, r32 = lane & 31, hi = lane >> 5;
  f32x16 acc[2][2];
#pragma unroll
  for (int mi = 0; mi < 2; ++mi)
#pragma unroll
    for (int ni = 0; ni < 2; ++ni)
#pragma unroll
      for (int q = 0; q < 16; ++q) acc[mi][ni][q] = 0.f;
  const int toff = ((lane >> 4) & 1) * 32 + (lane & 3) * 8 + ((lane & 15) >> 2) * 64 + hi * 256;
#pragma unroll
  for (int ks = 0; ks < 4; ++ks) {
    bf16x8 af[2], bfr[2];
#pragma unroll
    for (int i = 0; i < 2; ++i) {
      const char* ka = kimg + (wm * 2 + i) * 4096 + toff + (16 * ks) * 64;
      const char* va = vimg + (wn * 2 + i) * 4096 + toff + (16 * ks) * 64;
      af[i] = __builtin_shufflevector(vtr(ka), vtr(ka + 8 * 64), 0, 1, 2, 3, 4, 5, 6, 7);
      bfr[i] = __builtin_shufflevector(vtr(va), vtr(va + 8 * 64), 0, 1, 2, 3, 4, 5, 6, 7);
    }
    acc[0][0] = MFMA32(af[0], bfr[0], acc[0][0]);
    acc[0][1] = MFMA32(af[0], bfr[1], acc[0][1]);
    acc[1][0] = MFMA32(af[1], bfr[0], acc[1][0]);
    acc[1][1] = MFMA32(af[1], bfr[1], acc[1][1]);
  }
  bf16_t* ust = (bf16_t*)(lds + 32768);
#pragma unroll
  for (int mi = 0; mi < 2; ++mi)
#pragma unroll
    for (int ni = 0; ni < 2; ++ni)
#pragma unroll
      for (int q = 0; q < 16; ++q) {
        const int d = wm * 64 + mi * 32 + (q & 3) + 8 * (q >> 2) + 4 * hi;
        ust[d * 128 + wn * 64 + ni * 32 + r32] = f2bf(acc[mi][ni][q]);
        if ((q & 3) == 3) __builtin_amdgcn_sched_barrier(0);
      }
  __syncthreads();
  {
    const u32x4* us4 = (const u32x4*)ust;
    u32x4* U4 = (u32x4*)(p->MS + (size_t)tile * 16384);
#pragma unroll
    for (int i = 0; i < 8; ++i) U4[tid + 256 * i] = us4[tid + 256 * i];
  }
  if (tid < 128) {
    const char* kc = kimg + (tid >> 5) * 4096 + (tid & 31) * 2;
    float a = 0.f;
#pragma unroll 8
    for (int sidx = 0; sidx < 64; ++sidx) a = fmaf(s_ws[sidx], bf2f(*(const bf16_t*)(kc + sidx * 64)), a);
    p->MSn[tile * 128 + tid] = a;
  }
}

__device__ void mlstm_s3(KP p, int layer, int tile, char* lds, int tid);
__device__ void ph_scan_a(KP p, int layer, char* smc) {
  float* sm = (float*)smc;
  const int tid = opaque_tid();
  __builtin_amdgcn_s_setprio(3);
  for (int u = blockIdx.x; u < 256; u += gridDim.x) rwkv_unit(p, u, sm, tid);
  __builtin_amdgcn_s_setprio(0);
  {
    const int stage = layer == 1 ? 1 : 2;
    const int nconv = conv_stage_total(stage);
    const int total = NMT + (nconv + 7) / 8;
    int* qc = (int*)(p->bar + XCD_BAR_WORDS + 16 * stage);
    int* s_q = (int*)(smc + META_OFF + 3968);
    int jj = 0, j1 = 0;
#pragma unroll 1
    for (;;) {
      if (jj >= j1) {
        __syncthreads();
        if (tid == 0) *s_q = atomicAdd(qc, 1);
        __syncthreads();
        const int q = *s_q;
        if (q >= total) break;
        if (q < NMT) { mlstm_s3(p, layer, q, smc, tid); continue; }
        jj = (q - NMT) * 8; j1 = min(jj + 8, nconv);
      }
      convert_run(p, stage, jj, j1, sm, tid);
      jj = j1;
    }
  }
}

__device__ void ph_mlstm_s2(KP p, char* smc) {
  float* sw = (float*)smc;
  const int tid = opaque_tid();
  const int nitems = 64 * 33;
  for (int item = blockIdx.x; item < nitems; item += gridDim.x) {
    const int ch = item / 33, seg = item % 33;
    __syncthreads();
    if (tid < 2 * NCHUNK) sw[72 + tid] = p->msc[(tid < NCHUNK ? 0 : NMT - NCHUNK) + ch * NCHUNK + tid];
    __syncthreads();
    if (tid == 0) {
      float m = 0.f;
      for (int c = 0; c < NCHUNK; ++c) {
        const int tile = ch * NCHUNK + c;
        const float mloc = sw[72 + c], bend = sw[72 + NCHUNK + c];
        const float mn = fmaxf(bend + m, mloc);
        sw[c] = expf(bend + m - mn);
        sw[36 + c] = expf(mloc - mn);
        if (seg == 0) p->msc[2 * NMT + tile] = m;
        m = mn;
      }
    }
    __syncthreads();
    if (seg < 32) {
      unsigned* base = (unsigned*)(p->MS + (size_t)ch * NCHUNK * 16384) + seg * 256 + tid;
      unsigned v[NCHUNK];
#pragma unroll
      for (int c = 0; c < NCHUNK; ++c) v[c] = base[(size_t)c * 8192];
      float C0 = 0.f, C1 = 0.f;
#pragma unroll
      for (int c = 0; c < NCHUNK; ++c) {
        const float t0 = bflo(v[c]), t1 = bfhi(v[c]);
        v[c] = pk_bf16(C0, C1);
        C0 = sw[c] * C0 + sw[36 + c] * t0;
        C1 = sw[c] * C1 + sw[36 + c] * t1;
      }
#pragma unroll
      for (int c = 0; c < NCHUNK; ++c) base[(size_t)c * 8192] = v[c];
    } else if (tid < 128) {
      float* base = p->MSn + (size_t)ch * NCHUNK * 128 + tid;
      float v[NCHUNK];
#pragma unroll
      for (int c = 0; c < NCHUNK; ++c) v[c] = base[c * 128];
      float C = 0.f;
#pragma unroll
      for (int c = 0; c < NCHUNK; ++c) {
        const float t0 = v[c];
        v[c] = C;
        C = sw[c] * C + sw[36 + c] * t0;
      }
#pragma unroll
      for (int c = 0; c < NCHUNK; ++c) base[c * 128] = v[c];
    }
  }
}

__device__ void mlstm_s3(KP p, int layer, int tile, char* lds, int tid) {
  const int j = layer >> 1;
  const int ch = tile / NCHUNK, c = tile % NCHUNK;
  const int dir = ch >> 5, b = (ch >> 2) & 7, h = ch & 3;
  float* s_b = (float*)(lds + META_OFF);
  float* s_ig = s_b + 64;
  float* s_mt = s_b + 128;
  float* s_wi = s_b + 192;
  int* s_row = (int*)(s_b + 256);
  float* s_n = s_b + 320;
  float* s_c = s_b + 448;
  char* kimg = lds;
  char* vimg = lds + 16384;
  char* cimg = lds + 32768;
  const float mprev = p->msc[2 * NMT + tile];
  const float qscale = 0.08838834764831845f;
  const int lane = tid & 63, w = tid >> 6, wt = w >> 1, wv = w & 1, r32 = lane & 31, hi = lane >> 5;
  const int t = wt * 32 + r32;
  const int rowq = scan_row(dir, b, c * 64 + t);
  const int c8 = tid & 15;
  u32x4 kr[4], vr[4], cr[8];
#pragma unroll
  for (int i = 0; i < 4; ++i) {
    const int sidx = (tid >> 4) + 16 * i;
    const bf16_t* src = p->P + (size_t)scan_row(dir, b, c * 64 + sidx) * LDP + h * 128 + c8 * 8;
    kr[i] = *(const u32x4*)(src + 2560);
    vr[i] = *(const u32x4*)(src + 3072);
  }
  {
    const bf16_t* Cp = p->MS + (size_t)tile * 16384;
#pragma unroll
    for (int i = 0; i < 8; ++i) cr[i] = *(const u32x4*)(Cp + ((tid >> 4) + 16 * i) * 128 + c8 * 8);
  }
  bf16x8 qf[8];
  {
    const bf16_t* qp = p->P + (size_t)rowq * LDP + 2048 + h * 128 + hi * 8;
#pragma unroll
    for (int d0 = 0; d0 < 8; ++d0) qf[d0] = *(const bf16x8*)(qp + d0 * 16);
  }
  if (tid < 64) {
    const int row = scan_row(dir, b, c * 64 + tid);
    s_row[tid] = row;
    const float* g = p->GP + (size_t)row * 16;
    const float gi = g[(dir * 2) * 4 + h] + p->mlstm_gate_b[j * 16 + (dir * 2) * 4 + h];
    const float gf = g[(dir * 2 + 1) * 4 + h] + p->mlstm_gate_b[j * 16 + (dir * 2 + 1) * 4 + h];
    float bc = -softplus_f(-gf);
#pragma unroll
    for (int o = 1; o < 64; o <<= 1) {
      float tmp = __shfl_up(bc, o);
      if (tid >= o) bc += tmp;
    }
    float pm = gi - bc;
#pragma unroll
    for (int o = 1; o < 64; o <<= 1) {
      float tmp = __shfl_up(pm, o);
      if (tid >= o) pm = fmaxf(pm, tmp);
    }
    const float mt = bc + fmaxf(mprev, pm);
    s_b[tid] = bc;
    s_ig[tid] = gi;
    s_mt[tid] = mt;
    s_wi[tid] = expf(bc + mprev - mt);
    s_c[tid] = (gi - bc) * 1.4426950408889634f;
  } else if (tid < 192) s_n[tid - 64] = p->MSn[tile * 128 + (tid - 64)];
  {
    const int ioff = (c8 >> 2) * 4096 + (c8 & 3) * 16;
#pragma unroll
    for (int i = 0; i < 4; ++i) {
      const int sidx = (tid >> 4) + 16 * i;
      *(u32x4*)(kimg + sidx * 256 + ((c8 ^ (sidx & 15)) * 16)) = kr[i];
      *(u32x4*)(vimg + ioff + sidx * 64) = vr[i];
    }
    const int coff = (c8 >> 2) * 8192 + (c8 & 3) * 16;
#pragma unroll
    for (int i = 0; i < 8; ++i) *(u32x4*)(cimg + coff + ((tid >> 4) + 16 * i) * 64) = cr[i];
  }
  __syncthreads();
  const int toff = ((lane >> 4) & 1) * 32 + (lane & 3) * 8 + ((lane & 15) >> 2) * 64;
  constexpr float LOG2E_ = 1.4426950408889634f;
  float qn = 0.f;
#pragma unroll
  for (int d0 = 0; d0 < 8; ++d0) {
    const u32x4 qq = __builtin_bit_cast(u32x4, qf[d0]);
    const float* np = s_n + d0 * 16 + hi * 8;
    qn = fmaf(bflo(qq.x), np[0], qn); qn = fmaf(bfhi(qq.x), np[1], qn);
    qn = fmaf(bflo(qq.y), np[2], qn); qn = fmaf(bfhi(qq.y), np[3], qn);
    qn = fmaf(bflo(qq.z), np[4], qn); qn = fmaf(bfhi(qq.z), np[5], qn);
    qn = fmaf(bflo(qq.w), np[6], qn); qn = fmaf(bfhi(qq.w), np[7], qn);
  }
  qn += __shfl_xor(qn, 32);
  const float mtt = s_mt[t], wi = s_wi[t];
  const float ct = (s_b[t] - mtt) * LOG2E_;
  const float wq = wi * qscale;
  bf16x8 pf[4];
  float den = 0.f;
  {
    f32x16 sa0, sa1;
#pragma unroll
    for (int q = 0; q < 16; ++q) { sa0[q] = 0.f; sa1[q] = 0.f; }
#pragma unroll
    for (int d0 = 0; d0 < 8; ++d0) {
      const int chn = 2 * d0 + hi;
      const bf16x8 k0 = *(const bf16x8*)(kimg + r32 * 256 + ((chn ^ (r32 & 15)) * 16));
      sa0 = MFMA32(k0, qf[d0], sa0);
      if (wt) {
        const bf16x8 k1 = *(const bf16x8*)(kimg + (32 + r32) * 256 + ((chn ^ (r32 & 15)) * 16));
        sa1 = MFMA32(k1, qf[d0], sa1);
      }
      __builtin_amdgcn_sched_barrier(0);
    }
#pragma unroll
    for (int g = 0; g < 4; ++g) {
      const int sb0 = 8 * g + 4 * hi;
      const float4 c0v = *(const float4*)(s_c + sb0);
      const float4 c1v = *(const float4*)(s_c + sb0 + 32);
      const float cc0[4] = {c0v.x, c0v.y, c0v.z, c0v.w}, cc1[4] = {c1v.x, c1v.y, c1v.z, c1v.w};
#pragma unroll
      for (int e = 0; e < 4; ++e) {
        const int q = 4 * g + e;
        const float v0 = (sb0 + e <= t) ? sa0[q] * qscale * __builtin_amdgcn_exp2f(ct + cc0[e]) : 0.f;
        sa0[q] = v0; den += v0;
        const float v1 = (wt && sb0 + 32 + e <= t) ? sa1[q] * qscale * __builtin_amdgcn_exp2f(ct + cc1[e]) : 0.f;
        sa1[q] = v1; den += v1;
      }
      __builtin_amdgcn_sched_barrier(0);
    }
#pragma unroll
    for (int sx = 0; sx < 4; ++sx) {
      const int u = (sx & 1) * 8;
      u32x4 tpk;
      if (sx < 2) {
        tpk.x = pk_bf16(sa0[u + 0], sa0[u + 1]); tpk.y = pk_bf16(sa0[u + 2], sa0[u + 3]);
        tpk.z = pk_bf16(sa0[u + 4], sa0[u + 5]); tpk.w = pk_bf16(sa0[u + 6], sa0[u + 7]);
      } else {
        tpk.x = pk_bf16(sa1[u + 0], sa1[u + 1]); tpk.y = pk_bf16(sa1[u + 2], sa1[u + 3]);
        tpk.z = pk_bf16(sa1[u + 4], sa1[u + 5]); tpk.w = pk_bf16(sa1[u + 6], sa1[u + 7]);
      }
      pf[sx] = __builtin_bit_cast(bf16x8, tpk);
    }
  }
  den += __shfl_xor(den, 32);
  const float dtot = den + wq * qn;
  const float inv = 1.f / fmaxf(fabsf(dtot), expf(-mtt));
  bf16_t* op = p->P + (size_t)rowq * LDP + 1024 + dir * 512 + h * 128 + wv * 64 + 4 * hi;
#pragma unroll 1
  for (int vp = 0; vp < 2; ++vp) {
    f32x16 o0;
#pragma unroll
    for (int q = 0; q < 16; ++q) o0[q] = 0.f;
    const char* cb = cimg + (wv * 2 + vp) * 8192 + toff + hi * 512;
#pragma unroll
    for (int d0 = 0; d0 < 8; ++d0) {
      const bf16x8 A0 = __builtin_shufflevector(vtr(cb + (16 * d0) * 64), vtr(cb + (16 * d0 + 4) * 64), 0, 1, 2, 3, 4, 5, 6, 7);
      o0 = MFMA32(A0, qf[d0], o0);
    }
#pragma unroll
    for (int q = 0; q < 16; ++q) o0[q] *= wq;
    const char* vb = vimg + (wv * 2 + vp) * 4096 + toff + hi * 256;
#pragma unroll
    for (int sx = 0; sx < 4; ++sx) {
      if (sx < 2 || wt) {
        const bf16x8 A0 = __builtin_shufflevector(vtr(vb + (16 * sx) * 64), vtr(vb + (16 * sx + 8) * 64), 0, 1, 2, 3, 4, 5, 6, 7);
        o0 = MFMA32(A0, pf[sx], o0);
      }
    }
#pragma unroll
    for (int g = 0; g < 4; ++g) {
      u32x2 v0;
      v0.x = pk_bf16(o0[4 * g] * inv, o0[4 * g + 1] * inv); v0.y = pk_bf16(o0[4 * g + 2] * inv, o0[4 * g + 3] * inv);
      *(u32x2*)(op + vp * 32 + 8 * g) = v0;
    }
  }
}

__device__ void ph_mlstm_s1(KP p, int layer, char* smc) {
  const int tid = opaque_tid();
  __syncthreads();
  for (int tile = blockIdx.x; tile < NMT; tile += gridDim.x) { mlstm_s1(p, layer, tile, smc, tid); __syncthreads(); }
}

__device__ void ph_rec_final(KP p, int layer, bool keep) {
  const int tid = opaque_tid();
  const int j = layer >> 1;
  const int lane = tid & 63, wave = tid >> 6;
  const int rows = keep ? NT : NL;
  const int c0 = lane * 8;
  auto unpack = [](const u32x4 u, float (&f)[8]) {
    f[0] = bflo(u.x); f[1] = bfhi(u.x); f[2] = bflo(u.y); f[3] = bfhi(u.y);
    f[4] = bflo(u.z); f[5] = bfhi(u.z); f[6] = bflo(u.w); f[7] = bfhi(u.w);
  };
  for (int t = blockIdx.x * 4 + wave; t < rows; t += gridDim.x * 4) {
    const bf16_t* rw = p->RW + (size_t)t * RWS + c0;
    const bf16_t* pt = p->P + (size_t)t * LDP + c0;
    bf16_t* mo = p->AB + (size_t)t * DM + c0;
    {
      float yf[8], yb[8], r[8], v[8], k0[8], k1[8], g[8], y[8], o[8];
      unpack(*(const u32x4*)(pt), yf); unpack(*(const u32x4*)(pt + 512), yb);
      unpack(*(const u32x4*)(rw), r); unpack(*(const u32x4*)(rw + 512), v);
      unpack(*(const u32x4*)(rw + 5 * 512), k0); unpack(*(const u32x4*)(rw + 6 * 512), k1);
      unpack(*(const u32x4*)(rw + 9 * 512), g);
      float s1 = 0.f, bs = 0.f;
      const float* rk = p->rwkv_rk + j * 512 + c0;
#pragma unroll
      for (int e = 0; e < 8; ++e) { y[e] = yf[e] + yb[e]; s1 += y[e]; bs += r[e] * rk[e] * (k0[e] + k1[e]); }
      s1 += dppx<0xB1>(s1); s1 += dppx<0x4E>(s1); s1 += dppx<0x141>(s1);
      bs += dppx<0xB1>(bs); bs += dppx<0x4E>(bs); bs += dppx<0x141>(bs);
      const float mu = s1 * (1.f / 64.f);
      float s2 = 0.f;
#pragma unroll
      for (int e = 0; e < 8; ++e) { const float d = y[e] - mu; s2 += d * d; }
      s2 += dppx<0xB1>(s2); s2 += dppx<0x4E>(s2); s2 += dppx<0x141>(s2);
      const float rs = rsqrtf(s2 * (1.f / 64.f) + 64e-5f);
      const float* gn0 = p->rwkv_gn + (j * 2 + 0) * 512 + c0;
      const float* gn1 = p->rwkv_gn + (j * 2 + 1) * 512 + c0;
#pragma unroll
      for (int e = 0; e < 8; ++e) o[e] = ((y[e] - mu) * rs * gn0[e] + gn1[e] + bs * v[e]) * g[e];
      u32x4 ov;
      ov.x = pk_bf16(o[0], o[1]); ov.y = pk_bf16(o[2], o[3]); ov.z = pk_bf16(o[4], o[5]); ov.w = pk_bf16(o[6], o[7]);
      *(u32x4*)(mo) = ov;
    }
    {
      float hf[8], hb[8], og[8], hsum[8], o[8];
      unpack(*(const u32x4*)(pt + 1024), hf); unpack(*(const u32x4*)(pt + 1536), hb);
      unpack(*(const u32x4*)(pt + 3584), og);
      float ss = 0.f;
#pragma unroll
      for (int e = 0; e < 8; ++e) { hsum[e] = hf[e] + hb[e]; ss += hsum[e] * hsum[e]; }
      ss += dppx<0xB1>(ss); ss += dppx<0x4E>(ss); ss += dppx<0x141>(ss); ss += dppx<0x140>(ss);
      const float rs = rsqrtf(ss * (1.f / 128.f) + 1e-6f);
      const float* ng = p->mlstm_norm + j * 512 + c0;
#pragma unroll
      for (int e = 0; e < 8; ++e) o[e] = hsum[e] * rs * ng[e] * sigm_f(og[e]);
      u32x4 ov;
      ov.x = pk_bf16(o[0], o[1]); ov.y = pk_bf16(o[2], o[3]); ov.z = pk_bf16(o[4], o[5]); ov.w = pk_bf16(o[6], o[7]);
      *(u32x4*)(mo + 512) = ov;
    }
  }
}

using f32x4v = __attribute__((ext_vector_type(4))) float;
__device__ void ph_ln_router(KP p, int layer, bool keep, char* smc) {
  float* h2s = (float*)smc;
  float* lgs = (float*)smc;
  const int tid = opaque_tid();
  const int lane = tid & 63, wave = tid >> 6;
  const int rows = keep ? NT : NL;
  const float* lng = p->ln_g + (layer * 2 + 0) * 1024;
  const float* lnb = p->ln_b + (layer * 2 + 0) * 1024;
  for (int tile = blockIdx.x; tile < rows / 16; tile += gridDim.x) {
    const int t0 = tile * 16;
    const float* mod = p->MOD + (layer * 9 + modrow(t0)) * 6144;
    const float* brow = p->WrT + ((size_t)layer * 64 + 16 * wave + (lane & 15)) * 1024 + 4 * (lane >> 4);
    f32x4v b0[8], b1[8], b2[8];
#pragma unroll
    for (int q = 0; q < 8; ++q) { b0[q] = *(const f32x4v*)(brow + 16 * q); b1[q] = *(const f32x4v*)(brow + 16 * (8 + q)); }
    __builtin_amdgcn_sched_barrier(0);
    {
      float4 v[4][4];
      float s4[4];
#pragma unroll
      for (int q = 0; q < 4; ++q) {
        const int t = t0 + wave * 4 + q;
        s4[q] = 0.f;
#pragma unroll
        for (int i = 0; i < 4; ++i) v[q][i] = *(const float4*)(p->Tb + (size_t)t * DM + i * 256 + lane * 4);
      }
#pragma unroll
      for (int q = 0; q < 4; ++q)
#pragma unroll
        for (int i = 0; i < 4; ++i) s4[q] += (v[q][i].x + v[q][i].y) + (v[q][i].z + v[q][i].w);
      float mean4[4], rs4[4];
#pragma unroll
      for (int q = 0; q < 4; ++q) mean4[q] = wsum(s4[q]) * (1.f / 1024.f);
#pragma unroll
      for (int q = 0; q < 4; ++q) {
        float qq = 0.f;
#pragma unroll
        for (int i = 0; i < 4; ++i) {
          const float d0 = v[q][i].x - mean4[q], d1 = v[q][i].y - mean4[q], d2 = v[q][i].z - mean4[q], d3 = v[q][i].w - mean4[q];
          qq += (d0 * d0 + d1 * d1) + (d2 * d2 + d3 * d3);
        }
        s4[q] = qq;
      }
#pragma unroll
      for (int q = 0; q < 4; ++q) rs4[q] = rsqrtf(wsum(s4[q]) * (1.f / 1024.f) + 1e-5f);
#pragma unroll
      for (int i = 0; i < 4; ++i) {
        const int n = i * 256 + lane * 4;
        const float4 g = *(const float4*)(lng + n), bb = *(const float4*)(lnb + n);
        const float4 sc = *(const float4*)(mod + 4096 + n), sh = *(const float4*)(mod + 3072 + n);
#pragma unroll
        for (int q = 0; q < 4; ++q) {
          const int tl = wave * 4 + q, t = t0 + tl;
          const float mean = mean4[q], rs = rs4[q];
          const float4 xn = make_float4((v[q][i].x - mean) * rs * g.x + bb.x, (v[q][i].y - mean) * rs * g.y + bb.y,
                                        (v[q][i].z - mean) * rs * g.z + bb.z, (v[q][i].w - mean) * rs * g.w + bb.w);
          *(float4*)(p->X + (size_t)t * DM + n) = xn;
          const float4 hh = make_float4(xn.x * (1.f + sc.x) + sh.x, xn.y * (1.f + sc.y) + sh.y,
                                        xn.z * (1.f + sc.z) + sh.z, xn.w * (1.f + sc.w) + sh.w);
          *(unsigned*)((unsigned char*)p->AB + (size_t)t * DM + n) = pk_fp8x4(hh.x, hh.y, hh.z, hh.w);
          *(float4*)(h2s + tl * 1028 + n) = hh;
        }
      }
    }
    __syncthreads();
    f32x4v acc = {0.f, 0.f, 0.f, 0.f};
    {
      f32x4v a1 = {0.f, 0.f, 0.f, 0.f}, a2 = {0.f, 0.f, 0.f, 0.f}, a3 = {0.f, 0.f, 0.f, 0.f};
      const int i = lane & 15, kk = lane >> 4;
      const float* arow = h2s + i * 1028 + 4 * kk;
#define ROUTER_LOAD(B, Q0) _Pragma("unroll") for (int q = 0; q < 8; ++q) B[q] = *(const f32x4v*)(brow + 16 * ((Q0) + q)); __builtin_amdgcn_sched_barrier(0);
#define ROUTER_MFMA(B, Q0) _Pragma("unroll") for (int q = 0; q < 8; ++q) { \
        const float4 a = *(const float4*)(arow + 16 * ((Q0) + q)); \
        acc = __builtin_amdgcn_mfma_f32_16x16x4f32(a.x, B[q].x, acc, 0, 0, 0); \
        a1 = __builtin_amdgcn_mfma_f32_16x16x4f32(a.y, B[q].y, a1, 0, 0, 0); \
        a2 = __builtin_amdgcn_mfma_f32_16x16x4f32(a.z, B[q].z, a2, 0, 0, 0); \
        a3 = __builtin_amdgcn_mfma_f32_16x16x4f32(a.w, B[q].w, a3, 0, 0, 0); } __builtin_amdgcn_sched_barrier(0);
      ROUTER_LOAD(b2, 16) ROUTER_MFMA(b0, 0)
      ROUTER_LOAD(b0, 24) ROUTER_MFMA(b1, 8)
      ROUTER_LOAD(b1, 32) ROUTER_MFMA(b2, 16)
      ROUTER_LOAD(b2, 40) ROUTER_MFMA(b0, 24)
      ROUTER_LOAD(b0, 48) ROUTER_MFMA(b1, 32)
      ROUTER_LOAD(b1, 56) ROUTER_MFMA(b2, 40)
      ROUTER_MFMA(b0, 48)
      ROUTER_MFMA(b1, 56)
      acc = (acc + a1) + (a2 + a3);
    }
    __syncthreads();
#pragma unroll
    for (int r = 0; r < 4; ++r) lgs[((lane >> 4) * 4 + r) * 64 + 16 * wave + (lane & 15)] = acc[r];
    __syncthreads();
    {
      float score4[4], gate4[4];
      int kidx4[4], pos4[4];
      bool chosen4[4];
#pragma unroll
      for (int q = 0; q < 4; ++q) {
        const int tl = wave * 4 + q;
        const float logit = lgs[tl * 64 + lane];
        const float score = sigm_f(logit);
        float sel = score + p->moe_bias[layer * 64 + lane];
        bool chosen = false;
        for (int r = 0; r < 6; ++r) {
          const float mx = wmax(sel);
          const unsigned long long bal = __ballot(sel == mx);
          const int first = __ffsll((long long)bal) - 1;
          if (lane == first) { chosen = true; sel = -INFINITY; }
        }
        const float gsum = wsum(chosen ? score : 0.f);
        const unsigned long long cb = __ballot(chosen);
        score4[q] = score; gate4[q] = score / gsum * 2.5f; chosen4[q] = chosen;
        kidx4[q] = __popcll(cb & ((1ull << lane) - 1ull));
      }
#pragma unroll
      for (int q = 0; q < 4; ++q) pos4[q] = chosen4[q] ? atomicAdd(&p->cnt[lane * CSTR], 1) : 0;
#pragma unroll
      for (int q = 0; q < 4; ++q) {
        const int t = t0 + wave * 4 + q;
        if (chosen4[q]) {
          p->ltok[(size_t)lane * NT + pos4[q]] = t;
          p->lgate[(size_t)lane * NT + pos4[q]] = gate4[q];
          p->tsl[t * 6 + kidx4[q]] = (lane << 16) | pos4[q];
        }
      }
    }
    __syncthreads();
  }
}

__device__ __forceinline__ void moe_prefix(KP p, int rows, int* s_pref, int tid) {
  if (tid < 64) s_pref[322 + tid] = p->cnt[tid * CSTR];
  __syncthreads();
  if (tid == 0) {
    int a = 0;
    for (int e = 0; e < 64; ++e) { s_pref[e] = a; a += (s_pref[322 + e] + 127) >> 7; }
    s_pref[64] = a; a += rows >> 7;
    s_pref[65] = a;
  }
  __syncthreads();
}

__device__ void ph_gemm(KP p, int kind, int layer, bool keep, char* lds) {
  const int tid = opaque_tid();
  const int j = layer >> 1;
  const bool att = !(layer & 1);
  const int rows = keep ? NT : NL;
  int* pref = (int*)(lds + META_OFF);
  int* s_idx = pref + 66;
  float* s_gate = (float*)(s_idx + 128);
  if (kind == 1 && blockIdx.x == 0 && tid < 65) p->cnt[tid * CSTR] = 0;
  int total;
  const int ntn_in = att ? 18 : 33;
  switch (kind) {
    case 0: total = (NT / 128) * ntn_in; break;
    case 1: total = (rows / 128) * 8; break;
    case 2: total = pref[65] * 4; break;
    case 3: total = pref[65] * 8; break;
    case 4: total = (NT / 128) * 3; break;
    default: total = (NT / 128) * 20; break;
  }
  const bool moe = kind == 2 || kind == 3;
  const int tsh = kind == 2 ? 2 : 3;
  int e_nx = 0, idx_nx = tid; float g_nx = 1.f;
  auto fetch_moe = [&](int tl) {
    const int mt = tl >> tsh;
    while (mt >= pref[e_nx + 1]) ++e_nx;
    idx_nx = tid; g_nx = 1.f;
    if (tid < 128) {
      const int pos = (mt - pref[e_nx]) * 128 + tid;
      if (kind == 2) {
        idx_nx = 0;
        if (e_nx < 64) { if (pos < pref[322 + e_nx]) idx_nx = p->ltok[(size_t)e_nx * NT + pos]; }
        else idx_nx = pos;
      } else if (e_nx < 64) g_nx = pos < pref[322 + e_nx] ? p->lgate[(size_t)e_nx * NT + pos] : 0.f;
    }
  };
  if (moe && (int)blockIdx.x < total) fetch_moe(blockIdx.x);
  for (int tile = blockIdx.x; tile < total; tile += gridDim.x) {
    const bf16_t* Abase; const bf16_t* Bt;
    int astride, K, n0, m0 = 0, aux = 0, e = e_nx, mtile = 0;
    switch (kind) {
      case 0: { const int tm = tile / ntn_in, tn = tile % ntn_in; m0 = tm * 128; n0 = tn * 128;
                Abase = p->AB + (size_t)m0 * DM; astride = DM; K = 1024;
                Bt = att ? p->Wt_att + (size_t)j * ATT_N * 1024 : p->Wt_rec + (size_t)j * REC_NP * 1024; } break;
      case 1: { const int tm = tile >> 3, tn = tile & 7; m0 = tm * 128; n0 = tn * 128;
                Abase = p->AB + (size_t)m0 * DM; astride = DM; K = 1024; Bt = p->Wt_out + (size_t)layer * 1024 * 1024; } break;
      case 2: { mtile = tile >> 2; aux = tile & 3; n0 = aux * 128;
                Abase = p->AB; astride = DM; K = 1024;
                Bt = (const bf16_t*)((const unsigned char*)p->Wt13 + (size_t)(layer * 65 + e) * 512 * 1024); } break;
      case 3: { mtile = tile >> 3; aux = tile & 7; n0 = aux * 128;
                Abase = (const bf16_t*)((const unsigned char*)p->ACT + (size_t)mtile * 128 * 256); astride = 256; K = 256;
                Bt = (const bf16_t*)((const unsigned char*)p->Wt2 + (size_t)(layer * 65 + e) * 1024 * 256); } break;
      case 4: { const int tm = tile / 3; aux = tile % 3; m0 = tm * 128; n0 = 0;
                Abase = p->Zb + (size_t)m0 * 1536 + aux * 512; astride = 1536; K = 512; Bt = p->Wl1 + (size_t)(j * 3 + aux) * 128 * 512; } break;
      default: { const int tm = tile / 20; aux = tile % 20; m0 = tm * 128; n0 = aux * 128;
                const int grp = aux < 8 ? 0 : (aux < 16 ? 1 : 2);
                Abase = p->L1 + (size_t)m0 * 384 + grp * 128; astride = 384; K = 128; Bt = p->Wl2 + (size_t)j * 2560 * 128; } break;
    }
    if (tid < 128) { s_idx[tid] = idx_nx; s_gate[tid] = g_nx; }
    __syncthreads();
    if (moe && tile + (int)gridDim.x < total) fetch_moe(tile + gridDim.x);
    {
      f32x16 acc[2][2];
      if (kind == 2 || kind == 3) {
        const unsigned char* A8 = (const unsigned char*)Abase;
        gemm128_fp8(tid, [&](int r) { return A8 + (size_t)s_idx[r] * astride; }, (const unsigned char*)Bt, K, n0, lds, acc);
      } else
        gemm128_main(tid, [&](int r) { return Abase + (size_t)s_idx[r] * astride; }, Bt, K, n0, lds, acc);
      float* Ct = (float*)lds;
      acc_foreach(tid, acc, [&](int row, int col, float v) { Ct[row * 128 + col] = v; });
    }
    __syncthreads();
    {
      const float* Ct = (const float*)lds;
      int c4 = (tid & 31) * 4, r0 = tid >> 5;
      asm volatile("" : "+v"(c4), "+v"(r0));
      const int N_in = att ? ATT_N : REC_N;
      const int d5 = (aux >> 2) & 1, c05 = (aux & 3) * 128;
      switch (kind) {
        case 0: {
#pragma unroll 8
          for (int it = 0; it < 16; ++it) {
            const int row = it * 8 + r0;
            const float4 v = *(const float4*)(Ct + row * 128 + c4);

            const int cn = n0 + c4;
            float4 vq = v;
            if (att && n0 >= 1536 && n0 < 2176) {
              float ss = v.x * v.x + v.y * v.y + v.z * v.z + v.w * v.w;
              ss += dppx<0xB1>(ss); ss += dppx<0x4E>(ss); ss += dppx<0x141>(ss); ss += dppx<0x140>(ss);
              const float rs = rsqrtf(ss * (1.f / 64.f) + 1e-6f);
              const float4 g = *(const float4*)(p->qk_gain + j * 128 + (n0 >= 2048 ? 64 : 0) + (cn & 63));
              vq = make_float4(v.x * rs * g.x, v.y * rs * g.y, v.z * rs * g.z, v.w * rs * g.w);
              const int t = m0 + row;
              if (t < NL) {
                const int sidx = t & 2047, pi0 = (cn & 63) >> 1;
                const int pos = pi0 < 16 ? (sidx >> 6) : (sidx & 63);
                const float4 cs = *(const float4*)(p->ROPE + (pos * 16 + (pi0 & 15)) * 2);
                vq = make_float4(vq.x * cs.x - vq.y * cs.y, vq.x * cs.y + vq.y * cs.x,
                                 vq.z * cs.z - vq.w * cs.w, vq.z * cs.w + vq.w * cs.z);
              }
            }
            if (cn < N_in) {
              u32x2 o; o.x = pk_bf16(vq.x, vq.y); o.y = pk_bf16(vq.z, vq.w);
              *(u32x2*)(p->P + (size_t)(m0 + row) * LDP + cn) = o;
            }
            if (!att && cn >= 4096 && cn < 4112) *(float4*)(p->GP + (size_t)(m0 + row) * 16 + (cn - 4096)) = v;
          }
        } break;
        case 1: {
#pragma unroll 16
          for (int it = 0; it < 16; ++it) {
            const int row = it * 8 + r0;
            const float4 v = *(const float4*)(Ct + row * 128 + c4);

            const size_t o = (size_t)(m0 + row) * DM + n0 + c4;
            const float4 xv = *(const float4*)(p->X + o);
            const float4 g = *(const float4*)(p->MOD + (layer * 9 + modrow(m0)) * 6144 + 2048 + n0 + c4);
            *(float4*)(p->Tb + o) = make_float4(DN_ALPHA * xv.x + g.x * v.x, DN_ALPHA * xv.y + g.y * v.y,
                                                DN_ALPHA * xv.z + g.z * v.z, DN_ALPHA * xv.w + g.w * v.w);
          }
        } break;
        case 2: {
#pragma unroll 8
          for (int it = 0; it < 16; ++it) {
            const int row = it * 8 + r0;
            const float4 v = *(const float4*)(Ct + row * 128 + c4);

            if (((c4 >> 5) & 1) == 0) {
              const float4 u = *(const float4*)(Ct + row * 128 + c4 + 32);
              const float a0 = v.x * W8_INV, a1 = v.y * W8_INV, a2 = v.z * W8_INV, a3 = v.w * W8_INV;
              *(unsigned*)((unsigned char*)p->ACT + ((size_t)mtile * 128 + row) * 256 + aux * 64 + (c4 >> 6) * 32 + (c4 & 31)) =
                  pk_fp8x4(silu_f(a0) * (u.x * W8_INV), silu_f(a1) * (u.y * W8_INV), silu_f(a2) * (u.z * W8_INV), silu_f(a3) * (u.w * W8_INV));
            }
          }
        } break;
        case 3: {
#pragma unroll 16
          for (int it = 0; it < 16; ++it) {
            const int row = it * 8 + r0;
            const float4 v = *(const float4*)(Ct + row * 128 + c4);

            const float g = s_gate[row] * W8_INV;
            u32x2 o; o.x = pk_bf16(g * v.x, g * v.y); o.y = pk_bf16(g * v.z, g * v.w);
            *(u32x2*)(p->OUT2 + ((size_t)mtile * 128 + row) * 1024 + n0 + c4) = o;
          }
        } break;
        case 4: {
#pragma unroll 4
          for (int it = 0; it < 16; ++it) {
            const int row = it * 8 + r0;
            const float4 v = *(const float4*)(Ct + row * 128 + c4);

            float4 o4 = v;
            if (aux == 0) o4 = make_float4(tanhf(v.x), tanhf(v.y), tanhf(v.z), tanhf(v.w));
            else if (aux == 2) o4 = make_float4(sigm_f(v.x), sigm_f(v.y), sigm_f(v.z), sigm_f(v.w));
            u32x2 o; o.x = pk_bf16(o4.x, o4.y); o.y = pk_bf16(o4.z, o4.w);
            *(u32x2*)(p->L1 + (size_t)(m0 + row) * 384 + aux * 128 + c4) = o;
          }
        } break;
        default: {
#pragma unroll 4
          for (int it = 0; it < 16; ++it) {
            const int row = it * 8 + r0;
            const float4 v = *(const float4*)(Ct + row * 128 + c4);

            bf16_t* rr = p->RW + (size_t)(m0 + row) * RWS + c05 + c4;
            const float vv[4] = {v.x, v.y, v.z, v.w};
            if (aux < 8) {
              const float4 b0 = *(const float4*)(p->rwkv_w0 + (j * 2 + d5) * 512 + c05 + c4);
              const float bb[4] = {b0.x, b0.y, b0.z, b0.w};
              float e4[4];
#pragma unroll
              for (int q = 0; q < 4; ++q) e4[q] = expf(-softplus_f(-(bb[q] + vv[q])) - 0.5f);
              u32x2 o; o.x = pk_bf16(e4[0], e4[1]); o.y = pk_bf16(e4[2], e4[3]);
              *(u32x2*)(rr + (3 + d5) * 512) = o;
            } else if (aux < 16) {
              const float4 b0 = *(const float4*)(p->rwkv_a0 + (j * 2 + d5) * 512 + c05 + c4);
              const float4 k1 = *(const float4*)(p->rwkv_kvec + (j * 2 + 1) * 512 + c05 + c4);
              const u32x2 kx2 = *(const u32x2*)(rr + 10 * 512);
              const float bb[4] = {b0.x, b0.y, b0.z, b0.w}, kk1[4] = {k1.x, k1.y, k1.z, k1.w};
              const float kx[4] = {bflo(kx2.x), bfhi(kx2.x), bflo(kx2.y), bfhi(kx2.y)};
              float av[4], ke[4];
#pragma unroll
              for (int q = 0; q < 4; ++q) { av[q] = sigm_f(bb[q] + vv[q]); ke[q] = kx[q] * (1.f + (av[q] - 1.f) * kk1[q]); }
              u32x2 o; o.x = pk_bf16(av[0], av[1]); o.y = pk_bf16(av[2], av[3]);
              *(u32x2*)(rr + (7 + d5) * 512) = o;
              o.x = pk_bf16(ke[0], ke[1]); o.y = pk_bf16(ke[2], ke[3]);
              *(u32x2*)(rr + (5 + d5) * 512) = o;
            } else {
              u32x2 o; o.x = pk_bf16(v.x, v.y); o.y = pk_bf16(v.z, v.w);
              *(u32x2*)(rr + 9 * 512) = o;
            }
          }
        } break;
      }
    }
    __syncthreads();
  }
}

__device__ void ph_final_ln(KP p, int layer, bool keep, char* lds) {
  const int tid = opaque_tid();
  const int lane = tid & 63, wave = tid >> 6;
  const int rows = keep ? NT : NL;
  int* s_base = (int*)(lds + META_OFF);
  if (tid == 0) {
    int a = 0;
#pragma unroll 1
    for (int e = 0; e < 64; ++e) { s_base[e] = a * 128; a += (p->cnt[e * CSTR] + 127) >> 7; }
    s_base[64] = a * 128;
  }
  __syncthreads();
  const float* lng = p->ln_g + (layer * 2 + 1) * 1024;
  const float* lnb = p->ln_b + (layer * 2 + 1) * 1024;
  for (int t = blockIdx.x * 4 + wave; t < rows; t += gridDim.x * 4) {
    const int mr = modrow(t);
    const float* g2 = p->MOD + (layer * 9 + mr) * 6144 + 5120;
    const bf16_t* src[7];
#pragma unroll
    for (int k = 0; k < 6; ++k) {
      const int v = p->tsl[t * 6 + k];
      src[k] = p->OUT2 + (size_t)(s_base[v >> 16] + (v & 0xffff)) * 1024;
    }
    src[6] = p->OUT2 + (size_t)(s_base[64] + t) * 1024;
    float v[16];
    float s = 0.f;
#pragma unroll
    for (int c = 0; c < 2; ++c) {
      const int n0 = c * 512 + lane * 8;
      float y[8];
#pragma unroll
      for (int q = 0; q < 8; ++q) y[q] = 0.f;
#pragma unroll
      for (int k = 0; k < 7; ++k) {
        const u32x4 u = *(const u32x4*)(src[k] + n0);
        y[0] += bflo(u.x); y[1] += bfhi(u.x); y[2] += bflo(u.y); y[3] += bfhi(u.y);
        y[4] += bflo(u.z); y[5] += bfhi(u.z); y[6] += bflo(u.w); y[7] += bfhi(u.w);
      }
      const float4 xa = *(const float4*)(p->X + (size_t)t * DM + n0), xb = *(const float4*)(p->X + (size_t)t * DM + n0 + 4);
      const float4 ga = *(const float4*)(g2 + n0), gb = *(const float4*)(g2 + n0 + 4);
      const float xx[8] = {xa.x, xa.y, xa.z, xa.w, xb.x, xb.y, xb.z, xb.w};
      const float gg[8] = {ga.x, ga.y, ga.z, ga.w, gb.x, gb.y, gb.z, gb.w};
#pragma unroll
      for (int q = 0; q < 8; ++q) { v[c * 8 + q] = DN_ALPHA * xx[q] + gg[q] * y[q]; s += v[c * 8 + q]; }
    }
    const float mean = wsum(s) * (1.f / 1024.f);
    float q2 = 0.f;
#pragma unroll
    for (int i = 0; i < 16; ++i) { const float d = v[i] - mean; q2 += d * d; }
    const float rs = rsqrtf(wsum(q2) * (1.f / 1024.f) + 1e-5f);
    const float* modn = p->MOD + ((layer + 1) * 9 + mr) * 6144;
#pragma unroll
    for (int c = 0; c < 2; ++c) {
      const int n0 = c * 512 + lane * 8;
      float xn[8];
#pragma unroll
      for (int q = 0; q < 8; ++q) xn[q] = (v[c * 8 + q] - mean) * rs * lng[n0 + q] + lnb[n0 + q];
      float* xo = (layer == 3 ? p->out : p->X) + (size_t)t * DM + n0;
      *(float4*)(xo) = make_float4(xn[0], xn[1], xn[2], xn[3]);
      *(float4*)(xo + 4) = make_float4(xn[4], xn[5], xn[6], xn[7]);
      if (layer != 3) {
        float hb[8];
#pragma unroll
        for (int q = 0; q < 8; ++q) hb[q] = xn[q] * (1.f + modn[1024 + n0 + q]) + modn[n0 + q];
        u32x4 o;
        o.x = pk_bf16(hb[0], hb[1]); o.y = pk_bf16(hb[2], hb[3]); o.z = pk_bf16(hb[4], hb[5]); o.w = pk_bf16(hb[6], hb[7]);
        *(u32x4*)(p->AB + (size_t)t * DM + n0) = o;
      }
    }
  }
}

#define XB_TMO      128
#define XB_XCNT(j)  (256  + 64 * (j))
#define XB_XSUB(j)  (1280 + 64 * (j))
#define XB_XGEN(j)  (2304 + 64 * (j))
#define XB_TOP      3328
#define XB_TOPGEN   3392
#define XB_SPIN_CAP (1u << 20)
#define LAS __attribute__((address_space(3)))
__device__ __forceinline__ unsigned xb_ld(unsigned* p) { return __hip_atomic_load(p, __ATOMIC_RELAXED, __HIP_MEMORY_SCOPE_AGENT); }
__device__ __forceinline__ unsigned xb_add(unsigned* p, unsigned v) { return __hip_atomic_fetch_add(p, v, __ATOMIC_RELAXED, __HIP_MEMORY_SCOPE_AGENT); }
__device__ __forceinline__ unsigned xb_xcc_id() { return (unsigned)__builtin_amdgcn_s_getreg((3 << 11) | 20) & 0xFu; }
#define XB_SPIN(cond, bar) do { unsigned _sp = 0; while (cond) { __builtin_amdgcn_s_sleep(1); \
    if ((++_sp & 255u) == 0u) { if (xb_ld(&(bar)[XB_TMO])) break; if (_sp > XB_SPIN_CAP) { atomicAdd(&(bar)[XB_TMO], 1u); break; } } } } while (0)
struct XcdBarrier { unsigned* bar; unsigned x; volatile LAS unsigned* st; };
__device__ __forceinline__ XcdBarrier xcd_barrier_post(unsigned* bar, volatile LAS unsigned* st) {
  XcdBarrier b; b.bar = bar; b.x = xb_xcc_id(); b.st = st;
  if (threadIdx.x == 0) (void)xb_add(&bar[XB_XCNT(b.x)], 1u);
  return b;
}
__device__ __forceinline__ void xcd_barrier_complete(unsigned* bar, unsigned x, unsigned& nloc, unsigned& nx) {
  const unsigned G = gridDim.x;
  unsigned sum, cnt, mine, sp = 0u;
  for (;;) {
    sum = 0u; cnt = 0u; mine = 0u;
#pragma unroll
    for (unsigned j = 0; j < 16; ++j) { const unsigned c = xb_ld(&bar[XB_XCNT(j)]); sum += c; cnt += (c > 0u) ? 1u : 0u; mine = (j == x) ? c : mine; }
    if (sum == G) break;
    __builtin_amdgcn_s_sleep(1);
    if ((++sp & 255u) == 0u) { if (xb_ld(&bar[XB_TMO])) break; if (sp > XB_SPIN_CAP) { atomicAdd(&bar[XB_TMO], 1u); break; } }
  }
  nloc = mine > 0u ? mine : 1u; nx = cnt > 0u ? cnt : 1u;
}
__device__ __forceinline__ void xcd_barrier(const XcdBarrier& b) {
  asm volatile("s_waitcnt vmcnt(0)" ::: "memory");
  __syncthreads();
  if (threadIdx.x == 0) {
    unsigned* bar = b.bar;
    __builtin_amdgcn_s_waitcnt(0);
    unsigned nloc = b.st[0], nx = b.st[1];
    if (nloc == 0u) { xcd_barrier_complete(bar, b.x, nloc, nx); b.st[0] = nloc; b.st[1] = nx; }
    const unsigned old = xb_add(&bar[XB_XSUB(b.x)], 1u);
    const unsigned gen = old / nloc;
    if (old + 1u == (gen + 1u) * nloc) {
      __builtin_amdgcn_fence(__ATOMIC_RELEASE, "agent");
      asm volatile("s_waitcnt vmcnt(0)" ::: "memory");
      const unsigned og = xb_add(&bar[XB_TOP], 1u);
      const unsigned tg = og / nx;
      if (og + 1u == (tg + 1u) * nx) xb_add(&bar[XB_TOPGEN], 1u);
      else XB_SPIN(xb_ld(&bar[XB_TOPGEN]) == tg, bar);
      __builtin_amdgcn_fence(__ATOMIC_ACQUIRE, "agent");
      xb_add(&bar[XB_XGEN(b.x)], 1u);
      asm volatile("s_waitcnt vmcnt(0)" ::: "memory");
    } else {
      XB_SPIN(xb_ld(&bar[XB_XGEN(b.x)]) == gen, bar);
      __builtin_amdgcn_fence(__ATOMIC_ACQUIRE, "agent");
      asm volatile("s_waitcnt vmcnt(0)" ::: "memory");
    }
  }
  __syncthreads();
}

constexpr int NSLOTS = 13;
constexpr int NPHASE = 2 + 4 * NSLOTS;
__device__ __forceinline__ bool phase_is_nop(int ph) {
  if (ph < 2) return false;
  const int layer = (ph - 2) / NSLOTS, st = (ph - 2) % NSLOTS;
  if (st == 5 || st == 6) return true;
  return !(layer & 1) && (st == 1 || (st >= 3 && st <= 7));
}
__device__ void run_phase(KP p, int ph, char* sm) {
  if (ph == 0) { ph_init(p, sm); return; }
  if (ph == 1) { ph_mod_h(p, sm); return; }
  const int layer = (ph - 2) / NSLOTS, st = (ph - 2) % NSLOTS;
  const bool odd = layer & 1;
  const bool keep = layer < 3;
  int gk = -1;
  if (st == 0) gk = 0;
  else if (st == 8) gk = 1;
  else if (st == 10) gk = 2;
  else if (st == 11) gk = 3;
  else if (odd && st == 2) gk = 4;
  else if (odd && st == 3) gk = 5;
  asm volatile("" : "+s"(gk));
  if (gk >= 0) {
    if (gk == 2 || gk == 3) moe_prefix(p, keep ? NT : NL, (int*)(sm + META_OFF), opaque_tid());
    ph_gemm(p, gk, layer, keep, sm);
    if (gk == 5) { __syncthreads(); ph_mlstm_s2(p, sm); }
    return;
  }
  switch (st) {
    case 1: if (odd) { ph_rwkv_mix(p, layer); ph_mlstm_s1(p, layer, sm); } break;
    case 2: ph_attention(p, layer, keep, sm); break;
    case 4: if (odd) ph_scan_a(p, layer, sm); break;
    case 7: if (odd) ph_rec_final(p, layer, keep); break;
    case 9: ph_ln_router(p, layer, keep, sm); break;
    case 12: ph_final_ln(p, layer, keep, sm); break;
  }
}

__global__ void __launch_bounds__(NTHR, 2) mega_kernel(Params kargs) {
  extern __shared__ __attribute__((aligned(16))) char sm[];
  cg::grid_group grid = cg::this_grid();
  volatile LAS unsigned* st = (volatile LAS unsigned*)(sm + META_OFF + 4032);
  if (threadIdx.x == 0) { st[0] = 0u; st[1] = 0u; }
  __syncthreads();
  const XcdBarrier xb = xcd_barrier_post(kargs.bar, st);
  for (int ph = kargs.ph_lo; ph < kargs.ph_hi; ++ph) {
    if (phase_is_nop(ph)) continue;
    {
      KP kp = (KP)__builtin_amdgcn_kernarg_segment_ptr();
      asm volatile("" : "+s"(kp));
      run_phase(kp, ph, sm);
    }
    if (ph + 1 < kargs.ph_hi) {
      if (ph == 0) grid.sync();
      else xcd_barrier(xb);
    }
  }
}

extern "C" void kernel_launch(void* const* d_in, const int* in_sizes, int n_in, void* d_out, int out_size, void* d_ws,
                              size_t ws_size, hipStream_t stream) {
  static int grid_blocks = 0;
  if (!grid_blocks) {
    int dev = 0, cus = 0, per_cu = 0;
    (void)hipGetDevice(&dev);
    (void)hipDeviceGetAttribute(&cus, hipDeviceAttributeMultiprocessorCount, dev);
    (void)hipFuncSetAttribute((const void*)mega_kernel, hipFuncAttributeMaxDynamicSharedMemorySize, SMEM_BYTES);
    (void)hipOccupancyMaxActiveBlocksPerMultiprocessor(&per_cu, mega_kernel, NTHR, SMEM_BYTES);
    if (per_cu < 1) per_cu = 1;
    if (per_cu > 2) per_cu = 2;
    grid_blocks = cus * per_cu;
  }
  Params p;
  memset(&p, 0, sizeof(p));
  const float** pin = (const float**)&p;
  for (int i = 0; i < 35; ++i) pin[i] = (const float*)d_in[i];
  p.out = (float*)d_out;
  char* w = (char*)d_ws;
  size_t off = 0;
  auto take = [&](size_t bytes) { char* r = w + off; off += (bytes + 255) & ~(size_t)255; return r; };
  p.Wt_att = (bf16_t*)take((size_t)2 * ATT_N * 1024 * 2);
  p.Wt_rec = (bf16_t*)take((size_t)2 * REC_NP * 1024 * 2);
  p.Wt_out = (bf16_t*)take((size_t)4 * 1024 * 1024 * 2);
  p.Wt13 = (bf16_t*)take((size_t)4 * 65 * 512 * 1024);
  p.Wt2 = (bf16_t*)take((size_t)4 * 65 * 1024 * 256);
  p.Wl1 = (bf16_t*)take((size_t)2 * 3 * 128 * 512 * 2);
  p.Wl2 = (bf16_t*)take((size_t)2 * 2560 * 128 * 2);
  p.X = (float*)take((size_t)NT * DM * 4);
  p.AB = (bf16_t*)take((size_t)NT * DM * 2);
  p.MOD = (float*)take((size_t)5 * 9 * 6144 * 4);
  p.MODP = (float*)take((size_t)8 * 4 * 9 * 6144 * 4);
  p.GP = (float*)take((size_t)NT * 16 * 4);
  p.ROPE = (float*)take((size_t)64 * 16 * 2 * 4);
  p.WrT = (float*)take((size_t)4 * 64 * 1024 * 4);
  p.msc = (float*)take((size_t)3 * NMT * 4);
  p.lgate = (float*)take((size_t)64 * NT * 4);
  p.ltok = (int*)take((size_t)64 * NT * 4);
  p.tsl = (int*)take((size_t)NT * 6 * 4);
  p.cnt = (int*)take((size_t)65 * CSTR * 4);
  p.bar = (unsigned*)take((size_t)BAR_TOTAL_WORDS * 4);
  char* region = take(0);
  const size_t szP = (size_t)NT * LDP * 2, szRW = (size_t)NT * RWS * 2, szMS = (size_t)NMT * 16384 * 2,
               szMSn = (size_t)NMT * 128 * 4;
  const size_t szT = (size_t)NT * DM * 4, szOUT2 = (size_t)NSLOT * 1024 * 2;
  p.P = (bf16_t*)region;
  p.RW = (bf16_t*)(region + szP);
  p.MS = (bf16_t*)(region + szP + szRW);
  p.MSn = (float*)(region + szP + szRW + szMS);
  p.Tb = (float*)region;
  p.ACT = (bf16_t*)region;
  p.OUT2 = (bf16_t*)(region + szT);
  const size_t szZ = (size_t)NT * 2048 * 2;
  p.Zb = (bf16_t*)(region + szP + szRW + szMS + szMSn);
  p.L1 = p.Zb + (size_t)NT * 1536;
  size_t mixer = szP + szRW + szMS + szMSn + szZ, moe = szT + szOUT2;
  off += (mixer > moe ? mixer : moe);
  if (off > ws_size) { fprintf(stderr, "workspace too small: need %zu have %zu\n", off, ws_size); return; }
  p.ph_lo = 0;
  p.ph_hi = NPHASE;
  (void)hipMemsetAsync(p.bar, 0, (size_t)BAR_TOTAL_WORDS * 4, stream);
  void* args[] = {&p};
  hipError_t e = hipLaunchCooperativeKernel((void*)mega_kernel, dim3(grid_blocks), dim3(NTHR), args, SMEM_BYTES, stream);
  if (e != hipSuccess) fprintf(stderr, "cooperative launch failed: %s (grid %d)\n", hipGetErrorString(e), grid_blocks);
}
```

```cpp
#include <hip/hip_runtime.h>
#include <hip/hip_cooperative_groups.h>
#include <cstdio>
#include <cstring>
namespace cg = cooperative_groups;

constexpr int DM = 1024;
constexpr int NBATCH = 8;
constexpr int SEQ = 2048;
constexpr int CTXL = 256;
constexpr int NL = NBATCH * SEQ;
constexpr int NC = NBATCH * CTXL;
constexpr int NT = NL + NC;
constexpr int TSC = CTXL + SEQ;
constexpr int LDP = 4112;
constexpr int ATT_N = 2304;
constexpr int REC_N = 4112;
constexpr int REC_NP = 4224;
constexpr int NCHUNK = 36;
constexpr int NMT = 64 * NCHUNK;
constexpr int RWS = 5632;
constexpr int NSLOT = 137216;
constexpr float DN_ALPHA = 1.6817928305074290f;
constexpr int NTHR = 256;
constexpr int SMEM_BYTES = 65536 + 4096;
constexpr int META_OFF = 65536;
#define XCD_BAR_WORDS 3456
constexpr int CSTR = 32;
constexpr int BAR_TOTAL_WORDS = XCD_BAR_WORDS + 64;

typedef unsigned short bf16_t;
using bf16x8 = __attribute__((ext_vector_type(8))) short;
using f32x16 = __attribute__((ext_vector_type(16))) float;
using u32x4 = __attribute__((ext_vector_type(4))) unsigned;
using u32x2 = __attribute__((ext_vector_type(2))) unsigned;

struct Params {
  const float *x, *c, *ctx, *c_ctx, *ada_w, *ada_b, *ln_g, *ln_b, *mix_w_out, *att_w_in, *na_rpb, *qk_gain,
      *rec_w_in, *rwkv_mu, *rwkv_w0, *rwkv_w1, *rwkv_w2, *rwkv_a0, *rwkv_a1, *rwkv_a2, *rwkv_g1, *rwkv_g2,
      *rwkv_kvec, *rwkv_rk, *rwkv_gn, *mlstm_gate_b, *mlstm_norm, *moe_router, *moe_bias, *moe_w1, *moe_w3,
      *moe_w2, *shared_w1, *shared_w3, *shared_w2;
  float* out;
  bf16_t *Wt_att, *Wt_rec, *Wt_out, *Wt13, *Wt2, *Wl1, *Wl2;
  bf16_t *Zb, *L1;
  float *X, *MOD, *MODP, *GP, *msc, *lgate, *MSn, *Tb, *ROPE, *WrT;
  bf16_t *AB, *P, *RW, *MS, *ACT, *OUT2;
  int *cnt, *ltok, *tsl;
  unsigned* bar;
  int ph_lo, ph_hi;
};

typedef const Params __attribute__((address_space(4))) * KP;

__device__ __forceinline__ int modrow(int t) { return t < NL ? (t >> 11) : 8; }
__device__ __forceinline__ float silu_f(float x) { return x / (1.f + expf(-x)); }
__device__ __forceinline__ float sigm_f(float x) { return 1.f / (1.f + expf(-x)); }
__device__ __forceinline__ float softplus_f(float x) { return fmaxf(x, 0.f) + log1pf(expf(-fabsf(x))); }
template <int CTRL>
__device__ __forceinline__ float dppx(float x) {
  return __int_as_float(__builtin_amdgcn_update_dpp(0, __float_as_int(x), CTRL, 0xf, 0xf, true));
}
__device__ __forceinline__ float rdlane(float v, int l) {
  return __int_as_float(__builtin_amdgcn_readlane(__float_as_int(v), l));
}
__device__ __forceinline__ float wsum(float v) {
  v += dppx<0xB1>(v); v += dppx<0x4E>(v); v += dppx<0x141>(v); v += dppx<0x140>(v);
  return (rdlane(v, 0) + rdlane(v, 16)) + (rdlane(v, 32) + rdlane(v, 48));
}
__device__ __forceinline__ float wmax(float v) {
  v = fmaxf(v, dppx<0xB1>(v)); v = fmaxf(v, dppx<0x4E>(v)); v = fmaxf(v, dppx<0x141>(v)); v = fmaxf(v, dppx<0x140>(v));
  return fmaxf(fmaxf(rdlane(v, 0), rdlane(v, 16)), fmaxf(rdlane(v, 32), rdlane(v, 48)));
}
__device__ __forceinline__ int opaque_tid() {
  int t = threadIdx.x;
  asm volatile("" : "+v"(t));
  return t;
}
typedef __bf16 bf16x2_t __attribute__((ext_vector_type(2)));
typedef float f32x2_t __attribute__((ext_vector_type(2)));
__device__ __forceinline__ unsigned pk_bf16(float lo, float hi) {
  const f32x2_t v = {lo, hi};
  return __builtin_bit_cast(unsigned, __builtin_convertvector(v, bf16x2_t));
}
__device__ __forceinline__ bf16_t f2bf(float x) { return (bf16_t)(pk_bf16(x, 0.f) & 0xffffu); }
__device__ __forceinline__ float bf2f(bf16_t v) { return __uint_as_float((unsigned)v << 16); }
__device__ __forceinline__ float bflo(unsigned u) { return __uint_as_float(u << 16); }
__device__ __forceinline__ float bfhi(unsigned u) { return __uint_as_float(u & 0xffff0000u); }
__device__ __forceinline__ int scan_row(int dir, int b, int tau) {
  if (tau < CTXL) return NL + b * CTXL + (dir ? (CTXL - 1 - tau) : tau);
  int s = tau - CTXL;
  return b * SEQ + (dir ? (SEQ - 1 - s) : s);
}

template <class RowPtrA>
__device__ __forceinline__ void gemm128_main(int tid, RowPtrA rowA, const bf16_t* __restrict__ Bt, int K, int n0,
                                             char* lds, f32x16 (&acc)[2][2]) {
  const int lane = tid & 63, w = tid >> 6;
  const int wm = w >> 1, wn = w & 1, r = lane & 31, h = lane >> 5;
  const int c = tid & 7, sr = tid >> 3;
  const int lc = (c ^ ((tid >> 4) & 7)) * 8;
  const bf16_t* ap[4];
#pragma unroll
  for (int i = 0; i < 4; ++i) ap[i] = rowA(sr + 32 * i) + lc;
  const bf16_t* bp0 = Bt + (size_t)(n0 + sr) * K + lc;
  const int bstr = 32 * K;
#pragma unroll
  for (int mi = 0; mi < 2; ++mi)
#pragma unroll
    for (int ni = 0; ni < 2; ++ni)
#pragma unroll
      for (int q = 0; q < 16; ++q) acc[mi][ni][q] = 0.f;
  const int nk = K >> 6;
  auto issue = [&](int kt) {
    char* As = lds + (kt & 1) * 32768 + tid * 16;
    const int k0 = kt * 64;
#pragma unroll
    for (int i = 0; i < 4; ++i) {
      __builtin_amdgcn_global_load_lds((const unsigned*)(ap[i] + k0), (__attribute__((address_space(3))) unsigned*)(As + i * 4096), 16, 0, 0);
      __builtin_amdgcn_global_load_lds((const unsigned*)(bp0 + i * bstr + k0), (__attribute__((address_space(3))) unsigned*)(As + 16384 + i * 4096), 16, 0, 0);
    }
  };
  issue(0);
  const int sw = (r >> 1) & 7;
#pragma unroll 1
  for (int kt = 0; kt < nk; ++kt) {
    asm volatile("s_waitcnt vmcnt(0)" ::: "memory");
    __syncthreads();
    if (kt + 1 < nk) issue(kt + 1);
    const char* As = lds + (kt & 1) * 32768;
    const char* Ar = As + (wm * 64 + r) * 128;
    const char* Br = As + 16384 + (wn * 64 + r) * 128;
#pragma unroll
    for (int ks = 0; ks < 4; ++ks) {
      const int off = ((ks * 2 + h) ^ sw) * 16;
      const bf16x8 a0 = *(const bf16x8*)(Ar + off);
      const bf16x8 a1 = *(const bf16x8*)(Ar + 32 * 128 + off);
      const bf16x8 b0 = *(const bf16x8*)(Br + off);
      const bf16x8 b1 = *(const bf16x8*)(Br + 32 * 128 + off);
      acc[0][0] = __builtin_amdgcn_mfma_f32_32x32x16_bf16(a0, b0, acc[0][0], 0, 0, 0);
      acc[0][1] = __builtin_amdgcn_mfma_f32_32x32x16_bf16(a0, b1, acc[0][1], 0, 0, 0);
      acc[1][0] = __builtin_amdgcn_mfma_f32_32x32x16_bf16(a1, b0, acc[1][0], 0, 0, 0);
      acc[1][1] = __builtin_amdgcn_mfma_f32_32x32x16_bf16(a1, b1, acc[1][1], 0, 0, 0);
    }
  }
  __syncthreads();
}
using i64 = long;
template <class RowPtrA8>
__device__ __forceinline__ void gemm128_fp8(int tid, RowPtrA8 rowA, const unsigned char* __restrict__ Bt, int K, int n0,
                                            char* lds, f32x16 (&acc)[2][2]) {
  const int lane = tid & 63, w = tid >> 6;
  const int wm = w >> 1, wn = w & 1, r = lane & 31, h = lane >> 5;
  const int c = tid & 7, sr = tid >> 3;
  const int lc = (c ^ ((tid >> 4) & 7)) * 16;
  const unsigned char* ap[4];
#pragma unroll
  for (int i = 0; i < 4; ++i) ap[i] = rowA(sr + 32 * i) + lc;
  const unsigned char* bp0 = Bt + (size_t)(n0 + sr) * K + lc;
  const int bstr = 32 * K;
#pragma unroll
  for (int mi = 0; mi < 2; ++mi)
#pragma unroll
    for (int ni = 0; ni < 2; ++ni)
#pragma unroll
      for (int q = 0; q < 16; ++q) acc[mi][ni][q] = 0.f;
  const int nk = K >> 7;
  auto issue = [&](int kt) {
    char* As = lds + (kt & 1) * 32768 + tid * 16;
    const int k0 = kt * 128;
#pragma unroll
    for (int i = 0; i < 4; ++i) {
      __builtin_amdgcn_global_load_lds((const unsigned*)(ap[i] + k0), (__attribute__((address_space(3))) unsigned*)(As + i * 4096), 16, 0, 0);
      __builtin_amdgcn_global_load_lds((const unsigned*)(bp0 + i * bstr + k0), (__attribute__((address_space(3))) unsigned*)(As + 16384 + i * 4096), 16, 0, 0);
    }
  };
  issue(0);
  const int sw = (r >> 1) & 7;
#pragma unroll 1
  for (int kt = 0; kt < nk; ++kt) {
    asm volatile("s_waitcnt vmcnt(0)" ::: "memory");
    __syncthreads();
    if (kt + 1 < nk) issue(kt + 1);
    const char* As = lds + (kt & 1) * 32768;
    const char* Ar = As + (wm * 64 + r) * 128;
    const char* Br = As + 16384 + (wn * 64 + r) * 128;
#pragma unroll
    for (int q = 0; q < 4; ++q) {
      const int off = ((q * 2 + h) ^ sw) * 16;
      const u32x4 a0 = *(const u32x4*)(Ar + off);
      const u32x4 a1 = *(const u32x4*)(Ar + 32 * 128 + off);
      const u32x4 b0 = *(const u32x4*)(Br + off);
      const u32x4 b1 = *(const u32x4*)(Br + 32 * 128 + off);
      const i64 a0l = (i64)(((unsigned long long)a0.y << 32) | a0.x), a0h = (i64)(((unsigned long long)a0.w << 32) | a0.z);
      const i64 a1l = (i64)(((unsigned long long)a1.y << 32) | a1.x), a1h = (i64)(((unsigned long long)a1.w << 32) | a1.z);
      const i64 b0l = (i64)(((unsigned long long)b0.y << 32) | b0.x), b0h = (i64)(((unsigned long long)b0.w << 32) | b0.z);
      const i64 b1l = (i64)(((unsigned long long)b1.y << 32) | b1.x), b1h = (i64)(((unsigned long long)b1.w << 32) | b1.z);
      acc[0][0] = __builtin_amdgcn_mfma_f32_32x32x16_fp8_fp8(a0l, b0l, acc[0][0], 0, 0, 0);
      acc[0][1] = __builtin_amdgcn_mfma_f32_32x32x16_fp8_fp8(a0l, b1l, acc[0][1], 0, 0, 0);
      acc[1][0] = __builtin_amdgcn_mfma_f32_32x32x16_fp8_fp8(a1l, b0l, acc[1][0], 0, 0, 0);
      acc[1][1] = __builtin_amdgcn_mfma_f32_32x32x16_fp8_fp8(a1l, b1l, acc[1][1], 0, 0, 0);
      acc[0][0] = __builtin_amdgcn_mfma_f32_32x32x16_fp8_fp8(a0h, b0h, acc[0][0], 0, 0, 0);
      acc[0][1] = __builtin_amdgcn_mfma_f32_32x32x16_fp8_fp8(a0h, b1h, acc[0][1], 0, 0, 0);
      acc[1][0] = __builtin_amdgcn_mfma_f32_32x32x16_fp8_fp8(a1h, b0h, acc[1][0], 0, 0, 0);
      acc[1][1] = __builtin_amdgcn_mfma_f32_32x32x16_fp8_fp8(a1h, b1h, acc[1][1], 0, 0, 0);
    }
  }
  __syncthreads();
}
template <class F>
__device__ __forceinline__ void acc_foreach(int tid, const f32x16 (&acc)[2][2], F f) {
  const int lane = tid & 63, w = tid >> 6;
  const int wm = w >> 1, wn = w & 1, r = lane & 31, h = lane >> 5;
#pragma unroll
  for (int mi = 0; mi < 2; ++mi)
#pragma unroll
    for (int ni = 0; ni < 2; ++ni)
#pragma unroll
      for (int q = 0; q < 16; ++q) {
        const int row = wm * 64 + mi * 32 + (q & 3) + 8 * (q >> 2) + 4 * h;
        const int col = wn * 64 + ni * 32 + r;
        f(row, col, acc[mi][ni][q]);
        if ((q & 3) == 3) __builtin_amdgcn_sched_barrier(0);
      }
}

template <class RM>
__device__ __forceinline__ void tr_tile(int tid, const float* __restrict__ src, int N, int k0, int n0,
                                        bf16_t* __restrict__ dst, int K, RM rowmap, float* tile) {
  {
    const int tx = tid & 15, ty = tid >> 4;
    const int n = n0 + tx * 4;
#pragma unroll
    for (int i = 0; i < 4; ++i) {
      const int k = ty + 16 * i;
      float4 v = make_float4(0.f, 0.f, 0.f, 0.f);
      if (n < N) v = *(const float4*)(src + (size_t)(k0 + k) * N + n);
      tile[k * 65 + tx * 4 + 0] = v.x; tile[k * 65 + tx * 4 + 1] = v.y;
      tile[k * 65 + tx * 4 + 2] = v.z; tile[k * 65 + tx * 4 + 3] = v.w;
    }
  }
  __syncthreads();
  {
    const int kc = tid & 7;
#pragma unroll
    for (int i = 0; i < 2; ++i) {
      const int n = (tid >> 3) + 32 * i;
      if (n0 + n < N) {
        float v[8];
#pragma unroll
        for (int q = 0; q < 8; ++q) v[q] = tile[(kc * 8 + q) * 65 + n];
        u32x4 o;
        o.x = pk_bf16(v[0], v[1]); o.y = pk_bf16(v[2], v[3]); o.z = pk_bf16(v[4], v[5]); o.w = pk_bf16(v[6], v[7]);
        *(u32x4*)(dst + (size_t)rowmap(n0 + n) * K + k0 + kc * 8) = o;
      }
    }
  }
  __syncthreads();
}

constexpr float W8_SCALE = 32.f, W8_INV = 1.f / 32.f;
__device__ __forceinline__ unsigned pk_fp8x4(float a, float b, float c, float d) {
  int r = __builtin_amdgcn_cvt_pk_fp8_f32(a, b, 0, false);
  r = __builtin_amdgcn_cvt_pk_fp8_f32(c, d, r, true);
  return (unsigned)r;
}
template <class RM>
__device__ __forceinline__ void tr_tile_fp8(int tid, const float* __restrict__ src, int N, int k0, int n0,
                                            unsigned char* __restrict__ dst, int K, RM rowmap, float* tile) {
  {
    const int tx = tid & 15, ty = tid >> 4;
    const int n = n0 + tx * 4;
#pragma unroll
    for (int i = 0; i < 4; ++i) {
      const int k = ty + 16 * i;
      float4 v = make_float4(0.f, 0.f, 0.f, 0.f);
      if (n < N) v = *(const float4*)(src + (size_t)(k0 + k) * N + n);
      tile[k * 65 + tx * 4 + 0] = v.x; tile[k * 65 + tx * 4 + 1] = v.y;
      tile[k * 65 + tx * 4 + 2] = v.z; tile[k * 65 + tx * 4 + 3] = v.w;
    }
  }
  __syncthreads();
  {
    const int kc = tid & 3, n = tid >> 2;
    float v[16];
#pragma unroll
    for (int q = 0; q < 16; ++q) v[q] = tile[(kc * 16 + q) * 65 + n] * W8_SCALE;
    u32x4 o;
    o.x = pk_fp8x4(v[0], v[1], v[2], v[3]); o.y = pk_fp8x4(v[4], v[5], v[6], v[7]);
    o.z = pk_fp8x4(v[8], v[9], v[10], v[11]); o.w = pk_fp8x4(v[12], v[13], v[14], v[15]);
    *(u32x4*)(dst + (size_t)rowmap(n0 + n) * K + k0 + kc * 16) = o;
  }
  __syncthreads();
}

constexpr int CJ0 = 1152, CJ1 = CJ0 + 2080, CJ2 = CJ1 + 1024, CJ3 = CJ2 + 33280, CJ4 = CJ3 + 16640;
__device__ void convert_job(KP p, int job, float* sm, int tid) {
  if (job < CJ0) {
    const int j = job / 576, rem = job % 576, kt = rem / 36, nt = rem % 36;
    tr_tile_fp8(tid, p->att_w_in + (size_t)j * 1024 * ATT_N, ATT_N, kt * 64, nt * 64, (unsigned char*)p->Wt_att + (size_t)j * ATT_N * 1024,
                1024, [](int n) { return n; }, sm);
  } else if (job < CJ1) {
    const int q = job - CJ0;
    const int j = q / 1040, rem = q % 1040, kt = rem / 65, nt = rem % 65;
    tr_tile_fp8(tid, p->rec_w_in + (size_t)j * 1024 * REC_N, REC_N, kt * 64, nt * 64, (unsigned char*)p->Wt_rec + (size_t)j * REC_NP * 1024,
                1024, [](int n) { return n; }, sm);
  } else if (job < CJ2) {
    const int q = job - CJ1;
    const int i = q >> 8, rem = q & 255, kt = rem >> 4, nt = rem & 15;
    tr_tile(tid, p->mix_w_out + (size_t)i * 1024 * 1024, 1024, kt * 64, nt * 64, p->Wt_out + (size_t)i * 1024 * 1024,
            1024, [](int n) { return n; }, sm);
  } else if (job < CJ3) {
    const int q = job - CJ2;
    const int le = q >> 7, rem = q & 127;
    const int which = rem >> 6, kt = (rem >> 2) & 15, nt = rem & 3;
    const int layer = le / 65, e = le % 65;
    const float* src;
    if (e < 64) src = (which ? p->moe_w3 : p->moe_w1) + (size_t)(layer * 64 + e) * 1024 * 256;
    else src = (which ? p->shared_w3 : p->shared_w1) + (size_t)layer * 1024 * 256;
    tr_tile_fp8(tid, src, 256, kt * 64, nt * 64, (unsigned char*)p->Wt13 + (size_t)le * 512 * 1024, 1024,
                [which](int n) { return 64 * (n >> 5) + which * 32 + (n & 31); }, sm);
  } else {
    const int q = job - CJ3;
    const int le = q >> 6, rem = q & 63;
    const int kt = rem >> 4, nt = rem & 15;
    const int layer = le / 65, e = le % 65;
    const float* src = e < 64 ? p->moe_w2 + (size_t)(layer * 64 + e) * 256 * 1024 : p->shared_w2 + (size_t)layer * 256 * 1024;
    tr_tile_fp8(tid, src, 1024, kt * 64, nt * 64, (unsigned char*)p->Wt2 + (size_t)le * 1024 * 256, 256, [](int n) { return n; }, sm);
  }
}
__device__ __forceinline__ int conv_stage_total(int stage) {
  return stage == 0 ? (576 + 1040 + 512 + 8320 + 4160) : (stage == 1 ? (576 + 1040 + 256 + 16640 + 8320) : (256 + 8320 + 4160));
}
__device__ __forceinline__ int conv_stage_job(int stage, int q) {
  if (stage == 0) {
    if (q < 8320) return CJ2 + q;  q -= 8320;
    if (q < 4160) return CJ3 + q;  q -= 4160;
    if (q < 576) return q;  q -= 576;
    if (q < 1040) return CJ0 + q;  q -= 1040;
    return CJ1 + q;
  } else if (stage == 1) {
    if (q < 8320) return CJ2 + 8320 + q;  q -= 8320;
    if (q < 4160) return CJ3 + 4160 + q;  q -= 4160;
    if (q < 576) return 576 + q;  q -= 576;
    if (q < 256) return CJ1 + 512 + q;  q -= 256;
    if (q < 8320) return CJ2 + 16640 + q;  q -= 8320;
    if (q < 4160) return CJ3 + 8320 + q;  q -= 4160;
    return CJ0 + 1040 + q;
  }
  if (q < 256) return CJ1 + 768 + q;  q -= 256;
  if (q < 8320) return CJ2 + 24960 + q;  q -= 8320;
  return CJ3 + 12480 + q;
}

struct CvDesc { const float* src; unsigned char* dst; int N, K, k0, n0, which; };
__device__ __forceinline__ bool conv_desc_fp8(KP p, int job, CvDesc& d) {
  if (job < CJ2) return false;
  if (job < CJ3) {
    const int q = job - CJ2;
    const int le = q >> 7, rem = q & 127;
    const int which = rem >> 6, kt = (rem >> 2) & 15, nt = rem & 3;
    const int layer = le / 65, e = le % 65;
    if (e < 64) d.src = (which ? p->moe_w3 : p->moe_w1) + (size_t)(layer * 64 + e) * 1024 * 256;
    else d.src = (which ? p->shared_w3 : p->shared_w1) + (size_t)layer * 1024 * 256;
    d.dst = (unsigned char*)p->Wt13 + (size_t)le * 512 * 1024;
    d.N = 256; d.K = 1024; d.k0 = kt * 64; d.n0 = nt * 64; d.which = which;
  } else {
    const int q = job - CJ3;
    const int le = q >> 6, rem = q & 63;
    const int kt = rem >> 4, nt = rem & 15;
    const int layer = le / 65, e = le % 65;
    d.src = e < 64 ? p->moe_w2 + (size_t)(layer * 64 + e) * 256 * 1024 : p->shared_w2 + (size_t)layer * 256 * 1024;
    d.dst = (unsigned char*)p->Wt2 + (size_t)le * 1024 * 256;
    d.N = 1024; d.K = 256; d.k0 = kt * 64; d.n0 = nt * 64; d.which = -1;
  }
  return true;
}
typedef float cvf4 __attribute__((ext_vector_type(4)));
__device__ __forceinline__ void cv_load(const CvDesc& d, int tid, cvf4& v0, cvf4& v1, cvf4& v2, cvf4& v3) {
  const int tx = tid & 15, ty = tid >> 4;
  const float* s0 = d.src + (size_t)(d.k0 + ty) * d.N + d.n0 + tx * 4;
  v0 = *(const cvf4*)(s0);
  v1 = *(const cvf4*)(s0 + (size_t)16 * d.N);
  v2 = *(const cvf4*)(s0 + (size_t)32 * d.N);
  v3 = *(const cvf4*)(s0 + (size_t)48 * d.N);
}
__device__ __forceinline__ void cv_emit(const CvDesc& d, int tid, const cvf4 v0, const cvf4 v1, const cvf4 v2, const cvf4 v3, float* tile) {
  {
    const int tx = tid & 15, ty = tid >> 4;
    float* t0 = tile + ty * 65 + tx * 4;
    t0[0] = v0.x; t0[1] = v0.y; t0[2] = v0.z; t0[3] = v0.w;
    t0[16 * 65 + 0] = v1.x; t0[16 * 65 + 1] = v1.y; t0[16 * 65 + 2] = v1.z; t0[16 * 65 + 3] = v1.w;
    t0[32 * 65 + 0] = v2.x; t0[32 * 65 + 1] = v2.y; t0[32 * 65 + 2] = v2.z; t0[32 * 65 + 3] = v2.w;
    t0[48 * 65 + 0] = v3.x; t0[48 * 65 + 1] = v3.y; t0[48 * 65 + 2] = v3.z; t0[48 * 65 + 3] = v3.w;
  }
  __syncthreads();
  {
    const int kc = tid & 3, n = tid >> 2;
    float v[16];
#pragma unroll
    for (int q = 0; q < 16; ++q) v[q] = tile[(kc * 16 + q) * 65 + n] * W8_SCALE;
    u32x4 o;
    o.x = pk_fp8x4(v[0], v[1], v[2], v[3]); o.y = pk_fp8x4(v[4], v[5], v[6], v[7]);
    o.z = pk_fp8x4(v[8], v[9], v[10], v[11]); o.w = pk_fp8x4(v[12], v[13], v[14], v[15]);
    const int nn = d.n0 + n;
    const int row = d.which >= 0 ? 64 * (nn >> 5) + d.which * 32 + (nn & 31) : nn;
    *(u32x4*)(d.dst + (size_t)row * d.K + d.k0 + kc * 16) = o;
  }
  __syncthreads();
}
__device__ __forceinline__ void convert_run(KP p, int stage, int jj, int j1, float* sm, int tid) {
  CvDesc d, dn;
  cvf4 a0, a1, a2, a3, b0, b1, b2, b3;
  bool cur = false;
#pragma unroll 1
  for (; jj < j1; ++jj) {
    const int job = conv_stage_job(stage, jj);
    if (!cur) {
      if (!conv_desc_fp8(p, job, d)) { convert_job(p, job, sm, tid); continue; }
      cv_load(d, tid, a0, a1, a2, a3);
    }
    bool nxt = false;
    if (jj + 1 < j1) {
      nxt = conv_desc_fp8(p, conv_stage_job(stage, jj + 1), dn);
      if (nxt) cv_load(dn, tid, b0, b1, b2, b3);
    }
    cv_emit(d, tid, a0, a1, a2, a3, sm);
    if (nxt) { d = dn; a0 = b0; a1 = b1; a2 = b2; a3 = b3; }
    cur = nxt;
  }
}

__device__ void ph_init(KP p, char* smc) {
  float* sm = (float*)smc;
  const int tid = opaque_tid();
  {
    const size_t n4a = (size_t)NL * DM / 4, n4b = (size_t)NC * DM / 4;
    const float4* xs = (const float4*)p->x;
    const float4* cs = (const float4*)p->ctx;
    float4* X4 = (float4*)p->X;
    for (size_t i = (size_t)blockIdx.x * NTHR + tid; i < n4a + n4b; i += (size_t)gridDim.x * NTHR)
      X4[i] = i < n4a ? xs[i] : cs[i - n4a];
  }
  for (int tile = blockIdx.x; tile < 96 * 8; tile += gridDim.x) {
    const int ct = tile >> 3, ks = tile & 7;
    for (int i = tid; i < 9 * 128; i += NTHR) {
      const int r = i >> 7, k = ks * 128 + (i & 127);
      const float v = r < 8 ? p->c[r * 1024 + k] : p->c_ctx[k];
      sm[i] = silu_f(v);
    }
    __syncthreads();
    const int col = ct * 256 + tid;
    const int layer = col / 6144, n = col % 6144;
    const float* W = p->ada_w + ((size_t)layer * 1024 + ks * 128) * 6144 + n;
    float acc[9];
#pragma unroll
    for (int r = 0; r < 9; ++r) acc[r] = 0.f;
#pragma unroll 4
    for (int k = 0; k < 128; ++k) {
      const float w = W[(size_t)k * 6144];
#pragma unroll
      for (int r = 0; r < 9; ++r) acc[r] = fmaf(sm[r * 128 + k], w, acc[r]);
    }
#pragma unroll
    for (int r = 0; r < 9; ++r) p->MODP[((size_t)(ks * 4 + layer) * 9 + r) * 6144 + n] = acc[r];
    __syncthreads();
  }
  {
    const int total = conv_stage_total(0), chunk = (total + gridDim.x - 1) / gridDim.x;
    const int lo = min((int)blockIdx.x * chunk, total), hi = min(lo + chunk, total);
    __syncthreads();
    convert_run(p, 0, lo, hi, sm, tid);
  }
  for (int i = blockIdx.x * NTHR + tid; i < 2 * 3 * 128 * 512; i += gridDim.x * NTHR) {
    const int k = i & 511, n = (i >> 9) & 127, wj = i >> 16;
    const int j = wj / 3, which = wj % 3;
    float v = 0.f;
    if (which < 2) {
      if (n < 64) v = (which ? p->rwkv_a1 : p->rwkv_w1)[((size_t)(j * 2 + (n >> 5)) * 512 + k) * 32 + (n & 31)];
    } else if (n < 96) v = p->rwkv_g1[((size_t)j * 512 + k) * 96 + n];
    p->Wl1[i] = f2bf(v);
  }
  for (int i = blockIdx.x * NTHR + tid; i < 2 * 2560 * 128; i += gridDim.x * NTHR) {
    const int k = i & 127, n = (i >> 7) % 2560, j = i / (2560 * 128);
    float v = 0.f;
    if (n < 2048) {
      const int d = (n >> 9) & 1, c = n & 511;
      if (k < 64 && (k >> 5) == d) v = (n < 1024 ? p->rwkv_w2 : p->rwkv_a2)[((size_t)(j * 2 + d) * 32 + (k & 31)) * 512 + c];
    } else if (k < 96) v = p->rwkv_g2[((size_t)j * 96 + k) * 512 + (n - 2048)];
    p->Wl2[i] = f2bf(v);
  }
  for (int i = blockIdx.x * NTHR + tid; i < 4 * 64 * 1024; i += gridDim.x * NTHR) {
    const int k = i & 1023, n = (i >> 10) & 63, l = i >> 16;
    p->WrT[i] = p->moe_router[((size_t)l * 1024 + k) * 64 + n];
  }
  for (int i = blockIdx.x * NTHR + tid; i < 64 * 16; i += gridDim.x * NTHR) {
    const int pos = i >> 4, f = i & 15;
    const float ang = (float)pos * powf(10000.f, -(float)f / 16.f);
    p->ROPE[2 * i] = cosf(ang);
    p->ROPE[2 * i + 1] = sinf(ang);
  }
}

__device__ void ph_mod_h(KP p, char* smc) {
  float* sm = (float*)smc;
  const int tid = opaque_tid();
  for (int i = blockIdx.x * NTHR + tid; i < 4 * 9 * 6144; i += gridDim.x * NTHR) {
    const int layer = i / (9 * 6144), rem = i % (9 * 6144), n = rem % 6144;
    float s = p->ada_b[layer * 6144 + n];
#pragma unroll
    for (int ks = 0; ks < 8; ++ks) s += p->MODP[(size_t)(ks * 4 + layer) * 9 * 6144 + rem];
    p->MOD[i] = s;
  }
  const int lane = tid & 63, wave = tid >> 6;
  const int per = (((NT + gridDim.x - 1) / gridDim.x) + 3) & ~3;
  const int t0 = blockIdx.x * per, t1 = min(NT, t0 + per);
  int cur = -1;
  for (int tb = t0; tb < t1; tb += 4) {
    const int mr = modrow(tb);
    if (mr != cur) {
      __syncthreads();
      for (int n = tid; n < 2048; n += NTHR) {
        float a = p->ada_b[n];
#pragma unroll
        for (int ks = 0; ks < 8; ++ks) a += p->MODP[((size_t)(ks * 4) * 9 + mr) * 6144 + n];
        sm[n] = a;
      }
      cur = mr;
      __syncthreads();
    }
    const int t = tb + wave;
    if (t < t1) {
      const float* src = t < NL ? p->x + (size_t)t * DM : p->ctx + (size_t)(t - NL) * DM;
#pragma unroll
      for (int i = 0; i < 4; ++i) {
        const int n = i * 256 + lane * 4;
        const float4 xv = *(const float4*)(src + n);
        const float4 sh = *(const float4*)(sm + n);
        const float4 sc = *(const float4*)(sm + 1024 + n);
        *(unsigned*)((unsigned char*)p->AB + (size_t)t * DM + n) =
            pk_fp8x4(xv.x * (1.f + sc.x) + sh.x, xv.y * (1.f + sc.y) + sh.y, xv.z * (1.f + sc.z) + sh.z, xv.w * (1.f + sc.w) + sh.w);
      }
    }
  }
}

typedef short v4i16_t __attribute__((ext_vector_type(4)));
using s16x4 = __attribute__((ext_vector_type(4))) short;
__device__ __forceinline__ s16x4 vtr(const char* p) {
  return __builtin_bit_cast(s16x4, __builtin_amdgcn_ds_read_tr16_b64_v4i16((__attribute__((address_space(3))) v4i16_t*)p));
}
#define MFMA32(a, b, c) __builtin_amdgcn_mfma_f32_32x32x16_bf16(a, b, c, 0, 0, 0)
__device__ void ph_attention(KP p, int layer, bool keep, char* lds) {
  const int tid = opaque_tid();
  const int lane = tid & 63, w = tid >> 6, r32 = lane & 31, hi = lane >> 5;
  const int j = layer >> 1;
  float* bias_lds = (float*)(lds + 32768 + 1024);
  const int n_gqa = 1024, n_na = 1024, n_cb = keep ? 128 : 0, n_ca = keep ? 128 : 0;
  const int total = n_gqa + n_na + n_cb + n_ca;
  constexpr float LOG2E = 1.4426950408889634f;
  constexpr float C2 = 0.125f * LOG2E;
  const int c = tid & 7, sr = tid >> 3;
  const int kso = (c ^ ((tid >> 4) & 7)) * 16;
  const int vso = (c >> 2) * 4096 + (c & 3) * 16;
  const int sw = (r32 >> 1) & 7;
  for (int item = blockIdx.x; item < total; item += gridDim.x) {
    int b, qrow0, qoff, koff, voff, ocol, lat_tiles, lat_row0;
    bool na = false;
    int r_w = 0, start_w = 0, ru0 = 0, hN = 0;
    if (item < n_gqa) {
      b = item >> 7;
      const int g = (item >> 6) & 1, tt = item & 63;
      qrow0 = b * SEQ + tt * 32; qoff = 1536 + (g * 4 + w) * 64; koff = 2048 + g * 64; voff = 2176 + g * 64;
      ocol = 512 + (g * 4 + w) * 64; lat_tiles = 32; lat_row0 = b * SEQ;
    } else if (item < n_gqa + n_na) {
      const int it = item - n_gqa;
      b = it >> 7; hN = (it >> 4) & 7;
      const int rp = it & 15;
      na = true; r_w = 2 * rp + (w >> 1);
      qrow0 = b * SEQ + r_w * 64 + (w & 1) * 32; qoff = hN * 64; koff = 512 + hN * 64; voff = 1024 + hN * 64; ocol = hN * 64;
      const int s0 = min(max(2 * rp - 4, 0), 24), s1 = min(max(2 * rp - 3, 0), 24);
      start_w = (w >> 1) ? s1 : s0; ru0 = s0; lat_tiles = (s1 != s0) ? 9 : 8; lat_row0 = b * SEQ + ru0 * 64;
    } else if (item < n_gqa + n_na + n_cb) {
      const int it = item - n_gqa - n_na;
      b = it >> 4;
      const int g = (it >> 3) & 1, tt = it & 7;
      qrow0 = NL + b * CTXL + tt * 32; qoff = 1536 + (g * 4 + w) * 64; koff = 2048 + g * 64; voff = 2176 + g * 64;
      ocol = 512 + (g * 4 + w) * 64; lat_tiles = 0; lat_row0 = 0;
    } else {
      const int it = item - n_gqa - n_na - n_cb;
      b = it >> 4;
      const int h = (it >> 1) & 7, half = it & 1;
      qrow0 = NL + b * CTXL + half * 128 + w * 32; qoff = h * 64; koff = 512 + h * 64; voff = 1024 + h * 64; ocol = h * 64;
      lat_tiles = 0; lat_row0 = 0;
    }
    const int ctx_row0 = NL + b * CTXL, ntiles = lat_tiles + 4;
    if (na)
      for (int i = tid; i < 465; i += NTHR) bias_lds[i] = p->na_rpb[(j * 8 + hN) * 465 + i] * LOG2E;
    bf16x8 qf[4];
    {
      const bf16_t* qp = p->P + (size_t)(qrow0 + r32) * LDP + qoff + hi * 8;
#pragma unroll
      for (int d0 = 0; d0 < 4; ++d0) qf[d0] = *(const bf16x8*)(qp + d0 * 16);
    }
    f32x16 o0, o1;
#pragma unroll
    for (int q = 0; q < 16; ++q) { o0[q] = 0.f; o1[q] = 0.f; }
    float m = -INFINITY, l = 0.f;
    u32x4 kr0, kr1, vr0, vr1;
    auto gload = [&](int t) {
      const int row0 = t < lat_tiles ? lat_row0 + 64 * t : ctx_row0 + 64 * (t - lat_tiles);
      const bf16_t* base = p->P + (size_t)(row0 + sr) * LDP + c * 8;
      kr0 = *(const u32x4*)(base + koff); kr1 = *(const u32x4*)(base + (size_t)32 * LDP + koff);
      vr0 = *(const u32x4*)(base + voff); vr1 = *(const u32x4*)(base + (size_t)32 * LDP + voff);
    };
    auto swrite = [&](int buf) {
      char* Kb = lds + buf * 16384;
      char* Vb = Kb + 8192;
      *(u32x4*)(Kb + sr * 128 + kso) = kr0; *(u32x4*)(Kb + (sr + 32) * 128 + kso) = kr1;
      *(u32x4*)(Vb + vso + sr * 64) = vr0; *(u32x4*)(Vb + vso + (sr + 32) * 64) = vr1;
    };
    gload(0);
    swrite(0);
    for (int t = 0; t < ntiles; ++t) {
      __syncthreads();
      if (t + 1 < ntiles) gload(t + 1);
      const bool na_tile = na && t < lat_tiles;
      const int kr = ru0 + t;
      const bool part = !na_tile || (kr >= start_w && kr < start_w + 8);
      if (part) {
        const char* Ks = lds + (t & 1) * 16384;
        const char* Vs = Ks + 8192;
        f32x16 s0, s1;
#pragma unroll
        for (int q = 0; q < 16; ++q) { s0[q] = 0.f; s1[q] = 0.f; }
#pragma unroll
        for (int d0 = 0; d0 < 4; ++d0) {
          const int off = ((2 * d0 + hi) ^ sw) * 16;
          const bf16x8 k0 = *(const bf16x8*)(Ks + r32 * 128 + off);
          const bf16x8 k1 = *(const bf16x8*)(Ks + (32 + r32) * 128 + off);
          s0 = MFMA32(k0, qf[d0], s0);
          s1 = MFMA32(k1, qf[d0], s1);
        }
        float mx = -INFINITY;
        if (na_tile) {
          const int cq = (w & 1) * 32 + r32;
          const int c0 = min(max(cq - 8, 0), 48);
          const float* brow = bias_lds + (kr - r_w + 7) * 31 + (15 - cq);
#pragma unroll
          for (int q = 0; q < 16; ++q) {
            const int kc = (q & 3) + 8 * (q >> 2) + 4 * hi;
            const float v0 = ((unsigned)(kc - c0) < 16u) ? fmaf(s0[q], C2, brow[kc]) : -INFINITY;
            const float v1 = ((unsigned)(kc + 32 - c0) < 16u) ? fmaf(s1[q], C2, brow[kc + 32]) : -INFINITY;
            s0[q] = v0; s1[q] = v1;
            mx = fmaxf(mx, fmaxf(v0, v1));
          }
        } else {
#pragma unroll
          for (int q = 0; q < 16; ++q) {
            s0[q] *= C2; s1[q] *= C2;
            mx = fmaxf(mx, fmaxf(s0[q], s1[q]));
          }
        }
        {
          auto rr = __builtin_amdgcn_permlane32_swap(__float_as_uint(mx), __float_as_uint(mx), false, false);
          mx = fmaxf(__uint_as_float(rr[0]), __uint_as_float(rr[1]));
        }
        const float mnew = fmaxf(m, mx);
        const float alpha = __builtin_amdgcn_exp2f(m - mnew);
        float ls = 0.f;
#pragma unroll
        for (int q = 0; q < 16; ++q) {
          s0[q] = __builtin_amdgcn_exp2f(s0[q] - mnew);
          s1[q] = __builtin_amdgcn_exp2f(s1[q] - mnew);
          ls += s0[q] + s1[q];
        }
        l = l * alpha + ls;
        m = mnew;
#pragma unroll
        for (int q = 0; q < 16; ++q) { o0[q] *= alpha; o1[q] *= alpha; }
        bf16x8 pf[4];
#pragma unroll
        for (int s = 0; s < 4; ++s) {
          const int u = (s & 1) * 8;
          u32x4 tpk;
          if (s < 2) {
            tpk.x = pk_bf16(s0[u + 0], s0[u + 1]); tpk.y = pk_bf16(s0[u + 2], s0[u + 3]);
            tpk.z = pk_bf16(s0[u + 4], s0[u + 5]); tpk.w = pk_bf16(s0[u + 6], s0[u + 7]);
          } else {
            tpk.x = pk_bf16(s1[u + 0], s1[u + 1]); tpk.y = pk_bf16(s1[u + 2], s1[u + 3]);
            tpk.z = pk_bf16(s1[u + 4], s1[u + 5]); tpk.w = pk_bf16(s1[u + 6], s1[u + 7]);
          }
          pf[s] = __builtin_bit_cast(bf16x8, tpk);
        }
        const char* vb = Vs + ((lane >> 4) & 1) * 32 + (lane & 3) * 8 + ((lane & 15) >> 2) * 64 + hi * 256;
#pragma unroll
        for (int s = 0; s < 4; ++s) {
          const s16x4 a00 = vtr(vb + (16 * s) * 64), a01 = vtr(vb + (16 * s + 8) * 64);
          const s16x4 a10 = vtr(vb + 4096 + (16 * s) * 64), a11 = vtr(vb + 4096 + (16 * s + 8) * 64);
          const bf16x8 A0 = __builtin_shufflevector(a00, a01, 0, 1, 2, 3, 4, 5, 6, 7);
          const bf16x8 A1 = __builtin_shufflevector(a10, a11, 0, 1, 2, 3, 4, 5, 6, 7);
          o0 = MFMA32(A0, pf[s], o0);
          o1 = MFMA32(A1, pf[s], o1);
        }
      }
      if (t + 1 < ntiles) swrite((t + 1) & 1);
    }
    __syncthreads();
    const float lt = l + __shfl_xor(l, 32);
    const float inv = 1.f / lt;
    bf16_t* op = p->AB + (size_t)(qrow0 + r32) * DM + ocol + 4 * hi;
#pragma unroll
    for (int g = 0; g < 4; ++g) {
      u32x2 v0, v1;
      v0.x = pk_bf16(o0[4 * g] * inv, o0[4 * g + 1] * inv); v0.y = pk_bf16(o0[4 * g + 2] * inv, o0[4 * g + 3] * inv);
      v1.x = pk_bf16(o1[4 * g] * inv, o1[4 * g + 1] * inv); v1.y = pk_bf16(o1[4 * g + 2] * inv, o1[4 * g + 3] * inv);
      *(u32x2*)(op + 8 * g) = v0;
      *(u32x2*)(op + 32 + 8 * g) = v1;
    }
  }
}

__device__ void ph_rwkv_mix(KP p, int layer) {
  const int j = layer >> 1;
  const int tid = opaque_tid();
  const int lane = tid & 63, wave = tid >> 6;
  const float* mu = p->rwkv_mu + j * 6 * 512;
  const int c0 = lane * 8;
  auto unpack = [](const u32x4 u, float (&f)[8]) {
    f[0] = bflo(u.x); f[1] = bfhi(u.x); f[2] = bflo(u.y); f[3] = bfhi(u.y);
    f[4] = bflo(u.z); f[5] = bfhi(u.z); f[6] = bflo(u.w); f[7] = bfhi(u.w);
  };
  auto pack = [](const float (&f)[8]) {
    u32x4 o;
    o.x = pk_bf16(f[0], f[1]); o.y = pk_bf16(f[2], f[3]); o.z = pk_bf16(f[4], f[5]); o.w = pk_bf16(f[6], f[7]);
    return o;
  };
  for (int t = blockIdx.x * 4 + wave; t < NT; t += gridDim.x * 4) {
    bool hasp, hasn;
    if (t < NL) { int s = t & 2047; hasp = s > 0; hasn = s < SEQ - 1; }
    else { int s = (t - NL) & 255; hasp = s > 0; hasn = s < CTXL - 1; }
    const bf16_t* pt = p->P + (size_t)t * LDP + c0;
    bf16_t* rw = p->RW + (size_t)t * RWS + c0;
    bf16_t* zb = p->Zb + (size_t)t * 1536 + c0;
    const u32x4 zero = {0u, 0u, 0u, 0u};
#pragma unroll
    for (int q = 0; q < 4; ++q) {
      float cur[8], pv[8], nx[8], d[8];
      unpack(*(const u32x4*)(pt + q * 512), cur);
      unpack(hasp ? *(const u32x4*)(pt + q * 512 - LDP) : zero, pv);
      unpack(hasn ? *(const u32x4*)(pt + q * 512 + LDP) : zero, nx);
#pragma unroll
      for (int e = 0; e < 8; ++e) d[e] = 0.5f * (pv[e] + nx[e]) - cur[e];
      if (q < 3) {
        float o[8];
        const float* m = mu + q * 512 + c0;
#pragma unroll
        for (int e = 0; e < 8; ++e) o[e] = cur[e] + d[e] * m[e];
        if (q == 0) *(u32x4*)(rw) = pack(o);
        else if (q == 2) *(u32x4*)(rw + 512) = pack(o);
        else {
          *(u32x4*)(rw + 10 * 512) = pack(o);
          float kk[8], ss = 0.f;
          const float* kv0 = p->rwkv_kvec + (j * 2 + 0) * 512 + c0;
#pragma unroll
          for (int e = 0; e < 8; ++e) { kk[e] = o[e] * kv0[e]; ss += kk[e] * kk[e]; }
          ss += dppx<0xB1>(ss); ss += dppx<0x4E>(ss); ss += dppx<0x141>(ss);
          const float rn = rsqrtf(fmaxf(ss, 1e-24f));
#pragma unroll
          for (int e = 0; e < 8; ++e) kk[e] *= rn;
          *(u32x4*)(rw + 2 * 512) = pack(kk);
        }
      } else {
#pragma unroll
        for (int z = 0; z < 3; ++z) {
          float o[8];
          const float* m = mu + (3 + z) * 512 + c0;
#pragma unroll
          for (int e = 0; e < 8; ++e) o[e] = cur[e] + d[e] * m[e];
          *(u32x4*)(zb + z * 512) = pack(o);
        }
      }
    }
  }
}

constexpr int RS_STEP = 384;
constexpr int RS_TB = 16;
struct RwkvStage { u32x2 r, kk, e, ke, a, v; };
__device__ void rwkv_unit(KP p, int unit, float* sm, int tid) {
  const int ch = unit >> 1, hf = unit & 1;
  const int dir = ch >> 6, b = (ch >> 3) & 7, h = ch & 7;
  const int lane = tid & 63, w = tid >> 6, rl = lane >> 3, ks = lane & 7;
  float* ybuf = sm + 2 * RS_TB * RS_STEP;
  const int ss = tid >> 4, kq = tid & 15;
  auto gload = [&](int n, RwkvStage& g) {
    const int row = scan_row(dir, b, n * RS_TB + ss);
    const bf16_t* base = p->RW + (size_t)row * RWS + h * 64 + kq * 4;
    g.r = *(const u32x2*)(base);
    g.kk = *(const u32x2*)(base + 2 * 512);
    g.e = *(const u32x2*)(base + (3 + dir) * 512);
    g.ke = *(const u32x2*)(base + (5 + dir) * 512);
    g.a = *(const u32x2*)(base + (7 + dir) * 512);
    g.v = *(const u32x2*)(p->RW + (size_t)row * RWS + 512 + h * 64 + hf * 32 + (kq & 7) * 4);
  };
  auto swrite = [&](int buf, const RwkvStage& g) {
    float* sp = sm + (buf * RS_TB + ss) * RS_STEP;
    const float r0 = bflo(g.r.x), r1 = bfhi(g.r.x), r2 = bflo(g.r.y), r3 = bfhi(g.r.y);
    const float k0 = bflo(g.kk.x), k1 = bfhi(g.kk.x), k2 = bflo(g.kk.y), k3 = bfhi(g.kk.y);
    const float w0 = __expf(-bflo(g.e.x)), w1 = __expf(-bfhi(g.e.x)), w2 = __expf(-bflo(g.e.y)), w3 = __expf(-bfhi(g.e.y));
    const float e0 = bflo(g.ke.x), e1 = bfhi(g.ke.x), e2 = bflo(g.ke.y), e3 = bfhi(g.ke.y);
    const float a0 = k0 * bflo(g.a.x), a1 = k1 * bfhi(g.a.x), a2 = k2 * bflo(g.a.y), a3 = k3 * bfhi(g.a.y);
    *(float4*)(sp + kq * 4) = make_float4(k0, k1, k2, k3);
    *(float4*)(sp + 64 + kq * 4) = make_float4(w0 * r0, w1 * r1, w2 * r2, w3 * r3);
    *(float4*)(sp + 128 + kq * 4) = make_float4(w0, w1, w2, w3);
    *(float4*)(sp + 192 + kq * 4) = make_float4(a0, a1, a2, a3);
    *(float4*)(sp + 256 + kq * 4) = make_float4(e0, e1, e2, e3);
    if (kq < 8) *(float4*)(sp + 320 + kq * 4) = make_float4(bflo(g.v.x), bfhi(g.v.x), bflo(g.v.y), bfhi(g.v.y));
    float c1 = a0 * r0 + a1 * r1 + a2 * r2 + a3 * r3;
    float c2 = e0 * r0 + e1 * r1 + e2 * r2 + e3 * r3;
    c1 += dppx<0xB1>(c1); c2 += dppx<0xB1>(c2);
    c1 += dppx<0x4E>(c1); c2 += dppx<0x4E>(c2);
    c1 += dppx<0x141>(c1); c2 += dppx<0x141>(c2);
    c1 += dppx<0x140>(c1); c2 += dppx<0x140>(c2);
    if (kq == 0) { sp[352] = c1; sp[353] = c2; }
  };
  typedef float f2 __attribute__((ext_vector_type(2)));
  f2 S01 = {0.f, 0.f}, S23 = {0.f, 0.f}, S45 = {0.f, 0.f}, S67 = {0.f, 0.f};
  auto compute = [&](int n) {
    const float* bp = sm + (n & 1) * RS_TB * RS_STEP;
    float* yb = ybuf + (n & 1) * RS_TB * 32 + w * 8 + rl;
    struct Ops { f2 k[4], r[4], w[4], a[4], e[4]; float vv; f2 c; };
    auto ld = [&](int s, Ops& o) {
      const float* sq = bp + s * RS_STEP;
      const f2* sp = (const f2*)(sq + ks * 8);
#pragma unroll
      for (int i = 0; i < 4; ++i) { o.k[i] = sp[i]; o.r[i] = sp[32 + i]; o.w[i] = sp[64 + i]; o.a[i] = sp[96 + i]; o.e[i] = sp[128 + i]; }
      o.vv = sq[320 + w * 8 + rl]; o.c = *(const f2*)(sq + 352);
    };
    auto step = [&](const Ops& o) -> float {
      f2 sa2 = S01 * o.k[0];
      f2 y2 = S01 * o.r[0];
      sa2 = __builtin_elementwise_fma(S23, o.k[1], sa2); y2 = __builtin_elementwise_fma(S23, o.r[1], y2);
      sa2 = __builtin_elementwise_fma(S45, o.k[2], sa2); y2 = __builtin_elementwise_fma(S45, o.r[2], y2);
      sa2 = __builtin_elementwise_fma(S67, o.k[3], sa2); y2 = __builtin_elementwise_fma(S67, o.r[3], y2);
      float sa = sa2.x + sa2.y, y0 = y2.x + y2.y;
      sa += dppx<0xB1>(sa); y0 += dppx<0xB1>(y0);
      sa += dppx<0x4E>(sa); y0 += dppx<0x4E>(y0);
      sa += dppx<0x141>(sa); y0 += dppx<0x141>(y0);
      sa = -sa;
      const f2 sav = {sa, sa}, vvv = {o.vv, o.vv};
      S01 = __builtin_elementwise_fma(vvv, o.e[0], __builtin_elementwise_fma(sav, o.a[0], S01 * o.w[0]));
      S23 = __builtin_elementwise_fma(vvv, o.e[1], __builtin_elementwise_fma(sav, o.a[1], S23 * o.w[1]));
      S45 = __builtin_elementwise_fma(vvv, o.e[2], __builtin_elementwise_fma(sav, o.a[2], S45 * o.w[2]));
      S67 = __builtin_elementwise_fma(vvv, o.e[3], __builtin_elementwise_fma(sav, o.a[3], S67 * o.w[3]));
      return fmaf(o.vv, o.c.y, fmaf(sa, o.c.x, y0));
    };
    Ops oa, ob;
    ld(0, oa);
#pragma unroll 1
    for (int s = 0; s < RS_TB; s += 2) {
      __builtin_amdgcn_sched_barrier(0);
      ld(s + 1, ob);
      __builtin_amdgcn_sched_barrier(0);
      float y0 = step(oa);
      asm volatile("" : "+v"(y0));
      __builtin_amdgcn_sched_barrier(0);
      ld(s + 2, oa);
      __builtin_amdgcn_sched_barrier(0);
      float y1 = step(ob);
      asm volatile("" : "+v"(y1));
      __builtin_amdgcn_sched_barrier(0);
      if (ks == 0) { yb[s * 32] = y0; yb[(s + 1) * 32] = y1; }
    }
  };
  auto yout = [&](int n) {
    const int row = scan_row(dir, b, n * RS_TB + ss);
    const float* ys = ybuf + (n & 1) * RS_TB * 32 + ss * 32 + kq * 2;
    *(unsigned*)(p->P + (size_t)row * LDP + dir * 512 + h * 64 + hf * 32 + kq * 2) = pk_bf16(ys[0], ys[1]);
  };
  constexpr int NB = TSC / RS_TB;
  RwkvStage gA, gB;
  gload(0, gA);
  gload(1, gB);
  swrite(0, gA);
  gload(2, gA);
  __syncthreads();
  for (int n = 0; n < NB; n += 2) {
    compute(n);
    swrite(1, gB);
    if (n + 3 < NB) gload(n + 3, gB);
    __syncthreads();
    yout(n);
    compute(n + 1);
    if (n + 2 < NB) swrite(0, gA);
    if (n + 4 < NB) gload(n + 4, gA);
    __syncthreads();
    yout(n + 1);
  }
  __syncthreads();
}

__device__ void mlstm_s1(KP p, int layer, int tile, char* lds, int tid) {
  const int j = layer >> 1;
  const int ch = tile / NCHUNK, c = tile % NCHUNK;
  const int dir = ch >> 5, b = (ch >> 2) & 7, h = ch & 3;
  float* s_ws = (float*)(lds + META_OFF);
  int* s_row = (int*)(s_ws + 64);
  char* kimg = lds;
  char* vimg = lds + 16384;
  if (tid < 64) {
    const int row = scan_row(dir, b, c * 64 + tid);
    s_row[tid] = row;
    const float* g = p->GP + (size_t)row * 16;
    const float gi = g[(dir * 2) * 4 + h] + p->mlstm_gate_b[j * 16 + (dir * 2) * 4 + h];
    const float gf = g[(dir * 2 + 1) * 4 + h] + p->mlstm_gate_b[j * 16 + (dir * 2 + 1) * 4 + h];
    float bc = -softplus_f(-gf);
#pragma unroll
    for (int o = 1; o < 64; o <<= 1) {
      float tmp = __shfl_up(bc, o);
      if (tid >= o) bc += tmp;
    }
    const float bend = __shfl(bc, 63);
    const float ds = bend - bc + gi;
    const float mloc = wmax(ds);
    s_ws[tid] = expf(ds - mloc);
    if (tid == 0) { p->msc[tile] = mloc; p->msc[NMT + tile] = bend; }
  }
  __syncthreads();
  {
    const int c8 = tid & 15;
    const int ioff = (c8 >> 2) * 4096 + (c8 & 3) * 16;
#pragma unroll
    for (int i = 0; i < 4; ++i) {
      const int sidx = (tid >> 4) + 16 * i;
      const bf16_t* src = p->P + (size_t)s_row[sidx] * LDP + h * 128 + c8 * 8;
      const u32x4 kv = *(const u32x4*)(src + 2560);
      u32x4 vv = *(const u32x4*)(src + 3072);
      const float wsv = s_ws[sidx];
      vv.x = pk_bf16(bflo(vv.x) * wsv, bfhi(vv.x) * wsv); vv.y = pk_bf16(bflo(vv.y) * wsv, bfhi(vv.y) * wsv);
      vv.z = pk_bf16(bflo(vv.z) * wsv, bfhi(vv.z) * wsv); vv.w = pk_bf16(bflo(vv.w) * wsv, bfhi(vv.w) * wsv);
      *(u32x4*)(kimg + ioff + sidx * 64) = kv;
      *(u32x4*)(vimg + ioff + sidx * 64) = vv;
    }
  }
  __syncthreads();
  const int lane = tid & 63, w = tid >> 6, wm = w >> 1, wn = w & 1, r32 = lane & 31, hi = lane >> 5;
  f32x16 acc[2][2];
#pragma unroll
  for (int mi = 0; mi < 2; ++mi)
#pragma unroll
    for (int ni = 0; ni < 2; ++ni)
#pragma unroll
      for (int q = 0; q < 16; ++q) acc[mi][ni][q] = 0.f;
  const int toff = ((lane >> 4) & 1) * 32 + (lane & 3) * 8 + ((lane & 15) >> 2) * 64 + hi * 256;
#pragma unroll
  for (int ks = 0; ks < 4; ++ks) {
    bf16x8 af[2], bfr[2];
#pragma unroll
    for (int i = 0; i < 2; ++i) {
      const char* ka = kimg + (wm * 2 + i) * 4096 + toff + (16 * ks) * 64;
      const char* va = vimg + (wn * 2 + i) * 4096 + toff + (16 * ks) * 64;
      af[i] = __builtin_shufflevector(vtr(ka), vtr(ka + 8 * 64), 0, 1, 2, 3, 4, 5, 6, 7);
      bfr[i] = __builtin_shufflevector(vtr(va), vtr(va + 8 * 64), 0, 1, 2, 3, 4, 5, 6, 7);
    }
    acc[0][0] = MFMA32(af[0], bfr[0], acc[0][0]);
    acc[0][1] = MFMA32(af[0], bfr[1], acc[0][1]);
    acc[1][0] = MFMA32(af[1], bfr[0], acc[1][0]);
    acc[1][1] = MFMA32(af[1], bfr[1], acc[1][1]);
  }
  bf16_t* ust = (bf16_t*)(lds + 32768);
#pragma unroll
  for (int mi = 0; mi < 2; ++mi)
#pragma unroll
    for (int ni = 0; ni < 2; ++ni)
#pragma unroll
      for (int q = 0; q < 16; ++q) {
        const int d = wm * 64 + mi * 32 + (q & 3) + 8 * (q >> 2) + 4 * hi;
        ust[d * 128 + wn * 64 + ni * 32 + r32] = f2bf(acc[mi][ni][q]);
        if ((q & 3) == 3) __builtin_amdgcn_sched_barrier(0);
      }
  __syncthreads();
  {
    const u32x4* us4 = (const u32x4*)ust;
    u32x4* U4 = (u32x4*)(p->MS + (size_t)tile * 16384);
#pragma unroll
    for (int i = 0; i < 8; ++i) U4[tid + 256 * i] = us4[tid + 256 * i];
  }
  if (tid < 128) {
    const char* kc = kimg + (tid >> 5) * 4096 + (tid & 31) * 2;
    float a = 0.f;
#pragma unroll 8
    for (int sidx = 0; sidx < 64; ++sidx) a = fmaf(s_ws[sidx], bf2f(*(const bf16_t*)(kc + sidx * 64)), a);
    p->MSn[tile * 128 + tid] = a;
  }
}

__device__ void mlstm_s3(KP p, int layer, int tile, char* lds, int tid);
__device__ void ph_scan_a(KP p, int layer, char* smc) {
  float* sm = (float*)smc;
  const int tid = opaque_tid();
  __builtin_amdgcn_s_setprio(3);
  for (int u = blockIdx.x; u < 256; u += gridDim.x) rwkv_unit(p, u, sm, tid);
  __builtin_amdgcn_s_setprio(0);
  {
    const int stage = layer == 1 ? 1 : 2;
    const int nconv = conv_stage_total(stage);
    const int total = NMT + (nconv + 7) / 8;
    int* qc = (int*)(p->bar + XCD_BAR_WORDS + 16 * stage);
    int* s_q = (int*)(smc + META_OFF + 3968);
    int jj = 0, j1 = 0;
#pragma unroll 1
    for (;;) {
      if (jj >= j1) {
        __syncthreads();
        if (tid == 0) *s_q = atomicAdd(qc, 1);
        __syncthreads();
        const int q = *s_q;
        if (q >= total) break;
        if (q < NMT) { mlstm_s3(p, layer, q, smc, tid); continue; }
        jj = (q - NMT) * 8; j1 = min(jj + 8, nconv);
      }
      convert_run(p, stage, jj, j1, sm, tid);
      jj = j1;
    }
  }
}

__device__ void ph_mlstm_s2(KP p, char* smc) {
  float* sw = (float*)smc;
  const int tid = opaque_tid();
  const int nitems = 64 * 33;
  for (int item = blockIdx.x; item < nitems; item += gridDim.x) {
    const int ch = item / 33, seg = item % 33;
    __syncthreads();
    if (tid < 2 * NCHUNK) sw[72 + tid] = p->msc[(tid < NCHUNK ? 0 : NMT - NCHUNK) + ch * NCHUNK + tid];
    __syncthreads();
    if (tid == 0) {
      float m = 0.f;
      for (int c = 0; c < NCHUNK; ++c) {
        const int tile = ch * NCHUNK + c;
        const float mloc = sw[72 + c], bend = sw[72 + NCHUNK + c];
        const float mn = fmaxf(bend + m, mloc);
        sw[c] = expf(bend + m - mn);
        sw[36 + c] = expf(mloc - mn);
        if (seg == 0) p->msc[2 * NMT + tile] = m;
        m = mn;
      }
    }
    __syncthreads();
    if (seg < 32) {
      unsigned* base = (unsigned*)(p->MS + (size_t)ch * NCHUNK * 16384) + seg * 256 + tid;
      unsigned v[NCHUNK];
#pragma unroll
      for (int c = 0; c < NCHUNK; ++c) v[c] = base[(size_t)c * 8192];
      float C0 = 0.f, C1 = 0.f;
#pragma unroll
      for (int c = 0; c < NCHUNK; ++c) {
        const float t0 = bflo(v[c]), t1 = bfhi(v[c]);
        v[c] = pk_bf16(C0, C1);
        C0 = sw[c] * C0 + sw[36 + c] * t0;
        C1 = sw[c] * C1 + sw[36 + c] * t1;
      }
#pragma unroll
      for (int c = 0; c < NCHUNK; ++c) base[(size_t)c * 8192] = v[c];
    } else if (tid < 128) {
      float* base = p->MSn + (size_t)ch * NCHUNK * 128 + tid;
      float v[NCHUNK];
#pragma unroll
      for (int c = 0; c < NCHUNK; ++c) v[c] = base[c * 128];
      float C = 0.f;
#pragma unroll
      for (int c = 0; c < NCHUNK; ++c) {
        const float t0 = v[c];
        v[c] = C;
        C = sw[c] * C + sw[36 + c] * t0;
      }
#pragma unroll
      for (int c = 0; c < NCHUNK; ++c) base[c * 128] = v[c];
    }
  }
}

__device__ void mlstm_s3(KP p, int layer, int tile, char* lds, int tid) {
  const int j = layer >> 1;
  const int ch = tile / NCHUNK, c = tile % NCHUNK;
  const int dir = ch >> 5, b = (ch >> 2) & 7, h = ch & 3;
  float* s_b = (float*)(lds + META_OFF);
  float* s_ig = s_b + 64;
  float* s_mt = s_b + 128;
  float* s_wi = s_b + 192;
  int* s_row = (int*)(s_b + 256);
  float* s_n = s_b + 320;
  float* s_c = s_b + 448;
  char* kimg = lds;
  char* vimg = lds + 16384;
  char* cimg = lds + 32768;
  const float mprev = p->msc[2 * NMT + tile];
  const float qscale = 0.08838834764831845f;
  const int lane = tid & 63, w = tid >> 6, wt = w >> 1, wv = w & 1, r32 = lane & 31, hi = lane >> 5;
  const int t = wt * 32 + r32;
  const int rowq = scan_row(dir, b, c * 64 + t);
  const int c8 = tid & 15;
  u32x4 kr[4], vr[4], cr[8];
#pragma unroll
  for (int i = 0; i < 4; ++i) {
    const int sidx = (tid >> 4) + 16 * i;
    const bf16_t* src = p->P + (size_t)scan_row(dir, b, c * 64 + sidx) * LDP + h * 128 + c8 * 8;
    kr[i] = *(const u32x4*)(src + 2560);
    vr[i] = *(const u32x4*)(src + 3072);
  }
  {
    const bf16_t* Cp = p->MS + (size_t)tile * 16384;
#pragma unroll
    for (int i = 0; i < 8; ++i) cr[i] = *(const u32x4*)(Cp + ((tid >> 4) + 16 * i) * 128 + c8 * 8);
  }
  bf16x8 qf[8];
  {
    const bf16_t* qp = p->P + (size_t)rowq * LDP + 2048 + h * 128 + hi * 8;
#pragma unroll
    for (int d0 = 0; d0 < 8; ++d0) qf[d0] = *(const bf16x8*)(qp + d0 * 16);
  }
  if (tid < 64) {
    const int row = scan_row(dir, b, c * 64 + tid);
    s_row[tid] = row;
    const float* g = p->GP + (size_t)row * 16;
    const float gi = g[(dir * 2) * 4 + h] + p->mlstm_gate_b[j * 16 + (dir * 2) * 4 + h];
    const float gf = g[(dir * 2 + 1) * 4 + h] + p->mlstm_gate_b[j * 16 + (dir * 2 + 1) * 4 + h];
    float bc = -softplus_f(-gf);
#pragma unroll
    for (int o = 1; o < 64; o <<= 1) {
      float tmp = __shfl_up(bc, o);
      if (tid >= o) bc += tmp;
    }
    float pm = gi - bc;
#pragma unroll
    for (int o = 1; o < 64; o <<= 1) {
      float tmp = __shfl_up(pm, o);
      if (tid >= o) pm = fmaxf(pm, tmp);
    }
    const float mt = bc + fmaxf(mprev, pm);
    s_b[tid] = bc;
    s_ig[tid] = gi;
    s_mt[tid] = mt;
    s_wi[tid] = expf(bc + mprev - mt);
    s_c[tid] = (gi - bc) * 1.4426950408889634f;
  } else if (tid < 192) s_n[tid - 64] = p->MSn[tile * 128 + (tid - 64)];
  {
    const int ioff = (c8 >> 2) * 4096 + (c8 & 3) * 16;
#pragma unroll
    for (int i = 0; i < 4; ++i) {
      const int sidx = (tid >> 4) + 16 * i;
      *(u32x4*)(kimg + sidx * 256 + ((c8 ^ (sidx & 15)) * 16)) = kr[i];
      *(u32x4*)(vimg + ioff + sidx * 64) = vr[i];
    }
    const int coff = (c8 >> 2) * 8192 + (c8 & 3) * 16;
#pragma unroll
    for (int i = 0; i < 8; ++i) *(u32x4*)(cimg + coff + ((tid >> 4) + 16 * i) * 64) = cr[i];
  }
  __syncthreads();
  const int toff = ((lane >> 4) & 1) * 32 + (lane & 3) * 8 + ((lane & 15) >> 2) * 64;
  constexpr float LOG2E_ = 1.4426950408889634f;
  float qn = 0.f;
#pragma unroll
  for (int d0 = 0; d0 < 8; ++d0) {
    const u32x4 qq = __builtin_bit_cast(u32x4, qf[d0]);
    const float* np = s_n + d0 * 16 + hi * 8;
    qn = fmaf(bflo(qq.x), np[0], qn); qn = fmaf(bfhi(qq.x), np[1], qn);
    qn = fmaf(bflo(qq.y), np[2], qn); qn = fmaf(bfhi(qq.y), np[3], qn);
    qn = fmaf(bflo(qq.z), np[4], qn); qn = fmaf(bfhi(qq.z), np[5], qn);
    qn = fmaf(bflo(qq.w), np[6], qn); qn = fmaf(bfhi(qq.w), np[7], qn);
  }
  qn += __shfl_xor(qn, 32);
  const float mtt = s_mt[t], wi = s_wi[t];
  const float ct = (s_b[t] - mtt) * LOG2E_;
  const float wq = wi * qscale;
  bf16x8 pf[4];
  float den = 0.f;
  {
    f32x16 sa0, sa1;
#pragma unroll
    for (int q = 0; q < 16; ++q) { sa0[q] = 0.f; sa1[q] = 0.f; }
#pragma unroll
    for (int d0 = 0; d0 < 8; ++d0) {
      const int chn = 2 * d0 + hi;
      const bf16x8 k0 = *(const bf16x8*)(kimg + r32 * 256 + ((chn ^ (r32 & 15)) * 16));
      sa0 = MFMA32(k0, qf[d0], sa0);
      if (wt) {
        const bf16x8 k1 = *(const bf16x8*)(kimg + (32 + r32) * 256 + ((chn ^ (r32 & 15)) * 16));
        sa1 = MFMA32(k1, qf[d0], sa1);
      }
      __builtin_amdgcn_sched_barrier(0);
    }
#pragma unroll
    for (int g = 0; g < 4; ++g) {
      const int sb0 = 8 * g + 4 * hi;
      const float4 c0v = *(const float4*)(s_c + sb0);
      const float4 c1v = *(const float4*)(s_c + sb0 + 32);
      const float cc0[4] = {c0v.x, c0v.y, c0v.z, c0v.w}, cc1[4] = {c1v.x, c1v.y, c1v.z, c1v.w};
#pragma unroll
      for (int e = 0; e < 4; ++e) {
        const int q = 4 * g + e;
        const float v0 = (sb0 + e <= t) ? sa0[q] * qscale * __builtin_amdgcn_exp2f(ct + cc0[e]) : 0.f;
        sa0[q] = v0; den += v0;
        const float v1 = (wt && sb0 + 32 + e <= t) ? sa1[q] * qscale * __builtin_amdgcn_exp2f(ct + cc1[e]) : 0.f;
        sa1[q] = v1; den += v1;
      }
      __builtin_amdgcn_sched_barrier(0);
    }
#pragma unroll
    for (int sx = 0; sx < 4; ++sx) {
      const int u = (sx & 1) * 8;
      u32x4 tpk;
      if (sx < 2) {
        tpk.x = pk_bf16(sa0[u + 0], sa0[u + 1]); tpk.y = pk_bf16(sa0[u + 2], sa0[u + 3]);
        tpk.z = pk_bf16(sa0[u + 4], sa0[u + 5]); tpk.w = pk_bf16(sa0[u + 6], sa0[u + 7]);
      } else {
        tpk.x = pk_bf16(sa1[u + 0], sa1[u + 1]); tpk.y = pk_bf16(sa1[u + 2], sa1[u + 3]);
        tpk.z = pk_bf16(sa1[u + 4], sa1[u + 5]); tpk.w = pk_bf16(sa1[u + 6], sa1[u + 7]);
      }
      pf[sx] = __builtin_bit_cast(bf16x8, tpk);
    }
  }
  den += __shfl_xor(den, 32);
  const float dtot = den + wq * qn;
  const float inv = 1.f / fmaxf(fabsf(dtot), expf(-mtt));
  bf16_t* op = p->P + (size_t)rowq * LDP + 1024 + dir * 512 + h * 128 + wv * 64 + 4 * hi;
#pragma unroll 1
  for (int vp = 0; vp < 2; ++vp) {
    f32x16 o0;
#pragma unroll
    for (int q = 0; q < 16; ++q) o0[q] = 0.f;
    const char* cb = cimg + (wv * 2 + vp) * 8192 + toff + hi * 512;
#pragma unroll
    for (int d0 = 0; d0 < 8; ++d0) {
      const bf16x8 A0 = __builtin_shufflevector(vtr(cb + (16 * d0) * 64), vtr(cb + (16 * d0 + 4) * 64), 0, 1, 2, 3, 4, 5, 6, 7);
      o0 = MFMA32(A0, qf[d0], o0);
    }
#pragma unroll
    for (int q = 0; q < 16; ++q) o0[q] *= wq;
    const char* vb = vimg + (wv * 2 + vp) * 4096 + toff + hi * 256;
#pragma unroll
    for (int sx = 0; sx < 4; ++sx) {
      if (sx < 2 || wt) {
        const bf16x8 A0 = __builtin_shufflevector(vtr(vb + (16 * sx) * 64), vtr(vb + (16 * sx + 8) * 64), 0, 1, 2, 3, 4, 5, 6, 7);
        o0 = MFMA32(A0, pf[sx], o0);
      }
    }
#pragma unroll
    for (int g = 0; g < 4; ++g) {
      u32x2 v0;
      v0.x = pk_bf16(o0[4 * g] * inv, o0[4 * g + 1] * inv); v0.y = pk_bf16(o0[4 * g + 2] * inv, o0[4 * g + 3] * inv);
      *(u32x2*)(op + vp * 32 + 8 * g) = v0;
    }
  }
}

__device__ void ph_mlstm_s1(KP p, int layer, char* smc) {
  const int tid = opaque_tid();
  __syncthreads();
  for (int tile = blockIdx.x; tile < NMT; tile += gridDim.x) { mlstm_s1(p, layer, tile, smc, tid); __syncthreads(); }
}

__device__ void ph_rec_final(KP p, int layer, bool keep) {
  const int tid = opaque_tid();
  const int j = layer >> 1;
  const int lane = tid & 63, wave = tid >> 6;
  const int rows = keep ? NT : NL;
  const int c0 = lane * 8;
  auto unpack = [](const u32x4 u, float (&f)[8]) {
    f[0] = bflo(u.x); f[1] = bfhi(u.x); f[2] = bflo(u.y); f[3] = bfhi(u.y);
    f[4] = bflo(u.z); f[5] = bfhi(u.z); f[6] = bflo(u.w); f[7] = bfhi(u.w);
  };
  for (int t = blockIdx.x * 4 + wave; t < rows; t += gridDim.x * 4) {
    const bf16_t* rw = p->RW + (size_t)t * RWS + c0;
    const bf16_t* pt = p->P + (size_t)t * LDP + c0;
    bf16_t* mo = p->AB + (size_t)t * DM + c0;
    {
      float yf[8], yb[8], r[8], v[8], k0[8], k1[8], g[8], y[8], o[8];
      unpack(*(const u32x4*)(pt), yf); unpack(*(const u32x4*)(pt + 512), yb);
      unpack(*(const u32x4*)(rw), r); unpack(*(const u32x4*)(rw + 512), v);
      unpack(*(const u32x4*)(rw + 5 * 512), k0); unpack(*(const u32x4*)(rw + 6 * 512), k1);
      unpack(*(const u32x4*)(rw + 9 * 512), g);
      float s1 = 0.f, bs = 0.f;
      const float* rk = p->rwkv_rk + j * 512 + c0;
#pragma unroll
      for (int e = 0; e < 8; ++e) { y[e] = yf[e] + yb[e]; s1 += y[e]; bs += r[e] * rk[e] * (k0[e] + k1[e]); }
      s1 += dppx<0xB1>(s1); s1 += dppx<0x4E>(s1); s1 += dppx<0x141>(s1);
      bs += dppx<0xB1>(bs); bs += dppx<0x4E>(bs); bs += dppx<0x141>(bs);
      const float mu = s1 * (1.f / 64.f);
      float s2 = 0.f;
#pragma unroll
      for (int e = 0; e < 8; ++e) { const float d = y[e] - mu; s2 += d * d; }
      s2 += dppx<0xB1>(s2); s2 += dppx<0x4E>(s2); s2 += dppx<0x141>(s2);
      const float rs = rsqrtf(s2 * (1.f / 64.f) + 64e-5f);
      const float* gn0 = p->rwkv_gn + (j * 2 + 0) * 512 + c0;
      const float* gn1 = p->rwkv_gn + (j * 2 + 1) * 512 + c0;
#pragma unroll
      for (int e = 0; e < 8; ++e) o[e] = ((y[e] - mu) * rs * gn0[e] + gn1[e] + bs * v[e]) * g[e];
      u32x4 ov;
      ov.x = pk_bf16(o[0], o[1]); ov.y = pk_bf16(o[2], o[3]); ov.z = pk_bf16(o[4], o[5]); ov.w = pk_bf16(o[6], o[7]);
      *(u32x4*)(mo) = ov;
    }
    {
      float hf[8], hb[8], og[8], hsum[8], o[8];
      unpack(*(const u32x4*)(pt + 1024), hf); unpack(*(const u32x4*)(pt + 1536), hb);
      unpack(*(const u32x4*)(pt + 3584), og);
      float ss = 0.f;
#pragma unroll
      for (int e = 0; e < 8; ++e) { hsum[e] = hf[e] + hb[e]; ss += hsum[e] * hsum[e]; }
      ss += dppx<0xB1>(ss); ss += dppx<0x4E>(ss); ss += dppx<0x141>(ss); ss += dppx<0x140>(ss);
      const float rs = rsqrtf(ss * (1.f / 128.f) + 1e-6f);
      const float* ng = p->mlstm_norm + j * 512 + c0;
#pragma unroll
      for (int e = 0; e < 8; ++e) o[e] = hsum[e] * rs * ng[e] * sigm_f(og[e]);
      u32x4 ov;
      ov.x = pk_bf16(o[0], o[1]); ov.y = pk_bf16(o[2], o[3]); ov.z = pk_bf16(o[4], o[5]); ov.w = pk_bf16(o[6], o[7]);
      *(u32x4*)(mo + 512) = ov;
    }
  }
}

using f32x4v = __attribute__((ext_vector_type(4))) float;
__device__ void ph_ln_router(KP p, int layer, bool keep, char* smc) {
  float* h2s = (float*)smc;
  float* lgs = (float*)smc;
  const int tid = opaque_tid();
  const int lane = tid & 63, wave = tid >> 6;
  const int rows = keep ? NT : NL;
  const float* lng = p->ln_g + (layer * 2 + 0) * 1024;
  const float* lnb = p->ln_b + (layer * 2 + 0) * 1024;
  for (int tile = blockIdx.x; tile < rows / 16; tile += gridDim.x) {
    const int t0 = tile * 16;
    const float* mod = p->MOD + (layer * 9 + modrow(t0)) * 6144;
    const float* brow = p->WrT + ((size_t)layer * 64 + 16 * wave + (lane & 15)) * 1024 + 4 * (lane >> 4);
    f32x4v b0[8], b1[8], b2[8];
#pragma unroll
    for (int q = 0; q < 8; ++q) { b0[q] = *(const f32x4v*)(brow + 16 * q); b1[q] = *(const f32x4v*)(brow + 16 * (8 + q)); }
    __builtin_amdgcn_sched_barrier(0);
    {
      float4 v[4][4];
      float s4[4];
#pragma unroll
      for (int q = 0; q < 4; ++q) {
        const int t = t0 + wave * 4 + q;
        s4[q] = 0.f;
#pragma unroll
        for (int i = 0; i < 4; ++i) v[q][i] = *(const float4*)(p->Tb + (size_t)t * DM + i * 256 + lane * 4);
      }
#pragma unroll
      for (int q = 0; q < 4; ++q)
#pragma unroll
        for (int i = 0; i < 4; ++i) s4[q] += (v[q][i].x + v[q][i].y) + (v[q][i].z + v[q][i].w);
      float mean4[4], rs4[4];
#pragma unroll
      for (int q = 0; q < 4; ++q) mean4[q] = wsum(s4[q]) * (1.f / 1024.f);
#pragma unroll
      for (int q = 0; q < 4; ++q) {
        float qq = 0.f;
#pragma unroll
        for (int i = 0; i < 4; ++i) {
          const float d0 = v[q][i].x - mean4[q], d1 = v[q][i].y - mean4[q], d2 = v[q][i].z - mean4[q], d3 = v[q][i].w - mean4[q];
          qq += (d0 * d0 + d1 * d1) + (d2 * d2 + d3 * d3);
        }
        s4[q] = qq;
      }
#pragma unroll
      for (int q = 0; q < 4; ++q) rs4[q] = rsqrtf(wsum(s4[q]) * (1.f / 1024.f) + 1e-5f);
#pragma unroll
      for (int i = 0; i < 4; ++i) {
        const int n = i * 256 + lane * 4;
        const float4 g = *(const float4*)(lng + n), bb = *(const float4*)(lnb + n);
        const float4 sc = *(const float4*)(mod + 4096 + n), sh = *(const float4*)(mod + 3072 + n);
#pragma unroll
        for (int q = 0; q < 4; ++q) {
          const int tl = wave * 4 + q, t = t0 + tl;
          const float mean = mean4[q], rs = rs4[q];
          const float4 xn = make_float4((v[q][i].x - mean) * rs * g.x + bb.x, (v[q][i].y - mean) * rs * g.y + bb.y,
                                        (v[q][i].z - mean) * rs * g.z + bb.z, (v[q][i].w - mean) * rs * g.w + bb.w);
          *(float4*)(p->X + (size_t)t * DM + n) = xn;
          const float4 hh = make_float4(xn.x * (1.f + sc.x) + sh.x, xn.y * (1.f + sc.y) + sh.y,
                                        xn.z * (1.f + sc.z) + sh.z, xn.w * (1.f + sc.w) + sh.w);
          *(unsigned*)((unsigned char*)p->AB + (size_t)t * DM + n) = pk_fp8x4(hh.x, hh.y, hh.z, hh.w);
          *(float4*)(h2s + tl * 1028 + n) = hh;
        }
      }
    }
    __syncthreads();
    f32x4v acc = {0.f, 0.f, 0.f, 0.f};
    {
      f32x4v a1 = {0.f, 0.f, 0.f, 0.f}, a2 = {0.f, 0.f, 0.f, 0.f}, a3 = {0.f, 0.f, 0.f, 0.f};
      const int i = lane & 15, kk = lane >> 4;
      const float* arow = h2s + i * 1028 + 4 * kk;
#define ROUTER_LOAD(B, Q0) _Pragma("unroll") for (int q = 0; q < 8; ++q) B[q] = *(const f32x4v*)(brow + 16 * ((Q0) + q)); __builtin_amdgcn_sched_barrier(0);
#define ROUTER_MFMA(B, Q0) _Pragma("unroll") for (int q = 0; q < 8; ++q) { \
        const float4 a = *(const float4*)(arow + 16 * ((Q0) + q)); \
        acc = __builtin_amdgcn_mfma_f32_16x16x4f32(a.x, B[q].x, acc, 0, 0, 0); \
        a1 = __builtin_amdgcn_mfma_f32_16x16x4f32(a.y, B[q].y, a1, 0, 0, 0); \
        a2 = __builtin_amdgcn_mfma_f32_16x16x4f32(a.z, B[q].z, a2, 0, 0, 0); \
        a3 = __builtin_amdgcn_mfma_f32_16x16x4f32(a.w, B[q].w, a3, 0, 0, 0); } __builtin_amdgcn_sched_barrier(0);
      ROUTER_LOAD(b2, 16) ROUTER_MFMA(b0, 0)
      ROUTER_LOAD(b0, 24) ROUTER_MFMA(b1, 8)
      ROUTER_LOAD(b1, 32) ROUTER_MFMA(b2, 16)
      ROUTER_LOAD(b2, 40) ROUTER_MFMA(b0, 24)
      ROUTER_LOAD(b0, 48) ROUTER_MFMA(b1, 32)
      ROUTER_LOAD(b1, 56) ROUTER_MFMA(b2, 40)
      ROUTER_MFMA(b0, 48)
      ROUTER_MFMA(b1, 56)
      acc = (acc + a1) + (a2 + a3);
    }
    __syncthreads();
#pragma unroll
    for (int r = 0; r < 4; ++r) lgs[((lane >> 4) * 4 + r) * 64 + 16 * wave + (lane & 15)] = acc[r];
    __syncthreads();
    {
      float score4[4], gate4[4];
      int kidx4[4], pos4[4];
      bool chosen4[4];
#pragma unroll
      for (int q = 0; q < 4; ++q) {
        const int tl = wave * 4 + q;
        const float logit = lgs[tl * 64 + lane];
        const float score = sigm_f(logit);
        float sel = score + p->moe_bias[layer * 64 + lane];
        bool chosen = false;
        for (int r = 0; r < 6; ++r) {
          const float mx = wmax(sel);
          const unsigned long long bal = __ballot(sel == mx);
          const int first = __ffsll((long long)bal) - 1;
          if (lane == first) { chosen = true; sel = -INFINITY; }
        }
        const float gsum = wsum(chosen ? score : 0.f);
        const unsigned long long cb = __ballot(chosen);
        score4[q] = score; gate4[q] = score / gsum * 2.5f; chosen4[q] = chosen;
        kidx4[q] = __popcll(cb & ((1ull << lane) - 1ull));
      }
#pragma unroll
      for (int q = 0; q < 4; ++q) pos4[q] = chosen4[q] ? atomicAdd(&p->cnt[lane * CSTR], 1) : 0;
#pragma unroll
      for (int q = 0; q < 4; ++q) {
        const int t = t0 + wave * 4 + q;
        if (chosen4[q]) {
          p->ltok[(size_t)lane * NT + pos4[q]] = t;
          p->lgate[(size_t)lane * NT + pos4[q]] = gate4[q];
          p->tsl[t * 6 + kidx4[q]] = (lane << 16) | pos4[q];
        }
      }
    }
    __syncthreads();
  }
}

__device__ __forceinline__ void moe_prefix(KP p, int rows, int* s_pref, int tid) {
  if (tid < 64) s_pref[322 + tid] = p->cnt[tid * CSTR];
  __syncthreads();
  if (tid == 0) {
    int a = 0;
    for (int e = 0; e < 64; ++e) { s_pref[e] = a; a += (s_pref[322 + e] + 127) >> 7; }
    s_pref[64] = a; a += rows >> 7;
    s_pref[65] = a;
  }
  __syncthreads();
}

__device__ void ph_gemm(KP p, int kind, int layer, bool keep, char* lds) {
  const int tid = opaque_tid();
  const int j = layer >> 1;
  const bool att = !(layer & 1);
  const int rows = keep ? NT : NL;
  int* pref = (int*)(lds + META_OFF);
  int* s_idx = pref + 66;
  float* s_gate = (float*)(s_idx + 128);
  if (kind == 1 && blockIdx.x == 0 && tid < 65) p->cnt[tid * CSTR] = 0;
  int total;
  const int ntn_in = att ? 18 : 33;
  switch (kind) {
    case 0: total = (NT / 128) * ntn_in; break;
    case 1: total = (rows / 128) * 8; break;
    case 2: total = pref[65] * 4; break;
    case 3: total = pref[65] * 8; break;
    case 4: total = (NT / 128) * 3; break;
    default: total = (NT / 128) * 20; break;
  }
  const bool moe = kind == 2 || kind == 3;
  const int tsh = kind == 2 ? 2 : 3;
  int e_nx = 0, idx_nx = tid; float g_nx = 1.f;
  auto fetch_moe = [&](int tl) {
    const int mt = tl >> tsh;
    while (mt >= pref[e_nx + 1]) ++e_nx;
    idx_nx = tid; g_nx = 1.f;
    if (tid < 128) {
      const int pos = (mt - pref[e_nx]) * 128 + tid;
      if (kind == 2) {
        idx_nx = 0;
        if (e_nx < 64) { if (pos < pref[322 + e_nx]) idx_nx = p->ltok[(size_t)e_nx * NT + pos]; }
        else idx_nx = pos;
      } else if (e_nx < 64) g_nx = pos < pref[322 + e_nx] ? p->lgate[(size_t)e_nx * NT + pos] : 0.f;
    }
  };
  if (moe && (int)blockIdx.x < total) fetch_moe(blockIdx.x);
  for (int tile = blockIdx.x; tile < total; tile += gridDim.x) {
    const bf16_t* Abase; const bf16_t* Bt;
    int astride, K, n0, m0 = 0, aux = 0, e = e_nx, mtile = 0;
    switch (kind) {
      case 0: { const int tm = tile / ntn_in, tn = tile % ntn_in; m0 = tm * 128; n0 = tn * 128;
                Abase = (const bf16_t*)((const unsigned char*)p->AB + (size_t)m0 * DM); astride = DM; K = 1024;
                Bt = (const bf16_t*)(att ? (const unsigned char*)p->Wt_att + (size_t)j * ATT_N * 1024
                                         : (const unsigned char*)p->Wt_rec + (size_t)j * REC_NP * 1024); } break;
      case 1: { const int tm = tile >> 3, tn = tile & 7; m0 = tm * 128; n0 = tn * 128;
                Abase = p->AB + (size_t)m0 * DM; astride = DM; K = 1024; Bt = p->Wt_out + (size_t)layer * 1024 * 1024; } break;
      case 2: { mtile = tile >> 2; aux = tile & 3; n0 = aux * 128;
                Abase = p->AB; astride = DM; K = 1024;
                Bt = (const bf16_t*)((const unsigned char*)p->Wt13 + (size_t)(layer * 65 + e) * 512 * 1024); } break;
      case 3: { mtile = tile >> 3; aux = tile & 7; n0 = aux * 128;
                Abase = (const bf16_t*)((const unsigned char*)p->ACT + (size_t)mtile * 128 * 256); astride = 256; K = 256;
                Bt = (const bf16_t*)((const unsigned char*)p->Wt2 + (size_t)(layer * 65 + e) * 1024 * 256); } break;
      case 4: { const int tm = tile / 3; aux = tile % 3; m0 = tm * 128; n0 = 0;
                Abase = p->Zb + (size_t)m0 * 1536 + aux * 512; astride = 1536; K = 512; Bt = p->Wl1 + (size_t)(j * 3 + aux) * 128 * 512; } break;
      default: { const int tm = tile / 20; aux = tile % 20; m0 = tm * 128; n0 = aux * 128;
                const int grp = aux < 8 ? 0 : (aux < 16 ? 1 : 2);
                Abase = p->L1 + (size_t)m0 * 384 + grp * 128; astride = 384; K = 128; Bt = p->Wl2 + (size_t)j * 2560 * 128; } break;
    }
    if (tid < 128) { s_idx[tid] = idx_nx; s_gate[tid] = g_nx; }
    __syncthreads();
    if (moe && tile + (int)gridDim.x < total) fetch_moe(tile + gridDim.x);
    {
      f32x16 acc[2][2];
      if (kind == 0 || kind == 2 || kind == 3) {
        const unsigned char* A8 = (const unsigned char*)Abase;
        gemm128_fp8(tid, [&](int r) { return A8 + (size_t)s_idx[r] * astride; }, (const unsigned char*)Bt, K, n0, lds, acc);
      } else
        gemm128_main(tid, [&](int r) { return Abase + (size_t)s_idx[r] * astride; }, Bt, K, n0, lds, acc);
      float* Ct = (float*)lds;
      acc_foreach(tid, acc, [&](int row, int col, float v) { Ct[row * 128 + col] = v; });
    }
    __syncthreads();
    {
      const float* Ct = (const float*)lds;
      int c4 = (tid & 31) * 4, r0 = tid >> 5;
      asm volatile("" : "+v"(c4), "+v"(r0));
      const int N_in = att ? ATT_N : REC_N;
      const int d5 = (aux >> 2) & 1, c05 = (aux & 3) * 128;
      switch (kind) {
        case 0: {
#pragma unroll 8
          for (int it = 0; it < 16; ++it) {
            const int row = it * 8 + r0;
            const float4 vraw = *(const float4*)(Ct + row * 128 + c4);
            const float4 v = make_float4(vraw.x * W8_INV, vraw.y * W8_INV, vraw.z * W8_INV, vraw.w * W8_INV);

            const int cn = n0 + c4;
            float4 vq = v;
            if (att && n0 >= 1536 && n0 < 2176) {
              float ss = v.x * v.x + v.y * v.y + v.z * v.z + v.w * v.w;
              ss += dppx<0xB1>(ss); ss += dppx<0x4E>(ss); ss += dppx<0x141>(ss); ss += dppx<0x140>(ss);
              const float rs = rsqrtf(ss * (1.f / 64.f) + 1e-6f);
              const float4 g = *(const float4*)(p->qk_gain + j * 128 + (n0 >= 2048 ? 64 : 0) + (cn & 63));
              vq = make_float4(v.x * rs * g.x, v.y * rs * g.y, v.z * rs * g.z, v.w * rs * g.w);
              const int t = m0 + row;
              if (t < NL) {
                const int sidx = t & 2047, pi0 = (cn & 63) >> 1;
                const int pos = pi0 < 16 ? (sidx >> 6) : (sidx & 63);
                const float4 cs = *(const float4*)(p->ROPE + (pos * 16 + (pi0 & 15)) * 2);
                vq = make_float4(vq.x * cs.x - vq.y * cs.y, vq.x * cs.y + vq.y * cs.x,
                                 vq.z * cs.z - vq.w * cs.w, vq.z * cs.w + vq.w * cs.z);
              }
            }
            if (cn < N_in) {
              u32x2 o; o.x = pk_bf16(vq.x, vq.y); o.y = pk_bf16(vq.z, vq.w);
              *(u32x2*)(p->P + (size_t)(m0 + row) * LDP + cn) = o;
            }
            if (!att && cn >= 4096 && cn < 4112) *(float4*)(p->GP + (size_t)(m0 + row) * 16 + (cn - 4096)) = v;
          }
        } break;
        case 1: {
#pragma unroll 16
          for (int it = 0; it < 16; ++it) {
            const int row = it * 8 + r0;
            const float4 v = *(const float4*)(Ct + row * 128 + c4);

            const size_t o = (size_t)(m0 + row) * DM + n0 + c4;
            const float4 xv = *(const float4*)(p->X + o);
            const float4 g = *(const float4*)(p->MOD + (layer * 9 + modrow(m0)) * 6144 + 2048 + n0 + c4);
            *(float4*)(p->Tb + o) = make_float4(DN_ALPHA * xv.x + g.x * v.x, DN_ALPHA * xv.y + g.y * v.y,
                                                DN_ALPHA * xv.z + g.z * v.z, DN_ALPHA * xv.w + g.w * v.w);
          }
        } break;
        case 2: {
#pragma unroll 8
          for (int it = 0; it < 16; ++it) {
            const int row = it * 8 + r0;
            const float4 v = *(const float4*)(Ct + row * 128 + c4);

            if (((c4 >> 5) & 1) == 0) {
              const float4 u = *(const float4*)(Ct + row * 128 + c4 + 32);
              const float a0 = v.x * W8_INV, a1 = v.y * W8_INV, a2 = v.z * W8_INV, a3 = v.w * W8_INV;
              *(unsigned*)((unsigned char*)p->ACT + ((size_t)mtile * 128 + row) * 256 + aux * 64 + (c4 >> 6) * 32 + (c4 & 31)) =
                  pk_fp8x4(silu_f(a0) * (u.x * W8_INV), silu_f(a1) * (u.y * W8_INV), silu_f(a2) * (u.z * W8_INV), silu_f(a3) * (u.w * W8_INV));
            }
          }
        } break;
        case 3: {
#pragma unroll 16
          for (int it = 0; it < 16; ++it) {
            const int row = it * 8 + r0;
            const float4 v = *(const float4*)(Ct + row * 128 + c4);

            const float g = s_gate[row] * W8_INV;
            u32x2 o; o.x = pk_bf16(g * v.x, g * v.y); o.y = pk_bf16(g * v.z, g * v.w);
            *(u32x2*)(p->OUT2 + ((size_t)mtile * 128 + row) * 1024 + n0 + c4) = o;
          }
        } break;
        case 4: {
#pragma unroll 4
          for (int it = 0; it < 16; ++it) {
            const int row = it * 8 + r0;
            const float4 v = *(const float4*)(Ct + row * 128 + c4);

            float4 o4 = v;
            if (aux == 0) o4 = make_float4(tanhf(v.x), tanhf(v.y), tanhf(v.z), tanhf(v.w));
            else if (aux == 2) o4 = make_float4(sigm_f(v.x), sigm_f(v.y), sigm_f(v.z), sigm_f(v.w));
            u32x2 o; o.x = pk_bf16(o4.x, o4.y); o.y = pk_bf16(o4.z, o4.w);
            *(u32x2*)(p->L1 + (size_t)(m0 + row) * 384 + aux * 128 + c4) = o;
          }
        } break;
        default: {
#pragma unroll 4
          for (int it = 0; it < 16; ++it) {
            const int row = it * 8 + r0;
            const float4 v = *(const float4*)(Ct + row * 128 + c4);

            bf16_t* rr = p->RW + (size_t)(m0 + row) * RWS + c05 + c4;
            const float vv[4] = {v.x, v.y, v.z, v.w};
            if (aux < 8) {
              const float4 b0 = *(const float4*)(p->rwkv_w0 + (j * 2 + d5) * 512 + c05 + c4);
              const float bb[4] = {b0.x, b0.y, b0.z, b0.w};
              float e4[4];
#pragma unroll
              for (int q = 0; q < 4; ++q) e4[q] = expf(-softplus_f(-(bb[q] + vv[q])) - 0.5f);
              u32x2 o; o.x = pk_bf16(e4[0], e4[1]); o.y = pk_bf16(e4[2], e4[3]);
              *(u32x2*)(rr + (3 + d5) * 512) = o;
            } else if (aux < 16) {
              const float4 b0 = *(const float4*)(p->rwkv_a0 + (j * 2 + d5) * 512 + c05 + c4);
              const float4 k1 = *(const float4*)(p->rwkv_kvec + (j * 2 + 1) * 512 + c05 + c4);
              const u32x2 kx2 = *(const u32x2*)(rr + 10 * 512);
              const float bb[4] = {b0.x, b0.y, b0.z, b0.w}, kk1[4] = {k1.x, k1.y, k1.z, k1.w};
              const float kx[4] = {bflo(kx2.x), bfhi(kx2.x), bflo(kx2.y), bfhi(kx2.y)};
              float av[4], ke[4];
#pragma unroll
              for (int q = 0; q < 4; ++q) { av[q] = sigm_f(bb[q] + vv[q]); ke[q] = kx[q] * (1.f + (av[q] - 1.f) * kk1[q]); }
              u32x2 o; o.x = pk_bf16(av[0], av[1]); o.y = pk_bf16(av[2], av[3]);
              *(u32x2*)(rr + (7 + d5) * 512) = o;
              o.x = pk_bf16(ke[0], ke[1]); o.y = pk_bf16(ke[2], ke[3]);
              *(u32x2*)(rr + (5 + d5) * 512) = o;
            } else {
              u32x2 o; o.x = pk_bf16(v.x, v.y); o.y = pk_bf16(v.z, v.w);
              *(u32x2*)(rr + 9 * 512) = o;
            }
          }
        } break;
      }
    }
    __syncthreads();
  }
}

__device__ void ph_final_ln(KP p, int layer, bool keep, char* lds) {
  const int tid = opaque_tid();
  const int lane = tid & 63, wave = tid >> 6;
  const int rows = keep ? NT : NL;
  int* s_base = (int*)(lds + META_OFF);
  if (tid == 0) {
    int a = 0;
#pragma unroll 1
    for (int e = 0; e < 64; ++e) { s_base[e] = a * 128; a += (p->cnt[e * CSTR] + 127) >> 7; }
    s_base[64] = a * 128;
  }
  __syncthreads();
  const float* lng = p->ln_g + (layer * 2 + 1) * 1024;
  const float* lnb = p->ln_b + (layer * 2 + 1) * 1024;
  for (int t = blockIdx.x * 4 + wave; t < rows; t += gridDim.x * 4) {
    const int mr = modrow(t);
    const float* g2 = p->MOD + (layer * 9 + mr) * 6144 + 5120;
    const bf16_t* src[7];
#pragma unroll
    for (int k = 0; k < 6; ++k) {
      const int v = p->tsl[t * 6 + k];
      src[k] = p->OUT2 + (size_t)(s_base[v >> 16] + (v & 0xffff)) * 1024;
    }
    src[6] = p->OUT2 + (size_t)(s_base[64] + t) * 1024;
    float v[16];
    float s = 0.f;
#pragma unroll
    for (int c = 0; c < 2; ++c) {
      const int n0 = c * 512 + lane * 8;
      float y[8];
#pragma unroll
      for (int q = 0; q < 8; ++q) y[q] = 0.f;
#pragma unroll
      for (int k = 0; k < 7; ++k) {
        const u32x4 u = *(const u32x4*)(src[k] + n0);
        y[0] += bflo(u.x); y[1] += bfhi(u.x); y[2] += bflo(u.y); y[3] += bfhi(u.y);
        y[4] += bflo(u.z); y[5] += bfhi(u.z); y[6] += bflo(u.w); y[7] += bfhi(u.w);
      }
      const float4 xa = *(const float4*)(p->X + (size_t)t * DM + n0), xb = *(const float4*)(p->X + (size_t)t * DM + n0 + 4);
      const float4 ga = *(const float4*)(g2 + n0), gb = *(const float4*)(g2 + n0 + 4);
      const float xx[8] = {xa.x, xa.y, xa.z, xa.w, xb.x, xb.y, xb.z, xb.w};
      const float gg[8] = {ga.x, ga.y, ga.z, ga.w, gb.x, gb.y, gb.z, gb.w};
#pragma unroll
      for (int q = 0; q < 8; ++q) { v[c * 8 + q] = DN_ALPHA * xx[q] + gg[q] * y[q]; s += v[c * 8 + q]; }
    }
    const float mean = wsum(s) * (1.f / 1024.f);
    float q2 = 0.f;
#pragma unroll
    for (int i = 0; i < 16; ++i) { const float d = v[i] - mean; q2 += d * d; }
    const float rs = rsqrtf(wsum(q2) * (1.f / 1024.f) + 1e-5f);
    const float* modn = p->MOD + ((layer + 1) * 9 + mr) * 6144;
#pragma unroll
    for (int c = 0; c < 2; ++c) {
      const int n0 = c * 512 + lane * 8;
      float xn[8];
#pragma unroll
      for (int q = 0; q < 8; ++q) xn[q] = (v[c * 8 + q] - mean) * rs * lng[n0 + q] + lnb[n0 + q];
      float* xo = (layer == 3 ? p->out : p->X) + (size_t)t * DM + n0;
      *(float4*)(xo) = make_float4(xn[0], xn[1], xn[2], xn[3]);
      *(float4*)(xo + 4) = make_float4(xn[4], xn[5], xn[6], xn[7]);
      if (layer != 3) {
        float hb[8];
#pragma unroll
        for (int q = 0; q < 8; ++q) hb[q] = xn[q] * (1.f + modn[1024 + n0 + q]) + modn[n0 + q];
        u32x2 o;
        o.x = pk_fp8x4(hb[0], hb[1], hb[2], hb[3]); o.y = pk_fp8x4(hb[4], hb[5], hb[6], hb[7]);
        *(u32x2*)((unsigned char*)p->AB + (size_t)t * DM + n0) = o;
      }
    }
  }
}

#define XB_TMO      128
#define XB_XCNT(j)  (256  + 64 * (j))
#define XB_XSUB(j)  (1280 + 64 * (j))
#define XB_XGEN(j)  (2304 + 64 * (j))
#define XB_TOP      3328
#define XB_TOPGEN   3392
#define XB_SPIN_CAP (1u << 20)
#define LAS __attribute__((address_space(3)))
__device__ __forceinline__ unsigned xb_ld(unsigned* p) { return __hip_atomic_load(p, __ATOMIC_RELAXED, __HIP_MEMORY_SCOPE_AGENT); }
__device__ __forceinline__ unsigned xb_add(unsigned* p, unsigned v) { return __hip_atomic_fetch_add(p, v, __ATOMIC_RELAXED, __HIP_MEMORY_SCOPE_AGENT); }
__device__ __forceinline__ unsigned xb_xcc_id() { return (unsigned)__builtin_amdgcn_s_getreg((3 << 11) | 20) & 0xFu; }
#define XB_SPIN(cond, bar) do { unsigned _sp = 0; while (cond) { __builtin_amdgcn_s_sleep(1); \
    if ((++_sp & 255u) == 0u) { if (xb_ld(&(bar)[XB_TMO])) break; if (_sp > XB_SPIN_CAP) { atomicAdd(&(bar)[XB_TMO], 1u); break; } } } } while (0)
struct XcdBarrier { unsigned* bar; unsigned x; volatile LAS unsigned* st; };
__device__ __forceinline__ XcdBarrier xcd_barrier_post(unsigned* bar, volatile LAS unsigned* st) {
  XcdBarrier b; b.bar = bar; b.x = xb_xcc_id(); b.st = st;
  if (threadIdx.x == 0) (void)xb_add(&bar[XB_XCNT(b.x)], 1u);
  return b;
}
__device__ __forceinline__ void xcd_barrier_complete(unsigned* bar, unsigned x, unsigned& nloc, unsigned& nx) {
  const unsigned G = gridDim.x;
  unsigned sum, cnt, mine, sp = 0u;
  for (;;) {
    sum = 0u; cnt = 0u; mine = 0u;
#pragma unroll
    for (unsigned j = 0; j < 16; ++j) { const unsigned c = xb_ld(&bar[XB_XCNT(j)]); sum += c; cnt += (c > 0u) ? 1u : 0u; mine = (j == x) ? c : mine; }
    if (sum == G) break;
    __builtin_amdgcn_s_sleep(1);
    if ((++sp & 255u) == 0u) { if (xb_ld(&bar[XB_TMO])) break; if (sp > XB_SPIN_CAP) { atomicAdd(&bar[XB_TMO], 1u); break; } }
  }
  nloc = mine > 0u ? mine : 1u; nx = cnt > 0u ? cnt : 1u;
}
__device__ __forceinline__ void xcd_barrier(const XcdBarrier& b) {
  asm volatile("s_waitcnt vmcnt(0)" ::: "memory");
  __syncthreads();
  if (threadIdx.x == 0) {
    unsigned* bar = b.bar;
    __builtin_amdgcn_s_waitcnt(0);
    unsigned nloc = b.st[0], nx = b.st[1];
    if (nloc == 0u) { xcd_barrier_complete(bar, b.x, nloc, nx); b.st[0] = nloc; b.st[1] = nx; }
    const unsigned old = xb_add(&bar[XB_XSUB(b.x)], 1u);
    const unsigned gen = old / nloc;
    if (old + 1u == (gen + 1u) * nloc) {
      __builtin_amdgcn_fence(__ATOMIC_RELEASE, "agent");
      asm volatile("s_waitcnt vmcnt(0)" ::: "memory");
      const unsigned og = xb_add(&bar[XB_TOP], 1u);
      const unsigned tg = og / nx;
      if (og + 1u == (tg + 1u) * nx) xb_add(&bar[XB_TOPGEN], 1u);
      else XB_SPIN(xb_ld(&bar[XB_TOPGEN]) == tg, bar);
      __builtin_amdgcn_fence(__ATOMIC_ACQUIRE, "agent");
      xb_add(&bar[XB_XGEN(b.x)], 1u);
      asm volatile("s_waitcnt vmcnt(0)" ::: "memory");
    } else {
      XB_SPIN(xb_ld(&bar[XB_XGEN(b.x)]) == gen, bar);
      __builtin_amdgcn_fence(__ATOMIC_ACQUIRE, "agent");
      asm volatile("s_waitcnt vmcnt(0)" ::: "memory");
    }
  }
  __syncthreads();
}

constexpr int NSLOTS = 13;
constexpr int NPHASE = 2 + 4 * NSLOTS;
__device__ __forceinline__ bool phase_is_nop(int ph) {
  if (ph < 2) return false;
  const int layer = (ph - 2) / NSLOTS, st = (ph - 2) % NSLOTS;
  if (st == 5 || st == 6) return true;
  return !(layer & 1) && (st == 1 || (st >= 3 && st <= 7));
}
__device__ void run_phase(KP p, int ph, char* sm) {
  if (ph == 0) { ph_init(p, sm); return; }
  if (ph == 1) { ph_mod_h(p, sm); return; }
  const int layer = (ph - 2) / NSLOTS, st = (ph - 2) % NSLOTS;
  const bool odd = layer & 1;
  const bool keep = layer < 3;
  int gk = -1;
  if (st == 0) gk = 0;
  else if (st == 8) gk = 1;
  else if (st == 10) gk = 2;
  else if (st == 11) gk = 3;
  else if (odd && st == 2) gk = 4;
  else if (odd && st == 3) gk = 5;
  asm volatile("" : "+s"(gk));
  if (gk >= 0) {
    if (gk == 2 || gk == 3) moe_prefix(p, keep ? NT : NL, (int*)(sm + META_OFF), opaque_tid());
    ph_gemm(p, gk, layer, keep, sm);
    if (gk == 5) { __syncthreads(); ph_mlstm_s2(p, sm); }
    return;
  }
  switch (st) {
    case 1: if (odd) { ph_rwkv_mix(p, layer); ph_mlstm_s1(p, layer, sm); } break;
    case 2: ph_attention(p, layer, keep, sm); break;
    case 4: if (odd) ph_scan_a(p, layer, sm); break;
    case 7: if (odd) ph_rec_final(p, layer, keep); break;
    case 9: ph_ln_router(p, layer, keep, sm); break;
    case 12: ph_final_ln(p, layer, keep, sm); break;
  }
}

__global__ void __launch_bounds__(NTHR, 2) mega_kernel(Params kargs) {
  extern __shared__ __attribute__((aligned(16))) char sm[];
  cg::grid_group grid = cg::this_grid();
  volatile LAS unsigned* st = (volatile LAS unsigned*)(sm + META_OFF + 4032);
  if (threadIdx.x == 0) { st[0] = 0u; st[1] = 0u; }
  __syncthreads();
  const XcdBarrier xb = xcd_barrier_post(kargs.bar, st);
  for (int ph = kargs.ph_lo; ph < kargs.ph_hi; ++ph) {
    if (phase_is_nop(ph)) continue;
    {
      KP kp = (KP)__builtin_amdgcn_kernarg_segment_ptr();
      asm volatile("" : "+s"(kp));
      run_phase(kp, ph, sm);
    }
    if (ph + 1 < kargs.ph_hi) {
      if (ph == 0) grid.sync();
      else xcd_barrier(xb);
    }
  }
}

extern "C" void kernel_launch(void* const* d_in, const int* in_sizes, int n_in, void* d_out, int out_size, void* d_ws,
                              size_t ws_size, hipStream_t stream) {
  static int grid_blocks = 0;
  if (!grid_blocks) {
    int dev = 0, cus = 0, per_cu = 0;
    (void)hipGetDevice(&dev);
    (void)hipDeviceGetAttribute(&cus, hipDeviceAttributeMultiprocessorCount, dev);
    (void)hipFuncSetAttribute((const void*)mega_kernel, hipFuncAttributeMaxDynamicSharedMemorySize, SMEM_BYTES);
    (void)hipOccupancyMaxActiveBlocksPerMultiprocessor(&per_cu, mega_kernel, NTHR, SMEM_BYTES);
    if (per_cu < 1) per_cu = 1;
    if (per_cu > 2) per_cu = 2;
    grid_blocks = cus * per_cu;
  }
  Params p;
  memset(&p, 0, sizeof(p));
  const float** pin = (const float**)&p;
  for (int i = 0; i < 35; ++i) pin[i] = (const float*)d_in[i];
  p.out = (float*)d_out;
  char* w = (char*)d_ws;
  size_t off = 0;
  auto take = [&](size_t bytes) { char* r = w + off; off += (bytes + 255) & ~(size_t)255; return r; };
  p.Wt_att = (bf16_t*)take((size_t)2 * ATT_N * 1024 * 2);
  p.Wt_rec = (bf16_t*)take((size_t)2 * REC_NP * 1024 * 2);
  p.Wt_out = (bf16_t*)take((size_t)4 * 1024 * 1024 * 2);
  p.Wt13 = (bf16_t*)take((size_t)4 * 65 * 512 * 1024);
  p.Wt2 = (bf16_t*)take((size_t)4 * 65 * 1024 * 256);
  p.Wl1 = (bf16_t*)take((size_t)2 * 3 * 128 * 512 * 2);
  p.Wl2 = (bf16_t*)take((size_t)2 * 2560 * 128 * 2);
  p.X = (float*)take((size_t)NT * DM * 4);
  p.AB = (bf16_t*)take((size_t)NT * DM * 2);
  p.MOD = (float*)take((size_t)5 * 9 * 6144 * 4);
  p.MODP = (float*)take((size_t)8 * 4 * 9 * 6144 * 4);
  p.GP = (float*)take((size_t)NT * 16 * 4);
  p.ROPE = (float*)take((size_t)64 * 16 * 2 * 4);
  p.WrT = (float*)take((size_t)4 * 64 * 1024 * 4);
  p.msc = (float*)take((size_t)3 * NMT * 4);
  p.lgate = (float*)take((size_t)64 * NT * 4);
  p.ltok = (int*)take((size_t)64 * NT * 4);
  p.tsl = (int*)take((size_t)NT * 6 * 4);
  p.cnt = (int*)take((size_t)65 * CSTR * 4);
  p.bar = (unsigned*)take((size_t)BAR_TOTAL_WORDS * 4);
  char* region = take(0);
  const size_t szP = (size_t)NT * LDP * 2, szRW = (size_t)NT * RWS * 2, szMS = (size_t)NMT * 16384 * 2,
               szMSn = (size_t)NMT * 128 * 4;
  const size_t szT = (size_t)NT * DM * 4, szOUT2 = (size_t)NSLOT * 1024 * 2;
  p.P = (bf16_t*)region;
  p.RW = (bf16_t*)(region + szP);
  p.MS = (bf16_t*)(region + szP + szRW);
  p.MSn = (float*)(region + szP + szRW + szMS);
  p.Tb = (float*)region;
  p.ACT = (bf16_t*)region;
  p.OUT2 = (bf16_t*)(region + szT);
  const size_t szZ = (size_t)NT * 2048 * 2;
  p.Zb = (bf16_t*)(region + szP + szRW + szMS + szMSn);
  p.L1 = p.Zb + (size_t)NT * 1536;
  size_t mixer = szP + szRW + szMS + szMSn + szZ, moe = szT + szOUT2;
  off += (mixer > moe ? mixer : moe);
  if (off > ws_size) { fprintf(stderr, "workspace too small: need %zu have %zu\n", off, ws_size); return; }
  p.ph_lo = 0;
  p.ph_hi = NPHASE;
  (void)hipMemsetAsync(p.bar, 0, (size_t)BAR_TOTAL_WORDS * 4, stream);
  void* args[] = {&p};
  hipError_t e = hipLaunchCooperativeKernel((void*)mega_kernel, dim3(grid_blocks), dim3(NTHR), args, SMEM_BYTES, stream);
  if (e != hipSuccess) fprintf(stderr, "cooperative launch failed: %s (grid %d)\n", hipGetErrorString(e), grid_blocks);
}
```

```cpp
#include <hip/hip_runtime.h>
#include <hip/hip_cooperative_groups.h>
#include <cstdio>
#include <cstring>
namespace cg = cooperative_groups;

constexpr int DM = 1024;
constexpr int NBATCH = 8;
constexpr int SEQ = 2048;
constexpr int CTXL = 256;
constexpr int NL = NBATCH * SEQ;
constexpr int NC = NBATCH * CTXL;
constexpr int NT = NL + NC;
constexpr int TSC = CTXL + SEQ;
constexpr int LDP = 4112;
constexpr int ATT_N = 2304;
constexpr int REC_N = 4112;
constexpr int REC_NP = 4224;
constexpr int NCHUNK = 36;
constexpr int NMT = 64 * NCHUNK;
constexpr int RWS = 5632;
constexpr int NSLOT = 137216;
constexpr float DN_ALPHA = 1.6817928305074290f;
constexpr int NTHR = 256;
constexpr int SMEM_BYTES = 65536 + 4096;
constexpr int META_OFF = 65536;
#define XCD_BAR_WORDS 3456
constexpr int CSTR = 32;
constexpr int BAR_TOTAL_WORDS = XCD_BAR_WORDS + 64;

typedef unsigned short bf16_t;
using bf16x8 = __attribute__((ext_vector_type(8))) short;
using f32x16 = __attribute__((ext_vector_type(16))) float;
using u32x4 = __attribute__((ext_vector_type(4))) unsigned;
using u32x2 = __attribute__((ext_vector_type(2))) unsigned;

struct Params {
  const float *x, *c, *ctx, *c_ctx, *ada_w, *ada_b, *ln_g, *ln_b, *mix_w_out, *att_w_in, *na_rpb, *qk_gain,
      *rec_w_in, *rwkv_mu, *rwkv_w0, *rwkv_w1, *rwkv_w2, *rwkv_a0, *rwkv_a1, *rwkv_a2, *rwkv_g1, *rwkv_g2,
      *rwkv_kvec, *rwkv_rk, *rwkv_gn, *mlstm_gate_b, *mlstm_norm, *moe_router, *moe_bias, *moe_w1, *moe_w3,
      *moe_w2, *shared_w1, *shared_w3, *shared_w2;
  float* out;
  bf16_t *Wt_att, *Wt_rec, *Wt_out, *Wt13, *Wt2, *Wl1, *Wl2;
  bf16_t *Zb, *L1;
  float *X, *MOD, *MODP, *GP, *msc, *lgate, *MSn, *Tb, *ROPE, *WrT;
  bf16_t *AB, *P, *RW, *MS, *ACT, *OUT2;
  int *cnt, *ltok, *tsl;
  unsigned* bar;
  int ph_lo, ph_hi;
};

typedef const Params __attribute__((address_space(4))) * KP;

__device__ __forceinline__ int modrow(int t) { return t < NL ? (t >> 11) : 8; }
__device__ __forceinline__ float silu_f(float x) { return x / (1.f + expf(-x)); }
__device__ __forceinline__ float sigm_f(float x) { return 1.f / (1.f + expf(-x)); }
__device__ __forceinline__ float softplus_f(float x) { return fmaxf(x, 0.f) + log1pf(expf(-fabsf(x))); }
template <int CTRL>
__device__ __forceinline__ float dppx(float x) {
  return __int_as_float(__builtin_amdgcn_update_dpp(0, __float_as_int(x), CTRL, 0xf, 0xf, true));
}
__device__ __forceinline__ float rdlane(float v, int l) {
  return __int_as_float(__builtin_amdgcn_readlane(__float_as_int(v), l));
}
__device__ __forceinline__ float wsum(float v) {
  v += dppx<0xB1>(v); v += dppx<0x4E>(v); v += dppx<0x141>(v); v += dppx<0x140>(v);
  return (rdlane(v, 0) + rdlane(v, 16)) + (rdlane(v, 32) + rdlane(v, 48));
}
__device__ __forceinline__ float wmax(float v) {
  v = fmaxf(v, dppx<0xB1>(v)); v = fmaxf(v, dppx<0x4E>(v)); v = fmaxf(v, dppx<0x141>(v)); v = fmaxf(v, dppx<0x140>(v));
  return fmaxf(fmaxf(rdlane(v, 0), rdlane(v, 16)), fmaxf(rdlane(v, 32), rdlane(v, 48)));
}
__device__ __forceinline__ int opaque_tid() {
  int t = threadIdx.x;
  asm volatile("" : "+v"(t));
  return t;
}
typedef __bf16 bf16x2_t __attribute__((ext_vector_type(2)));
typedef float f32x2_t __attribute__((ext_vector_type(2)));
__device__ __forceinline__ unsigned pk_bf16(float lo, float hi) {
  const f32x2_t v = {lo, hi};
  return __builtin_bit_cast(unsigned, __builtin_convertvector(v, bf16x2_t));
}
__device__ __forceinline__ bf16_t f2bf(float x) { return (bf16_t)(pk_bf16(x, 0.f) & 0xffffu); }
__device__ __forceinline__ float bf2f(bf16_t v) { return __uint_as_float((unsigned)v << 16); }
__device__ __forceinline__ float bflo(unsigned u) { return __uint_as_float(u << 16); }
__device__ __forceinline__ float bfhi(unsigned u) { return __uint_as_float(u & 0xffff0000u); }
__device__ __forceinline__ int scan_row(int dir, int b, int tau) {
  if (tau < CTXL) return NL + b * CTXL + (dir ? (CTXL - 1 - tau) : tau);
  int s = tau - CTXL;
  return b * SEQ + (dir ? (SEQ - 1 - s) : s);
}

template <class RowPtrA>
__device__ __forceinline__ void gemm128_main(int tid, RowPtrA rowA, const bf16_t* __restrict__ Bt, int K, int n0,
                                             char* lds, f32x16 (&acc)[2][2]) {
  const int lane = tid & 63, w = tid >> 6;
  const int wm = w >> 1, wn = w & 1, r = lane & 31, h = lane >> 5;
  const int c = tid & 7, sr = tid >> 3;
  const int lc = (c ^ ((tid >> 4) & 7)) * 8;
  const bf16_t* ap[4];
#pragma unroll
  for (int i = 0; i < 4; ++i) ap[i] = rowA(sr + 32 * i) + lc;
  const bf16_t* bp0 = Bt + (size_t)(n0 + sr) * K + lc;
  const int bstr = 32 * K;
#pragma unroll
  for (int mi = 0; mi < 2; ++mi)
#pragma unroll
    for (int ni = 0; ni < 2; ++ni)
#pragma unroll
      for (int q = 0; q < 16; ++q) acc[mi][ni][q] = 0.f;
  const int nk = K >> 6;
  auto issue = [&](int kt) {
    char* As = lds + (kt & 1) * 32768 + tid * 16;
    const int k0 = kt * 64;
#pragma unroll
    for (int i = 0; i < 4; ++i) {
      __builtin_amdgcn_global_load_lds((const unsigned*)(ap[i] + k0), (__attribute__((address_space(3))) unsigned*)(As + i * 4096), 16, 0, 0);
      __builtin_amdgcn_global_load_lds((const unsigned*)(bp0 + i * bstr + k0), (__attribute__((address_space(3))) unsigned*)(As + 16384 + i * 4096), 16, 0, 0);
    }
  };
  issue(0);
  const int sw = (r >> 1) & 7;
#pragma unroll 1
  for (int kt = 0; kt < nk; ++kt) {
    asm volatile("s_waitcnt vmcnt(0)" ::: "memory");
    __syncthreads();
    if (kt + 1 < nk) issue(kt + 1);
    const char* As = lds + (kt & 1) * 32768;
    const char* Ar = As + (wm * 64 + r) * 128;
    const char* Br = As + 16384 + (wn * 64 + r) * 128;
#pragma unroll
    for (int ks = 0; ks < 4; ++ks) {
      const int off = ((ks * 2 + h) ^ sw) * 16;
      const bf16x8 a0 = *(const bf16x8*)(Ar + off);
      const bf16x8 a1 = *(const bf16x8*)(Ar + 32 * 128 + off);
      const bf16x8 b0 = *(const bf16x8*)(Br + off);
      const bf16x8 b1 = *(const bf16x8*)(Br + 32 * 128 + off);
      acc[0][0] = __builtin_amdgcn_mfma_f32_32x32x16_bf16(a0, b0, acc[0][0], 0, 0, 0);
      acc[0][1] = __builtin_amdgcn_mfma_f32_32x32x16_bf16(a0, b1, acc[0][1], 0, 0, 0);
      acc[1][0] = __builtin_amdgcn_mfma_f32_32x32x16_bf16(a1, b0, acc[1][0], 0, 0, 0);
      acc[1][1] = __builtin_amdgcn_mfma_f32_32x32x16_bf16(a1, b1, acc[1][1], 0, 0, 0);
    }
  }
  __syncthreads();
}
using i64 = long;
template <class RowPtrA8>
__device__ __forceinline__ void gemm128_fp8(int tid, RowPtrA8 rowA, const unsigned char* __restrict__ Bt, int K, int n0,
                                            char* lds, f32x16 (&acc)[2][2]) {
  const int lane = tid & 63, w = tid >> 6;
  const int wm = w >> 1, wn = w & 1, r = lane & 31, h = lane >> 5;
  const int c = tid & 7, sr = tid >> 3;
  const int lc = (c ^ ((tid >> 4) & 7)) * 16;
  const unsigned char* ap[4];
#pragma unroll
  for (int i = 0; i < 4; ++i) ap[i] = rowA(sr + 32 * i) + lc;
  const unsigned char* bp0 = Bt + (size_t)(n0 + sr) * K + lc;
  const int bstr = 32 * K;
#pragma unroll
  for (int mi = 0; mi < 2; ++mi)
#pragma unroll
    for (int ni = 0; ni < 2; ++ni)
#pragma unroll
      for (int q = 0; q < 16; ++q) acc[mi][ni][q] = 0.f;
  const int nk = K >> 7;
  auto issue = [&](int kt) {
    char* As = lds + (kt & 1) * 32768 + tid * 16;
    const int k0 = kt * 128;
#pragma unroll
    for (int i = 0; i < 4; ++i) {
      __builtin_amdgcn_global_load_lds((const unsigned*)(ap[i] + k0), (__attribute__((address_space(3))) unsigned*)(As + i * 4096), 16, 0, 0);
      __builtin_amdgcn_global_load_lds((const unsigned*)(bp0 + i * bstr + k0), (__attribute__((address_space(3))) unsigned*)(As + 16384 + i * 4096), 16, 0, 0);
    }
  };
  issue(0);
  const int sw = (r >> 1) & 7;
#pragma unroll 1
  for (int kt = 0; kt < nk; ++kt) {
    asm volatile("s_waitcnt vmcnt(0)" ::: "memory");
    __syncthreads();
    if (kt + 1 < nk) issue(kt + 1);
    const char* As = lds + (kt & 1) * 32768;
    const char* Ar = As + (wm * 64 + r) * 128;
    const char* Br = As + 16384 + (wn * 64 + r) * 128;
#pragma unroll
    for (int q = 0; q < 4; ++q) {
      const int off = ((q * 2 + h) ^ sw) * 16;
      const u32x4 a0 = *(const u32x4*)(Ar + off);
      const u32x4 a1 = *(const u32x4*)(Ar + 32 * 128 + off);
      const u32x4 b0 = *(const u32x4*)(Br + off);
      const u32x4 b1 = *(const u32x4*)(Br + 32 * 128 + off);
      const i64 a0l = (i64)(((unsigned long long)a0.y << 32) | a0.x), a0h = (i64)(((unsigned long long)a0.w << 32) | a0.z);
      const i64 a1l = (i64)(((unsigned long long)a1.y << 32) | a1.x), a1h = (i64)(((unsigned long long)a1.w << 32) | a1.z);
      const i64 b0l = (i64)(((unsigned long long)b0.y << 32) | b0.x), b0h = (i64)(((unsigned long long)b0.w << 32) | b0.z);
      const i64 b1l = (i64)(((unsigned long long)b1.y << 32) | b1.x), b1h = (i64)(((unsigned long long)b1.w << 32) | b1.z);
      acc[0][0] = __builtin_amdgcn_mfma_f32_32x32x16_fp8_fp8(a0l, b0l, acc[0][0], 0, 0, 0);
      acc[0][1] = __builtin_amdgcn_mfma_f32_32x32x16_fp8_fp8(a0l, b1l, acc[0][1], 0, 0, 0);
      acc[1][0] = __builtin_amdgcn_mfma_f32_32x32x16_fp8_fp8(a1l, b0l, acc[1][0], 0, 0, 0);
      acc[1][1] = __builtin_amdgcn_mfma_f32_32x32x16_fp8_fp8(a1l, b1l, acc[1][1], 0, 0, 0);
      acc[0][0] = __builtin_amdgcn_mfma_f32_32x32x16_fp8_fp8(a0h, b0h, acc[0][0], 0, 0, 0);
      acc[0][1] = __builtin_amdgcn_mfma_f32_32x32x16_fp8_fp8(a0h, b1h, acc[0][1], 0, 0, 0);
      acc[1][0] = __builtin_amdgcn_mfma_f32_32x32x16_fp8_fp8(a1h, b0h, acc[1][0], 0, 0, 0);
      acc[1][1] = __builtin_amdgcn_mfma_f32_32x32x16_fp8_fp8(a1h, b1h, acc[1][1], 0, 0, 0);
    }
  }
  __syncthreads();
}
template <class F>
__device__ __forceinline__ void acc_foreach(int tid, const f32x16 (&acc)[2][2], F f) {
  const int lane = tid & 63, w = tid >> 6;
  const int wm = w >> 1, wn = w & 1, r = lane & 31, h = lane >> 5;
#pragma unroll
  for (int mi = 0; mi < 2; ++mi)
#pragma unroll
    for (int ni = 0; ni < 2; ++ni)
#pragma unroll
      for (int q = 0; q < 16; ++q) {
        const int row = wm * 64 + mi * 32 + (q & 3) + 8 * (q >> 2) + 4 * h;
        const int col = wn * 64 + ni * 32 + r;
        f(row, col, acc[mi][ni][q]);
        if ((q & 3) == 3) __builtin_amdgcn_sched_barrier(0);
      }
}

template <class RM>
__device__ __forceinline__ void tr_tile(int tid, const float* __restrict__ src, int N, int k0, int n0,
                                        bf16_t* __restrict__ dst, int K, RM rowmap, float* tile) {
  {
    const int tx = tid & 15, ty = tid >> 4;
    const int n = n0 + tx * 4;
#pragma unroll
    for (int i = 0; i < 4; ++i) {
      const int k = ty + 16 * i;
      float4 v = make_float4(0.f, 0.f, 0.f, 0.f);
      if (n < N) v = *(const float4*)(src + (size_t)(k0 + k) * N + n);
      tile[k * 65 + tx * 4 + 0] = v.x; tile[k * 65 + tx * 4 + 1] = v.y;
      tile[k * 65 + tx * 4 + 2] = v.z; tile[k * 65 + tx * 4 + 3] = v.w;
    }
  }
  __syncthreads();
  {
    const int kc = tid & 7;
#pragma unroll
    for (int i = 0; i < 2; ++i) {
      const int n = (tid >> 3) + 32 * i;
      if (n0 + n < N) {
        float v[8];
#pragma unroll
        for (int q = 0; q < 8; ++q) v[q] = tile[(kc * 8 + q) * 65 + n];
        u32x4 o;
        o.x = pk_bf16(v[0], v[1]); o.y = pk_bf16(v[2], v[3]); o.z = pk_bf16(v[4], v[5]); o.w = pk_bf16(v[6], v[7]);
        *(u32x4*)(dst + (size_t)rowmap(n0 + n) * K + k0 + kc * 8) = o;
      }
    }
  }
  __syncthreads();
}

constexpr float W8_SCALE = 32.f, W8_INV = 1.f / 32.f;
__device__ __forceinline__ unsigned pk_fp8x4(float a, float b, float c, float d) {
  int r = __builtin_amdgcn_cvt_pk_fp8_f32(a, b, 0, false);
  r = __builtin_amdgcn_cvt_pk_fp8_f32(c, d, r, true);
  return (unsigned)r;
}
__device__ __forceinline__ unsigned pk_fp8x4c(float a, float b, float c, float d) {
  constexpr float M = 448.f;
  return pk_fp8x4(fminf(fmaxf(a, -M), M), fminf(fmaxf(b, -M), M), fminf(fmaxf(c, -M), M), fminf(fmaxf(d, -M), M));
}
template <class RM>
__device__ __forceinline__ void tr_tile_fp8(int tid, const float* __restrict__ src, int N, int k0, int n0,
                                            unsigned char* __restrict__ dst, int K, RM rowmap, float* tile) {
  {
    const int tx = tid & 15, ty = tid >> 4;
    const int n = n0 + tx * 4;
#pragma unroll
    for (int i = 0; i < 4; ++i) {
      const int k = ty + 16 * i;
      float4 v = make_float4(0.f, 0.f, 0.f, 0.f);
      if (n < N) v = *(const float4*)(src + (size_t)(k0 + k) * N + n);
      tile[k * 65 + tx * 4 + 0] = v.x; tile[k * 65 + tx * 4 + 1] = v.y;
      tile[k * 65 + tx * 4 + 2] = v.z; tile[k * 65 + tx * 4 + 3] = v.w;
    }
  }
  __syncthreads();
  {
    const int kc = tid & 3, n = tid >> 2;
    float v[16];
#pragma unroll
    for (int q = 0; q < 16; ++q) v[q] = tile[(kc * 16 + q) * 65 + n] * W8_SCALE;
    u32x4 o;
    o.x = pk_fp8x4(v[0], v[1], v[2], v[3]); o.y = pk_fp8x4(v[4], v[5], v[6], v[7]);
    o.z = pk_fp8x4(v[8], v[9], v[10], v[11]); o.w = pk_fp8x4(v[12], v[13], v[14], v[15]);
    *(u32x4*)(dst + (size_t)rowmap(n0 + n) * K + k0 + kc * 16) = o;
  }
  __syncthreads();
}

constexpr int CJ0 = 1152, CJ1 = CJ0 + 2080, CJ2 = CJ1 + 1024, CJ3 = CJ2 + 33280, CJ4 = CJ3 + 16640;
__device__ void convert_job(KP p, int job, float* sm, int tid) {
  if (job < CJ0) {
    const int j = job / 576, rem = job % 576, kt = rem / 36, nt = rem % 36;
    tr_tile_fp8(tid, p->att_w_in + (size_t)j * 1024 * ATT_N, ATT_N, kt * 64, nt * 64, (unsigned char*)p->Wt_att + (size_t)j * ATT_N * 1024,
                1024, [](int n) { return n; }, sm);
  } else if (job < CJ1) {
    const int q = job - CJ0;
    const int j = q / 1040, rem = q % 1040, kt = rem / 65, nt = rem % 65;
    tr_tile_fp8(tid, p->rec_w_in + (size_t)j * 1024 * REC_N, REC_N, kt * 64, nt * 64, (unsigned char*)p->Wt_rec + (size_t)j * REC_NP * 1024,
                1024, [](int n) { return n; }, sm);
  } else if (job < CJ2) {
    const int q = job - CJ1;
    const int i = q >> 8, rem = q & 255, kt = rem >> 4, nt = rem & 15;
    tr_tile_fp8(tid, p->mix_w_out + (size_t)i * 1024 * 1024, 1024, kt * 64, nt * 64, (unsigned char*)p->Wt_out + (size_t)i * 1024 * 1024,
                1024, [](int n) { return n; }, sm);
  } else if (job < CJ3) {
    const int q = job - CJ2;
    const int le = q >> 7, rem = q & 127;
    const int which = rem >> 6, kt = (rem >> 2) & 15, nt = rem & 3;
    const int layer = le / 65, e = le % 65;
    const float* src;
    if (e < 64) src = (which ? p->moe_w3 : p->moe_w1) + (size_t)(layer * 64 + e) * 1024 * 256;
    else src = (which ? p->shared_w3 : p->shared_w1) + (size_t)layer * 1024 * 256;
    tr_tile_fp8(tid, src, 256, kt * 64, nt * 64, (unsigned char*)p->Wt13 + (size_t)le * 512 * 1024, 1024,
                [which](int n) { return 64 * (n >> 5) + which * 32 + (n & 31); }, sm);
  } else {
    const int q = job - CJ3;
    const int le = q >> 6, rem = q & 63;
    const int kt = rem >> 4, nt = rem & 15;
    const int layer = le / 65, e = le % 65;
    const float* src = e < 64 ? p->moe_w2 + (size_t)(layer * 64 + e) * 256 * 1024 : p->shared_w2 + (size_t)layer * 256 * 1024;
    tr_tile_fp8(tid, src, 1024, kt * 64, nt * 64, (unsigned char*)p->Wt2 + (size_t)le * 1024 * 256, 256, [](int n) { return n; }, sm);
  }
}
__device__ __forceinline__ int conv_stage_total(int stage) {
  return stage == 0 ? (576 + 1040 + 512 + 8320 + 4160) : (stage == 1 ? (576 + 1040 + 256 + 16640 + 8320) : (256 + 8320 + 4160));
}
__device__ __forceinline__ int conv_stage_job(int stage, int q) {
  if (stage == 0) {
    if (q < 8320) return CJ2 + q;  q -= 8320;
    if (q < 4160) return CJ3 + q;  q -= 4160;
    if (q < 576) return q;  q -= 576;
    if (q < 1040) return CJ0 + q;  q -= 1040;
    return CJ1 + q;
  } else if (stage == 1) {
    if (q < 8320) return CJ2 + 8320 + q;  q -= 8320;
    if (q < 4160) return CJ3 + 4160 + q;  q -= 4160;
    if (q < 576) return 576 + q;  q -= 576;
    if (q < 256) return CJ1 + 512 + q;  q -= 256;
    if (q < 8320) return CJ2 + 16640 + q;  q -= 8320;
    if (q < 4160) return CJ3 + 8320 + q;  q -= 4160;
    return CJ0 + 1040 + q;
  }
  if (q < 256) return CJ1 + 768 + q;  q -= 256;
  if (q < 8320) return CJ2 + 24960 + q;  q -= 8320;
  return CJ3 + 12480 + q;
}

struct CvDesc { const float* src; unsigned char* dst; int N, K, k0, n0, which; };
__device__ __forceinline__ bool conv_desc_fp8(KP p, int job, CvDesc& d) {
  if (job < CJ2) return false;
  if (job < CJ3) {
    const int q = job - CJ2;
    const int le = q >> 7, rem = q & 127;
    const int which = rem >> 6, kt = (rem >> 2) & 15, nt = rem & 3;
    const int layer = le / 65, e = le % 65;
    if (e < 64) d.src = (which ? p->moe_w3 : p->moe_w1) + (size_t)(layer * 64 + e) * 1024 * 256;
    else d.src = (which ? p->shared_w3 : p->shared_w1) + (size_t)layer * 1024 * 256;
    d.dst = (unsigned char*)p->Wt13 + (size_t)le * 512 * 1024;
    d.N = 256; d.K = 1024; d.k0 = kt * 64; d.n0 = nt * 64; d.which = which;
  } else {
    const int q = job - CJ3;
    const int le = q >> 6, rem = q & 63;
    const int kt = rem >> 4, nt = rem & 15;
    const int layer = le / 65, e = le % 65;
    d.src = e < 64 ? p->moe_w2 + (size_t)(layer * 64 + e) * 256 * 1024 : p->shared_w2 + (size_t)layer * 256 * 1024;
    d.dst = (unsigned char*)p->Wt2 + (size_t)le * 1024 * 256;
    d.N = 1024; d.K = 256; d.k0 = kt * 64; d.n0 = nt * 64; d.which = -1;
  }
  return true;
}
typedef float cvf4 __attribute__((ext_vector_type(4)));
__device__ __forceinline__ void cv_load(const CvDesc& d, int tid, cvf4& v0, cvf4& v1, cvf4& v2, cvf4& v3) {
  const int tx = tid & 15, ty = tid >> 4;
  const float* s0 = d.src + (size_t)(d.k0 + ty) * d.N + d.n0 + tx * 4;
  v0 = *(const cvf4*)(s0);
  v1 = *(const cvf4*)(s0 + (size_t)16 * d.N);
  v2 = *(const cvf4*)(s0 + (size_t)32 * d.N);
  v3 = *(const cvf4*)(s0 + (size_t)48 * d.N);
}
__device__ __forceinline__ void cv_emit(const CvDesc& d, int tid, const cvf4 v0, const cvf4 v1, const cvf4 v2, const cvf4 v3, float* tile) {
  {
    const int tx = tid & 15, ty = tid >> 4;
    float* t0 = tile + ty * 65 + tx * 4;
    t0[0] = v0.x; t0[1] = v0.y; t0[2] = v0.z; t0[3] = v0.w;
    t0[16 * 65 + 0] = v1.x; t0[16 * 65 + 1] = v1.y; t0[16 * 65 + 2] = v1.z; t0[16 * 65 + 3] = v1.w;
    t0[32 * 65 + 0] = v2.x; t0[32 * 65 + 1] = v2.y; t0[32 * 65 + 2] = v2.z; t0[32 * 65 + 3] = v2.w;
    t0[48 * 65 + 0] = v3.x; t0[48 * 65 + 1] = v3.y; t0[48 * 65 + 2] = v3.z; t0[48 * 65 + 3] = v3.w;
  }
  __syncthreads();
  {
    const int kc = tid & 3, n = tid >> 2;
    float v[16];
#pragma unroll
    for (int q = 0; q < 16; ++q) v[q] = tile[(kc * 16 + q) * 65 + n] * W8_SCALE;
    u32x4 o;
    o.x = pk_fp8x4(v[0], v[1], v[2], v[3]); o.y = pk_fp8x4(v[4], v[5], v[6], v[7]);
    o.z = pk_fp8x4(v[8], v[9], v[10], v[11]); o.w = pk_fp8x4(v[12], v[13], v[14], v[15]);
    const int nn = d.n0 + n;
    const int row = d.which >= 0 ? 64 * (nn >> 5) + d.which * 32 + (nn & 31) : nn;
    *(u32x4*)(d.dst + (size_t)row * d.K + d.k0 + kc * 16) = o;
  }
  __syncthreads();
}
__device__ __forceinline__ void convert_run(KP p, int stage, int jj, int j1, float* sm, int tid) {
  CvDesc d, dn;
  cvf4 a0, a1, a2, a3, b0, b1, b2, b3;
  bool cur = false;
#pragma unroll 1
  for (; jj < j1; ++jj) {
    const int job = conv_stage_job(stage, jj);
    if (!cur) {
      if (!conv_desc_fp8(p, job, d)) { convert_job(p, job, sm, tid); continue; }
      cv_load(d, tid, a0, a1, a2, a3);
    }
    bool nxt = false;
    if (jj + 1 < j1) {
      nxt = conv_desc_fp8(p, conv_stage_job(stage, jj + 1), dn);
      if (nxt) cv_load(dn, tid, b0, b1, b2, b3);
    }
    cv_emit(d, tid, a0, a1, a2, a3, sm);
    if (nxt) { d = dn; a0 = b0; a1 = b1; a2 = b2; a3 = b3; }
    cur = nxt;
  }
}

__device__ void ph_init(KP p, char* smc) {
  float* sm = (float*)smc;
  const int tid = opaque_tid();
  {
    const size_t n4a = (size_t)NL * DM / 4, n4b = (size_t)NC * DM / 4;
    const float4* xs = (const float4*)p->x;
    const float4* cs = (const float4*)p->ctx;
    float4* X4 = (float4*)p->X;
    for (size_t i = (size_t)blockIdx.x * NTHR + tid; i < n4a + n4b; i += (size_t)gridDim.x * NTHR)
      X4[i] = i < n4a ? xs[i] : cs[i - n4a];
  }
  for (int tile = blockIdx.x; tile < 96 * 8; tile += gridDim.x) {
    const int ct = tile >> 3, ks = tile & 7;
    for (int i = tid; i < 9 * 128; i += NTHR) {
      const int r = i >> 7, k = ks * 128 + (i & 127);
      const float v = r < 8 ? p->c[r * 1024 + k] : p->c_ctx[k];
      sm[i] = silu_f(v);
    }
    __syncthreads();
    const int col = ct * 256 + tid;
    const int layer = col / 6144, n = col % 6144;
    const float* W = p->ada_w + ((size_t)layer * 1024 + ks * 128) * 6144 + n;
    float acc[9];
#pragma unroll
    for (int r = 0; r < 9; ++r) acc[r] = 0.f;
#pragma unroll 4
    for (int k = 0; k < 128; ++k) {
      const float w = W[(size_t)k * 6144];
#pragma unroll
      for (int r = 0; r < 9; ++r) acc[r] = fmaf(sm[r * 128 + k], w, acc[r]);
    }
#pragma unroll
    for (int r = 0; r < 9; ++r) p->MODP[((size_t)(ks * 4 + layer) * 9 + r) * 6144 + n] = acc[r];
    __syncthreads();
  }
  {
    const int total = conv_stage_total(0), chunk = (total + gridDim.x - 1) / gridDim.x;
    const int lo = min((int)blockIdx.x * chunk, total), hi = min(lo + chunk, total);
    __syncthreads();
    convert_run(p, 0, lo, hi, sm, tid);
  }
  for (int i = blockIdx.x * NTHR + tid; i < 2 * 3 * 128 * 512; i += gridDim.x * NTHR) {
    const int k = i & 511, n = (i >> 9) & 127, wj = i >> 16;
    const int j = wj / 3, which = wj % 3;
    float v = 0.f;
    if (which < 2) {
      if (n < 64) v = (which ? p->rwkv_a1 : p->rwkv_w1)[((size_t)(j * 2 + (n >> 5)) * 512 + k) * 32 + (n & 31)];
    } else if (n < 96) v = p->rwkv_g1[((size_t)j * 512 + k) * 96 + n];
    p->Wl1[i] = f2bf(v);
  }
  for (int i = blockIdx.x * NTHR + tid; i < 2 * 2560 * 128; i += gridDim.x * NTHR) {
    const int k = i & 127, n = (i >> 7) % 2560, j = i / (2560 * 128);
    float v = 0.f;
    if (n < 2048) {
      const int d = (n >> 9) & 1, c = n & 511;
      if (k < 64 && (k >> 5) == d) v = (n < 1024 ? p->rwkv_w2 : p->rwkv_a2)[((size_t)(j * 2 + d) * 32 + (k & 31)) * 512 + c];
    } else if (k < 96) v = p->rwkv_g2[((size_t)j * 96 + k) * 512 + (n - 2048)];
    p->Wl2[i] = f2bf(v);
  }
  for (int i = blockIdx.x * NTHR + tid; i < 4 * 64 * 1024; i += gridDim.x * NTHR) {
    const int k = i & 1023, n = (i >> 10) & 63, l = i >> 16;
    p->WrT[i] = p->moe_router[((size_t)l * 1024 + k) * 64 + n];
  }
  for (int i = blockIdx.x * NTHR + tid; i < 64 * 16; i += gridDim.x * NTHR) {
    const int pos = i >> 4, f = i & 15;
    const float ang = (float)pos * powf(10000.f, -(float)f / 16.f);
    p->ROPE[2 * i] = cosf(ang);
    p->ROPE[2 * i + 1] = sinf(ang);
  }
}

__device__ void ph_mod_h(KP p, char* smc) {
  float* sm = (float*)smc;
  const int tid = opaque_tid();
  for (int i = blockIdx.x * NTHR + tid; i < 4 * 9 * 6144; i += gridDim.x * NTHR) {
    const int layer = i / (9 * 6144), rem = i % (9 * 6144), n = rem % 6144;
    float s = p->ada_b[layer * 6144 + n];
#pragma unroll
    for (int ks = 0; ks < 8; ++ks) s += p->MODP[(size_t)(ks * 4 + layer) * 9 * 6144 + rem];
    p->MOD[i] = s;
  }
  const int lane = tid & 63, wave = tid >> 6;
  const int per = (((NT + gridDim.x - 1) / gridDim.x) + 3) & ~3;
  const int t0 = blockIdx.x * per, t1 = min(NT, t0 + per);
  int cur = -1;
  for (int tb = t0; tb < t1; tb += 4) {
    const int mr = modrow(tb);
    if (mr != cur) {
      __syncthreads();
      for (int n = tid; n < 2048; n += NTHR) {
        float a = p->ada_b[n];
#pragma unroll
        for (int ks = 0; ks < 8; ++ks) a += p->MODP[((size_t)(ks * 4) * 9 + mr) * 6144 + n];
        sm[n] = a;
      }
      cur = mr;
      __syncthreads();
    }
    const int t = tb + wave;
    if (t < t1) {
      const float* src = t < NL ? p->x + (size_t)t * DM : p->ctx + (size_t)(t - NL) * DM;
#pragma unroll
      for (int i = 0; i < 4; ++i) {
        const int n = i * 256 + lane * 4;
        const float4 xv = *(const float4*)(src + n);
        const float4 sh = *(const float4*)(sm + n);
        const float4 sc = *(const float4*)(sm + 1024 + n);
        *(unsigned*)((unsigned char*)p->AB + (size_t)t * DM + n) =
            pk_fp8x4(xv.x * (1.f + sc.x) + sh.x, xv.y * (1.f + sc.y) + sh.y, xv.z * (1.f + sc.z) + sh.z, xv.w * (1.f + sc.w) + sh.w);
      }
    }
  }
}

typedef short v4i16_t __attribute__((ext_vector_type(4)));
using s16x4 = __attribute__((ext_vector_type(4))) short;
__device__ __forceinline__ s16x4 vtr(const char* p) {
  return __builtin_bit_cast(s16x4, __builtin_amdgcn_ds_read_tr16_b64_v4i16((__attribute__((address_space(3))) v4i16_t*)p));
}
#define MFMA32(a, b, c) __builtin_amdgcn_mfma_f32_32x32x16_bf16(a, b, c, 0, 0, 0)
__device__ void ph_attention(KP p, int layer, bool keep, char* lds) {
  const int tid = opaque_tid();
  const int lane = tid & 63, w = tid >> 6, r32 = lane & 31, hi = lane >> 5;
  const int j = layer >> 1;
  float* bias_lds = (float*)(lds + 32768 + 1024);
  const int n_gqa = 1024, n_na = 1024, n_cb = keep ? 128 : 0, n_ca = keep ? 128 : 0;
  const int total = n_gqa + n_na + n_cb + n_ca;
  constexpr float LOG2E = 1.4426950408889634f;
  constexpr float C2 = 0.125f * LOG2E;
  const int c = tid & 7, sr = tid >> 3;
  const int kso = (c ^ ((tid >> 4) & 7)) * 16;
  const int vso = (c >> 2) * 4096 + (c & 3) * 16;
  const int sw = (r32 >> 1) & 7;
  for (int item = blockIdx.x; item < total; item += gridDim.x) {
    int b, qrow0, qoff, koff, voff, ocol, lat_tiles, lat_row0;
    bool na = false;
    int r_w = 0, start_w = 0, ru0 = 0, hN = 0;
    if (item < n_gqa) {
      b = item >> 7;
      const int g = (item >> 6) & 1, tt = item & 63;
      qrow0 = b * SEQ + tt * 32; qoff = 1536 + (g * 4 + w) * 64; koff = 2048 + g * 64; voff = 2176 + g * 64;
      ocol = 512 + (g * 4 + w) * 64; lat_tiles = 32; lat_row0 = b * SEQ;
    } else if (item < n_gqa + n_na) {
      const int it = item - n_gqa;
      b = it >> 7; hN = (it >> 4) & 7;
      const int rp = it & 15;
      na = true; r_w = 2 * rp + (w >> 1);
      qrow0 = b * SEQ + r_w * 64 + (w & 1) * 32; qoff = hN * 64; koff = 512 + hN * 64; voff = 1024 + hN * 64; ocol = hN * 64;
      const int s0 = min(max(2 * rp - 4, 0), 24), s1 = min(max(2 * rp - 3, 0), 24);
      start_w = (w >> 1) ? s1 : s0; ru0 = s0; lat_tiles = (s1 != s0) ? 9 : 8; lat_row0 = b * SEQ + ru0 * 64;
    } else if (item < n_gqa + n_na + n_cb) {
      const int it = item - n_gqa - n_na;
      b = it >> 4;
      const int g = (it >> 3) & 1, tt = it & 7;
      qrow0 = NL + b * CTXL + tt * 32; qoff = 1536 + (g * 4 + w) * 64; koff = 2048 + g * 64; voff = 2176 + g * 64;
      ocol = 512 + (g * 4 + w) * 64; lat_tiles = 0; lat_row0 = 0;
    } else {
      const int it = item - n_gqa - n_na - n_cb;
      b = it >> 4;
      const int h = (it >> 1) & 7, half = it & 1;
      qrow0 = NL + b * CTXL + half * 128 + w * 32; qoff = h * 64; koff = 512 + h * 64; voff = 1024 + h * 64; ocol = h * 64;
      lat_tiles = 0; lat_row0 = 0;
    }
    const int ctx_row0 = NL + b * CTXL, ntiles = lat_tiles + 4;
    if (na)
      for (int i = tid; i < 465; i += NTHR) bias_lds[i] = p->na_rpb[(j * 8 + hN) * 465 + i] * LOG2E;
    bf16x8 qf[4];
    {
      const bf16_t* qp = p->P + (size_t)(qrow0 + r32) * LDP + qoff + hi * 8;
#pragma unroll
      for (int d0 = 0; d0 < 4; ++d0) qf[d0] = *(const bf16x8*)(qp + d0 * 16);
    }
    f32x16 o0, o1;
#pragma unroll
    for (int q = 0; q < 16; ++q) { o0[q] = 0.f; o1[q] = 0.f; }
    float m = -INFINITY, l = 0.f;
    u32x4 kr0, kr1, vr0, vr1;
    auto gload = [&](int t) {
      const int row0 = t < lat_tiles ? lat_row0 + 64 * t : ctx_row0 + 64 * (t - lat_tiles);
      const bf16_t* base = p->P + (size_t)(row0 + sr) * LDP + c * 8;
      kr0 = *(const u32x4*)(base + koff); kr1 = *(const u32x4*)(base + (size_t)32 * LDP + koff);
      vr0 = *(const u32x4*)(base + voff); vr1 = *(const u32x4*)(base + (size_t)32 * LDP + voff);
    };
    auto swrite = [&](int buf) {
      char* Kb = lds + buf * 16384;
      char* Vb = Kb + 8192;
      *(u32x4*)(Kb + sr * 128 + kso) = kr0; *(u32x4*)(Kb + (sr + 32) * 128 + kso) = kr1;
      *(u32x4*)(Vb + vso + sr * 64) = vr0; *(u32x4*)(Vb + vso + (sr + 32) * 64) = vr1;
    };
    gload(0);
    swrite(0);
    for (int t = 0; t < ntiles; ++t) {
      __syncthreads();
      if (t + 1 < ntiles) gload(t + 1);
      const bool na_tile = na && t < lat_tiles;
      const int kr = ru0 + t;
      const bool part = !na_tile || (kr >= start_w && kr < start_w + 8);
      if (part) {
        const char* Ks = lds + (t & 1) * 16384;
        const char* Vs = Ks + 8192;
        f32x16 s0, s1;
#pragma unroll
        for (int q = 0; q < 16; ++q) { s0[q] = 0.f; s1[q] = 0.f; }
#pragma unroll
        for (int d0 = 0; d0 < 4; ++d0) {
          const int off = ((2 * d0 + hi) ^ sw) * 16;
          const bf16x8 k0 = *(const bf16x8*)(Ks + r32 * 128 + off);
          const bf16x8 k1 = *(const bf16x8*)(Ks + (32 + r32) * 128 + off);
          s0 = MFMA32(k0, qf[d0], s0);
          s1 = MFMA32(k1, qf[d0], s1);
        }
        float mx = -INFINITY;
        if (na_tile) {
          const int cq = (w & 1) * 32 + r32;
          const int c0 = min(max(cq - 8, 0), 48);
          const float* brow = bias_lds + (kr - r_w + 7) * 31 + (15 - cq);
#pragma unroll
          for (int q = 0; q < 16; ++q) {
            const int kc = (q & 3) + 8 * (q >> 2) + 4 * hi;
            const float v0 = ((unsigned)(kc - c0) < 16u) ? fmaf(s0[q], C2, brow[kc]) : -INFINITY;
            const float v1 = ((unsigned)(kc + 32 - c0) < 16u) ? fmaf(s1[q], C2, brow[kc + 32]) : -INFINITY;
            s0[q] = v0; s1[q] = v1;
            mx = fmaxf(mx, fmaxf(v0, v1));
          }
        } else {
#pragma unroll
          for (int q = 0; q < 16; ++q) {
            s0[q] *= C2; s1[q] *= C2;
            mx = fmaxf(mx, fmaxf(s0[q], s1[q]));
          }
        }
        {
          auto rr = __builtin_amdgcn_permlane32_swap(__float_as_uint(mx), __float_as_uint(mx), false, false);
          mx = fmaxf(__uint_as_float(rr[0]), __uint_as_float(rr[1]));
        }
        const float mnew = fmaxf(m, mx);
        const float alpha = __builtin_amdgcn_exp2f(m - mnew);
        float ls = 0.f;
#pragma unroll
        for (int q = 0; q < 16; ++q) {
          s0[q] = __builtin_amdgcn_exp2f(s0[q] - mnew);
          s1[q] = __builtin_amdgcn_exp2f(s1[q] - mnew);
          ls += s0[q] + s1[q];
        }
        l = l * alpha + ls;
        m = mnew;
#pragma unroll
        for (int q = 0; q < 16; ++q) { o0[q] *= alpha; o1[q] *= alpha; }
        bf16x8 pf[4];
#pragma unroll
        for (int s = 0; s < 4; ++s) {
          const int u = (s & 1) * 8;
          u32x4 tpk;
          if (s < 2) {
            tpk.x = pk_bf16(s0[u + 0], s0[u + 1]); tpk.y = pk_bf16(s0[u + 2], s0[u + 3]);
            tpk.z = pk_bf16(s0[u + 4], s0[u + 5]); tpk.w = pk_bf16(s0[u + 6], s0[u + 7]);
          } else {
            tpk.x = pk_bf16(s1[u + 0], s1[u + 1]); tpk.y = pk_bf16(s1[u + 2], s1[u + 3]);
            tpk.z = pk_bf16(s1[u + 4], s1[u + 5]); tpk.w = pk_bf16(s1[u + 6], s1[u + 7]);
          }
          pf[s] = __builtin_bit_cast(bf16x8, tpk);
        }
        const char* vb = Vs + ((lane >> 4) & 1) * 32 + (lane & 3) * 8 + ((lane & 15) >> 2) * 64 + hi * 256;
#pragma unroll
        for (int s = 0; s < 4; ++s) {
          const s16x4 a00 = vtr(vb + (16 * s) * 64), a01 = vtr(vb + (16 * s + 8) * 64);
          const s16x4 a10 = vtr(vb + 4096 + (16 * s) * 64), a11 = vtr(vb + 4096 + (16 * s + 8) * 64);
          const bf16x8 A0 = __builtin_shufflevector(a00, a01, 0, 1, 2, 3, 4, 5, 6, 7);
          const bf16x8 A1 = __builtin_shufflevector(a10, a11, 0, 1, 2, 3, 4, 5, 6, 7);
          o0 = MFMA32(A0, pf[s], o0);
          o1 = MFMA32(A1, pf[s], o1);
        }
      }
      if (t + 1 < ntiles) swrite((t + 1) & 1);
    }
    __syncthreads();
    const float lt = l + __shfl_xor(l, 32);
    const float inv = 1.f / lt;
    unsigned char* op = (unsigned char*)p->AB + (size_t)(qrow0 + r32) * DM + ocol + 4 * hi;
#pragma unroll
    for (int g = 0; g < 4; ++g) {
      *(unsigned*)(op + 8 * g) = pk_fp8x4c(o0[4 * g] * inv, o0[4 * g + 1] * inv, o0[4 * g + 2] * inv, o0[4 * g + 3] * inv);
      *(unsigned*)(op + 32 + 8 * g) = pk_fp8x4c(o1[4 * g] * inv, o1[4 * g + 1] * inv, o1[4 * g + 2] * inv, o1[4 * g + 3] * inv);
    }
  }
}

__device__ void ph_rwkv_mix(KP p, int layer) {
  const int j = layer >> 1;
  const int tid = opaque_tid();
  const int lane = tid & 63, wave = tid >> 6;
  const float* mu = p->rwkv_mu + j * 6 * 512;
  const int c0 = lane * 8;
  auto unpack = [](const u32x4 u, float (&f)[8]) {
    f[0] = bflo(u.x); f[1] = bfhi(u.x); f[2] = bflo(u.y); f[3] = bfhi(u.y);
    f[4] = bflo(u.z); f[5] = bfhi(u.z); f[6] = bflo(u.w); f[7] = bfhi(u.w);
  };
  auto pack = [](const float (&f)[8]) {
    u32x4 o;
    o.x = pk_bf16(f[0], f[1]); o.y = pk_bf16(f[2], f[3]); o.z = pk_bf16(f[4], f[5]); o.w = pk_bf16(f[6], f[7]);
    return o;
  };
  for (int t = blockIdx.x * 4 + wave; t < NT; t += gridDim.x * 4) {
    bool hasp, hasn;
    if (t < NL) { int s = t & 2047; hasp = s > 0; hasn = s < SEQ - 1; }
    else { int s = (t - NL) & 255; hasp = s > 0; hasn = s < CTXL - 1; }
    const bf16_t* pt = p->P + (size_t)t * LDP + c0;
    bf16_t* rw = p->RW + (size_t)t * RWS + c0;
    bf16_t* zb = p->Zb + (size_t)t * 1536 + c0;
    const u32x4 zero = {0u, 0u, 0u, 0u};
#pragma unroll
    for (int q = 0; q < 4; ++q) {
      float cur[8], pv[8], nx[8], d[8];
      unpack(*(const u32x4*)(pt + q * 512), cur);
      unpack(hasp ? *(const u32x4*)(pt + q * 512 - LDP) : zero, pv);
      unpack(hasn ? *(const u32x4*)(pt + q * 512 + LDP) : zero, nx);
#pragma unroll
      for (int e = 0; e < 8; ++e) d[e] = 0.5f * (pv[e] + nx[e]) - cur[e];
      if (q < 3) {
        float o[8];
        const float* m = mu + q * 512 + c0;
#pragma unroll
        for (int e = 0; e < 8; ++e) o[e] = cur[e] + d[e] * m[e];
        if (q == 0) *(u32x4*)(rw) = pack(o);
        else if (q == 2) *(u32x4*)(rw + 512) = pack(o);
        else {
          *(u32x4*)(rw + 10 * 512) = pack(o);
          float kk[8], ss = 0.f;
          const float* kv0 = p->rwkv_kvec + (j * 2 + 0) * 512 + c0;
#pragma unroll
          for (int e = 0; e < 8; ++e) { kk[e] = o[e] * kv0[e]; ss += kk[e] * kk[e]; }
          ss += dppx<0xB1>(ss); ss += dppx<0x4E>(ss); ss += dppx<0x141>(ss);
          const float rn = rsqrtf(fmaxf(ss, 1e-24f));
#pragma unroll
          for (int e = 0; e < 8; ++e) kk[e] *= rn;
          *(u32x4*)(rw + 2 * 512) = pack(kk);
        }
      } else {
#pragma unroll
        for (int z = 0; z < 3; ++z) {
          float o[8];
          const float* m = mu + (3 + z) * 512 + c0;
#pragma unroll
          for (int e = 0; e < 8; ++e) o[e] = cur[e] + d[e] * m[e];
          *(u32x4*)(zb + z * 512) = pack(o);
        }
      }
    }
  }
}

constexpr int RS_STEP = 384;
constexpr int RS_TB = 16;
struct RwkvStage { u32x2 r, kk, e, ke, a, v; };
__device__ void rwkv_unit(KP p, int unit, float* sm, int tid) {
  const int ch = unit >> 1, hf = unit & 1;
  const int dir = ch >> 6, b = (ch >> 3) & 7, h = ch & 7;
  const int lane = tid & 63, w = tid >> 6, rl = lane >> 3, ks = lane & 7;
  float* ybuf = sm + 2 * RS_TB * RS_STEP;
  const int ss = tid >> 4, kq = tid & 15;
  auto gload = [&](int n, RwkvStage& g) {
    const int row = scan_row(dir, b, n * RS_TB + ss);
    const bf16_t* base = p->RW + (size_t)row * RWS + h * 64 + kq * 4;
    g.r = *(const u32x2*)(base);
    g.kk = *(const u32x2*)(base + 2 * 512);
    g.e = *(const u32x2*)(base + (3 + dir) * 512);
    g.ke = *(const u32x2*)(base + (5 + dir) * 512);
    g.a = *(const u32x2*)(base + (7 + dir) * 512);
    g.v = *(const u32x2*)(p->RW + (size_t)row * RWS + 512 + h * 64 + hf * 32 + (kq & 7) * 4);
  };
  auto swrite = [&](int buf, const RwkvStage& g) {
    float* sp = sm + (buf * RS_TB + ss) * RS_STEP;
    const float r0 = bflo(g.r.x), r1 = bfhi(g.r.x), r2 = bflo(g.r.y), r3 = bfhi(g.r.y);
    const float k0 = bflo(g.kk.x), k1 = bfhi(g.kk.x), k2 = bflo(g.kk.y), k3 = bfhi(g.kk.y);
    const float w0 = __expf(-bflo(g.e.x)), w1 = __expf(-bfhi(g.e.x)), w2 = __expf(-bflo(g.e.y)), w3 = __expf(-bfhi(g.e.y));
    const float e0 = bflo(g.ke.x), e1 = bfhi(g.ke.x), e2 = bflo(g.ke.y), e3 = bfhi(g.ke.y);
    const float a0 = k0 * bflo(g.a.x), a1 = k1 * bfhi(g.a.x), a2 = k2 * bflo(g.a.y), a3 = k3 * bfhi(g.a.y);
    *(float4*)(sp + kq * 4) = make_float4(k0, k1, k2, k3);
    *(float4*)(sp + 64 + kq * 4) = make_float4(w0 * r0, w1 * r1, w2 * r2, w3 * r3);
    *(float4*)(sp + 128 + kq * 4) = make_float4(w0, w1, w2, w3);
    *(float4*)(sp + 192 + kq * 4) = make_float4(a0, a1, a2, a3);
    *(float4*)(sp + 256 + kq * 4) = make_float4(e0, e1, e2, e3);
    if (kq < 8) *(float4*)(sp + 320 + kq * 4) = make_float4(bflo(g.v.x), bfhi(g.v.x), bflo(g.v.y), bfhi(g.v.y));
    float c1 = a0 * r0 + a1 * r1 + a2 * r2 + a3 * r3;
    float c2 = e0 * r0 + e1 * r1 + e2 * r2 + e3 * r3;
    c1 += dppx<0xB1>(c1); c2 += dppx<0xB1>(c2);
    c1 += dppx<0x4E>(c1); c2 += dppx<0x4E>(c2);
    c1 += dppx<0x141>(c1); c2 += dppx<0x141>(c2);
    c1 += dppx<0x140>(c1); c2 += dppx<0x140>(c2);
    if (kq == 0) { sp[352] = c1; sp[353] = c2; }
  };
  typedef float f2 __attribute__((ext_vector_type(2)));
  f2 S01 = {0.f, 0.f}, S23 = {0.f, 0.f}, S45 = {0.f, 0.f}, S67 = {0.f, 0.f};
  auto compute = [&](int n) {
    const float* bp = sm + (n & 1) * RS_TB * RS_STEP;
    float* yb = ybuf + (n & 1) * RS_TB * 32 + w * 8 + rl;
    struct Ops { f2 k[4], r[4], w[4], a[4], e[4]; float vv; f2 c; };
    auto ld = [&](int s, Ops& o) {
      const float* sq = bp + s * RS_STEP;
      const f2* sp = (const f2*)(sq + ks * 8);
#pragma unroll
      for (int i = 0; i < 4; ++i) { o.k[i] = sp[i]; o.r[i] = sp[32 + i]; o.w[i] = sp[64 + i]; o.a[i] = sp[96 + i]; o.e[i] = sp[128 + i]; }
      o.vv = sq[320 + w * 8 + rl]; o.c = *(const f2*)(sq + 352);
    };
    auto step = [&](const Ops& o) -> float {
      f2 sa2 = S01 * o.k[0];
      f2 y2 = S01 * o.r[0];
      sa2 = __builtin_elementwise_fma(S23, o.k[1], sa2); y2 = __builtin_elementwise_fma(S23, o.r[1], y2);
      sa2 = __builtin_elementwise_fma(S45, o.k[2], sa2); y2 = __builtin_elementwise_fma(S45, o.r[2], y2);
      sa2 = __builtin_elementwise_fma(S67, o.k[3], sa2); y2 = __builtin_elementwise_fma(S67, o.r[3], y2);
      float sa = sa2.x + sa2.y, y0 = y2.x + y2.y;
      sa += dppx<0xB1>(sa); y0 += dppx<0xB1>(y0);
      sa += dppx<0x4E>(sa); y0 += dppx<0x4E>(y0);
      sa += dppx<0x141>(sa); y0 += dppx<0x141>(y0);
      sa = -sa;
      const f2 sav = {sa, sa}, vvv = {o.vv, o.vv};
      S01 = __builtin_elementwise_fma(vvv, o.e[0], __builtin_elementwise_fma(sav, o.a[0], S01 * o.w[0]));
      S23 = __builtin_elementwise_fma(vvv, o.e[1], __builtin_elementwise_fma(sav, o.a[1], S23 * o.w[1]));
      S45 = __builtin_elementwise_fma(vvv, o.e[2], __builtin_elementwise_fma(sav, o.a[2], S45 * o.w[2]));
      S67 = __builtin_elementwise_fma(vvv, o.e[3], __builtin_elementwise_fma(sav, o.a[3], S67 * o.w[3]));
      return fmaf(o.vv, o.c.y, fmaf(sa, o.c.x, y0));
    };
    Ops oa, ob;
    ld(0, oa);
#pragma unroll 1
    for (int s = 0; s < RS_TB; s += 2) {
      __builtin_amdgcn_sched_barrier(0);
      ld(s + 1, ob);
      __builtin_amdgcn_sched_barrier(0);
      float y0 = step(oa);
      asm volatile("" : "+v"(y0));
      __builtin_amdgcn_sched_barrier(0);
      ld(s + 2, oa);
      __builtin_amdgcn_sched_barrier(0);
      float y1 = step(ob);
      asm volatile("" : "+v"(y1));
      __builtin_amdgcn_sched_barrier(0);
      if (ks == 0) { yb[s * 32] = y0; yb[(s + 1) * 32] = y1; }
    }
  };
  auto yout = [&](int n) {
    const int row = scan_row(dir, b, n * RS_TB + ss);
    const float* ys = ybuf + (n & 1) * RS_TB * 32 + ss * 32 + kq * 2;
    *(unsigned*)(p->P + (size_t)row * LDP + dir * 512 + h * 64 + hf * 32 + kq * 2) = pk_bf16(ys[0], ys[1]);
  };
  constexpr int NB = TSC / RS_TB;
  RwkvStage gA, gB;
  gload(0, gA);
  gload(1, gB);
  swrite(0, gA);
  gload(2, gA);
  __syncthreads();
  for (int n = 0; n < NB; n += 2) {
    compute(n);
    swrite(1, gB);
    if (n + 3 < NB) gload(n + 3, gB);
    __syncthreads();
    yout(n);
    compute(n + 1);
    if (n + 2 < NB) swrite(0, gA);
    if (n + 4 < NB) gload(n + 4, gA);
    __syncthreads();
    yout(n + 1);
  }
  __syncthreads();
}

__device__ void mlstm_s1(KP p, int layer, int tile, char* lds, int tid) {
  const int j = layer >> 1;
  const int ch = tile / NCHUNK, c = tile % NCHUNK;
  const int dir = ch >> 5, b = (ch >> 2) & 7, h = ch & 3;
  float* s_ws = (float*)(lds + META_OFF);
  int* s_row = (int*)(s_ws + 64);
  char* kimg = lds;
  char* vimg = lds + 16384;
  if (tid < 64) {
    const int row = scan_row(dir, b, c * 64 + tid);
    s_row[tid] = row;
    const float* g = p->GP + (size_t)row * 16;
    const float gi = g[(dir * 2) * 4 + h] + p->mlstm_gate_b[j * 16 + (dir * 2) * 4 + h];
    const float gf = g[(dir * 2 + 1) * 4 + h] + p->mlstm_gate_b[j * 16 + (dir * 2 + 1) * 4 + h];
    float bc = -softplus_f(-gf);
#pragma unroll
    for (int o = 1; o < 64; o <<= 1) {
      float tmp = __shfl_up(bc, o);
      if (tid >= o) bc += tmp;
    }
    const float bend = __shfl(bc, 63);
    const float ds = bend - bc + gi;
    const float mloc = wmax(ds);
    s_ws[tid] = expf(ds - mloc);
    if (tid == 0) { p->msc[tile] = mloc; p->msc[NMT + tile] = bend; }
  }
  __syncthreads();
  {
    const int c8 = tid & 15;
    const int ioff = (c8 >> 2) * 4096 + (c8 & 3) * 16;
#pragma unroll
    for (int i = 0; i < 4; ++i) {
      const int sidx = (tid >> 4) + 16 * i;
      const bf16_t* src = p->P + (size_t)s_row[sidx] * LDP + h * 128 + c8 * 8;
      const u32x4 kv = *(const u32x4*)(src + 2560);
      u32x4 vv = *(const u32x4*)(src + 3072);
      const float wsv = s_ws[sidx];
      vv.x = pk_bf16(bflo(vv.x) * wsv, bfhi(vv.x) * wsv); vv.y = pk_bf16(bflo(vv.y) * wsv, bfhi(vv.y) * wsv);
      vv.z = pk_bf16(bflo(vv.z) * wsv, bfhi(vv.z) * wsv); vv.w = pk_bf16(bflo(vv.w) * wsv, bfhi(vv.w) * wsv);
      *(u32x4*)(kimg + ioff + sidx * 64) = kv;
      *(u32x4*)(vimg + ioff + sidx * 64) = vv;
    }
  }
  __syncthreads();
  const int lane = tid & 63, w = tid >> 6, wm = w >> 1, wn = w & 1, r32 = lane & 31, hi = lane >> 5;
  f32x16 acc[2][2];
#pragma unroll
  for (int mi = 0; mi < 2; ++mi)
#pragma unroll
    for (int ni = 0; ni < 2; ++ni)
#pragma unroll
      for (int q = 0; q < 16; ++q) acc[mi][ni][q] = 0.f;
  const int toff = ((lane >> 4) & 1) * 32 + (lane & 3) * 8 + ((lane & 15) >> 2) * 64 + hi * 256;
#pragma unroll
  for (int ks = 0; ks < 4; ++ks) {
    bf16x8 af[2], bfr[2];
#pragma unroll
    for (int i = 0; i < 2; ++i) {
      const char* ka = kimg + (wm * 2 + i) * 4096 + toff + (16 * ks) * 64;
      const char* va = vimg + (wn * 2 + i) * 4096 + toff + (16 * ks) * 64;
      af[i] = __builtin_shufflevector(vtr(ka), vtr(ka + 8 * 64), 0, 1, 2, 3, 4, 5, 6, 7);
      bfr[i] = __builtin_shufflevector(vtr(va), vtr(va + 8 * 64), 0, 1, 2, 3, 4, 5, 6, 7);
    }
    acc[0][0] = MFMA32(af[0], bfr[0], acc[0][0]);
    acc[0][1] = MFMA32(af[0], bfr[1], acc[0][1]);
    acc[1][0] = MFMA32(af[1], bfr[0], acc[1][0]);
    acc[1][1] = MFMA32(af[1], bfr[1], acc[1][1]);
  }
  bf16_t* ust = (bf16_t*)(lds + 32768);
#pragma unroll
  for (int mi = 0; mi < 2; ++mi)
#pragma unroll
    for (int ni = 0; ni < 2; ++ni)
#pragma unroll
      for (int q = 0; q < 16; ++q) {
        const int d = wm * 64 + mi * 32 + (q & 3) + 8 * (q >> 2) + 4 * hi;
        ust[d * 128 + wn * 64 + ni * 32 + r32] = f2bf(acc[mi][ni][q]);
        if ((q & 3) == 3) __builtin_amdgcn_sched_barrier(0);
      }
  __syncthreads();
  {
    const u32x4* us4 = (const u32x4*)ust;
    u32x4* U4 = (u32x4*)(p->MS + (size_t)tile * 16384);
#pragma unroll
    for (int i = 0; i < 8; ++i) U4[tid + 256 * i] = us4[tid + 256 * i];
  }
  if (tid < 128) {
    const char* kc = kimg + (tid >> 5) * 4096 + (tid & 31) * 2;
    float a = 0.f;
#pragma unroll 8
    for (int sidx = 0; sidx < 64; ++sidx) a = fmaf(s_ws[sidx], bf2f(*(const bf16_t*)(kc + sidx * 64)), a);
    p->MSn[tile * 128 + tid] = a;
  }
}

__device__ void mlstm_s3(KP p, int layer, int tile, char* lds, int tid);
__device__ void ph_scan_a(KP p, int layer, char* smc) {
  float* sm = (float*)smc;
  const int tid = opaque_tid();
  __builtin_amdgcn_s_setprio(3);
  for (int u = blockIdx.x; u < 256; u += gridDim.x) rwkv_unit(p, u, sm, tid);
  __builtin_amdgcn_s_setprio(0);
  {
    const int stage = layer == 1 ? 1 : 2;
    const int nconv = conv_stage_total(stage);
    const int total = NMT + (nconv + 7) / 8;
    int* qc = (int*)(p->bar + XCD_BAR_WORDS + 16 * stage);
    int* s_q = (int*)(smc + META_OFF + 3968);
    int jj = 0, j1 = 0;
#pragma unroll 1
    for (;;) {
      if (jj >= j1) {
        __syncthreads();
        if (tid == 0) *s_q = atomicAdd(qc, 1);
        __syncthreads();
        const int q = *s_q;
        if (q >= total) break;
        if (q < NMT) { mlstm_s3(p, layer, q, smc, tid); continue; }
        jj = (q - NMT) * 8; j1 = min(jj + 8, nconv);
      }
      convert_run(p, stage, jj, j1, sm, tid);
      jj = j1;
    }
  }
}

__device__ void ph_mlstm_s2(KP p, char* smc) {
  float* sw = (float*)smc;
  const int tid = opaque_tid();
  const int nitems = 64 * 33;
  for (int item = blockIdx.x; item < nitems; item += gridDim.x) {
    const int ch = item / 33, seg = item % 33;
    __syncthreads();
    if (tid < 2 * NCHUNK) sw[72 + tid] = p->msc[(tid < NCHUNK ? 0 : NMT - NCHUNK) + ch * NCHUNK + tid];
    __syncthreads();
    if (tid == 0) {
      float m = 0.f;
      for (int c = 0; c < NCHUNK; ++c) {
        const int tile = ch * NCHUNK + c;
        const float mloc = sw[72 + c], bend = sw[72 + NCHUNK + c];
        const float mn = fmaxf(bend + m, mloc);
        sw[c] = expf(bend + m - mn);
        sw[36 + c] = expf(mloc - mn);
        if (seg == 0) p->msc[2 * NMT + tile] = m;
        m = mn;
      }
    }
    __syncthreads();
    if (seg < 32) {
      unsigned* base = (unsigned*)(p->MS + (size_t)ch * NCHUNK * 16384) + seg * 256 + tid;
      unsigned v[NCHUNK];
#pragma unroll
      for (int c = 0; c < NCHUNK; ++c) v[c] = base[(size_t)c * 8192];
      float C0 = 0.f, C1 = 0.f;
#pragma unroll
      for (int c = 0; c < NCHUNK; ++c) {
        const float t0 = bflo(v[c]), t1 = bfhi(v[c]);
        v[c] = pk_bf16(C0, C1);
        C0 = sw[c] * C0 + sw[36 + c] * t0;
        C1 = sw[c] * C1 + sw[36 + c] * t1;
      }
#pragma unroll
      for (int c = 0; c < NCHUNK; ++c) base[(size_t)c * 8192] = v[c];
    } else if (tid < 128) {
      float* base = p->MSn + (size_t)ch * NCHUNK * 128 + tid;
      float v[NCHUNK];
#pragma unroll
      for (int c = 0; c < NCHUNK; ++c) v[c] = base[c * 128];
      float C = 0.f;
#pragma unroll
      for (int c = 0; c < NCHUNK; ++c) {
        const float t0 = v[c];
        v[c] = C;
        C = sw[c] * C + sw[36 + c] * t0;
      }
#pragma unroll
      for (int c = 0; c < NCHUNK; ++c) base[c * 128] = v[c];
    }
  }
}

__device__ void mlstm_s3(KP p, int layer, int tile, char* lds, int tid) {
  const int j = layer >> 1;
  const int ch = tile / NCHUNK, c = tile % NCHUNK;
  const int dir = ch >> 5, b = (ch >> 2) & 7, h = ch & 3;
  float* s_b = (float*)(lds + META_OFF);
  float* s_ig = s_b + 64;
  float* s_mt = s_b + 128;
  float* s_wi = s_b + 192;
  int* s_row = (int*)(s_b + 256);
  float* s_n = s_b + 320;
  float* s_c = s_b + 448;
  char* kimg = lds;
  char* vimg = lds + 16384;
  char* cimg = lds + 32768;
  const float mprev = p->msc[2 * NMT + tile];
  const float qscale = 0.08838834764831845f;
  const int lane = tid & 63, w = tid >> 6, wt = w >> 1, wv = w & 1, r32 = lane & 31, hi = lane >> 5;
  const int t = wt * 32 + r32;
  const int rowq = scan_row(dir, b, c * 64 + t);
  const int c8 = tid & 15;
  u32x4 kr[4], vr[4], cr[8];
#pragma unroll
  for (int i = 0; i < 4; ++i) {
    const int sidx = (tid >> 4) + 16 * i;
    const bf16_t* src = p->P + (size_t)scan_row(dir, b, c * 64 + sidx) * LDP + h * 128 + c8 * 8;
    kr[i] = *(const u32x4*)(src + 2560);
    vr[i] = *(const u32x4*)(src + 3072);
  }
  {
    const bf16_t* Cp = p->MS + (size_t)tile * 16384;
#pragma unroll
    for (int i = 0; i < 8; ++i) cr[i] = *(const u32x4*)(Cp + ((tid >> 4) + 16 * i) * 128 + c8 * 8);
  }
  bf16x8 qf[8];
  {
    const bf16_t* qp = p->P + (size_t)rowq * LDP + 2048 + h * 128 + hi * 8;
#pragma unroll
    for (int d0 = 0; d0 < 8; ++d0) qf[d0] = *(const bf16x8*)(qp + d0 * 16);
  }
  if (tid < 64) {
    const int row = scan_row(dir, b, c * 64 + tid);
    s_row[tid] = row;
    const float* g = p->GP + (size_t)row * 16;
    const float gi = g[(dir * 2) * 4 + h] + p->mlstm_gate_b[j * 16 + (dir * 2) * 4 + h];
    const float gf = g[(dir * 2 + 1) * 4 + h] + p->mlstm_gate_b[j * 16 + (dir * 2 + 1) * 4 + h];
    float bc = -softplus_f(-gf);
#pragma unroll
    for (int o = 1; o < 64; o <<= 1) {
      float tmp = __shfl_up(bc, o);
      if (tid >= o) bc += tmp;
    }
    float pm = gi - bc;
#pragma unroll
    for (int o = 1; o < 64; o <<= 1) {
      float tmp = __shfl_up(pm, o);
      if (tid >= o) pm = fmaxf(pm, tmp);
    }
    const float mt = bc + fmaxf(mprev, pm);
    s_b[tid] = bc;
    s_ig[tid] = gi;
    s_mt[tid] = mt;
    s_wi[tid] = expf(bc + mprev - mt);
    s_c[tid] = (gi - bc) * 1.4426950408889634f;
  } else if (tid < 192) s_n[tid - 64] = p->MSn[tile * 128 + (tid - 64)];
  {
    const int ioff = (c8 >> 2) * 4096 + (c8 & 3) * 16;
#pragma unroll
    for (int i = 0; i < 4; ++i) {
      const int sidx = (tid >> 4) + 16 * i;
      *(u32x4*)(kimg + sidx * 256 + ((c8 ^ (sidx & 15)) * 16)) = kr[i];
      *(u32x4*)(vimg + ioff + sidx * 64) = vr[i];
    }
    const int coff = (c8 >> 2) * 8192 + (c8 & 3) * 16;
#pragma unroll
    for (int i = 0; i < 8; ++i) *(u32x4*)(cimg + coff + ((tid >> 4) + 16 * i) * 64) = cr[i];
  }
  __syncthreads();
  const int toff = ((lane >> 4) & 1) * 32 + (lane & 3) * 8 + ((lane & 15) >> 2) * 64;
  constexpr float LOG2E_ = 1.4426950408889634f;
  float qn = 0.f;
#pragma unroll
  for (int d0 = 0; d0 < 8; ++d0) {
    const u32x4 qq = __builtin_bit_cast(u32x4, qf[d0]);
    const float* np = s_n + d0 * 16 + hi * 8;
    qn = fmaf(bflo(qq.x), np[0], qn); qn = fmaf(bfhi(qq.x), np[1], qn);
    qn = fmaf(bflo(qq.y), np[2], qn); qn = fmaf(bfhi(qq.y), np[3], qn);
    qn = fmaf(bflo(qq.z), np[4], qn); qn = fmaf(bfhi(qq.z), np[5], qn);
    qn = fmaf(bflo(qq.w), np[6], qn); qn = fmaf(bfhi(qq.w), np[7], qn);
  }
  qn += __shfl_xor(qn, 32);
  const float mtt = s_mt[t], wi = s_wi[t];
  const float ct = (s_b[t] - mtt) * LOG2E_;
  const float wq = wi * qscale;
  bf16x8 pf[4];
  float den = 0.f;
  {
    f32x16 sa0, sa1;
#pragma unroll
    for (int q = 0; q < 16; ++q) { sa0[q] = 0.f; sa1[q] = 0.f; }
#pragma unroll
    for (int d0 = 0; d0 < 8; ++d0) {
      const int chn = 2 * d0 + hi;
      const bf16x8 k0 = *(const bf16x8*)(kimg + r32 * 256 + ((chn ^ (r32 & 15)) * 16));
      sa0 = MFMA32(k0, qf[d0], sa0);
      if (wt) {
        const bf16x8 k1 = *(const bf16x8*)(kimg + (32 + r32) * 256 + ((chn ^ (r32 & 15)) * 16));
        sa1 = MFMA32(k1, qf[d0], sa1);
      }
      __builtin_amdgcn_sched_barrier(0);
    }
#pragma unroll
    for (int g = 0; g < 4; ++g) {
      const int sb0 = 8 * g + 4 * hi;
      const float4 c0v = *(const float4*)(s_c + sb0);
      const float4 c1v = *(const float4*)(s_c + sb0 + 32);
      const float cc0[4] = {c0v.x, c0v.y, c0v.z, c0v.w}, cc1[4] = {c1v.x, c1v.y, c1v.z, c1v.w};
#pragma unroll
      for (int e = 0; e < 4; ++e) {
        const int q = 4 * g + e;
        const float v0 = (sb0 + e <= t) ? sa0[q] * qscale * __builtin_amdgcn_exp2f(ct + cc0[e]) : 0.f;
        sa0[q] = v0; den += v0;
        const float v1 = (wt && sb0 + 32 + e <= t) ? sa1[q] * qscale * __builtin_amdgcn_exp2f(ct + cc1[e]) : 0.f;
        sa1[q] = v1; den += v1;
      }
      __builtin_amdgcn_sched_barrier(0);
    }
#pragma unroll
    for (int sx = 0; sx < 4; ++sx) {
      const int u = (sx & 1) * 8;
      u32x4 tpk;
      if (sx < 2) {
        tpk.x = pk_bf16(sa0[u + 0], sa0[u + 1]); tpk.y = pk_bf16(sa0[u + 2], sa0[u + 3]);
        tpk.z = pk_bf16(sa0[u + 4], sa0[u + 5]); tpk.w = pk_bf16(sa0[u + 6], sa0[u + 7]);
      } else {
        tpk.x = pk_bf16(sa1[u + 0], sa1[u + 1]); tpk.y = pk_bf16(sa1[u + 2], sa1[u + 3]);
        tpk.z = pk_bf16(sa1[u + 4], sa1[u + 5]); tpk.w = pk_bf16(sa1[u + 6], sa1[u + 7]);
      }
      pf[sx] = __builtin_bit_cast(bf16x8, tpk);
    }
  }
  den += __shfl_xor(den, 32);
  const float dtot = den + wq * qn;
  const float inv = 1.f / fmaxf(fabsf(dtot), expf(-mtt));
  bf16_t* op = p->P + (size_t)rowq * LDP + 1024 + dir * 512 + h * 128 + wv * 64 + 4 * hi;
#pragma unroll 1
  for (int vp = 0; vp < 2; ++vp) {
    f32x16 o0;
#pragma unroll
    for (int q = 0; q < 16; ++q) o0[q] = 0.f;
    const char* cb = cimg + (wv * 2 + vp) * 8192 + toff + hi * 512;
#pragma unroll
    for (int d0 = 0; d0 < 8; ++d0) {
      const bf16x8 A0 = __builtin_shufflevector(vtr(cb + (16 * d0) * 64), vtr(cb + (16 * d0 + 4) * 64), 0, 1, 2, 3, 4, 5, 6, 7);
      o0 = MFMA32(A0, qf[d0], o0);
    }
#pragma unroll
    for (int q = 0; q < 16; ++q) o0[q] *= wq;
    const char* vb = vimg + (wv * 2 + vp) * 4096 + toff + hi * 256;
#pragma unroll
    for (int sx = 0; sx < 4; ++sx) {
      if (sx < 2 || wt) {
        const bf16x8 A0 = __builtin_shufflevector(vtr(vb + (16 * sx) * 64), vtr(vb + (16 * sx + 8) * 64), 0, 1, 2, 3, 4, 5, 6, 7);
        o0 = MFMA32(A0, pf[sx], o0);
      }
    }
#pragma unroll
    for (int g = 0; g < 4; ++g) {
      u32x2 v0;
      v0.x = pk_bf16(o0[4 * g] * inv, o0[4 * g + 1] * inv); v0.y = pk_bf16(o0[4 * g + 2] * inv, o0[4 * g + 3] * inv);
      *(u32x2*)(op + vp * 32 + 8 * g) = v0;
    }
  }
}

__device__ void ph_mlstm_s1(KP p, int layer, char* smc) {
  const int tid = opaque_tid();
  __syncthreads();
  for (int tile = blockIdx.x; tile < NMT; tile += gridDim.x) { mlstm_s1(p, layer, tile, smc, tid); __syncthreads(); }
}

__device__ void ph_rec_final(KP p, int layer, bool keep) {
  const int tid = opaque_tid();
  const int j = layer >> 1;
  const int lane = tid & 63, wave = tid >> 6;
  const int rows = keep ? NT : NL;
  const int c0 = lane * 8;
  auto unpack = [](const u32x4 u, float (&f)[8]) {
    f[0] = bflo(u.x); f[1] = bfhi(u.x); f[2] = bflo(u.y); f[3] = bfhi(u.y);
    f[4] = bflo(u.z); f[5] = bfhi(u.z); f[6] = bflo(u.w); f[7] = bfhi(u.w);
  };
  for (int t = blockIdx.x * 4 + wave; t < rows; t += gridDim.x * 4) {
    const bf16_t* rw = p->RW + (size_t)t * RWS + c0;
    const bf16_t* pt = p->P + (size_t)t * LDP + c0;
    unsigned char* mo = (unsigned char*)p->AB + (size_t)t * DM + c0;
    {
      float yf[8], yb[8], r[8], v[8], k0[8], k1[8], g[8], y[8], o[8];
      unpack(*(const u32x4*)(pt), yf); unpack(*(const u32x4*)(pt + 512), yb);
      unpack(*(const u32x4*)(rw), r); unpack(*(const u32x4*)(rw + 512), v);
      unpack(*(const u32x4*)(rw + 5 * 512), k0); unpack(*(const u32x4*)(rw + 6 * 512), k1);
      unpack(*(const u32x4*)(rw + 9 * 512), g);
      float s1 = 0.f, bs = 0.f;
      const float* rk = p->rwkv_rk + j * 512 + c0;
#pragma unroll
      for (int e = 0; e < 8; ++e) { y[e] = yf[e] + yb[e]; s1 += y[e]; bs += r[e] * rk[e] * (k0[e] + k1[e]); }
      s1 += dppx<0xB1>(s1); s1 += dppx<0x4E>(s1); s1 += dppx<0x141>(s1);
      bs += dppx<0xB1>(bs); bs += dppx<0x4E>(bs); bs += dppx<0x141>(bs);
      const float mu = s1 * (1.f / 64.f);
      float s2 = 0.f;
#pragma unroll
      for (int e = 0; e < 8; ++e) { const float d = y[e] - mu; s2 += d * d; }
      s2 += dppx<0xB1>(s2); s2 += dppx<0x4E>(s2); s2 += dppx<0x141>(s2);
      const float rs = rsqrtf(s2 * (1.f / 64.f) + 64e-5f);
      const float* gn0 = p->rwkv_gn + (j * 2 + 0) * 512 + c0;
      const float* gn1 = p->rwkv_gn + (j * 2 + 1) * 512 + c0;
#pragma unroll
      for (int e = 0; e < 8; ++e) o[e] = ((y[e] - mu) * rs * gn0[e] + gn1[e] + bs * v[e]) * g[e];
      u32x2 ov;
      ov.x = pk_fp8x4c(o[0], o[1], o[2], o[3]); ov.y = pk_fp8x4c(o[4], o[5], o[6], o[7]);
      *(u32x2*)(mo) = ov;
    }
    {
      float hf[8], hb[8], og[8], hsum[8], o[8];
      unpack(*(const u32x4*)(pt + 1024), hf); unpack(*(const u32x4*)(pt + 1536), hb);
      unpack(*(const u32x4*)(pt + 3584), og);
      float ss = 0.f;
#pragma unroll
      for (int e = 0; e < 8; ++e) { hsum[e] = hf[e] + hb[e]; ss += hsum[e] * hsum[e]; }
      ss += dppx<0xB1>(ss); ss += dppx<0x4E>(ss); ss += dppx<0x141>(ss); ss += dppx<0x140>(ss);
      const float rs = rsqrtf(ss * (1.f / 128.f) + 1e-6f);
      const float* ng = p->mlstm_norm + j * 512 + c0;
#pragma unroll
      for (int e = 0; e < 8; ++e) o[e] = hsum[e] * rs * ng[e] * sigm_f(og[e]);
      u32x2 ov;
      ov.x = pk_fp8x4c(o[0], o[1], o[2], o[3]); ov.y = pk_fp8x4c(o[4], o[5], o[6], o[7]);
      *(u32x2*)(mo + 512) = ov;
    }
  }
}

using f32x4v = __attribute__((ext_vector_type(4))) float;
__device__ void ph_ln_router(KP p, int layer, bool keep, char* smc) {
  float* h2s = (float*)smc;
  float* lgs = (float*)smc;
  const int tid = opaque_tid();
  const int lane = tid & 63, wave = tid >> 6;
  const int rows = keep ? NT : NL;
  const float* lng = p->ln_g + (layer * 2 + 0) * 1024;
  const float* lnb = p->ln_b + (layer * 2 + 0) * 1024;
  for (int tile = blockIdx.x; tile < rows / 16; tile += gridDim.x) {
    const int t0 = tile * 16;
    const float* mod = p->MOD + (layer * 9 + modrow(t0)) * 6144;
    const float* brow = p->WrT + ((size_t)layer * 64 + 16 * wave + (lane & 15)) * 1024 + 4 * (lane >> 4);
    f32x4v b0[8], b1[8], b2[8];
#pragma unroll
    for (int q = 0; q < 8; ++q) { b0[q] = *(const f32x4v*)(brow + 16 * q); b1[q] = *(const f32x4v*)(brow + 16 * (8 + q)); }
    __builtin_amdgcn_sched_barrier(0);
    {
      float4 v[4][4];
      float s4[4];
#pragma unroll
      for (int q = 0; q < 4; ++q) {
        const int t = t0 + wave * 4 + q;
        s4[q] = 0.f;
#pragma unroll
        for (int i = 0; i < 4; ++i) v[q][i] = *(const float4*)(p->Tb + (size_t)t * DM + i * 256 + lane * 4);
      }
#pragma unroll
      for (int q = 0; q < 4; ++q)
#pragma unroll
        for (int i = 0; i < 4; ++i) s4[q] += (v[q][i].x + v[q][i].y) + (v[q][i].z + v[q][i].w);
      float mean4[4], rs4[4];
#pragma unroll
      for (int q = 0; q < 4; ++q) mean4[q] = wsum(s4[q]) * (1.f / 1024.f);
#pragma unroll
      for (int q = 0; q < 4; ++q) {
        float qq = 0.f;
#pragma unroll
        for (int i = 0; i < 4; ++i) {
          const float d0 = v[q][i].x - mean4[q], d1 = v[q][i].y - mean4[q], d2 = v[q][i].z - mean4[q], d3 = v[q][i].w - mean4[q];
          qq += (d0 * d0 + d1 * d1) + (d2 * d2 + d3 * d3);
        }
        s4[q] = qq;
      }
#pragma unroll
      for (int q = 0; q < 4; ++q) rs4[q] = rsqrtf(wsum(s4[q]) * (1.f / 1024.f) + 1e-5f);
#pragma unroll
      for (int i = 0; i < 4; ++i) {
        const int n = i * 256 + lane * 4;
        const float4 g = *(const float4*)(lng + n), bb = *(const float4*)(lnb + n);
        const float4 sc = *(const float4*)(mod + 4096 + n), sh = *(const float4*)(mod + 3072 + n);
#pragma unroll
        for (int q = 0; q < 4; ++q) {
          const int tl = wave * 4 + q, t = t0 + tl;
          const float mean = mean4[q], rs = rs4[q];
          const float4 xn = make_float4((v[q][i].x - mean) * rs * g.x + bb.x, (v[q][i].y - mean) * rs * g.y + bb.y,
                                        (v[q][i].z - mean) * rs * g.z + bb.z, (v[q][i].w - mean) * rs * g.w + bb.w);
          *(float4*)(p->X + (size_t)t * DM + n) = xn;
          const float4 hh = make_float4(xn.x * (1.f + sc.x) + sh.x, xn.y * (1.f + sc.y) + sh.y,
                                        xn.z * (1.f + sc.z) + sh.z, xn.w * (1.f + sc.w) + sh.w);
          *(unsigned*)((unsigned char*)p->AB + (size_t)t * DM + n) = pk_fp8x4(hh.x, hh.y, hh.z, hh.w);
          *(float4*)(h2s + tl * 1028 + n) = hh;
        }
      }
    }
    __syncthreads();
    f32x4v acc = {0.f, 0.f, 0.f, 0.f};
    {
      f32x4v a1 = {0.f, 0.f, 0.f, 0.f}, a2 = {0.f, 0.f, 0.f, 0.f}, a3 = {0.f, 0.f, 0.f, 0.f};
      const int i = lane & 15, kk = lane >> 4;
      const float* arow = h2s + i * 1028 + 4 * kk;
#define ROUTER_LOAD(B, Q0) _Pragma("unroll") for (int q = 0; q < 8; ++q) B[q] = *(const f32x4v*)(brow + 16 * ((Q0) + q)); __builtin_amdgcn_sched_barrier(0);
#define ROUTER_MFMA(B, Q0) _Pragma("unroll") for (int q = 0; q < 8; ++q) { \
        const float4 a = *(const float4*)(arow + 16 * ((Q0) + q)); \
        acc = __builtin_amdgcn_mfma_f32_16x16x4f32(a.x, B[q].x, acc, 0, 0, 0); \
        a1 = __builtin_amdgcn_mfma_f32_16x16x4f32(a.y, B[q].y, a1, 0, 0, 0); \
        a2 = __builtin_amdgcn_mfma_f32_16x16x4f32(a.z, B[q].z, a2, 0, 0, 0); \
        a3 = __builtin_amdgcn_mfma_f32_16x16x4f32(a.w, B[q].w, a3, 0, 0, 0); } __builtin_amdgcn_sched_barrier(0);
      ROUTER_LOAD(b2, 16) ROUTER_MFMA(b0, 0)
      ROUTER_LOAD(b0, 24) ROUTER_MFMA(b1, 8)
      ROUTER_LOAD(b1, 32) ROUTER_MFMA(b2, 16)
      ROUTER_LOAD(b2, 40) ROUTER_MFMA(b0, 24)
      ROUTER_LOAD(b0, 48) ROUTER_MFMA(b1, 32)
      ROUTER_LOAD(b1, 56) ROUTER_MFMA(b2, 40)
      ROUTER_MFMA(b0, 48)
      ROUTER_MFMA(b1, 56)
      acc = (acc + a1) + (a2 + a3);
    }
    __syncthreads();
#pragma unroll
    for (int r = 0; r < 4; ++r) lgs[((lane >> 4) * 4 + r) * 64 + 16 * wave + (lane & 15)] = acc[r];
    __syncthreads();
    {
      float score4[4], gate4[4];
      int kidx4[4], pos4[4];
      bool chosen4[4];
#pragma unroll
      for (int q = 0; q < 4; ++q) {
        const int tl = wave * 4 + q;
        const float logit = lgs[tl * 64 + lane];
        const float score = sigm_f(logit);
        float sel = score + p->moe_bias[layer * 64 + lane];
        bool chosen = false;
        for (int r = 0; r < 6; ++r) {
          const float mx = wmax(sel);
          const unsigned long long bal = __ballot(sel == mx);
          const int first = __ffsll((long long)bal) - 1;
          if (lane == first) { chosen = true; sel = -INFINITY; }
        }
        const float gsum = wsum(chosen ? score : 0.f);
        const unsigned long long cb = __ballot(chosen);
        score4[q] = score; gate4[q] = score / gsum * 2.5f; chosen4[q] = chosen;
        kidx4[q] = __popcll(cb & ((1ull << lane) - 1ull));
      }
#pragma unroll
      for (int q = 0; q < 4; ++q) pos4[q] = chosen4[q] ? atomicAdd(&p->cnt[lane * CSTR], 1) : 0;
#pragma unroll
      for (int q = 0; q < 4; ++q) {
        const int t = t0 + wave * 4 + q;
        if (chosen4[q]) {
          p->ltok[(size_t)lane * NT + pos4[q]] = t;
          p->lgate[(size_t)lane * NT + pos4[q]] = gate4[q];
          p->tsl[t * 6 + kidx4[q]] = (lane << 16) | pos4[q];
        }
      }
    }
    __syncthreads();
  }
}

__device__ __forceinline__ void moe_prefix(KP p, int rows, int* s_pref, int tid) {
  if (tid < 64) s_pref[322 + tid] = p->cnt[tid * CSTR];
  __syncthreads();
  if (tid == 0) {
    int a = 0;
    for (int e = 0; e < 64; ++e) { s_pref[e] = a; a += (s_pref[322 + e] + 127) >> 7; }
    s_pref[64] = a; a += rows >> 7;
    s_pref[65] = a;
  }
  __syncthreads();
}

__device__ void ph_gemm(KP p, int kind, int layer, bool keep, char* lds) {
  const int tid = opaque_tid();
  const int j = layer >> 1;
  const bool att = !(layer & 1);
  const int rows = keep ? NT : NL;
  int* pref = (int*)(lds + META_OFF);
  int* s_idx = pref + 66;
  float* s_gate = (float*)(s_idx + 128);
  if (kind == 1 && blockIdx.x == 0 && tid < 65) p->cnt[tid * CSTR] = 0;
  int total;
  const int ntn_in = att ? 18 : 33;
  switch (kind) {
    case 0: total = (NT / 128) * ntn_in; break;
    case 1: total = (rows / 128) * 8; break;
    case 2: total = pref[65] * 4; break;
    case 3: total = pref[65] * 8; break;
    case 4: total = (NT / 128) * 3; break;
    default: total = (NT / 128) * 20; break;
  }
  const bool moe = kind == 2 || kind == 3;
  const int tsh = kind == 2 ? 2 : 3;
  int e_nx = 0, idx_nx = tid; float g_nx = 1.f;
  auto fetch_moe = [&](int tl) {
    const int mt = tl >> tsh;
    while (mt >= pref[e_nx + 1]) ++e_nx;
    idx_nx = tid; g_nx = 1.f;
    if (tid < 128) {
      const int pos = (mt - pref[e_nx]) * 128 + tid;
      if (kind == 2) {
        idx_nx = 0;
        if (e_nx < 64) { if (pos < pref[322 + e_nx]) idx_nx = p->ltok[(size_t)e_nx * NT + pos]; }
        else idx_nx = pos;
      } else if (e_nx < 64) g_nx = pos < pref[322 + e_nx] ? p->lgate[(size_t)e_nx * NT + pos] : 0.f;
    }
  };
  if (moe && (int)blockIdx.x < total) fetch_moe(blockIdx.x);
  for (int tile = blockIdx.x; tile < total; tile += gridDim.x) {
    const bf16_t* Abase; const bf16_t* Bt;
    int astride, K, n0, m0 = 0, aux = 0, e = e_nx, mtile = 0;
    switch (kind) {
      case 0: { const int tm = tile / ntn_in, tn = tile % ntn_in; m0 = tm * 128; n0 = tn * 128;
                Abase = (const bf16_t*)((const unsigned char*)p->AB + (size_t)m0 * DM); astride = DM; K = 1024;
                Bt = (const bf16_t*)(att ? (const unsigned char*)p->Wt_att + (size_t)j * ATT_N * 1024
                                         : (const unsigned char*)p->Wt_rec + (size_t)j * REC_NP * 1024); } break;
      case 1: { const int tm = tile >> 3, tn = tile & 7; m0 = tm * 128; n0 = tn * 128;
                Abase = (const bf16_t*)((const unsigned char*)p->AB + (size_t)m0 * DM); astride = DM; K = 1024;
                Bt = (const bf16_t*)((const unsigned char*)p->Wt_out + (size_t)layer * 1024 * 1024); } break;
      case 2: { mtile = tile >> 2; aux = tile & 3; n0 = aux * 128;
                Abase = p->AB; astride = DM; K = 1024;
                Bt = (const bf16_t*)((const unsigned char*)p->Wt13 + (size_t)(layer * 65 + e) * 512 * 1024); } break;
      case 3: { mtile = tile >> 3; aux = tile & 7; n0 = aux * 128;
                Abase = (const bf16_t*)((const unsigned char*)p->ACT + (size_t)mtile * 128 * 256); astride = 256; K = 256;
                Bt = (const bf16_t*)((const unsigned char*)p->Wt2 + (size_t)(layer * 65 + e) * 1024 * 256); } break;
      case 4: { const int tm = tile / 3; aux = tile % 3; m0 = tm * 128; n0 = 0;
                Abase = p->Zb + (size_t)m0 * 1536 + aux * 512; astride = 1536; K = 512; Bt = p->Wl1 + (size_t)(j * 3 + aux) * 128 * 512; } break;
      default: { const int tm = tile / 20; aux = tile % 20; m0 = tm * 128; n0 = aux * 128;
                const int grp = aux < 8 ? 0 : (aux < 16 ? 1 : 2);
                Abase = p->L1 + (size_t)m0 * 384 + grp * 128; astride = 384; K = 128; Bt = p->Wl2 + (size_t)j * 2560 * 128; } break;
    }
    if (tid < 128) { s_idx[tid] = idx_nx; s_gate[tid] = g_nx; }
    __syncthreads();
    if (moe && tile + (int)gridDim.x < total) fetch_moe(tile + gridDim.x);
    {
      f32x16 acc[2][2];
      if (kind <= 3) {
        const unsigned char* A8 = (const unsigned char*)Abase;
        gemm128_fp8(tid, [&](int r) { return A8 + (size_t)s_idx[r] * astride; }, (const unsigned char*)Bt, K, n0, lds, acc);
      } else
        gemm128_main(tid, [&](int r) { return Abase + (size_t)s_idx[r] * astride; }, Bt, K, n0, lds, acc);
      float* Ct = (float*)lds;
      acc_foreach(tid, acc, [&](int row, int col, float v) { Ct[row * 128 + col] = v; });
    }
    __syncthreads();
    {
      const float* Ct = (const float*)lds;
      int c4 = (tid & 31) * 4, r0 = tid >> 5;
      asm volatile("" : "+v"(c4), "+v"(r0));
      const int N_in = att ? ATT_N : REC_N;
      const int d5 = (aux >> 2) & 1, c05 = (aux & 3) * 128;
      switch (kind) {
        case 0: {
#pragma unroll 8
          for (int it = 0; it < 16; ++it) {
            const int row = it * 8 + r0;
            const float4 vraw = *(const float4*)(Ct + row * 128 + c4);
            const float4 v = make_float4(vraw.x * W8_INV, vraw.y * W8_INV, vraw.z * W8_INV, vraw.w * W8_INV);

            const int cn = n0 + c4;
            float4 vq = v;
            if (att && n0 >= 1536 && n0 < 2176) {
              float ss = v.x * v.x + v.y * v.y + v.z * v.z + v.w * v.w;
              ss += dppx<0xB1>(ss); ss += dppx<0x4E>(ss); ss += dppx<0x141>(ss); ss += dppx<0x140>(ss);
              const float rs = rsqrtf(ss * (1.f / 64.f) + 1e-6f);
              const float4 g = *(const float4*)(p->qk_gain + j * 128 + (n0 >= 2048 ? 64 : 0) + (cn & 63));
              vq = make_float4(v.x * rs * g.x, v.y * rs * g.y, v.z * rs * g.z, v.w * rs * g.w);
              const int t = m0 + row;
              if (t < NL) {
                const int sidx = t & 2047, pi0 = (cn & 63) >> 1;
                const int pos = pi0 < 16 ? (sidx >> 6) : (sidx & 63);
                const float4 cs = *(const float4*)(p->ROPE + (pos * 16 + (pi0 & 15)) * 2);
                vq = make_float4(vq.x * cs.x - vq.y * cs.y, vq.x * cs.y + vq.y * cs.x,
                                 vq.z * cs.z - vq.w * cs.w, vq.z * cs.w + vq.w * cs.z);
              }
            }
            if (cn < N_in) {
              u32x2 o; o.x = pk_bf16(vq.x, vq.y); o.y = pk_bf16(vq.z, vq.w);
              *(u32x2*)(p->P + (size_t)(m0 + row) * LDP + cn) = o;
            }
            if (!att && cn >= 4096 && cn < 4112) *(float4*)(p->GP + (size_t)(m0 + row) * 16 + (cn - 4096)) = v;
          }
        } break;
        case 1: {
#pragma unroll 16
          for (int it = 0; it < 16; ++it) {
            const int row = it * 8 + r0;
            const float4 v = *(const float4*)(Ct + row * 128 + c4);

            const size_t o = (size_t)(m0 + row) * DM + n0 + c4;
            const float4 xv = *(const float4*)(p->X + o);
            const float4 g = *(const float4*)(p->MOD + (layer * 9 + modrow(m0)) * 6144 + 2048 + n0 + c4);
            *(float4*)(p->Tb + o) = make_float4(DN_ALPHA * xv.x + g.x * (v.x * W8_INV), DN_ALPHA * xv.y + g.y * (v.y * W8_INV),
                                                DN_ALPHA * xv.z + g.z * (v.z * W8_INV), DN_ALPHA * xv.w + g.w * (v.w * W8_INV));
          }
        } break;
        case 2: {
#pragma unroll 8
          for (int it = 0; it < 16; ++it) {
            const int row = it * 8 + r0;
            const float4 v = *(const float4*)(Ct + row * 128 + c4);

            if (((c4 >> 5) & 1) == 0) {
              const float4 u = *(const float4*)(Ct + row * 128 + c4 + 32);
              const float a0 = v.x * W8_INV, a1 = v.y * W8_INV, a2 = v.z * W8_INV, a3 = v.w * W8_INV;
              *(unsigned*)((unsigned char*)p->ACT + ((size_t)mtile * 128 + row) * 256 + aux * 64 + (c4 >> 6) * 32 + (c4 & 31)) =
                  pk_fp8x4(silu_f(a0) * (u.x * W8_INV), silu_f(a1) * (u.y * W8_INV), silu_f(a2) * (u.z * W8_INV), silu_f(a3) * (u.w * W8_INV));
            }
          }
        } break;
        case 3: {
#pragma unroll 16
          for (int it = 0; it < 16; ++it) {
            const int row = it * 8 + r0;
            const float4 v = *(const float4*)(Ct + row * 128 + c4);

            const float g = s_gate[row] * W8_INV;
            u32x2 o; o.x = pk_bf16(g * v.x, g * v.y); o.y = pk_bf16(g * v.z, g * v.w);
            *(u32x2*)(p->OUT2 + ((size_t)mtile * 128 + row) * 1024 + n0 + c4) = o;
          }
        } break;
        case 4: {
#pragma unroll 4
          for (int it = 0; it < 16; ++it) {
            const int row = it * 8 + r0;
            const float4 v = *(const float4*)(Ct + row * 128 + c4);

            float4 o4 = v;
            if (aux == 0) o4 = make_float4(tanhf(v.x), tanhf(v.y), tanhf(v.z), tanhf(v.w));
            else if (aux == 2) o4 = make_float4(sigm_f(v.x), sigm_f(v.y), sigm_f(v.z), sigm_f(v.w));
            u32x2 o; o.x = pk_bf16(o4.x, o4.y); o.y = pk_bf16(o4.z, o4.w);
            *(u32x2*)(p->L1 + (size_t)(m0 + row) * 384 + aux * 128 + c4) = o;
          }
        } break;
        default: {
#pragma unroll 4
          for (int it = 0; it < 16; ++it) {
            const int row = it * 8 + r0;
            const float4 v = *(const float4*)(Ct + row * 128 + c4);

            bf16_t* rr = p->RW + (size_t)(m0 + row) * RWS + c05 + c4;
            const float vv[4] = {v.x, v.y, v.z, v.w};
            if (aux < 8) {
              const float4 b0 = *(const float4*)(p->rwkv_w0 + (j * 2 + d5) * 512 + c05 + c4);
              const float bb[4] = {b0.x, b0.y, b0.z, b0.w};
              float e4[4];
#pragma unroll
              for (int q = 0; q < 4; ++q) e4[q] = expf(-softplus_f(-(bb[q] + vv[q])) - 0.5f);
              u32x2 o; o.x = pk_bf16(e4[0], e4[1]); o.y = pk_bf16(e4[2], e4[3]);
              *(u32x2*)(rr + (3 + d5) * 512) = o;
            } else if (aux < 16) {
              const float4 b0 = *(const float4*)(p->rwkv_a0 + (j * 2 + d5) * 512 + c05 + c4);
              const float4 k1 = *(const float4*)(p->rwkv_kvec + (j * 2 + 1) * 512 + c05 + c4);
              const u32x2 kx2 = *(const u32x2*)(rr + 10 * 512);
              const float bb[4] = {b0.x, b0.y, b0.z, b0.w}, kk1[4] = {k1.x, k1.y, k1.z, k1.w};
              const float kx[4] = {bflo(kx2.x), bfhi(kx2.x), bflo(kx2.y), bfhi(kx2.y)};
              float av[4], ke[4];
#pragma unroll
              for (int q = 0; q < 4; ++q) { av[q] = sigm_f(bb[q] + vv[q]); ke[q] = kx[q] * (1.f + (av[q] - 1.f) * kk1[q]); }
              u32x2 o; o.x = pk_bf16(av[0], av[1]); o.y = pk_bf16(av[2], av[3]);
              *(u32x2*)(rr + (7 + d5) * 512) = o;
              o.x = pk_bf16(ke[0], ke[1]); o.y = pk_bf16(ke[2], ke[3]);
              *(u32x2*)(rr + (5 + d5) * 512) = o;
            } else {
              u32x2 o; o.x = pk_bf16(v.x, v.y); o.y = pk_bf16(v.z, v.w);
              *(u32x2*)(rr + 9 * 512) = o;
            }
          }
        } break;
      }
    }
    __syncthreads();
  }
}

__device__ void ph_final_ln(KP p, int layer, bool keep, char* lds) {
  const int tid = opaque_tid();
  const int lane = tid & 63, wave = tid >> 6;
  const int rows = keep ? NT : NL;
  int* s_base = (int*)(lds + META_OFF);
  if (tid == 0) {
    int a = 0;
#pragma unroll 1
    for (int e = 0; e < 64; ++e) { s_base[e] = a * 128; a += (p->cnt[e * CSTR] + 127) >> 7; }
    s_base[64] = a * 128;
  }
  __syncthreads();
  const float* lng = p->ln_g + (layer * 2 + 1) * 1024;
  const float* lnb = p->ln_b + (layer * 2 + 1) * 1024;
  for (int t = blockIdx.x * 4 + wave; t < rows; t += gridDim.x * 4) {
    const int mr = modrow(t);
    const float* g2 = p->MOD + (layer * 9 + mr) * 6144 + 5120;
    const bf16_t* src[7];
#pragma unroll
    for (int k = 0; k < 6; ++k) {
      const int v = p->tsl[t * 6 + k];
      src[k] = p->OUT2 + (size_t)(s_base[v >> 16] + (v & 0xffff)) * 1024;
    }
    src[6] = p->OUT2 + (size_t)(s_base[64] + t) * 1024;
    float v[16];
    float s = 0.f;
#pragma unroll
    for (int c = 0; c < 2; ++c) {
      const int n0 = c * 512 + lane * 8;
      float y[8];
#pragma unroll
      for (int q = 0; q < 8; ++q) y[q] = 0.f;
#pragma unroll
      for (int k = 0; k < 7; ++k) {
        const u32x4 u = *(const u32x4*)(src[k] + n0);
        y[0] += bflo(u.x); y[1] += bfhi(u.x); y[2] += bflo(u.y); y[3] += bfhi(u.y);
        y[4] += bflo(u.z); y[5] += bfhi(u.z); y[6] += bflo(u.w); y[7] += bfhi(u.w);
      }
      const float4 xa = *(const float4*)(p->X + (size_t)t * DM + n0), xb = *(const float4*)(p->X + (size_t)t * DM + n0 + 4);
      const float4 ga = *(const float4*)(g2 + n0), gb = *(const float4*)(g2 + n0 + 4);
      const float xx[8] = {xa.x, xa.y, xa.z, xa.w, xb.x, xb.y, xb.z, xb.w};
      const float gg[8] = {ga.x, ga.y, ga.z, ga.w, gb.x, gb.y, gb.z, gb.w};
#pragma unroll
      for (int q = 0; q < 8; ++q) { v[c * 8 + q] = DN_ALPHA * xx[q] + gg[q] * y[q]; s += v[c * 8 + q]; }
    }
    const float mean = wsum(s) * (1.f / 1024.f);
    float q2 = 0.f;
#pragma unroll
    for (int i = 0; i < 16; ++i) { const float d = v[i] - mean; q2 += d * d; }
    const float rs = rsqrtf(wsum(q2) * (1.f / 1024.f) + 1e-5f);
    const float* modn = p->MOD + ((layer + 1) * 9 + mr) * 6144;
#pragma unroll
    for (int c = 0; c < 2; ++c) {
      const int n0 = c * 512 + lane * 8;
      float xn[8];
#pragma unroll
      for (int q = 0; q < 8; ++q) xn[q] = (v[c * 8 + q] - mean) * rs * lng[n0 + q] + lnb[n0 + q];
      float* xo = (layer == 3 ? p->out : p->X) + (size_t)t * DM + n0;
      *(float4*)(xo) = make_float4(xn[0], xn[1], xn[2], xn[3]);
      *(float4*)(xo + 4) = make_float4(xn[4], xn[5], xn[6], xn[7]);
      if (layer != 3) {
        float hb[8];
#pragma unroll
        for (int q = 0; q < 8; ++q) hb[q] = xn[q] * (1.f + modn[1024 + n0 + q]) + modn[n0 + q];
        u32x2 o;
        o.x = pk_fp8x4(hb[0], hb[1], hb[2], hb[3]); o.y = pk_fp8x4(hb[4], hb[5], hb[6], hb[7]);
        *(u32x2*)((unsigned char*)p->AB + (size_t)t * DM + n0) = o;
      }
    }
  }
}

#define XB_TMO      128
#define XB_XCNT(j)  (256  + 64 * (j))
#define XB_XSUB(j)  (1280 + 64 * (j))
#define XB_XGEN(j)  (2304 + 64 * (j))
#define XB_TOP      3328
#define XB_TOPGEN   3392
#define XB_SPIN_CAP (1u << 20)
#define LAS __attribute__((address_space(3)))
__device__ __forceinline__ unsigned xb_ld(unsigned* p) { return __hip_atomic_load(p, __ATOMIC_RELAXED, __HIP_MEMORY_SCOPE_AGENT); }
__device__ __forceinline__ unsigned xb_add(unsigned* p, unsigned v) { return __hip_atomic_fetch_add(p, v, __ATOMIC_RELAXED, __HIP_MEMORY_SCOPE_AGENT); }
__device__ __forceinline__ unsigned xb_xcc_id() { return (unsigned)__builtin_amdgcn_s_getreg((3 << 11) | 20) & 0xFu; }
#define XB_SPIN(cond, bar) do { unsigned _sp = 0; while (cond) { __builtin_amdgcn_s_sleep(1); \
    if ((++_sp & 255u) == 0u) { if (xb_ld(&(bar)[XB_TMO])) break; if (_sp > XB_SPIN_CAP) { atomicAdd(&(bar)[XB_TMO], 1u); break; } } } } while (0)
struct XcdBarrier { unsigned* bar; unsigned x; volatile LAS unsigned* st; };
__device__ __forceinline__ XcdBarrier xcd_barrier_post(unsigned* bar, volatile LAS unsigned* st) {
  XcdBarrier b; b.bar = bar; b.x = xb_xcc_id(); b.st = st;
  if (threadIdx.x == 0) (void)xb_add(&bar[XB_XCNT(b.x)], 1u);
  return b;
}
__device__ __forceinline__ void xcd_barrier_complete(unsigned* bar, unsigned x, unsigned& nloc, unsigned& nx) {
  const unsigned G = gridDim.x;
  unsigned sum, cnt, mine, sp = 0u;
  for (;;) {
    sum = 0u; cnt = 0u; mine = 0u;
#pragma unroll
    for (unsigned j = 0; j < 16; ++j) { const unsigned c = xb_ld(&bar[XB_XCNT(j)]); sum += c; cnt += (c > 0u) ? 1u : 0u; mine = (j == x) ? c : mine; }
    if (sum == G) break;
    __builtin_amdgcn_s_sleep(1);
    if ((++sp & 255u) == 0u) { if (xb_ld(&bar[XB_TMO])) break; if (sp > XB_SPIN_CAP) { atomicAdd(&bar[XB_TMO], 1u); break; } }
  }
  nloc = mine > 0u ? mine : 1u; nx = cnt > 0u ? cnt : 1u;
}
__device__ __forceinline__ void xcd_barrier(const XcdBarrier& b) {
  asm volatile("s_waitcnt vmcnt(0)" ::: "memory");
  __syncthreads();
  if (threadIdx.x == 0) {
    unsigned* bar = b.bar;
    __builtin_amdgcn_s_waitcnt(0);
    unsigned nloc = b.st[0], nx = b.st[1];
    if (nloc == 0u) { xcd_barrier_complete(bar, b.x, nloc, nx); b.st[0] = nloc; b.st[1] = nx; }
    const unsigned old = xb_add(&bar[XB_XSUB(b.x)], 1u);
    const unsigned gen = old / nloc;
    if (old + 1u == (gen + 1u) * nloc) {
      __builtin_amdgcn_fence(__ATOMIC_RELEASE, "agent");
      asm volatile("s_waitcnt vmcnt(0)" ::: "memory");
      const unsigned og = xb_add(&bar[XB_TOP], 1u);
      const unsigned tg = og / nx;
      if (og + 1u == (tg + 1u) * nx) xb_add(&bar[XB_TOPGEN], 1u);
      else XB_SPIN(xb_ld(&bar[XB_TOPGEN]) == tg, bar);
      __builtin_amdgcn_fence(__ATOMIC_ACQUIRE, "agent");
      xb_add(&bar[XB_XGEN(b.x)], 1u);
      asm volatile("s_waitcnt vmcnt(0)" ::: "memory");
    } else {
      XB_SPIN(xb_ld(&bar[XB_XGEN(b.x)]) == gen, bar);
      __builtin_amdgcn_fence(__ATOMIC_ACQUIRE, "agent");
      asm volatile("s_waitcnt vmcnt(0)" ::: "memory");
    }
  }
  __syncthreads();
}

constexpr int NSLOTS = 13;
constexpr int NPHASE = 2 + 4 * NSLOTS;
__device__ __forceinline__ bool phase_is_nop(int ph) {
  if (ph < 2) return false;
  const int layer = (ph - 2) / NSLOTS, st = (ph - 2) % NSLOTS;
  if (st == 5 || st == 6) return true;
  return !(layer & 1) && (st == 1 || (st >= 3 && st <= 7));
}
__device__ void run_phase(KP p, int ph, char* sm) {
  if (ph == 0) { ph_init(p, sm); return; }
  if (ph == 1) { ph_mod_h(p, sm); return; }
  const int layer = (ph - 2) / NSLOTS, st = (ph - 2) % NSLOTS;
  const bool odd = layer & 1;
  const bool keep = layer < 3;
  int gk = -1;
  if (st == 0) gk = 0;
  else if (st == 8) gk = 1;
  else if (st == 10) gk = 2;
  else if (st == 11) gk = 3;
  else if (odd && st == 2) gk = 4;
  else if (odd && st == 3) gk = 5;
  asm volatile("" : "+s"(gk));
  if (gk >= 0) {
    if (gk == 2 || gk == 3) moe_prefix(p, keep ? NT : NL, (int*)(sm + META_OFF), opaque_tid());
    ph_gemm(p, gk, layer, keep, sm);
    if (gk == 5) { __syncthreads(); ph_mlstm_s2(p, sm); }
    return;
  }
  switch (st) {
    case 1: if (odd) { ph_rwkv_mix(p, layer); ph_mlstm_s1(p, layer, sm); } break;
    case 2: ph_attention(p, layer, keep, sm); break;
    case 4: if (odd) ph_scan_a(p, layer, sm); break;
    case 7: if (odd) ph_rec_final(p, layer, keep); break;
    case 9: ph_ln_router(p, layer, keep, sm); break;
    case 12: ph_final_ln(p, layer, keep, sm); break;
  }
}

__global__ void __launch_bounds__(NTHR, 2) mega_kernel(Params kargs) {
  extern __shared__ __attribute__((aligned(16))) char sm[];
  cg::grid_group grid = cg::this_grid();
  volatile LAS unsigned* st = (volatile LAS unsigned*)(sm + META_OFF + 4032);
  if (threadIdx.x == 0) { st[0] = 0u; st[1] = 0u; }
  __syncthreads();
  const XcdBarrier xb = xcd_barrier_post(kargs.bar, st);
  for (int ph = kargs.ph_lo; ph < kargs.ph_hi; ++ph) {
    if (phase_is_nop(ph)) continue;
    {
      KP kp = (KP)__builtin_amdgcn_kernarg_segment_ptr();
      asm volatile("" : "+s"(kp));
      run_phase(kp, ph, sm);
    }
    if (ph + 1 < kargs.ph_hi) {
      if (ph == 0) grid.sync();
      else xcd_barrier(xb);
    }
  }
}

extern "C" void kernel_launch(void* const* d_in, const int* in_sizes, int n_in, void* d_out, int out_size, void* d_ws,
                              size_t ws_size, hipStream_t stream) {
  static int grid_blocks = 0;
  if (!grid_blocks) {
    int dev = 0, cus = 0, per_cu = 0;
    (void)hipGetDevice(&dev);
    (void)hipDeviceGetAttribute(&cus, hipDeviceAttributeMultiprocessorCount, dev);
    (void)hipFuncSetAttribute((const void*)mega_kernel, hipFuncAttributeMaxDynamicSharedMemorySize, SMEM_BYTES);
    (void)hipOccupancyMaxActiveBlocksPerMultiprocessor(&per_cu, mega_kernel, NTHR, SMEM_BYTES);
    if (per_cu < 1) per_cu = 1;
    if (per_cu > 2) per_cu = 2;
    grid_blocks = cus * per_cu;
  }
  Params p;
  memset(&p, 0, sizeof(p));
  const float** pin = (const float**)&p;
  for (int i = 0; i < 35; ++i) pin[i] = (const float*)d_in[i];
  p.out = (float*)d_out;
  char* w = (char*)d_ws;
  size_t off = 0;
  auto take = [&](size_t bytes) { char* r = w + off; off += (bytes + 255) & ~(size_t)255; return r; };
  p.Wt_att = (bf16_t*)take((size_t)2 * ATT_N * 1024 * 2);
  p.Wt_rec = (bf16_t*)take((size_t)2 * REC_NP * 1024 * 2);
  p.Wt_out = (bf16_t*)take((size_t)4 * 1024 * 1024 * 2);
  p.Wt13 = (bf16_t*)take((size_t)4 * 65 * 512 * 1024);
  p.Wt2 = (bf16_t*)take((size_t)4 * 65 * 1024 * 256);
  p.Wl1 = (bf16_t*)take((size_t)2 * 3 * 128 * 512 * 2);
  p.Wl2 = (bf16_t*)take((size_t)2 * 2560 * 128 * 2);
  p.X = (float*)take((size_t)NT * DM * 4);
  p.AB = (bf16_t*)take((size_t)NT * DM * 2);
  p.MOD = (float*)take((size_t)5 * 9 * 6144 * 4);
  p.MODP = (float*)take((size_t)8 * 4 * 9 * 6144 * 4);
  p.GP = (float*)take((size_t)NT * 16 * 4);
  p.ROPE = (float*)take((size_t)64 * 16 * 2 * 4);
  p.WrT = (float*)take((size_t)4 * 64 * 1024 * 4);
  p.msc = (float*)take((size_t)3 * NMT * 4);
  p.lgate = (float*)take((size_t)64 * NT * 4);
  p.ltok = (int*)take((size_t)64 * NT * 4);
  p.tsl = (int*)take((size_t)NT * 6 * 4);
  p.cnt = (int*)take((size_t)65 * CSTR * 4);
  p.bar = (unsigned*)take((size_t)BAR_TOTAL_WORDS * 4);
  char* region = take(0);
  const size_t szP = (size_t)NT * LDP * 2, szRW = (size_t)NT * RWS * 2, szMS = (size_t)NMT * 16384 * 2,
               szMSn = (size_t)NMT * 128 * 4;
  const size_t szT = (size_t)NT * DM * 4, szOUT2 = (size_t)NSLOT * 1024 * 2;
  p.P = (bf16_t*)region;
  p.RW = (bf16_t*)(region + szP);
  p.MS = (bf16_t*)(region + szP + szRW);
  p.MSn = (float*)(region + szP + szRW + szMS);
  p.Tb = (float*)region;
  p.ACT = (bf16_t*)region;
  p.OUT2 = (bf16_t*)(region + szT);
  const size_t szZ = (size_t)NT * 2048 * 2;
  p.Zb = (bf16_t*)(region + szP + szRW + szMS + szMSn);
  p.L1 = p.Zb + (size_t)NT * 1536;
  size_t mixer = szP + szRW + szMS + szMSn + szZ, moe = szT + szOUT2;
  off += (mixer > moe ? mixer : moe);
  if (off > ws_size) { fprintf(stderr, "workspace too small: need %zu have %zu\n", off, ws_size); return; }
  p.ph_lo = 0;
  p.ph_hi = NPHASE;
  (void)hipMemsetAsync(p.bar, 0, (size_t)BAR_TOTAL_WORDS * 4, stream);
  void* args[] = {&p};
  hipError_t e = hipLaunchCooperativeKernel((void*)mega_kernel, dim3(grid_blocks), dim3(NTHR), args, SMEM_BYTES, stream);
  if (e != hipSuccess) fprintf(stderr, "cooperative launch failed: %s (grid %d)\n", hipGetErrorString(e), grid_blocks);
}
```

```cpp
#include <hip/hip_runtime.h>
#include <hip/hip_cooperative_groups.h>
#include <cstdio>
#include <cstring>
namespace cg = cooperative_groups;

constexpr int DM = 1024;
constexpr int NBATCH = 8;
constexpr int SEQ = 2048;
constexpr int CTXL = 256;
constexpr int NL = NBATCH * SEQ;
constexpr int NC = NBATCH * CTXL;
constexpr int NT = NL + NC;
constexpr int TSC = CTXL + SEQ;
constexpr int LDP = 4112;
constexpr int ATT_N = 2304;
constexpr int REC_N = 4112;
constexpr int REC_NP = 4224;
constexpr int NCHUNK = 36;
constexpr int NMT = 64 * NCHUNK;
constexpr int RWS = 5632;
constexpr int NSLOT = 137216;
constexpr float DN_ALPHA = 1.6817928305074290f;
constexpr int NTHR = 256;
constexpr int SMEM_BYTES = 65536 + 4096;
constexpr int META_OFF = 65536;
#define XCD_BAR_WORDS 3456
constexpr int CSTR = 32;
constexpr int BAR_TOTAL_WORDS = XCD_BAR_WORDS + 64;

typedef unsigned short bf16_t;
using bf16x8 = __attribute__((ext_vector_type(8))) short;
using f32x16 = __attribute__((ext_vector_type(16))) float;
using u32x4 = __attribute__((ext_vector_type(4))) unsigned;
using u32x2 = __attribute__((ext_vector_type(2))) unsigned;

struct Params {
  const float *x, *c, *ctx, *c_ctx, *ada_w, *ada_b, *ln_g, *ln_b, *mix_w_out, *att_w_in, *na_rpb, *qk_gain,
      *rec_w_in, *rwkv_mu, *rwkv_w0, *rwkv_w1, *rwkv_w2, *rwkv_a0, *rwkv_a1, *rwkv_a2, *rwkv_g1, *rwkv_g2,
      *rwkv_kvec, *rwkv_rk, *rwkv_gn, *mlstm_gate_b, *mlstm_norm, *moe_router, *moe_bias, *moe_w1, *moe_w3,
      *moe_w2, *shared_w1, *shared_w3, *shared_w2;
  float* out;
  bf16_t *Wt_att, *Wt_rec, *Wt_out, *Wt13, *Wt2, *Wl1, *Wl2;
  bf16_t *Zb, *L1;
  float *X, *MOD, *MODP, *GP, *msc, *lgate, *MSn, *Tb, *ROPE, *WrT;
  bf16_t *AB, *P, *RW, *MS, *ACT, *OUT2;
  int *cnt, *ltok, *tsl;
  unsigned* bar;
  int ph_lo, ph_hi;
};

typedef const Params __attribute__((address_space(4))) * KP;

__device__ __forceinline__ int modrow(int t) { return t < NL ? (t >> 11) : 8; }
__device__ __forceinline__ float silu_f(float x) { return x / (1.f + expf(-x)); }
__device__ __forceinline__ float sigm_f(float x) { return 1.f / (1.f + expf(-x)); }
__device__ __forceinline__ float softplus_f(float x) { return fmaxf(x, 0.f) + log1pf(expf(-fabsf(x))); }
template <int CTRL>
__device__ __forceinline__ float dppx(float x) {
  return __int_as_float(__builtin_amdgcn_update_dpp(0, __float_as_int(x), CTRL, 0xf, 0xf, true));
}
__device__ __forceinline__ float rdlane(float v, int l) {
  return __int_as_float(__builtin_amdgcn_readlane(__float_as_int(v), l));
}
__device__ __forceinline__ float wsum(float v) {
  v += dppx<0xB1>(v); v += dppx<0x4E>(v); v += dppx<0x141>(v); v += dppx<0x140>(v);
  return (rdlane(v, 0) + rdlane(v, 16)) + (rdlane(v, 32) + rdlane(v, 48));
}
__device__ __forceinline__ float wmax(float v) {
  v = fmaxf(v, dppx<0xB1>(v)); v = fmaxf(v, dppx<0x4E>(v)); v = fmaxf(v, dppx<0x141>(v)); v = fmaxf(v, dppx<0x140>(v));
  return fmaxf(fmaxf(rdlane(v, 0), rdlane(v, 16)), fmaxf(rdlane(v, 32), rdlane(v, 48)));
}
__device__ __forceinline__ int opaque_tid() {
  int t = threadIdx.x;
  asm volatile("" : "+v"(t));
  return t;
}
typedef __bf16 bf16x2_t __attribute__((ext_vector_type(2)));
typedef float f32x2_t __attribute__((ext_vector_type(2)));
__device__ __forceinline__ unsigned pk_bf16(float lo, float hi) {
  const f32x2_t v = {lo, hi};
  return __builtin_bit_cast(unsigned, __builtin_convertvector(v, bf16x2_t));
}
__device__ __forceinline__ bf16_t f2bf(float x) { return (bf16_t)(pk_bf16(x, 0.f) & 0xffffu); }
__device__ __forceinline__ float bf2f(bf16_t v) { return __uint_as_float((unsigned)v << 16); }
__device__ __forceinline__ float bflo(unsigned u) { return __uint_as_float(u << 16); }
__device__ __forceinline__ float bfhi(unsigned u) { return __uint_as_float(u & 0xffff0000u); }
__device__ __forceinline__ int scan_row(int dir, int b, int tau) {
  if (tau < CTXL) return NL + b * CTXL + (dir ? (CTXL - 1 - tau) : tau);
  int s = tau - CTXL;
  return b * SEQ + (dir ? (SEQ - 1 - s) : s);
}

template <class RowPtrA>
__device__ __forceinline__ void gemm128_main(int tid, RowPtrA rowA, const bf16_t* __restrict__ Bt, int K, int n0,
                                             char* lds, f32x16 (&acc)[2][2]) {
  const int lane = tid & 63, w = tid >> 6;
  const int wm = w >> 1, wn = w & 1, r = lane & 31, h = lane >> 5;
  const int c = tid & 7, sr = tid >> 3;
  const int lc = (c ^ ((tid >> 4) & 7)) * 8;
  const bf16_t* ap[4];
#pragma unroll
  for (int i = 0; i < 4; ++i) ap[i] = rowA(sr + 32 * i) + lc;
  const bf16_t* bp0 = Bt + (size_t)(n0 + sr) * K + lc;
  const int bstr = 32 * K;
#pragma unroll
  for (int mi = 0; mi < 2; ++mi)
#pragma unroll
    for (int ni = 0; ni < 2; ++ni)
#pragma unroll
      for (int q = 0; q < 16; ++q) acc[mi][ni][q] = 0.f;
  const int nk = K >> 6;
  auto issue = [&](int kt) {
    char* As = lds + (kt & 1) * 32768 + tid * 16;
    const int k0 = kt * 64;
#pragma unroll
    for (int i = 0; i < 4; ++i) {
      __builtin_amdgcn_global_load_lds((const unsigned*)(ap[i] + k0), (__attribute__((address_space(3))) unsigned*)(As + i * 4096), 16, 0, 0);
      __builtin_amdgcn_global_load_lds((const unsigned*)(bp0 + i * bstr + k0), (__attribute__((address_space(3))) unsigned*)(As + 16384 + i * 4096), 16, 0, 0);
    }
  };
  issue(0);
  const int sw = (r >> 1) & 7;
#pragma unroll 1
  for (int kt = 0; kt < nk; ++kt) {
    asm volatile("s_waitcnt vmcnt(0)" ::: "memory");
    __syncthreads();
    if (kt + 1 < nk) issue(kt + 1);
    const char* As = lds + (kt & 1) * 32768;
    const char* Ar = As + (wm * 64 + r) * 128;
    const char* Br = As + 16384 + (wn * 64 + r) * 128;
#pragma unroll
    for (int ks = 0; ks < 4; ++ks) {
      const int off = ((ks * 2 + h) ^ sw) * 16;
      const bf16x8 a0 = *(const bf16x8*)(Ar + off);
      const bf16x8 a1 = *(const bf16x8*)(Ar + 32 * 128 + off);
      const bf16x8 b0 = *(const bf16x8*)(Br + off);
      const bf16x8 b1 = *(const bf16x8*)(Br + 32 * 128 + off);
      acc[0][0] = __builtin_amdgcn_mfma_f32_32x32x16_bf16(a0, b0, acc[0][0], 0, 0, 0);
      acc[0][1] = __builtin_amdgcn_mfma_f32_32x32x16_bf16(a0, b1, acc[0][1], 0, 0, 0);
      acc[1][0] = __builtin_amdgcn_mfma_f32_32x32x16_bf16(a1, b0, acc[1][0], 0, 0, 0);
      acc[1][1] = __builtin_amdgcn_mfma_f32_32x32x16_bf16(a1, b1, acc[1][1], 0, 0, 0);
    }
  }
  __syncthreads();
}
using i64 = long;
template <class RowPtrA8>
__device__ __forceinline__ void gemm128_fp8(int tid, RowPtrA8 rowA, const unsigned char* __restrict__ Bt, int K, int n0,
                                            char* lds, f32x16 (&acc)[2][2]) {
  const int lane = tid & 63, w = tid >> 6;
  const int wm = w >> 1, wn = w & 1, r = lane & 31, h = lane >> 5;
  const int c = tid & 7, sr = tid >> 3;
  const int lc = (c ^ ((tid >> 4) & 7)) * 16;
  const unsigned char* ap[4];
#pragma unroll
  for (int i = 0; i < 4; ++i) ap[i] = rowA(sr + 32 * i) + lc;
  const unsigned char* bp0 = Bt + (size_t)(n0 + sr) * K + lc;
  const int bstr = 32 * K;
#pragma unroll
  for (int mi = 0; mi < 2; ++mi)
#pragma unroll
    for (int ni = 0; ni < 2; ++ni)
#pragma unroll
      for (int q = 0; q < 16; ++q) acc[mi][ni][q] = 0.f;
  const int nk = K >> 7;
  auto issue = [&](int kt) {
    char* As = lds + (kt & 1) * 32768 + tid * 16;
    const int k0 = kt * 128;
#pragma unroll
    for (int i = 0; i < 4; ++i) {
      __builtin_amdgcn_global_load_lds((const unsigned*)(ap[i] + k0), (__attribute__((address_space(3))) unsigned*)(As + i * 4096), 16, 0, 0);
      __builtin_amdgcn_global_load_lds((const unsigned*)(bp0 + i * bstr + k0), (__attribute__((address_space(3))) unsigned*)(As + 16384 + i * 4096), 16, 0, 0);
    }
  };
  issue(0);
  const int sw = (r >> 1) & 7;
#pragma unroll 1
  for (int kt = 0; kt < nk; ++kt) {
    asm volatile("s_waitcnt vmcnt(0)" ::: "memory");
    __syncthreads();
    if (kt + 1 < nk) issue(kt + 1);
    const char* As = lds + (kt & 1) * 32768;
    const char* Ar = As + (wm * 64 + r) * 128;
    const char* Br = As + 16384 + (wn * 64 + r) * 128;
#pragma unroll
    for (int q = 0; q < 4; ++q) {
      const int off = ((q * 2 + h) ^ sw) * 16;
      const u32x4 a0 = *(const u32x4*)(Ar + off);
      const u32x4 a1 = *(const u32x4*)(Ar + 32 * 128 + off);
      const u32x4 b0 = *(const u32x4*)(Br + off);
      const u32x4 b1 = *(const u32x4*)(Br + 32 * 128 + off);
      const i64 a0l = (i64)(((unsigned long long)a0.y << 32) | a0.x), a0h = (i64)(((unsigned long long)a0.w << 32) | a0.z);
      const i64 a1l = (i64)(((unsigned long long)a1.y << 32) | a1.x), a1h = (i64)(((unsigned long long)a1.w << 32) | a1.z);
      const i64 b0l = (i64)(((unsigned long long)b0.y << 32) | b0.x), b0h = (i64)(((unsigned long long)b0.w << 32) | b0.z);
      const i64 b1l = (i64)(((unsigned long long)b1.y << 32) | b1.x), b1h = (i64)(((unsigned long long)b1.w << 32) | b1.z);
      acc[0][0] = __builtin_amdgcn_mfma_f32_32x32x16_fp8_fp8(a0l, b0l, acc[0][0], 0, 0, 0);
      acc[0][1] = __builtin_amdgcn_mfma_f32_32x32x16_fp8_fp8(a0l, b1l, acc[0][1], 0, 0, 0);
      acc[1][0] = __builtin_amdgcn_mfma_f32_32x32x16_fp8_fp8(a1l, b0l, acc[1][0], 0, 0, 0);
      acc[1][1] = __builtin_amdgcn_mfma_f32_32x32x16_fp8_fp8(a1l, b1l, acc[1][1], 0, 0, 0);
      acc[0][0] = __builtin_amdgcn_mfma_f32_32x32x16_fp8_fp8(a0h, b0h, acc[0][0], 0, 0, 0);
      acc[0][1] = __builtin_amdgcn_mfma_f32_32x32x16_fp8_fp8(a0h, b1h, acc[0][1], 0, 0, 0);
      acc[1][0] = __builtin_amdgcn_mfma_f32_32x32x16_fp8_fp8(a1h, b0h, acc[1][0], 0, 0, 0);
      acc[1][1] = __builtin_amdgcn_mfma_f32_32x32x16_fp8_fp8(a1h, b1h, acc[1][1], 0, 0, 0);
    }
  }
  __syncthreads();
}
template <class F>
__device__ __forceinline__ void acc_foreach(int tid, const f32x16 (&acc)[2][2], F f) {
  const int lane = tid & 63, w = tid >> 6;
  const int wm = w >> 1, wn = w & 1, r = lane & 31, h = lane >> 5;
#pragma unroll
  for (int mi = 0; mi < 2; ++mi)
#pragma unroll
    for (int ni = 0; ni < 2; ++ni)
#pragma unroll
      for (int q = 0; q < 16; ++q) {
        const int row = wm * 64 + mi * 32 + (q & 3) + 8 * (q >> 2) + 4 * h;
        const int col = wn * 64 + ni * 32 + r;
        f(row, col, acc[mi][ni][q]);
        if ((q & 3) == 3) __builtin_amdgcn_sched_barrier(0);
      }
}

template <class RM>
__device__ __forceinline__ void tr_tile(int tid, const float* __restrict__ src, int N, int k0, int n0,
                                        bf16_t* __restrict__ dst, int K, RM rowmap, float* tile) {
  {
    const int tx = tid & 15, ty = tid >> 4;
    const int n = n0 + tx * 4;
#pragma unroll
    for (int i = 0; i < 4; ++i) {
      const int k = ty + 16 * i;
      float4 v = make_float4(0.f, 0.f, 0.f, 0.f);
      if (n < N) v = *(const float4*)(src + (size_t)(k0 + k) * N + n);
      tile[k * 65 + tx * 4 + 0] = v.x; tile[k * 65 + tx * 4 + 1] = v.y;
      tile[k * 65 + tx * 4 + 2] = v.z; tile[k * 65 + tx * 4 + 3] = v.w;
    }
  }
  __syncthreads();
  {
    const int kc = tid & 7;
#pragma unroll
    for (int i = 0; i < 2; ++i) {
      const int n = (tid >> 3) + 32 * i;
      if (n0 + n < N) {
        float v[8];
#pragma unroll
        for (int q = 0; q < 8; ++q) v[q] = tile[(kc * 8 + q) * 65 + n];
        u32x4 o;
        o.x = pk_bf16(v[0], v[1]); o.y = pk_bf16(v[2], v[3]); o.z = pk_bf16(v[4], v[5]); o.w = pk_bf16(v[6], v[7]);
        *(u32x4*)(dst + (size_t)rowmap(n0 + n) * K + k0 + kc * 8) = o;
      }
    }
  }
  __syncthreads();
}

constexpr float W8_SCALE = 32.f, W8_INV = 1.f / 32.f;
__device__ __forceinline__ unsigned pk_fp8x4(float a, float b, float c, float d) {
  int r = __builtin_amdgcn_cvt_pk_fp8_f32(a, b, 0, false);
  r = __builtin_amdgcn_cvt_pk_fp8_f32(c, d, r, true);
  return (unsigned)r;
}
__device__ __forceinline__ unsigned pk_fp8x4c(float a, float b, float c, float d) {
  constexpr float M = 448.f;
  return pk_fp8x4(fminf(fmaxf(a, -M), M), fminf(fmaxf(b, -M), M), fminf(fmaxf(c, -M), M), fminf(fmaxf(d, -M), M));
}
template <class RM>
__device__ __forceinline__ void tr_tile_fp8(int tid, const float* __restrict__ src, int N, int k0, int n0,
                                            unsigned char* __restrict__ dst, int K, RM rowmap, float* tile) {
  {
    const int tx = tid & 15, ty = tid >> 4;
    const int n = n0 + tx * 4;
#pragma unroll
    for (int i = 0; i < 4; ++i) {
      const int k = ty + 16 * i;
      float4 v = make_float4(0.f, 0.f, 0.f, 0.f);
      if (n < N) v = *(const float4*)(src + (size_t)(k0 + k) * N + n);
      tile[k * 65 + tx * 4 + 0] = v.x; tile[k * 65 + tx * 4 + 1] = v.y;
      tile[k * 65 + tx * 4 + 2] = v.z; tile[k * 65 + tx * 4 + 3] = v.w;
    }
  }
  __syncthreads();
  {
    const int kc = tid & 3, n = tid >> 2;
    float v[16];
#pragma unroll
    for (int q = 0; q < 16; ++q) v[q] = tile[(kc * 16 + q) * 65 + n] * W8_SCALE;
    u32x4 o;
    o.x = pk_fp8x4(v[0], v[1], v[2], v[3]); o.y = pk_fp8x4(v[4], v[5], v[6], v[7]);
    o.z = pk_fp8x4(v[8], v[9], v[10], v[11]); o.w = pk_fp8x4(v[12], v[13], v[14], v[15]);
    *(u32x4*)(dst + (size_t)rowmap(n0 + n) * K + k0 + kc * 16) = o;
  }
  __syncthreads();
}

constexpr int CJ0 = 1152, CJ1 = CJ0 + 2080, CJ2 = CJ1 + 1024, CJ3 = CJ2 + 33280, CJ4 = CJ3 + 16640;
__device__ void convert_job(KP p, int job, float* sm, int tid) {
  if (job < CJ0) {
    const int j = job / 576, rem = job % 576, kt = rem / 36, nt = rem % 36;
    tr_tile_fp8(tid, p->att_w_in + (size_t)j * 1024 * ATT_N, ATT_N, kt * 64, nt * 64, (unsigned char*)p->Wt_att + (size_t)j * ATT_N * 1024,
                1024, [](int n) { return n; }, sm);
  } else if (job < CJ1) {
    const int q = job - CJ0;
    const int j = q / 1040, rem = q % 1040, kt = rem / 65, nt = rem % 65;
    tr_tile_fp8(tid, p->rec_w_in + (size_t)j * 1024 * REC_N, REC_N, kt * 64, nt * 64, (unsigned char*)p->Wt_rec + (size_t)j * REC_NP * 1024,
                1024, [](int n) { return n; }, sm);
  } else if (job < CJ2) {
    const int q = job - CJ1;
    const int i = q >> 8, rem = q & 255, kt = rem >> 4, nt = rem & 15;
    tr_tile_fp8(tid, p->mix_w_out + (size_t)i * 1024 * 1024, 1024, kt * 64, nt * 64, (unsigned char*)p->Wt_out + (size_t)i * 1024 * 1024,
                1024, [](int n) { return n; }, sm);
  } else if (job < CJ3) {
    const int q = job - CJ2;
    const int le = q >> 7, rem = q & 127;
    const int which = rem >> 6, kt = (rem >> 2) & 15, nt = rem & 3;
    const int layer = le / 65, e = le % 65;
    const float* src;
    if (e < 64) src = (which ? p->moe_w3 : p->moe_w1) + (size_t)(layer * 64 + e) * 1024 * 256;
    else src = (which ? p->shared_w3 : p->shared_w1) + (size_t)layer * 1024 * 256;
    tr_tile_fp8(tid, src, 256, kt * 64, nt * 64, (unsigned char*)p->Wt13 + (size_t)le * 512 * 1024, 1024,
                [which](int n) { return 64 * (n >> 5) + which * 32 + (n & 31); }, sm);
  } else {
    const int q = job - CJ3;
    const int le = q >> 6, rem = q & 63;
    const int kt = rem >> 4, nt = rem & 15;
    const int layer = le / 65, e = le % 65;
    const float* src = e < 64 ? p->moe_w2 + (size_t)(layer * 64 + e) * 256 * 1024 : p->shared_w2 + (size_t)layer * 256 * 1024;
    tr_tile_fp8(tid, src, 1024, kt * 64, nt * 64, (unsigned char*)p->Wt2 + (size_t)le * 1024 * 256, 256, [](int n) { return n; }, sm);
  }
}
__device__ __forceinline__ int conv_stage_total(int stage) {
  return stage == 0 ? (576 + 1040 + 512 + 8320 + 4160) : (stage == 1 ? (576 + 1040 + 256 + 16640 + 8320) : (256 + 8320 + 4160));
}
__device__ __forceinline__ int conv_stage_job(int stage, int q) {
  if (stage == 0) {
    if (q < 8320) return CJ2 + q;  q -= 8320;
    if (q < 4160) return CJ3 + q;  q -= 4160;
    if (q < 576) return q;  q -= 576;
    if (q < 1040) return CJ0 + q;  q -= 1040;
    return CJ1 + q;
  } else if (stage == 1) {
    if (q < 8320) return CJ2 + 8320 + q;  q -= 8320;
    if (q < 4160) return CJ3 + 4160 + q;  q -= 4160;
    if (q < 576) return 576 + q;  q -= 576;
    if (q < 256) return CJ1 + 512 + q;  q -= 256;
    if (q < 8320) return CJ2 + 16640 + q;  q -= 8320;
    if (q < 4160) return CJ3 + 8320 + q;  q -= 4160;
    return CJ0 + 1040 + q;
  }
  if (q < 256) return CJ1 + 768 + q;  q -= 256;
  if (q < 8320) return CJ2 + 24960 + q;  q -= 8320;
  return CJ3 + 12480 + q;
}

struct CvDesc { const float* src; unsigned char* dst; int N, K, k0, n0, which; };
__device__ __forceinline__ bool conv_desc_fp8(KP p, int job, CvDesc& d) {
  if (job < CJ2) return false;
  if (job < CJ3) {
    const int q = job - CJ2;
    const int le = q >> 7, rem = q & 127;
    const int which = rem >> 6, kt = (rem >> 2) & 15, nt = rem & 3;
    const int layer = le / 65, e = le % 65;
    if (e < 64) d.src = (which ? p->moe_w3 : p->moe_w1) + (size_t)(layer * 64 + e) * 1024 * 256;
    else d.src = (which ? p->shared_w3 : p->shared_w1) + (size_t)layer * 1024 * 256;
    d.dst = (unsigned char*)p->Wt13 + (size_t)le * 512 * 1024;
    d.N = 256; d.K = 1024; d.k0 = kt * 64; d.n0 = nt * 64; d.which = which;
  } else {
    const int q = job - CJ3;
    const int le = q >> 6, rem = q & 63;
    const int kt = rem >> 4, nt = rem & 15;
    const int layer = le / 65, e = le % 65;
    d.src = e < 64 ? p->moe_w2 + (size_t)(layer * 64 + e) * 256 * 1024 : p->shared_w2 + (size_t)layer * 256 * 1024;
    d.dst = (unsigned char*)p->Wt2 + (size_t)le * 1024 * 256;
    d.N = 1024; d.K = 256; d.k0 = kt * 64; d.n0 = nt * 64; d.which = -1;
  }
  return true;
}
typedef float cvf4 __attribute__((ext_vector_type(4)));
__device__ __forceinline__ void cv_load(const CvDesc& d, int tid, cvf4& v0, cvf4& v1, cvf4& v2, cvf4& v3) {
  const int tx = tid & 15, ty = tid >> 4;
  const float* s0 = d.src + (size_t)(d.k0 + ty) * d.N + d.n0 + tx * 4;
  v0 = *(const cvf4*)(s0);
  v1 = *(const cvf4*)(s0 + (size_t)16 * d.N);
  v2 = *(const cvf4*)(s0 + (size_t)32 * d.N);
  v3 = *(const cvf4*)(s0 + (size_t)48 * d.N);
}
__device__ __forceinline__ void cv_emit(const CvDesc& d, int tid, const cvf4 v0, const cvf4 v1, const cvf4 v2, const cvf4 v3, float* tile) {
  {
    const int tx = tid & 15, ty = tid >> 4;
    float* t0 = tile + ty * 65 + tx * 4;
    t0[0] = v0.x; t0[1] = v0.y; t0[2] = v0.z; t0[3] = v0.w;
    t0[16 * 65 + 0] = v1.x; t0[16 * 65 + 1] = v1.y; t0[16 * 65 + 2] = v1.z; t0[16 * 65 + 3] = v1.w;
    t0[32 * 65 + 0] = v2.x; t0[32 * 65 + 1] = v2.y; t0[32 * 65 + 2] = v2.z; t0[32 * 65 + 3] = v2.w;
    t0[48 * 65 + 0] = v3.x; t0[48 * 65 + 1] = v3.y; t0[48 * 65 + 2] = v3.z; t0[48 * 65 + 3] = v3.w;
  }
  __syncthreads();
  {
    const int kc = tid & 3, n = tid >> 2;
    float v[16];
#pragma unroll
    for (int q = 0; q < 16; ++q) v[q] = tile[(kc * 16 + q) * 65 + n] * W8_SCALE;
    u32x4 o;
    o.x = pk_fp8x4(v[0], v[1], v[2], v[3]); o.y = pk_fp8x4(v[4], v[5], v[6], v[7]);
    o.z = pk_fp8x4(v[8], v[9], v[10], v[11]); o.w = pk_fp8x4(v[12], v[13], v[14], v[15]);
    const int nn = d.n0 + n;
    const int row = d.which >= 0 ? 64 * (nn >> 5) + d.which * 32 + (nn & 31) : nn;
    *(u32x4*)(d.dst + (size_t)row * d.K + d.k0 + kc * 16) = o;
  }
  __syncthreads();
}
__device__ __forceinline__ void convert_run(KP p, int stage, int jj, int j1, float* sm, int tid) {
  CvDesc d, dn;
  cvf4 a0, a1, a2, a3, b0, b1, b2, b3;
  bool cur = false;
#pragma unroll 1
  for (; jj < j1; ++jj) {
    const int job = conv_stage_job(stage, jj);
    if (!cur) {
      if (!conv_desc_fp8(p, job, d)) { convert_job(p, job, sm, tid); continue; }
      cv_load(d, tid, a0, a1, a2, a3);
    }
    bool nxt = false;
    if (jj + 1 < j1) {
      nxt = conv_desc_fp8(p, conv_stage_job(stage, jj + 1), dn);
      if (nxt) cv_load(dn, tid, b0, b1, b2, b3);
    }
    cv_emit(d, tid, a0, a1, a2, a3, sm);
    if (nxt) { d = dn; a0 = b0; a1 = b1; a2 = b2; a3 = b3; }
    cur = nxt;
  }
}

__device__ void ph_init(KP p, char* smc) {
  float* sm = (float*)smc;
  const int tid = opaque_tid();
  {
    const size_t n4a = (size_t)NL * DM / 4, n4b = (size_t)NC * DM / 4;
    const float4* xs = (const float4*)p->x;
    const float4* cs = (const float4*)p->ctx;
    float4* X4 = (float4*)p->X;
    for (size_t i = (size_t)blockIdx.x * NTHR + tid; i < n4a + n4b; i += (size_t)gridDim.x * NTHR)
      X4[i] = i < n4a ? xs[i] : cs[i - n4a];
  }
  for (int tile = blockIdx.x; tile < 96 * 8; tile += gridDim.x) {
    const int ct = tile >> 3, ks = tile & 7;
    for (int i = tid; i < 9 * 128; i += NTHR) {
      const int r = i >> 7, k = ks * 128 + (i & 127);
      const float v = r < 8 ? p->c[r * 1024 + k] : p->c_ctx[k];
      sm[i] = silu_f(v);
    }
    __syncthreads();
    const int col = ct * 256 + tid;
    const int layer = col / 6144, n = col % 6144;
    const float* W = p->ada_w + ((size_t)layer * 1024 + ks * 128) * 6144 + n;
    float acc[9];
#pragma unroll
    for (int r = 0; r < 9; ++r) acc[r] = 0.f;
#pragma unroll 4
    for (int k = 0; k < 128; ++k) {
      const float w = W[(size_t)k * 6144];
#pragma unroll
      for (int r = 0; r < 9; ++r) acc[r] = fmaf(sm[r * 128 + k], w, acc[r]);
    }
#pragma unroll
    for (int r = 0; r < 9; ++r) p->MODP[((size_t)(ks * 4 + layer) * 9 + r) * 6144 + n] = acc[r];
    __syncthreads();
  }
  {
    const int total = conv_stage_total(0), chunk = (total + gridDim.x - 1) / gridDim.x;
    const int lo = min((int)blockIdx.x * chunk, total), hi = min(lo + chunk, total);
    __syncthreads();
    convert_run(p, 0, lo, hi, sm, tid);
  }
  for (int i = blockIdx.x * NTHR + tid; i < 2 * 3 * 128 * 512; i += gridDim.x * NTHR) {
    const int k = i & 511, n = (i >> 9) & 127, wj = i >> 16;
    const int j = wj / 3, which = wj % 3;
    float v = 0.f;
    if (which < 2) {
      if (n < 64) v = (which ? p->rwkv_a1 : p->rwkv_w1)[((size_t)(j * 2 + (n >> 5)) * 512 + k) * 32 + (n & 31)];
    } else if (n < 96) v = p->rwkv_g1[((size_t)j * 512 + k) * 96 + n];
    p->Wl1[i] = f2bf(v);
  }
  for (int i = blockIdx.x * NTHR + tid; i < 2 * 2560 * 128; i += gridDim.x * NTHR) {
    const int k = i & 127, n = (i >> 7) % 2560, j = i / (2560 * 128);
    float v = 0.f;
    if (n < 2048) {
      const int d = (n >> 9) & 1, c = n & 511;
      if (k < 64 && (k >> 5) == d) v = (n < 1024 ? p->rwkv_w2 : p->rwkv_a2)[((size_t)(j * 2 + d) * 32 + (k & 31)) * 512 + c];
    } else if (k < 96) v = p->rwkv_g2[((size_t)j * 96 + k) * 512 + (n - 2048)];
    p->Wl2[i] = f2bf(v);
  }
  for (int i = blockIdx.x * NTHR + tid; i < 4 * 64 * 1024; i += gridDim.x * NTHR) {
    const int k = i & 1023, n = (i >> 10) & 63, l = i >> 16;
    p->WrT[i] = p->moe_router[((size_t)l * 1024 + k) * 64 + n];
  }
  for (int i = blockIdx.x * NTHR + tid; i < 64 * 16; i += gridDim.x * NTHR) {
    const int pos = i >> 4, f = i & 15;
    const float ang = (float)pos * powf(10000.f, -(float)f / 16.f);
    p->ROPE[2 * i] = cosf(ang);
    p->ROPE[2 * i + 1] = sinf(ang);
  }
}

__device__ void ph_mod_h(KP p, char* smc) {
  float* sm = (float*)smc;
  const int tid = opaque_tid();
  for (int i = blockIdx.x * NTHR + tid; i < 4 * 9 * 6144; i += gridDim.x * NTHR) {
    const int layer = i / (9 * 6144), rem = i % (9 * 6144), n = rem % 6144;
    float s = p->ada_b[layer * 6144 + n];
#pragma unroll
    for (int ks = 0; ks < 8; ++ks) s += p->MODP[(size_t)(ks * 4 + layer) * 9 * 6144 + rem];
    p->MOD[i] = s;
  }
  const int lane = tid & 63, wave = tid >> 6;
  const int per = (((NT + gridDim.x - 1) / gridDim.x) + 3) & ~3;
  const int t0 = blockIdx.x * per, t1 = min(NT, t0 + per);
  int cur = -1;
  for (int tb = t0; tb < t1; tb += 4) {
    const int mr = modrow(tb);
    if (mr != cur) {
      __syncthreads();
      for (int n = tid; n < 2048; n += NTHR) {
        float a = p->ada_b[n];
#pragma unroll
        for (int ks = 0; ks < 8; ++ks) a += p->MODP[((size_t)(ks * 4) * 9 + mr) * 6144 + n];
        sm[n] = a;
      }
      cur = mr;
      __syncthreads();
    }
    const int t = tb + wave;
    if (t < t1) {
      const float* src = t < NL ? p->x + (size_t)t * DM : p->ctx + (size_t)(t - NL) * DM;
#pragma unroll
      for (int i = 0; i < 4; ++i) {
        const int n = i * 256 + lane * 4;
        const float4 xv = *(const float4*)(src + n);
        const float4 sh = *(const float4*)(sm + n);
        const float4 sc = *(const float4*)(sm + 1024 + n);
        *(unsigned*)((unsigned char*)p->AB + (size_t)t * DM + n) =
            pk_fp8x4(xv.x * (1.f + sc.x) + sh.x, xv.y * (1.f + sc.y) + sh.y, xv.z * (1.f + sc.z) + sh.z, xv.w * (1.f + sc.w) + sh.w);
      }
    }
  }
}

typedef short v4i16_t __attribute__((ext_vector_type(4)));
using s16x4 = __attribute__((ext_vector_type(4))) short;
__device__ __forceinline__ s16x4 vtr(const char* p) {
  return __builtin_bit_cast(s16x4, __builtin_amdgcn_ds_read_tr16_b64_v4i16((__attribute__((address_space(3))) v4i16_t*)p));
}
#define MFMA32(a, b, c) __builtin_amdgcn_mfma_f32_32x32x16_bf16(a, b, c, 0, 0, 0)
__device__ void ph_attention(KP p, int layer, bool keep, char* lds) {
  const int tid = opaque_tid();
  const int lane = tid & 63, w = tid >> 6, r32 = lane & 31, hi = lane >> 5;
  const int j = layer >> 1;
  float* bias_lds = (float*)(lds + 32768 + 1024);
  const int n_gqa = 1024, n_na = 1024, n_cb = keep ? 128 : 0, n_ca = keep ? 128 : 0;
  const int total = n_gqa + n_na + n_cb + n_ca;
  constexpr float LOG2E = 1.4426950408889634f;
  constexpr float C2 = 0.125f * LOG2E;
  const int c = tid & 7, sr = tid >> 3;
  const int kso = (c ^ ((tid >> 4) & 7)) * 16;
  const int vso = (c >> 2) * 4096 + (c & 3) * 16;
  const int sw = (r32 >> 1) & 7;
  for (int item = blockIdx.x; item < total; item += gridDim.x) {
    int b, qrow0, qoff, koff, voff, ocol, lat_tiles, lat_row0;
    bool na = false;
    int r_w = 0, start_w = 0, ru0 = 0, hN = 0;
    if (item < n_gqa) {
      b = item >> 7;
      const int g = (item >> 6) & 1, tt = item & 63;
      qrow0 = b * SEQ + tt * 32; qoff = 1536 + (g * 4 + w) * 64; koff = 2048 + g * 64; voff = 2176 + g * 64;
      ocol = 512 + (g * 4 + w) * 64; lat_tiles = 32; lat_row0 = b * SEQ;
    } else if (item < n_gqa + n_na) {
      const int it = item - n_gqa;
      b = it >> 7; hN = (it >> 4) & 7;
      const int rp = it & 15;
      na = true; r_w = 2 * rp + (w >> 1);
      qrow0 = b * SEQ + r_w * 64 + (w & 1) * 32; qoff = hN * 64; koff = 512 + hN * 64; voff = 1024 + hN * 64; ocol = hN * 64;
      const int s0 = min(max(2 * rp - 4, 0), 24), s1 = min(max(2 * rp - 3, 0), 24);
      start_w = (w >> 1) ? s1 : s0; ru0 = s0; lat_tiles = (s1 != s0) ? 9 : 8; lat_row0 = b * SEQ + ru0 * 64;
    } else if (item < n_gqa + n_na + n_cb) {
      const int it = item - n_gqa - n_na;
      b = it >> 4;
      const int g = (it >> 3) & 1, tt = it & 7;
      qrow0 = NL + b * CTXL + tt * 32; qoff = 1536 + (g * 4 + w) * 64; koff = 2048 + g * 64; voff = 2176 + g * 64;
      ocol = 512 + (g * 4 + w) * 64; lat_tiles = 0; lat_row0 = 0;
    } else {
      const int it = item - n_gqa - n_na - n_cb;
      b = it >> 4;
      const int h = (it >> 1) & 7, half = it & 1;
      qrow0 = NL + b * CTXL + half * 128 + w * 32; qoff = h * 64; koff = 512 + h * 64; voff = 1024 + h * 64; ocol = h * 64;
      lat_tiles = 0; lat_row0 = 0;
    }
    const int ctx_row0 = NL + b * CTXL, ntiles = lat_tiles + 4;
    if (na)
      for (int i = tid; i < 465; i += NTHR) bias_lds[i] = p->na_rpb[(j * 8 + hN) * 465 + i] * LOG2E;
    bf16x8 qf[4];
    {
      const bf16_t* qp = p->P + (size_t)(qrow0 + r32) * LDP + qoff + hi * 8;
#pragma unroll
      for (int d0 = 0; d0 < 4; ++d0) qf[d0] = *(const bf16x8*)(qp + d0 * 16);
    }
    f32x16 o0, o1;
#pragma unroll
    for (int q = 0; q < 16; ++q) { o0[q] = 0.f; o1[q] = 0.f; }
    float m = -INFINITY, l = 0.f;
    u32x4 kr0, kr1, vr0, vr1;
    auto gload = [&](int t) {
      const int row0 = t < lat_tiles ? lat_row0 + 64 * t : ctx_row0 + 64 * (t - lat_tiles);
      const bf16_t* base = p->P + (size_t)(row0 + sr) * LDP + c * 8;
      kr0 = *(const u32x4*)(base + koff); kr1 = *(const u32x4*)(base + (size_t)32 * LDP + koff);
      vr0 = *(const u32x4*)(base + voff); vr1 = *(const u32x4*)(base + (size_t)32 * LDP + voff);
    };
    auto swrite = [&](int buf) {
      char* Kb = lds + buf * 16384;
      char* Vb = Kb + 8192;
      *(u32x4*)(Kb + sr * 128 + kso) = kr0; *(u32x4*)(Kb + (sr + 32) * 128 + kso) = kr1;
      *(u32x4*)(Vb + vso + sr * 64) = vr0; *(u32x4*)(Vb + vso + (sr + 32) * 64) = vr1;
    };
    gload(0);
    swrite(0);
    for (int t = 0; t < ntiles; ++t) {
      __syncthreads();
      if (t + 1 < ntiles) gload(t + 1);
      const bool na_tile = na && t < lat_tiles;
      const int kr = ru0 + t;
      const bool part = !na_tile || (kr >= start_w && kr < start_w + 8);
      if (part) {
        const char* Ks = lds + (t & 1) * 16384;
        const char* Vs = Ks + 8192;
        f32x16 s0, s1;
#pragma unroll
        for (int q = 0; q < 16; ++q) { s0[q] = 0.f; s1[q] = 0.f; }
#pragma unroll
        for (int d0 = 0; d0 < 4; ++d0) {
          const int off = ((2 * d0 + hi) ^ sw) * 16;
          const bf16x8 k0 = *(const bf16x8*)(Ks + r32 * 128 + off);
          const bf16x8 k1 = *(const bf16x8*)(Ks + (32 + r32) * 128 + off);
          s0 = MFMA32(k0, qf[d0], s0);
          s1 = MFMA32(k1, qf[d0], s1);
        }
        float mx = -INFINITY;
        if (na_tile) {
          const int cq = (w & 1) * 32 + r32;
          const int c0 = min(max(cq - 8, 0), 48);
          const float* brow = bias_lds + (kr - r_w + 7) * 31 + (15 - cq);
#pragma unroll
          for (int q = 0; q < 16; ++q) {
            const int kc = (q & 3) + 8 * (q >> 2) + 4 * hi;
            const float v0 = ((unsigned)(kc - c0) < 16u) ? fmaf(s0[q], C2, brow[kc]) : -INFINITY;
            const float v1 = ((unsigned)(kc + 32 - c0) < 16u) ? fmaf(s1[q], C2, brow[kc + 32]) : -INFINITY;
            s0[q] = v0; s1[q] = v1;
            mx = fmaxf(mx, fmaxf(v0, v1));
          }
        } else {
#pragma unroll
          for (int q = 0; q < 16; ++q) {
            s0[q] *= C2; s1[q] *= C2;
            mx = fmaxf(mx, fmaxf(s0[q], s1[q]));
          }
        }
        {
          auto rr = __builtin_amdgcn_permlane32_swap(__float_as_uint(mx), __float_as_uint(mx), false, false);
          mx = fmaxf(__uint_as_float(rr[0]), __uint_as_float(rr[1]));
        }
        const float mnew = fmaxf(m, mx);
        const float alpha = __builtin_amdgcn_exp2f(m - mnew);
        float ls = 0.f;
#pragma unroll
        for (int q = 0; q < 16; ++q) {
          s0[q] = __builtin_amdgcn_exp2f(s0[q] - mnew);
          s1[q] = __builtin_amdgcn_exp2f(s1[q] - mnew);
          ls += s0[q] + s1[q];
        }
        l = l * alpha + ls;
        m = mnew;
#pragma unroll
        for (int q = 0; q < 16; ++q) { o0[q] *= alpha; o1[q] *= alpha; }
        bf16x8 pf[4];
#pragma unroll
        for (int s = 0; s < 4; ++s) {
          const int u = (s & 1) * 8;
          u32x4 tpk;
          if (s < 2) {
            tpk.x = pk_bf16(s0[u + 0], s0[u + 1]); tpk.y = pk_bf16(s0[u + 2], s0[u + 3]);
            tpk.z = pk_bf16(s0[u + 4], s0[u + 5]); tpk.w = pk_bf16(s0[u + 6], s0[u + 7]);
          } else {
            tpk.x = pk_bf16(s1[u + 0], s1[u + 1]); tpk.y = pk_bf16(s1[u + 2], s1[u + 3]);
            tpk.z = pk_bf16(s1[u + 4], s1[u + 5]); tpk.w = pk_bf16(s1[u + 6], s1[u + 7]);
          }
          pf[s] = __builtin_bit_cast(bf16x8, tpk);
        }
        const char* vb = Vs + ((lane >> 4) & 1) * 32 + (lane & 3) * 8 + ((lane & 15) >> 2) * 64 + hi * 256;
#pragma unroll
        for (int s = 0; s < 4; ++s) {
          const s16x4 a00 = vtr(vb + (16 * s) * 64), a01 = vtr(vb + (16 * s + 8) * 64);
          const s16x4 a10 = vtr(vb + 4096 + (16 * s) * 64), a11 = vtr(vb + 4096 + (16 * s + 8) * 64);
          const bf16x8 A0 = __builtin_shufflevector(a00, a01, 0, 1, 2, 3, 4, 5, 6, 7);
          const bf16x8 A1 = __builtin_shufflevector(a10, a11, 0, 1, 2, 3, 4, 5, 6, 7);
          o0 = MFMA32(A0, pf[s], o0);
          o1 = MFMA32(A1, pf[s], o1);
        }
      }
      if (t + 1 < ntiles) swrite((t + 1) & 1);
    }
    __syncthreads();
    const float lt = l + __shfl_xor(l, 32);
    const float inv = 1.f / lt;
    unsigned char* op = (unsigned char*)p->AB + (size_t)(qrow0 + r32) * DM + ocol + 4 * hi;
#pragma unroll
    for (int g = 0; g < 4; ++g) {
      *(unsigned*)(op + 8 * g) = pk_fp8x4c(o0[4 * g] * inv, o0[4 * g + 1] * inv, o0[4 * g + 2] * inv, o0[4 * g + 3] * inv);
      *(unsigned*)(op + 32 + 8 * g) = pk_fp8x4c(o1[4 * g] * inv, o1[4 * g + 1] * inv, o1[4 * g + 2] * inv, o1[4 * g + 3] * inv);
    }
  }
}

__device__ void ph_rwkv_mix(KP p, int layer) {
  const int j = layer >> 1;
  const int tid = opaque_tid();
  const int lane = tid & 63, wave = tid >> 6;
  const float* mu = p->rwkv_mu + j * 6 * 512;
  const int c0 = lane * 8;
  auto unpack = [](const u32x4 u, float (&f)[8]) {
    f[0] = bflo(u.x); f[1] = bfhi(u.x); f[2] = bflo(u.y); f[3] = bfhi(u.y);
    f[4] = bflo(u.z); f[5] = bfhi(u.z); f[6] = bflo(u.w); f[7] = bfhi(u.w);
  };
  auto pack = [](const float (&f)[8]) {
    u32x4 o;
    o.x = pk_bf16(f[0], f[1]); o.y = pk_bf16(f[2], f[3]); o.z = pk_bf16(f[4], f[5]); o.w = pk_bf16(f[6], f[7]);
    return o;
  };
  for (int t = blockIdx.x * 4 + wave; t < NT; t += gridDim.x * 4) {
    bool hasp, hasn;
    if (t < NL) { int s = t & 2047; hasp = s > 0; hasn = s < SEQ - 1; }
    else { int s = (t - NL) & 255; hasp = s > 0; hasn = s < CTXL - 1; }
    const bf16_t* pt = p->P + (size_t)t * LDP + c0;
    bf16_t* rw = p->RW + (size_t)t * RWS + c0;
    bf16_t* zb = p->Zb + (size_t)t * 1536 + c0;
    const u32x4 zero = {0u, 0u, 0u, 0u};
#pragma unroll
    for (int q = 0; q < 4; ++q) {
      float cur[8], pv[8], nx[8], d[8];
      unpack(*(const u32x4*)(pt + q * 512), cur);
      unpack(hasp ? *(const u32x4*)(pt + q * 512 - LDP) : zero, pv);
      unpack(hasn ? *(const u32x4*)(pt + q * 512 + LDP) : zero, nx);
#pragma unroll
      for (int e = 0; e < 8; ++e) d[e] = 0.5f * (pv[e] + nx[e]) - cur[e];
      if (q < 3) {
        float o[8];
        const float* m = mu + q * 512 + c0;
#pragma unroll
        for (int e = 0; e < 8; ++e) o[e] = cur[e] + d[e] * m[e];
        if (q == 0) *(u32x4*)(rw) = pack(o);
        else if (q == 2) *(u32x4*)(rw + 512) = pack(o);
        else {
          *(u32x4*)(rw + 10 * 512) = pack(o);
          float kk[8], ss = 0.f;
          const float* kv0 = p->rwkv_kvec + (j * 2 + 0) * 512 + c0;
#pragma unroll
          for (int e = 0; e < 8; ++e) { kk[e] = o[e] * kv0[e]; ss += kk[e] * kk[e]; }
          ss += dppx<0xB1>(ss); ss += dppx<0x4E>(ss); ss += dppx<0x141>(ss);
          const float rn = rsqrtf(fmaxf(ss, 1e-24f));
#pragma unroll
          for (int e = 0; e < 8; ++e) kk[e] *= rn;
          *(u32x4*)(rw + 2 * 512) = pack(kk);
        }
      } else {
#pragma unroll
        for (int z = 0; z < 3; ++z) {
          float o[8];
          const float* m = mu + (3 + z) * 512 + c0;
#pragma unroll
          for (int e = 0; e < 8; ++e) o[e] = cur[e] + d[e] * m[e];
          *(u32x4*)(zb + z * 512) = pack(o);
        }
      }
    }
  }
}

constexpr int RS_STEP = 384;
constexpr int RS_TB = 16;
struct RwkvStage { u32x2 r, kk, e, ke, a, v; };
__device__ void rwkv_unit(KP p, int unit, float* sm, int tid) {
  const int ch = unit >> 1, hf = unit & 1;
  const int dir = ch >> 6, b = (ch >> 3) & 7, h = ch & 7;
  const int lane = tid & 63, w = tid >> 6, rl = lane >> 3, ks = lane & 7;
  float* ybuf = sm + 2 * RS_TB * RS_STEP;
  const int ss = tid >> 4, kq = tid & 15;
  auto gload = [&](int n, RwkvStage& g) {
    const int row = scan_row(dir, b, n * RS_TB + ss);
    const bf16_t* base = p->RW + (size_t)row * RWS + h * 64 + kq * 4;
    g.r = *(const u32x2*)(base);
    g.kk = *(const u32x2*)(base + 2 * 512);
    g.e = *(const u32x2*)(base + (3 + dir) * 512);
    g.ke = *(const u32x2*)(base + (5 + dir) * 512);
    g.a = *(const u32x2*)(base + (7 + dir) * 512);
    g.v = *(const u32x2*)(p->RW + (size_t)row * RWS + 512 + h * 64 + hf * 32 + (kq & 7) * 4);
  };
  auto swrite = [&](int buf, const RwkvStage& g) {
    float* sp = sm + (buf * RS_TB + ss) * RS_STEP;
    const float r0 = bflo(g.r.x), r1 = bfhi(g.r.x), r2 = bflo(g.r.y), r3 = bfhi(g.r.y);
    const float k0 = bflo(g.kk.x), k1 = bfhi(g.kk.x), k2 = bflo(g.kk.y), k3 = bfhi(g.kk.y);
    const float w0 = __expf(-bflo(g.e.x)), w1 = __expf(-bfhi(g.e.x)), w2 = __expf(-bflo(g.e.y)), w3 = __expf(-bfhi(g.e.y));
    const float e0 = bflo(g.ke.x), e1 = bfhi(g.ke.x), e2 = bflo(g.ke.y), e3 = bfhi(g.ke.y);
    const float a0 = k0 * bflo(g.a.x), a1 = k1 * bfhi(g.a.x), a2 = k2 * bflo(g.a.y), a3 = k3 * bfhi(g.a.y);
    *(float4*)(sp + kq * 4) = make_float4(k0, k1, k2, k3);
    *(float4*)(sp + 64 + kq * 4) = make_float4(w0 * r0, w1 * r1, w2 * r2, w3 * r3);
    *(float4*)(sp + 128 + kq * 4) = make_float4(w0, w1, w2, w3);
    *(float4*)(sp + 192 + kq * 4) = make_float4(a0, a1, a2, a3);
    *(float4*)(sp + 256 + kq * 4) = make_float4(e0, e1, e2, e3);
    if (kq < 8) *(float4*)(sp + 320 + kq * 4) = make_float4(bflo(g.v.x), bfhi(g.v.x), bflo(g.v.y), bfhi(g.v.y));
    float c1 = a0 * r0 + a1 * r1 + a2 * r2 + a3 * r3;
    float c2 = e0 * r0 + e1 * r1 + e2 * r2 + e3 * r3;
    c1 += dppx<0xB1>(c1); c2 += dppx<0xB1>(c2);
    c1 += dppx<0x4E>(c1); c2 += dppx<0x4E>(c2);
    c1 += dppx<0x141>(c1); c2 += dppx<0x141>(c2);
    c1 += dppx<0x140>(c1); c2 += dppx<0x140>(c2);
    if (kq == 0) { sp[352] = c1; sp[353] = c2; }
  };
  typedef float f2 __attribute__((ext_vector_type(2)));
  f2 S01 = {0.f, 0.f}, S23 = {0.f, 0.f}, S45 = {0.f, 0.f}, S67 = {0.f, 0.f};
  auto compute = [&](int n) {
    const float* bp = sm + (n & 1) * RS_TB * RS_STEP;
    float* yb = ybuf + (n & 1) * RS_TB * 32 + w * 8 + rl;
    struct Ops { f2 k[4], r[4], w[4], a[4], e[4]; float vv; f2 c; };
    auto ld = [&](int s, Ops& o) {
      const float* sq = bp + s * RS_STEP;
      const f2* sp = (const f2*)(sq + ks * 8);
#pragma unroll
      for (int i = 0; i < 4; ++i) { o.k[i] = sp[i]; o.r[i] = sp[32 + i]; o.w[i] = sp[64 + i]; o.a[i] = sp[96 + i]; o.e[i] = sp[128 + i]; }
      o.vv = sq[320 + w * 8 + rl]; o.c = *(const f2*)(sq + 352);
    };
    auto step = [&](const Ops& o) -> float {
      f2 sa2 = S01 * o.k[0];
      f2 y2 = S01 * o.r[0];
      sa2 = __builtin_elementwise_fma(S23, o.k[1], sa2); y2 = __builtin_elementwise_fma(S23, o.r[1], y2);
      sa2 = __builtin_elementwise_fma(S45, o.k[2], sa2); y2 = __builtin_elementwise_fma(S45, o.r[2], y2);
      sa2 = __builtin_elementwise_fma(S67, o.k[3], sa2); y2 = __builtin_elementwise_fma(S67, o.r[3], y2);
      float sa = sa2.x + sa2.y, y0 = y2.x + y2.y;
      sa += dppx<0xB1>(sa); y0 += dppx<0xB1>(y0);
      sa += dppx<0x4E>(sa); y0 += dppx<0x4E>(y0);
      sa += dppx<0x141>(sa); y0 += dppx<0x141>(y0);
      sa = -sa;
      const f2 sav = {sa, sa}, vvv = {o.vv, o.vv};
      S01 = __builtin_elementwise_fma(vvv, o.e[0], __builtin_elementwise_fma(sav, o.a[0], S01 * o.w[0]));
      S23 = __builtin_elementwise_fma(vvv, o.e[1], __builtin_elementwise_fma(sav, o.a[1], S23 * o.w[1]));
      S45 = __builtin_elementwise_fma(vvv, o.e[2], __builtin_elementwise_fma(sav, o.a[2], S45 * o.w[2]));
      S67 = __builtin_elementwise_fma(vvv, o.e[3], __builtin_elementwise_fma(sav, o.a[3], S67 * o.w[3]));
      return fmaf(o.vv, o.c.y, fmaf(sa, o.c.x, y0));
    };
    Ops oa, ob;
    ld(0, oa);
#pragma unroll 1
    for (int s = 0; s < RS_TB; s += 2) {
      __builtin_amdgcn_sched_barrier(0);
      ld(s + 1, ob);
      __builtin_amdgcn_sched_barrier(0);
      float y0 = step(oa);
      asm volatile("" : "+v"(y0));
      __builtin_amdgcn_sched_barrier(0);
      ld(s + 2, oa);
      __builtin_amdgcn_sched_barrier(0);
      float y1 = step(ob);
      asm volatile("" : "+v"(y1));
      __builtin_amdgcn_sched_barrier(0);
      if (ks == 0) { yb[s * 32] = y0; yb[(s + 1) * 32] = y1; }
    }
  };
  auto yout = [&](int n) {
    const int row = scan_row(dir, b, n * RS_TB + ss);
    const float* ys = ybuf + (n & 1) * RS_TB * 32 + ss * 32 + kq * 2;
    *(unsigned*)(p->P + (size_t)row * LDP + dir * 512 + h * 64 + hf * 32 + kq * 2) = pk_bf16(ys[0], ys[1]);
  };
  constexpr int NB = TSC / RS_TB;
  RwkvStage gA, gB;
  gload(0, gA);
  gload(1, gB);
  swrite(0, gA);
  gload(2, gA);
  __syncthreads();
  for (int n = 0; n < NB; n += 2) {
    compute(n);
    swrite(1, gB);
    if (n + 3 < NB) gload(n + 3, gB);
    __syncthreads();
    yout(n);
    compute(n + 1);
    if (n + 2 < NB) swrite(0, gA);
    if (n + 4 < NB) gload(n + 4, gA);
    __syncthreads();
    yout(n + 1);
  }
  __syncthreads();
}

__device__ void mlstm_s1(KP p, int layer, int tile, char* lds, int tid) {
  const int j = layer >> 1;
  const int ch = tile / NCHUNK, c = tile % NCHUNK;
  const int dir = ch >> 5, b = (ch >> 2) & 7, h = ch & 3;
  float* s_ws = (float*)(lds + META_OFF);
  int* s_row = (int*)(s_ws + 64);
  char* kimg = lds;
  char* vimg = lds + 16384;
  if (tid < 64) {
    const int row = scan_row(dir, b, c * 64 + tid);
    s_row[tid] = row;
    const float* g = p->GP + (size_t)row * 16;
    const float gi = g[(dir * 2) * 4 + h] + p->mlstm_gate_b[j * 16 + (dir * 2) * 4 + h];
    const float gf = g[(dir * 2 + 1) * 4 + h] + p->mlstm_gate_b[j * 16 + (dir * 2 + 1) * 4 + h];
    float bc = -softplus_f(-gf);
#pragma unroll
    for (int o = 1; o < 64; o <<= 1) {
      float tmp = __shfl_up(bc, o);
      if (tid >= o) bc += tmp;
    }
    const float bend = __shfl(bc, 63);
    const float ds = bend - bc + gi;
    const float mloc = wmax(ds);
    s_ws[tid] = expf(ds - mloc);
    if (tid == 0) { p->msc[tile] = mloc; p->msc[NMT + tile] = bend; }
  }
  __syncthreads();
  {
    const int c8 = tid & 15;
    const int ioff = (c8 >> 2) * 4096 + (c8 & 3) * 16;
#pragma unroll
    for (int i = 0; i < 4; ++i) {
      const int sidx = (tid >> 4) + 16 * i;
      const bf16_t* src = p->P + (size_t)s_row[sidx] * LDP + h * 128 + c8 * 8;
      const u32x4 kv = *(const u32x4*)(src + 2560);
      u32x4 vv = *(const u32x4*)(src + 3072);
      const float wsv = s_ws[sidx];
      vv.x = pk_bf16(bflo(vv.x) * wsv, bfhi(vv.x) * wsv); vv.y = pk_bf16(bflo(vv.y) * wsv, bfhi(vv.y) * wsv);
      vv.z = pk_bf16(bflo(vv.z) * wsv, bfhi(vv.z) * wsv); vv.w = pk_bf16(bflo(vv.w) * wsv, bfhi(vv.w) * wsv);
      *(u32x4*)(kimg + ioff + sidx * 64) = kv;
      *(u32x4*)(vimg + ioff + sidx * 64) = vv;
    }
  }
  __syncthreads();
  const int lane = tid & 63, w = tid >> 6, wm = w >> 1, wn = w & 1, r32 = lane & 31, hi = lane >> 5;
  f32x16 acc[2][2];
#pragma unroll
  for (int mi = 0; mi < 2; ++mi)
#pragma unroll
    for (int ni = 0; ni < 2; ++ni)
#pragma unroll
      for (int q = 0; q < 16; ++q) acc[mi][ni][q] = 0.f;
  const int toff = ((lane >> 4) & 1) * 32 + (lane & 3) * 8 + ((lane & 15) >> 2) * 64 + hi * 256;
#pragma unroll
  for (int ks = 0; ks < 4; ++ks) {
    bf16x8 af[2], bfr[2];
#pragma unroll
    for (int i = 0; i < 2; ++i) {
      const char* ka = kimg + (wm * 2 + i) * 4096 + toff + (16 * ks) * 64;
      const char* va = vimg + (wn * 2 + i) * 4096 + toff + (16 * ks) * 64;
      af[i] = __builtin_shufflevector(vtr(ka), vtr(ka + 8 * 64), 0, 1, 2, 3, 4, 5, 6, 7);
      bfr[i] = __builtin_shufflevector(vtr(va), vtr(va + 8 * 64), 0, 1, 2, 3, 4, 5, 6, 7);
    }
    acc[0][0] = MFMA32(af[0], bfr[0], acc[0][0]);
    acc[0][1] = MFMA32(af[0], bfr[1], acc[0][1]);
    acc[1][0] = MFMA32(af[1], bfr[0], acc[1][0]);
    acc[1][1] = MFMA32(af[1], bfr[1], acc[1][1]);
  }
  bf16_t* ust = (bf16_t*)(lds + 32768);
#pragma unroll
  for (int mi = 0; mi < 2; ++mi)
#pragma unroll
    for (int ni = 0; ni < 2; ++ni)
#pragma unroll
      for (int q = 0; q < 16; ++q) {
        const int d = wm * 64 + mi * 32 + (q & 3) + 8 * (q >> 2) + 4 * hi;
        ust[d * 128 + wn * 64 + ni * 32 + r32] = f2bf(acc[mi][ni][q]);
        if ((q & 3) == 3) __builtin_amdgcn_sched_barrier(0);
      }
  __syncthreads();
  {
    const u32x4* us4 = (const u32x4*)ust;
    u32x4* U4 = (u32x4*)(p->MS + (size_t)tile * 16384);
#pragma unroll
    for (int i = 0; i < 8; ++i) U4[tid + 256 * i] = us4[tid + 256 * i];
  }
  if (tid < 128) {
    const char* kc = kimg + (tid >> 5) * 4096 + (tid & 31) * 2;
    float a = 0.f;
#pragma unroll 8
    for (int sidx = 0; sidx < 64; ++sidx) a = fmaf(s_ws[sidx], bf2f(*(const bf16_t*)(kc + sidx * 64)), a);
    p->MSn[tile * 128 + tid] = a;
  }
}

__device__ void mlstm_s3(KP p, int layer, int tile, char* lds, int tid);
__device__ void ph_scan_a(KP p, int layer, char* smc) {
  float* sm = (float*)smc;
  const int tid = opaque_tid();
  __builtin_amdgcn_s_setprio(3);
  for (int u = blockIdx.x; u < 256; u += gridDim.x) rwkv_unit(p, u, sm, tid);
  __builtin_amdgcn_s_setprio(0);
  {
    const int stage = layer == 1 ? 1 : 2;
    const int nconv = conv_stage_total(stage);
    const int total = NMT + (nconv + 7) / 8;
    int* qc = (int*)(p->bar + XCD_BAR_WORDS + 16 * stage);
    int* s_q = (int*)(smc + META_OFF + 3968);
    int jj = 0, j1 = 0;
#pragma unroll 1
    for (;;) {
      if (jj >= j1) {
        __syncthreads();
        if (tid == 0) *s_q = atomicAdd(qc, 1);
        __syncthreads();
        const int q = *s_q;
        if (q >= total) break;
        if (q < NMT) { mlstm_s3(p, layer, q, smc, tid); continue; }
        jj = (q - NMT) * 8; j1 = min(jj + 8, nconv);
      }
      convert_run(p, stage, jj, j1, sm, tid);
      jj = j1;
    }
  }
}

__device__ void ph_mlstm_s2(KP p, char* smc) {
  float* sw = (float*)smc;
  const int tid = opaque_tid();
  const int nitems = 64 * 33;
  for (int item = blockIdx.x; item < nitems; item += gridDim.x) {
    const int ch = item / 33, seg = item % 33;
    __syncthreads();
    if (tid < 2 * NCHUNK) sw[72 + tid] = p->msc[(tid < NCHUNK ? 0 : NMT - NCHUNK) + ch * NCHUNK + tid];
    __syncthreads();
    if (tid == 0) {
      float m = 0.f;
      for (int c = 0; c < NCHUNK; ++c) {
        const int tile = ch * NCHUNK + c;
        const float mloc = sw[72 + c], bend = sw[72 + NCHUNK + c];
        const float mn = fmaxf(bend + m, mloc);
        sw[c] = expf(bend + m - mn);
        sw[36 + c] = expf(mloc - mn);
        if (seg == 0) p->msc[2 * NMT + tile] = m;
        m = mn;
      }
    }
    __syncthreads();
    if (seg < 32) {
      unsigned* base = (unsigned*)(p->MS + (size_t)ch * NCHUNK * 16384) + seg * 256 + tid;
      unsigned v[NCHUNK];
#pragma unroll
      for (int c = 0; c < NCHUNK; ++c) v[c] = base[(size_t)c * 8192];
      float C0 = 0.f, C1 = 0.f;
#pragma unroll
      for (int c = 0; c < NCHUNK; ++c) {
        const float t0 = bflo(v[c]), t1 = bfhi(v[c]);
        v[c] = pk_bf16(C0, C1);
        C0 = sw[c] * C0 + sw[36 + c] * t0;
        C1 = sw[c] * C1 + sw[36 + c] * t1;
      }
#pragma unroll
      for (int c = 0; c < NCHUNK; ++c) base[(size_t)c * 8192] = v[c];
    } else if (tid < 128) {
      float* base = p->MSn + (size_t)ch * NCHUNK * 128 + tid;
      float v[NCHUNK];
#pragma unroll
      for (int c = 0; c < NCHUNK; ++c) v[c] = base[c * 128];
      float C = 0.f;
#pragma unroll
      for (int c = 0; c < NCHUNK; ++c) {
        const float t0 = v[c];
        v[c] = C;
        C = sw[c] * C + sw[36 + c] * t0;
      }
#pragma unroll
      for (int c = 0; c < NCHUNK; ++c) base[c * 128] = v[c];
    }
  }
}

__device__ void mlstm_s3(KP p, int layer, int tile, char* lds, int tid) {
  const int j = layer >> 1;
  const int ch = tile / NCHUNK, c = tile % NCHUNK;
  const int dir = ch >> 5, b = (ch >> 2) & 7, h = ch & 3;
  float* s_b = (float*)(lds + META_OFF);
  float* s_ig = s_b + 64;
  float* s_mt = s_b + 128;
  float* s_wi = s_b + 192;
  int* s_row = (int*)(s_b + 256);
  float* s_n = s_b + 320;
  float* s_c = s_b + 448;
  char* kimg = lds;
  char* vimg = lds + 16384;
  char* cimg = lds + 32768;
  const float mprev = p->msc[2 * NMT + tile];
  const float qscale = 0.08838834764831845f;
  const int lane = tid & 63, w = tid >> 6, wt = w >> 1, wv = w & 1, r32 = lane & 31, hi = lane >> 5;
  const int t = wt * 32 + r32;
  const int rowq = scan_row(dir, b, c * 64 + t);
  const int c8 = tid & 15;
  u32x4 kr[4], vr[4], cr[8];
#pragma unroll
  for (int i = 0; i < 4; ++i) {
    const int sidx = (tid >> 4) + 16 * i;
    const bf16_t* src = p->P + (size_t)scan_row(dir, b, c * 64 + sidx) * LDP + h * 128 + c8 * 8;
    kr[i] = *(const u32x4*)(src + 2560);
    vr[i] = *(const u32x4*)(src + 3072);
  }
  {
    const bf16_t* Cp = p->MS + (size_t)tile * 16384;
#pragma unroll
    for (int i = 0; i < 8; ++i) cr[i] = *(const u32x4*)(Cp + ((tid >> 4) + 16 * i) * 128 + c8 * 8);
  }
  bf16x8 qf[8];
  {
    const bf16_t* qp = p->P + (size_t)rowq * LDP + 2048 + h * 128 + hi * 8;
#pragma unroll
    for (int d0 = 0; d0 < 8; ++d0) qf[d0] = *(const bf16x8*)(qp + d0 * 16);
  }
  if (tid < 64) {
    const int row = scan_row(dir, b, c * 64 + tid);
    s_row[tid] = row;
    const float* g = p->GP + (size_t)row * 16;
    const float gi = g[(dir * 2) * 4 + h] + p->mlstm_gate_b[j * 16 + (dir * 2) * 4 + h];
    const float gf = g[(dir * 2 + 1) * 4 + h] + p->mlstm_gate_b[j * 16 + (dir * 2 + 1) * 4 + h];
    float bc = -softplus_f(-gf);
#pragma unroll
    for (int o = 1; o < 64; o <<= 1) {
      float tmp = __shfl_up(bc, o);
      if (tid >= o) bc += tmp;
    }
    float pm = gi - bc;
#pragma unroll
    for (int o = 1; o < 64; o <<= 1) {
      float tmp = __shfl_up(pm, o);
      if (tid >= o) pm = fmaxf(pm, tmp);
    }
    const float mt = bc + fmaxf(mprev, pm);
    s_b[tid] = bc;
    s_ig[tid] = gi;
    s_mt[tid] = mt;
    s_wi[tid] = expf(bc + mprev - mt);
    s_c[tid] = (gi - bc) * 1.4426950408889634f;
  } else if (tid < 192) s_n[tid - 64] = p->MSn[tile * 128 + (tid - 64)];
  {
    const int ioff = (c8 >> 2) * 4096 + (c8 & 3) * 16;
#pragma unroll
    for (int i = 0; i < 4; ++i) {
      const int sidx = (tid >> 4) + 16 * i;
      *(u32x4*)(kimg + sidx * 256 + ((c8 ^ (sidx & 15)) * 16)) = kr[i];
      *(u32x4*)(vimg + ioff + sidx * 64) = vr[i];
    }
    const int coff = (c8 >> 2) * 8192 + (c8 & 3) * 16;
#pragma unroll
    for (int i = 0; i < 8; ++i) *(u32x4*)(cimg + coff + ((tid >> 4) + 16 * i) * 64) = cr[i];
  }
  __syncthreads();
  const int toff = ((lane >> 4) & 1) * 32 + (lane & 3) * 8 + ((lane & 15) >> 2) * 64;
  constexpr float LOG2E_ = 1.4426950408889634f;
  float qn = 0.f;
#pragma unroll
  for (int d0 = 0; d0 < 8; ++d0) {
    const u32x4 qq = __builtin_bit_cast(u32x4, qf[d0]);
    const float* np = s_n + d0 * 16 + hi * 8;
    qn = fmaf(bflo(qq.x), np[0], qn); qn = fmaf(bfhi(qq.x), np[1], qn);
    qn = fmaf(bflo(qq.y), np[2], qn); qn = fmaf(bfhi(qq.y), np[3], qn);
    qn = fmaf(bflo(qq.z), np[4], qn); qn = fmaf(bfhi(qq.z), np[5], qn);
    qn = fmaf(bflo(qq.w), np[6], qn); qn = fmaf(bfhi(qq.w), np[7], qn);
  }
  qn += __shfl_xor(qn, 32);
  const float mtt = s_mt[t], wi = s_wi[t];
  const float ct = (s_b[t] - mtt) * LOG2E_;
  const float wq = wi * qscale;
  bf16x8 pf[4];
  float den = 0.f;
  {
    f32x16 sa0, sa1;
#pragma unroll
    for (int q = 0; q < 16; ++q) { sa0[q] = 0.f; sa1[q] = 0.f; }
#pragma unroll
    for (int d0 = 0; d0 < 8; ++d0) {
      const int chn = 2 * d0 + hi;
      const bf16x8 k0 = *(const bf16x8*)(kimg + r32 * 256 + ((chn ^ (r32 & 15)) * 16));
      sa0 = MFMA32(k0, qf[d0], sa0);
      if (wt) {
        const bf16x8 k1 = *(const bf16x8*)(kimg + (32 + r32) * 256 + ((chn ^ (r32 & 15)) * 16));
        sa1 = MFMA32(k1, qf[d0], sa1);
      }
      __builtin_amdgcn_sched_barrier(0);
    }
#pragma unroll
    for (int g = 0; g < 4; ++g) {
      const int sb0 = 8 * g + 4 * hi;
      const float4 c0v = *(const float4*)(s_c + sb0);
      const float4 c1v = *(const float4*)(s_c + sb0 + 32);
      const float cc0[4] = {c0v.x, c0v.y, c0v.z, c0v.w}, cc1[4] = {c1v.x, c1v.y, c1v.z, c1v.w};
#pragma unroll
      for (int e = 0; e < 4; ++e) {
        const int q = 4 * g + e;
        const float v0 = (sb0 + e <= t) ? sa0[q] * qscale * __builtin_amdgcn_exp2f(ct + cc0[e]) : 0.f;
        sa0[q] = v0; den += v0;
        const float v1 = (wt && sb0 + 32 + e <= t) ? sa1[q] * qscale * __builtin_amdgcn_exp2f(ct + cc1[e]) : 0.f;
        sa1[q] = v1; den += v1;
      }
      __builtin_amdgcn_sched_barrier(0);
    }
#pragma unroll
    for (int sx = 0; sx < 4; ++sx) {
      const int u = (sx & 1) * 8;
      u32x4 tpk;
      if (sx < 2) {
        tpk.x = pk_bf16(sa0[u + 0], sa0[u + 1]); tpk.y = pk_bf16(sa0[u + 2], sa0[u + 3]);
        tpk.z = pk_bf16(sa0[u + 4], sa0[u + 5]); tpk.w = pk_bf16(sa0[u + 6], sa0[u + 7]);
      } else {
        tpk.x = pk_bf16(sa1[u + 0], sa1[u + 1]); tpk.y = pk_bf16(sa1[u + 2], sa1[u + 3]);
        tpk.z = pk_bf16(sa1[u + 4], sa1[u + 5]); tpk.w = pk_bf16(sa1[u + 6], sa1[u + 7]);
      }
      pf[sx] = __builtin_bit_cast(bf16x8, tpk);
    }
  }
  den += __shfl_xor(den, 32);
  const float dtot = den + wq * qn;
  const float inv = 1.f / fmaxf(fabsf(dtot), expf(-mtt));
  bf16_t* op = p->P + (size_t)rowq * LDP + 1024 + dir * 512 + h * 128 + wv * 64 + 4 * hi;
#pragma unroll 1
  for (int vp = 0; vp < 2; ++vp) {
    f32x16 o0;
#pragma unroll
    for (int q = 0; q < 16; ++q) o0[q] = 0.f;
    const char* cb = cimg + (wv * 2 + vp) * 8192 + toff + hi * 512;
#pragma unroll
    for (int d0 = 0; d0 < 8; ++d0) {
      const bf16x8 A0 = __builtin_shufflevector(vtr(cb + (16 * d0) * 64), vtr(cb + (16 * d0 + 4) * 64), 0, 1, 2, 3, 4, 5, 6, 7);
      o0 = MFMA32(A0, qf[d0], o0);
    }
#pragma unroll
    for (int q = 0; q < 16; ++q) o0[q] *= wq;
    const char* vb = vimg + (wv * 2 + vp) * 4096 + toff + hi * 256;
#pragma unroll
    for (int sx = 0; sx < 4; ++sx) {
      if (sx < 2 || wt) {
        const bf16x8 A0 = __builtin_shufflevector(vtr(vb + (16 * sx) * 64), vtr(vb + (16 * sx + 8) * 64), 0, 1, 2, 3, 4, 5, 6, 7);
        o0 = MFMA32(A0, pf[sx], o0);
      }
    }
#pragma unroll
    for (int g = 0; g < 4; ++g) {
      u32x2 v0;
      v0.x = pk_bf16(o0[4 * g] * inv, o0[4 * g + 1] * inv); v0.y = pk_bf16(o0[4 * g + 2] * inv, o0[4 * g + 3] * inv);
      *(u32x2*)(op + vp * 32 + 8 * g) = v0;
    }
  }
}

__device__ void ph_mlstm_s1(KP p, int layer, char* smc) {
  const int tid = opaque_tid();
  __syncthreads();
  for (int tile = blockIdx.x; tile < NMT; tile += gridDim.x) { mlstm_s1(p, layer, tile, smc, tid); __syncthreads(); }
}

__device__ void ph_rec_final(KP p, int layer, bool keep) {
  const int tid = opaque_tid();
  const int j = layer >> 1;
  const int lane = tid & 63, wave = tid >> 6;
  const int rows = keep ? NT : NL;
  const int c0 = lane * 8;
  auto unpack = [](const u32x4 u, float (&f)[8]) {
    f[0] = bflo(u.x); f[1] = bfhi(u.x); f[2] = bflo(u.y); f[3] = bfhi(u.y);
    f[4] = bflo(u.z); f[5] = bfhi(u.z); f[6] = bflo(u.w); f[7] = bfhi(u.w);
  };
  for (int t = blockIdx.x * 4 + wave; t < rows; t += gridDim.x * 4) {
    const bf16_t* rw = p->RW + (size_t)t * RWS + c0;
    const bf16_t* pt = p->P + (size_t)t * LDP + c0;
    unsigned char* mo = (unsigned char*)p->AB + (size_t)t * DM + c0;
    {
      float yf[8], yb[8], r[8], v[8], k0[8], k1[8], g[8], y[8], o[8];
      unpack(*(const u32x4*)(pt), yf); unpack(*(const u32x4*)(pt + 512), yb);
      unpack(*(const u32x4*)(rw), r); unpack(*(const u32x4*)(rw + 512), v);
      unpack(*(const u32x4*)(rw + 5 * 512), k0); unpack(*(const u32x4*)(rw + 6 * 512), k1);
      unpack(*(const u32x4*)(rw + 9 * 512), g);
      float s1 = 0.f, bs = 0.f;
      const float* rk = p->rwkv_rk + j * 512 + c0;
#pragma unroll
      for (int e = 0; e < 8; ++e) { y[e] = yf[e] + yb[e]; s1 += y[e]; bs += r[e] * rk[e] * (k0[e] + k1[e]); }
      s1 += dppx<0xB1>(s1); s1 += dppx<0x4E>(s1); s1 += dppx<0x141>(s1);
      bs += dppx<0xB1>(bs); bs += dppx<0x4E>(bs); bs += dppx<0x141>(bs);
      const float mu = s1 * (1.f / 64.f);
      float s2 = 0.f;
#pragma unroll
      for (int e = 0; e < 8; ++e) { const float d = y[e] - mu; s2 += d * d; }
      s2 += dppx<0xB1>(s2); s2 += dppx<0x4E>(s2); s2 += dppx<0x141>(s2);
      const float rs = rsqrtf(s2 * (1.f / 64.f) + 64e-5f);
      const float* gn0 = p->rwkv_gn + (j * 2 + 0) * 512 + c0;
      const float* gn1 = p->rwkv_gn + (j * 2 + 1) * 512 + c0;
#pragma unroll
      for (int e = 0; e < 8; ++e) o[e] = ((y[e] - mu) * rs * gn0[e] + gn1[e] + bs * v[e]) * g[e];
      u32x2 ov;
      ov.x = pk_fp8x4c(o[0], o[1], o[2], o[3]); ov.y = pk_fp8x4c(o[4], o[5], o[6], o[7]);
      *(u32x2*)(mo) = ov;
    }
    {
      float hf[8], hb[8], og[8], hsum[8], o[8];
      unpack(*(const u32x4*)(pt + 1024), hf); unpack(*(const u32x4*)(pt + 1536), hb);
      unpack(*(const u32x4*)(pt + 3584), og);
      float ss = 0.f;
#pragma unroll
      for (int e = 0; e < 8; ++e) { hsum[e] = hf[e] + hb[e]; ss += hsum[e] * hsum[e]; }
      ss += dppx<0xB1>(ss); ss += dppx<0x4E>(ss); ss += dppx<0x141>(ss); ss += dppx<0x140>(ss);
      const float rs = rsqrtf(ss * (1.f / 128.f) + 1e-6f);
      const float* ng = p->mlstm_norm + j * 512 + c0;
#pragma unroll
      for (int e = 0; e < 8; ++e) o[e] = hsum[e] * rs * ng[e] * sigm_f(og[e]);
      u32x2 ov;
      ov.x = pk_fp8x4c(o[0], o[1], o[2], o[3]); ov.y = pk_fp8x4c(o[4], o[5], o[6], o[7]);
      *(u32x2*)(mo + 512) = ov;
    }
  }
}

using f32x4v = __attribute__((ext_vector_type(4))) float;
__device__ void ph_ln_router(KP p, int layer, bool keep, char* smc) {
  float* h2s = (float*)smc;
  float* lgs = (float*)smc;
  const int tid = opaque_tid();
  const int lane = tid & 63, wave = tid >> 6;
  const int rows = keep ? NT : NL;
  const float* lng = p->ln_g + (layer * 2 + 0) * 1024;
  const float* lnb = p->ln_b + (layer * 2 + 0) * 1024;
  for (int tile = blockIdx.x; tile < rows / 16; tile += gridDim.x) {
    const int t0 = tile * 16;
    const float* mod = p->MOD + (layer * 9 + modrow(t0)) * 6144;
    const float* brow = p->WrT + ((size_t)layer * 64 + 16 * wave + (lane & 15)) * 1024 + 4 * (lane >> 4);
    f32x4v b0[8], b1[8], b2[8];
#pragma unroll
    for (int q = 0; q < 8; ++q) { b0[q] = *(const f32x4v*)(brow + 16 * q); b1[q] = *(const f32x4v*)(brow + 16 * (8 + q)); }
    __builtin_amdgcn_sched_barrier(0);
    {
      float4 v[4][4];
      float s4[4];
#pragma unroll
      for (int q = 0; q < 4; ++q) {
        const int t = t0 + wave * 4 + q;
        s4[q] = 0.f;
#pragma unroll
        for (int i = 0; i < 4; ++i) v[q][i] = *(const float4*)(p->Tb + (size_t)t * DM + i * 256 + lane * 4);
      }
#pragma unroll
      for (int q = 0; q < 4; ++q)
#pragma unroll
        for (int i = 0; i < 4; ++i) s4[q] += (v[q][i].x + v[q][i].y) + (v[q][i].z + v[q][i].w);
      float mean4[4], rs4[4];
#pragma unroll
      for (int q = 0; q < 4; ++q) mean4[q] = wsum(s4[q]) * (1.f / 1024.f);
#pragma unroll
      for (int q = 0; q < 4; ++q) {
        float qq = 0.f;
#pragma unroll
        for (int i = 0; i < 4; ++i) {
          const float d0 = v[q][i].x - mean4[q], d1 = v[q][i].y - mean4[q], d2 = v[q][i].z - mean4[q], d3 = v[q][i].w - mean4[q];
          qq += (d0 * d0 + d1 * d1) + (d2 * d2 + d3 * d3);
        }
        s4[q] = qq;
      }
#pragma unroll
      for (int q = 0; q < 4; ++q) rs4[q] = rsqrtf(wsum(s4[q]) * (1.f / 1024.f) + 1e-5f);
#pragma unroll
      for (int i = 0; i < 4; ++i) {
        const int n = i * 256 + lane * 4;
        const float4 g = *(const float4*)(lng + n), bb = *(const float4*)(lnb + n);
        const float4 sc = *(const float4*)(mod + 4096 + n), sh = *(const float4*)(mod + 3072 + n);
#pragma unroll
        for (int q = 0; q < 4; ++q) {
          const int tl = wave * 4 + q, t = t0 + tl;
          const float mean = mean4[q], rs = rs4[q];
          const float4 xn = make_float4((v[q][i].x - mean) * rs * g.x + bb.x, (v[q][i].y - mean) * rs * g.y + bb.y,
                                        (v[q][i].z - mean) * rs * g.z + bb.z, (v[q][i].w - mean) * rs * g.w + bb.w);
          *(float4*)(p->X + (size_t)t * DM + n) = xn;
          const float4 hh = make_float4(xn.x * (1.f + sc.x) + sh.x, xn.y * (1.f + sc.y) + sh.y,
                                        xn.z * (1.f + sc.z) + sh.z, xn.w * (1.f + sc.w) + sh.w);
          *(unsigned*)((unsigned char*)p->AB + (size_t)t * DM + n) = pk_fp8x4(hh.x, hh.y, hh.z, hh.w);
          *(float4*)(h2s + tl * 1028 + n) = hh;
        }
      }
    }
    __syncthreads();
    f32x4v acc = {0.f, 0.f, 0.f, 0.f};
    {
      f32x4v a1 = {0.f, 0.f, 0.f, 0.f}, a2 = {0.f, 0.f, 0.f, 0.f}, a3 = {0.f, 0.f, 0.f, 0.f};
      const int i = lane & 15, kk = lane >> 4;
      const float* arow = h2s + i * 1028 + 4 * kk;
#define ROUTER_LOAD(B, Q0) _Pragma("unroll") for (int q = 0; q < 8; ++q) B[q] = *(const f32x4v*)(brow + 16 * ((Q0) + q)); __builtin_amdgcn_sched_barrier(0);
#define ROUTER_MFMA(B, Q0) _Pragma("unroll") for (int q = 0; q < 8; ++q) { \
        const float4 a = *(const float4*)(arow + 16 * ((Q0) + q)); \
        acc = __builtin_amdgcn_mfma_f32_16x16x4f32(a.x, B[q].x, acc, 0, 0, 0); \
        a1 = __builtin_amdgcn_mfma_f32_16x16x4f32(a.y, B[q].y, a1, 0, 0, 0); \
        a2 = __builtin_amdgcn_mfma_f32_16x16x4f32(a.z, B[q].z, a2, 0, 0, 0); \
        a3 = __builtin_amdgcn_mfma_f32_16x16x4f32(a.w, B[q].w, a3, 0, 0, 0); } __builtin_amdgcn_sched_barrier(0);
      ROUTER_LOAD(b2, 16) ROUTER_MFMA(b0, 0)
      ROUTER_LOAD(b0, 24) ROUTER_MFMA(b1, 8)
      ROUTER_LOAD(b1, 32) ROUTER_MFMA(b2, 16)
      ROUTER_LOAD(b2, 40) ROUTER_MFMA(b0, 24)
      ROUTER_LOAD(b0, 48) ROUTER_MFMA(b1, 32)
      ROUTER_LOAD(b1, 56) ROUTER_MFMA(b2, 40)
      ROUTER_MFMA(b0, 48)
      ROUTER_MFMA(b1, 56)
      acc = (acc + a1) + (a2 + a3);
    }
    __syncthreads();
#pragma unroll
    for (int r = 0; r < 4; ++r) lgs[((lane >> 4) * 4 + r) * 64 + 16 * wave + (lane & 15)] = acc[r];
    __syncthreads();
    {
      float score4[4], gate4[4];
      int kidx4[4], pos4[4];
      bool chosen4[4];
#pragma unroll
      for (int q = 0; q < 4; ++q) {
        const int tl = wave * 4 + q;
        const float logit = lgs[tl * 64 + lane];
        const float score = sigm_f(logit);
        float sel = score + p->moe_bias[layer * 64 + lane];
        bool chosen = false;
        for (int r = 0; r < 6; ++r) {
          const float mx = wmax(sel);
          const unsigned long long bal = __ballot(sel == mx);
          const int first = __ffsll((long long)bal) - 1;
          if (lane == first) { chosen = true; sel = -INFINITY; }
        }
        const float gsum = wsum(chosen ? score : 0.f);
        const unsigned long long cb = __ballot(chosen);
        score4[q] = score; gate4[q] = score / gsum * 2.5f; chosen4[q] = chosen;
        kidx4[q] = __popcll(cb & ((1ull << lane) - 1ull));
      }
#pragma unroll
      for (int q = 0; q < 4; ++q) pos4[q] = chosen4[q] ? atomicAdd(&p->cnt[lane * CSTR], 1) : 0;
#pragma unroll
      for (int q = 0; q < 4; ++q) {
        const int t = t0 + wave * 4 + q;
        if (chosen4[q]) {
          p->ltok[(size_t)lane * NT + pos4[q]] = t;
          p->lgate[(size_t)lane * NT + pos4[q]] = gate4[q];
          p->tsl[t * 6 + kidx4[q]] = (lane << 16) | pos4[q];
        }
      }
    }
    __syncthreads();
  }
}

__device__ __forceinline__ void moe_prefix(KP p, int rows, int* s_pref, int tid) {
  if (tid < 64) s_pref[322 + tid] = p->cnt[tid * CSTR];
  __syncthreads();
  if (tid == 0) {
    int a = 0;
    for (int e = 0; e < 64; ++e) { s_pref[e] = a; a += (s_pref[322 + e] + 127) >> 7; }
    s_pref[64] = a; a += rows >> 7;
    s_pref[65] = a;
  }
  __syncthreads();
}

__device__ void ph_gemm(KP p, int kind, int layer, bool keep, char* lds) {
  const int tid = opaque_tid();
  const int j = layer >> 1;
  const bool att = !(layer & 1);
  const int rows = keep ? NT : NL;
  int* pref = (int*)(lds + META_OFF);
  int* s_idx = pref + 66;
  float* s_gate = (float*)(s_idx + 128);
  if (kind == 1 && blockIdx.x == 0 && tid < 65) p->cnt[tid * CSTR] = 0;
  int total;
  const int ntn_in = att ? 18 : 33;
  switch (kind) {
    case 0: total = (NT / 128) * ntn_in; break;
    case 1: total = (rows / 128) * 8; break;
    case 2: total = pref[65] * 4; break;
    case 3: total = pref[65] * 8; break;
    case 4: total = (NT / 128) * 3; break;
    default: total = (NT / 128) * 20; break;
  }
  const bool moe = kind == 2 || kind == 3;
  const int tsh = kind == 2 ? 2 : 3;
  int e_nx = 0, idx_nx = tid; float g_nx = 1.f;
  auto fetch_moe = [&](int tl) {
    const int mt = tl >> tsh;
    while (mt >= pref[e_nx + 1]) ++e_nx;
    idx_nx = tid; g_nx = 1.f;
    if (tid < 128) {
      const int pos = (mt - pref[e_nx]) * 128 + tid;
      if (kind == 2) {
        idx_nx = 0;
        if (e_nx < 64) { if (pos < pref[322 + e_nx]) idx_nx = p->ltok[(size_t)e_nx * NT + pos]; }
        else idx_nx = pos;
      } else if (e_nx < 64) g_nx = pos < pref[322 + e_nx] ? p->lgate[(size_t)e_nx * NT + pos] : 0.f;
    }
  };
  const int xcd = blockIdx.x & 7, lb = blockIdx.x >> 3, nbx = ((int)gridDim.x - xcd + 7) >> 3;
  const int t_beg = (int)(((long long)total * xcd) >> 3), t_end = (int)(((long long)total * (xcd + 1)) >> 3);
  if (moe && t_beg + lb < t_end) fetch_moe(t_beg + lb);
  for (int tile = t_beg + lb; tile < t_end; tile += nbx) {
    const bf16_t* Abase; const bf16_t* Bt;
    int astride, K, n0, m0 = 0, aux = 0, e = e_nx, mtile = 0;
    switch (kind) {
      case 0: { const int tm = tile / ntn_in, tn = tile % ntn_in; m0 = tm * 128; n0 = tn * 128;
                Abase = (const bf16_t*)((const unsigned char*)p->AB + (size_t)m0 * DM); astride = DM; K = 1024;
                Bt = (const bf16_t*)(att ? (const unsigned char*)p->Wt_att + (size_t)j * ATT_N * 1024
                                         : (const unsigned char*)p->Wt_rec + (size_t)j * REC_NP * 1024); } break;
      case 1: { const int tm = tile >> 3, tn = tile & 7; m0 = tm * 128; n0 = tn * 128;
                Abase = (const bf16_t*)((const unsigned char*)p->AB + (size_t)m0 * DM); astride = DM; K = 1024;
                Bt = (const bf16_t*)((const unsigned char*)p->Wt_out + (size_t)layer * 1024 * 1024); } break;
      case 2: { mtile = tile >> 2; aux = tile & 3; n0 = aux * 128;
                Abase = p->AB; astride = DM; K = 1024;
                Bt = (const bf16_t*)((const unsigned char*)p->Wt13 + (size_t)(layer * 65 + e) * 512 * 1024); } break;
      case 3: { mtile = tile >> 3; aux = tile & 7; n0 = aux * 128;
                Abase = (const bf16_t*)((const unsigned char*)p->ACT + (size_t)mtile * 128 * 256); astride = 256; K = 256;
                Bt = (const bf16_t*)((const unsigned char*)p->Wt2 + (size_t)(layer * 65 + e) * 1024 * 256); } break;
      case 4: { const int tm = tile / 3; aux = tile % 3; m0 = tm * 128; n0 = 0;
                Abase = p->Zb + (size_t)m0 * 1536 + aux * 512; astride = 1536; K = 512; Bt = p->Wl1 + (size_t)(j * 3 + aux) * 128 * 512; } break;
      default: { const int tm = tile / 20; aux = tile % 20; m0 = tm * 128; n0 = aux * 128;
                const int grp = aux < 8 ? 0 : (aux < 16 ? 1 : 2);
                Abase = p->L1 + (size_t)m0 * 384 + grp * 128; astride = 384; K = 128; Bt = p->Wl2 + (size_t)j * 2560 * 128; } break;
    }
    if (tid < 128) { s_idx[tid] = idx_nx; s_gate[tid] = g_nx; }
    __syncthreads();
    if (moe && tile + nbx < t_end) fetch_moe(tile + nbx);
    {
      f32x16 acc[2][2];
      if (kind <= 3) {
        const unsigned char* A8 = (const unsigned char*)Abase;
        gemm128_fp8(tid, [&](int r) { return A8 + (size_t)s_idx[r] * astride; }, (const unsigned char*)Bt, K, n0, lds, acc);
      } else
        gemm128_main(tid, [&](int r) { return Abase + (size_t)s_idx[r] * astride; }, Bt, K, n0, lds, acc);
      float* Ct = (float*)lds;
      acc_foreach(tid, acc, [&](int row, int col, float v) { Ct[row * 128 + col] = v; });
    }
    __syncthreads();
    {
      const float* Ct = (const float*)lds;
      int c4 = (tid & 31) * 4, r0 = tid >> 5;
      asm volatile("" : "+v"(c4), "+v"(r0));
      const int N_in = att ? ATT_N : REC_N;
      const int d5 = (aux >> 2) & 1, c05 = (aux & 3) * 128;
      switch (kind) {
        case 0: {
#pragma unroll 8
          for (int it = 0; it < 16; ++it) {
            const int row = it * 8 + r0;
            const float4 vraw = *(const float4*)(Ct + row * 128 + c4);
            const float4 v = make_float4(vraw.x * W8_INV, vraw.y * W8_INV, vraw.z * W8_INV, vraw.w * W8_INV);

            const int cn = n0 + c4;
            float4 vq = v;
            if (att && n0 >= 1536 && n0 < 2176) {
              float ss = v.x * v.x + v.y * v.y + v.z * v.z + v.w * v.w;
              ss += dppx<0xB1>(ss); ss += dppx<0x4E>(ss); ss += dppx<0x141>(ss); ss += dppx<0x140>(ss);
              const float rs = rsqrtf(ss * (1.f / 64.f) + 1e-6f);
              const float4 g = *(const float4*)(p->qk_gain + j * 128 + (n0 >= 2048 ? 64 : 0) + (cn & 63));
              vq = make_float4(v.x * rs * g.x, v.y * rs * g.y, v.z * rs * g.z, v.w * rs * g.w);
              const int t = m0 + row;
              if (t < NL) {
                const int sidx = t & 2047, pi0 = (cn & 63) >> 1;
                const int pos = pi0 < 16 ? (sidx >> 6) : (sidx & 63);
                const float4 cs = *(const float4*)(p->ROPE + (pos * 16 + (pi0 & 15)) * 2);
                vq = make_float4(vq.x * cs.x - vq.y * cs.y, vq.x * cs.y + vq.y * cs.x,
                                 vq.z * cs.z - vq.w * cs.w, vq.z * cs.w + vq.w * cs.z);
              }
            }
            if (cn < N_in) {
              u32x2 o; o.x = pk_bf16(vq.x, vq.y); o.y = pk_bf16(vq.z, vq.w);
              *(u32x2*)(p->P + (size_t)(m0 + row) * LDP + cn) = o;
            }
            if (!att && cn >= 4096 && cn < 4112) *(float4*)(p->GP + (size_t)(m0 + row) * 16 + (cn - 4096)) = v;
          }
        } break;
        case 1: {
#pragma unroll 16
          for (int it = 0; it < 16; ++it) {
            const int row = it * 8 + r0;
            const float4 v = *(const float4*)(Ct + row * 128 + c4);

            const size_t o = (size_t)(m0 + row) * DM + n0 + c4;
            const float4 xv = *(const float4*)(p->X + o);
            const float4 g = *(const float4*)(p->MOD + (layer * 9 + modrow(m0)) * 6144 + 2048 + n0 + c4);
            *(float4*)(p->Tb + o) = make_float4(DN_ALPHA * xv.x + g.x * (v.x * W8_INV), DN_ALPHA * xv.y + g.y * (v.y * W8_INV),
                                                DN_ALPHA * xv.z + g.z * (v.z * W8_INV), DN_ALPHA * xv.w + g.w * (v.w * W8_INV));
          }
        } break;
        case 2: {
#pragma unroll 8
          for (int it = 0; it < 16; ++it) {
            const int row = it * 8 + r0;
            const float4 v = *(const float4*)(Ct + row * 128 + c4);

            if (((c4 >> 5) & 1) == 0) {
              const float4 u = *(const float4*)(Ct + row * 128 + c4 + 32);
              const float a0 = v.x * W8_INV, a1 = v.y * W8_INV, a2 = v.z * W8_INV, a3 = v.w * W8_INV;
              *(unsigned*)((unsigned char*)p->ACT + ((size_t)mtile * 128 + row) * 256 + aux * 64 + (c4 >> 6) * 32 + (c4 & 31)) =
                  pk_fp8x4(silu_f(a0) * (u.x * W8_INV), silu_f(a1) * (u.y * W8_INV), silu_f(a2) * (u.z * W8_INV), silu_f(a3) * (u.w * W8_INV));
            }
          }
        } break;
        case 3: {
#pragma unroll 16
          for (int it = 0; it < 16; ++it) {
            const int row = it * 8 + r0;
            const float4 v = *(const float4*)(Ct + row * 128 + c4);

            const float g = s_gate[row] * W8_INV;
            u32x2 o; o.x = pk_bf16(g * v.x, g * v.y); o.y = pk_bf16(g * v.z, g * v.w);
            *(u32x2*)(p->OUT2 + ((size_t)mtile * 128 + row) * 1024 + n0 + c4) = o;
          }
        } break;
        case 4: {
#pragma unroll 4
          for (int it = 0; it < 16; ++it) {
            const int row = it * 8 + r0;
            const float4 v = *(const float4*)(Ct + row * 128 + c4);

            float4 o4 = v;
            if (aux == 0) o4 = make_float4(tanhf(v.x), tanhf(v.y), tanhf(v.z), tanhf(v.w));
            else if (aux == 2) o4 = make_float4(sigm_f(v.x), sigm_f(v.y), sigm_f(v.z), sigm_f(v.w));
            u32x2 o; o.x = pk_bf16(o4.x, o4.y); o.y = pk_bf16(o4.z, o4.w);
            *(u32x2*)(p->L1 + (size_t)(m0 + row) * 384 + aux * 128 + c4) = o;
          }
        } break;
        default: {
#pragma unroll 4
          for (int it = 0; it < 16; ++it) {
            const int row = it * 8 + r0;
            const float4 v = *(const float4*)(Ct + row * 128 + c4);

            bf16_t* rr = p->RW + (size_t)(m0 + row) * RWS + c05 + c4;
            const float vv[4] = {v.x, v.y, v.z, v.w};
            if (aux < 8) {
              const float4 b0 = *(const float4*)(p->rwkv_w0 + (j * 2 + d5) * 512 + c05 + c4);
              const float bb[4] = {b0.x, b0.y, b0.z, b0.w};
              float e4[4];
#pragma unroll
              for (int q = 0; q < 4; ++q) e4[q] = expf(-softplus_f(-(bb[q] + vv[q])) - 0.5f);
              u32x2 o; o.x = pk_bf16(e4[0], e4[1]); o.y = pk_bf16(e4[2], e4[3]);
              *(u32x2*)(rr + (3 + d5) * 512) = o;
            } else if (aux < 16) {
              const float4 b0 = *(const float4*)(p->rwkv_a0 + (j * 2 + d5) * 512 + c05 + c4);
              const float4 k1 = *(const float4*)(p->rwkv_kvec + (j * 2 + 1) * 512 + c05 + c4);
              const u32x2 kx2 = *(const u32x2*)(rr + 10 * 512);
              const float bb[4] = {b0.x, b0.y, b0.z, b0.w}, kk1[4] = {k1.x, k1.y, k1.z, k1.w};
              const float kx[4] = {bflo(kx2.x), bfhi(kx2.x), bflo(kx2.y), bfhi(kx2.y)};
              float av[4], ke[4];
#pragma unroll
              for (int q = 0; q < 4; ++q) { av[q] = sigm_f(bb[q] + vv[q]); ke[q] = kx[q] * (1.f + (av[q] - 1.f) * kk1[q]); }
              u32x2 o; o.x = pk_bf16(av[0], av[1]); o.y = pk_bf16(av[2], av[3]);
              *(u32x2*)(rr + (7 + d5) * 512) = o;
              o.x = pk_bf16(ke[0], ke[1]); o.y = pk_bf16(ke[2], ke[3]);
              *(u32x2*)(rr + (5 + d5) * 512) = o;
            } else {
              u32x2 o; o.x = pk_bf16(v.x, v.y); o.y = pk_bf16(v.z, v.w);
              *(u32x2*)(rr + 9 * 512) = o;
            }
          }
        } break;
      }
    }
    __syncthreads();
  }
}

__device__ void ph_final_ln(KP p, int layer, bool keep, char* lds) {
  const int tid = opaque_tid();
  const int lane = tid & 63, wave = tid >> 6;
  const int rows = keep ? NT : NL;
  int* s_base = (int*)(lds + META_OFF);
  if (tid == 0) {
    int a = 0;
#pragma unroll 1
    for (int e = 0; e < 64; ++e) { s_base[e] = a * 128; a += (p->cnt[e * CSTR] + 127) >> 7; }
    s_base[64] = a * 128;
  }
  __syncthreads();
  const float* lng = p->ln_g + (layer * 2 + 1) * 1024;
  const float* lnb = p->ln_b + (layer * 2 + 1) * 1024;
  for (int t = blockIdx.x * 4 + wave; t < rows; t += gridDim.x * 4) {
    const int mr = modrow(t);
    const float* g2 = p->MOD + (layer * 9 + mr) * 6144 + 5120;
    const bf16_t* src[7];
#pragma unroll
    for (int k = 0; k < 6; ++k) {
      const int v = p->tsl[t * 6 + k];
      src[k] = p->OUT2 + (size_t)(s_base[v >> 16] + (v & 0xffff)) * 1024;
    }
    src[6] = p->OUT2 + (size_t)(s_base[64] + t) * 1024;
    float v[16];
    float s = 0.f;
#pragma unroll
    for (int c = 0; c < 2; ++c) {
      const int n0 = c * 512 + lane * 8;
      float y[8];
#pragma unroll
      for (int q = 0; q < 8; ++q) y[q] = 0.f;
#pragma unroll
      for (int k = 0; k < 7; ++k) {
        const u32x4 u = *(const u32x4*)(src[k] + n0);
        y[0] += bflo(u.x); y[1] += bfhi(u.x); y[2] += bflo(u.y); y[3] += bfhi(u.y);
        y[4] += bflo(u.z); y[5] += bfhi(u.z); y[6] += bflo(u.w); y[7] += bfhi(u.w);
      }
      const float4 xa = *(const float4*)(p->X + (size_t)t * DM + n0), xb = *(const float4*)(p->X + (size_t)t * DM + n0 + 4);
      const float4 ga = *(const float4*)(g2 + n0), gb = *(const float4*)(g2 + n0 + 4);
      const float xx[8] = {xa.x, xa.y, xa.z, xa.w, xb.x, xb.y, xb.z, xb.w};
      const float gg[8] = {ga.x, ga.y, ga.z, ga.w, gb.x, gb.y, gb.z, gb.w};
#pragma unroll
      for (int q = 0; q < 8; ++q) { v[c * 8 + q] = DN_ALPHA * xx[q] + gg[q] * y[q]; s += v[c * 8 + q]; }
    }
    const float mean = wsum(s) * (1.f / 1024.f);
    float q2 = 0.f;
#pragma unroll
    for (int i = 0; i < 16; ++i) { const float d = v[i] - mean; q2 += d * d; }
    const float rs = rsqrtf(wsum(q2) * (1.f / 1024.f) + 1e-5f);
    const float* modn = p->MOD + ((layer + 1) * 9 + mr) * 6144;
#pragma unroll
    for (int c = 0; c < 2; ++c) {
      const int n0 = c * 512 + lane * 8;
      float xn[8];
#pragma unroll
      for (int q = 0; q < 8; ++q) xn[q] = (v[c * 8 + q] - mean) * rs * lng[n0 + q] + lnb[n0 + q];
      float* xo = (layer == 3 ? p->out : p->X) + (size_t)t * DM + n0;
      *(float4*)(xo) = make_float4(xn[0], xn[1], xn[2], xn[3]);
      *(float4*)(xo + 4) = make_float4(xn[4], xn[5], xn[6], xn[7]);
      if (layer != 3) {
        float hb[8];
#pragma unroll
        for (int q = 0; q < 8; ++q) hb[q] = xn[q] * (1.f + modn[1024 + n0 + q]) + modn[n0 + q];
        u32x2 o;
        o.x = pk_fp8x4(hb[0], hb[1], hb[2], hb[3]); o.y = pk_fp8x4(hb[4], hb[5], hb[6], hb[7]);
        *(u32x2*)((unsigned char*)p->AB + (size_t)t * DM + n0) = o;
      }
    }
  }
}

#define XB_TMO      128
#define XB_XCNT(j)  (256  + 64 * (j))
#define XB_XSUB(j)  (1280 + 64 * (j))
#define XB_XGEN(j)  (2304 + 64 * (j))
#define XB_TOP      3328
#define XB_TOPGEN   3392
#define XB_SPIN_CAP (1u << 20)
#define LAS __attribute__((address_space(3)))
__device__ __forceinline__ unsigned xb_ld(unsigned* p) { return __hip_atomic_load(p, __ATOMIC_RELAXED, __HIP_MEMORY_SCOPE_AGENT); }
__device__ __forceinline__ unsigned xb_add(unsigned* p, unsigned v) { return __hip_atomic_fetch_add(p, v, __ATOMIC_RELAXED, __HIP_MEMORY_SCOPE_AGENT); }
__device__ __forceinline__ unsigned xb_xcc_id() { return (unsigned)__builtin_amdgcn_s_getreg((3 << 11) | 20) & 0xFu; }
#define XB_SPIN(cond, bar) do { unsigned _sp = 0; while (cond) { __builtin_amdgcn_s_sleep(1); \
    if ((++_sp & 255u) == 0u) { if (xb_ld(&(bar)[XB_TMO])) break; if (_sp > XB_SPIN_CAP) { atomicAdd(&(bar)[XB_TMO], 1u); break; } } } } while (0)
struct XcdBarrier { unsigned* bar; unsigned x; volatile LAS unsigned* st; };
__device__ __forceinline__ XcdBarrier xcd_barrier_post(unsigned* bar, volatile LAS unsigned* st) {
  XcdBarrier b; b.bar = bar; b.x = xb_xcc_id(); b.st = st;
  if (threadIdx.x == 0) (void)xb_add(&bar[XB_XCNT(b.x)], 1u);
  return b;
}
__device__ __forceinline__ void xcd_barrier_complete(unsigned* bar, unsigned x, unsigned& nloc, unsigned& nx) {
  const unsigned G = gridDim.x;
  unsigned sum, cnt, mine, sp = 0u;
  for (;;) {
    sum = 0u; cnt = 0u; mine = 0u;
#pragma unroll
    for (unsigned j = 0; j < 16; ++j) { const unsigned c = xb_ld(&bar[XB_XCNT(j)]); sum += c; cnt += (c > 0u) ? 1u : 0u; mine = (j == x) ? c : mine; }
    if (sum == G) break;
    __builtin_amdgcn_s_sleep(1);
    if ((++sp & 255u) == 0u) { if (xb_ld(&bar[XB_TMO])) break; if (sp > XB_SPIN_CAP) { atomicAdd(&bar[XB_TMO], 1u); break; } }
  }
  nloc = mine > 0u ? mine : 1u; nx = cnt > 0u ? cnt : 1u;
}
__device__ __forceinline__ void xcd_barrier(const XcdBarrier& b) {
  asm volatile("s_waitcnt vmcnt(0)" ::: "memory");
  __syncthreads();
  if (threadIdx.x == 0) {
    unsigned* bar = b.bar;
    __builtin_amdgcn_s_waitcnt(0);
    unsigned nloc = b.st[0], nx = b.st[1];
    if (nloc == 0u) { xcd_barrier_complete(bar, b.x, nloc, nx); b.st[0] = nloc; b.st[1] = nx; }
    const unsigned old = xb_add(&bar[XB_XSUB(b.x)], 1u);
    const unsigned gen = old / nloc;
    if (old + 1u == (gen + 1u) * nloc) {
      __builtin_amdgcn_fence(__ATOMIC_RELEASE, "agent");
      asm volatile("s_waitcnt vmcnt(0)" ::: "memory");
      const unsigned og = xb_add(&bar[XB_TOP], 1u);
      const unsigned tg = og / nx;
      if (og + 1u == (tg + 1u) * nx) xb_add(&bar[XB_TOPGEN], 1u);
      else XB_SPIN(xb_ld(&bar[XB_TOPGEN]) == tg, bar);
      __builtin_amdgcn_fence(__ATOMIC_ACQUIRE, "agent");
      xb_add(&bar[XB_XGEN(b.x)], 1u);
      asm volatile("s_waitcnt vmcnt(0)" ::: "memory");
    } else {
      XB_SPIN(xb_ld(&bar[XB_XGEN(b.x)]) == gen, bar);
      __builtin_amdgcn_fence(__ATOMIC_ACQUIRE, "agent");
      asm volatile("s_waitcnt vmcnt(0)" ::: "memory");
    }
  }
  __syncthreads();
}

constexpr int NSLOTS = 13;
constexpr int NPHASE = 2 + 4 * NSLOTS;
__device__ __forceinline__ bool phase_is_nop(int ph) {
  if (ph < 2) return false;
  const int layer = (ph - 2) / NSLOTS, st = (ph - 2) % NSLOTS;
  if (st == 5 || st == 6) return true;
  return !(layer & 1) && (st == 1 || (st >= 3 && st <= 7));
}
__device__ void run_phase(KP p, int ph, char* sm) {
  if (ph == 0) { ph_init(p, sm); return; }
  if (ph == 1) { ph_mod_h(p, sm); return; }
  const int layer = (ph - 2) / NSLOTS, st = (ph - 2) % NSLOTS;
  const bool odd = layer & 1;
  const bool keep = layer < 3;
  int gk = -1;
  if (st == 0) gk = 0;
  else if (st == 8) gk = 1;
  else if (st == 10) gk = 2;
  else if (st == 11) gk = 3;
  else if (odd && st == 2) gk = 4;
  else if (odd && st == 3) gk = 5;
  asm volatile("" : "+s"(gk));
  if (gk >= 0) {
    if (gk == 2 || gk == 3) moe_prefix(p, keep ? NT : NL, (int*)(sm + META_OFF), opaque_tid());
    ph_gemm(p, gk, layer, keep, sm);
    if (gk == 5) { __syncthreads(); ph_mlstm_s2(p, sm); }
    return;
  }
  switch (st) {
    case 1: if (odd) { ph_rwkv_mix(p, layer); ph_mlstm_s1(p, layer, sm); } break;
    case 2: ph_attention(p, layer, keep, sm); break;
    case 4: if (odd) ph_scan_a(p, layer, sm); break;
    case 7: if (odd) ph_rec_final(p, layer, keep); break;
    case 9: ph_ln_router(p, layer, keep, sm); break;
    case 12: ph_final_ln(p, layer, keep, sm); break;
  }
}

__global__ void __launch_bounds__(NTHR, 2) mega_kernel(Params kargs) {
  extern __shared__ __attribute__((aligned(16))) char sm[];
  cg::grid_group grid = cg::this_grid();
  volatile LAS unsigned* st = (volatile LAS unsigned*)(sm + META_OFF + 4032);
  if (threadIdx.x == 0) { st[0] = 0u; st[1] = 0u; }
  __syncthreads();
  const XcdBarrier xb = xcd_barrier_post(kargs.bar, st);
  for (int ph = kargs.ph_lo; ph < kargs.ph_hi; ++ph) {
    if (phase_is_nop(ph)) continue;
    {
      KP kp = (KP)__builtin_amdgcn_kernarg_segment_ptr();
      asm volatile("" : "+s"(kp));
      run_phase(kp, ph, sm);
    }
    if (ph + 1 < kargs.ph_hi) {
      if (ph == 0) grid.sync();
      else xcd_barrier(xb);
    }
  }
}

extern "C" void kernel_launch(void* const* d_in, const int* in_sizes, int n_in, void* d_out, int out_size, void* d_ws,
                              size_t ws_size, hipStream_t stream) {
  static int grid_blocks = 0;
  if (!grid_blocks) {
    int dev = 0, cus = 0, per_cu = 0;
    (void)hipGetDevice(&dev);
    (void)hipDeviceGetAttribute(&cus, hipDeviceAttributeMultiprocessorCount, dev);
    (void)hipFuncSetAttribute((const void*)mega_kernel, hipFuncAttributeMaxDynamicSharedMemorySize, SMEM_BYTES);
    (void)hipOccupancyMaxActiveBlocksPerMultiprocessor(&per_cu, mega_kernel, NTHR, SMEM_BYTES);
    if (per_cu < 1) per_cu = 1;
    if (per_cu > 2) per_cu = 2;
    grid_blocks = cus * per_cu;
  }
  Params p;
  memset(&p, 0, sizeof(p));
  const float** pin = (const float**)&p;
  for (int i = 0; i < 35; ++i) pin[i] = (const float*)d_in[i];
  p.out = (float*)d_out;
  char* w = (char*)d_ws;
  size_t off = 0;
  auto take = [&](size_t bytes) { char* r = w + off; off += (bytes + 255) & ~(size_t)255; return r; };
  p.Wt_att = (bf16_t*)take((size_t)2 * ATT_N * 1024 * 2);
  p.Wt_rec = (bf16_t*)take((size_t)2 * REC_NP * 1024 * 2);
  p.Wt_out = (bf16_t*)take((size_t)4 * 1024 * 1024 * 2);
  p.Wt13 = (bf16_t*)take((size_t)4 * 65 * 512 * 1024);
  p.Wt2 = (bf16_t*)take((size_t)4 * 65 * 1024 * 256);
  p.Wl1 = (bf16_t*)take((size_t)2 * 3 * 128 * 512 * 2);
  p.Wl2 = (bf16_t*)take((size_t)2 * 2560 * 128 * 2);
  p.X = (float*)take((size_t)NT * DM * 4);
  p.AB = (bf16_t*)take((size_t)NT * DM * 2);
  p.MOD = (float*)take((size_t)5 * 9 * 6144 * 4);
  p.MODP = (float*)take((size_t)8 * 4 * 9 * 6144 * 4);
  p.GP = (float*)take((size_t)NT * 16 * 4);
  p.ROPE = (float*)take((size_t)64 * 16 * 2 * 4);
  p.WrT = (float*)take((size_t)4 * 64 * 1024 * 4);
  p.msc = (float*)take((size_t)3 * NMT * 4);
  p.lgate = (float*)take((size_t)64 * NT * 4);
  p.ltok = (int*)take((size_t)64 * NT * 4);
  p.tsl = (int*)take((size_t)NT * 6 * 4);
  p.cnt = (int*)take((size_t)65 * CSTR * 4);
  p.bar = (unsigned*)take((size_t)BAR_TOTAL_WORDS * 4);
  char* region = take(0);
  const size_t szP = (size_t)NT * LDP * 2, szRW = (size_t)NT * RWS * 2, szMS = (size_t)NMT * 16384 * 2,
               szMSn = (size_t)NMT * 128 * 4;
  const size_t szT = (size_t)NT * DM * 4, szOUT2 = (size_t)NSLOT * 1024 * 2;
  p.P = (bf16_t*)region;
  p.RW = (bf16_t*)(region + szP);
  p.MS = (bf16_t*)(region + szP + szRW);
  p.MSn = (float*)(region + szP + szRW + szMS);
  p.Tb = (float*)region;
  p.ACT = (bf16_t*)region;
  p.OUT2 = (bf16_t*)(region + szT);
  const size_t szZ = (size_t)NT * 2048 * 2;
  p.Zb = (bf16_t*)(region + szP + szRW + szMS + szMSn);
  p.L1 = p.Zb + (size_t)NT * 1536;
  size_t mixer = szP + szRW + szMS + szMSn + szZ, moe = szT + szOUT2;
  off += (mixer > moe ? mixer : moe);
  if (off > ws_size) { fprintf(stderr, "workspace too small: need %zu have %zu\n", off, ws_size); return; }
  p.ph_lo = 0;
  p.ph_hi = NPHASE;
  (void)hipMemsetAsync(p.bar, 0, (size_t)BAR_TOTAL_WORDS * 4, stream);
  void* args[] = {&p};
  hipError_t e = hipLaunchCooperativeKernel((void*)mega_kernel, dim3(grid_blocks), dim3(NTHR), args, SMEM_BYTES, stream);
  if (e != hipSuccess) fprintf(stderr, "cooperative launch failed: %s (grid %d)\n", hipGetErrorString(e), grid_blocks);
}
```

```cpp
#include <hip/hip_runtime.h>
#include <hip/hip_cooperative_groups.h>
#include <cstdio>
#include <cstring>
namespace cg = cooperative_groups;

constexpr int DM = 1024;
constexpr int NBATCH = 8;
constexpr int SEQ = 2048;
constexpr int CTXL = 256;
constexpr int NL = NBATCH * SEQ;
constexpr int NC = NBATCH * CTXL;
constexpr int NT = NL + NC;
constexpr int TSC = CTXL + SEQ;
constexpr int LDP = 4112;
constexpr int ATT_N = 2304;
constexpr int REC_N = 4112;
constexpr int REC_NP = 4224;
constexpr int NCHUNK = 36;
constexpr int NMT = 64 * NCHUNK;
constexpr int RWS = 5632;
constexpr int NSLOT = 137216;
constexpr float DN_ALPHA = 1.6817928305074290f;
constexpr int NTHR = 256;
constexpr int SMEM_BYTES = 65536 + 4096;
constexpr int META_OFF = 65536;
#define XCD_BAR_WORDS 3456
constexpr int CSTR = 32;
constexpr int BAR_TOTAL_WORDS = XCD_BAR_WORDS + 64;

typedef unsigned short bf16_t;
using bf16x8 = __attribute__((ext_vector_type(8))) short;
using f32x16 = __attribute__((ext_vector_type(16))) float;
using u32x4 = __attribute__((ext_vector_type(4))) unsigned;
using u32x2 = __attribute__((ext_vector_type(2))) unsigned;

struct Params {
  const float *x, *c, *ctx, *c_ctx, *ada_w, *ada_b, *ln_g, *ln_b, *mix_w_out, *att_w_in, *na_rpb, *qk_gain,
      *rec_w_in, *rwkv_mu, *rwkv_w0, *rwkv_w1, *rwkv_w2, *rwkv_a0, *rwkv_a1, *rwkv_a2, *rwkv_g1, *rwkv_g2,
      *rwkv_kvec, *rwkv_rk, *rwkv_gn, *mlstm_gate_b, *mlstm_norm, *moe_router, *moe_bias, *moe_w1, *moe_w3,
      *moe_w2, *shared_w1, *shared_w3, *shared_w2;
  float* out;
  bf16_t *Wt_att, *Wt_rec, *Wt_out, *Wt13, *Wt2, *Wl1, *Wl2;
  bf16_t *Zb, *L1;
  float *X, *MOD, *MODP, *GP, *msc, *lgate, *MSn, *Tb, *ROPE, *WrT;
  bf16_t *AB, *P, *RW, *MS, *ACT, *OUT2;
  int *cnt, *ltok, *tsl;
  unsigned* bar;
  int ph_lo, ph_hi;
};

typedef const Params __attribute__((address_space(4))) * KP;

__device__ __forceinline__ int modrow(int t) { return t < NL ? (t >> 11) : 8; }
__device__ __forceinline__ float silu_f(float x) { return x / (1.f + expf(-x)); }
__device__ __forceinline__ float sigm_f(float x) { return 1.f / (1.f + expf(-x)); }
__device__ __forceinline__ float softplus_f(float x) { return fmaxf(x, 0.f) + log1pf(expf(-fabsf(x))); }
template <int CTRL>
__device__ __forceinline__ float dppx(float x) {
  return __int_as_float(__builtin_amdgcn_update_dpp(0, __float_as_int(x), CTRL, 0xf, 0xf, true));
}
__device__ __forceinline__ float rdlane(float v, int l) {
  return __int_as_float(__builtin_amdgcn_readlane(__float_as_int(v), l));
}
__device__ __forceinline__ float wsum(float v) {
  v += dppx<0xB1>(v); v += dppx<0x4E>(v); v += dppx<0x141>(v); v += dppx<0x140>(v);
  return (rdlane(v, 0) + rdlane(v, 16)) + (rdlane(v, 32) + rdlane(v, 48));
}
__device__ __forceinline__ float wmax(float v) {
  v = fmaxf(v, dppx<0xB1>(v)); v = fmaxf(v, dppx<0x4E>(v)); v = fmaxf(v, dppx<0x141>(v)); v = fmaxf(v, dppx<0x140>(v));
  return fmaxf(fmaxf(rdlane(v, 0), rdlane(v, 16)), fmaxf(rdlane(v, 32), rdlane(v, 48)));
}
__device__ __forceinline__ int opaque_tid() {
  int t = threadIdx.x;
  asm volatile("" : "+v"(t));
  return t;
}
typedef __bf16 bf16x2_t __attribute__((ext_vector_type(2)));
typedef float f32x2_t __attribute__((ext_vector_type(2)));
__device__ __forceinline__ unsigned pk_bf16(float lo, float hi) {
  const f32x2_t v = {lo, hi};
  return __builtin_bit_cast(unsigned, __builtin_convertvector(v, bf16x2_t));
}
__device__ __forceinline__ bf16_t f2bf(float x) { return (bf16_t)(pk_bf16(x, 0.f) & 0xffffu); }
__device__ __forceinline__ float bf2f(bf16_t v) { return __uint_as_float((unsigned)v << 16); }
__device__ __forceinline__ float bflo(unsigned u) { return __uint_as_float(u << 16); }
__device__ __forceinline__ float bfhi(unsigned u) { return __uint_as_float(u & 0xffff0000u); }
__device__ __forceinline__ int scan_row(int dir, int b, int tau) {
  if (tau < CTXL) return NL + b * CTXL + (dir ? (CTXL - 1 - tau) : tau);
  int s = tau - CTXL;
  return b * SEQ + (dir ? (SEQ - 1 - s) : s);
}

template <class RowPtrA>
__device__ __forceinline__ void gemm128_main(int tid, RowPtrA rowA, const bf16_t* __restrict__ Bt, int K, int n0,
                                             char* lds, f32x16 (&acc)[2][2]) {
  const int lane = tid & 63, w = tid >> 6;
  const int wm = w >> 1, wn = w & 1, r = lane & 31, h = lane >> 5;
  const int c = tid & 7, sr = tid >> 3;
  const int lc = (c ^ ((tid >> 4) & 7)) * 8;
  const bf16_t* ap[4];
#pragma unroll
  for (int i = 0; i < 4; ++i) ap[i] = rowA(sr + 32 * i) + lc;
  const bf16_t* bp0 = Bt + (size_t)(n0 + sr) * K + lc;
  const int bstr = 32 * K;
#pragma unroll
  for (int mi = 0; mi < 2; ++mi)
#pragma unroll
    for (int ni = 0; ni < 2; ++ni)
#pragma unroll
      for (int q = 0; q < 16; ++q) acc[mi][ni][q] = 0.f;
  const int nk = K >> 6;
  auto issue = [&](int kt) {
    char* As = lds + (kt & 1) * 32768 + tid * 16;
    const int k0 = kt * 64;
#pragma unroll
    for (int i = 0; i < 4; ++i) {
      __builtin_amdgcn_global_load_lds((const unsigned*)(ap[i] + k0), (__attribute__((address_space(3))) unsigned*)(As + i * 4096), 16, 0, 0);
      __builtin_amdgcn_global_load_lds((const unsigned*)(bp0 + i * bstr + k0), (__attribute__((address_space(3))) unsigned*)(As + 16384 + i * 4096), 16, 0, 0);
    }
  };
  issue(0);
  const int sw = (r >> 1) & 7;
#pragma unroll 1
  for (int kt = 0; kt < nk; ++kt) {
    asm volatile("s_waitcnt vmcnt(0)" ::: "memory");
    __syncthreads();
    if (kt + 1 < nk) issue(kt + 1);
    const char* As = lds + (kt & 1) * 32768;
    const char* Ar = As + (wm * 64 + r) * 128;
    const char* Br = As + 16384 + (wn * 64 + r) * 128;
#pragma unroll
    for (int ks = 0; ks < 4; ++ks) {
      const int off = ((ks * 2 + h) ^ sw) * 16;
      const bf16x8 a0 = *(const bf16x8*)(Ar + off);
      const bf16x8 a1 = *(const bf16x8*)(Ar + 32 * 128 + off);
      const bf16x8 b0 = *(const bf16x8*)(Br + off);
      const bf16x8 b1 = *(const bf16x8*)(Br + 32 * 128 + off);
      acc[0][0] = __builtin_amdgcn_mfma_f32_32x32x16_bf16(a0, b0, acc[0][0], 0, 0, 0);
      acc[0][1] = __builtin_amdgcn_mfma_f32_32x32x16_bf16(a0, b1, acc[0][1], 0, 0, 0);
      acc[1][0] = __builtin_amdgcn_mfma_f32_32x32x16_bf16(a1, b0, acc[1][0], 0, 0, 0);
      acc[1][1] = __builtin_amdgcn_mfma_f32_32x32x16_bf16(a1, b1, acc[1][1], 0, 0, 0);
    }
  }
  __syncthreads();
}
using i64 = long;
template <class RowPtrA8>
__device__ __forceinline__ void gemm128_fp8(int tid, RowPtrA8 rowA, const unsigned char* __restrict__ Bt, int K, int n0,
                                            char* lds, f32x16 (&acc)[2][2]) {
  const int lane = tid & 63, w = tid >> 6;
  const int wm = w >> 1, wn = w & 1, r = lane & 31, h = lane >> 5;
  const int c = tid & 7, sr = tid >> 3;
  const int lc = (c ^ ((tid >> 4) & 7)) * 16;
  const unsigned char* ap[4];
#pragma unroll
  for (int i = 0; i < 4; ++i) ap[i] = rowA(sr + 32 * i) + lc;
  const unsigned char* bp0 = Bt + (size_t)(n0 + sr) * K + lc;
  const int bstr = 32 * K;
#pragma unroll
  for (int mi = 0; mi < 2; ++mi)
#pragma unroll
    for (int ni = 0; ni < 2; ++ni)
#pragma unroll
      for (int q = 0; q < 16; ++q) acc[mi][ni][q] = 0.f;
  const int nk = K >> 7;
  auto issue = [&](int kt) {
    char* As = lds + (kt & 1) * 32768 + tid * 16;
    const int k0 = kt * 128;
#pragma unroll
    for (int i = 0; i < 4; ++i) {
      __builtin_amdgcn_global_load_lds((const unsigned*)(ap[i] + k0), (__attribute__((address_space(3))) unsigned*)(As + i * 4096), 16, 0, 0);
      __builtin_amdgcn_global_load_lds((const unsigned*)(bp0 + i * bstr + k0), (__attribute__((address_space(3))) unsigned*)(As + 16384 + i * 4096), 16, 0, 0);
    }
  };
  issue(0);
  const int sw = (r >> 1) & 7;
#pragma unroll 1
  for (int kt = 0; kt < nk; ++kt) {
    asm volatile("s_waitcnt vmcnt(0)" ::: "memory");
    __syncthreads();
    if (kt + 1 < nk) issue(kt + 1);
    const char* As = lds + (kt & 1) * 32768;
    const char* Ar = As + (wm * 64 + r) * 128;
    const char* Br = As + 16384 + (wn * 64 + r) * 128;
#pragma unroll
    for (int q = 0; q < 4; ++q) {
      const int off = ((q * 2 + h) ^ sw) * 16;
      const u32x4 a0 = *(const u32x4*)(Ar + off);
      const u32x4 a1 = *(const u32x4*)(Ar + 32 * 128 + off);
      const u32x4 b0 = *(const u32x4*)(Br + off);
      const u32x4 b1 = *(const u32x4*)(Br + 32 * 128 + off);
      const i64 a0l = (i64)(((unsigned long long)a0.y << 32) | a0.x), a0h = (i64)(((unsigned long long)a0.w << 32) | a0.z);
      const i64 a1l = (i64)(((unsigned long long)a1.y << 32) | a1.x), a1h = (i64)(((unsigned long long)a1.w << 32) | a1.z);
      const i64 b0l = (i64)(((unsigned long long)b0.y << 32) | b0.x), b0h = (i64)(((unsigned long long)b0.w << 32) | b0.z);
      const i64 b1l = (i64)(((unsigned long long)b1.y << 32) | b1.x), b1h = (i64)(((unsigned long long)b1.w << 32) | b1.z);
      acc[0][0] = __builtin_amdgcn_mfma_f32_32x32x16_fp8_fp8(a0l, b0l, acc[0][0], 0, 0, 0);
      acc[0][1] = __builtin_amdgcn_mfma_f32_32x32x16_fp8_fp8(a0l, b1l, acc[0][1], 0, 0, 0);
      acc[1][0] = __builtin_amdgcn_mfma_f32_32x32x16_fp8_fp8(a1l, b0l, acc[1][0], 0, 0, 0);
      acc[1][1] = __builtin_amdgcn_mfma_f32_32x32x16_fp8_fp8(a1l, b1l, acc[1][1], 0, 0, 0);
      acc[0][0] = __builtin_amdgcn_mfma_f32_32x32x16_fp8_fp8(a0h, b0h, acc[0][0], 0, 0, 0);
      acc[0][1] = __builtin_amdgcn_mfma_f32_32x32x16_fp8_fp8(a0h, b1h, acc[0][1], 0, 0, 0);
      acc[1][0] = __builtin_amdgcn_mfma_f32_32x32x16_fp8_fp8(a1h, b0h, acc[1][0], 0, 0, 0);
      acc[1][1] = __builtin_amdgcn_mfma_f32_32x32x16_fp8_fp8(a1h, b1h, acc[1][1], 0, 0, 0);
    }
  }
  __syncthreads();
}
template <class F>
__device__ __forceinline__ void acc_foreach(int tid, const f32x16 (&acc)[2][2], F f) {
  const int lane = tid & 63, w = tid >> 6;
  const int wm = w >> 1, wn = w & 1, r = lane & 31, h = lane >> 5;
#pragma unroll
  for (int mi = 0; mi < 2; ++mi)
#pragma unroll
    for (int ni = 0; ni < 2; ++ni)
#pragma unroll
      for (int q = 0; q < 16; ++q) {
        const int row = wm * 64 + mi * 32 + (q & 3) + 8 * (q >> 2) + 4 * h;
        const int col = wn * 64 + ni * 32 + r;
        f(row, col, acc[mi][ni][q]);
        if ((q & 3) == 3) __builtin_amdgcn_sched_barrier(0);
      }
}

template <class RM>
__device__ __forceinline__ void tr_tile(int tid, const float* __restrict__ src, int N, int k0, int n0,
                                        bf16_t* __restrict__ dst, int K, RM rowmap, float* tile) {
  {
    const int tx = tid & 15, ty = tid >> 4;
    const int n = n0 + tx * 4;
#pragma unroll
    for (int i = 0; i < 4; ++i) {
      const int k = ty + 16 * i;
      float4 v = make_float4(0.f, 0.f, 0.f, 0.f);
      if (n < N) v = *(const float4*)(src + (size_t)(k0 + k) * N + n);
      tile[k * 65 + tx * 4 + 0] = v.x; tile[k * 65 + tx * 4 + 1] = v.y;
      tile[k * 65 + tx * 4 + 2] = v.z; tile[k * 65 + tx * 4 + 3] = v.w;
    }
  }
  __syncthreads();
  {
    const int kc = tid & 7;
#pragma unroll
    for (int i = 0; i < 2; ++i) {
      const int n = (tid >> 3) + 32 * i;
      if (n0 + n < N) {
        float v[8];
#pragma unroll
        for (int q = 0; q < 8; ++q) v[q] = tile[(kc * 8 + q) * 65 + n];
        u32x4 o;
        o.x = pk_bf16(v[0], v[1]); o.y = pk_bf16(v[2], v[3]); o.z = pk_bf16(v[4], v[5]); o.w = pk_bf16(v[6], v[7]);
        *(u32x4*)(dst + (size_t)rowmap(n0 + n) * K + k0 + kc * 8) = o;
      }
    }
  }
  __syncthreads();
}

constexpr float W8_SCALE = 32.f, W8_INV = 1.f / 32.f;
__device__ __forceinline__ unsigned pk_fp8x4(float a, float b, float c, float d) {
  int r = __builtin_amdgcn_cvt_pk_fp8_f32(a, b, 0, false);
  r = __builtin_amdgcn_cvt_pk_fp8_f32(c, d, r, true);
  return (unsigned)r;
}
__device__ __forceinline__ unsigned pk_fp8x4c(float a, float b, float c, float d) {
  constexpr float M = 448.f;
  return pk_fp8x4(fminf(fmaxf(a, -M), M), fminf(fmaxf(b, -M), M), fminf(fmaxf(c, -M), M), fminf(fmaxf(d, -M), M));
}
template <class RM>
__device__ __forceinline__ void tr_tile_fp8(int tid, const float* __restrict__ src, int N, int k0, int n0,
                                            unsigned char* __restrict__ dst, int K, RM rowmap, float* tile) {
  {
    const int tx = tid & 15, ty = tid >> 4;
    const int n = n0 + tx * 4;
#pragma unroll
    for (int i = 0; i < 4; ++i) {
      const int k = ty + 16 * i;
      float4 v = make_float4(0.f, 0.f, 0.f, 0.f);
      if (n < N) v = *(const float4*)(src + (size_t)(k0 + k) * N + n);
      tile[k * 65 + tx * 4 + 0] = v.x; tile[k * 65 + tx * 4 + 1] = v.y;
      tile[k * 65 + tx * 4 + 2] = v.z; tile[k * 65 + tx * 4 + 3] = v.w;
    }
  }
  __syncthreads();
  {
    const int kc = tid & 3, n = tid >> 2;
    float v[16];
#pragma unroll
    for (int q = 0; q < 16; ++q) v[q] = tile[(kc * 16 + q) * 65 + n] * W8_SCALE;
    u32x4 o;
    o.x = pk_fp8x4(v[0], v[1], v[2], v[3]); o.y = pk_fp8x4(v[4], v[5], v[6], v[7]);
    o.z = pk_fp8x4(v[8], v[9], v[10], v[11]); o.w = pk_fp8x4(v[12], v[13], v[14], v[15]);
    *(u32x4*)(dst + (size_t)rowmap(n0 + n) * K + k0 + kc * 16) = o;
  }
  __syncthreads();
}

constexpr int CJ0 = 1152, CJ1 = CJ0 + 2080, CJ2 = CJ1 + 1024, CJ3 = CJ2 + 33280, CJ4 = CJ3 + 16640;
__device__ void convert_job(KP p, int job, float* sm, int tid) {
  if (job < CJ0) {
    const int j = job / 576, rem = job % 576, kt = rem / 36, nt = rem % 36;
    tr_tile_fp8(tid, p->att_w_in + (size_t)j * 1024 * ATT_N, ATT_N, kt * 64, nt * 64, (unsigned char*)p->Wt_att + (size_t)j * ATT_N * 1024,
                1024, [](int n) { return n; }, sm);
  } else if (job < CJ1) {
    const int q = job - CJ0;
    const int j = q / 1040, rem = q % 1040, kt = rem / 65, nt = rem % 65;
    tr_tile_fp8(tid, p->rec_w_in + (size_t)j * 1024 * REC_N, REC_N, kt * 64, nt * 64, (unsigned char*)p->Wt_rec + (size_t)j * REC_NP * 1024,
                1024, [](int n) { return n; }, sm);
  } else if (job < CJ2) {
    const int q = job - CJ1;
    const int i = q >> 8, rem = q & 255, kt = rem >> 4, nt = rem & 15;
    tr_tile_fp8(tid, p->mix_w_out + (size_t)i * 1024 * 1024, 1024, kt * 64, nt * 64, (unsigned char*)p->Wt_out + (size_t)i * 1024 * 1024,
                1024, [](int n) { return n; }, sm);
  } else if (job < CJ3) {
    const int q = job - CJ2;
    const int le = q >> 7, rem = q & 127;
    const int which = rem >> 6, kt = (rem >> 2) & 15, nt = rem & 3;
    const int layer = le / 65, e = le % 65;
    const float* src;
    if (e < 64) src = (which ? p->moe_w3 : p->moe_w1) + (size_t)(layer * 64 + e) * 1024 * 256;
    else src = (which ? p->shared_w3 : p->shared_w1) + (size_t)layer * 1024 * 256;
    tr_tile_fp8(tid, src, 256, kt * 64, nt * 64, (unsigned char*)p->Wt13 + (size_t)le * 512 * 1024, 1024,
                [which](int n) { return 64 * (n >> 5) + which * 32 + (n & 31); }, sm);
  } else {
    const int q = job - CJ3;
    const int le = q >> 6, rem = q & 63;
    const int kt = rem >> 4, nt = rem & 15;
    const int layer = le / 65, e = le % 65;
    const float* src = e < 64 ? p->moe_w2 + (size_t)(layer * 64 + e) * 256 * 1024 : p->shared_w2 + (size_t)layer * 256 * 1024;
    tr_tile_fp8(tid, src, 1024, kt * 64, nt * 64, (unsigned char*)p->Wt2 + (size_t)le * 1024 * 256, 256, [](int n) { return n; }, sm);
  }
}
__device__ __forceinline__ int conv_stage_total(int stage) {
  return stage == 0 ? (576 + 1040 + 512 + 8320 + 4160) : (stage == 1 ? (576 + 1040 + 256 + 16640 + 8320) : (256 + 8320 + 4160));
}
__device__ __forceinline__ int conv_stage_job(int stage, int q) {
  if (stage == 0) {
    if (q < 8320) return CJ2 + q;  q -= 8320;
    if (q < 4160) return CJ3 + q;  q -= 4160;
    if (q < 576) return q;  q -= 576;
    if (q < 1040) return CJ0 + q;  q -= 1040;
    return CJ1 + q;
  } else if (stage == 1) {
    if (q < 8320) return CJ2 + 8320 + q;  q -= 8320;
    if (q < 4160) return CJ3 + 4160 + q;  q -= 4160;
    if (q < 576) return 576 + q;  q -= 576;
    if (q < 256) return CJ1 + 512 + q;  q -= 256;
    if (q < 8320) return CJ2 + 16640 + q;  q -= 8320;
    if (q < 4160) return CJ3 + 8320 + q;  q -= 4160;
    return CJ0 + 1040 + q;
  }
  if (q < 256) return CJ1 + 768 + q;  q -= 256;
  if (q < 8320) return CJ2 + 24960 + q;  q -= 8320;
  return CJ3 + 12480 + q;
}

struct CvDesc { const float* src; unsigned char* dst; int N, K, k0, n0, which; };
__device__ __forceinline__ bool conv_desc_fp8(KP p, int job, CvDesc& d) {
  if (job < CJ2) return false;
  if (job < CJ3) {
    const int q = job - CJ2;
    const int le = q >> 7, rem = q & 127;
    const int which = rem >> 6, kt = (rem >> 2) & 15, nt = rem & 3;
    const int layer = le / 65, e = le % 65;
    if (e < 64) d.src = (which ? p->moe_w3 : p->moe_w1) + (size_t)(layer * 64 + e) * 1024 * 256;
    else d.src = (which ? p->shared_w3 : p->shared_w1) + (size_t)layer * 1024 * 256;
    d.dst = (unsigned char*)p->Wt13 + (size_t)le * 512 * 1024;
    d.N = 256; d.K = 1024; d.k0 = kt * 64; d.n0 = nt * 64; d.which = which;
  } else {
    const int q = job - CJ3;
    const int le = q >> 6, rem = q & 63;
    const int kt = rem >> 4, nt = rem & 15;
    const int layer = le / 65, e = le % 65;
    d.src = e < 64 ? p->moe_w2 + (size_t)(layer * 64 + e) * 256 * 1024 : p->shared_w2 + (size_t)layer * 256 * 1024;
    d.dst = (unsigned char*)p->Wt2 + (size_t)le * 1024 * 256;
    d.N = 1024; d.K = 256; d.k0 = kt * 64; d.n0 = nt * 64; d.which = -1;
  }
  return true;
}
typedef float cvf4 __attribute__((ext_vector_type(4)));
__device__ __forceinline__ void cv_load(const CvDesc& d, int tid, cvf4& v0, cvf4& v1, cvf4& v2, cvf4& v3) {
  const int tx = tid & 15, ty = tid >> 4;
  const float* s0 = d.src + (size_t)(d.k0 + ty) * d.N + d.n0 + tx * 4;
  v0 = *(const cvf4*)(s0);
  v1 = *(const cvf4*)(s0 + (size_t)16 * d.N);
  v2 = *(const cvf4*)(s0 + (size_t)32 * d.N);
  v3 = *(const cvf4*)(s0 + (size_t)48 * d.N);
}
__device__ __forceinline__ void cv_emit(const CvDesc& d, int tid, const cvf4 v0, const cvf4 v1, const cvf4 v2, const cvf4 v3, float* tile) {
  {
    const int tx = tid & 15, ty = tid >> 4;
    float* t0 = tile + ty * 65 + tx * 4;
    t0[0] = v0.x; t0[1] = v0.y; t0[2] = v0.z; t0[3] = v0.w;
    t0[16 * 65 + 0] = v1.x; t0[16 * 65 + 1] = v1.y; t0[16 * 65 + 2] = v1.z; t0[16 * 65 + 3] = v1.w;
    t0[32 * 65 + 0] = v2.x; t0[32 * 65 + 1] = v2.y; t0[32 * 65 + 2] = v2.z; t0[32 * 65 + 3] = v2.w;
    t0[48 * 65 + 0] = v3.x; t0[48 * 65 + 1] = v3.y; t0[48 * 65 + 2] = v3.z; t0[48 * 65 + 3] = v3.w;
  }
  __syncthreads();
  {
    const int kc = tid & 3, n = tid >> 2;
    float v[16];
#pragma unroll
    for (int q = 0; q < 16; ++q) v[q] = tile[(kc * 16 + q) * 65 + n] * W8_SCALE;
    u32x4 o;
    o.x = pk_fp8x4(v[0], v[1], v[2], v[3]); o.y = pk_fp8x4(v[4], v[5], v[6], v[7]);
    o.z = pk_fp8x4(v[8], v[9], v[10], v[11]); o.w = pk_fp8x4(v[12], v[13], v[14], v[15]);
    const int nn = d.n0 + n;
    const int row = d.which >= 0 ? 64 * (nn >> 5) + d.which * 32 + (nn & 31) : nn;
    *(u32x4*)(d.dst + (size_t)row * d.K + d.k0 + kc * 16) = o;
  }
  __syncthreads();
}
__device__ __forceinline__ void convert_run(KP p, int stage, int jj, int j1, float* sm, int tid) {
  CvDesc d, dn;
  cvf4 a0, a1, a2, a3, b0, b1, b2, b3;
  bool cur = false;
#pragma unroll 1
  for (; jj < j1; ++jj) {
    const int job = conv_stage_job(stage, jj);
    if (!cur) {
      if (!conv_desc_fp8(p, job, d)) { convert_job(p, job, sm, tid); continue; }
      cv_load(d, tid, a0, a1, a2, a3);
    }
    bool nxt = false;
    if (jj + 1 < j1) {
      nxt = conv_desc_fp8(p, conv_stage_job(stage, jj + 1), dn);
      if (nxt) cv_load(dn, tid, b0, b1, b2, b3);
    }
    cv_emit(d, tid, a0, a1, a2, a3, sm);
    if (nxt) { d = dn; a0 = b0; a1 = b1; a2 = b2; a3 = b3; }
    cur = nxt;
  }
}

__device__ void ph_init(KP p, char* smc) {
  float* sm = (float*)smc;
  const int tid = opaque_tid();
  {
    const size_t n4a = (size_t)NL * DM / 4, n4b = (size_t)NC * DM / 4;
    const float4* xs = (const float4*)p->x;
    const float4* cs = (const float4*)p->ctx;
    float4* X4 = (float4*)p->X;
    for (size_t i = (size_t)blockIdx.x * NTHR + tid; i < n4a + n4b; i += (size_t)gridDim.x * NTHR)
      X4[i] = i < n4a ? xs[i] : cs[i - n4a];
  }
  for (int tile = blockIdx.x; tile < 96 * 8; tile += gridDim.x) {
    const int ct = tile >> 3, ks = tile & 7;
    for (int i = tid; i < 9 * 128; i += NTHR) {
      const int r = i >> 7, k = ks * 128 + (i & 127);
      const float v = r < 8 ? p->c[r * 1024 + k] : p->c_ctx[k];
      sm[i] = silu_f(v);
    }
    __syncthreads();
    const int col = ct * 256 + tid;
    const int layer = col / 6144, n = col % 6144;
    const float* W = p->ada_w + ((size_t)layer * 1024 + ks * 128) * 6144 + n;
    float acc[9];
#pragma unroll
    for (int r = 0; r < 9; ++r) acc[r] = 0.f;
#pragma unroll 4
    for (int k = 0; k < 128; ++k) {
      const float w = W[(size_t)k * 6144];
#pragma unroll
      for (int r = 0; r < 9; ++r) acc[r] = fmaf(sm[r * 128 + k], w, acc[r]);
    }
#pragma unroll
    for (int r = 0; r < 9; ++r) p->MODP[((size_t)(ks * 4 + layer) * 9 + r) * 6144 + n] = acc[r];
    __syncthreads();
  }
  {
    const int total = conv_stage_total(0), chunk = (total + gridDim.x - 1) / gridDim.x;
    const int lo = min((int)blockIdx.x * chunk, total), hi = min(lo + chunk, total);
    __syncthreads();
    convert_run(p, 0, lo, hi, sm, tid);
  }
  for (int i = blockIdx.x * NTHR + tid; i < 2 * 3 * 128 * 512; i += gridDim.x * NTHR) {
    const int k = i & 511, n = (i >> 9) & 127, wj = i >> 16;
    const int j = wj / 3, which = wj % 3;
    float v = 0.f;
    if (which < 2) {
      if (n < 64) v = (which ? p->rwkv_a1 : p->rwkv_w1)[((size_t)(j * 2 + (n >> 5)) * 512 + k) * 32 + (n & 31)];
    } else if (n < 96) v = p->rwkv_g1[((size_t)j * 512 + k) * 96 + n];
    p->Wl1[i] = f2bf(v);
  }
  for (int i = blockIdx.x * NTHR + tid; i < 2 * 2560 * 128; i += gridDim.x * NTHR) {
    const int k = i & 127, n = (i >> 7) % 2560, j = i / (2560 * 128);
    float v = 0.f;
    if (n < 2048) {
      const int d = (n >> 9) & 1, c = n & 511;
      if (k < 64 && (k >> 5) == d) v = (n < 1024 ? p->rwkv_w2 : p->rwkv_a2)[((size_t)(j * 2 + d) * 32 + (k & 31)) * 512 + c];
    } else if (k < 96) v = p->rwkv_g2[((size_t)j * 96 + k) * 512 + (n - 2048)];
    p->Wl2[i] = f2bf(v);
  }
  for (int i = blockIdx.x * NTHR + tid; i < 4 * 64 * 1024; i += gridDim.x * NTHR) {
    const int k = i & 1023, n = (i >> 10) & 63, l = i >> 16;
    p->WrT[i] = p->moe_router[((size_t)l * 1024 + k) * 64 + n];
  }
  for (int i = blockIdx.x * NTHR + tid; i < 64 * 16; i += gridDim.x * NTHR) {
    const int pos = i >> 4, f = i & 15;
    const float ang = (float)pos * powf(10000.f, -(float)f / 16.f);
    p->ROPE[2 * i] = cosf(ang);
    p->ROPE[2 * i + 1] = sinf(ang);
  }
}

__device__ void ph_mod_h(KP p, char* smc) {
  float* sm = (float*)smc;
  const int tid = opaque_tid();
  for (int i = blockIdx.x * NTHR + tid; i < 4 * 9 * 6144; i += gridDim.x * NTHR) {
    const int layer = i / (9 * 6144), rem = i % (9 * 6144), n = rem % 6144;
    float s = p->ada_b[layer * 6144 + n];
#pragma unroll
    for (int ks = 0; ks < 8; ++ks) s += p->MODP[(size_t)(ks * 4 + layer) * 9 * 6144 + rem];
    p->MOD[i] = s;
  }
  const int lane = tid & 63, wave = tid >> 6;
  const int per = (((NT + gridDim.x - 1) / gridDim.x) + 3) & ~3;
  const int t0 = blockIdx.x * per, t1 = min(NT, t0 + per);
  int cur = -1;
  for (int tb = t0; tb < t1; tb += 4) {
    const int mr = modrow(tb);
    if (mr != cur) {
      __syncthreads();
      for (int n = tid; n < 2048; n += NTHR) {
        float a = p->ada_b[n];
#pragma unroll
        for (int ks = 0; ks < 8; ++ks) a += p->MODP[((size_t)(ks * 4) * 9 + mr) * 6144 + n];
        sm[n] = a;
      }
      cur = mr;
      __syncthreads();
    }
    const int t = tb + wave;
    if (t < t1) {
      const float* src = t < NL ? p->x + (size_t)t * DM : p->ctx + (size_t)(t - NL) * DM;
#pragma unroll
      for (int i = 0; i < 4; ++i) {
        const int n = i * 256 + lane * 4;
        const float4 xv = *(const float4*)(src + n);
        const float4 sh = *(const float4*)(sm + n);
        const float4 sc = *(const float4*)(sm + 1024 + n);
        *(unsigned*)((unsigned char*)p->AB + (size_t)t * DM + n) =
            pk_fp8x4(xv.x * (1.f + sc.x) + sh.x, xv.y * (1.f + sc.y) + sh.y, xv.z * (1.f + sc.z) + sh.z, xv.w * (1.f + sc.w) + sh.w);
      }
    }
  }
}

typedef short v4i16_t __attribute__((ext_vector_type(4)));
using s16x4 = __attribute__((ext_vector_type(4))) short;
__device__ __forceinline__ s16x4 vtr(const char* p) {
  return __builtin_bit_cast(s16x4, __builtin_amdgcn_ds_read_tr16_b64_v4i16((__attribute__((address_space(3))) v4i16_t*)p));
}
#define MFMA32(a, b, c) __builtin_amdgcn_mfma_f32_32x32x16_bf16(a, b, c, 0, 0, 0)
__device__ void ph_attention(KP p, int layer, bool keep, char* lds) {
  const int tid = opaque_tid();
  const int lane = tid & 63, w = tid >> 6, r32 = lane & 31, hi = lane >> 5;
  const int j = layer >> 1;
  float* bias_lds = (float*)(lds + 32768 + 1024);
  const int n_gqa = 1024, n_na = 1024, n_cb = keep ? 128 : 0, n_ca = keep ? 128 : 0;
  const int total = n_gqa + n_na + n_cb + n_ca;
  constexpr float LOG2E = 1.4426950408889634f;
  constexpr float C2 = 0.125f * LOG2E;
  const int c = tid & 7, sr = tid >> 3;
  const int kso = (c ^ ((tid >> 4) & 7)) * 16;
  const int vso = (c >> 2) * 4096 + (c & 3) * 16;
  const int sw = (r32 >> 1) & 7;
  for (int item = blockIdx.x; item < total; item += gridDim.x) {
    int b, qrow0, qoff, koff, voff, ocol, lat_tiles, lat_row0;
    bool na = false;
    int r_w = 0, start_w = 0, ru0 = 0, hN = 0;
    if (item < n_gqa) {
      b = item >> 7;
      const int g = (item >> 6) & 1, tt = item & 63;
      qrow0 = b * SEQ + tt * 32; qoff = 1536 + (g * 4 + w) * 64; koff = 2048 + g * 64; voff = 2176 + g * 64;
      ocol = 512 + (g * 4 + w) * 64; lat_tiles = 32; lat_row0 = b * SEQ;
    } else if (item < n_gqa + n_na) {
      const int it = item - n_gqa;
      b = it >> 7; hN = (it >> 4) & 7;
      const int rp = it & 15;
      na = true; r_w = 2 * rp + (w >> 1);
      qrow0 = b * SEQ + r_w * 64 + (w & 1) * 32; qoff = hN * 64; koff = 512 + hN * 64; voff = 1024 + hN * 64; ocol = hN * 64;
      const int s0 = min(max(2 * rp - 4, 0), 24), s1 = min(max(2 * rp - 3, 0), 24);
      start_w = (w >> 1) ? s1 : s0; ru0 = s0; lat_tiles = (s1 != s0) ? 9 : 8; lat_row0 = b * SEQ + ru0 * 64;
    } else if (item < n_gqa + n_na + n_cb) {
      const int it = item - n_gqa - n_na;
      b = it >> 4;
      const int g = (it >> 3) & 1, tt = it & 7;
      qrow0 = NL + b * CTXL + tt * 32; qoff = 1536 + (g * 4 + w) * 64; koff = 2048 + g * 64; voff = 2176 + g * 64;
      ocol = 512 + (g * 4 + w) * 64; lat_tiles = 0; lat_row0 = 0;
    } else {
      const int it = item - n_gqa - n_na - n_cb;
      b = it >> 4;
      const int h = (it >> 1) & 7, half = it & 1;
      qrow0 = NL + b * CTXL + half * 128 + w * 32; qoff = h * 64; koff = 512 + h * 64; voff = 1024 + h * 64; ocol = h * 64;
      lat_tiles = 0; lat_row0 = 0;
    }
    const int ctx_row0 = NL + b * CTXL, ntiles = lat_tiles + 4;
    if (na)
      for (int i = tid; i < 465; i += NTHR) bias_lds[i] = p->na_rpb[(j * 8 + hN) * 465 + i] * LOG2E;
    bf16x8 qf[4];
    {
      const bf16_t* qp = p->P + (size_t)(qrow0 + r32) * LDP + qoff + hi * 8;
#pragma unroll
      for (int d0 = 0; d0 < 4; ++d0) qf[d0] = *(const bf16x8*)(qp + d0 * 16);
    }
    f32x16 o0, o1;
#pragma unroll
    for (int q = 0; q < 16; ++q) { o0[q] = 0.f; o1[q] = 0.f; }
    float m = -INFINITY, l = 0.f;
    u32x4 kr0, kr1, vr0, vr1;
    auto gload = [&](int t) {
      const int row0 = t < lat_tiles ? lat_row0 + 64 * t : ctx_row0 + 64 * (t - lat_tiles);
      const bf16_t* base = p->P + (size_t)(row0 + sr) * LDP + c * 8;
      kr0 = *(const u32x4*)(base + koff); kr1 = *(const u32x4*)(base + (size_t)32 * LDP + koff);
      vr0 = *(const u32x4*)(base + voff); vr1 = *(const u32x4*)(base + (size_t)32 * LDP + voff);
    };
    auto swrite = [&](int buf) {
      char* Kb = lds + buf * 16384;
      char* Vb = Kb + 8192;
      *(u32x4*)(Kb + sr * 128 + kso) = kr0; *(u32x4*)(Kb + (sr + 32) * 128 + kso) = kr1;
      *(u32x4*)(Vb + vso + sr * 64) = vr0; *(u32x4*)(Vb + vso + (sr + 32) * 64) = vr1;
    };
    gload(0);
    swrite(0);
    for (int t = 0; t < ntiles; ++t) {
      __syncthreads();
      if (t + 1 < ntiles) gload(t + 1);
      const bool na_tile = na && t < lat_tiles;
      const int kr = ru0 + t;
      const bool part = !na_tile || (kr >= start_w && kr < start_w + 8);
      if (part) {
        const char* Ks = lds + (t & 1) * 16384;
        const char* Vs = Ks + 8192;
        f32x16 s0, s1;
#pragma unroll
        for (int q = 0; q < 16; ++q) { s0[q] = 0.f; s1[q] = 0.f; }
#pragma unroll
        for (int d0 = 0; d0 < 4; ++d0) {
          const int off = ((2 * d0 + hi) ^ sw) * 16;
          const bf16x8 k0 = *(const bf16x8*)(Ks + r32 * 128 + off);
          const bf16x8 k1 = *(const bf16x8*)(Ks + (32 + r32) * 128 + off);
          s0 = MFMA32(k0, qf[d0], s0);
          s1 = MFMA32(k1, qf[d0], s1);
        }
        float mx = -INFINITY;
        if (na_tile) {
          const int cq = (w & 1) * 32 + r32;
          const int c0 = min(max(cq - 8, 0), 48);
          const float* brow = bias_lds + (kr - r_w + 7) * 31 + (15 - cq);
#pragma unroll
          for (int q = 0; q < 16; ++q) {
            const int kc = (q & 3) + 8 * (q >> 2) + 4 * hi;
            const float v0 = ((unsigned)(kc - c0) < 16u) ? fmaf(s0[q], C2, brow[kc]) : -INFINITY;
            const float v1 = ((unsigned)(kc + 32 - c0) < 16u) ? fmaf(s1[q], C2, brow[kc + 32]) : -INFINITY;
            s0[q] = v0; s1[q] = v1;
            mx = fmaxf(mx, fmaxf(v0, v1));
          }
        } else {
#pragma unroll
          for (int q = 0; q < 16; ++q) {
            s0[q] *= C2; s1[q] *= C2;
            mx = fmaxf(mx, fmaxf(s0[q], s1[q]));
          }
        }
        {
          auto rr = __builtin_amdgcn_permlane32_swap(__float_as_uint(mx), __float_as_uint(mx), false, false);
          mx = fmaxf(__uint_as_float(rr[0]), __uint_as_float(rr[1]));
        }
        const float mnew = fmaxf(m, mx);
        const float alpha = __builtin_amdgcn_exp2f(m - mnew);
        float ls = 0.f;
#pragma unroll
        for (int q = 0; q < 16; ++q) {
          s0[q] = __builtin_amdgcn_exp2f(s0[q] - mnew);
          s1[q] = __builtin_amdgcn_exp2f(s1[q] - mnew);
          ls += s0[q] + s1[q];
        }
        l = l * alpha + ls;
        m = mnew;
#pragma unroll
        for (int q = 0; q < 16; ++q) { o0[q] *= alpha; o1[q] *= alpha; }
        bf16x8 pf[4];
#pragma unroll
        for (int s = 0; s < 4; ++s) {
          const int u = (s & 1) * 8;
          u32x4 tpk;
          if (s < 2) {
            tpk.x = pk_bf16(s0[u + 0], s0[u + 1]); tpk.y = pk_bf16(s0[u + 2], s0[u + 3]);
            tpk.z = pk_bf16(s0[u + 4], s0[u + 5]); tpk.w = pk_bf16(s0[u + 6], s0[u + 7]);
          } else {
            tpk.x = pk_bf16(s1[u + 0], s1[u + 1]); tpk.y = pk_bf16(s1[u + 2], s1[u + 3]);
            tpk.z = pk_bf16(s1[u + 4], s1[u + 5]); tpk.w = pk_bf16(s1[u + 6], s1[u + 7]);
          }
          pf[s] = __builtin_bit_cast(bf16x8, tpk);
        }
        const char* vb = Vs + ((lane >> 4) & 1) * 32 + (lane & 3) * 8 + ((lane & 15) >> 2) * 64 + hi * 256;
#pragma unroll
        for (int s = 0; s < 4; ++s) {
          const s16x4 a00 = vtr(vb + (16 * s) * 64), a01 = vtr(vb + (16 * s + 8) * 64);
          const s16x4 a10 = vtr(vb + 4096 + (16 * s) * 64), a11 = vtr(vb + 4096 + (16 * s + 8) * 64);
          const bf16x8 A0 = __builtin_shufflevector(a00, a01, 0, 1, 2, 3, 4, 5, 6, 7);
          const bf16x8 A1 = __builtin_shufflevector(a10, a11, 0, 1, 2, 3, 4, 5, 6, 7);
          o0 = MFMA32(A0, pf[s], o0);
          o1 = MFMA32(A1, pf[s], o1);
        }
      }
      if (t + 1 < ntiles) swrite((t + 1) & 1);
    }
    __syncthreads();
    const float lt = l + __shfl_xor(l, 32);
    const float inv = 1.f / lt;
    unsigned char* op = (unsigned char*)p->AB + (size_t)(qrow0 + r32) * DM + ocol + 4 * hi;
#pragma unroll
    for (int g = 0; g < 4; ++g) {
      *(unsigned*)(op + 8 * g) = pk_fp8x4c(o0[4 * g] * inv, o0[4 * g + 1] * inv, o0[4 * g + 2] * inv, o0[4 * g + 3] * inv);
      *(unsigned*)(op + 32 + 8 * g) = pk_fp8x4c(o1[4 * g] * inv, o1[4 * g + 1] * inv, o1[4 * g + 2] * inv, o1[4 * g + 3] * inv);
    }
  }
}

__device__ void ph_rwkv_mix(KP p, int layer) {
  const int j = layer >> 1;
  const int tid = opaque_tid();
  const int lane = tid & 63, wave = tid >> 6;
  const float* mu = p->rwkv_mu + j * 6 * 512;
  const int c0 = lane * 8;
  auto unpack = [](const u32x4 u, float (&f)[8]) {
    f[0] = bflo(u.x); f[1] = bfhi(u.x); f[2] = bflo(u.y); f[3] = bfhi(u.y);
    f[4] = bflo(u.z); f[5] = bfhi(u.z); f[6] = bflo(u.w); f[7] = bfhi(u.w);
  };
  auto pack = [](const float (&f)[8]) {
    u32x4 o;
    o.x = pk_bf16(f[0], f[1]); o.y = pk_bf16(f[2], f[3]); o.z = pk_bf16(f[4], f[5]); o.w = pk_bf16(f[6], f[7]);
    return o;
  };
  for (int t = blockIdx.x * 4 + wave; t < NT; t += gridDim.x * 4) {
    bool hasp, hasn;
    if (t < NL) { int s = t & 2047; hasp = s > 0; hasn = s < SEQ - 1; }
    else { int s = (t - NL) & 255; hasp = s > 0; hasn = s < CTXL - 1; }
    const bf16_t* pt = p->P + (size_t)t * LDP + c0;
    bf16_t* rw = p->RW + (size_t)t * RWS + c0;
    bf16_t* zb = p->Zb + (size_t)t * 1536 + c0;
    const u32x4 zero = {0u, 0u, 0u, 0u};
#pragma unroll
    for (int q = 0; q < 4; ++q) {
      float cur[8], pv[8], nx[8], d[8];
      unpack(*(const u32x4*)(pt + q * 512), cur);
      unpack(hasp ? *(const u32x4*)(pt + q * 512 - LDP) : zero, pv);
      unpack(hasn ? *(const u32x4*)(pt + q * 512 + LDP) : zero, nx);
#pragma unroll
      for (int e = 0; e < 8; ++e) d[e] = 0.5f * (pv[e] + nx[e]) - cur[e];
      if (q < 3) {
        float o[8];
        const float* m = mu + q * 512 + c0;
#pragma unroll
        for (int e = 0; e < 8; ++e) o[e] = cur[e] + d[e] * m[e];
        if (q == 0) *(u32x4*)(rw) = pack(o);
        else if (q == 2) *(u32x4*)(rw + 512) = pack(o);
        else {
          *(u32x4*)(rw + 10 * 512) = pack(o);
          float kk[8], ss = 0.f;
          const float* kv0 = p->rwkv_kvec + (j * 2 + 0) * 512 + c0;
#pragma unroll
          for (int e = 0; e < 8; ++e) { kk[e] = o[e] * kv0[e]; ss += kk[e] * kk[e]; }
          ss += dppx<0xB1>(ss); ss += dppx<0x4E>(ss); ss += dppx<0x141>(ss);
          const float rn = rsqrtf(fmaxf(ss, 1e-24f));
#pragma unroll
          for (int e = 0; e < 8; ++e) kk[e] *= rn;
          *(u32x4*)(rw + 2 * 512) = pack(kk);
        }
      } else {
#pragma unroll
        for (int z = 0; z < 3; ++z) {
          float o[8];
          const float* m = mu + (3 + z) * 512 + c0;
#pragma unroll
          for (int e = 0; e < 8; ++e) o[e] = cur[e] + d[e] * m[e];
          *(u32x4*)(zb + z * 512) = pack(o);
        }
      }
    }
  }
}

constexpr int RS_STEP = 384;
constexpr int RS_TB = 16;
struct RwkvStage { u32x2 r, kk, e, ke, a, v; };
__device__ void rwkv_unit(KP p, int unit, float* sm, int tid) {
  const int ch = unit >> 1, hf = unit & 1;
  const int dir = ch >> 6, b = (ch >> 3) & 7, h = ch & 7;
  const int lane = tid & 63, w = tid >> 6, rl = lane >> 3, ks = lane & 7;
  float* ybuf = sm + 2 * RS_TB * RS_STEP;
  const int ss = tid >> 4, kq = tid & 15;
  auto gload = [&](int n, RwkvStage& g) {
    const int row = scan_row(dir, b, n * RS_TB + ss);
    const bf16_t* base = p->RW + (size_t)row * RWS + h * 64 + kq * 4;
    g.r = *(const u32x2*)(base);
    g.kk = *(const u32x2*)(base + 2 * 512);
    g.e = *(const u32x2*)(base + (3 + dir) * 512);
    g.ke = *(const u32x2*)(base + (5 + dir) * 512);
    g.a = *(const u32x2*)(base + (7 + dir) * 512);
    g.v = *(const u32x2*)(p->RW + (size_t)row * RWS + 512 + h * 64 + hf * 32 + (kq & 7) * 4);
  };
  auto swrite = [&](int buf, const RwkvStage& g) {
    float* sp = sm + (buf * RS_TB + ss) * RS_STEP;
    const float r0 = bflo(g.r.x), r1 = bfhi(g.r.x), r2 = bflo(g.r.y), r3 = bfhi(g.r.y);
    const float k0 = bflo(g.kk.x), k1 = bfhi(g.kk.x), k2 = bflo(g.kk.y), k3 = bfhi(g.kk.y);
    const float w0 = __expf(-bflo(g.e.x)), w1 = __expf(-bfhi(g.e.x)), w2 = __expf(-bflo(g.e.y)), w3 = __expf(-bfhi(g.e.y));
    const float e0 = bflo(g.ke.x), e1 = bfhi(g.ke.x), e2 = bflo(g.ke.y), e3 = bfhi(g.ke.y);
    const float a0 = k0 * bflo(g.a.x), a1 = k1 * bfhi(g.a.x), a2 = k2 * bflo(g.a.y), a3 = k3 * bfhi(g.a.y);
    *(float4*)(sp + kq * 4) = make_float4(k0, k1, k2, k3);
    *(float4*)(sp + 64 + kq * 4) = make_float4(w0 * r0, w1 * r1, w2 * r2, w3 * r3);
    *(float4*)(sp + 128 + kq * 4) = make_float4(w0, w1, w2, w3);
    *(float4*)(sp + 192 + kq * 4) = make_float4(a0, a1, a2, a3);
    *(float4*)(sp + 256 + kq * 4) = make_float4(e0, e1, e2, e3);
    if (kq < 8) *(float4*)(sp + 320 + kq * 4) = make_float4(bflo(g.v.x), bfhi(g.v.x), bflo(g.v.y), bfhi(g.v.y));
    float c1 = a0 * r0 + a1 * r1 + a2 * r2 + a3 * r3;
    float c2 = e0 * r0 + e1 * r1 + e2 * r2 + e3 * r3;
    c1 += dppx<0xB1>(c1); c2 += dppx<0xB1>(c2);
    c1 += dppx<0x4E>(c1); c2 += dppx<0x4E>(c2);
    c1 += dppx<0x141>(c1); c2 += dppx<0x141>(c2);
    c1 += dppx<0x140>(c1); c2 += dppx<0x140>(c2);
    if (kq == 0) { sp[352] = c1; sp[353] = c2; }
  };
  typedef float f2 __attribute__((ext_vector_type(2)));
  f2 S01 = {0.f, 0.f}, S23 = {0.f, 0.f}, S45 = {0.f, 0.f}, S67 = {0.f, 0.f};
  auto compute = [&](int n) {
    const float* bp = sm + (n & 1) * RS_TB * RS_STEP;
    float* yb = ybuf + (n & 1) * RS_TB * 32 + w * 8 + rl;
    struct Ops { f2 k[4], r[4], w[4], a[4], e[4]; float vv; f2 c; };
    auto ld = [&](int s, Ops& o) {
      const float* sq = bp + s * RS_STEP;
      const f2* sp = (const f2*)(sq + ks * 8);
#pragma unroll
      for (int i = 0; i < 4; ++i) { o.k[i] = sp[i]; o.r[i] = sp[32 + i]; o.w[i] = sp[64 + i]; o.a[i] = sp[96 + i]; o.e[i] = sp[128 + i]; }
      o.vv = sq[320 + w * 8 + rl]; o.c = *(const f2*)(sq + 352);
    };
    auto step = [&](const Ops& o) -> float {
      f2 sa2 = S01 * o.k[0];
      f2 y2 = S01 * o.r[0];
      sa2 = __builtin_elementwise_fma(S23, o.k[1], sa2); y2 = __builtin_elementwise_fma(S23, o.r[1], y2);
      sa2 = __builtin_elementwise_fma(S45, o.k[2], sa2); y2 = __builtin_elementwise_fma(S45, o.r[2], y2);
      sa2 = __builtin_elementwise_fma(S67, o.k[3], sa2); y2 = __builtin_elementwise_fma(S67, o.r[3], y2);
      float sa = sa2.x + sa2.y, y0 = y2.x + y2.y;
      sa += dppx<0xB1>(sa); y0 += dppx<0xB1>(y0);
      sa += dppx<0x4E>(sa); y0 += dppx<0x4E>(y0);
      sa += dppx<0x141>(sa); y0 += dppx<0x141>(y0);
      sa = -sa;
      const f2 sav = {sa, sa}, vvv = {o.vv, o.vv};
      S01 = __builtin_elementwise_fma(vvv, o.e[0], __builtin_elementwise_fma(sav, o.a[0], S01 * o.w[0]));
      S23 = __builtin_elementwise_fma(vvv, o.e[1], __builtin_elementwise_fma(sav, o.a[1], S23 * o.w[1]));
      S45 = __builtin_elementwise_fma(vvv, o.e[2], __builtin_elementwise_fma(sav, o.a[2], S45 * o.w[2]));
      S67 = __builtin_elementwise_fma(vvv, o.e[3], __builtin_elementwise_fma(sav, o.a[3], S67 * o.w[3]));
      return fmaf(o.vv, o.c.y, fmaf(sa, o.c.x, y0));
    };
    Ops oa, ob;
    ld(0, oa);
#pragma unroll 1
    for (int s = 0; s < RS_TB; s += 2) {
      __builtin_amdgcn_sched_barrier(0);
      ld(s + 1, ob);
      __builtin_amdgcn_sched_barrier(0);
      float y0 = step(oa);
      asm volatile("" : "+v"(y0));
      __builtin_amdgcn_sched_barrier(0);
      ld(s + 2, oa);
      __builtin_amdgcn_sched_barrier(0);
      float y1 = step(ob);
      asm volatile("" : "+v"(y1));
      __builtin_amdgcn_sched_barrier(0);
      if (ks == 0) { yb[s * 32] = y0; yb[(s + 1) * 32] = y1; }
    }
  };
  auto yout = [&](int n) {
    const int row = scan_row(dir, b, n * RS_TB + ss);
    const float* ys = ybuf + (n & 1) * RS_TB * 32 + ss * 32 + kq * 2;
    *(unsigned*)(p->P + (size_t)row * LDP + dir * 512 + h * 64 + hf * 32 + kq * 2) = pk_bf16(ys[0], ys[1]);
  };
  constexpr int NB = TSC / RS_TB;
  RwkvStage gA, gB;
  gload(0, gA);
  gload(1, gB);
  swrite(0, gA);
  gload(2, gA);
  __syncthreads();
  for (int n = 0; n < NB; n += 2) {
    compute(n);
    swrite(1, gB);
    if (n + 3 < NB) gload(n + 3, gB);
    __syncthreads();
    yout(n);
    compute(n + 1);
    if (n + 2 < NB) swrite(0, gA);
    if (n + 4 < NB) gload(n + 4, gA);
    __syncthreads();
    yout(n + 1);
  }
  __syncthreads();
}

__device__ void mlstm_s1(KP p, int layer, int tile, char* lds, int tid) {
  const int j = layer >> 1;
  const int ch = tile / NCHUNK, c = tile % NCHUNK;
  const int dir = ch >> 5, b = (ch >> 2) & 7, h = ch & 3;
  float* s_ws = (float*)(lds + META_OFF);
  int* s_row = (int*)(s_ws + 64);
  char* kimg = lds;
  char* vimg = lds + 16384;
  if (tid < 64) {
    const int row = scan_row(dir, b, c * 64 + tid);
    s_row[tid] = row;
    const float* g = p->GP + (size_t)row * 16;
    const float gi = g[(dir * 2) * 4 + h] + p->mlstm_gate_b[j * 16 + (dir * 2) * 4 + h];
    const float gf = g[(dir * 2 + 1) * 4 + h] + p->mlstm_gate_b[j * 16 + (dir * 2 + 1) * 4 + h];
    float bc = -softplus_f(-gf);
#pragma unroll
    for (int o = 1; o < 64; o <<= 1) {
      float tmp = __shfl_up(bc, o);
      if (tid >= o) bc += tmp;
    }
    const float bend = __shfl(bc, 63);
    const float ds = bend - bc + gi;
    const float mloc = wmax(ds);
    s_ws[tid] = expf(ds - mloc);
    if (tid == 0) { p->msc[tile] = mloc; p->msc[NMT + tile] = bend; }
  }
  __syncthreads();
  {
    const int c8 = tid & 15;
    const int ioff = (c8 >> 2) * 4096 + (c8 & 3) * 16;
#pragma unroll
    for (int i = 0; i < 4; ++i) {
      const int sidx = (tid >> 4) + 16 * i;
      const bf16_t* src = p->P + (size_t)s_row[sidx] * LDP + h * 128 + c8 * 8;
      const u32x4 kv = *(const u32x4*)(src + 2560);
      u32x4 vv = *(const u32x4*)(src + 3072);
      const float wsv = s_ws[sidx];
      vv.x = pk_bf16(bflo(vv.x) * wsv, bfhi(vv.x) * wsv); vv.y = pk_bf16(bflo(vv.y) * wsv, bfhi(vv.y) * wsv);
      vv.z = pk_bf16(bflo(vv.z) * wsv, bfhi(vv.z) * wsv); vv.w = pk_bf16(bflo(vv.w) * wsv, bfhi(vv.w) * wsv);
      *(u32x4*)(kimg + ioff + sidx * 64) = kv;
      *(u32x4*)(vimg + ioff + sidx * 64) = vv;
    }
  }
  __syncthreads();
  const int lane = tid & 63, w = tid >> 6, wm = w >> 1, wn = w & 1, r32 = lane & 31, hi = lane >> 5;
  f32x16 acc[2][2];
#pragma unroll
  for (int mi = 0; mi < 2; ++mi)
#pragma unroll
    for (int ni = 0; ni < 2; ++ni)
#pragma unroll
      for (int q = 0; q < 16; ++q) acc[mi][ni][q] = 0.f;
  const int toff = ((lane >> 4) & 1) * 32 + (lane & 3) * 8 + ((lane & 15) >> 2) * 64 + hi * 256;
#pragma unroll
  for (int ks = 0; ks < 4; ++ks) {
    bf16x8 af[2], bfr[2];
#pragma unroll
    for (int i = 0; i < 2; ++i) {
      const char* ka = kimg + (wm * 2 + i) * 4096 + toff + (16 * ks) * 64;
      const char* va = vimg + (wn * 2 + i) * 4096 + toff + (16 * ks) * 64;
      af[i] = __builtin_shufflevector(vtr(ka), vtr(ka + 8 * 64), 0, 1, 2, 3, 4, 5, 6, 7);
      bfr[i] = __builtin_shufflevector(vtr(va), vtr(va + 8 * 64), 0, 1, 2, 3, 4, 5, 6, 7);
    }
    acc[0][0] = MFMA32(af[0], bfr[0], acc[0][0]);
    acc[0][1] = MFMA32(af[0], bfr[1], acc[0][1]);
    acc[1][0] = MFMA32(af[1], bfr[0], acc[1][0]);
    acc[1][1] = MFMA32(af[1], bfr[1], acc[1][1]);
  }
  bf16_t* ust = (bf16_t*)(lds + 32768);
#pragma unroll
  for (int mi = 0; mi < 2; ++mi)
#pragma unroll
    for (int ni = 0; ni < 2; ++ni)
#pragma unroll
      for (int q = 0; q < 16; ++q) {
        const int d = wm * 64 + mi * 32 + (q & 3) + 8 * (q >> 2) + 4 * hi;
        ust[d * 128 + wn * 64 + ni * 32 + r32] = f2bf(acc[mi][ni][q]);
        if ((q & 3) == 3) __builtin_amdgcn_sched_barrier(0);
      }
  __syncthreads();
  {
    const u32x4* us4 = (const u32x4*)ust;
    u32x4* U4 = (u32x4*)(p->MS + (size_t)tile * 16384);
#pragma unroll
    for (int i = 0; i < 8; ++i) U4[tid + 256 * i] = us4[tid + 256 * i];
  }
  if (tid < 128) {
    const char* kc = kimg + (tid >> 5) * 4096 + (tid & 31) * 2;
    float a = 0.f;
#pragma unroll 8
    for (int sidx = 0; sidx < 64; ++sidx) a = fmaf(s_ws[sidx], bf2f(*(const bf16_t*)(kc + sidx * 64)), a);
    p->MSn[tile * 128 + tid] = a;
  }
}

__device__ void mlstm_s3(KP p, int layer, int tile, char* lds, int tid);
__device__ void ph_scan_a(KP p, int layer, char* smc) {
  float* sm = (float*)smc;
  const int tid = opaque_tid();
  __builtin_amdgcn_s_setprio(3);
  for (int u = blockIdx.x; u < 256; u += gridDim.x) rwkv_unit(p, u, sm, tid);
  __builtin_amdgcn_s_setprio(0);
  {
    const int stage = layer == 1 ? 1 : 2;
    const int nconv = conv_stage_total(stage);
    const int total = NMT + (nconv + 7) / 8;
    int* qc = (int*)(p->bar + XCD_BAR_WORDS + 16 * stage);
    int* s_q = (int*)(smc + META_OFF + 3968);
    int jj = 0, j1 = 0;
#pragma unroll 1
    for (;;) {
      if (jj >= j1) {
        __syncthreads();
        if (tid == 0) *s_q = atomicAdd(qc, 1);
        __syncthreads();
        const int q = *s_q;
        if (q >= total) break;
        if (q < NMT) { mlstm_s3(p, layer, q, smc, tid); continue; }
        jj = (q - NMT) * 8; j1 = min(jj + 8, nconv);
      }
      convert_run(p, stage, jj, j1, sm, tid);
      jj = j1;
    }
  }
}

__device__ void ph_mlstm_s2(KP p, char* smc) {
  float* sw = (float*)smc;
  const int tid = opaque_tid();
  const int nitems = 64 * 33;
  for (int item = blockIdx.x; item < nitems; item += gridDim.x) {
    const int ch = item / 33, seg = item % 33;
    __syncthreads();
    if (tid < 2 * NCHUNK) sw[72 + tid] = p->msc[(tid < NCHUNK ? 0 : NMT - NCHUNK) + ch * NCHUNK + tid];
    __syncthreads();
    if (tid == 0) {
      float m = 0.f;
      for (int c = 0; c < NCHUNK; ++c) {
        const int tile = ch * NCHUNK + c;
        const float mloc = sw[72 + c], bend = sw[72 + NCHUNK + c];
        const float mn = fmaxf(bend + m, mloc);
        sw[c] = expf(bend + m - mn);
        sw[36 + c] = expf(mloc - mn);
        if (seg == 0) p->msc[2 * NMT + tile] = m;
        m = mn;
      }
    }
    __syncthreads();
    if (seg < 32) {
      unsigned* base = (unsigned*)(p->MS + (size_t)ch * NCHUNK * 16384) + seg * 256 + tid;
      unsigned v[NCHUNK];
#pragma unroll
      for (int c = 0; c < NCHUNK; ++c) v[c] = base[(size_t)c * 8192];
      float C0 = 0.f, C1 = 0.f;
#pragma unroll
      for (int c = 0; c < NCHUNK; ++c) {
        const float t0 = bflo(v[c]), t1 = bfhi(v[c]);
        v[c] = pk_bf16(C0, C1);
        C0 = sw[c] * C0 + sw[36 + c] * t0;
        C1 = sw[c] * C1 + sw[36 + c] * t1;
      }
#pragma unroll
      for (int c = 0; c < NCHUNK; ++c) base[(size_t)c * 8192] = v[c];
    } else if (tid < 128) {
      float* base = p->MSn + (size_t)ch * NCHUNK * 128 + tid;
      float v[NCHUNK];
#pragma unroll
      for (int c = 0; c < NCHUNK; ++c) v[c] = base[c * 128];
      float C = 0.f;
#pragma unroll
      for (int c = 0; c < NCHUNK; ++c) {
        const float t0 = v[c];
        v[c] = C;
        C = sw[c] * C + sw[36 + c] * t0;
      }
#pragma unroll
      for (int c = 0; c < NCHUNK; ++c) base[c * 128] = v[c];
    }
  }
}

__device__ void mlstm_s3(KP p, int layer, int tile, char* lds, int tid) {
  const int j = layer >> 1;
  const int ch = tile / NCHUNK, c = tile % NCHUNK;
  const int dir = ch >> 5, b = (ch >> 2) & 7, h = ch & 3;
  float* s_b = (float*)(lds + META_OFF);
  float* s_ig = s_b + 64;
  float* s_mt = s_b + 128;
  float* s_wi = s_b + 192;
  int* s_row = (int*)(s_b + 256);
  float* s_n = s_b + 320;
  float* s_c = s_b + 448;
  char* kimg = lds;
  char* vimg = lds + 16384;
  char* cimg = lds + 32768;
  const float mprev = p->msc[2 * NMT + tile];
  const float qscale = 0.08838834764831845f;
  const int lane = tid & 63, w = tid >> 6, wt = w >> 1, wv = w & 1, r32 = lane & 31, hi = lane >> 5;
  const int t = wt * 32 + r32;
  const int rowq = scan_row(dir, b, c * 64 + t);
  const int c8 = tid & 15;
  u32x4 kr[4], vr[4], cr[8];
#pragma unroll
  for (int i = 0; i < 4; ++i) {
    const int sidx = (tid >> 4) + 16 * i;
    const bf16_t* src = p->P + (size_t)scan_row(dir, b, c * 64 + sidx) * LDP + h * 128 + c8 * 8;
    kr[i] = *(const u32x4*)(src + 2560);
    vr[i] = *(const u32x4*)(src + 3072);
  }
  {
    const bf16_t* Cp = p->MS + (size_t)tile * 16384;
#pragma unroll
    for (int i = 0; i < 8; ++i) cr[i] = *(const u32x4*)(Cp + ((tid >> 4) + 16 * i) * 128 + c8 * 8);
  }
  bf16x8 qf[8];
  {
    const bf16_t* qp = p->P + (size_t)rowq * LDP + 2048 + h * 128 + hi * 8;
#pragma unroll
    for (int d0 = 0; d0 < 8; ++d0) qf[d0] = *(const bf16x8*)(qp + d0 * 16);
  }
  if (tid < 64) {
    const int row = scan_row(dir, b, c * 64 + tid);
    s_row[tid] = row;
    const float* g = p->GP + (size_t)row * 16;
    const float gi = g[(dir * 2) * 4 + h] + p->mlstm_gate_b[j * 16 + (dir * 2) * 4 + h];
    const float gf = g[(dir * 2 + 1) * 4 + h] + p->mlstm_gate_b[j * 16 + (dir * 2 + 1) * 4 + h];
    float bc = -softplus_f(-gf);
#pragma unroll
    for (int o = 1; o < 64; o <<= 1) {
      float tmp = __shfl_up(bc, o);
      if (tid >= o) bc += tmp;
    }
    float pm = gi - bc;
#pragma unroll
    for (int o = 1; o < 64; o <<= 1) {
      float tmp = __shfl_up(pm, o);
      if (tid >= o) pm = fmaxf(pm, tmp);
    }
    const float mt = bc + fmaxf(mprev, pm);
    s_b[tid] = bc;
    s_ig[tid] = gi;
    s_mt[tid] = mt;
    s_wi[tid] = expf(bc + mprev - mt);
    s_c[tid] = (gi - bc) * 1.4426950408889634f;
  } else if (tid < 192) s_n[tid - 64] = p->MSn[tile * 128 + (tid - 64)];
  {
    const int ioff = (c8 >> 2) * 4096 + (c8 & 3) * 16;
#pragma unroll
    for (int i = 0; i < 4; ++i) {
      const int sidx = (tid >> 4) + 16 * i;
      *(u32x4*)(kimg + sidx * 256 + ((c8 ^ (sidx & 15)) * 16)) = kr[i];
      *(u32x4*)(vimg + ioff + sidx * 64) = vr[i];
    }
    const int coff = (c8 >> 2) * 8192 + (c8 & 3) * 16;
#pragma unroll
    for (int i = 0; i < 8; ++i) *(u32x4*)(cimg + coff + ((tid >> 4) + 16 * i) * 64) = cr[i];
  }
  __syncthreads();
  const int toff = ((lane >> 4) & 1) * 32 + (lane & 3) * 8 + ((lane & 15) >> 2) * 64;
  constexpr float LOG2E_ = 1.4426950408889634f;
  float qn = 0.f;
#pragma unroll
  for (int d0 = 0; d0 < 8; ++d0) {
    const u32x4 qq = __builtin_bit_cast(u32x4, qf[d0]);
    const float* np = s_n + d0 * 16 + hi * 8;
    qn = fmaf(bflo(qq.x), np[0], qn); qn = fmaf(bfhi(qq.x), np[1], qn);
    qn = fmaf(bflo(qq.y), np[2], qn); qn = fmaf(bfhi(qq.y), np[3], qn);
    qn = fmaf(bflo(qq.z), np[4], qn); qn = fmaf(bfhi(qq.z), np[5], qn);
    qn = fmaf(bflo(qq.w), np[6], qn); qn = fmaf(bfhi(qq.w), np[7], qn);
  }
  qn += __shfl_xor(qn, 32);
  const float mtt = s_mt[t], wi = s_wi[t];
  const float ct = (s_b[t] - mtt) * LOG2E_;
  const float wq = wi * qscale;
  bf16x8 pf[4];
  float den = 0.f;
  {
    f32x16 sa0, sa1;
#pragma unroll
    for (int q = 0; q < 16; ++q) { sa0[q] = 0.f; sa1[q] = 0.f; }
#pragma unroll
    for (int d0 = 0; d0 < 8; ++d0) {
      const int chn = 2 * d0 + hi;
      const bf16x8 k0 = *(const bf16x8*)(kimg + r32 * 256 + ((chn ^ (r32 & 15)) * 16));
      sa0 = MFMA32(k0, qf[d0], sa0);
      if (wt) {
        const bf16x8 k1 = *(const bf16x8*)(kimg + (32 + r32) * 256 + ((chn ^ (r32 & 15)) * 16));
        sa1 = MFMA32(k1, qf[d0], sa1);
      }
      __builtin_amdgcn_sched_barrier(0);
    }
#pragma unroll
    for (int g = 0; g < 4; ++g) {
      const int sb0 = 8 * g + 4 * hi;
      const float4 c0v = *(const float4*)(s_c + sb0);
      const float4 c1v = *(const float4*)(s_c + sb0 + 32);
      const float cc0[4] = {c0v.x, c0v.y, c0v.z, c0v.w}, cc1[4] = {c1v.x, c1v.y, c1v.z, c1v.w};
#pragma unroll
      for (int e = 0; e < 4; ++e) {
        const int q = 4 * g + e;
        const float v0 = (sb0 + e <= t) ? sa0[q] * qscale * __builtin_amdgcn_exp2f(ct + cc0[e]) : 0.f;
        sa0[q] = v0; den += v0;
        const float v1 = (wt && sb0 + 32 + e <= t) ? sa1[q] * qscale * __builtin_amdgcn_exp2f(ct + cc1[e]) : 0.f;
        sa1[q] = v1; den += v1;
      }
      __builtin_amdgcn_sched_barrier(0);
    }
#pragma unroll
    for (int sx = 0; sx < 4; ++sx) {
      const int u = (sx & 1) * 8;
      u32x4 tpk;
      if (sx < 2) {
        tpk.x = pk_bf16(sa0[u + 0], sa0[u + 1]); tpk.y = pk_bf16(sa0[u + 2], sa0[u + 3]);
        tpk.z = pk_bf16(sa0[u + 4], sa0[u + 5]); tpk.w = pk_bf16(sa0[u + 6], sa0[u + 7]);
      } else {
        tpk.x = pk_bf16(sa1[u + 0], sa1[u + 1]); tpk.y = pk_bf16(sa1[u + 2], sa1[u + 3]);
        tpk.z = pk_bf16(sa1[u + 4], sa1[u + 5]); tpk.w = pk_bf16(sa1[u + 6], sa1[u + 7]);
      }
      pf[sx] = __builtin_bit_cast(bf16x8, tpk);
    }
  }
  den += __shfl_xor(den, 32);
  const float dtot = den + wq * qn;
  const float inv = 1.f / fmaxf(fabsf(dtot), expf(-mtt));
  bf16_t* op = p->P + (size_t)rowq * LDP + 1024 + dir * 512 + h * 128 + wv * 64 + 4 * hi;
#pragma unroll 1
  for (int vp = 0; vp < 2; ++vp) {
    f32x16 o0;
#pragma unroll
    for (int q = 0; q < 16; ++q) o0[q] = 0.f;
    const char* cb = cimg + (wv * 2 + vp) * 8192 + toff + hi * 512;
#pragma unroll
    for (int d0 = 0; d0 < 8; ++d0) {
      const bf16x8 A0 = __builtin_shufflevector(vtr(cb + (16 * d0) * 64), vtr(cb + (16 * d0 + 4) * 64), 0, 1, 2, 3, 4, 5, 6, 7);
      o0 = MFMA32(A0, qf[d0], o0);
    }
#pragma unroll
    for (int q = 0; q < 16; ++q) o0[q] *= wq;
    const char* vb = vimg + (wv * 2 + vp) * 4096 + toff + hi * 256;
#pragma unroll
    for (int sx = 0; sx < 4; ++sx) {
      if (sx < 2 || wt) {
        const bf16x8 A0 = __builtin_shufflevector(vtr(vb + (16 * sx) * 64), vtr(vb + (16 * sx + 8) * 64), 0, 1, 2, 3, 4, 5, 6, 7);
        o0 = MFMA32(A0, pf[sx], o0);
      }
    }
#pragma unroll
    for (int g = 0; g < 4; ++g) {
      u32x2 v0;
      v0.x = pk_bf16(o0[4 * g] * inv, o0[4 * g + 1] * inv); v0.y = pk_bf16(o0[4 * g + 2] * inv, o0[4 * g + 3] * inv);
      *(u32x2*)(op + vp * 32 + 8 * g) = v0;
    }
  }
}

__device__ void ph_mlstm_s1(KP p, int layer, char* smc) {
  const int tid = opaque_tid();
  __syncthreads();
  for (int tile = blockIdx.x; tile < NMT; tile += gridDim.x) { mlstm_s1(p, layer, tile, smc, tid); __syncthreads(); }
}

__device__ void ph_rec_final(KP p, int layer, bool keep) {
  const int tid = opaque_tid();
  const int j = layer >> 1;
  const int lane = tid & 63, wave = tid >> 6;
  const int rows = keep ? NT : NL;
  const int c0 = lane * 8;
  auto unpack = [](const u32x4 u, float (&f)[8]) {
    f[0] = bflo(u.x); f[1] = bfhi(u.x); f[2] = bflo(u.y); f[3] = bfhi(u.y);
    f[4] = bflo(u.z); f[5] = bfhi(u.z); f[6] = bflo(u.w); f[7] = bfhi(u.w);
  };
  for (int t = blockIdx.x * 4 + wave; t < rows; t += gridDim.x * 4) {
    const bf16_t* rw = p->RW + (size_t)t * RWS + c0;
    const bf16_t* pt = p->P + (size_t)t * LDP + c0;
    unsigned char* mo = (unsigned char*)p->AB + (size_t)t * DM + c0;
    {
      float yf[8], yb[8], r[8], v[8], k0[8], k1[8], g[8], y[8], o[8];
      unpack(*(const u32x4*)(pt), yf); unpack(*(const u32x4*)(pt + 512), yb);
      unpack(*(const u32x4*)(rw), r); unpack(*(const u32x4*)(rw + 512), v);
      unpack(*(const u32x4*)(rw + 5 * 512), k0); unpack(*(const u32x4*)(rw + 6 * 512), k1);
      unpack(*(const u32x4*)(rw + 9 * 512), g);
      float s1 = 0.f, bs = 0.f;
      const float* rk = p->rwkv_rk + j * 512 + c0;
#pragma unroll
      for (int e = 0; e < 8; ++e) { y[e] = yf[e] + yb[e]; s1 += y[e]; bs += r[e] * rk[e] * (k0[e] + k1[e]); }
      s1 += dppx<0xB1>(s1); s1 += dppx<0x4E>(s1); s1 += dppx<0x141>(s1);
      bs += dppx<0xB1>(bs); bs += dppx<0x4E>(bs); bs += dppx<0x141>(bs);
      const float mu = s1 * (1.f / 64.f);
      float s2 = 0.f;
#pragma unroll
      for (int e = 0; e < 8; ++e) { const float d = y[e] - mu; s2 += d * d; }
      s2 += dppx<0xB1>(s2); s2 += dppx<0x4E>(s2); s2 += dppx<0x141>(s2);
      const float rs = rsqrtf(s2 * (1.f / 64.f) + 64e-5f);
      const float* gn0 = p->rwkv_gn + (j * 2 + 0) * 512 + c0;
      const float* gn1 = p->rwkv_gn + (j * 2 + 1) * 512 + c0;
#pragma unroll
      for (int e = 0; e < 8; ++e) o[e] = ((y[e] - mu) * rs * gn0[e] + gn1[e] + bs * v[e]) * g[e];
      u32x2 ov;
      ov.x = pk_fp8x4c(o[0], o[1], o[2], o[3]); ov.y = pk_fp8x4c(o[4], o[5], o[6], o[7]);
      *(u32x2*)(mo) = ov;
    }
    {
      float hf[8], hb[8], og[8], hsum[8], o[8];
      unpack(*(const u32x4*)(pt + 1024), hf); unpack(*(const u32x4*)(pt + 1536), hb);
      unpack(*(const u32x4*)(pt + 3584), og);
      float ss = 0.f;
#pragma unroll
      for (int e = 0; e < 8; ++e) { hsum[e] = hf[e] + hb[e]; ss += hsum[e] * hsum[e]; }
      ss += dppx<0xB1>(ss); ss += dppx<0x4E>(ss); ss += dppx<0x141>(ss); ss += dppx<0x140>(ss);
      const float rs = rsqrtf(ss * (1.f / 128.f) + 1e-6f);
      const float* ng = p->mlstm_norm + j * 512 + c0;
#pragma unroll
      for (int e = 0; e < 8; ++e) o[e] = hsum[e] * rs * ng[e] * sigm_f(og[e]);
      u32x2 ov;
      ov.x = pk_fp8x4c(o[0], o[1], o[2], o[3]); ov.y = pk_fp8x4c(o[4], o[5], o[6], o[7]);
      *(u32x2*)(mo + 512) = ov;
    }
  }
}

using f32x4v = __attribute__((ext_vector_type(4))) float;
__device__ void ph_ln_router(KP p, int layer, bool keep, char* smc) {
  float* h2s = (float*)smc;
  float* lgs = (float*)smc;
  const int tid = opaque_tid();
  const int lane = tid & 63, wave = tid >> 6;
  const int rows = keep ? NT : NL;
  const float* lng = p->ln_g + (layer * 2 + 0) * 1024;
  const float* lnb = p->ln_b + (layer * 2 + 0) * 1024;
  for (int tile = blockIdx.x; tile < rows / 16; tile += gridDim.x) {
    const int t0 = tile * 16;
    const float* mod = p->MOD + (layer * 9 + modrow(t0)) * 6144;
    const float* brow = p->WrT + ((size_t)layer * 64 + 16 * wave + (lane & 15)) * 1024 + 4 * (lane >> 4);
    f32x4v b0[8], b1[8], b2[8];
#pragma unroll
    for (int q = 0; q < 8; ++q) { b0[q] = *(const f32x4v*)(brow + 16 * q); b1[q] = *(const f32x4v*)(brow + 16 * (8 + q)); }
    __builtin_amdgcn_sched_barrier(0);
    {
      float4 v[4][4];
      float s4[4];
#pragma unroll
      for (int q = 0; q < 4; ++q) {
        const int t = t0 + wave * 4 + q;
        s4[q] = 0.f;
#pragma unroll
        for (int i = 0; i < 4; ++i) v[q][i] = *(const float4*)(p->Tb + (size_t)t * DM + i * 256 + lane * 4);
      }
#pragma unroll
      for (int q = 0; q < 4; ++q)
#pragma unroll
        for (int i = 0; i < 4; ++i) s4[q] += (v[q][i].x + v[q][i].y) + (v[q][i].z + v[q][i].w);
      float mean4[4], rs4[4];
#pragma unroll
      for (int q = 0; q < 4; ++q) mean4[q] = wsum(s4[q]) * (1.f / 1024.f);
#pragma unroll
      for (int q = 0; q < 4; ++q) {
        float qq = 0.f;
#pragma unroll
        for (int i = 0; i < 4; ++i) {
          const float d0 = v[q][i].x - mean4[q], d1 = v[q][i].y - mean4[q], d2 = v[q][i].z - mean4[q], d3 = v[q][i].w - mean4[q];
          qq += (d0 * d0 + d1 * d1) + (d2 * d2 + d3 * d3);
        }
        s4[q] = qq;
      }
#pragma unroll
      for (int q = 0; q < 4; ++q) rs4[q] = rsqrtf(wsum(s4[q]) * (1.f / 1024.f) + 1e-5f);
#pragma unroll
      for (int i = 0; i < 4; ++i) {
        const int n = i * 256 + lane * 4;
        const float4 g = *(const float4*)(lng + n), bb = *(const float4*)(lnb + n);
        const float4 sc = *(const float4*)(mod + 4096 + n), sh = *(const float4*)(mod + 3072 + n);
#pragma unroll
        for (int q = 0; q < 4; ++q) {
          const int tl = wave * 4 + q, t = t0 + tl;
          const float mean = mean4[q], rs = rs4[q];
          const float4 xn = make_float4((v[q][i].x - mean) * rs * g.x + bb.x, (v[q][i].y - mean) * rs * g.y + bb.y,
                                        (v[q][i].z - mean) * rs * g.z + bb.z, (v[q][i].w - mean) * rs * g.w + bb.w);
          *(float4*)(p->X + (size_t)t * DM + n) = xn;
          const float4 hh = make_float4(xn.x * (1.f + sc.x) + sh.x, xn.y * (1.f + sc.y) + sh.y,
                                        xn.z * (1.f + sc.z) + sh.z, xn.w * (1.f + sc.w) + sh.w);
          *(unsigned*)((unsigned char*)p->AB + (size_t)t * DM + n) = pk_fp8x4(hh.x, hh.y, hh.z, hh.w);
          *(float4*)(h2s + tl * 1028 + n) = hh;
        }
      }
    }
    __syncthreads();
    f32x4v acc = {0.f, 0.f, 0.f, 0.f};
    {
      f32x4v a1 = {0.f, 0.f, 0.f, 0.f}, a2 = {0.f, 0.f, 0.f, 0.f}, a3 = {0.f, 0.f, 0.f, 0.f};
      const int i = lane & 15, kk = lane >> 4;
      const float* arow = h2s + i * 1028 + 4 * kk;
#define ROUTER_LOAD(B, Q0) _Pragma("unroll") for (int q = 0; q < 8; ++q) B[q] = *(const f32x4v*)(brow + 16 * ((Q0) + q)); __builtin_amdgcn_sched_barrier(0);
#define ROUTER_MFMA(B, Q0) _Pragma("unroll") for (int q = 0; q < 8; ++q) { \
        const float4 a = *(const float4*)(arow + 16 * ((Q0) + q)); \
        acc = __builtin_amdgcn_mfma_f32_16x16x4f32(a.x, B[q].x, acc, 0, 0, 0); \
        a1 = __builtin_amdgcn_mfma_f32_16x16x4f32(a.y, B[q].y, a1, 0, 0, 0); \
        a2 = __builtin_amdgcn_mfma_f32_16x16x4f32(a.z, B[q].z, a2, 0, 0, 0); \
        a3 = __builtin_amdgcn_mfma_f32_16x16x4f32(a.w, B[q].w, a3, 0, 0, 0); } __builtin_amdgcn_sched_barrier(0);
      ROUTER_LOAD(b2, 16) ROUTER_MFMA(b0, 0)
      ROUTER_LOAD(b0, 24) ROUTER_MFMA(b1, 8)
      ROUTER_LOAD(b1, 32) ROUTER_MFMA(b2, 16)
      ROUTER_LOAD(b2, 40) ROUTER_MFMA(b0, 24)
      ROUTER_LOAD(b0, 48) ROUTER_MFMA(b1, 32)
      ROUTER_LOAD(b1, 56) ROUTER_MFMA(b2, 40)
      ROUTER_MFMA(b0, 48)
      ROUTER_MFMA(b1, 56)
      acc = (acc + a1) + (a2 + a3);
    }
    __syncthreads();
#pragma unroll
    for (int r = 0; r < 4; ++r) lgs[((lane >> 4) * 4 + r) * 64 + 16 * wave + (lane & 15)] = acc[r];
    __syncthreads();
    {
      float score4[4], gate4[4];
      int kidx4[4], pos4[4];
      bool chosen4[4];
#pragma unroll
      for (int q = 0; q < 4; ++q) {
        const int tl = wave * 4 + q;
        const float logit = lgs[tl * 64 + lane];
        const float score = sigm_f(logit);
        float sel = score + p->moe_bias[layer * 64 + lane];
        bool chosen = false;
        for (int r = 0; r < 6; ++r) {
          const float mx = wmax(sel);
          const unsigned long long bal = __ballot(sel == mx);
          const int first = __ffsll((long long)bal) - 1;
          if (lane == first) { chosen = true; sel = -INFINITY; }
        }
        const float gsum = wsum(chosen ? score : 0.f);
        const unsigned long long cb = __ballot(chosen);
        score4[q] = score; gate4[q] = score / gsum * 2.5f; chosen4[q] = chosen;
        kidx4[q] = __popcll(cb & ((1ull << lane) - 1ull));
      }
#pragma unroll
      for (int q = 0; q < 4; ++q) pos4[q] = chosen4[q] ? atomicAdd(&p->cnt[lane * CSTR], 1) : 0;
#pragma unroll
      for (int q = 0; q < 4; ++q) {
        const int t = t0 + wave * 4 + q;
        if (chosen4[q]) {
          p->ltok[(size_t)lane * NT + pos4[q]] = t;
          p->lgate[(size_t)lane * NT + pos4[q]] = gate4[q];
          p->tsl[t * 6 + kidx4[q]] = (lane << 16) | pos4[q];
        }
      }
    }
    __syncthreads();
  }
}

__device__ __forceinline__ void moe_prefix(KP p, int rows, int* s_pref, int tid) {
  if (tid < 64) s_pref[322 + tid] = p->cnt[tid * CSTR];
  __syncthreads();
  if (tid == 0) {
    int a = 0;
    for (int e = 0; e < 64; ++e) { s_pref[e] = a; a += (s_pref[322 + e] + 127) >> 7; }
    s_pref[64] = a; a += rows >> 7;
    s_pref[65] = a;
  }
  __syncthreads();
}

__device__ void ph_gemm(KP p, int kind, int layer, bool keep, char* lds) {
  const int tid = opaque_tid();
  const int j = layer >> 1;
  const bool att = !(layer & 1);
  const int rows = keep ? NT : NL;
  int* pref = (int*)(lds + META_OFF);
  int* s_idx = pref + 66;
  float* s_gate = (float*)(s_idx + 128);
  if (kind == 1 && blockIdx.x == 0 && tid < 65) p->cnt[tid * CSTR] = 0;
  int total;
  const int ntn_in = att ? 18 : 33;
  switch (kind) {
    case 0: total = (NT / 128) * ntn_in; break;
    case 1: total = (rows / 128) * 8; break;
    case 2: total = pref[65] * 4; break;
    case 3: total = pref[65] * 8; break;
    case 4: total = (NT / 128) * 3; break;
    default: total = (NT / 128) * 20; break;
  }
  const bool moe = kind == 2 || kind == 3;
  const int tsh = kind == 2 ? 2 : 3;
  int e_nx = 0, idx_nx = tid; float g_nx = 1.f;
  auto fetch_moe = [&](int tl) {
    const int mt = tl >> tsh;
    while (mt >= pref[e_nx + 1]) ++e_nx;
    idx_nx = tid; g_nx = 1.f;
    if (tid < 128) {
      const int pos = (mt - pref[e_nx]) * 128 + tid;
      if (kind == 2) {
        idx_nx = 0;
        if (e_nx < 64) { if (pos < pref[322 + e_nx]) idx_nx = p->ltok[(size_t)e_nx * NT + pos]; }
        else idx_nx = pos;
      } else if (e_nx < 64) g_nx = pos < pref[322 + e_nx] ? p->lgate[(size_t)e_nx * NT + pos] : 0.f;
    }
  };
  const int xcd = blockIdx.x & 7, lb = blockIdx.x >> 3, nbx = ((int)gridDim.x - xcd + 7) >> 3;
  const int t_beg = (int)(((long long)total * xcd) >> 3), t_end = (int)(((long long)total * (xcd + 1)) >> 3);
  if (moe && t_beg + lb < t_end) fetch_moe(t_beg + lb);
  for (int tile = t_beg + lb; tile < t_end; tile += nbx) {
    const bf16_t* Abase; const bf16_t* Bt;
    int astride, K, n0, m0 = 0, aux = 0, e = e_nx, mtile = 0;
    switch (kind) {
      case 0: {
                const int q = tile - t_beg, g6 = q / (6 * ntn_in), r6 = q - g6 * 6 * ntn_in;
                const int tn = r6 / 6, tm = (t_beg / ntn_in) + 6 * g6 + (r6 - 6 * tn); m0 = tm * 128; n0 = tn * 128;
                Abase = (const bf16_t*)((const unsigned char*)p->AB + (size_t)m0 * DM); astride = DM; K = 1024;
                Bt = (const bf16_t*)(att ? (const unsigned char*)p->Wt_att + (size_t)j * ATT_N * 1024
                                         : (const unsigned char*)p->Wt_rec + (size_t)j * REC_NP * 1024); } break;
      case 1: { const int tm = tile >> 3, tn = tile & 7; m0 = tm * 128; n0 = tn * 128;
                Abase = (const bf16_t*)((const unsigned char*)p->AB + (size_t)m0 * DM); astride = DM; K = 1024;
                Bt = (const bf16_t*)((const unsigned char*)p->Wt_out + (size_t)layer * 1024 * 1024); } break;
      case 2: { mtile = tile >> 2; aux = tile & 3; n0 = aux * 128;
                Abase = p->AB; astride = DM; K = 1024;
                Bt = (const bf16_t*)((const unsigned char*)p->Wt13 + (size_t)(layer * 65 + e) * 512 * 1024); } break;
      case 3: { mtile = tile >> 3; aux = tile & 7; n0 = aux * 128;
                Abase = (const bf16_t*)((const unsigned char*)p->ACT + (size_t)mtile * 128 * 256); astride = 256; K = 256;
                Bt = (const bf16_t*)((const unsigned char*)p->Wt2 + (size_t)(layer * 65 + e) * 1024 * 256); } break;
      case 4: { const int tm = tile / 3; aux = tile % 3; m0 = tm * 128; n0 = 0;
                Abase = p->Zb + (size_t)m0 * 1536 + aux * 512; astride = 1536; K = 512; Bt = p->Wl1 + (size_t)(j * 3 + aux) * 128 * 512; } break;
      default: { const int tm = tile / 20; aux = tile % 20; m0 = tm * 128; n0 = aux * 128;
                const int grp = aux < 8 ? 0 : (aux < 16 ? 1 : 2);
                Abase = p->L1 + (size_t)m0 * 384 + grp * 128; astride = 384; K = 128; Bt = p->Wl2 + (size_t)j * 2560 * 128; } break;
    }
    if (tid < 128) { s_idx[tid] = idx_nx; s_gate[tid] = g_nx; }
    __syncthreads();
    if (moe && tile + nbx < t_end) fetch_moe(tile + nbx);
    {
      f32x16 acc[2][2];
      if (kind <= 3) {
        const unsigned char* A8 = (const unsigned char*)Abase;
        gemm128_fp8(tid, [&](int r) { return A8 + (size_t)s_idx[r] * astride; }, (const unsigned char*)Bt, K, n0, lds, acc);
      } else
        gemm128_main(tid, [&](int r) { return Abase + (size_t)s_idx[r] * astride; }, Bt, K, n0, lds, acc);
      float* Ct = (float*)lds;
      acc_foreach(tid, acc, [&](int row, int col, float v) { Ct[row * 128 + col] = v; });
    }
    __syncthreads();
    {
      const float* Ct = (const float*)lds;
      int c4 = (tid & 31) * 4, r0 = tid >> 5;
      asm volatile("" : "+v"(c4), "+v"(r0));
      const int N_in = att ? ATT_N : REC_N;
      const int d5 = (aux >> 2) & 1, c05 = (aux & 3) * 128;
      switch (kind) {
        case 0: {
#pragma unroll 8
          for (int it = 0; it < 16; ++it) {
            const int row = it * 8 + r0;
            const float4 vraw = *(const float4*)(Ct + row * 128 + c4);
            const float4 v = make_float4(vraw.x * W8_INV, vraw.y * W8_INV, vraw.z * W8_INV, vraw.w * W8_INV);

            const int cn = n0 + c4;
            float4 vq = v;
            if (att && n0 >= 1536 && n0 < 2176) {
              float ss = v.x * v.x + v.y * v.y + v.z * v.z + v.w * v.w;
              ss += dppx<0xB1>(ss); ss += dppx<0x4E>(ss); ss += dppx<0x141>(ss); ss += dppx<0x140>(ss);
              const float rs = rsqrtf(ss * (1.f / 64.f) + 1e-6f);
              const float4 g = *(const float4*)(p->qk_gain + j * 128 + (n0 >= 2048 ? 64 : 0) + (cn & 63));
              vq = make_float4(v.x * rs * g.x, v.y * rs * g.y, v.z * rs * g.z, v.w * rs * g.w);
              const int t = m0 + row;
              if (t < NL) {
                const int sidx = t & 2047, pi0 = (cn & 63) >> 1;
                const int pos = pi0 < 16 ? (sidx >> 6) : (sidx & 63);
                const float4 cs = *(const float4*)(p->ROPE + (pos * 16 + (pi0 & 15)) * 2);
                vq = make_float4(vq.x * cs.x - vq.y * cs.y, vq.x * cs.y + vq.y * cs.x,
                                 vq.z * cs.z - vq.w * cs.w, vq.z * cs.w + vq.w * cs.z);
              }
            }
            if (cn < N_in) {
              u32x2 o; o.x = pk_bf16(vq.x, vq.y); o.y = pk_bf16(vq.z, vq.w);
              *(u32x2*)(p->P + (size_t)(m0 + row) * LDP + cn) = o;
            }
            if (!att && cn >= 4096 && cn < 4112) *(float4*)(p->GP + (size_t)(m0 + row) * 16 + (cn - 4096)) = v;
          }
        } break;
        case 1: {
#pragma unroll 16
          for (int it = 0; it < 16; ++it) {
            const int row = it * 8 + r0;
            const float4 v = *(const float4*)(Ct + row * 128 + c4);

            const size_t o = (size_t)(m0 + row) * DM + n0 + c4;
            const float4 xv = *(const float4*)(p->X + o);
            const float4 g = *(const float4*)(p->MOD + (layer * 9 + modrow(m0)) * 6144 + 2048 + n0 + c4);
            *(float4*)(p->Tb + o) = make_float4(DN_ALPHA * xv.x + g.x * (v.x * W8_INV), DN_ALPHA * xv.y + g.y * (v.y * W8_INV),
                                                DN_ALPHA * xv.z + g.z * (v.z * W8_INV), DN_ALPHA * xv.w + g.w * (v.w * W8_INV));
          }
        } break;
        case 2: {
#pragma unroll 8
          for (int it = 0; it < 16; ++it) {
            const int row = it * 8 + r0;
            const float4 v = *(const float4*)(Ct + row * 128 + c4);

            if (((c4 >> 5) & 1) == 0) {
              const float4 u = *(const float4*)(Ct + row * 128 + c4 + 32);
              const float a0 = v.x * W8_INV, a1 = v.y * W8_INV, a2 = v.z * W8_INV, a3 = v.w * W8_INV;
              *(unsigned*)((unsigned char*)p->ACT + ((size_t)mtile * 128 + row) * 256 + aux * 64 + (c4 >> 6) * 32 + (c4 & 31)) =
                  pk_fp8x4(silu_f(a0) * (u.x * W8_INV), silu_f(a1) * (u.y * W8_INV), silu_f(a2) * (u.z * W8_INV), silu_f(a3) * (u.w * W8_INV));
            }
          }
        } break;
        case 3: {
#pragma unroll 16
          for (int it = 0; it < 16; ++it) {
            const int row = it * 8 + r0;
            const float4 v = *(const float4*)(Ct + row * 128 + c4);

            const float g = s_gate[row] * W8_INV;
            u32x2 o; o.x = pk_bf16(g * v.x, g * v.y); o.y = pk_bf16(g * v.z, g * v.w);
            *(u32x2*)(p->OUT2 + ((size_t)mtile * 128 + row) * 1024 + n0 + c4) = o;
          }
        } break;
        case 4: {
#pragma unroll 4
          for (int it = 0; it < 16; ++it) {
            const int row = it * 8 + r0;
            const float4 v = *(const float4*)(Ct + row * 128 + c4);

            float4 o4 = v;
            if (aux == 0) o4 = make_float4(tanhf(v.x), tanhf(v.y), tanhf(v.z), tanhf(v.w));
            else if (aux == 2) o4 = make_float4(sigm_f(v.x), sigm_f(v.y), sigm_f(v.z), sigm_f(v.w));
            u32x2 o; o.x = pk_bf16(o4.x, o4.y); o.y = pk_bf16(o4.z, o4.w);
            *(u32x2*)(p->L1 + (size_t)(m0 + row) * 384 + aux * 128 + c4) = o;
          }
        } break;
        default: {
#pragma unroll 4
          for (int it = 0; it < 16; ++it) {
            const int row = it * 8 + r0;
            const float4 v = *(const float4*)(Ct + row * 128 + c4);

            bf16_t* rr = p->RW + (size_t)(m0 + row) * RWS + c05 + c4;
            const float vv[4] = {v.x, v.y, v.z, v.w};
            if (aux < 8) {
              const float4 b0 = *(const float4*)(p->rwkv_w0 + (j * 2 + d5) * 512 + c05 + c4);
              const float bb[4] = {b0.x, b0.y, b0.z, b0.w};
              float e4[4];
#pragma unroll
              for (int q = 0; q < 4; ++q) e4[q] = expf(-softplus_f(-(bb[q] + vv[q])) - 0.5f);
              u32x2 o; o.x = pk_bf16(e4[0], e4[1]); o.y = pk_bf16(e4[2], e4[3]);
              *(u32x2*)(rr + (3 + d5) * 512) = o;
            } else if (aux < 16) {
              const float4 b0 = *(const float4*)(p->rwkv_a0 + (j * 2 + d5) * 512 + c05 + c4);
              const float4 k1 = *(const float4*)(p->rwkv_kvec + (j * 2 + 1) * 512 + c05 + c4);
              const u32x2 kx2 = *(const u32x2*)(rr + 10 * 512);
              const float bb[4] = {b0.x, b0.y, b0.z, b0.w}, kk1[4] = {k1.x, k1.y, k1.z, k1.w};
              const float kx[4] = {bflo(kx2.x), bfhi(kx2.x), bflo(kx2.y), bfhi(kx2.y)};
              float av[4], ke[4];
#pragma unroll
              for (int q = 0; q < 4; ++q) { av[q] = sigm_f(bb[q] + vv[q]); ke[q] = kx[q] * (1.f + (av[q] - 1.f) * kk1[q]); }
              u32x2 o; o.x = pk_bf16(av[0], av[1]); o.y = pk_bf16(av[2], av[3]);
              *(u32x2*)(rr + (7 + d5) * 512) = o;
              o.x = pk_bf16(ke[0], ke[1]); o.y = pk_bf16(ke[2], ke[3]);
              *(u32x2*)(rr + (5 + d5) * 512) = o;
            } else {
              u32x2 o; o.x = pk_bf16(v.x, v.y); o.y = pk_bf16(v.z, v.w);
              *(u32x2*)(rr + 9 * 512) = o;
            }
          }
        } break;
      }
    }
    __syncthreads();
  }
}

__device__ void ph_final_ln(KP p, int layer, bool keep, char* lds) {
  const int tid = opaque_tid();
  const int lane = tid & 63, wave = tid >> 6;
  const int rows = keep ? NT : NL;
  int* s_base = (int*)(lds + META_OFF);
  if (tid == 0) {
    int a = 0;
#pragma unroll 1
    for (int e = 0; e < 64; ++e) { s_base[e] = a * 128; a += (p->cnt[e * CSTR] + 127) >> 7; }
    s_base[64] = a * 128;
  }
  __syncthreads();
  const float* lng = p->ln_g + (layer * 2 + 1) * 1024;
  const float* lnb = p->ln_b + (layer * 2 + 1) * 1024;
  for (int t = blockIdx.x * 4 + wave; t < rows; t += gridDim.x * 4) {
    const int mr = modrow(t);
    const float* g2 = p->MOD + (layer * 9 + mr) * 6144 + 5120;
    const bf16_t* src[7];
#pragma unroll
    for (int k = 0; k < 6; ++k) {
      const int v = p->tsl[t * 6 + k];
      src[k] = p->OUT2 + (size_t)(s_base[v >> 16] + (v & 0xffff)) * 1024;
    }
    src[6] = p->OUT2 + (size_t)(s_base[64] + t) * 1024;
    float v[16];
    float s = 0.f;
#pragma unroll
    for (int c = 0; c < 2; ++c) {
      const int n0 = c * 512 + lane * 8;
      float y[8];
#pragma unroll
      for (int q = 0; q < 8; ++q) y[q] = 0.f;
#pragma unroll
      for (int k = 0; k < 7; ++k) {
        const u32x4 u = *(const u32x4*)(src[k] + n0);
        y[0] += bflo(u.x); y[1] += bfhi(u.x); y[2] += bflo(u.y); y[3] += bfhi(u.y);
        y[4] += bflo(u.z); y[5] += bfhi(u.z); y[6] += bflo(u.w); y[7] += bfhi(u.w);
      }
      const float4 xa = *(const float4*)(p->X + (size_t)t * DM + n0), xb = *(const float4*)(p->X + (size_t)t * DM + n0 + 4);
      const float4 ga = *(const float4*)(g2 + n0), gb = *(const float4*)(g2 + n0 + 4);
      const float xx[8] = {xa.x, xa.y, xa.z, xa.w, xb.x, xb.y, xb.z, xb.w};
      const float gg[8] = {ga.x, ga.y, ga.z, ga.w, gb.x, gb.y, gb.z, gb.w};
#pragma unroll
      for (int q = 0; q < 8; ++q) { v[c * 8 + q] = DN_ALPHA * xx[q] + gg[q] * y[q]; s += v[c * 8 + q]; }
    }
    const float mean = wsum(s) * (1.f / 1024.f);
    float q2 = 0.f;
#pragma unroll
    for (int i = 0; i < 16; ++i) { const float d = v[i] - mean; q2 += d * d; }
    const float rs = rsqrtf(wsum(q2) * (1.f / 1024.f) + 1e-5f);
    const float* modn = p->MOD + ((layer + 1) * 9 + mr) * 6144;
#pragma unroll
    for (int c = 0; c < 2; ++c) {
      const int n0 = c * 512 + lane * 8;
      float xn[8];
#pragma unroll
      for (int q = 0; q < 8; ++q) xn[q] = (v[c * 8 + q] - mean) * rs * lng[n0 + q] + lnb[n0 + q];
      float* xo = (layer == 3 ? p->out : p->X) + (size_t)t * DM + n0;
      *(float4*)(xo) = make_float4(xn[0], xn[1], xn[2], xn[3]);
      *(float4*)(xo + 4) = make_float4(xn[4], xn[5], xn[6], xn[7]);
      if (layer != 3) {
        float hb[8];
#pragma unroll
        for (int q = 0; q < 8; ++q) hb[q] = xn[q] * (1.f + modn[1024 + n0 + q]) + modn[n0 + q];
        u32x2 o;
        o.x = pk_fp8x4(hb[0], hb[1], hb[2], hb[3]); o.y = pk_fp8x4(hb[4], hb[5], hb[6], hb[7]);
        *(u32x2*)((unsigned char*)p->AB + (size_t)t * DM + n0) = o;
      }
    }
  }
}

#define XB_TMO      128
#define XB_XCNT(j)  (256  + 64 * (j))
#define XB_XSUB(j)  (1280 + 64 * (j))
#define XB_XGEN(j)  (2304 + 64 * (j))
#define XB_TOP      3328
#define XB_TOPGEN   3392
#define XB_SPIN_CAP (1u << 20)
#define LAS __attribute__((address_space(3)))
__device__ __forceinline__ unsigned xb_ld(unsigned* p) { return __hip_atomic_load(p, __ATOMIC_RELAXED, __HIP_MEMORY_SCOPE_AGENT); }
__device__ __forceinline__ unsigned xb_add(unsigned* p, unsigned v) { return __hip_atomic_fetch_add(p, v, __ATOMIC_RELAXED, __HIP_MEMORY_SCOPE_AGENT); }
__device__ __forceinline__ unsigned xb_xcc_id() { return (unsigned)__builtin_amdgcn_s_getreg((3 << 11) | 20) & 0xFu; }
#define XB_SPIN(cond, bar) do { unsigned _sp = 0; while (cond) { __builtin_amdgcn_s_sleep(1); \
    if ((++_sp & 255u) == 0u) { if (xb_ld(&(bar)[XB_TMO])) break; if (_sp > XB_SPIN_CAP) { atomicAdd(&(bar)[XB_TMO], 1u); break; } } } } while (0)
struct XcdBarrier { unsigned* bar; unsigned x; volatile LAS unsigned* st; };
__device__ __forceinline__ XcdBarrier xcd_barrier_post(unsigned* bar, volatile LAS unsigned* st) {
  XcdBarrier b; b.bar = bar; b.x = xb_xcc_id(); b.st = st;
  if (threadIdx.x == 0) (void)xb_add(&bar[XB_XCNT(b.x)], 1u);
  return b;
}
__device__ __forceinline__ void xcd_barrier_complete(unsigned* bar, unsigned x, unsigned& nloc, unsigned& nx) {
  const unsigned G = gridDim.x;
  unsigned sum, cnt, mine, sp = 0u;
  for (;;) {
    sum = 0u; cnt = 0u; mine = 0u;
#pragma unroll
    for (unsigned j = 0; j < 16; ++j) { const unsigned c = xb_ld(&bar[XB_XCNT(j)]); sum += c; cnt += (c > 0u) ? 1u : 0u; mine = (j == x) ? c : mine; }
    if (sum == G) break;
    __builtin_amdgcn_s_sleep(1);
    if ((++sp & 255u) == 0u) { if (xb_ld(&bar[XB_TMO])) break; if (sp > XB_SPIN_CAP) { atomicAdd(&bar[XB_TMO], 1u); break; } }
  }
  nloc = mine > 0u ? mine : 1u; nx = cnt > 0u ? cnt : 1u;
}
__device__ __forceinline__ void xcd_barrier(const XcdBarrier& b) {
  asm volatile("s_waitcnt vmcnt(0)" ::: "memory");
  __syncthreads();
  if (threadIdx.x == 0) {
    unsigned* bar = b.bar;
    __builtin_amdgcn_s_waitcnt(0);
    unsigned nloc = b.st[0], nx = b.st[1];
    if (nloc == 0u) { xcd_barrier_complete(bar, b.x, nloc, nx); b.st[0] = nloc; b.st[1] = nx; }
    const unsigned old = xb_add(&bar[XB_XSUB(b.x)], 1u);
    const unsigned gen = old / nloc;
    if (old + 1u == (gen + 1u) * nloc) {
      __builtin_amdgcn_fence(__ATOMIC_RELEASE, "agent");
      asm volatile("s_waitcnt vmcnt(0)" ::: "memory");
      const unsigned og = xb_add(&bar[XB_TOP], 1u);
      const unsigned tg = og / nx;
      if (og + 1u == (tg + 1u) * nx) xb_add(&bar[XB_TOPGEN], 1u);
      else XB_SPIN(xb_ld(&bar[XB_TOPGEN]) == tg, bar);
      __builtin_amdgcn_fence(__ATOMIC_ACQUIRE, "agent");
      xb_add(&bar[XB_XGEN(b.x)], 1u);
      asm volatile("s_waitcnt vmcnt(0)" ::: "memory");
    } else {
      XB_SPIN(xb_ld(&bar[XB_XGEN(b.x)]) == gen, bar);
      __builtin_amdgcn_fence(__ATOMIC_ACQUIRE, "agent");
      asm volatile("s_waitcnt vmcnt(0)" ::: "memory");
    }
  }
  __syncthreads();
}

constexpr int NSLOTS = 13;
constexpr int NPHASE = 2 + 4 * NSLOTS;
__device__ __forceinline__ bool phase_is_nop(int ph) {
  if (ph < 2) return false;
  const int layer = (ph - 2) / NSLOTS, st = (ph - 2) % NSLOTS;
  if (st == 5 || st == 6) return true;
  return !(layer & 1) && (st == 1 || (st >= 3 && st <= 7));
}
__device__ void run_phase(KP p, int ph, char* sm) {
  if (ph == 0) { ph_init(p, sm); return; }
  if (ph == 1) { ph_mod_h(p, sm); return; }
  const int layer = (ph - 2) / NSLOTS, st = (ph - 2) % NSLOTS;
  const bool odd = layer & 1;
  const bool keep = layer < 3;
  int gk = -1;
  if (st == 0) gk = 0;
  else if (st == 8) gk = 1;
  else if (st == 10) gk = 2;
  else if (st == 11) gk = 3;
  else if (odd && st == 2) gk = 4;
  else if (odd && st == 3) gk = 5;
  asm volatile("" : "+s"(gk));
  if (gk >= 0) {
    if (gk == 2 || gk == 3) moe_prefix(p, keep ? NT : NL, (int*)(sm + META_OFF), opaque_tid());
    ph_gemm(p, gk, layer, keep, sm);
    if (gk == 5) { __syncthreads(); ph_mlstm_s2(p, sm); }
    return;
  }
  switch (st) {
    case 1: if (odd) { ph_rwkv_mix(p, layer); ph_mlstm_s1(p, layer, sm); } break;
    case 2: ph_attention(p, layer, keep, sm); break;
    case 4: if (odd) ph_scan_a(p, layer, sm); break;
    case 7: if (odd) ph_rec_final(p, layer, keep); break;
    case 9: ph_ln_router(p, layer, keep, sm); break;
    case 12: ph_final_ln(p, layer, keep, sm); break;
  }
}

__global__ void __launch_bounds__(NTHR, 2) mega_kernel(Params kargs) {
  extern __shared__ __attribute__((aligned(16))) char sm[];
  cg::grid_group grid = cg::this_grid();
  volatile LAS unsigned* st = (volatile LAS unsigned*)(sm + META_OFF + 4032);
  if (threadIdx.x == 0) { st[0] = 0u; st[1] = 0u; }
  __syncthreads();
  const XcdBarrier xb = xcd_barrier_post(kargs.bar, st);
  for (int ph = kargs.ph_lo; ph < kargs.ph_hi; ++ph) {
    if (phase_is_nop(ph)) continue;
    {
      KP kp = (KP)__builtin_amdgcn_kernarg_segment_ptr();
      asm volatile("" : "+s"(kp));
      run_phase(kp, ph, sm);
    }
    if (ph + 1 < kargs.ph_hi) {
      if (ph == 0) grid.sync();
      else xcd_barrier(xb);
    }
  }
}

extern "C" void kernel_launch(void* const* d_in, const int* in_sizes, int n_in, void* d_out, int out_size, void* d_ws,
                              size_t ws_size, hipStream_t stream) {
  static int grid_blocks = 0;
  if (!grid_blocks) {
    int dev = 0, cus = 0, per_cu = 0;
    (void)hipGetDevice(&dev);
    (void)hipDeviceGetAttribute(&cus, hipDeviceAttributeMultiprocessorCount, dev);
    (void)hipFuncSetAttribute((const void*)mega_kernel, hipFuncAttributeMaxDynamicSharedMemorySize, SMEM_BYTES);
    (void)hipOccupancyMaxActiveBlocksPerMultiprocessor(&per_cu, mega_kernel, NTHR, SMEM_BYTES);
    if (per_cu < 1) per_cu = 1;
    if (per_cu > 2) per_cu = 2;
    grid_blocks = cus * per_cu;
  }
  Params p;
  memset(&p, 0, sizeof(p));
  const float** pin = (const float**)&p;
  for (int i = 0; i < 35; ++i) pin[i] = (const float*)d_in[i];
  p.out = (float*)d_out;
  char* w = (char*)d_ws;
  size_t off = 0;
  auto take = [&](size_t bytes) { char* r = w + off; off += (bytes + 255) & ~(size_t)255; return r; };
  p.Wt_att = (bf16_t*)take((size_t)2 * ATT_N * 1024 * 2);
  p.Wt_rec = (bf16_t*)take((size_t)2 * REC_NP * 1024 * 2);
  p.Wt_out = (bf16_t*)take((size_t)4 * 1024 * 1024 * 2);
  p.Wt13 = (bf16_t*)take((size_t)4 * 65 * 512 * 1024);
  p.Wt2 = (bf16_t*)take((size_t)4 * 65 * 1024 * 256);
  p.Wl1 = (bf16_t*)take((size_t)2 * 3 * 128 * 512 * 2);
  p.Wl2 = (bf16_t*)take((size_t)2 * 2560 * 128 * 2);
  p.X = (float*)take((size_t)NT * DM * 4);
  p.AB = (bf16_t*)take((size_t)NT * DM * 2);
  p.MOD = (float*)take((size_t)5 * 9 * 6144 * 4);
  p.MODP = (float*)take((size_t)8 * 4 * 9 * 6144 * 4);
  p.GP = (float*)take((size_t)NT * 16 * 4);
  p.ROPE = (float*)take((size_t)64 * 16 * 2 * 4);
  p.WrT = (float*)take((size_t)4 * 64 * 1024 * 4);
  p.msc = (float*)take((size_t)3 * NMT * 4);
  p.lgate = (float*)take((size_t)64 * NT * 4);
  p.ltok = (int*)take((size_t)64 * NT * 4);
  p.tsl = (int*)take((size_t)NT * 6 * 4);
  p.cnt = (int*)take((size_t)65 * CSTR * 4);
  p.bar = (unsigned*)take((size_t)BAR_TOTAL_WORDS * 4);
  char* region = take(0);
  const size_t szP = (size_t)NT * LDP * 2, szRW = (size_t)NT * RWS * 2, szMS = (size_t)NMT * 16384 * 2,
               szMSn = (size_t)NMT * 128 * 4;
  const size_t szT = (size_t)NT * DM * 4, szOUT2 = (size_t)NSLOT * 1024 * 2;
  p.P = (bf16_t*)region;
  p.RW = (bf16_t*)(region + szP);
  p.MS = (bf16_t*)(region + szP + szRW);
  p.MSn = (float*)(region + szP + szRW + szMS);
  p.Tb = (float*)region;
  p.ACT = (bf16_t*)region;
  p.OUT2 = (bf16_t*)(region + szT);
  const size_t szZ = (size_t)NT * 2048 * 2;
  p.Zb = (bf16_t*)(region + szP + szRW + szMS + szMSn);
  p.L1 = p.Zb + (size_t)NT * 1536;
  size_t mixer = szP + szRW + szMS + szMSn + szZ, moe = szT + szOUT2;
  off += (mixer > moe ? mixer : moe);
  if (off > ws_size) { fprintf(stderr, "workspace too small: need %zu have %zu\n", off, ws_size); return; }
  p.ph_lo = 0;
  p.ph_hi = NPHASE;
  (void)hipMemsetAsync(p.bar, 0, (size_t)BAR_TOTAL_WORDS * 4, stream);
  void* args[] = {&p};
  hipError_t e = hipLaunchCooperativeKernel((void*)mega_kernel, dim3(grid_blocks), dim3(NTHR), args, SMEM_BYTES, stream);
  if (e != hipSuccess) fprintf(stderr, "cooperative launch failed: %s (grid %d)\n", hipGetErrorString(e), grid_blocks);
}
```

```cpp
#include <hip/hip_runtime.h>
#include <hip/hip_cooperative_groups.h>
#include <cstdio>
#include <cstring>
namespace cg = cooperative_groups;

constexpr int DM = 1024;
constexpr int NBATCH = 8;
constexpr int SEQ = 2048;
constexpr int CTXL = 256;
constexpr int NL = NBATCH * SEQ;
constexpr int NC = NBATCH * CTXL;
constexpr int NT = NL + NC;
constexpr int TSC = CTXL + SEQ;
constexpr int LDP = 4112;
constexpr int ATT_N = 2304;
constexpr int REC_N = 4112;
constexpr int REC_NP = 4224;
constexpr int NCHUNK = 36;
constexpr int NMT = 64 * NCHUNK;
constexpr int RWS = 5632;
constexpr int NSLOT = 137216;
constexpr float DN_ALPHA = 1.6817928305074290f;
constexpr int NTHR = 256;
constexpr int SMEM_BYTES = 65536 + 4096;
constexpr int META_OFF = 65536;
#define XCD_BAR_WORDS 3456
constexpr int CSTR = 32;
constexpr int BAR_TOTAL_WORDS = XCD_BAR_WORDS + 64;

typedef unsigned short bf16_t;
using bf16x8 = __attribute__((ext_vector_type(8))) short;
using f32x16 = __attribute__((ext_vector_type(16))) float;
using u32x4 = __attribute__((ext_vector_type(4))) unsigned;
using u32x2 = __attribute__((ext_vector_type(2))) unsigned;

struct Params {
  const float *x, *c, *ctx, *c_ctx, *ada_w, *ada_b, *ln_g, *ln_b, *mix_w_out, *att_w_in, *na_rpb, *qk_gain,
      *rec_w_in, *rwkv_mu, *rwkv_w0, *rwkv_w1, *rwkv_w2, *rwkv_a0, *rwkv_a1, *rwkv_a2, *rwkv_g1, *rwkv_g2,
      *rwkv_kvec, *rwkv_rk, *rwkv_gn, *mlstm_gate_b, *mlstm_norm, *moe_router, *moe_bias, *moe_w1, *moe_w3,
      *moe_w2, *shared_w1, *shared_w3, *shared_w2;
  float* out;
  bf16_t *Wt_att, *Wt_rec, *Wt_out, *Wt13, *Wt2, *Wl1, *Wl2;
  bf16_t *Zb, *L1;
  float *X, *MOD, *MODP, *GP, *msc, *lgate, *MSn, *Tb, *ROPE, *WrT;
  bf16_t *AB, *P, *RW, *MS, *ACT, *OUT2;
  int *cnt, *ltok, *tsl;
  unsigned* bar;
  int ph_lo, ph_hi;
};

typedef const Params __attribute__((address_space(4))) * KP;

__device__ __forceinline__ int modrow(int t) { return t < NL ? (t >> 11) : 8; }
__device__ __forceinline__ float silu_f(float x) { return x / (1.f + expf(-x)); }
__device__ __forceinline__ float sigm_f(float x) { return 1.f / (1.f + expf(-x)); }
__device__ __forceinline__ float softplus_f(float x) { return fmaxf(x, 0.f) + log1pf(expf(-fabsf(x))); }
template <int CTRL>
__device__ __forceinline__ float dppx(float x) {
  return __int_as_float(__builtin_amdgcn_update_dpp(0, __float_as_int(x), CTRL, 0xf, 0xf, true));
}
__device__ __forceinline__ float rdlane(float v, int l) {
  return __int_as_float(__builtin_amdgcn_readlane(__float_as_int(v), l));
}
__device__ __forceinline__ float wsum(float v) {
  v += dppx<0xB1>(v); v += dppx<0x4E>(v); v += dppx<0x141>(v); v += dppx<0x140>(v);
  return (rdlane(v, 0) + rdlane(v, 16)) + (rdlane(v, 32) + rdlane(v, 48));
}
__device__ __forceinline__ float wmax(float v) {
  v = fmaxf(v, dppx<0xB1>(v)); v = fmaxf(v, dppx<0x4E>(v)); v = fmaxf(v, dppx<0x141>(v)); v = fmaxf(v, dppx<0x140>(v));
  return fmaxf(fmaxf(rdlane(v, 0), rdlane(v, 16)), fmaxf(rdlane(v, 32), rdlane(v, 48)));
}
__device__ __forceinline__ int opaque_tid() {
  int t = threadIdx.x;
  asm volatile("" : "+v"(t));
  return t;
}
typedef __bf16 bf16x2_t __attribute__((ext_vector_type(2)));
typedef float f32x2_t __attribute__((ext_vector_type(2)));
__device__ __forceinline__ unsigned pk_bf16(float lo, float hi) {
  const f32x2_t v = {lo, hi};
  return __builtin_bit_cast(unsigned, __builtin_convertvector(v, bf16x2_t));
}
__device__ __forceinline__ bf16_t f2bf(float x) { return (bf16_t)(pk_bf16(x, 0.f) & 0xffffu); }
__device__ __forceinline__ float bf2f(bf16_t v) { return __uint_as_float((unsigned)v << 16); }
__device__ __forceinline__ float bflo(unsigned u) { return __uint_as_float(u << 16); }
__device__ __forceinline__ float bfhi(unsigned u) { return __uint_as_float(u & 0xffff0000u); }
__device__ __forceinline__ int scan_row(int dir, int b, int tau) {
  if (tau < CTXL) return NL + b * CTXL + (dir ? (CTXL - 1 - tau) : tau);
  int s = tau - CTXL;
  return b * SEQ + (dir ? (SEQ - 1 - s) : s);
}

template <class RowPtrA>
__device__ __forceinline__ void gemm128_main(int tid, RowPtrA rowA, const bf16_t* __restrict__ Bt, int K, int n0,
                                             char* lds, f32x16 (&acc)[2][2]) {
  const int lane = tid & 63, w = tid >> 6;
  const int wm = w >> 1, wn = w & 1, r = lane & 31, h = lane >> 5;
  const int c = tid & 7, sr = tid >> 3;
  const int lc = (c ^ ((tid >> 4) & 7)) * 8;
  const bf16_t* ap[4];
#pragma unroll
  for (int i = 0; i < 4; ++i) ap[i] = rowA(sr + 32 * i) + lc;
  const bf16_t* bp0 = Bt + (size_t)(n0 + sr) * K + lc;
  const int bstr = 32 * K;
#pragma unroll
  for (int mi = 0; mi < 2; ++mi)
#pragma unroll
    for (int ni = 0; ni < 2; ++ni)
#pragma unroll
      for (int q = 0; q < 16; ++q) acc[mi][ni][q] = 0.f;
  const int nk = K >> 6;
  auto issue = [&](int kt) {
    char* As = lds + (kt & 1) * 32768 + tid * 16;
    const int k0 = kt * 64;
#pragma unroll
    for (int i = 0; i < 4; ++i) {
      __builtin_amdgcn_global_load_lds((const unsigned*)(ap[i] + k0), (__attribute__((address_space(3))) unsigned*)(As + i * 4096), 16, 0, 0);
      __builtin_amdgcn_global_load_lds((const unsigned*)(bp0 + i * bstr + k0), (__attribute__((address_space(3))) unsigned*)(As + 16384 + i * 4096), 16, 0, 0);
    }
  };
  issue(0);
  const int sw = (r >> 1) & 7;
#pragma unroll 1
  for (int kt = 0; kt < nk; ++kt) {
    asm volatile("s_waitcnt vmcnt(0)" ::: "memory");
    __syncthreads();
    if (kt + 1 < nk) issue(kt + 1);
    const char* As = lds + (kt & 1) * 32768;
    const char* Ar = As + (wm * 64 + r) * 128;
    const char* Br = As + 16384 + (wn * 64 + r) * 128;
#pragma unroll
    for (int ks = 0; ks < 4; ++ks) {
      const int off = ((ks * 2 + h) ^ sw) * 16;
      const bf16x8 a0 = *(const bf16x8*)(Ar + off);
      const bf16x8 a1 = *(const bf16x8*)(Ar + 32 * 128 + off);
      const bf16x8 b0 = *(const bf16x8*)(Br + off);
      const bf16x8 b1 = *(const bf16x8*)(Br + 32 * 128 + off);
      acc[0][0] = __builtin_amdgcn_mfma_f32_32x32x16_bf16(a0, b0, acc[0][0], 0, 0, 0);
      acc[0][1] = __builtin_amdgcn_mfma_f32_32x32x16_bf16(a0, b1, acc[0][1], 0, 0, 0);
      acc[1][0] = __builtin_amdgcn_mfma_f32_32x32x16_bf16(a1, b0, acc[1][0], 0, 0, 0);
      acc[1][1] = __builtin_amdgcn_mfma_f32_32x32x16_bf16(a1, b1, acc[1][1], 0, 0, 0);
    }
  }
  __syncthreads();
}
using i64 = long;
template <class RowPtrA8>
__device__ __forceinline__ void gemm128_fp8(int tid, RowPtrA8 rowA, const unsigned char* __restrict__ Bt, int K, int n0,
                                            char* lds, f32x16 (&acc)[2][2]) {
  const int lane = tid & 63, w = tid >> 6;
  const int wm = w >> 1, wn = w & 1, r = lane & 31, h = lane >> 5;
  const int c = tid & 7, sr = tid >> 3;
  const int lc = (c ^ ((tid >> 4) & 7)) * 16;
  const unsigned char* ap[4];
#pragma unroll
  for (int i = 0; i < 4; ++i) ap[i] = rowA(sr + 32 * i) + lc;
  const unsigned char* bp0 = Bt + (size_t)(n0 + sr) * K + lc;
  const int bstr = 32 * K;
#pragma unroll
  for (int mi = 0; mi < 2; ++mi)
#pragma unroll
    for (int ni = 0; ni < 2; ++ni)
#pragma unroll
      for (int q = 0; q < 16; ++q) acc[mi][ni][q] = 0.f;
  const int nk = K >> 7;
  auto issue = [&](int kt) {
    char* As = lds + (kt & 1) * 32768 + tid * 16;
    const int k0 = kt * 128;
#pragma unroll
    for (int i = 0; i < 4; ++i) {
      __builtin_amdgcn_global_load_lds((const unsigned*)(ap[i] + k0), (__attribute__((address_space(3))) unsigned*)(As + i * 4096), 16, 0, 0);
      __builtin_amdgcn_global_load_lds((const unsigned*)(bp0 + i * bstr + k0), (__attribute__((address_space(3))) unsigned*)(As + 16384 + i * 4096), 16, 0, 0);
    }
  };
  issue(0);
  const int sw = (r >> 1) & 7;
#pragma unroll 1
  for (int kt = 0; kt < nk; ++kt) {
    asm volatile("s_waitcnt vmcnt(0)" ::: "memory");
    __syncthreads();
    if (kt + 1 < nk) issue(kt + 1);
    const char* As = lds + (kt & 1) * 32768;
    const char* Ar = As + (wm * 64 + r) * 128;
    const char* Br = As + 16384 + (wn * 64 + r) * 128;
#pragma unroll
    for (int q = 0; q < 4; ++q) {
      const int off = ((q * 2 + h) ^ sw) * 16;
      const u32x4 a0 = *(const u32x4*)(Ar + off);
      const u32x4 a1 = *(const u32x4*)(Ar + 32 * 128 + off);
      const u32x4 b0 = *(const u32x4*)(Br + off);
      const u32x4 b1 = *(const u32x4*)(Br + 32 * 128 + off);
      const i64 a0l = (i64)(((unsigned long long)a0.y << 32) | a0.x), a0h = (i64)(((unsigned long long)a0.w << 32) | a0.z);
      const i64 a1l = (i64)(((unsigned long long)a1.y << 32) | a1.x), a1h = (i64)(((unsigned long long)a1.w << 32) | a1.z);
      const i64 b0l = (i64)(((unsigned long long)b0.y << 32) | b0.x), b0h = (i64)(((unsigned long long)b0.w << 32) | b0.z);
      const i64 b1l = (i64)(((unsigned long long)b1.y << 32) | b1.x), b1h = (i64)(((unsigned long long)b1.w << 32) | b1.z);
      acc[0][0] = __builtin_amdgcn_mfma_f32_32x32x16_fp8_fp8(a0l, b0l, acc[0][0], 0, 0, 0);
      acc[0][1] = __builtin_amdgcn_mfma_f32_32x32x16_fp8_fp8(a0l, b1l, acc[0][1], 0, 0, 0);
      acc[1][0] = __builtin_amdgcn_mfma_f32_32x32x16_fp8_fp8(a1l, b0l, acc[1][0], 0, 0, 0);
      acc[1][1] = __builtin_amdgcn_mfma_f32_32x32x16_fp8_fp8(a1l, b1l, acc[1][1], 0, 0, 0);
      acc[0][0] = __builtin_amdgcn_mfma_f32_32x32x16_fp8_fp8(a0h, b0h, acc[0][0], 0, 0, 0);
      acc[0][1] = __builtin_amdgcn_mfma_f32_32x32x16_fp8_fp8(a0h, b1h, acc[0][1], 0, 0, 0);
      acc[1][0] = __builtin_amdgcn_mfma_f32_32x32x16_fp8_fp8(a1h, b0h, acc[1][0], 0, 0, 0);
      acc[1][1] = __builtin_amdgcn_mfma_f32_32x32x16_fp8_fp8(a1h, b1h, acc[1][1], 0, 0, 0);
    }
  }
  __syncthreads();
}
template <class F>
__device__ __forceinline__ void acc_foreach(int tid, const f32x16 (&acc)[2][2], F f) {
  const int lane = tid & 63, w = tid >> 6;
  const int wm = w >> 1, wn = w & 1, r = lane & 31, h = lane >> 5;
#pragma unroll
  for (int mi = 0; mi < 2; ++mi)
#pragma unroll
    for (int ni = 0; ni < 2; ++ni)
#pragma unroll
      for (int q = 0; q < 16; ++q) {
        const int row = wm * 64 + mi * 32 + (q & 3) + 8 * (q >> 2) + 4 * h;
        const int col = wn * 64 + ni * 32 + r;
        f(row, col, acc[mi][ni][q]);
        if ((q & 3) == 3) __builtin_amdgcn_sched_barrier(0);
      }
}

template <class RM>
__device__ __forceinline__ void tr_tile(int tid, const float* __restrict__ src, int N, int k0, int n0,
                                        bf16_t* __restrict__ dst, int K, RM rowmap, float* tile) {
  {
    const int tx = tid & 15, ty = tid >> 4;
    const int n = n0 + tx * 4;
#pragma unroll
    for (int i = 0; i < 4; ++i) {
      const int k = ty + 16 * i;
      float4 v = make_float4(0.f, 0.f, 0.f, 0.f);
      if (n < N) v = *(const float4*)(src + (size_t)(k0 + k) * N + n);
      tile[k * 65 + tx * 4 + 0] = v.x; tile[k * 65 + tx * 4 + 1] = v.y;
      tile[k * 65 + tx * 4 + 2] = v.z; tile[k * 65 + tx * 4 + 3] = v.w;
    }
  }
  __syncthreads();
  {
    const int kc = tid & 7;
#pragma unroll
    for (int i = 0; i < 2; ++i) {
      const int n = (tid >> 3) + 32 * i;
      if (n0 + n < N) {
        float v[8];
#pragma unroll
        for (int q = 0; q < 8; ++q) v[q] = tile[(kc * 8 + q) * 65 + n];
        u32x4 o;
        o.x = pk_bf16(v[0], v[1]); o.y = pk_bf16(v[2], v[3]); o.z = pk_bf16(v[4], v[5]); o.w = pk_bf16(v[6], v[7]);
        *(u32x4*)(dst + (size_t)rowmap(n0 + n) * K + k0 + kc * 8) = o;
      }
    }
  }
  __syncthreads();
}

constexpr float W8_SCALE = 32.f, W8_INV = 1.f / 32.f;
__device__ __forceinline__ unsigned pk_fp8x4(float a, float b, float c, float d) {
  int r = __builtin_amdgcn_cvt_pk_fp8_f32(a, b, 0, false);
  r = __builtin_amdgcn_cvt_pk_fp8_f32(c, d, r, true);
  return (unsigned)r;
}
__device__ __forceinline__ unsigned pk_fp8x4c(float a, float b, float c, float d) {
  constexpr float M = 448.f;
  return pk_fp8x4(fminf(fmaxf(a, -M), M), fminf(fmaxf(b, -M), M), fminf(fmaxf(c, -M), M), fminf(fmaxf(d, -M), M));
}
template <class RM>
__device__ __forceinline__ void tr_tile_fp8(int tid, const float* __restrict__ src, int N, int k0, int n0,
                                            unsigned char* __restrict__ dst, int K, RM rowmap, float* tile) {
  {
    const int tx = tid & 15, ty = tid >> 4;
    const int n = n0 + tx * 4;
#pragma unroll
    for (int i = 0; i < 4; ++i) {
      const int k = ty + 16 * i;
      float4 v = make_float4(0.f, 0.f, 0.f, 0.f);
      if (n < N) v = *(const float4*)(src + (size_t)(k0 + k) * N + n);
      tile[k * 65 + tx * 4 + 0] = v.x; tile[k * 65 + tx * 4 + 1] = v.y;
      tile[k * 65 + tx * 4 + 2] = v.z; tile[k * 65 + tx * 4 + 3] = v.w;
    }
  }
  __syncthreads();
  {
    const int kc = tid & 3, n = tid >> 2;
    float v[16];
#pragma unroll
    for (int q = 0; q < 16; ++q) v[q] = tile[(kc * 16 + q) * 65 + n] * W8_SCALE;
    u32x4 o;
    o.x = pk_fp8x4(v[0], v[1], v[2], v[3]); o.y = pk_fp8x4(v[4], v[5], v[6], v[7]);
    o.z = pk_fp8x4(v[8], v[9], v[10], v[11]); o.w = pk_fp8x4(v[12], v[13], v[14], v[15]);
    *(u32x4*)(dst + (size_t)rowmap(n0 + n) * K + k0 + kc * 16) = o;
  }
  __syncthreads();
}

constexpr int CJ0 = 1152, CJ1 = CJ0 + 2080, CJ2 = CJ1 + 1024, CJ3 = CJ2 + 33280, CJ4 = CJ3 + 16640;
__device__ void convert_job(KP p, int job, float* sm, int tid) {
  if (job < CJ0) {
    const int j = job / 576, rem = job % 576, kt = rem / 36, nt = rem % 36;
    tr_tile_fp8(tid, p->att_w_in + (size_t)j * 1024 * ATT_N, ATT_N, kt * 64, nt * 64, (unsigned char*)p->Wt_att + (size_t)j * ATT_N * 1024,
                1024, [](int n) { return n; }, sm);
  } else if (job < CJ1) {
    const int q = job - CJ0;
    const int j = q / 1040, rem = q % 1040, kt = rem / 65, nt = rem % 65;
    tr_tile_fp8(tid, p->rec_w_in + (size_t)j * 1024 * REC_N, REC_N, kt * 64, nt * 64, (unsigned char*)p->Wt_rec + (size_t)j * REC_NP * 1024,
                1024, [](int n) { return n; }, sm);
  } else if (job < CJ2) {
    const int q = job - CJ1;
    const int i = q >> 8, rem = q & 255, kt = rem >> 4, nt = rem & 15;
    tr_tile_fp8(tid, p->mix_w_out + (size_t)i * 1024 * 1024, 1024, kt * 64, nt * 64, (unsigned char*)p->Wt_out + (size_t)i * 1024 * 1024,
                1024, [](int n) { return n; }, sm);
  } else if (job < CJ3) {
    const int q = job - CJ2;
    const int le = q >> 7, rem = q & 127;
    const int which = rem >> 6, kt = (rem >> 2) & 15, nt = rem & 3;
    const int layer = le / 65, e = le % 65;
    const float* src;
    if (e < 64) src = (which ? p->moe_w3 : p->moe_w1) + (size_t)(layer * 64 + e) * 1024 * 256;
    else src = (which ? p->shared_w3 : p->shared_w1) + (size_t)layer * 1024 * 256;
    tr_tile_fp8(tid, src, 256, kt * 64, nt * 64, (unsigned char*)p->Wt13 + (size_t)le * 512 * 1024, 1024,
                [which](int n) { return 64 * (n >> 5) + which * 32 + (n & 31); }, sm);
  } else {
    const int q = job - CJ3;
    const int le = q >> 6, rem = q & 63;
    const int kt = rem >> 4, nt = rem & 15;
    const int layer = le / 65, e = le % 65;
    const float* src = e < 64 ? p->moe_w2 + (size_t)(layer * 64 + e) * 256 * 1024 : p->shared_w2 + (size_t)layer * 256 * 1024;
    tr_tile_fp8(tid, src, 1024, kt * 64, nt * 64, (unsigned char*)p->Wt2 + (size_t)le * 1024 * 256, 256, [](int n) { return n; }, sm);
  }
}
__device__ __forceinline__ int conv_stage_total(int stage) {
  return stage == 0 ? (576 + 1040 + 512 + 8320 + 4160) : (stage == 1 ? (576 + 1040 + 256 + 16640 + 8320) : (256 + 8320 + 4160));
}
__device__ __forceinline__ int conv_stage_job(int stage, int q) {
  if (stage == 0) {
    if (q < 8320) return CJ2 + q;  q -= 8320;
    if (q < 4160) return CJ3 + q;  q -= 4160;
    if (q < 576) return q;  q -= 576;
    if (q < 1040) return CJ0 + q;  q -= 1040;
    return CJ1 + q;
  } else if (stage == 1) {
    if (q < 8320) return CJ2 + 8320 + q;  q -= 8320;
    if (q < 4160) return CJ3 + 4160 + q;  q -= 4160;
    if (q < 576) return 576 + q;  q -= 576;
    if (q < 256) return CJ1 + 512 + q;  q -= 256;
    if (q < 8320) return CJ2 + 16640 + q;  q -= 8320;
    if (q < 4160) return CJ3 + 8320 + q;  q -= 4160;
    return CJ0 + 1040 + q;
  }
  if (q < 256) return CJ1 + 768 + q;  q -= 256;
  if (q < 8320) return CJ2 + 24960 + q;  q -= 8320;
  return CJ3 + 12480 + q;
}

struct CvDesc { const float* src; unsigned char* dst; int N, K, k0, n0, which; };
__device__ __forceinline__ bool conv_desc_fp8(KP p, int job, CvDesc& d) {
  if (job < CJ2) return false;
  if (job < CJ3) {
    const int q = job - CJ2;
    const int le = q >> 7, rem = q & 127;
    const int which = rem >> 6, kt = (rem >> 2) & 15, nt = rem & 3;
    const int layer = le / 65, e = le % 65;
    if (e < 64) d.src = (which ? p->moe_w3 : p->moe_w1) + (size_t)(layer * 64 + e) * 1024 * 256;
    else d.src = (which ? p->shared_w3 : p->shared_w1) + (size_t)layer * 1024 * 256;
    d.dst = (unsigned char*)p->Wt13 + (size_t)le * 512 * 1024;
    d.N = 256; d.K = 1024; d.k0 = kt * 64; d.n0 = nt * 64; d.which = which;
  } else {
    const int q = job - CJ3;
    const int le = q >> 6, rem = q & 63;
    const int kt = rem >> 4, nt = rem & 15;
    const int layer = le / 65, e = le % 65;
    d.src = e < 64 ? p->moe_w2 + (size_t)(layer * 64 + e) * 256 * 1024 : p->shared_w2 + (size_t)layer * 256 * 1024;
    d.dst = (unsigned char*)p->Wt2 + (size_t)le * 1024 * 256;
    d.N = 1024; d.K = 256; d.k0 = kt * 64; d.n0 = nt * 64; d.which = -1;
  }
  return true;
}
typedef float cvf4 __attribute__((ext_vector_type(4)));
__device__ __forceinline__ void cv_load(const CvDesc& d, int tid, cvf4& v0, cvf4& v1, cvf4& v2, cvf4& v3) {
  const int tx = tid & 15, ty = tid >> 4;
  const float* s0 = d.src + (size_t)(d.k0 + ty) * d.N + d.n0 + tx * 4;
  v0 = *(const cvf4*)(s0);
  v1 = *(const cvf4*)(s0 + (size_t)16 * d.N);
  v2 = *(const cvf4*)(s0 + (size_t)32 * d.N);
  v3 = *(const cvf4*)(s0 + (size_t)48 * d.N);
}
__device__ __forceinline__ void cv_emit(const CvDesc& d, int tid, const cvf4 v0, const cvf4 v1, const cvf4 v2, const cvf4 v3, float* tile) {
  {
    const int tx = tid & 15, ty = tid >> 4;
    float* t0 = tile + ty * 65 + tx * 4;
    t0[0] = v0.x; t0[1] = v0.y; t0[2] = v0.z; t0[3] = v0.w;
    t0[16 * 65 + 0] = v1.x; t0[16 * 65 + 1] = v1.y; t0[16 * 65 + 2] = v1.z; t0[16 * 65 + 3] = v1.w;
    t0[32 * 65 + 0] = v2.x; t0[32 * 65 + 1] = v2.y; t0[32 * 65 + 2] = v2.z; t0[32 * 65 + 3] = v2.w;
    t0[48 * 65 + 0] = v3.x; t0[48 * 65 + 1] = v3.y; t0[48 * 65 + 2] = v3.z; t0[48 * 65 + 3] = v3.w;
  }
  __syncthreads();
  {
    const int kc = tid & 3, n = tid >> 2;
    float v[16];
#pragma unroll
    for (int q = 0; q < 16; ++q) v[q] = tile[(kc * 16 + q) * 65 + n] * W8_SCALE;
    u32x4 o;
    o.x = pk_fp8x4(v[0], v[1], v[2], v[3]); o.y = pk_fp8x4(v[4], v[5], v[6], v[7]);
    o.z = pk_fp8x4(v[8], v[9], v[10], v[11]); o.w = pk_fp8x4(v[12], v[13], v[14], v[15]);
    const int nn = d.n0 + n;
    const int row = d.which >= 0 ? 64 * (nn >> 5) + d.which * 32 + (nn & 31) : nn;
    *(u32x4*)(d.dst + (size_t)row * d.K + d.k0 + kc * 16) = o;
  }
  __syncthreads();
}
__device__ __forceinline__ void convert_run(KP p, int stage, int jj, int j1, float* sm, int tid) {
  CvDesc d, dn;
  cvf4 a0, a1, a2, a3, b0, b1, b2, b3;
  bool cur = false;
#pragma unroll 1
  for (; jj < j1; ++jj) {
    const int job = conv_stage_job(stage, jj);
    if (!cur) {
      if (!conv_desc_fp8(p, job, d)) { convert_job(p, job, sm, tid); continue; }
      cv_load(d, tid, a0, a1, a2, a3);
    }
    bool nxt = false;
    if (jj + 1 < j1) {
      nxt = conv_desc_fp8(p, conv_stage_job(stage, jj + 1), dn);
      if (nxt) cv_load(dn, tid, b0, b1, b2, b3);
    }
    cv_emit(d, tid, a0, a1, a2, a3, sm);
    if (nxt) { d = dn; a0 = b0; a1 = b1; a2 = b2; a3 = b3; }
    cur = nxt;
  }
}

__device__ void ph_init(KP p, char* smc) {
  float* sm = (float*)smc;
  const int tid = opaque_tid();
  {
    const size_t n4a = (size_t)NL * DM / 4, n4b = (size_t)NC * DM / 4;
    const float4* xs = (const float4*)p->x;
    const float4* cs = (const float4*)p->ctx;
    float4* X4 = (float4*)p->X;
    for (size_t i = (size_t)blockIdx.x * NTHR + tid; i < n4a + n4b; i += (size_t)gridDim.x * NTHR)
      X4[i] = i < n4a ? xs[i] : cs[i - n4a];
  }
  for (int tile = blockIdx.x; tile < 96 * 8; tile += gridDim.x) {
    const int ct = tile >> 3, ks = tile & 7;
    for (int i = tid; i < 9 * 128; i += NTHR) {
      const int r = i >> 7, k = ks * 128 + (i & 127);
      const float v = r < 8 ? p->c[r * 1024 + k] : p->c_ctx[k];
      sm[i] = silu_f(v);
    }
    __syncthreads();
    const int col = ct * 256 + tid;
    const int layer = col / 6144, n = col % 6144;
    const float* W = p->ada_w + ((size_t)layer * 1024 + ks * 128) * 6144 + n;
    float acc[9];
#pragma unroll
    for (int r = 0; r < 9; ++r) acc[r] = 0.f;
#pragma unroll 4
    for (int k = 0; k < 128; ++k) {
      const float w = W[(size_t)k * 6144];
#pragma unroll
      for (int r = 0; r < 9; ++r) acc[r] = fmaf(sm[r * 128 + k], w, acc[r]);
    }
#pragma unroll
    for (int r = 0; r < 9; ++r) p->MODP[((size_t)(ks * 4 + layer) * 9 + r) * 6144 + n] = acc[r];
    __syncthreads();
  }
  {
    const int total = conv_stage_total(0), chunk = (total + gridDim.x - 1) / gridDim.x;
    const int lo = min((int)blockIdx.x * chunk, total), hi = min(lo + chunk, total);
    __syncthreads();
    convert_run(p, 0, lo, hi, sm, tid);
  }
  for (int i = blockIdx.x * NTHR + tid; i < 2 * 3 * 128 * 512; i += gridDim.x * NTHR) {
    const int k = i & 511, n = (i >> 9) & 127, wj = i >> 16;
    const int j = wj / 3, which = wj % 3;
    float v = 0.f;
    if (which < 2) {
      if (n < 64) v = (which ? p->rwkv_a1 : p->rwkv_w1)[((size_t)(j * 2 + (n >> 5)) * 512 + k) * 32 + (n & 31)];
    } else if (n < 96) v = p->rwkv_g1[((size_t)j * 512 + k) * 96 + n];
    p->Wl1[i] = f2bf(v);
  }
  for (int i = blockIdx.x * NTHR + tid; i < 2 * 2560 * 128; i += gridDim.x * NTHR) {
    const int k = i & 127, n = (i >> 7) % 2560, j = i / (2560 * 128);
    float v = 0.f;
    if (n < 2048) {
      const int d = (n >> 9) & 1, c = n & 511;
      if (k < 64 && (k >> 5) == d) v = (n < 1024 ? p->rwkv_w2 : p->rwkv_a2)[((size_t)(j * 2 + d) * 32 + (k & 31)) * 512 + c];
    } else if (k < 96) v = p->rwkv_g2[((size_t)j * 96 + k) * 512 + (n - 2048)];
    p->Wl2[i] = f2bf(v);
  }
  for (int i = blockIdx.x * NTHR + tid; i < 4 * 64 * 1024; i += gridDim.x * NTHR) {
    const int k = i & 1023, n = (i >> 10) & 63, l = i >> 16;
    p->WrT[i] = p->moe_router[((size_t)l * 1024 + k) * 64 + n];
  }
  for (int i = blockIdx.x * NTHR + tid; i < 64 * 16; i += gridDim.x * NTHR) {
    const int pos = i >> 4, f = i & 15;
    const float ang = (float)pos * powf(10000.f, -(float)f / 16.f);
    p->ROPE[2 * i] = cosf(ang);
    p->ROPE[2 * i + 1] = sinf(ang);
  }
}

__device__ void ph_mod_h(KP p, char* smc) {
  float* sm = (float*)smc;
  const int tid = opaque_tid();
  for (int i = blockIdx.x * NTHR + tid; i < 4 * 9 * 6144; i += gridDim.x * NTHR) {
    const int layer = i / (9 * 6144), rem = i % (9 * 6144), n = rem % 6144;
    float s = p->ada_b[layer * 6144 + n];
#pragma unroll
    for (int ks = 0; ks < 8; ++ks) s += p->MODP[(size_t)(ks * 4 + layer) * 9 * 6144 + rem];
    p->MOD[i] = s;
  }
  const int lane = tid & 63, wave = tid >> 6;
  const int per = (((NT + gridDim.x - 1) / gridDim.x) + 3) & ~3;
  const int t0 = blockIdx.x * per, t1 = min(NT, t0 + per);
  int cur = -1;
  for (int tb = t0; tb < t1; tb += 4) {
    const int mr = modrow(tb);
    if (mr != cur) {
      __syncthreads();
      for (int n = tid; n < 2048; n += NTHR) {
        float a = p->ada_b[n];
#pragma unroll
        for (int ks = 0; ks < 8; ++ks) a += p->MODP[((size_t)(ks * 4) * 9 + mr) * 6144 + n];
        sm[n] = a;
      }
      cur = mr;
      __syncthreads();
    }
    const int t = tb + wave;
    if (t < t1) {
      const float* src = t < NL ? p->x + (size_t)t * DM : p->ctx + (size_t)(t - NL) * DM;
#pragma unroll
      for (int i = 0; i < 4; ++i) {
        const int n = i * 256 + lane * 4;
        const float4 xv = *(const float4*)(src + n);
        const float4 sh = *(const float4*)(sm + n);
        const float4 sc = *(const float4*)(sm + 1024 + n);
        *(unsigned*)((unsigned char*)p->AB + (size_t)t * DM + n) =
            pk_fp8x4(xv.x * (1.f + sc.x) + sh.x, xv.y * (1.f + sc.y) + sh.y, xv.z * (1.f + sc.z) + sh.z, xv.w * (1.f + sc.w) + sh.w);
      }
    }
  }
}

typedef short v4i16_t __attribute__((ext_vector_type(4)));
using s16x4 = __attribute__((ext_vector_type(4))) short;
__device__ __forceinline__ s16x4 vtr(const char* p) {
  return __builtin_bit_cast(s16x4, __builtin_amdgcn_ds_read_tr16_b64_v4i16((__attribute__((address_space(3))) v4i16_t*)p));
}
#define MFMA32(a, b, c) __builtin_amdgcn_mfma_f32_32x32x16_bf16(a, b, c, 0, 0, 0)
__device__ void ph_attention(KP p, int layer, bool keep, char* lds) {
  const int tid = opaque_tid();
  const int lane = tid & 63, w = tid >> 6, r32 = lane & 31, hi = lane >> 5;
  const int j = layer >> 1;
  float* bias_lds = (float*)(lds + 32768 + 1024);
  const int n_gqa = 1024, n_na = 1024, n_cb = keep ? 128 : 0, n_ca = keep ? 128 : 0;
  const int total = n_gqa + n_na + n_cb + n_ca;
  constexpr float LOG2E = 1.4426950408889634f;
  constexpr float C2 = 0.125f * LOG2E;
  const int c = tid & 7, sr = tid >> 3;
  const int kso = (c ^ ((tid >> 4) & 7)) * 16;
  const int vso = (c >> 2) * 4096 + (c & 3) * 16;
  const int sw = (r32 >> 1) & 7;
  for (int vitem = blockIdx.x; vitem < total; vitem += gridDim.x) {
    int item = vitem;
    if (gridDim.x == 512) {
      const int cls0 = vitem < n_gqa ? 0 : (vitem < n_gqa + n_na ? n_gqa : (vitem < n_gqa + n_na + n_cb ? n_gqa + n_na : n_gqa + n_na + n_cb));
      const int vl = vitem - cls0, b9 = vl & 511, r9 = vl >> 9;
      item = cls0 + (cls0 < n_gqa + n_na ? 128 * (b9 & 7) + 64 * r9 + (b9 >> 3) : 16 * (b9 & 7) + (b9 >> 3));
    }
    int b, qrow0, qoff, koff, voff, ocol, lat_tiles, lat_row0;
    bool na = false;
    int r_w = 0, start_w = 0, ru0 = 0, hN = 0;
    if (item < n_gqa) {
      b = item >> 7;
      const int g = (item >> 6) & 1, tt = item & 63;
      qrow0 = b * SEQ + tt * 32; qoff = 1536 + (g * 4 + w) * 64; koff = 2048 + g * 64; voff = 2176 + g * 64;
      ocol = 512 + (g * 4 + w) * 64; lat_tiles = 32; lat_row0 = b * SEQ;
    } else if (item < n_gqa + n_na) {
      const int it = item - n_gqa;
      b = it >> 7; hN = (it >> 4) & 7;
      const int rp = it & 15;
      na = true; r_w = 2 * rp + (w >> 1);
      qrow0 = b * SEQ + r_w * 64 + (w & 1) * 32; qoff = hN * 64; koff = 512 + hN * 64; voff = 1024 + hN * 64; ocol = hN * 64;
      const int s0 = min(max(2 * rp - 4, 0), 24), s1 = min(max(2 * rp - 3, 0), 24);
      start_w = (w >> 1) ? s1 : s0; ru0 = s0; lat_tiles = (s1 != s0) ? 9 : 8; lat_row0 = b * SEQ + ru0 * 64;
    } else if (item < n_gqa + n_na + n_cb) {
      const int it = item - n_gqa - n_na;
      b = it >> 4;
      const int g = (it >> 3) & 1, tt = it & 7;
      qrow0 = NL + b * CTXL + tt * 32; qoff = 1536 + (g * 4 + w) * 64; koff = 2048 + g * 64; voff = 2176 + g * 64;
      ocol = 512 + (g * 4 + w) * 64; lat_tiles = 0; lat_row0 = 0;
    } else {
      const int it = item - n_gqa - n_na - n_cb;
      b = it >> 4;
      const int h = (it >> 1) & 7, half = it & 1;
      qrow0 = NL + b * CTXL + half * 128 + w * 32; qoff = h * 64; koff = 512 + h * 64; voff = 1024 + h * 64; ocol = h * 64;
      lat_tiles = 0; lat_row0 = 0;
    }
    const int ctx_row0 = NL + b * CTXL, ntiles = lat_tiles + 4;
    if (na)
      for (int i = tid; i < 465; i += NTHR) bias_lds[i] = p->na_rpb[(j * 8 + hN) * 465 + i] * LOG2E;
    bf16x8 qf[4];
    {
      const bf16_t* qp = p->P + (size_t)(qrow0 + r32) * LDP + qoff + hi * 8;
#pragma unroll
      for (int d0 = 0; d0 < 4; ++d0) qf[d0] = *(const bf16x8*)(qp + d0 * 16);
    }
    f32x16 o0, o1;
#pragma unroll
    for (int q = 0; q < 16; ++q) { o0[q] = 0.f; o1[q] = 0.f; }
    float m = -INFINITY, l = 0.f;
    u32x4 kr0, kr1, vr0, vr1;
    auto gload = [&](int t) {
      const int row0 = t < lat_tiles ? lat_row0 + 64 * t : ctx_row0 + 64 * (t - lat_tiles);
      const bf16_t* base = p->P + (size_t)(row0 + sr) * LDP + c * 8;
      kr0 = *(const u32x4*)(base + koff); kr1 = *(const u32x4*)(base + (size_t)32 * LDP + koff);
      vr0 = *(const u32x4*)(base + voff); vr1 = *(const u32x4*)(base + (size_t)32 * LDP + voff);
    };
    auto swrite = [&](int buf) {
      char* Kb = lds + buf * 16384;
      char* Vb = Kb + 8192;
      *(u32x4*)(Kb + sr * 128 + kso) = kr0; *(u32x4*)(Kb + (sr + 32) * 128 + kso) = kr1;
      *(u32x4*)(Vb + vso + sr * 64) = vr0; *(u32x4*)(Vb + vso + (sr + 32) * 64) = vr1;
    };
    gload(0);
    swrite(0);
    for (int t = 0; t < ntiles; ++t) {
      __syncthreads();
      if (t + 1 < ntiles) gload(t + 1);
      const bool na_tile = na && t < lat_tiles;
      const int kr = ru0 + t;
      const bool part = !na_tile || (kr >= start_w && kr < start_w + 8);
      if (part) {
        const char* Ks = lds + (t & 1) * 16384;
        const char* Vs = Ks + 8192;
        f32x16 s0, s1;
#pragma unroll
        for (int q = 0; q < 16; ++q) { s0[q] = 0.f; s1[q] = 0.f; }
#pragma unroll
        for (int d0 = 0; d0 < 4; ++d0) {
          const int off = ((2 * d0 + hi) ^ sw) * 16;
          const bf16x8 k0 = *(const bf16x8*)(Ks + r32 * 128 + off);
          const bf16x8 k1 = *(const bf16x8*)(Ks + (32 + r32) * 128 + off);
          s0 = MFMA32(k0, qf[d0], s0);
          s1 = MFMA32(k1, qf[d0], s1);
        }
        float mx = -INFINITY;
        if (na_tile) {
          const int cq = (w & 1) * 32 + r32;
          const int c0 = min(max(cq - 8, 0), 48);
          const float* brow = bias_lds + (kr - r_w + 7) * 31 + (15 - cq);
#pragma unroll
          for (int q = 0; q < 16; ++q) {
            const int kc = (q & 3) + 8 * (q >> 2) + 4 * hi;
            const float v0 = ((unsigned)(kc - c0) < 16u) ? fmaf(s0[q], C2, brow[kc]) : -INFINITY;
            const float v1 = ((unsigned)(kc + 32 - c0) < 16u) ? fmaf(s1[q], C2, brow[kc + 32]) : -INFINITY;
            s0[q] = v0; s1[q] = v1;
            mx = fmaxf(mx, fmaxf(v0, v1));
          }
        } else {
#pragma unroll
          for (int q = 0; q < 16; ++q) {
            s0[q] *= C2; s1[q] *= C2;
            mx = fmaxf(mx, fmaxf(s0[q], s1[q]));
          }
        }
        {
          auto rr = __builtin_amdgcn_permlane32_swap(__float_as_uint(mx), __float_as_uint(mx), false, false);
          mx = fmaxf(__uint_as_float(rr[0]), __uint_as_float(rr[1]));
        }
        const float mnew = fmaxf(m, mx);
        const float alpha = __builtin_amdgcn_exp2f(m - mnew);
        float ls = 0.f;
#pragma unroll
        for (int q = 0; q < 16; ++q) {
          s0[q] = __builtin_amdgcn_exp2f(s0[q] - mnew);
          s1[q] = __builtin_amdgcn_exp2f(s1[q] - mnew);
          ls += s0[q] + s1[q];
        }
        l = l * alpha + ls;
        m = mnew;
#pragma unroll
        for (int q = 0; q < 16; ++q) { o0[q] *= alpha; o1[q] *= alpha; }
        bf16x8 pf[4];
#pragma unroll
        for (int s = 0; s < 4; ++s) {
          const int u = (s & 1) * 8;
          u32x4 tpk;
          if (s < 2) {
            tpk.x = pk_bf16(s0[u + 0], s0[u + 1]); tpk.y = pk_bf16(s0[u + 2], s0[u + 3]);
            tpk.z = pk_bf16(s0[u + 4], s0[u + 5]); tpk.w = pk_bf16(s0[u + 6], s0[u + 7]);
          } else {
            tpk.x = pk_bf16(s1[u + 0], s1[u + 1]); tpk.y = pk_bf16(s1[u + 2], s1[u + 3]);
            tpk.z = pk_bf16(s1[u + 4], s1[u + 5]); tpk.w = pk_bf16(s1[u + 6], s1[u + 7]);
          }
          pf[s] = __builtin_bit_cast(bf16x8, tpk);
        }
        const char* vb = Vs + ((lane >> 4) & 1) * 32 + (lane & 3) * 8 + ((lane & 15) >> 2) * 64 + hi * 256;
#pragma unroll
        for (int s = 0; s < 4; ++s) {
          const s16x4 a00 = vtr(vb + (16 * s) * 64), a01 = vtr(vb + (16 * s + 8) * 64);
          const s16x4 a10 = vtr(vb + 4096 + (16 * s) * 64), a11 = vtr(vb + 4096 + (16 * s + 8) * 64);
          const bf16x8 A0 = __builtin_shufflevector(a00, a01, 0, 1, 2, 3, 4, 5, 6, 7);
          const bf16x8 A1 = __builtin_shufflevector(a10, a11, 0, 1, 2, 3, 4, 5, 6, 7);
          o0 = MFMA32(A0, pf[s], o0);
          o1 = MFMA32(A1, pf[s], o1);
        }
      }
      if (t + 1 < ntiles) swrite((t + 1) & 1);
    }
    __syncthreads();
    const float lt = l + __shfl_xor(l, 32);
    const float inv = 1.f / lt;
    unsigned char* op = (unsigned char*)p->AB + (size_t)(qrow0 + r32) * DM + ocol + 4 * hi;
#pragma unroll
    for (int g = 0; g < 4; ++g) {
      *(unsigned*)(op + 8 * g) = pk_fp8x4c(o0[4 * g] * inv, o0[4 * g + 1] * inv, o0[4 * g + 2] * inv, o0[4 * g + 3] * inv);
      *(unsigned*)(op + 32 + 8 * g) = pk_fp8x4c(o1[4 * g] * inv, o1[4 * g + 1] * inv, o1[4 * g + 2] * inv, o1[4 * g + 3] * inv);
    }
  }
}

__device__ void ph_rwkv_mix(KP p, int layer) {
  const int j = layer >> 1;
  const int tid = opaque_tid();
  const int lane = tid & 63, wave = tid >> 6;
  const float* mu = p->rwkv_mu + j * 6 * 512;
  const int c0 = lane * 8;
  auto unpack = [](const u32x4 u, float (&f)[8]) {
    f[0] = bflo(u.x); f[1] = bfhi(u.x); f[2] = bflo(u.y); f[3] = bfhi(u.y);
    f[4] = bflo(u.z); f[5] = bfhi(u.z); f[6] = bflo(u.w); f[7] = bfhi(u.w);
  };
  auto pack = [](const float (&f)[8]) {
    u32x4 o;
    o.x = pk_bf16(f[0], f[1]); o.y = pk_bf16(f[2], f[3]); o.z = pk_bf16(f[4], f[5]); o.w = pk_bf16(f[6], f[7]);
    return o;
  };
  for (int t = blockIdx.x * 4 + wave; t < NT; t += gridDim.x * 4) {
    bool hasp, hasn;
    if (t < NL) { int s = t & 2047; hasp = s > 0; hasn = s < SEQ - 1; }
    else { int s = (t - NL) & 255; hasp = s > 0; hasn = s < CTXL - 1; }
    const bf16_t* pt = p->P + (size_t)t * LDP + c0;
    bf16_t* rw = p->RW + (size_t)t * RWS + c0;
    bf16_t* zb = p->Zb + (size_t)t * 1536 + c0;
    const u32x4 zero = {0u, 0u, 0u, 0u};
#pragma unroll
    for (int q = 0; q < 4; ++q) {
      float cur[8], pv[8], nx[8], d[8];
      unpack(*(const u32x4*)(pt + q * 512), cur);
      unpack(hasp ? *(const u32x4*)(pt + q * 512 - LDP) : zero, pv);
      unpack(hasn ? *(const u32x4*)(pt + q * 512 + LDP) : zero, nx);
#pragma unroll
      for (int e = 0; e < 8; ++e) d[e] = 0.5f * (pv[e] + nx[e]) - cur[e];
      if (q < 3) {
        float o[8];
        const float* m = mu + q * 512 + c0;
#pragma unroll
        for (int e = 0; e < 8; ++e) o[e] = cur[e] + d[e] * m[e];
        if (q == 0) *(u32x4*)(rw) = pack(o);
        else if (q == 2) *(u32x4*)(rw + 512) = pack(o);
        else {
          *(u32x4*)(rw + 10 * 512) = pack(o);
          float kk[8], ss = 0.f;
          const float* kv0 = p->rwkv_kvec + (j * 2 + 0) * 512 + c0;
#pragma unroll
          for (int e = 0; e < 8; ++e) { kk[e] = o[e] * kv0[e]; ss += kk[e] * kk[e]; }
          ss += dppx<0xB1>(ss); ss += dppx<0x4E>(ss); ss += dppx<0x141>(ss);
          const float rn = rsqrtf(fmaxf(ss, 1e-24f));
#pragma unroll
          for (int e = 0; e < 8; ++e) kk[e] *= rn;
          *(u32x4*)(rw + 2 * 512) = pack(kk);
        }
      } else {
#pragma unroll
        for (int z = 0; z < 3; ++z) {
          float o[8];
          const float* m = mu + (3 + z) * 512 + c0;
#pragma unroll
          for (int e = 0; e < 8; ++e) o[e] = cur[e] + d[e] * m[e];
          *(u32x4*)(zb + z * 512) = pack(o);
        }
      }
    }
  }
}

constexpr int RS_STEP = 384;
constexpr int RS_TB = 16;
struct RwkvStage { u32x2 r, kk, e, ke, a, v; };
__device__ void rwkv_unit(KP p, int unit, float* sm, int tid) {
  const int ch = unit >> 1, hf = unit & 1;
  const int dir = ch >> 6, b = (ch >> 3) & 7, h = ch & 7;
  const int lane = tid & 63, w = tid >> 6, rl = lane >> 3, ks = lane & 7;
  float* ybuf = sm + 2 * RS_TB * RS_STEP;
  const int ss = tid >> 4, kq = tid & 15;
  auto gload = [&](int n, RwkvStage& g) {
    const int row = scan_row(dir, b, n * RS_TB + ss);
    const bf16_t* base = p->RW + (size_t)row * RWS + h * 64 + kq * 4;
    g.r = *(const u32x2*)(base);
    g.kk = *(const u32x2*)(base + 2 * 512);
    g.e = *(const u32x2*)(base + (3 + dir) * 512);
    g.ke = *(const u32x2*)(base + (5 + dir) * 512);
    g.a = *(const u32x2*)(base + (7 + dir) * 512);
    g.v = *(const u32x2*)(p->RW + (size_t)row * RWS + 512 + h * 64 + hf * 32 + (kq & 7) * 4);
  };
  auto swrite = [&](int buf, const RwkvStage& g) {
    float* sp = sm + (buf * RS_TB + ss) * RS_STEP;
    const float r0 = bflo(g.r.x), r1 = bfhi(g.r.x), r2 = bflo(g.r.y), r3 = bfhi(g.r.y);
    const float k0 = bflo(g.kk.x), k1 = bfhi(g.kk.x), k2 = bflo(g.kk.y), k3 = bfhi(g.kk.y);
    const float w0 = __expf(-bflo(g.e.x)), w1 = __expf(-bfhi(g.e.x)), w2 = __expf(-bflo(g.e.y)), w3 = __expf(-bfhi(g.e.y));
    const float e0 = bflo(g.ke.x), e1 = bfhi(g.ke.x), e2 = bflo(g.ke.y), e3 = bfhi(g.ke.y);
    const float a0 = k0 * bflo(g.a.x), a1 = k1 * bfhi(g.a.x), a2 = k2 * bflo(g.a.y), a3 = k3 * bfhi(g.a.y);
    *(float4*)(sp + kq * 4) = make_float4(k0, k1, k2, k3);
    *(float4*)(sp + 64 + kq * 4) = make_float4(w0 * r0, w1 * r1, w2 * r2, w3 * r3);
    *(float4*)(sp + 128 + kq * 4) = make_float4(w0, w1, w2, w3);
    *(float4*)(sp + 192 + kq * 4) = make_float4(a0, a1, a2, a3);
    *(float4*)(sp + 256 + kq * 4) = make_float4(e0, e1, e2, e3);
    if (kq < 8) *(float4*)(sp + 320 + kq * 4) = make_float4(bflo(g.v.x), bfhi(g.v.x), bflo(g.v.y), bfhi(g.v.y));
    float c1 = a0 * r0 + a1 * r1 + a2 * r2 + a3 * r3;
    float c2 = e0 * r0 + e1 * r1 + e2 * r2 + e3 * r3;
    c1 += dppx<0xB1>(c1); c2 += dppx<0xB1>(c2);
    c1 += dppx<0x4E>(c1); c2 += dppx<0x4E>(c2);
    c1 += dppx<0x141>(c1); c2 += dppx<0x141>(c2);
    c1 += dppx<0x140>(c1); c2 += dppx<0x140>(c2);
    if (kq == 0) { sp[352] = c1; sp[353] = c2; }
  };
  typedef float f2 __attribute__((ext_vector_type(2)));
  f2 S01 = {0.f, 0.f}, S23 = {0.f, 0.f}, S45 = {0.f, 0.f}, S67 = {0.f, 0.f};
  auto compute = [&](int n) {
    const float* bp = sm + (n & 1) * RS_TB * RS_STEP;
    float* yb = ybuf + (n & 1) * RS_TB * 32 + w * 8 + rl;
    struct Ops { f2 k[4], r[4], w[4], a[4], e[4]; float vv; f2 c; };
    auto ld = [&](int s, Ops& o) {
      const float* sq = bp + s * RS_STEP;
      const f2* sp = (const f2*)(sq + ks * 8);
#pragma unroll
      for (int i = 0; i < 4; ++i) { o.k[i] = sp[i]; o.r[i] = sp[32 + i]; o.w[i] = sp[64 + i]; o.a[i] = sp[96 + i]; o.e[i] = sp[128 + i]; }
      o.vv = sq[320 + w * 8 + rl]; o.c = *(const f2*)(sq + 352);
    };
    auto step = [&](const Ops& o) -> float {
      f2 sa2 = S01 * o.k[0];
      f2 y2 = S01 * o.r[0];
      sa2 = __builtin_elementwise_fma(S23, o.k[1], sa2); y2 = __builtin_elementwise_fma(S23, o.r[1], y2);
      sa2 = __builtin_elementwise_fma(S45, o.k[2], sa2); y2 = __builtin_elementwise_fma(S45, o.r[2], y2);
      sa2 = __builtin_elementwise_fma(S67, o.k[3], sa2); y2 = __builtin_elementwise_fma(S67, o.r[3], y2);
      float sa = sa2.x + sa2.y, y0 = y2.x + y2.y;
      sa += dppx<0xB1>(sa); y0 += dppx<0xB1>(y0);
      sa += dppx<0x4E>(sa); y0 += dppx<0x4E>(y0);
      sa += dppx<0x141>(sa); y0 += dppx<0x141>(y0);
      sa = -sa;
      const f2 sav = {sa, sa}, vvv = {o.vv, o.vv};
      S01 = __builtin_elementwise_fma(vvv, o.e[0], __builtin_elementwise_fma(sav, o.a[0], S01 * o.w[0]));
      S23 = __builtin_elementwise_fma(vvv, o.e[1], __builtin_elementwise_fma(sav, o.a[1], S23 * o.w[1]));
      S45 = __builtin_elementwise_fma(vvv, o.e[2], __builtin_elementwise_fma(sav, o.a[2], S45 * o.w[2]));
      S67 = __builtin_elementwise_fma(vvv, o.e[3], __builtin_elementwise_fma(sav, o.a[3], S67 * o.w[3]));
      return fmaf(o.vv, o.c.y, fmaf(sa, o.c.x, y0));
    };
    Ops oa, ob;
    ld(0, oa);
#pragma unroll 1
    for (int s = 0; s < RS_TB; s += 2) {
      __builtin_amdgcn_sched_barrier(0);
      ld(s + 1, ob);
      __builtin_amdgcn_sched_barrier(0);
      float y0 = step(oa);
      asm volatile("" : "+v"(y0));
      __builtin_amdgcn_sched_barrier(0);
      ld(s + 2, oa);
      __builtin_amdgcn_sched_barrier(0);
      float y1 = step(ob);
      asm volatile("" : "+v"(y1));
      __builtin_amdgcn_sched_barrier(0);
      if (ks == 0) { yb[s * 32] = y0; yb[(s + 1) * 32] = y1; }
    }
  };
  auto yout = [&](int n) {
    const int row = scan_row(dir, b, n * RS_TB + ss);
    const float* ys = ybuf + (n & 1) * RS_TB * 32 + ss * 32 + kq * 2;
    *(unsigned*)(p->P + (size_t)row * LDP + dir * 512 + h * 64 + hf * 32 + kq * 2) = pk_bf16(ys[0], ys[1]);
  };
  constexpr int NB = TSC / RS_TB;
  RwkvStage gA, gB;
  gload(0, gA);
  gload(1, gB);
  swrite(0, gA);
  gload(2, gA);
  __syncthreads();
  for (int n = 0; n < NB; n += 2) {
    compute(n);
    swrite(1, gB);
    if (n + 3 < NB) gload(n + 3, gB);
    __syncthreads();
    yout(n);
    compute(n + 1);
    if (n + 2 < NB) swrite(0, gA);
    if (n + 4 < NB) gload(n + 4, gA);
    __syncthreads();
    yout(n + 1);
  }
  __syncthreads();
}

__device__ void mlstm_s1(KP p, int layer, int tile, char* lds, int tid) {
  const int j = layer >> 1;
  const int ch = tile / NCHUNK, c = tile % NCHUNK;
  const int dir = ch >> 5, b = (ch >> 2) & 7, h = ch & 3;
  float* s_ws = (float*)(lds + META_OFF);
  int* s_row = (int*)(s_ws + 64);
  char* kimg = lds;
  char* vimg = lds + 16384;
  if (tid < 64) {
    const int row = scan_row(dir, b, c * 64 + tid);
    s_row[tid] = row;
    const float* g = p->GP + (size_t)row * 16;
    const float gi = g[(dir * 2) * 4 + h] + p->mlstm_gate_b[j * 16 + (dir * 2) * 4 + h];
    const float gf = g[(dir * 2 + 1) * 4 + h] + p->mlstm_gate_b[j * 16 + (dir * 2 + 1) * 4 + h];
    float bc = -softplus_f(-gf);
#pragma unroll
    for (int o = 1; o < 64; o <<= 1) {
      float tmp = __shfl_up(bc, o);
      if (tid >= o) bc += tmp;
    }
    const float bend = __shfl(bc, 63);
    const float ds = bend - bc + gi;
    const float mloc = wmax(ds);
    s_ws[tid] = expf(ds - mloc);
    if (tid == 0) { p->msc[tile] = mloc; p->msc[NMT + tile] = bend; }
  }
  __syncthreads();
  {
    const int c8 = tid & 15;
    const int ioff = (c8 >> 2) * 4096 + (c8 & 3) * 16;
#pragma unroll
    for (int i = 0; i < 4; ++i) {
      const int sidx = (tid >> 4) + 16 * i;
      const bf16_t* src = p->P + (size_t)s_row[sidx] * LDP + h * 128 + c8 * 8;
      const u32x4 kv = *(const u32x4*)(src + 2560);
      u32x4 vv = *(const u32x4*)(src + 3072);
      const float wsv = s_ws[sidx];
      vv.x = pk_bf16(bflo(vv.x) * wsv, bfhi(vv.x) * wsv); vv.y = pk_bf16(bflo(vv.y) * wsv, bfhi(vv.y) * wsv);
      vv.z = pk_bf16(bflo(vv.z) * wsv, bfhi(vv.z) * wsv); vv.w = pk_bf16(bflo(vv.w) * wsv, bfhi(vv.w) * wsv);
      *(u32x4*)(kimg + ioff + sidx * 64) = kv;
      *(u32x4*)(vimg + ioff + sidx * 64) = vv;
    }
  }
  __syncthreads();
  const int lane = tid & 63, w = tid >> 6, wm = w >> 1, wn = w & 1, r32 = lane & 31, hi = lane >> 5;
  f32x16 acc[2][2];
#pragma unroll
  for (int mi = 0; mi < 2; ++mi)
#pragma unroll
    for (int ni = 0; ni < 2; ++ni)
#pragma unroll
      for (int q = 0; q < 16; ++q) acc[mi][ni][q] = 0.f;
  const int toff = ((lane >> 4) & 1) * 32 + (lane & 3) * 8 + ((lane & 15) >> 2) * 64 + hi * 256;
#pragma unroll
  for (int ks = 0; ks < 4; ++ks) {
    bf16x8 af[2], bfr[2];
#pragma unroll
    for (int i = 0; i < 2; ++i) {
      const char* ka = kimg + (wm * 2 + i) * 4096 + toff + (16 * ks) * 64;
      const char* va = vimg + (wn * 2 + i) * 4096 + toff + (16 * ks) * 64;
      af[i] = __builtin_shufflevector(vtr(ka), vtr(ka + 8 * 64), 0, 1, 2, 3, 4, 5, 6, 7);
      bfr[i] = __builtin_shufflevector(vtr(va), vtr(va + 8 * 64), 0, 1, 2, 3, 4, 5, 6, 7);
    }
    acc[0][0] = MFMA32(af[0], bfr[0], acc[0][0]);
    acc[0][1] = MFMA32(af[0], bfr[1], acc[0][1]);
    acc[1][0] = MFMA32(af[1], bfr[0], acc[1][0]);
    acc[1][1] = MFMA32(af[1], bfr[1], acc[1][1]);
  }
  bf16_t* ust = (bf16_t*)(lds + 32768);
#pragma unroll
  for (int mi = 0; mi < 2; ++mi)
#pragma unroll
    for (int ni = 0; ni < 2; ++ni)
#pragma unroll
      for (int q = 0; q < 16; ++q) {
        const int d = wm * 64 + mi * 32 + (q & 3) + 8 * (q >> 2) + 4 * hi;
        ust[d * 128 + wn * 64 + ni * 32 + r32] = f2bf(acc[mi][ni][q]);
        if ((q & 3) == 3) __builtin_amdgcn_sched_barrier(0);
      }
  __syncthreads();
  {
    const u32x4* us4 = (const u32x4*)ust;
    u32x4* U4 = (u32x4*)(p->MS + (size_t)tile * 16384);
#pragma unroll
    for (int i = 0; i < 8; ++i) U4[tid + 256 * i] = us4[tid + 256 * i];
  }
  if (tid < 128) {
    const char* kc = kimg + (tid >> 5) * 4096 + (tid & 31) * 2;
    float a = 0.f;
#pragma unroll 8
    for (int sidx = 0; sidx < 64; ++sidx) a = fmaf(s_ws[sidx], bf2f(*(const bf16_t*)(kc + sidx * 64)), a);
    p->MSn[tile * 128 + tid] = a;
  }
}

__device__ void mlstm_s3(KP p, int layer, int tile, char* lds, int tid);
__device__ void ph_scan_a(KP p, int layer, char* smc) {
  float* sm = (float*)smc;
  const int tid = opaque_tid();
  __builtin_amdgcn_s_setprio(3);
  for (int u = blockIdx.x; u < 256; u += gridDim.x) rwkv_unit(p, u, sm, tid);
  __builtin_amdgcn_s_setprio(0);
  {
    const int stage = layer == 1 ? 1 : 2;
    const int nconv = conv_stage_total(stage);
    const int total = NMT + (nconv + 7) / 8;
    int* qc = (int*)(p->bar + XCD_BAR_WORDS + 16 * stage);
    int* s_q = (int*)(smc + META_OFF + 3968);
    int jj = 0, j1 = 0;
#pragma unroll 1
    for (;;) {
      if (jj >= j1) {
        __syncthreads();
        if (tid == 0) *s_q = atomicAdd(qc, 1);
        __syncthreads();
        const int q = *s_q;
        if (q >= total) break;
        if (q < NMT) { mlstm_s3(p, layer, q, smc, tid); continue; }
        jj = (q - NMT) * 8; j1 = min(jj + 8, nconv);
      }
      convert_run(p, stage, jj, j1, sm, tid);
      jj = j1;
    }
  }
}

__device__ void ph_mlstm_s2(KP p, char* smc) {
  float* sw = (float*)smc;
  const int tid = opaque_tid();
  const int nitems = 64 * 33;
  for (int item = blockIdx.x; item < nitems; item += gridDim.x) {
    const int ch = item / 33, seg = item % 33;
    __syncthreads();
    if (tid < 2 * NCHUNK) sw[72 + tid] = p->msc[(tid < NCHUNK ? 0 : NMT - NCHUNK) + ch * NCHUNK + tid];
    __syncthreads();
    if (tid == 0) {
      float m = 0.f;
      for (int c = 0; c < NCHUNK; ++c) {
        const int tile = ch * NCHUNK + c;
        const float mloc = sw[72 + c], bend = sw[72 + NCHUNK + c];
        const float mn = fmaxf(bend + m, mloc);
        sw[c] = expf(bend + m - mn);
        sw[36 + c] = expf(mloc - mn);
        if (seg == 0) p->msc[2 * NMT + tile] = m;
        m = mn;
      }
    }
    __syncthreads();
    if (seg < 32) {
      unsigned* base = (unsigned*)(p->MS + (size_t)ch * NCHUNK * 16384) + seg * 256 + tid;
      unsigned v[NCHUNK];
#pragma unroll
      for (int c = 0; c < NCHUNK; ++c) v[c] = base[(size_t)c * 8192];
      float C0 = 0.f, C1 = 0.f;
#pragma unroll
      for (int c = 0; c < NCHUNK; ++c) {
        const float t0 = bflo(v[c]), t1 = bfhi(v[c]);
        v[c] = pk_bf16(C0, C1);
        C0 = sw[c] * C0 + sw[36 + c] * t0;
        C1 = sw[c] * C1 + sw[36 + c] * t1;
      }
#pragma unroll
      for (int c = 0; c < NCHUNK; ++c) base[(size_t)c * 8192] = v[c];
    } else if (tid < 128) {
      float* base = p->MSn + (size_t)ch * NCHUNK * 128 + tid;
      float v[NCHUNK];
#pragma unroll
      for (int c = 0; c < NCHUNK; ++c) v[c] = base[c * 128];
      float C = 0.f;
#pragma unroll
      for (int c = 0; c < NCHUNK; ++c) {
        const float t0 = v[c];
        v[c] = C;
        C = sw[c] * C + sw[36 + c] * t0;
      }
#pragma unroll
      for (int c = 0; c < NCHUNK; ++c) base[c * 128] = v[c];
    }
  }
}

__device__ void mlstm_s3(KP p, int layer, int tile, char* lds, int tid) {
  const int j = layer >> 1;
  const int ch = tile / NCHUNK, c = tile % NCHUNK;
  const int dir = ch >> 5, b = (ch >> 2) & 7, h = ch & 3;
  float* s_b = (float*)(lds + META_OFF);
  float* s_ig = s_b + 64;
  float* s_mt = s_b + 128;
  float* s_wi = s_b + 192;
  int* s_row = (int*)(s_b + 256);
  float* s_n = s_b + 320;
  float* s_c = s_b + 448;
  char* kimg = lds;
  char* vimg = lds + 16384;
  char* cimg = lds + 32768;
  const float mprev = p->msc[2 * NMT + tile];
  const float qscale = 0.08838834764831845f;
  const int lane = tid & 63, w = tid >> 6, wt = w >> 1, wv = w & 1, r32 = lane & 31, hi = lane >> 5;
  const int t = wt * 32 + r32;
  const int rowq = scan_row(dir, b, c * 64 + t);
  const int c8 = tid & 15;
  u32x4 kr[4], vr[4], cr[8];
#pragma unroll
  for (int i = 0; i < 4; ++i) {
    const int sidx = (tid >> 4) + 16 * i;
    const bf16_t* src = p->P + (size_t)scan_row(dir, b, c * 64 + sidx) * LDP + h * 128 + c8 * 8;
    kr[i] = *(const u32x4*)(src + 2560);
    vr[i] = *(const u32x4*)(src + 3072);
  }
  {
    const bf16_t* Cp = p->MS + (size_t)tile * 16384;
#pragma unroll
    for (int i = 0; i < 8; ++i) cr[i] = *(const u32x4*)(Cp + ((tid >> 4) + 16 * i) * 128 + c8 * 8);
  }
  bf16x8 qf[8];
  {
    const bf16_t* qp = p->P + (size_t)rowq * LDP + 2048 + h * 128 + hi * 8;
#pragma unroll
    for (int d0 = 0; d0 < 8; ++d0) qf[d0] = *(const bf16x8*)(qp + d0 * 16);
  }
  if (tid < 64) {
    const int row = scan_row(dir, b, c * 64 + tid);
    s_row[tid] = row;
    const float* g = p->GP + (size_t)row * 16;
    const float gi = g[(dir * 2) * 4 + h] + p->mlstm_gate_b[j * 16 + (dir * 2) * 4 + h];
    const float gf = g[(dir * 2 + 1) * 4 + h] + p->mlstm_gate_b[j * 16 + (dir * 2 + 1) * 4 + h];
    float bc = -softplus_f(-gf);
#pragma unroll
    for (int o = 1; o < 64; o <<= 1) {
      float tmp = __shfl_up(bc, o);
      if (tid >= o) bc += tmp;
    }
    float pm = gi - bc;
#pragma unroll
    for (int o = 1; o < 64; o <<= 1) {
      float tmp = __shfl_up(pm, o);
      if (tid >= o) pm = fmaxf(pm, tmp);
    }
    const float mt = bc + fmaxf(mprev, pm);
    s_b[tid] = bc;
    s_ig[tid] = gi;
    s_mt[tid] = mt;
    s_wi[tid] = expf(bc + mprev - mt);
    s_c[tid] = (gi - bc) * 1.4426950408889634f;
  } else if (tid < 192) s_n[tid - 64] = p->MSn[tile * 128 + (tid - 64)];
  {
    const int ioff = (c8 >> 2) * 4096 + (c8 & 3) * 16;
#pragma unroll
    for (int i = 0; i < 4; ++i) {
      const int sidx = (tid >> 4) + 16 * i;
      *(u32x4*)(kimg + sidx * 256 + ((c8 ^ (sidx & 15)) * 16)) = kr[i];
      *(u32x4*)(vimg + ioff + sidx * 64) = vr[i];
    }
    const int coff = (c8 >> 2) * 8192 + (c8 & 3) * 16;
#pragma unroll
    for (int i = 0; i < 8; ++i) *(u32x4*)(cimg + coff + ((tid >> 4) + 16 * i) * 64) = cr[i];
  }
  __syncthreads();
  const int toff = ((lane >> 4) & 1) * 32 + (lane & 3) * 8 + ((lane & 15) >> 2) * 64;
  constexpr float LOG2E_ = 1.4426950408889634f;
  float qn = 0.f;
#pragma unroll
  for (int d0 = 0; d0 < 8; ++d0) {
    const u32x4 qq = __builtin_bit_cast(u32x4, qf[d0]);
    const float* np = s_n + d0 * 16 + hi * 8;
    qn = fmaf(bflo(qq.x), np[0], qn); qn = fmaf(bfhi(qq.x), np[1], qn);
    qn = fmaf(bflo(qq.y), np[2], qn); qn = fmaf(bfhi(qq.y), np[3], qn);
    qn = fmaf(bflo(qq.z), np[4], qn); qn = fmaf(bfhi(qq.z), np[5], qn);
    qn = fmaf(bflo(qq.w), np[6], qn); qn = fmaf(bfhi(qq.w), np[7], qn);
  }
  qn += __shfl_xor(qn, 32);
  const float mtt = s_mt[t], wi = s_wi[t];
  const float ct = (s_b[t] - mtt) * LOG2E_;
  const float wq = wi * qscale;
  bf16x8 pf[4];
  float den = 0.f;
  {
    f32x16 sa0, sa1;
#pragma unroll
    for (int q = 0; q < 16; ++q) { sa0[q] = 0.f; sa1[q] = 0.f; }
#pragma unroll
    for (int d0 = 0; d0 < 8; ++d0) {
      const int chn = 2 * d0 + hi;
      const bf16x8 k0 = *(const bf16x8*)(kimg + r32 * 256 + ((chn ^ (r32 & 15)) * 16));
      sa0 = MFMA32(k0, qf[d0], sa0);
      if (wt) {
        const bf16x8 k1 = *(const bf16x8*)(kimg + (32 + r32) * 256 + ((chn ^ (r32 & 15)) * 16));
        sa1 = MFMA32(k1, qf[d0], sa1);
      }
      __builtin_amdgcn_sched_barrier(0);
    }
#pragma unroll
    for (int g = 0; g < 4; ++g) {
      const int sb0 = 8 * g + 4 * hi;
      const float4 c0v = *(const float4*)(s_c + sb0);
      const float4 c1v = *(const float4*)(s_c + sb0 + 32);
      const float cc0[4] = {c0v.x, c0v.y, c0v.z, c0v.w}, cc1[4] = {c1v.x, c1v.y, c1v.z, c1v.w};
#pragma unroll
      for (int e = 0; e < 4; ++e) {
        const int q = 4 * g + e;
        const float v0 = (sb0 + e <= t) ? sa0[q] * qscale * __builtin_amdgcn_exp2f(ct + cc0[e]) : 0.f;
        sa0[q] = v0; den += v0;
        const float v1 = (wt && sb0 + 32 + e <= t) ? sa1[q] * qscale * __builtin_amdgcn_exp2f(ct + cc1[e]) : 0.f;
        sa1[q] = v1; den += v1;
      }
      __builtin_amdgcn_sched_barrier(0);
    }
#pragma unroll
    for (int sx = 0; sx < 4; ++sx) {
      const int u = (sx & 1) * 8;
      u32x4 tpk;
      if (sx < 2) {
        tpk.x = pk_bf16(sa0[u + 0], sa0[u + 1]); tpk.y = pk_bf16(sa0[u + 2], sa0[u + 3]);
        tpk.z = pk_bf16(sa0[u + 4], sa0[u + 5]); tpk.w = pk_bf16(sa0[u + 6], sa0[u + 7]);
      } else {
        tpk.x = pk_bf16(sa1[u + 0], sa1[u + 1]); tpk.y = pk_bf16(sa1[u + 2], sa1[u + 3]);
        tpk.z = pk_bf16(sa1[u + 4], sa1[u + 5]); tpk.w = pk_bf16(sa1[u + 6], sa1[u + 7]);
      }
      pf[sx] = __builtin_bit_cast(bf16x8, tpk);
    }
  }
  den += __shfl_xor(den, 32);
  const float dtot = den + wq * qn;
  const float inv = 1.f / fmaxf(fabsf(dtot), expf(-mtt));
  bf16_t* op = p->P + (size_t)rowq * LDP + 1024 + dir * 512 + h * 128 + wv * 64 + 4 * hi;
#pragma unroll 1
  for (int vp = 0; vp < 2; ++vp) {
    f32x16 o0;
#pragma unroll
    for (int q = 0; q < 16; ++q) o0[q] = 0.f;
    const char* cb = cimg + (wv * 2 + vp) * 8192 + toff + hi * 512;
#pragma unroll
    for (int d0 = 0; d0 < 8; ++d0) {
      const bf16x8 A0 = __builtin_shufflevector(vtr(cb + (16 * d0) * 64), vtr(cb + (16 * d0 + 4) * 64), 0, 1, 2, 3, 4, 5, 6, 7);
      o0 = MFMA32(A0, qf[d0], o0);
    }
#pragma unroll
    for (int q = 0; q < 16; ++q) o0[q] *= wq;
    const char* vb = vimg + (wv * 2 + vp) * 4096 + toff + hi * 256;
#pragma unroll
    for (int sx = 0; sx < 4; ++sx) {
      if (sx < 2 || wt) {
        const bf16x8 A0 = __builtin_shufflevector(vtr(vb + (16 * sx) * 64), vtr(vb + (16 * sx + 8) * 64), 0, 1, 2, 3, 4, 5, 6, 7);
        o0 = MFMA32(A0, pf[sx], o0);
      }
    }
#pragma unroll
    for (int g = 0; g < 4; ++g) {
      u32x2 v0;
      v0.x = pk_bf16(o0[4 * g] * inv, o0[4 * g + 1] * inv); v0.y = pk_bf16(o0[4 * g + 2] * inv, o0[4 * g + 3] * inv);
      *(u32x2*)(op + vp * 32 + 8 * g) = v0;
    }
  }
}

__device__ void ph_mlstm_s1(KP p, int layer, char* smc) {
  const int tid = opaque_tid();
  __syncthreads();
  for (int tile = blockIdx.x; tile < NMT; tile += gridDim.x) { mlstm_s1(p, layer, tile, smc, tid); __syncthreads(); }
}

__device__ void ph_rec_final(KP p, int layer, bool keep) {
  const int tid = opaque_tid();
  const int j = layer >> 1;
  const int lane = tid & 63, wave = tid >> 6;
  const int rows = keep ? NT : NL;
  const int c0 = lane * 8;
  auto unpack = [](const u32x4 u, float (&f)[8]) {
    f[0] = bflo(u.x); f[1] = bfhi(u.x); f[2] = bflo(u.y); f[3] = bfhi(u.y);
    f[4] = bflo(u.z); f[5] = bfhi(u.z); f[6] = bflo(u.w); f[7] = bfhi(u.w);
  };
  for (int t = blockIdx.x * 4 + wave; t < rows; t += gridDim.x * 4) {
    const bf16_t* rw = p->RW + (size_t)t * RWS + c0;
    const bf16_t* pt = p->P + (size_t)t * LDP + c0;
    unsigned char* mo = (unsigned char*)p->AB + (size_t)t * DM + c0;
    {
      float yf[8], yb[8], r[8], v[8], k0[8], k1[8], g[8], y[8], o[8];
      unpack(*(const u32x4*)(pt), yf); unpack(*(const u32x4*)(pt + 512), yb);
      unpack(*(const u32x4*)(rw), r); unpack(*(const u32x4*)(rw + 512), v);
      unpack(*(const u32x4*)(rw + 5 * 512), k0); unpack(*(const u32x4*)(rw + 6 * 512), k1);
      unpack(*(const u32x4*)(rw + 9 * 512), g);
      float s1 = 0.f, bs = 0.f;
      const float* rk = p->rwkv_rk + j * 512 + c0;
#pragma unroll
      for (int e = 0; e < 8; ++e) { y[e] = yf[e] + yb[e]; s1 += y[e]; bs += r[e] * rk[e] * (k0[e] + k1[e]); }
      s1 += dppx<0xB1>(s1); s1 += dppx<0x4E>(s1); s1 += dppx<0x141>(s1);
      bs += dppx<0xB1>(bs); bs += dppx<0x4E>(bs); bs += dppx<0x141>(bs);
      const float mu = s1 * (1.f / 64.f);
      float s2 = 0.f;
#pragma unroll
      for (int e = 0; e < 8; ++e) { const float d = y[e] - mu; s2 += d * d; }
      s2 += dppx<0xB1>(s2); s2 += dppx<0x4E>(s2); s2 += dppx<0x141>(s2);
      const float rs = rsqrtf(s2 * (1.f / 64.f) + 64e-5f);
      const float* gn0 = p->rwkv_gn + (j * 2 + 0) * 512 + c0;
      const float* gn1 = p->rwkv_gn + (j * 2 + 1) * 512 + c0;
#pragma unroll
      for (int e = 0; e < 8; ++e) o[e] = ((y[e] - mu) * rs * gn0[e] + gn1[e] + bs * v[e]) * g[e];
      u32x2 ov;
      ov.x = pk_fp8x4c(o[0], o[1], o[2], o[3]); ov.y = pk_fp8x4c(o[4], o[5], o[6], o[7]);
      *(u32x2*)(mo) = ov;
    }
    {
      float hf[8], hb[8], og[8], hsum[8], o[8];
      unpack(*(const u32x4*)(pt + 1024), hf); unpack(*(const u32x4*)(pt + 1536), hb);
      unpack(*(const u32x4*)(pt + 3584), og);
      float ss = 0.f;
#pragma unroll
      for (int e = 0; e < 8; ++e) { hsum[e] = hf[e] + hb[e]; ss += hsum[e] * hsum[e]; }
      ss += dppx<0xB1>(ss); ss += dppx<0x4E>(ss); ss += dppx<0x141>(ss); ss += dppx<0x140>(ss);
      const float rs = rsqrtf(ss * (1.f / 128.f) + 1e-6f);
      const float* ng = p->mlstm_norm + j * 512 + c0;
#pragma unroll
      for (int e = 0; e < 8; ++e) o[e] = hsum[e] * rs * ng[e] * sigm_f(og[e]);
      u32x2 ov;
      ov.x = pk_fp8x4c(o[0], o[1], o[2], o[3]); ov.y = pk_fp8x4c(o[4], o[5], o[6], o[7]);
      *(u32x2*)(mo + 512) = ov;
    }
  }
}

using f32x4v = __attribute__((ext_vector_type(4))) float;
__device__ void ph_ln_router(KP p, int layer, bool keep, char* smc) {
  float* h2s = (float*)smc;
  float* lgs = (float*)smc;
  const int tid = opaque_tid();
  const int lane = tid & 63, wave = tid >> 6;
  const int rows = keep ? NT : NL;
  const float* lng = p->ln_g + (layer * 2 + 0) * 1024;
  const float* lnb = p->ln_b + (layer * 2 + 0) * 1024;
  for (int tile = blockIdx.x; tile < rows / 16; tile += gridDim.x) {
    const int t0 = tile * 16;
    const float* mod = p->MOD + (layer * 9 + modrow(t0)) * 6144;
    const float* brow = p->WrT + ((size_t)layer * 64 + 16 * wave + (lane & 15)) * 1024 + 4 * (lane >> 4);
    f32x4v b0[8], b1[8], b2[8];
#pragma unroll
    for (int q = 0; q < 8; ++q) { b0[q] = *(const f32x4v*)(brow + 16 * q); b1[q] = *(const f32x4v*)(brow + 16 * (8 + q)); }
    __builtin_amdgcn_sched_barrier(0);
    {
      float4 v[4][4];
      float s4[4];
#pragma unroll
      for (int q = 0; q < 4; ++q) {
        const int t = t0 + wave * 4 + q;
        s4[q] = 0.f;
#pragma unroll
        for (int i = 0; i < 4; ++i) v[q][i] = *(const float4*)(p->Tb + (size_t)t * DM + i * 256 + lane * 4);
      }
#pragma unroll
      for (int q = 0; q < 4; ++q)
#pragma unroll
        for (int i = 0; i < 4; ++i) s4[q] += (v[q][i].x + v[q][i].y) + (v[q][i].z + v[q][i].w);
      float mean4[4], rs4[4];
#pragma unroll
      for (int q = 0; q < 4; ++q) mean4[q] = wsum(s4[q]) * (1.f / 1024.f);
#pragma unroll
      for (int q = 0; q < 4; ++q) {
        float qq = 0.f;
#pragma unroll
        for (int i = 0; i < 4; ++i) {
          const float d0 = v[q][i].x - mean4[q], d1 = v[q][i].y - mean4[q], d2 = v[q][i].z - mean4[q], d3 = v[q][i].w - mean4[q];
          qq += (d0 * d0 + d1 * d1) + (d2 * d2 + d3 * d3);
        }
        s4[q] = qq;
      }
#pragma unroll
      for (int q = 0; q < 4; ++q) rs4[q] = rsqrtf(wsum(s4[q]) * (1.f / 1024.f) + 1e-5f);
#pragma unroll
      for (int i = 0; i < 4; ++i) {
        const int n = i * 256 + lane * 4;
        const float4 g = *(const float4*)(lng + n), bb = *(const float4*)(lnb + n);
        const float4 sc = *(const float4*)(mod + 4096 + n), sh = *(const float4*)(mod + 3072 + n);
#pragma unroll
        for (int q = 0; q < 4; ++q) {
          const int tl = wave * 4 + q, t = t0 + tl;
          const float mean = mean4[q], rs = rs4[q];
          const float4 xn = make_float4((v[q][i].x - mean) * rs * g.x + bb.x, (v[q][i].y - mean) * rs * g.y + bb.y,
                                        (v[q][i].z - mean) * rs * g.z + bb.z, (v[q][i].w - mean) * rs * g.w + bb.w);
          *(float4*)(p->X + (size_t)t * DM + n) = xn;
          const float4 hh = make_float4(xn.x * (1.f + sc.x) + sh.x, xn.y * (1.f + sc.y) + sh.y,
                                        xn.z * (1.f + sc.z) + sh.z, xn.w * (1.f + sc.w) + sh.w);
          *(unsigned*)((unsigned char*)p->AB + (size_t)t * DM + n) = pk_fp8x4(hh.x, hh.y, hh.z, hh.w);
          *(float4*)(h2s + tl * 1028 + n) = hh;
        }
      }
    }
    __syncthreads();
    f32x4v acc = {0.f, 0.f, 0.f, 0.f};
    {
      f32x4v a1 = {0.f, 0.f, 0.f, 0.f}, a2 = {0.f, 0.f, 0.f, 0.f}, a3 = {0.f, 0.f, 0.f, 0.f};
      const int i = lane & 15, kk = lane >> 4;
      const float* arow = h2s + i * 1028 + 4 * kk;
#define ROUTER_LOAD(B, Q0) _Pragma("unroll") for (int q = 0; q < 8; ++q) B[q] = *(const f32x4v*)(brow + 16 * ((Q0) + q)); __builtin_amdgcn_sched_barrier(0);
#define ROUTER_MFMA(B, Q0) _Pragma("unroll") for (int q = 0; q < 8; ++q) { \
        const float4 a = *(const float4*)(arow + 16 * ((Q0) + q)); \
        acc = __builtin_amdgcn_mfma_f32_16x16x4f32(a.x, B[q].x, acc, 0, 0, 0); \
        a1 = __builtin_amdgcn_mfma_f32_16x16x4f32(a.y, B[q].y, a1, 0, 0, 0); \
        a2 = __builtin_amdgcn_mfma_f32_16x16x4f32(a.z, B[q].z, a2, 0, 0, 0); \
        a3 = __builtin_amdgcn_mfma_f32_16x16x4f32(a.w, B[q].w, a3, 0, 0, 0); } __builtin_amdgcn_sched_barrier(0);
      ROUTER_LOAD(b2, 16) ROUTER_MFMA(b0, 0)
      ROUTER_LOAD(b0, 24) ROUTER_MFMA(b1, 8)
      ROUTER_LOAD(b1, 32) ROUTER_MFMA(b2, 16)
      ROUTER_LOAD(b2, 40) ROUTER_MFMA(b0, 24)
      ROUTER_LOAD(b0, 48) ROUTER_MFMA(b1, 32)
      ROUTER_LOAD(b1, 56) ROUTER_MFMA(b2, 40)
      ROUTER_MFMA(b0, 48)
      ROUTER_MFMA(b1, 56)
      acc = (acc + a1) + (a2 + a3);
    }
    __syncthreads();
#pragma unroll
    for (int r = 0; r < 4; ++r) lgs[((lane >> 4) * 4 + r) * 64 + 16 * wave + (lane & 15)] = acc[r];
    __syncthreads();
    {
      float score4[4], gate4[4];
      int kidx4[4], pos4[4];
      bool chosen4[4];
#pragma unroll
      for (int q = 0; q < 4; ++q) {
        const int tl = wave * 4 + q;
        const float logit = lgs[tl * 64 + lane];
        const float score = sigm_f(logit);
        float sel = score + p->moe_bias[layer * 64 + lane];
        bool chosen = false;
        for (int r = 0; r < 6; ++r) {
          const float mx = wmax(sel);
          const unsigned long long bal = __ballot(sel == mx);
          const int first = __ffsll((long long)bal) - 1;
          if (lane == first) { chosen = true; sel = -INFINITY; }
        }
        const float gsum = wsum(chosen ? score : 0.f);
        const unsigned long long cb = __ballot(chosen);
        score4[q] = score; gate4[q] = score / gsum * 2.5f; chosen4[q] = chosen;
        kidx4[q] = __popcll(cb & ((1ull << lane) - 1ull));
      }
#pragma unroll
      for (int q = 0; q < 4; ++q) pos4[q] = chosen4[q] ? atomicAdd(&p->cnt[lane * CSTR], 1) : 0;
#pragma unroll
      for (int q = 0; q < 4; ++q) {
        const int t = t0 + wave * 4 + q;
        if (chosen4[q]) {
          p->ltok[(size_t)lane * NT + pos4[q]] = t;
          p->lgate[(size_t)lane * NT + pos4[q]] = gate4[q];
          p->tsl[t * 6 + kidx4[q]] = (lane << 16) | pos4[q];
        }
      }
    }
    __syncthreads();
  }
}

__device__ __forceinline__ void moe_prefix(KP p, int rows, int* s_pref, int tid) {
  if (tid < 64) s_pref[322 + tid] = p->cnt[tid * CSTR];
  __syncthreads();
  if (tid == 0) {
    int a = 0;
    for (int e = 0; e < 64; ++e) { s_pref[e] = a; a += (s_pref[322 + e] + 127) >> 7; }
    s_pref[64] = a; a += rows >> 7;
    s_pref[65] = a;
  }
  __syncthreads();
}

__device__ void ph_gemm(KP p, int kind, int layer, bool keep, char* lds) {
  const int tid = opaque_tid();
  const int j = layer >> 1;
  const bool att = !(layer & 1);
  const int rows = keep ? NT : NL;
  int* pref = (int*)(lds + META_OFF);
  int* s_idx = pref + 66;
  float* s_gate = (float*)(s_idx + 128);
  if (kind == 1 && blockIdx.x == 0 && tid < 65) p->cnt[tid * CSTR] = 0;
  int total;
  const int ntn_in = att ? 18 : 33;
  switch (kind) {
    case 0: total = (NT / 128) * ntn_in; break;
    case 1: total = (rows / 128) * 8; break;
    case 2: total = pref[65] * 4; break;
    case 3: total = pref[65] * 8; break;
    case 4: total = (NT / 128) * 3; break;
    default: total = (NT / 128) * 20; break;
  }
  const bool moe = kind == 2 || kind == 3;
  const int tsh = kind == 2 ? 2 : 3;
  int e_nx = 0, idx_nx = tid; float g_nx = 1.f;
  auto fetch_moe = [&](int tl) {
    const int mt = tl >> tsh;
    while (mt >= pref[e_nx + 1]) ++e_nx;
    idx_nx = tid; g_nx = 1.f;
    if (tid < 128) {
      const int pos = (mt - pref[e_nx]) * 128 + tid;
      if (kind == 2) {
        idx_nx = 0;
        if (e_nx < 64) { if (pos < pref[322 + e_nx]) idx_nx = p->ltok[(size_t)e_nx * NT + pos]; }
        else idx_nx = pos;
      } else if (e_nx < 64) g_nx = pos < pref[322 + e_nx] ? p->lgate[(size_t)e_nx * NT + pos] : 0.f;
    }
  };
  const int xcd = blockIdx.x & 7, lb = blockIdx.x >> 3, nbx = ((int)gridDim.x - xcd + 7) >> 3;
  const int t_beg = (int)(((long long)total * xcd) >> 3), t_end = (int)(((long long)total * (xcd + 1)) >> 3);
  if (moe && t_beg + lb < t_end) fetch_moe(t_beg + lb);
  for (int tile = t_beg + lb; tile < t_end; tile += nbx) {
    const bf16_t* Abase; const bf16_t* Bt;
    int astride, K, n0, m0 = 0, aux = 0, e = e_nx, mtile = 0;
    switch (kind) {
      case 0: { const int tm = tile / ntn_in, tn = tile % ntn_in; m0 = tm * 128; n0 = tn * 128;
                Abase = (const bf16_t*)((const unsigned char*)p->AB + (size_t)m0 * DM); astride = DM; K = 1024;
                Bt = (const bf16_t*)(att ? (const unsigned char*)p->Wt_att + (size_t)j * ATT_N * 1024
                                         : (const unsigned char*)p->Wt_rec + (size_t)j * REC_NP * 1024); } break;
      case 1: { const int tm = tile >> 3, tn = tile & 7; m0 = tm * 128; n0 = tn * 128;
                Abase = (const bf16_t*)((const unsigned char*)p->AB + (size_t)m0 * DM); astride = DM; K = 1024;
                Bt = (const bf16_t*)((const unsigned char*)p->Wt_out + (size_t)layer * 1024 * 1024); } break;
      case 2: { mtile = tile >> 2; aux = tile & 3; n0 = aux * 128;
                Abase = p->AB; astride = DM; K = 1024;
                Bt = (const bf16_t*)((const unsigned char*)p->Wt13 + (size_t)(layer * 65 + e) * 512 * 1024); } break;
      case 3: { mtile = tile >> 3; aux = tile & 7; n0 = aux * 128;
                Abase = (const bf16_t*)((const unsigned char*)p->ACT + (size_t)mtile * 128 * 256); astride = 256; K = 256;
                Bt = (const bf16_t*)((const unsigned char*)p->Wt2 + (size_t)(layer * 65 + e) * 1024 * 256); } break;
      case 4: { const int tm = tile / 3; aux = tile % 3; m0 = tm * 128; n0 = 0;
                Abase = p->Zb + (size_t)m0 * 1536 + aux * 512; astride = 1536; K = 512; Bt = p->Wl1 + (size_t)(j * 3 + aux) * 128 * 512; } break;
      default: { const int tm = tile / 20; aux = tile % 20; m0 = tm * 128; n0 = aux * 128;
                const int grp = aux < 8 ? 0 : (aux < 16 ? 1 : 2);
                Abase = p->L1 + (size_t)m0 * 384 + grp * 128; astride = 384; K = 128; Bt = p->Wl2 + (size_t)j * 2560 * 128; } break;
    }
    if (tid < 128) { s_idx[tid] = idx_nx; s_gate[tid] = g_nx; }
    __syncthreads();
    if (moe && tile + nbx < t_end) fetch_moe(tile + nbx);
    {
      f32x16 acc[2][2];
      if (kind <= 3) {
        const unsigned char* A8 = (const unsigned char*)Abase;
        gemm128_fp8(tid, [&](int r) { return A8 + (size_t)s_idx[r] * astride; }, (const unsigned char*)Bt, K, n0, lds, acc);
      } else
        gemm128_main(tid, [&](int r) { return Abase + (size_t)s_idx[r] * astride; }, Bt, K, n0, lds, acc);
      float* Ct = (float*)lds;
      acc_foreach(tid, acc, [&](int row, int col, float v) { Ct[row * 128 + col] = v; });
    }
    __syncthreads();
    {
      const float* Ct = (const float*)lds;
      int c4 = (tid & 31) * 4, r0 = tid >> 5;
      asm volatile("" : "+v"(c4), "+v"(r0));
      const int N_in = att ? ATT_N : REC_N;
      const int d5 = (aux >> 2) & 1, c05 = (aux & 3) * 128;
      switch (kind) {
        case 0: {
#pragma unroll 8
          for (int it = 0; it < 16; ++it) {
            const int row = it * 8 + r0;
            const float4 vraw = *(const float4*)(Ct + row * 128 + c4);
            const float4 v = make_float4(vraw.x * W8_INV, vraw.y * W8_INV, vraw.z * W8_INV, vraw.w * W8_INV);

            const int cn = n0 + c4;
            float4 vq = v;
            if (att && n0 >= 1536 && n0 < 2176) {
              float ss = v.x * v.x + v.y * v.y + v.z * v.z + v.w * v.w;
              ss += dppx<0xB1>(ss); ss += dppx<0x4E>(ss); ss += dppx<0x141>(ss); ss += dppx<0x140>(ss);
              const float rs = rsqrtf(ss * (1.f / 64.f) + 1e-6f);
              const float4 g = *(const float4*)(p->qk_gain + j * 128 + (n0 >= 2048 ? 64 : 0) + (cn & 63));
              vq = make_float4(v.x * rs * g.x, v.y * rs * g.y, v.z * rs * g.z, v.w * rs * g.w);
              const int t = m0 + row;
              if (t < NL) {
                const int sidx = t & 2047, pi0 = (cn & 63) >> 1;
                const int pos = pi0 < 16 ? (sidx >> 6) : (sidx & 63);
                const float4 cs = *(const float4*)(p->ROPE + (pos * 16 + (pi0 & 15)) * 2);
                vq = make_float4(vq.x * cs.x - vq.y * cs.y, vq.x * cs.y + vq.y * cs.x,
                                 vq.z * cs.z - vq.w * cs.w, vq.z * cs.w + vq.w * cs.z);
              }
            }
            if (cn < N_in) {
              u32x2 o; o.x = pk_bf16(vq.x, vq.y); o.y = pk_bf16(vq.z, vq.w);
              *(u32x2*)(p->P + (size_t)(m0 + row) * LDP + cn) = o;
            }
            if (!att && cn >= 4096 && cn < 4112) *(float4*)(p->GP + (size_t)(m0 + row) * 16 + (cn - 4096)) = v;
          }
        } break;
        case 1: {
#pragma unroll 16
          for (int it = 0; it < 16; ++it) {
            const int row = it * 8 + r0;
            const float4 v = *(const float4*)(Ct + row * 128 + c4);

            const size_t o = (size_t)(m0 + row) * DM + n0 + c4;
            const float4 xv = *(const float4*)(p->X + o);
            const float4 g = *(const float4*)(p->MOD + (layer * 9 + modrow(m0)) * 6144 + 2048 + n0 + c4);
            *(float4*)(p->Tb + o) = make_float4(DN_ALPHA * xv.x + g.x * (v.x * W8_INV), DN_ALPHA * xv.y + g.y * (v.y * W8_INV),
                                                DN_ALPHA * xv.z + g.z * (v.z * W8_INV), DN_ALPHA * xv.w + g.w * (v.w * W8_INV));
          }
        } break;
        case 2: {
#pragma unroll 8
          for (int it = 0; it < 16; ++it) {
            const int row = it * 8 + r0;
            const float4 v = *(const float4*)(Ct + row * 128 + c4);

            if (((c4 >> 5) & 1) == 0) {
              const float4 u = *(const float4*)(Ct + row * 128 + c4 + 32);
              const float a0 = v.x * W8_INV, a1 = v.y * W8_INV, a2 = v.z * W8_INV, a3 = v.w * W8_INV;
              *(unsigned*)((unsigned char*)p->ACT + ((size_t)mtile * 128 + row) * 256 + aux * 64 + (c4 >> 6) * 32 + (c4 & 31)) =
                  pk_fp8x4(silu_f(a0) * (u.x * W8_INV), silu_f(a1) * (u.y * W8_INV), silu_f(a2) * (u.z * W8_INV), silu_f(a3) * (u.w * W8_INV));
            }
          }
        } break;
        case 3: {
#pragma unroll 16
          for (int it = 0; it < 16; ++it) {
            const int row = it * 8 + r0;
            const float4 v = *(const float4*)(Ct + row * 128 + c4);

            const float g = s_gate[row] * W8_INV;
            u32x2 o; o.x = pk_bf16(g * v.x, g * v.y); o.y = pk_bf16(g * v.z, g * v.w);
            *(u32x2*)(p->OUT2 + ((size_t)mtile * 128 + row) * 1024 + n0 + c4) = o;
          }
        } break;
        case 4: {
#pragma unroll 4
          for (int it = 0; it < 16; ++it) {
            const int row = it * 8 + r0;
            const float4 v = *(const float4*)(Ct + row * 128 + c4);

            float4 o4 = v;
            if (aux == 0) o4 = make_float4(tanhf(v.x), tanhf(v.y), tanhf(v.z), tanhf(v.w));
            else if (aux == 2) o4 = make_float4(sigm_f(v.x), sigm_f(v.y), sigm_f(v.z), sigm_f(v.w));
            u32x2 o; o.x = pk_bf16(o4.x, o4.y); o.y = pk_bf16(o4.z, o4.w);
            *(u32x2*)(p->L1 + (size_t)(m0 + row) * 384 + aux * 128 + c4) = o;
          }
        } break;
        default: {
#pragma unroll 4
          for (int it = 0; it < 16; ++it) {
            const int row = it * 8 + r0;
            const float4 v = *(const float4*)(Ct + row * 128 + c4);

            bf16_t* rr = p->RW + (size_t)(m0 + row) * RWS + c05 + c4;
            const float vv[4] = {v.x, v.y, v.z, v.w};
            if (aux < 8) {
              const float4 b0 = *(const float4*)(p->rwkv_w0 + (j * 2 + d5) * 512 + c05 + c4);
              const float bb[4] = {b0.x, b0.y, b0.z, b0.w};
              float e4[4];
#pragma unroll
              for (int q = 0; q < 4; ++q) e4[q] = expf(-softplus_f(-(bb[q] + vv[q])) - 0.5f);
              u32x2 o; o.x = pk_bf16(e4[0], e4[1]); o.y = pk_bf16(e4[2], e4[3]);
              *(u32x2*)(rr + (3 + d5) * 512) = o;
            } else if (aux < 16) {
              const float4 b0 = *(const float4*)(p->rwkv_a0 + (j * 2 + d5) * 512 + c05 + c4);
              const float4 k1 = *(const float4*)(p->rwkv_kvec + (j * 2 + 1) * 512 + c05 + c4);
              const u32x2 kx2 = *(const u32x2*)(rr + 10 * 512);
              const float bb[4] = {b0.x, b0.y, b0.z, b0.w}, kk1[4] = {k1.x, k1.y, k1.z, k1.w};
              const float kx[4] = {bflo(kx2.x), bfhi(kx2.x), bflo(kx2.y), bfhi(kx2.y)};
              float av[4], ke[4];
#pragma unroll
              for (int q = 0; q < 4; ++q) { av[q] = sigm_f(bb[q] + vv[q]); ke[q] = kx[q] * (1.f + (av[q] - 1.f) * kk1[q]); }
              u32x2 o; o.x = pk_bf16(av[0], av[1]); o.y = pk_bf16(av[2], av[3]);
              *(u32x2*)(rr + (7 + d5) * 512) = o;
              o.x = pk_bf16(ke[0], ke[1]); o.y = pk_bf16(ke[2], ke[3]);
              *(u32x2*)(rr + (5 + d5) * 512) = o;
            } else {
              u32x2 o; o.x = pk_bf16(v.x, v.y); o.y = pk_bf16(v.z, v.w);
              *(u32x2*)(rr + 9 * 512) = o;
            }
          }
        } break;
      }
    }
    __syncthreads();
  }
}

__device__ void ph_final_ln(KP p, int layer, bool keep, char* lds) {
  const int tid = opaque_tid();
  const int lane = tid & 63, wave = tid >> 6;
  const int rows = keep ? NT : NL;
  int* s_base = (int*)(lds + META_OFF);
  if (tid == 0) {
    int a = 0;
#pragma unroll 1
    for (int e = 0; e < 64; ++e) { s_base[e] = a * 128; a += (p->cnt[e * CSTR] + 127) >> 7; }
    s_base[64] = a * 128;
  }
  __syncthreads();
  const float* lng = p->ln_g + (layer * 2 + 1) * 1024;
  const float* lnb = p->ln_b + (layer * 2 + 1) * 1024;
  for (int t = blockIdx.x * 4 + wave; t < rows; t += gridDim.x * 4) {
    const int mr = modrow(t);
    const float* g2 = p->MOD + (layer * 9 + mr) * 6144 + 5120;
    const bf16_t* src[7];
#pragma unroll
    for (int k = 0; k < 6; ++k) {
      const int v = p->tsl[t * 6 + k];
      src[k] = p->OUT2 + (size_t)(s_base[v >> 16] + (v & 0xffff)) * 1024;
    }
    src[6] = p->OUT2 + (size_t)(s_base[64] + t) * 1024;
    float v[16];
    float s = 0.f;
#pragma unroll
    for (int c = 0; c < 2; ++c) {
      const int n0 = c * 512 + lane * 8;
      float y[8];
#pragma unroll
      for (int q = 0; q < 8; ++q) y[q] = 0.f;
#pragma unroll
      for (int k = 0; k < 7; ++k) {
        const u32x4 u = *(const u32x4*)(src[k] + n0);
        y[0] += bflo(u.x); y[1] += bfhi(u.x); y[2] += bflo(u.y); y[3] += bfhi(u.y);
        y[4] += bflo(u.z); y[5] += bfhi(u.z); y[6] += bflo(u.w); y[7] += bfhi(u.w);
      }
      const float4 xa = *(const float4*)(p->X + (size_t)t * DM + n0), xb = *(const float4*)(p->X + (size_t)t * DM + n0 + 4);
      const float4 ga = *(const float4*)(g2 + n0), gb = *(const float4*)(g2 + n0 + 4);
      const float xx[8] = {xa.x, xa.y, xa.z, xa.w, xb.x, xb.y, xb.z, xb.w};
      const float gg[8] = {ga.x, ga.y, ga.z, ga.w, gb.x, gb.y, gb.z, gb.w};
#pragma unroll
      for (int q = 0; q < 8; ++q) { v[c * 8 + q] = DN_ALPHA * xx[q] + gg[q] * y[q]; s += v[c * 8 + q]; }
    }
    const float mean = wsum(s) * (1.f / 1024.f);
    float q2 = 0.f;
#pragma unroll
    for (int i = 0; i < 16; ++i) { const float d = v[i] - mean; q2 += d * d; }
    const float rs = rsqrtf(wsum(q2) * (1.f / 1024.f) + 1e-5f);
    const float* modn = p->MOD + ((layer + 1) * 9 + mr) * 6144;
#pragma unroll
    for (int c = 0; c < 2; ++c) {
      const int n0 = c * 512 + lane * 8;
      float xn[8];
#pragma unroll
      for (int q = 0; q < 8; ++q) xn[q] = (v[c * 8 + q] - mean) * rs * lng[n0 + q] + lnb[n0 + q];
      float* xo = (layer == 3 ? p->out : p->X) + (size_t)t * DM + n0;
      *(float4*)(xo) = make_float4(xn[0], xn[1], xn[2], xn[3]);
      *(float4*)(xo + 4) = make_float4(xn[4], xn[5], xn[6], xn[7]);
      if (layer != 3) {
        float hb[8];
#pragma unroll
        for (int q = 0; q < 8; ++q) hb[q] = xn[q] * (1.f + modn[1024 + n0 + q]) + modn[n0 + q];
        u32x2 o;
        o.x = pk_fp8x4(hb[0], hb[1], hb[2], hb[3]); o.y = pk_fp8x4(hb[4], hb[5], hb[6], hb[7]);
        *(u32x2*)((unsigned char*)p->AB + (size_t)t * DM + n0) = o;
      }
    }
  }
}

#define XB_TMO      128
#define XB_XCNT(j)  (256  + 64 * (j))
#define XB_XSUB(j)  (1280 + 64 * (j))
#define XB_XGEN(j)  (2304 + 64 * (j))
#define XB_TOP      3328
#define XB_TOPGEN   3392
#define XB_SPIN_CAP (1u << 20)
#define LAS __attribute__((address_space(3)))
__device__ __forceinline__ unsigned xb_ld(unsigned* p) { return __hip_atomic_load(p, __ATOMIC_RELAXED, __HIP_MEMORY_SCOPE_AGENT); }
__device__ __forceinline__ unsigned xb_add(unsigned* p, unsigned v) { return __hip_atomic_fetch_add(p, v, __ATOMIC_RELAXED, __HIP_MEMORY_SCOPE_AGENT); }
__device__ __forceinline__ unsigned xb_xcc_id() { return (unsigned)__builtin_amdgcn_s_getreg((3 << 11) | 20) & 0xFu; }
#define XB_SPIN(cond, bar) do { unsigned _sp = 0; while (cond) { __builtin_amdgcn_s_sleep(1); \
    if ((++_sp & 255u) == 0u) { if (xb_ld(&(bar)[XB_TMO])) break; if (_sp > XB_SPIN_CAP) { atomicAdd(&(bar)[XB_TMO], 1u); break; } } } } while (0)
struct XcdBarrier { unsigned* bar; unsigned x; volatile LAS unsigned* st; };
__device__ __forceinline__ XcdBarrier xcd_barrier_post(unsigned* bar, volatile LAS unsigned* st) {
  XcdBarrier b; b.bar = bar; b.x = xb_xcc_id(); b.st = st;
  if (threadIdx.x == 0) (void)xb_add(&bar[XB_XCNT(b.x)], 1u);
  return b;
}
__device__ __forceinline__ void xcd_barrier_complete(unsigned* bar, unsigned x, unsigned& nloc, unsigned& nx) {
  const unsigned G = gridDim.x;
  unsigned sum, cnt, mine, sp = 0u;
  for (;;) {
    sum = 0u; cnt = 0u; mine = 0u;
#pragma unroll
    for (unsigned j = 0; j < 16; ++j) { const unsigned c = xb_ld(&bar[XB_XCNT(j)]); sum += c; cnt += (c > 0u) ? 1u : 0u; mine = (j == x) ? c : mine; }
    if (sum == G) break;
    __builtin_amdgcn_s_sleep(1);
    if ((++sp & 255u) == 0u) { if (xb_ld(&bar[XB_TMO])) break; if (sp > XB_SPIN_CAP) { atomicAdd(&bar[XB_TMO], 1u); break; } }
  }
  nloc = mine > 0u ? mine : 1u; nx = cnt > 0u ? cnt : 1u;
}
__device__ __forceinline__ void xcd_barrier(const XcdBarrier& b) {
  asm volatile("s_waitcnt vmcnt(0)" ::: "memory");
  __syncthreads();
  if (threadIdx.x == 0) {
    unsigned* bar = b.bar;
    __builtin_amdgcn_s_waitcnt(0);
    unsigned nloc = b.st[0], nx = b.st[1];
    if (nloc == 0u) { xcd_barrier_complete(bar, b.x, nloc, nx); b.st[0] = nloc; b.st[1] = nx; }
    const unsigned old = xb_add(&bar[XB_XSUB(b.x)], 1u);
    const unsigned gen = old / nloc;
    if (old + 1u == (gen + 1u) * nloc) {
      __builtin_amdgcn_fence(__ATOMIC_RELEASE, "agent");
      asm volatile("s_waitcnt vmcnt(0)" ::: "memory");
      const unsigned og = xb_add(&bar[XB_TOP], 1u);
      const unsigned tg = og / nx;
      if (og + 1u == (tg + 1u) * nx) xb_add(&bar[XB_TOPGEN], 1u);
      else XB_SPIN(xb_ld(&bar[XB_TOPGEN]) == tg, bar);
      __builtin_amdgcn_fence(__ATOMIC_ACQUIRE, "agent");
      xb_add(&bar[XB_XGEN(b.x)], 1u);
      asm volatile("s_waitcnt vmcnt(0)" ::: "memory");
    } else {
      XB_SPIN(xb_ld(&bar[XB_XGEN(b.x)]) == gen, bar);
      __builtin_amdgcn_fence(__ATOMIC_ACQUIRE, "agent");
      asm volatile("s_waitcnt vmcnt(0)" ::: "memory");
    }
  }
  __syncthreads();
}

constexpr int NSLOTS = 13;
constexpr int NPHASE = 2 + 4 * NSLOTS;
__device__ __forceinline__ bool phase_is_nop(int ph) {
  if (ph < 2) return false;
  const int layer = (ph - 2) / NSLOTS, st = (ph - 2) % NSLOTS;
  if (st == 5 || st == 6) return true;
  return !(layer & 1) && (st == 1 || (st >= 3 && st <= 7));
}
__device__ void run_phase(KP p, int ph, char* sm) {
  if (ph == 0) { ph_init(p, sm); return; }
  if (ph == 1) { ph_mod_h(p, sm); return; }
  const int layer = (ph - 2) / NSLOTS, st = (ph - 2) % NSLOTS;
  const bool odd = layer & 1;
  const bool keep = layer < 3;
  int gk = -1;
  if (st == 0) gk = 0;
  else if (st == 8) gk = 1;
  else if (st == 10) gk = 2;
  else if (st == 11) gk = 3;
  else if (odd && st == 2) gk = 4;
  else if (odd && st == 3) gk = 5;
  asm volatile("" : "+s"(gk));
  if (gk >= 0) {
    if (gk == 2 || gk == 3) moe_prefix(p, keep ? NT : NL, (int*)(sm + META_OFF), opaque_tid());
    ph_gemm(p, gk, layer, keep, sm);
    if (gk == 5) { __syncthreads(); ph_mlstm_s2(p, sm); }
    return;
  }
  switch (st) {
    case 1: if (odd) { ph_rwkv_mix(p, layer); ph_mlstm_s1(p, layer, sm); } break;
    case 2: ph_attention(p, layer, keep, sm); break;
    case 4: if (odd) ph_scan_a(p, layer, sm); break;
    case 7: if (odd) ph_rec_final(p, layer, keep); break;
    case 9: ph_ln_router(p, layer, keep, sm); break;
    case 12: ph_final_ln(p, layer, keep, sm); break;
  }
}

__global__ void __launch_bounds__(NTHR, 2) mega_kernel(Params kargs) {
  extern __shared__ __attribute__((aligned(16))) char sm[];
  cg::grid_group grid = cg::this_grid();
  volatile LAS unsigned* st = (volatile LAS unsigned*)(sm + META_OFF + 4032);
  if (threadIdx.x == 0) { st[0] = 0u; st[1] = 0u; }
  __syncthreads();
  const XcdBarrier xb = xcd_barrier_post(kargs.bar, st);
  for (int ph = kargs.ph_lo; ph < kargs.ph_hi; ++ph) {
    if (phase_is_nop(ph)) continue;
    {
      KP kp = (KP)__builtin_amdgcn_kernarg_segment_ptr();
      asm volatile("" : "+s"(kp));
      run_phase(kp, ph, sm);
    }
    if (ph + 1 < kargs.ph_hi) {
      if (ph == 0) grid.sync();
      else xcd_barrier(xb);
    }
  }
}

extern "C" void kernel_launch(void* const* d_in, const int* in_sizes, int n_in, void* d_out, int out_size, void* d_ws,
                              size_t ws_size, hipStream_t stream) {
  static int grid_blocks = 0;
  if (!grid_blocks) {
    int dev = 0, cus = 0, per_cu = 0;
    (void)hipGetDevice(&dev);
    (void)hipDeviceGetAttribute(&cus, hipDeviceAttributeMultiprocessorCount, dev);
    (void)hipFuncSetAttribute((const void*)mega_kernel, hipFuncAttributeMaxDynamicSharedMemorySize, SMEM_BYTES);
    (void)hipOccupancyMaxActiveBlocksPerMultiprocessor(&per_cu, mega_kernel, NTHR, SMEM_BYTES);
    if (per_cu < 1) per_cu = 1;
    if (per_cu > 2) per_cu = 2;
    grid_blocks = cus * per_cu;
  }
  Params p;
  memset(&p, 0, sizeof(p));
  const float** pin = (const float**)&p;
  for (int i = 0; i < 35; ++i) pin[i] = (const float*)d_in[i];
  p.out = (float*)d_out;
  char* w = (char*)d_ws;
  size_t off = 0;
  auto take = [&](size_t bytes) { char* r = w + off; off += (bytes + 255) & ~(size_t)255; return r; };
  p.Wt_att = (bf16_t*)take((size_t)2 * ATT_N * 1024 * 2);
  p.Wt_rec = (bf16_t*)take((size_t)2 * REC_NP * 1024 * 2);
  p.Wt_out = (bf16_t*)take((size_t)4 * 1024 * 1024 * 2);
  p.Wt13 = (bf16_t*)take((size_t)4 * 65 * 512 * 1024);
  p.Wt2 = (bf16_t*)take((size_t)4 * 65 * 1024 * 256);
  p.Wl1 = (bf16_t*)take((size_t)2 * 3 * 128 * 512 * 2);
  p.Wl2 = (bf16_t*)take((size_t)2 * 2560 * 128 * 2);
  p.X = (float*)take((size_t)NT * DM * 4);
  p.AB = (bf16_t*)take((size_t)NT * DM * 2);
  p.MOD = (float*)take((size_t)5 * 9 * 6144 * 4);
  p.MODP = (float*)take((size_t)8 * 4 * 9 * 6144 * 4);
  p.GP = (float*)take((size_t)NT * 16 * 4);
  p.ROPE = (float*)take((size_t)64 * 16 * 2 * 4);
  p.WrT = (float*)take((size_t)4 * 64 * 1024 * 4);
  p.msc = (float*)take((size_t)3 * NMT * 4);
  p.lgate = (float*)take((size_t)64 * NT * 4);
  p.ltok = (int*)take((size_t)64 * NT * 4);
  p.tsl = (int*)take((size_t)NT * 6 * 4);
  p.cnt = (int*)take((size_t)65 * CSTR * 4);
  p.bar = (unsigned*)take((size_t)BAR_TOTAL_WORDS * 4);
  char* region = take(0);
  const size_t szP = (size_t)NT * LDP * 2, szRW = (size_t)NT * RWS * 2, szMS = (size_t)NMT * 16384 * 2,
               szMSn = (size_t)NMT * 128 * 4;
  const size_t szT = (size_t)NT * DM * 4, szOUT2 = (size_t)NSLOT * 1024 * 2;
  p.P = (bf16_t*)region;
  p.RW = (bf16_t*)(region + szP);
  p.MS = (bf16_t*)(region + szP + szRW);
  p.MSn = (float*)(region + szP + szRW + szMS);
  p.Tb = (float*)region;
  p.ACT = (bf16_t*)region;
  p.OUT2 = (bf16_t*)(region + szT);
  const size_t szZ = (size_t)NT * 2048 * 2;
  p.Zb = (bf16_t*)(region + szP + szRW + szMS + szMSn);
  p.L1 = p.Zb + (size_t)NT * 1536;
  size_t mixer = szP + szRW + szMS + szMSn + szZ, moe = szT + szOUT2;
  off += (mixer > moe ? mixer : moe);
  if (off > ws_size) { fprintf(stderr, "workspace too small: need %zu have %zu\n", off, ws_size); return; }
  p.ph_lo = 0;
  p.ph_hi = NPHASE;
  (void)hipMemsetAsync(p.bar, 0, (size_t)BAR_TOTAL_WORDS * 4, stream);
  void* args[] = {&p};
  hipError_t e = hipLaunchCooperativeKernel((void*)mega_kernel, dim3(grid_blocks), dim3(NTHR), args, SMEM_BYTES, stream);
  if (e != hipSuccess) fprintf(stderr, "cooperative launch failed: %s (grid %d)\n", hipGetErrorString(e), grid_blocks);
}
```

```cpp
#include <hip/hip_runtime.h>
#include <hip/hip_cooperative_groups.h>
#include <cstdio>
#include <cstring>
namespace cg = cooperative_groups;

constexpr int DM = 1024;
constexpr int NBATCH = 8;
constexpr int SEQ = 2048;
constexpr int CTXL = 256;
constexpr int NL = NBATCH * SEQ;
constexpr int NC = NBATCH * CTXL;
constexpr int NT = NL + NC;
constexpr int TSC = CTXL + SEQ;
constexpr int LDP = 4112;
constexpr int ATT_N = 2304;
constexpr int REC_N = 4112;
constexpr int REC_NP = 4224;
constexpr int NCHUNK = 36;
constexpr int NMT = 64 * NCHUNK;
constexpr int RWS = 5632;
constexpr int NSLOT = 137216;
constexpr float DN_ALPHA = 1.6817928305074290f;
constexpr int NTHR = 256;
constexpr int SMEM_BYTES = 65536 + 4096;
constexpr int META_OFF = 65536;
#define XCD_BAR_WORDS 3456
constexpr int CSTR = 32;
constexpr int BAR_TOTAL_WORDS = XCD_BAR_WORDS + 64;

typedef unsigned short bf16_t;
using bf16x8 = __attribute__((ext_vector_type(8))) short;
using f32x16 = __attribute__((ext_vector_type(16))) float;
using u32x4 = __attribute__((ext_vector_type(4))) unsigned;
using u32x2 = __attribute__((ext_vector_type(2))) unsigned;

struct Params {
  const float *x, *c, *ctx, *c_ctx, *ada_w, *ada_b, *ln_g, *ln_b, *mix_w_out, *att_w_in, *na_rpb, *qk_gain,
      *rec_w_in, *rwkv_mu, *rwkv_w0, *rwkv_w1, *rwkv_w2, *rwkv_a0, *rwkv_a1, *rwkv_a2, *rwkv_g1, *rwkv_g2,
      *rwkv_kvec, *rwkv_rk, *rwkv_gn, *mlstm_gate_b, *mlstm_norm, *moe_router, *moe_bias, *moe_w1, *moe_w3,
      *moe_w2, *shared_w1, *shared_w3, *shared_w2;
  float* out;
  bf16_t *Wt_att, *Wt_rec, *Wt_out, *Wt13, *Wt2, *Wl1, *Wl2;
  bf16_t *Zb, *L1;
  float *X, *MOD, *MODP, *GP, *msc, *lgate, *MSn, *Tb, *ROPE, *WrT;
  bf16_t *AB, *P, *RW, *MS, *ACT, *OUT2;
  int *cnt, *ltok, *tsl;
  unsigned* bar;
  int ph_lo, ph_hi;
};

typedef const Params __attribute__((address_space(4))) * KP;

__device__ __forceinline__ int modrow(int t) { return t < NL ? (t >> 11) : 8; }
__device__ __forceinline__ float silu_f(float x) { return x / (1.f + expf(-x)); }
__device__ __forceinline__ float sigm_f(float x) { return 1.f / (1.f + expf(-x)); }
__device__ __forceinline__ float softplus_f(float x) { return fmaxf(x, 0.f) + log1pf(expf(-fabsf(x))); }
template <int CTRL>
__device__ __forceinline__ float dppx(float x) {
  return __int_as_float(__builtin_amdgcn_update_dpp(0, __float_as_int(x), CTRL, 0xf, 0xf, true));
}
__device__ __forceinline__ float rdlane(float v, int l) {
  return __int_as_float(__builtin_amdgcn_readlane(__float_as_int(v), l));
}
__device__ __forceinline__ float wsum(float v) {
  v += dppx<0xB1>(v); v += dppx<0x4E>(v); v += dppx<0x141>(v); v += dppx<0x140>(v);
  return (rdlane(v, 0) + rdlane(v, 16)) + (rdlane(v, 32) + rdlane(v, 48));
}
__device__ __forceinline__ float wmax(float v) {
  v = fmaxf(v, dppx<0xB1>(v)); v = fmaxf(v, dppx<0x4E>(v)); v = fmaxf(v, dppx<0x141>(v)); v = fmaxf(v, dppx<0x140>(v));
  return fmaxf(fmaxf(rdlane(v, 0), rdlane(v, 16)), fmaxf(rdlane(v, 32), rdlane(v, 48)));
}
__device__ __forceinline__ int opaque_tid() {
  int t = threadIdx.x;
  asm volatile("" : "+v"(t));
  return t;
}
typedef __bf16 bf16x2_t __attribute__((ext_vector_type(2)));
typedef float f32x2_t __attribute__((ext_vector_type(2)));
__device__ __forceinline__ unsigned pk_bf16(float lo, float hi) {
  const f32x2_t v = {lo, hi};
  return __builtin_bit_cast(unsigned, __builtin_convertvector(v, bf16x2_t));
}
__device__ __forceinline__ bf16_t f2bf(float x) { return (bf16_t)(pk_bf16(x, 0.f) & 0xffffu); }
__device__ __forceinline__ float bf2f(bf16_t v) { return __uint_as_float((unsigned)v << 16); }
__device__ __forceinline__ float bflo(unsigned u) { return __uint_as_float(u << 16); }
__device__ __forceinline__ float bfhi(unsigned u) { return __uint_as_float(u & 0xffff0000u); }
__device__ __forceinline__ int scan_row(int dir, int b, int tau) {
  if (tau < CTXL) return NL + b * CTXL + (dir ? (CTXL - 1 - tau) : tau);
  int s = tau - CTXL;
  return b * SEQ + (dir ? (SEQ - 1 - s) : s);
}

template <class RowPtrA>
__device__ __forceinline__ void gemm128_main(int tid, RowPtrA rowA, const bf16_t* __restrict__ Bt, int K, int n0,
                                             char* lds, f32x16 (&acc)[2][2]) {
  const int lane = tid & 63, w = tid >> 6;
  const int wm = w >> 1, wn = w & 1, r = lane & 31, h = lane >> 5;
  const int c = tid & 7, sr = tid >> 3;
  const int lc = (c ^ ((tid >> 4) & 7)) * 8;
  const bf16_t* ap[4];
#pragma unroll
  for (int i = 0; i < 4; ++i) ap[i] = rowA(sr + 32 * i) + lc;
  const bf16_t* bp0 = Bt + (size_t)(n0 + sr) * K + lc;
  const int bstr = 32 * K;
#pragma unroll
  for (int mi = 0; mi < 2; ++mi)
#pragma unroll
    for (int ni = 0; ni < 2; ++ni)
#pragma unroll
      for (int q = 0; q < 16; ++q) acc[mi][ni][q] = 0.f;
  const int nk = K >> 6;
  auto issue = [&](int kt) {
    char* As = lds + (kt & 1) * 32768 + tid * 16;
    const int k0 = kt * 64;
#pragma unroll
    for (int i = 0; i < 4; ++i) {
      __builtin_amdgcn_global_load_lds((const unsigned*)(ap[i] + k0), (__attribute__((address_space(3))) unsigned*)(As + i * 4096), 16, 0, 0);
      __builtin_amdgcn_global_load_lds((const unsigned*)(bp0 + i * bstr + k0), (__attribute__((address_space(3))) unsigned*)(As + 16384 + i * 4096), 16, 0, 0);
    }
  };
  issue(0);
  const int sw = (r >> 1) & 7;
#pragma unroll 1
  for (int kt = 0; kt < nk; ++kt) {
    asm volatile("s_waitcnt vmcnt(0)" ::: "memory");
    __syncthreads();
    if (kt + 1 < nk) issue(kt + 1);
    const char* As = lds + (kt & 1) * 32768;
    const char* Ar = As + (wm * 64 + r) * 128;
    const char* Br = As + 16384 + (wn * 64 + r) * 128;
#pragma unroll
    for (int ks = 0; ks < 4; ++ks) {
      const int off = ((ks * 2 + h) ^ sw) * 16;
      const bf16x8 a0 = *(const bf16x8*)(Ar + off);
      const bf16x8 a1 = *(const bf16x8*)(Ar + 32 * 128 + off);
      const bf16x8 b0 = *(const bf16x8*)(Br + off);
      const bf16x8 b1 = *(const bf16x8*)(Br + 32 * 128 + off);
      acc[0][0] = __builtin_amdgcn_mfma_f32_32x32x16_bf16(a0, b0, acc[0][0], 0, 0, 0);
      acc[0][1] = __builtin_amdgcn_mfma_f32_32x32x16_bf16(a0, b1, acc[0][1], 0, 0, 0);
      acc[1][0] = __builtin_amdgcn_mfma_f32_32x32x16_bf16(a1, b0, acc[1][0], 0, 0, 0);
      acc[1][1] = __builtin_amdgcn_mfma_f32_32x32x16_bf16(a1, b1, acc[1][1], 0, 0, 0);
    }
  }
  __syncthreads();
}
using i64 = long;
template <class RowPtrA8>
__device__ __forceinline__ void gemm128_fp8(int tid, RowPtrA8 rowA, const unsigned char* __restrict__ Bt, int K, int n0,
                                            char* lds, f32x16 (&acc)[2][2]) {
  const int lane = tid & 63, w = tid >> 6;
  const int wm = w >> 1, wn = w & 1, r = lane & 31, h = lane >> 5;
  const int c = tid & 7, sr = tid >> 3;
  const int lc = (c ^ ((tid >> 4) & 7)) * 16;
  const unsigned char* ap[4];
#pragma unroll
  for (int i = 0; i < 4; ++i) ap[i] = rowA(sr + 32 * i) + lc;
  const unsigned char* bp0 = Bt + (size_t)(n0 + sr) * K + lc;
  const int bstr = 32 * K;
#pragma unroll
  for (int mi = 0; mi < 2; ++mi)
#pragma unroll
    for (int ni = 0; ni < 2; ++ni)
#pragma unroll
      for (int q = 0; q < 16; ++q) acc[mi][ni][q] = 0.f;
  const int nk = K >> 7;
  auto issue = [&](int kt) {
    char* As = lds + (kt & 1) * 32768 + tid * 16;
    const int k0 = kt * 128;
#pragma unroll
    for (int i = 0; i < 4; ++i) {
      __builtin_amdgcn_global_load_lds((const unsigned*)(ap[i] + k0), (__attribute__((address_space(3))) unsigned*)(As + i * 4096), 16, 0, 0);
      __builtin_amdgcn_global_load_lds((const unsigned*)(bp0 + i * bstr + k0), (__attribute__((address_space(3))) unsigned*)(As + 16384 + i * 4096), 16, 0, 0);
    }
  };
  issue(0);
  const int sw = (r >> 1) & 7;
#pragma unroll 1
  for (int kt = 0; kt < nk; ++kt) {
    asm volatile("s_waitcnt vmcnt(0)" ::: "memory");
    __syncthreads();
    if (kt + 1 < nk) issue(kt + 1);
    const char* As = lds + (kt & 1) * 32768;
    const char* Ar = As + (wm * 64 + r) * 128;
    const char* Br = As + 16384 + (wn * 64 + r) * 128;
#pragma unroll
    for (int q = 0; q < 4; ++q) {
      const int off = ((q * 2 + h) ^ sw) * 16;
      const u32x4 a0 = *(const u32x4*)(Ar + off);
      const u32x4 a1 = *(const u32x4*)(Ar + 32 * 128 + off);
      const u32x4 b0 = *(const u32x4*)(Br + off);
      const u32x4 b1 = *(const u32x4*)(Br + 32 * 128 + off);
      const i64 a0l = (i64)(((unsigned long long)a0.y << 32) | a0.x), a0h = (i64)(((unsigned long long)a0.w << 32) | a0.z);
      const i64 a1l = (i64)(((unsigned long long)a1.y << 32) | a1.x), a1h = (i64)(((unsigned long long)a1.w << 32) | a1.z);
      const i64 b0l = (i64)(((unsigned long long)b0.y << 32) | b0.x), b0h = (i64)(((unsigned long long)b0.w << 32) | b0.z);
      const i64 b1l = (i64)(((unsigned long long)b1.y << 32) | b1.x), b1h = (i64)(((unsigned long long)b1.w << 32) | b1.z);
      acc[0][0] = __builtin_amdgcn_mfma_f32_32x32x16_fp8_fp8(a0l, b0l, acc[0][0], 0, 0, 0);
      acc[0][1] = __builtin_amdgcn_mfma_f32_32x32x16_fp8_fp8(a0l, b1l, acc[0][1], 0, 0, 0);
      acc[1][0] = __builtin_amdgcn_mfma_f32_32x32x16_fp8_fp8(a1l, b0l, acc[1][0], 0, 0, 0);
      acc[1][1] = __builtin_amdgcn_mfma_f32_32x32x16_fp8_fp8(a1l, b1l, acc[1][1], 0, 0, 0);
      acc[0][0] = __builtin_amdgcn_mfma_f32_32x32x16_fp8_fp8(a0h, b0h, acc[0][0], 0, 0, 0);
      acc[0][1] = __builtin_amdgcn_mfma_f32_32x32x16_fp8_fp8(a0h, b1h, acc[0][1], 0, 0, 0);
      acc[1][0] = __builtin_amdgcn_mfma_f32_32x32x16_fp8_fp8(a1h, b0h, acc[1][0], 0, 0, 0);
      acc[1][1] = __builtin_amdgcn_mfma_f32_32x32x16_fp8_fp8(a1h, b1h, acc[1][1], 0, 0, 0);
    }
  }
  __syncthreads();
}
template <class F>
__device__ __forceinline__ void acc_foreach(int tid, const f32x16 (&acc)[2][2], F f) {
  const int lane = tid & 63, w = tid >> 6;
  const int wm = w >> 1, wn = w & 1, r = lane & 31, h = lane >> 5;
#pragma unroll
  for (int mi = 0; mi < 2; ++mi)
#pragma unroll
    for (int ni = 0; ni < 2; ++ni)
#pragma unroll
      for (int q = 0; q < 16; ++q) {
        const int row = wm * 64 + mi * 32 + (q & 3) + 8 * (q >> 2) + 4 * h;
        const int col = wn * 64 + ni * 32 + r;
        f(row, col, acc[mi][ni][q]);
        if ((q & 3) == 3) __builtin_amdgcn_sched_barrier(0);
      }
}

template <class RM>
__device__ __forceinline__ void tr_tile(int tid, const float* __restrict__ src, int N, int k0, int n0,
                                        bf16_t* __restrict__ dst, int K, RM rowmap, float* tile) {
  {
    const int tx = tid & 15, ty = tid >> 4;
    const int n = n0 + tx * 4;
#pragma unroll
    for (int i = 0; i < 4; ++i) {
      const int k = ty + 16 * i;
      float4 v = make_float4(0.f, 0.f, 0.f, 0.f);
      if (n < N) v = *(const float4*)(src + (size_t)(k0 + k) * N + n);
      tile[k * 65 + tx * 4 + 0] = v.x; tile[k * 65 + tx * 4 + 1] = v.y;
      tile[k * 65 + tx * 4 + 2] = v.z; tile[k * 65 + tx * 4 + 3] = v.w;
    }
  }
  __syncthreads();
  {
    const int kc = tid & 7;
#pragma unroll
    for (int i = 0; i < 2; ++i) {
      const int n = (tid >> 3) + 32 * i;
      if (n0 + n < N) {
        float v[8];
#pragma unroll
        for (int q = 0; q < 8; ++q) v[q] = tile[(kc * 8 + q) * 65 + n];
        u32x4 o;
        o.x = pk_bf16(v[0], v[1]); o.y = pk_bf16(v[2], v[3]); o.z = pk_bf16(v[4], v[5]); o.w = pk_bf16(v[6], v[7]);
        *(u32x4*)(dst + (size_t)rowmap(n0 + n) * K + k0 + kc * 8) = o;
      }
    }
  }
  __syncthreads();
}

constexpr float W8_SCALE = 32.f, W8_INV = 1.f / 32.f;
__device__ __forceinline__ unsigned pk_fp8x4(float a, float b, float c, float d) {
  int r = __builtin_amdgcn_cvt_pk_fp8_f32(a, b, 0, false);
  r = __builtin_amdgcn_cvt_pk_fp8_f32(c, d, r, true);
  return (unsigned)r;
}
__device__ __forceinline__ unsigned pk_fp8x4c(float a, float b, float c, float d) {
  constexpr float M = 448.f;
  return pk_fp8x4(fminf(fmaxf(a, -M), M), fminf(fmaxf(b, -M), M), fminf(fmaxf(c, -M), M), fminf(fmaxf(d, -M), M));
}
template <class RM>
__device__ __forceinline__ void tr_tile_fp8(int tid, const float* __restrict__ src, int N, int k0, int n0,
                                            unsigned char* __restrict__ dst, int K, RM rowmap, float* tile) {
  {
    const int tx = tid & 15, ty = tid >> 4;
    const int n = n0 + tx * 4;
#pragma unroll
    for (int i = 0; i < 4; ++i) {
      const int k = ty + 16 * i;
      float4 v = make_float4(0.f, 0.f, 0.f, 0.f);
      if (n < N) v = *(const float4*)(src + (size_t)(k0 + k) * N + n);
      tile[k * 65 + tx * 4 + 0] = v.x; tile[k * 65 + tx * 4 + 1] = v.y;
      tile[k * 65 + tx * 4 + 2] = v.z; tile[k * 65 + tx * 4 + 3] = v.w;
    }
  }
  __syncthreads();
  {
    const int kc = tid & 3, n = tid >> 2;
    float v[16];
#pragma unroll
    for (int q = 0; q < 16; ++q) v[q] = tile[(kc * 16 + q) * 65 + n] * W8_SCALE;
    u32x4 o;
    o.x = pk_fp8x4c(v[0], v[1], v[2], v[3]); o.y = pk_fp8x4c(v[4], v[5], v[6], v[7]);
    o.z = pk_fp8x4c(v[8], v[9], v[10], v[11]); o.w = pk_fp8x4c(v[12], v[13], v[14], v[15]);
    *(u32x4*)(dst + (size_t)rowmap(n0 + n) * K + k0 + kc * 16) = o;
  }
  __syncthreads();
}

constexpr int CJ0 = 1152, CJ1 = CJ0 + 2080, CJ2 = CJ1 + 1024, CJ3 = CJ2 + 33280, CJ4 = CJ3 + 16640;
__device__ void convert_job(KP p, int job, float* sm, int tid) {
  if (job < CJ0) {
    const int j = job / 576, rem = job % 576, kt = rem / 36, nt = rem % 36;
    tr_tile_fp8(tid, p->att_w_in + (size_t)j * 1024 * ATT_N, ATT_N, kt * 64, nt * 64, (unsigned char*)p->Wt_att + (size_t)j * ATT_N * 1024,
                1024, [](int n) { return n; }, sm);
  } else if (job < CJ1) {
    const int q = job - CJ0;
    const int j = q / 1040, rem = q % 1040, kt = rem / 65, nt = rem % 65;
    tr_tile_fp8(tid, p->rec_w_in + (size_t)j * 1024 * REC_N, REC_N, kt * 64, nt * 64, (unsigned char*)p->Wt_rec + (size_t)j * REC_NP * 1024,
                1024, [](int n) { return n; }, sm);
  } else if (job < CJ2) {
    const int q = job - CJ1;
    const int i = q >> 8, rem = q & 255, kt = rem >> 4, nt = rem & 15;
    tr_tile_fp8(tid, p->mix_w_out + (size_t)i * 1024 * 1024, 1024, kt * 64, nt * 64, (unsigned char*)p->Wt_out + (size_t)i * 1024 * 1024,
                1024, [](int n) { return n; }, sm);
  } else if (job < CJ3) {
    const int q = job - CJ2;
    const int le = q >> 7, rem = q & 127;
    const int which = rem >> 6, kt = (rem >> 2) & 15, nt = rem & 3;
    const int layer = le / 65, e = le % 65;
    const float* src;
    if (e < 64) src = (which ? p->moe_w3 : p->moe_w1) + (size_t)(layer * 64 + e) * 1024 * 256;
    else src = (which ? p->shared_w3 : p->shared_w1) + (size_t)layer * 1024 * 256;
    tr_tile_fp8(tid, src, 256, kt * 64, nt * 64, (unsigned char*)p->Wt13 + (size_t)le * 512 * 1024, 1024,
                [which](int n) { return 64 * (n >> 5) + which * 32 + (n & 31); }, sm);
  } else {
    const int q = job - CJ3;
    const int le = q >> 6, rem = q & 63;
    const int kt = rem >> 4, nt = rem & 15;
    const int layer = le / 65, e = le % 65;
    const float* src = e < 64 ? p->moe_w2 + (size_t)(layer * 64 + e) * 256 * 1024 : p->shared_w2 + (size_t)layer * 256 * 1024;
    tr_tile_fp8(tid, src, 1024, kt * 64, nt * 64, (unsigned char*)p->Wt2 + (size_t)le * 1024 * 256, 256, [](int n) { return n; }, sm);
  }
}
__device__ __forceinline__ int conv_stage_total(int stage) {
  return stage == 0 ? (576 + 1040 + 512 + 8320 + 4160) : (stage == 1 ? (576 + 1040 + 256 + 16640 + 8320) : (256 + 8320 + 4160));
}
__device__ __forceinline__ int conv_stage_job(int stage, int q) {
  if (stage == 0) {
    if (q < 8320) return CJ2 + q;  q -= 8320;
    if (q < 4160) return CJ3 + q;  q -= 4160;
    if (q < 576) return q;  q -= 576;
    if (q < 1040) return CJ0 + q;  q -= 1040;
    return CJ1 + q;
  } else if (stage == 1) {
    if (q < 8320) return CJ2 + 8320 + q;  q -= 8320;
    if (q < 4160) return CJ3 + 4160 + q;  q -= 4160;
    if (q < 576) return 576 + q;  q -= 576;
    if (q < 256) return CJ1 + 512 + q;  q -= 256;
    if (q < 8320) return CJ2 + 16640 + q;  q -= 8320;
    if (q < 4160) return CJ3 + 8320 + q;  q -= 4160;
    return CJ0 + 1040 + q;
  }
  if (q < 256) return CJ1 + 768 + q;  q -= 256;
  if (q < 8320) return CJ2 + 24960 + q;  q -= 8320;
  return CJ3 + 12480 + q;
}

struct CvDesc { const float* src; unsigned char* dst; int N, K, k0, n0, which; };
__device__ __forceinline__ bool conv_desc_fp8(KP p, int job, CvDesc& d) {
  if (job < CJ2) return false;
  if (job < CJ3) {
    const int q = job - CJ2;
    const int le = q >> 7, rem = q & 127;
    const int which = rem >> 6, kt = (rem >> 2) & 15, nt = rem & 3;
    const int layer = le / 65, e = le % 65;
    if (e < 64) d.src = (which ? p->moe_w3 : p->moe_w1) + (size_t)(layer * 64 + e) * 1024 * 256;
    else d.src = (which ? p->shared_w3 : p->shared_w1) + (size_t)layer * 1024 * 256;
    d.dst = (unsigned char*)p->Wt13 + (size_t)le * 512 * 1024;
    d.N = 256; d.K = 1024; d.k0 = kt * 64; d.n0 = nt * 64; d.which = which;
  } else {
    const int q = job - CJ3;
    const int le = q >> 6, rem = q & 63;
    const int kt = rem >> 4, nt = rem & 15;
    const int layer = le / 65, e = le % 65;
    d.src = e < 64 ? p->moe_w2 + (size_t)(layer * 64 + e) * 256 * 1024 : p->shared_w2 + (size_t)layer * 256 * 1024;
    d.dst = (unsigned char*)p->Wt2 + (size_t)le * 1024 * 256;
    d.N = 1024; d.K = 256; d.k0 = kt * 64; d.n0 = nt * 64; d.which = -1;
  }
  return true;
}
typedef float cvf4 __attribute__((ext_vector_type(4)));
__device__ __forceinline__ void cv_load(const CvDesc& d, int tid, cvf4& v0, cvf4& v1, cvf4& v2, cvf4& v3) {
  const int tx = tid & 15, ty = tid >> 4;
  const float* s0 = d.src + (size_t)(d.k0 + ty) * d.N + d.n0 + tx * 4;
  v0 = *(const cvf4*)(s0);
  v1 = *(const cvf4*)(s0 + (size_t)16 * d.N);
  v2 = *(const cvf4*)(s0 + (size_t)32 * d.N);
  v3 = *(const cvf4*)(s0 + (size_t)48 * d.N);
}
__device__ __forceinline__ void cv_emit(const CvDesc& d, int tid, const cvf4 v0, const cvf4 v1, const cvf4 v2, const cvf4 v3, float* tile) {
  {
    const int tx = tid & 15, ty = tid >> 4;
    float* t0 = tile + ty * 65 + tx * 4;
    t0[0] = v0.x; t0[1] = v0.y; t0[2] = v0.z; t0[3] = v0.w;
    t0[16 * 65 + 0] = v1.x; t0[16 * 65 + 1] = v1.y; t0[16 * 65 + 2] = v1.z; t0[16 * 65 + 3] = v1.w;
    t0[32 * 65 + 0] = v2.x; t0[32 * 65 + 1] = v2.y; t0[32 * 65 + 2] = v2.z; t0[32 * 65 + 3] = v2.w;
    t0[48 * 65 + 0] = v3.x; t0[48 * 65 + 1] = v3.y; t0[48 * 65 + 2] = v3.z; t0[48 * 65 + 3] = v3.w;
  }
  __syncthreads();
  {
    const int kc = tid & 3, n = tid >> 2;
    float v[16];
#pragma unroll
    for (int q = 0; q < 16; ++q) v[q] = tile[(kc * 16 + q) * 65 + n] * W8_SCALE;
    u32x4 o;
    o.x = pk_fp8x4c(v[0], v[1], v[2], v[3]); o.y = pk_fp8x4c(v[4], v[5], v[6], v[7]);
    o.z = pk_fp8x4c(v[8], v[9], v[10], v[11]); o.w = pk_fp8x4c(v[12], v[13], v[14], v[15]);
    const int nn = d.n0 + n;
    const int row = d.which >= 0 ? 64 * (nn >> 5) + d.which * 32 + (nn & 31) : nn;
    *(u32x4*)(d.dst + (size_t)row * d.K + d.k0 + kc * 16) = o;
  }
  __syncthreads();
}
__device__ __forceinline__ void convert_run(KP p, int stage, int jj, int j1, float* sm, int tid) {
  CvDesc d, dn;
  cvf4 a0, a1, a2, a3, b0, b1, b2, b3;
  bool cur = false;
#pragma unroll 1
  for (; jj < j1; ++jj) {
    const int job = conv_stage_job(stage, jj);
    if (!cur) {
      if (!conv_desc_fp8(p, job, d)) { convert_job(p, job, sm, tid); continue; }
      cv_load(d, tid, a0, a1, a2, a3);
    }
    bool nxt = false;
    if (jj + 1 < j1) {
      nxt = conv_desc_fp8(p, conv_stage_job(stage, jj + 1), dn);
      if (nxt) cv_load(dn, tid, b0, b1, b2, b3);
    }
    cv_emit(d, tid, a0, a1, a2, a3, sm);
    if (nxt) { d = dn; a0 = b0; a1 = b1; a2 = b2; a3 = b3; }
    cur = nxt;
  }
}

__device__ void ph_init(KP p, char* smc) {
  float* sm = (float*)smc;
  const int tid = opaque_tid();
  {
    const size_t n4a = (size_t)NL * DM / 4, n4b = (size_t)NC * DM / 4;
    const float4* xs = (const float4*)p->x;
    const float4* cs = (const float4*)p->ctx;
    float4* X4 = (float4*)p->X;
    for (size_t i = (size_t)blockIdx.x * NTHR + tid; i < n4a + n4b; i += (size_t)gridDim.x * NTHR)
      X4[i] = i < n4a ? xs[i] : cs[i - n4a];
  }
  for (int tile = blockIdx.x; tile < 96 * 8; tile += gridDim.x) {
    const int ct = tile >> 3, ks = tile & 7;
    for (int i = tid; i < 9 * 128; i += NTHR) {
      const int r = i >> 7, k = ks * 128 + (i & 127);
      const float v = r < 8 ? p->c[r * 1024 + k] : p->c_ctx[k];
      sm[i] = silu_f(v);
    }
    __syncthreads();
    const int col = ct * 256 + tid;
    const int layer = col / 6144, n = col % 6144;
    const float* W = p->ada_w + ((size_t)layer * 1024 + ks * 128) * 6144 + n;
    float acc[9];
#pragma unroll
    for (int r = 0; r < 9; ++r) acc[r] = 0.f;
#pragma unroll 4
    for (int k = 0; k < 128; ++k) {
      const float w = W[(size_t)k * 6144];
#pragma unroll
      for (int r = 0; r < 9; ++r) acc[r] = fmaf(sm[r * 128 + k], w, acc[r]);
    }
#pragma unroll
    for (int r = 0; r < 9; ++r) p->MODP[((size_t)(ks * 4 + layer) * 9 + r) * 6144 + n] = acc[r];
    __syncthreads();
  }
  {
    const int total = conv_stage_total(0), chunk = (total + gridDim.x - 1) / gridDim.x;
    const int lo = min((int)blockIdx.x * chunk, total), hi = min(lo + chunk, total);
    __syncthreads();
    convert_run(p, 0, lo, hi, sm, tid);
  }
  for (int i = blockIdx.x * NTHR + tid; i < 2 * 3 * 128 * 512; i += gridDim.x * NTHR) {
    const int k = i & 511, n = (i >> 9) & 127, wj = i >> 16;
    const int j = wj / 3, which = wj % 3;
    float v = 0.f;
    if (which < 2) {
      if (n < 64) v = (which ? p->rwkv_a1 : p->rwkv_w1)[((size_t)(j * 2 + (n >> 5)) * 512 + k) * 32 + (n & 31)];
    } else if (n < 96) v = p->rwkv_g1[((size_t)j * 512 + k) * 96 + n];
    p->Wl1[i] = f2bf(v);
  }
  for (int i = blockIdx.x * NTHR + tid; i < 2 * 2560 * 128; i += gridDim.x * NTHR) {
    const int k = i & 127, n = (i >> 7) % 2560, j = i / (2560 * 128);
    float v = 0.f;
    if (n < 2048) {
      const int d = (n >> 9) & 1, c = n & 511;
      if (k < 64 && (k >> 5) == d) v = (n < 1024 ? p->rwkv_w2 : p->rwkv_a2)[((size_t)(j * 2 + d) * 32 + (k & 31)) * 512 + c];
    } else if (k < 96) v = p->rwkv_g2[((size_t)j * 96 + k) * 512 + (n - 2048)];
    p->Wl2[i] = f2bf(v);
  }
  for (int i = blockIdx.x * NTHR + tid; i < 4 * 64 * 1024; i += gridDim.x * NTHR) {
    const int k = i & 1023, n = (i >> 10) & 63, l = i >> 16;
    p->WrT[i] = p->moe_router[((size_t)l * 1024 + k) * 64 + n];
  }
  for (int i = blockIdx.x * NTHR + tid; i < 64 * 16; i += gridDim.x * NTHR) {
    const int pos = i >> 4, f = i & 15;
    const float ang = (float)pos * powf(10000.f, -(float)f / 16.f);
    p->ROPE[2 * i] = cosf(ang);
    p->ROPE[2 * i + 1] = sinf(ang);
  }
}

__device__ void ph_mod_h(KP p, char* smc) {
  float* sm = (float*)smc;
  const int tid = opaque_tid();
  for (int i = blockIdx.x * NTHR + tid; i < 4 * 9 * 6144; i += gridDim.x * NTHR) {
    const int layer = i / (9 * 6144), rem = i % (9 * 6144), n = rem % 6144;
    float s = p->ada_b[layer * 6144 + n];
#pragma unroll
    for (int ks = 0; ks < 8; ++ks) s += p->MODP[(size_t)(ks * 4 + layer) * 9 * 6144 + rem];
    p->MOD[i] = s;
  }
  const int lane = tid & 63, wave = tid >> 6;
  const int per = (((NT + gridDim.x - 1) / gridDim.x) + 3) & ~3;
  const int t0 = blockIdx.x * per, t1 = min(NT, t0 + per);
  int cur = -1;
  for (int tb = t0; tb < t1; tb += 4) {
    const int mr = modrow(tb);
    if (mr != cur) {
      __syncthreads();
      for (int n = tid; n < 2048; n += NTHR) {
        float a = p->ada_b[n];
#pragma unroll
        for (int ks = 0; ks < 8; ++ks) a += p->MODP[((size_t)(ks * 4) * 9 + mr) * 6144 + n];
        sm[n] = a;
      }
      cur = mr;
      __syncthreads();
    }
    const int t = tb + wave;
    if (t < t1) {
      const float* src = t < NL ? p->x + (size_t)t * DM : p->ctx + (size_t)(t - NL) * DM;
#pragma unroll
      for (int i = 0; i < 4; ++i) {
        const int n = i * 256 + lane * 4;
        const float4 xv = *(const float4*)(src + n);
        const float4 sh = *(const float4*)(sm + n);
        const float4 sc = *(const float4*)(sm + 1024 + n);
        *(unsigned*)((unsigned char*)p->AB + (size_t)t * DM + n) =
            pk_fp8x4c(xv.x * (1.f + sc.x) + sh.x, xv.y * (1.f + sc.y) + sh.y, xv.z * (1.f + sc.z) + sh.z, xv.w * (1.f + sc.w) + sh.w);
      }
    }
  }
}

typedef short v4i16_t __attribute__((ext_vector_type(4)));
using s16x4 = __attribute__((ext_vector_type(4))) short;
__device__ __forceinline__ s16x4 vtr(const char* p) {
  return __builtin_bit_cast(s16x4, __builtin_amdgcn_ds_read_tr16_b64_v4i16((__attribute__((address_space(3))) v4i16_t*)p));
}
#define MFMA32(a, b, c) __builtin_amdgcn_mfma_f32_32x32x16_bf16(a, b, c, 0, 0, 0)
__device__ void ph_attention(KP p, int layer, bool keep, char* lds) {
  const int tid = opaque_tid();
  const int lane = tid & 63, w = tid >> 6, r32 = lane & 31, hi = lane >> 5;
  const int j = layer >> 1;
  float* bias_lds = (float*)(lds + 32768 + 1024);
  const int n_gqa = 1024, n_na = 1024, n_cb = keep ? 128 : 0, n_ca = keep ? 128 : 0;
  const int total = n_gqa + n_na + n_cb + n_ca;
  constexpr float LOG2E = 1.4426950408889634f;
  constexpr float C2 = 0.125f * LOG2E;
  const int c = tid & 7, sr = tid >> 3;
  const int kso = (c ^ ((tid >> 4) & 7)) * 16;
  const int vso = (c >> 2) * 4096 + (c & 3) * 16;
  const int sw = (r32 >> 1) & 7;
  for (int vitem = blockIdx.x; vitem < total; vitem += gridDim.x) {
    int item = vitem;
    if (gridDim.x == 512) {
      const int cls0 = vitem < n_gqa ? 0 : (vitem < n_gqa + n_na ? n_gqa : (vitem < n_gqa + n_na + n_cb ? n_gqa + n_na : n_gqa + n_na + n_cb));
      const int vl = vitem - cls0, b9 = vl & 511, r9 = vl >> 9;
      item = cls0 + (cls0 < n_gqa + n_na ? 128 * (b9 & 7) + 64 * r9 + (b9 >> 3) : 16 * (b9 & 7) + (b9 >> 3));
    }
    int b, qrow0, qoff, koff, voff, ocol, lat_tiles, lat_row0;
    bool na = false;
    int r_w = 0, start_w = 0, ru0 = 0, hN = 0;
    if (item < n_gqa) {
      b = item >> 7;
      const int g = (item >> 6) & 1, tt = item & 63;
      qrow0 = b * SEQ + tt * 32; qoff = 1536 + (g * 4 + w) * 64; koff = 2048 + g * 64; voff = 2176 + g * 64;
      ocol = 512 + (g * 4 + w) * 64; lat_tiles = 32; lat_row0 = b * SEQ;
    } else if (item < n_gqa + n_na) {
      const int it = item - n_gqa;
      b = it >> 7; hN = (it >> 4) & 7;
      const int rp = it & 15;
      na = true; r_w = 2 * rp + (w >> 1);
      qrow0 = b * SEQ + r_w * 64 + (w & 1) * 32; qoff = hN * 64; koff = 512 + hN * 64; voff = 1024 + hN * 64; ocol = hN * 64;
      const int s0 = min(max(2 * rp - 4, 0), 24), s1 = min(max(2 * rp - 3, 0), 24);
      start_w = (w >> 1) ? s1 : s0; ru0 = s0; lat_tiles = (s1 != s0) ? 9 : 8; lat_row0 = b * SEQ + ru0 * 64;
    } else if (item < n_gqa + n_na + n_cb) {
      const int it = item - n_gqa - n_na;
      b = it >> 4;
      const int g = (it >> 3) & 1, tt = it & 7;
      qrow0 = NL + b * CTXL + tt * 32; qoff = 1536 + (g * 4 + w) * 64; koff = 2048 + g * 64; voff = 2176 + g * 64;
      ocol = 512 + (g * 4 + w) * 64; lat_tiles = 0; lat_row0 = 0;
    } else {
      const int it = item - n_gqa - n_na - n_cb;
      b = it >> 4;
      const int h = (it >> 1) & 7, half = it & 1;
      qrow0 = NL + b * CTXL + half * 128 + w * 32; qoff = h * 64; koff = 512 + h * 64; voff = 1024 + h * 64; ocol = h * 64;
      lat_tiles = 0; lat_row0 = 0;
    }
    const int ctx_row0 = NL + b * CTXL, ntiles = lat_tiles + 4;
    if (na)
      for (int i = tid; i < 465; i += NTHR) bias_lds[i] = p->na_rpb[(j * 8 + hN) * 465 + i] * LOG2E;
    bf16x8 qf[4];
    {
      const bf16_t* qp = p->P + (size_t)(qrow0 + r32) * LDP + qoff + hi * 8;
#pragma unroll
      for (int d0 = 0; d0 < 4; ++d0) qf[d0] = *(const bf16x8*)(qp + d0 * 16);
    }
    f32x16 o0, o1;
#pragma unroll
    for (int q = 0; q < 16; ++q) { o0[q] = 0.f; o1[q] = 0.f; }
    float m = -INFINITY, l = 0.f;
    u32x4 kr0, kr1, vr0, vr1;
    auto gload = [&](int t) {
      const int row0 = t < lat_tiles ? lat_row0 + 64 * t : ctx_row0 + 64 * (t - lat_tiles);
      const bf16_t* base = p->P + (size_t)(row0 + sr) * LDP + c * 8;
      kr0 = *(const u32x4*)(base + koff); kr1 = *(const u32x4*)(base + (size_t)32 * LDP + koff);
      vr0 = *(const u32x4*)(base + voff); vr1 = *(const u32x4*)(base + (size_t)32 * LDP + voff);
    };
    auto swrite = [&](int buf) {
      char* Kb = lds + buf * 16384;
      char* Vb = Kb + 8192;
      *(u32x4*)(Kb + sr * 128 + kso) = kr0; *(u32x4*)(Kb + (sr + 32) * 128 + kso) = kr1;
      *(u32x4*)(Vb + vso + sr * 64) = vr0; *(u32x4*)(Vb + vso + (sr + 32) * 64) = vr1;
    };
    gload(0);
    swrite(0);
    for (int t = 0; t < ntiles; ++t) {
      __syncthreads();
      if (t + 1 < ntiles) gload(t + 1);
      const bool na_tile = na && t < lat_tiles;
      const int kr = ru0 + t;
      const bool part = !na_tile || (kr >= start_w && kr < start_w + 8);
      if (part) {
        const char* Ks = lds + (t & 1) * 16384;
        const char* Vs = Ks + 8192;
        f32x16 s0, s1;
#pragma unroll
        for (int q = 0; q < 16; ++q) { s0[q] = 0.f; s1[q] = 0.f; }
#pragma unroll
        for (int d0 = 0; d0 < 4; ++d0) {
          const int off = ((2 * d0 + hi) ^ sw) * 16;
          const bf16x8 k0 = *(const bf16x8*)(Ks + r32 * 128 + off);
          const bf16x8 k1 = *(const bf16x8*)(Ks + (32 + r32) * 128 + off);
          s0 = MFMA32(k0, qf[d0], s0);
          s1 = MFMA32(k1, qf[d0], s1);
        }
        float mx = -INFINITY;
        if (na_tile) {
          const int cq = (w & 1) * 32 + r32;
          const int c0 = min(max(cq - 8, 0), 48);
          const float* brow = bias_lds + (kr - r_w + 7) * 31 + (15 - cq);
#pragma unroll
          for (int q = 0; q < 16; ++q) {
            const int kc = (q & 3) + 8 * (q >> 2) + 4 * hi;
            const float v0 = ((unsigned)(kc - c0) < 16u) ? fmaf(s0[q], C2, brow[kc]) : -INFINITY;
            const float v1 = ((unsigned)(kc + 32 - c0) < 16u) ? fmaf(s1[q], C2, brow[kc + 32]) : -INFINITY;
            s0[q] = v0; s1[q] = v1;
            mx = fmaxf(mx, fmaxf(v0, v1));
          }
        } else {
#pragma unroll
          for (int q = 0; q < 16; ++q) {
            s0[q] *= C2; s1[q] *= C2;
            mx = fmaxf(mx, fmaxf(s0[q], s1[q]));
          }
        }
        {
          auto rr = __builtin_amdgcn_permlane32_swap(__float_as_uint(mx), __float_as_uint(mx), false, false);
          mx = fmaxf(__uint_as_float(rr[0]), __uint_as_float(rr[1]));
        }
        const float mnew = fmaxf(m, mx);
        const float alpha = __builtin_amdgcn_exp2f(m - mnew);
        float ls = 0.f;
#pragma unroll
        for (int q = 0; q < 16; ++q) {
          s0[q] = __builtin_amdgcn_exp2f(s0[q] - mnew);
          s1[q] = __builtin_amdgcn_exp2f(s1[q] - mnew);
          ls += s0[q] + s1[q];
        }
        l = l * alpha + ls;
        m = mnew;
#pragma unroll
        for (int q = 0; q < 16; ++q) { o0[q] *= alpha; o1[q] *= alpha; }
        bf16x8 pf[4];
#pragma unroll
        for (int s = 0; s < 4; ++s) {
          const int u = (s & 1) * 8;
          u32x4 tpk;
          if (s < 2) {
            tpk.x = pk_bf16(s0[u + 0], s0[u + 1]); tpk.y = pk_bf16(s0[u + 2], s0[u + 3]);
            tpk.z = pk_bf16(s0[u + 4], s0[u + 5]); tpk.w = pk_bf16(s0[u + 6], s0[u + 7]);
          } else {
            tpk.x = pk_bf16(s1[u + 0], s1[u + 1]); tpk.y = pk_bf16(s1[u + 2], s1[u + 3]);
            tpk.z = pk_bf16(s1[u + 4], s1[u + 5]); tpk.w = pk_bf16(s1[u + 6], s1[u + 7]);
          }
          pf[s] = __builtin_bit_cast(bf16x8, tpk);
        }
        const char* vb = Vs + ((lane >> 4) & 1) * 32 + (lane & 3) * 8 + ((lane & 15) >> 2) * 64 + hi * 256;
#pragma unroll
        for (int s = 0; s < 4; ++s) {
          const s16x4 a00 = vtr(vb + (16 * s) * 64), a01 = vtr(vb + (16 * s + 8) * 64);
          const s16x4 a10 = vtr(vb + 4096 + (16 * s) * 64), a11 = vtr(vb + 4096 + (16 * s + 8) * 64);
          const bf16x8 A0 = __builtin_shufflevector(a00, a01, 0, 1, 2, 3, 4, 5, 6, 7);
          const bf16x8 A1 = __builtin_shufflevector(a10, a11, 0, 1, 2, 3, 4, 5, 6, 7);
          o0 = MFMA32(A0, pf[s], o0);
          o1 = MFMA32(A1, pf[s], o1);
        }
      }
      if (t + 1 < ntiles) swrite((t + 1) & 1);
    }
    __syncthreads();
    const float lt = l + __shfl_xor(l, 32);
    const float inv = 1.f / lt;
    unsigned char* op = (unsigned char*)p->AB + (size_t)(qrow0 + r32) * DM + ocol + 4 * hi;
#pragma unroll
    for (int g = 0; g < 4; ++g) {
      *(unsigned*)(op + 8 * g) = pk_fp8x4c(o0[4 * g] * inv, o0[4 * g + 1] * inv, o0[4 * g + 2] * inv, o0[4 * g + 3] * inv);
      *(unsigned*)(op + 32 + 8 * g) = pk_fp8x4c(o1[4 * g] * inv, o1[4 * g + 1] * inv, o1[4 * g + 2] * inv, o1[4 * g + 3] * inv);
    }
  }
}

__device__ void ph_rwkv_mix(KP p, int layer) {
  const int j = layer >> 1;
  const int tid = opaque_tid();
  const int lane = tid & 63, wave = tid >> 6;
  const float* mu = p->rwkv_mu + j * 6 * 512;
  const int c0 = lane * 8;
  auto unpack = [](const u32x4 u, float (&f)[8]) {
    f[0] = bflo(u.x); f[1] = bfhi(u.x); f[2] = bflo(u.y); f[3] = bfhi(u.y);
    f[4] = bflo(u.z); f[5] = bfhi(u.z); f[6] = bflo(u.w); f[7] = bfhi(u.w);
  };
  auto pack = [](const float (&f)[8]) {
    u32x4 o;
    o.x = pk_bf16(f[0], f[1]); o.y = pk_bf16(f[2], f[3]); o.z = pk_bf16(f[4], f[5]); o.w = pk_bf16(f[6], f[7]);
    return o;
  };
  for (int t = blockIdx.x * 4 + wave; t < NT; t += gridDim.x * 4) {
    bool hasp, hasn;
    if (t < NL) { int s = t & 2047; hasp = s > 0; hasn = s < SEQ - 1; }
    else { int s = (t - NL) & 255; hasp = s > 0; hasn = s < CTXL - 1; }
    const bf16_t* pt = p->P + (size_t)t * LDP + c0;
    bf16_t* rw = p->RW + (size_t)t * RWS + c0;
    bf16_t* zb = p->Zb + (size_t)t * 1536 + c0;
    const u32x4 zero = {0u, 0u, 0u, 0u};
#pragma unroll
    for (int q = 0; q < 4; ++q) {
      float cur[8], pv[8], nx[8], d[8];
      unpack(*(const u32x4*)(pt + q * 512), cur);
      unpack(hasp ? *(const u32x4*)(pt + q * 512 - LDP) : zero, pv);
      unpack(hasn ? *(const u32x4*)(pt + q * 512 + LDP) : zero, nx);
#pragma unroll
      for (int e = 0; e < 8; ++e) d[e] = 0.5f * (pv[e] + nx[e]) - cur[e];
      if (q < 3) {
        float o[8];
        const float* m = mu + q * 512 + c0;
#pragma unroll
        for (int e = 0; e < 8; ++e) o[e] = cur[e] + d[e] * m[e];
        if (q == 0) *(u32x4*)(rw) = pack(o);
        else if (q == 2) *(u32x4*)(rw + 512) = pack(o);
        else {
          *(u32x4*)(rw + 10 * 512) = pack(o);
          float kk[8], ss = 0.f;
          const float* kv0 = p->rwkv_kvec + (j * 2 + 0) * 512 + c0;
#pragma unroll
          for (int e = 0; e < 8; ++e) { kk[e] = o[e] * kv0[e]; ss += kk[e] * kk[e]; }
          ss += dppx<0xB1>(ss); ss += dppx<0x4E>(ss); ss += dppx<0x141>(ss);
          const float rn = rsqrtf(fmaxf(ss, 1e-24f));
#pragma unroll
          for (int e = 0; e < 8; ++e) kk[e] *= rn;
          *(u32x4*)(rw + 2 * 512) = pack(kk);
        }
      } else {
#pragma unroll
        for (int z = 0; z < 3; ++z) {
          float o[8];
          const float* m = mu + (3 + z) * 512 + c0;
#pragma unroll
          for (int e = 0; e < 8; ++e) o[e] = cur[e] + d[e] * m[e];
          *(u32x4*)(zb + z * 512) = pack(o);
        }
      }
    }
  }
}

constexpr int RS_STEP = 384;
constexpr int RS_TB = 16;
struct RwkvStage { u32x2 r, kk, e, ke, a, v; };
__device__ void rwkv_unit(KP p, int unit, float* sm, int tid) {
  const int ch = unit >> 1, hf = unit & 1;
  const int dir = ch >> 6, b = (ch >> 3) & 7, h = ch & 7;
  const int lane = tid & 63, w = tid >> 6, rl = lane >> 3, ks = lane & 7;
  float* ybuf = sm + 2 * RS_TB * RS_STEP;
  const int ss = tid >> 4, kq = tid & 15;
  auto gload = [&](int n, RwkvStage& g) {
    const int row = scan_row(dir, b, n * RS_TB + ss);
    const bf16_t* base = p->RW + (size_t)row * RWS + h * 64 + kq * 4;
    g.r = *(const u32x2*)(base);
    g.kk = *(const u32x2*)(base + 2 * 512);
    g.e = *(const u32x2*)(base + (3 + dir) * 512);
    g.ke = *(const u32x2*)(base + (5 + dir) * 512);
    g.a = *(const u32x2*)(base + (7 + dir) * 512);
    g.v = *(const u32x2*)(p->RW + (size_t)row * RWS + 512 + h * 64 + hf * 32 + (kq & 7) * 4);
  };
  auto swrite = [&](int buf, const RwkvStage& g) {
    float* sp = sm + (buf * RS_TB + ss) * RS_STEP;
    const float r0 = bflo(g.r.x), r1 = bfhi(g.r.x), r2 = bflo(g.r.y), r3 = bfhi(g.r.y);
    const float k0 = bflo(g.kk.x), k1 = bfhi(g.kk.x), k2 = bflo(g.kk.y), k3 = bfhi(g.kk.y);
    const float w0 = __expf(-bflo(g.e.x)), w1 = __expf(-bfhi(g.e.x)), w2 = __expf(-bflo(g.e.y)), w3 = __expf(-bfhi(g.e.y));
    const float e0 = bflo(g.ke.x), e1 = bfhi(g.ke.x), e2 = bflo(g.ke.y), e3 = bfhi(g.ke.y);
    const float a0 = k0 * bflo(g.a.x), a1 = k1 * bfhi(g.a.x), a2 = k2 * bflo(g.a.y), a3 = k3 * bfhi(g.a.y);
    *(float4*)(sp + kq * 4) = make_float4(k0, k1, k2, k3);
    *(float4*)(sp + 64 + kq * 4) = make_float4(w0 * r0, w1 * r1, w2 * r2, w3 * r3);
    *(float4*)(sp + 128 + kq * 4) = make_float4(w0, w1, w2, w3);
    *(float4*)(sp + 192 + kq * 4) = make_float4(a0, a1, a2, a3);
    *(float4*)(sp + 256 + kq * 4) = make_float4(e0, e1, e2, e3);
    if (kq < 8) *(float4*)(sp + 320 + kq * 4) = make_float4(bflo(g.v.x), bfhi(g.v.x), bflo(g.v.y), bfhi(g.v.y));
    float c1 = a0 * r0 + a1 * r1 + a2 * r2 + a3 * r3;
    float c2 = e0 * r0 + e1 * r1 + e2 * r2 + e3 * r3;
    c1 += dppx<0xB1>(c1); c2 += dppx<0xB1>(c2);
    c1 += dppx<0x4E>(c1); c2 += dppx<0x4E>(c2);
    c1 += dppx<0x141>(c1); c2 += dppx<0x141>(c2);
    c1 += dppx<0x140>(c1); c2 += dppx<0x140>(c2);
    if (kq == 0) { sp[352] = c1; sp[353] = c2; }
  };
  typedef float f2 __attribute__((ext_vector_type(2)));
  f2 S01 = {0.f, 0.f}, S23 = {0.f, 0.f}, S45 = {0.f, 0.f}, S67 = {0.f, 0.f};
  auto compute = [&](int n) {
    const float* bp = sm + (n & 1) * RS_TB * RS_STEP;
    float* yb = ybuf + (n & 1) * RS_TB * 32 + w * 8 + rl;
    struct Ops { f2 k[4], r[4], w[4], a[4], e[4]; float vv; f2 c; };
    auto ld = [&](int s, Ops& o) {
      const float* sq = bp + s * RS_STEP;
      const f2* sp = (const f2*)(sq + ks * 8);
#pragma unroll
      for (int i = 0; i < 4; ++i) { o.k[i] = sp[i]; o.r[i] = sp[32 + i]; o.w[i] = sp[64 + i]; o.a[i] = sp[96 + i]; o.e[i] = sp[128 + i]; }
      o.vv = sq[320 + w * 8 + rl]; o.c = *(const f2*)(sq + 352);
    };
    auto step = [&](const Ops& o) -> float {
      f2 sa2 = S01 * o.k[0];
      f2 y2 = S01 * o.r[0];
      sa2 = __builtin_elementwise_fma(S23, o.k[1], sa2); y2 = __builtin_elementwise_fma(S23, o.r[1], y2);
      sa2 = __builtin_elementwise_fma(S45, o.k[2], sa2); y2 = __builtin_elementwise_fma(S45, o.r[2], y2);
      sa2 = __builtin_elementwise_fma(S67, o.k[3], sa2); y2 = __builtin_elementwise_fma(S67, o.r[3], y2);
      float sa = sa2.x + sa2.y, y0 = y2.x + y2.y;
      sa += dppx<0xB1>(sa); y0 += dppx<0xB1>(y0);
      sa += dppx<0x4E>(sa); y0 += dppx<0x4E>(y0);
      sa += dppx<0x141>(sa); y0 += dppx<0x141>(y0);
      sa = -sa;
      const f2 sav = {sa, sa}, vvv = {o.vv, o.vv};
      S01 = __builtin_elementwise_fma(vvv, o.e[0], __builtin_elementwise_fma(sav, o.a[0], S01 * o.w[0]));
      S23 = __builtin_elementwise_fma(vvv, o.e[1], __builtin_elementwise_fma(sav, o.a[1], S23 * o.w[1]));
      S45 = __builtin_elementwise_fma(vvv, o.e[2], __builtin_elementwise_fma(sav, o.a[2], S45 * o.w[2]));
      S67 = __builtin_elementwise_fma(vvv, o.e[3], __builtin_elementwise_fma(sav, o.a[3], S67 * o.w[3]));
      return fmaf(o.vv, o.c.y, fmaf(sa, o.c.x, y0));
    };
    Ops oa, ob;
    ld(0, oa);
#pragma unroll 1
    for (int s = 0; s < RS_TB; s += 2) {
      __builtin_amdgcn_sched_barrier(0);
      ld(s + 1, ob);
      __builtin_amdgcn_sched_barrier(0);
      float y0 = step(oa);
      asm volatile("" : "+v"(y0));
      __builtin_amdgcn_sched_barrier(0);
      ld(s + 2, oa);
      __builtin_amdgcn_sched_barrier(0);
      float y1 = step(ob);
      asm volatile("" : "+v"(y1));
      __builtin_amdgcn_sched_barrier(0);
      if (ks == 0) { yb[s * 32] = y0; yb[(s + 1) * 32] = y1; }
    }
  };
  auto yout = [&](int n) {
    const int row = scan_row(dir, b, n * RS_TB + ss);
    const float* ys = ybuf + (n & 1) * RS_TB * 32 + ss * 32 + kq * 2;
    *(unsigned*)(p->P + (size_t)row * LDP + dir * 512 + h * 64 + hf * 32 + kq * 2) = pk_bf16(ys[0], ys[1]);
  };
  constexpr int NB = TSC / RS_TB;
  RwkvStage gA, gB;
  gload(0, gA);
  gload(1, gB);
  swrite(0, gA);
  gload(2, gA);
  __syncthreads();
  for (int n = 0; n < NB; n += 2) {
    compute(n);
    swrite(1, gB);
    if (n + 3 < NB) gload(n + 3, gB);
    __syncthreads();
    yout(n);
    compute(n + 1);
    if (n + 2 < NB) swrite(0, gA);
    if (n + 4 < NB) gload(n + 4, gA);
    __syncthreads();
    yout(n + 1);
  }
  __syncthreads();
}

__device__ void mlstm_s1(KP p, int layer, int tile, char* lds, int tid) {
  const int j = layer >> 1;
  const int ch = tile / NCHUNK, c = tile % NCHUNK;
  const int dir = ch >> 5, b = (ch >> 2) & 7, h = ch & 3;
  float* s_ws = (float*)(lds + META_OFF);
  int* s_row = (int*)(s_ws + 64);
  char* kimg = lds;
  char* vimg = lds + 16384;
  if (tid < 64) {
    const int row = scan_row(dir, b, c * 64 + tid);
    s_row[tid] = row;
    const float* g = p->GP + (size_t)row * 16;
    const float gi = g[(dir * 2) * 4 + h] + p->mlstm_gate_b[j * 16 + (dir * 2) * 4 + h];
    const float gf = g[(dir * 2 + 1) * 4 + h] + p->mlstm_gate_b[j * 16 + (dir * 2 + 1) * 4 + h];
    float bc = -softplus_f(-gf);
#pragma unroll
    for (int o = 1; o < 64; o <<= 1) {
      float tmp = __shfl_up(bc, o);
      if (tid >= o) bc += tmp;
    }
    const float bend = __shfl(bc, 63);
    const float ds = bend - bc + gi;
    const float mloc = wmax(ds);
    s_ws[tid] = expf(ds - mloc);
    if (tid == 0) { p->msc[tile] = mloc; p->msc[NMT + tile] = bend; }
  }
  __syncthreads();
  {
    const int c8 = tid & 15;
    const int ioff = (c8 >> 2) * 4096 + (c8 & 3) * 16;
#pragma unroll
    for (int i = 0; i < 4; ++i) {
      const int sidx = (tid >> 4) + 16 * i;
      const bf16_t* src = p->P + (size_t)s_row[sidx] * LDP + h * 128 + c8 * 8;
      const u32x4 kv = *(const u32x4*)(src + 2560);
      u32x4 vv = *(const u32x4*)(src + 3072);
      const float wsv = s_ws[sidx];
      vv.x = pk_bf16(bflo(vv.x) * wsv, bfhi(vv.x) * wsv); vv.y = pk_bf16(bflo(vv.y) * wsv, bfhi(vv.y) * wsv);
      vv.z = pk_bf16(bflo(vv.z) * wsv, bfhi(vv.z) * wsv); vv.w = pk_bf16(bflo(vv.w) * wsv, bfhi(vv.w) * wsv);
      *(u32x4*)(kimg + ioff + sidx * 64) = kv;
      *(u32x4*)(vimg + ioff + sidx * 64) = vv;
    }
  }
  __syncthreads();
  const int lane = tid & 63, w = tid >> 6, wm = w >> 1, wn = w & 1, r32 = lane & 31, hi = lane >> 5;
  f32x16 acc[2][2];
#pragma unroll
  for (int mi = 0; mi < 2; ++mi)
#pragma unroll
    for (int ni = 0; ni < 2; ++ni)
#pragma unroll
      for (int q = 0; q < 16; ++q) acc[mi][ni][q] = 0.f;
  const int toff = ((lane >> 4) & 1) * 32 + (lane & 3) * 8 + ((lane & 15) >> 2) * 64 + hi * 256;
#pragma unroll
  for (int ks = 0; ks < 4; ++ks) {
    bf16x8 af[2], bfr[2];
#pragma unroll
    for (int i = 0; i < 2; ++i) {
      const char* ka = kimg + (wm * 2 + i) * 4096 + toff + (16 * ks) * 64;
      const char* va = vimg + (wn * 2 + i) * 4096 + toff + (16 * ks) * 64;
      af[i] = __builtin_shufflevector(vtr(ka), vtr(ka + 8 * 64), 0, 1, 2, 3, 4, 5, 6, 7);
      bfr[i] = __builtin_shufflevector(vtr(va), vtr(va + 8 * 64), 0, 1, 2, 3, 4, 5, 6, 7);
    }
    acc[0][0] = MFMA32(af[0], bfr[0], acc[0][0]);
    acc[0][1] = MFMA32(af[0], bfr[1], acc[0][1]);
    acc[1][0] = MFMA32(af[1], bfr[0], acc[1][0]);
    acc[1][1] = MFMA32(af[1], bfr[1], acc[1][1]);
  }
  bf16_t* ust = (bf16_t*)(lds + 32768);
#pragma unroll
  for (int mi = 0; mi < 2; ++mi)
#pragma unroll
    for (int ni = 0; ni < 2; ++ni)
#pragma unroll
      for (int q = 0; q < 16; ++q) {
        const int d = wm * 64 + mi * 32 + (q & 3) + 8 * (q >> 2) + 4 * hi;
        ust[d * 128 + wn * 64 + ni * 32 + r32] = f2bf(acc[mi][ni][q]);
        if ((q & 3) == 3) __builtin_amdgcn_sched_barrier(0);
      }
  __syncthreads();
  {
    const u32x4* us4 = (const u32x4*)ust;
    u32x4* U4 = (u32x4*)(p->MS + (size_t)tile * 16384);
#pragma unroll
    for (int i = 0; i < 8; ++i) U4[tid + 256 * i] = us4[tid + 256 * i];
  }
  if (tid < 128) {
    const char* kc = kimg + (tid >> 5) * 4096 + (tid & 31) * 2;
    float a = 0.f;
#pragma unroll 8
    for (int sidx = 0; sidx < 64; ++sidx) a = fmaf(s_ws[sidx], bf2f(*(const bf16_t*)(kc + sidx * 64)), a);
    p->MSn[tile * 128 + tid] = a;
  }
}

__device__ void mlstm_s3(KP p, int layer, int tile, char* lds, int tid);
__device__ void ph_scan_a(KP p, int layer, char* smc) {
  float* sm = (float*)smc;
  const int tid = opaque_tid();
  __builtin_amdgcn_s_setprio(3);
  for (int u = blockIdx.x; u < 256; u += gridDim.x) rwkv_unit(p, u, sm, tid);
  __builtin_amdgcn_s_setprio(0);
  {
    const int stage = layer == 1 ? 1 : 2;
    const int nconv = conv_stage_total(stage);
    const int total = NMT + (nconv + 7) / 8;
    int* qc = (int*)(p->bar + XCD_BAR_WORDS + 16 * stage);
    int* s_q = (int*)(smc + META_OFF + 3968);
    int jj = 0, j1 = 0;
#pragma unroll 1
    for (;;) {
      if (jj >= j1) {
        __syncthreads();
        if (tid == 0) *s_q = atomicAdd(qc, 1);
        __syncthreads();
        const int q = *s_q;
        if (q >= total) break;
        if (q < NMT) { mlstm_s3(p, layer, q, smc, tid); continue; }
        jj = (q - NMT) * 8; j1 = min(jj + 8, nconv);
      }
      convert_run(p, stage, jj, j1, sm, tid);
      jj = j1;
    }
  }
}

__device__ void ph_mlstm_s2(KP p, char* smc) {
  float* sw = (float*)smc;
  const int tid = opaque_tid();
  const int nitems = 64 * 33;
  for (int item = blockIdx.x; item < nitems; item += gridDim.x) {
    const int ch = item / 33, seg = item % 33;
    __syncthreads();
    if (tid < 2 * NCHUNK) sw[72 + tid] = p->msc[(tid < NCHUNK ? 0 : NMT - NCHUNK) + ch * NCHUNK + tid];
    __syncthreads();
    if (tid == 0) {
      float m = 0.f;
      for (int c = 0; c < NCHUNK; ++c) {
        const int tile = ch * NCHUNK + c;
        const float mloc = sw[72 + c], bend = sw[72 + NCHUNK + c];
        const float mn = fmaxf(bend + m, mloc);
        sw[c] = expf(bend + m - mn);
        sw[36 + c] = expf(mloc - mn);
        if (seg == 0) p->msc[2 * NMT + tile] = m;
        m = mn;
      }
    }
    __syncthreads();
    if (seg < 32) {
      unsigned* base = (unsigned*)(p->MS + (size_t)ch * NCHUNK * 16384) + seg * 256 + tid;
      unsigned v[NCHUNK];
#pragma unroll
      for (int c = 0; c < NCHUNK; ++c) v[c] = base[(size_t)c * 8192];
      float C0 = 0.f, C1 = 0.f;
#pragma unroll
      for (int c = 0; c < NCHUNK; ++c) {
        const float t0 = bflo(v[c]), t1 = bfhi(v[c]);
        v[c] = pk_bf16(C0, C1);
        C0 = sw[c] * C0 + sw[36 + c] * t0;
        C1 = sw[c] * C1 + sw[36 + c] * t1;
      }
#pragma unroll
      for (int c = 0; c < NCHUNK; ++c) base[(size_t)c * 8192] = v[c];
    } else if (tid < 128) {
      float* base = p->MSn + (size_t)ch * NCHUNK * 128 + tid;
      float v[NCHUNK];
#pragma unroll
      for (int c = 0; c < NCHUNK; ++c) v[c] = base[c * 128];
      float C = 0.f;
#pragma unroll
      for (int c = 0; c < NCHUNK; ++c) {
        const float t0 = v[c];
        v[c] = C;
        C = sw[c] * C + sw[36 + c] * t0;
      }
#pragma unroll
      for (int c = 0; c < NCHUNK; ++c) base[c * 128] = v[c];
    }
  }
}

__device__ void mlstm_s3(KP p, int layer, int tile, char* lds, int tid) {
  const int j = layer >> 1;
  const int ch = tile / NCHUNK, c = tile % NCHUNK;
  const int dir = ch >> 5, b = (ch >> 2) & 7, h = ch & 3;
  float* s_b = (float*)(lds + META_OFF);
  float* s_ig = s_b + 64;
  float* s_mt = s_b + 128;
  float* s_wi = s_b + 192;
  int* s_row = (int*)(s_b + 256);
  float* s_n = s_b + 320;
  float* s_c = s_b + 448;
  char* kimg = lds;
  char* vimg = lds + 16384;
  char* cimg = lds + 32768;
  const float mprev = p->msc[2 * NMT + tile];
  const float qscale = 0.08838834764831845f;
  const int lane = tid & 63, w = tid >> 6, wt = w >> 1, wv = w & 1, r32 = lane & 31, hi = lane >> 5;
  const int t = wt * 32 + r32;
  const int rowq = scan_row(dir, b, c * 64 + t);
  const int c8 = tid & 15;
  u32x4 kr[4], vr[4], cr[8];
#pragma unroll
  for (int i = 0; i < 4; ++i) {
    const int sidx = (tid >> 4) + 16 * i;
    const bf16_t* src = p->P + (size_t)scan_row(dir, b, c * 64 + sidx) * LDP + h * 128 + c8 * 8;
    kr[i] = *(const u32x4*)(src + 2560);
    vr[i] = *(const u32x4*)(src + 3072);
  }
  {
    const bf16_t* Cp = p->MS + (size_t)tile * 16384;
#pragma unroll
    for (int i = 0; i < 8; ++i) cr[i] = *(const u32x4*)(Cp + ((tid >> 4) + 16 * i) * 128 + c8 * 8);
  }
  bf16x8 qf[8];
  {
    const bf16_t* qp = p->P + (size_t)rowq * LDP + 2048 + h * 128 + hi * 8;
#pragma unroll
    for (int d0 = 0; d0 < 8; ++d0) qf[d0] = *(const bf16x8*)(qp + d0 * 16);
  }
  if (tid < 64) {
    const int row = scan_row(dir, b, c * 64 + tid);
    s_row[tid] = row;
    const float* g = p->GP + (size_t)row * 16;
    const float gi = g[(dir * 2) * 4 + h] + p->mlstm_gate_b[j * 16 + (dir * 2) * 4 + h];
    const float gf = g[(dir * 2 + 1) * 4 + h] + p->mlstm_gate_b[j * 16 + (dir * 2 + 1) * 4 + h];
    float bc = -softplus_f(-gf);
#pragma unroll
    for (int o = 1; o < 64; o <<= 1) {
      float tmp = __shfl_up(bc, o);
      if (tid >= o) bc += tmp;
    }
    float pm = gi - bc;
#pragma unroll
    for (int o = 1; o < 64; o <<= 1) {
      float tmp = __shfl_up(pm, o);
      if (tid >= o) pm = fmaxf(pm, tmp);
    }
    const float mt = bc + fmaxf(mprev, pm);
    s_b[tid] = bc;
    s_ig[tid] = gi;
    s_mt[tid] = mt;
    s_wi[tid] = expf(bc + mprev - mt);
    s_c[tid] = (gi - bc) * 1.4426950408889634f;
  } else if (tid < 192) s_n[tid - 64] = p->MSn[tile * 128 + (tid - 64)];
  {
    const int ioff = (c8 >> 2) * 4096 + (c8 & 3) * 16;
#pragma unroll
    for (int i = 0; i < 4; ++i) {
      const int sidx = (tid >> 4) + 16 * i;
      *(u32x4*)(kimg + sidx * 256 + ((c8 ^ (sidx & 15)) * 16)) = kr[i];
      *(u32x4*)(vimg + ioff + sidx * 64) = vr[i];
    }
    const int coff = (c8 >> 2) * 8192 + (c8 & 3) * 16;
#pragma unroll
    for (int i = 0; i < 8; ++i) *(u32x4*)(cimg + coff + ((tid >> 4) + 16 * i) * 64) = cr[i];
  }
  __syncthreads();
  const int toff = ((lane >> 4) & 1) * 32 + (lane & 3) * 8 + ((lane & 15) >> 2) * 64;
  constexpr float LOG2E_ = 1.4426950408889634f;
  float qn = 0.f;
#pragma unroll
  for (int d0 = 0; d0 < 8; ++d0) {
    const u32x4 qq = __builtin_bit_cast(u32x4, qf[d0]);
    const float* np = s_n + d0 * 16 + hi * 8;
    qn = fmaf(bflo(qq.x), np[0], qn); qn = fmaf(bfhi(qq.x), np[1], qn);
    qn = fmaf(bflo(qq.y), np[2], qn); qn = fmaf(bfhi(qq.y), np[3], qn);
    qn = fmaf(bflo(qq.z), np[4], qn); qn = fmaf(bfhi(qq.z), np[5], qn);
    qn = fmaf(bflo(qq.w), np[6], qn); qn = fmaf(bfhi(qq.w), np[7], qn);
  }
  qn += __shfl_xor(qn, 32);
  const float mtt = s_mt[t], wi = s_wi[t];
  const float ct = (s_b[t] - mtt) * LOG2E_;
  const float wq = wi * qscale;
  bf16x8 pf[4];
  float den = 0.f;
  {
    f32x16 sa0, sa1;
#pragma unroll
    for (int q = 0; q < 16; ++q) { sa0[q] = 0.f; sa1[q] = 0.f; }
#pragma unroll
    for (int d0 = 0; d0 < 8; ++d0) {
      const int chn = 2 * d0 + hi;
      const bf16x8 k0 = *(const bf16x8*)(kimg + r32 * 256 + ((chn ^ (r32 & 15)) * 16));
      sa0 = MFMA32(k0, qf[d0], sa0);
      if (wt) {
        const bf16x8 k1 = *(const bf16x8*)(kimg + (32 + r32) * 256 + ((chn ^ (r32 & 15)) * 16));
        sa1 = MFMA32(k1, qf[d0], sa1);
      }
      __builtin_amdgcn_sched_barrier(0);
    }
#pragma unroll
    for (int g = 0; g < 4; ++g) {
      const int sb0 = 8 * g + 4 * hi;
      const float4 c0v = *(const float4*)(s_c + sb0);
      const float4 c1v = *(const float4*)(s_c + sb0 + 32);
      const float cc0[4] = {c0v.x, c0v.y, c0v.z, c0v.w}, cc1[4] = {c1v.x, c1v.y, c1v.z, c1v.w};
#pragma unroll
      for (int e = 0; e < 4; ++e) {
        const int q = 4 * g + e;
        const float v0 = (sb0 + e <= t) ? sa0[q] * qscale * __builtin_amdgcn_exp2f(ct + cc0[e]) : 0.f;
        sa0[q] = v0; den += v0;
        const float v1 = (wt && sb0 + 32 + e <= t) ? sa1[q] * qscale * __builtin_amdgcn_exp2f(ct + cc1[e]) : 0.f;
        sa1[q] = v1; den += v1;
      }
      __builtin_amdgcn_sched_barrier(0);
    }
#pragma unroll
    for (int sx = 0; sx < 4; ++sx) {
      const int u = (sx & 1) * 8;
      u32x4 tpk;
      if (sx < 2) {
        tpk.x = pk_bf16(sa0[u + 0], sa0[u + 1]); tpk.y = pk_bf16(sa0[u + 2], sa0[u + 3]);
        tpk.z = pk_bf16(sa0[u + 4], sa0[u + 5]); tpk.w = pk_bf16(sa0[u + 6], sa0[u + 7]);
      } else {
        tpk.x = pk_bf16(sa1[u + 0], sa1[u + 1]); tpk.y = pk_bf16(sa1[u + 2], sa1[u + 3]);
        tpk.z = pk_bf16(sa1[u + 4], sa1[u + 5]); tpk.w = pk_bf16(sa1[u + 6], sa1[u + 7]);
      }
      pf[sx] = __builtin_bit_cast(bf16x8, tpk);
    }
  }
  den += __shfl_xor(den, 32);
  const float dtot = den + wq * qn;
  const float inv = 1.f / fmaxf(fabsf(dtot), expf(-mtt));
  bf16_t* op = p->P + (size_t)rowq * LDP + 1024 + dir * 512 + h * 128 + wv * 64 + 4 * hi;
#pragma unroll 1
  for (int vp = 0; vp < 2; ++vp) {
    f32x16 o0;
#pragma unroll
    for (int q = 0; q < 16; ++q) o0[q] = 0.f;
    const char* cb = cimg + (wv * 2 + vp) * 8192 + toff + hi * 512;
#pragma unroll
    for (int d0 = 0; d0 < 8; ++d0) {
      const bf16x8 A0 = __builtin_shufflevector(vtr(cb + (16 * d0) * 64), vtr(cb + (16 * d0 + 4) * 64), 0, 1, 2, 3, 4, 5, 6, 7);
      o0 = MFMA32(A0, qf[d0], o0);
    }
#pragma unroll
    for (int q = 0; q < 16; ++q) o0[q] *= wq;
    const char* vb = vimg + (wv * 2 + vp) * 4096 + toff + hi * 256;
#pragma unroll
    for (int sx = 0; sx < 4; ++sx) {
      if (sx < 2 || wt) {
        const bf16x8 A0 = __builtin_shufflevector(vtr(vb + (16 * sx) * 64), vtr(vb + (16 * sx + 8) * 64), 0, 1, 2, 3, 4, 5, 6, 7);
        o0 = MFMA32(A0, pf[sx], o0);
      }
    }
#pragma unroll
    for (int g = 0; g < 4; ++g) {
      u32x2 v0;
      v0.x = pk_bf16(o0[4 * g] * inv, o0[4 * g + 1] * inv); v0.y = pk_bf16(o0[4 * g + 2] * inv, o0[4 * g + 3] * inv);
      *(u32x2*)(op + vp * 32 + 8 * g) = v0;
    }
  }
}

__device__ void ph_mlstm_s1(KP p, int layer, char* smc) {
  const int tid = opaque_tid();
  __syncthreads();
  for (int tile = blockIdx.x; tile < NMT; tile += gridDim.x) { mlstm_s1(p, layer, tile, smc, tid); __syncthreads(); }
}

__device__ void ph_rec_final(KP p, int layer, bool keep) {
  const int tid = opaque_tid();
  const int j = layer >> 1;
  const int lane = tid & 63, wave = tid >> 6;
  const int rows = keep ? NT : NL;
  const int c0 = lane * 8;
  auto unpack = [](const u32x4 u, float (&f)[8]) {
    f[0] = bflo(u.x); f[1] = bfhi(u.x); f[2] = bflo(u.y); f[3] = bfhi(u.y);
    f[4] = bflo(u.z); f[5] = bfhi(u.z); f[6] = bflo(u.w); f[7] = bfhi(u.w);
  };
  for (int t = blockIdx.x * 4 + wave; t < rows; t += gridDim.x * 4) {
    const bf16_t* rw = p->RW + (size_t)t * RWS + c0;
    const bf16_t* pt = p->P + (size_t)t * LDP + c0;
    unsigned char* mo = (unsigned char*)p->AB + (size_t)t * DM + c0;
    {
      float yf[8], yb[8], r[8], v[8], k0[8], k1[8], g[8], y[8], o[8];
      unpack(*(const u32x4*)(pt), yf); unpack(*(const u32x4*)(pt + 512), yb);
      unpack(*(const u32x4*)(rw), r); unpack(*(const u32x4*)(rw + 512), v);
      unpack(*(const u32x4*)(rw + 5 * 512), k0); unpack(*(const u32x4*)(rw + 6 * 512), k1);
      unpack(*(const u32x4*)(rw + 9 * 512), g);
      float s1 = 0.f, bs = 0.f;
      const float* rk = p->rwkv_rk + j * 512 + c0;
#pragma unroll
      for (int e = 0; e < 8; ++e) { y[e] = yf[e] + yb[e]; s1 += y[e]; bs += r[e] * rk[e] * (k0[e] + k1[e]); }
      s1 += dppx<0xB1>(s1); s1 += dppx<0x4E>(s1); s1 += dppx<0x141>(s1);
      bs += dppx<0xB1>(bs); bs += dppx<0x4E>(bs); bs += dppx<0x141>(bs);
      const float mu = s1 * (1.f / 64.f);
      float s2 = 0.f;
#pragma unroll
      for (int e = 0; e < 8; ++e) { const float d = y[e] - mu; s2 += d * d; }
      s2 += dppx<0xB1>(s2); s2 += dppx<0x4E>(s2); s2 += dppx<0x141>(s2);
      const float rs = rsqrtf(s2 * (1.f / 64.f) + 64e-5f);
      const float* gn0 = p->rwkv_gn + (j * 2 + 0) * 512 + c0;
      const float* gn1 = p->rwkv_gn + (j * 2 + 1) * 512 + c0;
#pragma unroll
      for (int e = 0; e < 8; ++e) o[e] = ((y[e] - mu) * rs * gn0[e] + gn1[e] + bs * v[e]) * g[e];
      u32x2 ov;
      ov.x = pk_fp8x4c(o[0], o[1], o[2], o[3]); ov.y = pk_fp8x4c(o[4], o[5], o[6], o[7]);
      *(u32x2*)(mo) = ov;
    }
    {
      float hf[8], hb[8], og[8], hsum[8], o[8];
      unpack(*(const u32x4*)(pt + 1024), hf); unpack(*(const u32x4*)(pt + 1536), hb);
      unpack(*(const u32x4*)(pt + 3584), og);
      float ss = 0.f;
#pragma unroll
      for (int e = 0; e < 8; ++e) { hsum[e] = hf[e] + hb[e]; ss += hsum[e] * hsum[e]; }
      ss += dppx<0xB1>(ss); ss += dppx<0x4E>(ss); ss += dppx<0x141>(ss); ss += dppx<0x140>(ss);
      const float rs = rsqrtf(ss * (1.f / 128.f) + 1e-6f);
      const float* ng = p->mlstm_norm + j * 512 + c0;
#pragma unroll
      for (int e = 0; e < 8; ++e) o[e] = hsum[e] * rs * ng[e] * sigm_f(og[e]);
      u32x2 ov;
      ov.x = pk_fp8x4c(o[0], o[1], o[2], o[3]); ov.y = pk_fp8x4c(o[4], o[5], o[6], o[7]);
      *(u32x2*)(mo + 512) = ov;
    }
  }
}

using f32x4v = __attribute__((ext_vector_type(4))) float;
__device__ void ph_ln_router(KP p, int layer, bool keep, char* smc) {
  float* h2s = (float*)smc;
  float* lgs = (float*)smc;
  const int tid = opaque_tid();
  const int lane = tid & 63, wave = tid >> 6;
  const int rows = keep ? NT : NL;
  const float* lng = p->ln_g + (layer * 2 + 0) * 1024;
  const float* lnb = p->ln_b + (layer * 2 + 0) * 1024;
  for (int tile = blockIdx.x; tile < rows / 16; tile += gridDim.x) {
    const int t0 = tile * 16;
    const float* mod = p->MOD + (layer * 9 + modrow(t0)) * 6144;
    const float* brow = p->WrT + ((size_t)layer * 64 + 16 * wave + (lane & 15)) * 1024 + 4 * (lane >> 4);
    f32x4v b0[8], b1[8], b2[8];
#pragma unroll
    for (int q = 0; q < 8; ++q) { b0[q] = *(const f32x4v*)(brow + 16 * q); b1[q] = *(const f32x4v*)(brow + 16 * (8 + q)); }
    __builtin_amdgcn_sched_barrier(0);
    {
      float4 v[4][4];
      float s4[4];
#pragma unroll
      for (int q = 0; q < 4; ++q) {
        const int t = t0 + wave * 4 + q;
        s4[q] = 0.f;
#pragma unroll
        for (int i = 0; i < 4; ++i) v[q][i] = *(const float4*)(p->Tb + (size_t)t * DM + i * 256 + lane * 4);
      }
#pragma unroll
      for (int q = 0; q < 4; ++q)
#pragma unroll
        for (int i = 0; i < 4; ++i) s4[q] += (v[q][i].x + v[q][i].y) + (v[q][i].z + v[q][i].w);
      float mean4[4], rs4[4];
#pragma unroll
      for (int q = 0; q < 4; ++q) mean4[q] = wsum(s4[q]) * (1.f / 1024.f);
#pragma unroll
      for (int q = 0; q < 4; ++q) {
        float qq = 0.f;
#pragma unroll
        for (int i = 0; i < 4; ++i) {
          const float d0 = v[q][i].x - mean4[q], d1 = v[q][i].y - mean4[q], d2 = v[q][i].z - mean4[q], d3 = v[q][i].w - mean4[q];
          qq += (d0 * d0 + d1 * d1) + (d2 * d2 + d3 * d3);
        }
        s4[q] = qq;
      }
#pragma unroll
      for (int q = 0; q < 4; ++q) rs4[q] = rsqrtf(wsum(s4[q]) * (1.f / 1024.f) + 1e-5f);
#pragma unroll
      for (int i = 0; i < 4; ++i) {
        const int n = i * 256 + lane * 4;
        const float4 g = *(const float4*)(lng + n), bb = *(const float4*)(lnb + n);
        const float4 sc = *(const float4*)(mod + 4096 + n), sh = *(const float4*)(mod + 3072 + n);
#pragma unroll
        for (int q = 0; q < 4; ++q) {
          const int tl = wave * 4 + q, t = t0 + tl;
          const float mean = mean4[q], rs = rs4[q];
          const float4 xn = make_float4((v[q][i].x - mean) * rs * g.x + bb.x, (v[q][i].y - mean) * rs * g.y + bb.y,
                                        (v[q][i].z - mean) * rs * g.z + bb.z, (v[q][i].w - mean) * rs * g.w + bb.w);
          *(float4*)(p->X + (size_t)t * DM + n) = xn;
          const float4 hh = make_float4(xn.x * (1.f + sc.x) + sh.x, xn.y * (1.f + sc.y) + sh.y,
                                        xn.z * (1.f + sc.z) + sh.z, xn.w * (1.f + sc.w) + sh.w);
          *(unsigned*)((unsigned char*)p->AB + (size_t)t * DM + n) = pk_fp8x4c(hh.x, hh.y, hh.z, hh.w);
          *(float4*)(h2s + tl * 1028 + n) = hh;
        }
      }
    }
    __syncthreads();
    f32x4v acc = {0.f, 0.f, 0.f, 0.f};
    {
      f32x4v a1 = {0.f, 0.f, 0.f, 0.f}, a2 = {0.f, 0.f, 0.f, 0.f}, a3 = {0.f, 0.f, 0.f, 0.f};
      const int i = lane & 15, kk = lane >> 4;
      const float* arow = h2s + i * 1028 + 4 * kk;
#define ROUTER_LOAD(B, Q0) _Pragma("unroll") for (int q = 0; q < 8; ++q) B[q] = *(const f32x4v*)(brow + 16 * ((Q0) + q)); __builtin_amdgcn_sched_barrier(0);
#define ROUTER_MFMA(B, Q0) _Pragma("unroll") for (int q = 0; q < 8; ++q) { \
        const float4 a = *(const float4*)(arow + 16 * ((Q0) + q)); \
        acc = __builtin_amdgcn_mfma_f32_16x16x4f32(a.x, B[q].x, acc, 0, 0, 0); \
        a1 = __builtin_amdgcn_mfma_f32_16x16x4f32(a.y, B[q].y, a1, 0, 0, 0); \
        a2 = __builtin_amdgcn_mfma_f32_16x16x4f32(a.z, B[q].z, a2, 0, 0, 0); \
        a3 = __builtin_amdgcn_mfma_f32_16x16x4f32(a.w, B[q].w, a3, 0, 0, 0); } __builtin_amdgcn_sched_barrier(0);
      ROUTER_LOAD(b2, 16) ROUTER_MFMA(b0, 0)
      ROUTER_LOAD(b0, 24) ROUTER_MFMA(b1, 8)
      ROUTER_LOAD(b1, 32) ROUTER_MFMA(b2, 16)
      ROUTER_LOAD(b2, 40) ROUTER_MFMA(b0, 24)
      ROUTER_LOAD(b0, 48) ROUTER_MFMA(b1, 32)
      ROUTER_LOAD(b1, 56) ROUTER_MFMA(b2, 40)
      ROUTER_MFMA(b0, 48)
      ROUTER_MFMA(b1, 56)
      acc = (acc + a1) + (a2 + a3);
    }
    __syncthreads();
#pragma unroll
    for (int r = 0; r < 4; ++r) lgs[((lane >> 4) * 4 + r) * 64 + 16 * wave + (lane & 15)] = acc[r];
    __syncthreads();
    {
      float score4[4], gate4[4];
      int kidx4[4], pos4[4];
      bool chosen4[4];
#pragma unroll
      for (int q = 0; q < 4; ++q) {
        const int tl = wave * 4 + q;
        const float logit = lgs[tl * 64 + lane];
        const float score = sigm_f(logit);
        float sel = score + p->moe_bias[layer * 64 + lane];
        bool chosen = false;
        for (int r = 0; r < 6; ++r) {
          const float mx = wmax(sel);
          const unsigned long long bal = __ballot(sel == mx);
          const int first = __ffsll((long long)bal) - 1;
          if (lane == first) { chosen = true; sel = -INFINITY; }
        }
        const float gsum = wsum(chosen ? score : 0.f);
        const unsigned long long cb = __ballot(chosen);
        score4[q] = score; gate4[q] = score / gsum * 2.5f; chosen4[q] = chosen;
        kidx4[q] = __popcll(cb & ((1ull << lane) - 1ull));
      }
#pragma unroll
      for (int q = 0; q < 4; ++q) pos4[q] = chosen4[q] ? atomicAdd(&p->cnt[lane * CSTR], 1) : 0;
#pragma unroll
      for (int q = 0; q < 4; ++q) {
        const int t = t0 + wave * 4 + q;
        if (chosen4[q]) {
          p->ltok[(size_t)lane * NT + pos4[q]] = t;
          p->lgate[(size_t)lane * NT + pos4[q]] = gate4[q];
          p->tsl[t * 6 + kidx4[q]] = (lane << 16) | pos4[q];
        }
      }
    }
    __syncthreads();
  }
}

__device__ __forceinline__ void moe_prefix(KP p, int rows, int* s_pref, int tid) {
  if (tid < 64) s_pref[322 + tid] = p->cnt[tid * CSTR];
  __syncthreads();
  if (tid == 0) {
    int a = 0;
    for (int e = 0; e < 64; ++e) { s_pref[e] = a; a += (s_pref[322 + e] + 127) >> 7; }
    s_pref[64] = a; a += rows >> 7;
    s_pref[65] = a;
  }
  __syncthreads();
}

__device__ void ph_gemm(KP p, int kind, int layer, bool keep, char* lds) {
  const int tid = opaque_tid();
  const int j = layer >> 1;
  const bool att = !(layer & 1);
  const int rows = keep ? NT : NL;
  int* pref = (int*)(lds + META_OFF);
  int* s_idx = pref + 66;
  float* s_gate = (float*)(s_idx + 128);
  if (kind == 1 && blockIdx.x == 0 && tid < 65) p->cnt[tid * CSTR] = 0;
  int total;
  const int ntn_in = att ? 18 : 33;
  switch (kind) {
    case 0: total = (NT / 128) * ntn_in; break;
    case 1: total = (rows / 128) * 8; break;
    case 2: total = pref[65] * 4; break;
    case 3: total = pref[65] * 8; break;
    case 4: total = (NT / 128) * 3; break;
    default: total = (NT / 128) * 20; break;
  }
  const bool moe = kind == 2 || kind == 3;
  const int tsh = kind == 2 ? 2 : 3;
  int e_nx = 0, idx_nx = tid; float g_nx = 1.f;
  auto fetch_moe = [&](int tl) {
    const int mt = tl >> tsh;
    while (mt >= pref[e_nx + 1]) ++e_nx;
    idx_nx = tid; g_nx = 1.f;
    if (tid < 128) {
      const int pos = (mt - pref[e_nx]) * 128 + tid;
      if (kind == 2) {
        idx_nx = 0;
        if (e_nx < 64) { if (pos < pref[322 + e_nx]) idx_nx = p->ltok[(size_t)e_nx * NT + pos]; }
        else idx_nx = pos;
      } else if (e_nx < 64) g_nx = pos < pref[322 + e_nx] ? p->lgate[(size_t)e_nx * NT + pos] : 0.f;
    }
  };
  const int xcd = blockIdx.x & 7, lb = blockIdx.x >> 3, nbx = ((int)gridDim.x - xcd + 7) >> 3;
  const int t_beg = (int)(((long long)total * xcd) >> 3), t_end = (int)(((long long)total * (xcd + 1)) >> 3);
  if (moe && t_beg + lb < t_end) fetch_moe(t_beg + lb);
  for (int tile = t_beg + lb; tile < t_end; tile += nbx) {
    const bf16_t* Abase; const bf16_t* Bt;
    int astride, K, n0, m0 = 0, aux = 0, e = e_nx, mtile = 0;
    switch (kind) {
      case 0: { const int tm = tile / ntn_in, tn = tile % ntn_in; m0 = tm * 128; n0 = tn * 128;
                Abase = (const bf16_t*)((const unsigned char*)p->AB + (size_t)m0 * DM); astride = DM; K = 1024;
                Bt = (const bf16_t*)(att ? (const unsigned char*)p->Wt_att + (size_t)j * ATT_N * 1024
                                         : (const unsigned char*)p->Wt_rec + (size_t)j * REC_NP * 1024); } break;
      case 1: { const int tm = tile >> 3, tn = tile & 7; m0 = tm * 128; n0 = tn * 128;
                Abase = (const bf16_t*)((const unsigned char*)p->AB + (size_t)m0 * DM); astride = DM; K = 1024;
                Bt = (const bf16_t*)((const unsigned char*)p->Wt_out + (size_t)layer * 1024 * 1024); } break;
      case 2: { mtile = tile >> 2; aux = tile & 3; n0 = aux * 128;
                Abase = p->AB; astride = DM; K = 1024;
                Bt = (const bf16_t*)((const unsigned char*)p->Wt13 + (size_t)(layer * 65 + e) * 512 * 1024); } break;
      case 3: { mtile = tile >> 3; aux = tile & 7; n0 = aux * 128;
                Abase = (const bf16_t*)((const unsigned char*)p->ACT + (size_t)mtile * 128 * 256); astride = 256; K = 256;
                Bt = (const bf16_t*)((const unsigned char*)p->Wt2 + (size_t)(layer * 65 + e) * 1024 * 256); } break;
      case 4: { const int tm = tile / 3; aux = tile % 3; m0 = tm * 128; n0 = 0;
                Abase = p->Zb + (size_t)m0 * 1536 + aux * 512; astride = 1536; K = 512; Bt = p->Wl1 + (size_t)(j * 3 + aux) * 128 * 512; } break;
      default: { const int tm = tile / 20; aux = tile % 20; m0 = tm * 128; n0 = aux * 128;
                const int grp = aux < 8 ? 0 : (aux < 16 ? 1 : 2);
                Abase = p->L1 + (size_t)m0 * 384 + grp * 128; astride = 384; K = 128; Bt = p->Wl2 + (size_t)j * 2560 * 128; } break;
    }
    if (tid < 128) { s_idx[tid] = idx_nx; s_gate[tid] = g_nx; }
    __syncthreads();
    if (moe && tile + nbx < t_end) fetch_moe(tile + nbx);
    {
      f32x16 acc[2][2];
      if (kind <= 3) {
        const unsigned char* A8 = (const unsigned char*)Abase;
        gemm128_fp8(tid, [&](int r) { return A8 + (size_t)s_idx[r] * astride; }, (const unsigned char*)Bt, K, n0, lds, acc);
      } else
        gemm128_main(tid, [&](int r) { return Abase + (size_t)s_idx[r] * astride; }, Bt, K, n0, lds, acc);
      float* Ct = (float*)lds;
      acc_foreach(tid, acc, [&](int row, int col, float v) { Ct[row * 128 + col] = v; });
    }
    __syncthreads();
    {
      const float* Ct = (const float*)lds;
      int c4 = (tid & 31) * 4, r0 = tid >> 5;
      asm volatile("" : "+v"(c4), "+v"(r0));
      const int N_in = att ? ATT_N : REC_N;
      const int d5 = (aux >> 2) & 1, c05 = (aux & 3) * 128;
      switch (kind) {
        case 0: {
#pragma unroll 8
          for (int it = 0; it < 16; ++it) {
            const int row = it * 8 + r0;
            const float4 vraw = *(const float4*)(Ct + row * 128 + c4);
            const float4 v = make_float4(vraw.x * W8_INV, vraw.y * W8_INV, vraw.z * W8_INV, vraw.w * W8_INV);

            const int cn = n0 + c4;
            float4 vq = v;
            if (att && n0 >= 1536 && n0 < 2176) {
              float ss = v.x * v.x + v.y * v.y + v.z * v.z + v.w * v.w;
              ss += dppx<0xB1>(ss); ss += dppx<0x4E>(ss); ss += dppx<0x141>(ss); ss += dppx<0x140>(ss);
              const float rs = rsqrtf(ss * (1.f / 64.f) + 1e-6f);
              const float4 g = *(const float4*)(p->qk_gain + j * 128 + (n0 >= 2048 ? 64 : 0) + (cn & 63));
              vq = make_float4(v.x * rs * g.x, v.y * rs * g.y, v.z * rs * g.z, v.w * rs * g.w);
              const int t = m0 + row;
              if (t < NL) {
                const int sidx = t & 2047, pi0 = (cn & 63) >> 1;
                const int pos = pi0 < 16 ? (sidx >> 6) : (sidx & 63);
                const float4 cs = *(const float4*)(p->ROPE + (pos * 16 + (pi0 & 15)) * 2);
                vq = make_float4(vq.x * cs.x - vq.y * cs.y, vq.x * cs.y + vq.y * cs.x,
                                 vq.z * cs.z - vq.w * cs.w, vq.z * cs.w + vq.w * cs.z);
              }
            }
            if (cn < N_in) {
              u32x2 o; o.x = pk_bf16(vq.x, vq.y); o.y = pk_bf16(vq.z, vq.w);
              *(u32x2*)(p->P + (size_t)(m0 + row) * LDP + cn) = o;
            }
            if (!att && cn >= 4096 && cn < 4112) *(float4*)(p->GP + (size_t)(m0 + row) * 16 + (cn - 4096)) = v;
          }
        } break;
        case 1: {
#pragma unroll 16
          for (int it = 0; it < 16; ++it) {
            const int row = it * 8 + r0;
            const float4 v = *(const float4*)(Ct + row * 128 + c4);

            const size_t o = (size_t)(m0 + row) * DM + n0 + c4;
            const float4 xv = *(const float4*)(p->X + o);
            const float4 g = *(const float4*)(p->MOD + (layer * 9 + modrow(m0)) * 6144 + 2048 + n0 + c4);
            *(float4*)(p->Tb + o) = make_float4(DN_ALPHA * xv.x + g.x * (v.x * W8_INV), DN_ALPHA * xv.y + g.y * (v.y * W8_INV),
                                                DN_ALPHA * xv.z + g.z * (v.z * W8_INV), DN_ALPHA * xv.w + g.w * (v.w * W8_INV));
          }
        } break;
        case 2: {
#pragma unroll 8
          for (int it = 0; it < 16; ++it) {
            const int row = it * 8 + r0;
            const float4 v = *(const float4*)(Ct + row * 128 + c4);

            if (((c4 >> 5) & 1) == 0) {
              const float4 u = *(const float4*)(Ct + row * 128 + c4 + 32);
              const float a0 = v.x * W8_INV, a1 = v.y * W8_INV, a2 = v.z * W8_INV, a3 = v.w * W8_INV;
              *(unsigned*)((unsigned char*)p->ACT + ((size_t)mtile * 128 + row) * 256 + aux * 64 + (c4 >> 6) * 32 + (c4 & 31)) =
                  pk_fp8x4c(silu_f(a0) * (u.x * W8_INV), silu_f(a1) * (u.y * W8_INV), silu_f(a2) * (u.z * W8_INV), silu_f(a3) * (u.w * W8_INV));
            }
          }
        } break;
        case 3: {
#pragma unroll 16
          for (int it = 0; it < 16; ++it) {
            const int row = it * 8 + r0;
            const float4 v = *(const float4*)(Ct + row * 128 + c4);

            const float g = s_gate[row] * W8_INV;
            u32x2 o; o.x = pk_bf16(g * v.x, g * v.y); o.y = pk_bf16(g * v.z, g * v.w);
            *(u32x2*)(p->OUT2 + ((size_t)mtile * 128 + row) * 1024 + n0 + c4) = o;
          }
        } break;
        case 4: {
#pragma unroll 4
          for (int it = 0; it < 16; ++it) {
            const int row = it * 8 + r0;
            const float4 v = *(const float4*)(Ct + row * 128 + c4);

            float4 o4 = v;
            if (aux == 0) o4 = make_float4(tanhf(v.x), tanhf(v.y), tanhf(v.z), tanhf(v.w));
            else if (aux == 2) o4 = make_float4(sigm_f(v.x), sigm_f(v.y), sigm_f(v.z), sigm_f(v.w));
            u32x2 o; o.x = pk_bf16(o4.x, o4.y); o.y = pk_bf16(o4.z, o4.w);
            *(u32x2*)(p->L1 + (size_t)(m0 + row) * 384 + aux * 128 + c4) = o;
          }
        } break;
        default: {
#pragma unroll 4
          for (int it = 0; it < 16; ++it) {
            const int row = it * 8 + r0;
            const float4 v = *(const float4*)(Ct + row * 128 + c4);

            bf16_t* rr = p->RW + (size_t)(m0 + row) * RWS + c05 + c4;
            const float vv[4] = {v.x, v.y, v.z, v.w};
            if (aux < 8) {
              const float4 b0 = *(const float4*)(p->rwkv_w0 + (j * 2 + d5) * 512 + c05 + c4);
              const float bb[4] = {b0.x, b0.y, b0.z, b0.w};
              float e4[4];
#pragma unroll
              for (int q = 0; q < 4; ++q) e4[q] = expf(-softplus_f(-(bb[q] + vv[q])) - 0.5f);
              u32x2 o; o.x = pk_bf16(e4[0], e4[1]); o.y = pk_bf16(e4[2], e4[3]);
              *(u32x2*)(rr + (3 + d5) * 512) = o;
            } else if (aux < 16) {
              const float4 b0 = *(const float4*)(p->rwkv_a0 + (j * 2 + d5) * 512 + c05 + c4);
              const float4 k1 = *(const float4*)(p->rwkv_kvec + (j * 2 + 1) * 512 + c05 + c4);
              const u32x2 kx2 = *(const u32x2*)(rr + 10 * 512);
              const float bb[4] = {b0.x, b0.y, b0.z, b0.w}, kk1[4] = {k1.x, k1.y, k1.z, k1.w};
              const float kx[4] = {bflo(kx2.x), bfhi(kx2.x), bflo(kx2.y), bfhi(kx2.y)};
              float av[4], ke[4];
#pragma unroll
              for (int q = 0; q < 4; ++q) { av[q] = sigm_f(bb[q] + vv[q]); ke[q] = kx[q] * (1.f + (av[q] - 1.f) * kk1[q]); }
              u32x2 o; o.x = pk_bf16(av[0], av[1]); o.y = pk_bf16(av[2], av[3]);
              *(u32x2*)(rr + (7 + d5) * 512) = o;
              o.x = pk_bf16(ke[0], ke[1]); o.y = pk_bf16(ke[2], ke[3]);
              *(u32x2*)(rr + (5 + d5) * 512) = o;
            } else {
              u32x2 o; o.x = pk_bf16(v.x, v.y); o.y = pk_bf16(v.z, v.w);
              *(u32x2*)(rr + 9 * 512) = o;
            }
          }
        } break;
      }
    }
    __syncthreads();
  }
}

__device__ void ph_final_ln(KP p, int layer, bool keep, char* lds) {
  const int tid = opaque_tid();
  const int lane = tid & 63, wave = tid >> 6;
  const int rows = keep ? NT : NL;
  int* s_base = (int*)(lds + META_OFF);
  if (tid == 0) {
    int a = 0;
#pragma unroll 1
    for (int e = 0; e < 64; ++e) { s_base[e] = a * 128; a += (p->cnt[e * CSTR] + 127) >> 7; }
    s_base[64] = a * 128;
  }
  __syncthreads();
  const float* lng = p->ln_g + (layer * 2 + 1) * 1024;
  const float* lnb = p->ln_b + (layer * 2 + 1) * 1024;
  for (int t = blockIdx.x * 4 + wave; t < rows; t += gridDim.x * 4) {
    const int mr = modrow(t);
    const float* g2 = p->MOD + (layer * 9 + mr) * 6144 + 5120;
    const bf16_t* src[7];
#pragma unroll
    for (int k = 0; k < 6; ++k) {
      const int v = p->tsl[t * 6 + k];
      src[k] = p->OUT2 + (size_t)(s_base[v >> 16] + (v & 0xffff)) * 1024;
    }
    src[6] = p->OUT2 + (size_t)(s_base[64] + t) * 1024;
    float v[16];
    float s = 0.f;
#pragma unroll
    for (int c = 0; c < 2; ++c) {
      const int n0 = c * 512 + lane * 8;
      float y[8];
#pragma unroll
      for (int q = 0; q < 8; ++q) y[q] = 0.f;
#pragma unroll
      for (int k = 0; k < 7; ++k) {
        const u32x4 u = *(const u32x4*)(src[k] + n0);
        y[0] += bflo(u.x); y[1] += bfhi(u.x); y[2] += bflo(u.y); y[3] += bfhi(u.y);
        y[4] += bflo(u.z); y[5] += bfhi(u.z); y[6] += bflo(u.w); y[7] += bfhi(u.w);
      }
      const float4 xa = *(const float4*)(p->X + (size_t)t * DM + n0), xb = *(const float4*)(p->X + (size_t)t * DM + n0 + 4);
      const float4 ga = *(const float4*)(g2 + n0), gb = *(const float4*)(g2 + n0 + 4);
      const float xx[8] = {xa.x, xa.y, xa.z, xa.w, xb.x, xb.y, xb.z, xb.w};
      const float gg[8] = {ga.x, ga.y, ga.z, ga.w, gb.x, gb.y, gb.z, gb.w};
#pragma unroll
      for (int q = 0; q < 8; ++q) { v[c * 8 + q] = DN_ALPHA * xx[q] + gg[q] * y[q]; s += v[c * 8 + q]; }
    }
    const float mean = wsum(s) * (1.f / 1024.f);
    float q2 = 0.f;
#pragma unroll
    for (int i = 0; i < 16; ++i) { const float d = v[i] - mean; q2 += d * d; }
    const float rs = rsqrtf(wsum(q2) * (1.f / 1024.f) + 1e-5f);
    const float* modn = p->MOD + ((layer + 1) * 9 + mr) * 6144;
#pragma unroll
    for (int c = 0; c < 2; ++c) {
      const int n0 = c * 512 + lane * 8;
      float xn[8];
#pragma unroll
      for (int q = 0; q < 8; ++q) xn[q] = (v[c * 8 + q] - mean) * rs * lng[n0 + q] + lnb[n0 + q];
      float* xo = (layer == 3 ? p->out : p->X) + (size_t)t * DM + n0;
      *(float4*)(xo) = make_float4(xn[0], xn[1], xn[2], xn[3]);
      *(float4*)(xo + 4) = make_float4(xn[4], xn[5], xn[6], xn[7]);
      if (layer != 3) {
        float hb[8];
#pragma unroll
        for (int q = 0; q < 8; ++q) hb[q] = xn[q] * (1.f + modn[1024 + n0 + q]) + modn[n0 + q];
        u32x2 o;
        o.x = pk_fp8x4c(hb[0], hb[1], hb[2], hb[3]); o.y = pk_fp8x4c(hb[4], hb[5], hb[6], hb[7]);
        *(u32x2*)((unsigned char*)p->AB + (size_t)t * DM + n0) = o;
      }
    }
  }
}

#define XB_TMO      128
#define XB_XCNT(j)  (256  + 64 * (j))
#define XB_XSUB(j)  (1280 + 64 * (j))
#define XB_XGEN(j)  (2304 + 64 * (j))
#define XB_TOP      3328
#define XB_TOPGEN   3392
#define XB_SPIN_CAP (1u << 20)
#define LAS __attribute__((address_space(3)))
__device__ __forceinline__ unsigned xb_ld(unsigned* p) { return __hip_atomic_load(p, __ATOMIC_RELAXED, __HIP_MEMORY_SCOPE_AGENT); }
__device__ __forceinline__ unsigned xb_add(unsigned* p, unsigned v) { return __hip_atomic_fetch_add(p, v, __ATOMIC_RELAXED, __HIP_MEMORY_SCOPE_AGENT); }
__device__ __forceinline__ unsigned xb_xcc_id() { return (unsigned)__builtin_amdgcn_s_getreg((3 << 11) | 20) & 0xFu; }
#define XB_SPIN(cond, bar) do { unsigned _sp = 0; while (cond) { __builtin_amdgcn_s_sleep(1); \
    if ((++_sp & 255u) == 0u) { if (xb_ld(&(bar)[XB_TMO])) break; if (_sp > XB_SPIN_CAP) { atomicAdd(&(bar)[XB_TMO], 1u); break; } } } } while (0)
struct XcdBarrier { unsigned* bar; unsigned x; volatile LAS unsigned* st; };
__device__ __forceinline__ XcdBarrier xcd_barrier_post(unsigned* bar, volatile LAS unsigned* st) {
  XcdBarrier b; b.bar = bar; b.x = xb_xcc_id(); b.st = st;
  if (threadIdx.x == 0) (void)xb_add(&bar[XB_XCNT(b.x)], 1u);
  return b;
}
__device__ __forceinline__ void xcd_barrier_complete(unsigned* bar, unsigned x, unsigned& nloc, unsigned& nx) {
  const unsigned G = gridDim.x;
  unsigned sum, cnt, mine, sp = 0u;
  for (;;) {
    sum = 0u; cnt = 0u; mine = 0u;
#pragma unroll
    for (unsigned j = 0; j < 16; ++j) { const unsigned c = xb_ld(&bar[XB_XCNT(j)]); sum += c; cnt += (c > 0u) ? 1u : 0u; mine = (j == x) ? c : mine; }
    if (sum == G) break;
    __builtin_amdgcn_s_sleep(1);
    if ((++sp & 255u) == 0u) { if (xb_ld(&bar[XB_TMO])) break; if (sp > XB_SPIN_CAP) { atomicAdd(&bar[XB_TMO], 1u); break; } }
  }
  nloc = mine > 0u ? mine : 1u; nx = cnt > 0u ? cnt : 1u;
}
__device__ __forceinline__ void xcd_barrier(const XcdBarrier& b) {
  asm volatile("s_waitcnt vmcnt(0)" ::: "memory");
  __syncthreads();
  if (threadIdx.x == 0) {
    unsigned* bar = b.bar;
    __builtin_amdgcn_s_waitcnt(0);
    unsigned nloc = b.st[0], nx = b.st[1];
    if (nloc == 0u) { xcd_barrier_complete(bar, b.x, nloc, nx); b.st[0] = nloc; b.st[1] = nx; }
    const unsigned old = xb_add(&bar[XB_XSUB(b.x)], 1u);
    const unsigned gen = old / nloc;
    if (old + 1u == (gen + 1u) * nloc) {
      __builtin_amdgcn_fence(__ATOMIC_RELEASE, "agent");
      asm volatile("s_waitcnt vmcnt(0)" ::: "memory");
      const unsigned og = xb_add(&bar[XB_TOP], 1u);
      const unsigned tg = og / nx;
      if (og + 1u == (tg + 1u) * nx) xb_add(&bar[XB_TOPGEN], 1u);
      else XB_SPIN(xb_ld(&bar[XB_TOPGEN]) == tg, bar);
      __builtin_amdgcn_fence(__ATOMIC_ACQUIRE, "agent");
      xb_add(&bar[XB_XGEN(b.x)], 1u);
      asm volatile("s_waitcnt vmcnt(0)" ::: "memory");
    } else {
      XB_SPIN(xb_ld(&bar[XB_XGEN(b.x)]) == gen, bar);
      __builtin_amdgcn_fence(__ATOMIC_ACQUIRE, "agent");
      asm volatile("s_waitcnt vmcnt(0)" ::: "memory");
    }
  }
  __syncthreads();
}

constexpr int NSLOTS = 13;
constexpr int NPHASE = 2 + 4 * NSLOTS;
__device__ __forceinline__ bool phase_is_nop(int ph) {
  if (ph < 2) return false;
  const int layer = (ph - 2) / NSLOTS, st = (ph - 2) % NSLOTS;
  if (st == 5 || st == 6) return true;
  return !(layer & 1) && (st == 1 || (st >= 3 && st <= 7));
}
__device__ void run_phase(KP p, int ph, char* sm) {
  if (ph == 0) { ph_init(p, sm); return; }
  if (ph == 1) { ph_mod_h(p, sm); return; }
  const int layer = (ph - 2) / NSLOTS, st = (ph - 2) % NSLOTS;
  const bool odd = layer & 1;
  const bool keep = layer < 3;
  int gk = -1;
  if (st == 0) gk = 0;
  else if (st == 8) gk = 1;
  else if (st == 10) gk = 2;
  else if (st == 11) gk = 3;
  else if (odd && st == 2) gk = 4;
  else if (odd && st == 3) gk = 5;
  asm volatile("" : "+s"(gk));
  if (gk >= 0) {
    if (gk == 2 || gk == 3) moe_prefix(p, keep ? NT : NL, (int*)(sm + META_OFF), opaque_tid());
    ph_gemm(p, gk, layer, keep, sm);
    if (gk == 5) { __syncthreads(); ph_mlstm_s2(p, sm); }
    return;
  }
  switch (st) {
    case 1: if (odd) { ph_rwkv_mix(p, layer); ph_mlstm_s1(p, layer, sm); } break;
    case 2: ph_attention(p, layer, keep, sm); break;
    case 4: if (odd) ph_scan_a(p, layer, sm); break;
    case 7: if (odd) ph_rec_final(p, layer, keep); break;
    case 9: ph_ln_router(p, layer, keep, sm); break;
    case 12: ph_final_ln(p, layer, keep, sm); break;
  }
}

__global__ void __launch_bounds__(NTHR, 2) mega_kernel(Params kargs) {
  extern __shared__ __attribute__((aligned(16))) char sm[];
  cg::grid_group grid = cg::this_grid();
  volatile LAS unsigned* st = (volatile LAS unsigned*)(sm + META_OFF + 4032);
  if (threadIdx.x == 0) { st[0] = 0u; st[1] = 0u; }
  __syncthreads();
  const XcdBarrier xb = xcd_barrier_post(kargs.bar, st);
  for (int ph = kargs.ph_lo; ph < kargs.ph_hi; ++ph) {
    if (phase_is_nop(ph)) continue;
    {
      KP kp = (KP)__builtin_amdgcn_kernarg_segment_ptr();
      asm volatile("" : "+s"(kp));
      run_phase(kp, ph, sm);
    }
    if (ph + 1 < kargs.ph_hi) {
      if (ph == 0) grid.sync();
      else xcd_barrier(xb);
    }
  }
}

extern "C" void kernel_launch(void* const* d_in, const int* in_sizes, int n_in, void* d_out, int out_size, void* d_ws,
                              size_t ws_size, hipStream_t stream) {
  static int grid_blocks = 0;
  if (!grid_blocks) {
    int dev = 0, cus = 0, per_cu = 0;
    (void)hipGetDevice(&dev);
    (void)hipDeviceGetAttribute(&cus, hipDeviceAttributeMultiprocessorCount, dev);
    (void)hipFuncSetAttribute((const void*)mega_kernel, hipFuncAttributeMaxDynamicSharedMemorySize, SMEM_BYTES);
    (void)hipOccupancyMaxActiveBlocksPerMultiprocessor(&per_cu, mega_kernel, NTHR, SMEM_BYTES);
    if (per_cu < 1) per_cu = 1;
    if (per_cu > 2) per_cu = 2;
    grid_blocks = cus * per_cu;
  }
  Params p;
  memset(&p, 0, sizeof(p));
  const float** pin = (const float**)&p;
  for (int i = 0; i < 35; ++i) pin[i] = (const float*)d_in[i];
  p.out = (float*)d_out;
  char* w = (char*)d_ws;
  size_t off = 0;
  auto take = [&](size_t bytes) { char* r = w + off; off += (bytes + 255) & ~(size_t)255; return r; };
  p.Wt_att = (bf16_t*)take((size_t)2 * ATT_N * 1024 * 2);
  p.Wt_rec = (bf16_t*)take((size_t)2 * REC_NP * 1024 * 2);
  p.Wt_out = (bf16_t*)take((size_t)4 * 1024 * 1024 * 2);
  p.Wt13 = (bf16_t*)take((size_t)4 * 65 * 512 * 1024);
  p.Wt2 = (bf16_t*)take((size_t)4 * 65 * 1024 * 256);
  p.Wl1 = (bf16_t*)take((size_t)2 * 3 * 128 * 512 * 2);
  p.Wl2 = (bf16_t*)take((size_t)2 * 2560 * 128 * 2);
  p.X = (float*)take((size_t)NT * DM * 4);
  p.AB = (bf16_t*)take((size_t)NT * DM * 2);
  p.MOD = (float*)take((size_t)5 * 9 * 6144 * 4);
  p.MODP = (float*)take((size_t)8 * 4 * 9 * 6144 * 4);
  p.GP = (float*)take((size_t)NT * 16 * 4);
  p.ROPE = (float*)take((size_t)64 * 16 * 2 * 4);
  p.WrT = (float*)take((size_t)4 * 64 * 1024 * 4);
  p.msc = (float*)take((size_t)3 * NMT * 4);
  p.lgate = (float*)take((size_t)64 * NT * 4);
  p.ltok = (int*)take((size_t)64 * NT * 4);
  p.tsl = (int*)take((size_t)NT * 6 * 4);
  p.cnt = (int*)take((size_t)65 * CSTR * 4);
  p.bar = (unsigned*)take((size_t)BAR_TOTAL_WORDS * 4);
  char* region = take(0);
  const size_t szP = (size_t)NT * LDP * 2, szRW = (size_t)NT * RWS * 2, szMS = (size_t)NMT * 16384 * 2,
               szMSn = (size_t)NMT * 128 * 4;
  const size_t szT = (size_t)NT * DM * 4, szOUT2 = (size_t)NSLOT * 1024 * 2;
  p.P = (bf16_t*)region;
  p.RW = (bf16_t*)(region + szP);
  p.MS = (bf16_t*)(region + szP + szRW);
  p.MSn = (float*)(region + szP + szRW + szMS);
  p.Tb = (float*)region;
  p.ACT = (bf16_t*)region;
  p.OUT2 = (bf16_t*)(region + szT);
  const size_t szZ = (size_t)NT * 2048 * 2;
  p.Zb = (bf16_t*)(region + szP + szRW + szMS + szMSn);
  p.L1 = p.Zb + (size_t)NT * 1536;
  size_t mixer = szP + szRW + szMS + szMSn + szZ, moe = szT + szOUT2;
  off += (mixer > moe ? mixer : moe);
  if (off > ws_size) { fprintf(stderr, "workspace too small: need %zu have %zu\n", off, ws_size); return; }
  p.ph_lo = 0;
  p.ph_hi = NPHASE;
  (void)hipMemsetAsync(p.bar, 0, (size_t)BAR_TOTAL_WORDS * 4, stream);
  void* args[] = {&p};
  hipError_t e = hipLaunchCooperativeKernel((void*)mega_kernel, dim3(grid_blocks), dim3(NTHR), args, SMEM_BYTES, stream);
  if (e != hipSuccess) fprintf(stderr, "cooperative launch failed: %s (grid %d)\n", hipGetErrorString(e), grid_blocks);
}
```

```cpp
#include <hip/hip_runtime.h>
#include <hip/hip_cooperative_groups.h>
#include <cstdio>
#include <cstring>
namespace cg = cooperative_groups;

constexpr int DM = 1024;
constexpr int NBATCH = 8;
constexpr int SEQ = 2048;
constexpr int CTXL = 256;
constexpr int NL = NBATCH * SEQ;
constexpr int NC = NBATCH * CTXL;
constexpr int NT = NL + NC;
constexpr int TSC = CTXL + SEQ;
constexpr int LDP = 4112;
constexpr int ATT_N = 2304;
constexpr int REC_N = 4112;
constexpr int REC_NP = 4224;
constexpr int NCHUNK = 36;
constexpr int NMT = 64 * NCHUNK;
constexpr int RWS = 5632;
constexpr int NSLOT = 137216;
constexpr float DN_ALPHA = 1.6817928305074290f;
constexpr int NTHR = 256;
constexpr int SMEM_BYTES = 65536 + 4096;
constexpr int META_OFF = 65536;
#define XCD_BAR_WORDS 3456
constexpr int CSTR = 32;
constexpr int BAR_TOTAL_WORDS = XCD_BAR_WORDS + 64;

typedef unsigned short bf16_t;
using bf16x8 = __attribute__((ext_vector_type(8))) short;
using f32x16 = __attribute__((ext_vector_type(16))) float;
using u32x4 = __attribute__((ext_vector_type(4))) unsigned;
using u32x2 = __attribute__((ext_vector_type(2))) unsigned;

struct Params {
  const float *x, *c, *ctx, *c_ctx, *ada_w, *ada_b, *ln_g, *ln_b, *mix_w_out, *att_w_in, *na_rpb, *qk_gain,
      *rec_w_in, *rwkv_mu, *rwkv_w0, *rwkv_w1, *rwkv_w2, *rwkv_a0, *rwkv_a1, *rwkv_a2, *rwkv_g1, *rwkv_g2,
      *rwkv_kvec, *rwkv_rk, *rwkv_gn, *mlstm_gate_b, *mlstm_norm, *moe_router, *moe_bias, *moe_w1, *moe_w3,
      *moe_w2, *shared_w1, *shared_w3, *shared_w2;
  float* out;
  bf16_t *Wt_att, *Wt_rec, *Wt_out, *Wt13, *Wt2, *Wl1, *Wl2;
  bf16_t *Zb, *L1;
  float *X, *MOD, *MODP, *GP, *msc, *lgate, *MSn, *Tb, *ROPE, *WrT;
  bf16_t *AB, *P, *RW, *MS, *ACT, *OUT2;
  int *cnt, *ltok, *tsl;
  unsigned* bar;
  int ph_lo, ph_hi;
};

typedef const Params __attribute__((address_space(4))) * KP;

__device__ __forceinline__ int modrow(int t) { return t < NL ? (t >> 11) : 8; }
__device__ __forceinline__ float silu_f(float x) { return x / (1.f + expf(-x)); }
__device__ __forceinline__ float sigm_f(float x) { return 1.f / (1.f + expf(-x)); }
__device__ __forceinline__ float softplus_f(float x) { return fmaxf(x, 0.f) + log1pf(expf(-fabsf(x))); }
template <int CTRL>
__device__ __forceinline__ float dppx(float x) {
  return __int_as_float(__builtin_amdgcn_update_dpp(0, __float_as_int(x), CTRL, 0xf, 0xf, true));
}
__device__ __forceinline__ float rdlane(float v, int l) {
  return __int_as_float(__builtin_amdgcn_readlane(__float_as_int(v), l));
}
__device__ __forceinline__ float wsum(float v) {
  v += dppx<0xB1>(v); v += dppx<0x4E>(v); v += dppx<0x141>(v); v += dppx<0x140>(v);
  return (rdlane(v, 0) + rdlane(v, 16)) + (rdlane(v, 32) + rdlane(v, 48));
}
__device__ __forceinline__ float wmax(float v) {
  v = fmaxf(v, dppx<0xB1>(v)); v = fmaxf(v, dppx<0x4E>(v)); v = fmaxf(v, dppx<0x141>(v)); v = fmaxf(v, dppx<0x140>(v));
  return fmaxf(fmaxf(rdlane(v, 0), rdlane(v, 16)), fmaxf(rdlane(v, 32), rdlane(v, 48)));
}
__device__ __forceinline__ int opaque_tid() {
  int t = threadIdx.x;
  asm volatile("" : "+v"(t));
  return t;
}
typedef __bf16 bf16x2_t __attribute__((ext_vector_type(2)));
typedef float f32x2_t __attribute__((ext_vector_type(2)));
__device__ __forceinline__ unsigned pk_bf16(float lo, float hi) {
  const f32x2_t v = {lo, hi};
  return __builtin_bit_cast(unsigned, __builtin_convertvector(v, bf16x2_t));
}
__device__ __forceinline__ bf16_t f2bf(float x) { return (bf16_t)(pk_bf16(x, 0.f) & 0xffffu); }
__device__ __forceinline__ float bf2f(bf16_t v) { return __uint_as_float((unsigned)v << 16); }
__device__ __forceinline__ float bflo(unsigned u) { return __uint_as_float(u << 16); }
__device__ __forceinline__ float bfhi(unsigned u) { return __uint_as_float(u & 0xffff0000u); }
__device__ __forceinline__ int scan_row(int dir, int b, int tau) {
  if (tau < CTXL) return NL + b * CTXL + (dir ? (CTXL - 1 - tau) : tau);
  int s = tau - CTXL;
  return b * SEQ + (dir ? (SEQ - 1 - s) : s);
}

template <class RowPtrA>
__device__ __forceinline__ void gemm128_main(int tid, RowPtrA rowA, const bf16_t* __restrict__ Bt, int K, int n0,
                                             char* lds, f32x16 (&acc)[2][2]) {
  const int lane = tid & 63, w = tid >> 6;
  const int wm = w >> 1, wn = w & 1, r = lane & 31, h = lane >> 5;
  const int c = tid & 7, sr = tid >> 3;
  const int lc = (c ^ ((tid >> 4) & 7)) * 8;
  const bf16_t* ap[4];
#pragma unroll
  for (int i = 0; i < 4; ++i) ap[i] = rowA(sr + 32 * i) + lc;
  const bf16_t* bp0 = Bt + (size_t)(n0 + sr) * K + lc;
  const int bstr = 32 * K;
#pragma unroll
  for (int mi = 0; mi < 2; ++mi)
#pragma unroll
    for (int ni = 0; ni < 2; ++ni)
#pragma unroll
      for (int q = 0; q < 16; ++q) acc[mi][ni][q] = 0.f;
  const int nk = K >> 6;
  auto issue = [&](int kt) {
    char* As = lds + (kt & 1) * 32768 + tid * 16;
    const int k0 = kt * 64;
#pragma unroll
    for (int i = 0; i < 4; ++i) {
      __builtin_amdgcn_global_load_lds((const unsigned*)(ap[i] + k0), (__attribute__((address_space(3))) unsigned*)(As + i * 4096), 16, 0, 0);
      __builtin_amdgcn_global_load_lds((const unsigned*)(bp0 + i * bstr + k0), (__attribute__((address_space(3))) unsigned*)(As + 16384 + i * 4096), 16, 0, 0);
    }
  };
  issue(0);
  const int sw = (r >> 1) & 7;
#pragma unroll 1
  for (int kt = 0; kt < nk; ++kt) {
    asm volatile("s_waitcnt vmcnt(0)" ::: "memory");
    __syncthreads();
    if (kt + 1 < nk) issue(kt + 1);
    const char* As = lds + (kt & 1) * 32768;
    const char* Ar = As + (wm * 64 + r) * 128;
    const char* Br = As + 16384 + (wn * 64 + r) * 128;
#pragma unroll
    for (int ks = 0; ks < 4; ++ks) {
      const int off = ((ks * 2 + h) ^ sw) * 16;
      const bf16x8 a0 = *(const bf16x8*)(Ar + off);
      const bf16x8 a1 = *(const bf16x8*)(Ar + 32 * 128 + off);
      const bf16x8 b0 = *(const bf16x8*)(Br + off);
      const bf16x8 b1 = *(const bf16x8*)(Br + 32 * 128 + off);
      acc[0][0] = __builtin_amdgcn_mfma_f32_32x32x16_bf16(a0, b0, acc[0][0], 0, 0, 0);
      acc[0][1] = __builtin_amdgcn_mfma_f32_32x32x16_bf16(a0, b1, acc[0][1], 0, 0, 0);
      acc[1][0] = __builtin_amdgcn_mfma_f32_32x32x16_bf16(a1, b0, acc[1][0], 0, 0, 0);
      acc[1][1] = __builtin_amdgcn_mfma_f32_32x32x16_bf16(a1, b1, acc[1][1], 0, 0, 0);
    }
  }
  __syncthreads();
}
using i64 = long;
typedef int i32x8 __attribute__((ext_vector_type(8)));
template <class RowPtrA8>
__device__ __forceinline__ void gemm128_fp8(int tid, RowPtrA8 rowA, const unsigned char* __restrict__ Bt, int K, int n0,
                                            char* lds, f32x16 (&acc)[2][2]) {
  const int lane = tid & 63, w = tid >> 6;
  const int wm = w >> 1, wn = w & 1, r = lane & 31, h = lane >> 5;
  const int c = tid & 7, sr = tid >> 3;
  const int lc = (c ^ ((tid >> 4) & 7)) * 16;
  const unsigned char* ap[4];
#pragma unroll
  for (int i = 0; i < 4; ++i) ap[i] = rowA(sr + 32 * i) + lc;
  const unsigned char* bp0 = Bt + (size_t)(n0 + sr) * K + lc;
  const int bstr = 32 * K;
#pragma unroll
  for (int mi = 0; mi < 2; ++mi)
#pragma unroll
    for (int ni = 0; ni < 2; ++ni)
#pragma unroll
      for (int q = 0; q < 16; ++q) acc[mi][ni][q] = 0.f;
  const int nk = K >> 7;
  auto issue = [&](int kt) {
    char* As = lds + (kt & 1) * 32768 + tid * 16;
    const int k0 = kt * 128;
#pragma unroll
    for (int i = 0; i < 4; ++i) {
      __builtin_amdgcn_global_load_lds((const unsigned*)(ap[i] + k0), (__attribute__((address_space(3))) unsigned*)(As + i * 4096), 16, 0, 0);
      __builtin_amdgcn_global_load_lds((const unsigned*)(bp0 + i * bstr + k0), (__attribute__((address_space(3))) unsigned*)(As + 16384 + i * 4096), 16, 0, 0);
    }
  };
  issue(0);
  const int sw = (r >> 1) & 7;
#pragma unroll 1
  for (int kt = 0; kt < nk; ++kt) {
    asm volatile("s_waitcnt vmcnt(0)" ::: "memory");
    __syncthreads();
    if (kt + 1 < nk) issue(kt + 1);
    const char* As = lds + (kt & 1) * 32768;
    const char* Ar = As + (wm * 64 + r) * 128;
    const char* Br = As + 16384 + (wn * 64 + r) * 128;
#pragma unroll
    for (int pq = 0; pq < 2; ++pq) {
      const int o0 = ((4 * pq + 2 * h) ^ sw) * 16, o1 = ((4 * pq + 2 * h + 1) ^ sw) * 16;
      const u32x4 a0l = *(const u32x4*)(Ar + o0), a0h = *(const u32x4*)(Ar + o1);
      const u32x4 a1l = *(const u32x4*)(Ar + 32 * 128 + o0), a1h = *(const u32x4*)(Ar + 32 * 128 + o1);
      const u32x4 b0l = *(const u32x4*)(Br + o0), b0h = *(const u32x4*)(Br + o1);
      const u32x4 b1l = *(const u32x4*)(Br + 32 * 128 + o0), b1h = *(const u32x4*)(Br + 32 * 128 + o1);
      const i32x8 A0 = {(int)a0l.x, (int)a0l.y, (int)a0l.z, (int)a0l.w, (int)a0h.x, (int)a0h.y, (int)a0h.z, (int)a0h.w};
      const i32x8 A1 = {(int)a1l.x, (int)a1l.y, (int)a1l.z, (int)a1l.w, (int)a1h.x, (int)a1h.y, (int)a1h.z, (int)a1h.w};
      const i32x8 B0 = {(int)b0l.x, (int)b0l.y, (int)b0l.z, (int)b0l.w, (int)b0h.x, (int)b0h.y, (int)b0h.z, (int)b0h.w};
      const i32x8 B1 = {(int)b1l.x, (int)b1l.y, (int)b1l.z, (int)b1l.w, (int)b1h.x, (int)b1h.y, (int)b1h.z, (int)b1h.w};
      acc[0][0] = __builtin_amdgcn_mfma_scale_f32_32x32x64_f8f6f4(A0, B0, acc[0][0], 0, 0, 0, 0, 0, 0);
      acc[0][1] = __builtin_amdgcn_mfma_scale_f32_32x32x64_f8f6f4(A0, B1, acc[0][1], 0, 0, 0, 0, 0, 0);
      acc[1][0] = __builtin_amdgcn_mfma_scale_f32_32x32x64_f8f6f4(A1, B0, acc[1][0], 0, 0, 0, 0, 0, 0);
      acc[1][1] = __builtin_amdgcn_mfma_scale_f32_32x32x64_f8f6f4(A1, B1, acc[1][1], 0, 0, 0, 0, 0, 0);
    }
  }
  __syncthreads();
}
template <class F>
__device__ __forceinline__ void acc_foreach(int tid, const f32x16 (&acc)[2][2], F f) {
  const int lane = tid & 63, w = tid >> 6;
  const int wm = w >> 1, wn = w & 1, r = lane & 31, h = lane >> 5;
#pragma unroll
  for (int mi = 0; mi < 2; ++mi)
#pragma unroll
    for (int ni = 0; ni < 2; ++ni)
#pragma unroll
      for (int q = 0; q < 16; ++q) {
        const int row = wm * 64 + mi * 32 + (q & 3) + 8 * (q >> 2) + 4 * h;
        const int col = wn * 64 + ni * 32 + r;
        f(row, col, acc[mi][ni][q]);
        if ((q & 3) == 3) __builtin_amdgcn_sched_barrier(0);
      }
}

template <class RM>
__device__ __forceinline__ void tr_tile(int tid, const float* __restrict__ src, int N, int k0, int n0,
                                        bf16_t* __restrict__ dst, int K, RM rowmap, float* tile) {
  {
    const int tx = tid & 15, ty = tid >> 4;
    const int n = n0 + tx * 4;
#pragma unroll
    for (int i = 0; i < 4; ++i) {
      const int k = ty + 16 * i;
      float4 v = make_float4(0.f, 0.f, 0.f, 0.f);
      if (n < N) v = *(const float4*)(src + (size_t)(k0 + k) * N + n);
      tile[k * 65 + tx * 4 + 0] = v.x; tile[k * 65 + tx * 4 + 1] = v.y;
      tile[k * 65 + tx * 4 + 2] = v.z; tile[k * 65 + tx * 4 + 3] = v.w;
    }
  }
  __syncthreads();
  {
    const int kc = tid & 7;
#pragma unroll
    for (int i = 0; i < 2; ++i) {
      const int n = (tid >> 3) + 32 * i;
      if (n0 + n < N) {
        float v[8];
#pragma unroll
        for (int q = 0; q < 8; ++q) v[q] = tile[(kc * 8 + q) * 65 + n];
        u32x4 o;
        o.x = pk_bf16(v[0], v[1]); o.y = pk_bf16(v[2], v[3]); o.z = pk_bf16(v[4], v[5]); o.w = pk_bf16(v[6], v[7]);
        *(u32x4*)(dst + (size_t)rowmap(n0 + n) * K + k0 + kc * 8) = o;
      }
    }
  }
  __syncthreads();
}

constexpr float W8_SCALE = 32.f, W8_INV = 1.f / 32.f;
__device__ __forceinline__ unsigned pk_fp8x4(float a, float b, float c, float d) {
  int r = __builtin_amdgcn_cvt_pk_fp8_f32(a, b, 0, false);
  r = __builtin_amdgcn_cvt_pk_fp8_f32(c, d, r, true);
  return (unsigned)r;
}
__device__ __forceinline__ unsigned pk_fp8x4c(float a, float b, float c, float d) {
  constexpr float M = 448.f;
  return pk_fp8x4(fminf(fmaxf(a, -M), M), fminf(fmaxf(b, -M), M), fminf(fmaxf(c, -M), M), fminf(fmaxf(d, -M), M));
}
template <class RM>
__device__ __forceinline__ void tr_tile_fp8(int tid, const float* __restrict__ src, int N, int k0, int n0,
                                            unsigned char* __restrict__ dst, int K, RM rowmap, float* tile) {
  {
    const int tx = tid & 15, ty = tid >> 4;
    const int n = n0 + tx * 4;
#pragma unroll
    for (int i = 0; i < 4; ++i) {
      const int k = ty + 16 * i;
      float4 v = make_float4(0.f, 0.f, 0.f, 0.f);
      if (n < N) v = *(const float4*)(src + (size_t)(k0 + k) * N + n);
      tile[k * 65 + tx * 4 + 0] = v.x; tile[k * 65 + tx * 4 + 1] = v.y;
      tile[k * 65 + tx * 4 + 2] = v.z; tile[k * 65 + tx * 4 + 3] = v.w;
    }
  }
  __syncthreads();
  {
    const int kc = tid & 3, n = tid >> 2;
    float v[16];
#pragma unroll
    for (int q = 0; q < 16; ++q) v[q] = tile[(kc * 16 + q) * 65 + n] * W8_SCALE;
    u32x4 o;
    o.x = pk_fp8x4c(v[0], v[1], v[2], v[3]); o.y = pk_fp8x4c(v[4], v[5], v[6], v[7]);
    o.z = pk_fp8x4c(v[8], v[9], v[10], v[11]); o.w = pk_fp8x4c(v[12], v[13], v[14], v[15]);
    *(u32x4*)(dst + (size_t)rowmap(n0 + n) * K + k0 + kc * 16) = o;
  }
  __syncthreads();
}

constexpr int CJ0 = 1152, CJ1 = CJ0 + 2080, CJ2 = CJ1 + 1024, CJ3 = CJ2 + 33280, CJ4 = CJ3 + 16640;
__device__ void convert_job(KP p, int job, float* sm, int tid) {
  if (job < CJ0) {
    const int j = job / 576, rem = job % 576, kt = rem / 36, nt = rem % 36;
    tr_tile_fp8(tid, p->att_w_in + (size_t)j * 1024 * ATT_N, ATT_N, kt * 64, nt * 64, (unsigned char*)p->Wt_att + (size_t)j * ATT_N * 1024,
                1024, [](int n) { return n; }, sm);
  } else if (job < CJ1) {
    const int q = job - CJ0;
    const int j = q / 1040, rem = q % 1040, kt = rem / 65, nt = rem % 65;
    tr_tile_fp8(tid, p->rec_w_in + (size_t)j * 1024 * REC_N, REC_N, kt * 64, nt * 64, (unsigned char*)p->Wt_rec + (size_t)j * REC_NP * 1024,
                1024, [](int n) { return n; }, sm);
  } else if (job < CJ2) {
    const int q = job - CJ1;
    const int i = q >> 8, rem = q & 255, kt = rem >> 4, nt = rem & 15;
    tr_tile_fp8(tid, p->mix_w_out + (size_t)i * 1024 * 1024, 1024, kt * 64, nt * 64, (unsigned char*)p->Wt_out + (size_t)i * 1024 * 1024,
                1024, [](int n) { return n; }, sm);
  } else if (job < CJ3) {
    const int q = job - CJ2;
    const int le = q >> 7, rem = q & 127;
    const int which = rem >> 6, kt = (rem >> 2) & 15, nt = rem & 3;
    const int layer = le / 65, e = le % 65;
    const float* src;
    if (e < 64) src = (which ? p->moe_w3 : p->moe_w1) + (size_t)(layer * 64 + e) * 1024 * 256;
    else src = (which ? p->shared_w3 : p->shared_w1) + (size_t)layer * 1024 * 256;
    tr_tile_fp8(tid, src, 256, kt * 64, nt * 64, (unsigned char*)p->Wt13 + (size_t)le * 512 * 1024, 1024,
                [which](int n) { return 64 * (n >> 5) + which * 32 + (n & 31); }, sm);
  } else {
    const int q = job - CJ3;
    const int le = q >> 6, rem = q & 63;
    const int kt = rem >> 4, nt = rem & 15;
    const int layer = le / 65, e = le % 65;
    const float* src = e < 64 ? p->moe_w2 + (size_t)(layer * 64 + e) * 256 * 1024 : p->shared_w2 + (size_t)layer * 256 * 1024;
    tr_tile_fp8(tid, src, 1024, kt * 64, nt * 64, (unsigned char*)p->Wt2 + (size_t)le * 1024 * 256, 256, [](int n) { return n; }, sm);
  }
}
__device__ __forceinline__ int conv_stage_total(int stage) {
  return stage == 0 ? (576 + 1040 + 512 + 8320 + 4160) : (stage == 1 ? (576 + 1040 + 256 + 16640 + 8320) : (256 + 8320 + 4160));
}
__device__ __forceinline__ int conv_stage_job(int stage, int q) {
  if (stage == 0) {
    if (q < 8320) return CJ2 + q;  q -= 8320;
    if (q < 4160) return CJ3 + q;  q -= 4160;
    if (q < 576) return q;  q -= 576;
    if (q < 1040) return CJ0 + q;  q -= 1040;
    return CJ1 + q;
  } else if (stage == 1) {
    if (q < 8320) return CJ2 + 8320 + q;  q -= 8320;
    if (q < 4160) return CJ3 + 4160 + q;  q -= 4160;
    if (q < 576) return 576 + q;  q -= 576;
    if (q < 256) return CJ1 + 512 + q;  q -= 256;
    if (q < 8320) return CJ2 + 16640 + q;  q -= 8320;
    if (q < 4160) return CJ3 + 8320 + q;  q -= 4160;
    return CJ0 + 1040 + q;
  }
  if (q < 256) return CJ1 + 768 + q;  q -= 256;
  if (q < 8320) return CJ2 + 24960 + q;  q -= 8320;
  return CJ3 + 12480 + q;
}

struct CvDesc { const float* src; unsigned char* dst; int N, K, k0, n0, which; };
__device__ __forceinline__ bool conv_desc_fp8(KP p, int job, CvDesc& d) {
  if (job < CJ2) return false;
  if (job < CJ3) {
    const int q = job - CJ2;
    const int le = q >> 7, rem = q & 127;
    const int which = rem >> 6, kt = (rem >> 2) & 15, nt = rem & 3;
    const int layer = le / 65, e = le % 65;
    if (e < 64) d.src = (which ? p->moe_w3 : p->moe_w1) + (size_t)(layer * 64 + e) * 1024 * 256;
    else d.src = (which ? p->shared_w3 : p->shared_w1) + (size_t)layer * 1024 * 256;
    d.dst = (unsigned char*)p->Wt13 + (size_t)le * 512 * 1024;
    d.N = 256; d.K = 1024; d.k0 = kt * 64; d.n0 = nt * 64; d.which = which;
  } else {
    const int q = job - CJ3;
    const int le = q >> 6, rem = q & 63;
    const int kt = rem >> 4, nt = rem & 15;
    const int layer = le / 65, e = le % 65;
    d.src = e < 64 ? p->moe_w2 + (size_t)(layer * 64 + e) * 256 * 1024 : p->shared_w2 + (size_t)layer * 256 * 1024;
    d.dst = (unsigned char*)p->Wt2 + (size_t)le * 1024 * 256;
    d.N = 1024; d.K = 256; d.k0 = kt * 64; d.n0 = nt * 64; d.which = -1;
  }
  return true;
}
typedef float cvf4 __attribute__((ext_vector_type(4)));
__device__ __forceinline__ void cv_load(const CvDesc& d, int tid, cvf4& v0, cvf4& v1, cvf4& v2, cvf4& v3) {
  const int tx = tid & 15, ty = tid >> 4;
  const float* s0 = d.src + (size_t)(d.k0 + ty) * d.N + d.n0 + tx * 4;
  v0 = *(const cvf4*)(s0);
  v1 = *(const cvf4*)(s0 + (size_t)16 * d.N);
  v2 = *(const cvf4*)(s0 + (size_t)32 * d.N);
  v3 = *(const cvf4*)(s0 + (size_t)48 * d.N);
}
__device__ __forceinline__ void cv_emit(const CvDesc& d, int tid, const cvf4 v0, const cvf4 v1, const cvf4 v2, const cvf4 v3, float* tile) {
  {
    const int tx = tid & 15, ty = tid >> 4;
    float* t0 = tile + ty * 65 + tx * 4;
    t0[0] = v0.x; t0[1] = v0.y; t0[2] = v0.z; t0[3] = v0.w;
    t0[16 * 65 + 0] = v1.x; t0[16 * 65 + 1] = v1.y; t0[16 * 65 + 2] = v1.z; t0[16 * 65 + 3] = v1.w;
    t0[32 * 65 + 0] = v2.x; t0[32 * 65 + 1] = v2.y; t0[32 * 65 + 2] = v2.z; t0[32 * 65 + 3] = v2.w;
    t0[48 * 65 + 0] = v3.x; t0[48 * 65 + 1] = v3.y; t0[48 * 65 + 2] = v3.z; t0[48 * 65 + 3] = v3.w;
  }
  __syncthreads();
  {
    const int kc = tid & 3, n = tid >> 2;
    float v[16];
#pragma unroll
    for (int q = 0; q < 16; ++q) v[q] = tile[(kc * 16 + q) * 65 + n] * W8_SCALE;
    u32x4 o;
    o.x = pk_fp8x4c(v[0], v[1], v[2], v[3]); o.y = pk_fp8x4c(v[4], v[5], v[6], v[7]);
    o.z = pk_fp8x4c(v[8], v[9], v[10], v[11]); o.w = pk_fp8x4c(v[12], v[13], v[14], v[15]);
    const int nn = d.n0 + n;
    const int row = d.which >= 0 ? 64 * (nn >> 5) + d.which * 32 + (nn & 31) : nn;
    *(u32x4*)(d.dst + (size_t)row * d.K + d.k0 + kc * 16) = o;
  }
  __syncthreads();
}
__device__ __forceinline__ void convert_run(KP p, int stage, int jj, int j1, float* sm, int tid) {
  CvDesc d, dn;
  cvf4 a0, a1, a2, a3, b0, b1, b2, b3;
  bool cur = false;
#pragma unroll 1
  for (; jj < j1; ++jj) {
    const int job = conv_stage_job(stage, jj);
    if (!cur) {
      if (!conv_desc_fp8(p, job, d)) { convert_job(p, job, sm, tid); continue; }
      cv_load(d, tid, a0, a1, a2, a3);
    }
    bool nxt = false;
    if (jj + 1 < j1) {
      nxt = conv_desc_fp8(p, conv_stage_job(stage, jj + 1), dn);
      if (nxt) cv_load(dn, tid, b0, b1, b2, b3);
    }
    cv_emit(d, tid, a0, a1, a2, a3, sm);
    if (nxt) { d = dn; a0 = b0; a1 = b1; a2 = b2; a3 = b3; }
    cur = nxt;
  }
}

__device__ void ph_init(KP p, char* smc) {
  float* sm = (float*)smc;
  const int tid = opaque_tid();
  {
    const size_t n4a = (size_t)NL * DM / 4, n4b = (size_t)NC * DM / 4;
    const float4* xs = (const float4*)p->x;
    const float4* cs = (const float4*)p->ctx;
    float4* X4 = (float4*)p->X;
    for (size_t i = (size_t)blockIdx.x * NTHR + tid; i < n4a + n4b; i += (size_t)gridDim.x * NTHR)
      X4[i] = i < n4a ? xs[i] : cs[i - n4a];
  }
  for (int tile = blockIdx.x; tile < 96 * 8; tile += gridDim.x) {
    const int ct = tile >> 3, ks = tile & 7;
    for (int i = tid; i < 9 * 128; i += NTHR) {
      const int r = i >> 7, k = ks * 128 + (i & 127);
      const float v = r < 8 ? p->c[r * 1024 + k] : p->c_ctx[k];
      sm[i] = silu_f(v);
    }
    __syncthreads();
    const int col = ct * 256 + tid;
    const int layer = col / 6144, n = col % 6144;
    const float* W = p->ada_w + ((size_t)layer * 1024 + ks * 128) * 6144 + n;
    float acc[9];
#pragma unroll
    for (int r = 0; r < 9; ++r) acc[r] = 0.f;
#pragma unroll 4
    for (int k = 0; k < 128; ++k) {
      const float w = W[(size_t)k * 6144];
#pragma unroll
      for (int r = 0; r < 9; ++r) acc[r] = fmaf(sm[r * 128 + k], w, acc[r]);
    }
#pragma unroll
    for (int r = 0; r < 9; ++r) p->MODP[((size_t)(ks * 4 + layer) * 9 + r) * 6144 + n] = acc[r];
    __syncthreads();
  }
  {
    const int total = conv_stage_total(0), chunk = (total + gridDim.x - 1) / gridDim.x;
    const int lo = min((int)blockIdx.x * chunk, total), hi = min(lo + chunk, total);
    __syncthreads();
    convert_run(p, 0, lo, hi, sm, tid);
  }
  for (int i = blockIdx.x * NTHR + tid; i < 2 * 3 * 128 * 512; i += gridDim.x * NTHR) {
    const int k = i & 511, n = (i >> 9) & 127, wj = i >> 16;
    const int j = wj / 3, which = wj % 3;
    float v = 0.f;
    if (which < 2) {
      if (n < 64) v = (which ? p->rwkv_a1 : p->rwkv_w1)[((size_t)(j * 2 + (n >> 5)) * 512 + k) * 32 + (n & 31)];
    } else if (n < 96) v = p->rwkv_g1[((size_t)j * 512 + k) * 96 + n];
    p->Wl1[i] = f2bf(v);
  }
  for (int i = blockIdx.x * NTHR + tid; i < 2 * 2560 * 128; i += gridDim.x * NTHR) {
    const int k = i & 127, n = (i >> 7) % 2560, j = i / (2560 * 128);
    float v = 0.f;
    if (n < 2048) {
      const int d = (n >> 9) & 1, c = n & 511;
      if (k < 64 && (k >> 5) == d) v = (n < 1024 ? p->rwkv_w2 : p->rwkv_a2)[((size_t)(j * 2 + d) * 32 + (k & 31)) * 512 + c];
    } else if (k < 96) v = p->rwkv_g2[((size_t)j * 96 + k) * 512 + (n - 2048)];
    p->Wl2[i] = f2bf(v);
  }
  for (int i = blockIdx.x * NTHR + tid; i < 4 * 64 * 1024; i += gridDim.x * NTHR) {
    const int k = i & 1023, n = (i >> 10) & 63, l = i >> 16;
    p->WrT[i] = p->moe_router[((size_t)l * 1024 + k) * 64 + n];
  }
  for (int i = blockIdx.x * NTHR + tid; i < 64 * 16; i += gridDim.x * NTHR) {
    const int pos = i >> 4, f = i & 15;
    const float ang = (float)pos * powf(10000.f, -(float)f / 16.f);
    p->ROPE[2 * i] = cosf(ang);
    p->ROPE[2 * i + 1] = sinf(ang);
  }
}

__device__ void ph_mod_h(KP p, char* smc) {
  float* sm = (float*)smc;
  const int tid = opaque_tid();
  for (int i = blockIdx.x * NTHR + tid; i < 4 * 9 * 6144; i += gridDim.x * NTHR) {
    const int layer = i / (9 * 6144), rem = i % (9 * 6144), n = rem % 6144;
    float s = p->ada_b[layer * 6144 + n];
#pragma unroll
    for (int ks = 0; ks < 8; ++ks) s += p->MODP[(size_t)(ks * 4 + layer) * 9 * 6144 + rem];
    p->MOD[i] = s;
  }
  const int lane = tid & 63, wave = tid >> 6;
  const int per = (((NT + gridDim.x - 1) / gridDim.x) + 3) & ~3;
  const int t0 = blockIdx.x * per, t1 = min(NT, t0 + per);
  int cur = -1;
  for (int tb = t0; tb < t1; tb += 4) {
    const int mr = modrow(tb);
    if (mr != cur) {
      __syncthreads();
      for (int n = tid; n < 2048; n += NTHR) {
        float a = p->ada_b[n];
#pragma unroll
        for (int ks = 0; ks < 8; ++ks) a += p->MODP[((size_t)(ks * 4) * 9 + mr) * 6144 + n];
        sm[n] = a;
      }
      cur = mr;
      __syncthreads();
    }
    const int t = tb + wave;
    if (t < t1) {
      const float* src = t < NL ? p->x + (size_t)t * DM : p->ctx + (size_t)(t - NL) * DM;
#pragma unroll
      for (int i = 0; i < 4; ++i) {
        const int n = i * 256 + lane * 4;
        const float4 xv = *(const float4*)(src + n);
        const float4 sh = *(const float4*)(sm + n);
        const float4 sc = *(const float4*)(sm + 1024 + n);
        *(unsigned*)((unsigned char*)p->AB + (size_t)t * DM + n) =
            pk_fp8x4c(xv.x * (1.f + sc.x) + sh.x, xv.y * (1.f + sc.y) + sh.y, xv.z * (1.f + sc.z) + sh.z, xv.w * (1.f + sc.w) + sh.w);
      }
    }
  }
}

typedef short v4i16_t __attribute__((ext_vector_type(4)));
using s16x4 = __attribute__((ext_vector_type(4))) short;
__device__ __forceinline__ s16x4 vtr(const char* p) {
  return __builtin_bit_cast(s16x4, __builtin_amdgcn_ds_read_tr16_b64_v4i16((__attribute__((address_space(3))) v4i16_t*)p));
}
#define MFMA32(a, b, c) __builtin_amdgcn_mfma_f32_32x32x16_bf16(a, b, c, 0, 0, 0)
__device__ void ph_attention(KP p, int layer, bool keep, char* lds) {
  const int tid = opaque_tid();
  const int lane = tid & 63, w = tid >> 6, r32 = lane & 31, hi = lane >> 5;
  const int j = layer >> 1;
  float* bias_lds = (float*)(lds + 32768 + 1024);
  const int n_gqa = 1024, n_na = 1024, n_cb = keep ? 128 : 0, n_ca = keep ? 128 : 0;
  const int total = n_gqa + n_na + n_cb + n_ca;
  constexpr float LOG2E = 1.4426950408889634f;
  constexpr float C2 = 0.125f * LOG2E;
  const int c = tid & 7, sr = tid >> 3;
  const int kso = (c ^ ((tid >> 4) & 7)) * 16;
  const int vso = (c >> 2) * 4096 + (c & 3) * 16;
  const int sw = (r32 >> 1) & 7;
  for (int vitem = blockIdx.x; vitem < total; vitem += gridDim.x) {
    int item = vitem;
    if (gridDim.x == 512) {
      const int cls0 = vitem < n_gqa ? 0 : (vitem < n_gqa + n_na ? n_gqa : (vitem < n_gqa + n_na + n_cb ? n_gqa + n_na : n_gqa + n_na + n_cb));
      const int vl = vitem - cls0, b9 = vl & 511, r9 = vl >> 9;
      item = cls0 + (cls0 < n_gqa + n_na ? 128 * (b9 & 7) + 64 * r9 + (b9 >> 3) : 16 * (b9 & 7) + (b9 >> 3));
    }
    int b, qrow0, qoff, koff, voff, ocol, lat_tiles, lat_row0;
    bool na = false;
    int r_w = 0, start_w = 0, ru0 = 0, hN = 0;
    if (item < n_gqa) {
      b = item >> 7;
      const int g = (item >> 6) & 1, tt = item & 63;
      qrow0 = b * SEQ + tt * 32; qoff = 1536 + (g * 4 + w) * 64; koff = 2048 + g * 64; voff = 2176 + g * 64;
      ocol = 512 + (g * 4 + w) * 64; lat_tiles = 32; lat_row0 = b * SEQ;
    } else if (item < n_gqa + n_na) {
      const int it = item - n_gqa;
      b = it >> 7; hN = (it >> 4) & 7;
      const int rp = it & 15;
      na = true; r_w = 2 * rp + (w >> 1);
      qrow0 = b * SEQ + r_w * 64 + (w & 1) * 32; qoff = hN * 64; koff = 512 + hN * 64; voff = 1024 + hN * 64; ocol = hN * 64;
      const int s0 = min(max(2 * rp - 4, 0), 24), s1 = min(max(2 * rp - 3, 0), 24);
      start_w = (w >> 1) ? s1 : s0; ru0 = s0; lat_tiles = (s1 != s0) ? 9 : 8; lat_row0 = b * SEQ + ru0 * 64;
    } else if (item < n_gqa + n_na + n_cb) {
      const int it = item - n_gqa - n_na;
      b = it >> 4;
      const int g = (it >> 3) & 1, tt = it & 7;
      qrow0 = NL + b * CTXL + tt * 32; qoff = 1536 + (g * 4 + w) * 64; koff = 2048 + g * 64; voff = 2176 + g * 64;
      ocol = 512 + (g * 4 + w) * 64; lat_tiles = 0; lat_row0 = 0;
    } else {
      const int it = item - n_gqa - n_na - n_cb;
      b = it >> 4;
      const int h = (it >> 1) & 7, half = it & 1;
      qrow0 = NL + b * CTXL + half * 128 + w * 32; qoff = h * 64; koff = 512 + h * 64; voff = 1024 + h * 64; ocol = h * 64;
      lat_tiles = 0; lat_row0 = 0;
    }
    const int ctx_row0 = NL + b * CTXL, ntiles = lat_tiles + 4;
    if (na)
      for (int i = tid; i < 465; i += NTHR) bias_lds[i] = p->na_rpb[(j * 8 + hN) * 465 + i] * LOG2E;
    bf16x8 qf[4];
    {
      const bf16_t* qp = p->P + (size_t)(qrow0 + r32) * LDP + qoff + hi * 8;
#pragma unroll
      for (int d0 = 0; d0 < 4; ++d0) qf[d0] = *(const bf16x8*)(qp + d0 * 16);
    }
    f32x16 o0, o1;
#pragma unroll
    for (int q = 0; q < 16; ++q) { o0[q] = 0.f; o1[q] = 0.f; }
    float m = -INFINITY, l = 0.f;
    u32x4 kr0, kr1, vr0, vr1;
    auto gload = [&](int t) {
      const int row0 = t < lat_tiles ? lat_row0 + 64 * t : ctx_row0 + 64 * (t - lat_tiles);
      const bf16_t* base = p->P + (size_t)(row0 + sr) * LDP + c * 8;
      kr0 = *(const u32x4*)(base + koff); kr1 = *(const u32x4*)(base + (size_t)32 * LDP + koff);
      vr0 = *(const u32x4*)(base + voff); vr1 = *(const u32x4*)(base + (size_t)32 * LDP + voff);
    };
    auto swrite = [&](int buf) {
      char* Kb = lds + buf * 16384;
      char* Vb = Kb + 8192;
      *(u32x4*)(Kb + sr * 128 + kso) = kr0; *(u32x4*)(Kb + (sr + 32) * 128 + kso) = kr1;
      *(u32x4*)(Vb + vso + sr * 64) = vr0; *(u32x4*)(Vb + vso + (sr + 32) * 64) = vr1;
    };
    gload(0);
    swrite(0);
    for (int t = 0; t < ntiles; ++t) {
      __syncthreads();
      if (t + 1 < ntiles) gload(t + 1);
      const bool na_tile = na && t < lat_tiles;
      const int kr = ru0 + t;
      const bool part = !na_tile || (kr >= start_w && kr < start_w + 8);
      if (part) {
        const char* Ks = lds + (t & 1) * 16384;
        const char* Vs = Ks + 8192;
        f32x16 s0, s1;
#pragma unroll
        for (int q = 0; q < 16; ++q) { s0[q] = 0.f; s1[q] = 0.f; }
#pragma unroll
        for (int d0 = 0; d0 < 4; ++d0) {
          const int off = ((2 * d0 + hi) ^ sw) * 16;
          const bf16x8 k0 = *(const bf16x8*)(Ks + r32 * 128 + off);
          const bf16x8 k1 = *(const bf16x8*)(Ks + (32 + r32) * 128 + off);
          s0 = MFMA32(k0, qf[d0], s0);
          s1 = MFMA32(k1, qf[d0], s1);
        }
        float mx = -INFINITY;
        if (na_tile) {
          const int cq = (w & 1) * 32 + r32;
          const int c0 = min(max(cq - 8, 0), 48);
          const float* brow = bias_lds + (kr - r_w + 7) * 31 + (15 - cq);
#pragma unroll
          for (int q = 0; q < 16; ++q) {
            const int kc = (q & 3) + 8 * (q >> 2) + 4 * hi;
            const float v0 = ((unsigned)(kc - c0) < 16u) ? fmaf(s0[q], C2, brow[kc]) : -INFINITY;
            const float v1 = ((unsigned)(kc + 32 - c0) < 16u) ? fmaf(s1[q], C2, brow[kc + 32]) : -INFINITY;
            s0[q] = v0; s1[q] = v1;
            mx = fmaxf(mx, fmaxf(v0, v1));
          }
        } else {
#pragma unroll
          for (int q = 0; q < 16; ++q) {
            s0[q] *= C2; s1[q] *= C2;
            mx = fmaxf(mx, fmaxf(s0[q], s1[q]));
          }
        }
        {
          auto rr = __builtin_amdgcn_permlane32_swap(__float_as_uint(mx), __float_as_uint(mx), false, false);
          mx = fmaxf(__uint_as_float(rr[0]), __uint_as_float(rr[1]));
        }
        const float mnew = fmaxf(m, mx);
        const float alpha = __builtin_amdgcn_exp2f(m - mnew);
        float ls = 0.f;
#pragma unroll
        for (int q = 0; q < 16; ++q) {
          s0[q] = __builtin_amdgcn_exp2f(s0[q] - mnew);
          s1[q] = __builtin_amdgcn_exp2f(s1[q] - mnew);
          ls += s0[q] + s1[q];
        }
        l = l * alpha + ls;
        m = mnew;
#pragma unroll
        for (int q = 0; q < 16; ++q) { o0[q] *= alpha; o1[q] *= alpha; }
        bf16x8 pf[4];
#pragma unroll
        for (int s = 0; s < 4; ++s) {
          const int u = (s & 1) * 8;
          u32x4 tpk;
          if (s < 2) {
            tpk.x = pk_bf16(s0[u + 0], s0[u + 1]); tpk.y = pk_bf16(s0[u + 2], s0[u + 3]);
            tpk.z = pk_bf16(s0[u + 4], s0[u + 5]); tpk.w = pk_bf16(s0[u + 6], s0[u + 7]);
          } else {
            tpk.x = pk_bf16(s1[u + 0], s1[u + 1]); tpk.y = pk_bf16(s1[u + 2], s1[u + 3]);
            tpk.z = pk_bf16(s1[u + 4], s1[u + 5]); tpk.w = pk_bf16(s1[u + 6], s1[u + 7]);
          }
          pf[s] = __builtin_bit_cast(bf16x8, tpk);
        }
        const char* vb = Vs + ((lane >> 4) & 1) * 32 + (lane & 3) * 8 + ((lane & 15) >> 2) * 64 + hi * 256;
#pragma unroll
        for (int s = 0; s < 4; ++s) {
          const s16x4 a00 = vtr(vb + (16 * s) * 64), a01 = vtr(vb + (16 * s + 8) * 64);
          const s16x4 a10 = vtr(vb + 4096 + (16 * s) * 64), a11 = vtr(vb + 4096 + (16 * s + 8) * 64);
          const bf16x8 A0 = __builtin_shufflevector(a00, a01, 0, 1, 2, 3, 4, 5, 6, 7);
          const bf16x8 A1 = __builtin_shufflevector(a10, a11, 0, 1, 2, 3, 4, 5, 6, 7);
          o0 = MFMA32(A0, pf[s], o0);
          o1 = MFMA32(A1, pf[s], o1);
        }
      }
      if (t + 1 < ntiles) swrite((t + 1) & 1);
    }
    __syncthreads();
    const float lt = l + __shfl_xor(l, 32);
    const float inv = 1.f / lt;
    unsigned char* op = (unsigned char*)p->AB + (size_t)(qrow0 + r32) * DM + ocol + 4 * hi;
#pragma unroll
    for (int g = 0; g < 4; ++g) {
      *(unsigned*)(op + 8 * g) = pk_fp8x4c(o0[4 * g] * inv, o0[4 * g + 1] * inv, o0[4 * g + 2] * inv, o0[4 * g + 3] * inv);
      *(unsigned*)(op + 32 + 8 * g) = pk_fp8x4c(o1[4 * g] * inv, o1[4 * g + 1] * inv, o1[4 * g + 2] * inv, o1[4 * g + 3] * inv);
    }
  }
}

__device__ void ph_rwkv_mix(KP p, int layer) {
  const int j = layer >> 1;
  const int tid = opaque_tid();
  const int lane = tid & 63, wave = tid >> 6;
  const float* mu = p->rwkv_mu + j * 6 * 512;
  const int c0 = lane * 8;
  auto unpack = [](const u32x4 u, float (&f)[8]) {
    f[0] = bflo(u.x); f[1] = bfhi(u.x); f[2] = bflo(u.y); f[3] = bfhi(u.y);
    f[4] = bflo(u.z); f[5] = bfhi(u.z); f[6] = bflo(u.w); f[7] = bfhi(u.w);
  };
  auto pack = [](const float (&f)[8]) {
    u32x4 o;
    o.x = pk_bf16(f[0], f[1]); o.y = pk_bf16(f[2], f[3]); o.z = pk_bf16(f[4], f[5]); o.w = pk_bf16(f[6], f[7]);
    return o;
  };
  for (int t = blockIdx.x * 4 + wave; t < NT; t += gridDim.x * 4) {
    bool hasp, hasn;
    if (t < NL) { int s = t & 2047; hasp = s > 0; hasn = s < SEQ - 1; }
    else { int s = (t - NL) & 255; hasp = s > 0; hasn = s < CTXL - 1; }
    const bf16_t* pt = p->P + (size_t)t * LDP + c0;
    bf16_t* rw = p->RW + (size_t)t * RWS + c0;
    bf16_t* zb = p->Zb + (size_t)t * 1536 + c0;
    const u32x4 zero = {0u, 0u, 0u, 0u};
#pragma unroll
    for (int q = 0; q < 4; ++q) {
      float cur[8], pv[8], nx[8], d[8];
      unpack(*(const u32x4*)(pt + q * 512), cur);
      unpack(hasp ? *(const u32x4*)(pt + q * 512 - LDP) : zero, pv);
      unpack(hasn ? *(const u32x4*)(pt + q * 512 + LDP) : zero, nx);
#pragma unroll
      for (int e = 0; e < 8; ++e) d[e] = 0.5f * (pv[e] + nx[e]) - cur[e];
      if (q < 3) {
        float o[8];
        const float* m = mu + q * 512 + c0;
#pragma unroll
        for (int e = 0; e < 8; ++e) o[e] = cur[e] + d[e] * m[e];
        if (q == 0) *(u32x4*)(rw) = pack(o);
        else if (q == 2) *(u32x4*)(rw + 512) = pack(o);
        else {
          *(u32x4*)(rw + 10 * 512) = pack(o);
          float kk[8], ss = 0.f;
          const float* kv0 = p->rwkv_kvec + (j * 2 + 0) * 512 + c0;
#pragma unroll
          for (int e = 0; e < 8; ++e) { kk[e] = o[e] * kv0[e]; ss += kk[e] * kk[e]; }
          ss += dppx<0xB1>(ss); ss += dppx<0x4E>(ss); ss += dppx<0x141>(ss);
          const float rn = rsqrtf(fmaxf(ss, 1e-24f));
#pragma unroll
          for (int e = 0; e < 8; ++e) kk[e] *= rn;
          *(u32x4*)(rw + 2 * 512) = pack(kk);
        }
      } else {
#pragma unroll
        for (int z = 0; z < 3; ++z) {
          float o[8];
          const float* m = mu + (3 + z) * 512 + c0;
#pragma unroll
          for (int e = 0; e < 8; ++e) o[e] = cur[e] + d[e] * m[e];
          *(u32x4*)(zb + z * 512) = pack(o);
        }
      }
    }
  }
}

constexpr int RS_STEP = 384;
constexpr int RS_TB = 16;
struct RwkvStage { u32x2 r, kk, e, ke, a, v; };
__device__ void rwkv_unit(KP p, int unit, float* sm, int tid) {
  const int ch = unit >> 1, hf = unit & 1;
  const int dir = ch >> 6, b = (ch >> 3) & 7, h = ch & 7;
  const int lane = tid & 63, w = tid >> 6, rl = lane >> 3, ks = lane & 7;
  float* ybuf = sm + 2 * RS_TB * RS_STEP;
  const int ss = tid >> 4, kq = tid & 15;
  auto gload = [&](int n, RwkvStage& g) {
    const int row = scan_row(dir, b, n * RS_TB + ss);
    const bf16_t* base = p->RW + (size_t)row * RWS + h * 64 + kq * 4;
    g.r = *(const u32x2*)(base);
    g.kk = *(const u32x2*)(base + 2 * 512);
    g.e = *(const u32x2*)(base + (3 + dir) * 512);
    g.ke = *(const u32x2*)(base + (5 + dir) * 512);
    g.a = *(const u32x2*)(base + (7 + dir) * 512);
    g.v = *(const u32x2*)(p->RW + (size_t)row * RWS + 512 + h * 64 + hf * 32 + (kq & 7) * 4);
  };
  auto swrite = [&](int buf, const RwkvStage& g) {
    float* sp = sm + (buf * RS_TB + ss) * RS_STEP;
    const float r0 = bflo(g.r.x), r1 = bfhi(g.r.x), r2 = bflo(g.r.y), r3 = bfhi(g.r.y);
    const float k0 = bflo(g.kk.x), k1 = bfhi(g.kk.x), k2 = bflo(g.kk.y), k3 = bfhi(g.kk.y);
    const float w0 = __expf(-bflo(g.e.x)), w1 = __expf(-bfhi(g.e.x)), w2 = __expf(-bflo(g.e.y)), w3 = __expf(-bfhi(g.e.y));
    const float e0 = bflo(g.ke.x), e1 = bfhi(g.ke.x), e2 = bflo(g.ke.y), e3 = bfhi(g.ke.y);
    const float a0 = k0 * bflo(g.a.x), a1 = k1 * bfhi(g.a.x), a2 = k2 * bflo(g.a.y), a3 = k3 * bfhi(g.a.y);
    *(float4*)(sp + kq * 4) = make_float4(k0, k1, k2, k3);
    *(float4*)(sp + 64 + kq * 4) = make_float4(w0 * r0, w1 * r1, w2 * r2, w3 * r3);
    *(float4*)(sp + 128 + kq * 4) = make_float4(w0, w1, w2, w3);
    *(float4*)(sp + 192 + kq * 4) = make_float4(a0, a1, a2, a3);
    *(float4*)(sp + 256 + kq * 4) = make_float4(e0, e1, e2, e3);
    if (kq < 8) *(float4*)(sp + 320 + kq * 4) = make_float4(bflo(g.v.x), bfhi(g.v.x), bflo(g.v.y), bfhi(g.v.y));
    float c1 = a0 * r0 + a1 * r1 + a2 * r2 + a3 * r3;
    float c2 = e0 * r0 + e1 * r1 + e2 * r2 + e3 * r3;
    c1 += dppx<0xB1>(c1); c2 += dppx<0xB1>(c2);
    c1 += dppx<0x4E>(c1); c2 += dppx<0x4E>(c2);
    c1 += dppx<0x141>(c1); c2 += dppx<0x141>(c2);
    c1 += dppx<0x140>(c1); c2 += dppx<0x140>(c2);
    if (kq == 0) { sp[352] = c1; sp[353] = c2; }
  };
  typedef float f2 __attribute__((ext_vector_type(2)));
  f2 S01 = {0.f, 0.f}, S23 = {0.f, 0.f}, S45 = {0.f, 0.f}, S67 = {0.f, 0.f};
  auto compute = [&](int n) {
    const float* bp = sm + (n & 1) * RS_TB * RS_STEP;
    float* yb = ybuf + (n & 1) * RS_TB * 32 + w * 8 + rl;
    struct Ops { f2 k[4], r[4], w[4], a[4], e[4]; float vv; f2 c; };
    auto ld = [&](int s, Ops& o) {
      const float* sq = bp + s * RS_STEP;
      const f2* sp = (const f2*)(sq + ks * 8);
#pragma unroll
      for (int i = 0; i < 4; ++i) { o.k[i] = sp[i]; o.r[i] = sp[32 + i]; o.w[i] = sp[64 + i]; o.a[i] = sp[96 + i]; o.e[i] = sp[128 + i]; }
      o.vv = sq[320 + w * 8 + rl]; o.c = *(const f2*)(sq + 352);
    };
    auto step = [&](const Ops& o) -> float {
      f2 sa2 = S01 * o.k[0];
      f2 y2 = S01 * o.r[0];
      sa2 = __builtin_elementwise_fma(S23, o.k[1], sa2); y2 = __builtin_elementwise_fma(S23, o.r[1], y2);
      sa2 = __builtin_elementwise_fma(S45, o.k[2], sa2); y2 = __builtin_elementwise_fma(S45, o.r[2], y2);
      sa2 = __builtin_elementwise_fma(S67, o.k[3], sa2); y2 = __builtin_elementwise_fma(S67, o.r[3], y2);
      float sa = sa2.x + sa2.y, y0 = y2.x + y2.y;
      sa += dppx<0xB1>(sa); y0 += dppx<0xB1>(y0);
      sa += dppx<0x4E>(sa); y0 += dppx<0x4E>(y0);
      sa += dppx<0x141>(sa); y0 += dppx<0x141>(y0);
      sa = -sa;
      const f2 sav = {sa, sa}, vvv = {o.vv, o.vv};
      S01 = __builtin_elementwise_fma(vvv, o.e[0], __builtin_elementwise_fma(sav, o.a[0], S01 * o.w[0]));
      S23 = __builtin_elementwise_fma(vvv, o.e[1], __builtin_elementwise_fma(sav, o.a[1], S23 * o.w[1]));
      S45 = __builtin_elementwise_fma(vvv, o.e[2], __builtin_elementwise_fma(sav, o.a[2], S45 * o.w[2]));
      S67 = __builtin_elementwise_fma(vvv, o.e[3], __builtin_elementwise_fma(sav, o.a[3], S67 * o.w[3]));
      return fmaf(o.vv, o.c.y, fmaf(sa, o.c.x, y0));
    };
    Ops oa, ob;
    ld(0, oa);
#pragma unroll 1
    for (int s = 0; s < RS_TB; s += 2) {
      __builtin_amdgcn_sched_barrier(0);
      ld(s + 1, ob);
      __builtin_amdgcn_sched_barrier(0);
      float y0 = step(oa);
      asm volatile("" : "+v"(y0));
      __builtin_amdgcn_sched_barrier(0);
      ld(s + 2, oa);
      __builtin_amdgcn_sched_barrier(0);
      float y1 = step(ob);
      asm volatile("" : "+v"(y1));
      __builtin_amdgcn_sched_barrier(0);
      if (ks == 0) { yb[s * 32] = y0; yb[(s + 1) * 32] = y1; }
    }
  };
  auto yout = [&](int n) {
    const int row = scan_row(dir, b, n * RS_TB + ss);
    const float* ys = ybuf + (n & 1) * RS_TB * 32 + ss * 32 + kq * 2;
    *(unsigned*)(p->P + (size_t)row * LDP + dir * 512 + h * 64 + hf * 32 + kq * 2) = pk_bf16(ys[0], ys[1]);
  };
  constexpr int NB = TSC / RS_TB;
  RwkvStage gA, gB;
  gload(0, gA);
  gload(1, gB);
  swrite(0, gA);
  gload(2, gA);
  __syncthreads();
  for (int n = 0; n < NB; n += 2) {
    compute(n);
    swrite(1, gB);
    if (n + 3 < NB) gload(n + 3, gB);
    __syncthreads();
    yout(n);
    compute(n + 1);
    if (n + 2 < NB) swrite(0, gA);
    if (n + 4 < NB) gload(n + 4, gA);
    __syncthreads();
    yout(n + 1);
  }
  __syncthreads();
}

__device__ void mlstm_s1(KP p, int layer, int tile, char* lds, int tid) {
  const int j = layer >> 1;
  const int ch = tile / NCHUNK, c = tile % NCHUNK;
  const int dir = ch >> 5, b = (ch >> 2) & 7, h = ch & 3;
  float* s_ws = (float*)(lds + META_OFF);
  int* s_row = (int*)(s_ws + 64);
  char* kimg = lds;
  char* vimg = lds + 16384;
  if (tid < 64) {
    const int row = scan_row(dir, b, c * 64 + tid);
    s_row[tid] = row;
    const float* g = p->GP + (size_t)row * 16;
    const float gi = g[(dir * 2) * 4 + h] + p->mlstm_gate_b[j * 16 + (dir * 2) * 4 + h];
    const float gf = g[(dir * 2 + 1) * 4 + h] + p->mlstm_gate_b[j * 16 + (dir * 2 + 1) * 4 + h];
    float bc = -softplus_f(-gf);
#pragma unroll
    for (int o = 1; o < 64; o <<= 1) {
      float tmp = __shfl_up(bc, o);
      if (tid >= o) bc += tmp;
    }
    const float bend = __shfl(bc, 63);
    const float ds = bend - bc + gi;
    const float mloc = wmax(ds);
    s_ws[tid] = expf(ds - mloc);
    if (tid == 0) { p->msc[tile] = mloc; p->msc[NMT + tile] = bend; }
  }
  __syncthreads();
  {
    const int c8 = tid & 15;
    const int ioff = (c8 >> 2) * 4096 + (c8 & 3) * 16;
#pragma unroll
    for (int i = 0; i < 4; ++i) {
      const int sidx = (tid >> 4) + 16 * i;
      const bf16_t* src = p->P + (size_t)s_row[sidx] * LDP + h * 128 + c8 * 8;
      const u32x4 kv = *(const u32x4*)(src + 2560);
      u32x4 vv = *(const u32x4*)(src + 3072);
      const float wsv = s_ws[sidx];
      vv.x = pk_bf16(bflo(vv.x) * wsv, bfhi(vv.x) * wsv); vv.y = pk_bf16(bflo(vv.y) * wsv, bfhi(vv.y) * wsv);
      vv.z = pk_bf16(bflo(vv.z) * wsv, bfhi(vv.z) * wsv); vv.w = pk_bf16(bflo(vv.w) * wsv, bfhi(vv.w) * wsv);
      *(u32x4*)(kimg + ioff + sidx * 64) = kv;
      *(u32x4*)(vimg + ioff + sidx * 64) = vv;
    }
  }
  __syncthreads();
  const int lane = tid & 63, w = tid >> 6, wm = w >> 1, wn = w & 1, r32 = lane & 31, hi = lane >> 5;
  f32x16 acc[2][2];
#pragma unroll
  for (int mi = 0; mi < 2; ++mi)
#pragma unroll
    for (int ni = 0; ni < 2; ++ni)
#pragma unroll
      for (int q = 0; q < 16; ++q) acc[mi][ni][q] = 0.f;
  const int toff = ((lane >> 4) & 1) * 32 + (lane & 3) * 8 + ((lane & 15) >> 2) * 64 + hi * 256;
#pragma unroll
  for (int ks = 0; ks < 4; ++ks) {
    bf16x8 af[2], bfr[2];
#pragma unroll
    for (int i = 0; i < 2; ++i) {
      const char* ka = kimg + (wm * 2 + i) * 4096 + toff + (16 * ks) * 64;
      const char* va = vimg + (wn * 2 + i) * 4096 + toff + (16 * ks) * 64;
      af[i] = __builtin_shufflevector(vtr(ka), vtr(ka + 8 * 64), 0, 1, 2, 3, 4, 5, 6, 7);
      bfr[i] = __builtin_shufflevector(vtr(va), vtr(va + 8 * 64), 0, 1, 2, 3, 4, 5, 6, 7);
    }
    acc[0][0] = MFMA32(af[0], bfr[0], acc[0][0]);
    acc[0][1] = MFMA32(af[0], bfr[1], acc[0][1]);
    acc[1][0] = MFMA32(af[1], bfr[0], acc[1][0]);
    acc[1][1] = MFMA32(af[1], bfr[1], acc[1][1]);
  }
  bf16_t* ust = (bf16_t*)(lds + 32768);
#pragma unroll
  for (int mi = 0; mi < 2; ++mi)
#pragma unroll
    for (int ni = 0; ni < 2; ++ni)
#pragma unroll
      for (int q = 0; q < 16; ++q) {
        const int d = wm * 64 + mi * 32 + (q & 3) + 8 * (q >> 2) + 4 * hi;
        ust[d * 128 + wn * 64 + ni * 32 + r32] = f2bf(acc[mi][ni][q]);
        if ((q & 3) == 3) __builtin_amdgcn_sched_barrier(0);
      }
  __syncthreads();
  {
    const u32x4* us4 = (const u32x4*)ust;
    u32x4* U4 = (u32x4*)(p->MS + (size_t)tile * 16384);
#pragma unroll
    for (int i = 0; i < 8; ++i) U4[tid + 256 * i] = us4[tid + 256 * i];
  }
  if (tid < 128) {
    const char* kc = kimg + (tid >> 5) * 4096 + (tid & 31) * 2;
    float a = 0.f;
#pragma unroll 8
    for (int sidx = 0; sidx < 64; ++sidx) a = fmaf(s_ws[sidx], bf2f(*(const bf16_t*)(kc + sidx * 64)), a);
    p->MSn[tile * 128 + tid] = a;
  }
}

__device__ void mlstm_s3(KP p, int layer, int tile, char* lds, int tid);
__device__ void ph_scan_a(KP p, int layer, char* smc) {
  float* sm = (float*)smc;
  const int tid = opaque_tid();
  __builtin_amdgcn_s_setprio(3);
  for (int u = blockIdx.x; u < 256; u += gridDim.x) rwkv_unit(p, u, sm, tid);
  __builtin_amdgcn_s_setprio(0);
  {
    const int stage = layer == 1 ? 1 : 2;
    const int nconv = conv_stage_total(stage);
    const int total = NMT + (nconv + 7) / 8;
    int* qc = (int*)(p->bar + XCD_BAR_WORDS + 16 * stage);
    int* s_q = (int*)(smc + META_OFF + 3968);
    int jj = 0, j1 = 0;
#pragma unroll 1
    for (;;) {
      if (jj >= j1) {
        __syncthreads();
        if (tid == 0) *s_q = atomicAdd(qc, 1);
        __syncthreads();
        const int q = *s_q;
        if (q >= total) break;
        if (q < NMT) { mlstm_s3(p, layer, q, smc, tid); continue; }
        jj = (q - NMT) * 8; j1 = min(jj + 8, nconv);
      }
      convert_run(p, stage, jj, j1, sm, tid);
      jj = j1;
    }
  }
}

__device__ void ph_mlstm_s2(KP p, char* smc) {
  float* sw = (float*)smc;
  const int tid = opaque_tid();
  const int nitems = 64 * 33;
  for (int item = blockIdx.x; item < nitems; item += gridDim.x) {
    const int ch = item / 33, seg = item % 33;
    __syncthreads();
    if (tid < 2 * NCHUNK) sw[72 + tid] = p->msc[(tid < NCHUNK ? 0 : NMT - NCHUNK) + ch * NCHUNK + tid];
    __syncthreads();
    if (tid == 0) {
      float m = 0.f;
      for (int c = 0; c < NCHUNK; ++c) {
        const int tile = ch * NCHUNK + c;
        const float mloc = sw[72 + c], bend = sw[72 + NCHUNK + c];
        const float mn = fmaxf(bend + m, mloc);
        sw[c] = expf(bend + m - mn);
        sw[36 + c] = expf(mloc - mn);
        if (seg == 0) p->msc[2 * NMT + tile] = m;
        m = mn;
      }
    }
    __syncthreads();
    if (seg < 32) {
      unsigned* base = (unsigned*)(p->MS + (size_t)ch * NCHUNK * 16384) + seg * 256 + tid;
      unsigned v[NCHUNK];
#pragma unroll
      for (int c = 0; c < NCHUNK; ++c) v[c] = base[(size_t)c * 8192];
      float C0 = 0.f, C1 = 0.f;
#pragma unroll
      for (int c = 0; c < NCHUNK; ++c) {
        const float t0 = bflo(v[c]), t1 = bfhi(v[c]);
        v[c] = pk_bf16(C0, C1);
        C0 = sw[c] * C0 + sw[36 + c] * t0;
        C1 = sw[c] * C1 + sw[36 + c] * t1;
      }
#pragma unroll
      for (int c = 0; c < NCHUNK; ++c) base[(size_t)c * 8192] = v[c];
    } else if (tid < 128) {
      float* base = p->MSn + (size_t)ch * NCHUNK * 128 + tid;
      float v[NCHUNK];
#pragma unroll
      for (int c = 0; c < NCHUNK; ++c) v[c] = base[c * 128];
      float C = 0.f;
#pragma unroll
      for (int c = 0; c < NCHUNK; ++c) {
        const float t0 = v[c];
        v[c] = C;
        C = sw[c] * C + sw[36 + c] * t0;
      }
#pragma unroll
      for (int c = 0; c < NCHUNK; ++c) base[c * 128] = v[c];
    }
  }
}

__device__ void mlstm_s3(KP p, int layer, int tile, char* lds, int tid) {
  const int j = layer >> 1;
  const int ch = tile / NCHUNK, c = tile % NCHUNK;
  const int dir = ch >> 5, b = (ch >> 2) & 7, h = ch & 3;
  float* s_b = (float*)(lds + META_OFF);
  float* s_ig = s_b + 64;
  float* s_mt = s_b + 128;
  float* s_wi = s_b + 192;
  int* s_row = (int*)(s_b + 256);
  float* s_n = s_b + 320;
  float* s_c = s_b + 448;
  char* kimg = lds;
  char* vimg = lds + 16384;
  char* cimg = lds + 32768;
  const float mprev = p->msc[2 * NMT + tile];
  const float qscale = 0.08838834764831845f;
  const int lane = tid & 63, w = tid >> 6, wt = w >> 1, wv = w & 1, r32 = lane & 31, hi = lane >> 5;
  const int t = wt * 32 + r32;
  const int rowq = scan_row(dir, b, c * 64 + t);
  const int c8 = tid & 15;
  u32x4 kr[4], vr[4], cr[8];
#pragma unroll
  for (int i = 0; i < 4; ++i) {
    const int sidx = (tid >> 4) + 16 * i;
    const bf16_t* src = p->P + (size_t)scan_row(dir, b, c * 64 + sidx) * LDP + h * 128 + c8 * 8;
    kr[i] = *(const u32x4*)(src + 2560);
    vr[i] = *(const u32x4*)(src + 3072);
  }
  {
    const bf16_t* Cp = p->MS + (size_t)tile * 16384;
#pragma unroll
    for (int i = 0; i < 8; ++i) cr[i] = *(const u32x4*)(Cp + ((tid >> 4) + 16 * i) * 128 + c8 * 8);
  }
  bf16x8 qf[8];
  {
    const bf16_t* qp = p->P + (size_t)rowq * LDP + 2048 + h * 128 + hi * 8;
#pragma unroll
    for (int d0 = 0; d0 < 8; ++d0) qf[d0] = *(const bf16x8*)(qp + d0 * 16);
  }
  if (tid < 64) {
    const int row = scan_row(dir, b, c * 64 + tid);
    s_row[tid] = row;
    const float* g = p->GP + (size_t)row * 16;
    const float gi = g[(dir * 2) * 4 + h] + p->mlstm_gate_b[j * 16 + (dir * 2) * 4 + h];
    const float gf = g[(dir * 2 + 1) * 4 + h] + p->mlstm_gate_b[j * 16 + (dir * 2 + 1) * 4 + h];
    float bc = -softplus_f(-gf);
#pragma unroll
    for (int o = 1; o < 64; o <<= 1) {
      float tmp = __shfl_up(bc, o);
      if (tid >= o) bc += tmp;
    }
    float pm = gi - bc;
#pragma unroll
    for (int o = 1; o < 64; o <<= 1) {
      float tmp = __shfl_up(pm, o);
      if (tid >= o) pm = fmaxf(pm, tmp);
    }
    const float mt = bc + fmaxf(mprev, pm);
    s_b[tid] = bc;
    s_ig[tid] = gi;
    s_mt[tid] = mt;
    s_wi[tid] = expf(bc + mprev - mt);
    s_c[tid] = (gi - bc) * 1.4426950408889634f;
  } else if (tid < 192) s_n[tid - 64] = p->MSn[tile * 128 + (tid - 64)];
  {
    const int ioff = (c8 >> 2) * 4096 + (c8 & 3) * 16;
#pragma unroll
    for (int i = 0; i < 4; ++i) {
      const int sidx = (tid >> 4) + 16 * i;
      *(u32x4*)(kimg + sidx * 256 + ((c8 ^ (sidx & 15)) * 16)) = kr[i];
      *(u32x4*)(vimg + ioff + sidx * 64) = vr[i];
    }
    const int coff = (c8 >> 2) * 8192 + (c8 & 3) * 16;
#pragma unroll
    for (int i = 0; i < 8; ++i) *(u32x4*)(cimg + coff + ((tid >> 4) + 16 * i) * 64) = cr[i];
  }
  __syncthreads();
  const int toff = ((lane >> 4) & 1) * 32 + (lane & 3) * 8 + ((lane & 15) >> 2) * 64;
  constexpr float LOG2E_ = 1.4426950408889634f;
  float qn = 0.f;
#pragma unroll
  for (int d0 = 0; d0 < 8; ++d0) {
    const u32x4 qq = __builtin_bit_cast(u32x4, qf[d0]);
    const float* np = s_n + d0 * 16 + hi * 8;
    qn = fmaf(bflo(qq.x), np[0], qn); qn = fmaf(bfhi(qq.x), np[1], qn);
    qn = fmaf(bflo(qq.y), np[2], qn); qn = fmaf(bfhi(qq.y), np[3], qn);
    qn = fmaf(bflo(qq.z), np[4], qn); qn = fmaf(bfhi(qq.z), np[5], qn);
    qn = fmaf(bflo(qq.w), np[6], qn); qn = fmaf(bfhi(qq.w), np[7], qn);
  }
  qn += __shfl_xor(qn, 32);
  const float mtt = s_mt[t], wi = s_wi[t];
  const float ct = (s_b[t] - mtt) * LOG2E_;
  const float wq = wi * qscale;
  bf16x8 pf[4];
  float den = 0.f;
  {
    f32x16 sa0, sa1;
#pragma unroll
    for (int q = 0; q < 16; ++q) { sa0[q] = 0.f; sa1[q] = 0.f; }
#pragma unroll
    for (int d0 = 0; d0 < 8; ++d0) {
      const int chn = 2 * d0 + hi;
      const bf16x8 k0 = *(const bf16x8*)(kimg + r32 * 256 + ((chn ^ (r32 & 15)) * 16));
      sa0 = MFMA32(k0, qf[d0], sa0);
      if (wt) {
        const bf16x8 k1 = *(const bf16x8*)(kimg + (32 + r32) * 256 + ((chn ^ (r32 & 15)) * 16));
        sa1 = MFMA32(k1, qf[d0], sa1);
      }
      __builtin_amdgcn_sched_barrier(0);
    }
#pragma unroll
    for (int g = 0; g < 4; ++g) {
      const int sb0 = 8 * g + 4 * hi;
      const float4 c0v = *(const float4*)(s_c + sb0);
      const float4 c1v = *(const float4*)(s_c + sb0 + 32);
      const float cc0[4] = {c0v.x, c0v.y, c0v.z, c0v.w}, cc1[4] = {c1v.x, c1v.y, c1v.z, c1v.w};
#pragma unroll
      for (int e = 0; e < 4; ++e) {
        const int q = 4 * g + e;
        const float v0 = (sb0 + e <= t) ? sa0[q] * qscale * __builtin_amdgcn_exp2f(ct + cc0[e]) : 0.f;
        sa0[q] = v0; den += v0;
        const float v1 = (wt && sb0 + 32 + e <= t) ? sa1[q] * qscale * __builtin_amdgcn_exp2f(ct + cc1[e]) : 0.f;
        sa1[q] = v1; den += v1;
      }
      __builtin_amdgcn_sched_barrier(0);
    }
#pragma unroll
    for (int sx = 0; sx < 4; ++sx) {
      const int u = (sx & 1) * 8;
      u32x4 tpk;
      if (sx < 2) {
        tpk.x = pk_bf16(sa0[u + 0], sa0[u + 1]); tpk.y = pk_bf16(sa0[u + 2], sa0[u + 3]);
        tpk.z = pk_bf16(sa0[u + 4], sa0[u + 5]); tpk.w = pk_bf16(sa0[u + 6], sa0[u + 7]);
      } else {
        tpk.x = pk_bf16(sa1[u + 0], sa1[u + 1]); tpk.y = pk_bf16(sa1[u + 2], sa1[u + 3]);
        tpk.z = pk_bf16(sa1[u + 4], sa1[u + 5]); tpk.w = pk_bf16(sa1[u + 6], sa1[u + 7]);
      }
      pf[sx] = __builtin_bit_cast(bf16x8, tpk);
    }
  }
  den += __shfl_xor(den, 32);
  const float dtot = den + wq * qn;
  const float inv = 1.f / fmaxf(fabsf(dtot), expf(-mtt));
  bf16_t* op = p->P + (size_t)rowq * LDP + 1024 + dir * 512 + h * 128 + wv * 64 + 4 * hi;
#pragma unroll 1
  for (int vp = 0; vp < 2; ++vp) {
    f32x16 o0;
#pragma unroll
    for (int q = 0; q < 16; ++q) o0[q] = 0.f;
    const char* cb = cimg + (wv * 2 + vp) * 8192 + toff + hi * 512;
#pragma unroll
    for (int d0 = 0; d0 < 8; ++d0) {
      const bf16x8 A0 = __builtin_shufflevector(vtr(cb + (16 * d0) * 64), vtr(cb + (16 * d0 + 4) * 64), 0, 1, 2, 3, 4, 5, 6, 7);
      o0 = MFMA32(A0, qf[d0], o0);
    }
#pragma unroll
    for (int q = 0; q < 16; ++q) o0[q] *= wq;
    const char* vb = vimg + (wv * 2 + vp) * 4096 + toff + hi * 256;
#pragma unroll
    for (int sx = 0; sx < 4; ++sx) {
      if (sx < 2 || wt) {
        const bf16x8 A0 = __builtin_shufflevector(vtr(vb + (16 * sx) * 64), vtr(vb + (16 * sx + 8) * 64), 0, 1, 2, 3, 4, 5, 6, 7);
        o0 = MFMA32(A0, pf[sx], o0);
      }
    }
#pragma unroll
    for (int g = 0; g < 4; ++g) {
      u32x2 v0;
      v0.x = pk_bf16(o0[4 * g] * inv, o0[4 * g + 1] * inv); v0.y = pk_bf16(o0[4 * g + 2] * inv, o0[4 * g + 3] * inv);
      *(u32x2*)(op + vp * 32 + 8 * g) = v0;
    }
  }
}

__device__ void ph_mlstm_s1(KP p, int layer, char* smc) {
  const int tid = opaque_tid();
  __syncthreads();
  for (int tile = blockIdx.x; tile < NMT; tile += gridDim.x) { mlstm_s1(p, layer, tile, smc, tid); __syncthreads(); }
}

__device__ void ph_rec_final(KP p, int layer, bool keep) {
  const int tid = opaque_tid();
  const int j = layer >> 1;
  const int lane = tid & 63, wave = tid >> 6;
  const int rows = keep ? NT : NL;
  const int c0 = lane * 8;
  auto unpack = [](const u32x4 u, float (&f)[8]) {
    f[0] = bflo(u.x); f[1] = bfhi(u.x); f[2] = bflo(u.y); f[3] = bfhi(u.y);
    f[4] = bflo(u.z); f[5] = bfhi(u.z); f[6] = bflo(u.w); f[7] = bfhi(u.w);
  };
  for (int t = blockIdx.x * 4 + wave; t < rows; t += gridDim.x * 4) {
    const bf16_t* rw = p->RW + (size_t)t * RWS + c0;
    const bf16_t* pt = p->P + (size_t)t * LDP + c0;
    unsigned char* mo = (unsigned char*)p->AB + (size_t)t * DM + c0;
    {
      float yf[8], yb[8], r[8], v[8], k0[8], k1[8], g[8], y[8], o[8];
      unpack(*(const u32x4*)(pt), yf); unpack(*(const u32x4*)(pt + 512), yb);
      unpack(*(const u32x4*)(rw), r); unpack(*(const u32x4*)(rw + 512), v);
      unpack(*(const u32x4*)(rw + 5 * 512), k0); unpack(*(const u32x4*)(rw + 6 * 512), k1);
      unpack(*(const u32x4*)(rw + 9 * 512), g);
      float s1 = 0.f, bs = 0.f;
      const float* rk = p->rwkv_rk + j * 512 + c0;
#pragma unroll
      for (int e = 0; e < 8; ++e) { y[e] = yf[e] + yb[e]; s1 += y[e]; bs += r[e] * rk[e] * (k0[e] + k1[e]); }
      s1 += dppx<0xB1>(s1); s1 += dppx<0x4E>(s1); s1 += dppx<0x141>(s1);
      bs += dppx<0xB1>(bs); bs += dppx<0x4E>(bs); bs += dppx<0x141>(bs);
      const float mu = s1 * (1.f / 64.f);
      float s2 = 0.f;
#pragma unroll
      for (int e = 0; e < 8; ++e) { const float d = y[e] - mu; s2 += d * d; }
      s2 += dppx<0xB1>(s2); s2 += dppx<0x4E>(s2); s2 += dppx<0x141>(s2);
      const float rs = rsqrtf(s2 * (1.f / 64.f) + 64e-5f);
      const float* gn0 = p->rwkv_gn + (j * 2 + 0) * 512 + c0;
      const float* gn1 = p->rwkv_gn + (j * 2 + 1) * 512 + c0;
#pragma unroll
      for (int e = 0; e < 8; ++e) o[e] = ((y[e] - mu) * rs * gn0[e] + gn1[e] + bs * v[e]) * g[e];
      u32x2 ov;
      ov.x = pk_fp8x4c(o[0], o[1], o[2], o[3]); ov.y = pk_fp8x4c(o[4], o[5], o[6], o[7]);
      *(u32x2*)(mo) = ov;
    }
    {
      float hf[8], hb[8], og[8], hsum[8], o[8];
      unpack(*(const u32x4*)(pt + 1024), hf); unpack(*(const u32x4*)(pt + 1536), hb);
      unpack(*(const u32x4*)(pt + 3584), og);
      float ss = 0.f;
#pragma unroll
      for (int e = 0; e < 8; ++e) { hsum[e] = hf[e] + hb[e]; ss += hsum[e] * hsum[e]; }
      ss += dppx<0xB1>(ss); ss += dppx<0x4E>(ss); ss += dppx<0x141>(ss); ss += dppx<0x140>(ss);
      const float rs = rsqrtf(ss * (1.f / 128.f) + 1e-6f);
      const float* ng = p->mlstm_norm + j * 512 + c0;
#pragma unroll
      for (int e = 0; e < 8; ++e) o[e] = hsum[e] * rs * ng[e] * sigm_f(og[e]);
      u32x2 ov;
      ov.x = pk_fp8x4c(o[0], o[1], o[2], o[3]); ov.y = pk_fp8x4c(o[4], o[5], o[6], o[7]);
      *(u32x2*)(mo + 512) = ov;
    }
  }
}

using f32x4v = __attribute__((ext_vector_type(4))) float;
__device__ void ph_ln_router(KP p, int layer, bool keep, char* smc) {
  float* h2s = (float*)smc;
  float* lgs = (float*)smc;
  const int tid = opaque_tid();
  const int lane = tid & 63, wave = tid >> 6;
  const int rows = keep ? NT : NL;
  const float* lng = p->ln_g + (layer * 2 + 0) * 1024;
  const float* lnb = p->ln_b + (layer * 2 + 0) * 1024;
  for (int tile = blockIdx.x; tile < rows / 16; tile += gridDim.x) {
    const int t0 = tile * 16;
    const float* mod = p->MOD + (layer * 9 + modrow(t0)) * 6144;
    const float* brow = p->WrT + ((size_t)layer * 64 + 16 * wave + (lane & 15)) * 1024 + 4 * (lane >> 4);
    f32x4v b0[8], b1[8], b2[8];
#pragma unroll
    for (int q = 0; q < 8; ++q) { b0[q] = *(const f32x4v*)(brow + 16 * q); b1[q] = *(const f32x4v*)(brow + 16 * (8 + q)); }
    __builtin_amdgcn_sched_barrier(0);
    {
      float4 v[4][4];
      float s4[4];
#pragma unroll
      for (int q = 0; q < 4; ++q) {
        const int t = t0 + wave * 4 + q;
        s4[q] = 0.f;
#pragma unroll
        for (int i = 0; i < 4; ++i) v[q][i] = *(const float4*)(p->Tb + (size_t)t * DM + i * 256 + lane * 4);
      }
#pragma unroll
      for (int q = 0; q < 4; ++q)
#pragma unroll
        for (int i = 0; i < 4; ++i) s4[q] += (v[q][i].x + v[q][i].y) + (v[q][i].z + v[q][i].w);
      float mean4[4], rs4[4];
#pragma unroll
      for (int q = 0; q < 4; ++q) mean4[q] = wsum(s4[q]) * (1.f / 1024.f);
#pragma unroll
      for (int q = 0; q < 4; ++q) {
        float qq = 0.f;
#pragma unroll
        for (int i = 0; i < 4; ++i) {
          const float d0 = v[q][i].x - mean4[q], d1 = v[q][i].y - mean4[q], d2 = v[q][i].z - mean4[q], d3 = v[q][i].w - mean4[q];
          qq += (d0 * d0 + d1 * d1) + (d2 * d2 + d3 * d3);
        }
        s4[q] = qq;
      }
#pragma unroll
      for (int q = 0; q < 4; ++q) rs4[q] = rsqrtf(wsum(s4[q]) * (1.f / 1024.f) + 1e-5f);
#pragma unroll
      for (int i = 0; i < 4; ++i) {
        const int n = i * 256 + lane * 4;
        const float4 g = *(const float4*)(lng + n), bb = *(const float4*)(lnb + n);
        const float4 sc = *(const float4*)(mod + 4096 + n), sh = *(const float4*)(mod + 3072 + n);
#pragma unroll
        for (int q = 0; q < 4; ++q) {
          const int tl = wave * 4 + q, t = t0 + tl;
          const float mean = mean4[q], rs = rs4[q];
          const float4 xn = make_float4((v[q][i].x - mean) * rs * g.x + bb.x, (v[q][i].y - mean) * rs * g.y + bb.y,
                                        (v[q][i].z - mean) * rs * g.z + bb.z, (v[q][i].w - mean) * rs * g.w + bb.w);
          *(float4*)(p->X + (size_t)t * DM + n) = xn;
          const float4 hh = make_float4(xn.x * (1.f + sc.x) + sh.x, xn.y * (1.f + sc.y) + sh.y,
                                        xn.z * (1.f + sc.z) + sh.z, xn.w * (1.f + sc.w) + sh.w);
          *(unsigned*)((unsigned char*)p->AB + (size_t)t * DM + n) = pk_fp8x4c(hh.x, hh.y, hh.z, hh.w);
          *(float4*)(h2s + tl * 1028 + n) = hh;
        }
      }
    }
    __syncthreads();
    f32x4v acc = {0.f, 0.f, 0.f, 0.f};
    {
      f32x4v a1 = {0.f, 0.f, 0.f, 0.f}, a2 = {0.f, 0.f, 0.f, 0.f}, a3 = {0.f, 0.f, 0.f, 0.f};
      const int i = lane & 15, kk = lane >> 4;
      const float* arow = h2s + i * 1028 + 4 * kk;
#define ROUTER_LOAD(B, Q0) _Pragma("unroll") for (int q = 0; q < 8; ++q) B[q] = *(const f32x4v*)(brow + 16 * ((Q0) + q)); __builtin_amdgcn_sched_barrier(0);
#define ROUTER_MFMA(B, Q0) _Pragma("unroll") for (int q = 0; q < 8; ++q) { \
        const float4 a = *(const float4*)(arow + 16 * ((Q0) + q)); \
        acc = __builtin_amdgcn_mfma_f32_16x16x4f32(a.x, B[q].x, acc, 0, 0, 0); \
        a1 = __builtin_amdgcn_mfma_f32_16x16x4f32(a.y, B[q].y, a1, 0, 0, 0); \
        a2 = __builtin_amdgcn_mfma_f32_16x16x4f32(a.z, B[q].z, a2, 0, 0, 0); \
        a3 = __builtin_amdgcn_mfma_f32_16x16x4f32(a.w, B[q].w, a3, 0, 0, 0); } __builtin_amdgcn_sched_barrier(0);
      ROUTER_LOAD(b2, 16) ROUTER_MFMA(b0, 0)
      ROUTER_LOAD(b0, 24) ROUTER_MFMA(b1, 8)
      ROUTER_LOAD(b1, 32) ROUTER_MFMA(b2, 16)
      ROUTER_LOAD(b2, 40) ROUTER_MFMA(b0, 24)
      ROUTER_LOAD(b0, 48) ROUTER_MFMA(b1, 32)
      ROUTER_LOAD(b1, 56) ROUTER_MFMA(b2, 40)
      ROUTER_MFMA(b0, 48)
      ROUTER_MFMA(b1, 56)
      acc = (acc + a1) + (a2 + a3);
    }
    __syncthreads();
#pragma unroll
    for (int r = 0; r < 4; ++r) lgs[((lane >> 4) * 4 + r) * 64 + 16 * wave + (lane & 15)] = acc[r];
    __syncthreads();
    {
      float score4[4], gate4[4];
      int kidx4[4], pos4[4];
      bool chosen4[4];
#pragma unroll
      for (int q = 0; q < 4; ++q) {
        const int tl = wave * 4 + q;
        const float logit = lgs[tl * 64 + lane];
        const float score = sigm_f(logit);
        float sel = score + p->moe_bias[layer * 64 + lane];
        bool chosen = false;
        for (int r = 0; r < 6; ++r) {
          const float mx = wmax(sel);
          const unsigned long long bal = __ballot(sel == mx);
          const int first = __ffsll((long long)bal) - 1;
          if (lane == first) { chosen = true; sel = -INFINITY; }
        }
        const float gsum = wsum(chosen ? score : 0.f);
        const unsigned long long cb = __ballot(chosen);
        score4[q] = score; gate4[q] = score / gsum * 2.5f; chosen4[q] = chosen;
        kidx4[q] = __popcll(cb & ((1ull << lane) - 1ull));
      }
#pragma unroll
      for (int q = 0; q < 4; ++q) pos4[q] = chosen4[q] ? atomicAdd(&p->cnt[lane * CSTR], 1) : 0;
#pragma unroll
      for (int q = 0; q < 4; ++q) {
        const int t = t0 + wave * 4 + q;
        if (chosen4[q]) {
          p->ltok[(size_t)lane * NT + pos4[q]] = t;
          p->lgate[(size_t)lane * NT + pos4[q]] = gate4[q];
          p->tsl[t * 6 + kidx4[q]] = (lane << 16) | pos4[q];
        }
      }
    }
    __syncthreads();
  }
}

__device__ __forceinline__ void moe_prefix(KP p, int rows, int* s_pref, int tid) {
  if (tid < 64) s_pref[322 + tid] = p->cnt[tid * CSTR];
  __syncthreads();
  if (tid == 0) {
    int a = 0;
    for (int e = 0; e < 64; ++e) { s_pref[e] = a; a += (s_pref[322 + e] + 127) >> 7; }
    s_pref[64] = a; a += rows >> 7;
    s_pref[65] = a;
  }
  __syncthreads();
}

__device__ void ph_gemm(KP p, int kind, int layer, bool keep, char* lds) {
  const int tid = opaque_tid();
  const int j = layer >> 1;
  const bool att = !(layer & 1);
  const int rows = keep ? NT : NL;
  int* pref = (int*)(lds + META_OFF);
  int* s_idx = pref + 66;
  float* s_gate = (float*)(s_idx + 128);
  if (kind == 1 && blockIdx.x == 0 && tid < 65) p->cnt[tid * CSTR] = 0;
  int total;
  const int ntn_in = att ? 18 : 33;
  switch (kind) {
    case 0: total = (NT / 128) * ntn_in; break;
    case 1: total = (rows / 128) * 8; break;
    case 2: total = pref[65] * 4; break;
    case 3: total = pref[65] * 8; break;
    case 4: total = (NT / 128) * 3; break;
    default: total = (NT / 128) * 20; break;
  }
  const bool moe = kind == 2 || kind == 3;
  const int tsh = kind == 2 ? 2 : 3;
  int e_nx = 0, idx_nx = tid; float g_nx = 1.f;
  auto fetch_moe = [&](int tl) {
    const int mt = tl >> tsh;
    while (mt >= pref[e_nx + 1]) ++e_nx;
    idx_nx = tid; g_nx = 1.f;
    if (tid < 128) {
      const int pos = (mt - pref[e_nx]) * 128 + tid;
      if (kind == 2) {
        idx_nx = 0;
        if (e_nx < 64) { if (pos < pref[322 + e_nx]) idx_nx = p->ltok[(size_t)e_nx * NT + pos]; }
        else idx_nx = pos;
      } else if (e_nx < 64) g_nx = pos < pref[322 + e_nx] ? p->lgate[(size_t)e_nx * NT + pos] : 0.f;
    }
  };
  const int xcd = blockIdx.x & 7, lb = blockIdx.x >> 3, nbx = ((int)gridDim.x - xcd + 7) >> 3;
  const int t_beg = (int)(((long long)total * xcd) >> 3), t_end = (int)(((long long)total * (xcd + 1)) >> 3);
  if (moe && t_beg + lb < t_end) fetch_moe(t_beg + lb);
  for (int tile = t_beg + lb; tile < t_end; tile += nbx) {
    const bf16_t* Abase; const bf16_t* Bt;
    int astride, K, n0, m0 = 0, aux = 0, e = e_nx, mtile = 0;
    switch (kind) {
      case 0: { const int tm = tile / ntn_in, tn = tile % ntn_in; m0 = tm * 128; n0 = tn * 128;
                Abase = (const bf16_t*)((const unsigned char*)p->AB + (size_t)m0 * DM); astride = DM; K = 1024;
                Bt = (const bf16_t*)(att ? (const unsigned char*)p->Wt_att + (size_t)j * ATT_N * 1024
                                         : (const unsigned char*)p->Wt_rec + (size_t)j * REC_NP * 1024); } break;
      case 1: { const int tm = tile >> 3, tn = tile & 7; m0 = tm * 128; n0 = tn * 128;
                Abase = (const bf16_t*)((const unsigned char*)p->AB + (size_t)m0 * DM); astride = DM; K = 1024;
                Bt = (const bf16_t*)((const unsigned char*)p->Wt_out + (size_t)layer * 1024 * 1024); } break;
      case 2: { mtile = tile >> 2; aux = tile & 3; n0 = aux * 128;
                Abase = p->AB; astride = DM; K = 1024;
                Bt = (const bf16_t*)((const unsigned char*)p->Wt13 + (size_t)(layer * 65 + e) * 512 * 1024); } break;
      case 3: { mtile = tile >> 3; aux = tile & 7; n0 = aux * 128;
                Abase = (const bf16_t*)((const unsigned char*)p->ACT + (size_t)mtile * 128 * 256); astride = 256; K = 256;
                Bt = (const bf16_t*)((const unsigned char*)p->Wt2 + (size_t)(layer * 65 + e) * 1024 * 256); } break;
      case 4: { const int tm = tile / 3; aux = tile % 3; m0 = tm * 128; n0 = 0;
                Abase = p->Zb + (size_t)m0 * 1536 + aux * 512; astride = 1536; K = 512; Bt = p->Wl1 + (size_t)(j * 3 + aux) * 128 * 512; } break;
      default: { const int tm = tile / 20; aux = tile % 20; m0 = tm * 128; n0 = aux * 128;
                const int grp = aux < 8 ? 0 : (aux < 16 ? 1 : 2);
                Abase = p->L1 + (size_t)m0 * 384 + grp * 128; astride = 384; K = 128; Bt = p->Wl2 + (size_t)j * 2560 * 128; } break;
    }
    if (tid < 128) { s_idx[tid] = idx_nx; s_gate[tid] = g_nx; }
    __syncthreads();
    if (moe && tile + nbx < t_end) fetch_moe(tile + nbx);
    {
      f32x16 acc[2][2];
      if (kind <= 3) {
        const unsigned char* A8 = (const unsigned char*)Abase;
        gemm128_fp8(tid, [&](int r) { return A8 + (size_t)s_idx[r] * astride; }, (const unsigned char*)Bt, K, n0, lds, acc);
      } else
        gemm128_main(tid, [&](int r) { return Abase + (size_t)s_idx[r] * astride; }, Bt, K, n0, lds, acc);
      float* Ct = (float*)lds;
      acc_foreach(tid, acc, [&](int row, int col, float v) { Ct[row * 128 + col] = v; });
    }
    __syncthreads();
    {
      const float* Ct = (const float*)lds;
      int c4 = (tid & 31) * 4, r0 = tid >> 5;
      asm volatile("" : "+v"(c4), "+v"(r0));
      const int N_in = att ? ATT_N : REC_N;
      const int d5 = (aux >> 2) & 1, c05 = (aux & 3) * 128;
      switch (kind) {
        case 0: {
#pragma unroll 8
          for (int it = 0; it < 16; ++it) {
            const int row = it * 8 + r0;
            const float4 vraw = *(const float4*)(Ct + row * 128 + c4);
            const float4 v = make_float4(vraw.x * W8_INV, vraw.y * W8_INV, vraw.z * W8_INV, vraw.w * W8_INV);

            const int cn = n0 + c4;
            float4 vq = v;
            if (att && n0 >= 1536 && n0 < 2176) {
              float ss = v.x * v.x + v.y * v.y + v.z * v.z + v.w * v.w;
              ss += dppx<0xB1>(ss); ss += dppx<0x4E>(ss); ss += dppx<0x141>(ss); ss += dppx<0x140>(ss);
              const float rs = rsqrtf(ss * (1.f / 64.f) + 1e-6f);
              const float4 g = *(const float4*)(p->qk_gain + j * 128 + (n0 >= 2048 ? 64 : 0) + (cn & 63));
              vq = make_float4(v.x * rs * g.x, v.y * rs * g.y, v.z * rs * g.z, v.w * rs * g.w);
              const int t = m0 + row;
              if (t < NL) {
                const int sidx = t & 2047, pi0 = (cn & 63) >> 1;
                const int pos = pi0 < 16 ? (sidx >> 6) : (sidx & 63);
                const float4 cs = *(const float4*)(p->ROPE + (pos * 16 + (pi0 & 15)) * 2);
                vq = make_float4(vq.x * cs.x - vq.y * cs.y, vq.x * cs.y + vq.y * cs.x,
                                 vq.z * cs.z - vq.w * cs.w, vq.z * cs.w + vq.w * cs.z);
              }
            }
            if (cn < N_in) {
              u32x2 o; o.x = pk_bf16(vq.x, vq.y); o.y = pk_bf16(vq.z, vq.w);
              *(u32x2*)(p->P + (size_t)(m0 + row) * LDP + cn) = o;
            }
            if (!att && cn >= 4096 && cn < 4112) *(float4*)(p->GP + (size_t)(m0 + row) * 16 + (cn - 4096)) = v;
          }
        } break;
        case 1: {
#pragma unroll 16
          for (int it = 0; it < 16; ++it) {
            const int row = it * 8 + r0;
            const float4 v = *(const float4*)(Ct + row * 128 + c4);

            const size_t o = (size_t)(m0 + row) * DM + n0 + c4;
            const float4 xv = *(const float4*)(p->X + o);
            const float4 g = *(const float4*)(p->MOD + (layer * 9 + modrow(m0)) * 6144 + 2048 + n0 + c4);
            *(float4*)(p->Tb + o) = make_float4(DN_ALPHA * xv.x + g.x * (v.x * W8_INV), DN_ALPHA * xv.y + g.y * (v.y * W8_INV),
                                                DN_ALPHA * xv.z + g.z * (v.z * W8_INV), DN_ALPHA * xv.w + g.w * (v.w * W8_INV));
          }
        } break;
        case 2: {
#pragma unroll 8
          for (int it = 0; it < 16; ++it) {
            const int row = it * 8 + r0;
            const float4 v = *(const float4*)(Ct + row * 128 + c4);

            if (((c4 >> 5) & 1) == 0) {
              const float4 u = *(const float4*)(Ct + row * 128 + c4 + 32);
              const float a0 = v.x * W8_INV, a1 = v.y * W8_INV, a2 = v.z * W8_INV, a3 = v.w * W8_INV;
              *(unsigned*)((unsigned char*)p->ACT + ((size_t)mtile * 128 + row) * 256 + aux * 64 + (c4 >> 6) * 32 + (c4 & 31)) =
                  pk_fp8x4c(silu_f(a0) * (u.x * W8_INV), silu_f(a1) * (u.y * W8_INV), silu_f(a2) * (u.z * W8_INV), silu_f(a3) * (u.w * W8_INV));
            }
          }
        } break;
        case 3: {
#pragma unroll 16
          for (int it = 0; it < 16; ++it) {
            const int row = it * 8 + r0;
            const float4 v = *(const float4*)(Ct + row * 128 + c4);

            const float g = s_gate[row] * W8_INV;
            u32x2 o; o.x = pk_bf16(g * v.x, g * v.y); o.y = pk_bf16(g * v.z, g * v.w);
            *(u32x2*)(p->OUT2 + ((size_t)mtile * 128 + row) * 1024 + n0 + c4) = o;
          }
        } break;
        case 4: {
#pragma unroll 4
          for (int it = 0; it < 16; ++it) {
            const int row = it * 8 + r0;
            const float4 v = *(const float4*)(Ct + row * 128 + c4);

            float4 o4 = v;
            if (aux == 0) o4 = make_float4(tanhf(v.x), tanhf(v.y), tanhf(v.z), tanhf(v.w));
            else if (aux == 2) o4 = make_float4(sigm_f(v.x), sigm_f(v.y), sigm_f(v.z), sigm_f(v.w));
            u32x2 o; o.x = pk_bf16(o4.x, o4.y); o.y = pk_bf16(o4.z, o4.w);
            *(u32x2*)(p->L1 + (size_t)(m0 + row) * 384 + aux * 128 + c4) = o;
          }
        } break;
        default: {
#pragma unroll 4
          for (int it = 0; it < 16; ++it) {
            const int row = it * 8 + r0;
            const float4 v = *(const float4*)(Ct + row * 128 + c4);

            bf16_t* rr = p->RW + (size_t)(m0 + row) * RWS + c05 + c4;
            const float vv[4] = {v.x, v.y, v.z, v.w};
            if (aux < 8) {
              const float4 b0 = *(const float4*)(p->rwkv_w0 + (j * 2 + d5) * 512 + c05 + c4);
              const float bb[4] = {b0.x, b0.y, b0.z, b0.w};
              float e4[4];
#pragma unroll
              for (int q = 0; q < 4; ++q) e4[q] = expf(-softplus_f(-(bb[q] + vv[q])) - 0.5f);
              u32x2 o; o.x = pk_bf16(e4[0], e4[1]); o.y = pk_bf16(e4[2], e4[3]);
              *(u32x2*)(rr + (3 + d5) * 512) = o;
            } else if (aux < 16) {
              const float4 b0 = *(const float4*)(p->rwkv_a0 + (j * 2 + d5) * 512 + c05 + c4);
              const float4 k1 = *(const float4*)(p->rwkv_kvec + (j * 2 + 1) * 512 + c05 + c4);
              const u32x2 kx2 = *(const u32x2*)(rr + 10 * 512);
              const float bb[4] = {b0.x, b0.y, b0.z, b0.w}, kk1[4] = {k1.x, k1.y, k1.z, k1.w};
              const float kx[4] = {bflo(kx2.x), bfhi(kx2.x), bflo(kx2.y), bfhi(kx2.y)};
              float av[4], ke[4];
#pragma unroll
              for (int q = 0; q < 4; ++q) { av[q] = sigm_f(bb[q] + vv[q]); ke[q] = kx[q] * (1.f + (av[q] - 1.f) * kk1[q]); }
              u32x2 o; o.x = pk_bf16(av[0], av[1]); o.y = pk_bf16(av[2], av[3]);
              *(u32x2*)(rr + (7 + d5) * 512) = o;
              o.x = pk_bf16(ke[0], ke[1]); o.y = pk_bf16(ke[2], ke[3]);
              *(u32x2*)(rr + (5 + d5) * 512) = o;
            } else {
              u32x2 o; o.x = pk_bf16(v.x, v.y); o.y = pk_bf16(v.z, v.w);
              *(u32x2*)(rr + 9 * 512) = o;
            }
          }
        } break;
      }
    }
    __syncthreads();
  }
}

__device__ void ph_final_ln(KP p, int layer, bool keep, char* lds) {
  const int tid = opaque_tid();
  const int lane = tid & 63, wave = tid >> 6;
  const int rows = keep ? NT : NL;
  int* s_base = (int*)(lds + META_OFF);
  if (tid == 0) {
    int a = 0;
#pragma unroll 1
    for (int e = 0; e < 64; ++e) { s_base[e] = a * 128; a += (p->cnt[e * CSTR] + 127) >> 7; }
    s_base[64] = a * 128;
  }
  __syncthreads();
  const float* lng = p->ln_g + (layer * 2 + 1) * 1024;
  const float* lnb = p->ln_b + (layer * 2 + 1) * 1024;
  for (int t = blockIdx.x * 4 + wave; t < rows; t += gridDim.x * 4) {
    const int mr = modrow(t);
    const float* g2 = p->MOD + (layer * 9 + mr) * 6144 + 5120;
    const bf16_t* src[7];
#pragma unroll
    for (int k = 0; k < 6; ++k) {
      const int v = p->tsl[t * 6 + k];
      src[k] = p->OUT2 + (size_t)(s_base[v >> 16] + (v & 0xffff)) * 1024;
    }
    src[6] = p->OUT2 + (size_t)(s_base[64] + t) * 1024;
    float v[16];
    float s = 0.f;
#pragma unroll
    for (int c = 0; c < 2; ++c) {
      const int n0 = c * 512 + lane * 8;
      float y[8];
#pragma unroll
      for (int q = 0; q < 8; ++q) y[q] = 0.f;
#pragma unroll
      for (int k = 0; k < 7; ++k) {
        const u32x4 u = *(const u32x4*)(src[k] + n0);
        y[0] += bflo(u.x); y[1] += bfhi(u.x); y[2] += bflo(u.y); y[3] += bfhi(u.y);
        y[4] += bflo(u.z); y[5] += bfhi(u.z); y[6] += bflo(u.w); y[7] += bfhi(u.w);
      }
      const float4 xa = *(const float4*)(p->X + (size_t)t * DM + n0), xb = *(const float4*)(p->X + (size_t)t * DM + n0 + 4);
      const float4 ga = *(const float4*)(g2 + n0), gb = *(const float4*)(g2 + n0 + 4);
      const float xx[8] = {xa.x, xa.y, xa.z, xa.w, xb.x, xb.y, xb.z, xb.w};
      const float gg[8] = {ga.x, ga.y, ga.z, ga.w, gb.x, gb.y, gb.z, gb.w};
#pragma unroll
      for (int q = 0; q < 8; ++q) { v[c * 8 + q] = DN_ALPHA * xx[q] + gg[q] * y[q]; s += v[c * 8 + q]; }
    }
    const float mean = wsum(s) * (1.f / 1024.f);
    float q2 = 0.f;
#pragma unroll
    for (int i = 0; i < 16; ++i) { const float d = v[i] - mean; q2 += d * d; }
    const float rs = rsqrtf(wsum(q2) * (1.f / 1024.f) + 1e-5f);
    const float* modn = p->MOD + ((layer + 1) * 9 + mr) * 6144;
#pragma unroll
    for (int c = 0; c < 2; ++c) {
      const int n0 = c * 512 + lane * 8;
      float xn[8];
#pragma unroll
      for (int q = 0; q < 8; ++q) xn[q] = (v[c * 8 + q] - mean) * rs * lng[n0 + q] + lnb[n0 + q];
      float* xo = (layer == 3 ? p->out : p->X) + (size_t)t * DM + n0;
      *(float4*)(xo) = make_float4(xn[0], xn[1], xn[2], xn[3]);
      *(float4*)(xo + 4) = make_float4(xn[4], xn[5], xn[6], xn[7]);
      if (layer != 3) {
        float hb[8];
#pragma unroll
        for (int q = 0; q < 8; ++q) hb[q] = xn[q] * (1.f + modn[1024 + n0 + q]) + modn[n0 + q];
        u32x2 o;
        o.x = pk_fp8x4c(hb[0], hb[1], hb[2], hb[3]); o.y = pk_fp8x4c(hb[4], hb[5], hb[6], hb[7]);
        *(u32x2*)((unsigned char*)p->AB + (size_t)t * DM + n0) = o;
      }
    }
  }
}

#define XB_TMO      128
#define XB_XCNT(j)  (256  + 64 * (j))
#define XB_XSUB(j)  (1280 + 64 * (j))
#define XB_XGEN(j)  (2304 + 64 * (j))
#define XB_TOP      3328
#define XB_TOPGEN   3392
#define XB_SPIN_CAP (1u << 20)
#define LAS __attribute__((address_space(3)))
__device__ __forceinline__ unsigned xb_ld(unsigned* p) { return __hip_atomic_load(p, __ATOMIC_RELAXED, __HIP_MEMORY_SCOPE_AGENT); }
__device__ __forceinline__ unsigned xb_add(unsigned* p, unsigned v) { return __hip_atomic_fetch_add(p, v, __ATOMIC_RELAXED, __HIP_MEMORY_SCOPE_AGENT); }
__device__ __forceinline__ unsigned xb_xcc_id() { return (unsigned)__builtin_amdgcn_s_getreg((3 << 11) | 20) & 0xFu; }
#define XB_SPIN(cond, bar) do { unsigned _sp = 0; while (cond) { __builtin_amdgcn_s_sleep(1); \
    if ((++_sp & 255u) == 0u) { if (xb_ld(&(bar)[XB_TMO])) break; if (_sp > XB_SPIN_CAP) { atomicAdd(&(bar)[XB_TMO], 1u); break; } } } } while (0)
struct XcdBarrier { unsigned* bar; unsigned x; volatile LAS unsigned* st; };
__device__ __forceinline__ XcdBarrier xcd_barrier_post(unsigned* bar, volatile LAS unsigned* st) {
  XcdBarrier b; b.bar = bar; b.x = xb_xcc_id(); b.st = st;
  if (threadIdx.x == 0) (void)xb_add(&bar[XB_XCNT(b.x)], 1u);
  return b;
}
__device__ __forceinline__ void xcd_barrier_complete(unsigned* bar, unsigned x, unsigned& nloc, unsigned& nx) {
  const unsigned G = gridDim.x;
  unsigned sum, cnt, mine, sp = 0u;
  for (;;) {
    sum = 0u; cnt = 0u; mine = 0u;
#pragma unroll
    for (unsigned j = 0; j < 16; ++j) { const unsigned c = xb_ld(&bar[XB_XCNT(j)]); sum += c; cnt += (c > 0u) ? 1u : 0u; mine = (j == x) ? c : mine; }
    if (sum == G) break;
    __builtin_amdgcn_s_sleep(1);
    if ((++sp & 255u) == 0u) { if (xb_ld(&bar[XB_TMO])) break; if (sp > XB_SPIN_CAP) { atomicAdd(&bar[XB_TMO], 1u); break; } }
  }
  nloc = mine > 0u ? mine : 1u; nx = cnt > 0u ? cnt : 1u;
}
__device__ __forceinline__ void xcd_barrier(const XcdBarrier& b) {
  asm volatile("s_waitcnt vmcnt(0)" ::: "memory");
  __syncthreads();
  if (threadIdx.x == 0) {
    unsigned* bar = b.bar;
    __builtin_amdgcn_s_waitcnt(0);
    unsigned nloc = b.st[0], nx = b.st[1];
    if (nloc == 0u) { xcd_barrier_complete(bar, b.x, nloc, nx); b.st[0] = nloc; b.st[1] = nx; }
    const unsigned old = xb_add(&bar[XB_XSUB(b.x)], 1u);
    const unsigned gen = old / nloc;
    if (old + 1u == (gen + 1u) * nloc) {
      __builtin_amdgcn_fence(__ATOMIC_RELEASE, "agent");
      asm volatile("s_waitcnt vmcnt(0)" ::: "memory");
      const unsigned og = xb_add(&bar[XB_TOP], 1u);
      const unsigned tg = og / nx;
      if (og + 1u == (tg + 1u) * nx) xb_add(&bar[XB_TOPGEN], 1u);
      else XB_SPIN(xb_ld(&bar[XB_TOPGEN]) == tg, bar);
      __builtin_amdgcn_fence(__ATOMIC_ACQUIRE, "agent");
      xb_add(&bar[XB_XGEN(b.x)], 1u);
      asm volatile("s_waitcnt vmcnt(0)" ::: "memory");
    } else {
      XB_SPIN(xb_ld(&bar[XB_XGEN(b.x)]) == gen, bar);
      __builtin_amdgcn_fence(__ATOMIC_ACQUIRE, "agent");
      asm volatile("s_waitcnt vmcnt(0)" ::: "memory");
    }
  }
  __syncthreads();
}

constexpr int NSLOTS = 13;
constexpr int NPHASE = 2 + 4 * NSLOTS;
__device__ __forceinline__ bool phase_is_nop(int ph) {
  if (ph < 2) return false;
  const int layer = (ph - 2) / NSLOTS, st = (ph - 2) % NSLOTS;
  if (st == 5 || st == 6) return true;
  return !(layer & 1) && (st == 1 || (st >= 3 && st <= 7));
}
__device__ void run_phase(KP p, int ph, char* sm) {
  if (ph == 0) { ph_init(p, sm); return; }
  if (ph == 1) { ph_mod_h(p, sm); return; }
  const int layer = (ph - 2) / NSLOTS, st = (ph - 2) % NSLOTS;
  const bool odd = layer & 1;
  const bool keep = layer < 3;
  int gk = -1;
  if (st == 0) gk = 0;
  else if (st == 8) gk = 1;
  else if (st == 10) gk = 2;
  else if (st == 11) gk = 3;
  else if (odd && st == 2) gk = 4;
  else if (odd && st == 3) gk = 5;
  asm volatile("" : "+s"(gk));
  if (gk >= 0) {
    if (gk == 2 || gk == 3) moe_prefix(p, keep ? NT : NL, (int*)(sm + META_OFF), opaque_tid());
    ph_gemm(p, gk, layer, keep, sm);
    if (gk == 5) { __syncthreads(); ph_mlstm_s2(p, sm); }
    return;
  }
  switch (st) {
    case 1: if (odd) { ph_rwkv_mix(p, layer); ph_mlstm_s1(p, layer, sm); } break;
    case 2: ph_attention(p, layer, keep, sm); break;
    case 4: if (odd) ph_scan_a(p, layer, sm); break;
    case 7: if (odd) ph_rec_final(p, layer, keep); break;
    case 9: ph_ln_router(p, layer, keep, sm); break;
    case 12: ph_final_ln(p, layer, keep, sm); break;
  }
}

__global__ void __launch_bounds__(NTHR, 2) mega_kernel(Params kargs) {
  extern __shared__ __attribute__((aligned(16))) char sm[];
  cg::grid_group grid = cg::this_grid();
  volatile LAS unsigned* st = (volatile LAS unsigned*)(sm + META_OFF + 4032);
  if (threadIdx.x == 0) { st[0] = 0u; st[1] = 0u; }
  __syncthreads();
  const XcdBarrier xb = xcd_barrier_post(kargs.bar, st);
  for (int ph = kargs.ph_lo; ph < kargs.ph_hi; ++ph) {
    if (phase_is_nop(ph)) continue;
    {
      KP kp = (KP)__builtin_amdgcn_kernarg_segment_ptr();
      asm volatile("" : "+s"(kp));
      run_phase(kp, ph, sm);
    }
    if (ph + 1 < kargs.ph_hi) {
      if (ph == 0) grid.sync();
      else xcd_barrier(xb);
    }
  }
}

extern "C" void kernel_launch(void* const* d_in, const int* in_sizes, int n_in, void* d_out, int out_size, void* d_ws,
                              size_t ws_size, hipStream_t stream) {
  static int grid_blocks = 0;
  if (!grid_blocks) {
    int dev = 0, cus = 0, per_cu = 0;
    (void)hipGetDevice(&dev);
    (void)hipDeviceGetAttribute(&cus, hipDeviceAttributeMultiprocessorCount, dev);
    (void)hipFuncSetAttribute((const void*)mega_kernel, hipFuncAttributeMaxDynamicSharedMemorySize, SMEM_BYTES);
    (void)hipOccupancyMaxActiveBlocksPerMultiprocessor(&per_cu, mega_kernel, NTHR, SMEM_BYTES);
    if (per_cu < 1) per_cu = 1;
    if (per_cu > 2) per_cu = 2;
    grid_blocks = cus * per_cu;
  }
  Params p;
  memset(&p, 0, sizeof(p));
  const float** pin = (const float**)&p;
  for (int i = 0; i < 35; ++i) pin[i] = (const float*)d_in[i];
  p.out = (float*)d_out;
  char* w = (char*)d_ws;
  size_t off = 0;
  auto take = [&](size_t bytes) { char* r = w + off; off += (bytes + 255) & ~(size_t)255; return r; };
  p.Wt_att = (bf16_t*)take((size_t)2 * ATT_N * 1024 * 2);
  p.Wt_rec = (bf16_t*)take((size_t)2 * REC_NP * 1024 * 2);
  p.Wt_out = (bf16_t*)take((size_t)4 * 1024 * 1024 * 2);
  p.Wt13 = (bf16_t*)take((size_t)4 * 65 * 512 * 1024);
  p.Wt2 = (bf16_t*)take((size_t)4 * 65 * 1024 * 256);
  p.Wl1 = (bf16_t*)take((size_t)2 * 3 * 128 * 512 * 2);
  p.Wl2 = (bf16_t*)take((size_t)2 * 2560 * 128 * 2);
  p.X = (float*)take((size_t)NT * DM * 4);
  p.AB = (bf16_t*)take((size_t)NT * DM * 2);
  p.MOD = (float*)take((size_t)5 * 9 * 6144 * 4);
  p.MODP = (float*)take((size_t)8 * 4 * 9 * 6144 * 4);
  p.GP = (float*)take((size_t)NT * 16 * 4);
  p.ROPE = (float*)take((size_t)64 * 16 * 2 * 4);
  p.WrT = (float*)take((size_t)4 * 64 * 1024 * 4);
  p.msc = (float*)take((size_t)3 * NMT * 4);
  p.lgate = (float*)take((size_t)64 * NT * 4);
  p.ltok = (int*)take((size_t)64 * NT * 4);
  p.tsl = (int*)take((size_t)NT * 6 * 4);
  p.cnt = (int*)take((size_t)65 * CSTR * 4);
  p.bar = (unsigned*)take((size_t)BAR_TOTAL_WORDS * 4);
  char* region = take(0);
  const size_t szP = (size_t)NT * LDP * 2, szRW = (size_t)NT * RWS * 2, szMS = (size_t)NMT * 16384 * 2,
               szMSn = (size_t)NMT * 128 * 4;
  const size_t szT = (size_t)NT * DM * 4, szOUT2 = (size_t)NSLOT * 1024 * 2;
  p.P = (bf16_t*)region;
  p.RW = (bf16_t*)(region + szP);
  p.MS = (bf16_t*)(region + szP + szRW);
  p.MSn = (float*)(region + szP + szRW + szMS);
  p.Tb = (float*)region;
  p.ACT = (bf16_t*)region;
  p.OUT2 = (bf16_t*)(region + szT);
  const size_t szZ = (size_t)NT * 2048 * 2;
  p.Zb = (bf16_t*)(region + szP + szRW + szMS + szMSn);
  p.L1 = p.Zb + (size_t)NT * 1536;
  size_t mixer = szP + szRW + szMS + szMSn + szZ, moe = szT + szOUT2;
  off += (mixer > moe ? mixer : moe);
  if (off > ws_size) { fprintf(stderr, "workspace too small: need %zu have %zu\n", off, ws_size); return; }
  p.ph_lo = 0;
  p.ph_hi = NPHASE;
  (void)hipMemsetAsync(p.bar, 0, (size_t)BAR_TOTAL_WORDS * 4, stream);
  void* args[] = {&p};
  hipError_t e = hipLaunchCooperativeKernel((void*)mega_kernel, dim3(grid_blocks), dim3(NTHR), args, SMEM_BYTES, stream);
  if (e != hipSuccess) fprintf(stderr, "cooperative launch failed: %s (grid %d)\n", hipGetErrorString(e), grid_blocks);
}
```

```cpp
#include <hip/hip_runtime.h>
#include <hip/hip_cooperative_groups.h>
#include <cstdio>
#include <cstring>
namespace cg = cooperative_groups;

constexpr int DM = 1024;
constexpr int NBATCH = 8;
constexpr int SEQ = 2048;
constexpr int CTXL = 256;
constexpr int NL = NBATCH * SEQ;
constexpr int NC = NBATCH * CTXL;
constexpr int NT = NL + NC;
constexpr int TSC = CTXL + SEQ;
constexpr int LDP = 4112;
constexpr int ATT_N = 2304;
constexpr int REC_N = 4112;
constexpr int REC_NP = 4224;
constexpr int NCHUNK = 36;
constexpr int NMT = 64 * NCHUNK;
constexpr int RWS = 5632;
constexpr int NSLOT = 137216;
constexpr float DN_ALPHA = 1.6817928305074290f;
constexpr int NTHR = 256;
constexpr int SMEM_BYTES = 65536 + 4096;
constexpr int META_OFF = 65536;
#define XCD_BAR_WORDS 3456
constexpr int CSTR = 32;
constexpr int BAR_TOTAL_WORDS = XCD_BAR_WORDS + 64;

typedef unsigned short bf16_t;
using bf16x8 = __attribute__((ext_vector_type(8))) short;
using f32x16 = __attribute__((ext_vector_type(16))) float;
using u32x4 = __attribute__((ext_vector_type(4))) unsigned;
using u32x2 = __attribute__((ext_vector_type(2))) unsigned;

struct Params {
  const float *x, *c, *ctx, *c_ctx, *ada_w, *ada_b, *ln_g, *ln_b, *mix_w_out, *att_w_in, *na_rpb, *qk_gain,
      *rec_w_in, *rwkv_mu, *rwkv_w0, *rwkv_w1, *rwkv_w2, *rwkv_a0, *rwkv_a1, *rwkv_a2, *rwkv_g1, *rwkv_g2,
      *rwkv_kvec, *rwkv_rk, *rwkv_gn, *mlstm_gate_b, *mlstm_norm, *moe_router, *moe_bias, *moe_w1, *moe_w3,
      *moe_w2, *shared_w1, *shared_w3, *shared_w2;
  float* out;
  bf16_t *Wt_att, *Wt_rec, *Wt_out, *Wt13, *Wt2, *Wl1, *Wl2;
  bf16_t *Zb, *L1;
  float *X, *MOD, *MODP, *GP, *msc, *lgate, *MSn, *Tb, *ROPE, *WrT;
  bf16_t *AB, *P, *RW, *MS, *ACT, *OUT2;
  int *cnt, *ltok, *tsl;
  unsigned* bar;
  int ph_lo, ph_hi;
};

typedef const Params __attribute__((address_space(4))) * KP;

__device__ __forceinline__ int modrow(int t) { return t < NL ? (t >> 11) : 8; }
__device__ __forceinline__ float silu_f(float x) { return x / (1.f + expf(-x)); }
__device__ __forceinline__ float sigm_f(float x) { return 1.f / (1.f + expf(-x)); }
__device__ __forceinline__ float softplus_f(float x) { return fmaxf(x, 0.f) + log1pf(expf(-fabsf(x))); }
template <int CTRL>
__device__ __forceinline__ float dppx(float x) {
  return __int_as_float(__builtin_amdgcn_update_dpp(0, __float_as_int(x), CTRL, 0xf, 0xf, true));
}
__device__ __forceinline__ float rdlane(float v, int l) {
  return __int_as_float(__builtin_amdgcn_readlane(__float_as_int(v), l));
}
__device__ __forceinline__ float wsum(float v) {
  v += dppx<0xB1>(v); v += dppx<0x4E>(v); v += dppx<0x141>(v); v += dppx<0x140>(v);
  return (rdlane(v, 0) + rdlane(v, 16)) + (rdlane(v, 32) + rdlane(v, 48));
}
__device__ __forceinline__ float wmax(float v) {
  v = fmaxf(v, dppx<0xB1>(v)); v = fmaxf(v, dppx<0x4E>(v)); v = fmaxf(v, dppx<0x141>(v)); v = fmaxf(v, dppx<0x140>(v));
  return fmaxf(fmaxf(rdlane(v, 0), rdlane(v, 16)), fmaxf(rdlane(v, 32), rdlane(v, 48)));
}
__device__ __forceinline__ int opaque_tid() {
  int t = threadIdx.x;
  asm volatile("" : "+v"(t));
  return t;
}
typedef __bf16 bf16x2_t __attribute__((ext_vector_type(2)));
typedef float f32x2_t __attribute__((ext_vector_type(2)));
__device__ __forceinline__ unsigned pk_bf16(float lo, float hi) {
  const f32x2_t v = {lo, hi};
  return __builtin_bit_cast(unsigned, __builtin_convertvector(v, bf16x2_t));
}
__device__ __forceinline__ bf16_t f2bf(float x) { return (bf16_t)(pk_bf16(x, 0.f) & 0xffffu); }
__device__ __forceinline__ float bf2f(bf16_t v) { return __uint_as_float((unsigned)v << 16); }
__device__ __forceinline__ float bflo(unsigned u) { return __uint_as_float(u << 16); }
__device__ __forceinline__ float bfhi(unsigned u) { return __uint_as_float(u & 0xffff0000u); }
__device__ __forceinline__ int scan_row(int dir, int b, int tau) {
  if (tau < CTXL) return NL + b * CTXL + (dir ? (CTXL - 1 - tau) : tau);
  int s = tau - CTXL;
  return b * SEQ + (dir ? (SEQ - 1 - s) : s);
}

template <class RowPtrA>
__device__ __forceinline__ void gemm128_main(int tid, RowPtrA rowA, const bf16_t* __restrict__ Bt, int K, int n0,
                                             char* lds, f32x16 (&acc)[2][2]) {
  const int lane = tid & 63, w = tid >> 6;
  const int wm = w >> 1, wn = w & 1, r = lane & 31, h = lane >> 5;
  const int c = tid & 7, sr = tid >> 3;
  const int lc = (c ^ ((tid >> 4) & 7)) * 8;
  const bf16_t* ap[4];
#pragma unroll
  for (int i = 0; i < 4; ++i) ap[i] = rowA(sr + 32 * i) + lc;
  const bf16_t* bp0 = Bt + (size_t)(n0 + sr) * K + lc;
  const int bstr = 32 * K;
#pragma unroll
  for (int mi = 0; mi < 2; ++mi)
#pragma unroll
    for (int ni = 0; ni < 2; ++ni)
#pragma unroll
      for (int q = 0; q < 16; ++q) acc[mi][ni][q] = 0.f;
  const int nk = K >> 6;
  auto issue = [&](int kt) {
    char* As = lds + (kt & 1) * 32768 + tid * 16;
    const int k0 = kt * 64;
#pragma unroll
    for (int i = 0; i < 4; ++i) {
      __builtin_amdgcn_global_load_lds((const unsigned*)(ap[i] + k0), (__attribute__((address_space(3))) unsigned*)(As + i * 4096), 16, 0, 0);
      __builtin_amdgcn_global_load_lds((const unsigned*)(bp0 + i * bstr + k0), (__attribute__((address_space(3))) unsigned*)(As + 16384 + i * 4096), 16, 0, 0);
    }
  };
  issue(0);
  const int sw = (r >> 1) & 7;
#pragma unroll 1
  for (int kt = 0; kt < nk; ++kt) {
    asm volatile("s_waitcnt vmcnt(0)" ::: "memory");
    __syncthreads();
    if (kt + 1 < nk) issue(kt + 1);
    const char* As = lds + (kt & 1) * 32768;
    const char* Ar = As + (wm * 64 + r) * 128;
    const char* Br = As + 16384 + (wn * 64 + r) * 128;
#pragma unroll
    for (int ks = 0; ks < 4; ++ks) {
      const int off = ((ks * 2 + h) ^ sw) * 16;
      const bf16x8 a0 = *(const bf16x8*)(Ar + off);
      const bf16x8 a1 = *(const bf16x8*)(Ar + 32 * 128 + off);
      const bf16x8 b0 = *(const bf16x8*)(Br + off);
      const bf16x8 b1 = *(const bf16x8*)(Br + 32 * 128 + off);
      acc[0][0] = __builtin_amdgcn_mfma_f32_32x32x16_bf16(a0, b0, acc[0][0], 0, 0, 0);
      acc[0][1] = __builtin_amdgcn_mfma_f32_32x32x16_bf16(a0, b1, acc[0][1], 0, 0, 0);
      acc[1][0] = __builtin_amdgcn_mfma_f32_32x32x16_bf16(a1, b0, acc[1][0], 0, 0, 0);
      acc[1][1] = __builtin_amdgcn_mfma_f32_32x32x16_bf16(a1, b1, acc[1][1], 0, 0, 0);
    }
  }
  __syncthreads();
}
using i64 = long;
typedef int i32x8 __attribute__((ext_vector_type(8)));
template <class RowPtrA8>
__device__ __forceinline__ void gemm128_fp8(int tid, RowPtrA8 rowA, const unsigned char* __restrict__ Bt, int K, int n0,
                                            char* lds, f32x16 (&acc)[2][2]) {
  const int lane = tid & 63, w = tid >> 6;
  const int wm = w >> 1, wn = w & 1, r = lane & 31, h = lane >> 5;
  const int c = tid & 7, sr = tid >> 3;
  const int lc = (c ^ ((tid >> 4) & 7)) * 16;
  const unsigned char* ap[4];
#pragma unroll
  for (int i = 0; i < 4; ++i) ap[i] = rowA(sr + 32 * i) + lc;
  const unsigned char* bp0 = Bt + (size_t)(n0 + sr) * K + lc;
  const int bstr = 32 * K;
#pragma unroll
  for (int mi = 0; mi < 2; ++mi)
#pragma unroll
    for (int ni = 0; ni < 2; ++ni)
#pragma unroll
      for (int q = 0; q < 16; ++q) acc[mi][ni][q] = 0.f;
  const int nk = K >> 7;
  auto issue = [&](int kt) {
    char* As = lds + (kt & 1) * 32768 + tid * 16;
    const int k0 = kt * 128;
#pragma unroll
    for (int i = 0; i < 4; ++i) {
      __builtin_amdgcn_global_load_lds((const unsigned*)(ap[i] + k0), (__attribute__((address_space(3))) unsigned*)(As + i * 4096), 16, 0, 0);
      __builtin_amdgcn_global_load_lds((const unsigned*)(bp0 + i * bstr + k0), (__attribute__((address_space(3))) unsigned*)(As + 16384 + i * 4096), 16, 0, 0);
    }
  };
  issue(0);
  if (nk > 1) issue(1);
  const int sw = (r >> 1) & 7;
#pragma unroll 1
  for (int kt = 0; kt < nk; ++kt) {
    if (kt == 0 && nk > 1) asm volatile("s_waitcnt vmcnt(8)" ::: "memory");
    else asm volatile("s_waitcnt vmcnt(0)" ::: "memory");
    __syncthreads();
    if (kt > 0 && kt + 1 < nk) issue(kt + 1);
    const char* As = lds + (kt & 1) * 32768;
    const char* Ar = As + (wm * 64 + r) * 128;
    const char* Br = As + 16384 + (wn * 64 + r) * 128;
#pragma unroll
    for (int pq = 0; pq < 2; ++pq) {
      const int o0 = ((4 * pq + 2 * h) ^ sw) * 16, o1 = ((4 * pq + 2 * h + 1) ^ sw) * 16;
      const u32x4 a0l = *(const u32x4*)(Ar + o0), a0h = *(const u32x4*)(Ar + o1);
      const u32x4 a1l = *(const u32x4*)(Ar + 32 * 128 + o0), a1h = *(const u32x4*)(Ar + 32 * 128 + o1);
      const u32x4 b0l = *(const u32x4*)(Br + o0), b0h = *(const u32x4*)(Br + o1);
      const u32x4 b1l = *(const u32x4*)(Br + 32 * 128 + o0), b1h = *(const u32x4*)(Br + 32 * 128 + o1);
      const i32x8 A0 = {(int)a0l.x, (int)a0l.y, (int)a0l.z, (int)a0l.w, (int)a0h.x, (int)a0h.y, (int)a0h.z, (int)a0h.w};
      const i32x8 A1 = {(int)a1l.x, (int)a1l.y, (int)a1l.z, (int)a1l.w, (int)a1h.x, (int)a1h.y, (int)a1h.z, (int)a1h.w};
      const i32x8 B0 = {(int)b0l.x, (int)b0l.y, (int)b0l.z, (int)b0l.w, (int)b0h.x, (int)b0h.y, (int)b0h.z, (int)b0h.w};
      const i32x8 B1 = {(int)b1l.x, (int)b1l.y, (int)b1l.z, (int)b1l.w, (int)b1h.x, (int)b1h.y, (int)b1h.z, (int)b1h.w};
      acc[0][0] = __builtin_amdgcn_mfma_scale_f32_32x32x64_f8f6f4(A0, B0, acc[0][0], 0, 0, 0, 0, 0, 0);
      acc[0][1] = __builtin_amdgcn_mfma_scale_f32_32x32x64_f8f6f4(A0, B1, acc[0][1], 0, 0, 0, 0, 0, 0);
      acc[1][0] = __builtin_amdgcn_mfma_scale_f32_32x32x64_f8f6f4(A1, B0, acc[1][0], 0, 0, 0, 0, 0, 0);
      acc[1][1] = __builtin_amdgcn_mfma_scale_f32_32x32x64_f8f6f4(A1, B1, acc[1][1], 0, 0, 0, 0, 0, 0);
    }
  }
  __syncthreads();
}
template <class F>
__device__ __forceinline__ void acc_foreach(int tid, const f32x16 (&acc)[2][2], F f) {
  const int lane = tid & 63, w = tid >> 6;
  const int wm = w >> 1, wn = w & 1, r = lane & 31, h = lane >> 5;
#pragma unroll
  for (int mi = 0; mi < 2; ++mi)
#pragma unroll
    for (int ni = 0; ni < 2; ++ni)
#pragma unroll
      for (int q = 0; q < 16; ++q) {
        const int row = wm * 64 + mi * 32 + (q & 3) + 8 * (q >> 2) + 4 * h;
        const int col = wn * 64 + ni * 32 + r;
        f(row, col, acc[mi][ni][q]);
        if ((q & 3) == 3) __builtin_amdgcn_sched_barrier(0);
      }
}

template <class RM>
__device__ __forceinline__ void tr_tile(int tid, const float* __restrict__ src, int N, int k0, int n0,
                                        bf16_t* __restrict__ dst, int K, RM rowmap, float* tile) {
  {
    const int tx = tid & 15, ty = tid >> 4;
    const int n = n0 + tx * 4;
#pragma unroll
    for (int i = 0; i < 4; ++i) {
      const int k = ty + 16 * i;
      float4 v = make_float4(0.f, 0.f, 0.f, 0.f);
      if (n < N) v = *(const float4*)(src + (size_t)(k0 + k) * N + n);
      tile[k * 65 + tx * 4 + 0] = v.x; tile[k * 65 + tx * 4 + 1] = v.y;
      tile[k * 65 + tx * 4 + 2] = v.z; tile[k * 65 + tx * 4 + 3] = v.w;
    }
  }
  __syncthreads();
  {
    const int kc = tid & 7;
#pragma unroll
    for (int i = 0; i < 2; ++i) {
      const int n = (tid >> 3) + 32 * i;
      if (n0 + n < N) {
        float v[8];
#pragma unroll
        for (int q = 0; q < 8; ++q) v[q] = tile[(kc * 8 + q) * 65 + n];
        u32x4 o;
        o.x = pk_bf16(v[0], v[1]); o.y = pk_bf16(v[2], v[3]); o.z = pk_bf16(v[4], v[5]); o.w = pk_bf16(v[6], v[7]);
        *(u32x4*)(dst + (size_t)rowmap(n0 + n) * K + k0 + kc * 8) = o;
      }
    }
  }
  __syncthreads();
}

constexpr float W8_SCALE = 32.f, W8_INV = 1.f / 32.f;
__device__ __forceinline__ unsigned pk_fp8x4(float a, float b, float c, float d) {
  int r = __builtin_amdgcn_cvt_pk_fp8_f32(a, b, 0, false);
  r = __builtin_amdgcn_cvt_pk_fp8_f32(c, d, r, true);
  return (unsigned)r;
}
__device__ __forceinline__ unsigned pk_fp8x4c(float a, float b, float c, float d) {
  constexpr float M = 448.f;
  return pk_fp8x4(fminf(fmaxf(a, -M), M), fminf(fmaxf(b, -M), M), fminf(fmaxf(c, -M), M), fminf(fmaxf(d, -M), M));
}
template <class RM>
__device__ __forceinline__ void tr_tile_fp8(int tid, const float* __restrict__ src, int N, int k0, int n0,
                                            unsigned char* __restrict__ dst, int K, RM rowmap, float* tile) {
  {
    const int tx = tid & 15, ty = tid >> 4;
    const int n = n0 + tx * 4;
#pragma unroll
    for (int i = 0; i < 4; ++i) {
      const int k = ty + 16 * i;
      float4 v = make_float4(0.f, 0.f, 0.f, 0.f);
      if (n < N) v = *(const float4*)(src + (size_t)(k0 + k) * N + n);
      tile[k * 65 + tx * 4 + 0] = v.x; tile[k * 65 + tx * 4 + 1] = v.y;
      tile[k * 65 + tx * 4 + 2] = v.z; tile[k * 65 + tx * 4 + 3] = v.w;
    }
  }
  __syncthreads();
  {
    const int kc = tid & 3, n = tid >> 2;
    float v[16];
#pragma unroll
    for (int q = 0; q < 16; ++q) v[q] = tile[(kc * 16 + q) * 65 + n] * W8_SCALE;
    u32x4 o;
    o.x = pk_fp8x4c(v[0], v[1], v[2], v[3]); o.y = pk_fp8x4c(v[4], v[5], v[6], v[7]);
    o.z = pk_fp8x4c(v[8], v[9], v[10], v[11]); o.w = pk_fp8x4c(v[12], v[13], v[14], v[15]);
    *(u32x4*)(dst + (size_t)rowmap(n0 + n) * K + k0 + kc * 16) = o;
  }
  __syncthreads();
}

constexpr int CJ0 = 1152, CJ1 = CJ0 + 2080, CJ2 = CJ1 + 1024, CJ3 = CJ2 + 33280, CJ4 = CJ3 + 16640;
__device__ void convert_job(KP p, int job, float* sm, int tid) {
  if (job < CJ0) {
    const int j = job / 576, rem = job % 576, kt = rem / 36, nt = rem % 36;
    tr_tile_fp8(tid, p->att_w_in + (size_t)j * 1024 * ATT_N, ATT_N, kt * 64, nt * 64, (unsigned char*)p->Wt_att + (size_t)j * ATT_N * 1024,
                1024, [](int n) { return n; }, sm);
  } else if (job < CJ1) {
    const int q = job - CJ0;
    const int j = q / 1040, rem = q % 1040, kt = rem / 65, nt = rem % 65;
    tr_tile_fp8(tid, p->rec_w_in + (size_t)j * 1024 * REC_N, REC_N, kt * 64, nt * 64, (unsigned char*)p->Wt_rec + (size_t)j * REC_NP * 1024,
                1024, [](int n) { return n; }, sm);
  } else if (job < CJ2) {
    const int q = job - CJ1;
    const int i = q >> 8, rem = q & 255, kt = rem >> 4, nt = rem & 15;
    tr_tile_fp8(tid, p->mix_w_out + (size_t)i * 1024 * 1024, 1024, kt * 64, nt * 64, (unsigned char*)p->Wt_out + (size_t)i * 1024 * 1024,
                1024, [](int n) { return n; }, sm);
  } else if (job < CJ3) {
    const int q = job - CJ2;
    const int le = q >> 7, rem = q & 127;
    const int which = rem >> 6, kt = (rem >> 2) & 15, nt = rem & 3;
    const int layer = le / 65, e = le % 65;
    const float* src;
    if (e < 64) src = (which ? p->moe_w3 : p->moe_w1) + (size_t)(layer * 64 + e) * 1024 * 256;
    else src = (which ? p->shared_w3 : p->shared_w1) + (size_t)layer * 1024 * 256;
    tr_tile_fp8(tid, src, 256, kt * 64, nt * 64, (unsigned char*)p->Wt13 + (size_t)le * 512 * 1024, 1024,
                [which](int n) { return 64 * (n >> 5) + which * 32 + (n & 31); }, sm);
  } else {
    const int q = job - CJ3;
    const int le = q >> 6, rem = q & 63;
    const int kt = rem >> 4, nt = rem & 15;
    const int layer = le / 65, e = le % 65;
    const float* src = e < 64 ? p->moe_w2 + (size_t)(layer * 64 + e) * 256 * 1024 : p->shared_w2 + (size_t)layer * 256 * 1024;
    tr_tile_fp8(tid, src, 1024, kt * 64, nt * 64, (unsigned char*)p->Wt2 + (size_t)le * 1024 * 256, 256, [](int n) { return n; }, sm);
  }
}
__device__ __forceinline__ int conv_stage_total(int stage) {
  return stage == 0 ? (576 + 1040 + 512 + 8320 + 4160) : (stage == 1 ? (576 + 1040 + 256 + 16640 + 8320) : (256 + 8320 + 4160));
}
__device__ __forceinline__ int conv_stage_job(int stage, int q) {
  if (stage == 0) {
    if (q < 8320) return CJ2 + q;  q -= 8320;
    if (q < 4160) return CJ3 + q;  q -= 4160;
    if (q < 576) return q;  q -= 576;
    if (q < 1040) return CJ0 + q;  q -= 1040;
    return CJ1 + q;
  } else if (stage == 1) {
    if (q < 8320) return CJ2 + 8320 + q;  q -= 8320;
    if (q < 4160) return CJ3 + 4160 + q;  q -= 4160;
    if (q < 576) return 576 + q;  q -= 576;
    if (q < 256) return CJ1 + 512 + q;  q -= 256;
    if (q < 8320) return CJ2 + 16640 + q;  q -= 8320;
    if (q < 4160) return CJ3 + 8320 + q;  q -= 4160;
    return CJ0 + 1040 + q;
  }
  if (q < 256) return CJ1 + 768 + q;  q -= 256;
  if (q < 8320) return CJ2 + 24960 + q;  q -= 8320;
  return CJ3 + 12480 + q;
}

struct CvDesc { const float* src; unsigned char* dst; int N, K, k0, n0, which; };
__device__ __forceinline__ bool conv_desc_fp8(KP p, int job, CvDesc& d) {
  if (job < CJ2) return false;
  if (job < CJ3) {
    const int q = job - CJ2;
    const int le = q >> 7, rem = q & 127;
    const int which = rem >> 6, kt = (rem >> 2) & 15, nt = rem & 3;
    const int layer = le / 65, e = le % 65;
    if (e < 64) d.src = (which ? p->moe_w3 : p->moe_w1) + (size_t)(layer * 64 + e) * 1024 * 256;
    else d.src = (which ? p->shared_w3 : p->shared_w1) + (size_t)layer * 1024 * 256;
    d.dst = (unsigned char*)p->Wt13 + (size_t)le * 512 * 1024;
    d.N = 256; d.K = 1024; d.k0 = kt * 64; d.n0 = nt * 64; d.which = which;
  } else {
    const int q = job - CJ3;
    const int le = q >> 6, rem = q & 63;
    const int kt = rem >> 4, nt = rem & 15;
    const int layer = le / 65, e = le % 65;
    d.src = e < 64 ? p->moe_w2 + (size_t)(layer * 64 + e) * 256 * 1024 : p->shared_w2 + (size_t)layer * 256 * 1024;
    d.dst = (unsigned char*)p->Wt2 + (size_t)le * 1024 * 256;
    d.N = 1024; d.K = 256; d.k0 = kt * 64; d.n0 = nt * 64; d.which = -1;
  }
  return true;
}
typedef float cvf4 __attribute__((ext_vector_type(4)));
__device__ __forceinline__ void cv_load(const CvDesc& d, int tid, cvf4& v0, cvf4& v1, cvf4& v2, cvf4& v3) {
  const int tx = tid & 15, ty = tid >> 4;
  const float* s0 = d.src + (size_t)(d.k0 + ty) * d.N + d.n0 + tx * 4;
  v0 = *(const cvf4*)(s0);
  v1 = *(const cvf4*)(s0 + (size_t)16 * d.N);
  v2 = *(const cvf4*)(s0 + (size_t)32 * d.N);
  v3 = *(const cvf4*)(s0 + (size_t)48 * d.N);
}
__device__ __forceinline__ void cv_emit(const CvDesc& d, int tid, const cvf4 v0, const cvf4 v1, const cvf4 v2, const cvf4 v3, float* tile) {
  {
    const int tx = tid & 15, ty = tid >> 4;
    float* t0 = tile + ty * 65 + tx * 4;
    t0[0] = v0.x; t0[1] = v0.y; t0[2] = v0.z; t0[3] = v0.w;
    t0[16 * 65 + 0] = v1.x; t0[16 * 65 + 1] = v1.y; t0[16 * 65 + 2] = v1.z; t0[16 * 65 + 3] = v1.w;
    t0[32 * 65 + 0] = v2.x; t0[32 * 65 + 1] = v2.y; t0[32 * 65 + 2] = v2.z; t0[32 * 65 + 3] = v2.w;
    t0[48 * 65 + 0] = v3.x; t0[48 * 65 + 1] = v3.y; t0[48 * 65 + 2] = v3.z; t0[48 * 65 + 3] = v3.w;
  }
  __syncthreads();
  {
    const int kc = tid & 3, n = tid >> 2;
    float v[16];
#pragma unroll
    for (int q = 0; q < 16; ++q) v[q] = tile[(kc * 16 + q) * 65 + n] * W8_SCALE;
    u32x4 o;
    o.x = pk_fp8x4c(v[0], v[1], v[2], v[3]); o.y = pk_fp8x4c(v[4], v[5], v[6], v[7]);
    o.z = pk_fp8x4c(v[8], v[9], v[10], v[11]); o.w = pk_fp8x4c(v[12], v[13], v[14], v[15]);
    const int nn = d.n0 + n;
    const int row = d.which >= 0 ? 64 * (nn >> 5) + d.which * 32 + (nn & 31) : nn;
    *(u32x4*)(d.dst + (size_t)row * d.K + d.k0 + kc * 16) = o;
  }
  __syncthreads();
}
__device__ __forceinline__ void convert_run(KP p, int stage, int jj, int j1, float* sm, int tid) {
  CvDesc d, dn;
  cvf4 a0, a1, a2, a3, b0, b1, b2, b3;
  bool cur = false;
#pragma unroll 1
  for (; jj < j1; ++jj) {
    const int job = conv_stage_job(stage, jj);
    if (!cur) {
      if (!conv_desc_fp8(p, job, d)) { convert_job(p, job, sm, tid); continue; }
      cv_load(d, tid, a0, a1, a2, a3);
    }
    bool nxt = false;
    if (jj + 1 < j1) {
      nxt = conv_desc_fp8(p, conv_stage_job(stage, jj + 1), dn);
      if (nxt) cv_load(dn, tid, b0, b1, b2, b3);
    }
    cv_emit(d, tid, a0, a1, a2, a3, sm);
    if (nxt) { d = dn; a0 = b0; a1 = b1; a2 = b2; a3 = b3; }
    cur = nxt;
  }
}

__device__ void ph_init(KP p, char* smc) {
  float* sm = (float*)smc;
  const int tid = opaque_tid();
  {
    const size_t n4a = (size_t)NL * DM / 4, n4b = (size_t)NC * DM / 4;
    const float4* xs = (const float4*)p->x;
    const float4* cs = (const float4*)p->ctx;
    float4* X4 = (float4*)p->X;
    for (size_t i = (size_t)blockIdx.x * NTHR + tid; i < n4a + n4b; i += (size_t)gridDim.x * NTHR)
      X4[i] = i < n4a ? xs[i] : cs[i - n4a];
  }
  for (int tile = blockIdx.x; tile < 96 * 8; tile += gridDim.x) {
    const int ct = tile >> 3, ks = tile & 7;
    for (int i = tid; i < 9 * 128; i += NTHR) {
      const int r = i >> 7, k = ks * 128 + (i & 127);
      const float v = r < 8 ? p->c[r * 1024 + k] : p->c_ctx[k];
      sm[i] = silu_f(v);
    }
    __syncthreads();
    const int col = ct * 256 + tid;
    const int layer = col / 6144, n = col % 6144;
    const float* W = p->ada_w + ((size_t)layer * 1024 + ks * 128) * 6144 + n;
    float acc[9];
#pragma unroll
    for (int r = 0; r < 9; ++r) acc[r] = 0.f;
#pragma unroll 4
    for (int k = 0; k < 128; ++k) {
      const float w = W[(size_t)k * 6144];
#pragma unroll
      for (int r = 0; r < 9; ++r) acc[r] = fmaf(sm[r * 128 + k], w, acc[r]);
    }
#pragma unroll
    for (int r = 0; r < 9; ++r) p->MODP[((size_t)(ks * 4 + layer) * 9 + r) * 6144 + n] = acc[r];
    __syncthreads();
  }
  {
    const int total = conv_stage_total(0), chunk = (total + gridDim.x - 1) / gridDim.x;
    const int lo = min((int)blockIdx.x * chunk, total), hi = min(lo + chunk, total);
    __syncthreads();
    convert_run(p, 0, lo, hi, sm, tid);
  }
  for (int i = blockIdx.x * NTHR + tid; i < 2 * 3 * 128 * 512; i += gridDim.x * NTHR) {
    const int k = i & 511, n = (i >> 9) & 127, wj = i >> 16;
    const int j = wj / 3, which = wj % 3;
    float v = 0.f;
    if (which < 2) {
      if (n < 64) v = (which ? p->rwkv_a1 : p->rwkv_w1)[((size_t)(j * 2 + (n >> 5)) * 512 + k) * 32 + (n & 31)];
    } else if (n < 96) v = p->rwkv_g1[((size_t)j * 512 + k) * 96 + n];
    p->Wl1[i] = f2bf(v);
  }
  for (int i = blockIdx.x * NTHR + tid; i < 2 * 2560 * 128; i += gridDim.x * NTHR) {
    const int k = i & 127, n = (i >> 7) % 2560, j = i / (2560 * 128);
    float v = 0.f;
    if (n < 2048) {
      const int d = (n >> 9) & 1, c = n & 511;
      if (k < 64 && (k >> 5) == d) v = (n < 1024 ? p->rwkv_w2 : p->rwkv_a2)[((size_t)(j * 2 + d) * 32 + (k & 31)) * 512 + c];
    } else if (k < 96) v = p->rwkv_g2[((size_t)j * 96 + k) * 512 + (n - 2048)];
    p->Wl2[i] = f2bf(v);
  }
  for (int i = blockIdx.x * NTHR + tid; i < 4 * 64 * 1024; i += gridDim.x * NTHR) {
    const int k = i & 1023, n = (i >> 10) & 63, l = i >> 16;
    p->WrT[i] = p->moe_router[((size_t)l * 1024 + k) * 64 + n];
  }
  for (int i = blockIdx.x * NTHR + tid; i < 64 * 16; i += gridDim.x * NTHR) {
    const int pos = i >> 4, f = i & 15;
    const float ang = (float)pos * powf(10000.f, -(float)f / 16.f);
    p->ROPE[2 * i] = cosf(ang);
    p->ROPE[2 * i + 1] = sinf(ang);
  }
}

__device__ void ph_mod_h(KP p, char* smc) {
  float* sm = (float*)smc;
  const int tid = opaque_tid();
  for (int i = blockIdx.x * NTHR + tid; i < 4 * 9 * 6144; i += gridDim.x * NTHR) {
    const int layer = i / (9 * 6144), rem = i % (9 * 6144), n = rem % 6144;
    float s = p->ada_b[layer * 6144 + n];
#pragma unroll
    for (int ks = 0; ks < 8; ++ks) s += p->MODP[(size_t)(ks * 4 + layer) * 9 * 6144 + rem];
    p->MOD[i] = s;
  }
  const int lane = tid & 63, wave = tid >> 6;
  const int per = (((NT + gridDim.x - 1) / gridDim.x) + 3) & ~3;
  const int t0 = blockIdx.x * per, t1 = min(NT, t0 + per);
  int cur = -1;
  for (int tb = t0; tb < t1; tb += 4) {
    const int mr = modrow(tb);
    if (mr != cur) {
      __syncthreads();
      for (int n = tid; n < 2048; n += NTHR) {
        float a = p->ada_b[n];
#pragma unroll
        for (int ks = 0; ks < 8; ++ks) a += p->MODP[((size_t)(ks * 4) * 9 + mr) * 6144 + n];
        sm[n] = a;
      }
      cur = mr;
      __syncthreads();
    }
    const int t = tb + wave;
    if (t < t1) {
      const float* src = t < NL ? p->x + (size_t)t * DM : p->ctx + (size_t)(t - NL) * DM;
#pragma unroll
      for (int i = 0; i < 4; ++i) {
        const int n = i * 256 + lane * 4;
        const float4 xv = *(const float4*)(src + n);
        const float4 sh = *(const float4*)(sm + n);
        const float4 sc = *(const float4*)(sm + 1024 + n);
        *(unsigned*)((unsigned char*)p->AB + (size_t)t * DM + n) =
            pk_fp8x4c(xv.x * (1.f + sc.x) + sh.x, xv.y * (1.f + sc.y) + sh.y, xv.z * (1.f + sc.z) + sh.z, xv.w * (1.f + sc.w) + sh.w);
      }
    }
  }
}

typedef short v4i16_t __attribute__((ext_vector_type(4)));
using s16x4 = __attribute__((ext_vector_type(4))) short;
__device__ __forceinline__ s16x4 vtr(const char* p) {
  return __builtin_bit_cast(s16x4, __builtin_amdgcn_ds_read_tr16_b64_v4i16((__attribute__((address_space(3))) v4i16_t*)p));
}
#define MFMA32(a, b, c) __builtin_amdgcn_mfma_f32_32x32x16_bf16(a, b, c, 0, 0, 0)
__device__ void ph_attention(KP p, int layer, bool keep, char* lds) {
  const int tid = opaque_tid();
  const int lane = tid & 63, w = tid >> 6, r32 = lane & 31, hi = lane >> 5;
  const int j = layer >> 1;
  float* bias_lds = (float*)(lds + 32768 + 1024);
  const int n_gqa = 1024, n_na = 1024, n_cb = keep ? 128 : 0, n_ca = keep ? 128 : 0;
  const int total = n_gqa + n_na + n_cb + n_ca;
  constexpr float LOG2E = 1.4426950408889634f;
  constexpr float C2 = 0.125f * LOG2E;
  const int c = tid & 7, sr = tid >> 3;
  const int kso = (c ^ ((tid >> 4) & 7)) * 16;
  const int vso = (c >> 2) * 4096 + (c & 3) * 16;
  const int sw = (r32 >> 1) & 7;
  for (int vitem = blockIdx.x; vitem < total; vitem += gridDim.x) {
    int item = vitem;
    if (gridDim.x == 512) {
      const int cls0 = vitem < n_gqa ? 0 : (vitem < n_gqa + n_na ? n_gqa : (vitem < n_gqa + n_na + n_cb ? n_gqa + n_na : n_gqa + n_na + n_cb));
      const int vl = vitem - cls0, b9 = vl & 511, r9 = vl >> 9;
      item = cls0 + (cls0 < n_gqa + n_na ? 128 * (b9 & 7) + 64 * r9 + (b9 >> 3) : 16 * (b9 & 7) + (b9 >> 3));
    }
    int b, qrow0, qoff, koff, voff, ocol, lat_tiles, lat_row0;
    bool na = false;
    int r_w = 0, start_w = 0, ru0 = 0, hN = 0;
    if (item < n_gqa) {
      b = item >> 7;
      const int g = (item >> 6) & 1, tt = item & 63;
      qrow0 = b * SEQ + tt * 32; qoff = 1536 + (g * 4 + w) * 64; koff = 2048 + g * 64; voff = 2176 + g * 64;
      ocol = 512 + (g * 4 + w) * 64; lat_tiles = 32; lat_row0 = b * SEQ;
    } else if (item < n_gqa + n_na) {
      const int it = item - n_gqa;
      b = it >> 7; hN = (it >> 4) & 7;
      const int rp = it & 15;
      na = true; r_w = 2 * rp + (w >> 1);
      qrow0 = b * SEQ + r_w * 64 + (w & 1) * 32; qoff = hN * 64; koff = 512 + hN * 64; voff = 1024 + hN * 64; ocol = hN * 64;
      const int s0 = min(max(2 * rp - 4, 0), 24), s1 = min(max(2 * rp - 3, 0), 24);
      start_w = (w >> 1) ? s1 : s0; ru0 = s0; lat_tiles = (s1 != s0) ? 9 : 8; lat_row0 = b * SEQ + ru0 * 64;
    } else if (item < n_gqa + n_na + n_cb) {
      const int it = item - n_gqa - n_na;
      b = it >> 4;
      const int g = (it >> 3) & 1, tt = it & 7;
      qrow0 = NL + b * CTXL + tt * 32; qoff = 1536 + (g * 4 + w) * 64; koff = 2048 + g * 64; voff = 2176 + g * 64;
      ocol = 512 + (g * 4 + w) * 64; lat_tiles = 0; lat_row0 = 0;
    } else {
      const int it = item - n_gqa - n_na - n_cb;
      b = it >> 4;
      const int h = (it >> 1) & 7, half = it & 1;
      qrow0 = NL + b * CTXL + half * 128 + w * 32; qoff = h * 64; koff = 512 + h * 64; voff = 1024 + h * 64; ocol = h * 64;
      lat_tiles = 0; lat_row0 = 0;
    }
    const int ctx_row0 = NL + b * CTXL, ntiles = lat_tiles + 4;
    if (na)
      for (int i = tid; i < 465; i += NTHR) bias_lds[i] = p->na_rpb[(j * 8 + hN) * 465 + i] * LOG2E;
    bf16x8 qf[4];
    {
      const bf16_t* qp = p->P + (size_t)(qrow0 + r32) * LDP + qoff + hi * 8;
#pragma unroll
      for (int d0 = 0; d0 < 4; ++d0) qf[d0] = *(const bf16x8*)(qp + d0 * 16);
    }
    f32x16 o0, o1;
#pragma unroll
    for (int q = 0; q < 16; ++q) { o0[q] = 0.f; o1[q] = 0.f; }
    float m = -INFINITY, l = 0.f;
    u32x4 kr0, kr1, vr0, vr1;
    auto gload = [&](int t) {
      const int row0 = t < lat_tiles ? lat_row0 + 64 * t : ctx_row0 + 64 * (t - lat_tiles);
      const bf16_t* base = p->P + (size_t)(row0 + sr) * LDP + c * 8;
      kr0 = *(const u32x4*)(base + koff); kr1 = *(const u32x4*)(base + (size_t)32 * LDP + koff);
      vr0 = *(const u32x4*)(base + voff); vr1 = *(const u32x4*)(base + (size_t)32 * LDP + voff);
    };
    auto swrite = [&](int buf) {
      char* Kb = lds + buf * 16384;
      char* Vb = Kb + 8192;
      *(u32x4*)(Kb + sr * 128 + kso) = kr0; *(u32x4*)(Kb + (sr + 32) * 128 + kso) = kr1;
      *(u32x4*)(Vb + vso + sr * 64) = vr0; *(u32x4*)(Vb + vso + (sr + 32) * 64) = vr1;
    };
    gload(0);
    swrite(0);
    for (int t = 0; t < ntiles; ++t) {
      __syncthreads();
      if (t + 1 < ntiles) gload(t + 1);
      const bool na_tile = na && t < lat_tiles;
      const int kr = ru0 + t;
      const bool part = !na_tile || (kr >= start_w && kr < start_w + 8);
      if (part) {
        const char* Ks = lds + (t & 1) * 16384;
        const char* Vs = Ks + 8192;
        f32x16 s0, s1;
#pragma unroll
        for (int q = 0; q < 16; ++q) { s0[q] = 0.f; s1[q] = 0.f; }
#pragma unroll
        for (int d0 = 0; d0 < 4; ++d0) {
          const int off = ((2 * d0 + hi) ^ sw) * 16;
          const bf16x8 k0 = *(const bf16x8*)(Ks + r32 * 128 + off);
          const bf16x8 k1 = *(const bf16x8*)(Ks + (32 + r32) * 128 + off);
          s0 = MFMA32(k0, qf[d0], s0);
          s1 = MFMA32(k1, qf[d0], s1);
        }
        float mx = -INFINITY;
        if (na_tile) {
          const int cq = (w & 1) * 32 + r32;
          const int c0 = min(max(cq - 8, 0), 48);
          const float* brow = bias_lds + (kr - r_w + 7) * 31 + (15 - cq);
#pragma unroll
          for (int q = 0; q < 16; ++q) {
            const int kc = (q & 3) + 8 * (q >> 2) + 4 * hi;
            const float v0 = ((unsigned)(kc - c0) < 16u) ? fmaf(s0[q], C2, brow[kc]) : -INFINITY;
            const float v1 = ((unsigned)(kc + 32 - c0) < 16u) ? fmaf(s1[q], C2, brow[kc + 32]) : -INFINITY;
            s0[q] = v0; s1[q] = v1;
            mx = fmaxf(mx, fmaxf(v0, v1));
          }
        } else {
#pragma unroll
          for (int q = 0; q < 16; ++q) {
            s0[q] *= C2; s1[q] *= C2;
            mx = fmaxf(mx, fmaxf(s0[q], s1[q]));
          }
        }
        {
          auto rr = __builtin_amdgcn_permlane32_swap(__float_as_uint(mx), __float_as_uint(mx), false, false);
          mx = fmaxf(__uint_as_float(rr[0]), __uint_as_float(rr[1]));
        }
        const float mnew = fmaxf(m, mx);
        const float alpha = __builtin_amdgcn_exp2f(m - mnew);
        float ls = 0.f;
#pragma unroll
        for (int q = 0; q < 16; ++q) {
          s0[q] = __builtin_amdgcn_exp2f(s0[q] - mnew);
          s1[q] = __builtin_amdgcn_exp2f(s1[q] - mnew);
          ls += s0[q] + s1[q];
        }
        l = l * alpha + ls;
        m = mnew;
#pragma unroll
        for (int q = 0; q < 16; ++q) { o0[q] *= alpha; o1[q] *= alpha; }
        bf16x8 pf[4];
#pragma unroll
        for (int s = 0; s < 4; ++s) {
          const int u = (s & 1) * 8;
          u32x4 tpk;
          if (s < 2) {
            tpk.x = pk_bf16(s0[u + 0], s0[u + 1]); tpk.y = pk_bf16(s0[u + 2], s0[u + 3]);
            tpk.z = pk_bf16(s0[u + 4], s0[u + 5]); tpk.w = pk_bf16(s0[u + 6], s0[u + 7]);
          } else {
            tpk.x = pk_bf16(s1[u + 0], s1[u + 1]); tpk.y = pk_bf16(s1[u + 2], s1[u + 3]);
            tpk.z = pk_bf16(s1[u + 4], s1[u + 5]); tpk.w = pk_bf16(s1[u + 6], s1[u + 7]);
          }
          pf[s] = __builtin_bit_cast(bf16x8, tpk);
        }
        const char* vb = Vs + ((lane >> 4) & 1) * 32 + (lane & 3) * 8 + ((lane & 15) >> 2) * 64 + hi * 256;
#pragma unroll
        for (int s = 0; s < 4; ++s) {
          const s16x4 a00 = vtr(vb + (16 * s) * 64), a01 = vtr(vb + (16 * s + 8) * 64);
          const s16x4 a10 = vtr(vb + 4096 + (16 * s) * 64), a11 = vtr(vb + 4096 + (16 * s + 8) * 64);
          const bf16x8 A0 = __builtin_shufflevector(a00, a01, 0, 1, 2, 3, 4, 5, 6, 7);
          const bf16x8 A1 = __builtin_shufflevector(a10, a11, 0, 1, 2, 3, 4, 5, 6, 7);
          o0 = MFMA32(A0, pf[s], o0);
          o1 = MFMA32(A1, pf[s], o1);
        }
      }
      if (t + 1 < ntiles) swrite((t + 1) & 1);
    }
    __syncthreads();
    const float lt = l + __shfl_xor(l, 32);
    const float inv = 1.f / lt;
    unsigned char* op = (unsigned char*)p->AB + (size_t)(qrow0 + r32) * DM + ocol + 4 * hi;
#pragma unroll
    for (int g = 0; g < 4; ++g) {
      *(unsigned*)(op + 8 * g) = pk_fp8x4c(o0[4 * g] * inv, o0[4 * g + 1] * inv, o0[4 * g + 2] * inv, o0[4 * g + 3] * inv);
      *(unsigned*)(op + 32 + 8 * g) = pk_fp8x4c(o1[4 * g] * inv, o1[4 * g + 1] * inv, o1[4 * g + 2] * inv, o1[4 * g + 3] * inv);
    }
  }
}

__device__ void ph_rwkv_mix(KP p, int layer) {
  const int j = layer >> 1;
  const int tid = opaque_tid();
  const int lane = tid & 63, wave = tid >> 6;
  const float* mu = p->rwkv_mu + j * 6 * 512;
  const int c0 = lane * 8;
  auto unpack = [](const u32x4 u, float (&f)[8]) {
    f[0] = bflo(u.x); f[1] = bfhi(u.x); f[2] = bflo(u.y); f[3] = bfhi(u.y);
    f[4] = bflo(u.z); f[5] = bfhi(u.z); f[6] = bflo(u.w); f[7] = bfhi(u.w);
  };
  auto pack = [](const float (&f)[8]) {
    u32x4 o;
    o.x = pk_bf16(f[0], f[1]); o.y = pk_bf16(f[2], f[3]); o.z = pk_bf16(f[4], f[5]); o.w = pk_bf16(f[6], f[7]);
    return o;
  };
  for (int t = blockIdx.x * 4 + wave; t < NT; t += gridDim.x * 4) {
    bool hasp, hasn;
    if (t < NL) { int s = t & 2047; hasp = s > 0; hasn = s < SEQ - 1; }
    else { int s = (t - NL) & 255; hasp = s > 0; hasn = s < CTXL - 1; }
    const bf16_t* pt = p->P + (size_t)t * LDP + c0;
    bf16_t* rw = p->RW + (size_t)t * RWS + c0;
    bf16_t* zb = p->Zb + (size_t)t * 1536 + c0;
    const u32x4 zero = {0u, 0u, 0u, 0u};
#pragma unroll
    for (int q = 0; q < 4; ++q) {
      float cur[8], pv[8], nx[8], d[8];
      unpack(*(const u32x4*)(pt + q * 512), cur);
      unpack(hasp ? *(const u32x4*)(pt + q * 512 - LDP) : zero, pv);
      unpack(hasn ? *(const u32x4*)(pt + q * 512 + LDP) : zero, nx);
#pragma unroll
      for (int e = 0; e < 8; ++e) d[e] = 0.5f * (pv[e] + nx[e]) - cur[e];
      if (q < 3) {
        float o[8];
        const float* m = mu + q * 512 + c0;
#pragma unroll
        for (int e = 0; e < 8; ++e) o[e] = cur[e] + d[e] * m[e];
        if (q == 0) *(u32x4*)(rw) = pack(o);
        else if (q == 2) *(u32x4*)(rw + 512) = pack(o);
        else {
          *(u32x4*)(rw + 10 * 512) = pack(o);
          float kk[8], ss = 0.f;
          const float* kv0 = p->rwkv_kvec + (j * 2 + 0) * 512 + c0;
#pragma unroll
          for (int e = 0; e < 8; ++e) { kk[e] = o[e] * kv0[e]; ss += kk[e] * kk[e]; }
          ss += dppx<0xB1>(ss); ss += dppx<0x4E>(ss); ss += dppx<0x141>(ss);
          const float rn = rsqrtf(fmaxf(ss, 1e-24f));
#pragma unroll
          for (int e = 0; e < 8; ++e) kk[e] *= rn;
          *(u32x4*)(rw + 2 * 512) = pack(kk);
        }
      } else {
#pragma unroll
        for (int z = 0; z < 3; ++z) {
          float o[8];
          const float* m = mu + (3 + z) * 512 + c0;
#pragma unroll
          for (int e = 0; e < 8; ++e) o[e] = cur[e] + d[e] * m[e];
          *(u32x4*)(zb + z * 512) = pack(o);
        }
      }
    }
  }
}

constexpr int RS_STEP = 384;
constexpr int RS_TB = 16;
struct RwkvStage { u32x2 r, kk, e, ke, a, v; };
__device__ void rwkv_unit(KP p, int unit, float* sm, int tid) {
  const int ch = unit >> 1, hf = unit & 1;
  const int dir = ch >> 6, b = (ch >> 3) & 7, h = ch & 7;
  const int lane = tid & 63, w = tid >> 6, rl = lane >> 3, ks = lane & 7;
  float* ybuf = sm + 2 * RS_TB * RS_STEP;
  const int ss = tid >> 4, kq = tid & 15;
  auto gload = [&](int n, RwkvStage& g) {
    const int row = scan_row(dir, b, n * RS_TB + ss);
    const bf16_t* base = p->RW + (size_t)row * RWS + h * 64 + kq * 4;
    g.r = *(const u32x2*)(base);
    g.kk = *(const u32x2*)(base + 2 * 512);
    g.e = *(const u32x2*)(base + (3 + dir) * 512);
    g.ke = *(const u32x2*)(base + (5 + dir) * 512);
    g.a = *(const u32x2*)(base + (7 + dir) * 512);
    g.v = *(const u32x2*)(p->RW + (size_t)row * RWS + 512 + h * 64 + hf * 32 + (kq & 7) * 4);
  };
  auto swrite = [&](int buf, const RwkvStage& g) {
    float* sp = sm + (buf * RS_TB + ss) * RS_STEP;
    const float r0 = bflo(g.r.x), r1 = bfhi(g.r.x), r2 = bflo(g.r.y), r3 = bfhi(g.r.y);
    const float k0 = bflo(g.kk.x), k1 = bfhi(g.kk.x), k2 = bflo(g.kk.y), k3 = bfhi(g.kk.y);
    const float w0 = __expf(-bflo(g.e.x)), w1 = __expf(-bfhi(g.e.x)), w2 = __expf(-bflo(g.e.y)), w3 = __expf(-bfhi(g.e.y));
    const float e0 = bflo(g.ke.x), e1 = bfhi(g.ke.x), e2 = bflo(g.ke.y), e3 = bfhi(g.ke.y);
    const float a0 = k0 * bflo(g.a.x), a1 = k1 * bfhi(g.a.x), a2 = k2 * bflo(g.a.y), a3 = k3 * bfhi(g.a.y);
    *(float4*)(sp + kq * 4) = make_float4(k0, k1, k2, k3);
    *(float4*)(sp + 64 + kq * 4) = make_float4(w0 * r0, w1 * r1, w2 * r2, w3 * r3);
    *(float4*)(sp + 128 + kq * 4) = make_float4(w0, w1, w2, w3);
    *(float4*)(sp + 192 + kq * 4) = make_float4(a0, a1, a2, a3);
    *(float4*)(sp + 256 + kq * 4) = make_float4(e0, e1, e2, e3);
    if (kq < 8) *(float4*)(sp + 320 + kq * 4) = make_float4(bflo(g.v.x), bfhi(g.v.x), bflo(g.v.y), bfhi(g.v.y));
    float c1 = a0 * r0 + a1 * r1 + a2 * r2 + a3 * r3;
    float c2 = e0 * r0 + e1 * r1 + e2 * r2 + e3 * r3;
    c1 += dppx<0xB1>(c1); c2 += dppx<0xB1>(c2);
    c1 += dppx<0x4E>(c1); c2 += dppx<0x4E>(c2);
    c1 += dppx<0x141>(c1); c2 += dppx<0x141>(c2);
    c1 += dppx<0x140>(c1); c2 += dppx<0x140>(c2);
    if (kq == 0) { sp[352] = c1; sp[353] = c2; }
  };
  typedef float f2 __attribute__((ext_vector_type(2)));
  f2 S01 = {0.f, 0.f}, S23 = {0.f, 0.f}, S45 = {0.f, 0.f}, S67 = {0.f, 0.f};
  auto compute = [&](int n) {
    const float* bp = sm + (n & 1) * RS_TB * RS_STEP;
    float* yb = ybuf + (n & 1) * RS_TB * 32 + w * 8 + rl;
    struct Ops { f2 k[4], r[4], w[4], a[4], e[4]; float vv; f2 c; };
    auto ld = [&](int s, Ops& o) {
      const float* sq = bp + s * RS_STEP;
      const f2* sp = (const f2*)(sq + ks * 8);
#pragma unroll
      for (int i = 0; i < 4; ++i) { o.k[i] = sp[i]; o.r[i] = sp[32 + i]; o.w[i] = sp[64 + i]; o.a[i] = sp[96 + i]; o.e[i] = sp[128 + i]; }
      o.vv = sq[320 + w * 8 + rl]; o.c = *(const f2*)(sq + 352);
    };
    auto step = [&](const Ops& o) -> float {
      f2 sa2 = S01 * o.k[0];
      f2 y2 = S01 * o.r[0];
      sa2 = __builtin_elementwise_fma(S23, o.k[1], sa2); y2 = __builtin_elementwise_fma(S23, o.r[1], y2);
      sa2 = __builtin_elementwise_fma(S45, o.k[2], sa2); y2 = __builtin_elementwise_fma(S45, o.r[2], y2);
      sa2 = __builtin_elementwise_fma(S67, o.k[3], sa2); y2 = __builtin_elementwise_fma(S67, o.r[3], y2);
      float sa = sa2.x + sa2.y, y0 = y2.x + y2.y;
      sa += dppx<0xB1>(sa); y0 += dppx<0xB1>(y0);
      sa += dppx<0x4E>(sa); y0 += dppx<0x4E>(y0);
      sa += dppx<0x141>(sa); y0 += dppx<0x141>(y0);
      sa = -sa;
      const f2 sav = {sa, sa}, vvv = {o.vv, o.vv};
      S01 = __builtin_elementwise_fma(vvv, o.e[0], __builtin_elementwise_fma(sav, o.a[0], S01 * o.w[0]));
      S23 = __builtin_elementwise_fma(vvv, o.e[1], __builtin_elementwise_fma(sav, o.a[1], S23 * o.w[1]));
      S45 = __builtin_elementwise_fma(vvv, o.e[2], __builtin_elementwise_fma(sav, o.a[2], S45 * o.w[2]));
      S67 = __builtin_elementwise_fma(vvv, o.e[3], __builtin_elementwise_fma(sav, o.a[3], S67 * o.w[3]));
      return fmaf(o.vv, o.c.y, fmaf(sa, o.c.x, y0));
    };
    Ops oa, ob;
    ld(0, oa);
#pragma unroll 1
    for (int s = 0; s < RS_TB; s += 2) {
      __builtin_amdgcn_sched_barrier(0);
      ld(s + 1, ob);
      __builtin_amdgcn_sched_barrier(0);
      float y0 = step(oa);
      asm volatile("" : "+v"(y0));
      __builtin_amdgcn_sched_barrier(0);
      ld(s + 2, oa);
      __builtin_amdgcn_sched_barrier(0);
      float y1 = step(ob);
      asm volatile("" : "+v"(y1));
      __builtin_amdgcn_sched_barrier(0);
      if (ks == 0) { yb[s * 32] = y0; yb[(s + 1) * 32] = y1; }
    }
  };
  auto yout = [&](int n) {
    const int row = scan_row(dir, b, n * RS_TB + ss);
    const float* ys = ybuf + (n & 1) * RS_TB * 32 + ss * 32 + kq * 2;
    *(unsigned*)(p->P + (size_t)row * LDP + dir * 512 + h * 64 + hf * 32 + kq * 2) = pk_bf16(ys[0], ys[1]);
  };
  constexpr int NB = TSC / RS_TB;
  RwkvStage gA, gB;
  gload(0, gA);
  gload(1, gB);
  swrite(0, gA);
  gload(2, gA);
  __syncthreads();
  for (int n = 0; n < NB; n += 2) {
    compute(n);
    swrite(1, gB);
    if (n + 3 < NB) gload(n + 3, gB);
    __syncthreads();
    yout(n);
    compute(n + 1);
    if (n + 2 < NB) swrite(0, gA);
    if (n + 4 < NB) gload(n + 4, gA);
    __syncthreads();
    yout(n + 1);
  }
  __syncthreads();
}

__device__ void mlstm_s1(KP p, int layer, int tile, char* lds, int tid) {
  const int j = layer >> 1;
  const int ch = tile / NCHUNK, c = tile % NCHUNK;
  const int dir = ch >> 5, b = (ch >> 2) & 7, h = ch & 3;
  float* s_ws = (float*)(lds + META_OFF);
  int* s_row = (int*)(s_ws + 64);
  char* kimg = lds;
  char* vimg = lds + 16384;
  if (tid < 64) {
    const int row = scan_row(dir, b, c * 64 + tid);
    s_row[tid] = row;
    const float* g = p->GP + (size_t)row * 16;
    const float gi = g[(dir * 2) * 4 + h] + p->mlstm_gate_b[j * 16 + (dir * 2) * 4 + h];
    const float gf = g[(dir * 2 + 1) * 4 + h] + p->mlstm_gate_b[j * 16 + (dir * 2 + 1) * 4 + h];
    float bc = -softplus_f(-gf);
#pragma unroll
    for (int o = 1; o < 64; o <<= 1) {
      float tmp = __shfl_up(bc, o);
      if (tid >= o) bc += tmp;
    }
    const float bend = __shfl(bc, 63);
    const float ds = bend - bc + gi;
    const float mloc = wmax(ds);
    s_ws[tid] = expf(ds - mloc);
    if (tid == 0) { p->msc[tile] = mloc; p->msc[NMT + tile] = bend; }
  }
  __syncthreads();
  {
    const int c8 = tid & 15;
    const int ioff = (c8 >> 2) * 4096 + (c8 & 3) * 16;
#pragma unroll
    for (int i = 0; i < 4; ++i) {
      const int sidx = (tid >> 4) + 16 * i;
      const bf16_t* src = p->P + (size_t)s_row[sidx] * LDP + h * 128 + c8 * 8;
      const u32x4 kv = *(const u32x4*)(src + 2560);
      u32x4 vv = *(const u32x4*)(src + 3072);
      const float wsv = s_ws[sidx];
      vv.x = pk_bf16(bflo(vv.x) * wsv, bfhi(vv.x) * wsv); vv.y = pk_bf16(bflo(vv.y) * wsv, bfhi(vv.y) * wsv);
      vv.z = pk_bf16(bflo(vv.z) * wsv, bfhi(vv.z) * wsv); vv.w = pk_bf16(bflo(vv.w) * wsv, bfhi(vv.w) * wsv);
      *(u32x4*)(kimg + ioff + sidx * 64) = kv;
      *(u32x4*)(vimg + ioff + sidx * 64) = vv;
    }
  }
  __syncthreads();
  const int lane = tid & 63, w = tid >> 6, wm = w >> 1, wn = w & 1, r32 = lane & 31, hi = lane >> 5;
  f32x16 acc[2][2];
#pragma unroll
  for (int mi = 0; mi < 2; ++mi)
#pragma unroll
    for (int ni = 0; ni < 2; ++ni)
#pragma unroll
      for (int q = 0; q < 16; ++q) acc[mi][ni][q] = 0.f;
  const int toff = ((lane >> 4) & 1) * 32 + (lane & 3) * 8 + ((lane & 15) >> 2) * 64 + hi * 256;
#pragma unroll
  for (int ks = 0; ks < 4; ++ks) {
    bf16x8 af[2], bfr[2];
#pragma unroll
    for (int i = 0; i < 2; ++i) {
      const char* ka = kimg + (wm * 2 + i) * 4096 + toff + (16 * ks) * 64;
      const char* va = vimg + (wn * 2 + i) * 4096 + toff + (16 * ks) * 64;
      af[i] = __builtin_shufflevector(vtr(ka), vtr(ka + 8 * 64), 0, 1, 2, 3, 4, 5, 6, 7);
      bfr[i] = __builtin_shufflevector(vtr(va), vtr(va + 8 * 64), 0, 1, 2, 3, 4, 5, 6, 7);
    }
    acc[0][0] = MFMA32(af[0], bfr[0], acc[0][0]);
    acc[0][1] = MFMA32(af[0], bfr[1], acc[0][1]);
    acc[1][0] = MFMA32(af[1], bfr[0], acc[1][0]);
    acc[1][1] = MFMA32(af[1], bfr[1], acc[1][1]);
  }
  bf16_t* ust = (bf16_t*)(lds + 32768);
#pragma unroll
  for (int mi = 0; mi < 2; ++mi)
#pragma unroll
    for (int ni = 0; ni < 2; ++ni)
#pragma unroll
      for (int q = 0; q < 16; ++q) {
        const int d = wm * 64 + mi * 32 + (q & 3) + 8 * (q >> 2) + 4 * hi;
        ust[d * 128 + wn * 64 + ni * 32 + r32] = f2bf(acc[mi][ni][q]);
        if ((q & 3) == 3) __builtin_amdgcn_sched_barrier(0);
      }
  __syncthreads();
  {
    const u32x4* us4 = (const u32x4*)ust;
    u32x4* U4 = (u32x4*)(p->MS + (size_t)tile * 16384);
#pragma unroll
    for (int i = 0; i < 8; ++i) U4[tid + 256 * i] = us4[tid + 256 * i];
  }
  if (tid < 128) {
    const char* kc = kimg + (tid >> 5) * 4096 + (tid & 31) * 2;
    float a = 0.f;
#pragma unroll 8
    for (int sidx = 0; sidx < 64; ++sidx) a = fmaf(s_ws[sidx], bf2f(*(const bf16_t*)(kc + sidx * 64)), a);
    p->MSn[tile * 128 + tid] = a;
  }
}

__device__ void mlstm_s3(KP p, int layer, int tile, char* lds, int tid);
__device__ void ph_scan_a(KP p, int layer, char* smc) {
  float* sm = (float*)smc;
  const int tid = opaque_tid();
  __builtin_amdgcn_s_setprio(3);
  for (int u = blockIdx.x; u < 256; u += gridDim.x) rwkv_unit(p, u, sm, tid);
  __builtin_amdgcn_s_setprio(0);
  {
    const int stage = layer == 1 ? 1 : 2;
    const int nconv = conv_stage_total(stage);
    const int total = NMT + (nconv + 7) / 8;
    int* qc = (int*)(p->bar + XCD_BAR_WORDS + 16 * stage);
    int* s_q = (int*)(smc + META_OFF + 3968);
    int jj = 0, j1 = 0;
#pragma unroll 1
    for (;;) {
      if (jj >= j1) {
        __syncthreads();
        if (tid == 0) *s_q = atomicAdd(qc, 1);
        __syncthreads();
        const int q = *s_q;
        if (q >= total) break;
        if (q < NMT) { mlstm_s3(p, layer, q, smc, tid); continue; }
        jj = (q - NMT) * 8; j1 = min(jj + 8, nconv);
      }
      convert_run(p, stage, jj, j1, sm, tid);
      jj = j1;
    }
  }
}

__device__ void ph_mlstm_s2(KP p, char* smc) {
  float* sw = (float*)smc;
  const int tid = opaque_tid();
  const int nitems = 64 * 33;
  for (int item = blockIdx.x; item < nitems; item += gridDim.x) {
    const int ch = item / 33, seg = item % 33;
    __syncthreads();
    if (tid < 2 * NCHUNK) sw[72 + tid] = p->msc[(tid < NCHUNK ? 0 : NMT - NCHUNK) + ch * NCHUNK + tid];
    __syncthreads();
    if (tid == 0) {
      float m = 0.f;
      for (int c = 0; c < NCHUNK; ++c) {
        const int tile = ch * NCHUNK + c;
        const float mloc = sw[72 + c], bend = sw[72 + NCHUNK + c];
        const float mn = fmaxf(bend + m, mloc);
        sw[c] = expf(bend + m - mn);
        sw[36 + c] = expf(mloc - mn);
        if (seg == 0) p->msc[2 * NMT + tile] = m;
        m = mn;
      }
    }
    __syncthreads();
    if (seg < 32) {
      unsigned* base = (unsigned*)(p->MS + (size_t)ch * NCHUNK * 16384) + seg * 256 + tid;
      unsigned v[NCHUNK];
#pragma unroll
      for (int c = 0; c < NCHUNK; ++c) v[c] = base[(size_t)c * 8192];
      float C0 = 0.f, C1 = 0.f;
#pragma unroll
      for (int c = 0; c < NCHUNK; ++c) {
        const float t0 = bflo(v[c]), t1 = bfhi(v[c]);
        v[c] = pk_bf16(C0, C1);
        C0 = sw[c] * C0 + sw[36 + c] * t0;
        C1 = sw[c] * C1 + sw[36 + c] * t1;
      }
#pragma unroll
      for (int c = 0; c < NCHUNK; ++c) base[(size_t)c * 8192] = v[c];
    } else if (tid < 128) {
      float* base = p->MSn + (size_t)ch * NCHUNK * 128 + tid;
      float v[NCHUNK];
#pragma unroll
      for (int c = 0; c < NCHUNK; ++c) v[c] = base[c * 128];
      float C = 0.f;
#pragma unroll
      for (int c = 0; c < NCHUNK; ++c) {
        const float t0 = v[c];
        v[c] = C;
        C = sw[c] * C + sw[36 + c] * t0;
      }
#pragma unroll
      for (int c = 0; c < NCHUNK; ++c) base[c * 128] = v[c];
    }
  }
}

__device__ void mlstm_s3(KP p, int layer, int tile, char* lds, int tid) {
  const int j = layer >> 1;
  const int ch = tile / NCHUNK, c = tile % NCHUNK;
  const int dir = ch >> 5, b = (ch >> 2) & 7, h = ch & 3;
  float* s_b = (float*)(lds + META_OFF);
  float* s_ig = s_b + 64;
  float* s_mt = s_b + 128;
  float* s_wi = s_b + 192;
  int* s_row = (int*)(s_b + 256);
  float* s_n = s_b + 320;
  float* s_c = s_b + 448;
  char* kimg = lds;
  char* vimg = lds + 16384;
  char* cimg = lds + 32768;
  const float mprev = p->msc[2 * NMT + tile];
  const float qscale = 0.08838834764831845f;
  const int lane = tid & 63, w = tid >> 6, wt = w >> 1, wv = w & 1, r32 = lane & 31, hi = lane >> 5;
  const int t = wt * 32 + r32;
  const int rowq = scan_row(dir, b, c * 64 + t);
  const int c8 = tid & 15;
  u32x4 kr[4], vr[4], cr[8];
#pragma unroll
  for (int i = 0; i < 4; ++i) {
    const int sidx = (tid >> 4) + 16 * i;
    const bf16_t* src = p->P + (size_t)scan_row(dir, b, c * 64 + sidx) * LDP + h * 128 + c8 * 8;
    kr[i] = *(const u32x4*)(src + 2560);
    vr[i] = *(const u32x4*)(src + 3072);
  }
  {
    const bf16_t* Cp = p->MS + (size_t)tile * 16384;
#pragma unroll
    for (int i = 0; i < 8; ++i) cr[i] = *(const u32x4*)(Cp + ((tid >> 4) + 16 * i) * 128 + c8 * 8);
  }
  bf16x8 qf[8];
  {
    const bf16_t* qp = p->P + (size_t)rowq * LDP + 2048 + h * 128 + hi * 8;
#pragma unroll
    for (int d0 = 0; d0 < 8; ++d0) qf[d0] = *(const bf16x8*)(qp + d0 * 16);
  }
  if (tid < 64) {
    const int row = scan_row(dir, b, c * 64 + tid);
    s_row[tid] = row;
    const float* g = p->GP + (size_t)row * 16;
    const float gi = g[(dir * 2) * 4 + h] + p->mlstm_gate_b[j * 16 + (dir * 2) * 4 + h];
    const float gf = g[(dir * 2 + 1) * 4 + h] + p->mlstm_gate_b[j * 16 + (dir * 2 + 1) * 4 + h];
    float bc = -softplus_f(-gf);
#pragma unroll
    for (int o = 1; o < 64; o <<= 1) {
      float tmp = __shfl_up(bc, o);
      if (tid >= o) bc += tmp;
    }
    float pm = gi - bc;
#pragma unroll
    for (int o = 1; o < 64; o <<= 1) {
      float tmp = __shfl_up(pm, o);
      if (tid >= o) pm = fmaxf(pm, tmp);
    }
    const float mt = bc + fmaxf(mprev, pm);
    s_b[tid] = bc;
    s_ig[tid] = gi;
    s_mt[tid] = mt;
    s_wi[tid] = expf(bc + mprev - mt);
    s_c[tid] = (gi - bc) * 1.4426950408889634f;
  } else if (tid < 192) s_n[tid - 64] = p->MSn[tile * 128 + (tid - 64)];
  {
    const int ioff = (c8 >> 2) * 4096 + (c8 & 3) * 16;
#pragma unroll
    for (int i = 0; i < 4; ++i) {
      const int sidx = (tid >> 4) + 16 * i;
      *(u32x4*)(kimg + sidx * 256 + ((c8 ^ (sidx & 15)) * 16)) = kr[i];
      *(u32x4*)(vimg + ioff + sidx * 64) = vr[i];
    }
    const int coff = (c8 >> 2) * 8192 + (c8 & 3) * 16;
#pragma unroll
    for (int i = 0; i < 8; ++i) *(u32x4*)(cimg + coff + ((tid >> 4) + 16 * i) * 64) = cr[i];
  }
  __syncthreads();
  const int toff = ((lane >> 4) & 1) * 32 + (lane & 3) * 8 + ((lane & 15) >> 2) * 64;
  constexpr float LOG2E_ = 1.4426950408889634f;
  float qn = 0.f;
#pragma unroll
  for (int d0 = 0; d0 < 8; ++d0) {
    const u32x4 qq = __builtin_bit_cast(u32x4, qf[d0]);
    const float* np = s_n + d0 * 16 + hi * 8;
    qn = fmaf(bflo(qq.x), np[0], qn); qn = fmaf(bfhi(qq.x), np[1], qn);
    qn = fmaf(bflo(qq.y), np[2], qn); qn = fmaf(bfhi(qq.y), np[3], qn);
    qn = fmaf(bflo(qq.z), np[4], qn); qn = fmaf(bfhi(qq.z), np[5], qn);
    qn = fmaf(bflo(qq.w), np[6], qn); qn = fmaf(bfhi(qq.w), np[7], qn);
  }
  qn += __shfl_xor(qn, 32);
  const float mtt = s_mt[t], wi = s_wi[t];
  const float ct = (s_b[t] - mtt) * LOG2E_;
  const float wq = wi * qscale;
  bf16x8 pf[4];
  float den = 0.f;
  {
    f32x16 sa0, sa1;
#pragma unroll
    for (int q = 0; q < 16; ++q) { sa0[q] = 0.f; sa1[q] = 0.f; }
#pragma unroll
    for (int d0 = 0; d0 < 8; ++d0) {
      const int chn = 2 * d0 + hi;
      const bf16x8 k0 = *(const bf16x8*)(kimg + r32 * 256 + ((chn ^ (r32 & 15)) * 16));
      sa0 = MFMA32(k0, qf[d0], sa0);
      if (wt) {
        const bf16x8 k1 = *(const bf16x8*)(kimg + (32 + r32) * 256 + ((chn ^ (r32 & 15)) * 16));
        sa1 = MFMA32(k1, qf[d0], sa1);
      }
      __builtin_amdgcn_sched_barrier(0);
    }
#pragma unroll
    for (int g = 0; g < 4; ++g) {
      const int sb0 = 8 * g + 4 * hi;
      const float4 c0v = *(const float4*)(s_c + sb0);
      const float4 c1v = *(const float4*)(s_c + sb0 + 32);
      const float cc0[4] = {c0v.x, c0v.y, c0v.z, c0v.w}, cc1[4] = {c1v.x, c1v.y, c1v.z, c1v.w};
#pragma unroll
      for (int e = 0; e < 4; ++e) {
        const int q = 4 * g + e;
        const float v0 = (sb0 + e <= t) ? sa0[q] * qscale * __builtin_amdgcn_exp2f(ct + cc0[e]) : 0.f;
        sa0[q] = v0; den += v0;
        const float v1 = (wt && sb0 + 32 + e <= t) ? sa1[q] * qscale * __builtin_amdgcn_exp2f(ct + cc1[e]) : 0.f;
        sa1[q] = v1; den += v1;
      }
      __builtin_amdgcn_sched_barrier(0);
    }
#pragma unroll
    for (int sx = 0; sx < 4; ++sx) {
      const int u = (sx & 1) * 8;
      u32x4 tpk;
      if (sx < 2) {
        tpk.x = pk_bf16(sa0[u + 0], sa0[u + 1]); tpk.y = pk_bf16(sa0[u + 2], sa0[u + 3]);
        tpk.z = pk_bf16(sa0[u + 4], sa0[u + 5]); tpk.w = pk_bf16(sa0[u + 6], sa0[u + 7]);
      } else {
        tpk.x = pk_bf16(sa1[u + 0], sa1[u + 1]); tpk.y = pk_bf16(sa1[u + 2], sa1[u + 3]);
        tpk.z = pk_bf16(sa1[u + 4], sa1[u + 5]); tpk.w = pk_bf16(sa1[u + 6], sa1[u + 7]);
      }
      pf[sx] = __builtin_bit_cast(bf16x8, tpk);
    }
  }
  den += __shfl_xor(den, 32);
  const float dtot = den + wq * qn;
  const float inv = 1.f / fmaxf(fabsf(dtot), expf(-mtt));
  bf16_t* op = p->P + (size_t)rowq * LDP + 1024 + dir * 512 + h * 128 + wv * 64 + 4 * hi;
#pragma unroll 1
  for (int vp = 0; vp < 2; ++vp) {
    f32x16 o0;
#pragma unroll
    for (int q = 0; q < 16; ++q) o0[q] = 0.f;
    const char* cb = cimg + (wv * 2 + vp) * 8192 + toff + hi * 512;
#pragma unroll
    for (int d0 = 0; d0 < 8; ++d0) {
      const bf16x8 A0 = __builtin_shufflevector(vtr(cb + (16 * d0) * 64), vtr(cb + (16 * d0 + 4) * 64), 0, 1, 2, 3, 4, 5, 6, 7);
      o0 = MFMA32(A0, qf[d0], o0);
    }
#pragma unroll
    for (int q = 0; q < 16; ++q) o0[q] *= wq;
    const char* vb = vimg + (wv * 2 + vp) * 4096 + toff + hi * 256;
#pragma unroll
    for (int sx = 0; sx < 4; ++sx) {
      if (sx < 2 || wt) {
        const bf16x8 A0 = __builtin_shufflevector(vtr(vb + (16 * sx) * 64), vtr(vb + (16 * sx + 8) * 64), 0, 1, 2, 3, 4, 5, 6, 7);
        o0 = MFMA32(A0, pf[sx], o0);
      }
    }
#pragma unroll
    for (int g = 0; g < 4; ++g) {
      u32x2 v0;
      v0.x = pk_bf16(o0[4 * g] * inv, o0[4 * g + 1] * inv); v0.y = pk_bf16(o0[4 * g + 2] * inv, o0[4 * g + 3] * inv);
      *(u32x2*)(op + vp * 32 + 8 * g) = v0;
    }
  }
}

__device__ void ph_mlstm_s1(KP p, int layer, char* smc) {
  const int tid = opaque_tid();
  __syncthreads();
  for (int tile = blockIdx.x; tile < NMT; tile += gridDim.x) { mlstm_s1(p, layer, tile, smc, tid); __syncthreads(); }
}

__device__ void ph_rec_final(KP p, int layer, bool keep) {
  const int tid = opaque_tid();
  const int j = layer >> 1;
  const int lane = tid & 63, wave = tid >> 6;
  const int rows = keep ? NT : NL;
  const int c0 = lane * 8;
  auto unpack = [](const u32x4 u, float (&f)[8]) {
    f[0] = bflo(u.x); f[1] = bfhi(u.x); f[2] = bflo(u.y); f[3] = bfhi(u.y);
    f[4] = bflo(u.z); f[5] = bfhi(u.z); f[6] = bflo(u.w); f[7] = bfhi(u.w);
  };
  for (int t = blockIdx.x * 4 + wave; t < rows; t += gridDim.x * 4) {
    const bf16_t* rw = p->RW + (size_t)t * RWS + c0;
    const bf16_t* pt = p->P + (size_t)t * LDP + c0;
    unsigned char* mo = (unsigned char*)p->AB + (size_t)t * DM + c0;
    {
      float yf[8], yb[8], r[8], v[8], k0[8], k1[8], g[8], y[8], o[8];
      unpack(*(const u32x4*)(pt), yf); unpack(*(const u32x4*)(pt + 512), yb);
      unpack(*(const u32x4*)(rw), r); unpack(*(const u32x4*)(rw + 512), v);
      unpack(*(const u32x4*)(rw + 5 * 512), k0); unpack(*(const u32x4*)(rw + 6 * 512), k1);
      unpack(*(const u32x4*)(rw + 9 * 512), g);
      float s1 = 0.f, bs = 0.f;
      const float* rk = p->rwkv_rk + j * 512 + c0;
#pragma unroll
      for (int e = 0; e < 8; ++e) { y[e] = yf[e] + yb[e]; s1 += y[e]; bs += r[e] * rk[e] * (k0[e] + k1[e]); }
      s1 += dppx<0xB1>(s1); s1 += dppx<0x4E>(s1); s1 += dppx<0x141>(s1);
      bs += dppx<0xB1>(bs); bs += dppx<0x4E>(bs); bs += dppx<0x141>(bs);
      const float mu = s1 * (1.f / 64.f);
      float s2 = 0.f;
#pragma unroll
      for (int e = 0; e < 8; ++e) { const float d = y[e] - mu; s2 += d * d; }
      s2 += dppx<0xB1>(s2); s2 += dppx<0x4E>(s2); s2 += dppx<0x141>(s2);
      const float rs = rsqrtf(s2 * (1.f / 64.f) + 64e-5f);
      const float* gn0 = p->rwkv_gn + (j * 2 + 0) * 512 + c0;
      const float* gn1 = p->rwkv_gn + (j * 2 + 1) * 512 + c0;
#pragma unroll
      for (int e = 0; e < 8; ++e) o[e] = ((y[e] - mu) * rs * gn0[e] + gn1[e] + bs * v[e]) * g[e];
      u32x2 ov;
      ov.x = pk_fp8x4c(o[0], o[1], o[2], o[3]); ov.y = pk_fp8x4c(o[4], o[5], o[6], o[7]);
      *(u32x2*)(mo) = ov;
    }
    {
      float hf[8], hb[8], og[8], hsum[8], o[8];
      unpack(*(const u32x4*)(pt + 1024), hf); unpack(*(const u32x4*)(pt + 1536), hb);
      unpack(*(const u32x4*)(pt + 3584), og);
      float ss = 0.f;
#pragma unroll
      for (int e = 0; e < 8; ++e) { hsum[e] = hf[e] + hb[e]; ss += hsum[e] * hsum[e]; }
      ss += dppx<0xB1>(ss); ss += dppx<0x4E>(ss); ss += dppx<0x141>(ss); ss += dppx<0x140>(ss);
      const float rs = rsqrtf(ss * (1.f / 128.f) + 1e-6f);
      const float* ng = p->mlstm_norm + j * 512 + c0;
#pragma unroll
      for (int e = 0; e < 8; ++e) o[e] = hsum[e] * rs * ng[e] * sigm_f(og[e]);
      u32x2 ov;
      ov.x = pk_fp8x4c(o[0], o[1], o[2], o[3]); ov.y = pk_fp8x4c(o[4], o[5], o[6], o[7]);
      *(u32x2*)(mo + 512) = ov;
    }
  }
}

using f32x4v = __attribute__((ext_vector_type(4))) float;
__device__ void ph_ln_router(KP p, int layer, bool keep, char* smc) {
  float* h2s = (float*)smc;
  float* lgs = (float*)smc;
  const int tid = opaque_tid();
  const int lane = tid & 63, wave = tid >> 6;
  const int rows = keep ? NT : NL;
  const float* lng = p->ln_g + (layer * 2 + 0) * 1024;
  const float* lnb = p->ln_b + (layer * 2 + 0) * 1024;
  for (int tile = blockIdx.x; tile < rows / 16; tile += gridDim.x) {
    const int t0 = tile * 16;
    const float* mod = p->MOD + (layer * 9 + modrow(t0)) * 6144;
    const float* brow = p->WrT + ((size_t)layer * 64 + 16 * wave + (lane & 15)) * 1024 + 4 * (lane >> 4);
    f32x4v b0[8], b1[8], b2[8];
#pragma unroll
    for (int q = 0; q < 8; ++q) { b0[q] = *(const f32x4v*)(brow + 16 * q); b1[q] = *(const f32x4v*)(brow + 16 * (8 + q)); }
    __builtin_amdgcn_sched_barrier(0);
    {
      float4 v[4][4];
      float s4[4];
#pragma unroll
      for (int q = 0; q < 4; ++q) {
        const int t = t0 + wave * 4 + q;
        s4[q] = 0.f;
#pragma unroll
        for (int i = 0; i < 4; ++i) v[q][i] = *(const float4*)(p->Tb + (size_t)t * DM + i * 256 + lane * 4);
      }
#pragma unroll
      for (int q = 0; q < 4; ++q)
#pragma unroll
        for (int i = 0; i < 4; ++i) s4[q] += (v[q][i].x + v[q][i].y) + (v[q][i].z + v[q][i].w);
      float mean4[4], rs4[4];
#pragma unroll
      for (int q = 0; q < 4; ++q) mean4[q] = wsum(s4[q]) * (1.f / 1024.f);
#pragma unroll
      for (int q = 0; q < 4; ++q) {
        float qq = 0.f;
#pragma unroll
        for (int i = 0; i < 4; ++i) {
          const float d0 = v[q][i].x - mean4[q], d1 = v[q][i].y - mean4[q], d2 = v[q][i].z - mean4[q], d3 = v[q][i].w - mean4[q];
          qq += (d0 * d0 + d1 * d1) + (d2 * d2 + d3 * d3);
        }
        s4[q] = qq;
      }
#pragma unroll
      for (int q = 0; q < 4; ++q) rs4[q] = rsqrtf(wsum(s4[q]) * (1.f / 1024.f) + 1e-5f);
#pragma unroll
      for (int i = 0; i < 4; ++i) {
        const int n = i * 256 + lane * 4;
        const float4 g = *(const float4*)(lng + n), bb = *(const float4*)(lnb + n);
        const float4 sc = *(const float4*)(mod + 4096 + n), sh = *(const float4*)(mod + 3072 + n);
#pragma unroll
        for (int q = 0; q < 4; ++q) {
          const int tl = wave * 4 + q, t = t0 + tl;
          const float mean = mean4[q], rs = rs4[q];
          const float4 xn = make_float4((v[q][i].x - mean) * rs * g.x + bb.x, (v[q][i].y - mean) * rs * g.y + bb.y,
                                        (v[q][i].z - mean) * rs * g.z + bb.z, (v[q][i].w - mean) * rs * g.w + bb.w);
          *(float4*)(p->X + (size_t)t * DM + n) = xn;
          const float4 hh = make_float4(xn.x * (1.f + sc.x) + sh.x, xn.y * (1.f + sc.y) + sh.y,
                                        xn.z * (1.f + sc.z) + sh.z, xn.w * (1.f + sc.w) + sh.w);
          *(unsigned*)((unsigned char*)p->AB + (size_t)t * DM + n) = pk_fp8x4c(hh.x, hh.y, hh.z, hh.w);
          *(float4*)(h2s + tl * 1028 + n) = hh;
        }
      }
    }
    __syncthreads();
    f32x4v acc = {0.f, 0.f, 0.f, 0.f};
    {
      f32x4v a1 = {0.f, 0.f, 0.f, 0.f}, a2 = {0.f, 0.f, 0.f, 0.f}, a3 = {0.f, 0.f, 0.f, 0.f};
      const int i = lane & 15, kk = lane >> 4;
      const float* arow = h2s + i * 1028 + 4 * kk;
#define ROUTER_LOAD(B, Q0) _Pragma("unroll") for (int q = 0; q < 8; ++q) B[q] = *(const f32x4v*)(brow + 16 * ((Q0) + q)); __builtin_amdgcn_sched_barrier(0);
#define ROUTER_MFMA(B, Q0) _Pragma("unroll") for (int q = 0; q < 8; ++q) { \
        const float4 a = *(const float4*)(arow + 16 * ((Q0) + q)); \
        acc = __builtin_amdgcn_mfma_f32_16x16x4f32(a.x, B[q].x, acc, 0, 0, 0); \
        a1 = __builtin_amdgcn_mfma_f32_16x16x4f32(a.y, B[q].y, a1, 0, 0, 0); \
        a2 = __builtin_amdgcn_mfma_f32_16x16x4f32(a.z, B[q].z, a2, 0, 0, 0); \
        a3 = __builtin_amdgcn_mfma_f32_16x16x4f32(a.w, B[q].w, a3, 0, 0, 0); } __builtin_amdgcn_sched_barrier(0);
      ROUTER_LOAD(b2, 16) ROUTER_MFMA(b0, 0)
      ROUTER_LOAD(b0, 24) ROUTER_MFMA(b1, 8)
      ROUTER_LOAD(b1, 32) ROUTER_MFMA(b2, 16)
      ROUTER_LOAD(b2, 40) ROUTER_MFMA(b0, 24)
      ROUTER_LOAD(b0, 48) ROUTER_MFMA(b1, 32)
      ROUTER_LOAD(b1, 56) ROUTER_MFMA(b2, 40)
      ROUTER_MFMA(b0, 48)
      ROUTER_MFMA(b1, 56)
      acc = (acc + a1) + (a2 + a3);
    }
    __syncthreads();
#pragma unroll
    for (int r = 0; r < 4; ++r) lgs[((lane >> 4) * 4 + r) * 64 + 16 * wave + (lane & 15)] = acc[r];
    __syncthreads();
    {
      float score4[4], gate4[4];
      int kidx4[4], pos4[4];
      bool chosen4[4];
#pragma unroll
      for (int q = 0; q < 4; ++q) {
        const int tl = wave * 4 + q;
        const float logit = lgs[tl * 64 + lane];
        const float score = sigm_f(logit);
        float sel = score + p->moe_bias[layer * 64 + lane];
        bool chosen = false;
        for (int r = 0; r < 6; ++r) {
          const float mx = wmax(sel);
          const unsigned long long bal = __ballot(sel == mx);
          const int first = __ffsll((long long)bal) - 1;
          if (lane == first) { chosen = true; sel = -INFINITY; }
        }
        const float gsum = wsum(chosen ? score : 0.f);
        const unsigned long long cb = __ballot(chosen);
        score4[q] = score; gate4[q] = score / gsum * 2.5f; chosen4[q] = chosen;
        kidx4[q] = __popcll(cb & ((1ull << lane) - 1ull));
      }
#pragma unroll
      for (int q = 0; q < 4; ++q) pos4[q] = chosen4[q] ? atomicAdd(&p->cnt[lane * CSTR], 1) : 0;
#pragma unroll
      for (int q = 0; q < 4; ++q) {
        const int t = t0 + wave * 4 + q;
        if (chosen4[q]) {
          p->ltok[(size_t)lane * NT + pos4[q]] = t;
          p->lgate[(size_t)lane * NT + pos4[q]] = gate4[q];
          p->tsl[t * 6 + kidx4[q]] = (lane << 16) | pos4[q];
        }
      }
    }
    __syncthreads();
  }
}

__device__ __forceinline__ void moe_prefix(KP p, int rows, int* s_pref, int tid) {
  if (tid < 64) s_pref[322 + tid] = p->cnt[tid * CSTR];
  __syncthreads();
  if (tid == 0) {
    int a = 0;
    for (int e = 0; e < 64; ++e) { s_pref[e] = a; a += (s_pref[322 + e] + 127) >> 7; }
    s_pref[64] = a; a += rows >> 7;
    s_pref[65] = a;
  }
  __syncthreads();
}

__device__ void ph_gemm(KP p, int kind, int layer, bool keep, char* lds) {
  const int tid = opaque_tid();
  const int j = layer >> 1;
  const bool att = !(layer & 1);
  const int rows = keep ? NT : NL;
  int* pref = (int*)(lds + META_OFF);
  int* s_idx = pref + 66;
  float* s_gate = (float*)(s_idx + 128);
  if (kind == 1 && blockIdx.x == 0 && tid < 65) p->cnt[tid * CSTR] = 0;
  int total;
  const int ntn_in = att ? 18 : 33;
  switch (kind) {
    case 0: total = (NT / 128) * ntn_in; break;
    case 1: total = (rows / 128) * 8; break;
    case 2: total = pref[65] * 4; break;
    case 3: total = pref[65] * 8; break;
    case 4: total = (NT / 128) * 3; break;
    default: total = (NT / 128) * 20; break;
  }
  const bool moe = kind == 2 || kind == 3;
  const int tsh = kind == 2 ? 2 : 3;
  int e_nx = 0, idx_nx = tid; float g_nx = 1.f;
  auto fetch_moe = [&](int tl) {
    const int mt = tl >> tsh;
    while (mt >= pref[e_nx + 1]) ++e_nx;
    idx_nx = tid; g_nx = 1.f;
    if (tid < 128) {
      const int pos = (mt - pref[e_nx]) * 128 + tid;
      if (kind == 2) {
        idx_nx = 0;
        if (e_nx < 64) { if (pos < pref[322 + e_nx]) idx_nx = p->ltok[(size_t)e_nx * NT + pos]; }
        else idx_nx = pos;
      } else if (e_nx < 64) g_nx = pos < pref[322 + e_nx] ? p->lgate[(size_t)e_nx * NT + pos] : 0.f;
    }
  };
  const int xcd = blockIdx.x & 7, lb = blockIdx.x >> 3, nbx = ((int)gridDim.x - xcd + 7) >> 3;
  const int t_beg = (int)(((long long)total * xcd) >> 3), t_end = (int)(((long long)total * (xcd + 1)) >> 3);
  if (moe && t_beg + lb < t_end) fetch_moe(t_beg + lb);
  for (int tile = t_beg + lb; tile < t_end; tile += nbx) {
    const bf16_t* Abase; const bf16_t* Bt;
    int astride, K, n0, m0 = 0, aux = 0, e = e_nx, mtile = 0;
    switch (kind) {
      case 0: { const int tm = tile / ntn_in, tn = tile % ntn_in; m0 = tm * 128; n0 = tn * 128;
                Abase = (const bf16_t*)((const unsigned char*)p->AB + (size_t)m0 * DM); astride = DM; K = 1024;
                Bt = (const bf16_t*)(att ? (const unsigned char*)p->Wt_att + (size_t)j * ATT_N * 1024
                                         : (const unsigned char*)p->Wt_rec + (size_t)j * REC_NP * 1024); } break;
      case 1: { const int tm = tile >> 3, tn = tile & 7; m0 = tm * 128; n0 = tn * 128;
                Abase = (const bf16_t*)((const unsigned char*)p->AB + (size_t)m0 * DM); astride = DM; K = 1024;
                Bt = (const bf16_t*)((const unsigned char*)p->Wt_out + (size_t)layer * 1024 * 1024); } break;
      case 2: { mtile = tile >> 2; aux = tile & 3; n0 = aux * 128;
                Abase = p->AB; astride = DM; K = 1024;
                Bt = (const bf16_t*)((const unsigned char*)p->Wt13 + (size_t)(layer * 65 + e) * 512 * 1024); } break;
      case 3: { mtile = tile >> 3; aux = tile & 7; n0 = aux * 128;
                Abase = (const bf16_t*)((const unsigned char*)p->ACT + (size_t)mtile * 128 * 256); astride = 256; K = 256;
                Bt = (const bf16_t*)((const unsigned char*)p->Wt2 + (size_t)(layer * 65 + e) * 1024 * 256); } break;
      case 4: { const int tm = tile / 3; aux = tile % 3; m0 = tm * 128; n0 = 0;
                Abase = p->Zb + (size_t)m0 * 1536 + aux * 512; astride = 1536; K = 512; Bt = p->Wl1 + (size_t)(j * 3 + aux) * 128 * 512; } break;
      default: { const int tm = tile / 20; aux = tile % 20; m0 = tm * 128; n0 = aux * 128;
                const int grp = aux < 8 ? 0 : (aux < 16 ? 1 : 2);
                Abase = p->L1 + (size_t)m0 * 384 + grp * 128; astride = 384; K = 128; Bt = p->Wl2 + (size_t)j * 2560 * 128; } break;
    }
    if (tid < 128) { s_idx[tid] = idx_nx; s_gate[tid] = g_nx; }
    __syncthreads();
    if (moe && tile + nbx < t_end) fetch_moe(tile + nbx);
    {
      f32x16 acc[2][2];
      if (kind <= 3) {
        const unsigned char* A8 = (const unsigned char*)Abase;
        gemm128_fp8(tid, [&](int r) { return A8 + (size_t)s_idx[r] * astride; }, (const unsigned char*)Bt, K, n0, lds, acc);
      } else
        gemm128_main(tid, [&](int r) { return Abase + (size_t)s_idx[r] * astride; }, Bt, K, n0, lds, acc);
      float* Ct = (float*)lds;
      acc_foreach(tid, acc, [&](int row, int col, float v) { Ct[row * 128 + col] = v; });
    }
    __syncthreads();
    {
      const float* Ct = (const float*)lds;
      int c4 = (tid & 31) * 4, r0 = tid >> 5;
      asm volatile("" : "+v"(c4), "+v"(r0));
      const int N_in = att ? ATT_N : REC_N;
      const int d5 = (aux >> 2) & 1, c05 = (aux & 3) * 128;
      switch (kind) {
        case 0: {
#pragma unroll 8
          for (int it = 0; it < 16; ++it) {
            const int row = it * 8 + r0;
            const float4 vraw = *(const float4*)(Ct + row * 128 + c4);
            const float4 v = make_float4(vraw.x * W8_INV, vraw.y * W8_INV, vraw.z * W8_INV, vraw.w * W8_INV);

            const int cn = n0 + c4;
            float4 vq = v;
            if (att && n0 >= 1536 && n0 < 2176) {
              float ss = v.x * v.x + v.y * v.y + v.z * v.z + v.w * v.w;
              ss += dppx<0xB1>(ss); ss += dppx<0x4E>(ss); ss += dppx<0x141>(ss); ss += dppx<0x140>(ss);
              const float rs = rsqrtf(ss * (1.f / 64.f) + 1e-6f);
              const float4 g = *(const float4*)(p->qk_gain + j * 128 + (n0 >= 2048 ? 64 : 0) + (cn & 63));
              vq = make_float4(v.x * rs * g.x, v.y * rs * g.y, v.z * rs * g.z, v.w * rs * g.w);
              const int t = m0 + row;
              if (t < NL) {
                const int sidx = t & 2047, pi0 = (cn & 63) >> 1;
                const int pos = pi0 < 16 ? (sidx >> 6) : (sidx & 63);
                const float4 cs = *(const float4*)(p->ROPE + (pos * 16 + (pi0 & 15)) * 2);
                vq = make_float4(vq.x * cs.x - vq.y * cs.y, vq.x * cs.y + vq.y * cs.x,
                                 vq.z * cs.z - vq.w * cs.w, vq.z * cs.w + vq.w * cs.z);
              }
            }
            if (cn < N_in) {
              u32x2 o; o.x = pk_bf16(vq.x, vq.y); o.y = pk_bf16(vq.z, vq.w);
              *(u32x2*)(p->P + (size_t)(m0 + row) * LDP + cn) = o;
            }
            if (!att && cn >= 4096 && cn < 4112) *(float4*)(p->GP + (size_t)(m0 + row) * 16 + (cn - 4096)) = v;
          }
        } break;
        case 1: {
#pragma unroll 16
          for (int it = 0; it < 16; ++it) {
            const int row = it * 8 + r0;
            const float4 v = *(const float4*)(Ct + row * 128 + c4);

            const size_t o = (size_t)(m0 + row) * DM + n0 + c4;
            const float4 xv = *(const float4*)(p->X + o);
            const float4 g = *(const float4*)(p->MOD + (layer * 9 + modrow(m0)) * 6144 + 2048 + n0 + c4);
            *(float4*)(p->Tb + o) = make_float4(DN_ALPHA * xv.x + g.x * (v.x * W8_INV), DN_ALPHA * xv.y + g.y * (v.y * W8_INV),
                                                DN_ALPHA * xv.z + g.z * (v.z * W8_INV), DN_ALPHA * xv.w + g.w * (v.w * W8_INV));
          }
        } break;
        case 2: {
#pragma unroll 8
          for (int it = 0; it < 16; ++it) {
            const int row = it * 8 + r0;
            const float4 v = *(const float4*)(Ct + row * 128 + c4);

            if (((c4 >> 5) & 1) == 0) {
              const float4 u = *(const float4*)(Ct + row * 128 + c4 + 32);
              const float a0 = v.x * W8_INV, a1 = v.y * W8_INV, a2 = v.z * W8_INV, a3 = v.w * W8_INV;
              *(unsigned*)((unsigned char*)p->ACT + ((size_t)mtile * 128 + row) * 256 + aux * 64 + (c4 >> 6) * 32 + (c4 & 31)) =
                  pk_fp8x4c(silu_f(a0) * (u.x * W8_INV), silu_f(a1) * (u.y * W8_INV), silu_f(a2) * (u.z * W8_INV), silu_f(a3) * (u.w * W8_INV));
            }
          }
        } break;
        case 3: {
#pragma unroll 16
          for (int it = 0; it < 16; ++it) {
            const int row = it * 8 + r0;
            const float4 v = *(const float4*)(Ct + row * 128 + c4);

            const float g = s_gate[row] * W8_INV;
            u32x2 o; o.x = pk_bf16(g * v.x, g * v.y); o.y = pk_bf16(g * v.z, g * v.w);
            *(u32x2*)(p->OUT2 + ((size_t)mtile * 128 + row) * 1024 + n0 + c4) = o;
          }
        } break;
        case 4: {
#pragma unroll 4
          for (int it = 0; it < 16; ++it) {
            const int row = it * 8 + r0;
            const float4 v = *(const float4*)(Ct + row * 128 + c4);

            float4 o4 = v;
            if (aux == 0) o4 = make_float4(tanhf(v.x), tanhf(v.y), tanhf(v.z), tanhf(v.w));
            else if (aux == 2) o4 = make_float4(sigm_f(v.x), sigm_f(v.y), sigm_f(v.z), sigm_f(v.w));
            u32x2 o; o.x = pk_bf16(o4.x, o4.y); o.y = pk_bf16(o4.z, o4.w);
            *(u32x2*)(p->L1 + (size_t)(m0 + row) * 384 + aux * 128 + c4) = o;
          }
        } break;
        default: {
#pragma unroll 4
          for (int it = 0; it < 16; ++it) {
            const int row = it * 8 + r0;
            const float4 v = *(const float4*)(Ct + row * 128 + c4);

            bf16_t* rr = p->RW + (size_t)(m0 + row) * RWS + c05 + c4;
            const float vv[4] = {v.x, v.y, v.z, v.w};
            if (aux < 8) {
              const float4 b0 = *(const float4*)(p->rwkv_w0 + (j * 2 + d5) * 512 + c05 + c4);
              const float bb[4] = {b0.x, b0.y, b0.z, b0.w};
              float e4[4];
#pragma unroll
              for (int q = 0; q < 4; ++q) e4[q] = expf(-softplus_f(-(bb[q] + vv[q])) - 0.5f);
              u32x2 o; o.x = pk_bf16(e4[0], e4[1]); o.y = pk_bf16(e4[2], e4[3]);
              *(u32x2*)(rr + (3 + d5) * 512) = o;
            } else if (aux < 16) {
              const float4 b0 = *(const float4*)(p->rwkv_a0 + (j * 2 + d5) * 512 + c05 + c4);
              const float4 k1 = *(const float4*)(p->rwkv_kvec + (j * 2 + 1) * 512 + c05 + c4);
              const u32x2 kx2 = *(const u32x2*)(rr + 10 * 512);
              const float bb[4] = {b0.x, b0.y, b0.z, b0.w}, kk1[4] = {k1.x, k1.y, k1.z, k1.w};
              const float kx[4] = {bflo(kx2.x), bfhi(kx2.x), bflo(kx2.y), bfhi(kx2.y)};
              float av[4], ke[4];
#pragma unroll
              for (int q = 0; q < 4; ++q) { av[q] = sigm_f(bb[q] + vv[q]); ke[q] = kx[q] * (1.f + (av[q] - 1.f) * kk1[q]); }
              u32x2 o; o.x = pk_bf16(av[0], av[1]); o.y = pk_bf16(av[2], av[3]);
              *(u32x2*)(rr + (7 + d5) * 512) = o;
              o.x = pk_bf16(ke[0], ke[1]); o.y = pk_bf16(ke[2], ke[3]);
              *(u32x2*)(rr + (5 + d5) * 512) = o;
            } else {
              u32x2 o; o.x = pk_bf16(v.x, v.y); o.y = pk_bf16(v.z, v.w);
              *(u32x2*)(rr + 9 * 512) = o;
            }
          }
        } break;
      }
    }
    __syncthreads();
  }
}

__device__ void ph_final_ln(KP p, int layer, bool keep, char* lds) {
  const int tid = opaque_tid();
  const int lane = tid & 63, wave = tid >> 6;
  const int rows = keep ? NT : NL;
  int* s_base = (int*)(lds + META_OFF);
  if (tid == 0) {
    int a = 0;
#pragma unroll 1
    for (int e = 0; e < 64; ++e) { s_base[e] = a * 128; a += (p->cnt[e * CSTR] + 127) >> 7; }
    s_base[64] = a * 128;
  }
  __syncthreads();
  const float* lng = p->ln_g + (layer * 2 + 1) * 1024;
  const float* lnb = p->ln_b + (layer * 2 + 1) * 1024;
  for (int t = blockIdx.x * 4 + wave; t < rows; t += gridDim.x * 4) {
    const int mr = modrow(t);
    const float* g2 = p->MOD + (layer * 9 + mr) * 6144 + 5120;
    const bf16_t* src[7];
#pragma unroll
    for (int k = 0; k < 6; ++k) {
      const int v = p->tsl[t * 6 + k];
      src[k] = p->OUT2 + (size_t)(s_base[v >> 16] + (v & 0xffff)) * 1024;
    }
    src[6] = p->OUT2 + (size_t)(s_base[64] + t) * 1024;
    float v[16];
    float s = 0.f;
#pragma unroll
    for (int c = 0; c < 2; ++c) {
      const int n0 = c * 512 + lane * 8;
      float y[8];
#pragma unroll
      for (int q = 0; q < 8; ++q) y[q] = 0.f;
#pragma unroll
      for (int k = 0; k < 7; ++k) {
        const u32x4 u = *(const u32x4*)(src[k] + n0);
        y[0] += bflo(u.x); y[1] += bfhi(u.x); y[2] += bflo(u.y); y[3] += bfhi(u.y);
        y[4] += bflo(u.z); y[5] += bfhi(u.z); y[6] += bflo(u.w); y[7] += bfhi(u.w);
      }
      const float4 xa = *(const float4*)(p->X + (size_t)t * DM + n0), xb = *(const float4*)(p->X + (size_t)t * DM + n0 + 4);
      const float4 ga = *(const float4*)(g2 + n0), gb = *(const float4*)(g2 + n0 + 4);
      const float xx[8] = {xa.x, xa.y, xa.z, xa.w, xb.x, xb.y, xb.z, xb.w};
      const float gg[8] = {ga.x, ga.y, ga.z, ga.w, gb.x, gb.y, gb.z, gb.w};
#pragma unroll
      for (int q = 0; q < 8; ++q) { v[c * 8 + q] = DN_ALPHA * xx[q] + gg[q] * y[q]; s += v[c * 8 + q]; }
    }
    const float mean = wsum(s) * (1.f / 1024.f);
    float q2 = 0.f;
#pragma unroll
    for (int i = 0; i < 16; ++i) { const float d = v[i] - mean; q2 += d * d; }
    const float rs = rsqrtf(wsum(q2) * (1.f / 1024.f) + 1e-5f);
    const float* modn = p->MOD + ((layer + 1) * 9 + mr) * 6144;
#pragma unroll
    for (int c = 0; c < 2; ++c) {
      const int n0 = c * 512 + lane * 8;
      float xn[8];
#pragma unroll
      for (int q = 0; q < 8; ++q) xn[q] = (v[c * 8 + q] - mean) * rs * lng[n0 + q] + lnb[n0 + q];
      float* xo = (layer == 3 ? p->out : p->X) + (size_t)t * DM + n0;
      *(float4*)(xo) = make_float4(xn[0], xn[1], xn[2], xn[3]);
      *(float4*)(xo + 4) = make_float4(xn[4], xn[5], xn[6], xn[7]);
      if (layer != 3) {
        float hb[8];
#pragma unroll
        for (int q = 0; q < 8; ++q) hb[q] = xn[q] * (1.f + modn[1024 + n0 + q]) + modn[n0 + q];
        u32x2 o;
        o.x = pk_fp8x4c(hb[0], hb[1], hb[2], hb[3]); o.y = pk_fp8x4c(hb[4], hb[5], hb[6], hb[7]);
        *(u32x2*)((unsigned char*)p->AB + (size_t)t * DM + n0) = o;
      }
    }
  }
}

#define XB_TMO      128
#define XB_XCNT(j)  (256  + 64 * (j))
#define XB_XSUB(j)  (1280 + 64 * (j))
#define XB_XGEN(j)  (2304 + 64 * (j))
#define XB_TOP      3328
#define XB_TOPGEN   3392
#define XB_SPIN_CAP (1u << 20)
#define LAS __attribute__((address_space(3)))
__device__ __forceinline__ unsigned xb_ld(unsigned* p) { return __hip_atomic_load(p, __ATOMIC_RELAXED, __HIP_MEMORY_SCOPE_AGENT); }
__device__ __forceinline__ unsigned xb_add(unsigned* p, unsigned v) { return __hip_atomic_fetch_add(p, v, __ATOMIC_RELAXED, __HIP_MEMORY_SCOPE_AGENT); }
__device__ __forceinline__ unsigned xb_xcc_id() { return (unsigned)__builtin_amdgcn_s_getreg((3 << 11) | 20) & 0xFu; }
#define XB_SPIN(cond, bar) do { unsigned _sp = 0; while (cond) { __builtin_amdgcn_s_sleep(1); \
    if ((++_sp & 255u) == 0u) { if (xb_ld(&(bar)[XB_TMO])) break; if (_sp > XB_SPIN_CAP) { atomicAdd(&(bar)[XB_TMO], 1u); break; } } } } while (0)
struct XcdBarrier { unsigned* bar; unsigned x; volatile LAS unsigned* st; };
__device__ __forceinline__ XcdBarrier xcd_barrier_post(unsigned* bar, volatile LAS unsigned* st) {
  XcdBarrier b; b.bar = bar; b.x = xb_xcc_id(); b.st = st;
  if (threadIdx.x == 0) (void)xb_add(&bar[XB_XCNT(b.x)], 1u);
  return b;
}
__device__ __forceinline__ void xcd_barrier_complete(unsigned* bar, unsigned x, unsigned& nloc, unsigned& nx) {
  const unsigned G = gridDim.x;
  unsigned sum, cnt, mine, sp = 0u;
  for (;;) {
    sum = 0u; cnt = 0u; mine = 0u;
#pragma unroll
    for (unsigned j = 0; j < 16; ++j) { const unsigned c = xb_ld(&bar[XB_XCNT(j)]); sum += c; cnt += (c > 0u) ? 1u : 0u; mine = (j == x) ? c : mine; }
    if (sum == G) break;
    __builtin_amdgcn_s_sleep(1);
    if ((++sp & 255u) == 0u) { if (xb_ld(&bar[XB_TMO])) break; if (sp > XB_SPIN_CAP) { atomicAdd(&bar[XB_TMO], 1u); break; } }
  }
  nloc = mine > 0u ? mine : 1u; nx = cnt > 0u ? cnt : 1u;
}
__device__ __forceinline__ void xcd_barrier(const XcdBarrier& b) {
  asm volatile("s_waitcnt vmcnt(0)" ::: "memory");
  __syncthreads();
  if (threadIdx.x == 0) {
    unsigned* bar = b.bar;
    __builtin_amdgcn_s_waitcnt(0);
    unsigned nloc = b.st[0], nx = b.st[1];
    if (nloc == 0u) { xcd_barrier_complete(bar, b.x, nloc, nx); b.st[0] = nloc; b.st[1] = nx; }
    const unsigned old = xb_add(&bar[XB_XSUB(b.x)], 1u);
    const unsigned gen = old / nloc;
    if (old + 1u == (gen + 1u) * nloc) {
      __builtin_amdgcn_fence(__ATOMIC_RELEASE, "agent");
      asm volatile("s_waitcnt vmcnt(0)" ::: "memory");
      const unsigned og = xb_add(&bar[XB_TOP], 1u);
      const unsigned tg = og / nx;
      if (og + 1u == (tg + 1u) * nx) xb_add(&bar[XB_TOPGEN], 1u);
      else XB_SPIN(xb_ld(&bar[XB_TOPGEN]) == tg, bar);
      __builtin_amdgcn_fence(__ATOMIC_ACQUIRE, "agent");
      xb_add(&bar[XB_XGEN(b.x)], 1u);
      asm volatile("s_waitcnt vmcnt(0)" ::: "memory");
    } else {
      XB_SPIN(xb_ld(&bar[XB_XGEN(b.x)]) == gen, bar);
      __builtin_amdgcn_fence(__ATOMIC_ACQUIRE, "agent");
      asm volatile("s_waitcnt vmcnt(0)" ::: "memory");
    }
  }
  __syncthreads();
}

constexpr int NSLOTS = 13;
constexpr int NPHASE = 2 + 4 * NSLOTS;
__device__ __forceinline__ bool phase_is_nop(int ph) {
  if (ph < 2) return false;
  const int layer = (ph - 2) / NSLOTS, st = (ph - 2) % NSLOTS;
  if (st == 5 || st == 6) return true;
  return !(layer & 1) && (st == 1 || (st >= 3 && st <= 7));
}
__device__ void run_phase(KP p, int ph, char* sm) {
  if (ph == 0) { ph_init(p, sm); return; }
  if (ph == 1) { ph_mod_h(p, sm); return; }
  const int layer = (ph - 2) / NSLOTS, st = (ph - 2) % NSLOTS;
  const bool odd = layer & 1;
  const bool keep = layer < 3;
  int gk = -1;
  if (st == 0) gk = 0;
  else if (st == 8) gk = 1;
  else if (st == 10) gk = 2;
  else if (st == 11) gk = 3;
  else if (odd && st == 2) gk = 4;
  else if (odd && st == 3) gk = 5;
  asm volatile("" : "+s"(gk));
  if (gk >= 0) {
    if (gk == 2 || gk == 3) moe_prefix(p, keep ? NT : NL, (int*)(sm + META_OFF), opaque_tid());
    ph_gemm(p, gk, layer, keep, sm);
    if (gk == 5) { __syncthreads(); ph_mlstm_s2(p, sm); }
    return;
  }
  switch (st) {
    case 1: if (odd) { ph_rwkv_mix(p, layer); ph_mlstm_s1(p, layer, sm); } break;
    case 2: ph_attention(p, layer, keep, sm); break;
    case 4: if (odd) ph_scan_a(p, layer, sm); break;
    case 7: if (odd) ph_rec_final(p, layer, keep); break;
    case 9: ph_ln_router(p, layer, keep, sm); break;
    case 12: ph_final_ln(p, layer, keep, sm); break;
  }
}

__global__ void __launch_bounds__(NTHR, 2) mega_kernel(Params kargs) {
  extern __shared__ __attribute__((aligned(16))) char sm[];
  cg::grid_group grid = cg::this_grid();
  volatile LAS unsigned* st = (volatile LAS unsigned*)(sm + META_OFF + 4032);
  if (threadIdx.x == 0) { st[0] = 0u; st[1] = 0u; }
  __syncthreads();
  const XcdBarrier xb = xcd_barrier_post(kargs.bar, st);
  for (int ph = kargs.ph_lo; ph < kargs.ph_hi; ++ph) {
    if (phase_is_nop(ph)) continue;
    {
      KP kp = (KP)__builtin_amdgcn_kernarg_segment_ptr();
      asm volatile("" : "+s"(kp));
      run_phase(kp, ph, sm);
    }
    if (ph + 1 < kargs.ph_hi) {
      if (ph == 0) grid.sync();
      else xcd_barrier(xb);
    }
  }
}

extern "C" void kernel_launch(void* const* d_in, const int* in_sizes, int n_in, void* d_out, int out_size, void* d_ws,
                              size_t ws_size, hipStream_t stream) {
  static int grid_blocks = 0;
  if (!grid_blocks) {
    int dev = 0, cus = 0, per_cu = 0;
    (void)hipGetDevice(&dev);
    (void)hipDeviceGetAttribute(&cus, hipDeviceAttributeMultiprocessorCount, dev);
    (void)hipFuncSetAttribute((const void*)mega_kernel, hipFuncAttributeMaxDynamicSharedMemorySize, SMEM_BYTES);
    (void)hipOccupancyMaxActiveBlocksPerMultiprocessor(&per_cu, mega_kernel, NTHR, SMEM_BYTES);
    if (per_cu < 1) per_cu = 1;
    if (per_cu > 2) per_cu = 2;
    grid_blocks = cus * per_cu;
  }
  Params p;
  memset(&p, 0, sizeof(p));
  const float** pin = (const float**)&p;
  for (int i = 0; i < 35; ++i) pin[i] = (const float*)d_in[i];
  p.out = (float*)d_out;
  char* w = (char*)d_ws;
  size_t off = 0;
  auto take = [&](size_t bytes) { char* r = w + off; off += (bytes + 255) & ~(size_t)255; return r; };
  p.Wt_att = (bf16_t*)take((size_t)2 * ATT_N * 1024 * 2);
  p.Wt_rec = (bf16_t*)take((size_t)2 * REC_NP * 1024 * 2);
  p.Wt_out = (bf16_t*)take((size_t)4 * 1024 * 1024 * 2);
  p.Wt13 = (bf16_t*)take((size_t)4 * 65 * 512 * 1024);
  p.Wt2 = (bf16_t*)take((size_t)4 * 65 * 1024 * 256);
  p.Wl1 = (bf16_t*)take((size_t)2 * 3 * 128 * 512 * 2);
  p.Wl2 = (bf16_t*)take((size_t)2 * 2560 * 128 * 2);
  p.X = (float*)take((size_t)NT * DM * 4);
  p.AB = (bf16_t*)take((size_t)NT * DM * 2);
  p.MOD = (float*)take((size_t)5 * 9 * 6144 * 4);
  p.MODP = (float*)take((size_t)8 * 4 * 9 * 6144 * 4);
  p.GP = (float*)take((size_t)NT * 16 * 4);
  p.ROPE = (float*)take((size_t)64 * 16 * 2 * 4);
  p.WrT = (float*)take((size_t)4 * 64 * 1024 * 4);
  p.msc = (float*)take((size_t)3 * NMT * 4);
  p.lgate = (float*)take((size_t)64 * NT * 4);
  p.ltok = (int*)take((size_t)64 * NT * 4);
  p.tsl = (int*)take((size_t)NT * 6 * 4);
  p.cnt = (int*)take((size_t)65 * CSTR * 4);
  p.bar = (unsigned*)take((size_t)BAR_TOTAL_WORDS * 4);
  char* region = take(0);
  const size_t szP = (size_t)NT * LDP * 2, szRW = (size_t)NT * RWS * 2, szMS = (size_t)NMT * 16384 * 2,
               szMSn = (size_t)NMT * 128 * 4;
  const size_t szT = (size_t)NT * DM * 4, szOUT2 = (size_t)NSLOT * 1024 * 2;
  p.P = (bf16_t*)region;
  p.RW = (bf16_t*)(region + szP);
  p.MS = (bf16_t*)(region + szP + szRW);
  p.MSn = (float*)(region + szP + szRW + szMS);
  p.Tb = (float*)region;
  p.ACT = (bf16_t*)region;
  p.OUT2 = (bf16_t*)(region + szT);
  const size_t szZ = (size_t)NT * 2048 * 2;
  p.Zb = (bf16_t*)(region + szP + szRW + szMS + szMSn);
  p.L1 = p.Zb + (size_t)NT * 1536;
  size_t mixer = szP + szRW + szMS + szMSn + szZ, moe = szT + szOUT2;
  off += (mixer > moe ? mixer : moe);
  if (off > ws_size) { fprintf(stderr, "workspace too small: need %zu have %zu\n", off, ws_size); return; }
  p.ph_lo = 0;
  p.ph_hi = NPHASE;
  (void)hipMemsetAsync(p.bar, 0, (size_t)BAR_TOTAL_WORDS * 4, stream);
  void* args[] = {&p};
  hipError_t e = hipLaunchCooperativeKernel((void*)mega_kernel, dim3(grid_blocks), dim3(NTHR), args, SMEM_BYTES, stream);
  if (e != hipSuccess) fprintf(stderr, "cooperative launch failed: %s (grid %d)\n", hipGetErrorString(e), grid_blocks);
}
```

```cpp
#include <hip/hip_runtime.h>
#include <hip/hip_cooperative_groups.h>
#include <cstdio>
#include <cstring>
namespace cg = cooperative_groups;

constexpr int DM = 1024;
constexpr int NBATCH = 8;
constexpr int SEQ = 2048;
constexpr int CTXL = 256;
constexpr int NL = NBATCH * SEQ;
constexpr int NC = NBATCH * CTXL;
constexpr int NT = NL + NC;
constexpr int TSC = CTXL + SEQ;
constexpr int LDP = 4112;
constexpr int ATT_N = 2304;
constexpr int REC_N = 4112;
constexpr int REC_NP = 4224;
constexpr int NCHUNK = 36;
constexpr int NMT = 64 * NCHUNK;
constexpr int RWS = 5632;
constexpr int NSLOT = 137216;
constexpr float DN_ALPHA = 1.6817928305074290f;
constexpr int NTHR = 256;
constexpr int SMEM_BYTES = 65536 + 4096;
constexpr int META_OFF = 65536;
#define XCD_BAR_WORDS 3456
constexpr int CSTR = 32;
constexpr int BAR_TOTAL_WORDS = XCD_BAR_WORDS + 64;

typedef unsigned short bf16_t;
using bf16x8 = __attribute__((ext_vector_type(8))) short;
using f32x16 = __attribute__((ext_vector_type(16))) float;
using u32x4 = __attribute__((ext_vector_type(4))) unsigned;
using u32x2 = __attribute__((ext_vector_type(2))) unsigned;

struct Params {
  const float *x, *c, *ctx, *c_ctx, *ada_w, *ada_b, *ln_g, *ln_b, *mix_w_out, *att_w_in, *na_rpb, *qk_gain,
      *rec_w_in, *rwkv_mu, *rwkv_w0, *rwkv_w1, *rwkv_w2, *rwkv_a0, *rwkv_a1, *rwkv_a2, *rwkv_g1, *rwkv_g2,
      *rwkv_kvec, *rwkv_rk, *rwkv_gn, *mlstm_gate_b, *mlstm_norm, *moe_router, *moe_bias, *moe_w1, *moe_w3,
      *moe_w2, *shared_w1, *shared_w3, *shared_w2;
  float* out;
  bf16_t *Wt_att, *Wt_rec, *Wt_out, *Wt13, *Wt2, *Wl1, *Wl2;
  bf16_t *Zb, *L1;
  float *X, *MOD, *MODP, *GP, *msc, *lgate, *MSn, *Tb, *ROPE, *WrT;
  bf16_t *AB, *P, *RW, *MS, *ACT, *OUT2;
  int *cnt, *ltok, *tsl;
  unsigned* bar;
  int ph_lo, ph_hi;
};

typedef const Params __attribute__((address_space(4))) * KP;

__device__ __forceinline__ int modrow(int t) { return t < NL ? (t >> 11) : 8; }
__device__ __forceinline__ float silu_f(float x) { return x / (1.f + expf(-x)); }
__device__ __forceinline__ float sigm_f(float x) { return 1.f / (1.f + expf(-x)); }
__device__ __forceinline__ float softplus_f(float x) { return fmaxf(x, 0.f) + log1pf(expf(-fabsf(x))); }
template <int CTRL>
__device__ __forceinline__ float dppx(float x) {
  return __int_as_float(__builtin_amdgcn_update_dpp(0, __float_as_int(x), CTRL, 0xf, 0xf, true));
}
__device__ __forceinline__ float rdlane(float v, int l) {
  return __int_as_float(__builtin_amdgcn_readlane(__float_as_int(v), l));
}
__device__ __forceinline__ float wsum(float v) {
  v += dppx<0xB1>(v); v += dppx<0x4E>(v); v += dppx<0x141>(v); v += dppx<0x140>(v);
  return (rdlane(v, 0) + rdlane(v, 16)) + (rdlane(v, 32) + rdlane(v, 48));
}
__device__ __forceinline__ float wmax(float v) {
  v = fmaxf(v, dppx<0xB1>(v)); v = fmaxf(v, dppx<0x4E>(v)); v = fmaxf(v, dppx<0x141>(v)); v = fmaxf(v, dppx<0x140>(v));
  return fmaxf(fmaxf(rdlane(v, 0), rdlane(v, 16)), fmaxf(rdlane(v, 32), rdlane(v, 48)));
}
__device__ __forceinline__ int opaque_tid() {
  int t = threadIdx.x;
  asm volatile("" : "+v"(t));
  return t;
}
typedef __bf16 bf16x2_t __attribute__((ext_vector_type(2)));
typedef float f32x2_t __attribute__((ext_vector_type(2)));
__device__ __forceinline__ unsigned pk_bf16(float lo, float hi) {
  const f32x2_t v = {lo, hi};
  return __builtin_bit_cast(unsigned, __builtin_convertvector(v, bf16x2_t));
}
__device__ __forceinline__ bf16_t f2bf(float x) { return (bf16_t)(pk_bf16(x, 0.f) & 0xffffu); }
__device__ __forceinline__ float bf2f(bf16_t v) { return __uint_as_float((unsigned)v << 16); }
__device__ __forceinline__ float bflo(unsigned u) { return __uint_as_float(u << 16); }
__device__ __forceinline__ float bfhi(unsigned u) { return __uint_as_float(u & 0xffff0000u); }
__device__ __forceinline__ int scan_row(int dir, int b, int tau) {
  if (tau < CTXL) return NL + b * CTXL + (dir ? (CTXL - 1 - tau) : tau);
  int s = tau - CTXL;
  return b * SEQ + (dir ? (SEQ - 1 - s) : s);
}

template <class RowPtrA>
__device__ __forceinline__ void gemm128_main(int tid, RowPtrA rowA, const bf16_t* __restrict__ Bt, int K, int n0,
                                             char* lds, f32x16 (&acc)[2][2]) {
  const int lane = tid & 63, w = tid >> 6;
  const int wm = w >> 1, wn = w & 1, r = lane & 31, h = lane >> 5;
  const int c = tid & 7, sr = tid >> 3;
  const int lc = (c ^ ((tid >> 4) & 7)) * 8;
  const bf16_t* ap[4];
#pragma unroll
  for (int i = 0; i < 4; ++i) ap[i] = rowA(sr + 32 * i) + lc;
  const bf16_t* bp0 = Bt + (size_t)(n0 + sr) * K + lc;
  const int bstr = 32 * K;
#pragma unroll
  for (int mi = 0; mi < 2; ++mi)
#pragma unroll
    for (int ni = 0; ni < 2; ++ni)
#pragma unroll
      for (int q = 0; q < 16; ++q) acc[mi][ni][q] = 0.f;
  const int nk = K >> 6;
  auto issue = [&](int kt) {
    char* As = lds + (kt & 1) * 32768 + tid * 16;
    const int k0 = kt * 64;
#pragma unroll
    for (int i = 0; i < 4; ++i) {
      __builtin_amdgcn_global_load_lds((const unsigned*)(ap[i] + k0), (__attribute__((address_space(3))) unsigned*)(As + i * 4096), 16, 0, 0);
      __builtin_amdgcn_global_load_lds((const unsigned*)(bp0 + i * bstr + k0), (__attribute__((address_space(3))) unsigned*)(As + 16384 + i * 4096), 16, 0, 0);
    }
  };
  issue(0);
  const int sw = (r >> 1) & 7;
#pragma unroll 1
  for (int kt = 0; kt < nk; ++kt) {
    asm volatile("s_waitcnt vmcnt(0)" ::: "memory");
    __syncthreads();
    if (kt + 1 < nk) issue(kt + 1);
    const char* As = lds + (kt & 1) * 32768;
    const char* Ar = As + (wm * 64 + r) * 128;
    const char* Br = As + 16384 + (wn * 64 + r) * 128;
#pragma unroll
    for (int ks = 0; ks < 4; ++ks) {
      const int off = ((ks * 2 + h) ^ sw) * 16;
      const bf16x8 a0 = *(const bf16x8*)(Ar + off);
      const bf16x8 a1 = *(const bf16x8*)(Ar + 32 * 128 + off);
      const bf16x8 b0 = *(const bf16x8*)(Br + off);
      const bf16x8 b1 = *(const bf16x8*)(Br + 32 * 128 + off);
      acc[0][0] = __builtin_amdgcn_mfma_f32_32x32x16_bf16(a0, b0, acc[0][0], 0, 0, 0);
      acc[0][1] = __builtin_amdgcn_mfma_f32_32x32x16_bf16(a0, b1, acc[0][1], 0, 0, 0);
      acc[1][0] = __builtin_amdgcn_mfma_f32_32x32x16_bf16(a1, b0, acc[1][0], 0, 0, 0);
      acc[1][1] = __builtin_amdgcn_mfma_f32_32x32x16_bf16(a1, b1, acc[1][1], 0, 0, 0);
    }
  }
  __syncthreads();
}
using i64 = long;
typedef int i32x8 __attribute__((ext_vector_type(8)));
template <class RowPtrA8>
__device__ __forceinline__ void gemm128_fp8(int tid, RowPtrA8 rowA, const unsigned char* __restrict__ Bt, int K, int n0,
                                            char* lds, f32x16 (&acc)[2][2]) {
  const int lane = tid & 63, w = tid >> 6;
  const int wm = w >> 1, wn = w & 1, r = lane & 31, h = lane >> 5;
  const int c = tid & 7, sr = tid >> 3;
  const int lc = (c ^ ((tid >> 4) & 7)) * 16;
  const unsigned char* ap[4];
#pragma unroll
  for (int i = 0; i < 4; ++i) ap[i] = rowA(sr + 32 * i) + lc;
  const unsigned char* bp0 = Bt + (size_t)(n0 + sr) * K + lc;
  const int bstr = 32 * K;
#pragma unroll
  for (int mi = 0; mi < 2; ++mi)
#pragma unroll
    for (int ni = 0; ni < 2; ++ni)
#pragma unroll
      for (int q = 0; q < 16; ++q) acc[mi][ni][q] = 0.f;
  const int nk = K >> 7;
  auto issue = [&](int kt) {
    char* As = lds + (kt & 1) * 32768 + tid * 16;
    const int k0 = kt * 128;
#pragma unroll
    for (int i = 0; i < 4; ++i) {
      __builtin_amdgcn_global_load_lds((const unsigned*)(ap[i] + k0), (__attribute__((address_space(3))) unsigned*)(As + i * 4096), 16, 0, 0);
      __builtin_amdgcn_global_load_lds((const unsigned*)(bp0 + i * bstr + k0), (__attribute__((address_space(3))) unsigned*)(As + 16384 + i * 4096), 16, 0, 0);
    }
  };
  issue(0);
  if (nk > 1) issue(1);
  const int sw = (r >> 1) & 7;
#pragma unroll 1
  for (int kt = 0; kt < nk; ++kt) {
    if (kt == 0 && nk > 1) asm volatile("s_waitcnt vmcnt(8)" ::: "memory");
    else asm volatile("s_waitcnt vmcnt(0)" ::: "memory");
    __syncthreads();
    if (kt > 0 && kt + 1 < nk) issue(kt + 1);
    const char* As = lds + (kt & 1) * 32768;
    const char* Ar = As + (wm * 64 + r) * 128;
    const char* Br = As + 16384 + (wn * 64 + r) * 128;
#pragma unroll
    for (int pq = 0; pq < 2; ++pq) {
      const int o0 = ((4 * pq + 2 * h) ^ sw) * 16, o1 = ((4 * pq + 2 * h + 1) ^ sw) * 16;
      const u32x4 a0l = *(const u32x4*)(Ar + o0), a0h = *(const u32x4*)(Ar + o1);
      const u32x4 a1l = *(const u32x4*)(Ar + 32 * 128 + o0), a1h = *(const u32x4*)(Ar + 32 * 128 + o1);
      const u32x4 b0l = *(const u32x4*)(Br + o0), b0h = *(const u32x4*)(Br + o1);
      const u32x4 b1l = *(const u32x4*)(Br + 32 * 128 + o0), b1h = *(const u32x4*)(Br + 32 * 128 + o1);
      const i32x8 A0 = {(int)a0l.x, (int)a0l.y, (int)a0l.z, (int)a0l.w, (int)a0h.x, (int)a0h.y, (int)a0h.z, (int)a0h.w};
      const i32x8 A1 = {(int)a1l.x, (int)a1l.y, (int)a1l.z, (int)a1l.w, (int)a1h.x, (int)a1h.y, (int)a1h.z, (int)a1h.w};
      const i32x8 B0 = {(int)b0l.x, (int)b0l.y, (int)b0l.z, (int)b0l.w, (int)b0h.x, (int)b0h.y, (int)b0h.z, (int)b0h.w};
      const i32x8 B1 = {(int)b1l.x, (int)b1l.y, (int)b1l.z, (int)b1l.w, (int)b1h.x, (int)b1h.y, (int)b1h.z, (int)b1h.w};
      acc[0][0] = __builtin_amdgcn_mfma_scale_f32_32x32x64_f8f6f4(A0, B0, acc[0][0], 0, 0, 0, 0, 0, 0);
      acc[0][1] = __builtin_amdgcn_mfma_scale_f32_32x32x64_f8f6f4(A0, B1, acc[0][1], 0, 0, 0, 0, 0, 0);
      acc[1][0] = __builtin_amdgcn_mfma_scale_f32_32x32x64_f8f6f4(A1, B0, acc[1][0], 0, 0, 0, 0, 0, 0);
      acc[1][1] = __builtin_amdgcn_mfma_scale_f32_32x32x64_f8f6f4(A1, B1, acc[1][1], 0, 0, 0, 0, 0, 0);
    }
  }
  __syncthreads();
}
template <class F>
__device__ __forceinline__ void acc_foreach(int tid, const f32x16 (&acc)[2][2], F f) {
  const int lane = tid & 63, w = tid >> 6;
  const int wm = w >> 1, wn = w & 1, r = lane & 31, h = lane >> 5;
#pragma unroll
  for (int mi = 0; mi < 2; ++mi)
#pragma unroll
    for (int ni = 0; ni < 2; ++ni)
#pragma unroll
      for (int q = 0; q < 16; ++q) {
        const int row = wm * 64 + mi * 32 + (q & 3) + 8 * (q >> 2) + 4 * h;
        const int col = wn * 64 + ni * 32 + r;
        f(row, col, acc[mi][ni][q]);
        if ((q & 3) == 3) __builtin_amdgcn_sched_barrier(0);
      }
}

template <class RM>
__device__ __forceinline__ void tr_tile(int tid, const float* __restrict__ src, int N, int k0, int n0,
                                        bf16_t* __restrict__ dst, int K, RM rowmap, float* tile) {
  {
    const int tx = tid & 15, ty = tid >> 4;
    const int n = n0 + tx * 4;
#pragma unroll
    for (int i = 0; i < 4; ++i) {
      const int k = ty + 16 * i;
      float4 v = make_float4(0.f, 0.f, 0.f, 0.f);
      if (n < N) v = *(const float4*)(src + (size_t)(k0 + k) * N + n);
      tile[k * 65 + tx * 4 + 0] = v.x; tile[k * 65 + tx * 4 + 1] = v.y;
      tile[k * 65 + tx * 4 + 2] = v.z; tile[k * 65 + tx * 4 + 3] = v.w;
    }
  }
  __syncthreads();
  {
    const int kc = tid & 7;
#pragma unroll
    for (int i = 0; i < 2; ++i) {
      const int n = (tid >> 3) + 32 * i;
      if (n0 + n < N) {
        float v[8];
#pragma unroll
        for (int q = 0; q < 8; ++q) v[q] = tile[(kc * 8 + q) * 65 + n];
        u32x4 o;
        o.x = pk_bf16(v[0], v[1]); o.y = pk_bf16(v[2], v[3]); o.z = pk_bf16(v[4], v[5]); o.w = pk_bf16(v[6], v[7]);
        *(u32x4*)(dst + (size_t)rowmap(n0 + n) * K + k0 + kc * 8) = o;
      }
    }
  }
  __syncthreads();
}

constexpr float W8_SCALE = 32.f, W8_INV = 1.f / 32.f;
__device__ __forceinline__ unsigned pk_fp8x4(float a, float b, float c, float d) {
  int r = __builtin_amdgcn_cvt_pk_fp8_f32(a, b, 0, false);
  r = __builtin_amdgcn_cvt_pk_fp8_f32(c, d, r, true);
  return (unsigned)r;
}
__device__ __forceinline__ unsigned pk_fp8x4c(float a, float b, float c, float d) {
  constexpr float M = 448.f;
  return pk_fp8x4(fminf(fmaxf(a, -M), M), fminf(fmaxf(b, -M), M), fminf(fmaxf(c, -M), M), fminf(fmaxf(d, -M), M));
}
template <class RM>
__device__ __forceinline__ void tr_tile_fp8(int tid, const float* __restrict__ src, int N, int k0, int n0,
                                            unsigned char* __restrict__ dst, int K, RM rowmap, float* tile) {
  {
    const int tx = tid & 15, ty = tid >> 4;
    const int n = n0 + tx * 4;
#pragma unroll
    for (int i = 0; i < 4; ++i) {
      const int k = ty + 16 * i;
      float4 v = make_float4(0.f, 0.f, 0.f, 0.f);
      if (n < N) v = *(const float4*)(src + (size_t)(k0 + k) * N + n);
      tile[k * 65 + tx * 4 + 0] = v.x; tile[k * 65 + tx * 4 + 1] = v.y;
      tile[k * 65 + tx * 4 + 2] = v.z; tile[k * 65 + tx * 4 + 3] = v.w;
    }
  }
  __syncthreads();
  {
    const int kc = tid & 3, n = tid >> 2;
    float v[16];
#pragma unroll
    for (int q = 0; q < 16; ++q) v[q] = tile[(kc * 16 + q) * 65 + n] * W8_SCALE;
    u32x4 o;
    o.x = pk_fp8x4c(v[0], v[1], v[2], v[3]); o.y = pk_fp8x4c(v[4], v[5], v[6], v[7]);
    o.z = pk_fp8x4c(v[8], v[9], v[10], v[11]); o.w = pk_fp8x4c(v[12], v[13], v[14], v[15]);
    *(u32x4*)(dst + (size_t)rowmap(n0 + n) * K + k0 + kc * 16) = o;
  }
  __syncthreads();
}

constexpr int CJ0 = 1152, CJ1 = CJ0 + 2080, CJ2 = CJ1 + 1024, CJ3 = CJ2 + 33280, CJ4 = CJ3 + 16640;
__device__ void convert_job(KP p, int job, float* sm, int tid) {
  if (job < CJ0) {
    const int j = job / 576, rem = job % 576, kt = rem / 36, nt = rem % 36;
    tr_tile_fp8(tid, p->att_w_in + (size_t)j * 1024 * ATT_N, ATT_N, kt * 64, nt * 64, (unsigned char*)p->Wt_att + (size_t)j * ATT_N * 1024,
                1024, [](int n) { return n; }, sm);
  } else if (job < CJ1) {
    const int q = job - CJ0;
    const int j = q / 1040, rem = q % 1040, kt = rem / 65, nt = rem % 65;
    tr_tile_fp8(tid, p->rec_w_in + (size_t)j * 1024 * REC_N, REC_N, kt * 64, nt * 64, (unsigned char*)p->Wt_rec + (size_t)j * REC_NP * 1024,
                1024, [](int n) { return n; }, sm);
  } else if (job < CJ2) {
    const int q = job - CJ1;
    const int i = q >> 8, rem = q & 255, kt = rem >> 4, nt = rem & 15;
    tr_tile_fp8(tid, p->mix_w_out + (size_t)i * 1024 * 1024, 1024, kt * 64, nt * 64, (unsigned char*)p->Wt_out + (size_t)i * 1024 * 1024,
                1024, [](int n) { return n; }, sm);
  } else if (job < CJ3) {
    const int q = job - CJ2;
    const int le = q >> 7, rem = q & 127;
    const int which = rem >> 6, kt = (rem >> 2) & 15, nt = rem & 3;
    const int layer = le / 65, e = le % 65;
    const float* src;
    if (e < 64) src = (which ? p->moe_w3 : p->moe_w1) + (size_t)(layer * 64 + e) * 1024 * 256;
    else src = (which ? p->shared_w3 : p->shared_w1) + (size_t)layer * 1024 * 256;
    tr_tile_fp8(tid, src, 256, kt * 64, nt * 64, (unsigned char*)p->Wt13 + (size_t)le * 512 * 1024, 1024,
                [which](int n) { return 64 * (n >> 5) + which * 32 + (n & 31); }, sm);
  } else {
    const int q = job - CJ3;
    const int le = q >> 6, rem = q & 63;
    const int kt = rem >> 4, nt = rem & 15;
    const int layer = le / 65, e = le % 65;
    const float* src = e < 64 ? p->moe_w2 + (size_t)(layer * 64 + e) * 256 * 1024 : p->shared_w2 + (size_t)layer * 256 * 1024;
    tr_tile_fp8(tid, src, 1024, kt * 64, nt * 64, (unsigned char*)p->Wt2 + (size_t)le * 1024 * 256, 256, [](int n) { return n; }, sm);
  }
}
__device__ __forceinline__ int conv_stage_total(int stage) {
  return stage == 0 ? (576 + 1040 + 512 + 8320 + 4160) : (stage == 1 ? (576 + 1040 + 256 + 16640 + 8320) : (256 + 8320 + 4160));
}
__device__ __forceinline__ int conv_stage_job(int stage, int q) {
  if (stage == 0) {
    if (q < 8320) return CJ2 + q;  q -= 8320;
    if (q < 4160) return CJ3 + q;  q -= 4160;
    if (q < 576) return q;  q -= 576;
    if (q < 1040) return CJ0 + q;  q -= 1040;
    return CJ1 + q;
  } else if (stage == 1) {
    if (q < 8320) return CJ2 + 8320 + q;  q -= 8320;
    if (q < 4160) return CJ3 + 4160 + q;  q -= 4160;
    if (q < 576) return 576 + q;  q -= 576;
    if (q < 256) return CJ1 + 512 + q;  q -= 256;
    if (q < 8320) return CJ2 + 16640 + q;  q -= 8320;
    if (q < 4160) return CJ3 + 8320 + q;  q -= 4160;
    return CJ0 + 1040 + q;
  }
  if (q < 256) return CJ1 + 768 + q;  q -= 256;
  if (q < 8320) return CJ2 + 24960 + q;  q -= 8320;
  return CJ3 + 12480 + q;
}

struct CvDesc { const float* src; unsigned char* dst; int N, K, k0, n0, which; };
__device__ __forceinline__ bool conv_desc_fp8(KP p, int job, CvDesc& d) {
  if (job < CJ2) return false;
  if (job < CJ3) {
    const int q = job - CJ2;
    const int le = q >> 7, rem = q & 127;
    const int which = rem >> 6, kt = (rem >> 2) & 15, nt = rem & 3;
    const int layer = le / 65, e = le % 65;
    if (e < 64) d.src = (which ? p->moe_w3 : p->moe_w1) + (size_t)(layer * 64 + e) * 1024 * 256;
    else d.src = (which ? p->shared_w3 : p->shared_w1) + (size_t)layer * 1024 * 256;
    d.dst = (unsigned char*)p->Wt13 + (size_t)le * 512 * 1024;
    d.N = 256; d.K = 1024; d.k0 = kt * 64; d.n0 = nt * 64; d.which = which;
  } else {
    const int q = job - CJ3;
    const int le = q >> 6, rem = q & 63;
    const int kt = rem >> 4, nt = rem & 15;
    const int layer = le / 65, e = le % 65;
    d.src = e < 64 ? p->moe_w2 + (size_t)(layer * 64 + e) * 256 * 1024 : p->shared_w2 + (size_t)layer * 256 * 1024;
    d.dst = (unsigned char*)p->Wt2 + (size_t)le * 1024 * 256;
    d.N = 1024; d.K = 256; d.k0 = kt * 64; d.n0 = nt * 64; d.which = -1;
  }
  return true;
}
typedef float cvf4 __attribute__((ext_vector_type(4)));
__device__ __forceinline__ void cv_load(const CvDesc& d, int tid, cvf4& v0, cvf4& v1, cvf4& v2, cvf4& v3) {
  const int tx = tid & 15, ty = tid >> 4;
  const float* s0 = d.src + (size_t)(d.k0 + ty) * d.N + d.n0 + tx * 4;
  v0 = *(const cvf4*)(s0);
  v1 = *(const cvf4*)(s0 + (size_t)16 * d.N);
  v2 = *(const cvf4*)(s0 + (size_t)32 * d.N);
  v3 = *(const cvf4*)(s0 + (size_t)48 * d.N);
}
__device__ __forceinline__ void cv_emit(const CvDesc& d, int tid, const cvf4 v0, const cvf4 v1, const cvf4 v2, const cvf4 v3, float* tile) {
  {
    const int tx = tid & 15, ty = tid >> 4;
    float* t0 = tile + ty * 65 + tx * 4;
    t0[0] = v0.x; t0[1] = v0.y; t0[2] = v0.z; t0[3] = v0.w;
    t0[16 * 65 + 0] = v1.x; t0[16 * 65 + 1] = v1.y; t0[16 * 65 + 2] = v1.z; t0[16 * 65 + 3] = v1.w;
    t0[32 * 65 + 0] = v2.x; t0[32 * 65 + 1] = v2.y; t0[32 * 65 + 2] = v2.z; t0[32 * 65 + 3] = v2.w;
    t0[48 * 65 + 0] = v3.x; t0[48 * 65 + 1] = v3.y; t0[48 * 65 + 2] = v3.z; t0[48 * 65 + 3] = v3.w;
  }
  __syncthreads();
  {
    const int kc = tid & 3, n = tid >> 2;
    float v[16];
#pragma unroll
    for (int q = 0; q < 16; ++q) v[q] = tile[(kc * 16 + q) * 65 + n] * W8_SCALE;
    u32x4 o;
    o.x = pk_fp8x4c(v[0], v[1], v[2], v[3]); o.y = pk_fp8x4c(v[4], v[5], v[6], v[7]);
    o.z = pk_fp8x4c(v[8], v[9], v[10], v[11]); o.w = pk_fp8x4c(v[12], v[13], v[14], v[15]);
    const int nn = d.n0 + n;
    const int row = d.which >= 0 ? 64 * (nn >> 5) + d.which * 32 + (nn & 31) : nn;
    *(u32x4*)(d.dst + (size_t)row * d.K + d.k0 + kc * 16) = o;
  }
  __syncthreads();
}
__device__ __forceinline__ void convert_run(KP p, int stage, int jj, int j1, float* sm, int tid) {
  CvDesc d, dn;
  cvf4 a0, a1, a2, a3, b0, b1, b2, b3;
  bool cur = false;
#pragma unroll 1
  for (; jj < j1; ++jj) {
    const int job = conv_stage_job(stage, jj);
    if (!cur) {
      if (!conv_desc_fp8(p, job, d)) { convert_job(p, job, sm, tid); continue; }
      cv_load(d, tid, a0, a1, a2, a3);
    }
    bool nxt = false;
    if (jj + 1 < j1) {
      nxt = conv_desc_fp8(p, conv_stage_job(stage, jj + 1), dn);
      if (nxt) cv_load(dn, tid, b0, b1, b2, b3);
    }
    cv_emit(d, tid, a0, a1, a2, a3, sm);
    if (nxt) { d = dn; a0 = b0; a1 = b1; a2 = b2; a3 = b3; }
    cur = nxt;
  }
}

__device__ void ph_init(KP p, char* smc) {
  float* sm = (float*)smc;
  const int tid = opaque_tid();
  {
    const size_t n4a = (size_t)NL * DM / 4, n4b = (size_t)NC * DM / 4;
    const float4* xs = (const float4*)p->x;
    const float4* cs = (const float4*)p->ctx;
    float4* X4 = (float4*)p->X;
    for (size_t i = (size_t)blockIdx.x * NTHR + tid; i < n4a + n4b; i += (size_t)gridDim.x * NTHR)
      X4[i] = i < n4a ? xs[i] : cs[i - n4a];
  }
  for (int tile = blockIdx.x; tile < 96 * 8; tile += gridDim.x) {
    const int ct = tile >> 3, ks = tile & 7;
    for (int i = tid; i < 9 * 128; i += NTHR) {
      const int r = i >> 7, k = ks * 128 + (i & 127);
      const float v = r < 8 ? p->c[r * 1024 + k] : p->c_ctx[k];
      sm[i] = silu_f(v);
    }
    __syncthreads();
    const int col = ct * 256 + tid;
    const int layer = col / 6144, n = col % 6144;
    const float* W = p->ada_w + ((size_t)layer * 1024 + ks * 128) * 6144 + n;
    float acc[9];
#pragma unroll
    for (int r = 0; r < 9; ++r) acc[r] = 0.f;
#pragma unroll 4
    for (int k = 0; k < 128; ++k) {
      const float w = W[(size_t)k * 6144];
#pragma unroll
      for (int r = 0; r < 9; ++r) acc[r] = fmaf(sm[r * 128 + k], w, acc[r]);
    }
#pragma unroll
    for (int r = 0; r < 9; ++r) p->MODP[((size_t)(ks * 4 + layer) * 9 + r) * 6144 + n] = acc[r];
    __syncthreads();
  }
  {
    const int total = conv_stage_total(0), chunk = (total + gridDim.x - 1) / gridDim.x;
    const int lo = min((int)blockIdx.x * chunk, total), hi = min(lo + chunk, total);
    __syncthreads();
    convert_run(p, 0, lo, hi, sm, tid);
  }
  for (int i = blockIdx.x * NTHR + tid; i < 2 * 3 * 128 * 512; i += gridDim.x * NTHR) {
    const int k = i & 511, n = (i >> 9) & 127, wj = i >> 16;
    const int j = wj / 3, which = wj % 3;
    float v = 0.f;
    if (which < 2) {
      if (n < 64) v = (which ? p->rwkv_a1 : p->rwkv_w1)[((size_t)(j * 2 + (n >> 5)) * 512 + k) * 32 + (n & 31)];
    } else if (n < 96) v = p->rwkv_g1[((size_t)j * 512 + k) * 96 + n];
    p->Wl1[i] = f2bf(v);
  }
  for (int i = blockIdx.x * NTHR + tid; i < 2 * 2560 * 128; i += gridDim.x * NTHR) {
    const int k = i & 127, n = (i >> 7) % 2560, j = i / (2560 * 128);
    float v = 0.f;
    if (n < 2048) {
      const int d = (n >> 9) & 1, c = n & 511;
      if (k < 64 && (k >> 5) == d) v = (n < 1024 ? p->rwkv_w2 : p->rwkv_a2)[((size_t)(j * 2 + d) * 32 + (k & 31)) * 512 + c];
    } else if (k < 96) v = p->rwkv_g2[((size_t)j * 96 + k) * 512 + (n - 2048)];
    p->Wl2[i] = f2bf(v);
  }
  for (int i = blockIdx.x * NTHR + tid; i < 4 * 64 * 1024; i += gridDim.x * NTHR) {
    const int k = i & 1023, n = (i >> 10) & 63, l = i >> 16;
    p->WrT[i] = p->moe_router[((size_t)l * 1024 + k) * 64 + n];
  }
  for (int i = blockIdx.x * NTHR + tid; i < 64 * 16; i += gridDim.x * NTHR) {
    const int pos = i >> 4, f = i & 15;
    const float ang = (float)pos * powf(10000.f, -(float)f / 16.f);
    p->ROPE[2 * i] = cosf(ang);
    p->ROPE[2 * i + 1] = sinf(ang);
  }
}

__device__ void ph_mod_h(KP p, char* smc) {
  float* sm = (float*)smc;
  const int tid = opaque_tid();
  for (int i = blockIdx.x * NTHR + tid; i < 4 * 9 * 6144; i += gridDim.x * NTHR) {
    const int layer = i / (9 * 6144), rem = i % (9 * 6144), n = rem % 6144;
    float s = p->ada_b[layer * 6144 + n];
#pragma unroll
    for (int ks = 0; ks < 8; ++ks) s += p->MODP[(size_t)(ks * 4 + layer) * 9 * 6144 + rem];
    p->MOD[i] = s;
  }
  const int lane = tid & 63, wave = tid >> 6;
  const int per = (((NT + gridDim.x - 1) / gridDim.x) + 3) & ~3;
  const int t0 = blockIdx.x * per, t1 = min(NT, t0 + per);
  int cur = -1;
  for (int tb = t0; tb < t1; tb += 4) {
    const int mr = modrow(tb);
    if (mr != cur) {
      __syncthreads();
      for (int n = tid; n < 2048; n += NTHR) {
        float a = p->ada_b[n];
#pragma unroll
        for (int ks = 0; ks < 8; ++ks) a += p->MODP[((size_t)(ks * 4) * 9 + mr) * 6144 + n];
        sm[n] = a;
      }
      cur = mr;
      __syncthreads();
    }
    const int t = tb + wave;
    if (t < t1) {
      const float* src = t < NL ? p->x + (size_t)t * DM : p->ctx + (size_t)(t - NL) * DM;
#pragma unroll
      for (int i = 0; i < 4; ++i) {
        const int n = i * 256 + lane * 4;
        const float4 xv = *(const float4*)(src + n);
        const float4 sh = *(const float4*)(sm + n);
        const float4 sc = *(const float4*)(sm + 1024 + n);
        *(unsigned*)((unsigned char*)p->AB + (size_t)t * DM + n) =
            pk_fp8x4c(xv.x * (1.f + sc.x) + sh.x, xv.y * (1.f + sc.y) + sh.y, xv.z * (1.f + sc.z) + sh.z, xv.w * (1.f + sc.w) + sh.w);
      }
    }
  }
}

typedef short v4i16_t __attribute__((ext_vector_type(4)));
using s16x4 = __attribute__((ext_vector_type(4))) short;
__device__ __forceinline__ s16x4 vtr(const char* p) {
  return __builtin_bit_cast(s16x4, __builtin_amdgcn_ds_read_tr16_b64_v4i16((__attribute__((address_space(3))) v4i16_t*)p));
}
#define MFMA32(a, b, c) __builtin_amdgcn_mfma_f32_32x32x16_bf16(a, b, c, 0, 0, 0)
__device__ void ph_attention(KP p, int layer, bool keep, char* lds) {
  const int tid = opaque_tid();
  const int lane = tid & 63, w = tid >> 6, r32 = lane & 31, hi = lane >> 5;
  const int j = layer >> 1;
  float* bias_lds = (float*)(lds + 32768 + 1024);
  const int n_gqa = 1024, n_na = 1024, n_cb = keep ? 128 : 0, n_ca = keep ? 128 : 0;
  const int total = n_gqa + n_na + n_cb + n_ca;
  constexpr float LOG2E = 1.4426950408889634f;
  constexpr float C2 = 0.125f * LOG2E;
  const int c = tid & 7, sr = tid >> 3;
  const int kso = (c ^ ((tid >> 4) & 7)) * 16;
  const int vso = (c >> 2) * 4096 + (c & 3) * 16;
  const int sw = (r32 >> 1) & 7;
  for (int vitem = blockIdx.x; vitem < total; vitem += gridDim.x) {
    int item = vitem;
    if (gridDim.x == 512) {
      const int cls0 = vitem < n_gqa ? 0 : (vitem < n_gqa + n_na ? n_gqa : (vitem < n_gqa + n_na + n_cb ? n_gqa + n_na : n_gqa + n_na + n_cb));
      const int vl = vitem - cls0, b9 = vl & 511, r9 = vl >> 9;
      item = cls0 + (cls0 < n_gqa + n_na ? 128 * (b9 & 7) + 64 * r9 + (b9 >> 3) : 16 * (b9 & 7) + (b9 >> 3));
    }
    int b, qrow0, qoff, koff, voff, ocol, lat_tiles, lat_row0;
    bool na = false;
    int r_w = 0, start_w = 0, ru0 = 0, hN = 0;
    if (item < n_gqa) {
      b = item >> 7;
      const int g = (item >> 6) & 1, tt = item & 63;
      qrow0 = b * SEQ + tt * 32; qoff = 1536 + (g * 4 + w) * 64; koff = 2048 + g * 64; voff = 2176 + g * 64;
      ocol = 512 + (g * 4 + w) * 64; lat_tiles = 32; lat_row0 = b * SEQ;
    } else if (item < n_gqa + n_na) {
      const int it = item - n_gqa;
      b = it >> 7; hN = (it >> 4) & 7;
      const int rp = it & 15;
      na = true; r_w = 2 * rp + (w >> 1);
      qrow0 = b * SEQ + r_w * 64 + (w & 1) * 32; qoff = hN * 64; koff = 512 + hN * 64; voff = 1024 + hN * 64; ocol = hN * 64;
      const int s0 = min(max(2 * rp - 4, 0), 24), s1 = min(max(2 * rp - 3, 0), 24);
      start_w = (w >> 1) ? s1 : s0; ru0 = s0; lat_tiles = (s1 != s0) ? 9 : 8; lat_row0 = b * SEQ + ru0 * 64;
    } else if (item < n_gqa + n_na + n_cb) {
      const int it = item - n_gqa - n_na;
      b = it >> 4;
      const int g = (it >> 3) & 1, tt = it & 7;
      qrow0 = NL + b * CTXL + tt * 32; qoff = 1536 + (g * 4 + w) * 64; koff = 2048 + g * 64; voff = 2176 + g * 64;
      ocol = 512 + (g * 4 + w) * 64; lat_tiles = 0; lat_row0 = 0;
    } else {
      const int it = item - n_gqa - n_na - n_cb;
      b = it >> 4;
      const int h = (it >> 1) & 7, half = it & 1;
      qrow0 = NL + b * CTXL + half * 128 + w * 32; qoff = h * 64; koff = 512 + h * 64; voff = 1024 + h * 64; ocol = h * 64;
      lat_tiles = 0; lat_row0 = 0;
    }
    const int ctx_row0 = NL + b * CTXL, ntiles = lat_tiles + 4;
    if (na)
      for (int i = tid; i < 465; i += NTHR) bias_lds[i] = p->na_rpb[(j * 8 + hN) * 465 + i] * LOG2E;
    bf16x8 qf[4];
    {
      const bf16_t* qp = p->P + (size_t)(qrow0 + r32) * LDP + qoff + hi * 8;
#pragma unroll
      for (int d0 = 0; d0 < 4; ++d0) qf[d0] = *(const bf16x8*)(qp + d0 * 16);
    }
    f32x16 o0, o1;
#pragma unroll
    for (int q = 0; q < 16; ++q) { o0[q] = 0.f; o1[q] = 0.f; }
    float m = -INFINITY, l = 0.f;
    u32x4 kr0, kr1, vr0, vr1;
    auto gload = [&](int t) {
      const int row0 = t < lat_tiles ? lat_row0 + 64 * t : ctx_row0 + 64 * (t - lat_tiles);
      const bf16_t* base = p->P + (size_t)(row0 + sr) * LDP + c * 8;
      kr0 = *(const u32x4*)(base + koff); kr1 = *(const u32x4*)(base + (size_t)32 * LDP + koff);
      vr0 = *(const u32x4*)(base + voff); vr1 = *(const u32x4*)(base + (size_t)32 * LDP + voff);
    };
    auto swrite = [&](int buf) {
      char* Kb = lds + buf * 16384;
      char* Vb = Kb + 8192;
      *(u32x4*)(Kb + sr * 128 + kso) = kr0; *(u32x4*)(Kb + (sr + 32) * 128 + kso) = kr1;
      *(u32x4*)(Vb + vso + sr * 64) = vr0; *(u32x4*)(Vb + vso + (sr + 32) * 64) = vr1;
    };
    gload(0);
    swrite(0);
    for (int t = 0; t < ntiles; ++t) {
      __syncthreads();
      if (t + 1 < ntiles) gload(t + 1);
      const bool na_tile = na && t < lat_tiles;
      const int kr = ru0 + t;
      const bool part = !na_tile || (kr >= start_w && kr < start_w + 8);
      if (part) {
        const char* Ks = lds + (t & 1) * 16384;
        const char* Vs = Ks + 8192;
        f32x16 s0, s1;
#pragma unroll
        for (int q = 0; q < 16; ++q) { s0[q] = 0.f; s1[q] = 0.f; }
#pragma unroll
        for (int d0 = 0; d0 < 4; ++d0) {
          const int off = ((2 * d0 + hi) ^ sw) * 16;
          const bf16x8 k0 = *(const bf16x8*)(Ks + r32 * 128 + off);
          const bf16x8 k1 = *(const bf16x8*)(Ks + (32 + r32) * 128 + off);
          s0 = MFMA32(k0, qf[d0], s0);
          s1 = MFMA32(k1, qf[d0], s1);
        }
        float mx = -INFINITY;
        if (na_tile) {
          const int cq = (w & 1) * 32 + r32;
          const int c0 = min(max(cq - 8, 0), 48);
          const float* brow = bias_lds + (kr - r_w + 7) * 31 + (15 - cq);
#pragma unroll
          for (int q = 0; q < 16; ++q) {
            const int kc = (q & 3) + 8 * (q >> 2) + 4 * hi;
            const float v0 = ((unsigned)(kc - c0) < 16u) ? fmaf(s0[q], C2, brow[kc]) : -INFINITY;
            const float v1 = ((unsigned)(kc + 32 - c0) < 16u) ? fmaf(s1[q], C2, brow[kc + 32]) : -INFINITY;
            s0[q] = v0; s1[q] = v1;
            mx = fmaxf(mx, fmaxf(v0, v1));
          }
        } else {
#pragma unroll
          for (int q = 0; q < 16; ++q) {
            s0[q] *= C2; s1[q] *= C2;
            mx = fmaxf(mx, fmaxf(s0[q], s1[q]));
          }
        }
        {
          auto rr = __builtin_amdgcn_permlane32_swap(__float_as_uint(mx), __float_as_uint(mx), false, false);
          mx = fmaxf(__uint_as_float(rr[0]), __uint_as_float(rr[1]));
        }
        const float mnew = fmaxf(m, mx);
        const float alpha = __builtin_amdgcn_exp2f(m - mnew);
        float ls = 0.f;
#pragma unroll
        for (int q = 0; q < 16; ++q) {
          s0[q] = __builtin_amdgcn_exp2f(s0[q] - mnew);
          s1[q] = __builtin_amdgcn_exp2f(s1[q] - mnew);
          ls += s0[q] + s1[q];
        }
        l = l * alpha + ls;
        m = mnew;
#pragma unroll
        for (int q = 0; q < 16; ++q) { o0[q] *= alpha; o1[q] *= alpha; }
        bf16x8 pf[4];
#pragma unroll
        for (int s = 0; s < 4; ++s) {
          const int u = (s & 1) * 8;
          u32x4 tpk;
          if (s < 2) {
            tpk.x = pk_bf16(s0[u + 0], s0[u + 1]); tpk.y = pk_bf16(s0[u + 2], s0[u + 3]);
            tpk.z = pk_bf16(s0[u + 4], s0[u + 5]); tpk.w = pk_bf16(s0[u + 6], s0[u + 7]);
          } else {
            tpk.x = pk_bf16(s1[u + 0], s1[u + 1]); tpk.y = pk_bf16(s1[u + 2], s1[u + 3]);
            tpk.z = pk_bf16(s1[u + 4], s1[u + 5]); tpk.w = pk_bf16(s1[u + 6], s1[u + 7]);
          }
          pf[s] = __builtin_bit_cast(bf16x8, tpk);
        }
        const char* vb = Vs + ((lane >> 4) & 1) * 32 + (lane & 3) * 8 + ((lane & 15) >> 2) * 64 + hi * 256;
#pragma unroll
        for (int s = 0; s < 4; ++s) {
          const s16x4 a00 = vtr(vb + (16 * s) * 64), a01 = vtr(vb + (16 * s + 8) * 64);
          const s16x4 a10 = vtr(vb + 4096 + (16 * s) * 64), a11 = vtr(vb + 4096 + (16 * s + 8) * 64);
          const bf16x8 A0 = __builtin_shufflevector(a00, a01, 0, 1, 2, 3, 4, 5, 6, 7);
          const bf16x8 A1 = __builtin_shufflevector(a10, a11, 0, 1, 2, 3, 4, 5, 6, 7);
          o0 = MFMA32(A0, pf[s], o0);
          o1 = MFMA32(A1, pf[s], o1);
        }
      }
      if (t + 1 < ntiles) swrite((t + 1) & 1);
    }
    __syncthreads();
    const float lt = l + __shfl_xor(l, 32);
    const float inv = 1.f / lt;
    unsigned char* op = (unsigned char*)p->AB + (size_t)(qrow0 + r32) * DM + ocol + 4 * hi;
#pragma unroll
    for (int g = 0; g < 4; ++g) {
      *(unsigned*)(op + 8 * g) = pk_fp8x4c(o0[4 * g] * inv, o0[4 * g + 1] * inv, o0[4 * g + 2] * inv, o0[4 * g + 3] * inv);
      *(unsigned*)(op + 32 + 8 * g) = pk_fp8x4c(o1[4 * g] * inv, o1[4 * g + 1] * inv, o1[4 * g + 2] * inv, o1[4 * g + 3] * inv);
    }
  }
}

__device__ void ph_rwkv_mix(KP p, int layer) {
  const int j = layer >> 1;
  const int tid = opaque_tid();
  const int lane = tid & 63, wave = tid >> 6;
  const float* mu = p->rwkv_mu + j * 6 * 512;
  const int c0 = lane * 8;
  auto unpack = [](const u32x4 u, float (&f)[8]) {
    f[0] = bflo(u.x); f[1] = bfhi(u.x); f[2] = bflo(u.y); f[3] = bfhi(u.y);
    f[4] = bflo(u.z); f[5] = bfhi(u.z); f[6] = bflo(u.w); f[7] = bfhi(u.w);
  };
  auto pack = [](const float (&f)[8]) {
    u32x4 o;
    o.x = pk_bf16(f[0], f[1]); o.y = pk_bf16(f[2], f[3]); o.z = pk_bf16(f[4], f[5]); o.w = pk_bf16(f[6], f[7]);
    return o;
  };
  for (int t = blockIdx.x * 4 + wave; t < NT; t += gridDim.x * 4) {
    bool hasp, hasn;
    if (t < NL) { int s = t & 2047; hasp = s > 0; hasn = s < SEQ - 1; }
    else { int s = (t - NL) & 255; hasp = s > 0; hasn = s < CTXL - 1; }
    const bf16_t* pt = p->P + (size_t)t * LDP + c0;
    bf16_t* rw = p->RW + (size_t)t * RWS + c0;
    bf16_t* zb = p->Zb + (size_t)t * 1536 + c0;
    const u32x4 zero = {0u, 0u, 0u, 0u};
#pragma unroll
    for (int q = 0; q < 4; ++q) {
      float cur[8], pv[8], nx[8], d[8];
      unpack(*(const u32x4*)(pt + q * 512), cur);
      unpack(hasp ? *(const u32x4*)(pt + q * 512 - LDP) : zero, pv);
      unpack(hasn ? *(const u32x4*)(pt + q * 512 + LDP) : zero, nx);
#pragma unroll
      for (int e = 0; e < 8; ++e) d[e] = 0.5f * (pv[e] + nx[e]) - cur[e];
      if (q < 3) {
        float o[8];
        const float* m = mu + q * 512 + c0;
#pragma unroll
        for (int e = 0; e < 8; ++e) o[e] = cur[e] + d[e] * m[e];
        if (q == 0) *(u32x4*)(rw) = pack(o);
        else if (q == 2) *(u32x4*)(rw + 512) = pack(o);
        else {
          *(u32x4*)(rw + 10 * 512) = pack(o);
          float kk[8], ss = 0.f;
          const float* kv0 = p->rwkv_kvec + (j * 2 + 0) * 512 + c0;
#pragma unroll
          for (int e = 0; e < 8; ++e) { kk[e] = o[e] * kv0[e]; ss += kk[e] * kk[e]; }
          ss += dppx<0xB1>(ss); ss += dppx<0x4E>(ss); ss += dppx<0x141>(ss);
          const float rn = rsqrtf(fmaxf(ss, 1e-24f));
#pragma unroll
          for (int e = 0; e < 8; ++e) kk[e] *= rn;
          *(u32x4*)(rw + 2 * 512) = pack(kk);
        }
      } else {
#pragma unroll
        for (int z = 0; z < 3; ++z) {
          float o[8];
          const float* m = mu + (3 + z) * 512 + c0;
#pragma unroll
          for (int e = 0; e < 8; ++e) o[e] = cur[e] + d[e] * m[e];
          *(u32x4*)(zb + z * 512) = pack(o);
        }
      }
    }
  }
}

constexpr int RS_STEP = 384;
constexpr int RS_TB = 16;
struct RwkvStage { u32x2 r, kk, e, ke, a, v; };
__device__ void rwkv_unit(KP p, int unit, float* sm, int tid) {
  const int ch = unit >> 1, hf = unit & 1;
  const int dir = ch >> 6, b = (ch >> 3) & 7, h = ch & 7;
  const int lane = tid & 63, w = tid >> 6, rl = lane >> 3, ks = lane & 7;
  float* ybuf = sm + 2 * RS_TB * RS_STEP;
  const int ss = tid >> 4, kq = tid & 15;
  auto gload = [&](int n, RwkvStage& g) {
    const int row = scan_row(dir, b, n * RS_TB + ss);
    const bf16_t* base = p->RW + (size_t)row * RWS + h * 64 + kq * 4;
    g.r = *(const u32x2*)(base);
    g.kk = *(const u32x2*)(base + 2 * 512);
    g.e = *(const u32x2*)(base + (3 + dir) * 512);
    g.ke = *(const u32x2*)(base + (5 + dir) * 512);
    g.a = *(const u32x2*)(base + (7 + dir) * 512);
    g.v = *(const u32x2*)(p->RW + (size_t)row * RWS + 512 + h * 64 + hf * 32 + (kq & 7) * 4);
  };
  auto swrite = [&](int buf, const RwkvStage& g) {
    float* sp = sm + (buf * RS_TB + ss) * RS_STEP;
    const float r0 = bflo(g.r.x), r1 = bfhi(g.r.x), r2 = bflo(g.r.y), r3 = bfhi(g.r.y);
    const float k0 = bflo(g.kk.x), k1 = bfhi(g.kk.x), k2 = bflo(g.kk.y), k3 = bfhi(g.kk.y);
    const float w0 = __expf(-bflo(g.e.x)), w1 = __expf(-bfhi(g.e.x)), w2 = __expf(-bflo(g.e.y)), w3 = __expf(-bfhi(g.e.y));
    const float e0 = bflo(g.ke.x), e1 = bfhi(g.ke.x), e2 = bflo(g.ke.y), e3 = bfhi(g.ke.y);
    const float a0 = k0 * bflo(g.a.x), a1 = k1 * bfhi(g.a.x), a2 = k2 * bflo(g.a.y), a3 = k3 * bfhi(g.a.y);
    *(float4*)(sp + kq * 4) = make_float4(k0, k1, k2, k3);
    *(float4*)(sp + 64 + kq * 4) = make_float4(w0 * r0, w1 * r1, w2 * r2, w3 * r3);
    *(float4*)(sp + 128 + kq * 4) = make_float4(w0, w1, w2, w3);
    *(float4*)(sp + 192 + kq * 4) = make_float4(a0, a1, a2, a3);
    *(float4*)(sp + 256 + kq * 4) = make_float4(e0, e1, e2, e3);
    if (kq < 8) *(float4*)(sp + 320 + kq * 4) = make_float4(bflo(g.v.x), bfhi(g.v.x), bflo(g.v.y), bfhi(g.v.y));
    float c1 = a0 * r0 + a1 * r1 + a2 * r2 + a3 * r3;
    float c2 = e0 * r0 + e1 * r1 + e2 * r2 + e3 * r3;
    c1 += dppx<0xB1>(c1); c2 += dppx<0xB1>(c2);
    c1 += dppx<0x4E>(c1); c2 += dppx<0x4E>(c2);
    c1 += dppx<0x141>(c1); c2 += dppx<0x141>(c2);
    c1 += dppx<0x140>(c1); c2 += dppx<0x140>(c2);
    if (kq == 0) { sp[352] = c1; sp[353] = c2; }
  };
  typedef float f2 __attribute__((ext_vector_type(2)));
  f2 S01 = {0.f, 0.f}, S23 = {0.f, 0.f}, S45 = {0.f, 0.f}, S67 = {0.f, 0.f};
  auto compute = [&](int n) {
    const float* bp = sm + (n & 1) * RS_TB * RS_STEP;
    float* yb = ybuf + (n & 1) * RS_TB * 32 + w * 8 + rl;
    struct Ops { f2 k[4], r[4], w[4], a[4], e[4]; float vv; f2 c; };
    auto ld = [&](int s, Ops& o) {
      const float* sq = bp + s * RS_STEP;
      const f2* sp = (const f2*)(sq + ks * 8);
#pragma unroll
      for (int i = 0; i < 4; ++i) { o.k[i] = sp[i]; o.r[i] = sp[32 + i]; o.w[i] = sp[64 + i]; o.a[i] = sp[96 + i]; o.e[i] = sp[128 + i]; }
      o.vv = sq[320 + w * 8 + rl]; o.c = *(const f2*)(sq + 352);
    };
    auto step = [&](const Ops& o) -> float {
      f2 sa2 = S01 * o.k[0];
      f2 y2 = S01 * o.r[0];
      sa2 = __builtin_elementwise_fma(S23, o.k[1], sa2); y2 = __builtin_elementwise_fma(S23, o.r[1], y2);
      sa2 = __builtin_elementwise_fma(S45, o.k[2], sa2); y2 = __builtin_elementwise_fma(S45, o.r[2], y2);
      sa2 = __builtin_elementwise_fma(S67, o.k[3], sa2); y2 = __builtin_elementwise_fma(S67, o.r[3], y2);
      float sa = sa2.x + sa2.y, y0 = y2.x + y2.y;
      sa += dppx<0xB1>(sa); y0 += dppx<0xB1>(y0);
      sa += dppx<0x4E>(sa); y0 += dppx<0x4E>(y0);
      sa += dppx<0x141>(sa); y0 += dppx<0x141>(y0);
      sa = -sa;
      const f2 sav = {sa, sa}, vvv = {o.vv, o.vv};
      S01 = __builtin_elementwise_fma(vvv, o.e[0], __builtin_elementwise_fma(sav, o.a[0], S01 * o.w[0]));
      S23 = __builtin_elementwise_fma(vvv, o.e[1], __builtin_elementwise_fma(sav, o.a[1], S23 * o.w[1]));
      S45 = __builtin_elementwise_fma(vvv, o.e[2], __builtin_elementwise_fma(sav, o.a[2], S45 * o.w[2]));
      S67 = __builtin_elementwise_fma(vvv, o.e[3], __builtin_elementwise_fma(sav, o.a[3], S67 * o.w[3]));
      return fmaf(o.vv, o.c.y, fmaf(sa, o.c.x, y0));
    };
    Ops oa, ob;
    ld(0, oa);
#pragma unroll 1
    for (int s = 0; s < RS_TB; s += 2) {
      __builtin_amdgcn_sched_barrier(0);
      ld(s + 1, ob);
      __builtin_amdgcn_sched_barrier(0);
      float y0 = step(oa);
      asm volatile("" : "+v"(y0));
      __builtin_amdgcn_sched_barrier(0);
      ld(s + 2, oa);
      __builtin_amdgcn_sched_barrier(0);
      float y1 = step(ob);
      asm volatile("" : "+v"(y1));
      __builtin_amdgcn_sched_barrier(0);
      if (ks == 0) { yb[s * 32] = y0; yb[(s + 1) * 32] = y1; }
    }
  };
  auto yout = [&](int n) {
    const int row = scan_row(dir, b, n * RS_TB + ss);
    const float* ys = ybuf + (n & 1) * RS_TB * 32 + ss * 32 + kq * 2;
    *(unsigned*)(p->P + (size_t)row * LDP + dir * 512 + h * 64 + hf * 32 + kq * 2) = pk_bf16(ys[0], ys[1]);
  };
  constexpr int NB = TSC / RS_TB;
  RwkvStage gA, gB;
  gload(0, gA);
  gload(1, gB);
  swrite(0, gA);
  gload(2, gA);
  __syncthreads();
  for (int n = 0; n < NB; n += 2) {
    compute(n);
    swrite(1, gB);
    if (n + 3 < NB) gload(n + 3, gB);
    __syncthreads();
    yout(n);
    compute(n + 1);
    if (n + 2 < NB) swrite(0, gA);
    if (n + 4 < NB) gload(n + 4, gA);
    __syncthreads();
    yout(n + 1);
  }
  __syncthreads();
}

__device__ void mlstm_s1(KP p, int layer, int tile, char* lds, int tid) {
  const int j = layer >> 1;
  const int ch = tile / NCHUNK, c = tile % NCHUNK;
  const int dir = ch >> 5, b = (ch >> 2) & 7, h = ch & 3;
  float* s_ws = (float*)(lds + META_OFF);
  int* s_row = (int*)(s_ws + 64);
  char* kimg = lds;
  char* vimg = lds + 16384;
  if (tid < 64) {
    const int row = scan_row(dir, b, c * 64 + tid);
    s_row[tid] = row;
    const float* g = p->GP + (size_t)row * 16;
    const float gi = g[(dir * 2) * 4 + h] + p->mlstm_gate_b[j * 16 + (dir * 2) * 4 + h];
    const float gf = g[(dir * 2 + 1) * 4 + h] + p->mlstm_gate_b[j * 16 + (dir * 2 + 1) * 4 + h];
    float bc = -softplus_f(-gf);
#pragma unroll
    for (int o = 1; o < 64; o <<= 1) {
      float tmp = __shfl_up(bc, o);
      if (tid >= o) bc += tmp;
    }
    const float bend = __shfl(bc, 63);
    const float ds = bend - bc + gi;
    const float mloc = wmax(ds);
    s_ws[tid] = expf(ds - mloc);
    if (tid == 0) { p->msc[tile] = mloc; p->msc[NMT + tile] = bend; }
  }
  __syncthreads();
  {
    const int c8 = tid & 15;
    const int ioff = (c8 >> 2) * 4096 + (c8 & 3) * 16;
#pragma unroll
    for (int i = 0; i < 4; ++i) {
      const int sidx = (tid >> 4) + 16 * i;
      const bf16_t* src = p->P + (size_t)s_row[sidx] * LDP + h * 128 + c8 * 8;
      const u32x4 kv = *(const u32x4*)(src + 2560);
      u32x4 vv = *(const u32x4*)(src + 3072);
      const float wsv = s_ws[sidx];
      vv.x = pk_bf16(bflo(vv.x) * wsv, bfhi(vv.x) * wsv); vv.y = pk_bf16(bflo(vv.y) * wsv, bfhi(vv.y) * wsv);
      vv.z = pk_bf16(bflo(vv.z) * wsv, bfhi(vv.z) * wsv); vv.w = pk_bf16(bflo(vv.w) * wsv, bfhi(vv.w) * wsv);
      *(u32x4*)(kimg + ioff + sidx * 64) = kv;
      *(u32x4*)(vimg + ioff + sidx * 64) = vv;
    }
  }
  __syncthreads();
  const int lane = tid & 63, w = tid >> 6, wm = w >> 1, wn = w & 1, r32 = lane & 31, hi = lane >> 5;
  f32x16 acc[2][2];
#pragma unroll
  for (int mi = 0; mi < 2; ++mi)
#pragma unroll
    for (int ni = 0; ni < 2; ++ni)
#pragma unroll
      for (int q = 0; q < 16; ++q) acc[mi][ni][q] = 0.f;
  const int toff = ((lane >> 4) & 1) * 32 + (lane & 3) * 8 + ((lane & 15) >> 2) * 64 + hi * 256;
#pragma unroll
  for (int ks = 0; ks < 4; ++ks) {
    bf16x8 af[2], bfr[2];
#pragma unroll
    for (int i = 0; i < 2; ++i) {
      const char* ka = kimg + (wm * 2 + i) * 4096 + toff + (16 * ks) * 64;
      const char* va = vimg + (wn * 2 + i) * 4096 + toff + (16 * ks) * 64;
      af[i] = __builtin_shufflevector(vtr(ka), vtr(ka + 8 * 64), 0, 1, 2, 3, 4, 5, 6, 7);
      bfr[i] = __builtin_shufflevector(vtr(va), vtr(va + 8 * 64), 0, 1, 2, 3, 4, 5, 6, 7);
    }
    acc[0][0] = MFMA32(af[0], bfr[0], acc[0][0]);
    acc[0][1] = MFMA32(af[0], bfr[1], acc[0][1]);
    acc[1][0] = MFMA32(af[1], bfr[0], acc[1][0]);
    acc[1][1] = MFMA32(af[1], bfr[1], acc[1][1]);
  }
  bf16_t* ust = (bf16_t*)(lds + 32768);
#pragma unroll
  for (int mi = 0; mi < 2; ++mi)
#pragma unroll
    for (int ni = 0; ni < 2; ++ni)
#pragma unroll
      for (int q = 0; q < 16; ++q) {
        const int d = wm * 64 + mi * 32 + (q & 3) + 8 * (q >> 2) + 4 * hi;
        ust[d * 128 + wn * 64 + ni * 32 + r32] = f2bf(acc[mi][ni][q]);
        if ((q & 3) == 3) __builtin_amdgcn_sched_barrier(0);
      }
  __syncthreads();
  {
    const u32x4* us4 = (const u32x4*)ust;
    u32x4* U4 = (u32x4*)(p->MS + (size_t)tile * 16384);
#pragma unroll
    for (int i = 0; i < 8; ++i) U4[tid + 256 * i] = us4[tid + 256 * i];
  }
  if (tid < 128) {
    const char* kc = kimg + (tid >> 5) * 4096 + (tid & 31) * 2;
    float a = 0.f;
#pragma unroll 8
    for (int sidx = 0; sidx < 64; ++sidx) a = fmaf(s_ws[sidx], bf2f(*(const bf16_t*)(kc + sidx * 64)), a);
    p->MSn[tile * 128 + tid] = a;
  }
}

__device__ void mlstm_s3(KP p, int layer, int tile, char* lds, int tid);
__device__ void ph_scan_a(KP p, int layer, char* smc) {
  float* sm = (float*)smc;
  const int tid = opaque_tid();
  __builtin_amdgcn_s_setprio(3);
  for (int u = blockIdx.x; u < 256; u += gridDim.x) rwkv_unit(p, u, sm, tid);
  __builtin_amdgcn_s_setprio(0);
  {
    const int stage = layer == 1 ? 1 : 2;
    const int nconv = conv_stage_total(stage);
    const int total = NMT + (nconv + 7) / 8;
    int* qc = (int*)(p->bar + XCD_BAR_WORDS + 16 * stage);
    int* s_q = (int*)(smc + META_OFF + 3968);
    int jj = 0, j1 = 0;
#pragma unroll 1
    for (;;) {
      if (jj >= j1) {
        __syncthreads();
        if (tid == 0) *s_q = atomicAdd(qc, 1);
        __syncthreads();
        const int q = *s_q;
        if (q >= total) break;
        if (q < NMT) { mlstm_s3(p, layer, q, smc, tid); continue; }
        jj = (q - NMT) * 8; j1 = min(jj + 8, nconv);
      }
      convert_run(p, stage, jj, j1, sm, tid);
      jj = j1;
    }
  }
}

__device__ void ph_mlstm_s2(KP p, char* smc) {
  float* sw = (float*)smc;
  const int tid = opaque_tid();
  const int nitems = 64 * 33;
  for (int item = blockIdx.x; item < nitems; item += gridDim.x) {
    const int ch = item / 33, seg = item % 33;
    __syncthreads();
    if (tid < 2 * NCHUNK) sw[72 + tid] = p->msc[(tid < NCHUNK ? 0 : NMT - NCHUNK) + ch * NCHUNK + tid];
    __syncthreads();
    if (tid == 0) {
      float m = 0.f;
      for (int c = 0; c < NCHUNK; ++c) {
        const int tile = ch * NCHUNK + c;
        const float mloc = sw[72 + c], bend = sw[72 + NCHUNK + c];
        const float mn = fmaxf(bend + m, mloc);
        sw[c] = expf(bend + m - mn);
        sw[36 + c] = expf(mloc - mn);
        if (seg == 0) p->msc[2 * NMT + tile] = m;
        m = mn;
      }
    }
    __syncthreads();
    if (seg < 32) {
      unsigned* base = (unsigned*)(p->MS + (size_t)ch * NCHUNK * 16384) + seg * 256 + tid;
      unsigned v[NCHUNK];
#pragma unroll
      for (int c = 0; c < NCHUNK; ++c) v[c] = base[(size_t)c * 8192];
      float C0 = 0.f, C1 = 0.f;
#pragma unroll
      for (int c = 0; c < NCHUNK; ++c) {
        const float t0 = bflo(v[c]), t1 = bfhi(v[c]);
        v[c] = pk_bf16(C0, C1);
        C0 = sw[c] * C0 + sw[36 + c] * t0;
        C1 = sw[c] * C1 + sw[36 + c] * t1;
      }
#pragma unroll
      for (int c = 0; c < NCHUNK; ++c) base[(size_t)c * 8192] = v[c];
    } else if (tid < 128) {
      float* base = p->MSn + (size_t)ch * NCHUNK * 128 + tid;
      float v[NCHUNK];
#pragma unroll
      for (int c = 0; c < NCHUNK; ++c) v[c] = base[c * 128];
      float C = 0.f;
#pragma unroll
      for (int c = 0; c < NCHUNK; ++c) {
        const float t0 = v[c];
        v[c] = C;
        C = sw[c] * C + sw[36 + c] * t0;
      }
#pragma unroll
      for (int c = 0; c < NCHUNK; ++c) base[c * 128] = v[c];
    }
  }
}

__device__ void mlstm_s3(KP p, int layer, int tile, char* lds, int tid) {
  const int j = layer >> 1;
  const int ch = tile / NCHUNK, c = tile % NCHUNK;
  const int dir = ch >> 5, b = (ch >> 2) & 7, h = ch & 3;
  float* s_b = (float*)(lds + META_OFF);
  float* s_ig = s_b + 64;
  float* s_mt = s_b + 128;
  float* s_wi = s_b + 192;
  int* s_row = (int*)(s_b + 256);
  float* s_n = s_b + 320;
  float* s_c = s_b + 448;
  char* kimg = lds;
  char* vimg = lds + 16384;
  char* cimg = lds + 32768;
  const float mprev = p->msc[2 * NMT + tile];
  const float qscale = 0.08838834764831845f;
  const int lane = tid & 63, w = tid >> 6, wt = w >> 1, wv = w & 1, r32 = lane & 31, hi = lane >> 5;
  const int t = wt * 32 + r32;
  const int rowq = scan_row(dir, b, c * 64 + t);
  const int c8 = tid & 15;
  u32x4 kr[4], vr[4], cr[8];
#pragma unroll
  for (int i = 0; i < 4; ++i) {
    const int sidx = (tid >> 4) + 16 * i;
    const bf16_t* src = p->P + (size_t)scan_row(dir, b, c * 64 + sidx) * LDP + h * 128 + c8 * 8;
    kr[i] = *(const u32x4*)(src + 2560);
    vr[i] = *(const u32x4*)(src + 3072);
  }
  {
    const bf16_t* Cp = p->MS + (size_t)tile * 16384;
#pragma unroll
    for (int i = 0; i < 8; ++i) cr[i] = *(const u32x4*)(Cp + ((tid >> 4) + 16 * i) * 128 + c8 * 8);
  }
  bf16x8 qf[8];
  {
    const bf16_t* qp = p->P + (size_t)rowq * LDP + 2048 + h * 128 + hi * 8;
#pragma unroll
    for (int d0 = 0; d0 < 8; ++d0) qf[d0] = *(const bf16x8*)(qp + d0 * 16);
  }
  if (tid < 64) {
    const int row = scan_row(dir, b, c * 64 + tid);
    s_row[tid] = row;
    const float* g = p->GP + (size_t)row * 16;
    const float gi = g[(dir * 2) * 4 + h] + p->mlstm_gate_b[j * 16 + (dir * 2) * 4 + h];
    const float gf = g[(dir * 2 + 1) * 4 + h] + p->mlstm_gate_b[j * 16 + (dir * 2 + 1) * 4 + h];
    float bc = -softplus_f(-gf);
#pragma unroll
    for (int o = 1; o < 64; o <<= 1) {
      float tmp = __shfl_up(bc, o);
      if (tid >= o) bc += tmp;
    }
    float pm = gi - bc;
#pragma unroll
    for (int o = 1; o < 64; o <<= 1) {
      float tmp = __shfl_up(pm, o);
      if (tid >= o) pm = fmaxf(pm, tmp);
    }
    const float mt = bc + fmaxf(mprev, pm);
    s_b[tid] = bc;
    s_ig[tid] = gi;
    s_mt[tid] = mt;
    s_wi[tid] = expf(bc + mprev - mt);
    s_c[tid] = (gi - bc) * 1.4426950408889634f;
  } else if (tid < 192) s_n[tid - 64] = p->MSn[tile * 128 + (tid - 64)];
  {
    const int ioff = (c8 >> 2) * 4096 + (c8 & 3) * 16;
#pragma unroll
    for (int i = 0; i < 4; ++i) {
      const int sidx = (tid >> 4) + 16 * i;
      *(u32x4*)(kimg + sidx * 256 + ((c8 ^ (sidx & 15)) * 16)) = kr[i];
      *(u32x4*)(vimg + ioff + sidx * 64) = vr[i];
    }
    const int coff = (c8 >> 2) * 8192 + (c8 & 3) * 16;
#pragma unroll
    for (int i = 0; i < 8; ++i) *(u32x4*)(cimg + coff + ((tid >> 4) + 16 * i) * 64) = cr[i];
  }
  __syncthreads();
  const int toff = ((lane >> 4) & 1) * 32 + (lane & 3) * 8 + ((lane & 15) >> 2) * 64;
  constexpr float LOG2E_ = 1.4426950408889634f;
  float qn = 0.f;
#pragma unroll
  for (int d0 = 0; d0 < 8; ++d0) {
    const u32x4 qq = __builtin_bit_cast(u32x4, qf[d0]);
    const float* np = s_n + d0 * 16 + hi * 8;
    qn = fmaf(bflo(qq.x), np[0], qn); qn = fmaf(bfhi(qq.x), np[1], qn);
    qn = fmaf(bflo(qq.y), np[2], qn); qn = fmaf(bfhi(qq.y), np[3], qn);
    qn = fmaf(bflo(qq.z), np[4], qn); qn = fmaf(bfhi(qq.z), np[5], qn);
    qn = fmaf(bflo(qq.w), np[6], qn); qn = fmaf(bfhi(qq.w), np[7], qn);
  }
  qn += __shfl_xor(qn, 32);
  const float mtt = s_mt[t], wi = s_wi[t];
  const float ct = (s_b[t] - mtt) * LOG2E_;
  const float wq = wi * qscale;
  bf16x8 pf[4];
  float den = 0.f;
  {
    f32x16 sa0, sa1;
#pragma unroll
    for (int q = 0; q < 16; ++q) { sa0[q] = 0.f; sa1[q] = 0.f; }
#pragma unroll
    for (int d0 = 0; d0 < 8; ++d0) {
      const int chn = 2 * d0 + hi;
      const bf16x8 k0 = *(const bf16x8*)(kimg + r32 * 256 + ((chn ^ (r32 & 15)) * 16));
      sa0 = MFMA32(k0, qf[d0], sa0);
      if (wt) {
        const bf16x8 k1 = *(const bf16x8*)(kimg + (32 + r32) * 256 + ((chn ^ (r32 & 15)) * 16));
        sa1 = MFMA32(k1, qf[d0], sa1);
      }
      __builtin_amdgcn_sched_barrier(0);
    }
#pragma unroll
    for (int g = 0; g < 4; ++g) {
      const int sb0 = 8 * g + 4 * hi;
      const float4 c0v = *(const float4*)(s_c + sb0);
      const float4 c1v = *(const float4*)(s_c + sb0 + 32);
      const float cc0[4] = {c0v.x, c0v.y, c0v.z, c0v.w}, cc1[4] = {c1v.x, c1v.y, c1v.z, c1v.w};
#pragma unroll
      for (int e = 0; e < 4; ++e) {
        const int q = 4 * g + e;
        const float v0 = (sb0 + e <= t) ? sa0[q] * qscale * __builtin_amdgcn_exp2f(ct + cc0[e]) : 0.f;
        sa0[q] = v0; den += v0;
        const float v1 = (wt && sb0 + 32 + e <= t) ? sa1[q] * qscale * __builtin_amdgcn_exp2f(ct + cc1[e]) : 0.f;
        sa1[q] = v1; den += v1;
      }
      __builtin_amdgcn_sched_barrier(0);
    }
#pragma unroll
    for (int sx = 0; sx < 4; ++sx) {
      const int u = (sx & 1) * 8;
      u32x4 tpk;
      if (sx < 2) {
        tpk.x = pk_bf16(sa0[u + 0], sa0[u + 1]); tpk.y = pk_bf16(sa0[u + 2], sa0[u + 3]);
        tpk.z = pk_bf16(sa0[u + 4], sa0[u + 5]); tpk.w = pk_bf16(sa0[u + 6], sa0[u + 7]);
      } else {
        tpk.x = pk_bf16(sa1[u + 0], sa1[u + 1]); tpk.y = pk_bf16(sa1[u + 2], sa1[u + 3]);
        tpk.z = pk_bf16(sa1[u + 4], sa1[u + 5]); tpk.w = pk_bf16(sa1[u + 6], sa1[u + 7]);
      }
      pf[sx] = __builtin_bit_cast(bf16x8, tpk);
    }
  }
  den += __shfl_xor(den, 32);
  const float dtot = den + wq * qn;
  const float inv = 1.f / fmaxf(fabsf(dtot), expf(-mtt));
  bf16_t* op = p->P + (size_t)rowq * LDP + 1024 + dir * 512 + h * 128 + wv * 64 + 4 * hi;
#pragma unroll 1
  for (int vp = 0; vp < 2; ++vp) {
    f32x16 o0;
#pragma unroll
    for (int q = 0; q < 16; ++q) o0[q] = 0.f;
    const char* cb = cimg + (wv * 2 + vp) * 8192 + toff + hi * 512;
#pragma unroll
    for (int d0 = 0; d0 < 8; ++d0) {
      const bf16x8 A0 = __builtin_shufflevector(vtr(cb + (16 * d0) * 64), vtr(cb + (16 * d0 + 4) * 64), 0, 1, 2, 3, 4, 5, 6, 7);
      o0 = MFMA32(A0, qf[d0], o0);
    }
#pragma unroll
    for (int q = 0; q < 16; ++q) o0[q] *= wq;
    const char* vb = vimg + (wv * 2 + vp) * 4096 + toff + hi * 256;
#pragma unroll
    for (int sx = 0; sx < 4; ++sx) {
      if (sx < 2 || wt) {
        const bf16x8 A0 = __builtin_shufflevector(vtr(vb + (16 * sx) * 64), vtr(vb + (16 * sx + 8) * 64), 0, 1, 2, 3, 4, 5, 6, 7);
        o0 = MFMA32(A0, pf[sx], o0);
      }
    }
#pragma unroll
    for (int g = 0; g < 4; ++g) {
      u32x2 v0;
      v0.x = pk_bf16(o0[4 * g] * inv, o0[4 * g + 1] * inv); v0.y = pk_bf16(o0[4 * g + 2] * inv, o0[4 * g + 3] * inv);
      *(u32x2*)(op + vp * 32 + 8 * g) = v0;
    }
  }
}

__device__ void ph_mlstm_s1(KP p, int layer, char* smc) {
  const int tid = opaque_tid();
  __syncthreads();
  for (int tile = blockIdx.x; tile < NMT; tile += gridDim.x) { mlstm_s1(p, layer, tile, smc, tid); __syncthreads(); }
}

__device__ void ph_rec_final(KP p, int layer, bool keep) {
  const int tid = opaque_tid();
  const int j = layer >> 1;
  const int lane = tid & 63, wave = tid >> 6;
  const int rows = keep ? NT : NL;
  const int c0 = lane * 8;
  auto unpack = [](const u32x4 u, float (&f)[8]) {
    f[0] = bflo(u.x); f[1] = bfhi(u.x); f[2] = bflo(u.y); f[3] = bfhi(u.y);
    f[4] = bflo(u.z); f[5] = bfhi(u.z); f[6] = bflo(u.w); f[7] = bfhi(u.w);
  };
  for (int t = blockIdx.x * 4 + wave; t < rows; t += gridDim.x * 4) {
    const bf16_t* rw = p->RW + (size_t)t * RWS + c0;
    const bf16_t* pt = p->P + (size_t)t * LDP + c0;
    unsigned char* mo = (unsigned char*)p->AB + (size_t)t * DM + c0;
    {
      float yf[8], yb[8], r[8], v[8], k0[8], k1[8], g[8], y[8], o[8];
      unpack(*(const u32x4*)(pt), yf); unpack(*(const u32x4*)(pt + 512), yb);
      unpack(*(const u32x4*)(rw), r); unpack(*(const u32x4*)(rw + 512), v);
      unpack(*(const u32x4*)(rw + 5 * 512), k0); unpack(*(const u32x4*)(rw + 6 * 512), k1);
      unpack(*(const u32x4*)(rw + 9 * 512), g);
      float s1 = 0.f, bs = 0.f;
      const float* rk = p->rwkv_rk + j * 512 + c0;
#pragma unroll
      for (int e = 0; e < 8; ++e) { y[e] = yf[e] + yb[e]; s1 += y[e]; bs += r[e] * rk[e] * (k0[e] + k1[e]); }
      s1 += dppx<0xB1>(s1); s1 += dppx<0x4E>(s1); s1 += dppx<0x141>(s1);
      bs += dppx<0xB1>(bs); bs += dppx<0x4E>(bs); bs += dppx<0x141>(bs);
      const float mu = s1 * (1.f / 64.f);
      float s2 = 0.f;
#pragma unroll
      for (int e = 0; e < 8; ++e) { const float d = y[e] - mu; s2 += d * d; }
      s2 += dppx<0xB1>(s2); s2 += dppx<0x4E>(s2); s2 += dppx<0x141>(s2);
      const float rs = rsqrtf(s2 * (1.f / 64.f) + 64e-5f);
      const float* gn0 = p->rwkv_gn + (j * 2 + 0) * 512 + c0;
      const float* gn1 = p->rwkv_gn + (j * 2 + 1) * 512 + c0;
#pragma unroll
      for (int e = 0; e < 8; ++e) o[e] = ((y[e] - mu) * rs * gn0[e] + gn1[e] + bs * v[e]) * g[e];
      u32x2 ov;
      ov.x = pk_fp8x4c(o[0], o[1], o[2], o[3]); ov.y = pk_fp8x4c(o[4], o[5], o[6], o[7]);
      *(u32x2*)(mo) = ov;
    }
    {
      float hf[8], hb[8], og[8], hsum[8], o[8];
      unpack(*(const u32x4*)(pt + 1024), hf); unpack(*(const u32x4*)(pt + 1536), hb);
      unpack(*(const u32x4*)(pt + 3584), og);
      float ss = 0.f;
#pragma unroll
      for (int e = 0; e < 8; ++e) { hsum[e] = hf[e] + hb[e]; ss += hsum[e] * hsum[e]; }
      ss += dppx<0xB1>(ss); ss += dppx<0x4E>(ss); ss += dppx<0x141>(ss); ss += dppx<0x140>(ss);
      const float rs = rsqrtf(ss * (1.f / 128.f) + 1e-6f);
      const float* ng = p->mlstm_norm + j * 512 + c0;
#pragma unroll
      for (int e = 0; e < 8; ++e) o[e] = hsum[e] * rs * ng[e] * sigm_f(og[e]);
      u32x2 ov;
      ov.x = pk_fp8x4c(o[0], o[1], o[2], o[3]); ov.y = pk_fp8x4c(o[4], o[5], o[6], o[7]);
      *(u32x2*)(mo + 512) = ov;
    }
  }
}

using f32x4v = __attribute__((ext_vector_type(4))) float;
__device__ void ph_ln_router(KP p, int layer, bool keep, char* smc) {
  float* h2s = (float*)smc;
  float* lgs = (float*)smc;
  const int tid = opaque_tid();
  const int lane = tid & 63, wave = tid >> 6;
  const int rows = keep ? NT : NL;
  const float* lng = p->ln_g + (layer * 2 + 0) * 1024;
  const float* lnb = p->ln_b + (layer * 2 + 0) * 1024;
  for (int tile = blockIdx.x; tile < rows / 16; tile += gridDim.x) {
    const int t0 = tile * 16;
    const float* mod = p->MOD + (layer * 9 + modrow(t0)) * 6144;
    const float* brow = p->WrT + ((size_t)layer * 64 + 16 * wave + (lane & 15)) * 1024 + 4 * (lane >> 4);
    f32x4v b0[8], b1[8], b2[8];
#pragma unroll
    for (int q = 0; q < 8; ++q) { b0[q] = *(const f32x4v*)(brow + 16 * q); b1[q] = *(const f32x4v*)(brow + 16 * (8 + q)); }
    __builtin_amdgcn_sched_barrier(0);
    {
      float4 v[4][4];
      float s4[4];
#pragma unroll
      for (int q = 0; q < 4; ++q) {
        const int t = t0 + wave * 4 + q;
        s4[q] = 0.f;
#pragma unroll
        for (int i = 0; i < 4; ++i) v[q][i] = *(const float4*)(p->Tb + (size_t)t * DM + i * 256 + lane * 4);
      }
#pragma unroll
      for (int q = 0; q < 4; ++q)
#pragma unroll
        for (int i = 0; i < 4; ++i) s4[q] += (v[q][i].x + v[q][i].y) + (v[q][i].z + v[q][i].w);
      float mean4[4], rs4[4];
#pragma unroll
      for (int q = 0; q < 4; ++q) mean4[q] = wsum(s4[q]) * (1.f / 1024.f);
#pragma unroll
      for (int q = 0; q < 4; ++q) {
        float qq = 0.f;
#pragma unroll
        for (int i = 0; i < 4; ++i) {
          const float d0 = v[q][i].x - mean4[q], d1 = v[q][i].y - mean4[q], d2 = v[q][i].z - mean4[q], d3 = v[q][i].w - mean4[q];
          qq += (d0 * d0 + d1 * d1) + (d2 * d2 + d3 * d3);
        }
        s4[q] = qq;
      }
#pragma unroll
      for (int q = 0; q < 4; ++q) rs4[q] = rsqrtf(wsum(s4[q]) * (1.f / 1024.f) + 1e-5f);
#pragma unroll
      for (int i = 0; i < 4; ++i) {
        const int n = i * 256 + lane * 4;
        const float4 g = *(const float4*)(lng + n), bb = *(const float4*)(lnb + n);
        const float4 sc = *(const float4*)(mod + 4096 + n), sh = *(const float4*)(mod + 3072 + n);
#pragma unroll
        for (int q = 0; q < 4; ++q) {
          const int tl = wave * 4 + q, t = t0 + tl;
          const float mean = mean4[q], rs = rs4[q];
          const float4 xn = make_float4((v[q][i].x - mean) * rs * g.x + bb.x, (v[q][i].y - mean) * rs * g.y + bb.y,
                                        (v[q][i].z - mean) * rs * g.z + bb.z, (v[q][i].w - mean) * rs * g.w + bb.w);
          *(float4*)(p->X + (size_t)t * DM + n) = xn;
          const float4 hh = make_float4(xn.x * (1.f + sc.x) + sh.x, xn.y * (1.f + sc.y) + sh.y,
                                        xn.z * (1.f + sc.z) + sh.z, xn.w * (1.f + sc.w) + sh.w);
          *(unsigned*)((unsigned char*)p->AB + (size_t)t * DM + n) = pk_fp8x4c(hh.x, hh.y, hh.z, hh.w);
          *(float4*)(h2s + tl * 1028 + n) = hh;
        }
      }
    }
    __syncthreads();
    f32x4v acc = {0.f, 0.f, 0.f, 0.f};
    {
      f32x4v a1 = {0.f, 0.f, 0.f, 0.f}, a2 = {0.f, 0.f, 0.f, 0.f}, a3 = {0.f, 0.f, 0.f, 0.f};
      const int i = lane & 15, kk = lane >> 4;
      const float* arow = h2s + i * 1028 + 4 * kk;
#define ROUTER_LOAD(B, Q0) _Pragma("unroll") for (int q = 0; q < 8; ++q) B[q] = *(const f32x4v*)(brow + 16 * ((Q0) + q)); __builtin_amdgcn_sched_barrier(0);
#define ROUTER_MFMA(B, Q0) _Pragma("unroll") for (int q = 0; q < 8; ++q) { \
        const float4 a = *(const float4*)(arow + 16 * ((Q0) + q)); \
        acc = __builtin_amdgcn_mfma_f32_16x16x4f32(a.x, B[q].x, acc, 0, 0, 0); \
        a1 = __builtin_amdgcn_mfma_f32_16x16x4f32(a.y, B[q].y, a1, 0, 0, 0); \
        a2 = __builtin_amdgcn_mfma_f32_16x16x4f32(a.z, B[q].z, a2, 0, 0, 0); \
        a3 = __builtin_amdgcn_mfma_f32_16x16x4f32(a.w, B[q].w, a3, 0, 0, 0); } __builtin_amdgcn_sched_barrier(0);
      ROUTER_LOAD(b2, 16) ROUTER_MFMA(b0, 0)
      ROUTER_LOAD(b0, 24) ROUTER_MFMA(b1, 8)
      ROUTER_LOAD(b1, 32) ROUTER_MFMA(b2, 16)
      ROUTER_LOAD(b2, 40) ROUTER_MFMA(b0, 24)
      ROUTER_LOAD(b0, 48) ROUTER_MFMA(b1, 32)
      ROUTER_LOAD(b1, 56) ROUTER_MFMA(b2, 40)
      ROUTER_MFMA(b0, 48)
      ROUTER_MFMA(b1, 56)
      acc = (acc + a1) + (a2 + a3);
    }
    __syncthreads();
#pragma unroll
    for (int r = 0; r < 4; ++r) lgs[((lane >> 4) * 4 + r) * 64 + 16 * wave + (lane & 15)] = acc[r];
    __syncthreads();
    {
      float score4[4], gate4[4];
      int kidx4[4], pos4[4];
      bool chosen4[4];
#pragma unroll
      for (int q = 0; q < 4; ++q) {
        const int tl = wave * 4 + q;
        const float logit = lgs[tl * 64 + lane];
        const float score = sigm_f(logit);
        float sel = score + p->moe_bias[layer * 64 + lane];
        bool chosen = false;
        for (int r = 0; r < 6; ++r) {
          const float mx = wmax(sel);
          const unsigned long long bal = __ballot(sel == mx);
          const int first = __ffsll((long long)bal) - 1;
          if (lane == first) { chosen = true; sel = -INFINITY; }
        }
        const float gsum = wsum(chosen ? score : 0.f);
        const unsigned long long cb = __ballot(chosen);
        score4[q] = score; gate4[q] = score / gsum * 2.5f; chosen4[q] = chosen;
        kidx4[q] = __popcll(cb & ((1ull << lane) - 1ull));
      }
#pragma unroll
      for (int q = 0; q < 4; ++q) pos4[q] = chosen4[q] ? atomicAdd(&p->cnt[lane * CSTR], 1) : 0;
#pragma unroll
      for (int q = 0; q < 4; ++q) {
        const int t = t0 + wave * 4 + q;
        if (chosen4[q]) {
          p->ltok[(size_t)lane * NT + pos4[q]] = t;
          p->lgate[(size_t)lane * NT + pos4[q]] = gate4[q];
          p->tsl[t * 6 + kidx4[q]] = (lane << 16) | pos4[q];
        }
      }
    }
    __syncthreads();
  }
}

__device__ __forceinline__ void moe_prefix(KP p, int rows, int* s_pref, int tid) {
  if (tid < 64) s_pref[322 + tid] = p->cnt[tid * CSTR];
  __syncthreads();
  if (tid == 0) {
    int a = 0;
    for (int e = 0; e < 64; ++e) { s_pref[e] = a; a += (s_pref[322 + e] + 127) >> 7; }
    s_pref[64] = a; a += rows >> 7;
    s_pref[65] = a;
  }
  __syncthreads();
}

__device__ void ph_gemm(KP p, int kind, int layer, bool keep, char* lds) {
  const int tid = opaque_tid();
  const int j = layer >> 1;
  const bool att = !(layer & 1);
  const int rows = keep ? NT : NL;
  int* pref = (int*)(lds + META_OFF);
  int* s_idx = pref + 66;
  float* s_gate = (float*)(s_idx + 128);
  if (kind == 1 && blockIdx.x == 0 && tid < 65) p->cnt[tid * CSTR] = 0;
  int total;
  const int ntn_in = att ? 18 : 33;
  switch (kind) {
    case 0: total = (NT / 128) * ntn_in; break;
    case 1: total = (rows / 128) * 8; break;
    case 2: total = pref[65] * 4; break;
    case 3: total = pref[65] * 8; break;
    case 4: total = (NT / 128) * 3; break;
    default: total = (NT / 128) * 20; break;
  }
  const bool moe = kind == 2 || kind == 3;
  const int tsh = kind == 2 ? 2 : 3;
  int e_nx = 0, idx_nx = tid; float g_nx = 1.f;
  auto fetch_moe = [&](int tl) {
    const int mt = tl >> tsh;
    while (mt >= pref[e_nx + 1]) ++e_nx;
    idx_nx = tid; g_nx = 1.f;
    if (tid < 128) {
      const int pos = (mt - pref[e_nx]) * 128 + tid;
      if (kind == 2) {
        idx_nx = 0;
        if (e_nx < 64) { if (pos < pref[322 + e_nx]) idx_nx = p->ltok[(size_t)e_nx * NT + pos]; }
        else idx_nx = pos;
      } else if (e_nx < 64) g_nx = pos < pref[322 + e_nx] ? p->lgate[(size_t)e_nx * NT + pos] : 0.f;
    }
  };
  const int xcd = blockIdx.x & 7, lb = blockIdx.x >> 3, nbx = ((int)gridDim.x - xcd + 7) >> 3;
  const int t_beg = (int)(((long long)total * xcd) >> 3), t_end = (int)(((long long)total * (xcd + 1)) >> 3);
  if (moe && t_beg + lb < t_end) fetch_moe(t_beg + lb);
  for (int tile = t_beg + lb; tile < t_end; tile += nbx) {
    const bf16_t* Abase; const bf16_t* Bt;
    int astride, K, n0, m0 = 0, aux = 0, e = e_nx, mtile = 0;
    switch (kind) {
      case 0: { const int tm = tile / ntn_in, tn = tile % ntn_in; m0 = tm * 128; n0 = tn * 128;
                Abase = (const bf16_t*)((const unsigned char*)p->AB + (size_t)m0 * DM); astride = DM; K = 1024;
                Bt = (const bf16_t*)(att ? (const unsigned char*)p->Wt_att + (size_t)j * ATT_N * 1024
                                         : (const unsigned char*)p->Wt_rec + (size_t)j * REC_NP * 1024); } break;
      case 1: { const int tm = tile >> 3, tn = tile & 7; m0 = tm * 128; n0 = tn * 128;
                Abase = (const bf16_t*)((const unsigned char*)p->AB + (size_t)m0 * DM); astride = DM; K = 1024;
                Bt = (const bf16_t*)((const unsigned char*)p->Wt_out + (size_t)layer * 1024 * 1024); } break;
      case 2: { mtile = tile >> 2; aux = tile & 3; n0 = aux * 128;
                Abase = p->AB; astride = DM; K = 1024;
                Bt = (const bf16_t*)((const unsigned char*)p->Wt13 + (size_t)(layer * 65 + e) * 512 * 1024); } break;
      case 3: { mtile = tile >> 3; aux = tile & 7; n0 = aux * 128;
                Abase = (const bf16_t*)((const unsigned char*)p->ACT + (size_t)mtile * 128 * 256); astride = 256; K = 256;
                Bt = (const bf16_t*)((const unsigned char*)p->Wt2 + (size_t)(layer * 65 + e) * 1024 * 256); } break;
      case 4: { const int tm = tile / 3; aux = tile % 3; m0 = tm * 128; n0 = 0;
                Abase = p->Zb + (size_t)m0 * 1536 + aux * 512; astride = 1536; K = 512; Bt = p->Wl1 + (size_t)(j * 3 + aux) * 128 * 512; } break;
      default: { const int tm = tile / 20; aux = tile % 20; m0 = tm * 128; n0 = aux * 128;
                const int grp = aux < 8 ? 0 : (aux < 16 ? 1 : 2);
                Abase = p->L1 + (size_t)m0 * 384 + grp * 128; astride = 384; K = 128; Bt = p->Wl2 + (size_t)j * 2560 * 128; } break;
    }
    if (tid < 128) { s_idx[tid] = idx_nx; s_gate[tid] = g_nx; }
    __syncthreads();
    if (moe && tile + nbx < t_end) fetch_moe(tile + nbx);
    {
      f32x16 acc[2][2];
      if (kind <= 3) {
        const unsigned char* A8 = (const unsigned char*)Abase;
        gemm128_fp8(tid, [&](int r) { return A8 + (size_t)s_idx[r] * astride; }, (const unsigned char*)Bt, K, n0, lds, acc);
      } else
        gemm128_main(tid, [&](int r) { return Abase + (size_t)s_idx[r] * astride; }, Bt, K, n0, lds, acc);
      float* Ct = (float*)lds;
      acc_foreach(tid, acc, [&](int row, int col, float v) { Ct[row * 128 + col] = v; });
    }
    __syncthreads();
    {
      const float* Ct = (const float*)lds;
      int c4 = (tid & 31) * 4, r0 = tid >> 5;
      asm volatile("" : "+v"(c4), "+v"(r0));
      const int N_in = att ? ATT_N : REC_N;
      const int d5 = (aux >> 2) & 1, c05 = (aux & 3) * 128;
      switch (kind) {
        case 0: {
#pragma unroll 8
          for (int it = 0; it < 16; ++it) {
            const int row = it * 8 + r0;
            const float4 vraw = *(const float4*)(Ct + row * 128 + c4);
            const float4 v = make_float4(vraw.x * W8_INV, vraw.y * W8_INV, vraw.z * W8_INV, vraw.w * W8_INV);

            const int cn = n0 + c4;
            float4 vq = v;
            if (att && n0 >= 1536 && n0 < 2176) {
              float ss = v.x * v.x + v.y * v.y + v.z * v.z + v.w * v.w;
              ss += dppx<0xB1>(ss); ss += dppx<0x4E>(ss); ss += dppx<0x141>(ss); ss += dppx<0x140>(ss);
              const float rs = rsqrtf(ss * (1.f / 64.f) + 1e-6f);
              const float4 g = *(const float4*)(p->qk_gain + j * 128 + (n0 >= 2048 ? 64 : 0) + (cn & 63));
              vq = make_float4(v.x * rs * g.x, v.y * rs * g.y, v.z * rs * g.z, v.w * rs * g.w);
              const int t = m0 + row;
              if (t < NL) {
                const int sidx = t & 2047, pi0 = (cn & 63) >> 1;
                const int pos = pi0 < 16 ? (sidx >> 6) : (sidx & 63);
                const float4 cs = *(const float4*)(p->ROPE + (pos * 16 + (pi0 & 15)) * 2);
                vq = make_float4(vq.x * cs.x - vq.y * cs.y, vq.x * cs.y + vq.y * cs.x,
                                 vq.z * cs.z - vq.w * cs.w, vq.z * cs.w + vq.w * cs.z);
              }
            }
            if (cn < N_in) {
              u32x2 o; o.x = pk_bf16(vq.x, vq.y); o.y = pk_bf16(vq.z, vq.w);
              *(u32x2*)(p->P + (size_t)(m0 + row) * LDP + cn) = o;
            }
            if (!att && cn >= 4096 && cn < 4112) *(float4*)(p->GP + (size_t)(m0 + row) * 16 + (cn - 4096)) = v;
          }
        } break;
        case 1: {
#pragma unroll 16
          for (int it = 0; it < 16; ++it) {
            const int row = it * 8 + r0;
            const float4 v = *(const float4*)(Ct + row * 128 + c4);

            const size_t o = (size_t)(m0 + row) * DM + n0 + c4;
            const float4 xv = *(const float4*)(p->X + o);
            const float4 g = *(const float4*)(p->MOD + (layer * 9 + modrow(m0)) * 6144 + 2048 + n0 + c4);
            *(float4*)(p->Tb + o) = make_float4(DN_ALPHA * xv.x + g.x * (v.x * W8_INV), DN_ALPHA * xv.y + g.y * (v.y * W8_INV),
                                                DN_ALPHA * xv.z + g.z * (v.z * W8_INV), DN_ALPHA * xv.w + g.w * (v.w * W8_INV));
          }
        } break;
        case 2: {
#pragma unroll 8
          for (int it = 0; it < 16; ++it) {
            const int row = it * 8 + r0;
            const float4 v = *(const float4*)(Ct + row * 128 + c4);

            if (((c4 >> 5) & 1) == 0) {
              const float4 u = *(const float4*)(Ct + row * 128 + c4 + 32);
              const float a0 = v.x * W8_INV, a1 = v.y * W8_INV, a2 = v.z * W8_INV, a3 = v.w * W8_INV;
              *(unsigned*)((unsigned char*)p->ACT + ((size_t)mtile * 128 + row) * 256 + aux * 64 + (c4 >> 6) * 32 + (c4 & 31)) =
                  pk_fp8x4c(silu_f(a0) * (u.x * W8_INV), silu_f(a1) * (u.y * W8_INV), silu_f(a2) * (u.z * W8_INV), silu_f(a3) * (u.w * W8_INV));
            }
          }
        } break;
        case 3: {
#pragma unroll 16
          for (int it = 0; it < 16; ++it) {
            const int row = it * 8 + r0;
            const float4 v = *(const float4*)(Ct + row * 128 + c4);

            const float g = s_gate[row] * (W8_INV * 16.f);
            *(unsigned*)((unsigned char*)p->OUT2 + ((size_t)mtile * 128 + row) * 1024 + n0 + c4) = pk_fp8x4c(g * v.x, g * v.y, g * v.z, g * v.w);
          }
        } break;
        case 4: {
#pragma unroll 4
          for (int it = 0; it < 16; ++it) {
            const int row = it * 8 + r0;
            const float4 v = *(const float4*)(Ct + row * 128 + c4);

            float4 o4 = v;
            if (aux == 0) o4 = make_float4(tanhf(v.x), tanhf(v.y), tanhf(v.z), tanhf(v.w));
            else if (aux == 2) o4 = make_float4(sigm_f(v.x), sigm_f(v.y), sigm_f(v.z), sigm_f(v.w));
            u32x2 o; o.x = pk_bf16(o4.x, o4.y); o.y = pk_bf16(o4.z, o4.w);
            *(u32x2*)(p->L1 + (size_t)(m0 + row) * 384 + aux * 128 + c4) = o;
          }
        } break;
        default: {
#pragma unroll 4
          for (int it = 0; it < 16; ++it) {
            const int row = it * 8 + r0;
            const float4 v = *(const float4*)(Ct + row * 128 + c4);

            bf16_t* rr = p->RW + (size_t)(m0 + row) * RWS + c05 + c4;
            const float vv[4] = {v.x, v.y, v.z, v.w};
            if (aux < 8) {
              const float4 b0 = *(const float4*)(p->rwkv_w0 + (j * 2 + d5) * 512 + c05 + c4);
              const float bb[4] = {b0.x, b0.y, b0.z, b0.w};
              float e4[4];
#pragma unroll
              for (int q = 0; q < 4; ++q) e4[q] = expf(-softplus_f(-(bb[q] + vv[q])) - 0.5f);
              u32x2 o; o.x = pk_bf16(e4[0], e4[1]); o.y = pk_bf16(e4[2], e4[3]);
              *(u32x2*)(rr + (3 + d5) * 512) = o;
            } else if (aux < 16) {
              const float4 b0 = *(const float4*)(p->rwkv_a0 + (j * 2 + d5) * 512 + c05 + c4);
              const float4 k1 = *(const float4*)(p->rwkv_kvec + (j * 2 + 1) * 512 + c05 + c4);
              const u32x2 kx2 = *(const u32x2*)(rr + 10 * 512);
              const float bb[4] = {b0.x, b0.y, b0.z, b0.w}, kk1[4] = {k1.x, k1.y, k1.z, k1.w};
              const float kx[4] = {bflo(kx2.x), bfhi(kx2.x), bflo(kx2.y), bfhi(kx2.y)};
              float av[4], ke[4];
#pragma unroll
              for (int q = 0; q < 4; ++q) { av[q] = sigm_f(bb[q] + vv[q]); ke[q] = kx[q] * (1.f + (av[q] - 1.f) * kk1[q]); }
              u32x2 o; o.x = pk_bf16(av[0], av[1]); o.y = pk_bf16(av[2], av[3]);
              *(u32x2*)(rr + (7 + d5) * 512) = o;
              o.x = pk_bf16(ke[0], ke[1]); o.y = pk_bf16(ke[2], ke[3]);
              *(u32x2*)(rr + (5 + d5) * 512) = o;
            } else {
              u32x2 o; o.x = pk_bf16(v.x, v.y); o.y = pk_bf16(v.z, v.w);
              *(u32x2*)(rr + 9 * 512) = o;
            }
          }
        } break;
      }
    }
    __syncthreads();
  }
}

__device__ void ph_final_ln(KP p, int layer, bool keep, char* lds) {
  const int tid = opaque_tid();
  const int lane = tid & 63, wave = tid >> 6;
  const int rows = keep ? NT : NL;
  int* s_base = (int*)(lds + META_OFF);
  if (tid == 0) {
    int a = 0;
#pragma unroll 1
    for (int e = 0; e < 64; ++e) { s_base[e] = a * 128; a += (p->cnt[e * CSTR] + 127) >> 7; }
    s_base[64] = a * 128;
  }
  __syncthreads();
  const float* lng = p->ln_g + (layer * 2 + 1) * 1024;
  const float* lnb = p->ln_b + (layer * 2 + 1) * 1024;
  for (int t = blockIdx.x * 4 + wave; t < rows; t += gridDim.x * 4) {
    const int mr = modrow(t);
    const float* g2 = p->MOD + (layer * 9 + mr) * 6144 + 5120;
    const unsigned char* src[7];
#pragma unroll
    for (int k = 0; k < 6; ++k) {
      const int v = p->tsl[t * 6 + k];
      src[k] = (const unsigned char*)p->OUT2 + (size_t)(s_base[v >> 16] + (v & 0xffff)) * 1024;
    }
    src[6] = (const unsigned char*)p->OUT2 + (size_t)(s_base[64] + t) * 1024;
    float v[16];
    float s = 0.f;
#pragma unroll
    for (int c = 0; c < 2; ++c) {
      const int n0 = c * 512 + lane * 8;
      float y[8];
#pragma unroll
      for (int q = 0; q < 8; ++q) y[q] = 0.f;
#pragma unroll
      for (int k = 0; k < 7; ++k) {
        const u32x2 u = *(const u32x2*)(src[k] + n0);
        const auto f0 = __builtin_amdgcn_cvt_pk_f32_fp8((int)u.x, false), f1 = __builtin_amdgcn_cvt_pk_f32_fp8((int)u.x, true);
        const auto f2 = __builtin_amdgcn_cvt_pk_f32_fp8((int)u.y, false), f3 = __builtin_amdgcn_cvt_pk_f32_fp8((int)u.y, true);
        y[0] += f0[0]; y[1] += f0[1]; y[2] += f1[0]; y[3] += f1[1];
        y[4] += f2[0]; y[5] += f2[1]; y[6] += f3[0]; y[7] += f3[1];
      }
      const float4 xa = *(const float4*)(p->X + (size_t)t * DM + n0), xb = *(const float4*)(p->X + (size_t)t * DM + n0 + 4);
      const float4 ga = *(const float4*)(g2 + n0), gb = *(const float4*)(g2 + n0 + 4);
      const float xx[8] = {xa.x, xa.y, xa.z, xa.w, xb.x, xb.y, xb.z, xb.w};
      const float gg[8] = {ga.x, ga.y, ga.z, ga.w, gb.x, gb.y, gb.z, gb.w};
#pragma unroll
      for (int q = 0; q < 8; ++q) { v[c * 8 + q] = DN_ALPHA * xx[q] + gg[q] * (y[q] * 0.0625f); s += v[c * 8 + q]; }
    }
    const float mean = wsum(s) * (1.f / 1024.f);
    float q2 = 0.f;
#pragma unroll
    for (int i = 0; i < 16; ++i) { const float d = v[i] - mean; q2 += d * d; }
    const float rs = rsqrtf(wsum(q2) * (1.f / 1024.f) + 1e-5f);
    const float* modn = p->MOD + ((layer + 1) * 9 + mr) * 6144;
#pragma unroll
    for (int c = 0; c < 2; ++c) {
      const int n0 = c * 512 + lane * 8;
      float xn[8];
#pragma unroll
      for (int q = 0; q < 8; ++q) xn[q] = (v[c * 8 + q] - mean) * rs * lng[n0 + q] + lnb[n0 + q];
      float* xo = (layer == 3 ? p->out : p->X) + (size_t)t * DM + n0;
      *(float4*)(xo) = make_float4(xn[0], xn[1], xn[2], xn[3]);
      *(float4*)(xo + 4) = make_float4(xn[4], xn[5], xn[6], xn[7]);
      if (layer != 3) {
        float hb[8];
#pragma unroll
        for (int q = 0; q < 8; ++q) hb[q] = xn[q] * (1.f + modn[1024 + n0 + q]) + modn[n0 + q];
        u32x2 o;
        o.x = pk_fp8x4c(hb[0], hb[1], hb[2], hb[3]); o.y = pk_fp8x4c(hb[4], hb[5], hb[6], hb[7]);
        *(u32x2*)((unsigned char*)p->AB + (size_t)t * DM + n0) = o;
      }
    }
  }
}

#define XB_TMO      128
#define XB_XCNT(j)  (256  + 64 * (j))
#define XB_XSUB(j)  (1280 + 64 * (j))
#define XB_XGEN(j)  (2304 + 64 * (j))
#define XB_TOP      3328
#define XB_TOPGEN   3392
#define XB_SPIN_CAP (1u << 20)
#define LAS __attribute__((address_space(3)))
__device__ __forceinline__ unsigned xb_ld(unsigned* p) { return __hip_atomic_load(p, __ATOMIC_RELAXED, __HIP_MEMORY_SCOPE_AGENT); }
__device__ __forceinline__ unsigned xb_add(unsigned* p, unsigned v) { return __hip_atomic_fetch_add(p, v, __ATOMIC_RELAXED, __HIP_MEMORY_SCOPE_AGENT); }
__device__ __forceinline__ unsigned xb_xcc_id() { return (unsigned)__builtin_amdgcn_s_getreg((3 << 11) | 20) & 0xFu; }
#define XB_SPIN(cond, bar) do { unsigned _sp = 0; while (cond) { __builtin_amdgcn_s_sleep(1); \
    if ((++_sp & 255u) == 0u) { if (xb_ld(&(bar)[XB_TMO])) break; if (_sp > XB_SPIN_CAP) { atomicAdd(&(bar)[XB_TMO], 1u); break; } } } } while (0)
struct XcdBarrier { unsigned* bar; unsigned x; volatile LAS unsigned* st; };
__device__ __forceinline__ XcdBarrier xcd_barrier_post(unsigned* bar, volatile LAS unsigned* st) {
  XcdBarrier b; b.bar = bar; b.x = xb_xcc_id(); b.st = st;
  if (threadIdx.x == 0) (void)xb_add(&bar[XB_XCNT(b.x)], 1u);
  return b;
}
__device__ __forceinline__ void xcd_barrier_complete(unsigned* bar, unsigned x, unsigned& nloc, unsigned& nx) {
  const unsigned G = gridDim.x;
  unsigned sum, cnt, mine, sp = 0u;
  for (;;) {
    sum = 0u; cnt = 0u; mine = 0u;
#pragma unroll
    for (unsigned j = 0; j < 16; ++j) { const unsigned c = xb_ld(&bar[XB_XCNT(j)]); sum += c; cnt += (c > 0u) ? 1u : 0u; mine = (j == x) ? c : mine; }
    if (sum == G) break;
    __builtin_amdgcn_s_sleep(1);
    if ((++sp & 255u) == 0u) { if (xb_ld(&bar[XB_TMO])) break; if (sp > XB_SPIN_CAP) { atomicAdd(&bar[XB_TMO], 1u); break; } }
  }
  nloc = mine > 0u ? mine : 1u; nx = cnt > 0u ? cnt : 1u;
}
__device__ __forceinline__ void xcd_barrier(const XcdBarrier& b) {
  asm volatile("s_waitcnt vmcnt(0)" ::: "memory");
  __syncthreads();
  if (threadIdx.x == 0) {
    unsigned* bar = b.bar;
    __builtin_amdgcn_s_waitcnt(0);
    unsigned nloc = b.st[0], nx = b.st[1];
    if (nloc == 0u) { xcd_barrier_complete(bar, b.x, nloc, nx); b.st[0] = nloc; b.st[1] = nx; }
    const unsigned old = xb_add(&bar[XB_XSUB(b.x)], 1u);
    const unsigned gen = old / nloc;
    if (old + 1u == (gen + 1u) * nloc) {
      __builtin_amdgcn_fence(__ATOMIC_RELEASE, "agent");
      asm volatile("s_waitcnt vmcnt(0)" ::: "memory");
      const unsigned og = xb_add(&bar[XB_TOP], 1u);
      const unsigned tg = og / nx;
      if (og + 1u == (tg + 1u) * nx) xb_add(&bar[XB_TOPGEN], 1u);
      else XB_SPIN(xb_ld(&bar[XB_TOPGEN]) == tg, bar);
      __builtin_amdgcn_fence(__ATOMIC_ACQUIRE, "agent");
      xb_add(&bar[XB_XGEN(b.x)], 1u);
      asm volatile("s_waitcnt vmcnt(0)" ::: "memory");
    } else {
      XB_SPIN(xb_ld(&bar[XB_XGEN(b.x)]) == gen, bar);
      __builtin_amdgcn_fence(__ATOMIC_ACQUIRE, "agent");
      asm volatile("s_waitcnt vmcnt(0)" ::: "memory");
    }
  }
  __syncthreads();
}

constexpr int NSLOTS = 13;
constexpr int NPHASE = 2 + 4 * NSLOTS;
__device__ __forceinline__ bool phase_is_nop(int ph) {
  if (ph < 2) return false;
  const int layer = (ph - 2) / NSLOTS, st = (ph - 2) % NSLOTS;
  if (st == 5 || st == 6) return true;
  return !(layer & 1) && (st == 1 || (st >= 3 && st <= 7));
}
__device__ void run_phase(KP p, int ph, char* sm) {
  if (ph == 0) { ph_init(p, sm); return; }
  if (ph == 1) { ph_mod_h(p, sm); return; }
  const int layer = (ph - 2) / NSLOTS, st = (ph - 2) % NSLOTS;
  const bool odd = layer & 1;
  const bool keep = layer < 3;
  int gk = -1;
  if (st == 0) gk = 0;
  else if (st == 8) gk = 1;
  else if (st == 10) gk = 2;
  else if (st == 11) gk = 3;
  else if (odd && st == 2) gk = 4;
  else if (odd && st == 3) gk = 5;
  asm volatile("" : "+s"(gk));
  if (gk >= 0) {
    if (gk == 2 || gk == 3) moe_prefix(p, keep ? NT : NL, (int*)(sm + META_OFF), opaque_tid());
    ph_gemm(p, gk, layer, keep, sm);
    if (gk == 5) { __syncthreads(); ph_mlstm_s2(p, sm); }
    return;
  }
  switch (st) {
    case 1: if (odd) { ph_rwkv_mix(p, layer); ph_mlstm_s1(p, layer, sm); } break;
    case 2: ph_attention(p, layer, keep, sm); break;
    case 4: if (odd) ph_scan_a(p, layer, sm); break;
    case 7: if (odd) ph_rec_final(p, layer, keep); break;
    case 9: ph_ln_router(p, layer, keep, sm); break;
    case 12: ph_final_ln(p, layer, keep, sm); break;
  }
}

__global__ void __launch_bounds__(NTHR, 2) mega_kernel(Params kargs) {
  extern __shared__ __attribute__((aligned(16))) char sm[];
  cg::grid_group grid = cg::this_grid();
  volatile LAS unsigned* st = (volatile LAS unsigned*)(sm + META_OFF + 4032);
  if (threadIdx.x == 0) { st[0] = 0u; st[1] = 0u; }
  __syncthreads();
  const XcdBarrier xb = xcd_barrier_post(kargs.bar, st);
  for (int ph = kargs.ph_lo; ph < kargs.ph_hi; ++ph) {
    if (phase_is_nop(ph)) continue;
    {
      KP kp = (KP)__builtin_amdgcn_kernarg_segment_ptr();
      asm volatile("" : "+s"(kp));
      run_phase(kp, ph, sm);
    }
    if (ph + 1 < kargs.ph_hi) {
      if (ph == 0) grid.sync();
      else xcd_barrier(xb);
    }
  }
}

extern "C" void kernel_launch(void* const* d_in, const int* in_sizes, int n_in, void* d_out, int out_size, void* d_ws,
                              size_t ws_size, hipStream_t stream) {
  static int grid_blocks = 0;
  if (!grid_blocks) {
    int dev = 0, cus = 0, per_cu = 0;
    (void)hipGetDevice(&dev);
    (void)hipDeviceGetAttribute(&cus, hipDeviceAttributeMultiprocessorCount, dev);
    (void)hipFuncSetAttribute((const void*)mega_kernel, hipFuncAttributeMaxDynamicSharedMemorySize, SMEM_BYTES);
    (void)hipOccupancyMaxActiveBlocksPerMultiprocessor(&per_cu, mega_kernel, NTHR, SMEM_BYTES);
    if (per_cu < 1) per_cu = 1;
    if (per_cu > 2) per_cu = 2;
    grid_blocks = cus * per_cu;
  }
  Params p;
  memset(&p, 0, sizeof(p));
  const float** pin = (const float**)&p;
  for (int i = 0; i < 35; ++i) pin[i] = (const float*)d_in[i];
  p.out = (float*)d_out;
  char* w = (char*)d_ws;
  size_t off = 0;
  auto take = [&](size_t bytes) { char* r = w + off; off += (bytes + 255) & ~(size_t)255; return r; };
  p.Wt_att = (bf16_t*)take((size_t)2 * ATT_N * 1024 * 2);
  p.Wt_rec = (bf16_t*)take((size_t)2 * REC_NP * 1024 * 2);
  p.Wt_out = (bf16_t*)take((size_t)4 * 1024 * 1024 * 2);
  p.Wt13 = (bf16_t*)take((size_t)4 * 65 * 512 * 1024);
  p.Wt2 = (bf16_t*)take((size_t)4 * 65 * 1024 * 256);
  p.Wl1 = (bf16_t*)take((size_t)2 * 3 * 128 * 512 * 2);
  p.Wl2 = (bf16_t*)take((size_t)2 * 2560 * 128 * 2);
  p.X = (float*)take((size_t)NT * DM * 4);
  p.AB = (bf16_t*)take((size_t)NT * DM * 2);
  p.MOD = (float*)take((size_t)5 * 9 * 6144 * 4);
  p.MODP = (float*)take((size_t)8 * 4 * 9 * 6144 * 4);
  p.GP = (float*)take((size_t)NT * 16 * 4);
  p.ROPE = (float*)take((size_t)64 * 16 * 2 * 4);
  p.WrT = (float*)take((size_t)4 * 64 * 1024 * 4);
  p.msc = (float*)take((size_t)3 * NMT * 4);
  p.lgate = (float*)take((size_t)64 * NT * 4);
  p.ltok = (int*)take((size_t)64 * NT * 4);
  p.tsl = (int*)take((size_t)NT * 6 * 4);
  p.cnt = (int*)take((size_t)65 * CSTR * 4);
  p.bar = (unsigned*)take((size_t)BAR_TOTAL_WORDS * 4);
  char* region = take(0);
  const size_t szP = (size_t)NT * LDP * 2, szRW = (size_t)NT * RWS * 2, szMS = (size_t)NMT * 16384 * 2,
               szMSn = (size_t)NMT * 128 * 4;
  const size_t szT = (size_t)NT * DM * 4, szOUT2 = (size_t)NSLOT * 1024 * 2;
  p.P = (bf16_t*)region;
  p.RW = (bf16_t*)(region + szP);
  p.MS = (bf16_t*)(region + szP + szRW);
  p.MSn = (float*)(region + szP + szRW + szMS);
  p.Tb = (float*)region;
  p.ACT = (bf16_t*)region;
  p.OUT2 = (bf16_t*)(region + szT);
  const size_t szZ = (size_t)NT * 2048 * 2;
  p.Zb = (bf16_t*)(region + szP + szRW + szMS + szMSn);
  p.L1 = p.Zb + (size_t)NT * 1536;
  size_t mixer = szP + szRW + szMS + szMSn + szZ, moe = szT + szOUT2;
  off += (mixer > moe ? mixer : moe);
  if (off > ws_size) { fprintf(stderr, "workspace too small: need %zu have %zu\n", off, ws_size); return; }
  p.ph_lo = 0;
  p.ph_hi = NPHASE;
  (void)hipMemsetAsync(p.bar, 0, (size_t)BAR_TOTAL_WORDS * 4, stream);
  void* args[] = {&p};
  hipError_t e = hipLaunchCooperativeKernel((void*)mega_kernel, dim3(grid_blocks), dim3(NTHR), args, SMEM_BYTES, stream);
  if (e != hipSuccess) fprintf(stderr, "cooperative launch failed: %s (grid %d)\n", hipGetErrorString(e), grid_blocks);
}
```

```cpp
#include <hip/hip_runtime.h>
#include <hip/hip_cooperative_groups.h>
#include <cstdio>
#include <cstring>
namespace cg = cooperative_groups;

constexpr int DM = 1024;
constexpr int NBATCH = 8;
constexpr int SEQ = 2048;
constexpr int CTXL = 256;
constexpr int NL = NBATCH * SEQ;
constexpr int NC = NBATCH * CTXL;
constexpr int NT = NL + NC;
constexpr int TSC = CTXL + SEQ;
constexpr int LDP = 4112;
constexpr int ATT_N = 2304;
constexpr int REC_N = 4112;
constexpr int REC_NP = 4224;
constexpr int NCHUNK = 36;
constexpr int NMT = 64 * NCHUNK;
constexpr int RWS = 5632;
constexpr int NSLOT = 137216;
constexpr float DN_ALPHA = 1.6817928305074290f;
constexpr int NTHR = 256;
constexpr int SMEM_BYTES = 65536 + 4096;
constexpr int META_OFF = 65536;
#define XCD_BAR_WORDS 3456
constexpr int CSTR = 32;
constexpr int BAR_TOTAL_WORDS = XCD_BAR_WORDS + 64;

typedef unsigned short bf16_t;
using bf16x8 = __attribute__((ext_vector_type(8))) short;
using f32x16 = __attribute__((ext_vector_type(16))) float;
using u32x4 = __attribute__((ext_vector_type(4))) unsigned;
using u32x2 = __attribute__((ext_vector_type(2))) unsigned;

struct Params {
  const float *x, *c, *ctx, *c_ctx, *ada_w, *ada_b, *ln_g, *ln_b, *mix_w_out, *att_w_in, *na_rpb, *qk_gain,
      *rec_w_in, *rwkv_mu, *rwkv_w0, *rwkv_w1, *rwkv_w2, *rwkv_a0, *rwkv_a1, *rwkv_a2, *rwkv_g1, *rwkv_g2,
      *rwkv_kvec, *rwkv_rk, *rwkv_gn, *mlstm_gate_b, *mlstm_norm, *moe_router, *moe_bias, *moe_w1, *moe_w3,
      *moe_w2, *shared_w1, *shared_w3, *shared_w2;
  float* out;
  bf16_t *Wt_att, *Wt_rec, *Wt_out, *Wt13, *Wt2, *Wl1, *Wl2;
  bf16_t *Zb, *L1;
  float *X, *MOD, *MODP, *GP, *msc, *lgate, *MSn, *Tb, *ROPE, *WrT;
  bf16_t *AB, *P, *RW, *MS, *ACT, *OUT2;
  int *cnt, *ltok, *tsl;
  unsigned* bar;
  int ph_lo, ph_hi;
};

typedef const Params __attribute__((address_space(4))) * KP;

__device__ __forceinline__ int modrow(int t) { return t < NL ? (t >> 11) : 8; }
__device__ __forceinline__ float silu_f(float x) { return x / (1.f + expf(-x)); }
__device__ __forceinline__ float sigm_f(float x) { return 1.f / (1.f + expf(-x)); }
__device__ __forceinline__ float softplus_f(float x) { return fmaxf(x, 0.f) + log1pf(expf(-fabsf(x))); }
template <int CTRL>
__device__ __forceinline__ float dppx(float x) {
  return __int_as_float(__builtin_amdgcn_update_dpp(0, __float_as_int(x), CTRL, 0xf, 0xf, true));
}
__device__ __forceinline__ float rdlane(float v, int l) {
  return __int_as_float(__builtin_amdgcn_readlane(__float_as_int(v), l));
}
__device__ __forceinline__ float wsum(float v) {
  v += dppx<0xB1>(v); v += dppx<0x4E>(v); v += dppx<0x141>(v); v += dppx<0x140>(v);
  return (rdlane(v, 0) + rdlane(v, 16)) + (rdlane(v, 32) + rdlane(v, 48));
}
__device__ __forceinline__ float wmax(float v) {
  v = fmaxf(v, dppx<0xB1>(v)); v = fmaxf(v, dppx<0x4E>(v)); v = fmaxf(v, dppx<0x141>(v)); v = fmaxf(v, dppx<0x140>(v));
  return fmaxf(fmaxf(rdlane(v, 0), rdlane(v, 16)), fmaxf(rdlane(v, 32), rdlane(v, 48)));
}
__device__ __forceinline__ int opaque_tid() {
  int t = threadIdx.x;
  asm volatile("" : "+v"(t));
  return t;
}
typedef __bf16 bf16x2_t __attribute__((ext_vector_type(2)));
typedef float f32x2_t __attribute__((ext_vector_type(2)));
__device__ __forceinline__ unsigned pk_bf16(float lo, float hi) {
  const f32x2_t v = {lo, hi};
  return __builtin_bit_cast(unsigned, __builtin_convertvector(v, bf16x2_t));
}
__device__ __forceinline__ bf16_t f2bf(float x) { return (bf16_t)(pk_bf16(x, 0.f) & 0xffffu); }
__device__ __forceinline__ float bf2f(bf16_t v) { return __uint_as_float((unsigned)v << 16); }
__device__ __forceinline__ float bflo(unsigned u) { return __uint_as_float(u << 16); }
__device__ __forceinline__ float bfhi(unsigned u) { return __uint_as_float(u & 0xffff0000u); }
__device__ __forceinline__ int scan_row(int dir, int b, int tau) {
  if (tau < CTXL) return NL + b * CTXL + (dir ? (CTXL - 1 - tau) : tau);
  int s = tau - CTXL;
  return b * SEQ + (dir ? (SEQ - 1 - s) : s);
}

template <class RowPtrA>
__device__ __forceinline__ void gemm128_main(int tid, RowPtrA rowA, const bf16_t* __restrict__ Bt, int K, int n0,
                                             char* lds, f32x16 (&acc)[2][2]) {
  const int lane = tid & 63, w = tid >> 6;
  const int wm = w >> 1, wn = w & 1, r = lane & 31, h = lane >> 5;
  const int c = tid & 7, sr = tid >> 3;
  const int lc = (c ^ ((tid >> 4) & 7)) * 8;
  const bf16_t* ap[4];
#pragma unroll
  for (int i = 0; i < 4; ++i) ap[i] = rowA(sr + 32 * i) + lc;
  const bf16_t* bp0 = Bt + (size_t)(n0 + sr) * K + lc;
  const int bstr = 32 * K;
#pragma unroll
  for (int mi = 0; mi < 2; ++mi)
#pragma unroll
    for (int ni = 0; ni < 2; ++ni)
#pragma unroll
      for (int q = 0; q < 16; ++q) acc[mi][ni][q] = 0.f;
  const int nk = K >> 6;
  auto issue = [&](int kt) {
    char* As = lds + (kt & 1) * 32768 + tid * 16;
    const int k0 = kt * 64;
#pragma unroll
    for (int i = 0; i < 4; ++i) {
      __builtin_amdgcn_global_load_lds((const unsigned*)(ap[i] + k0), (__attribute__((address_space(3))) unsigned*)(As + i * 4096), 16, 0, 0);
      __builtin_amdgcn_global_load_lds((const unsigned*)(bp0 + i * bstr + k0), (__attribute__((address_space(3))) unsigned*)(As + 16384 + i * 4096), 16, 0, 0);
    }
  };
  issue(0);
  const int sw = (r >> 1) & 7;
#pragma unroll 1
  for (int kt = 0; kt < nk; ++kt) {
    asm volatile("s_waitcnt vmcnt(0)" ::: "memory");
    __syncthreads();
    if (kt + 1 < nk) issue(kt + 1);
    const char* As = lds + (kt & 1) * 32768;
    const char* Ar = As + (wm * 64 + r) * 128;
    const char* Br = As + 16384 + (wn * 64 + r) * 128;
#pragma unroll
    for (int ks = 0; ks < 4; ++ks) {
      const int off = ((ks * 2 + h) ^ sw) * 16;
      const bf16x8 a0 = *(const bf16x8*)(Ar + off);
      const bf16x8 a1 = *(const bf16x8*)(Ar + 32 * 128 + off);
      const bf16x8 b0 = *(const bf16x8*)(Br + off);
      const bf16x8 b1 = *(const bf16x8*)(Br + 32 * 128 + off);
      acc[0][0] = __builtin_amdgcn_mfma_f32_32x32x16_bf16(a0, b0, acc[0][0], 0, 0, 0);
      acc[0][1] = __builtin_amdgcn_mfma_f32_32x32x16_bf16(a0, b1, acc[0][1], 0, 0, 0);
      acc[1][0] = __builtin_amdgcn_mfma_f32_32x32x16_bf16(a1, b0, acc[1][0], 0, 0, 0);
      acc[1][1] = __builtin_amdgcn_mfma_f32_32x32x16_bf16(a1, b1, acc[1][1], 0, 0, 0);
    }
  }
  __syncthreads();
}
using i64 = long;
typedef int i32x8 __attribute__((ext_vector_type(8)));
template <class RowPtrA8>
__device__ __forceinline__ void gemm128_fp8(int tid, RowPtrA8 rowA, const unsigned char* __restrict__ Bt, int K, int n0,
                                            char* lds, f32x16 (&acc)[2][2]) {
  const int lane = tid & 63, w = tid >> 6;
  const int wm = w >> 1, wn = w & 1, r = lane & 31, h = lane >> 5;
  const int c = tid & 7, sr = tid >> 3;
  const int lc = (c ^ ((tid >> 4) & 7)) * 16;
  const unsigned char* ap[4];
#pragma unroll
  for (int i = 0; i < 4; ++i) ap[i] = rowA(sr + 32 * i) + lc;
  const unsigned char* bp0 = Bt + (size_t)(n0 + sr) * K + lc;
  const int bstr = 32 * K;
#pragma unroll
  for (int mi = 0; mi < 2; ++mi)
#pragma unroll
    for (int ni = 0; ni < 2; ++ni)
#pragma unroll
      for (int q = 0; q < 16; ++q) acc[mi][ni][q] = 0.f;
  const int nk = K >> 7;
  auto issue = [&](int kt) {
    char* As = lds + (kt & 1) * 32768 + tid * 16;
    const int k0 = kt * 128;
#pragma unroll
    for (int i = 0; i < 4; ++i) {
      __builtin_amdgcn_global_load_lds((const unsigned*)(ap[i] + k0), (__attribute__((address_space(3))) unsigned*)(As + i * 4096), 16, 0, 0);
      __builtin_amdgcn_global_load_lds((const unsigned*)(bp0 + i * bstr + k0), (__attribute__((address_space(3))) unsigned*)(As + 16384 + i * 4096), 16, 0, 0);
    }
  };
  issue(0);
  if (nk > 1) issue(1);
  const int sw = (r >> 1) & 7;
#pragma unroll 1
  for (int kt = 0; kt < nk; ++kt) {
    if (kt == 0 && nk > 1) asm volatile("s_waitcnt vmcnt(8)" ::: "memory");
    else asm volatile("s_waitcnt vmcnt(0)" ::: "memory");
    __syncthreads();
    if (kt > 0 && kt + 1 < nk) issue(kt + 1);
    const char* As = lds + (kt & 1) * 32768;
    const char* Ar = As + (wm * 64 + r) * 128;
    const char* Br = As + 16384 + (wn * 64 + r) * 128;
#pragma unroll
    for (int pq = 0; pq < 2; ++pq) {
      const int o0 = ((4 * pq + 2 * h) ^ sw) * 16, o1 = ((4 * pq + 2 * h + 1) ^ sw) * 16;
      const u32x4 a0l = *(const u32x4*)(Ar + o0), a0h = *(const u32x4*)(Ar + o1);
      const u32x4 a1l = *(const u32x4*)(Ar + 32 * 128 + o0), a1h = *(const u32x4*)(Ar + 32 * 128 + o1);
      const u32x4 b0l = *(const u32x4*)(Br + o0), b0h = *(const u32x4*)(Br + o1);
      const u32x4 b1l = *(const u32x4*)(Br + 32 * 128 + o0), b1h = *(const u32x4*)(Br + 32 * 128 + o1);
      const i32x8 A0 = {(int)a0l.x, (int)a0l.y, (int)a0l.z, (int)a0l.w, (int)a0h.x, (int)a0h.y, (int)a0h.z, (int)a0h.w};
      const i32x8 A1 = {(int)a1l.x, (int)a1l.y, (int)a1l.z, (int)a1l.w, (int)a1h.x, (int)a1h.y, (int)a1h.z, (int)a1h.w};
      const i32x8 B0 = {(int)b0l.x, (int)b0l.y, (int)b0l.z, (int)b0l.w, (int)b0h.x, (int)b0h.y, (int)b0h.z, (int)b0h.w};
      const i32x8 B1 = {(int)b1l.x, (int)b1l.y, (int)b1l.z, (int)b1l.w, (int)b1h.x, (int)b1h.y, (int)b1h.z, (int)b1h.w};
      acc[0][0] = __builtin_amdgcn_mfma_scale_f32_32x32x64_f8f6f4(A0, B0, acc[0][0], 0, 0, 0, 0, 0, 0);
      acc[0][1] = __builtin_amdgcn_mfma_scale_f32_32x32x64_f8f6f4(A0, B1, acc[0][1], 0, 0, 0, 0, 0, 0);
      acc[1][0] = __builtin_amdgcn_mfma_scale_f32_32x32x64_f8f6f4(A1, B0, acc[1][0], 0, 0, 0, 0, 0, 0);
      acc[1][1] = __builtin_amdgcn_mfma_scale_f32_32x32x64_f8f6f4(A1, B1, acc[1][1], 0, 0, 0, 0, 0, 0);
    }
  }
  __syncthreads();
}
template <class F>
__device__ __forceinline__ void acc_foreach(int tid, const f32x16 (&acc)[2][2], F f) {
  const int lane = tid & 63, w = tid >> 6;
  const int wm = w >> 1, wn = w & 1, r = lane & 31, h = lane >> 5;
#pragma unroll
  for (int mi = 0; mi < 2; ++mi)
#pragma unroll
    for (int ni = 0; ni < 2; ++ni)
#pragma unroll
      for (int q = 0; q < 16; ++q) {
        const int row = wm * 64 + mi * 32 + (q & 3) + 8 * (q >> 2) + 4 * h;
        const int col = wn * 64 + ni * 32 + r;
        f(row, col, acc[mi][ni][q]);
        if ((q & 3) == 3) __builtin_amdgcn_sched_barrier(0);
      }
}

template <class RM>
__device__ __forceinline__ void tr_tile(int tid, const float* __restrict__ src, int N, int k0, int n0,
                                        bf16_t* __restrict__ dst, int K, RM rowmap, float* tile) {
  {
    const int tx = tid & 15, ty = tid >> 4;
    const int n = n0 + tx * 4;
#pragma unroll
    for (int i = 0; i < 4; ++i) {
      const int k = ty + 16 * i;
      float4 v = make_float4(0.f, 0.f, 0.f, 0.f);
      if (n < N) v = *(const float4*)(src + (size_t)(k0 + k) * N + n);
      tile[k * 65 + tx * 4 + 0] = v.x; tile[k * 65 + tx * 4 + 1] = v.y;
      tile[k * 65 + tx * 4 + 2] = v.z; tile[k * 65 + tx * 4 + 3] = v.w;
    }
  }
  __syncthreads();
  {
    const int kc = tid & 7;
#pragma unroll
    for (int i = 0; i < 2; ++i) {
      const int n = (tid >> 3) + 32 * i;
      if (n0 + n < N) {
        float v[8];
#pragma unroll
        for (int q = 0; q < 8; ++q) v[q] = tile[(kc * 8 + q) * 65 + n];
        u32x4 o;
        o.x = pk_bf16(v[0], v[1]); o.y = pk_bf16(v[2], v[3]); o.z = pk_bf16(v[4], v[5]); o.w = pk_bf16(v[6], v[7]);
        *(u32x4*)(dst + (size_t)rowmap(n0 + n) * K + k0 + kc * 8) = o;
      }
    }
  }
  __syncthreads();
}

constexpr float W8_SCALE = 32.f, W8_INV = 1.f / 32.f;
__device__ __forceinline__ unsigned pk_fp8x4(float a, float b, float c, float d) {
  int r = __builtin_amdgcn_cvt_pk_fp8_f32(a, b, 0, false);
  r = __builtin_amdgcn_cvt_pk_fp8_f32(c, d, r, true);
  return (unsigned)r;
}
__device__ __forceinline__ unsigned pk_fp8x4c(float a, float b, float c, float d) {
  constexpr float M = 448.f;
  return pk_fp8x4(fminf(fmaxf(a, -M), M), fminf(fmaxf(b, -M), M), fminf(fmaxf(c, -M), M), fminf(fmaxf(d, -M), M));
}
template <class RM>
__device__ __forceinline__ void tr_tile_fp8(int tid, const float* __restrict__ src, int N, int k0, int n0,
                                            unsigned char* __restrict__ dst, int K, RM rowmap, float* tile) {
  {
    const int tx = tid & 15, ty = tid >> 4;
    const int n = n0 + tx * 4;
#pragma unroll
    for (int i = 0; i < 4; ++i) {
      const int k = ty + 16 * i;
      float4 v = make_float4(0.f, 0.f, 0.f, 0.f);
      if (n < N) v = *(const float4*)(src + (size_t)(k0 + k) * N + n);
      tile[k * 65 + tx * 4 + 0] = v.x; tile[k * 65 + tx * 4 + 1] = v.y;
      tile[k * 65 + tx * 4 + 2] = v.z; tile[k * 65 + tx * 4 + 3] = v.w;
    }
  }
  __syncthreads();
  {
    const int kc = tid & 3, n = tid >> 2;
    float v[16];
#pragma unroll
    for (int q = 0; q < 16; ++q) v[q] = tile[(kc * 16 + q) * 65 + n] * W8_SCALE;
    u32x4 o;
    o.x = pk_fp8x4c(v[0], v[1], v[2], v[3]); o.y = pk_fp8x4c(v[4], v[5], v[6], v[7]);
    o.z = pk_fp8x4c(v[8], v[9], v[10], v[11]); o.w = pk_fp8x4c(v[12], v[13], v[14], v[15]);
    *(u32x4*)(dst + (size_t)rowmap(n0 + n) * K + k0 + kc * 16) = o;
  }
  __syncthreads();
}

constexpr int CJ0 = 1152, CJ1 = CJ0 + 2080, CJ2 = CJ1 + 1024, CJ3 = CJ2 + 33280, CJ4 = CJ3 + 16640;
__device__ void convert_job(KP p, int job, float* sm, int tid) {
  if (job < CJ0) {
    const int j = job / 576, rem = job % 576, kt = rem / 36, nt = rem % 36;
    tr_tile_fp8(tid, p->att_w_in + (size_t)j * 1024 * ATT_N, ATT_N, kt * 64, nt * 64, (unsigned char*)p->Wt_att + (size_t)j * ATT_N * 1024,
                1024, [](int n) { return n; }, sm);
  } else if (job < CJ1) {
    const int q = job - CJ0;
    const int j = q / 1040, rem = q % 1040, kt = rem / 65, nt = rem % 65;
    tr_tile_fp8(tid, p->rec_w_in + (size_t)j * 1024 * REC_N, REC_N, kt * 64, nt * 64, (unsigned char*)p->Wt_rec + (size_t)j * REC_NP * 1024,
                1024, [](int n) { return n; }, sm);
  } else if (job < CJ2) {
    const int q = job - CJ1;
    const int i = q >> 8, rem = q & 255, kt = rem >> 4, nt = rem & 15;
    tr_tile_fp8(tid, p->mix_w_out + (size_t)i * 1024 * 1024, 1024, kt * 64, nt * 64, (unsigned char*)p->Wt_out + (size_t)i * 1024 * 1024,
                1024, [](int n) { return n; }, sm);
  } else if (job < CJ3) {
    const int q = job - CJ2;
    const int le = q >> 7, rem = q & 127;
    const int which = rem >> 6, kt = (rem >> 2) & 15, nt = rem & 3;
    const int layer = le / 65, e = le % 65;
    const float* src;
    if (e < 64) src = (which ? p->moe_w3 : p->moe_w1) + (size_t)(layer * 64 + e) * 1024 * 256;
    else src = (which ? p->shared_w3 : p->shared_w1) + (size_t)layer * 1024 * 256;
    tr_tile_fp8(tid, src, 256, kt * 64, nt * 64, (unsigned char*)p->Wt13 + (size_t)le * 512 * 1024, 1024,
                [which](int n) { return 64 * (n >> 5) + which * 32 + (n & 31); }, sm);
  } else {
    const int q = job - CJ3;
    const int le = q >> 6, rem = q & 63;
    const int kt = rem >> 4, nt = rem & 15;
    const int layer = le / 65, e = le % 65;
    const float* src = e < 64 ? p->moe_w2 + (size_t)(layer * 64 + e) * 256 * 1024 : p->shared_w2 + (size_t)layer * 256 * 1024;
    tr_tile_fp8(tid, src, 1024, kt * 64, nt * 64, (unsigned char*)p->Wt2 + (size_t)le * 1024 * 256, 256, [](int n) { return n; }, sm);
  }
}
__device__ __forceinline__ int conv_stage_total(int stage) {
  return stage == 0 ? (576 + 1040 + 512 + 8320 + 4160) : (stage == 1 ? (576 + 1040 + 256 + 16640 + 8320) : (256 + 8320 + 4160));
}
__device__ __forceinline__ int conv_stage_job(int stage, int q) {
  if (stage == 0) {
    if (q < 8320) return CJ2 + q;  q -= 8320;
    if (q < 4160) return CJ3 + q;  q -= 4160;
    if (q < 576) return q;  q -= 576;
    if (q < 1040) return CJ0 + q;  q -= 1040;
    return CJ1 + q;
  } else if (stage == 1) {
    if (q < 8320) return CJ2 + 8320 + q;  q -= 8320;
    if (q < 4160) return CJ3 + 4160 + q;  q -= 4160;
    if (q < 576) return 576 + q;  q -= 576;
    if (q < 256) return CJ1 + 512 + q;  q -= 256;
    if (q < 8320) return CJ2 + 16640 + q;  q -= 8320;
    if (q < 4160) return CJ3 + 8320 + q;  q -= 4160;
    return CJ0 + 1040 + q;
  }
  if (q < 256) return CJ1 + 768 + q;  q -= 256;
  if (q < 8320) return CJ2 + 24960 + q;  q -= 8320;
  return CJ3 + 12480 + q;
}

struct CvDesc { const float* src; unsigned char* dst; int N, K, k0, n0, which; };
__device__ __forceinline__ bool conv_desc_fp8(KP p, int job, CvDesc& d) {
  if (job < CJ2) return false;
  if (job < CJ3) {
    const int q = job - CJ2;
    const int le = q >> 7, rem = q & 127;
    const int which = rem >> 6, kt = (rem >> 2) & 15, nt = rem & 3;
    const int layer = le / 65, e = le % 65;
    if (e < 64) d.src = (which ? p->moe_w3 : p->moe_w1) + (size_t)(layer * 64 + e) * 1024 * 256;
    else d.src = (which ? p->shared_w3 : p->shared_w1) + (size_t)layer * 1024 * 256;
    d.dst = (unsigned char*)p->Wt13 + (size_t)le * 512 * 1024;
    d.N = 256; d.K = 1024; d.k0 = kt * 64; d.n0 = nt * 64; d.which = which;
  } else {
    const int q = job - CJ3;
    const int le = q >> 6, rem = q & 63;
    const int kt = rem >> 4, nt = rem & 15;
    const int layer = le / 65, e = le % 65;
    d.src = e < 64 ? p->moe_w2 + (size_t)(layer * 64 + e) * 256 * 1024 : p->shared_w2 + (size_t)layer * 256 * 1024;
    d.dst = (unsigned char*)p->Wt2 + (size_t)le * 1024 * 256;
    d.N = 1024; d.K = 256; d.k0 = kt * 64; d.n0 = nt * 64; d.which = -1;
  }
  return true;
}
typedef float cvf4 __attribute__((ext_vector_type(4)));
__device__ __forceinline__ void cv_load(const CvDesc& d, int tid, cvf4& v0, cvf4& v1, cvf4& v2, cvf4& v3) {
  const int tx = tid & 15, ty = tid >> 4;
  const float* s0 = d.src + (size_t)(d.k0 + ty) * d.N + d.n0 + tx * 4;
  v0 = *(const cvf4*)(s0);
  v1 = *(const cvf4*)(s0 + (size_t)16 * d.N);
  v2 = *(const cvf4*)(s0 + (size_t)32 * d.N);
  v3 = *(const cvf4*)(s0 + (size_t)48 * d.N);
}
__device__ __forceinline__ void cv_emit(const CvDesc& d, int tid, const cvf4 v0, const cvf4 v1, const cvf4 v2, const cvf4 v3, float* tile) {
  {
    const int tx = tid & 15, ty = tid >> 4;
    float* t0 = tile + ty * 65 + tx * 4;
    t0[0] = v0.x; t0[1] = v0.y; t0[2] = v0.z; t0[3] = v0.w;
    t0[16 * 65 + 0] = v1.x; t0[16 * 65 + 1] = v1.y; t0[16 * 65 + 2] = v1.z; t0[16 * 65 + 3] = v1.w;
    t0[32 * 65 + 0] = v2.x; t0[32 * 65 + 1] = v2.y; t0[32 * 65 + 2] = v2.z; t0[32 * 65 + 3] = v2.w;
    t0[48 * 65 + 0] = v3.x; t0[48 * 65 + 1] = v3.y; t0[48 * 65 + 2] = v3.z; t0[48 * 65 + 3] = v3.w;
  }
  __syncthreads();
  {
    const int kc = tid & 3, n = tid >> 2;
    float v[16];
#pragma unroll
    for (int q = 0; q < 16; ++q) v[q] = tile[(kc * 16 + q) * 65 + n] * W8_SCALE;
    u32x4 o;
    o.x = pk_fp8x4c(v[0], v[1], v[2], v[3]); o.y = pk_fp8x4c(v[4], v[5], v[6], v[7]);
    o.z = pk_fp8x4c(v[8], v[9], v[10], v[11]); o.w = pk_fp8x4c(v[12], v[13], v[14], v[15]);
    const int nn = d.n0 + n;
    const int row = d.which >= 0 ? 64 * (nn >> 5) + d.which * 32 + (nn & 31) : nn;
    *(u32x4*)(d.dst + (size_t)row * d.K + d.k0 + kc * 16) = o;
  }
  __syncthreads();
}
__device__ __forceinline__ void convert_run(KP p, int stage, int jj, int j1, float* sm, int tid) {
  CvDesc d, dn;
  cvf4 a0, a1, a2, a3, b0, b1, b2, b3;
  bool cur = false;
#pragma unroll 1
  for (; jj < j1; ++jj) {
    const int job = conv_stage_job(stage, jj);
    if (!cur) {
      if (!conv_desc_fp8(p, job, d)) { convert_job(p, job, sm, tid); continue; }
      cv_load(d, tid, a0, a1, a2, a3);
    }
    bool nxt = false;
    if (jj + 1 < j1) {
      nxt = conv_desc_fp8(p, conv_stage_job(stage, jj + 1), dn);
      if (nxt) cv_load(dn, tid, b0, b1, b2, b3);
    }
    cv_emit(d, tid, a0, a1, a2, a3, sm);
    if (nxt) { d = dn; a0 = b0; a1 = b1; a2 = b2; a3 = b3; }
    cur = nxt;
  }
}

__device__ void ph_init(KP p, char* smc) {
  float* sm = (float*)smc;
  const int tid = opaque_tid();
  {
    const size_t n4a = (size_t)NL * DM / 4, n4b = (size_t)NC * DM / 4;
    const float4* xs = (const float4*)p->x;
    const float4* cs = (const float4*)p->ctx;
    float4* X4 = (float4*)p->X;
    for (size_t i = (size_t)blockIdx.x * NTHR + tid; i < n4a + n4b; i += (size_t)gridDim.x * NTHR)
      X4[i] = i < n4a ? xs[i] : cs[i - n4a];
  }
  for (int tile = blockIdx.x; tile < 96 * 8; tile += gridDim.x) {
    const int ct = tile >> 3, ks = tile & 7;
    for (int i = tid; i < 9 * 128; i += NTHR) {
      const int r = i >> 7, k = ks * 128 + (i & 127);
      const float v = r < 8 ? p->c[r * 1024 + k] : p->c_ctx[k];
      sm[i] = silu_f(v);
    }
    __syncthreads();
    const int col = ct * 256 + tid;
    const int layer = col / 6144, n = col % 6144;
    const float* W = p->ada_w + ((size_t)layer * 1024 + ks * 128) * 6144 + n;
    float acc[9];
#pragma unroll
    for (int r = 0; r < 9; ++r) acc[r] = 0.f;
#pragma unroll 4
    for (int k = 0; k < 128; ++k) {
      const float w = W[(size_t)k * 6144];
#pragma unroll
      for (int r = 0; r < 9; ++r) acc[r] = fmaf(sm[r * 128 + k], w, acc[r]);
    }
#pragma unroll
    for (int r = 0; r < 9; ++r) p->MODP[((size_t)(ks * 4 + layer) * 9 + r) * 6144 + n] = acc[r];
    __syncthreads();
  }
  {
    const int total = conv_stage_total(0), chunk = (total + gridDim.x - 1) / gridDim.x;
    const int lo = min((int)blockIdx.x * chunk, total), hi = min(lo + chunk, total);
    __syncthreads();
    convert_run(p, 0, lo, hi, sm, tid);
  }
  for (int i = blockIdx.x * NTHR + tid; i < 2 * 3 * 128 * 512; i += gridDim.x * NTHR) {
    const int k = i & 511, n = (i >> 9) & 127, wj = i >> 16;
    const int j = wj / 3, which = wj % 3;
    float v = 0.f;
    if (which < 2) {
      if (n < 64) v = (which ? p->rwkv_a1 : p->rwkv_w1)[((size_t)(j * 2 + (n >> 5)) * 512 + k) * 32 + (n & 31)];
    } else if (n < 96) v = p->rwkv_g1[((size_t)j * 512 + k) * 96 + n];
    p->Wl1[i] = f2bf(v);
  }
  for (int i = blockIdx.x * NTHR + tid; i < 2 * 2560 * 128; i += gridDim.x * NTHR) {
    const int k = i & 127, n = (i >> 7) % 2560, j = i / (2560 * 128);
    float v = 0.f;
    if (n < 2048) {
      const int d = (n >> 9) & 1, c = n & 511;
      if (k < 64 && (k >> 5) == d) v = (n < 1024 ? p->rwkv_w2 : p->rwkv_a2)[((size_t)(j * 2 + d) * 32 + (k & 31)) * 512 + c];
    } else if (k < 96) v = p->rwkv_g2[((size_t)j * 96 + k) * 512 + (n - 2048)];
    p->Wl2[i] = f2bf(v);
  }
  for (int i = blockIdx.x * NTHR + tid; i < 4 * 64 * 1024; i += gridDim.x * NTHR) {
    const int k = i & 1023, n = (i >> 10) & 63, l = i >> 16;
    p->WrT[i] = p->moe_router[((size_t)l * 1024 + k) * 64 + n];
  }
  for (int i = blockIdx.x * NTHR + tid; i < 64 * 16; i += gridDim.x * NTHR) {
    const int pos = i >> 4, f = i & 15;
    const float ang = (float)pos * powf(10000.f, -(float)f / 16.f);
    p->ROPE[2 * i] = cosf(ang);
    p->ROPE[2 * i + 1] = sinf(ang);
  }
}

__device__ void ph_mod_h(KP p, char* smc) {
  float* sm = (float*)smc;
  const int tid = opaque_tid();
  for (int i = blockIdx.x * NTHR + tid; i < 4 * 9 * 6144; i += gridDim.x * NTHR) {
    const int layer = i / (9 * 6144), rem = i % (9 * 6144), n = rem % 6144;
    float s = p->ada_b[layer * 6144 + n];
#pragma unroll
    for (int ks = 0; ks < 8; ++ks) s += p->MODP[(size_t)(ks * 4 + layer) * 9 * 6144 + rem];
    p->MOD[i] = s;
  }
  const int lane = tid & 63, wave = tid >> 6;
  const int per = (((NT + gridDim.x - 1) / gridDim.x) + 3) & ~3;
  const int t0 = blockIdx.x * per, t1 = min(NT, t0 + per);
  int cur = -1;
  for (int tb = t0; tb < t1; tb += 4) {
    const int mr = modrow(tb);
    if (mr != cur) {
      __syncthreads();
      for (int n = tid; n < 2048; n += NTHR) {
        float a = p->ada_b[n];
#pragma unroll
        for (int ks = 0; ks < 8; ++ks) a += p->MODP[((size_t)(ks * 4) * 9 + mr) * 6144 + n];
        sm[n] = a;
      }
      cur = mr;
      __syncthreads();
    }
    const int t = tb + wave;
    if (t < t1) {
      const float* src = t < NL ? p->x + (size_t)t * DM : p->ctx + (size_t)(t - NL) * DM;
#pragma unroll
      for (int i = 0; i < 4; ++i) {
        const int n = i * 256 + lane * 4;
        const float4 xv = *(const float4*)(src + n);
        const float4 sh = *(const float4*)(sm + n);
        const float4 sc = *(const float4*)(sm + 1024 + n);
        *(unsigned*)((unsigned char*)p->AB + (size_t)t * DM + n) =
            pk_fp8x4c(xv.x * (1.f + sc.x) + sh.x, xv.y * (1.f + sc.y) + sh.y, xv.z * (1.f + sc.z) + sh.z, xv.w * (1.f + sc.w) + sh.w);
      }
    }
  }
}

typedef short v4i16_t __attribute__((ext_vector_type(4)));
using s16x4 = __attribute__((ext_vector_type(4))) short;
__device__ __forceinline__ s16x4 vtr(const char* p) {
  return __builtin_bit_cast(s16x4, __builtin_amdgcn_ds_read_tr16_b64_v4i16((__attribute__((address_space(3))) v4i16_t*)p));
}
#define MFMA32(a, b, c) __builtin_amdgcn_mfma_f32_32x32x16_bf16(a, b, c, 0, 0, 0)
__device__ void ph_attention(KP p, int layer, bool keep, char* lds) {
  const int tid = opaque_tid();
  const int lane = tid & 63, w = tid >> 6, r32 = lane & 31, hi = lane >> 5;
  const int j = layer >> 1;
  float* bias_lds = (float*)(lds + 32768 + 1024);
  const int n_gqa = 1024, n_na = 1024, n_cb = keep ? 128 : 0, n_ca = keep ? 128 : 0;
  const int total = n_gqa + n_na + n_cb + n_ca;
  constexpr float LOG2E = 1.4426950408889634f;
  constexpr float C2 = 0.125f * LOG2E;
  const int c = tid & 7, sr = tid >> 3;
  const int kso = (c ^ ((tid >> 4) & 7)) * 16;
  const int vso = (c >> 2) * 4096 + (c & 3) * 16;
  const int sw = (r32 >> 1) & 7;
  for (int vitem = blockIdx.x; vitem < total; vitem += gridDim.x) {
    int item = vitem;
    if (gridDim.x == 512) {
      const int cls0 = vitem < n_gqa ? 0 : (vitem < n_gqa + n_na ? n_gqa : (vitem < n_gqa + n_na + n_cb ? n_gqa + n_na : n_gqa + n_na + n_cb));
      const int vl = vitem - cls0, b9 = vl & 511, r9 = vl >> 9;
      item = cls0 + (cls0 < n_gqa + n_na ? 128 * (b9 & 7) + 64 * r9 + (b9 >> 3) : 16 * (b9 & 7) + (b9 >> 3));
    }
    int b, qrow0, qoff, koff, voff, ocol, lat_tiles, lat_row0;
    bool na = false;
    int r_w = 0, start_w = 0, ru0 = 0, hN = 0;
    if (item < n_gqa) {
      b = item >> 7;
      const int g = (item >> 6) & 1, tt = item & 63;
      qrow0 = b * SEQ + tt * 32; qoff = 1536 + (g * 4 + w) * 64; koff = 2048 + g * 64; voff = 2176 + g * 64;
      ocol = 512 + (g * 4 + w) * 64; lat_tiles = 32; lat_row0 = b * SEQ;
    } else if (item < n_gqa + n_na) {
      const int it = item - n_gqa;
      b = it >> 7; hN = (it >> 4) & 7;
      const int rp = it & 15;
      na = true; r_w = 2 * rp + (w >> 1);
      qrow0 = b * SEQ + r_w * 64 + (w & 1) * 32; qoff = hN * 64; koff = 512 + hN * 64; voff = 1024 + hN * 64; ocol = hN * 64;
      const int s0 = min(max(2 * rp - 4, 0), 24), s1 = min(max(2 * rp - 3, 0), 24);
      start_w = (w >> 1) ? s1 : s0; ru0 = s0; lat_tiles = (s1 != s0) ? 9 : 8; lat_row0 = b * SEQ + ru0 * 64;
    } else if (item < n_gqa + n_na + n_cb) {
      const int it = item - n_gqa - n_na;
      b = it >> 4;
      const int g = (it >> 3) & 1, tt = it & 7;
      qrow0 = NL + b * CTXL + tt * 32; qoff = 1536 + (g * 4 + w) * 64; koff = 2048 + g * 64; voff = 2176 + g * 64;
      ocol = 512 + (g * 4 + w) * 64; lat_tiles = 0; lat_row0 = 0;
    } else {
      const int it = item - n_gqa - n_na - n_cb;
      b = it >> 4;
      const int h = (it >> 1) & 7, half = it & 1;
      qrow0 = NL + b * CTXL + half * 128 + w * 32; qoff = h * 64; koff = 512 + h * 64; voff = 1024 + h * 64; ocol = h * 64;
      lat_tiles = 0; lat_row0 = 0;
    }
    const int ctx_row0 = NL + b * CTXL, ntiles = lat_tiles + 4;
    if (na)
      for (int i = tid; i < 465; i += NTHR) bias_lds[i] = p->na_rpb[(j * 8 + hN) * 465 + i] * LOG2E;
    bf16x8 qf[4];
    {
      const bf16_t* qp = p->P + (size_t)(qrow0 + r32) * LDP + qoff + hi * 8;
#pragma unroll
      for (int d0 = 0; d0 < 4; ++d0) qf[d0] = *(const bf16x8*)(qp + d0 * 16);
    }
    f32x16 o0, o1;
#pragma unroll
    for (int q = 0; q < 16; ++q) { o0[q] = 0.f; o1[q] = 0.f; }
    float m = -INFINITY, l = 0.f;
    u32x4 kr0, kr1, vr0, vr1;
    auto gload = [&](int t) {
      const int row0 = t < lat_tiles ? lat_row0 + 64 * t : ctx_row0 + 64 * (t - lat_tiles);
      const bf16_t* base = p->P + (size_t)(row0 + sr) * LDP + c * 8;
      kr0 = *(const u32x4*)(base + koff); kr1 = *(const u32x4*)(base + (size_t)32 * LDP + koff);
      vr0 = *(const u32x4*)(base + voff); vr1 = *(const u32x4*)(base + (size_t)32 * LDP + voff);
    };
    auto swrite = [&](int buf) {
      char* Kb = lds + buf * 16384;
      char* Vb = Kb + 8192;
      *(u32x4*)(Kb + sr * 128 + kso) = kr0; *(u32x4*)(Kb + (sr + 32) * 128 + kso) = kr1;
      *(u32x4*)(Vb + vso + sr * 64) = vr0; *(u32x4*)(Vb + vso + (sr + 32) * 64) = vr1;
    };
    gload(0);
    swrite(0);
    for (int t = 0; t < ntiles; ++t) {
      __syncthreads();
      if (t + 1 < ntiles) gload(t + 1);
      const bool na_tile = na && t < lat_tiles;
      const int kr = ru0 + t;
      const bool part = !na_tile || (kr >= start_w && kr < start_w + 8);
      if (part) {
        const char* Ks = lds + (t & 1) * 16384;
        const char* Vs = Ks + 8192;
        f32x16 s0, s1;
#pragma unroll
        for (int q = 0; q < 16; ++q) { s0[q] = 0.f; s1[q] = 0.f; }
#pragma unroll
        for (int d0 = 0; d0 < 4; ++d0) {
          const int off = ((2 * d0 + hi) ^ sw) * 16;
          const bf16x8 k0 = *(const bf16x8*)(Ks + r32 * 128 + off);
          const bf16x8 k1 = *(const bf16x8*)(Ks + (32 + r32) * 128 + off);
          s0 = MFMA32(k0, qf[d0], s0);
          s1 = MFMA32(k1, qf[d0], s1);
        }
        float mx = -INFINITY;
        if (na_tile) {
          const int cq = (w & 1) * 32 + r32;
          const int c0 = min(max(cq - 8, 0), 48);
          const float* brow = bias_lds + (kr - r_w + 7) * 31 + (15 - cq);
#pragma unroll
          for (int q = 0; q < 16; ++q) {
            const int kc = (q & 3) + 8 * (q >> 2) + 4 * hi;
            const float v0 = ((unsigned)(kc - c0) < 16u) ? fmaf(s0[q], C2, brow[kc]) : -INFINITY;
            const float v1 = ((unsigned)(kc + 32 - c0) < 16u) ? fmaf(s1[q], C2, brow[kc + 32]) : -INFINITY;
            s0[q] = v0; s1[q] = v1;
            mx = fmaxf(mx, fmaxf(v0, v1));
          }
        } else {
#pragma unroll
          for (int q = 0; q < 16; ++q) {
            s0[q] *= C2; s1[q] *= C2;
            mx = fmaxf(mx, fmaxf(s0[q], s1[q]));
          }
        }
        {
          auto rr = __builtin_amdgcn_permlane32_swap(__float_as_uint(mx), __float_as_uint(mx), false, false);
          mx = fmaxf(__uint_as_float(rr[0]), __uint_as_float(rr[1]));
        }
        const float mnew = fmaxf(m, mx);
        const float alpha = __builtin_amdgcn_exp2f(m - mnew);
        float ls = 0.f;
#pragma unroll
        for (int q = 0; q < 16; ++q) {
          s0[q] = __builtin_amdgcn_exp2f(s0[q] - mnew);
          s1[q] = __builtin_amdgcn_exp2f(s1[q] - mnew);
          ls += s0[q] + s1[q];
        }
        l = l * alpha + ls;
        m = mnew;
#pragma unroll
        for (int q = 0; q < 16; ++q) { o0[q] *= alpha; o1[q] *= alpha; }
        bf16x8 pf[4];
#pragma unroll
        for (int s = 0; s < 4; ++s) {
          const int u = (s & 1) * 8;
          u32x4 tpk;
          if (s < 2) {
            tpk.x = pk_bf16(s0[u + 0], s0[u + 1]); tpk.y = pk_bf16(s0[u + 2], s0[u + 3]);
            tpk.z = pk_bf16(s0[u + 4], s0[u + 5]); tpk.w = pk_bf16(s0[u + 6], s0[u + 7]);
          } else {
            tpk.x = pk_bf16(s1[u + 0], s1[u + 1]); tpk.y = pk_bf16(s1[u + 2], s1[u + 3]);
            tpk.z = pk_bf16(s1[u + 4], s1[u + 5]); tpk.w = pk_bf16(s1[u + 6], s1[u + 7]);
          }
          pf[s] = __builtin_bit_cast(bf16x8, tpk);
        }
        const char* vb = Vs + ((lane >> 4) & 1) * 32 + (lane & 3) * 8 + ((lane & 15) >> 2) * 64 + hi * 256;
#pragma unroll
        for (int s = 0; s < 4; ++s) {
          const s16x4 a00 = vtr(vb + (16 * s) * 64), a01 = vtr(vb + (16 * s + 8) * 64);
          const s16x4 a10 = vtr(vb + 4096 + (16 * s) * 64), a11 = vtr(vb + 4096 + (16 * s + 8) * 64);
          const bf16x8 A0 = __builtin_shufflevector(a00, a01, 0, 1, 2, 3, 4, 5, 6, 7);
          const bf16x8 A1 = __builtin_shufflevector(a10, a11, 0, 1, 2, 3, 4, 5, 6, 7);
          o0 = MFMA32(A0, pf[s], o0);
          o1 = MFMA32(A1, pf[s], o1);
        }
      }
      if (t + 1 < ntiles) swrite((t + 1) & 1);
    }
    __syncthreads();
    const float lt = l + __shfl_xor(l, 32);
    const float inv = 1.f / lt;
    unsigned char* op = (unsigned char*)p->AB + (size_t)(qrow0 + r32) * DM + ocol + 4 * hi;
#pragma unroll
    for (int g = 0; g < 4; ++g) {
      *(unsigned*)(op + 8 * g) = pk_fp8x4c(o0[4 * g] * inv, o0[4 * g + 1] * inv, o0[4 * g + 2] * inv, o0[4 * g + 3] * inv);
      *(unsigned*)(op + 32 + 8 * g) = pk_fp8x4c(o1[4 * g] * inv, o1[4 * g + 1] * inv, o1[4 * g + 2] * inv, o1[4 * g + 3] * inv);
    }
  }
}

__device__ void ph_rwkv_mix(KP p, int layer) {
  const int j = layer >> 1;
  const int tid = opaque_tid();
  const int lane = tid & 63, wave = tid >> 6;
  const float* mu = p->rwkv_mu + j * 6 * 512;
  const int c0 = lane * 8;
  auto unpack = [](const u32x4 u, float (&f)[8]) {
    f[0] = bflo(u.x); f[1] = bfhi(u.x); f[2] = bflo(u.y); f[3] = bfhi(u.y);
    f[4] = bflo(u.z); f[5] = bfhi(u.z); f[6] = bflo(u.w); f[7] = bfhi(u.w);
  };
  auto pack = [](const float (&f)[8]) {
    u32x4 o;
    o.x = pk_bf16(f[0], f[1]); o.y = pk_bf16(f[2], f[3]); o.z = pk_bf16(f[4], f[5]); o.w = pk_bf16(f[6], f[7]);
    return o;
  };
  for (int t = blockIdx.x * 4 + wave; t < NT; t += gridDim.x * 4) {
    bool hasp, hasn;
    if (t < NL) { int s = t & 2047; hasp = s > 0; hasn = s < SEQ - 1; }
    else { int s = (t - NL) & 255; hasp = s > 0; hasn = s < CTXL - 1; }
    const bf16_t* pt = p->P + (size_t)t * LDP + c0;
    bf16_t* rw = p->RW + (size_t)t * RWS + c0;
    bf16_t* zb = p->Zb + (size_t)t * 1536 + c0;
    const u32x4 zero = {0u, 0u, 0u, 0u};
#pragma unroll
    for (int q = 0; q < 4; ++q) {
      float cur[8], pv[8], nx[8], d[8];
      unpack(*(const u32x4*)(pt + q * 512), cur);
      unpack(hasp ? *(const u32x4*)(pt + q * 512 - LDP) : zero, pv);
      unpack(hasn ? *(const u32x4*)(pt + q * 512 + LDP) : zero, nx);
#pragma unroll
      for (int e = 0; e < 8; ++e) d[e] = 0.5f * (pv[e] + nx[e]) - cur[e];
      if (q < 3) {
        float o[8];
        const float* m = mu + q * 512 + c0;
#pragma unroll
        for (int e = 0; e < 8; ++e) o[e] = cur[e] + d[e] * m[e];
        if (q == 0) *(u32x4*)(rw) = pack(o);
        else if (q == 2) *(u32x4*)(rw + 512) = pack(o);
        else {
          *(u32x4*)(rw + 10 * 512) = pack(o);
          float kk[8], ss = 0.f;
          const float* kv0 = p->rwkv_kvec + (j * 2 + 0) * 512 + c0;
#pragma unroll
          for (int e = 0; e < 8; ++e) { kk[e] = o[e] * kv0[e]; ss += kk[e] * kk[e]; }
          ss += dppx<0xB1>(ss); ss += dppx<0x4E>(ss); ss += dppx<0x141>(ss);
          const float rn = rsqrtf(fmaxf(ss, 1e-24f));
#pragma unroll
          for (int e = 0; e < 8; ++e) kk[e] *= rn;
          *(u32x4*)(rw + 2 * 512) = pack(kk);
        }
      } else {
#pragma unroll
        for (int z = 0; z < 3; ++z) {
          float o[8];
          const float* m = mu + (3 + z) * 512 + c0;
#pragma unroll
          for (int e = 0; e < 8; ++e) o[e] = cur[e] + d[e] * m[e];
          *(u32x4*)(zb + z * 512) = pack(o);
        }
      }
    }
  }
}

constexpr int RS_STEP = 384;
constexpr int RS_TB = 16;
struct RwkvStage { u32x2 r, kk, e, ke, a, v; };
__device__ void rwkv_unit(KP p, int unit, float* sm, int tid) {
  const int ch = unit >> 1, hf = unit & 1;
  const int dir = ch >> 6, b = (ch >> 3) & 7, h = ch & 7;
  const int lane = tid & 63, w = tid >> 6, rl = lane >> 3, ks = lane & 7;
  float* ybuf = sm + 2 * RS_TB * RS_STEP;
  const int ss = tid >> 4, kq = tid & 15;
  auto gload = [&](int n, RwkvStage& g) {
    const int row = scan_row(dir, b, n * RS_TB + ss);
    const bf16_t* base = p->RW + (size_t)row * RWS + h * 64 + kq * 4;
    g.r = *(const u32x2*)(base);
    g.kk = *(const u32x2*)(base + 2 * 512);
    g.e = *(const u32x2*)(base + (3 + dir) * 512);
    g.ke = *(const u32x2*)(base + (5 + dir) * 512);
    g.a = *(const u32x2*)(base + (7 + dir) * 512);
    g.v = *(const u32x2*)(p->RW + (size_t)row * RWS + 512 + h * 64 + hf * 32 + (kq & 7) * 4);
  };
  auto swrite = [&](int buf, const RwkvStage& g) {
    float* sp = sm + (buf * RS_TB + ss) * RS_STEP;
    const float r0 = bflo(g.r.x), r1 = bfhi(g.r.x), r2 = bflo(g.r.y), r3 = bfhi(g.r.y);
    const float k0 = bflo(g.kk.x), k1 = bfhi(g.kk.x), k2 = bflo(g.kk.y), k3 = bfhi(g.kk.y);
    const float w0 = __expf(-bflo(g.e.x)), w1 = __expf(-bfhi(g.e.x)), w2 = __expf(-bflo(g.e.y)), w3 = __expf(-bfhi(g.e.y));
    const float e0 = bflo(g.ke.x), e1 = bfhi(g.ke.x), e2 = bflo(g.ke.y), e3 = bfhi(g.ke.y);
    const float a0 = k0 * bflo(g.a.x), a1 = k1 * bfhi(g.a.x), a2 = k2 * bflo(g.a.y), a3 = k3 * bfhi(g.a.y);
    *(float4*)(sp + kq * 4) = make_float4(k0, k1, k2, k3);
    *(float4*)(sp + 64 + kq * 4) = make_float4(w0 * r0, w1 * r1, w2 * r2, w3 * r3);
    *(float4*)(sp + 128 + kq * 4) = make_float4(w0, w1, w2, w3);
    *(float4*)(sp + 192 + kq * 4) = make_float4(a0, a1, a2, a3);
    *(float4*)(sp + 256 + kq * 4) = make_float4(e0, e1, e2, e3);
    if (kq < 8) *(float4*)(sp + 320 + kq * 4) = make_float4(bflo(g.v.x), bfhi(g.v.x), bflo(g.v.y), bfhi(g.v.y));
    float c1 = a0 * r0 + a1 * r1 + a2 * r2 + a3 * r3;
    float c2 = e0 * r0 + e1 * r1 + e2 * r2 + e3 * r3;
    c1 += dppx<0xB1>(c1); c2 += dppx<0xB1>(c2);
    c1 += dppx<0x4E>(c1); c2 += dppx<0x4E>(c2);
    c1 += dppx<0x141>(c1); c2 += dppx<0x141>(c2);
    c1 += dppx<0x140>(c1); c2 += dppx<0x140>(c2);
    if (kq == 0) { sp[352] = c1; sp[353] = c2; }
  };
  typedef float f2 __attribute__((ext_vector_type(2)));
  f2 S01 = {0.f, 0.f}, S23 = {0.f, 0.f}, S45 = {0.f, 0.f}, S67 = {0.f, 0.f};
  auto compute = [&](int n) {
    const float* bp = sm + (n & 1) * RS_TB * RS_STEP;
    float* yb = ybuf + (n & 1) * RS_TB * 32 + w * 8 + rl;
    struct Ops { f2 k[4], r[4], w[4], a[4], e[4]; float vv; f2 c; };
    auto ld = [&](int s, Ops& o) {
      const float* sq = bp + s * RS_STEP;
      const f2* sp = (const f2*)(sq + ks * 8);
#pragma unroll
      for (int i = 0; i < 4; ++i) { o.k[i] = sp[i]; o.r[i] = sp[32 + i]; o.w[i] = sp[64 + i]; o.a[i] = sp[96 + i]; o.e[i] = sp[128 + i]; }
      o.vv = sq[320 + w * 8 + rl]; o.c = *(const f2*)(sq + 352);
    };
    auto step = [&](const Ops& o) -> float {
      f2 sa2 = S01 * o.k[0];
      f2 y2 = S01 * o.r[0];
      sa2 = __builtin_elementwise_fma(S23, o.k[1], sa2); y2 = __builtin_elementwise_fma(S23, o.r[1], y2);
      sa2 = __builtin_elementwise_fma(S45, o.k[2], sa2); y2 = __builtin_elementwise_fma(S45, o.r[2], y2);
      sa2 = __builtin_elementwise_fma(S67, o.k[3], sa2); y2 = __builtin_elementwise_fma(S67, o.r[3], y2);
      float sa = sa2.x + sa2.y, y0 = y2.x + y2.y;
      sa += dppx<0xB1>(sa); y0 += dppx<0xB1>(y0);
      sa += dppx<0x4E>(sa); y0 += dppx<0x4E>(y0);
      sa += dppx<0x141>(sa); y0 += dppx<0x141>(y0);
      sa = -sa;
      const f2 sav = {sa, sa}, vvv = {o.vv, o.vv};
      S01 = __builtin_elementwise_fma(vvv, o.e[0], __builtin_elementwise_fma(sav, o.a[0], S01 * o.w[0]));
      S23 = __builtin_elementwise_fma(vvv, o.e[1], __builtin_elementwise_fma(sav, o.a[1], S23 * o.w[1]));
      S45 = __builtin_elementwise_fma(vvv, o.e[2], __builtin_elementwise_fma(sav, o.a[2], S45 * o.w[2]));
      S67 = __builtin_elementwise_fma(vvv, o.e[3], __builtin_elementwise_fma(sav, o.a[3], S67 * o.w[3]));
      return fmaf(o.vv, o.c.y, fmaf(sa, o.c.x, y0));
    };
    Ops oa, ob;
    ld(0, oa);
#pragma unroll 1
    for (int s = 0; s < RS_TB; s += 2) {
      __builtin_amdgcn_sched_barrier(0);
      ld(s + 1, ob);
      __builtin_amdgcn_sched_barrier(0);
      float y0 = step(oa);
      asm volatile("" : "+v"(y0));
      __builtin_amdgcn_sched_barrier(0);
      ld(s + 2, oa);
      __builtin_amdgcn_sched_barrier(0);
      float y1 = step(ob);
      asm volatile("" : "+v"(y1));
      __builtin_amdgcn_sched_barrier(0);
      if (ks == 0) { yb[s * 32] = y0; yb[(s + 1) * 32] = y1; }
    }
  };
  auto yout = [&](int n) {
    const int row = scan_row(dir, b, n * RS_TB + ss);
    const float* ys = ybuf + (n & 1) * RS_TB * 32 + ss * 32 + kq * 2;
    *(unsigned*)(p->P + (size_t)row * LDP + dir * 512 + h * 64 + hf * 32 + kq * 2) = pk_bf16(ys[0], ys[1]);
  };
  constexpr int NB = TSC / RS_TB;
  RwkvStage gA, gB;
  gload(0, gA);
  gload(1, gB);
  swrite(0, gA);
  gload(2, gA);
  __syncthreads();
  for (int n = 0; n < NB; n += 2) {
    compute(n);
    swrite(1, gB);
    if (n + 3 < NB) gload(n + 3, gB);
    __syncthreads();
    yout(n);
    compute(n + 1);
    if (n + 2 < NB) swrite(0, gA);
    if (n + 4 < NB) gload(n + 4, gA);
    __syncthreads();
    yout(n + 1);
  }
  __syncthreads();
}

__device__ void mlstm_s1(KP p, int layer, int tile, char* lds, int tid) {
  const int j = layer >> 1;
  const int ch = tile / NCHUNK, c = tile % NCHUNK;
  const int dir = ch >> 5, b = (ch >> 2) & 7, h = ch & 3;
  float* s_ws = (float*)(lds + META_OFF);
  int* s_row = (int*)(s_ws + 64);
  char* kimg = lds;
  char* vimg = lds + 16384;
  if (tid < 64) {
    const int row = scan_row(dir, b, c * 64 + tid);
    s_row[tid] = row;
    const float* g = p->GP + (size_t)row * 16;
    const float gi = g[(dir * 2) * 4 + h] + p->mlstm_gate_b[j * 16 + (dir * 2) * 4 + h];
    const float gf = g[(dir * 2 + 1) * 4 + h] + p->mlstm_gate_b[j * 16 + (dir * 2 + 1) * 4 + h];
    float bc = -softplus_f(-gf);
#pragma unroll
    for (int o = 1; o < 64; o <<= 1) {
      float tmp = __shfl_up(bc, o);
      if (tid >= o) bc += tmp;
    }
    const float bend = __shfl(bc, 63);
    const float ds = bend - bc + gi;
    const float mloc = wmax(ds);
    s_ws[tid] = expf(ds - mloc);
    if (tid == 0) { p->msc[tile] = mloc; p->msc[NMT + tile] = bend; }
  }
  __syncthreads();
  {
    const int c8 = tid & 15;
    const int ioff = (c8 >> 2) * 4096 + (c8 & 3) * 16;
#pragma unroll
    for (int i = 0; i < 4; ++i) {
      const int sidx = (tid >> 4) + 16 * i;
      const bf16_t* src = p->P + (size_t)s_row[sidx] * LDP + h * 128 + c8 * 8;
      const u32x4 kv = *(const u32x4*)(src + 2560);
      u32x4 vv = *(const u32x4*)(src + 3072);
      const float wsv = s_ws[sidx];
      vv.x = pk_bf16(bflo(vv.x) * wsv, bfhi(vv.x) * wsv); vv.y = pk_bf16(bflo(vv.y) * wsv, bfhi(vv.y) * wsv);
      vv.z = pk_bf16(bflo(vv.z) * wsv, bfhi(vv.z) * wsv); vv.w = pk_bf16(bflo(vv.w) * wsv, bfhi(vv.w) * wsv);
      *(u32x4*)(kimg + ioff + sidx * 64) = kv;
      *(u32x4*)(vimg + ioff + sidx * 64) = vv;
    }
  }
  __syncthreads();
  const int lane = tid & 63, w = tid >> 6, wm = w >> 1, wn = w & 1, r32 = lane & 31, hi = lane >> 5;
  f32x16 acc[2][2];
#pragma unroll
  for (int mi = 0; mi < 2; ++mi)
#pragma unroll
    for (int ni = 0; ni < 2; ++ni)
#pragma unroll
      for (int q = 0; q < 16; ++q) acc[mi][ni][q] = 0.f;
  const int toff = ((lane >> 4) & 1) * 32 + (lane & 3) * 8 + ((lane & 15) >> 2) * 64 + hi * 256;
#pragma unroll
  for (int ks = 0; ks < 4; ++ks) {
    bf16x8 af[2], bfr[2];
#pragma unroll
    for (int i = 0; i < 2; ++i) {
      const char* ka = kimg + (wm * 2 + i) * 4096 + toff + (16 * ks) * 64;
      const char* va = vimg + (wn * 2 + i) * 4096 + toff + (16 * ks) * 64;
      af[i] = __builtin_shufflevector(vtr(ka), vtr(ka + 8 * 64), 0, 1, 2, 3, 4, 5, 6, 7);
      bfr[i] = __builtin_shufflevector(vtr(va), vtr(va + 8 * 64), 0, 1, 2, 3, 4, 5, 6, 7);
    }
    acc[0][0] = MFMA32(af[0], bfr[0], acc[0][0]);
    acc[0][1] = MFMA32(af[0], bfr[1], acc[0][1]);
    acc[1][0] = MFMA32(af[1], bfr[0], acc[1][0]);
    acc[1][1] = MFMA32(af[1], bfr[1], acc[1][1]);
  }
  bf16_t* ust = (bf16_t*)(lds + 32768);
#pragma unroll
  for (int mi = 0; mi < 2; ++mi)
#pragma unroll
    for (int ni = 0; ni < 2; ++ni)
#pragma unroll
      for (int q = 0; q < 16; ++q) {
        const int d = wm * 64 + mi * 32 + (q & 3) + 8 * (q >> 2) + 4 * hi;
        ust[d * 128 + wn * 64 + ni * 32 + r32] = f2bf(acc[mi][ni][q]);
        if ((q & 3) == 3) __builtin_amdgcn_sched_barrier(0);
      }
  __syncthreads();
  {
    const u32x4* us4 = (const u32x4*)ust;
    u32x4* U4 = (u32x4*)(p->MS + (size_t)tile * 16384);
#pragma unroll
    for (int i = 0; i < 8; ++i) U4[tid + 256 * i] = us4[tid + 256 * i];
  }
  if (tid < 128) {
    const char* kc = kimg + (tid >> 5) * 4096 + (tid & 31) * 2;
    float a = 0.f;
#pragma unroll 8
    for (int sidx = 0; sidx < 64; ++sidx) a = fmaf(s_ws[sidx], bf2f(*(const bf16_t*)(kc + sidx * 64)), a);
    p->MSn[tile * 128 + tid] = a;
  }
}

__device__ void mlstm_s3(KP p, int layer, int tile, char* lds, int tid);
__device__ void ph_scan_a(KP p, int layer, char* smc) {
  float* sm = (float*)smc;
  const int tid = opaque_tid();
  __builtin_amdgcn_s_setprio(3);
  for (int u = blockIdx.x; u < 256; u += gridDim.x) rwkv_unit(p, u, sm, tid);
  __builtin_amdgcn_s_setprio(0);
  {
    const int stage = layer == 1 ? 1 : 2;
    const int nconv = conv_stage_total(stage);
    const int total = NMT + (nconv + 7) / 8;
    int* qc = (int*)(p->bar + XCD_BAR_WORDS + 16 * stage);
    int* s_q = (int*)(smc + META_OFF + 3968);
    int jj = 0, j1 = 0;
#pragma unroll 1
    for (;;) {
      if (jj >= j1) {
        __syncthreads();
        if (tid == 0) *s_q = atomicAdd(qc, 1);
        __syncthreads();
        const int q = *s_q;
        if (q >= total) break;
        if (q < NMT) { mlstm_s3(p, layer, q, smc, tid); continue; }
        jj = (q - NMT) * 8; j1 = min(jj + 8, nconv);
      }
      convert_run(p, stage, jj, j1, sm, tid);
      jj = j1;
    }
  }
}

__device__ void ph_mlstm_s2(KP p, char* smc) {
  float* sw = (float*)smc;
  const int tid = opaque_tid();
  const int nitems = 64 * 33;
  for (int item = blockIdx.x; item < nitems; item += gridDim.x) {
    const int ch = item / 33, seg = item % 33;
    __syncthreads();
    if (tid < 2 * NCHUNK) sw[72 + tid] = p->msc[(tid < NCHUNK ? 0 : NMT - NCHUNK) + ch * NCHUNK + tid];
    __syncthreads();
    if (tid == 0) {
      float m = 0.f;
      for (int c = 0; c < NCHUNK; ++c) {
        const int tile = ch * NCHUNK + c;
        const float mloc = sw[72 + c], bend = sw[72 + NCHUNK + c];
        const float mn = fmaxf(bend + m, mloc);
        sw[c] = expf(bend + m - mn);
        sw[36 + c] = expf(mloc - mn);
        if (seg == 0) p->msc[2 * NMT + tile] = m;
        m = mn;
      }
    }
    __syncthreads();
    if (seg < 32) {
      unsigned* base = (unsigned*)(p->MS + (size_t)ch * NCHUNK * 16384) + seg * 256 + tid;
      unsigned v[NCHUNK];
#pragma unroll
      for (int c = 0; c < NCHUNK; ++c) v[c] = base[(size_t)c * 8192];
      float C0 = 0.f, C1 = 0.f;
#pragma unroll
      for (int c = 0; c < NCHUNK; ++c) {
        const float t0 = bflo(v[c]), t1 = bfhi(v[c]);
        v[c] = pk_bf16(C0, C1);
        C0 = sw[c] * C0 + sw[36 + c] * t0;
        C1 = sw[c] * C1 + sw[36 + c] * t1;
      }
#pragma unroll
      for (int c = 0; c < NCHUNK; ++c) base[(size_t)c * 8192] = v[c];
    } else if (tid < 128) {
      float* base = p->MSn + (size_t)ch * NCHUNK * 128 + tid;
      float v[NCHUNK];
#pragma unroll
      for (int c = 0; c < NCHUNK; ++c) v[c] = base[c * 128];
      float C = 0.f;
#pragma unroll
      for (int c = 0; c < NCHUNK; ++c) {
        const float t0 = v[c];
        v[c] = C;
        C = sw[c] * C + sw[36 + c] * t0;
      }
#pragma unroll
      for (int c = 0; c < NCHUNK; ++c) base[c * 128] = v[c];
    }
  }
}

__device__ void mlstm_s3(KP p, int layer, int tile, char* lds, int tid) {
  const int j = layer >> 1;
  const int ch = tile / NCHUNK, c = tile % NCHUNK;
  const int dir = ch >> 5, b = (ch >> 2) & 7, h = ch & 3;
  float* s_b = (float*)(lds + META_OFF);
  float* s_ig = s_b + 64;
  float* s_mt = s_b + 128;
  float* s_wi = s_b + 192;
  int* s_row = (int*)(s_b + 256);
  float* s_n = s_b + 320;
  float* s_c = s_b + 448;
  char* kimg = lds;
  char* vimg = lds + 16384;
  char* cimg = lds + 32768;
  const float mprev = p->msc[2 * NMT + tile];
  const float qscale = 0.08838834764831845f;
  const int lane = tid & 63, w = tid >> 6, wt = w >> 1, wv = w & 1, r32 = lane & 31, hi = lane >> 5;
  const int t = wt * 32 + r32;
  const int rowq = scan_row(dir, b, c * 64 + t);
  const int c8 = tid & 15;
  u32x4 kr[4], vr[4], cr[8];
#pragma unroll
  for (int i = 0; i < 4; ++i) {
    const int sidx = (tid >> 4) + 16 * i;
    const bf16_t* src = p->P + (size_t)scan_row(dir, b, c * 64 + sidx) * LDP + h * 128 + c8 * 8;
    kr[i] = *(const u32x4*)(src + 2560);
    vr[i] = *(const u32x4*)(src + 3072);
  }
  {
    const bf16_t* Cp = p->MS + (size_t)tile * 16384;
#pragma unroll
    for (int i = 0; i < 8; ++i) cr[i] = *(const u32x4*)(Cp + ((tid >> 4) + 16 * i) * 128 + c8 * 8);
  }
  bf16x8 qf[8];
  {
    const bf16_t* qp = p->P + (size_t)rowq * LDP + 2048 + h * 128 + hi * 8;
#pragma unroll
    for (int d0 = 0; d0 < 8; ++d0) qf[d0] = *(const bf16x8*)(qp + d0 * 16);
  }
  if (tid < 64) {
    const int row = scan_row(dir, b, c * 64 + tid);
    s_row[tid] = row;
    const float* g = p->GP + (size_t)row * 16;
    const float gi = g[(dir * 2) * 4 + h] + p->mlstm_gate_b[j * 16 + (dir * 2) * 4 + h];
    const float gf = g[(dir * 2 + 1) * 4 + h] + p->mlstm_gate_b[j * 16 + (dir * 2 + 1) * 4 + h];
    float bc = -softplus_f(-gf);
#pragma unroll
    for (int o = 1; o < 64; o <<= 1) {
      float tmp = __shfl_up(bc, o);
      if (tid >= o) bc += tmp;
    }
    float pm = gi - bc;
#pragma unroll
    for (int o = 1; o < 64; o <<= 1) {
      float tmp = __shfl_up(pm, o);
      if (tid >= o) pm = fmaxf(pm, tmp);
    }
    const float mt = bc + fmaxf(mprev, pm);
    s_b[tid] = bc;
    s_ig[tid] = gi;
    s_mt[tid] = mt;
    s_wi[tid] = expf(bc + mprev - mt);
    s_c[tid] = (gi - bc) * 1.4426950408889634f;
  } else if (tid < 192) s_n[tid - 64] = p->MSn[tile * 128 + (tid - 64)];
  {
    const int ioff = (c8 >> 2) * 4096 + (c8 & 3) * 16;
#pragma unroll
    for (int i = 0; i < 4; ++i) {
      const int sidx = (tid >> 4) + 16 * i;
      *(u32x4*)(kimg + sidx * 256 + ((c8 ^ (sidx & 15)) * 16)) = kr[i];
      *(u32x4*)(vimg + ioff + sidx * 64) = vr[i];
    }
    const int coff = (c8 >> 2) * 8192 + (c8 & 3) * 16;
#pragma unroll
    for (int i = 0; i < 8; ++i) *(u32x4*)(cimg + coff + ((tid >> 4) + 16 * i) * 64) = cr[i];
  }
  __syncthreads();
  const int toff = ((lane >> 4) & 1) * 32 + (lane & 3) * 8 + ((lane & 15) >> 2) * 64;
  constexpr float LOG2E_ = 1.4426950408889634f;
  float qn = 0.f;
#pragma unroll
  for (int d0 = 0; d0 < 8; ++d0) {
    const u32x4 qq = __builtin_bit_cast(u32x4, qf[d0]);
    const float* np = s_n + d0 * 16 + hi * 8;
    qn = fmaf(bflo(qq.x), np[0], qn); qn = fmaf(bfhi(qq.x), np[1], qn);
    qn = fmaf(bflo(qq.y), np[2], qn); qn = fmaf(bfhi(qq.y), np[3], qn);
    qn = fmaf(bflo(qq.z), np[4], qn); qn = fmaf(bfhi(qq.z), np[5], qn);
    qn = fmaf(bflo(qq.w), np[6], qn); qn = fmaf(bfhi(qq.w), np[7], qn);
  }
  qn += __shfl_xor(qn, 32);
  const float mtt = s_mt[t], wi = s_wi[t];
  const float ct = (s_b[t] - mtt) * LOG2E_;
  const float wq = wi * qscale;
  bf16x8 pf[4];
  float den = 0.f;
  {
    f32x16 sa0, sa1;
#pragma unroll
    for (int q = 0; q < 16; ++q) { sa0[q] = 0.f; sa1[q] = 0.f; }
#pragma unroll
    for (int d0 = 0; d0 < 8; ++d0) {
      const int chn = 2 * d0 + hi;
      const bf16x8 k0 = *(const bf16x8*)(kimg + r32 * 256 + ((chn ^ (r32 & 15)) * 16));
      sa0 = MFMA32(k0, qf[d0], sa0);
      if (wt) {
        const bf16x8 k1 = *(const bf16x8*)(kimg + (32 + r32) * 256 + ((chn ^ (r32 & 15)) * 16));
        sa1 = MFMA32(k1, qf[d0], sa1);
      }
      __builtin_amdgcn_sched_barrier(0);
    }
#pragma unroll
    for (int g = 0; g < 4; ++g) {
      const int sb0 = 8 * g + 4 * hi;
      const float4 c0v = *(const float4*)(s_c + sb0);
      const float4 c1v = *(const float4*)(s_c + sb0 + 32);
      const float cc0[4] = {c0v.x, c0v.y, c0v.z, c0v.w}, cc1[4] = {c1v.x, c1v.y, c1v.z, c1v.w};
#pragma unroll
      for (int e = 0; e < 4; ++e) {
        const int q = 4 * g + e;
        const float v0 = (sb0 + e <= t) ? sa0[q] * qscale * __builtin_amdgcn_exp2f(ct + cc0[e]) : 0.f;
        sa0[q] = v0; den += v0;
        const float v1 = (wt && sb0 + 32 + e <= t) ? sa1[q] * qscale * __builtin_amdgcn_exp2f(ct + cc1[e]) : 0.f;
        sa1[q] = v1; den += v1;
      }
      __builtin_amdgcn_sched_barrier(0);
    }
#pragma unroll
    for (int sx = 0; sx < 4; ++sx) {
      const int u = (sx & 1) * 8;
      u32x4 tpk;
      if (sx < 2) {
        tpk.x = pk_bf16(sa0[u + 0], sa0[u + 1]); tpk.y = pk_bf16(sa0[u + 2], sa0[u + 3]);
        tpk.z = pk_bf16(sa0[u + 4], sa0[u + 5]); tpk.w = pk_bf16(sa0[u + 6], sa0[u + 7]);
      } else {
        tpk.x = pk_bf16(sa1[u + 0], sa1[u + 1]); tpk.y = pk_bf16(sa1[u + 2], sa1[u + 3]);
        tpk.z = pk_bf16(sa1[u + 4], sa1[u + 5]); tpk.w = pk_bf16(sa1[u + 6], sa1[u + 7]);
      }
      pf[sx] = __builtin_bit_cast(bf16x8, tpk);
    }
  }
  den += __shfl_xor(den, 32);
  const float dtot = den + wq * qn;
  const float inv = 1.f / fmaxf(fabsf(dtot), expf(-mtt));
  bf16_t* op = p->P + (size_t)rowq * LDP + 1024 + dir * 512 + h * 128 + wv * 64 + 4 * hi;
#pragma unroll 1
  for (int vp = 0; vp < 2; ++vp) {
    f32x16 o0;
#pragma unroll
    for (int q = 0; q < 16; ++q) o0[q] = 0.f;
    const char* cb = cimg + (wv * 2 + vp) * 8192 + toff + hi * 512;
#pragma unroll
    for (int d0 = 0; d0 < 8; ++d0) {
      const bf16x8 A0 = __builtin_shufflevector(vtr(cb + (16 * d0) * 64), vtr(cb + (16 * d0 + 4) * 64), 0, 1, 2, 3, 4, 5, 6, 7);
      o0 = MFMA32(A0, qf[d0], o0);
    }
#pragma unroll
    for (int q = 0; q < 16; ++q) o0[q] *= wq;
    const char* vb = vimg + (wv * 2 + vp) * 4096 + toff + hi * 256;
#pragma unroll
    for (int sx = 0; sx < 4; ++sx) {
      if (sx < 2 || wt) {
        const bf16x8 A0 = __builtin_shufflevector(vtr(vb + (16 * sx) * 64), vtr(vb + (16 * sx + 8) * 64), 0, 1, 2, 3, 4, 5, 6, 7);
        o0 = MFMA32(A0, pf[sx], o0);
      }
    }
#pragma unroll
    for (int g = 0; g < 4; ++g) {
      u32x2 v0;
      v0.x = pk_bf16(o0[4 * g] * inv, o0[4 * g + 1] * inv); v0.y = pk_bf16(o0[4 * g + 2] * inv, o0[4 * g + 3] * inv);
      *(u32x2*)(op + vp * 32 + 8 * g) = v0;
    }
  }
}

__device__ void ph_mlstm_s1(KP p, int layer, char* smc) {
  const int tid = opaque_tid();
  __syncthreads();
  for (int tile = blockIdx.x; tile < NMT; tile += gridDim.x) { mlstm_s1(p, layer, tile, smc, tid); __syncthreads(); }
}

__device__ void ph_rec_final(KP p, int layer, bool keep) {
  const int tid = opaque_tid();
  const int j = layer >> 1;
  const int lane = tid & 63, wave = tid >> 6;
  const int rows = keep ? NT : NL;
  const int c0 = lane * 8;
  auto unpack = [](const u32x4 u, float (&f)[8]) {
    f[0] = bflo(u.x); f[1] = bfhi(u.x); f[2] = bflo(u.y); f[3] = bfhi(u.y);
    f[4] = bflo(u.z); f[5] = bfhi(u.z); f[6] = bflo(u.w); f[7] = bfhi(u.w);
  };
  for (int t = blockIdx.x * 4 + wave; t < rows; t += gridDim.x * 4) {
    const bf16_t* rw = p->RW + (size_t)t * RWS + c0;
    const bf16_t* pt = p->P + (size_t)t * LDP + c0;
    unsigned char* mo = (unsigned char*)p->AB + (size_t)t * DM + c0;
    {
      float yf[8], yb[8], r[8], v[8], k0[8], k1[8], g[8], y[8], o[8];
      unpack(*(const u32x4*)(pt), yf); unpack(*(const u32x4*)(pt + 512), yb);
      unpack(*(const u32x4*)(rw), r); unpack(*(const u32x4*)(rw + 512), v);
      unpack(*(const u32x4*)(rw + 5 * 512), k0); unpack(*(const u32x4*)(rw + 6 * 512), k1);
      unpack(*(const u32x4*)(rw + 9 * 512), g);
      float s1 = 0.f, bs = 0.f;
      const float* rk = p->rwkv_rk + j * 512 + c0;
#pragma unroll
      for (int e = 0; e < 8; ++e) { y[e] = yf[e] + yb[e]; s1 += y[e]; bs += r[e] * rk[e] * (k0[e] + k1[e]); }
      s1 += dppx<0xB1>(s1); s1 += dppx<0x4E>(s1); s1 += dppx<0x141>(s1);
      bs += dppx<0xB1>(bs); bs += dppx<0x4E>(bs); bs += dppx<0x141>(bs);
      const float mu = s1 * (1.f / 64.f);
      float s2 = 0.f;
#pragma unroll
      for (int e = 0; e < 8; ++e) { const float d = y[e] - mu; s2 += d * d; }
      s2 += dppx<0xB1>(s2); s2 += dppx<0x4E>(s2); s2 += dppx<0x141>(s2);
      const float rs = rsqrtf(s2 * (1.f / 64.f) + 64e-5f);
      const float* gn0 = p->rwkv_gn + (j * 2 + 0) * 512 + c0;
      const float* gn1 = p->rwkv_gn + (j * 2 + 1) * 512 + c0;
#pragma unroll
      for (int e = 0; e < 8; ++e) o[e] = ((y[e] - mu) * rs * gn0[e] + gn1[e] + bs * v[e]) * g[e];
      u32x2 ov;
      ov.x = pk_fp8x4c(o[0], o[1], o[2], o[3]); ov.y = pk_fp8x4c(o[4], o[5], o[6], o[7]);
      *(u32x2*)(mo) = ov;
    }
    {
      float hf[8], hb[8], og[8], hsum[8], o[8];
      unpack(*(const u32x4*)(pt + 1024), hf); unpack(*(const u32x4*)(pt + 1536), hb);
      unpack(*(const u32x4*)(pt + 3584), og);
      float ss = 0.f;
#pragma unroll
      for (int e = 0; e < 8; ++e) { hsum[e] = hf[e] + hb[e]; ss += hsum[e] * hsum[e]; }
      ss += dppx<0xB1>(ss); ss += dppx<0x4E>(ss); ss += dppx<0x141>(ss); ss += dppx<0x140>(ss);
      const float rs = rsqrtf(ss * (1.f / 128.f) + 1e-6f);
      const float* ng = p->mlstm_norm + j * 512 + c0;
#pragma unroll
      for (int e = 0; e < 8; ++e) o[e] = hsum[e] * rs * ng[e] * sigm_f(og[e]);
      u32x2 ov;
      ov.x = pk_fp8x4c(o[0], o[1], o[2], o[3]); ov.y = pk_fp8x4c(o[4], o[5], o[6], o[7]);
      *(u32x2*)(mo + 512) = ov;
    }
  }
}

using f32x4v = __attribute__((ext_vector_type(4))) float;
__device__ void ph_ln_router(KP p, int layer, bool keep, char* smc) {
  float* h2s = (float*)smc;
  float* lgs = (float*)smc;
  const int tid = opaque_tid();
  const int lane = tid & 63, wave = tid >> 6;
  const int rows = keep ? NT : NL;
  const float* lng = p->ln_g + (layer * 2 + 0) * 1024;
  const float* lnb = p->ln_b + (layer * 2 + 0) * 1024;
  for (int tile = blockIdx.x; tile < rows / 16; tile += gridDim.x) {
    const int t0 = tile * 16;
    const float* mod = p->MOD + (layer * 9 + modrow(t0)) * 6144;
    const float* brow = p->WrT + ((size_t)layer * 64 + 16 * wave + (lane & 15)) * 1024 + 4 * (lane >> 4);
    f32x4v b0[8], b1[8], b2[8];
#pragma unroll
    for (int q = 0; q < 8; ++q) { b0[q] = *(const f32x4v*)(brow + 16 * q); b1[q] = *(const f32x4v*)(brow + 16 * (8 + q)); }
    __builtin_amdgcn_sched_barrier(0);
    {
      float4 v[4][4];
      float s4[4];
#pragma unroll
      for (int q = 0; q < 4; ++q) {
        const int t = t0 + wave * 4 + q;
        s4[q] = 0.f;
#pragma unroll
        for (int i = 0; i < 4; ++i) {
          const u32x2 tb = *(const u32x2*)((const bf16_t*)p->Tb + (size_t)t * DM + i * 256 + lane * 4);
          v[q][i] = make_float4(bflo(tb.x), bfhi(tb.x), bflo(tb.y), bfhi(tb.y));
        }
      }
#pragma unroll
      for (int q = 0; q < 4; ++q)
#pragma unroll
        for (int i = 0; i < 4; ++i) s4[q] += (v[q][i].x + v[q][i].y) + (v[q][i].z + v[q][i].w);
      float mean4[4], rs4[4];
#pragma unroll
      for (int q = 0; q < 4; ++q) mean4[q] = wsum(s4[q]) * (1.f / 1024.f);
#pragma unroll
      for (int q = 0; q < 4; ++q) {
        float qq = 0.f;
#pragma unroll
        for (int i = 0; i < 4; ++i) {
          const float d0 = v[q][i].x - mean4[q], d1 = v[q][i].y - mean4[q], d2 = v[q][i].z - mean4[q], d3 = v[q][i].w - mean4[q];
          qq += (d0 * d0 + d1 * d1) + (d2 * d2 + d3 * d3);
        }
        s4[q] = qq;
      }
#pragma unroll
      for (int q = 0; q < 4; ++q) rs4[q] = rsqrtf(wsum(s4[q]) * (1.f / 1024.f) + 1e-5f);
#pragma unroll
      for (int i = 0; i < 4; ++i) {
        const int n = i * 256 + lane * 4;
        const float4 g = *(const float4*)(lng + n), bb = *(const float4*)(lnb + n);
        const float4 sc = *(const float4*)(mod + 4096 + n), sh = *(const float4*)(mod + 3072 + n);
#pragma unroll
        for (int q = 0; q < 4; ++q) {
          const int tl = wave * 4 + q, t = t0 + tl;
          const float mean = mean4[q], rs = rs4[q];
          const float4 xn = make_float4((v[q][i].x - mean) * rs * g.x + bb.x, (v[q][i].y - mean) * rs * g.y + bb.y,
                                        (v[q][i].z - mean) * rs * g.z + bb.z, (v[q][i].w - mean) * rs * g.w + bb.w);
          *(float4*)(p->X + (size_t)t * DM + n) = xn;
          const float4 hh = make_float4(xn.x * (1.f + sc.x) + sh.x, xn.y * (1.f + sc.y) + sh.y,
                                        xn.z * (1.f + sc.z) + sh.z, xn.w * (1.f + sc.w) + sh.w);
          *(unsigned*)((unsigned char*)p->AB + (size_t)t * DM + n) = pk_fp8x4c(hh.x, hh.y, hh.z, hh.w);
          *(float4*)(h2s + tl * 1028 + n) = hh;
        }
      }
    }
    __syncthreads();
    f32x4v acc = {0.f, 0.f, 0.f, 0.f};
    {
      f32x4v a1 = {0.f, 0.f, 0.f, 0.f}, a2 = {0.f, 0.f, 0.f, 0.f}, a3 = {0.f, 0.f, 0.f, 0.f};
      const int i = lane & 15, kk = lane >> 4;
      const float* arow = h2s + i * 1028 + 4 * kk;
#define ROUTER_LOAD(B, Q0) _Pragma("unroll") for (int q = 0; q < 8; ++q) B[q] = *(const f32x4v*)(brow + 16 * ((Q0) + q)); __builtin_amdgcn_sched_barrier(0);
#define ROUTER_MFMA(B, Q0) _Pragma("unroll") for (int q = 0; q < 8; ++q) { \
        const float4 a = *(const float4*)(arow + 16 * ((Q0) + q)); \
        acc = __builtin_amdgcn_mfma_f32_16x16x4f32(a.x, B[q].x, acc, 0, 0, 0); \
        a1 = __builtin_amdgcn_mfma_f32_16x16x4f32(a.y, B[q].y, a1, 0, 0, 0); \
        a2 = __builtin_amdgcn_mfma_f32_16x16x4f32(a.z, B[q].z, a2, 0, 0, 0); \
        a3 = __builtin_amdgcn_mfma_f32_16x16x4f32(a.w, B[q].w, a3, 0, 0, 0); } __builtin_amdgcn_sched_barrier(0);
      ROUTER_LOAD(b2, 16) ROUTER_MFMA(b0, 0)
      ROUTER_LOAD(b0, 24) ROUTER_MFMA(b1, 8)
      ROUTER_LOAD(b1, 32) ROUTER_MFMA(b2, 16)
      ROUTER_LOAD(b2, 40) ROUTER_MFMA(b0, 24)
      ROUTER_LOAD(b0, 48) ROUTER_MFMA(b1, 32)
      ROUTER_LOAD(b1, 56) ROUTER_MFMA(b2, 40)
      ROUTER_MFMA(b0, 48)
      ROUTER_MFMA(b1, 56)
      acc = (acc + a1) + (a2 + a3);
    }
    __syncthreads();
#pragma unroll
    for (int r = 0; r < 4; ++r) lgs[((lane >> 4) * 4 + r) * 64 + 16 * wave + (lane & 15)] = acc[r];
    __syncthreads();
    {
      float score4[4], gate4[4];
      int kidx4[4], pos4[4];
      bool chosen4[4];
#pragma unroll
      for (int q = 0; q < 4; ++q) {
        const int tl = wave * 4 + q;
        const float logit = lgs[tl * 64 + lane];
        const float score = sigm_f(logit);
        float sel = score + p->moe_bias[layer * 64 + lane];
        bool chosen = false;
        for (int r = 0; r < 6; ++r) {
          const float mx = wmax(sel);
          const unsigned long long bal = __ballot(sel == mx);
          const int first = __ffsll((long long)bal) - 1;
          if (lane == first) { chosen = true; sel = -INFINITY; }
        }
        const float gsum = wsum(chosen ? score : 0.f);
        const unsigned long long cb = __ballot(chosen);
        score4[q] = score; gate4[q] = score / gsum * 2.5f; chosen4[q] = chosen;
        kidx4[q] = __popcll(cb & ((1ull << lane) - 1ull));
      }
#pragma unroll
      for (int q = 0; q < 4; ++q) pos4[q] = chosen4[q] ? atomicAdd(&p->cnt[lane * CSTR], 1) : 0;
#pragma unroll
      for (int q = 0; q < 4; ++q) {
        const int t = t0 + wave * 4 + q;
        if (chosen4[q]) {
          p->ltok[(size_t)lane * NT + pos4[q]] = t;
          p->lgate[(size_t)lane * NT + pos4[q]] = gate4[q];
          p->tsl[t * 6 + kidx4[q]] = (lane << 16) | pos4[q];
        }
      }
    }
    __syncthreads();
  }
}

__device__ __forceinline__ void moe_prefix(KP p, int rows, int* s_pref, int tid) {
  if (tid < 64) s_pref[322 + tid] = p->cnt[tid * CSTR];
  __syncthreads();
  if (tid == 0) {
    int a = 0;
    for (int e = 0; e < 64; ++e) { s_pref[e] = a; a += (s_pref[322 + e] + 127) >> 7; }
    s_pref[64] = a; a += rows >> 7;
    s_pref[65] = a;
  }
  __syncthreads();
}

__device__ void ph_gemm(KP p, int kind, int layer, bool keep, char* lds) {
  const int tid = opaque_tid();
  const int j = layer >> 1;
  const bool att = !(layer & 1);
  const int rows = keep ? NT : NL;
  int* pref = (int*)(lds + META_OFF);
  int* s_idx = pref + 66;
  float* s_gate = (float*)(s_idx + 128);
  if (kind == 1 && blockIdx.x == 0 && tid < 65) p->cnt[tid * CSTR] = 0;
  int total;
  const int ntn_in = att ? 18 : 33;
  switch (kind) {
    case 0: total = (NT / 128) * ntn_in; break;
    case 1: total = (rows / 128) * 8; break;
    case 2: total = pref[65] * 4; break;
    case 3: total = pref[65] * 8; break;
    case 4: total = (NT / 128) * 3; break;
    default: total = (NT / 128) * 20; break;
  }
  const bool moe = kind == 2 || kind == 3;
  const int tsh = kind == 2 ? 2 : 3;
  int e_nx = 0, idx_nx = tid; float g_nx = 1.f;
  auto fetch_moe = [&](int tl) {
    const int mt = tl >> tsh;
    while (mt >= pref[e_nx + 1]) ++e_nx;
    idx_nx = tid; g_nx = 1.f;
    if (tid < 128) {
      const int pos = (mt - pref[e_nx]) * 128 + tid;
      if (kind == 2) {
        idx_nx = 0;
        if (e_nx < 64) { if (pos < pref[322 + e_nx]) idx_nx = p->ltok[(size_t)e_nx * NT + pos]; }
        else idx_nx = pos;
      } else if (e_nx < 64) g_nx = pos < pref[322 + e_nx] ? p->lgate[(size_t)e_nx * NT + pos] : 0.f;
    }
  };
  const int xcd = blockIdx.x & 7, lb = blockIdx.x >> 3, nbx = ((int)gridDim.x - xcd + 7) >> 3;
  const int t_beg = (int)(((long long)total * xcd) >> 3), t_end = (int)(((long long)total * (xcd + 1)) >> 3);
  if (moe && t_beg + lb < t_end) fetch_moe(t_beg + lb);
  for (int tile = t_beg + lb; tile < t_end; tile += nbx) {
    const bf16_t* Abase; const bf16_t* Bt;
    int astride, K, n0, m0 = 0, aux = 0, e = e_nx, mtile = 0;
    switch (kind) {
      case 0: { const int tm = tile / ntn_in, tn = tile % ntn_in; m0 = tm * 128; n0 = tn * 128;
                Abase = (const bf16_t*)((const unsigned char*)p->AB + (size_t)m0 * DM); astride = DM; K = 1024;
                Bt = (const bf16_t*)(att ? (const unsigned char*)p->Wt_att + (size_t)j * ATT_N * 1024
                                         : (const unsigned char*)p->Wt_rec + (size_t)j * REC_NP * 1024); } break;
      case 1: { const int tm = tile >> 3, tn = tile & 7; m0 = tm * 128; n0 = tn * 128;
                Abase = (const bf16_t*)((const unsigned char*)p->AB + (size_t)m0 * DM); astride = DM; K = 1024;
                Bt = (const bf16_t*)((const unsigned char*)p->Wt_out + (size_t)layer * 1024 * 1024); } break;
      case 2: { mtile = tile >> 2; aux = tile & 3; n0 = aux * 128;
                Abase = p->AB; astride = DM; K = 1024;
                Bt = (const bf16_t*)((const unsigned char*)p->Wt13 + (size_t)(layer * 65 + e) * 512 * 1024); } break;
      case 3: { mtile = tile >> 3; aux = tile & 7; n0 = aux * 128;
                Abase = (const bf16_t*)((const unsigned char*)p->ACT + (size_t)mtile * 128 * 256); astride = 256; K = 256;
                Bt = (const bf16_t*)((const unsigned char*)p->Wt2 + (size_t)(layer * 65 + e) * 1024 * 256); } break;
      case 4: { const int tm = tile / 3; aux = tile % 3; m0 = tm * 128; n0 = 0;
                Abase = p->Zb + (size_t)m0 * 1536 + aux * 512; astride = 1536; K = 512; Bt = p->Wl1 + (size_t)(j * 3 + aux) * 128 * 512; } break;
      default: { const int tm = tile / 20; aux = tile % 20; m0 = tm * 128; n0 = aux * 128;
                const int grp = aux < 8 ? 0 : (aux < 16 ? 1 : 2);
                Abase = p->L1 + (size_t)m0 * 384 + grp * 128; astride = 384; K = 128; Bt = p->Wl2 + (size_t)j * 2560 * 128; } break;
    }
    if (tid < 128) { s_idx[tid] = idx_nx; s_gate[tid] = g_nx; }
    __syncthreads();
    if (moe && tile + nbx < t_end) fetch_moe(tile + nbx);
    {
      f32x16 acc[2][2];
      if (kind <= 3) {
        const unsigned char* A8 = (const unsigned char*)Abase;
        gemm128_fp8(tid, [&](int r) { return A8 + (size_t)s_idx[r] * astride; }, (const unsigned char*)Bt, K, n0, lds, acc);
      } else
        gemm128_main(tid, [&](int r) { return Abase + (size_t)s_idx[r] * astride; }, Bt, K, n0, lds, acc);
      float* Ct = (float*)lds;
      acc_foreach(tid, acc, [&](int row, int col, float v) { Ct[row * 128 + col] = v; });
    }
    __syncthreads();
    {
      const float* Ct = (const float*)lds;
      int c4 = (tid & 31) * 4, r0 = tid >> 5;
      asm volatile("" : "+v"(c4), "+v"(r0));
      const int N_in = att ? ATT_N : REC_N;
      const int d5 = (aux >> 2) & 1, c05 = (aux & 3) * 128;
      switch (kind) {
        case 0: {
#pragma unroll 8
          for (int it = 0; it < 16; ++it) {
            const int row = it * 8 + r0;
            const float4 vraw = *(const float4*)(Ct + row * 128 + c4);
            const float4 v = make_float4(vraw.x * W8_INV, vraw.y * W8_INV, vraw.z * W8_INV, vraw.w * W8_INV);

            const int cn = n0 + c4;
            float4 vq = v;
            if (att && n0 >= 1536 && n0 < 2176) {
              float ss = v.x * v.x + v.y * v.y + v.z * v.z + v.w * v.w;
              ss += dppx<0xB1>(ss); ss += dppx<0x4E>(ss); ss += dppx<0x141>(ss); ss += dppx<0x140>(ss);
              const float rs = rsqrtf(ss * (1.f / 64.f) + 1e-6f);
              const float4 g = *(const float4*)(p->qk_gain + j * 128 + (n0 >= 2048 ? 64 : 0) + (cn & 63));
              vq = make_float4(v.x * rs * g.x, v.y * rs * g.y, v.z * rs * g.z, v.w * rs * g.w);
              const int t = m0 + row;
              if (t < NL) {
                const int sidx = t & 2047, pi0 = (cn & 63) >> 1;
                const int pos = pi0 < 16 ? (sidx >> 6) : (sidx & 63);
                const float4 cs = *(const float4*)(p->ROPE + (pos * 16 + (pi0 & 15)) * 2);
                vq = make_float4(vq.x * cs.x - vq.y * cs.y, vq.x * cs.y + vq.y * cs.x,
                                 vq.z * cs.z - vq.w * cs.w, vq.z * cs.w + vq.w * cs.z);
              }
            }
            if (cn < N_in) {
              u32x2 o; o.x = pk_bf16(vq.x, vq.y); o.y = pk_bf16(vq.z, vq.w);
              *(u32x2*)(p->P + (size_t)(m0 + row) * LDP + cn) = o;
            }
            if (!att && cn >= 4096 && cn < 4112) *(float4*)(p->GP + (size_t)(m0 + row) * 16 + (cn - 4096)) = v;
          }
        } break;
        case 1: {
#pragma unroll 16
          for (int it = 0; it < 16; ++it) {
            const int row = it * 8 + r0;
            const float4 v = *(const float4*)(Ct + row * 128 + c4);

            const size_t o = (size_t)(m0 + row) * DM + n0 + c4;
            const float4 xv = *(const float4*)(p->X + o);
            const float4 g = *(const float4*)(p->MOD + (layer * 9 + modrow(m0)) * 6144 + 2048 + n0 + c4);
            u32x2 tb;
            tb.x = pk_bf16(DN_ALPHA * xv.x + g.x * (v.x * W8_INV), DN_ALPHA * xv.y + g.y * (v.y * W8_INV));
            tb.y = pk_bf16(DN_ALPHA * xv.z + g.z * (v.z * W8_INV), DN_ALPHA * xv.w + g.w * (v.w * W8_INV));
            *(u32x2*)((bf16_t*)p->Tb + o) = tb;
          }
        } break;
        case 2: {
#pragma unroll 8
          for (int it = 0; it < 16; ++it) {
            const int row = it * 8 + r0;
            const float4 v = *(const float4*)(Ct + row * 128 + c4);

            if (((c4 >> 5) & 1) == 0) {
              const float4 u = *(const float4*)(Ct + row * 128 + c4 + 32);
              const float a0 = v.x * W8_INV, a1 = v.y * W8_INV, a2 = v.z * W8_INV, a3 = v.w * W8_INV;
              *(unsigned*)((unsigned char*)p->ACT + ((size_t)mtile * 128 + row) * 256 + aux * 64 + (c4 >> 6) * 32 + (c4 & 31)) =
                  pk_fp8x4c(silu_f(a0) * (u.x * W8_INV), silu_f(a1) * (u.y * W8_INV), silu_f(a2) * (u.z * W8_INV), silu_f(a3) * (u.w * W8_INV));
            }
          }
        } break;
        case 3: {
#pragma unroll 16
          for (int it = 0; it < 16; ++it) {
            const int row = it * 8 + r0;
            const float4 v = *(const float4*)(Ct + row * 128 + c4);

            const float g = s_gate[row] * (W8_INV * 16.f);
            *(unsigned*)((unsigned char*)p->OUT2 + ((size_t)mtile * 128 + row) * 1024 + n0 + c4) = pk_fp8x4c(g * v.x, g * v.y, g * v.z, g * v.w);
          }
        } break;
        case 4: {
#pragma unroll 4
          for (int it = 0; it < 16; ++it) {
            const int row = it * 8 + r0;
            const float4 v = *(const float4*)(Ct + row * 128 + c4);

            float4 o4 = v;
            if (aux == 0) o4 = make_float4(tanhf(v.x), tanhf(v.y), tanhf(v.z), tanhf(v.w));
            else if (aux == 2) o4 = make_float4(sigm_f(v.x), sigm_f(v.y), sigm_f(v.z), sigm_f(v.w));
            u32x2 o; o.x = pk_bf16(o4.x, o4.y); o.y = pk_bf16(o4.z, o4.w);
            *(u32x2*)(p->L1 + (size_t)(m0 + row) * 384 + aux * 128 + c4) = o;
          }
        } break;
        default: {
#pragma unroll 4
          for (int it = 0; it < 16; ++it) {
            const int row = it * 8 + r0;
            const float4 v = *(const float4*)(Ct + row * 128 + c4);

            bf16_t* rr = p->RW + (size_t)(m0 + row) * RWS + c05 + c4;
            const float vv[4] = {v.x, v.y, v.z, v.w};
            if (aux < 8) {
              const float4 b0 = *(const float4*)(p->rwkv_w0 + (j * 2 + d5) * 512 + c05 + c4);
              const float bb[4] = {b0.x, b0.y, b0.z, b0.w};
              float e4[4];
#pragma unroll
              for (int q = 0; q < 4; ++q) e4[q] = expf(-softplus_f(-(bb[q] + vv[q])) - 0.5f);
              u32x2 o; o.x = pk_bf16(e4[0], e4[1]); o.y = pk_bf16(e4[2], e4[3]);
              *(u32x2*)(rr + (3 + d5) * 512) = o;
            } else if (aux < 16) {
              const float4 b0 = *(const float4*)(p->rwkv_a0 + (j * 2 + d5) * 512 + c05 + c4);
              const float4 k1 = *(const float4*)(p->rwkv_kvec + (j * 2 + 1) * 512 + c05 + c4);
              const u32x2 kx2 = *(const u32x2*)(rr + 10 * 512);
              const float bb[4] = {b0.x, b0.y, b0.z, b0.w}, kk1[4] = {k1.x, k1.y, k1.z, k1.w};
              const float kx[4] = {bflo(kx2.x), bfhi(kx2.x), bflo(kx2.y), bfhi(kx2.y)};
              float av[4], ke[4];
#pragma unroll
              for (int q = 0; q < 4; ++q) { av[q] = sigm_f(bb[q] + vv[q]); ke[q] = kx[q] * (1.f + (av[q] - 1.f) * kk1[q]); }
              u32x2 o; o.x = pk_bf16(av[0], av[1]); o.y = pk_bf16(av[2], av[3]);
              *(u32x2*)(rr + (7 + d5) * 512) = o;
              o.x = pk_bf16(ke[0], ke[1]); o.y = pk_bf16(ke[2], ke[3]);
              *(u32x2*)(rr + (5 + d5) * 512) = o;
            } else {
              u32x2 o; o.x = pk_bf16(v.x, v.y); o.y = pk_bf16(v.z, v.w);
              *(u32x2*)(rr + 9 * 512) = o;
            }
          }
        } break;
      }
    }
    __syncthreads();
  }
}

__device__ void ph_final_ln(KP p, int layer, bool keep, char* lds) {
  const int tid = opaque_tid();
  const int lane = tid & 63, wave = tid >> 6;
  const int rows = keep ? NT : NL;
  int* s_base = (int*)(lds + META_OFF);
  if (tid == 0) {
    int a = 0;
#pragma unroll 1
    for (int e = 0; e < 64; ++e) { s_base[e] = a * 128; a += (p->cnt[e * CSTR] + 127) >> 7; }
    s_base[64] = a * 128;
  }
  __syncthreads();
  const float* lng = p->ln_g + (layer * 2 + 1) * 1024;
  const float* lnb = p->ln_b + (layer * 2 + 1) * 1024;
  for (int t = blockIdx.x * 4 + wave; t < rows; t += gridDim.x * 4) {
    const int mr = modrow(t);
    const float* g2 = p->MOD + (layer * 9 + mr) * 6144 + 5120;
    const unsigned char* src[7];
#pragma unroll
    for (int k = 0; k < 6; ++k) {
      const int v = p->tsl[t * 6 + k];
      src[k] = (const unsigned char*)p->OUT2 + (size_t)(s_base[v >> 16] + (v & 0xffff)) * 1024;
    }
    src[6] = (const unsigned char*)p->OUT2 + (size_t)(s_base[64] + t) * 1024;
    float v[16];
    float s = 0.f;
#pragma unroll
    for (int c = 0; c < 2; ++c) {
      const int n0 = c * 512 + lane * 8;
      float y[8];
#pragma unroll
      for (int q = 0; q < 8; ++q) y[q] = 0.f;
#pragma unroll
      for (int k = 0; k < 7; ++k) {
        const u32x2 u = *(const u32x2*)(src[k] + n0);
        const auto f0 = __builtin_amdgcn_cvt_pk_f32_fp8((int)u.x, false), f1 = __builtin_amdgcn_cvt_pk_f32_fp8((int)u.x, true);
        const auto f2 = __builtin_amdgcn_cvt_pk_f32_fp8((int)u.y, false), f3 = __builtin_amdgcn_cvt_pk_f32_fp8((int)u.y, true);
        y[0] += f0[0]; y[1] += f0[1]; y[2] += f1[0]; y[3] += f1[1];
        y[4] += f2[0]; y[5] += f2[1]; y[6] += f3[0]; y[7] += f3[1];
      }
      const float4 xa = *(const float4*)(p->X + (size_t)t * DM + n0), xb = *(const float4*)(p->X + (size_t)t * DM + n0 + 4);
      const float4 ga = *(const float4*)(g2 + n0), gb = *(const float4*)(g2 + n0 + 4);
      const float xx[8] = {xa.x, xa.y, xa.z, xa.w, xb.x, xb.y, xb.z, xb.w};
      const float gg[8] = {ga.x, ga.y, ga.z, ga.w, gb.x, gb.y, gb.z, gb.w};
#pragma unroll
      for (int q = 0; q < 8; ++q) { v[c * 8 + q] = DN_ALPHA * xx[q] + gg[q] * (y[q] * 0.0625f); s += v[c * 8 + q]; }
    }
    const float mean = wsum(s) * (1.f / 1024.f);
    float q2 = 0.f;
#pragma unroll
    for (int i = 0; i < 16; ++i) { const float d = v[i] - mean; q2 += d * d; }
    const float rs = rsqrtf(wsum(q2) * (1.f / 1024.f) + 1e-5f);
    const float* modn = p->MOD + ((layer + 1) * 9 + mr) * 6144;
#pragma unroll
    for (int c = 0; c < 2; ++c) {
      const int n0 = c * 512 + lane * 8;
      float xn[8];
#pragma unroll
      for (int q = 0; q < 8; ++q) xn[q] = (v[c * 8 + q] - mean) * rs * lng[n0 + q] + lnb[n0 + q];
      float* xo = (layer == 3 ? p->out : p->X) + (size_t)t * DM + n0;
      *(float4*)(xo) = make_float4(xn[0], xn[1], xn[2], xn[3]);
      *(float4*)(xo + 4) = make_float4(xn[4], xn[5], xn[6], xn[7]);
      if (layer != 3) {
        float hb[8];
#pragma unroll
        for (int q = 0; q < 8; ++q) hb[q] = xn[q] * (1.f + modn[1024 + n0 + q]) + modn[n0 + q];
        u32x2 o;
        o.x = pk_fp8x4c(hb[0], hb[1], hb[2], hb[3]); o.y = pk_fp8x4c(hb[4], hb[5], hb[6], hb[7]);
        *(u32x2*)((unsigned char*)p->AB + (size_t)t * DM + n0) = o;
      }
    }
  }
}

#define XB_TMO      128
#define XB_XCNT(j)  (256  + 64 * (j))
#define XB_XSUB(j)  (1280 + 64 * (j))
#define XB_XGEN(j)  (2304 + 64 * (j))
#define XB_TOP      3328
#define XB_TOPGEN   3392
#define XB_SPIN_CAP (1u << 20)
#define LAS __attribute__((address_space(3)))
__device__ __forceinline__ unsigned xb_ld(unsigned* p) { return __hip_atomic_load(p, __ATOMIC_RELAXED, __HIP_MEMORY_SCOPE_AGENT); }
__device__ __forceinline__ unsigned xb_add(unsigned* p, unsigned v) { return __hip_atomic_fetch_add(p, v, __ATOMIC_RELAXED, __HIP_MEMORY_SCOPE_AGENT); }
__device__ __forceinline__ unsigned xb_xcc_id() { return (unsigned)__builtin_amdgcn_s_getreg((3 << 11) | 20) & 0xFu; }
#define XB_SPIN(cond, bar) do { unsigned _sp = 0; while (cond) { __builtin_amdgcn_s_sleep(1); \
    if ((++_sp & 255u) == 0u) { if (xb_ld(&(bar)[XB_TMO])) break; if (_sp > XB_SPIN_CAP) { atomicAdd(&(bar)[XB_TMO], 1u); break; } } } } while (0)
struct XcdBarrier { unsigned* bar; unsigned x; volatile LAS unsigned* st; };
__device__ __forceinline__ XcdBarrier xcd_barrier_post(unsigned* bar, volatile LAS unsigned* st) {
  XcdBarrier b; b.bar = bar; b.x = xb_xcc_id(); b.st = st;
  if (threadIdx.x == 0) (void)xb_add(&bar[XB_XCNT(b.x)], 1u);
  return b;
}
__device__ __forceinline__ void xcd_barrier_complete(unsigned* bar, unsigned x, unsigned& nloc, unsigned& nx) {
  const unsigned G = gridDim.x;
  unsigned sum, cnt, mine, sp = 0u;
  for (;;) {
    sum = 0u; cnt = 0u; mine = 0u;
#pragma unroll
    for (unsigned j = 0; j < 16; ++j) { const unsigned c = xb_ld(&bar[XB_XCNT(j)]); sum += c; cnt += (c > 0u) ? 1u : 0u; mine = (j == x) ? c : mine; }
    if (sum == G) break;
    __builtin_amdgcn_s_sleep(1);
    if ((++sp & 255u) == 0u) { if (xb_ld(&bar[XB_TMO])) break; if (sp > XB_SPIN_CAP) { atomicAdd(&bar[XB_TMO], 1u); break; } }
  }
  nloc = mine > 0u ? mine : 1u; nx = cnt > 0u ? cnt : 1u;
}
__device__ __forceinline__ void xcd_barrier(const XcdBarrier& b) {
  asm volatile("s_waitcnt vmcnt(0)" ::: "memory");
  __syncthreads();
  if (threadIdx.x == 0) {
    unsigned* bar = b.bar;
    __builtin_amdgcn_s_waitcnt(0);
    unsigned nloc = b.st[0], nx = b.st[1];
    if (nloc == 0u) { xcd_barrier_complete(bar, b.x, nloc, nx); b.st[0] = nloc; b.st[1] = nx; }
    const unsigned old = xb_add(&bar[XB_XSUB(b.x)], 1u);
    const unsigned gen = old / nloc;
    if (old + 1u == (gen + 1u) * nloc) {
      __builtin_amdgcn_fence(__ATOMIC_RELEASE, "agent");
      asm volatile("s_waitcnt vmcnt(0)" ::: "memory");
      const unsigned og = xb_add(&bar[XB_TOP], 1u);
      const unsigned tg = og / nx;
      if (og + 1u == (tg + 1u) * nx) xb_add(&bar[XB_TOPGEN], 1u);
      else XB_SPIN(xb_ld(&bar[XB_TOPGEN]) == tg, bar);
      __builtin_amdgcn_fence(__ATOMIC_ACQUIRE, "agent");
      xb_add(&bar[XB_XGEN(b.x)], 1u);
      asm volatile("s_waitcnt vmcnt(0)" ::: "memory");
    } else {
      XB_SPIN(xb_ld(&bar[XB_XGEN(b.x)]) == gen, bar);
      __builtin_amdgcn_fence(__ATOMIC_ACQUIRE, "agent");
      asm volatile("s_waitcnt vmcnt(0)" ::: "memory");
    }
  }
  __syncthreads();
}

constexpr int NSLOTS = 13;
constexpr int NPHASE = 2 + 4 * NSLOTS;
__device__ __forceinline__ bool phase_is_nop(int ph) {
  if (ph < 2) return false;
  const int layer = (ph - 2) / NSLOTS, st = (ph - 2) % NSLOTS;
  if (st == 5 || st == 6) return true;
  return !(layer & 1) && (st == 1 || (st >= 3 && st <= 7));
}
__device__ void run_phase(KP p, int ph, char* sm) {
  if (ph == 0) { ph_init(p, sm); return; }
  if (ph == 1) { ph_mod_h(p, sm); return; }
  const int layer = (ph - 2) / NSLOTS, st = (ph - 2) % NSLOTS;
  const bool odd = layer & 1;
  const bool keep = layer < 3;
  int gk = -1;
  if (st == 0) gk = 0;
  else if (st == 8) gk = 1;
  else if (st == 10) gk = 2;
  else if (st == 11) gk = 3;
  else if (odd && st == 2) gk = 4;
  else if (odd && st == 3) gk = 5;
  asm volatile("" : "+s"(gk));
  if (gk >= 0) {
    if (gk == 2 || gk == 3) moe_prefix(p, keep ? NT : NL, (int*)(sm + META_OFF), opaque_tid());
    ph_gemm(p, gk, layer, keep, sm);
    if (gk == 5) { __syncthreads(); ph_mlstm_s2(p, sm); }
    return;
  }
  switch (st) {
    case 1: if (odd) { ph_rwkv_mix(p, layer); ph_mlstm_s1(p, layer, sm); } break;
    case 2: ph_attention(p, layer, keep, sm); break;
    case 4: if (odd) ph_scan_a(p, layer, sm); break;
    case 7: if (odd) ph_rec_final(p, layer, keep); break;
    case 9: ph_ln_router(p, layer, keep, sm); break;
    case 12: ph_final_ln(p, layer, keep, sm); break;
  }
}

__global__ void __launch_bounds__(NTHR, 2) mega_kernel(Params kargs) {
  extern __shared__ __attribute__((aligned(16))) char sm[];
  cg::grid_group grid = cg::this_grid();
  volatile LAS unsigned* st = (volatile LAS unsigned*)(sm + META_OFF + 4032);
  if (threadIdx.x == 0) { st[0] = 0u; st[1] = 0u; }
  __syncthreads();
  const XcdBarrier xb = xcd_barrier_post(kargs.bar, st);
  for (int ph = kargs.ph_lo; ph < kargs.ph_hi; ++ph) {
    if (phase_is_nop(ph)) continue;
    {
      KP kp = (KP)__builtin_amdgcn_kernarg_segment_ptr();
      asm volatile("" : "+s"(kp));
      run_phase(kp, ph, sm);
    }
    if (ph + 1 < kargs.ph_hi) {
      if (ph == 0) grid.sync();
      else xcd_barrier(xb);
    }
  }
}

extern "C" void kernel_launch(void* const* d_in, const int* in_sizes, int n_in, void* d_out, int out_size, void* d_ws,
                              size_t ws_size, hipStream_t stream) {
  static int grid_blocks = 0;
  if (!grid_blocks) {
    int dev = 0, cus = 0, per_cu = 0;
    (void)hipGetDevice(&dev);
    (void)hipDeviceGetAttribute(&cus, hipDeviceAttributeMultiprocessorCount, dev);
    (void)hipFuncSetAttribute((const void*)mega_kernel, hipFuncAttributeMaxDynamicSharedMemorySize, SMEM_BYTES);
    (void)hipOccupancyMaxActiveBlocksPerMultiprocessor(&per_cu, mega_kernel, NTHR, SMEM_BYTES);
    if (per_cu < 1) per_cu = 1;
    if (per_cu > 2) per_cu = 2;
    grid_blocks = cus * per_cu;
  }
  Params p;
  memset(&p, 0, sizeof(p));
  const float** pin = (const float**)&p;
  for (int i = 0; i < 35; ++i) pin[i] = (const float*)d_in[i];
  p.out = (float*)d_out;
  char* w = (char*)d_ws;
  size_t off = 0;
  auto take = [&](size_t bytes) { char* r = w + off; off += (bytes + 255) & ~(size_t)255; return r; };
  p.Wt_att = (bf16_t*)take((size_t)2 * ATT_N * 1024 * 2);
  p.Wt_rec = (bf16_t*)take((size_t)2 * REC_NP * 1024 * 2);
  p.Wt_out = (bf16_t*)take((size_t)4 * 1024 * 1024 * 2);
  p.Wt13 = (bf16_t*)take((size_t)4 * 65 * 512 * 1024);
  p.Wt2 = (bf16_t*)take((size_t)4 * 65 * 1024 * 256);
  p.Wl1 = (bf16_t*)take((size_t)2 * 3 * 128 * 512 * 2);
  p.Wl2 = (bf16_t*)take((size_t)2 * 2560 * 128 * 2);
  p.X = (float*)take((size_t)NT * DM * 4);
  p.AB = (bf16_t*)take((size_t)NT * DM * 2);
  p.MOD = (float*)take((size_t)5 * 9 * 6144 * 4);
  p.MODP = (float*)take((size_t)8 * 4 * 9 * 6144 * 4);
  p.GP = (float*)take((size_t)NT * 16 * 4);
  p.ROPE = (float*)take((size_t)64 * 16 * 2 * 4);
  p.WrT = (float*)take((size_t)4 * 64 * 1024 * 4);
  p.msc = (float*)take((size_t)3 * NMT * 4);
  p.lgate = (float*)take((size_t)64 * NT * 4);
  p.ltok = (int*)take((size_t)64 * NT * 4);
  p.tsl = (int*)take((size_t)NT * 6 * 4);
  p.cnt = (int*)take((size_t)65 * CSTR * 4);
  p.bar = (unsigned*)take((size_t)BAR_TOTAL_WORDS * 4);
  char* region = take(0);
  const size_t szP = (size_t)NT * LDP * 2, szRW = (size_t)NT * RWS * 2, szMS = (size_t)NMT * 16384 * 2,
               szMSn = (size_t)NMT * 128 * 4;
  const size_t szT = (size_t)NT * DM * 4, szOUT2 = (size_t)NSLOT * 1024 * 2;
  p.P = (bf16_t*)region;
  p.RW = (bf16_t*)(region + szP);
  p.MS = (bf16_t*)(region + szP + szRW);
  p.MSn = (float*)(region + szP + szRW + szMS);
  p.Tb = (float*)region;
  p.ACT = (bf16_t*)region;
  p.OUT2 = (bf16_t*)(region + szT);
  const size_t szZ = (size_t)NT * 2048 * 2;
  p.Zb = (bf16_t*)(region + szP + szRW + szMS + szMSn);
  p.L1 = p.Zb + (size_t)NT * 1536;
  size_t mixer = szP + szRW + szMS + szMSn + szZ, moe = szT + szOUT2;
  off += (mixer > moe ? mixer : moe);
  if (off > ws_size) { fprintf(stderr, "workspace too small: need %zu have %zu\n", off, ws_size); return; }
  p.ph_lo = 0;
  p.ph_hi = NPHASE;
  (void)hipMemsetAsync(p.bar, 0, (size_t)BAR_TOTAL_WORDS * 4, stream);
  void* args[] = {&p};
  hipError_t e = hipLaunchCooperativeKernel((void*)mega_kernel, dim3(grid_blocks), dim3(NTHR), args, SMEM_BYTES, stream);
  if (e != hipSuccess) fprintf(stderr, "cooperative launch failed: %s (grid %d)\n", hipGetErrorString(e), grid_blocks);
}
```

```cpp
#include <hip/hip_runtime.h>
#include <hip/hip_cooperative_groups.h>
#include <cstdio>
#include <cstring>
namespace cg = cooperative_groups;

constexpr int DM = 1024;
constexpr int NBATCH = 8;
constexpr int SEQ = 2048;
constexpr int CTXL = 256;
constexpr int NL = NBATCH * SEQ;
constexpr int NC = NBATCH * CTXL;
constexpr int NT = NL + NC;
constexpr int TSC = CTXL + SEQ;
constexpr int LDP = 4112;
constexpr int ATT_N = 2304;
constexpr int REC_N = 4112;
constexpr int REC_NP = 4224;
constexpr int NCHUNK = 36;
constexpr int NMT = 64 * NCHUNK;
constexpr int RWS = 5632;
constexpr int NSLOT = 137216;
constexpr float DN_ALPHA = 1.6817928305074290f;
constexpr int NTHR = 256;
constexpr int SMEM_BYTES = 65536 + 4096;
constexpr int META_OFF = 65536;
#define XCD_BAR_WORDS 3456
constexpr int CSTR = 32;
constexpr int BAR_TOTAL_WORDS = XCD_BAR_WORDS + 64;

typedef unsigned short bf16_t;
using bf16x8 = __attribute__((ext_vector_type(8))) short;
using f32x16 = __attribute__((ext_vector_type(16))) float;
using u32x4 = __attribute__((ext_vector_type(4))) unsigned;
using u32x2 = __attribute__((ext_vector_type(2))) unsigned;

struct Params {
  const float *x, *c, *ctx, *c_ctx, *ada_w, *ada_b, *ln_g, *ln_b, *mix_w_out, *att_w_in, *na_rpb, *qk_gain,
      *rec_w_in, *rwkv_mu, *rwkv_w0, *rwkv_w1, *rwkv_w2, *rwkv_a0, *rwkv_a1, *rwkv_a2, *rwkv_g1, *rwkv_g2,
      *rwkv_kvec, *rwkv_rk, *rwkv_gn, *mlstm_gate_b, *mlstm_norm, *moe_router, *moe_bias, *moe_w1, *moe_w3,
      *moe_w2, *shared_w1, *shared_w3, *shared_w2;
  float* out;
  bf16_t *Wt_att, *Wt_rec, *Wt_out, *Wt13, *Wt2, *Wl1, *Wl2;
  bf16_t *Zb, *L1;
  float *X, *MOD, *MODP, *GP, *msc, *lgate, *MSn, *Tb, *ROPE, *WrT;
  bf16_t *AB, *P, *RW, *MS, *ACT, *OUT2;
  int *cnt, *ltok, *tsl;
  unsigned* bar;
  int ph_lo, ph_hi;
};

typedef const Params __attribute__((address_space(4))) * KP;

__device__ __forceinline__ int modrow(int t) { return t < NL ? (t >> 11) : 8; }
__device__ __forceinline__ float silu_f(float x) { return x / (1.f + expf(-x)); }
__device__ __forceinline__ float sigm_f(float x) { return 1.f / (1.f + expf(-x)); }
__device__ __forceinline__ float softplus_f(float x) { return fmaxf(x, 0.f) + log1pf(expf(-fabsf(x))); }
template <int CTRL>
__device__ __forceinline__ float dppx(float x) {
  return __int_as_float(__builtin_amdgcn_update_dpp(0, __float_as_int(x), CTRL, 0xf, 0xf, true));
}
__device__ __forceinline__ float rdlane(float v, int l) {
  return __int_as_float(__builtin_amdgcn_readlane(__float_as_int(v), l));
}
__device__ __forceinline__ float wsum(float v) {
  v += dppx<0xB1>(v); v += dppx<0x4E>(v); v += dppx<0x141>(v); v += dppx<0x140>(v);
  return (rdlane(v, 0) + rdlane(v, 16)) + (rdlane(v, 32) + rdlane(v, 48));
}
__device__ __forceinline__ float wmax(float v) {
  v = fmaxf(v, dppx<0xB1>(v)); v = fmaxf(v, dppx<0x4E>(v)); v = fmaxf(v, dppx<0x141>(v)); v = fmaxf(v, dppx<0x140>(v));
  return fmaxf(fmaxf(rdlane(v, 0), rdlane(v, 16)), fmaxf(rdlane(v, 32), rdlane(v, 48)));
}
__device__ __forceinline__ int opaque_tid() {
  int t = threadIdx.x;
  asm volatile("" : "+v"(t));
  return t;
}
typedef __bf16 bf16x2_t __attribute__((ext_vector_type(2)));
typedef float f32x2_t __attribute__((ext_vector_type(2)));
__device__ __forceinline__ unsigned pk_bf16(float lo, float hi) {
  const f32x2_t v = {lo, hi};
  return __builtin_bit_cast(unsigned, __builtin_convertvector(v, bf16x2_t));
}
__device__ __forceinline__ bf16_t f2bf(float x) { return (bf16_t)(pk_bf16(x, 0.f) & 0xffffu); }
__device__ __forceinline__ float bf2f(bf16_t v) { return __uint_as_float((unsigned)v << 16); }
__device__ __forceinline__ float bflo(unsigned u) { return __uint_as_float(u << 16); }
__device__ __forceinline__ float bfhi(unsigned u) { return __uint_as_float(u & 0xffff0000u); }
__device__ __forceinline__ int scan_row(int dir, int b, int tau) {
  if (tau < CTXL) return NL + b * CTXL + (dir ? (CTXL - 1 - tau) : tau);
  int s = tau - CTXL;
  return b * SEQ + (dir ? (SEQ - 1 - s) : s);
}

template <class RowPtrA>
__device__ __forceinline__ void gemm128_main(int tid, RowPtrA rowA, const bf16_t* __restrict__ Bt, int K, int n0,
                                             char* lds, f32x16 (&acc)[2][2]) {
  const int lane = tid & 63, w = tid >> 6;
  const int wm = w >> 1, wn = w & 1, r = lane & 31, h = lane >> 5;
  const int c = tid & 7, sr = tid >> 3;
  const int lc = (c ^ ((tid >> 4) & 7)) * 8;
  const bf16_t* ap[4];
#pragma unroll
  for (int i = 0; i < 4; ++i) ap[i] = rowA(sr + 32 * i) + lc;
  const bf16_t* bp0 = Bt + (size_t)(n0 + sr) * K + lc;
  const int bstr = 32 * K;
#pragma unroll
  for (int mi = 0; mi < 2; ++mi)
#pragma unroll
    for (int ni = 0; ni < 2; ++ni)
#pragma unroll
      for (int q = 0; q < 16; ++q) acc[mi][ni][q] = 0.f;
  const int nk = K >> 6;
  auto issue = [&](int kt) {
    char* As = lds + (kt & 1) * 32768 + tid * 16;
    const int k0 = kt * 64;
#pragma unroll
    for (int i = 0; i < 4; ++i) {
      __builtin_amdgcn_global_load_lds((const unsigned*)(ap[i] + k0), (__attribute__((address_space(3))) unsigned*)(As + i * 4096), 16, 0, 0);
      __builtin_amdgcn_global_load_lds((const unsigned*)(bp0 + i * bstr + k0), (__attribute__((address_space(3))) unsigned*)(As + 16384 + i * 4096), 16, 0, 0);
    }
  };
  issue(0);
  const int sw = (r >> 1) & 7;
#pragma unroll 1
  for (int kt = 0; kt < nk; ++kt) {
    asm volatile("s_waitcnt vmcnt(0)" ::: "memory");
    __syncthreads();
    if (kt + 1 < nk) issue(kt + 1);
    const char* As = lds + (kt & 1) * 32768;
    const char* Ar = As + (wm * 64 + r) * 128;
    const char* Br = As + 16384 + (wn * 64 + r) * 128;
#pragma unroll
    for (int ks = 0; ks < 4; ++ks) {
      const int off = ((ks * 2 + h) ^ sw) * 16;
      const bf16x8 a0 = *(const bf16x8*)(Ar + off);
      const bf16x8 a1 = *(const bf16x8*)(Ar + 32 * 128 + off);
      const bf16x8 b0 = *(const bf16x8*)(Br + off);
      const bf16x8 b1 = *(const bf16x8*)(Br + 32 * 128 + off);
      acc[0][0] = __builtin_amdgcn_mfma_f32_32x32x16_bf16(a0, b0, acc[0][0], 0, 0, 0);
      acc[0][1] = __builtin_amdgcn_mfma_f32_32x32x16_bf16(a0, b1, acc[0][1], 0, 0, 0);
      acc[1][0] = __builtin_amdgcn_mfma_f32_32x32x16_bf16(a1, b0, acc[1][0], 0, 0, 0);
      acc[1][1] = __builtin_amdgcn_mfma_f32_32x32x16_bf16(a1, b1, acc[1][1], 0, 0, 0);
    }
  }
  __syncthreads();
}
using i64 = long;
typedef int i32x8 __attribute__((ext_vector_type(8)));
template <class RowPtrA8>
__device__ __forceinline__ void gemm128_fp8(int tid, RowPtrA8 rowA, const unsigned char* __restrict__ Bt, int K, int n0,
                                            char* lds, f32x16 (&acc)[2][2]) {
  const int lane = tid & 63, w = tid >> 6;
  const int wm = w >> 1, wn = w & 1, r = lane & 31, h = lane >> 5;
  const int c = tid & 7, sr = tid >> 3;
  const int lc = (c ^ ((tid >> 4) & 7)) * 16;
  const unsigned char* ap[4];
#pragma unroll
  for (int i = 0; i < 4; ++i) ap[i] = rowA(sr + 32 * i) + lc;
  const unsigned char* bp0 = Bt + (size_t)(n0 + sr) * K + lc;
  const int bstr = 32 * K;
#pragma unroll
  for (int mi = 0; mi < 2; ++mi)
#pragma unroll
    for (int ni = 0; ni < 2; ++ni)
#pragma unroll
      for (int q = 0; q < 16; ++q) acc[mi][ni][q] = 0.f;
  const int nk = K >> 7;
  auto issue = [&](int kt) {
    char* As = lds + (kt & 1) * 32768 + tid * 16;
    const int k0 = kt * 128;
#pragma unroll
    for (int i = 0; i < 4; ++i) {
      __builtin_amdgcn_global_load_lds((const unsigned*)(ap[i] + k0), (__attribute__((address_space(3))) unsigned*)(As + i * 4096), 16, 0, 0);
      __builtin_amdgcn_global_load_lds((const unsigned*)(bp0 + i * bstr + k0), (__attribute__((address_space(3))) unsigned*)(As + 16384 + i * 4096), 16, 0, 0);
    }
  };
  issue(0);
  if (nk > 1) issue(1);
  const int sw = (r >> 1) & 7;
#pragma unroll 1
  for (int kt = 0; kt < nk; ++kt) {
    if (kt == 0 && nk > 1) asm volatile("s_waitcnt vmcnt(8)" ::: "memory");
    else asm volatile("s_waitcnt vmcnt(0)" ::: "memory");
    __syncthreads();
    if (kt > 0 && kt + 1 < nk) issue(kt + 1);
    const char* As = lds + (kt & 1) * 32768;
    const char* Ar = As + (wm * 64 + r) * 128;
    const char* Br = As + 16384 + (wn * 64 + r) * 128;
#pragma unroll
    for (int pq = 0; pq < 2; ++pq) {
      const int o0 = ((4 * pq + 2 * h) ^ sw) * 16, o1 = ((4 * pq + 2 * h + 1) ^ sw) * 16;
      const u32x4 a0l = *(const u32x4*)(Ar + o0), a0h = *(const u32x4*)(Ar + o1);
      const u32x4 a1l = *(const u32x4*)(Ar + 32 * 128 + o0), a1h = *(const u32x4*)(Ar + 32 * 128 + o1);
      const u32x4 b0l = *(const u32x4*)(Br + o0), b0h = *(const u32x4*)(Br + o1);
      const u32x4 b1l = *(const u32x4*)(Br + 32 * 128 + o0), b1h = *(const u32x4*)(Br + 32 * 128 + o1);
      const i32x8 A0 = {(int)a0l.x, (int)a0l.y, (int)a0l.z, (int)a0l.w, (int)a0h.x, (int)a0h.y, (int)a0h.z, (int)a0h.w};
      const i32x8 A1 = {(int)a1l.x, (int)a1l.y, (int)a1l.z, (int)a1l.w, (int)a1h.x, (int)a1h.y, (int)a1h.z, (int)a1h.w};
      const i32x8 B0 = {(int)b0l.x, (int)b0l.y, (int)b0l.z, (int)b0l.w, (int)b0h.x, (int)b0h.y, (int)b0h.z, (int)b0h.w};
      const i32x8 B1 = {(int)b1l.x, (int)b1l.y, (int)b1l.z, (int)b1l.w, (int)b1h.x, (int)b1h.y, (int)b1h.z, (int)b1h.w};
      acc[0][0] = __builtin_amdgcn_mfma_scale_f32_32x32x64_f8f6f4(A0, B0, acc[0][0], 0, 0, 0, 0, 0, 0);
      acc[0][1] = __builtin_amdgcn_mfma_scale_f32_32x32x64_f8f6f4(A0, B1, acc[0][1], 0, 0, 0, 0, 0, 0);
      acc[1][0] = __builtin_amdgcn_mfma_scale_f32_32x32x64_f8f6f4(A1, B0, acc[1][0], 0, 0, 0, 0, 0, 0);
      acc[1][1] = __builtin_amdgcn_mfma_scale_f32_32x32x64_f8f6f4(A1, B1, acc[1][1], 0, 0, 0, 0, 0, 0);
    }
  }
  __syncthreads();
}
template <class F>
__device__ __forceinline__ void acc_foreach(int tid, const f32x16 (&acc)[2][2], F f) {
  const int lane = tid & 63, w = tid >> 6;
  const int wm = w >> 1, wn = w & 1, r = lane & 31, h = lane >> 5;
#pragma unroll
  for (int mi = 0; mi < 2; ++mi)
#pragma unroll
    for (int ni = 0; ni < 2; ++ni)
#pragma unroll
      for (int q = 0; q < 16; ++q) {
        const int row = wm * 64 + mi * 32 + (q & 3) + 8 * (q >> 2) + 4 * h;
        const int col = wn * 64 + ni * 32 + r;
        f(row, col, acc[mi][ni][q]);
        if ((q & 3) == 3) __builtin_amdgcn_sched_barrier(0);
      }
}

template <class RM>
__device__ __forceinline__ void tr_tile(int tid, const float* __restrict__ src, int N, int k0, int n0,
                                        bf16_t* __restrict__ dst, int K, RM rowmap, float* tile) {
  {
    const int tx = tid & 15, ty = tid >> 4;
    const int n = n0 + tx * 4;
#pragma unroll
    for (int i = 0; i < 4; ++i) {
      const int k = ty + 16 * i;
      float4 v = make_float4(0.f, 0.f, 0.f, 0.f);
      if (n < N) v = *(const float4*)(src + (size_t)(k0 + k) * N + n);
      tile[k * 65 + tx * 4 + 0] = v.x; tile[k * 65 + tx * 4 + 1] = v.y;
      tile[k * 65 + tx * 4 + 2] = v.z; tile[k * 65 + tx * 4 + 3] = v.w;
    }
  }
  __syncthreads();
  {
    const int kc = tid & 7;
#pragma unroll
    for (int i = 0; i < 2; ++i) {
      const int n = (tid >> 3) + 32 * i;
      if (n0 + n < N) {
        float v[8];
#pragma unroll
        for (int q = 0; q < 8; ++q) v[q] = tile[(kc * 8 + q) * 65 + n];
        u32x4 o;
        o.x = pk_bf16(v[0], v[1]); o.y = pk_bf16(v[2], v[3]); o.z = pk_bf16(v[4], v[5]); o.w = pk_bf16(v[6], v[7]);
        *(u32x4*)(dst + (size_t)rowmap(n0 + n) * K + k0 + kc * 8) = o;
      }
    }
  }
  __syncthreads();
}

constexpr float W8_SCALE = 32.f, W8_INV = 1.f / 32.f;
__device__ __forceinline__ unsigned pk_fp8x4(float a, float b, float c, float d) {
  int r = __builtin_amdgcn_cvt_pk_fp8_f32(a, b, 0, false);
  r = __builtin_amdgcn_cvt_pk_fp8_f32(c, d, r, true);
  return (unsigned)r;
}
__device__ __forceinline__ unsigned pk_fp8x4c(float a, float b, float c, float d) {
  constexpr float M = 448.f;
  return pk_fp8x4(fminf(fmaxf(a, -M), M), fminf(fmaxf(b, -M), M), fminf(fmaxf(c, -M), M), fminf(fmaxf(d, -M), M));
}
template <class RM>
__device__ __forceinline__ void tr_tile_fp8(int tid, const float* __restrict__ src, int N, int k0, int n0,
                                            unsigned char* __restrict__ dst, int K, RM rowmap, float* tile) {
  {
    const int tx = tid & 15, ty = tid >> 4;
    const int n = n0 + tx * 4;
#pragma unroll
    for (int i = 0; i < 4; ++i) {
      const int k = ty + 16 * i;
      float4 v = make_float4(0.f, 0.f, 0.f, 0.f);
      if (n < N) v = *(const float4*)(src + (size_t)(k0 + k) * N + n);
      tile[k * 65 + tx * 4 + 0] = v.x; tile[k * 65 + tx * 4 + 1] = v.y;
      tile[k * 65 + tx * 4 + 2] = v.z; tile[k * 65 + tx * 4 + 3] = v.w;
    }
  }
  __syncthreads();
  {
    const int kc = tid & 3, n = tid >> 2;
    float v[16];
#pragma unroll
    for (int q = 0; q < 16; ++q) v[q] = tile[(kc * 16 + q) * 65 + n] * W8_SCALE;
    u32x4 o;
    o.x = pk_fp8x4c(v[0], v[1], v[2], v[3]); o.y = pk_fp8x4c(v[4], v[5], v[6], v[7]);
    o.z = pk_fp8x4c(v[8], v[9], v[10], v[11]); o.w = pk_fp8x4c(v[12], v[13], v[14], v[15]);
    *(u32x4*)(dst + (size_t)rowmap(n0 + n) * K + k0 + kc * 16) = o;
  }
  __syncthreads();
}

constexpr int CJ0 = 1152, CJ1 = CJ0 + 2080, CJ2 = CJ1 + 1024, CJ3 = CJ2 + 33280, CJ4 = CJ3 + 16640;
__device__ void convert_job(KP p, int job, float* sm, int tid) {
  if (job < CJ0) {
    const int j = job / 576, rem = job % 576, kt = rem / 36, nt = rem % 36;
    tr_tile_fp8(tid, p->att_w_in + (size_t)j * 1024 * ATT_N, ATT_N, kt * 64, nt * 64, (unsigned char*)p->Wt_att + (size_t)j * ATT_N * 1024,
                1024, [](int n) { return n; }, sm);
  } else if (job < CJ1) {
    const int q = job - CJ0;
    const int j = q / 1040, rem = q % 1040, kt = rem / 65, nt = rem % 65;
    tr_tile_fp8(tid, p->rec_w_in + (size_t)j * 1024 * REC_N, REC_N, kt * 64, nt * 64, (unsigned char*)p->Wt_rec + (size_t)j * REC_NP * 1024,
                1024, [](int n) { return n; }, sm);
  } else if (job < CJ2) {
    const int q = job - CJ1;
    const int i = q >> 8, rem = q & 255, kt = rem >> 4, nt = rem & 15;
    tr_tile_fp8(tid, p->mix_w_out + (size_t)i * 1024 * 1024, 1024, kt * 64, nt * 64, (unsigned char*)p->Wt_out + (size_t)i * 1024 * 1024,
                1024, [](int n) { return n; }, sm);
  } else if (job < CJ3) {
    const int q = job - CJ2;
    const int le = q >> 7, rem = q & 127;
    const int which = rem >> 6, kt = (rem >> 2) & 15, nt = rem & 3;
    const int layer = le / 65, e = le % 65;
    const float* src;
    if (e < 64) src = (which ? p->moe_w3 : p->moe_w1) + (size_t)(layer * 64 + e) * 1024 * 256;
    else src = (which ? p->shared_w3 : p->shared_w1) + (size_t)layer * 1024 * 256;
    tr_tile_fp8(tid, src, 256, kt * 64, nt * 64, (unsigned char*)p->Wt13 + (size_t)le * 512 * 1024, 1024,
                [which](int n) { return 64 * (n >> 5) + which * 32 + (n & 31); }, sm);
  } else {
    const int q = job - CJ3;
    const int le = q >> 6, rem = q & 63;
    const int kt = rem >> 4, nt = rem & 15;
    const int layer = le / 65, e = le % 65;
    const float* src = e < 64 ? p->moe_w2 + (size_t)(layer * 64 + e) * 256 * 1024 : p->shared_w2 + (size_t)layer * 256 * 1024;
    tr_tile_fp8(tid, src, 1024, kt * 64, nt * 64, (unsigned char*)p->Wt2 + (size_t)le * 1024 * 256, 256, [](int n) { return n; }, sm);
  }
}
__device__ __forceinline__ int conv_stage_total(int stage) {
  return stage == 0 ? (576 + 1040 + 512 + 8320 + 4160) : (stage == 1 ? (576 + 1040 + 256 + 16640 + 8320) : (256 + 8320 + 4160));
}
__device__ __forceinline__ int conv_stage_job(int stage, int q) {
  if (stage == 0) {
    if (q < 8320) return CJ2 + q;  q -= 8320;
    if (q < 4160) return CJ3 + q;  q -= 4160;
    if (q < 576) return q;  q -= 576;
    if (q < 1040) return CJ0 + q;  q -= 1040;
    return CJ1 + q;
  } else if (stage == 1) {
    if (q < 8320) return CJ2 + 8320 + q;  q -= 8320;
    if (q < 4160) return CJ3 + 4160 + q;  q -= 4160;
    if (q < 576) return 576 + q;  q -= 576;
    if (q < 256) return CJ1 + 512 + q;  q -= 256;
    if (q < 8320) return CJ2 + 16640 + q;  q -= 8320;
    if (q < 4160) return CJ3 + 8320 + q;  q -= 4160;
    return CJ0 + 1040 + q;
  }
  if (q < 256) return CJ1 + 768 + q;  q -= 256;
  if (q < 8320) return CJ2 + 24960 + q;  q -= 8320;
  return CJ3 + 12480 + q;
}

struct CvDesc { const float* src; unsigned char* dst; int N, K, k0, n0, which; };
__device__ __forceinline__ bool conv_desc_fp8(KP p, int job, CvDesc& d) {
  if (job < CJ2) return false;
  if (job < CJ3) {
    const int q = job - CJ2;
    const int le = q >> 7, rem = q & 127;
    const int which = rem >> 6, kt = (rem >> 2) & 15, nt = rem & 3;
    const int layer = le / 65, e = le % 65;
    if (e < 64) d.src = (which ? p->moe_w3 : p->moe_w1) + (size_t)(layer * 64 + e) * 1024 * 256;
    else d.src = (which ? p->shared_w3 : p->shared_w1) + (size_t)layer * 1024 * 256;
    d.dst = (unsigned char*)p->Wt13 + (size_t)le * 512 * 1024;
    d.N = 256; d.K = 1024; d.k0 = kt * 64; d.n0 = nt * 64; d.which = which;
  } else {
    const int q = job - CJ3;
    const int le = q >> 6, rem = q & 63;
    const int kt = rem >> 4, nt = rem & 15;
    const int layer = le / 65, e = le % 65;
    d.src = e < 64 ? p->moe_w2 + (size_t)(layer * 64 + e) * 256 * 1024 : p->shared_w2 + (size_t)layer * 256 * 1024;
    d.dst = (unsigned char*)p->Wt2 + (size_t)le * 1024 * 256;
    d.N = 1024; d.K = 256; d.k0 = kt * 64; d.n0 = nt * 64; d.which = -1;
  }
  return true;
}
typedef float cvf4 __attribute__((ext_vector_type(4)));
__device__ __forceinline__ void cv_load(const CvDesc& d, int tid, cvf4& v0, cvf4& v1, cvf4& v2, cvf4& v3) {
  const int tx = tid & 15, ty = tid >> 4;
  const float* s0 = d.src + (size_t)(d.k0 + ty) * d.N + d.n0 + tx * 4;
  v0 = *(const cvf4*)(s0);
  v1 = *(const cvf4*)(s0 + (size_t)16 * d.N);
  v2 = *(const cvf4*)(s0 + (size_t)32 * d.N);
  v3 = *(const cvf4*)(s0 + (size_t)48 * d.N);
}
__device__ __forceinline__ void cv_emit(const CvDesc& d, int tid, const cvf4 v0, const cvf4 v1, const cvf4 v2, const cvf4 v3, float* tile) {
  {
    const int tx = tid & 15, ty = tid >> 4;
    float* t0 = tile + ty * 65 + tx * 4;
    t0[0] = v0.x; t0[1] = v0.y; t0[2] = v0.z; t0[3] = v0.w;
    t0[16 * 65 + 0] = v1.x; t0[16 * 65 + 1] = v1.y; t0[16 * 65 + 2] = v1.z; t0[16 * 65 + 3] = v1.w;
    t0[32 * 65 + 0] = v2.x; t0[32 * 65 + 1] = v2.y; t0[32 * 65 + 2] = v2.z; t0[32 * 65 + 3] = v2.w;
    t0[48 * 65 + 0] = v3.x; t0[48 * 65 + 1] = v3.y; t0[48 * 65 + 2] = v3.z; t0[48 * 65 + 3] = v3.w;
  }
  __syncthreads();
  {
    const int kc = tid & 3, n = tid >> 2;
    float v[16];
#pragma unroll
    for (int q = 0; q < 16; ++q) v[q] = tile[(kc * 16 + q) * 65 + n] * W8_SCALE;
    u32x4 o;
    o.x = pk_fp8x4c(v[0], v[1], v[2], v[3]); o.y = pk_fp8x4c(v[4], v[5], v[6], v[7]);
    o.z = pk_fp8x4c(v[8], v[9], v[10], v[11]); o.w = pk_fp8x4c(v[12], v[13], v[14], v[15]);
    const int nn = d.n0 + n;
    const int row = d.which >= 0 ? 64 * (nn >> 5) + d.which * 32 + (nn & 31) : nn;
    *(u32x4*)(d.dst + (size_t)row * d.K + d.k0 + kc * 16) = o;
  }
  __syncthreads();
}
__device__ __forceinline__ void convert_run(KP p, int stage, int jj, int j1, float* sm, int tid) {
  CvDesc d, dn;
  cvf4 a0, a1, a2, a3, b0, b1, b2, b3;
  bool cur = false;
#pragma unroll 1
  for (; jj < j1; ++jj) {
    const int job = conv_stage_job(stage, jj);
    if (!cur) {
      if (!conv_desc_fp8(p, job, d)) { convert_job(p, job, sm, tid); continue; }
      cv_load(d, tid, a0, a1, a2, a3);
    }
    bool nxt = false;
    if (jj + 1 < j1) {
      nxt = conv_desc_fp8(p, conv_stage_job(stage, jj + 1), dn);
      if (nxt) cv_load(dn, tid, b0, b1, b2, b3);
    }
    cv_emit(d, tid, a0, a1, a2, a3, sm);
    if (nxt) { d = dn; a0 = b0; a1 = b1; a2 = b2; a3 = b3; }
    cur = nxt;
  }
}

__device__ void ph_init(KP p, char* smc) {
  float* sm = (float*)smc;
  const int tid = opaque_tid();
  {
    const size_t n4a = (size_t)NL * DM / 4, n4b = (size_t)NC * DM / 4;
    const float4* xs = (const float4*)p->x;
    const float4* cs = (const float4*)p->ctx;
    u32x2* X4 = (u32x2*)p->X;
    for (size_t i = (size_t)blockIdx.x * NTHR + tid; i < n4a + n4b; i += (size_t)gridDim.x * NTHR) {
      const float4 xv = i < n4a ? xs[i] : cs[i - n4a];
      u32x2 o; o.x = pk_bf16(xv.x, xv.y); o.y = pk_bf16(xv.z, xv.w);
      X4[i] = o;
    }
  }
  for (int tile = blockIdx.x; tile < 96 * 8; tile += gridDim.x) {
    const int ct = tile >> 3, ks = tile & 7;
    for (int i = tid; i < 9 * 128; i += NTHR) {
      const int r = i >> 7, k = ks * 128 + (i & 127);
      const float v = r < 8 ? p->c[r * 1024 + k] : p->c_ctx[k];
      sm[i] = silu_f(v);
    }
    __syncthreads();
    const int col = ct * 256 + tid;
    const int layer = col / 6144, n = col % 6144;
    const float* W = p->ada_w + ((size_t)layer * 1024 + ks * 128) * 6144 + n;
    float acc[9];
#pragma unroll
    for (int r = 0; r < 9; ++r) acc[r] = 0.f;
#pragma unroll 4
    for (int k = 0; k < 128; ++k) {
      const float w = W[(size_t)k * 6144];
#pragma unroll
      for (int r = 0; r < 9; ++r) acc[r] = fmaf(sm[r * 128 + k], w, acc[r]);
    }
#pragma unroll
    for (int r = 0; r < 9; ++r) p->MODP[((size_t)(ks * 4 + layer) * 9 + r) * 6144 + n] = acc[r];
    __syncthreads();
  }
  {
    const int total = conv_stage_total(0), chunk = (total + gridDim.x - 1) / gridDim.x;
    const int lo = min((int)blockIdx.x * chunk, total), hi = min(lo + chunk, total);
    __syncthreads();
    convert_run(p, 0, lo, hi, sm, tid);
  }
  for (int i = blockIdx.x * NTHR + tid; i < 2 * 3 * 128 * 512; i += gridDim.x * NTHR) {
    const int k = i & 511, n = (i >> 9) & 127, wj = i >> 16;
    const int j = wj / 3, which = wj % 3;
    float v = 0.f;
    if (which < 2) {
      if (n < 64) v = (which ? p->rwkv_a1 : p->rwkv_w1)[((size_t)(j * 2 + (n >> 5)) * 512 + k) * 32 + (n & 31)];
    } else if (n < 96) v = p->rwkv_g1[((size_t)j * 512 + k) * 96 + n];
    p->Wl1[i] = f2bf(v);
  }
  for (int i = blockIdx.x * NTHR + tid; i < 2 * 2560 * 128; i += gridDim.x * NTHR) {
    const int k = i & 127, n = (i >> 7) % 2560, j = i / (2560 * 128);
    float v = 0.f;
    if (n < 2048) {
      const int d = (n >> 9) & 1, c = n & 511;
      if (k < 64 && (k >> 5) == d) v = (n < 1024 ? p->rwkv_w2 : p->rwkv_a2)[((size_t)(j * 2 + d) * 32 + (k & 31)) * 512 + c];
    } else if (k < 96) v = p->rwkv_g2[((size_t)j * 96 + k) * 512 + (n - 2048)];
    p->Wl2[i] = f2bf(v);
  }
  for (int i = blockIdx.x * NTHR + tid; i < 4 * 64 * 1024; i += gridDim.x * NTHR) {
    const int k = i & 1023, n = (i >> 10) & 63, l = i >> 16;
    p->WrT[i] = p->moe_router[((size_t)l * 1024 + k) * 64 + n];
  }
  for (int i = blockIdx.x * NTHR + tid; i < 64 * 16; i += gridDim.x * NTHR) {
    const int pos = i >> 4, f = i & 15;
    const float ang = (float)pos * powf(10000.f, -(float)f / 16.f);
    p->ROPE[2 * i] = cosf(ang);
    p->ROPE[2 * i + 1] = sinf(ang);
  }
}

__device__ void ph_mod_h(KP p, char* smc) {
  float* sm = (float*)smc;
  const int tid = opaque_tid();
  for (int i = blockIdx.x * NTHR + tid; i < 4 * 9 * 6144; i += gridDim.x * NTHR) {
    const int layer = i / (9 * 6144), rem = i % (9 * 6144), n = rem % 6144;
    float s = p->ada_b[layer * 6144 + n];
#pragma unroll
    for (int ks = 0; ks < 8; ++ks) s += p->MODP[(size_t)(ks * 4 + layer) * 9 * 6144 + rem];
    p->MOD[i] = s;
  }
  const int lane = tid & 63, wave = tid >> 6;
  const int per = (((NT + gridDim.x - 1) / gridDim.x) + 3) & ~3;
  const int t0 = blockIdx.x * per, t1 = min(NT, t0 + per);
  int cur = -1;
  for (int tb = t0; tb < t1; tb += 4) {
    const int mr = modrow(tb);
    if (mr != cur) {
      __syncthreads();
      for (int n = tid; n < 2048; n += NTHR) {
        float a = p->ada_b[n];
#pragma unroll
        for (int ks = 0; ks < 8; ++ks) a += p->MODP[((size_t)(ks * 4) * 9 + mr) * 6144 + n];
        sm[n] = a;
      }
      cur = mr;
      __syncthreads();
    }
    const int t = tb + wave;
    if (t < t1) {
      const float* src = t < NL ? p->x + (size_t)t * DM : p->ctx + (size_t)(t - NL) * DM;
#pragma unroll
      for (int i = 0; i < 4; ++i) {
        const int n = i * 256 + lane * 4;
        const float4 xv = *(const float4*)(src + n);
        const float4 sh = *(const float4*)(sm + n);
        const float4 sc = *(const float4*)(sm + 1024 + n);
        *(unsigned*)((unsigned char*)p->AB + (size_t)t * DM + n) =
            pk_fp8x4c(xv.x * (1.f + sc.x) + sh.x, xv.y * (1.f + sc.y) + sh.y, xv.z * (1.f + sc.z) + sh.z, xv.w * (1.f + sc.w) + sh.w);
      }
    }
  }
}

typedef short v4i16_t __attribute__((ext_vector_type(4)));
using s16x4 = __attribute__((ext_vector_type(4))) short;
__device__ __forceinline__ s16x4 vtr(const char* p) {
  return __builtin_bit_cast(s16x4, __builtin_amdgcn_ds_read_tr16_b64_v4i16((__attribute__((address_space(3))) v4i16_t*)p));
}
#define MFMA32(a, b, c) __builtin_amdgcn_mfma_f32_32x32x16_bf16(a, b, c, 0, 0, 0)
__device__ void ph_attention(KP p, int layer, bool keep, char* lds) {
  const int tid = opaque_tid();
  const int lane = tid & 63, w = tid >> 6, r32 = lane & 31, hi = lane >> 5;
  const int j = layer >> 1;
  float* bias_lds = (float*)(lds + 32768 + 1024);
  const int n_gqa = 1024, n_na = 1024, n_cb = keep ? 128 : 0, n_ca = keep ? 128 : 0;
  const int total = n_gqa + n_na + n_cb + n_ca;
  constexpr float LOG2E = 1.4426950408889634f;
  constexpr float C2 = 0.125f * LOG2E;
  const int c = tid & 7, sr = tid >> 3;
  const int kso = (c ^ ((tid >> 4) & 7)) * 16;
  const int vso = (c >> 2) * 4096 + (c & 3) * 16;
  const int sw = (r32 >> 1) & 7;
  for (int vitem = blockIdx.x; vitem < total; vitem += gridDim.x) {
    int item = vitem;
    if (gridDim.x == 512) {
      const int cls0 = vitem < n_gqa ? 0 : (vitem < n_gqa + n_na ? n_gqa : (vitem < n_gqa + n_na + n_cb ? n_gqa + n_na : n_gqa + n_na + n_cb));
      const int vl = vitem - cls0, b9 = vl & 511, r9 = vl >> 9;
      item = cls0 + (cls0 < n_gqa + n_na ? 128 * (b9 & 7) + 64 * r9 + (b9 >> 3) : 16 * (b9 & 7) + (b9 >> 3));
    }
    int b, qrow0, qoff, koff, voff, ocol, lat_tiles, lat_row0;
    bool na = false;
    int r_w = 0, start_w = 0, ru0 = 0, hN = 0;
    if (item < n_gqa) {
      b = item >> 7;
      const int g = (item >> 6) & 1, tt = item & 63;
      qrow0 = b * SEQ + tt * 32; qoff = 1536 + (g * 4 + w) * 64; koff = 2048 + g * 64; voff = 2176 + g * 64;
      ocol = 512 + (g * 4 + w) * 64; lat_tiles = 32; lat_row0 = b * SEQ;
    } else if (item < n_gqa + n_na) {
      const int it = item - n_gqa;
      b = it >> 7; hN = (it >> 4) & 7;
      const int rp = it & 15;
      na = true; r_w = 2 * rp + (w >> 1);
      qrow0 = b * SEQ + r_w * 64 + (w & 1) * 32; qoff = hN * 64; koff = 512 + hN * 64; voff = 1024 + hN * 64; ocol = hN * 64;
      const int s0 = min(max(2 * rp - 4, 0), 24), s1 = min(max(2 * rp - 3, 0), 24);
      start_w = (w >> 1) ? s1 : s0; ru0 = s0; lat_tiles = (s1 != s0) ? 9 : 8; lat_row0 = b * SEQ + ru0 * 64;
    } else if (item < n_gqa + n_na + n_cb) {
      const int it = item - n_gqa - n_na;
      b = it >> 4;
      const int g = (it >> 3) & 1, tt = it & 7;
      qrow0 = NL + b * CTXL + tt * 32; qoff = 1536 + (g * 4 + w) * 64; koff = 2048 + g * 64; voff = 2176 + g * 64;
      ocol = 512 + (g * 4 + w) * 64; lat_tiles = 0; lat_row0 = 0;
    } else {
      const int it = item - n_gqa - n_na - n_cb;
      b = it >> 4;
      const int h = (it >> 1) & 7, half = it & 1;
      qrow0 = NL + b * CTXL + half * 128 + w * 32; qoff = h * 64; koff = 512 + h * 64; voff = 1024 + h * 64; ocol = h * 64;
      lat_tiles = 0; lat_row0 = 0;
    }
    const int ctx_row0 = NL + b * CTXL, ntiles = lat_tiles + 4;
    if (na)
      for (int i = tid; i < 465; i += NTHR) bias_lds[i] = p->na_rpb[(j * 8 + hN) * 465 + i] * LOG2E;
    bf16x8 qf[4];
    {
      const bf16_t* qp = p->P + (size_t)(qrow0 + r32) * LDP + qoff + hi * 8;
#pragma unroll
      for (int d0 = 0; d0 < 4; ++d0) qf[d0] = *(const bf16x8*)(qp + d0 * 16);
    }
    f32x16 o0, o1;
#pragma unroll
    for (int q = 0; q < 16; ++q) { o0[q] = 0.f; o1[q] = 0.f; }
    float m = -INFINITY, l = 0.f;
    u32x4 kr0, kr1, vr0, vr1;
    auto gload = [&](int t) {
      const int row0 = t < lat_tiles ? lat_row0 + 64 * t : ctx_row0 + 64 * (t - lat_tiles);
      const bf16_t* base = p->P + (size_t)(row0 + sr) * LDP + c * 8;
      kr0 = *(const u32x4*)(base + koff); kr1 = *(const u32x4*)(base + (size_t)32 * LDP + koff);
      vr0 = *(const u32x4*)(base + voff); vr1 = *(const u32x4*)(base + (size_t)32 * LDP + voff);
    };
    auto swrite = [&](int buf) {
      char* Kb = lds + buf * 16384;
      char* Vb = Kb + 8192;
      *(u32x4*)(Kb + sr * 128 + kso) = kr0; *(u32x4*)(Kb + (sr + 32) * 128 + kso) = kr1;
      *(u32x4*)(Vb + vso + sr * 64) = vr0; *(u32x4*)(Vb + vso + (sr + 32) * 64) = vr1;
    };
    gload(0);
    swrite(0);
    for (int t = 0; t < ntiles; ++t) {
      __syncthreads();
      if (t + 1 < ntiles) gload(t + 1);
      const bool na_tile = na && t < lat_tiles;
      const int kr = ru0 + t;
      const bool part = !na_tile || (kr >= start_w && kr < start_w + 8);
      if (part) {
        const char* Ks = lds + (t & 1) * 16384;
        const char* Vs = Ks + 8192;
        f32x16 s0, s1;
#pragma unroll
        for (int q = 0; q < 16; ++q) { s0[q] = 0.f; s1[q] = 0.f; }
#pragma unroll
        for (int d0 = 0; d0 < 4; ++d0) {
          const int off = ((2 * d0 + hi) ^ sw) * 16;
          const bf16x8 k0 = *(const bf16x8*)(Ks + r32 * 128 + off);
          const bf16x8 k1 = *(const bf16x8*)(Ks + (32 + r32) * 128 + off);
          s0 = MFMA32(k0, qf[d0], s0);
          s1 = MFMA32(k1, qf[d0], s1);
        }
        float mx = -INFINITY;
        if (na_tile) {
          const int cq = (w & 1) * 32 + r32;
          const int c0 = min(max(cq - 8, 0), 48);
          const float* brow = bias_lds + (kr - r_w + 7) * 31 + (15 - cq);
#pragma unroll
          for (int q = 0; q < 16; ++q) {
            const int kc = (q & 3) + 8 * (q >> 2) + 4 * hi;
            const float v0 = ((unsigned)(kc - c0) < 16u) ? fmaf(s0[q], C2, brow[kc]) : -INFINITY;
            const float v1 = ((unsigned)(kc + 32 - c0) < 16u) ? fmaf(s1[q], C2, brow[kc + 32]) : -INFINITY;
            s0[q] = v0; s1[q] = v1;
            mx = fmaxf(mx, fmaxf(v0, v1));
          }
        } else {
#pragma unroll
          for (int q = 0; q < 16; ++q) {
            s0[q] *= C2; s1[q] *= C2;
            mx = fmaxf(mx, fmaxf(s0[q], s1[q]));
          }
        }
        {
          auto rr = __builtin_amdgcn_permlane32_swap(__float_as_uint(mx), __float_as_uint(mx), false, false);
          mx = fmaxf(__uint_as_float(rr[0]), __uint_as_float(rr[1]));
        }
        const float mnew = fmaxf(m, mx);
        const float alpha = __builtin_amdgcn_exp2f(m - mnew);
        float ls = 0.f;
#pragma unroll
        for (int q = 0; q < 16; ++q) {
          s0[q] = __builtin_amdgcn_exp2f(s0[q] - mnew);
          s1[q] = __builtin_amdgcn_exp2f(s1[q] - mnew);
          ls += s0[q] + s1[q];
        }
        l = l * alpha + ls;
        m = mnew;
#pragma unroll
        for (int q = 0; q < 16; ++q) { o0[q] *= alpha; o1[q] *= alpha; }
        bf16x8 pf[4];
#pragma unroll
        for (int s = 0; s < 4; ++s) {
          const int u = (s & 1) * 8;
          u32x4 tpk;
          if (s < 2) {
            tpk.x = pk_bf16(s0[u + 0], s0[u + 1]); tpk.y = pk_bf16(s0[u + 2], s0[u + 3]);
            tpk.z = pk_bf16(s0[u + 4], s0[u + 5]); tpk.w = pk_bf16(s0[u + 6], s0[u + 7]);
          } else {
            tpk.x = pk_bf16(s1[u + 0], s1[u + 1]); tpk.y = pk_bf16(s1[u + 2], s1[u + 3]);
            tpk.z = pk_bf16(s1[u + 4], s1[u + 5]); tpk.w = pk_bf16(s1[u + 6], s1[u + 7]);
          }
          pf[s] = __builtin_bit_cast(bf16x8, tpk);
        }
        const char* vb = Vs + ((lane >> 4) & 1) * 32 + (lane & 3) * 8 + ((lane & 15) >> 2) * 64 + hi * 256;
#pragma unroll
        for (int s = 0; s < 4; ++s) {
          const s16x4 a00 = vtr(vb + (16 * s) * 64), a01 = vtr(vb + (16 * s + 8) * 64);
          const s16x4 a10 = vtr(vb + 4096 + (16 * s) * 64), a11 = vtr(vb + 4096 + (16 * s + 8) * 64);
          const bf16x8 A0 = __builtin_shufflevector(a00, a01, 0, 1, 2, 3, 4, 5, 6, 7);
          const bf16x8 A1 = __builtin_shufflevector(a10, a11, 0, 1, 2, 3, 4, 5, 6, 7);
          o0 = MFMA32(A0, pf[s], o0);
          o1 = MFMA32(A1, pf[s], o1);
        }
      }
      if (t + 1 < ntiles) swrite((t + 1) & 1);
    }
    __syncthreads();
    const float lt = l + __shfl_xor(l, 32);
    const float inv = 1.f / lt;
    unsigned char* op = (unsigned char*)p->AB + (size_t)(qrow0 + r32) * DM + ocol + 4 * hi;
#pragma unroll
    for (int g = 0; g < 4; ++g) {
      *(unsigned*)(op + 8 * g) = pk_fp8x4c(o0[4 * g] * inv, o0[4 * g + 1] * inv, o0[4 * g + 2] * inv, o0[4 * g + 3] * inv);
      *(unsigned*)(op + 32 + 8 * g) = pk_fp8x4c(o1[4 * g] * inv, o1[4 * g + 1] * inv, o1[4 * g + 2] * inv, o1[4 * g + 3] * inv);
    }
  }
}

__device__ void ph_rwkv_mix(KP p, int layer) {
  const int j = layer >> 1;
  const int tid = opaque_tid();
  const int lane = tid & 63, wave = tid >> 6;
  const float* mu = p->rwkv_mu + j * 6 * 512;
  const int c0 = lane * 8;
  auto unpack = [](const u32x4 u, float (&f)[8]) {
    f[0] = bflo(u.x); f[1] = bfhi(u.x); f[2] = bflo(u.y); f[3] = bfhi(u.y);
    f[4] = bflo(u.z); f[5] = bfhi(u.z); f[6] = bflo(u.w); f[7] = bfhi(u.w);
  };
  auto pack = [](const float (&f)[8]) {
    u32x4 o;
    o.x = pk_bf16(f[0], f[1]); o.y = pk_bf16(f[2], f[3]); o.z = pk_bf16(f[4], f[5]); o.w = pk_bf16(f[6], f[7]);
    return o;
  };
  for (int t = blockIdx.x * 4 + wave; t < NT; t += gridDim.x * 4) {
    bool hasp, hasn;
    if (t < NL) { int s = t & 2047; hasp = s > 0; hasn = s < SEQ - 1; }
    else { int s = (t - NL) & 255; hasp = s > 0; hasn = s < CTXL - 1; }
    const bf16_t* pt = p->P + (size_t)t * LDP + c0;
    bf16_t* rw = p->RW + (size_t)t * RWS + c0;
    bf16_t* zb = p->Zb + (size_t)t * 1536 + c0;
    const u32x4 zero = {0u, 0u, 0u, 0u};
#pragma unroll
    for (int q = 0; q < 4; ++q) {
      float cur[8], pv[8], nx[8], d[8];
      unpack(*(const u32x4*)(pt + q * 512), cur);
      unpack(hasp ? *(const u32x4*)(pt + q * 512 - LDP) : zero, pv);
      unpack(hasn ? *(const u32x4*)(pt + q * 512 + LDP) : zero, nx);
#pragma unroll
      for (int e = 0; e < 8; ++e) d[e] = 0.5f * (pv[e] + nx[e]) - cur[e];
      if (q < 3) {
        float o[8];
        const float* m = mu + q * 512 + c0;
#pragma unroll
        for (int e = 0; e < 8; ++e) o[e] = cur[e] + d[e] * m[e];
        if (q == 0) *(u32x4*)(rw) = pack(o);
        else if (q == 2) *(u32x4*)(rw + 512) = pack(o);
        else {
          *(u32x4*)(rw + 10 * 512) = pack(o);
          float kk[8], ss = 0.f;
          const float* kv0 = p->rwkv_kvec + (j * 2 + 0) * 512 + c0;
#pragma unroll
          for (int e = 0; e < 8; ++e) { kk[e] = o[e] * kv0[e]; ss += kk[e] * kk[e]; }
          ss += dppx<0xB1>(ss); ss += dppx<0x4E>(ss); ss += dppx<0x141>(ss);
          const float rn = rsqrtf(fmaxf(ss, 1e-24f));
#pragma unroll
          for (int e = 0; e < 8; ++e) kk[e] *= rn;
          *(u32x4*)(rw + 2 * 512) = pack(kk);
        }
      } else {
#pragma unroll
        for (int z = 0; z < 3; ++z) {
          float o[8];
          const float* m = mu + (3 + z) * 512 + c0;
#pragma unroll
          for (int e = 0; e < 8; ++e) o[e] = cur[e] + d[e] * m[e];
          *(u32x4*)(zb + z * 512) = pack(o);
        }
      }
    }
  }
}

constexpr int RS_STEP = 384;
constexpr int RS_TB = 16;
struct RwkvStage { u32x2 r, kk, e, ke, a, v; };
__device__ void rwkv_unit(KP p, int unit, float* sm, int tid) {
  const int ch = unit >> 1, hf = unit & 1;
  const int dir = ch >> 6, b = (ch >> 3) & 7, h = ch & 7;
  const int lane = tid & 63, w = tid >> 6, rl = lane >> 3, ks = lane & 7;
  float* ybuf = sm + 2 * RS_TB * RS_STEP;
  const int ss = tid >> 4, kq = tid & 15;
  auto gload = [&](int n, RwkvStage& g) {
    const int row = scan_row(dir, b, n * RS_TB + ss);
    const bf16_t* base = p->RW + (size_t)row * RWS + h * 64 + kq * 4;
    g.r = *(const u32x2*)(base);
    g.kk = *(const u32x2*)(base + 2 * 512);
    g.e = *(const u32x2*)(base + (3 + dir) * 512);
    g.ke = *(const u32x2*)(base + (5 + dir) * 512);
    g.a = *(const u32x2*)(base + (7 + dir) * 512);
    g.v = *(const u32x2*)(p->RW + (size_t)row * RWS + 512 + h * 64 + hf * 32 + (kq & 7) * 4);
  };
  auto swrite = [&](int buf, const RwkvStage& g) {
    float* sp = sm + (buf * RS_TB + ss) * RS_STEP;
    const float r0 = bflo(g.r.x), r1 = bfhi(g.r.x), r2 = bflo(g.r.y), r3 = bfhi(g.r.y);
    const float k0 = bflo(g.kk.x), k1 = bfhi(g.kk.x), k2 = bflo(g.kk.y), k3 = bfhi(g.kk.y);
    const float w0 = __expf(-bflo(g.e.x)), w1 = __expf(-bfhi(g.e.x)), w2 = __expf(-bflo(g.e.y)), w3 = __expf(-bfhi(g.e.y));
    const float e0 = bflo(g.ke.x), e1 = bfhi(g.ke.x), e2 = bflo(g.ke.y), e3 = bfhi(g.ke.y);
    const float a0 = k0 * bflo(g.a.x), a1 = k1 * bfhi(g.a.x), a2 = k2 * bflo(g.a.y), a3 = k3 * bfhi(g.a.y);
    *(float4*)(sp + kq * 4) = make_float4(k0, k1, k2, k3);
    *(float4*)(sp + 64 + kq * 4) = make_float4(w0 * r0, w1 * r1, w2 * r2, w3 * r3);
    *(float4*)(sp + 128 + kq * 4) = make_float4(w0, w1, w2, w3);
    *(float4*)(sp + 192 + kq * 4) = make_float4(a0, a1, a2, a3);
    *(float4*)(sp + 256 + kq * 4) = make_float4(e0, e1, e2, e3);
    if (kq < 8) *(float4*)(sp + 320 + kq * 4) = make_float4(bflo(g.v.x), bfhi(g.v.x), bflo(g.v.y), bfhi(g.v.y));
    float c1 = a0 * r0 + a1 * r1 + a2 * r2 + a3 * r3;
    float c2 = e0 * r0 + e1 * r1 + e2 * r2 + e3 * r3;
    c1 += dppx<0xB1>(c1); c2 += dppx<0xB1>(c2);
    c1 += dppx<0x4E>(c1); c2 += dppx<0x4E>(c2);
    c1 += dppx<0x141>(c1); c2 += dppx<0x141>(c2);
    c1 += dppx<0x140>(c1); c2 += dppx<0x140>(c2);
    if (kq == 0) { sp[352] = c1; sp[353] = c2; }
  };
  typedef float f2 __attribute__((ext_vector_type(2)));
  f2 S01 = {0.f, 0.f}, S23 = {0.f, 0.f}, S45 = {0.f, 0.f}, S67 = {0.f, 0.f};
  auto compute = [&](int n) {
    const float* bp = sm + (n & 1) * RS_TB * RS_STEP;
    float* yb = ybuf + (n & 1) * RS_TB * 32 + w * 8 + rl;
    struct Ops { f2 k[4], r[4], w[4], a[4], e[4]; float vv; f2 c; };
    auto ld = [&](int s, Ops& o) {
      const float* sq = bp + s * RS_STEP;
      const f2* sp = (const f2*)(sq + ks * 8);
#pragma unroll
      for (int i = 0; i < 4; ++i) { o.k[i] = sp[i]; o.r[i] = sp[32 + i]; o.w[i] = sp[64 + i]; o.a[i] = sp[96 + i]; o.e[i] = sp[128 + i]; }
      o.vv = sq[320 + w * 8 + rl]; o.c = *(const f2*)(sq + 352);
    };
    auto step = [&](const Ops& o) -> float {
      f2 sa2 = S01 * o.k[0];
      f2 y2 = S01 * o.r[0];
      sa2 = __builtin_elementwise_fma(S23, o.k[1], sa2); y2 = __builtin_elementwise_fma(S23, o.r[1], y2);
      sa2 = __builtin_elementwise_fma(S45, o.k[2], sa2); y2 = __builtin_elementwise_fma(S45, o.r[2], y2);
      sa2 = __builtin_elementwise_fma(S67, o.k[3], sa2); y2 = __builtin_elementwise_fma(S67, o.r[3], y2);
      float sa = sa2.x + sa2.y, y0 = y2.x + y2.y;
      sa += dppx<0xB1>(sa); y0 += dppx<0xB1>(y0);
      sa += dppx<0x4E>(sa); y0 += dppx<0x4E>(y0);
      sa += dppx<0x141>(sa); y0 += dppx<0x141>(y0);
      sa = -sa;
      const f2 sav = {sa, sa}, vvv = {o.vv, o.vv};
      S01 = __builtin_elementwise_fma(vvv, o.e[0], __builtin_elementwise_fma(sav, o.a[0], S01 * o.w[0]));
      S23 = __builtin_elementwise_fma(vvv, o.e[1], __builtin_elementwise_fma(sav, o.a[1], S23 * o.w[1]));
      S45 = __builtin_elementwise_fma(vvv, o.e[2], __builtin_elementwise_fma(sav, o.a[2], S45 * o.w[2]));
      S67 = __builtin_elementwise_fma(vvv, o.e[3], __builtin_elementwise_fma(sav, o.a[3], S67 * o.w[3]));
      return fmaf(o.vv, o.c.y, fmaf(sa, o.c.x, y0));
    };
    Ops oa, ob;
    ld(0, oa);
#pragma unroll 1
    for (int s = 0; s < RS_TB; s += 2) {
      __builtin_amdgcn_sched_barrier(0);
      ld(s + 1, ob);
      __builtin_amdgcn_sched_barrier(0);
      float y0 = step(oa);
      asm volatile("" : "+v"(y0));
      __builtin_amdgcn_sched_barrier(0);
      ld(s + 2, oa);
      __builtin_amdgcn_sched_barrier(0);
      float y1 = step(ob);
      asm volatile("" : "+v"(y1));
      __builtin_amdgcn_sched_barrier(0);
      if (ks == 0) { yb[s * 32] = y0; yb[(s + 1) * 32] = y1; }
    }
  };
  auto yout = [&](int n) {
    const int row = scan_row(dir, b, n * RS_TB + ss);
    const float* ys = ybuf + (n & 1) * RS_TB * 32 + ss * 32 + kq * 2;
    *(unsigned*)(p->P + (size_t)row * LDP + dir * 512 + h * 64 + hf * 32 + kq * 2) = pk_bf16(ys[0], ys[1]);
  };
  constexpr int NB = TSC / RS_TB;
  RwkvStage gA, gB;
  gload(0, gA);
  gload(1, gB);
  swrite(0, gA);
  gload(2, gA);
  __syncthreads();
  for (int n = 0; n < NB; n += 2) {
    compute(n);
    swrite(1, gB);
    if (n + 3 < NB) gload(n + 3, gB);
    __syncthreads();
    yout(n);
    compute(n + 1);
    if (n + 2 < NB) swrite(0, gA);
    if (n + 4 < NB) gload(n + 4, gA);
    __syncthreads();
    yout(n + 1);
  }
  __syncthreads();
}

__device__ void mlstm_s1(KP p, int layer, int tile, char* lds, int tid) {
  const int j = layer >> 1;
  const int ch = tile / NCHUNK, c = tile % NCHUNK;
  const int dir = ch >> 5, b = (ch >> 2) & 7, h = ch & 3;
  float* s_ws = (float*)(lds + META_OFF);
  int* s_row = (int*)(s_ws + 64);
  char* kimg = lds;
  char* vimg = lds + 16384;
  if (tid < 64) {
    const int row = scan_row(dir, b, c * 64 + tid);
    s_row[tid] = row;
    const float* g = p->GP + (size_t)row * 16;
    const float gi = g[(dir * 2) * 4 + h] + p->mlstm_gate_b[j * 16 + (dir * 2) * 4 + h];
    const float gf = g[(dir * 2 + 1) * 4 + h] + p->mlstm_gate_b[j * 16 + (dir * 2 + 1) * 4 + h];
    float bc = -softplus_f(-gf);
#pragma unroll
    for (int o = 1; o < 64; o <<= 1) {
      float tmp = __shfl_up(bc, o);
      if (tid >= o) bc += tmp;
    }
    const float bend = __shfl(bc, 63);
    const float ds = bend - bc + gi;
    const float mloc = wmax(ds);
    s_ws[tid] = expf(ds - mloc);
    if (tid == 0) { p->msc[tile] = mloc; p->msc[NMT + tile] = bend; }
  }
  __syncthreads();
  {
    const int c8 = tid & 15;
    const int ioff = (c8 >> 2) * 4096 + (c8 & 3) * 16;
#pragma unroll
    for (int i = 0; i < 4; ++i) {
      const int sidx = (tid >> 4) + 16 * i;
      const bf16_t* src = p->P + (size_t)s_row[sidx] * LDP + h * 128 + c8 * 8;
      const u32x4 kv = *(const u32x4*)(src + 2560);
      u32x4 vv = *(const u32x4*)(src + 3072);
      const float wsv = s_ws[sidx];
      vv.x = pk_bf16(bflo(vv.x) * wsv, bfhi(vv.x) * wsv); vv.y = pk_bf16(bflo(vv.y) * wsv, bfhi(vv.y) * wsv);
      vv.z = pk_bf16(bflo(vv.z) * wsv, bfhi(vv.z) * wsv); vv.w = pk_bf16(bflo(vv.w) * wsv, bfhi(vv.w) * wsv);
      *(u32x4*)(kimg + ioff + sidx * 64) = kv;
      *(u32x4*)(vimg + ioff + sidx * 64) = vv;
    }
  }
  __syncthreads();
  const int lane = tid & 63, w = tid >> 6, wm = w >> 1, wn = w & 1, r32 = lane & 31, hi = lane >> 5;
  f32x16 acc[2][2];
#pragma unroll
  for (int mi = 0; mi < 2; ++mi)
#pragma unroll
    for (int ni = 0; ni < 2; ++ni)
#pragma unroll
      for (int q = 0; q < 16; ++q) acc[mi][ni][q] = 0.f;
  const int toff = ((lane >> 4) & 1) * 32 + (lane & 3) * 8 + ((lane & 15) >> 2) * 64 + hi * 256;
#pragma unroll
  for (int ks = 0; ks < 4; ++ks) {
    bf16x8 af[2], bfr[2];
#pragma unroll
    for (int i = 0; i < 2; ++i) {
      const char* ka = kimg + (wm * 2 + i) * 4096 + toff + (16 * ks) * 64;
      const char* va = vimg + (wn * 2 + i) * 4096 + toff + (16 * ks) * 64;
      af[i] = __builtin_shufflevector(vtr(ka), vtr(ka + 8 * 64), 0, 1, 2, 3, 4, 5, 6, 7);
      bfr[i] = __builtin_shufflevector(vtr(va), vtr(va + 8 * 64), 0, 1, 2, 3, 4, 5, 6, 7);
    }
    acc[0][0] = MFMA32(af[0], bfr[0], acc[0][0]);
    acc[0][1] = MFMA32(af[0], bfr[1], acc[0][1]);
    acc[1][0] = MFMA32(af[1], bfr[0], acc[1][0]);
    acc[1][1] = MFMA32(af[1], bfr[1], acc[1][1]);
  }
  bf16_t* ust = (bf16_t*)(lds + 32768);
#pragma unroll
  for (int mi = 0; mi < 2; ++mi)
#pragma unroll
    for (int ni = 0; ni < 2; ++ni)
#pragma unroll
      for (int q = 0; q < 16; ++q) {
        const int d = wm * 64 + mi * 32 + (q & 3) + 8 * (q >> 2) + 4 * hi;
        ust[d * 128 + wn * 64 + ni * 32 + r32] = f2bf(acc[mi][ni][q]);
        if ((q & 3) == 3) __builtin_amdgcn_sched_barrier(0);
      }
  __syncthreads();
  {
    const u32x4* us4 = (const u32x4*)ust;
    u32x4* U4 = (u32x4*)(p->MS + (size_t)tile * 16384);
#pragma unroll
    for (int i = 0; i < 8; ++i) U4[tid + 256 * i] = us4[tid + 256 * i];
  }
  if (tid < 128) {
    const char* kc = kimg + (tid >> 5) * 4096 + (tid & 31) * 2;
    float a = 0.f;
#pragma unroll 8
    for (int sidx = 0; sidx < 64; ++sidx) a = fmaf(s_ws[sidx], bf2f(*(const bf16_t*)(kc + sidx * 64)), a);
    p->MSn[tile * 128 + tid] = a;
  }
}

__device__ void mlstm_s3(KP p, int layer, int tile, char* lds, int tid);
__device__ void ph_scan_a(KP p, int layer, char* smc) {
  float* sm = (float*)smc;
  const int tid = opaque_tid();
  __builtin_amdgcn_s_setprio(3);
  for (int u = blockIdx.x; u < 256; u += gridDim.x) rwkv_unit(p, u, sm, tid);
  __builtin_amdgcn_s_setprio(0);
  {
    const int stage = layer == 1 ? 1 : 2;
    const int nconv = conv_stage_total(stage);
    const int total = NMT + (nconv + 7) / 8;
    int* qc = (int*)(p->bar + XCD_BAR_WORDS + 16 * stage);
    int* s_q = (int*)(smc + META_OFF + 3968);
    int jj = 0, j1 = 0;
#pragma unroll 1
    for (;;) {
      if (jj >= j1) {
        __syncthreads();
        if (tid == 0) *s_q = atomicAdd(qc, 1);
        __syncthreads();
        const int q = *s_q;
        if (q >= total) break;
        if (q < NMT) { mlstm_s3(p, layer, q, smc, tid); continue; }
        jj = (q - NMT) * 8; j1 = min(jj + 8, nconv);
      }
      convert_run(p, stage, jj, j1, sm, tid);
      jj = j1;
    }
  }
}

__device__ void ph_mlstm_s2(KP p, char* smc) {
  float* sw = (float*)smc;
  const int tid = opaque_tid();
  const int nitems = 64 * 33;
  for (int item = blockIdx.x; item < nitems; item += gridDim.x) {
    const int ch = item / 33, seg = item % 33;
    __syncthreads();
    if (tid < 2 * NCHUNK) sw[72 + tid] = p->msc[(tid < NCHUNK ? 0 : NMT - NCHUNK) + ch * NCHUNK + tid];
    __syncthreads();
    if (tid == 0) {
      float m = 0.f;
      for (int c = 0; c < NCHUNK; ++c) {
        const int tile = ch * NCHUNK + c;
        const float mloc = sw[72 + c], bend = sw[72 + NCHUNK + c];
        const float mn = fmaxf(bend + m, mloc);
        sw[c] = expf(bend + m - mn);
        sw[36 + c] = expf(mloc - mn);
        if (seg == 0) p->msc[2 * NMT + tile] = m;
        m = mn;
      }
    }
    __syncthreads();
    if (seg < 32) {
      unsigned* base = (unsigned*)(p->MS + (size_t)ch * NCHUNK * 16384) + seg * 256 + tid;
      unsigned v[NCHUNK];
#pragma unroll
      for (int c = 0; c < NCHUNK; ++c) v[c] = base[(size_t)c * 8192];
      float C0 = 0.f, C1 = 0.f;
#pragma unroll
      for (int c = 0; c < NCHUNK; ++c) {
        const float t0 = bflo(v[c]), t1 = bfhi(v[c]);
        v[c] = pk_bf16(C0, C1);
        C0 = sw[c] * C0 + sw[36 + c] * t0;
        C1 = sw[c] * C1 + sw[36 + c] * t1;
      }
#pragma unroll
      for (int c = 0; c < NCHUNK; ++c) base[(size_t)c * 8192] = v[c];
    } else if (tid < 128) {
      float* base = p->MSn + (size_t)ch * NCHUNK * 128 + tid;
      float v[NCHUNK];
#pragma unroll
      for (int c = 0; c < NCHUNK; ++c) v[c] = base[c * 128];
      float C = 0.f;
#pragma unroll
      for (int c = 0; c < NCHUNK; ++c) {
        const float t0 = v[c];
        v[c] = C;
        C = sw[c] * C + sw[36 + c] * t0;
      }
#pragma unroll
      for (int c = 0; c < NCHUNK; ++c) base[c * 128] = v[c];
    }
  }
}

__device__ void mlstm_s3(KP p, int layer, int tile, char* lds, int tid) {
  const int j = layer >> 1;
  const int ch = tile / NCHUNK, c = tile % NCHUNK;
  const int dir = ch >> 5, b = (ch >> 2) & 7, h = ch & 3;
  float* s_b = (float*)(lds + META_OFF);
  float* s_ig = s_b + 64;
  float* s_mt = s_b + 128;
  float* s_wi = s_b + 192;
  int* s_row = (int*)(s_b + 256);
  float* s_n = s_b + 320;
  float* s_c = s_b + 448;
  char* kimg = lds;
  char* vimg = lds + 16384;
  char* cimg = lds + 32768;
  const float mprev = p->msc[2 * NMT + tile];
  const float qscale = 0.08838834764831845f;
  const int lane = tid & 63, w = tid >> 6, wt = w >> 1, wv = w & 1, r32 = lane & 31, hi = lane >> 5;
  const int t = wt * 32 + r32;
  const int rowq = scan_row(dir, b, c * 64 + t);
  const int c8 = tid & 15;
  u32x4 kr[4], vr[4], cr[8];
#pragma unroll
  for (int i = 0; i < 4; ++i) {
    const int sidx = (tid >> 4) + 16 * i;
    const bf16_t* src = p->P + (size_t)scan_row(dir, b, c * 64 + sidx) * LDP + h * 128 + c8 * 8;
    kr[i] = *(const u32x4*)(src + 2560);
    vr[i] = *(const u32x4*)(src + 3072);
  }
  {
    const bf16_t* Cp = p->MS + (size_t)tile * 16384;
#pragma unroll
    for (int i = 0; i < 8; ++i) cr[i] = *(const u32x4*)(Cp + ((tid >> 4) + 16 * i) * 128 + c8 * 8);
  }
  bf16x8 qf[8];
  {
    const bf16_t* qp = p->P + (size_t)rowq * LDP + 2048 + h * 128 + hi * 8;
#pragma unroll
    for (int d0 = 0; d0 < 8; ++d0) qf[d0] = *(const bf16x8*)(qp + d0 * 16);
  }
  if (tid < 64) {
    const int row = scan_row(dir, b, c * 64 + tid);
    s_row[tid] = row;
    const float* g = p->GP + (size_t)row * 16;
    const float gi = g[(dir * 2) * 4 + h] + p->mlstm_gate_b[j * 16 + (dir * 2) * 4 + h];
    const float gf = g[(dir * 2 + 1) * 4 + h] + p->mlstm_gate_b[j * 16 + (dir * 2 + 1) * 4 + h];
    float bc = -softplus_f(-gf);
#pragma unroll
    for (int o = 1; o < 64; o <<= 1) {
      float tmp = __shfl_up(bc, o);
      if (tid >= o) bc += tmp;
    }
    float pm = gi - bc;
#pragma unroll
    for (int o = 1; o < 64; o <<= 1) {
      float tmp = __shfl_up(pm, o);
      if (tid >= o) pm = fmaxf(pm, tmp);
    }
    const float mt = bc + fmaxf(mprev, pm);
    s_b[tid] = bc;
    s_ig[tid] = gi;
    s_mt[tid] = mt;
    s_wi[tid] = expf(bc + mprev - mt);
    s_c[tid] = (gi - bc) * 1.4426950408889634f;
  } else if (tid < 192) s_n[tid - 64] = p->MSn[tile * 128 + (tid - 64)];
  {
    const int ioff = (c8 >> 2) * 4096 + (c8 & 3) * 16;
#pragma unroll
    for (int i = 0; i < 4; ++i) {
      const int sidx = (tid >> 4) + 16 * i;
      *(u32x4*)(kimg + sidx * 256 + ((c8 ^ (sidx & 15)) * 16)) = kr[i];
      *(u32x4*)(vimg + ioff + sidx * 64) = vr[i];
    }
    const int coff = (c8 >> 2) * 8192 + (c8 & 3) * 16;
#pragma unroll
    for (int i = 0; i < 8; ++i) *(u32x4*)(cimg + coff + ((tid >> 4) + 16 * i) * 64) = cr[i];
  }
  __syncthreads();
  const int toff = ((lane >> 4) & 1) * 32 + (lane & 3) * 8 + ((lane & 15) >> 2) * 64;
  constexpr float LOG2E_ = 1.4426950408889634f;
  float qn = 0.f;
#pragma unroll
  for (int d0 = 0; d0 < 8; ++d0) {
    const u32x4 qq = __builtin_bit_cast(u32x4, qf[d0]);
    const float* np = s_n + d0 * 16 + hi * 8;
    qn = fmaf(bflo(qq.x), np[0], qn); qn = fmaf(bfhi(qq.x), np[1], qn);
    qn = fmaf(bflo(qq.y), np[2], qn); qn = fmaf(bfhi(qq.y), np[3], qn);
    qn = fmaf(bflo(qq.z), np[4], qn); qn = fmaf(bfhi(qq.z), np[5], qn);
    qn = fmaf(bflo(qq.w), np[6], qn); qn = fmaf(bfhi(qq.w), np[7], qn);
  }
  qn += __shfl_xor(qn, 32);
  const float mtt = s_mt[t], wi = s_wi[t];
  const float ct = (s_b[t] - mtt) * LOG2E_;
  const float wq = wi * qscale;
  bf16x8 pf[4];
  float den = 0.f;
  {
    f32x16 sa0, sa1;
#pragma unroll
    for (int q = 0; q < 16; ++q) { sa0[q] = 0.f; sa1[q] = 0.f; }
#pragma unroll
    for (int d0 = 0; d0 < 8; ++d0) {
      const int chn = 2 * d0 + hi;
      const bf16x8 k0 = *(const bf16x8*)(kimg + r32 * 256 + ((chn ^ (r32 & 15)) * 16));
      sa0 = MFMA32(k0, qf[d0], sa0);
      if (wt) {
        const bf16x8 k1 = *(const bf16x8*)(kimg + (32 + r32) * 256 + ((chn ^ (r32 & 15)) * 16));
        sa1 = MFMA32(k1, qf[d0], sa1);
      }
      __builtin_amdgcn_sched_barrier(0);
    }
#pragma unroll
    for (int g = 0; g < 4; ++g) {
      const int sb0 = 8 * g + 4 * hi;
      const float4 c0v = *(const float4*)(s_c + sb0);
      const float4 c1v = *(const float4*)(s_c + sb0 + 32);
      const float cc0[4] = {c0v.x, c0v.y, c0v.z, c0v.w}, cc1[4] = {c1v.x, c1v.y, c1v.z, c1v.w};
#pragma unroll
      for (int e = 0; e < 4; ++e) {
        const int q = 4 * g + e;
        const float v0 = (sb0 + e <= t) ? sa0[q] * qscale * __builtin_amdgcn_exp2f(ct + cc0[e]) : 0.f;
        sa0[q] = v0; den += v0;
        const float v1 = (wt && sb0 + 32 + e <= t) ? sa1[q] * qscale * __builtin_amdgcn_exp2f(ct + cc1[e]) : 0.f;
        sa1[q] = v1; den += v1;
      }
      __builtin_amdgcn_sched_barrier(0);
    }
#pragma unroll
    for (int sx = 0; sx < 4; ++sx) {
      const int u = (sx & 1) * 8;
      u32x4 tpk;
      if (sx < 2) {
        tpk.x = pk_bf16(sa0[u + 0], sa0[u + 1]); tpk.y = pk_bf16(sa0[u + 2], sa0[u + 3]);
        tpk.z = pk_bf16(sa0[u + 4], sa0[u + 5]); tpk.w = pk_bf16(sa0[u + 6], sa0[u + 7]);
      } else {
        tpk.x = pk_bf16(sa1[u + 0], sa1[u + 1]); tpk.y = pk_bf16(sa1[u + 2], sa1[u + 3]);
        tpk.z = pk_bf16(sa1[u + 4], sa1[u + 5]); tpk.w = pk_bf16(sa1[u + 6], sa1[u + 7]);
      }
      pf[sx] = __builtin_bit_cast(bf16x8, tpk);
    }
  }
  den += __shfl_xor(den, 32);
  const float dtot = den + wq * qn;
  const float inv = 1.f / fmaxf(fabsf(dtot), expf(-mtt));
  bf16_t* op = p->P + (size_t)rowq * LDP + 1024 + dir * 512 + h * 128 + wv * 64 + 4 * hi;
#pragma unroll 1
  for (int vp = 0; vp < 2; ++vp) {
    f32x16 o0;
#pragma unroll
    for (int q = 0; q < 16; ++q) o0[q] = 0.f;
    const char* cb = cimg + (wv * 2 + vp) * 8192 + toff + hi * 512;
#pragma unroll
    for (int d0 = 0; d0 < 8; ++d0) {
      const bf16x8 A0 = __builtin_shufflevector(vtr(cb + (16 * d0) * 64), vtr(cb + (16 * d0 + 4) * 64), 0, 1, 2, 3, 4, 5, 6, 7);
      o0 = MFMA32(A0, qf[d0], o0);
    }
#pragma unroll
    for (int q = 0; q < 16; ++q) o0[q] *= wq;
    const char* vb = vimg + (wv * 2 + vp) * 4096 + toff + hi * 256;
#pragma unroll
    for (int sx = 0; sx < 4; ++sx) {
      if (sx < 2 || wt) {
        const bf16x8 A0 = __builtin_shufflevector(vtr(vb + (16 * sx) * 64), vtr(vb + (16 * sx + 8) * 64), 0, 1, 2, 3, 4, 5, 6, 7);
        o0 = MFMA32(A0, pf[sx], o0);
      }
    }
#pragma unroll
    for (int g = 0; g < 4; ++g) {
      u32x2 v0;
      v0.x = pk_bf16(o0[4 * g] * inv, o0[4 * g + 1] * inv); v0.y = pk_bf16(o0[4 * g + 2] * inv, o0[4 * g + 3] * inv);
      *(u32x2*)(op + vp * 32 + 8 * g) = v0;
    }
  }
}

__device__ void ph_mlstm_s1(KP p, int layer, char* smc) {
  const int tid = opaque_tid();
  __syncthreads();
  for (int tile = blockIdx.x; tile < NMT; tile += gridDim.x) { mlstm_s1(p, layer, tile, smc, tid); __syncthreads(); }
}

__device__ void ph_rec_final(KP p, int layer, bool keep) {
  const int tid = opaque_tid();
  const int j = layer >> 1;
  const int lane = tid & 63, wave = tid >> 6;
  const int rows = keep ? NT : NL;
  const int c0 = lane * 8;
  auto unpack = [](const u32x4 u, float (&f)[8]) {
    f[0] = bflo(u.x); f[1] = bfhi(u.x); f[2] = bflo(u.y); f[3] = bfhi(u.y);
    f[4] = bflo(u.z); f[5] = bfhi(u.z); f[6] = bflo(u.w); f[7] = bfhi(u.w);
  };
  for (int t = blockIdx.x * 4 + wave; t < rows; t += gridDim.x * 4) {
    const bf16_t* rw = p->RW + (size_t)t * RWS + c0;
    const bf16_t* pt = p->P + (size_t)t * LDP + c0;
    unsigned char* mo = (unsigned char*)p->AB + (size_t)t * DM + c0;
    {
      float yf[8], yb[8], r[8], v[8], k0[8], k1[8], g[8], y[8], o[8];
      unpack(*(const u32x4*)(pt), yf); unpack(*(const u32x4*)(pt + 512), yb);
      unpack(*(const u32x4*)(rw), r); unpack(*(const u32x4*)(rw + 512), v);
      unpack(*(const u32x4*)(rw + 5 * 512), k0); unpack(*(const u32x4*)(rw + 6 * 512), k1);
      unpack(*(const u32x4*)(rw + 9 * 512), g);
      float s1 = 0.f, bs = 0.f;
      const float* rk = p->rwkv_rk + j * 512 + c0;
#pragma unroll
      for (int e = 0; e < 8; ++e) { y[e] = yf[e] + yb[e]; s1 += y[e]; bs += r[e] * rk[e] * (k0[e] + k1[e]); }
      s1 += dppx<0xB1>(s1); s1 += dppx<0x4E>(s1); s1 += dppx<0x141>(s1);
      bs += dppx<0xB1>(bs); bs += dppx<0x4E>(bs); bs += dppx<0x141>(bs);
      const float mu = s1 * (1.f / 64.f);
      float s2 = 0.f;
#pragma unroll
      for (int e = 0; e < 8; ++e) { const float d = y[e] - mu; s2 += d * d; }
      s2 += dppx<0xB1>(s2); s2 += dppx<0x4E>(s2); s2 += dppx<0x141>(s2);
      const float rs = rsqrtf(s2 * (1.f / 64.f) + 64e-5f);
      const float* gn0 = p->rwkv_gn + (j * 2 + 0) * 512 + c0;
      const float* gn1 = p->rwkv_gn + (j * 2 + 1) * 512 + c0;
#pragma unroll
      for (int e = 0; e < 8; ++e) o[e] = ((y[e] - mu) * rs * gn0[e] + gn1[e] + bs * v[e]) * g[e];
      u32x2 ov;
      ov.x = pk_fp8x4c(o[0], o[1], o[2], o[3]); ov.y = pk_fp8x4c(o[4], o[5], o[6], o[7]);
      *(u32x2*)(mo) = ov;
    }
    {
      float hf[8], hb[8], og[8], hsum[8], o[8];
      unpack(*(const u32x4*)(pt + 1024), hf); unpack(*(const u32x4*)(pt + 1536), hb);
      unpack(*(const u32x4*)(pt + 3584), og);
      float ss = 0.f;
#pragma unroll
      for (int e = 0; e < 8; ++e) { hsum[e] = hf[e] + hb[e]; ss += hsum[e] * hsum[e]; }
      ss += dppx<0xB1>(ss); ss += dppx<0x4E>(ss); ss += dppx<0x141>(ss); ss += dppx<0x140>(ss);
      const float rs = rsqrtf(ss * (1.f / 128.f) + 1e-6f);
      const float* ng = p->mlstm_norm + j * 512 + c0;
#pragma unroll
      for (int e = 0; e < 8; ++e) o[e] = hsum[e] * rs * ng[e] * sigm_f(og[e]);
      u32x2 ov;
      ov.x = pk_fp8x4c(o[0], o[1], o[2], o[3]); ov.y = pk_fp8x4c(o[4], o[5], o[6], o[7]);
      *(u32x2*)(mo + 512) = ov;
    }
  }
}

using f32x4v = __attribute__((ext_vector_type(4))) float;
__device__ void ph_ln_router(KP p, int layer, bool keep, char* smc) {
  float* h2s = (float*)smc;
  float* lgs = (float*)smc;
  const int tid = opaque_tid();
  const int lane = tid & 63, wave = tid >> 6;
  const int rows = keep ? NT : NL;
  const float* lng = p->ln_g + (layer * 2 + 0) * 1024;
  const float* lnb = p->ln_b + (layer * 2 + 0) * 1024;
  for (int tile = blockIdx.x; tile < rows / 16; tile += gridDim.x) {
    const int t0 = tile * 16;
    const float* mod = p->MOD + (layer * 9 + modrow(t0)) * 6144;
    const float* brow = p->WrT + ((size_t)layer * 64 + 16 * wave + (lane & 15)) * 1024 + 4 * (lane >> 4);
    f32x4v b0[8], b1[8], b2[8];
#pragma unroll
    for (int q = 0; q < 8; ++q) { b0[q] = *(const f32x4v*)(brow + 16 * q); b1[q] = *(const f32x4v*)(brow + 16 * (8 + q)); }
    __builtin_amdgcn_sched_barrier(0);
    {
      float4 v[4][4];
      float s4[4];
#pragma unroll
      for (int q = 0; q < 4; ++q) {
        const int t = t0 + wave * 4 + q;
        s4[q] = 0.f;
#pragma unroll
        for (int i = 0; i < 4; ++i) {
          const u32x2 tb = *(const u32x2*)((const bf16_t*)p->Tb + (size_t)t * DM + i * 256 + lane * 4);
          v[q][i] = make_float4(bflo(tb.x), bfhi(tb.x), bflo(tb.y), bfhi(tb.y));
        }
      }
#pragma unroll
      for (int q = 0; q < 4; ++q)
#pragma unroll
        for (int i = 0; i < 4; ++i) s4[q] += (v[q][i].x + v[q][i].y) + (v[q][i].z + v[q][i].w);
      float mean4[4], rs4[4];
#pragma unroll
      for (int q = 0; q < 4; ++q) mean4[q] = wsum(s4[q]) * (1.f / 1024.f);
#pragma unroll
      for (int q = 0; q < 4; ++q) {
        float qq = 0.f;
#pragma unroll
        for (int i = 0; i < 4; ++i) {
          const float d0 = v[q][i].x - mean4[q], d1 = v[q][i].y - mean4[q], d2 = v[q][i].z - mean4[q], d3 = v[q][i].w - mean4[q];
          qq += (d0 * d0 + d1 * d1) + (d2 * d2 + d3 * d3);
        }
        s4[q] = qq;
      }
#pragma unroll
      for (int q = 0; q < 4; ++q) rs4[q] = rsqrtf(wsum(s4[q]) * (1.f / 1024.f) + 1e-5f);
#pragma unroll
      for (int i = 0; i < 4; ++i) {
        const int n = i * 256 + lane * 4;
        const float4 g = *(const float4*)(lng + n), bb = *(const float4*)(lnb + n);
        const float4 sc = *(const float4*)(mod + 4096 + n), sh = *(const float4*)(mod + 3072 + n);
#pragma unroll
        for (int q = 0; q < 4; ++q) {
          const int tl = wave * 4 + q, t = t0 + tl;
          const float mean = mean4[q], rs = rs4[q];
          const float4 xn = make_float4((v[q][i].x - mean) * rs * g.x + bb.x, (v[q][i].y - mean) * rs * g.y + bb.y,
                                        (v[q][i].z - mean) * rs * g.z + bb.z, (v[q][i].w - mean) * rs * g.w + bb.w);
          { u32x2 xo2; xo2.x = pk_bf16(xn.x, xn.y); xo2.y = pk_bf16(xn.z, xn.w); *(u32x2*)((bf16_t*)p->X + (size_t)t * DM + n) = xo2; }
          const float4 hh = make_float4(xn.x * (1.f + sc.x) + sh.x, xn.y * (1.f + sc.y) + sh.y,
                                        xn.z * (1.f + sc.z) + sh.z, xn.w * (1.f + sc.w) + sh.w);
          *(unsigned*)((unsigned char*)p->AB + (size_t)t * DM + n) = pk_fp8x4c(hh.x, hh.y, hh.z, hh.w);
          *(float4*)(h2s + tl * 1028 + n) = hh;
        }
      }
    }
    __syncthreads();
    f32x4v acc = {0.f, 0.f, 0.f, 0.f};
    {
      f32x4v a1 = {0.f, 0.f, 0.f, 0.f}, a2 = {0.f, 0.f, 0.f, 0.f}, a3 = {0.f, 0.f, 0.f, 0.f};
      const int i = lane & 15, kk = lane >> 4;
      const float* arow = h2s + i * 1028 + 4 * kk;
#define ROUTER_LOAD(B, Q0) _Pragma("unroll") for (int q = 0; q < 8; ++q) B[q] = *(const f32x4v*)(brow + 16 * ((Q0) + q)); __builtin_amdgcn_sched_barrier(0);
#define ROUTER_MFMA(B, Q0) _Pragma("unroll") for (int q = 0; q < 8; ++q) { \
        const float4 a = *(const float4*)(arow + 16 * ((Q0) + q)); \
        acc = __builtin_amdgcn_mfma_f32_16x16x4f32(a.x, B[q].x, acc, 0, 0, 0); \
        a1 = __builtin_amdgcn_mfma_f32_16x16x4f32(a.y, B[q].y, a1, 0, 0, 0); \
        a2 = __builtin_amdgcn_mfma_f32_16x16x4f32(a.z, B[q].z, a2, 0, 0, 0); \
        a3 = __builtin_amdgcn_mfma_f32_16x16x4f32(a.w, B[q].w, a3, 0, 0, 0); } __builtin_amdgcn_sched_barrier(0);
      ROUTER_LOAD(b2, 16) ROUTER_MFMA(b0, 0)
      ROUTER_LOAD(b0, 24) ROUTER_MFMA(b1, 8)
      ROUTER_LOAD(b1, 32) ROUTER_MFMA(b2, 16)
      ROUTER_LOAD(b2, 40) ROUTER_MFMA(b0, 24)
      ROUTER_LOAD(b0, 48) ROUTER_MFMA(b1, 32)
      ROUTER_LOAD(b1, 56) ROUTER_MFMA(b2, 40)
      ROUTER_MFMA(b0, 48)
      ROUTER_MFMA(b1, 56)
      acc = (acc + a1) + (a2 + a3);
    }
    __syncthreads();
#pragma unroll
    for (int r = 0; r < 4; ++r) lgs[((lane >> 4) * 4 + r) * 64 + 16 * wave + (lane & 15)] = acc[r];
    __syncthreads();
    {
      float score4[4], gate4[4];
      int kidx4[4], pos4[4];
      bool chosen4[4];
#pragma unroll
      for (int q = 0; q < 4; ++q) {
        const int tl = wave * 4 + q;
        const float logit = lgs[tl * 64 + lane];
        const float score = sigm_f(logit);
        float sel = score + p->moe_bias[layer * 64 + lane];
        bool chosen = false;
        for (int r = 0; r < 6; ++r) {
          const float mx = wmax(sel);
          const unsigned long long bal = __ballot(sel == mx);
          const int first = __ffsll((long long)bal) - 1;
          if (lane == first) { chosen = true; sel = -INFINITY; }
        }
        const float gsum = wsum(chosen ? score : 0.f);
        const unsigned long long cb = __ballot(chosen);
        score4[q] = score; gate4[q] = score / gsum * 2.5f; chosen4[q] = chosen;
        kidx4[q] = __popcll(cb & ((1ull << lane) - 1ull));
      }
#pragma unroll
      for (int q = 0; q < 4; ++q) pos4[q] = chosen4[q] ? atomicAdd(&p->cnt[lane * CSTR], 1) : 0;
#pragma unroll
      for (int q = 0; q < 4; ++q) {
        const int t = t0 + wave * 4 + q;
        if (chosen4[q]) {
          p->ltok[(size_t)lane * NT + pos4[q]] = t;
          p->lgate[(size_t)lane * NT + pos4[q]] = gate4[q];
          p->tsl[t * 6 + kidx4[q]] = (lane << 16) | pos4[q];
        }
      }
    }
    __syncthreads();
  }
}

__device__ __forceinline__ void moe_prefix(KP p, int rows, int* s_pref, int tid) {
  if (tid < 64) s_pref[322 + tid] = p->cnt[tid * CSTR];
  __syncthreads();
  if (tid == 0) {
    int a = 0;
    for (int e = 0; e < 64; ++e) { s_pref[e] = a; a += (s_pref[322 + e] + 127) >> 7; }
    s_pref[64] = a; a += rows >> 7;
    s_pref[65] = a;
  }
  __syncthreads();
}

__device__ void ph_gemm(KP p, int kind, int layer, bool keep, char* lds) {
  const int tid = opaque_tid();
  const int j = layer >> 1;
  const bool att = !(layer & 1);
  const int rows = keep ? NT : NL;
  int* pref = (int*)(lds + META_OFF);
  int* s_idx = pref + 66;
  float* s_gate = (float*)(s_idx + 128);
  if (kind == 1 && blockIdx.x == 0 && tid < 65) p->cnt[tid * CSTR] = 0;
  int total;
  const int ntn_in = att ? 18 : 33;
  switch (kind) {
    case 0: total = (NT / 128) * ntn_in; break;
    case 1: total = (rows / 128) * 8; break;
    case 2: total = pref[65] * 4; break;
    case 3: total = pref[65] * 8; break;
    case 4: total = (NT / 128) * 3; break;
    default: total = (NT / 128) * 20; break;
  }
  const bool moe = kind == 2 || kind == 3;
  const int tsh = kind == 2 ? 2 : 3;
  int e_nx = 0, idx_nx = tid; float g_nx = 1.f;
  auto fetch_moe = [&](int tl) {
    const int mt = tl >> tsh;
    while (mt >= pref[e_nx + 1]) ++e_nx;
    idx_nx = tid; g_nx = 1.f;
    if (tid < 128) {
      const int pos = (mt - pref[e_nx]) * 128 + tid;
      if (kind == 2) {
        idx_nx = 0;
        if (e_nx < 64) { if (pos < pref[322 + e_nx]) idx_nx = p->ltok[(size_t)e_nx * NT + pos]; }
        else idx_nx = pos;
      } else if (e_nx < 64) g_nx = pos < pref[322 + e_nx] ? p->lgate[(size_t)e_nx * NT + pos] : 0.f;
    }
  };
  const int xcd = blockIdx.x & 7, lb = blockIdx.x >> 3, nbx = ((int)gridDim.x - xcd + 7) >> 3;
  const int t_beg = (int)(((long long)total * xcd) >> 3), t_end = (int)(((long long)total * (xcd + 1)) >> 3);
  if (moe && t_beg + lb < t_end) fetch_moe(t_beg + lb);
  for (int tile = t_beg + lb; tile < t_end; tile += nbx) {
    const bf16_t* Abase; const bf16_t* Bt;
    int astride, K, n0, m0 = 0, aux = 0, e = e_nx, mtile = 0;
    switch (kind) {
      case 0: { const int tm = tile / ntn_in, tn = tile % ntn_in; m0 = tm * 128; n0 = tn * 128;
                Abase = (const bf16_t*)((const unsigned char*)p->AB + (size_t)m0 * DM); astride = DM; K = 1024;
                Bt = (const bf16_t*)(att ? (const unsigned char*)p->Wt_att + (size_t)j * ATT_N * 1024
                                         : (const unsigned char*)p->Wt_rec + (size_t)j * REC_NP * 1024); } break;
      case 1: { const int tm = tile >> 3, tn = tile & 7; m0 = tm * 128; n0 = tn * 128;
                Abase = (const bf16_t*)((const unsigned char*)p->AB + (size_t)m0 * DM); astride = DM; K = 1024;
                Bt = (const bf16_t*)((const unsigned char*)p->Wt_out + (size_t)layer * 1024 * 1024); } break;
      case 2: { mtile = tile >> 2; aux = tile & 3; n0 = aux * 128;
                Abase = p->AB; astride = DM; K = 1024;
                Bt = (const bf16_t*)((const unsigned char*)p->Wt13 + (size_t)(layer * 65 + e) * 512 * 1024); } break;
      case 3: { mtile = tile >> 3; aux = tile & 7; n0 = aux * 128;
                Abase = (const bf16_t*)((const unsigned char*)p->ACT + (size_t)mtile * 128 * 256); astride = 256; K = 256;
                Bt = (const bf16_t*)((const unsigned char*)p->Wt2 + (size_t)(layer * 65 + e) * 1024 * 256); } break;
      case 4: { const int tm = tile / 3; aux = tile % 3; m0 = tm * 128; n0 = 0;
                Abase = p->Zb + (size_t)m0 * 1536 + aux * 512; astride = 1536; K = 512; Bt = p->Wl1 + (size_t)(j * 3 + aux) * 128 * 512; } break;
      default: { const int tm = tile / 20; aux = tile % 20; m0 = tm * 128; n0 = aux * 128;
                const int grp = aux < 8 ? 0 : (aux < 16 ? 1 : 2);
                Abase = p->L1 + (size_t)m0 * 384 + grp * 128; astride = 384; K = 128; Bt = p->Wl2 + (size_t)j * 2560 * 128; } break;
    }
    if (tid < 128) { s_idx[tid] = idx_nx; s_gate[tid] = g_nx; }
    __syncthreads();
    if (moe && tile + nbx < t_end) fetch_moe(tile + nbx);
    {
      f32x16 acc[2][2];
      if (kind <= 3) {
        const unsigned char* A8 = (const unsigned char*)Abase;
        gemm128_fp8(tid, [&](int r) { return A8 + (size_t)s_idx[r] * astride; }, (const unsigned char*)Bt, K, n0, lds, acc);
      } else
        gemm128_main(tid, [&](int r) { return Abase + (size_t)s_idx[r] * astride; }, Bt, K, n0, lds, acc);
      float* Ct = (float*)lds;
      acc_foreach(tid, acc, [&](int row, int col, float v) { Ct[row * 128 + col] = v; });
    }
    __syncthreads();
    {
      const float* Ct = (const float*)lds;
      int c4 = (tid & 31) * 4, r0 = tid >> 5;
      asm volatile("" : "+v"(c4), "+v"(r0));
      const int N_in = att ? ATT_N : REC_N;
      const int d5 = (aux >> 2) & 1, c05 = (aux & 3) * 128;
      switch (kind) {
        case 0: {
#pragma unroll 8
          for (int it = 0; it < 16; ++it) {
            const int row = it * 8 + r0;
            const float4 vraw = *(const float4*)(Ct + row * 128 + c4);
            const float4 v = make_float4(vraw.x * W8_INV, vraw.y * W8_INV, vraw.z * W8_INV, vraw.w * W8_INV);

            const int cn = n0 + c4;
            float4 vq = v;
            if (att && n0 >= 1536 && n0 < 2176) {
              float ss = v.x * v.x + v.y * v.y + v.z * v.z + v.w * v.w;
              ss += dppx<0xB1>(ss); ss += dppx<0x4E>(ss); ss += dppx<0x141>(ss); ss += dppx<0x140>(ss);
              const float rs = rsqrtf(ss * (1.f / 64.f) + 1e-6f);
              const float4 g = *(const float4*)(p->qk_gain + j * 128 + (n0 >= 2048 ? 64 : 0) + (cn & 63));
              vq = make_float4(v.x * rs * g.x, v.y * rs * g.y, v.z * rs * g.z, v.w * rs * g.w);
              const int t = m0 + row;
              if (t < NL) {
                const int sidx = t & 2047, pi0 = (cn & 63) >> 1;
                const int pos = pi0 < 16 ? (sidx >> 6) : (sidx & 63);
                const float4 cs = *(const float4*)(p->ROPE + (pos * 16 + (pi0 & 15)) * 2);
                vq = make_float4(vq.x * cs.x - vq.y * cs.y, vq.x * cs.y + vq.y * cs.x,
                                 vq.z * cs.z - vq.w * cs.w, vq.z * cs.w + vq.w * cs.z);
              }
            }
            if (cn < N_in) {
              u32x2 o; o.x = pk_bf16(vq.x, vq.y); o.y = pk_bf16(vq.z, vq.w);
              *(u32x2*)(p->P + (size_t)(m0 + row) * LDP + cn) = o;
            }
            if (!att && cn >= 4096 && cn < 4112) *(float4*)(p->GP + (size_t)(m0 + row) * 16 + (cn - 4096)) = v;
          }
        } break;
        case 1: {
#pragma unroll 16
          for (int it = 0; it < 16; ++it) {
            const int row = it * 8 + r0;
            const float4 v = *(const float4*)(Ct + row * 128 + c4);

            const size_t o = (size_t)(m0 + row) * DM + n0 + c4;
            const u32x2 xr = *(const u32x2*)((const bf16_t*)p->X + o);
            const float4 xv = make_float4(bflo(xr.x), bfhi(xr.x), bflo(xr.y), bfhi(xr.y));
            const float4 g = *(const float4*)(p->MOD + (layer * 9 + modrow(m0)) * 6144 + 2048 + n0 + c4);
            u32x2 tb;
            tb.x = pk_bf16(DN_ALPHA * xv.x + g.x * (v.x * W8_INV), DN_ALPHA * xv.y + g.y * (v.y * W8_INV));
            tb.y = pk_bf16(DN_ALPHA * xv.z + g.z * (v.z * W8_INV), DN_ALPHA * xv.w + g.w * (v.w * W8_INV));
            *(u32x2*)((bf16_t*)p->Tb + o) = tb;
          }
        } break;
        case 2: {
#pragma unroll 8
          for (int it = 0; it < 16; ++it) {
            const int row = it * 8 + r0;
            const float4 v = *(const float4*)(Ct + row * 128 + c4);

            if (((c4 >> 5) & 1) == 0) {
              const float4 u = *(const float4*)(Ct + row * 128 + c4 + 32);
              const float a0 = v.x * W8_INV, a1 = v.y * W8_INV, a2 = v.z * W8_INV, a3 = v.w * W8_INV;
              *(unsigned*)((unsigned char*)p->ACT + ((size_t)mtile * 128 + row) * 256 + aux * 64 + (c4 >> 6) * 32 + (c4 & 31)) =
                  pk_fp8x4c(silu_f(a0) * (u.x * W8_INV), silu_f(a1) * (u.y * W8_INV), silu_f(a2) * (u.z * W8_INV), silu_f(a3) * (u.w * W8_INV));
            }
          }
        } break;
        case 3: {
#pragma unroll 16
          for (int it = 0; it < 16; ++it) {
            const int row = it * 8 + r0;
            const float4 v = *(const float4*)(Ct + row * 128 + c4);

            const float g = s_gate[row] * (W8_INV * 16.f);
            *(unsigned*)((unsigned char*)p->OUT2 + ((size_t)mtile * 128 + row) * 1024 + n0 + c4) = pk_fp8x4c(g * v.x, g * v.y, g * v.z, g * v.w);
          }
        } break;
        case 4: {
#pragma unroll 4
          for (int it = 0; it < 16; ++it) {
            const int row = it * 8 + r0;
            const float4 v = *(const float4*)(Ct + row * 128 + c4);

            float4 o4 = v;
            if (aux == 0) o4 = make_float4(tanhf(v.x), tanhf(v.y), tanhf(v.z), tanhf(v.w));
            else if (aux == 2) o4 = make_float4(sigm_f(v.x), sigm_f(v.y), sigm_f(v.z), sigm_f(v.w));
            u32x2 o; o.x = pk_bf16(o4.x, o4.y); o.y = pk_bf16(o4.z, o4.w);
            *(u32x2*)(p->L1 + (size_t)(m0 + row) * 384 + aux * 128 + c4) = o;
          }
        } break;
        default: {
#pragma unroll 4
          for (int it = 0; it < 16; ++it) {
            const int row = it * 8 + r0;
            const float4 v = *(const float4*)(Ct + row * 128 + c4);

            bf16_t* rr = p->RW + (size_t)(m0 + row) * RWS + c05 + c4;
            const float vv[4] = {v.x, v.y, v.z, v.w};
            if (aux < 8) {
              const float4 b0 = *(const float4*)(p->rwkv_w0 + (j * 2 + d5) * 512 + c05 + c4);
              const float bb[4] = {b0.x, b0.y, b0.z, b0.w};
              float e4[4];
#pragma unroll
              for (int q = 0; q < 4; ++q) e4[q] = expf(-softplus_f(-(bb[q] + vv[q])) - 0.5f);
              u32x2 o; o.x = pk_bf16(e4[0], e4[1]); o.y = pk_bf16(e4[2], e4[3]);
              *(u32x2*)(rr + (3 + d5) * 512) = o;
            } else if (aux < 16) {
              const float4 b0 = *(const float4*)(p->rwkv_a0 + (j * 2 + d5) * 512 + c05 + c4);
              const float4 k1 = *(const float4*)(p->rwkv_kvec + (j * 2 + 1) * 512 + c05 + c4);
              const u32x2 kx2 = *(const u32x2*)(rr + 10 * 512);
              const float bb[4] = {b0.x, b0.y, b0.z, b0.w}, kk1[4] = {k1.x, k1.y, k1.z, k1.w};
              const float kx[4] = {bflo(kx2.x), bfhi(kx2.x), bflo(kx2.y), bfhi(kx2.y)};
              float av[4], ke[4];
#pragma unroll
              for (int q = 0; q < 4; ++q) { av[q] = sigm_f(bb[q] + vv[q]); ke[q] = kx[q] * (1.f + (av[q] - 1.f) * kk1[q]); }
              u32x2 o; o.x = pk_bf16(av[0], av[1]); o.y = pk_bf16(av[2], av[3]);
              *(u32x2*)(rr + (7 + d5) * 512) = o;
              o.x = pk_bf16(ke[0], ke[1]); o.y = pk_bf16(ke[2], ke[3]);
              *(u32x2*)(rr + (5 + d5) * 512) = o;
            } else {
              u32x2 o; o.x = pk_bf16(v.x, v.y); o.y = pk_bf16(v.z, v.w);
              *(u32x2*)(rr + 9 * 512) = o;
            }
          }
        } break;
      }
    }
    __syncthreads();
  }
}

__device__ void ph_final_ln(KP p, int layer, bool keep, char* lds) {
  const int tid = opaque_tid();
  const int lane = tid & 63, wave = tid >> 6;
  const int rows = keep ? NT : NL;
  int* s_base = (int*)(lds + META_OFF);
  if (tid == 0) {
    int a = 0;
#pragma unroll 1
    for (int e = 0; e < 64; ++e) { s_base[e] = a * 128; a += (p->cnt[e * CSTR] + 127) >> 7; }
    s_base[64] = a * 128;
  }
  __syncthreads();
  const float* lng = p->ln_g + (layer * 2 + 1) * 1024;
  const float* lnb = p->ln_b + (layer * 2 + 1) * 1024;
  for (int t = blockIdx.x * 4 + wave; t < rows; t += gridDim.x * 4) {
    const int mr = modrow(t);
    const float* g2 = p->MOD + (layer * 9 + mr) * 6144 + 5120;
    const unsigned char* src[7];
#pragma unroll
    for (int k = 0; k < 6; ++k) {
      const int v = p->tsl[t * 6 + k];
      src[k] = (const unsigned char*)p->OUT2 + (size_t)(s_base[v >> 16] + (v & 0xffff)) * 1024;
    }
    src[6] = (const unsigned char*)p->OUT2 + (size_t)(s_base[64] + t) * 1024;
    float v[16];
    float s = 0.f;
#pragma unroll
    for (int c = 0; c < 2; ++c) {
      const int n0 = c * 512 + lane * 8;
      float y[8];
#pragma unroll
      for (int q = 0; q < 8; ++q) y[q] = 0.f;
#pragma unroll
      for (int k = 0; k < 7; ++k) {
        const u32x2 u = *(const u32x2*)(src[k] + n0);
        const auto f0 = __builtin_amdgcn_cvt_pk_f32_fp8((int)u.x, false), f1 = __builtin_amdgcn_cvt_pk_f32_fp8((int)u.x, true);
        const auto f2 = __builtin_amdgcn_cvt_pk_f32_fp8((int)u.y, false), f3 = __builtin_amdgcn_cvt_pk_f32_fp8((int)u.y, true);
        y[0] += f0[0]; y[1] += f0[1]; y[2] += f1[0]; y[3] += f1[1];
        y[4] += f2[0]; y[5] += f2[1]; y[6] += f3[0]; y[7] += f3[1];
      }
      const u32x4 xr = *(const u32x4*)((const bf16_t*)p->X + (size_t)t * DM + n0);
      const float4 xa = make_float4(bflo(xr.x), bfhi(xr.x), bflo(xr.y), bfhi(xr.y)), xb = make_float4(bflo(xr.z), bfhi(xr.z), bflo(xr.w), bfhi(xr.w));
      const float4 ga = *(const float4*)(g2 + n0), gb = *(const float4*)(g2 + n0 + 4);
      const float xx[8] = {xa.x, xa.y, xa.z, xa.w, xb.x, xb.y, xb.z, xb.w};
      const float gg[8] = {ga.x, ga.y, ga.z, ga.w, gb.x, gb.y, gb.z, gb.w};
#pragma unroll
      for (int q = 0; q < 8; ++q) { v[c * 8 + q] = DN_ALPHA * xx[q] + gg[q] * (y[q] * 0.0625f); s += v[c * 8 + q]; }
    }
    const float mean = wsum(s) * (1.f / 1024.f);
    float q2 = 0.f;
#pragma unroll
    for (int i = 0; i < 16; ++i) { const float d = v[i] - mean; q2 += d * d; }
    const float rs = rsqrtf(wsum(q2) * (1.f / 1024.f) + 1e-5f);
    const float* modn = p->MOD + ((layer + 1) * 9 + mr) * 6144;
#pragma unroll
    for (int c = 0; c < 2; ++c) {
      const int n0 = c * 512 + lane * 8;
      float xn[8];
#pragma unroll
      for (int q = 0; q < 8; ++q) xn[q] = (v[c * 8 + q] - mean) * rs * lng[n0 + q] + lnb[n0 + q];
      if (layer == 3) {
        float* xo = p->out + (size_t)t * DM + n0;
        *(float4*)(xo) = make_float4(xn[0], xn[1], xn[2], xn[3]);
        *(float4*)(xo + 4) = make_float4(xn[4], xn[5], xn[6], xn[7]);
      } else {
        u32x4 xo4;
        xo4.x = pk_bf16(xn[0], xn[1]); xo4.y = pk_bf16(xn[2], xn[3]); xo4.z = pk_bf16(xn[4], xn[5]); xo4.w = pk_bf16(xn[6], xn[7]);
        *(u32x4*)((bf16_t*)p->X + (size_t)t * DM + n0) = xo4;
      }
      if (layer != 3) {
        float hb[8];
#pragma unroll
        for (int q = 0; q < 8; ++q) hb[q] = xn[q] * (1.f + modn[1024 + n0 + q]) + modn[n0 + q];
        u32x2 o;
        o.x = pk_fp8x4c(hb[0], hb[1], hb[2], hb[3]); o.y = pk_fp8x4c(hb[4], hb[5], hb[6], hb[7]);
        *(u32x2*)((unsigned char*)p->AB + (size_t)t * DM + n0) = o;
      }
    }
  }
}

#define XB_TMO      128
#define XB_XCNT(j)  (256  + 64 * (j))
#define XB_XSUB(j)  (1280 + 64 * (j))
#define XB_XGEN(j)  (2304 + 64 * (j))
#define XB_TOP      3328
#define XB_TOPGEN   3392
#define XB_SPIN_CAP (1u << 20)
#define LAS __attribute__((address_space(3)))
__device__ __forceinline__ unsigned xb_ld(unsigned* p) { return __hip_atomic_load(p, __ATOMIC_RELAXED, __HIP_MEMORY_SCOPE_AGENT); }
__device__ __forceinline__ unsigned xb_add(unsigned* p, unsigned v) { return __hip_atomic_fetch_add(p, v, __ATOMIC_RELAXED, __HIP_MEMORY_SCOPE_AGENT); }
__device__ __forceinline__ unsigned xb_xcc_id() { return (unsigned)__builtin_amdgcn_s_getreg((3 << 11) | 20) & 0xFu; }
#define XB_SPIN(cond, bar) do { unsigned _sp = 0; while (cond) { __builtin_amdgcn_s_sleep(1); \
    if ((++_sp & 255u) == 0u) { if (xb_ld(&(bar)[XB_TMO])) break; if (_sp > XB_SPIN_CAP) { atomicAdd(&(bar)[XB_TMO], 1u); break; } } } } while (0)
struct XcdBarrier { unsigned* bar; unsigned x; volatile LAS unsigned* st; };
__device__ __forceinline__ XcdBarrier xcd_barrier_post(unsigned* bar, volatile LAS unsigned* st) {
  XcdBarrier b; b.bar = bar; b.x = xb_xcc_id(); b.st = st;
  if (threadIdx.x == 0) (void)xb_add(&bar[XB_XCNT(b.x)], 1u);
  return b;
}
__device__ __forceinline__ void xcd_barrier_complete(unsigned* bar, unsigned x, unsigned& nloc, unsigned& nx) {
  const unsigned G = gridDim.x;
  unsigned sum, cnt, mine, sp = 0u;
  for (;;) {
    sum = 0u; cnt = 0u; mine = 0u;
#pragma unroll
    for (unsigned j = 0; j < 16; ++j) { const unsigned c = xb_ld(&bar[XB_XCNT(j)]); sum += c; cnt += (c > 0u) ? 1u : 0u; mine = (j == x) ? c : mine; }
    if (sum == G) break;
    __builtin_amdgcn_s_sleep(1);
    if ((++sp & 255u) == 0u) { if (xb_ld(&bar[XB_TMO])) break; if (sp > XB_SPIN_CAP) { atomicAdd(&bar[XB_TMO], 1u); break; } }
  }
  nloc = mine > 0u ? mine : 1u; nx = cnt > 0u ? cnt : 1u;
}
__device__ __forceinline__ void xcd_barrier(const XcdBarrier& b) {
  asm volatile("s_waitcnt vmcnt(0)" ::: "memory");
  __syncthreads();
  if (threadIdx.x == 0) {
    unsigned* bar = b.bar;
    __builtin_amdgcn_s_waitcnt(0);
    unsigned nloc = b.st[0], nx = b.st[1];
    if (nloc == 0u) { xcd_barrier_complete(bar, b.x, nloc, nx); b.st[0] = nloc; b.st[1] = nx; }
    const unsigned old = xb_add(&bar[XB_XSUB(b.x)], 1u);
    const unsigned gen = old / nloc;
    if (old + 1u == (gen + 1u) * nloc) {
      __builtin_amdgcn_fence(__ATOMIC_RELEASE, "agent");
      asm volatile("s_waitcnt vmcnt(0)" ::: "memory");
      const unsigned og = xb_add(&bar[XB_TOP], 1u);
      const unsigned tg = og / nx;
      if (og + 1u == (tg + 1u) * nx) xb_add(&bar[XB_TOPGEN], 1u);
      else XB_SPIN(xb_ld(&bar[XB_TOPGEN]) == tg, bar);
      __builtin_amdgcn_fence(__ATOMIC_ACQUIRE, "agent");
      xb_add(&bar[XB_XGEN(b.x)], 1u);
      asm volatile("s_waitcnt vmcnt(0)" ::: "memory");
    } else {
      XB_SPIN(xb_ld(&bar[XB_XGEN(b.x)]) == gen, bar);
      __builtin_amdgcn_fence(__ATOMIC_ACQUIRE, "agent");
      asm volatile("s_waitcnt vmcnt(0)" ::: "memory");
    }
  }
  __syncthreads();
}

constexpr int NSLOTS = 13;
constexpr int NPHASE = 2 + 4 * NSLOTS;
__device__ __forceinline__ bool phase_is_nop(int ph) {
  if (ph < 2) return false;
  const int layer = (ph - 2) / NSLOTS, st = (ph - 2) % NSLOTS;
  if (st == 5 || st == 6) return true;
  return !(layer & 1) && (st == 1 || (st >= 3 && st <= 7));
}
__device__ void run_phase(KP p, int ph, char* sm) {
  if (ph == 0) { ph_init(p, sm); return; }
  if (ph == 1) { ph_mod_h(p, sm); return; }
  const int layer = (ph - 2) / NSLOTS, st = (ph - 2) % NSLOTS;
  const bool odd = layer & 1;
  const bool keep = layer < 3;
  int gk = -1;
  if (st == 0) gk = 0;
  else if (st == 8) gk = 1;
  else if (st == 10) gk = 2;
  else if (st == 11) gk = 3;
  else if (odd && st == 2) gk = 4;
  else if (odd && st == 3) gk = 5;
  asm volatile("" : "+s"(gk));
  if (gk >= 0) {
    if (gk == 2 || gk == 3) moe_prefix(p, keep ? NT : NL, (int*)(sm + META_OFF), opaque_tid());
    ph_gemm(p, gk, layer, keep, sm);
    if (gk == 5) { __syncthreads(); ph_mlstm_s2(p, sm); }
    return;
  }
  switch (st) {
    case 1: if (odd) { ph_rwkv_mix(p, layer); ph_mlstm_s1(p, layer, sm); } break;
    case 2: ph_attention(p, layer, keep, sm); break;
    case 4: if (odd) ph_scan_a(p, layer, sm); break;
    case 7: if (odd) ph_rec_final(p, layer, keep); break;
    case 9: ph_ln_router(p, layer, keep, sm); break;
    case 12: ph_final_ln(p, layer, keep, sm); break;
  }
}

__global__ void __launch_bounds__(NTHR, 2) mega_kernel(Params kargs) {
  extern __shared__ __attribute__((aligned(16))) char sm[];
  cg::grid_group grid = cg::this_grid();
  volatile LAS unsigned* st = (volatile LAS unsigned*)(sm + META_OFF + 4032);
  if (threadIdx.x == 0) { st[0] = 0u; st[1] = 0u; }
  __syncthreads();
  const XcdBarrier xb = xcd_barrier_post(kargs.bar, st);
  for (int ph = kargs.ph_lo; ph < kargs.ph_hi; ++ph) {
    if (phase_is_nop(ph)) continue;
    {
      KP kp = (KP)__builtin_amdgcn_kernarg_segment_ptr();
      asm volatile("" : "+s"(kp));
      run_phase(kp, ph, sm);
    }
    if (ph + 1 < kargs.ph_hi) {
      if (ph == 0) grid.sync();
      else xcd_barrier(xb);
    }
  }
}

extern "C" void kernel_launch(void* const* d_in, const int* in_sizes, int n_in, void* d_out, int out_size, void* d_ws,
                              size_t ws_size, hipStream_t stream) {
  static int grid_blocks = 0;
  if (!grid_blocks) {
    int dev = 0, cus = 0, per_cu = 0;
    (void)hipGetDevice(&dev);
    (void)hipDeviceGetAttribute(&cus, hipDeviceAttributeMultiprocessorCount, dev);
    (void)hipFuncSetAttribute((const void*)mega_kernel, hipFuncAttributeMaxDynamicSharedMemorySize, SMEM_BYTES);
    (void)hipOccupancyMaxActiveBlocksPerMultiprocessor(&per_cu, mega_kernel, NTHR, SMEM_BYTES);
    if (per_cu < 1) per_cu = 1;
    if (per_cu > 2) per_cu = 2;
    grid_blocks = cus * per_cu;
  }
  Params p;
  memset(&p, 0, sizeof(p));
  const float** pin = (const float**)&p;
  for (int i = 0; i < 35; ++i) pin[i] = (const float*)d_in[i];
  p.out = (float*)d_out;
  char* w = (char*)d_ws;
  size_t off = 0;
  auto take = [&](size_t bytes) { char* r = w + off; off += (bytes + 255) & ~(size_t)255; return r; };
  p.Wt_att = (bf16_t*)take((size_t)2 * ATT_N * 1024 * 2);
  p.Wt_rec = (bf16_t*)take((size_t)2 * REC_NP * 1024 * 2);
  p.Wt_out = (bf16_t*)take((size_t)4 * 1024 * 1024 * 2);
  p.Wt13 = (bf16_t*)take((size_t)4 * 65 * 512 * 1024);
  p.Wt2 = (bf16_t*)take((size_t)4 * 65 * 1024 * 256);
  p.Wl1 = (bf16_t*)take((size_t)2 * 3 * 128 * 512 * 2);
  p.Wl2 = (bf16_t*)take((size_t)2 * 2560 * 128 * 2);
  p.X = (float*)take((size_t)NT * DM * 4);
  p.AB = (bf16_t*)take((size_t)NT * DM * 2);
  p.MOD = (float*)take((size_t)5 * 9 * 6144 * 4);
  p.MODP = (float*)take((size_t)8 * 4 * 9 * 6144 * 4);
  p.GP = (float*)take((size_t)NT * 16 * 4);
  p.ROPE = (float*)take((size_t)64 * 16 * 2 * 4);
  p.WrT = (float*)take((size_t)4 * 64 * 1024 * 4);
  p.msc = (float*)take((size_t)3 * NMT * 4);
  p.lgate = (float*)take((size_t)64 * NT * 4);
  p.ltok = (int*)take((size_t)64 * NT * 4);
  p.tsl = (int*)take((size_t)NT * 6 * 4);
  p.cnt = (int*)take((size_t)65 * CSTR * 4);
  p.bar = (unsigned*)take((size_t)BAR_TOTAL_WORDS * 4);
  char* region = take(0);
  const size_t szP = (size_t)NT * LDP * 2, szRW = (size_t)NT * RWS * 2, szMS = (size_t)NMT * 16384 * 2,
               szMSn = (size_t)NMT * 128 * 4;
  const size_t szT = (size_t)NT * DM * 4, szOUT2 = (size_t)NSLOT * 1024 * 2;
  p.P = (bf16_t*)region;
  p.RW = (bf16_t*)(region + szP);
  p.MS = (bf16_t*)(region + szP + szRW);
  p.MSn = (float*)(region + szP + szRW + szMS);
  p.Tb = (float*)region;
  p.ACT = (bf16_t*)region;
  p.OUT2 = (bf16_t*)(region + szT);
  const size_t szZ = (size_t)NT * 2048 * 2;
  p.Zb = (bf16_t*)(region + szP + szRW + szMS + szMSn);
  p.L1 = p.Zb + (size_t)NT * 1536;
  size_t mixer = szP + szRW + szMS + szMSn + szZ, moe = szT + szOUT2;
  off += (mixer > moe ? mixer : moe);
  if (off > ws_size) { fprintf(stderr, "workspace too small: need %zu have %zu\n", off, ws_size); return; }
  p.ph_lo = 0;
  p.ph_hi = NPHASE;
  (void)hipMemsetAsync(p.bar, 0, (size_t)BAR_TOTAL_WORDS * 4, stream);
  void* args[] = {&p};
  hipError_t e = hipLaunchCooperativeKernel((void*)mega_kernel, dim3(grid_blocks), dim3(NTHR), args, SMEM_BYTES, stream);
  if (e != hipSuccess) fprintf(stderr, "cooperative launch failed: %s (grid %d)\n", hipGetErrorString(e), grid_blocks);
}
```

```cpp
#include <hip/hip_runtime.h>
#include <hip/hip_cooperative_groups.h>
#include <cstdio>
#include <cstring>
namespace cg = cooperative_groups;

constexpr int DM = 1024;
constexpr int NBATCH = 8;
constexpr int SEQ = 2048;
constexpr int CTXL = 256;
constexpr int NL = NBATCH * SEQ;
constexpr int NC = NBATCH * CTXL;
constexpr int NT = NL + NC;
constexpr int TSC = CTXL + SEQ;
constexpr int LDP = 4112;
constexpr int ATT_N = 2304;
constexpr int REC_N = 4112;
constexpr int REC_NP = 4224;
constexpr int NCHUNK = 36;
constexpr int NMT = 64 * NCHUNK;
constexpr int RWS = 5632;
constexpr int NSLOT = 137216;
constexpr float DN_ALPHA = 1.6817928305074290f;
constexpr int NTHR = 256;
constexpr int SMEM_BYTES = 65536 + 4096;
constexpr int META_OFF = 65536;
#define XCD_BAR_WORDS 3456
constexpr int CSTR = 32;
constexpr int BAR_TOTAL_WORDS = XCD_BAR_WORDS + 64;

typedef unsigned short bf16_t;
using bf16x8 = __attribute__((ext_vector_type(8))) short;
using f32x16 = __attribute__((ext_vector_type(16))) float;
using u32x4 = __attribute__((ext_vector_type(4))) unsigned;
using u32x2 = __attribute__((ext_vector_type(2))) unsigned;

struct Params {
  const float *x, *c, *ctx, *c_ctx, *ada_w, *ada_b, *ln_g, *ln_b, *mix_w_out, *att_w_in, *na_rpb, *qk_gain,
      *rec_w_in, *rwkv_mu, *rwkv_w0, *rwkv_w1, *rwkv_w2, *rwkv_a0, *rwkv_a1, *rwkv_a2, *rwkv_g1, *rwkv_g2,
      *rwkv_kvec, *rwkv_rk, *rwkv_gn, *mlstm_gate_b, *mlstm_norm, *moe_router, *moe_bias, *moe_w1, *moe_w3,
      *moe_w2, *shared_w1, *shared_w3, *shared_w2;
  float* out;
  bf16_t *Wt_att, *Wt_rec, *Wt_out, *Wt13, *Wt2, *Wl1, *Wl2;
  bf16_t *Zb, *L1;
  float *X, *MOD, *MODP, *GP, *msc, *lgate, *MSn, *Tb, *ROPE;
  bf16_t* WrTb;
  bf16_t *AB, *P, *RW, *MS, *ACT, *OUT2;
  int *cnt, *ltok, *tsl;
  unsigned* bar;
  int ph_lo, ph_hi;
};

typedef const Params __attribute__((address_space(4))) * KP;

__device__ __forceinline__ int modrow(int t) { return t < NL ? (t >> 11) : 8; }
__device__ __forceinline__ float sigm_f(float x) { return __builtin_amdgcn_rcpf(1.f + __builtin_amdgcn_exp2f(-1.4426950408889634f * x)); }
__device__ __forceinline__ float silu_f(float x) { return x * sigm_f(x); }
__device__ __forceinline__ float tanh_fast(float x) { return 2.f * sigm_f(2.f * x) - 1.f; }
__device__ __forceinline__ float softplus_f(float x) { return fmaxf(x, 0.f) + log1pf(expf(-fabsf(x))); }
template <int CTRL>
__device__ __forceinline__ float dppx(float x) {
  return __int_as_float(__builtin_amdgcn_update_dpp(0, __float_as_int(x), CTRL, 0xf, 0xf, true));
}
__device__ __forceinline__ float rdlane(float v, int l) {
  return __int_as_float(__builtin_amdgcn_readlane(__float_as_int(v), l));
}
__device__ __forceinline__ float wsum(float v) {
  v += dppx<0xB1>(v); v += dppx<0x4E>(v); v += dppx<0x141>(v); v += dppx<0x140>(v);
  return (rdlane(v, 0) + rdlane(v, 16)) + (rdlane(v, 32) + rdlane(v, 48));
}
__device__ __forceinline__ float wmax(float v) {
  v = fmaxf(v, dppx<0xB1>(v)); v = fmaxf(v, dppx<0x4E>(v)); v = fmaxf(v, dppx<0x141>(v)); v = fmaxf(v, dppx<0x140>(v));
  return fmaxf(fmaxf(rdlane(v, 0), rdlane(v, 16)), fmaxf(rdlane(v, 32), rdlane(v, 48)));
}
__device__ __forceinline__ int opaque_tid() {
  int t = threadIdx.x;
  asm volatile("" : "+v"(t));
  return t;
}
typedef __bf16 bf16x2_t __attribute__((ext_vector_type(2)));
typedef float f32x2_t __attribute__((ext_vector_type(2)));
__device__ __forceinline__ unsigned pk_bf16(float lo, float hi) {
  const f32x2_t v = {lo, hi};
  return __builtin_bit_cast(unsigned, __builtin_convertvector(v, bf16x2_t));
}
__device__ __forceinline__ bf16_t f2bf(float x) { return (bf16_t)(pk_bf16(x, 0.f) & 0xffffu); }
__device__ __forceinline__ float bf2f(bf16_t v) { return __uint_as_float((unsigned)v << 16); }
__device__ __forceinline__ float bflo(unsigned u) { return __uint_as_float(u << 16); }
__device__ __forceinline__ float bfhi(unsigned u) { return __uint_as_float(u & 0xffff0000u); }
__device__ __forceinline__ int scan_row(int dir, int b, int tau) {
  if (tau < CTXL) return NL + b * CTXL + (dir ? (CTXL - 1 - tau) : tau);
  int s = tau - CTXL;
  return b * SEQ + (dir ? (SEQ - 1 - s) : s);
}

template <class RowPtrA>
__device__ __forceinline__ void gemm128_main(int tid, RowPtrA rowA, const bf16_t* __restrict__ Bt, int K, int n0,
                                             char* lds, f32x16 (&acc)[2][2]) {
  const int lane = tid & 63, w = tid >> 6;
  const int wm = w >> 1, wn = w & 1, r = lane & 31, h = lane >> 5;
  const int c = tid & 7, sr = tid >> 3;
  const int lc = (c ^ ((tid >> 4) & 7)) * 8;
  const bf16_t* ap[4];
#pragma unroll
  for (int i = 0; i < 4; ++i) ap[i] = rowA(sr + 32 * i) + lc;
  const bf16_t* bp0 = Bt + (size_t)(n0 + sr) * K + lc;
  const int bstr = 32 * K;
#pragma unroll
  for (int mi = 0; mi < 2; ++mi)
#pragma unroll
    for (int ni = 0; ni < 2; ++ni)
#pragma unroll
      for (int q = 0; q < 16; ++q) acc[mi][ni][q] = 0.f;
  const int nk = K >> 6;
  auto issue = [&](int kt) {
    char* As = lds + (kt & 1) * 32768 + tid * 16;
    const int k0 = kt * 64;
#pragma unroll
    for (int i = 0; i < 4; ++i) {
      __builtin_amdgcn_global_load_lds((const unsigned*)(ap[i] + k0), (__attribute__((address_space(3))) unsigned*)(As + i * 4096), 16, 0, 0);
      __builtin_amdgcn_global_load_lds((const unsigned*)(bp0 + i * bstr + k0), (__attribute__((address_space(3))) unsigned*)(As + 16384 + i * 4096), 16, 0, 0);
    }
  };
  issue(0);
  const int sw = (r >> 1) & 7;
#pragma unroll 1
  for (int kt = 0; kt < nk; ++kt) {
    asm volatile("s_waitcnt vmcnt(0)" ::: "memory");
    __syncthreads();
    if (kt + 1 < nk) issue(kt + 1);
    const char* As = lds + (kt & 1) * 32768;
    const char* Ar = As + (wm * 64 + r) * 128;
    const char* Br = As + 16384 + (wn * 64 + r) * 128;
#pragma unroll
    for (int ks = 0; ks < 4; ++ks) {
      const int off = ((ks * 2 + h) ^ sw) * 16;
      const bf16x8 a0 = *(const bf16x8*)(Ar + off);
      const bf16x8 a1 = *(const bf16x8*)(Ar + 32 * 128 + off);
      const bf16x8 b0 = *(const bf16x8*)(Br + off);
      const bf16x8 b1 = *(const bf16x8*)(Br + 32 * 128 + off);
      acc[0][0] = __builtin_amdgcn_mfma_f32_32x32x16_bf16(a0, b0, acc[0][0], 0, 0, 0);
      acc[0][1] = __builtin_amdgcn_mfma_f32_32x32x16_bf16(a0, b1, acc[0][1], 0, 0, 0);
      acc[1][0] = __builtin_amdgcn_mfma_f32_32x32x16_bf16(a1, b0, acc[1][0], 0, 0, 0);
      acc[1][1] = __builtin_amdgcn_mfma_f32_32x32x16_bf16(a1, b1, acc[1][1], 0, 0, 0);
    }
  }
  __syncthreads();
}
using i64 = long;
typedef int i32x8 __attribute__((ext_vector_type(8)));
template <class RowPtrA8>
__device__ __forceinline__ void gemm128_fp8(int tid, RowPtrA8 rowA, const unsigned char* __restrict__ Bt, int K, int n0,
                                            char* lds, f32x16 (&acc)[2][2]) {
  const int lane = tid & 63, w = tid >> 6;
  const int wm = w >> 1, wn = w & 1, r = lane & 31, h = lane >> 5;
  const int c = tid & 7, sr = tid >> 3;
  const int lc = (c ^ ((tid >> 4) & 7)) * 16;
  const unsigned char* ap[4];
#pragma unroll
  for (int i = 0; i < 4; ++i) ap[i] = rowA(sr + 32 * i) + lc;
  const unsigned char* bp0 = Bt + (size_t)(n0 + sr) * K + lc;
  const int bstr = 32 * K;
#pragma unroll
  for (int mi = 0; mi < 2; ++mi)
#pragma unroll
    for (int ni = 0; ni < 2; ++ni)
#pragma unroll
      for (int q = 0; q < 16; ++q) acc[mi][ni][q] = 0.f;
  const int nk = K >> 7;
  auto issue = [&](int kt) {
    char* As = lds + (kt & 1) * 32768 + tid * 16;
    const int k0 = kt * 128;
#pragma unroll
    for (int i = 0; i < 4; ++i) {
      __builtin_amdgcn_global_load_lds((const unsigned*)(ap[i] + k0), (__attribute__((address_space(3))) unsigned*)(As + i * 4096), 16, 0, 0);
      __builtin_amdgcn_global_load_lds((const unsigned*)(bp0 + i * bstr + k0), (__attribute__((address_space(3))) unsigned*)(As + 16384 + i * 4096), 16, 0, 0);
    }
  };
  issue(0);
  if (nk > 1) issue(1);
  const int sw = (r >> 1) & 7;
#pragma unroll 1
  for (int kt = 0; kt < nk; ++kt) {
    if (kt == 0 && nk > 1) asm volatile("s_waitcnt vmcnt(8)" ::: "memory");
    else asm volatile("s_waitcnt vmcnt(0)" ::: "memory");
    __syncthreads();
    if (kt > 0 && kt + 1 < nk) issue(kt + 1);
    const char* As = lds + (kt & 1) * 32768;
    const char* Ar = As + (wm * 64 + r) * 128;
    const char* Br = As + 16384 + (wn * 64 + r) * 128;
#pragma unroll
    for (int pq = 0; pq < 2; ++pq) {
      const int o0 = ((4 * pq + 2 * h) ^ sw) * 16, o1 = ((4 * pq + 2 * h + 1) ^ sw) * 16;
      const u32x4 a0l = *(const u32x4*)(Ar + o0), a0h = *(const u32x4*)(Ar + o1);
      const u32x4 a1l = *(const u32x4*)(Ar + 32 * 128 + o0), a1h = *(const u32x4*)(Ar + 32 * 128 + o1);
      const u32x4 b0l = *(const u32x4*)(Br + o0), b0h = *(const u32x4*)(Br + o1);
      const u32x4 b1l = *(const u32x4*)(Br + 32 * 128 + o0), b1h = *(const u32x4*)(Br + 32 * 128 + o1);
      const i32x8 A0 = {(int)a0l.x, (int)a0l.y, (int)a0l.z, (int)a0l.w, (int)a0h.x, (int)a0h.y, (int)a0h.z, (int)a0h.w};
      const i32x8 A1 = {(int)a1l.x, (int)a1l.y, (int)a1l.z, (int)a1l.w, (int)a1h.x, (int)a1h.y, (int)a1h.z, (int)a1h.w};
      const i32x8 B0 = {(int)b0l.x, (int)b0l.y, (int)b0l.z, (int)b0l.w, (int)b0h.x, (int)b0h.y, (int)b0h.z, (int)b0h.w};
      const i32x8 B1 = {(int)b1l.x, (int)b1l.y, (int)b1l.z, (int)b1l.w, (int)b1h.x, (int)b1h.y, (int)b1h.z, (int)b1h.w};
      acc[0][0] = __builtin_amdgcn_mfma_scale_f32_32x32x64_f8f6f4(A0, B0, acc[0][0], 0, 0, 0, 0, 0, 0);
      acc[0][1] = __builtin_amdgcn_mfma_scale_f32_32x32x64_f8f6f4(A0, B1, acc[0][1], 0, 0, 0, 0, 0, 0);
      acc[1][0] = __builtin_amdgcn_mfma_scale_f32_32x32x64_f8f6f4(A1, B0, acc[1][0], 0, 0, 0, 0, 0, 0);
      acc[1][1] = __builtin_amdgcn_mfma_scale_f32_32x32x64_f8f6f4(A1, B1, acc[1][1], 0, 0, 0, 0, 0, 0);
    }
  }
  __syncthreads();
}
template <class F>
__device__ __forceinline__ void acc_foreach(int tid, const f32x16 (&acc)[2][2], F f) {
  const int lane = tid & 63, w = tid >> 6;
  const int wm = w >> 1, wn = w & 1, r = lane & 31, h = lane >> 5;
#pragma unroll
  for (int mi = 0; mi < 2; ++mi)
#pragma unroll
    for (int ni = 0; ni < 2; ++ni)
#pragma unroll
      for (int q = 0; q < 16; ++q) {
        const int row = wm * 64 + mi * 32 + (q & 3) + 8 * (q >> 2) + 4 * h;
        const int col = wn * 64 + ni * 32 + r;
        f(row, col, acc[mi][ni][q]);
        if ((q & 3) == 3) __builtin_amdgcn_sched_barrier(0);
      }
}

template <class RM>
__device__ __forceinline__ void tr_tile(int tid, const float* __restrict__ src, int N, int k0, int n0,
                                        bf16_t* __restrict__ dst, int K, RM rowmap, float* tile) {
  {
    const int tx = tid & 15, ty = tid >> 4;
    const int n = n0 + tx * 4;
#pragma unroll
    for (int i = 0; i < 4; ++i) {
      const int k = ty + 16 * i;
      float4 v = make_float4(0.f, 0.f, 0.f, 0.f);
      if (n < N) v = *(const float4*)(src + (size_t)(k0 + k) * N + n);
      tile[k * 65 + tx * 4 + 0] = v.x; tile[k * 65 + tx * 4 + 1] = v.y;
      tile[k * 65 + tx * 4 + 2] = v.z; tile[k * 65 + tx * 4 + 3] = v.w;
    }
  }
  __syncthreads();
  {
    const int kc = tid & 7;
#pragma unroll
    for (int i = 0; i < 2; ++i) {
      const int n = (tid >> 3) + 32 * i;
      if (n0 + n < N) {
        float v[8];
#pragma unroll
        for (int q = 0; q < 8; ++q) v[q] = tile[(kc * 8 + q) * 65 + n];
        u32x4 o;
        o.x = pk_bf16(v[0], v[1]); o.y = pk_bf16(v[2], v[3]); o.z = pk_bf16(v[4], v[5]); o.w = pk_bf16(v[6], v[7]);
        *(u32x4*)(dst + (size_t)rowmap(n0 + n) * K + k0 + kc * 8) = o;
      }
    }
  }
  __syncthreads();
}

constexpr float W8_SCALE = 32.f, W8_INV = 1.f / 32.f;
__device__ __forceinline__ unsigned pk_fp8x4(float a, float b, float c, float d) {
  int r = __builtin_amdgcn_cvt_pk_fp8_f32(a, b, 0, false);
  r = __builtin_amdgcn_cvt_pk_fp8_f32(c, d, r, true);
  return (unsigned)r;
}
__device__ __forceinline__ unsigned pk_fp8x4c(float a, float b, float c, float d) {
  constexpr float M = 448.f;
  return pk_fp8x4(fminf(fmaxf(a, -M), M), fminf(fmaxf(b, -M), M), fminf(fmaxf(c, -M), M), fminf(fmaxf(d, -M), M));
}
template <class RM>
__device__ __forceinline__ void tr_tile_fp8(int tid, const float* __restrict__ src, int N, int k0, int n0,
                                            unsigned char* __restrict__ dst, int K, RM rowmap, float* tile) {
  {
    const int tx = tid & 15, ty = tid >> 4;
    const int n = n0 + tx * 4;
#pragma unroll
    for (int i = 0; i < 4; ++i) {
      const int k = ty + 16 * i;
      float4 v = make_float4(0.f, 0.f, 0.f, 0.f);
      if (n < N) v = *(const float4*)(src + (size_t)(k0 + k) * N + n);
      tile[k * 65 + tx * 4 + 0] = v.x; tile[k * 65 + tx * 4 + 1] = v.y;
      tile[k * 65 + tx * 4 + 2] = v.z; tile[k * 65 + tx * 4 + 3] = v.w;
    }
  }
  __syncthreads();
  {
    const int kc = tid & 3, n = tid >> 2;
    float v[16];
#pragma unroll
    for (int q = 0; q < 16; ++q) v[q] = tile[(kc * 16 + q) * 65 + n] * W8_SCALE;
    u32x4 o;
    o.x = pk_fp8x4c(v[0], v[1], v[2], v[3]); o.y = pk_fp8x4c(v[4], v[5], v[6], v[7]);
    o.z = pk_fp8x4c(v[8], v[9], v[10], v[11]); o.w = pk_fp8x4c(v[12], v[13], v[14], v[15]);
    *(u32x4*)(dst + (size_t)rowmap(n0 + n) * K + k0 + kc * 16) = o;
  }
  __syncthreads();
}

constexpr int CJ0 = 1152, CJ1 = CJ0 + 2080, CJ2 = CJ1 + 1024, CJ3 = CJ2 + 33280, CJ4 = CJ3 + 16640;
__device__ void convert_job(KP p, int job, float* sm, int tid) {
  if (job < CJ0) {
    const int j = job / 576, rem = job % 576, kt = rem / 36, nt = rem % 36;
    tr_tile_fp8(tid, p->att_w_in + (size_t)j * 1024 * ATT_N, ATT_N, kt * 64, nt * 64, (unsigned char*)p->Wt_att + (size_t)j * ATT_N * 1024,
                1024, [](int n) { return n; }, sm);
  } else if (job < CJ1) {
    const int q = job - CJ0;
    const int j = q / 1040, rem = q % 1040, kt = rem / 65, nt = rem % 65;
    tr_tile_fp8(tid, p->rec_w_in + (size_t)j * 1024 * REC_N, REC_N, kt * 64, nt * 64, (unsigned char*)p->Wt_rec + (size_t)j * REC_NP * 1024,
                1024, [](int n) { return n; }, sm);
  } else if (job < CJ2) {
    const int q = job - CJ1;
    const int i = q >> 8, rem = q & 255, kt = rem >> 4, nt = rem & 15;
    tr_tile_fp8(tid, p->mix_w_out + (size_t)i * 1024 * 1024, 1024, kt * 64, nt * 64, (unsigned char*)p->Wt_out + (size_t)i * 1024 * 1024,
                1024, [](int n) { return n; }, sm);
  } else if (job < CJ3) {
    const int q = job - CJ2;
    const int le = q >> 7, rem = q & 127;
    const int which = rem >> 6, kt = (rem >> 2) & 15, nt = rem & 3;
    const int layer = le / 65, e = le % 65;
    const float* src;
    if (e < 64) src = (which ? p->moe_w3 : p->moe_w1) + (size_t)(layer * 64 + e) * 1024 * 256;
    else src = (which ? p->shared_w3 : p->shared_w1) + (size_t)layer * 1024 * 256;
    tr_tile_fp8(tid, src, 256, kt * 64, nt * 64, (unsigned char*)p->Wt13 + (size_t)le * 512 * 1024, 1024,
                [which](int n) { return 64 * (n >> 5) + which * 32 + (n & 31); }, sm);
  } else {
    const int q = job - CJ3;
    const int le = q >> 6, rem = q & 63;
    const int kt = rem >> 4, nt = rem & 15;
    const int layer = le / 65, e = le % 65;
    const float* src = e < 64 ? p->moe_w2 + (size_t)(layer * 64 + e) * 256 * 1024 : p->shared_w2 + (size_t)layer * 256 * 1024;
    tr_tile_fp8(tid, src, 1024, kt * 64, nt * 64, (unsigned char*)p->Wt2 + (size_t)le * 1024 * 256, 256, [](int n) { return n; }, sm);
  }
}
__device__ __forceinline__ int conv_stage_total(int stage) {
  return stage == 0 ? (576 + 1040 + 512 + 8320 + 4160) : (stage == 1 ? (576 + 1040 + 256 + 16640 + 8320) : (256 + 8320 + 4160));
}
__device__ __forceinline__ int conv_stage_job(int stage, int q) {
  if (stage == 0) {
    if (q < 8320) return CJ2 + q;  q -= 8320;
    if (q < 4160) return CJ3 + q;  q -= 4160;
    if (q < 576) return q;  q -= 576;
    if (q < 1040) return CJ0 + q;  q -= 1040;
    return CJ1 + q;
  } else if (stage == 1) {
    if (q < 8320) return CJ2 + 8320 + q;  q -= 8320;
    if (q < 4160) return CJ3 + 4160 + q;  q -= 4160;
    if (q < 576) return 576 + q;  q -= 576;
    if (q < 256) return CJ1 + 512 + q;  q -= 256;
    if (q < 8320) return CJ2 + 16640 + q;  q -= 8320;
    if (q < 4160) return CJ3 + 8320 + q;  q -= 4160;
    return CJ0 + 1040 + q;
  }
  if (q < 256) return CJ1 + 768 + q;  q -= 256;
  if (q < 8320) return CJ2 + 24960 + q;  q -= 8320;
  return CJ3 + 12480 + q;
}

struct CvDesc { const float* src; unsigned char* dst; int N, K, k0, n0, which; };
__device__ __forceinline__ bool conv_desc_fp8(KP p, int job, CvDesc& d) {
  if (job < CJ2) return false;
  if (job < CJ3) {
    const int q = job - CJ2;
    const int le = q >> 7, rem = q & 127;
    const int which = rem >> 6, kt = (rem >> 2) & 15, nt = rem & 3;
    const int layer = le / 65, e = le % 65;
    if (e < 64) d.src = (which ? p->moe_w3 : p->moe_w1) + (size_t)(layer * 64 + e) * 1024 * 256;
    else d.src = (which ? p->shared_w3 : p->shared_w1) + (size_t)layer * 1024 * 256;
    d.dst = (unsigned char*)p->Wt13 + (size_t)le * 512 * 1024;
    d.N = 256; d.K = 1024; d.k0 = kt * 64; d.n0 = nt * 64; d.which = which;
  } else {
    const int q = job - CJ3;
    const int le = q >> 6, rem = q & 63;
    const int kt = rem >> 4, nt = rem & 15;
    const int layer = le / 65, e = le % 65;
    d.src = e < 64 ? p->moe_w2 + (size_t)(layer * 64 + e) * 256 * 1024 : p->shared_w2 + (size_t)layer * 256 * 1024;
    d.dst = (unsigned char*)p->Wt2 + (size_t)le * 1024 * 256;
    d.N = 1024; d.K = 256; d.k0 = kt * 64; d.n0 = nt * 64; d.which = -1;
  }
  return true;
}
typedef float cvf4 __attribute__((ext_vector_type(4)));
__device__ __forceinline__ void cv_load(const CvDesc& d, int tid, cvf4& v0, cvf4& v1, cvf4& v2, cvf4& v3) {
  const int tx = tid & 15, ty = tid >> 4;
  const float* s0 = d.src + (size_t)(d.k0 + ty) * d.N + d.n0 + tx * 4;
  v0 = *(const cvf4*)(s0);
  v1 = *(const cvf4*)(s0 + (size_t)16 * d.N);
  v2 = *(const cvf4*)(s0 + (size_t)32 * d.N);
  v3 = *(const cvf4*)(s0 + (size_t)48 * d.N);
}
__device__ __forceinline__ void cv_emit(const CvDesc& d, int tid, const cvf4 v0, const cvf4 v1, const cvf4 v2, const cvf4 v3, float* tile) {
  {
    const int tx = tid & 15, ty = tid >> 4;
    float* t0 = tile + ty * 65 + tx * 4;
    t0[0] = v0.x; t0[1] = v0.y; t0[2] = v0.z; t0[3] = v0.w;
    t0[16 * 65 + 0] = v1.x; t0[16 * 65 + 1] = v1.y; t0[16 * 65 + 2] = v1.z; t0[16 * 65 + 3] = v1.w;
    t0[32 * 65 + 0] = v2.x; t0[32 * 65 + 1] = v2.y; t0[32 * 65 + 2] = v2.z; t0[32 * 65 + 3] = v2.w;
    t0[48 * 65 + 0] = v3.x; t0[48 * 65 + 1] = v3.y; t0[48 * 65 + 2] = v3.z; t0[48 * 65 + 3] = v3.w;
  }
  __syncthreads();
  {
    const int kc = tid & 3, n = tid >> 2;
    float v[16];
#pragma unroll
    for (int q = 0; q < 16; ++q) v[q] = tile[(kc * 16 + q) * 65 + n] * W8_SCALE;
    u32x4 o;
    o.x = pk_fp8x4c(v[0], v[1], v[2], v[3]); o.y = pk_fp8x4c(v[4], v[5], v[6], v[7]);
    o.z = pk_fp8x4c(v[8], v[9], v[10], v[11]); o.w = pk_fp8x4c(v[12], v[13], v[14], v[15]);
    const int nn = d.n0 + n;
    const int row = d.which >= 0 ? 64 * (nn >> 5) + d.which * 32 + (nn & 31) : nn;
    *(u32x4*)(d.dst + (size_t)row * d.K + d.k0 + kc * 16) = o;
  }
  __syncthreads();
}
__device__ __forceinline__ void convert_run(KP p, int stage, int jj, int j1, float* sm, int tid) {
  CvDesc d, dn;
  cvf4 a0, a1, a2, a3, b0, b1, b2, b3;
  bool cur = false;
#pragma unroll 1
  for (; jj < j1; ++jj) {
    const int job = conv_stage_job(stage, jj);
    if (!cur) {
      if (!conv_desc_fp8(p, job, d)) { convert_job(p, job, sm, tid); continue; }
      cv_load(d, tid, a0, a1, a2, a3);
    }
    bool nxt = false;
    if (jj + 1 < j1) {
      nxt = conv_desc_fp8(p, conv_stage_job(stage, jj + 1), dn);
      if (nxt) cv_load(dn, tid, b0, b1, b2, b3);
    }
    cv_emit(d, tid, a0, a1, a2, a3, sm);
    if (nxt) { d = dn; a0 = b0; a1 = b1; a2 = b2; a3 = b3; }
    cur = nxt;
  }
}

__device__ void ph_init(KP p, char* smc) {
  float* sm = (float*)smc;
  const int tid = opaque_tid();
  for (int tile = blockIdx.x; tile < 96 * 8; tile += gridDim.x) {
    const int ct = tile >> 3, ks = tile & 7;
    for (int i = tid; i < 9 * 128; i += NTHR) {
      const int r = i >> 7, k = ks * 128 + (i & 127);
      const float v = r < 8 ? p->c[r * 1024 + k] : p->c_ctx[k];
      sm[i] = silu_f(v);
    }
    __syncthreads();
    const int col = ct * 256 + tid;
    const int layer = col / 6144, n = col % 6144;
    const float* W = p->ada_w + ((size_t)layer * 1024 + ks * 128) * 6144 + n;
    float acc[9];
#pragma unroll
    for (int r = 0; r < 9; ++r) acc[r] = 0.f;
    f32x16 wc, wn;
#pragma unroll
    for (int q = 0; q < 16; ++q) wc[q] = W[(size_t)q * 6144];
    wn = wc;
#pragma unroll 1
    for (int kb = 0; kb < 8; ++kb) {
      if (kb < 7) {
#pragma unroll
        for (int q = 0; q < 16; ++q) wn[q] = W[(size_t)((kb + 1) * 16 + q) * 6144];
      }
#pragma unroll
      for (int q = 0; q < 16; ++q) {
#pragma unroll
        for (int r = 0; r < 9; ++r) acc[r] = fmaf(sm[r * 128 + kb * 16 + q], wc[q], acc[r]);
      }
      wc = wn;
    }
#pragma unroll
    for (int r = 0; r < 9; ++r) p->MODP[((size_t)(ks * 4 + layer) * 9 + r) * 6144 + n] = acc[r];
    __syncthreads();
  }
  {
    const int total = conv_stage_total(0), chunk = (total + gridDim.x - 1) / gridDim.x;
    const int lo = min((int)blockIdx.x * chunk, total), hi = min(lo + chunk, total);
    __syncthreads();
    convert_run(p, 0, lo, hi, sm, tid);
  }
  const int i00 = blockIdx.x * NTHR + tid, istr = gridDim.x * NTHR;
  auto lw1 = [&](int i) -> float {
    const int k = i & 511, n = (i >> 9) & 127, wj = i >> 16;
    const int j = wj / 3, which = wj % 3;
    float v = 0.f;
    if (which < 2) {
      if (n < 64) v = (which ? p->rwkv_a1 : p->rwkv_w1)[((size_t)(j * 2 + (n >> 5)) * 512 + k) * 32 + (n & 31)];
    } else if (n < 96) v = p->rwkv_g1[((size_t)j * 512 + k) * 96 + n];
    return v;
  };
  auto lw2 = [&](int i) -> float {
    const int k = i & 127, n = (i >> 7) % 2560, j = i / (2560 * 128);
    float v = 0.f;
    if (n < 2048) {
      const int d = (n >> 9) & 1, c = n & 511;
      if (k < 64 && (k >> 5) == d) v = (n < 1024 ? p->rwkv_w2 : p->rwkv_a2)[((size_t)(j * 2 + d) * 32 + (k & 31)) * 512 + c];
    } else if (k < 96) v = p->rwkv_g2[((size_t)j * 96 + k) * 512 + (n - 2048)];
    return v;
  };
  auto lwr = [&](int i) -> float {
    const int k = i & 1023, n = (i >> 10) & 63, l = i >> 16;
    return p->moe_router[((size_t)l * 1024 + k) * 64 + n];
  };
  auto batched = [&](int N, auto ld, bf16_t* dst) {
#pragma unroll 1
    for (int ib = i00; ib < N; ib += 8 * istr) {
      float v[8];
#pragma unroll
      for (int u = 0; u < 8; ++u) { const int idx = ib + u * istr; v[u] = 0.f; if (idx < N) v[u] = ld(idx); }
#pragma unroll
      for (int u = 0; u < 8; ++u) { const int idx = ib + u * istr; if (idx < N) dst[idx] = f2bf(v[u]); }
    }
  };
  batched(2 * 3 * 128 * 512, lw1, p->Wl1);
  batched(2 * 2560 * 128, lw2, p->Wl2);
  batched(4 * 64 * 1024, lwr, p->WrTb);
  for (int i = blockIdx.x * NTHR + tid; i < 64 * 16; i += gridDim.x * NTHR) {
    const int pos = i >> 4, f = i & 15;
    const float ang = (float)pos * powf(10000.f, -(float)f / 16.f);
    p->ROPE[2 * i] = cosf(ang);
    p->ROPE[2 * i + 1] = sinf(ang);
  }
}

__device__ void ph_mod_h(KP p, char* smc) {
  float* sm = (float*)smc;
  const int tid = opaque_tid();
  for (int i = blockIdx.x * NTHR + tid; i < 4 * 9 * 6144; i += gridDim.x * NTHR) {
    const int layer = i / (9 * 6144), rem = i % (9 * 6144), n = rem % 6144;
    float s = p->ada_b[layer * 6144 + n];
#pragma unroll
    for (int ks = 0; ks < 8; ++ks) s += p->MODP[(size_t)(ks * 4 + layer) * 9 * 6144 + rem];
    p->MOD[i] = s;
  }
  const int lane = tid & 63, wave = tid >> 6;
  const int per = (((NT + gridDim.x - 1) / gridDim.x) + 3) & ~3;
  const int t0 = blockIdx.x * per, t1 = min(NT, t0 + per);
  int cur = -1;
  typedef float f4v __attribute__((ext_vector_type(4)));
  f4v nx0 = {0.f, 0.f, 0.f, 0.f}, nx1 = nx0, nx2 = nx0, nx3 = nx0;
  auto ldrow = [&](int t) {
    const float* src = (t < NL ? p->x + (size_t)t * DM : p->ctx + (size_t)(t - NL) * DM) + lane * 4;
    nx0 = *(const f4v*)(src); nx1 = *(const f4v*)(src + 256); nx2 = *(const f4v*)(src + 512); nx3 = *(const f4v*)(src + 768);
  };
  if (t0 + wave < t1) ldrow(t0 + wave);
  for (int tb = t0; tb < t1; tb += 4) {
    const int mr = modrow(tb);
    if (mr != cur) {
      __syncthreads();
      for (int n = tid; n < 2048; n += NTHR) {
        float a = p->ada_b[n];
#pragma unroll
        for (int ks = 0; ks < 8; ++ks) a += p->MODP[((size_t)(ks * 4) * 9 + mr) * 6144 + n];
        sm[n] = a;
      }
      cur = mr;
      __syncthreads();
    }
    const int t = tb + wave;
    const f4v c0 = nx0, c1 = nx1, c2 = nx2, c3 = nx3;
    if (t + 4 < t1) ldrow(t + 4);
    if (t < t1) {
      unsigned char* dst = (unsigned char*)p->AB + (size_t)t * DM + lane * 4;
      auto emit = [&](int i, const f4v xv) {
        const int n = i * 256 + lane * 4;
        const float4 sh = *(const float4*)(sm + n);
        const float4 sc = *(const float4*)(sm + 1024 + n);
        *(unsigned*)(dst + i * 256) =
            pk_fp8x4c(xv.x * (1.f + sc.x) + sh.x, xv.y * (1.f + sc.y) + sh.y, xv.z * (1.f + sc.z) + sh.z, xv.w * (1.f + sc.w) + sh.w);
      };
      emit(0, c0); emit(1, c1); emit(2, c2); emit(3, c3);
    }
  }
}

typedef short v4i16_t __attribute__((ext_vector_type(4)));
using s16x4 = __attribute__((ext_vector_type(4))) short;
__device__ __forceinline__ s16x4 vtr(const char* p) {
  return __builtin_bit_cast(s16x4, __builtin_amdgcn_ds_read_tr16_b64_v4i16((__attribute__((address_space(3))) v4i16_t*)p));
}
#define MFMA32(a, b, c) __builtin_amdgcn_mfma_f32_32x32x16_bf16(a, b, c, 0, 0, 0)
__device__ __forceinline__ void lds_barrier() {
  asm volatile("s_waitcnt lgkmcnt(0)" ::: "memory");
  __builtin_amdgcn_s_barrier();
  asm volatile("" ::: "memory");
}
__device__ __forceinline__ float vmax3(float a, float b, float c) {
  float r;
  asm("v_max3_f32 %0, %1, %2, %3" : "=v"(r) : "v"(a), "v"(b), "v"(c));
  return r;
}
__device__ void ph_attention(KP p, int layer, bool keep, char* lds) {
  const int tid = opaque_tid();
  const int lane = tid & 63, w = tid >> 6, r32 = lane & 31, hi = lane >> 5;
  const int j = layer >> 1;
  float* bias_lds = (float*)(lds + 32768 + 1024);
  const int n_gqa = 1024, n_na = 1024, n_cb = keep ? 128 : 0, n_ca = keep ? 128 : 0;
  const int total = n_gqa + n_na + n_cb + n_ca;
  constexpr float LOG2E = 1.4426950408889634f;
  constexpr float C2 = 0.125f * LOG2E;
  const int c = tid & 7, sr = tid >> 3;
  const int kso = (c ^ ((tid >> 4) & 7)) * 16;
  const int vso = (c >> 2) * 4096 + (c & 3) * 16;
  const int sw = (r32 >> 1) & 7;
  for (int vitem = blockIdx.x; vitem < total; vitem += gridDim.x) {
    int item = vitem;
    if (gridDim.x == 512) {
      const int cls0 = vitem < n_gqa ? 0 : (vitem < n_gqa + n_na ? n_gqa : (vitem < n_gqa + n_na + n_cb ? n_gqa + n_na : n_gqa + n_na + n_cb));
      const int vl = vitem - cls0, b9 = vl & 511, r9 = vl >> 9;
      item = cls0 + (cls0 < n_gqa + n_na ? 128 * (b9 & 7) + 64 * r9 + (b9 >> 3) : 16 * (b9 & 7) + (b9 >> 3));
    }
    int b, qrow0, qoff, koff, voff, ocol, lat_tiles, lat_row0;
    bool na = false;
    int r_w = 0, start_w = 0, ru0 = 0, hN = 0;
    if (item < n_gqa) {
      b = item >> 7;
      const int g = (item >> 6) & 1, tt = item & 63;
      qrow0 = b * SEQ + tt * 32; qoff = 1536 + (g * 4 + w) * 64; koff = 2048 + g * 64; voff = 2176 + g * 64;
      ocol = 512 + (g * 4 + w) * 64; lat_tiles = 32; lat_row0 = b * SEQ;
    } else if (item < n_gqa + n_na) {
      const int it = item - n_gqa;
      b = it >> 7; hN = (it >> 4) & 7;
      const int rp = it & 15;
      na = true; r_w = 2 * rp + (w >> 1);
      qrow0 = b * SEQ + r_w * 64 + (w & 1) * 32; qoff = hN * 64; koff = 512 + hN * 64; voff = 1024 + hN * 64; ocol = hN * 64;
      const int s0 = min(max(2 * rp - 4, 0), 24), s1 = min(max(2 * rp - 3, 0), 24);
      start_w = (w >> 1) ? s1 : s0; ru0 = s0; lat_tiles = (s1 != s0) ? 9 : 8; lat_row0 = b * SEQ + ru0 * 64;
    } else if (item < n_gqa + n_na + n_cb) {
      const int it = item - n_gqa - n_na;
      b = it >> 4;
      const int g = (it >> 3) & 1, tt = it & 7;
      qrow0 = NL + b * CTXL + tt * 32; qoff = 1536 + (g * 4 + w) * 64; koff = 2048 + g * 64; voff = 2176 + g * 64;
      ocol = 512 + (g * 4 + w) * 64; lat_tiles = 0; lat_row0 = 0;
    } else {
      const int it = item - n_gqa - n_na - n_cb;
      b = it >> 4;
      const int h = (it >> 1) & 7, half = it & 1;
      qrow0 = NL + b * CTXL + half * 128 + w * 32; qoff = h * 64; koff = 512 + h * 64; voff = 1024 + h * 64; ocol = h * 64;
      lat_tiles = 0; lat_row0 = 0;
    }
    const int ctx_row0 = NL + b * CTXL, ntiles = lat_tiles + 4;
    bf16x8 qf[4];
    {
      const bf16_t* qp = p->P + (size_t)(qrow0 + r32) * LDP + qoff + hi * 8;
#pragma unroll
      for (int d0 = 0; d0 < 4; ++d0) qf[d0] = *(const bf16x8*)(qp + d0 * 16);
    }
    f32x16 o0, o1;
#pragma unroll
    for (int q = 0; q < 16; ++q) { o0[q] = 0.f; o1[q] = 0.f; }
    float m = -INFINITY, l = 0.f;
    u32x4 ka0, ka1, va0, va1, kb0, kb1, vb0, vb1;
    auto gload = [&](int t, u32x4& k0, u32x4& k1, u32x4& v0, u32x4& v1) {
      const int row0 = t < lat_tiles ? lat_row0 + 64 * t : ctx_row0 + 64 * (t - lat_tiles);
      const bf16_t* base = p->P + (size_t)(row0 + sr) * LDP + c * 8;
      k0 = *(const u32x4*)(base + koff); k1 = *(const u32x4*)(base + (size_t)32 * LDP + koff);
      v0 = *(const u32x4*)(base + voff); v1 = *(const u32x4*)(base + (size_t)32 * LDP + voff);
    };
    auto swrite = [&](int buf, const u32x4 k0, const u32x4 k1, const u32x4 v0, const u32x4 v1) {
      char* Kb = lds + buf * 16384;
      char* Vb = Kb + 8192;
      *(u32x4*)(Kb + sr * 128 + kso) = k0; *(u32x4*)(Kb + (sr + 32) * 128 + kso) = k1;
      *(u32x4*)(Vb + vso + sr * 64) = v0; *(u32x4*)(Vb + vso + (sr + 32) * 64) = v1;
    };
    auto tile_compute = [&](int t) {
      const bool na_tile = na && t < lat_tiles;
      const int kr = ru0 + t;
      const bool part = !na_tile || (kr >= start_w && kr < start_w + 8);
      if (part) {
        const char* Ks = lds + (t & 1) * 16384;
        const char* Vs = Ks + 8192;
        f32x16 s0, s1;
#pragma unroll
        for (int q = 0; q < 16; ++q) { s0[q] = 0.f; s1[q] = 0.f; }
#pragma unroll
        for (int d0 = 0; d0 < 4; ++d0) {
          const int off = ((2 * d0 + hi) ^ sw) * 16;
          const bf16x8 k0 = *(const bf16x8*)(Ks + r32 * 128 + off);
          const bf16x8 k1 = *(const bf16x8*)(Ks + (32 + r32) * 128 + off);
          s0 = MFMA32(k0, qf[d0], s0);
          s1 = MFMA32(k1, qf[d0], s1);
        }
        float mxa = -INFINITY, mxb = -INFINITY;
        if (na_tile) {
          const int cq = (w & 1) * 32 + r32;
          const int c0 = min(max(cq - 8, 0), 48);
          const float* brow = bias_lds + (kr - r_w + 7) * 31 + (15 - cq);
          f32x16 bv0, bv1;
#pragma unroll
          for (int q = 0; q < 16; ++q) {
            const int kc = (q & 3) + 8 * (q >> 2) + 4 * hi;
            bv0[q] = brow[kc]; bv1[q] = brow[kc + 32];
          }
#pragma unroll
          for (int q = 0; q < 16; ++q) {
            const int kc = (q & 3) + 8 * (q >> 2) + 4 * hi;
            float b0 = bv0[q], b1 = bv1[q];
            asm("" : "+v"(b0), "+v"(b1));
            const float f0 = fmaf(s0[q], C2, b0), f1 = fmaf(s1[q], C2, b1);
            s0[q] = ((unsigned)(kc - c0) < 16u) ? f0 : -INFINITY;
            s1[q] = ((unsigned)(kc + 32 - c0) < 16u) ? f1 : -INFINITY;
          }
        } else {
#pragma unroll
          for (int q = 0; q < 16; ++q) { s0[q] *= C2; s1[q] *= C2; }
        }
#pragma unroll
        for (int q = 0; q < 16; q += 2) { mxa = vmax3(mxa, s0[q], s1[q]); mxb = vmax3(mxb, s0[q + 1], s1[q + 1]); }
        float mx = vmax3(mxa, mxb, mxb);
        {
          auto rr = __builtin_amdgcn_permlane32_swap(__float_as_uint(mx), __float_as_uint(mx), false, false);
          mx = fmaxf(__uint_as_float(rr[0]), __uint_as_float(rr[1]));
        }
        const float mnew = fmaxf(m, mx);
        const float alpha = __builtin_amdgcn_exp2f(m - mnew);
        typedef float f2 __attribute__((ext_vector_type(2)));
        const f2 mn2 = {mnew, mnew};
        f2 ls2a = {0.f, 0.f}, ls2b = {0.f, 0.f};
#pragma unroll
        for (int q = 0; q < 16; q += 2) {
          f2 d0 = {s0[q], s0[q + 1]}, d1 = {s1[q], s1[q + 1]};
          d0 -= mn2; d1 -= mn2;
          f2 e0, e1;
          e0.x = __builtin_amdgcn_exp2f(d0.x); e0.y = __builtin_amdgcn_exp2f(d0.y);
          e1.x = __builtin_amdgcn_exp2f(d1.x); e1.y = __builtin_amdgcn_exp2f(d1.y);
          ls2a += e0; ls2b += e1;
          s0[q] = e0.x; s0[q + 1] = e0.y; s1[q] = e1.x; s1[q + 1] = e1.y;
        }
        const f2 ls2 = ls2a + ls2b;
        const float ls = ls2.x + ls2.y;
        l = l * alpha + ls;
        m = mnew;
#pragma unroll
        for (int q = 0; q < 16; ++q) { o0[q] *= alpha; o1[q] *= alpha; }
        bf16x8 pf[4];
#pragma unroll
        for (int s = 0; s < 4; ++s) {
          const int u = (s & 1) * 8;
          u32x4 tpk;
          if (s < 2) {
            tpk.x = pk_bf16(s0[u + 0], s0[u + 1]); tpk.y = pk_bf16(s0[u + 2], s0[u + 3]);
            tpk.z = pk_bf16(s0[u + 4], s0[u + 5]); tpk.w = pk_bf16(s0[u + 6], s0[u + 7]);
          } else {
            tpk.x = pk_bf16(s1[u + 0], s1[u + 1]); tpk.y = pk_bf16(s1[u + 2], s1[u + 3]);
            tpk.z = pk_bf16(s1[u + 4], s1[u + 5]); tpk.w = pk_bf16(s1[u + 6], s1[u + 7]);
          }
          pf[s] = __builtin_bit_cast(bf16x8, tpk);
        }
        const char* vb = Vs + ((lane >> 4) & 1) * 32 + (lane & 3) * 8 + ((lane & 15) >> 2) * 64 + hi * 256;
#pragma unroll
        for (int s = 0; s < 4; ++s) {
          const s16x4 a00 = vtr(vb + (16 * s) * 64), a01 = vtr(vb + (16 * s + 8) * 64);
          const s16x4 a10 = vtr(vb + 4096 + (16 * s) * 64), a11 = vtr(vb + 4096 + (16 * s + 8) * 64);
          const bf16x8 A0 = __builtin_shufflevector(a00, a01, 0, 1, 2, 3, 4, 5, 6, 7);
          const bf16x8 A1 = __builtin_shufflevector(a10, a11, 0, 1, 2, 3, 4, 5, 6, 7);
          o0 = MFMA32(A0, pf[s], o0);
          o1 = MFMA32(A1, pf[s], o1);
        }
      }
    };
    gload(0, ka0, ka1, va0, va1);
    if (na)
      for (int i = tid; i < 465; i += NTHR) bias_lds[i] = p->na_rpb[(j * 8 + hN) * 465 + i] * LOG2E;
    swrite(0, ka0, ka1, va0, va1);
    gload(1, ka0, ka1, va0, va1);
    for (int t = 0; t < ntiles; t += 2) {
      __syncthreads();
      gload(min(t + 2, ntiles - 1), kb0, kb1, vb0, vb1);
      tile_compute(t);
      if (t + 1 < ntiles) swrite(1, ka0, ka1, va0, va1);
      if (t + 1 < ntiles) {
        __syncthreads();
        gload(min(t + 3, ntiles - 1), ka0, ka1, va0, va1);
        tile_compute(t + 1);
        if (t + 2 < ntiles) swrite(0, kb0, kb1, vb0, vb1);
      }
    }
    __syncthreads();
    const float lt = l + __shfl_xor(l, 32);
    const float inv = 1.f / lt;
    unsigned char* op = (unsigned char*)p->AB + (size_t)(qrow0 + r32) * DM + ocol + 4 * hi;
#pragma unroll
    for (int g = 0; g < 4; ++g) {
      *(unsigned*)(op + 8 * g) = pk_fp8x4c(o0[4 * g] * inv, o0[4 * g + 1] * inv, o0[4 * g + 2] * inv, o0[4 * g + 3] * inv);
      *(unsigned*)(op + 32 + 8 * g) = pk_fp8x4c(o1[4 * g] * inv, o1[4 * g + 1] * inv, o1[4 * g + 2] * inv, o1[4 * g + 3] * inv);
    }
  }
}

__device__ void ph_rwkv_mix(KP p, int layer) {
  const int j = layer >> 1;
  const int tid = opaque_tid();
  const int lane = tid & 63, wave = tid >> 6;
  const float* mu = p->rwkv_mu + j * 6 * 512;
  const int c0 = lane * 8;
  auto unpack = [](const u32x4 u, float (&f)[8]) {
    f[0] = bflo(u.x); f[1] = bfhi(u.x); f[2] = bflo(u.y); f[3] = bfhi(u.y);
    f[4] = bflo(u.z); f[5] = bfhi(u.z); f[6] = bflo(u.w); f[7] = bfhi(u.w);
  };
  auto pack = [](const float (&f)[8]) {
    u32x4 o;
    o.x = pk_bf16(f[0], f[1]); o.y = pk_bf16(f[2], f[3]); o.z = pk_bf16(f[4], f[5]); o.w = pk_bf16(f[6], f[7]);
    return o;
  };
  float muv[6][8], kv0v[8];
  {
    const float* kv0 = p->rwkv_kvec + (j * 2 + 0) * 512 + c0;
#pragma unroll
    for (int e = 0; e < 8; ++e) kv0v[e] = kv0[e];
#pragma unroll
    for (int z = 0; z < 6; ++z)
#pragma unroll
      for (int e = 0; e < 8; ++e) muv[z][e] = mu[z * 512 + c0 + e];
  }
  for (int t = blockIdx.x * 4 + wave; t < NT; t += gridDim.x * 4) {
    bool hasp, hasn;
    if (t < NL) { int s = t & 2047; hasp = s > 0; hasn = s < SEQ - 1; }
    else { int s = (t - NL) & 255; hasp = s > 0; hasn = s < CTXL - 1; }
    const bf16_t* pt = p->P + (size_t)t * LDP + c0;
    bf16_t* rw = p->RW + (size_t)t * RWS + c0;
    bf16_t* zb = p->Zb + (size_t)t * 1536 + c0;
    const u32x4 zero = {0u, 0u, 0u, 0u};
    u32x4 uc[4], up[4], un[4];
#pragma unroll
    for (int q = 0; q < 4; ++q) uc[q] = *(const u32x4*)(pt + q * 512);
#pragma unroll
    for (int q = 0; q < 4; ++q) up[q] = zero;
#pragma unroll
    for (int q = 0; q < 4; ++q) un[q] = zero;
    if (hasp) {
#pragma unroll
      for (int q = 0; q < 4; ++q) up[q] = *(const u32x4*)(pt + q * 512 - LDP);
    }
    if (hasn) {
#pragma unroll
      for (int q = 0; q < 4; ++q) un[q] = *(const u32x4*)(pt + q * 512 + LDP);
    }
#pragma unroll
    for (int q = 0; q < 4; ++q) {
      float cur[8], pv[8], nx[8], d[8];
      unpack(uc[q], cur);
      unpack(up[q], pv);
      unpack(un[q], nx);
#pragma unroll
      for (int e = 0; e < 8; ++e) d[e] = 0.5f * (pv[e] + nx[e]) - cur[e];
      if (q < 3) {
        float o[8];
#pragma unroll
        for (int e = 0; e < 8; ++e) o[e] = cur[e] + d[e] * muv[q][e];
        if (q == 0) *(u32x4*)(rw) = pack(o);
        else if (q == 2) *(u32x4*)(rw + 512) = pack(o);
        else {
          *(u32x4*)(rw + 10 * 512) = pack(o);
          float kk[8], ss = 0.f;
#pragma unroll
          for (int e = 0; e < 8; ++e) { kk[e] = o[e] * kv0v[e]; ss += kk[e] * kk[e]; }
          ss += dppx<0xB1>(ss); ss += dppx<0x4E>(ss); ss += dppx<0x141>(ss);
          const float rn = rsqrtf(fmaxf(ss, 1e-24f));
#pragma unroll
          for (int e = 0; e < 8; ++e) kk[e] *= rn;
          *(u32x4*)(rw + 2 * 512) = pack(kk);
        }
      } else {
#pragma unroll
        for (int z = 0; z < 3; ++z) {
          float o[8];
#pragma unroll
          for (int e = 0; e < 8; ++e) o[e] = cur[e] + d[e] * muv[3 + z][e];
          *(u32x4*)(zb + z * 512) = pack(o);
        }
      }
    }
  }
}

constexpr int RS_STEP = 384;
constexpr int RS_TB = 16;
struct RwkvStage { u32x2 r, kk, e, ke, a, v; };
__device__ void rwkv_unit(KP p, int unit, float* sm, int tid) {
  const int ch = unit >> 1, hf = unit & 1;
  const int dir = ch >> 6, b = (ch >> 3) & 7, h = ch & 7;
  const int lane = tid & 63, w = tid >> 6, rl = lane >> 3, ks = lane & 7;
  float* ybuf = sm + 2 * RS_TB * RS_STEP;
  const int ss = tid >> 4, kq = tid & 15;
  auto gload = [&](int n, RwkvStage& g) {
    const int row = scan_row(dir, b, n * RS_TB + ss);
    const bf16_t* base = p->RW + (size_t)row * RWS + h * 64 + kq * 4;
    g.r = *(const u32x2*)(base);
    g.kk = *(const u32x2*)(base + 2 * 512);
    g.e = *(const u32x2*)(base + (3 + dir) * 512);
    g.ke = *(const u32x2*)(base + (5 + dir) * 512);
    g.a = *(const u32x2*)(base + (7 + dir) * 512);
    g.v = *(const u32x2*)(p->RW + (size_t)row * RWS + 512 + h * 64 + hf * 32 + (kq & 7) * 4);
  };
  auto swrite = [&](int buf, const RwkvStage& g) {
    float* sp = sm + (buf * RS_TB + ss) * RS_STEP;
    const float r0 = bflo(g.r.x), r1 = bfhi(g.r.x), r2 = bflo(g.r.y), r3 = bfhi(g.r.y);
    const float k0 = bflo(g.kk.x), k1 = bfhi(g.kk.x), k2 = bflo(g.kk.y), k3 = bfhi(g.kk.y);
    const float w0 = __expf(-bflo(g.e.x)), w1 = __expf(-bfhi(g.e.x)), w2 = __expf(-bflo(g.e.y)), w3 = __expf(-bfhi(g.e.y));
    const float e0 = bflo(g.ke.x), e1 = bfhi(g.ke.x), e2 = bflo(g.ke.y), e3 = bfhi(g.ke.y);
    const float a0 = k0 * bflo(g.a.x), a1 = k1 * bfhi(g.a.x), a2 = k2 * bflo(g.a.y), a3 = k3 * bfhi(g.a.y);
    *(float4*)(sp + kq * 4) = make_float4(k0, k1, k2, k3);
    *(float4*)(sp + 64 + kq * 4) = make_float4(w0 * r0, w1 * r1, w2 * r2, w3 * r3);
    *(float4*)(sp + 128 + kq * 4) = make_float4(w0, w1, w2, w3);
    *(float4*)(sp + 192 + kq * 4) = make_float4(a0, a1, a2, a3);
    *(float4*)(sp + 256 + kq * 4) = make_float4(e0, e1, e2, e3);
    if (kq < 8) *(float4*)(sp + 320 + kq * 4) = make_float4(bflo(g.v.x), bfhi(g.v.x), bflo(g.v.y), bfhi(g.v.y));
    float c1 = a0 * r0 + a1 * r1 + a2 * r2 + a3 * r3;
    float c2 = e0 * r0 + e1 * r1 + e2 * r2 + e3 * r3;
    c1 += dppx<0xB1>(c1); c2 += dppx<0xB1>(c2);
    c1 += dppx<0x4E>(c1); c2 += dppx<0x4E>(c2);
    c1 += dppx<0x141>(c1); c2 += dppx<0x141>(c2);
    c1 += dppx<0x140>(c1); c2 += dppx<0x140>(c2);
    if (kq == 0) { sp[352] = c1; sp[353] = c2; }
  };
  typedef float f2 __attribute__((ext_vector_type(2)));
  f2 S01 = {0.f, 0.f}, S23 = {0.f, 0.f}, S45 = {0.f, 0.f}, S67 = {0.f, 0.f};
  auto compute = [&](int n) {
    const float* bp = sm + (n & 1) * RS_TB * RS_STEP;
    float* yb = ybuf + (n & 1) * RS_TB * 32 + w * 8 + rl;
    struct Ops { f2 k[4], r[4], w[4], a[4], e[4]; float vv; f2 c; };
    auto ld = [&](int s, Ops& o) {
      const float* sq = bp + s * RS_STEP;
      const f2* sp = (const f2*)(sq + ks * 8);
#pragma unroll
      for (int i = 0; i < 4; ++i) { o.k[i] = sp[i]; o.r[i] = sp[32 + i]; o.w[i] = sp[64 + i]; o.a[i] = sp[96 + i]; o.e[i] = sp[128 + i]; }
      o.vv = sq[320 + w * 8 + rl]; o.c = *(const f2*)(sq + 352);
    };
    auto step = [&](const Ops& o) -> float {
      f2 sa2 = S01 * o.k[0];
      f2 y2 = S01 * o.r[0];
      sa2 = __builtin_elementwise_fma(S23, o.k[1], sa2); y2 = __builtin_elementwise_fma(S23, o.r[1], y2);
      sa2 = __builtin_elementwise_fma(S45, o.k[2], sa2); y2 = __builtin_elementwise_fma(S45, o.r[2], y2);
      sa2 = __builtin_elementwise_fma(S67, o.k[3], sa2); y2 = __builtin_elementwise_fma(S67, o.r[3], y2);
      float sa = sa2.x + sa2.y, y0 = y2.x + y2.y;
      sa += dppx<0xB1>(sa); y0 += dppx<0xB1>(y0);
      sa += dppx<0x4E>(sa); y0 += dppx<0x4E>(y0);
      sa += dppx<0x141>(sa); y0 += dppx<0x141>(y0);
      sa = -sa;
      const f2 sav = {sa, sa}, vvv = {o.vv, o.vv};
      S01 = __builtin_elementwise_fma(vvv, o.e[0], __builtin_elementwise_fma(sav, o.a[0], S01 * o.w[0]));
      S23 = __builtin_elementwise_fma(vvv, o.e[1], __builtin_elementwise_fma(sav, o.a[1], S23 * o.w[1]));
      S45 = __builtin_elementwise_fma(vvv, o.e[2], __builtin_elementwise_fma(sav, o.a[2], S45 * o.w[2]));
      S67 = __builtin_elementwise_fma(vvv, o.e[3], __builtin_elementwise_fma(sav, o.a[3], S67 * o.w[3]));
      return fmaf(o.vv, o.c.y, fmaf(sa, o.c.x, y0));
    };
    Ops oa, ob;
    ld(0, oa);
#pragma unroll 1
    for (int s = 0; s < RS_TB; s += 2) {
      __builtin_amdgcn_sched_barrier(0);
      ld(s + 1, ob);
      __builtin_amdgcn_sched_barrier(0);
      float y0 = step(oa);
      asm volatile("" : "+v"(y0));
      __builtin_amdgcn_sched_barrier(0);
      ld(s + 2, oa);
      __builtin_amdgcn_sched_barrier(0);
      float y1 = step(ob);
      asm volatile("" : "+v"(y1));
      __builtin_amdgcn_sched_barrier(0);
      if (ks == 0) { yb[s * 32] = y0; yb[(s + 1) * 32] = y1; }
    }
  };
  auto yout = [&](int n) {
    const int row = scan_row(dir, b, n * RS_TB + ss);
    const float* ys = ybuf + (n & 1) * RS_TB * 32 + ss * 32 + kq * 2;
    *(unsigned*)(p->P + (size_t)row * LDP + dir * 512 + h * 64 + hf * 32 + kq * 2) = pk_bf16(ys[0], ys[1]);
  };
  constexpr int NB = TSC / RS_TB;
  RwkvStage gA, gB;
  gload(0, gA);
  gload(1, gB);
  swrite(0, gA);
  gload(2, gA);
  __syncthreads();
  for (int n = 0; n < NB; n += 2) {
    compute(n);
    swrite(1, gB);
    if (n + 3 < NB) gload(n + 3, gB);
    __syncthreads();
    yout(n);
    compute(n + 1);
    if (n + 2 < NB) swrite(0, gA);
    if (n + 4 < NB) gload(n + 4, gA);
    __syncthreads();
    yout(n + 1);
  }
  __syncthreads();
}

__device__ void mlstm_s1(KP p, int layer, int tile, char* lds, int tid) {
  const int j = layer >> 1;
  const int ch = tile / NCHUNK, c = tile % NCHUNK;
  const int dir = ch >> 5, b = (ch >> 2) & 7, h = ch & 3;
  float* s_ws = (float*)(lds + META_OFF);
  int* s_row = (int*)(s_ws + 64);
  char* kimg = lds;
  char* vimg = lds + 16384;
  if (tid < 64) {
    const int row = scan_row(dir, b, c * 64 + tid);
    s_row[tid] = row;
    const float* g = p->GP + (size_t)row * 16;
    const float gi = g[(dir * 2) * 4 + h] + p->mlstm_gate_b[j * 16 + (dir * 2) * 4 + h];
    const float gf = g[(dir * 2 + 1) * 4 + h] + p->mlstm_gate_b[j * 16 + (dir * 2 + 1) * 4 + h];
    float bc = -softplus_f(-gf);
#pragma unroll
    for (int o = 1; o < 64; o <<= 1) {
      float tmp = __shfl_up(bc, o);
      if (tid >= o) bc += tmp;
    }
    const float bend = __shfl(bc, 63);
    const float ds = bend - bc + gi;
    const float mloc = wmax(ds);
    s_ws[tid] = expf(ds - mloc);
    if (tid == 0) { p->msc[tile] = mloc; p->msc[NMT + tile] = bend; }
  }
  __syncthreads();
  {
    const int c8 = tid & 15;
    const int ioff = (c8 >> 2) * 4096 + (c8 & 3) * 16;
#pragma unroll
    for (int i = 0; i < 4; ++i) {
      const int sidx = (tid >> 4) + 16 * i;
      const bf16_t* src = p->P + (size_t)s_row[sidx] * LDP + h * 128 + c8 * 8;
      const u32x4 kv = *(const u32x4*)(src + 2560);
      u32x4 vv = *(const u32x4*)(src + 3072);
      const float wsv = s_ws[sidx];
      vv.x = pk_bf16(bflo(vv.x) * wsv, bfhi(vv.x) * wsv); vv.y = pk_bf16(bflo(vv.y) * wsv, bfhi(vv.y) * wsv);
      vv.z = pk_bf16(bflo(vv.z) * wsv, bfhi(vv.z) * wsv); vv.w = pk_bf16(bflo(vv.w) * wsv, bfhi(vv.w) * wsv);
      *(u32x4*)(kimg + ioff + sidx * 64) = kv;
      *(u32x4*)(vimg + ioff + sidx * 64) = vv;
    }
  }
  __syncthreads();
  const int lane = tid & 63, w = tid >> 6, wm = w >> 1, wn = w & 1, r32 = lane & 31, hi = lane >> 5;
  f32x16 acc[2][2];
#pragma unroll
  for (int mi = 0; mi < 2; ++mi)
#pragma unroll
    for (int ni = 0; ni < 2; ++ni)
#pragma unroll
      for (int q = 0; q < 16; ++q) acc[mi][ni][q] = 0.f;
  const int toff = ((lane >> 4) & 1) * 32 + (lane & 3) * 8 + ((lane & 15) >> 2) * 64 + hi * 256;
#pragma unroll
  for (int ks = 0; ks < 4; ++ks) {
    bf16x8 af[2], bfr[2];
#pragma unroll
    for (int i = 0; i < 2; ++i) {
      const char* ka = kimg + (wm * 2 + i) * 4096 + toff + (16 * ks) * 64;
      const char* va = vimg + (wn * 2 + i) * 4096 + toff + (16 * ks) * 64;
      af[i] = __builtin_shufflevector(vtr(ka), vtr(ka + 8 * 64), 0, 1, 2, 3, 4, 5, 6, 7);
      bfr[i] = __builtin_shufflevector(vtr(va), vtr(va + 8 * 64), 0, 1, 2, 3, 4, 5, 6, 7);
    }
    acc[0][0] = MFMA32(af[0], bfr[0], acc[0][0]);
    acc[0][1] = MFMA32(af[0], bfr[1], acc[0][1]);
    acc[1][0] = MFMA32(af[1], bfr[0], acc[1][0]);
    acc[1][1] = MFMA32(af[1], bfr[1], acc[1][1]);
  }
  bf16_t* ust = (bf16_t*)(lds + 32768);
#pragma unroll
  for (int mi = 0; mi < 2; ++mi)
#pragma unroll
    for (int ni = 0; ni < 2; ++ni)
#pragma unroll
      for (int q = 0; q < 16; ++q) {
        const int d = wm * 64 + mi * 32 + (q & 3) + 8 * (q >> 2) + 4 * hi;
        ust[d * 128 + wn * 64 + ni * 32 + r32] = f2bf(acc[mi][ni][q]);
        if ((q & 3) == 3) __builtin_amdgcn_sched_barrier(0);
      }
  __syncthreads();
  {
    const u32x4* us4 = (const u32x4*)ust;
    u32x4* U4 = (u32x4*)(p->MS + (size_t)tile * 16384);
#pragma unroll
    for (int i = 0; i < 8; ++i) U4[tid + 256 * i] = us4[tid + 256 * i];
  }
  if (tid < 128) {
    const char* kc = kimg + (tid >> 5) * 4096 + (tid & 31) * 2;
    float a = 0.f;
#pragma unroll 8
    for (int sidx = 0; sidx < 64; ++sidx) a = fmaf(s_ws[sidx], bf2f(*(const bf16_t*)(kc + sidx * 64)), a);
    p->MSn[tile * 128 + tid] = a;
  }
}

__device__ void mlstm_s3(KP p, int layer, int tile, char* lds, int tid);
__device__ void ph_scan_a(KP p, int layer, char* smc) {
  float* sm = (float*)smc;
  const int tid = opaque_tid();
  __builtin_amdgcn_s_setprio(3);
  for (int u = blockIdx.x; u < 256; u += gridDim.x) rwkv_unit(p, u, sm, tid);
  __builtin_amdgcn_s_setprio(0);
  {
    const int stage = layer == 1 ? 1 : 2;
    const int nconv = conv_stage_total(stage);
    const int total = NMT + (nconv + 7) / 8;
    int* qc = (int*)(p->bar + XCD_BAR_WORDS + 16 * stage);
    int* s_q = (int*)(smc + META_OFF + 3968);
    int jj = 0, j1 = 0;
#pragma unroll 1
    for (;;) {
      if (jj >= j1) {
        __syncthreads();
        if (tid == 0) *s_q = atomicAdd(qc, 1);
        __syncthreads();
        const int q = *s_q;
        if (q >= total) break;
        if (q < NMT) { mlstm_s3(p, layer, q, smc, tid); continue; }
        jj = (q - NMT) * 8; j1 = min(jj + 8, nconv);
      }
      convert_run(p, stage, jj, j1, sm, tid);
      jj = j1;
    }
  }
}

__device__ void ph_mlstm_s2(KP p, char* smc) {
  float* sw = (float*)smc;
  const int tid = opaque_tid();
  const int nitems = 64 * 33;
  for (int item = blockIdx.x; item < nitems; item += gridDim.x) {
    const int ch = item / 33, seg = item % 33;
    __syncthreads();
    unsigned* base = (unsigned*)(p->MS + (size_t)ch * NCHUNK * 16384) + seg * 256 + tid;
    unsigned v[NCHUNK];
    if (seg < 32) {
#pragma unroll
      for (int c = 0; c < NCHUNK; ++c) v[c] = base[(size_t)c * 8192];
    }
    if (tid < 2 * NCHUNK) sw[72 + tid] = p->msc[(tid < NCHUNK ? 0 : NMT - NCHUNK) + ch * NCHUNK + tid];
    __syncthreads();
    if (tid == 0) {
      float m = 0.f;
      for (int c = 0; c < NCHUNK; ++c) {
        sw[144 + c] = m;
        m = fmaxf(sw[72 + NCHUNK + c] + m, sw[72 + c]);
      }
      sw[144 + NCHUNK] = m;
    }
    __syncthreads();
    if (tid < NCHUNK) {
      const float m = sw[144 + tid], mn = sw[145 + tid];
      sw[tid] = __expf(sw[72 + NCHUNK + tid] + m - mn);
      sw[36 + tid] = __expf(sw[72 + tid] - mn);
      if (seg == 0) p->msc[2 * NMT + ch * NCHUNK + tid] = m;
    }
    __syncthreads();
    if (seg < 32) {
      float C0 = 0.f, C1 = 0.f;
#pragma unroll
      for (int c = 0; c < NCHUNK; ++c) {
        const float t0 = bflo(v[c]), t1 = bfhi(v[c]);
        v[c] = pk_bf16(C0, C1);
        C0 = sw[c] * C0 + sw[36 + c] * t0;
        C1 = sw[c] * C1 + sw[36 + c] * t1;
      }
#pragma unroll
      for (int c = 0; c < NCHUNK; ++c) base[(size_t)c * 8192] = v[c];
    } else if (tid < 128) {
      float* base = p->MSn + (size_t)ch * NCHUNK * 128 + tid;
      float v[NCHUNK];
#pragma unroll
      for (int c = 0; c < NCHUNK; ++c) v[c] = base[c * 128];
      float C = 0.f;
#pragma unroll
      for (int c = 0; c < NCHUNK; ++c) {
        const float t0 = v[c];
        v[c] = C;
        C = sw[c] * C + sw[36 + c] * t0;
      }
#pragma unroll
      for (int c = 0; c < NCHUNK; ++c) base[c * 128] = v[c];
    }
  }
}

__device__ void mlstm_s3(KP p, int layer, int tile, char* lds, int tid) {
  const int j = layer >> 1;
  const int ch = tile / NCHUNK, c = tile % NCHUNK;
  const int dir = ch >> 5, b = (ch >> 2) & 7, h = ch & 3;
  float* s_b = (float*)(lds + META_OFF);
  float* s_ig = s_b + 64;
  float* s_mt = s_b + 128;
  float* s_wi = s_b + 192;
  int* s_row = (int*)(s_b + 256);
  float* s_n = s_b + 320;
  float* s_c = s_b + 448;
  char* kimg = lds;
  char* vimg = lds + 16384;
  char* cimg = lds + 32768;
  const float mprev = p->msc[2 * NMT + tile];
  const float qscale = 0.08838834764831845f;
  const int lane = tid & 63, w = tid >> 6, wt = w >> 1, wv = w & 1, r32 = lane & 31, hi = lane >> 5;
  const int t = wt * 32 + r32;
  const int rowq = scan_row(dir, b, c * 64 + t);
  const int c8 = tid & 15;
  u32x4 kr[4], vr[4], cr[8];
#pragma unroll
  for (int i = 0; i < 4; ++i) {
    const int sidx = (tid >> 4) + 16 * i;
    const bf16_t* src = p->P + (size_t)scan_row(dir, b, c * 64 + sidx) * LDP + h * 128 + c8 * 8;
    kr[i] = *(const u32x4*)(src + 2560);
    vr[i] = *(const u32x4*)(src + 3072);
  }
  {
    const bf16_t* Cp = p->MS + (size_t)tile * 16384;
#pragma unroll
    for (int i = 0; i < 8; ++i) cr[i] = *(const u32x4*)(Cp + ((tid >> 4) + 16 * i) * 128 + c8 * 8);
  }
  bf16x8 qf[8];
  {
    const bf16_t* qp = p->P + (size_t)rowq * LDP + 2048 + h * 128 + hi * 8;
#pragma unroll
    for (int d0 = 0; d0 < 8; ++d0) qf[d0] = *(const bf16x8*)(qp + d0 * 16);
  }
  if (tid < 64) {
    const int row = scan_row(dir, b, c * 64 + tid);
    s_row[tid] = row;
    const float* g = p->GP + (size_t)row * 16;
    const float gi = g[(dir * 2) * 4 + h] + p->mlstm_gate_b[j * 16 + (dir * 2) * 4 + h];
    const float gf = g[(dir * 2 + 1) * 4 + h] + p->mlstm_gate_b[j * 16 + (dir * 2 + 1) * 4 + h];
    float bc = -softplus_f(-gf);
#pragma unroll
    for (int o = 1; o < 64; o <<= 1) {
      float tmp = __shfl_up(bc, o);
      if (tid >= o) bc += tmp;
    }
    float pm = gi - bc;
#pragma unroll
    for (int o = 1; o < 64; o <<= 1) {
      float tmp = __shfl_up(pm, o);
      if (tid >= o) pm = fmaxf(pm, tmp);
    }
    const float mt = bc + fmaxf(mprev, pm);
    s_b[tid] = bc;
    s_ig[tid] = gi;
    s_mt[tid] = mt;
    s_wi[tid] = expf(bc + mprev - mt);
    s_c[tid] = (gi - bc) * 1.4426950408889634f;
  } else if (tid < 192) s_n[tid - 64] = p->MSn[tile * 128 + (tid - 64)];
  {
    const int ioff = (c8 >> 2) * 4096 + (c8 & 3) * 16;
#pragma unroll
    for (int i = 0; i < 4; ++i) {
      const int sidx = (tid >> 4) + 16 * i;
      *(u32x4*)(kimg + sidx * 256 + ((c8 ^ (sidx & 15)) * 16)) = kr[i];
      *(u32x4*)(vimg + ioff + sidx * 64) = vr[i];
    }
    const int coff = (c8 >> 2) * 8192 + (c8 & 3) * 16;
#pragma unroll
    for (int i = 0; i < 8; ++i) *(u32x4*)(cimg + coff + ((tid >> 4) + 16 * i) * 64) = cr[i];
  }
  __syncthreads();
  const int toff = ((lane >> 4) & 1) * 32 + (lane & 3) * 8 + ((lane & 15) >> 2) * 64;
  constexpr float LOG2E_ = 1.4426950408889634f;
  float qn = 0.f;
#pragma unroll
  for (int d0 = 0; d0 < 8; ++d0) {
    const u32x4 qq = __builtin_bit_cast(u32x4, qf[d0]);
    const float* np = s_n + d0 * 16 + hi * 8;
    qn = fmaf(bflo(qq.x), np[0], qn); qn = fmaf(bfhi(qq.x), np[1], qn);
    qn = fmaf(bflo(qq.y), np[2], qn); qn = fmaf(bfhi(qq.y), np[3], qn);
    qn = fmaf(bflo(qq.z), np[4], qn); qn = fmaf(bfhi(qq.z), np[5], qn);
    qn = fmaf(bflo(qq.w), np[6], qn); qn = fmaf(bfhi(qq.w), np[7], qn);
  }
  qn += __shfl_xor(qn, 32);
  const float mtt = s_mt[t], wi = s_wi[t];
  const float ct = (s_b[t] - mtt) * LOG2E_;
  const float wq = wi * qscale;
  bf16x8 pf[4];
  float den = 0.f;
  {
    f32x16 sa0, sa1;
#pragma unroll
    for (int q = 0; q < 16; ++q) { sa0[q] = 0.f; sa1[q] = 0.f; }
#pragma unroll
    for (int d0 = 0; d0 < 8; ++d0) {
      const int chn = 2 * d0 + hi;
      const bf16x8 k0 = *(const bf16x8*)(kimg + r32 * 256 + ((chn ^ (r32 & 15)) * 16));
      sa0 = MFMA32(k0, qf[d0], sa0);
      if (wt) {
        const bf16x8 k1 = *(const bf16x8*)(kimg + (32 + r32) * 256 + ((chn ^ (r32 & 15)) * 16));
        sa1 = MFMA32(k1, qf[d0], sa1);
      }
      __builtin_amdgcn_sched_barrier(0);
    }
#pragma unroll
    for (int g = 0; g < 4; ++g) {
      const int sb0 = 8 * g + 4 * hi;
      const float4 c0v = *(const float4*)(s_c + sb0);
      const float4 c1v = *(const float4*)(s_c + sb0 + 32);
      const float cc0[4] = {c0v.x, c0v.y, c0v.z, c0v.w}, cc1[4] = {c1v.x, c1v.y, c1v.z, c1v.w};
#pragma unroll
      for (int e = 0; e < 4; ++e) {
        const int q = 4 * g + e;
        const float v0 = (sb0 + e <= t) ? sa0[q] * qscale * __builtin_amdgcn_exp2f(ct + cc0[e]) : 0.f;
        sa0[q] = v0; den += v0;
        const float v1 = (wt && sb0 + 32 + e <= t) ? sa1[q] * qscale * __builtin_amdgcn_exp2f(ct + cc1[e]) : 0.f;
        sa1[q] = v1; den += v1;
      }
      __builtin_amdgcn_sched_barrier(0);
    }
#pragma unroll
    for (int sx = 0; sx < 4; ++sx) {
      const int u = (sx & 1) * 8;
      u32x4 tpk;
      if (sx < 2) {
        tpk.x = pk_bf16(sa0[u + 0], sa0[u + 1]); tpk.y = pk_bf16(sa0[u + 2], sa0[u + 3]);
        tpk.z = pk_bf16(sa0[u + 4], sa0[u + 5]); tpk.w = pk_bf16(sa0[u + 6], sa0[u + 7]);
      } else {
        tpk.x = pk_bf16(sa1[u + 0], sa1[u + 1]); tpk.y = pk_bf16(sa1[u + 2], sa1[u + 3]);
        tpk.z = pk_bf16(sa1[u + 4], sa1[u + 5]); tpk.w = pk_bf16(sa1[u + 6], sa1[u + 7]);
      }
      pf[sx] = __builtin_bit_cast(bf16x8, tpk);
    }
  }
  den += __shfl_xor(den, 32);
  const float dtot = den + wq * qn;
  const float inv = 1.f / fmaxf(fabsf(dtot), expf(-mtt));
  bf16_t* op = p->P + (size_t)rowq * LDP + 1024 + dir * 512 + h * 128 + wv * 64 + 4 * hi;
#pragma unroll 1
  for (int vp = 0; vp < 2; ++vp) {
    f32x16 o0;
#pragma unroll
    for (int q = 0; q < 16; ++q) o0[q] = 0.f;
    const char* cb = cimg + (wv * 2 + vp) * 8192 + toff + hi * 512;
#pragma unroll
    for (int d0 = 0; d0 < 8; ++d0) {
      const bf16x8 A0 = __builtin_shufflevector(vtr(cb + (16 * d0) * 64), vtr(cb + (16 * d0 + 4) * 64), 0, 1, 2, 3, 4, 5, 6, 7);
      o0 = MFMA32(A0, qf[d0], o0);
    }
#pragma unroll
    for (int q = 0; q < 16; ++q) o0[q] *= wq;
    const char* vb = vimg + (wv * 2 + vp) * 4096 + toff + hi * 256;
#pragma unroll
    for (int sx = 0; sx < 4; ++sx) {
      if (sx < 2 || wt) {
        const bf16x8 A0 = __builtin_shufflevector(vtr(vb + (16 * sx) * 64), vtr(vb + (16 * sx + 8) * 64), 0, 1, 2, 3, 4, 5, 6, 7);
        o0 = MFMA32(A0, pf[sx], o0);
      }
    }
#pragma unroll
    for (int g = 0; g < 4; ++g) {
      u32x2 v0;
      v0.x = pk_bf16(o0[4 * g] * inv, o0[4 * g + 1] * inv); v0.y = pk_bf16(o0[4 * g + 2] * inv, o0[4 * g + 3] * inv);
      *(u32x2*)(op + vp * 32 + 8 * g) = v0;
    }
  }
}

__device__ void ph_mlstm_s1(KP p, int layer, char* smc) {
  const int tid = opaque_tid();
  __syncthreads();
  for (int tile = blockIdx.x; tile < NMT; tile += gridDim.x) { mlstm_s1(p, layer, tile, smc, tid); lds_barrier(); }
}

__device__ void ph_rec_final(KP p, int layer, bool keep) {
  const int tid = opaque_tid();
  const int j = layer >> 1;
  const int lane = tid & 63, wave = tid >> 6;
  const int rows = keep ? NT : NL;
  const int c0 = lane * 8;
  auto unpack = [](const u32x4 u, float (&f)[8]) {
    f[0] = bflo(u.x); f[1] = bfhi(u.x); f[2] = bflo(u.y); f[3] = bfhi(u.y);
    f[4] = bflo(u.z); f[5] = bfhi(u.z); f[6] = bflo(u.w); f[7] = bfhi(u.w);
  };
  float rkv[8], gn0v[8], gn1v[8], ngv[8];
  {
    const float* rk = p->rwkv_rk + j * 512 + c0;
    const float* gn0 = p->rwkv_gn + (j * 2 + 0) * 512 + c0;
    const float* gn1 = p->rwkv_gn + (j * 2 + 1) * 512 + c0;
    const float* ng = p->mlstm_norm + j * 512 + c0;
#pragma unroll
    for (int e = 0; e < 8; ++e) { rkv[e] = rk[e]; gn0v[e] = gn0[e]; gn1v[e] = gn1[e]; ngv[e] = ng[e]; }
  }
  for (int t = blockIdx.x * 4 + wave; t < rows; t += gridDim.x * 4) {
    const bf16_t* rw = p->RW + (size_t)t * RWS + c0;
    const bf16_t* pt = p->P + (size_t)t * LDP + c0;
    unsigned char* mo = (unsigned char*)p->AB + (size_t)t * DM + c0;
    const u32x4 u_yf = *(const u32x4*)(pt), u_yb = *(const u32x4*)(pt + 512);
    const u32x4 u_r = *(const u32x4*)(rw), u_v = *(const u32x4*)(rw + 512);
    const u32x4 u_k0 = *(const u32x4*)(rw + 5 * 512), u_k1 = *(const u32x4*)(rw + 6 * 512);
    const u32x4 u_g = *(const u32x4*)(rw + 9 * 512);
    const u32x4 u_hf = *(const u32x4*)(pt + 1024), u_hb = *(const u32x4*)(pt + 1536), u_og = *(const u32x4*)(pt + 3584);
    {
      float yf[8], yb[8], r[8], v[8], k0[8], k1[8], g[8], y[8], o[8];
      unpack(u_yf, yf); unpack(u_yb, yb);
      unpack(u_r, r); unpack(u_v, v);
      unpack(u_k0, k0); unpack(u_k1, k1);
      unpack(u_g, g);
      float s1 = 0.f, bs = 0.f;
#pragma unroll
      for (int e = 0; e < 8; ++e) { y[e] = yf[e] + yb[e]; s1 += y[e]; bs += r[e] * rkv[e] * (k0[e] + k1[e]); }
      s1 += dppx<0xB1>(s1); s1 += dppx<0x4E>(s1); s1 += dppx<0x141>(s1);
      bs += dppx<0xB1>(bs); bs += dppx<0x4E>(bs); bs += dppx<0x141>(bs);
      const float mu = s1 * (1.f / 64.f);
      float s2 = 0.f;
#pragma unroll
      for (int e = 0; e < 8; ++e) { const float d = y[e] - mu; s2 += d * d; }
      s2 += dppx<0xB1>(s2); s2 += dppx<0x4E>(s2); s2 += dppx<0x141>(s2);
      const float rs = rsqrtf(s2 * (1.f / 64.f) + 64e-5f);
#pragma unroll
      for (int e = 0; e < 8; ++e) o[e] = ((y[e] - mu) * rs * gn0v[e] + gn1v[e] + bs * v[e]) * g[e];
      u32x2 ov;
      ov.x = pk_fp8x4c(o[0], o[1], o[2], o[3]); ov.y = pk_fp8x4c(o[4], o[5], o[6], o[7]);
      *(u32x2*)(mo) = ov;
    }
    {
      float hf[8], hb[8], og[8], hsum[8], o[8];
      unpack(u_hf, hf); unpack(u_hb, hb);
      unpack(u_og, og);
      float ss = 0.f;
#pragma unroll
      for (int e = 0; e < 8; ++e) { hsum[e] = hf[e] + hb[e]; ss += hsum[e] * hsum[e]; }
      ss += dppx<0xB1>(ss); ss += dppx<0x4E>(ss); ss += dppx<0x141>(ss); ss += dppx<0x140>(ss);
      const float rs = rsqrtf(ss * (1.f / 128.f) + 1e-6f);
#pragma unroll
      for (int e = 0; e < 8; ++e) o[e] = hsum[e] * rs * ngv[e] * sigm_f(og[e]);
      u32x2 ov;
      ov.x = pk_fp8x4c(o[0], o[1], o[2], o[3]); ov.y = pk_fp8x4c(o[4], o[5], o[6], o[7]);
      *(u32x2*)(mo + 512) = ov;
    }
  }
}

using f32x4v = __attribute__((ext_vector_type(4))) float;
__device__ void ph_ln_router(KP p, int layer, bool keep, char* smc) {
  bf16_t* h2b = (bf16_t*)smc;
  unsigned long long* s_mask = (unsigned long long*)(smc + META_OFF + 2048);
  int* s_tbase = (int*)(smc + META_OFF + 2048 + 128);
  float* lgs = (float*)smc;
  const int tid = opaque_tid();
  const int lane = tid & 63, wave = tid >> 6;
  const int rows = keep ? NT : NL;
  const float* lng = p->ln_g + (layer * 2 + 0) * 1024;
  const float* lnb = p->ln_b + (layer * 2 + 0) * 1024;
  float* s_par = (float*)(smc + 36864);
  ((float4*)s_par)[tid] = ((const float4*)lng)[tid];
  ((float4*)(s_par + 1024))[tid] = ((const float4*)lnb)[tid];
  bool pend = false;
  int p_t0 = 0, p_tb = 0;
  float p_gate[4] = {0.f, 0.f, 0.f, 0.f};
  int p_kidx[4] = {0, 0, 0, 0}, p_rank[4] = {0, 0, 0, 0};
  bool p_ch[4] = {false, false, false, false};
  auto flush_entries = [&]() {
    const int tb = s_tbase[lane];
#pragma unroll
    for (int q = 0; q < 4; ++q) {
      const int t = p_t0 + wave * 4 + q;
      if (p_ch[q]) {
        const int pos = tb + p_rank[q];
        p->ltok[(size_t)lane * NT + pos] = t;
        p->lgate[(size_t)lane * NT + pos] = p_gate[q];
        p->tsl[t * 6 + p_kidx[q]] = (lane << 16) | pos;
      }
    }
  };
  for (int tile = blockIdx.x; tile < rows / 16; tile += gridDim.x) {
    const int t0 = tile * 16;
    const float* mod = p->MOD + (layer * 9 + modrow(t0)) * 6144;
    const bf16_t* brow = p->WrTb + ((size_t)layer * 64 + 16 * wave + (lane & 15)) * 1024 + 8 * (lane >> 4);
    {
      const float4 st_sh = ((const float4*)(mod + 3072))[tid], st_sc = ((const float4*)(mod + 4096))[tid];
      ((float4*)(s_par + 2048))[tid] = st_sh;
      ((float4*)(s_par + 3072))[tid] = st_sc;
    }
    __builtin_amdgcn_sched_barrier(0);
    bf16x8 b0[8], b1[8], b2[8];
#pragma unroll
    for (int q = 0; q < 8; ++q) { b0[q] = *(const bf16x8*)(brow + 32 * q); b1[q] = *(const bf16x8*)(brow + 32 * (8 + q)); }
    __builtin_amdgcn_sched_barrier(0);
    {
      float4 v[4][4];
      float s4[4];
#pragma unroll
      for (int q = 0; q < 4; ++q) {
        const int t = t0 + wave * 4 + q;
        s4[q] = 0.f;
#pragma unroll
        for (int i = 0; i < 4; ++i) {
          const u32x2 tb = *(const u32x2*)((const bf16_t*)p->Tb + (size_t)t * DM + i * 256 + lane * 4);
          v[q][i] = make_float4(bflo(tb.x), bfhi(tb.x), bflo(tb.y), bfhi(tb.y));
        }
      }
      lds_barrier();
#pragma unroll
      for (int q = 0; q < 4; ++q)
#pragma unroll
        for (int i = 0; i < 4; ++i) s4[q] += (v[q][i].x + v[q][i].y) + (v[q][i].z + v[q][i].w);
      float mean4[4], rs4[4];
#pragma unroll
      for (int q = 0; q < 4; ++q) mean4[q] = wsum(s4[q]) * (1.f / 1024.f);
#pragma unroll
      for (int q = 0; q < 4; ++q) {
        float qq = 0.f;
#pragma unroll
        for (int i = 0; i < 4; ++i) {
          const float d0 = v[q][i].x - mean4[q], d1 = v[q][i].y - mean4[q], d2 = v[q][i].z - mean4[q], d3 = v[q][i].w - mean4[q];
          qq += (d0 * d0 + d1 * d1) + (d2 * d2 + d3 * d3);
        }
        s4[q] = qq;
      }
#pragma unroll
      for (int q = 0; q < 4; ++q) rs4[q] = rsqrtf(wsum(s4[q]) * (1.f / 1024.f) + 1e-5f);
#pragma unroll
      for (int i = 0; i < 4; ++i) {
        const int n = i * 256 + lane * 4;
        __builtin_amdgcn_sched_barrier(0);
        const float4 g = *(const float4*)(s_par + n), bb = *(const float4*)(s_par + 1024 + n);
        const float4 sh = *(const float4*)(s_par + 2048 + n), sc = *(const float4*)(s_par + 3072 + n);
#pragma unroll
        for (int q = 0; q < 4; ++q) {
          const int tl = wave * 4 + q, t = t0 + tl;
          const float mean = mean4[q], rs = rs4[q];
          const float4 xn = make_float4((v[q][i].x - mean) * rs * g.x + bb.x, (v[q][i].y - mean) * rs * g.y + bb.y,
                                        (v[q][i].z - mean) * rs * g.z + bb.z, (v[q][i].w - mean) * rs * g.w + bb.w);
          { u32x2 xo2; xo2.x = pk_bf16(xn.x, xn.y); xo2.y = pk_bf16(xn.z, xn.w); *(u32x2*)((bf16_t*)p->X + (size_t)t * DM + n) = xo2; }
          const float4 hh = make_float4(xn.x * (1.f + sc.x) + sh.x, xn.y * (1.f + sc.y) + sh.y,
                                        xn.z * (1.f + sc.z) + sh.z, xn.w * (1.f + sc.w) + sh.w);
          *(unsigned*)((unsigned char*)p->AB + (size_t)t * DM + n) = pk_fp8x4c(hh.x, hh.y, hh.z, hh.w);
          { u32x2 hb2; hb2.x = pk_bf16(hh.x, hh.y); hb2.y = pk_bf16(hh.z, hh.w); *(u32x2*)(h2b + tl * 1032 + n) = hb2; }
        }
      }
    }
    if (pend && wave == 0) s_tbase[lane] = p_tb;
    lds_barrier();
    if (pend) flush_entries();
    f32x4v acc = {0.f, 0.f, 0.f, 0.f};
    {
      f32x4v a1 = {0.f, 0.f, 0.f, 0.f}, a2 = {0.f, 0.f, 0.f, 0.f}, a3 = {0.f, 0.f, 0.f, 0.f};
      const int i = lane & 15, kk = lane >> 4;
      const bf16_t* arow = h2b + i * 1032 + 8 * kk;
#define ROUTER_LOAD(B, Q0) _Pragma("unroll") for (int q = 0; q < 8; ++q) B[q] = *(const bf16x8*)(brow + 32 * ((Q0) + q)); __builtin_amdgcn_sched_barrier(0);
#define ROUTER_MFMA(B, Q0) _Pragma("unroll") for (int q = 0; q < 8; q += 4) { \
        acc = __builtin_amdgcn_mfma_f32_16x16x32_bf16(*(const bf16x8*)(arow + 32 * ((Q0) + q)), B[q], acc, 0, 0, 0); \
        a1 = __builtin_amdgcn_mfma_f32_16x16x32_bf16(*(const bf16x8*)(arow + 32 * ((Q0) + q + 1)), B[q + 1], a1, 0, 0, 0); \
        a2 = __builtin_amdgcn_mfma_f32_16x16x32_bf16(*(const bf16x8*)(arow + 32 * ((Q0) + q + 2)), B[q + 2], a2, 0, 0, 0); \
        a3 = __builtin_amdgcn_mfma_f32_16x16x32_bf16(*(const bf16x8*)(arow + 32 * ((Q0) + q + 3)), B[q + 3], a3, 0, 0, 0); } __builtin_amdgcn_sched_barrier(0);
      ROUTER_LOAD(b2, 16) ROUTER_MFMA(b0, 0)
      ROUTER_LOAD(b0, 24) ROUTER_MFMA(b1, 8)
      ROUTER_MFMA(b2, 16)
      ROUTER_MFMA(b0, 24)
      acc = (acc + a1) + (a2 + a3);
    }
    lds_barrier();
#pragma unroll
    for (int r = 0; r < 4; ++r) lgs[((lane >> 4) * 4 + r) * 64 + 16 * wave + (lane & 15)] = acc[r];
    lds_barrier();
    {
      float score4[4], gate4[4];
      int kidx4[4], pos4[4];
      bool chosen4[4];
#pragma unroll
      for (int q = 0; q < 4; ++q) {
        const int tl = wave * 4 + q;
        const float logit = lgs[tl * 64 + lane];
        const float score = sigm_f(logit);
        float sel = score + p->moe_bias[layer * 64 + lane];
        bool chosen = false;
        for (int r = 0; r < 6; ++r) {
          const float mx = wmax(sel);
          const unsigned long long bal = __ballot(sel == mx);
          const int first = __ffsll((long long)bal) - 1;
          if (lane == first) { chosen = true; sel = -INFINITY; }
        }
        const float gsum = wsum(chosen ? score : 0.f);
        const unsigned long long cb = __ballot(chosen);
        score4[q] = score; gate4[q] = score / gsum * 2.5f; chosen4[q] = chosen;
        kidx4[q] = __popcll(cb & ((1ull << lane) - 1ull));
        if (lane == 0) s_mask[tl] = cb;
      }
      lds_barrier();
      int cnt_e = 0, rank4[4] = {0, 0, 0, 0};
#pragma unroll
      for (int tl = 0; tl < 16; ++tl) {
        if ((tl >> 2) == wave) rank4[tl & 3] = cnt_e;
        cnt_e += (int)((s_mask[tl] >> lane) & 1ull);
      }
      if (wave == 0) p_tb = cnt_e > 0 ? atomicAdd(&p->cnt[lane * CSTR], cnt_e) : 0;
      pend = true; p_t0 = t0;
#pragma unroll
      for (int q = 0; q < 4; ++q) { p_gate[q] = gate4[q]; p_kidx[q] = kidx4[q]; p_rank[q] = rank4[q]; p_ch[q] = chosen4[q]; }
    }
    lds_barrier();
  }
  if (pend) {
    if (wave == 0) s_tbase[lane] = p_tb;
    __syncthreads();
    flush_entries();
  }
}

__device__ __forceinline__ void moe_prefix(KP p, int rows, int* s_pref, int tid) {
  if (tid < 64) {
    const int c = p->cnt[tid * CSTR];
    s_pref[322 + tid] = c;
    const int tiles = (c + 127) >> 7;
    int incl = tiles;
#pragma unroll
    for (int o = 1; o < 64; o <<= 1) {
      const int up = __shfl_up(incl, o);
      if (tid >= o) incl += up;
    }
    s_pref[tid] = incl - tiles;
    if (tid == 63) { s_pref[64] = incl; s_pref[65] = incl + (rows >> 7); }
  }
  __syncthreads();
}

__device__ void ph_gemm(KP p, int kind, int layer, bool keep, char* lds) {
  const int tid = opaque_tid();
  const int j = layer >> 1;
  const bool att = !(layer & 1);
  const int rows = keep ? NT : NL;
  int* pref = (int*)(lds + META_OFF);
  int* s_idx = pref + 66;
  float* s_gate = (float*)(s_idx + 128);
  if (kind == 1 && blockIdx.x == 0 && tid < 65) p->cnt[tid * CSTR] = 0;
  int total;
  const int ntn_in = att ? 18 : 33;
  switch (kind) {
    case 0: total = (NT / 128) * ntn_in; break;
    case 1: total = (rows / 128) * 8; break;
    case 2: total = pref[65] * 4; break;
    case 3: total = pref[65] * 8; break;
    case 4: total = (NT / 128) * 3; break;
    default: total = (NT / 128) * 20; break;
  }
  const bool moe = kind == 2 || kind == 3;
  const int tsh = kind == 2 ? 2 : 3;
  int e_nx = 0, idx_nx = tid; float g_nx = 1.f;
  auto fetch_moe = [&](int tl) {
    const int mt = tl >> tsh;
    while (mt >= pref[e_nx + 1]) ++e_nx;
    idx_nx = tid; g_nx = 1.f;
    if (tid < 128) {
      const int pos = (mt - pref[e_nx]) * 128 + tid;
      if (kind == 2) {
        idx_nx = 0;
        if (e_nx < 64) { if (pos < pref[322 + e_nx]) idx_nx = p->ltok[(size_t)e_nx * NT + pos]; }
        else idx_nx = pos;
      } else if (e_nx < 64) g_nx = pos < pref[322 + e_nx] ? p->lgate[(size_t)e_nx * NT + pos] : 0.f;
    }
  };
  const int xcd = blockIdx.x & 7, lb = blockIdx.x >> 3, nbx = ((int)gridDim.x - xcd + 7) >> 3;
  const int t_beg = (int)(((long long)total * xcd) >> 3), t_end = (int)(((long long)total * (xcd + 1)) >> 3);
  if (moe && t_beg + lb < t_end) fetch_moe(t_beg + lb);
  for (int tile = t_beg + lb; tile < t_end; tile += nbx) {
    const bf16_t* Abase; const bf16_t* Bt;
    int astride, K, n0, m0 = 0, aux = 0, e = e_nx, mtile = 0;
    switch (kind) {
      case 0: { const int tm = tile / ntn_in, tn = tile % ntn_in; m0 = tm * 128; n0 = tn * 128;
                Abase = (const bf16_t*)((const unsigned char*)p->AB + (size_t)m0 * DM); astride = DM; K = 1024;
                Bt = (const bf16_t*)(att ? (const unsigned char*)p->Wt_att + (size_t)j * ATT_N * 1024
                                         : (const unsigned char*)p->Wt_rec + (size_t)j * REC_NP * 1024); } break;
      case 1: { const int tm = tile >> 3, tn = tile & 7; m0 = tm * 128; n0 = tn * 128;
                Abase = (const bf16_t*)((const unsigned char*)p->AB + (size_t)m0 * DM); astride = DM; K = 1024;
                Bt = (const bf16_t*)((const unsigned char*)p->Wt_out + (size_t)layer * 1024 * 1024); } break;
      case 2: { mtile = tile >> 2; aux = tile & 3; n0 = aux * 128;
                Abase = p->AB; astride = DM; K = 1024;
                Bt = (const bf16_t*)((const unsigned char*)p->Wt13 + (size_t)(layer * 65 + e) * 512 * 1024); } break;
      case 3: { mtile = tile >> 3; aux = tile & 7; n0 = aux * 128;
                Abase = (const bf16_t*)((const unsigned char*)p->ACT + (size_t)mtile * 128 * 256); astride = 256; K = 256;
                Bt = (const bf16_t*)((const unsigned char*)p->Wt2 + (size_t)(layer * 65 + e) * 1024 * 256); } break;
      case 4: { const int tm = tile / 3; aux = tile % 3; m0 = tm * 128; n0 = 0;
                Abase = p->Zb + (size_t)m0 * 1536 + aux * 512; astride = 1536; K = 512; Bt = p->Wl1 + (size_t)(j * 3 + aux) * 128 * 512; } break;
      default: { const int tm = tile / 20; aux = tile % 20; m0 = tm * 128; n0 = aux * 128;
                const int grp = aux < 8 ? 0 : (aux < 16 ? 1 : 2);
                Abase = p->L1 + (size_t)m0 * 384 + grp * 128; astride = 384; K = 128; Bt = p->Wl2 + (size_t)j * 2560 * 128; } break;
    }
    if (tid < 128) { s_idx[tid] = idx_nx; s_gate[tid] = g_nx; }
    __syncthreads();
    if (moe && tile + nbx < t_end) fetch_moe(tile + nbx);
    {
      f32x16 acc[2][2];
      if (kind <= 3) {
        const unsigned char* A8 = (const unsigned char*)Abase;
        gemm128_fp8(tid, [&](int r) { return A8 + (size_t)s_idx[r] * astride; }, (const unsigned char*)Bt, K, n0, lds, acc);
      } else
        gemm128_main(tid, [&](int r) { return Abase + (size_t)s_idx[r] * astride; }, Bt, K, n0, lds, acc);
      float* Ct = (float*)lds;
      acc_foreach(tid, acc, [&](int row, int col, float v) { Ct[row * 128 + col] = v; });
    }
    __syncthreads();
    {
      const float* Ct = (const float*)lds;
      int c4 = (tid & 31) * 4, r0 = tid >> 5;
      asm volatile("" : "+v"(c4), "+v"(r0));
      const int N_in = att ? ATT_N : REC_N;
      const int d5 = (aux >> 2) & 1, c05 = (aux & 3) * 128;
      switch (kind) {
        case 0: {
          int c8 = (tid & 15) * 8, r8 = tid >> 4;
          asm volatile("" : "+v"(c8), "+v"(r8));
          const int cn = n0 + c8;
          const bool gqa = att && n0 >= 1536 && n0 < 2176;
#pragma unroll 4
          for (int it = 0; it < 8; ++it) {
            const int row = it * 16 + r8;
            const float4 ra = *(const float4*)(Ct + row * 128 + c8), rb = *(const float4*)(Ct + row * 128 + c8 + 4);
            float v[8] = {ra.x * W8_INV, ra.y * W8_INV, ra.z * W8_INV, ra.w * W8_INV,
                          rb.x * W8_INV, rb.y * W8_INV, rb.z * W8_INV, rb.w * W8_INV};
            if (!att && cn >= 4096 && cn < 4112) {
              float* gp = p->GP + (size_t)(m0 + row) * 16 + (cn - 4096);
              *(float4*)(gp) = make_float4(v[0], v[1], v[2], v[3]);
              *(float4*)(gp + 4) = make_float4(v[4], v[5], v[6], v[7]);
            }
            if (gqa) {
              float ss = 0.f;
#pragma unroll
              for (int e = 0; e < 8; ++e) ss = fmaf(v[e], v[e], ss);
              ss += dppx<0xB1>(ss); ss += dppx<0x4E>(ss); ss += dppx<0x141>(ss);
              const float rs = rsqrtf(ss * (1.f / 64.f) + 1e-6f);
              const float* gq = p->qk_gain + j * 128 + (n0 >= 2048 ? 64 : 0) + (cn & 63);
              const float4 g0 = *(const float4*)(gq), g1 = *(const float4*)(gq + 4);
              const float gg[8] = {g0.x, g0.y, g0.z, g0.w, g1.x, g1.y, g1.z, g1.w};
#pragma unroll
              for (int e = 0; e < 8; ++e) v[e] *= rs * gg[e];
              const int t = m0 + row;
              if (t < NL) {
                const int sidx = t & 2047, pi0 = (cn & 63) >> 1;
                const int pos = pi0 < 16 ? (sidx >> 6) : (sidx & 63);
                const float* cp = p->ROPE + (pos * 16 + (pi0 & 15)) * 2;
                const float4 c0 = *(const float4*)(cp), c1 = *(const float4*)(cp + 4);
                const float cs[8] = {c0.x, c0.y, c0.z, c0.w, c1.x, c1.y, c1.z, c1.w};
#pragma unroll
                for (int e = 0; e < 4; ++e) {
                  const float a = v[2 * e], bq = v[2 * e + 1];
                  v[2 * e] = a * cs[2 * e] - bq * cs[2 * e + 1];
                  v[2 * e + 1] = a * cs[2 * e + 1] + bq * cs[2 * e];
                }
              }
            }
            if (cn < N_in) {
              u32x4 o;
              o.x = pk_bf16(v[0], v[1]); o.y = pk_bf16(v[2], v[3]); o.z = pk_bf16(v[4], v[5]); o.w = pk_bf16(v[6], v[7]);
              *(u32x4*)(p->P + (size_t)(m0 + row) * LDP + cn) = o;
            }
          }
        } break;
        case 1: {
          int c8 = (tid & 15) * 8, r8 = tid >> 4;
          asm volatile("" : "+v"(c8), "+v"(r8));
          const float* gp = p->MOD + (layer * 9 + modrow(m0)) * 6144 + 2048 + n0 + c8;
          const float4 ga = *(const float4*)(gp), gb = *(const float4*)(gp + 4);
          auto emit = [&](int it, const float (&xx)[8]) {
            const int row = it * 16 + r8;
            const float4 va = *(const float4*)(Ct + row * 128 + c8), vb = *(const float4*)(Ct + row * 128 + c8 + 4);
            const size_t o = (size_t)(m0 + row) * DM + n0 + c8;
            u32x4 tb;
            tb.x = pk_bf16(DN_ALPHA * xx[0] + ga.x * (va.x * W8_INV), DN_ALPHA * xx[1] + ga.y * (va.y * W8_INV));
            tb.y = pk_bf16(DN_ALPHA * xx[2] + ga.z * (va.z * W8_INV), DN_ALPHA * xx[3] + ga.w * (va.w * W8_INV));
            tb.z = pk_bf16(DN_ALPHA * xx[4] + gb.x * (vb.x * W8_INV), DN_ALPHA * xx[5] + gb.y * (vb.y * W8_INV));
            tb.w = pk_bf16(DN_ALPHA * xx[6] + gb.z * (vb.z * W8_INV), DN_ALPHA * xx[7] + gb.w * (vb.w * W8_INV));
            *(u32x4*)((bf16_t*)p->Tb + o) = tb;
          };
          if (layer == 0) {
            const float* xin0 = (m0 < NL ? p->x + (size_t)m0 * DM : p->ctx + (size_t)(m0 - NL) * DM) + n0 + c8;
#pragma unroll 1
            for (int hlf = 0; hlf < 2; ++hlf) {
              typedef float f4v __attribute__((ext_vector_type(4)));
              f4v x0[4], x1[4];
#pragma unroll
              for (int i = 0; i < 4; ++i) {
                const float* xin = xin0 + (size_t)((hlf * 4 + i) * 16 + r8) * DM;
                x0[i] = *(const f4v*)(xin); x1[i] = *(const f4v*)(xin + 4);
              }
#pragma unroll
              for (int i = 0; i < 4; ++i) {
                const float xx[8] = {x0[i].x, x0[i].y, x0[i].z, x0[i].w, x1[i].x, x1[i].y, x1[i].z, x1[i].w};
                emit(hlf * 4 + i, xx);
              }
            }
          } else {
            u32x4 xr[8];
#pragma unroll
            for (int it = 0; it < 8; ++it) xr[it] = *(const u32x4*)((const bf16_t*)p->X + (size_t)(m0 + it * 16 + r8) * DM + n0 + c8);
#pragma unroll
            for (int it = 0; it < 8; ++it) {
              const float xx[8] = {bflo(xr[it].x), bfhi(xr[it].x), bflo(xr[it].y), bfhi(xr[it].y),
                                   bflo(xr[it].z), bfhi(xr[it].z), bflo(xr[it].w), bfhi(xr[it].w)};
              emit(it, xx);
            }
          }
        } break;
        case 2: {
          int cg = ((tid & 15) >> 3) * 64 + (tid & 7) * 4, rg = tid >> 4;
          asm volatile("" : "+v"(cg), "+v"(rg));
#pragma unroll 8
          for (int it = 0; it < 8; ++it) {
            const int row = it * 16 + rg;
            const float4 v = *(const float4*)(Ct + row * 128 + cg);
            const float4 u = *(const float4*)(Ct + row * 128 + cg + 32);
            const float a0 = v.x * W8_INV, a1 = v.y * W8_INV, a2 = v.z * W8_INV, a3 = v.w * W8_INV;
            *(unsigned*)((unsigned char*)p->ACT + ((size_t)mtile * 128 + row) * 256 + aux * 64 + (cg >> 6) * 32 + (cg & 31)) =
                pk_fp8x4c(silu_f(a0) * (u.x * W8_INV), silu_f(a1) * (u.y * W8_INV), silu_f(a2) * (u.z * W8_INV), silu_f(a3) * (u.w * W8_INV));
          }
        } break;
        case 3: {
          int c8 = (tid & 15) * 8, r8 = tid >> 4;
          asm volatile("" : "+v"(c8), "+v"(r8));
#pragma unroll 8
          for (int it = 0; it < 8; ++it) {
            const int row = it * 16 + r8;
            const float4 va = *(const float4*)(Ct + row * 128 + c8), vb = *(const float4*)(Ct + row * 128 + c8 + 4);
            const float g = s_gate[row] * (W8_INV * 16.f);
            u32x2 o; o.x = pk_fp8x4c(g * va.x, g * va.y, g * va.z, g * va.w); o.y = pk_fp8x4c(g * vb.x, g * vb.y, g * vb.z, g * vb.w);
            *(u32x2*)((unsigned char*)p->OUT2 + ((size_t)mtile * 128 + row) * 1024 + n0 + c8) = o;
          }
        } break;
        case 4: {
          int c8 = (tid & 15) * 8, r8 = tid >> 4;
          asm volatile("" : "+v"(c8), "+v"(r8));
#pragma unroll 4
          for (int it = 0; it < 8; ++it) {
            const int row = it * 16 + r8;
            const float4 va = *(const float4*)(Ct + row * 128 + c8), vb = *(const float4*)(Ct + row * 128 + c8 + 4);
            float f[8] = {va.x, va.y, va.z, va.w, vb.x, vb.y, vb.z, vb.w};
            if (aux == 0) {
#pragma unroll
              for (int q = 0; q < 8; ++q) f[q] = tanh_fast(f[q]);
            } else if (aux == 2) {
#pragma unroll
              for (int q = 0; q < 8; ++q) f[q] = sigm_f(f[q]);
            }
            u32x4 o; o.x = pk_bf16(f[0], f[1]); o.y = pk_bf16(f[2], f[3]); o.z = pk_bf16(f[4], f[5]); o.w = pk_bf16(f[6], f[7]);
            *(u32x4*)(p->L1 + (size_t)(m0 + row) * 384 + aux * 128 + c8) = o;
          }
        } break;
        default: {
          int c8 = (tid & 15) * 8, r8 = tid >> 4;
          asm volatile("" : "+v"(c8), "+v"(r8));
          float pa[8], pb[8];
          {
            const float* s0 = (aux < 8 ? p->rwkv_w0 : p->rwkv_a0) + (j * 2 + d5) * 512 + c05 + c8;
            const float* s1 = p->rwkv_kvec + (j * 2 + 1) * 512 + c05 + c8;
            const float4 a0 = *(const float4*)(s0), a1 = *(const float4*)(s0 + 4), k0 = *(const float4*)(s1), k1 = *(const float4*)(s1 + 4);
            pa[0] = a0.x; pa[1] = a0.y; pa[2] = a0.z; pa[3] = a0.w; pa[4] = a1.x; pa[5] = a1.y; pa[6] = a1.z; pa[7] = a1.w;
            pb[0] = k0.x; pb[1] = k0.y; pb[2] = k0.z; pb[3] = k0.w; pb[4] = k1.x; pb[5] = k1.y; pb[6] = k1.z; pb[7] = k1.w;
          }
          auto pack8 = [](const float (&f)[8]) {
            u32x4 o; o.x = pk_bf16(f[0], f[1]); o.y = pk_bf16(f[2], f[3]); o.z = pk_bf16(f[4], f[5]); o.w = pk_bf16(f[6], f[7]);
            return o;
          };
          u32x4 kxa[8];
#pragma unroll
          for (int it = 0; it < 8; ++it) kxa[it] = u32x4{0u, 0u, 0u, 0u};
          if (aux >= 8 && aux < 16) {
#pragma unroll
            for (int it = 0; it < 8; ++it) kxa[it] = *(const u32x4*)(p->RW + (size_t)(m0 + it * 16 + r8) * RWS + c05 + c8 + 10 * 512);
          }
#pragma unroll
          for (int it = 0; it < 8; ++it) {
            const int row = it * 16 + r8;
            const float4 va = *(const float4*)(Ct + row * 128 + c8), vb = *(const float4*)(Ct + row * 128 + c8 + 4);
            const float vv[8] = {va.x, va.y, va.z, va.w, vb.x, vb.y, vb.z, vb.w};
            bf16_t* rr = p->RW + (size_t)(m0 + row) * RWS + c05 + c8;
            if (aux < 8) {
              float e8[8];
#pragma unroll
              for (int q = 0; q < 8; ++q) e8[q] = 0.6065306597126334f * sigm_f(pa[q] + vv[q]);
              *(u32x4*)(rr + (3 + d5) * 512) = pack8(e8);
            } else if (aux < 16) {
              const u32x4 kx4 = kxa[it];
              const float kx[8] = {bflo(kx4.x), bfhi(kx4.x), bflo(kx4.y), bfhi(kx4.y), bflo(kx4.z), bfhi(kx4.z), bflo(kx4.w), bfhi(kx4.w)};
              float av[8], ke[8];
#pragma unroll
              for (int q = 0; q < 8; ++q) { av[q] = sigm_f(pa[q] + vv[q]); ke[q] = kx[q] * (1.f + (av[q] - 1.f) * pb[q]); }
              *(u32x4*)(rr + (7 + d5) * 512) = pack8(av);
              *(u32x4*)(rr + (5 + d5) * 512) = pack8(ke);
            } else {
              *(u32x4*)(rr + 9 * 512) = pack8(vv);
            }
          }
        } break;
      }
    }
    __syncthreads();
  }
}

__device__ void ph_final_ln(KP p, int layer, bool keep, char* lds) {
  const int tid = opaque_tid();
  const int lane = tid & 63, wave = tid >> 6;
  const int rows = keep ? NT : NL;
  int* s_base = (int*)(lds + META_OFF);
  if (tid < 64) {
    const int c = p->cnt[tid * CSTR];
    s_base[128 + tid] = c;
    const int tiles = (c + 127) >> 7;
    int incl = tiles;
#pragma unroll
    for (int o = 1; o < 64; o <<= 1) {
      const int up = __shfl_up(incl, o);
      if (tid >= o) incl += up;
    }
    s_base[tid] = (incl - tiles) * 128;
    if (tid == 63) s_base[64] = incl * 128;
  }
  __syncthreads();
  const float* lng = p->ln_g + (layer * 2 + 1) * 1024;
  const float* lnb = p->ln_b + (layer * 2 + 1) * 1024;
  typedef float f4v __attribute__((ext_vector_type(4)));
  f4v lg[4], lb[4];
#pragma unroll
  for (int c = 0; c < 2; ++c) {
    const int n0 = c * 512 + lane * 8;
    lg[2 * c] = *(const f4v*)(lng + n0); lg[2 * c + 1] = *(const f4v*)(lng + n0 + 4);
    lb[2 * c] = *(const f4v*)(lnb + n0); lb[2 * c + 1] = *(const f4v*)(lnb + n0 + 4);
  }
  const int tstride = gridDim.x * 4;
  u32x2 ta = {0u, 0u}, tb = ta, tc = ta;
  auto ld_tsl = [&](int t) {
    const u32x2* q = (const u32x2*)(p->tsl + (size_t)t * 6);
    ta = q[0]; tb = q[1]; tc = q[2];
  };
  {
    const int t = blockIdx.x * 4 + wave;
    if (t < rows) ld_tsl(t);
  }
  for (int t = blockIdx.x * 4 + wave; t < rows; t += tstride) {
    const int mr = modrow(t);
    const float* g2 = p->MOD + (layer * 9 + mr) * 6144 + 5120;
    const float* modn = p->MOD + ((layer + 1) * 9 + mr) * 6144;
    const unsigned tv[6] = {ta.x, ta.y, tb.x, tb.y, tc.x, tc.y};
    const unsigned char* src[7];
#pragma unroll
    for (int k = 0; k < 6; ++k) {
      const int v = (int)tv[k];
      src[k] = (const unsigned char*)p->OUT2 + (size_t)(s_base[v >> 16] + (v & 0xffff)) * 1024;
    }
    src[6] = (const unsigned char*)p->OUT2 + (size_t)(s_base[64] + t) * 1024;
    u32x2 er[2][7];
    u32x4 xr[2];
    f4v ga[2], gb[2], sha[2], shb[2], sca[2], scb[2];
#pragma unroll
    for (int c = 0; c < 2; ++c) {
      const int n0 = c * 512 + lane * 8;
#pragma unroll
      for (int k = 0; k < 7; ++k) er[c][k] = *(const u32x2*)(src[k] + n0);
      xr[c] = *(const u32x4*)((const bf16_t*)p->X + (size_t)t * DM + n0);
      ga[c] = *(const f4v*)(g2 + n0); gb[c] = *(const f4v*)(g2 + n0 + 4);
      if (layer != 3) {
        sha[c] = *(const f4v*)(modn + n0); shb[c] = *(const f4v*)(modn + n0 + 4);
        sca[c] = *(const f4v*)(modn + 1024 + n0); scb[c] = *(const f4v*)(modn + 1024 + n0 + 4);
      }
    }
    if (t + tstride < rows) ld_tsl(t + tstride);
    float v[16];
    float s = 0.f;
#pragma unroll
    for (int c = 0; c < 2; ++c) {
      float y[8];
#pragma unroll
      for (int q = 0; q < 8; ++q) y[q] = 0.f;
#pragma unroll
      for (int k = 0; k < 7; ++k) {
        const u32x2 u = er[c][k];
        const auto f0 = __builtin_amdgcn_cvt_pk_f32_fp8((int)u.x, false), f1 = __builtin_amdgcn_cvt_pk_f32_fp8((int)u.x, true);
        const auto f2 = __builtin_amdgcn_cvt_pk_f32_fp8((int)u.y, false), f3 = __builtin_amdgcn_cvt_pk_f32_fp8((int)u.y, true);
        y[0] += f0[0]; y[1] += f0[1]; y[2] += f1[0]; y[3] += f1[1];
        y[4] += f2[0]; y[5] += f2[1]; y[6] += f3[0]; y[7] += f3[1];
      }
      const float xx[8] = {bflo(xr[c].x), bfhi(xr[c].x), bflo(xr[c].y), bfhi(xr[c].y), bflo(xr[c].z), bfhi(xr[c].z), bflo(xr[c].w), bfhi(xr[c].w)};
      const float gg[8] = {ga[c].x, ga[c].y, ga[c].z, ga[c].w, gb[c].x, gb[c].y, gb[c].z, gb[c].w};
#pragma unroll
      for (int q = 0; q < 8; ++q) { v[c * 8 + q] = DN_ALPHA * xx[q] + gg[q] * (y[q] * 0.0625f); s += v[c * 8 + q]; }
    }
    const float mean = wsum(s) * (1.f / 1024.f);
    float q2 = 0.f;
#pragma unroll
    for (int i = 0; i < 16; ++i) { const float d = v[i] - mean; q2 += d * d; }
    const float rs = rsqrtf(wsum(q2) * (1.f / 1024.f) + 1e-5f);
#pragma unroll
    for (int c = 0; c < 2; ++c) {
      const int n0 = c * 512 + lane * 8;
      const float lgv[8] = {lg[2 * c].x, lg[2 * c].y, lg[2 * c].z, lg[2 * c].w, lg[2 * c + 1].x, lg[2 * c + 1].y, lg[2 * c + 1].z, lg[2 * c + 1].w};
      const float lbv[8] = {lb[2 * c].x, lb[2 * c].y, lb[2 * c].z, lb[2 * c].w, lb[2 * c + 1].x, lb[2 * c + 1].y, lb[2 * c + 1].z, lb[2 * c + 1].w};
      float xn[8];
#pragma unroll
      for (int q = 0; q < 8; ++q) xn[q] = (v[c * 8 + q] - mean) * rs * lgv[q] + lbv[q];
      if (layer == 3) {
        float* xo = p->out + (size_t)t * DM + n0;
        *(float4*)(xo) = make_float4(xn[0], xn[1], xn[2], xn[3]);
        *(float4*)(xo + 4) = make_float4(xn[4], xn[5], xn[6], xn[7]);
      } else {
        u32x4 xo4;
        xo4.x = pk_bf16(xn[0], xn[1]); xo4.y = pk_bf16(xn[2], xn[3]); xo4.z = pk_bf16(xn[4], xn[5]); xo4.w = pk_bf16(xn[6], xn[7]);
        *(u32x4*)((bf16_t*)p->X + (size_t)t * DM + n0) = xo4;
        const float shv[8] = {sha[c].x, sha[c].y, sha[c].z, sha[c].w, shb[c].x, shb[c].y, shb[c].z, shb[c].w};
        const float scv[8] = {sca[c].x, sca[c].y, sca[c].z, sca[c].w, scb[c].x, scb[c].y, scb[c].z, scb[c].w};
        float hb[8];
#pragma unroll
        for (int q = 0; q < 8; ++q) hb[q] = xn[q] * (1.f + scv[q]) + shv[q];
        u32x2 o;
        o.x = pk_fp8x4c(hb[0], hb[1], hb[2], hb[3]); o.y = pk_fp8x4c(hb[4], hb[5], hb[6], hb[7]);
        *(u32x2*)((unsigned char*)p->AB + (size_t)t * DM + n0) = o;
      }
    }
  }
}

#define XB_TMO      128
#define XB_XCNT(j)  (256  + 64 * (j))
#define XB_XSUB(j)  (1280 + 64 * (j))
#define XB_XGEN(j)  (2304 + 64 * (j))
#define XB_TOP      3328
#define XB_TOPGEN   3392
#define XB_SPIN_CAP (1u << 20)
#define LAS __attribute__((address_space(3)))
__device__ __forceinline__ unsigned xb_ld(unsigned* p) { return __hip_atomic_load(p, __ATOMIC_RELAXED, __HIP_MEMORY_SCOPE_AGENT); }
__device__ __forceinline__ unsigned xb_add(unsigned* p, unsigned v) { return __hip_atomic_fetch_add(p, v, __ATOMIC_RELAXED, __HIP_MEMORY_SCOPE_AGENT); }
__device__ __forceinline__ unsigned xb_xcc_id() { return (unsigned)__builtin_amdgcn_s_getreg((3 << 11) | 20) & 0xFu; }
#define XB_SPIN(cond, bar) do { unsigned _sp = 0; while (cond) { __builtin_amdgcn_s_sleep(1); \
    if ((++_sp & 255u) == 0u) { if (xb_ld(&(bar)[XB_TMO])) break; if (_sp > XB_SPIN_CAP) { atomicAdd(&(bar)[XB_TMO], 1u); break; } } } } while (0)
struct XcdBarrier { unsigned* bar; unsigned x; volatile LAS unsigned* st; };
__device__ __forceinline__ XcdBarrier xcd_barrier_post(unsigned* bar, volatile LAS unsigned* st) {
  XcdBarrier b; b.bar = bar; b.x = xb_xcc_id(); b.st = st;
  if (threadIdx.x == 0) (void)xb_add(&bar[XB_XCNT(b.x)], 1u);
  return b;
}
__device__ __forceinline__ void xcd_barrier_complete(unsigned* bar, unsigned x, unsigned& nloc, unsigned& nx) {
  const unsigned G = gridDim.x;
  unsigned sum, cnt, mine, sp = 0u;
  for (;;) {
    sum = 0u; cnt = 0u; mine = 0u;
#pragma unroll
    for (unsigned j = 0; j < 16; ++j) { const unsigned c = xb_ld(&bar[XB_XCNT(j)]); sum += c; cnt += (c > 0u) ? 1u : 0u; mine = (j == x) ? c : mine; }
    if (sum == G) break;
    __builtin_amdgcn_s_sleep(1);
    if ((++sp & 255u) == 0u) { if (xb_ld(&bar[XB_TMO])) break; if (sp > XB_SPIN_CAP) { atomicAdd(&bar[XB_TMO], 1u); break; } }
  }
  nloc = mine > 0u ? mine : 1u; nx = cnt > 0u ? cnt : 1u;
}
__device__ __forceinline__ void xcd_barrier(const XcdBarrier& b) {
  asm volatile("s_waitcnt vmcnt(0)" ::: "memory");
  __syncthreads();
  if (threadIdx.x == 0) {
    unsigned* bar = b.bar;
    __builtin_amdgcn_s_waitcnt(0);
    unsigned nloc = b.st[0], nx = b.st[1];
    if (nloc == 0u) { xcd_barrier_complete(bar, b.x, nloc, nx); b.st[0] = nloc; b.st[1] = nx; }
    const unsigned old = xb_add(&bar[XB_XSUB(b.x)], 1u);
    const unsigned gen = old / nloc;
    if (old + 1u == (gen + 1u) * nloc) {
      __builtin_amdgcn_fence(__ATOMIC_RELEASE, "agent");
      asm volatile("s_waitcnt vmcnt(0)" ::: "memory");
      const unsigned og = xb_add(&bar[XB_TOP], 1u);
      const unsigned tg = og / nx;
      if (og + 1u == (tg + 1u) * nx) xb_add(&bar[XB_TOPGEN], 1u);
      else XB_SPIN(xb_ld(&bar[XB_TOPGEN]) == tg, bar);
      __builtin_amdgcn_fence(__ATOMIC_ACQUIRE, "agent");
      xb_add(&bar[XB_XGEN(b.x)], 1u);
      asm volatile("s_waitcnt vmcnt(0)" ::: "memory");
    } else {
      XB_SPIN(xb_ld(&bar[XB_XGEN(b.x)]) == gen, bar);
      __builtin_amdgcn_fence(__ATOMIC_ACQUIRE, "agent");
      asm volatile("s_waitcnt vmcnt(0)" ::: "memory");
    }
  }
  __syncthreads();
}

constexpr int NSLOTS = 13;
constexpr int NPHASE = 2 + 4 * NSLOTS;
__device__ __forceinline__ bool phase_is_nop(int ph) {
  if (ph < 2) return false;
  const int layer = (ph - 2) / NSLOTS, st = (ph - 2) % NSLOTS;
  if (st == 5 || st == 6) return true;
  return !(layer & 1) && (st == 1 || (st >= 3 && st <= 7));
}
__device__ void run_phase(KP p, int ph, char* sm) {
  if (ph == 0) { ph_init(p, sm); return; }
  if (ph == 1) { ph_mod_h(p, sm); return; }
  const int layer = (ph - 2) / NSLOTS, st = (ph - 2) % NSLOTS;
  const bool odd = layer & 1;
  const bool keep = layer < 3;
  int gk = -1;
  if (st == 0) gk = 0;
  else if (st == 8) gk = 1;
  else if (st == 10) gk = 2;
  else if (st == 11) gk = 3;
  else if (odd && st == 2) gk = 4;
  else if (odd && st == 3) gk = 5;
  asm volatile("" : "+s"(gk));
  if (gk >= 0) {
    if (gk == 2 || gk == 3) moe_prefix(p, keep ? NT : NL, (int*)(sm + META_OFF), opaque_tid());
    ph_gemm(p, gk, layer, keep, sm);
    if (gk == 5) { __syncthreads(); ph_mlstm_s2(p, sm); }
    return;
  }
  switch (st) {
    case 1: if (odd) { ph_rwkv_mix(p, layer); ph_mlstm_s1(p, layer, sm); } break;
    case 2: ph_attention(p, layer, keep, sm); break;
    case 4: if (odd) ph_scan_a(p, layer, sm); break;
    case 7: if (odd) ph_rec_final(p, layer, keep); break;
    case 9: ph_ln_router(p, layer, keep, sm); break;
    case 12: ph_final_ln(p, layer, keep, sm); break;
  }
}

__global__ void __launch_bounds__(NTHR, 2) mega_kernel(Params kargs) {
  extern __shared__ __attribute__((aligned(16))) char sm[];
  cg::grid_group grid = cg::this_grid();
  volatile LAS unsigned* st = (volatile LAS unsigned*)(sm + META_OFF + 4032);
  if (threadIdx.x == 0) { st[0] = 0u; st[1] = 0u; }
  __syncthreads();
  const XcdBarrier xb = xcd_barrier_post(kargs.bar, st);
  for (int ph = kargs.ph_lo; ph < kargs.ph_hi; ++ph) {
    if (phase_is_nop(ph)) continue;
    {
      KP kp = (KP)__builtin_amdgcn_kernarg_segment_ptr();
      asm volatile("" : "+s"(kp));
      run_phase(kp, ph, sm);
    }
    if (ph + 1 < kargs.ph_hi) {
      if (ph == 0) grid.sync();
      else xcd_barrier(xb);
    }
  }
}

extern "C" void kernel_launch(void* const* d_in, const int* in_sizes, int n_in, void* d_out, int out_size, void* d_ws,
                              size_t ws_size, hipStream_t stream) {
  static int grid_blocks = 0;
  if (!grid_blocks) {
    int dev = 0, cus = 0, per_cu = 0;
    (void)hipGetDevice(&dev);
    (void)hipDeviceGetAttribute(&cus, hipDeviceAttributeMultiprocessorCount, dev);
    (void)hipFuncSetAttribute((const void*)mega_kernel, hipFuncAttributeMaxDynamicSharedMemorySize, SMEM_BYTES);
    (void)hipOccupancyMaxActiveBlocksPerMultiprocessor(&per_cu, mega_kernel, NTHR, SMEM_BYTES);
    if (per_cu < 1) per_cu = 1;
    if (per_cu > 2) per_cu = 2;
    grid_blocks = cus * per_cu;
  }
  Params p;
  memset(&p, 0, sizeof(p));
  const float** pin = (const float**)&p;
  for (int i = 0; i < 35; ++i) pin[i] = (const float*)d_in[i];
  p.out = (float*)d_out;
  char* w = (char*)d_ws;
  size_t off = 0;
  auto take = [&](size_t bytes) { char* r = w + off; off += (bytes + 255) & ~(size_t)255; return r; };
  p.Wt_att = (bf16_t*)take((size_t)2 * ATT_N * 1024 * 2);
  p.Wt_rec = (bf16_t*)take((size_t)2 * REC_NP * 1024 * 2);
  p.Wt_out = (bf16_t*)take((size_t)4 * 1024 * 1024 * 2);
  p.Wt13 = (bf16_t*)take((size_t)4 * 65 * 512 * 1024);
  p.Wt2 = (bf16_t*)take((size_t)4 * 65 * 1024 * 256);
  p.Wl1 = (bf16_t*)take((size_t)2 * 3 * 128 * 512 * 2);
  p.Wl2 = (bf16_t*)take((size_t)2 * 2560 * 128 * 2);
  p.X = (float*)take((size_t)NT * DM * 4);
  p.AB = (bf16_t*)take((size_t)NT * DM * 2);
  p.MOD = (float*)take((size_t)5 * 9 * 6144 * 4);
  p.MODP = (float*)take((size_t)8 * 4 * 9 * 6144 * 4);
  p.GP = (float*)take((size_t)NT * 16 * 4);
  p.ROPE = (float*)take((size_t)64 * 16 * 2 * 4);
  p.WrTb = (bf16_t*)take((size_t)4 * 64 * 1024 * 2);
  p.msc = (float*)take((size_t)3 * NMT * 4);
  p.lgate = (float*)take((size_t)64 * NT * 4);
  p.ltok = (int*)take((size_t)64 * NT * 4);
  p.tsl = (int*)take((size_t)NT * 6 * 4);
  p.cnt = (int*)take((size_t)65 * CSTR * 4);
  p.bar = (unsigned*)take((size_t)BAR_TOTAL_WORDS * 4);
  char* region = take(0);
  const size_t szP = (size_t)NT * LDP * 2, szRW = (size_t)NT * RWS * 2, szMS = (size_t)NMT * 16384 * 2,
               szMSn = (size_t)NMT * 128 * 4;
  const size_t szT = (size_t)NT * DM * 4, szOUT2 = (size_t)NSLOT * 1024 * 2;
  p.P = (bf16_t*)region;
  p.RW = (bf16_t*)(region + szP);
  p.MS = (bf16_t*)(region + szP + szRW);
  p.MSn = (float*)(region + szP + szRW + szMS);
  p.Tb = (float*)region;
  p.ACT = (bf16_t*)region;
  p.OUT2 = (bf16_t*)(region + szT);
  const size_t szZ = (size_t)NT * 2048 * 2;
  p.Zb = (bf16_t*)(region + szP + szRW + szMS + szMSn);
  p.L1 = p.Zb + (size_t)NT * 1536;
  size_t mixer = szP + szRW + szMS + szMSn + szZ, moe = szT + szOUT2;
  off += (mixer > moe ? mixer : moe);
  if (off > ws_size) { fprintf(stderr, "workspace too small: need %zu have %zu\n", off, ws_size); return; }
  p.ph_lo = 0;
  p.ph_hi = NPHASE;
  (void)hipMemsetAsync(p.bar, 0, (size_t)BAR_TOTAL_WORDS * 4, stream);
  void* args[] = {&p};
  hipError_t e = hipLaunchCooperativeKernel((void*)mega_kernel, dim3(grid_blocks), dim3(NTHR), args, SMEM_BYTES, stream);
  if (e != hipSuccess) fprintf(stderr, "cooperative launch failed: %s (grid %d)\n", hipGetErrorString(e), grid_blocks);
}
```
